# Optimizing an MI355X kernel written in HIP

```python
import numpy as np
import jax
import jax.numpy as jnp
from jax import lax

D_MODEL = 1024
BATCH = 16
SEQ = 2048
DEPTH = 2

CTX_LEN = 256
GRID_W = 64
N_DIR = 2
N_BRANCH = 3
BRANCH_WIDTH = 512
RMS_EPS = 1e-6
NEG_INF = -1e30

RWKV_HEAD = 64
RWKV_HEADS = BRANCH_WIDTH // RWKV_HEAD
RWKV_DECAY_LORA = 64
RWKV_A_LORA = 64
RWKV_V_LORA = 32
RWKV_G_LORA = 128
RWKV_LNX_EPS = 64e-5

NA_HEAD = 64
NA_HEADS = BRANCH_WIDTH // NA_HEAD
NA_WIN_R = 8
NA_WIN_C = 16
NA_QC = 16
NA_BAND = NA_QC + NA_WIN_C
NA_NCB = GRID_W // NA_QC

MLSTM_HEADS = 4
MLSTM_DQK = 64
MLSTM_DV = BRANCH_WIDTH // MLSTM_HEADS
MLSTM_CHUNK = 64
GATE_CAP = 15.0
ROPE_ROT = MLSTM_DQK // 4
ROPE_BASE = 10000.0

N_EXPERTS = 64
TOP_K = 8
N_GROUPS = 8
TOPK_GROUPS = 4
D_EXPERT = 128
D_SHARED = 256
ROUTED_SCALE = 2.5

RWKV_COLS = 3 * BRANCH_WIDTH + N_DIR * RWKV_DECAY_LORA + N_DIR * RWKV_A_LORA + RWKV_G_LORA
NA_COLS = 3 * BRANCH_WIDTH
MLSTM_QK = MLSTM_HEADS * MLSTM_DQK
MLSTM_COLS = 2 * MLSTM_QK + 2 * BRANCH_WIDTH + 2 * N_DIR * MLSTM_HEADS
GATE_COLS = N_BRANCH * D_MODEL
IN_COLS = RWKV_COLS + NA_COLS + MLSTM_COLS + GATE_COLS
IN_SPLITS = [RWKV_COLS, RWKV_COLS + NA_COLS, RWKV_COLS + NA_COLS + MLSTM_COLS]
RWKV_SPLITS = [BRANCH_WIDTH, 2 * BRANCH_WIDTH, 3 * BRANCH_WIDTH, 3 * BRANCH_WIDTH + N_DIR * RWKV_DECAY_LORA, 3 * BRANCH_WIDTH + N_DIR * (RWKV_DECAY_LORA + RWKV_A_LORA)]
MLSTM_SPLITS = [MLSTM_QK, 2 * MLSTM_QK, 2 * MLSTM_QK + BRANCH_WIDTH, 2 * MLSTM_QK + 2 * BRANCH_WIDTH, 2 * MLSTM_QK + 2 * BRANCH_WIDTH + N_DIR * MLSTM_HEADS]

kernel_name = 'hybrid_rwkv7_natten_mlstm_moe_dit'


def rms_norm(z, g):
    zf = z.astype(jnp.float32)
    zf = zf * lax.rsqrt(jnp.mean(zf * zf, axis=-1, keepdims=True) + RMS_EPS)
    return zf.astype(z.dtype) * g


def soft_cap(z):
    return GATE_CAP * jnp.tanh(z / GATE_CAP)


def token_shift(z, mu):
    zp = jnp.pad(z, ((0, 0), (1, 1), (0, 0)))
    return z + mu * (0.5 * (zp[:, :-2] + zp[:, 2:]) - z)


def rwkv_features(z, v_first, mu, w0, w2, a0, a2, k_k, k_a, g2, vres):
    B, T, _ = z.shape
    z = token_shift(z, mu)
    r, k, v, wd, ad, gd = jnp.split(z, RWKV_SPLITS, axis=-1)
    wd = wd.reshape(B, T, N_DIR, RWKV_DECAY_LORA)
    ad = ad.reshape(B, T, N_DIR, RWKV_A_LORA)
    w = -jax.nn.softplus(-(w0 + jnp.einsum('btdl,dlc->btdc', jnp.tanh(wd), w2))) - 0.5
    decay = jnp.exp(-jnp.exp(w.astype(jnp.float32)))
    a = jax.nn.sigmoid(a0 + jnp.einsum('btdl,dlc->btdc', ad, a2))
    kk = (k * k_k).astype(jnp.float32).reshape(B, T, RWKV_HEADS, RWKV_HEAD)
    kk = kk / jnp.maximum(jnp.sqrt(jnp.sum(kk * kk, axis=-1, keepdims=True)), 1e-12)
    k_dir = k[:, :, None, :] * (1 + (a - 1) * k_a)
    if vres is None:
        v_first = v
    else:
        v0, v1, v2 = vres
        v = v + (v_first - v) * jax.nn.sigmoid(v0 + (v @ v1) @ v2)
    g = jax.nn.sigmoid(gd) @ g2
    return (r, k_dir, v, decay, a, kk, g), v_first


def rwkv_scan_inputs(feats, d):
    r, k_dir, v, decay, a, kk, g = feats
    B, T, _ = r.shape
    heads = lambda t: t.astype(jnp.float32).reshape(B, T, RWKV_HEADS, RWKV_HEAD)
    return heads(r), heads(decay[:, :, d]), -kk, kk * heads(a[:, :, d]), heads(k_dir[:, :, d]), heads(v)


def wkv_scan(state, r, w, a, b, k, v, reverse):
    def step(S, inp):
        r_t, w_t, a_t, b_t, k_t, v_t = inp
        sa = jnp.einsum('bhvk,bhk->bhv', S, a_t)
        S = S * w_t[:, :, None, :] + sa[..., None] * b_t[:, :, None, :] + v_t[..., None] * k_t[:, :, None, :]
        return S, jnp.einsum('bhvk,bhk->bhv', S, r_t)
    xs = tuple(jnp.moveaxis(t, 1, 0) for t in (r, w, a, b, k, v))
    state, y = lax.scan(step, state, xs, reverse=reverse)
    return state, jnp.moveaxis(y, 0, 1)


def rwkv_readout(y, feats, r_k, lnx_g, lnx_b):
    r, k_dir, v, decay, a, kk, g = feats
    B, T, C = r.shape
    mean = jnp.mean(y, axis=-1, keepdims=True)
    var = jnp.mean(jnp.square(y - mean), axis=-1, keepdims=True)
    yn = ((y - mean) * lax.rsqrt(var + RWKV_LNX_EPS)).reshape(B, T, C).astype(r.dtype) * lnx_g + lnx_b
    rh = r.reshape(B, T, RWKV_HEADS, RWKV_HEAD)
    kh = k_dir.reshape(B, T, N_DIR, RWKV_HEADS, RWKV_HEAD)
    bonus = jnp.einsum('bthn,btdhn,hn->bth', rh, kh, r_k)[..., None] * v.reshape(B, T, RWKV_HEADS, RWKV_HEAD)
    return (yn + bonus.reshape(B, T, C)) * g


def rwkv_mix(zx, zc, vf_x, vf_c, mu, w0, w2, a0, a2, k_k, k_a, r_k, g2, lnx_g, lnx_b, vres, need_ctx):
    fx, vf_x = rwkv_features(zx, vf_x, mu, w0, w2, a0, a2, k_k, k_a, g2, vres)
    fc, vf_c = rwkv_features(zc, vf_c, mu, w0, w2, a0, a2, k_k, k_a, g2, vres)
    B = zx.shape[0]
    y_x = 0.0
    y_c = 0.0
    for d in range(N_DIR):
        rev = d == 1
        s0 = jnp.zeros((B, RWKV_HEADS, RWKV_HEAD, RWKV_HEAD), jnp.float32)
        s_ctx, yc = wkv_scan(s0, *rwkv_scan_inputs(fc, d), reverse=rev)
        _, yx = wkv_scan(s_ctx, *rwkv_scan_inputs(fx, d), reverse=rev)
        y_x = y_x + yx
        y_c = y_c + yc
    out_x = rwkv_readout(y_x, fx, r_k, lnx_g, lnx_b)
    out_c = rwkv_readout(y_c, fc, r_k, lnx_g, lnx_b) if need_ctx else None
    return out_x, out_c, vf_x, vf_c


def neighbourhood_attention(q, k, v, kc, vc, rpb, rows):
    B, S, H, DH = q.shape
    win_r = min(NA_WIN_R, rows)
    qcol = np.arange(GRID_W).reshape(NA_NCB, NA_QC)
    band0 = np.clip(np.arange(NA_NCB) * NA_QC - NA_WIN_C // 2, 0, GRID_W - NA_BAND)
    keycol = band0[:, None] + np.arange(NA_BAND)[None, :]
    cs = np.clip(qcol - NA_WIN_C // 2, 0, GRID_W - NA_WIN_C)
    kcol = keycol[:, None, :]
    col_valid = (kcol >= cs[..., None]) & (kcol < cs[..., None] + NA_WIN_C)
    col_idx = np.clip(kcol - qcol[..., None] + NA_WIN_C - 1, 0, 2 * NA_WIN_C - 2)
    qg = (q * DH ** -0.5).reshape(B, rows, GRID_W, H, DH)
    kg = k.reshape(B, rows, GRID_W, H, DH)
    vg = v.reshape(B, rows, GRID_W, H, DH)
    n_loc = win_r * NA_BAND

    def row_block(r):
        rs = jnp.clip(r - win_r // 2, 0, rows - win_r)
        q_b = lax.dynamic_index_in_dim(qg, r, axis=1, keepdims=False).reshape(B, NA_NCB, NA_QC, H, DH)
        k_b = lax.dynamic_slice_in_dim(kg, rs, win_r, axis=1)[:, :, keycol]
        v_b = lax.dynamic_slice_in_dim(vg, rs, win_r, axis=1)[:, :, keycol]
        s_loc = jnp.einsum('bnqhd,brnkhd->bhnqrk', q_b, k_b).astype(jnp.float32)
        row_off = rs + jnp.arange(win_r) - r + NA_WIN_R - 1
        bias = rpb[:, row_off][:, :, col_idx].transpose(0, 2, 3, 1, 4).astype(jnp.float32)
        s_loc = jnp.where(col_valid[:, :, None, :], s_loc + bias, NEG_INF)
        s_ctx = jnp.einsum('bnqhd,bchd->bhnqc', q_b, kc).astype(jnp.float32)
        s = jnp.concatenate([s_loc.reshape(B, H, NA_NCB, NA_QC, n_loc), s_ctx], axis=-1)
        p = jax.nn.softmax(s, axis=-1).astype(v.dtype)
        p_loc = p[..., :n_loc].reshape(B, H, NA_NCB, NA_QC, win_r, NA_BAND)
        o = jnp.einsum('bhnqrk,brnkhd->bnqhd', p_loc, v_b) + jnp.einsum('bhnqc,bchd->bnqhd', p[..., n_loc:], vc)
        return o.reshape(B, GRID_W, H * DH)

    out = lax.map(row_block, jnp.arange(rows))
    return jnp.moveaxis(out, 0, 1).reshape(B, S, H * DH)


def ctx_attention(q, k, v):
    s = jnp.einsum('bqhd,bkhd->bhqk', q * q.shape[-1] ** -0.5, k).astype(jnp.float32)
    p = jax.nn.softmax(s, axis=-1).astype(v.dtype)
    return jnp.einsum('bhqk,bkhd->bqhd', p, v)


def na_mix(zx, zc, qn_g, kn_g, rpb, rows, need_ctx):
    heads = lambda t: t.reshape(t.shape[0], t.shape[1], NA_HEADS, NA_HEAD)
    qx, kx, vx = jnp.split(zx, 3, axis=-1)
    qc, kc, vc = jnp.split(zc, 3, axis=-1)
    kc = rms_norm(heads(kc), kn_g)
    vc = heads(vc)
    out_x = neighbourhood_attention(rms_norm(heads(qx), qn_g), rms_norm(heads(kx), kn_g), heads(vx), kc, vc, rpb, rows)
    out_c = None
    if need_ctx:
        out_c = ctx_attention(rms_norm(heads(qc), qn_g), kc, vc)
        out_c = out_c.reshape(out_c.shape[0], out_c.shape[1], BRANCH_WIDTH)
    return out_x, out_c


def axial_rope_tables(n_tokens, dtype):
    t = jnp.arange(n_tokens)
    pos = jnp.stack([t // GRID_W, t % GRID_W], axis=-1).astype(jnp.float32)
    inv = ROPE_BASE ** (-jnp.arange(ROPE_ROT, dtype=jnp.float32) / ROPE_ROT)
    ang = pos[:, :, None] * inv
    return jnp.cos(ang).astype(dtype), jnp.sin(ang).astype(dtype)


def apply_axial_rope(z, cos, sin):
    B, T, H, DK = z.shape
    zr = z.reshape(B, T, H, 2, 2, ROPE_ROT)
    z1, z2 = zr[..., 0, :], zr[..., 1, :]
    c, s = cos[None, :, None], sin[None, :, None]
    return jnp.stack([z1 * c - z2 * s, z2 * c + z1 * s], axis=-2).reshape(B, T, H, DK)


def mlstm_features(z, i_bias, f_bias, cos, sin):
    B, T, _ = z.shape
    q, k, v, o, ig, fg = jnp.split(z, MLSTM_SPLITS, axis=-1)
    q = q.reshape(B, T, MLSTM_HEADS, MLSTM_DQK)
    k = k.reshape(B, T, MLSTM_HEADS, MLSTM_DQK)
    if cos is not None:
        q = apply_axial_rope(q, cos, sin)
        k = apply_axial_rope(k, cos, sin)
    v = v.reshape(B, T, MLSTM_HEADS, MLSTM_DV)
    hf = lambda t: t.astype(jnp.float32).transpose(0, 2, 1, 3)
    gate = lambda g, bias: soft_cap(g.reshape(B, T, N_DIR, MLSTM_HEADS).astype(jnp.float32) + bias.astype(jnp.float32)).transpose(2, 0, 3, 1)
    return hf(q), hf(k), hf(v), o, gate(ig, i_bias), gate(fg, f_bias)


def mlstm_chunkwise(q, k, v, ig, fg, state):
    B, H, T, DK = q.shape
    DV = v.shape[-1]
    L = MLSTM_CHUNK
    NC = T // L
    q = q * DK ** -0.5
    split = lambda t: jnp.moveaxis(t.reshape(B, H, NC, L, *t.shape[3:]), 2, 0)
    causal = jnp.tril(jnp.ones((L, L), dtype=bool))

    def step(carry, inp):
        C, n, m = carry
        qc, kc, vc, ic, fc = inp
        b = jnp.cumsum(jax.nn.log_sigmoid(fc), axis=-1)
        d = jnp.where(causal, b[..., :, None] - b[..., None, :] + ic[..., None, :], NEG_INF)
        inter = b + m[..., None]
        m_t = jnp.maximum(inter, jnp.max(d, axis=-1))
        s = jnp.einsum('bhtk,bhsk->bhts', qc, kc) * jnp.exp(d - m_t[..., None])
        sc_inter = jnp.exp(inter - m_t)
        num = sc_inter[..., None] * jnp.einsum('bhtk,bhkv->bhtv', qc, C) + jnp.einsum('bhts,bhsv->bhtv', s, vc)
        den = sc_inter * jnp.einsum('bhtk,bhk->bht', qc, n) + jnp.sum(s, axis=-1)
        h = num / jnp.maximum(jnp.abs(den), jnp.exp(-m_t))[..., None]
        b_last = b[..., -1]
        wlog = b_last[..., None] - b + ic
        m_new = jnp.maximum(b_last + m, jnp.max(wlog, axis=-1))
        dec = jnp.exp(b_last + m - m_new)
        wexp = jnp.exp(wlog - m_new[..., None])
        C = dec[..., None, None] * C + jnp.einsum('bhs,bhsk,bhsv->bhkv', wexp, kc, vc)
        n = dec[..., None] * n + jnp.einsum('bhs,bhsk->bhk', wexp, kc)
        return (C, n, m_new), h

    state, h = lax.scan(step, state, (split(q), split(k), split(v), split(ig), split(fg)))
    return jnp.moveaxis(h, 0, 2).reshape(B, H, T, DV), state


def mlstm_readout(h, o, norm_g):
    B, H, T, DV = h.shape
    h = h.transpose(0, 2, 1, 3)
    h = h * lax.rsqrt(jnp.mean(h * h, axis=-1, keepdims=True) + RMS_EPS)
    h = h.reshape(B, T, H * DV).astype(o.dtype) * norm_g
    return h * jax.nn.sigmoid(o)


def mlstm_mix(zx, zc, i_bias, f_bias, norm_g, cos, sin, need_ctx):
    qx, kx, vx, ox, ix, fx = mlstm_features(zx, i_bias, f_bias, cos, sin)
    qc, kc, vc, oc, ic, fc = mlstm_features(zc, i_bias, f_bias, None, None)
    B = zx.shape[0]
    h_x = 0.0
    h_c = 0.0
    for d in range(N_DIR):
        fl = (lambda t: jnp.flip(t, axis=2)) if d == 1 else (lambda t: t)
        st0 = (jnp.zeros((B, MLSTM_HEADS, MLSTM_DQK, MLSTM_DV), jnp.float32),
               jnp.zeros((B, MLSTM_HEADS, MLSTM_DQK), jnp.float32),
               jnp.zeros((B, MLSTM_HEADS), jnp.float32))
        hc_d, st_ctx = mlstm_chunkwise(fl(qc), fl(kc), fl(vc), fl(ic[d]), fl(fc[d]), st0)
        hx_d, _ = mlstm_chunkwise(fl(qx), fl(kx), fl(vx), fl(ix[d]), fl(fx[d]), st_ctx)
        h_x = h_x + fl(hx_d)
        h_c = h_c + fl(hc_d)
    out_x = mlstm_readout(h_x, ox, norm_g)
    out_c = mlstm_readout(h_c, oc, norm_g) if need_ctx else None
    return out_x, out_c


def merge_branches(ya, yb, yc, gate_cols, w_branch, w_out):
    ga, gb, gc = jnp.split(jax.nn.sigmoid(gate_cols), N_BRANCH, axis=-1)
    merged = ga * (ya @ w_branch[0]) + gb * (yb @ w_branch[1]) + gc * (yc @ w_branch[2])
    return merged @ w_out


def moe_ffn(h, w_router, router_bias, w_gate, w_up, w_down, s_gate, s_up, s_down):
    def per_sample(hs):
        T = hs.shape[0]
        scores = jax.nn.sigmoid((hs @ w_router).astype(jnp.float32))
        sel = scores + router_bias.astype(jnp.float32)
        grp = sel.reshape(T, N_GROUPS, N_EXPERTS // N_GROUPS)
        gscore = jnp.sum(lax.top_k(grp, 2)[0], axis=-1)
        gidx = lax.top_k(gscore, TOPK_GROUPS)[1]
        gmask = jnp.sum(jax.nn.one_hot(gidx, N_GROUPS, dtype=jnp.float32), axis=-2) > 0
        emask = jnp.repeat(gmask, N_EXPERTS // N_GROUPS, axis=-1)
        eidx = lax.top_k(jnp.where(emask, sel, NEG_INF), TOP_K)[1]
        w = jnp.take_along_axis(scores, eidx, axis=-1)
        w = w / jnp.sum(w, axis=-1, keepdims=True) * ROUTED_SCALE
        gates = jnp.sum(jax.nn.one_hot(eidx, N_EXPERTS, dtype=jnp.float32) * w[..., None], axis=-2).astype(hs.dtype)
        hg = jnp.einsum('td,edf->tef', hs, w_gate)
        hu = jnp.einsum('td,edf->tef', hs, w_up)
        routed = jnp.einsum('tef,efd->td', jax.nn.silu(hg) * hu * gates[:, :, None], w_down)
        shared = (jax.nn.silu(hs @ s_gate) * (hs @ s_up)) @ s_down
        return routed + shared
    return lax.map(per_sample, h)


def setup_inputs(seed: int = 0) -> dict:
    key = jax.random.key(seed)
    keys = iter(jax.random.split(key, 64))

    def nrm(shape, scale, shift=0.0):
        return shift + scale * jax.random.normal(next(keys), shape, jnp.float32)

    L, D, C = DEPTH, D_MODEL, BRANCH_WIDTH
    return {
        'x': nrm((BATCH, SEQ, D), 1.0),
        'c': nrm((BATCH, D), 1.0),
        'ctx': nrm((BATCH, CTX_LEN, D), 1.0),
        'c_ctx': nrm((D,), 1.0),
        'w_ada': nrm((L, D, 6 * D), 0.5 * D ** -0.5),
        'b_ada': nrm((L, 6 * D), 0.02),
        'norm1_g': nrm((L, D), 0.1, 1.0),
        'norm2_g': nrm((L, D), 0.1, 1.0),
        'w_in': nrm((L, D, IN_COLS), D ** -0.5),
        'rw_mu': jax.random.uniform(next(keys), (L, RWKV_COLS), jnp.float32),
        'rw_w0': nrm((L, N_DIR, C), 0.5, -1.0),
        'rw_w2': nrm((L, N_DIR, RWKV_DECAY_LORA, C), 0.1),
        'rw_a0': nrm((L, N_DIR, C), 0.5),
        'rw_a2': nrm((L, N_DIR, RWKV_A_LORA, C), 0.1),
        'rw_k_k': nrm((L, C), 0.1, 1.0),
        'rw_k_a': nrm((L, C), 0.1, 1.0),
        'rw_r_k': nrm((L, RWKV_HEADS, RWKV_HEAD), 0.1),
        'rw_g2': nrm((L, RWKV_G_LORA, C), RWKV_G_LORA ** -0.5),
        'rw_lnx_g': nrm((L, C), 0.1, 1.0),
        'rw_lnx_b': nrm((L, C), 0.02),
        'rw_v0': nrm((L - 1, C), 0.5),
        'rw_v1': nrm((L - 1, C, RWKV_V_LORA), C ** -0.5),
        'rw_v2': nrm((L - 1, RWKV_V_LORA, C), 0.1),
        'na_qn_g': nrm((L, NA_HEAD), 0.1, 1.0),
        'na_kn_g': nrm((L, NA_HEAD), 0.1, 1.0),
        'na_rpb': nrm((L, NA_HEADS, 2 * NA_WIN_R - 1, 2 * NA_WIN_C - 1), 0.5),
        'ml_i_bias': nrm((L, N_DIR, MLSTM_HEADS), 0.5, -1.0),
        'ml_f_bias': nrm((L, N_DIR, MLSTM_HEADS), 0.5, 3.0),
        'ml_norm_g': nrm((L, C), 0.1, 1.0),
        'w_branch': nrm((L, N_BRANCH, C, D), C ** -0.5),
        'w_out': nrm((L, D, D), D ** -0.5),
        'moe_router': nrm((L, D, N_EXPERTS), D ** -0.5),
        'moe_bias': nrm((L, N_EXPERTS), 0.01),
        'moe_w_gate': nrm((L, N_EXPERTS, D, D_EXPERT), D ** -0.5),
        'moe_w_up': nrm((L, N_EXPERTS, D, D_EXPERT), D ** -0.5),
        'moe_w_down': nrm((L, N_EXPERTS, D_EXPERT, D), D_EXPERT ** -0.5),
        'sh_w_gate': nrm((L, D, D_SHARED), D ** -0.5),
        'sh_w_up': nrm((L, D, D_SHARED), D ** -0.5),
        'sh_w_down': nrm((L, D_SHARED, D), D_SHARED ** -0.5),
    }


def reference(x, c, ctx, c_ctx, w_ada, b_ada, norm1_g, norm2_g, w_in, rw_mu, rw_w0, rw_w2, rw_a0, rw_a2,
              rw_k_k, rw_k_a, rw_r_k, rw_g2, rw_lnx_g, rw_lnx_b, rw_v0, rw_v1, rw_v2, na_qn_g, na_kn_g, na_rpb,
              ml_i_bias, ml_f_bias, ml_norm_g, w_branch, w_out, moe_router, moe_bias, moe_w_gate, moe_w_up,
              moe_w_down, sh_w_gate, sh_w_up, sh_w_down):
    B, S, D = x.shape
    rows = S // GRID_W
    cos, sin = axial_rope_tables(S, x.dtype)
    s_c = jax.nn.silu(c)
    s_cctx = jax.nn.silu(c_ctx)
    vf_x = None
    vf_c = None
    for l in range(DEPTH):
        need_ctx = l < DEPTH - 1
        mod_x = (s_c @ w_ada[l] + b_ada[l])[:, None, :]
        mod_c = s_cctx @ w_ada[l] + b_ada[l]
        shx1, scx1, gx1, shx2, scx2, gx2 = jnp.split(mod_x, 6, axis=-1)
        shc1, scc1, gc1, shc2, scc2, gc2 = jnp.split(mod_c, 6, axis=-1)
        hx = rms_norm(x, norm1_g[l]) * (1 + scx1) + shx1
        hc = rms_norm(ctx, norm1_g[l]) * (1 + scc1) + shc1
        px = hx @ w_in[l]
        pc = hc @ w_in[l]
        ax, bx, cx, gx = jnp.split(px, IN_SPLITS, axis=-1)
        ac, bc, cc, gcol = jnp.split(pc, IN_SPLITS, axis=-1)
        vres = None if l == 0 else (rw_v0[l - 1], rw_v1[l - 1], rw_v2[l - 1])
        ya_x, ya_c, vf_x, vf_c = rwkv_mix(ax, ac, vf_x, vf_c, rw_mu[l], rw_w0[l], rw_w2[l], rw_a0[l], rw_a2[l],
                                          rw_k_k[l], rw_k_a[l], rw_r_k[l], rw_g2[l], rw_lnx_g[l], rw_lnx_b[l],
                                          vres, need_ctx)
        yb_x, yb_c = na_mix(bx, bc, na_qn_g[l], na_kn_g[l], na_rpb[l], rows, need_ctx)
        yc_x, yc_c = mlstm_mix(cx, cc, ml_i_bias[l], ml_f_bias[l], ml_norm_g[l], cos, sin, need_ctx)
        x = x + gx1 * merge_branches(ya_x, yb_x, yc_x, gx, w_branch[l], w_out[l])
        h2 = rms_norm(x, norm2_g[l]) * (1 + scx2) + shx2
        x = x + gx2 * moe_ffn(h2, moe_router[l], moe_bias[l], moe_w_gate[l], moe_w_up[l], moe_w_down[l],
                              sh_w_gate[l], sh_w_up[l], sh_w_down[l])
        if need_ctx:
            ctx = ctx + gc1 * merge_branches(ya_c, yb_c, yc_c, gcol, w_branch[l], w_out[l])
            hc2 = rms_norm(ctx, norm2_g[l]) * (1 + scc2) + shc2
            ctx = ctx + gc2 * moe_ffn(hc2, moe_router[l], moe_bias[l], moe_w_gate[l], moe_w_up[l], moe_w_down[l],
                                      sh_w_gate[l], sh_w_up[l], sh_w_down[l])
    return x
```

```cpp
#include <hip/hip_runtime.h>
#include <stdint.h>
#include <stdio.h>

#define DEV __device__ __forceinline__
#define UNROLL _Pragma("unroll")

typedef unsigned short bf16_t;
typedef short bf16x8 __attribute__((ext_vector_type(8)));
typedef float f32x16 __attribute__((ext_vector_type(16)));
typedef unsigned u32x4 __attribute__((ext_vector_type(4)));
typedef unsigned u32x2 __attribute__((ext_vector_type(2)));

constexpr int DM = 1024, NBATCH = 16, SEQ = 2048, CTXL = 256;
constexpr int NX = NBATCH * SEQ, NC = NBATCH * CTXL, NT = NX + NC;
constexpr int RW_COLS = 1920, NA_COLS = 1536, ML_COLS = 1552, GATE_COLS = 3072, IN_COLS = 8080;
constexpr int NTHREADS = 512;
constexpr int MOE_CHUNK = 9216, MOE_ST = 768;

enum { I_X = 0, I_C, I_CTX, I_CCTX, I_WADA, I_BADA, I_N1G, I_N2G, I_WIN, I_MU, I_W0, I_W2, I_A0, I_A2, I_KK, I_KA, I_RK, I_G2,
       I_LNG, I_LNB, I_V0, I_V1, I_V2, I_QNG, I_KNG, I_RPB, I_IB, I_FB, I_MNG, I_WBR, I_WOUT, I_RTR, I_MB, I_MWG, I_MWU, I_MWD,
       I_SG, I_SU, I_SD, N_IN };

constexpr size_t OFF_BAR = 0;
constexpr size_t OFF_MOD = 16384;
constexpr size_t OFF_WINT = OFF_MOD + 417792;
constexpr size_t OFF_WBT = OFF_WINT + (size_t)IN_COLS * 1024 * 2;
constexpr size_t OFF_WOUTT = OFF_WBT + (size_t)3 * 1024 * 512 * 2;
constexpr size_t OFF_SGUT = OFF_WOUTT + (size_t)1024 * 1024 * 2;
constexpr size_t OFF_SDT = OFF_SGUT + (size_t)512 * 1024 * 2;
constexpr size_t OFF_G2T = OFF_SDT + (size_t)1024 * 256 * 2;
constexpr size_t OFF_RTR = OFF_G2T + (size_t)512 * 128 * 2;
constexpr size_t OFF_CTXS = OFF_RTR + (size_t)2 * 64 * 1024 * 2;
constexpr size_t OFF_VF = OFF_CTXS + (size_t)NC * 1024 * 4;
constexpr size_t OFF_HX = OFF_VF + (size_t)NT * 512 * 2;
constexpr size_t OFF_BIG = OFF_HX + (size_t)NT * 1024 * 2;
constexpr size_t SZ_Y1 = (size_t)NT * 512 * 2;
constexpr size_t OFF_YA = OFF_BIG, OFF_YB = OFF_YA + SZ_Y1, OFF_YC = OFF_YB + SZ_Y1;
constexpr size_t OFF_PX = OFF_BIG + 3 * SZ_Y1;
constexpr size_t OFF_SCR = OFF_PX + (size_t)NT * RW_COLS * 2;
constexpr size_t SZ_SCR = (size_t)NT * 1152 * 2;
constexpr size_t WS_END = OFF_SCR + SZ_SCR;
constexpr size_t OFF_YS = OFF_YB;
constexpr size_t OFF_SGB = OFF_SCR;
constexpr size_t OFF_CB = OFF_SCR + (size_t)NT * 128 * 2;
constexpr size_t OFF_HS = OFF_SCR;
constexpr size_t OFF_GATES = OFF_PX;
constexpr size_t OFF_MGU = OFF_BIG;
constexpr size_t OFF_MDT = OFF_MGU + (size_t)64 * 256 * 1024 * 2;
constexpr size_t OFF_SA = OFF_MDT + (size_t)64 * 1024 * 128 * 2;
constexpr size_t OFF_EIDX = OFF_SA + (size_t)NT * 256 * 2;
constexpr size_t OFF_EW = OFF_EIDX + (size_t)NT * 8 * 4;
constexpr size_t OFF_LOG = OFF_EW + (size_t)NT * 8 * 4;
constexpr size_t OFF_H2LO = OFF_LOG + (size_t)NT * 64 * 4;
constexpr size_t OFF_YBUF = OFF_H2LO + (size_t)NT * 1024 * 2;
static_assert(OFF_YBUF + (size_t)MOE_CHUNK * 8 * 1024 * 2 <= WS_END, "moe layout");
static_assert(OFF_GATES + (size_t)NT * 3072 * 2 <= WS_END, "gates layout");
static_assert(WS_END <= (size_t)536870912, "workspace");

constexpr int LDS_BYTES = 155648;

struct Params {
    const float* in[N_IN];
    float* out;
    char* ws;
};

DEV float bf2f(bf16_t h) { return __uint_as_float(((unsigned)h) << 16); }
DEV bf16_t f2bf(float f) { unsigned u = __float_as_uint(f); u += 0x7FFFu + ((u >> 16) & 1u); return (bf16_t)(u >> 16); }
DEV unsigned pk2(float lo, float hi) { return (unsigned)f2bf(lo) | ((unsigned)f2bf(hi) << 16); }
DEV void ld8(const bf16_t* p, float (&o)[8]) {
    const u32x4 v = *(const u32x4*)p;
    o[0] = __uint_as_float(v.x << 16); o[1] = __uint_as_float(v.x & 0xffff0000u);
    o[2] = __uint_as_float(v.y << 16); o[3] = __uint_as_float(v.y & 0xffff0000u);
    o[4] = __uint_as_float(v.z << 16); o[5] = __uint_as_float(v.z & 0xffff0000u);
    o[6] = __uint_as_float(v.w << 16); o[7] = __uint_as_float(v.w & 0xffff0000u);
}
DEV void st8(bf16_t* p, const float (&v)[8]) {
    u32x4 o; o.x = pk2(v[0], v[1]); o.y = pk2(v[2], v[3]); o.z = pk2(v[4], v[5]); o.w = pk2(v[6], v[7]);
    *(u32x4*)p = o;
}
DEV float sigm(float x) { return 1.f / (1.f + __expf(-x)); }
DEV float sigm_acc(float x) { return 1.f / (1.f + expf(-x)); }
DEV int mod_row(int n) { return n < NX ? (n >> 11) : 16; }
DEV float* xs_row(const Params& p, int n) { return n < NX ? p.out + (size_t)n * DM : (float*)(p.ws + OFF_CTXS) + (size_t)(n - NX) * DM; }
DEV const float* xprev_row(const Params& p, int L, int n) {
    if (L == 0) return n < NX ? p.in[I_X] + (size_t)n * DM : p.in[I_CTX] + (size_t)(n - NX) * DM;
    return xs_row(p, n);
}
DEV void seq_of(int n, int& nb, int& tt, int& T) {
    if (n < NX) { nb = n & ~2047; tt = n & 2047; T = SEQ; } else { const int m = n - NX; nb = NX + (m & ~255); tt = m & 255; T = CTXL; }
}
DEV void shift8(const bf16_t* z, int ld, int nb, int tt, int T, int col0, const float* mu, float (&o)[8]) {
    float c[8], l[8], r[8];
    ld8(z + (size_t)(nb + tt) * ld + col0, c);
    if (tt > 0) ld8(z + (size_t)(nb + tt - 1) * ld + col0, l); else { UNROLL for (int i = 0; i < 8; ++i) l[i] = 0.f; }
    if (tt < T - 1) ld8(z + (size_t)(nb + tt + 1) * ld + col0, r); else { UNROLL for (int i = 0; i < 8; ++i) r[i] = 0.f; }
    UNROLL for (int i = 0; i < 8; ++i) o[i] = c[i] + mu[col0 + i] * (0.5f * (l[i] + r[i]) - c[i]);
}

constexpr int LROW = 144;
template <int WM, int WN> struct GC {
    static constexpr int BM = 64 * WM, BN = 64 * WN;
    static constexpr int AB = BM * LROW, BB = BN * LROW, STG = AB + BB;
    static constexpr int NA = BM / 64, NBC = BN / 64;
};
DEV void acc_zero(f32x16 (&acc)[2][2]) {
    UNROLL for (int a = 0; a < 2; ++a) UNROLL for (int b = 0; b < 2; ++b) UNROLL for (int r = 0; r < 16; ++r) acc[a][b][r] = 0.f;
}
template <int WM, int WN, bool A_LDS, class ARow>
DEV void gemm_tile(f32x16 (&acc)[2][2], ARow arow, const bf16_t* Bt, int ldb, int n0, int Nvalid, int K, char* smem, const char* alds) {
    typedef GC<WM, WN> C;
    const int tid = threadIdx.x, lane = tid & 63, wave = tid >> 6, wm = wave / WN, wn = wave % WN;
    const int fr = lane & 31, fh = lane >> 5;
    const int crow = tid >> 3, ckc = tid & 7;
    const bf16_t* pa[C::NA]; const bf16_t* pb[C::NBC];
    if (!A_LDS) { UNROLL for (int i = 0; i < C::NA; ++i) { const bf16_t* r = arow(crow + 64 * i); pa[i] = r ? r + ckc * 8 : nullptr; } }
    UNROLL for (int i = 0; i < C::NBC; ++i) { const int n = n0 + crow + 64 * i; pb[i] = n < Nvalid ? Bt + (size_t)n * ldb + ckc * 8 : nullptr; }
    u32x4 ra[C::NA], rb[C::NBC];
    const u32x4 z4 = {0u, 0u, 0u, 0u};
    const int nk = K >> 6;
    if (!A_LDS) { UNROLL for (int i = 0; i < C::NA; ++i) ra[i] = pa[i] ? *(const u32x4*)(pa[i]) : z4; }
    UNROLL for (int i = 0; i < C::NBC; ++i) rb[i] = pb[i] ? *(const u32x4*)(pb[i]) : z4;
    {
        char* As = smem; char* Bs = smem + C::AB;
        if (!A_LDS) { UNROLL for (int i = 0; i < C::NA; ++i) *(u32x4*)(As + (crow + 64 * i) * LROW + ckc * 16) = ra[i]; }
        UNROLL for (int i = 0; i < C::NBC; ++i) *(u32x4*)(Bs + (crow + 64 * i) * LROW + ckc * 16) = rb[i];
    }
    __syncthreads();
    const int a_off = (wm * 64 + fr) * LROW + fh * 16, b_off = (wn * 64 + fr) * LROW + fh * 16;
    for (int kt = 0; kt < nk; ++kt) {
        const bool more = kt + 1 < nk;
        if (more) {
            if (!A_LDS) { UNROLL for (int i = 0; i < C::NA; ++i) ra[i] = pa[i] ? *(const u32x4*)(pa[i] + (kt + 1) * 64) : z4; }
            UNROLL for (int i = 0; i < C::NBC; ++i) rb[i] = pb[i] ? *(const u32x4*)(pb[i] + (kt + 1) * 64) : z4;
        }
        const char* As = A_LDS ? alds + kt * C::AB : smem + (kt & 1) * C::STG;
        const char* Bs = smem + (kt & 1) * C::STG + C::AB;
        UNROLL for (int ks = 0; ks < 4; ++ks) {
            bf16x8 af[2], bfv[2];
            UNROLL for (int mi = 0; mi < 2; ++mi) af[mi] = *(const bf16x8*)(As + a_off + mi * 32 * LROW + ks * 32);
            UNROLL for (int ni = 0; ni < 2; ++ni) bfv[ni] = *(const bf16x8*)(Bs + b_off + ni * 32 * LROW + ks * 32);
            UNROLL for (int mi = 0; mi < 2; ++mi) UNROLL for (int ni = 0; ni < 2; ++ni)
                acc[mi][ni] = __builtin_amdgcn_mfma_f32_32x32x16_bf16(af[mi], bfv[ni], acc[mi][ni], 0, 0, 0);
        }
        if (more) {
            char* As2 = smem + ((kt + 1) & 1) * C::STG; char* Bs2 = As2 + C::AB;
            if (!A_LDS) { UNROLL for (int i = 0; i < C::NA; ++i) *(u32x4*)(As2 + (crow + 64 * i) * LROW + ckc * 16) = ra[i]; }
            UNROLL for (int i = 0; i < C::NBC; ++i) *(u32x4*)(Bs2 + (crow + 64 * i) * LROW + ckc * 16) = rb[i];
        }
        __syncthreads();
    }
}
#define ACC_ROW(mi, r, fh) ((mi) * 32 + ((r) & 3) + 8 * ((r) >> 2) + 4 * (fh))

template <int WM, int WN, class Epi>
DEV void gemm_phase(const bf16_t* A, int lda, int M, const bf16_t* Bt, int ldb, int N, int K, char* smem, Epi epi) {
    typedef GC<WM, WN> C;
    const int nM = M / C::BM, nN = (N + C::BN - 1) / C::BN;
    const int wave = threadIdx.x >> 6, wm = wave / WN, wn = wave % WN;
    for (int t = blockIdx.x; t < nM * nN; t += gridDim.x) {
        const int pm = t / nN, pn = t % nN;
        f32x16 acc[2][2]; acc_zero(acc);
        const bf16_t* Ab = A + (size_t)pm * C::BM * lda;
        gemm_tile<WM, WN, false>(acc, [&](int r) { return Ab + (size_t)r * lda; }, Bt, ldb, pn * C::BN, N, K, smem, nullptr);
        epi(acc, pm * C::BM + wm * 64, pn * C::BN + wn * 64);
    }
}

DEV void ph_mod(const Params& p, int L, char* smem) {
    const int tid = threadIdx.x;
    float* sc = (float*)smem;
    float* red = sc + 17 * 1024;
    const float* c = p.in[I_C]; const float* cc = p.in[I_CCTX];
    for (int i = tid; i < 17 * 1024; i += NTHREADS) { const float v = i < 16 * 1024 ? c[i] : cc[i - 16 * 1024]; sc[i] = v / (1.f + expf(-v)); }
    __syncthreads();
    const float* W = p.in[I_WADA] + (size_t)L * 1024 * 6144; const float* bA = p.in[I_BADA] + (size_t)L * 6144;
    float* MOD = (float*)(p.ws + OFF_MOD);
    for (int u = blockIdx.x; u < 192; u += gridDim.x) {
        const int ci = tid & 31, ks = tid >> 5, j = u * 32 + ci;
        float acc[17];
        UNROLL for (int r = 0; r < 17; ++r) acc[r] = 0.f;
        for (int k = ks * 64; k < ks * 64 + 64; ++k) {
            const float w = W[(size_t)k * 6144 + j];
            UNROLL for (int r = 0; r < 17; ++r) acc[r] += sc[r * 1024 + k] * w;
        }
        UNROLL for (int r = 0; r < 17; ++r) red[(ks * 17 + r) * 32 + ci] = acc[r];
        __syncthreads();
        for (int i = tid; i < 17 * 32; i += NTHREADS) {
            const int r = i >> 5, c2 = i & 31; float s = bA[u * 32 + c2];
            for (int k2 = 0; k2 < 16; ++k2) s += red[(k2 * 17 + r) * 32 + c2];
            MOD[r * 6144 + u * 32 + c2] = s;
        }
        __syncthreads();
    }
}
DEV void conv_job(const float* s0, const float* s1, bf16_t* d, int K, int N, int mode, int nmat, size_t sstride, size_t dstride, char* smem) {
    float* tile = (float*)smem;
    const int tid = threadIdx.x;
    const int tK = K / 64, tN = mode == 1 ? (2 * N) / 64 : (N + 63) / 64, per = tK * tN;
    for (int t = blockIdx.x; t < per * nmat; t += gridDim.x) {
        const int mat = t / per, r = t % per, tk = r / tN, tn = r % tN;
        const float* a0 = s0 + (size_t)mat * sstride; const float* a1 = s1 ? s1 + (size_t)mat * sstride : nullptr;
        bf16_t* dd = d + (size_t)mat * dstride;
        UNROLL for (int i = 0; i < 8; ++i) {
            const int cc = tid & 63, k = (tid >> 6) + 8 * i; float v;
            if (mode == 1) { const float* s = (cc >> 5) ? a1 : a0; v = s[(size_t)(tk * 64 + k) * N + tn * 32 + (cc & 31)]; }
            else { const int n = tn * 64 + cc; v = n < N ? a0[(size_t)(tk * 64 + k) * N + n] : 0.f; }
            tile[k * 65 + cc] = v;
        }
        __syncthreads();
        UNROLL for (int i = 0; i < 8; ++i) {
            const int k = tid & 63, cc = (tid >> 6) + 8 * i; const int row = tn * 64 + cc;
            const float v = tile[k * 65 + cc];
            if (mode == 1 || row < N) {
                const bf16_t hi = f2bf(v);
                dd[(size_t)row * K + tk * 64 + k] = hi;
                if (mode == 2) dd[(size_t)N * K + (size_t)row * K + tk * 64 + k] = f2bf(v - bf2f(hi));
            }
        }
        __syncthreads();
    }
}
DEV void ph_conv_mix(const Params& p, int L, char* smem) {
    char* ws = p.ws;
    conv_job(p.in[I_WIN] + (size_t)L * 1024 * IN_COLS, nullptr, (bf16_t*)(ws + OFF_WINT), 1024, IN_COLS, 0, 1, 0, 0, smem);
    conv_job(p.in[I_WBR] + (size_t)L * 3 * 512 * 1024, nullptr, (bf16_t*)(ws + OFF_WBT), 512, 1024, 0, 3, (size_t)512 * 1024, (size_t)512 * 1024, smem);
    conv_job(p.in[I_WOUT] + (size_t)L * 1024 * 1024, nullptr, (bf16_t*)(ws + OFF_WOUTT), 1024, 1024, 0, 1, 0, 0, smem);
    conv_job(p.in[I_SG] + (size_t)L * 1024 * 256, p.in[I_SU] + (size_t)L * 1024 * 256, (bf16_t*)(ws + OFF_SGUT), 1024, 256, 1, 1, 0, 0, smem);
    conv_job(p.in[I_SD] + (size_t)L * 256 * 1024, nullptr, (bf16_t*)(ws + OFF_SDT), 256, 1024, 0, 1, 0, 0, smem);
    conv_job(p.in[I_G2] + (size_t)L * 128 * 512, nullptr, (bf16_t*)(ws + OFF_G2T), 128, 512, 0, 1, 0, 0, smem);
    conv_job(p.in[I_RTR] + (size_t)L * 1024 * 64, nullptr, (bf16_t*)(ws + OFF_RTR), 1024, 64, 2, 1, 0, 0, smem);
}
DEV void ph_conv_moe(const Params& p, int L, char* smem) {
    char* ws = p.ws;
    const size_t eo = (size_t)L * 64 * 1024 * 128;
    conv_job(p.in[I_MWG] + eo, p.in[I_MWU] + eo, (bf16_t*)(ws + OFF_MGU), 1024, 128, 1, 64, (size_t)1024 * 128, (size_t)256 * 1024, smem);
    conv_job(p.in[I_MWD] + eo, nullptr, (bf16_t*)(ws + OFF_MDT), 128, 1024, 0, 64, (size_t)128 * 1024, (size_t)1024 * 128, smem);
}

DEV void ph_norm(const Params& p, int L, int which, int ntok) {
    const int lane = threadIdx.x & 63, wave = threadIdx.x >> 6;
    const float* MOD = (const float*)(p.ws + OFF_MOD);
    const float* g = p.in[which ? I_N2G : I_N1G] + (size_t)L * DM;
    bf16_t* H = (bf16_t*)(p.ws + OFF_HX); bf16_t* HLO = (bf16_t*)(p.ws + OFF_H2LO);
    for (int n0 = blockIdx.x * 8; n0 < ntok; n0 += gridDim.x * 8) {
        const int n = n0 + wave;
        const float* xr = which ? xs_row(p, n) : xprev_row(p, L, n);
        float4 v[4]; float ss = 0.f;
        UNROLL for (int i = 0; i < 4; ++i) { v[i] = *(const float4*)(xr + i * 256 + lane * 4); ss += v[i].x * v[i].x + v[i].y * v[i].y + v[i].z * v[i].z + v[i].w * v[i].w; }
        UNROLL for (int o = 1; o < 64; o <<= 1) ss += __shfl_xor(ss, o);
        const float rstd = rsqrtf(ss * (1.f / DM) + 1e-6f);
        const float* sh = MOD + mod_row(n) * 6144 + (which ? 3 : 0) * DM; const float* sc = sh + DM;
        UNROLL for (int i = 0; i < 4; ++i) {
            const int c = i * 256 + lane * 4;
            const float4 gg = *(const float4*)(g + c), s1 = *(const float4*)(sc + c), s0 = *(const float4*)(sh + c);
            const float h0 = v[i].x * rstd * gg.x * (1.f + s1.x) + s0.x, h1 = v[i].y * rstd * gg.y * (1.f + s1.y) + s0.y;
            const float h2 = v[i].z * rstd * gg.z * (1.f + s1.z) + s0.z, h3 = v[i].w * rstd * gg.w * (1.f + s1.w) + s0.w;
            u32x2 o; o.x = pk2(h0, h1); o.y = pk2(h2, h3);
            *(u32x2*)(H + (size_t)n * DM + c) = o;
            if (which) {
                u32x2 o2;
                o2.x = pk2(h0 - bf2f((bf16_t)(o.x & 0xffff)), h1 - bf2f((bf16_t)(o.x >> 16)));
                o2.y = pk2(h2 - bf2f((bf16_t)(o.y & 0xffff)), h3 - bf2f((bf16_t)(o.y >> 16)));
                *(u32x2*)(HLO + (size_t)n * DM + c) = o2;
            }
        }
    }
}

DEV void ph_rw_prep(const Params& p, int L, char* smem) {
    const int lane = threadIdx.x & 63, wave = threadIdx.x >> 6;
    float* vsh = (float*)smem + wave * 512;
    const bf16_t* PXR = (const bf16_t*)(p.ws + OFF_PX); bf16_t* VF = (bf16_t*)(p.ws + OFF_VF);
    const float* mu = p.in[I_MU] + (size_t)L * RW_COLS;
    const float* v0 = p.in[I_V0]; const float* v1 = p.in[I_V1]; const float* v2 = p.in[I_V2];
    for (int n0 = blockIdx.x * 8; n0 < NT; n0 += gridDim.x * 8) {
        const int n = n0 + wave; int nb, tt, T; seq_of(n, nb, tt, T);
        float vs[8]; shift8(PXR, RW_COLS, nb, tt, T, 1024 + lane * 8, mu, vs);
        if (L == 0) { st8(VF + (size_t)n * 512 + lane * 8, vs); }
        else {
            UNROLL for (int i = 0; i < 8; ++i) vsh[lane * 8 + i] = vs[i];
            __syncthreads();
            const int q = lane & 31, hf = lane >> 5; float t1 = 0.f;
            for (int jj = 0; jj < 256; ++jj) t1 += vsh[hf * 256 + jj] * v1[(hf * 256 + jj) * 32 + q];
            t1 += __shfl_xor(t1, 32);
            float u[8];
            UNROLL for (int i = 0; i < 8; ++i) u[i] = v0[lane * 8 + i];
            for (int q2 = 0; q2 < 32; ++q2) { const float tq = __shfl(t1, q2); UNROLL for (int i = 0; i < 8; ++i) u[i] += tq * v2[q2 * 512 + lane * 8 + i]; }
            float vf[8], o[8]; ld8(VF + (size_t)n * 512 + lane * 8, vf);
            UNROLL for (int i = 0; i < 8; ++i) o[i] = vs[i] + (vf[i] - vs[i]) * sigm_acc(u[i]);
            st8(VF + (size_t)n * 512 + lane * 8, o);
            __syncthreads();
        }
    }
}

DEV void ph_rw_scan(const Params& p, int L, char* smem) {
    const int tid = threadIdx.x, tq = tid >> 3, j = tid & 7;
    float* Wd = (float*)smem; float* Bv = Wd + 4096; float* Av = Bv + 4096; float* Kd = Av + 4096; float* Rr = Kd + 4096;
    float* Vv = Rr + 4096; float* Yc = Vv + 4096; float* lw2 = Yc + 4096; float* la2 = lw2 + 4096;
    const bf16_t* PXR = (const bf16_t*)(p.ws + OFF_PX); const bf16_t* VF = (const bf16_t*)(p.ws + OFF_VF);
    bf16_t* YS = (bf16_t*)(p.ws + OFF_YS); float* CB = (float*)(p.ws + OFF_CB);
    const float* mu = p.in[I_MU] + (size_t)L * RW_COLS;
    const float* w0 = p.in[I_W0] + (size_t)L * 1024; const float* w2 = p.in[I_W2] + (size_t)L * 65536;
    const float* a0 = p.in[I_A0] + (size_t)L * 1024; const float* a2 = p.in[I_A2] + (size_t)L * 65536;
    const float* kkw = p.in[I_KK] + (size_t)L * 512; const float* kaw = p.in[I_KA] + (size_t)L * 512; const float* rkw = p.in[I_RK] + (size_t)L * 512;
    for (int u = blockIdx.x; u < 256; u += gridDim.x) {
        const int b = u >> 4, h = (u >> 1) & 7, d = u & 1;
        for (int i = tid; i < 4096; i += NTHREADS) { const int l = i >> 6, n = i & 63; lw2[i] = w2[(size_t)(d * 64 + l) * 512 + h * 64 + n]; la2[i] = a2[(size_t)(d * 64 + l) * 512 + h * 64 + n]; }
        float S[8];
        UNROLL for (int i = 0; i < 8; ++i) S[i] = 0.f;
        const int ch = h * 64 + 8 * j, idx = tq * 64 + 8 * j;
        for (int ci = 0; ci < 36; ++ci) {
            const bool isc = ci < 4; const int T = isc ? CTXL : SEQ, cc = isc ? ci : ci - 4;
            const int t0 = d == 0 ? cc * 64 : T - 64 * (cc + 1), nb = isc ? NX + b * CTXL : b * SEQ, tt = t0 + tq;
            {
                float x1[8], x2[8];
                shift8(PXR, RW_COLS, nb, tt, T, 1536 + d * 64 + 8 * j, mu, x1);
                shift8(PXR, RW_COLS, nb, tt, T, 1664 + d * 64 + 8 * j, mu, x2);
                UNROLL for (int i = 0; i < 8; ++i) { Wd[idx + i] = tanhf(x1[i]); Bv[idx + i] = x2[i]; }
            }
            __syncthreads();
            float wl[8], al[8];
            UNROLL for (int i = 0; i < 8; ++i) { wl[i] = 0.f; al[i] = 0.f; }
            for (int l = 0; l < 64; ++l) {
                const float x1 = Wd[tq * 64 + l], x2 = Bv[tq * 64 + l];
                const float4 wa = *(const float4*)(lw2 + l * 64 + 8 * j), wb = *(const float4*)(lw2 + l * 64 + 8 * j + 4);
                const float4 aa = *(const float4*)(la2 + l * 64 + 8 * j), ab = *(const float4*)(la2 + l * 64 + 8 * j + 4);
                wl[0] += x1 * wa.x; wl[1] += x1 * wa.y; wl[2] += x1 * wa.z; wl[3] += x1 * wa.w; wl[4] += x1 * wb.x; wl[5] += x1 * wb.y; wl[6] += x1 * wb.z; wl[7] += x1 * wb.w;
                al[0] += x2 * aa.x; al[1] += x2 * aa.y; al[2] += x2 * aa.z; al[3] += x2 * aa.w; al[4] += x2 * ab.x; al[5] += x2 * ab.y; al[6] += x2 * ab.z; al[7] += x2 * ab.w;
            }
            __syncthreads();
            {
                float r8[8], k8[8], v8[8], kkr[8], av[8];
                shift8(PXR, RW_COLS, nb, tt, T, h * 64 + 8 * j, mu, r8);
                shift8(PXR, RW_COLS, nb, tt, T, 512 + h * 64 + 8 * j, mu, k8);
                ld8(VF + (size_t)(nb + tt) * 512 + ch, v8);
                float ss = 0.f, cbp = 0.f;
                UNROLL for (int i = 0; i < 8; ++i) {
                    const float xw = -(w0[d * 512 + ch + i] + wl[i]);
                    const float sp = fmaxf(xw, 0.f) + log1pf(expf(-fabsf(xw)));
                    const float w = -sp - 0.5f;
                    const float dec = expf(-expf(w));
                    const float a = sigm_acc(a0[d * 512 + ch + i] + al[i]);
                    const float kr = k8[i] * kkw[ch + i]; kkr[i] = kr; ss += kr * kr;
                    const float kd = k8[i] * (1.f + (a - 1.f) * kaw[ch + i]);
                    cbp += r8[i] * kd * rkw[ch + i];
                    Wd[idx + i] = dec; Kd[idx + i] = kd; Rr[idx + i] = r8[i]; Vv[idx + i] = v8[i]; av[i] = a;
                }
                ss += __shfl_xor(ss, 1); ss += __shfl_xor(ss, 2); ss += __shfl_xor(ss, 4);
                cbp += __shfl_xor(cbp, 1); cbp += __shfl_xor(cbp, 2); cbp += __shfl_xor(cbp, 4);
                const float inv = 1.f / fmaxf(sqrtf(ss), 1e-12f);
                UNROLL for (int i = 0; i < 8; ++i) { const float kk = kkr[i] * inv; Av[idx + i] = -kk; Bv[idx + i] = kk * av[i]; }
                if (j == 0) CB[((size_t)d * NT + nb + tt) * 8 + h] = cbp;
            }
            __syncthreads();
            for (int s = 0; s < 64; ++s) {
                const int t = d == 0 ? s : 63 - s, o = t * 64 + 8 * j;
                const float4 w_a = *(const float4*)(Wd + o), w_b = *(const float4*)(Wd + o + 4);
                const float4 a_a = *(const float4*)(Av + o), a_b = *(const float4*)(Av + o + 4);
                const float4 b_a = *(const float4*)(Bv + o), b_b = *(const float4*)(Bv + o + 4);
                const float4 k_a = *(const float4*)(Kd + o), k_b = *(const float4*)(Kd + o + 4);
                const float4 r_a = *(const float4*)(Rr + o), r_b = *(const float4*)(Rr + o + 4);
                const float vv = Vv[t * 64 + tq];
                float sa = S[0] * a_a.x + S[1] * a_a.y + S[2] * a_a.z + S[3] * a_a.w + S[4] * a_b.x + S[5] * a_b.y + S[6] * a_b.z + S[7] * a_b.w;
                sa += __shfl_xor(sa, 1); sa += __shfl_xor(sa, 2); sa += __shfl_xor(sa, 4);
                S[0] = S[0] * w_a.x + sa * b_a.x + vv * k_a.x; S[1] = S[1] * w_a.y + sa * b_a.y + vv * k_a.y;
                S[2] = S[2] * w_a.z + sa * b_a.z + vv * k_a.z; S[3] = S[3] * w_a.w + sa * b_a.w + vv * k_a.w;
                S[4] = S[4] * w_b.x + sa * b_b.x + vv * k_b.x; S[5] = S[5] * w_b.y + sa * b_b.y + vv * k_b.y;
                S[6] = S[6] * w_b.z + sa * b_b.z + vv * k_b.z; S[7] = S[7] * w_b.w + sa * b_b.w + vv * k_b.w;
                float y = S[0] * r_a.x + S[1] * r_a.y + S[2] * r_a.z + S[3] * r_a.w + S[4] * r_b.x + S[5] * r_b.y + S[6] * r_b.z + S[7] * r_b.w;
                y += __shfl_xor(y, 1); y += __shfl_xor(y, 2); y += __shfl_xor(y, 4);
                if (j == 0) Yc[t * 64 + tq] = y;
            }
            __syncthreads();
            {
                float y8[8];
                UNROLL for (int i = 0; i < 8; ++i) y8[i] = Yc[idx + i];
                st8(YS + ((size_t)d * NT + nb + tt) * 512 + ch, y8);
            }
        }
        __syncthreads();
    }
}

DEV void ph_rw_read(const Params& p, int L, int ntok) {
    const int lane = threadIdx.x & 63, wave = threadIdx.x >> 6;
    const bf16_t* PXR = (const bf16_t*)(p.ws + OFF_PX); const bf16_t* VF = (const bf16_t*)(p.ws + OFF_VF);
    const bf16_t* YS = (const bf16_t*)(p.ws + OFF_YS); const float* CB = (const float*)(p.ws + OFF_CB);
    bf16_t* YA = (bf16_t*)(p.ws + OFF_YA); bf16_t* SG = (bf16_t*)(p.ws + OFF_SGB);
    const float* mu = p.in[I_MU] + (size_t)L * RW_COLS;
    const float* lg = p.in[I_LNG] + (size_t)L * 512; const float* lb = p.in[I_LNB] + (size_t)L * 512;
    for (int n0 = blockIdx.x * 8; n0 < ntok; n0 += gridDim.x * 8) {
        const int n = n0 + wave, c = lane * 8, h = lane >> 3;
        float y0[8], y1[8], v8[8], o[8];
        ld8(YS + (size_t)n * 512 + c, y0); ld8(YS + ((size_t)NT + n) * 512 + c, y1); ld8(VF + (size_t)n * 512 + c, v8);
        float s = 0.f;
        UNROLL for (int i = 0; i < 8; ++i) { y0[i] += y1[i]; s += y0[i]; }
        s += __shfl_xor(s, 1); s += __shfl_xor(s, 2); s += __shfl_xor(s, 4);
        const float mean = s * (1.f / 64.f); float q = 0.f;
        UNROLL for (int i = 0; i < 8; ++i) { const float dd = y0[i] - mean; q += dd * dd; }
        q += __shfl_xor(q, 1); q += __shfl_xor(q, 2); q += __shfl_xor(q, 4);
        const float rstd = rsqrtf(q * (1.f / 64.f) + 64e-5f);
        const float bon = CB[(size_t)n * 8 + h] + CB[((size_t)NT + n) * 8 + h];
        UNROLL for (int i = 0; i < 8; ++i) o[i] = (y0[i] - mean) * rstd * lg[c + i] + lb[c + i] + bon * v8[i];
        st8(YA + (size_t)n * 512 + c, o);
        if (lane < 16) {
            int nb, tt, T; seq_of(n, nb, tt, T);
            float g8[8]; shift8(PXR, RW_COLS, nb, tt, T, 1792 + lane * 8, mu, g8);
            UNROLL for (int i = 0; i < 8; ++i) g8[i] = sigm_acc(g8[i]);
            st8(SG + (size_t)n * 128 + lane * 8, g8);
        }
    }
}

DEV void ph_na_norm(const Params& p, int L) {
    const int lane = threadIdx.x & 63, wave = threadIdx.x >> 6;
    bf16_t* PXN = (bf16_t*)(p.ws + OFF_PX);
    const float* qg = p.in[I_QNG] + (size_t)L * 64; const float* kg = p.in[I_KNG] + (size_t)L * 64;
    for (int n0 = blockIdx.x * 8; n0 < NT; n0 += gridDim.x * 8) {
        const int n = n0 + wave, c = lane * 8;
        UNROLL for (int w = 0; w < 2; ++w) {
            bf16_t* ptr = PXN + (size_t)n * NA_COLS + w * 512 + c;
            float x[8]; ld8(ptr, x);
            float ss = 0.f;
            UNROLL for (int i = 0; i < 8; ++i) ss += x[i] * x[i];
            ss += __shfl_xor(ss, 1); ss += __shfl_xor(ss, 2); ss += __shfl_xor(ss, 4);
            const float r = rsqrtf(ss * (1.f / 64.f) + 1e-6f) * (w == 0 ? 0.125f : 1.f);
            const float* g = w == 0 ? qg : kg;
            UNROLL for (int i = 0; i < 8; ++i) x[i] = x[i] * r * g[(c + i) & 63];
            st8(ptr, x);
        }
    }
}

DEV void ph_na_att(const Params& p, int L, char* smem) {
    const int tid = threadIdx.x;
    char* KV = smem;
    float* P = (float*)(smem + 512 * LROW);
    float* Q = P + 16 * 512;
    float* RP = Q + 16 * 64;
    const bf16_t* PXN = (const bf16_t*)(p.ws + OFF_PX); bf16_t* YB = (bf16_t*)(p.ws + OFF_YB);
    const int nunits = 16384 + (L == 0 ? 2048 : 0);
    for (int u = blockIdx.x; u < nunits; u += gridDim.x) {
        const bool cu = u >= 16384;
        int b, h, r = 0, nbk = 0, qb = 0, rs = 0, band0 = 0, nkeys;
        if (!cu) { h = u & 7; nbk = (u >> 3) & 3; r = (u >> 5) & 31; b = u >> 10; rs = min(max(r - 4, 0), 24); band0 = min(max(nbk * 16 - 8, 0), 32); nkeys = 512; }
        else { const int v = u - 16384; h = v & 7; qb = (v >> 3) & 15; b = v >> 7; nkeys = 256; }
        const int ctx0 = NX + b * CTXL;
        for (int i = tid; i < 16 * 64; i += NTHREADS) {
            const int qi = i >> 6, dd = i & 63;
            const int tok = cu ? ctx0 + qb * 16 + qi : b * SEQ + r * 64 + nbk * 16 + qi;
            Q[i] = bf2f(PXN[(size_t)tok * NA_COLS + h * 64 + dd]);
        }
        if (!cu) for (int i = tid; i < 15 * 31; i += NTHREADS) RP[i] = p.in[I_RPB][((size_t)L * 8 + h) * 465 + i];
        UNROLL for (int i = 0; i < 8; ++i) {
            const int c = tid + NTHREADS * i, kx = c >> 3, part = c & 7;
            if (kx < nkeys) {
                int tok;
                if (cu) tok = ctx0 + kx;
                else tok = kx < 256 ? b * SEQ + (rs + (kx >> 5)) * 64 + band0 + (kx & 31) : ctx0 + (kx - 256);
                *(u32x4*)(KV + kx * LROW + part * 16) = *(const u32x4*)(PXN + (size_t)tok * NA_COLS + 512 + h * 64 + part * 8);
            }
        }
        __syncthreads();
        {
            const int qi = tid >> 5, part = tid & 31;
            float q[64];
            UNROLL for (int i = 0; i < 16; ++i) { const float4 t = *(const float4*)(Q + qi * 64 + i * 4); q[4 * i] = t.x; q[4 * i + 1] = t.y; q[4 * i + 2] = t.z; q[4 * i + 3] = t.w; }
            float sc[16]; float mx = -3e38f;
            const int col = nbk * 16 + qi, cs = min(max(col - 8, 0), 48);
            UNROLL for (int i = 0; i < 16; ++i) {
                const int kx = part + 32 * i;
                float s = -1e30f;
                if (kx < nkeys) {
                    s = 0.f;
                    UNROLL for (int g = 0; g < 8; ++g) { float kf[8]; ld8((const bf16_t*)(KV + kx * LROW + g * 16), kf); UNROLL for (int e = 0; e < 8; ++e) s += q[g * 8 + e] * kf[e]; }
                    if (!cu && i < 8) {
                        const int kc = band0 + part, kr = rs + i;
                        const bool valid = kc >= cs && kc < cs + 16;
                        s = valid ? s + RP[(kr - r + 7) * 31 + (kc - col + 15)] : -1e30f;
                    }
                }
                sc[i] = s; mx = fmaxf(mx, s);
            }
            UNROLL for (int o = 1; o < 32; o <<= 1) mx = fmaxf(mx, __shfl_xor(mx, o));
            float sum = 0.f;
            UNROLL for (int i = 0; i < 16; ++i) { sc[i] = __expf(sc[i] - mx); sum += sc[i]; }
            UNROLL for (int o = 1; o < 32; o <<= 1) sum += __shfl_xor(sum, o);
            const float inv = 1.f / sum;
            UNROLL for (int i = 0; i < 16; ++i) P[qi * 512 + part + 32 * i] = sc[i] * inv;
        }
        __syncthreads();
        UNROLL for (int i = 0; i < 8; ++i) {
            const int c = tid + NTHREADS * i, kx = c >> 3, part = c & 7;
            if (kx < nkeys) {
                int tok;
                if (cu) tok = ctx0 + kx;
                else tok = kx < 256 ? b * SEQ + (rs + (kx >> 5)) * 64 + band0 + (kx & 31) : ctx0 + (kx - 256);
                *(u32x4*)(KV + kx * LROW + part * 16) = *(const u32x4*)(PXN + (size_t)tok * NA_COLS + 1024 + h * 64 + part * 8);
            }
        }
        __syncthreads();
        {
            const int qi = tid >> 5, dp = tid & 31;
            float o0 = 0.f, o1 = 0.f;
            for (int kx = 0; kx < nkeys; ++kx) {
                const float pp = P[qi * 512 + kx];
                const unsigned vv = *(const unsigned*)(KV + kx * LROW + dp * 4);
                o0 += pp * __uint_as_float(vv << 16); o1 += pp * __uint_as_float(vv & 0xffff0000u);
            }
            const int tok = cu ? ctx0 + qb * 16 + qi : b * SEQ + r * 64 + nbk * 16 + qi;
            *(unsigned*)(YB + (size_t)tok * 512 + h * 64 + dp * 2) = pk2(o0, o1);
        }
        __syncthreads();
    }
}

DEV void ph_ml_scan(const Params& p, int L, char* smem) {
    const int tid = threadIdx.x, tq = tid >> 3, j = tid & 7;
    float* Qc = (float*)smem; float* Kc = Qc + 4096; float* Vc = Kc + 4096; float* Hc = Vc + 4096; float* FI = Hc + 4096;
    const bf16_t* PXM = (const bf16_t*)(p.ws + OFF_PX); bf16_t* HS = (bf16_t*)(p.ws + OFF_HS);
    for (int u = blockIdx.x; u < 256; u += gridDim.x) {
        const int vh = u & 1, d = (u >> 1) & 1, h = (u >> 2) & 3, b = u >> 4;
        const float ib = p.in[I_IB][L * 8 + d * 4 + h], fb = p.in[I_FB][L * 8 + d * 4 + h];
        float C[8], nn[8];
        UNROLL for (int i = 0; i < 8; ++i) { C[i] = 0.f; nn[i] = 0.f; }
        const int idx = tq * 64 + 8 * j;
        for (int ci = 0; ci < 36; ++ci) {
            const bool isc = ci < 4; const int T = isc ? CTXL : SEQ, cc = isc ? ci : ci - 4;
            const int t0 = d == 0 ? cc * 64 : T - 64 * (cc + 1), nb = isc ? NX + b * CTXL : b * SEQ, tt = t0 + tq;
            {
                const bf16_t* row = PXM + (size_t)(nb + tt) * ML_COLS;
                float q8[8], k8[8], v8[8];
                ld8(row + h * 64 + 8 * j, q8); ld8(row + 256 + h * 64 + 8 * j, k8); ld8(row + 512 + h * 128 + vh * 64 + 8 * j, v8);
                if (!isc) {
                    const int axis = j >> 2, half = (j >> 1) & 1; const float pos = (float)(axis == 0 ? (tt >> 6) : (tt & 63));
                    UNROLL for (int i = 0; i < 8; ++i) {
                        const int f = (j & 1) * 8 + i;
                        const float inv = exp2f(-(float)f * 0.83048202372184059f);
                        const float ang = pos * inv; const float cs = __cosf(ang), sn = __sinf(ang);
                        const float qo = __shfl_xor(q8[i], 2), ko = __shfl_xor(k8[i], 2);
                        q8[i] = half == 0 ? q8[i] * cs - qo * sn : q8[i] * cs + qo * sn;
                        k8[i] = half == 0 ? k8[i] * cs - ko * sn : k8[i] * cs + ko * sn;
                    }
                }
                UNROLL for (int i = 0; i < 8; ++i) { Qc[idx + i] = q8[i] * 0.125f; Kc[idx + i] = k8[i]; Vc[idx + i] = v8[i]; }
                if (j == 0) {
                    const float ig = bf2f(row[1536 + d * 4 + h]) + ib, fg = bf2f(row[1544 + d * 4 + h]) + fb;
                    const float igc = 15.f * tanhf(ig * (1.f / 15.f)), fgc = 15.f * tanhf(fg * (1.f / 15.f));
                    FI[tq * 2] = sigm_acc(fgc); FI[tq * 2 + 1] = expf(igc);
                }
            }
            __syncthreads();
            for (int s = 0; s < 64; ++s) {
                const int t = d == 0 ? s : 63 - s, o = t * 64 + 8 * j;
                const float4 ka = *(const float4*)(Kc + o), kb = *(const float4*)(Kc + o + 4);
                const float4 qa = *(const float4*)(Qc + o), qb = *(const float4*)(Qc + o + 4);
                const float f = FI[t * 2], ii = FI[t * 2 + 1];
                const float iv = ii * Vc[t * 64 + tq];
                C[0] = f * C[0] + iv * ka.x; C[1] = f * C[1] + iv * ka.y; C[2] = f * C[2] + iv * ka.z; C[3] = f * C[3] + iv * ka.w;
                C[4] = f * C[4] + iv * kb.x; C[5] = f * C[5] + iv * kb.y; C[6] = f * C[6] + iv * kb.z; C[7] = f * C[7] + iv * kb.w;
                nn[0] = f * nn[0] + ii * ka.x; nn[1] = f * nn[1] + ii * ka.y; nn[2] = f * nn[2] + ii * ka.z; nn[3] = f * nn[3] + ii * ka.w;
                nn[4] = f * nn[4] + ii * kb.x; nn[5] = f * nn[5] + ii * kb.y; nn[6] = f * nn[6] + ii * kb.z; nn[7] = f * nn[7] + ii * kb.w;
                float num = C[0] * qa.x + C[1] * qa.y + C[2] * qa.z + C[3] * qa.w + C[4] * qb.x + C[5] * qb.y + C[6] * qb.z + C[7] * qb.w;
                float den = nn[0] * qa.x + nn[1] * qa.y + nn[2] * qa.z + nn[3] * qa.w + nn[4] * qb.x + nn[5] * qb.y + nn[6] * qb.z + nn[7] * qb.w;
                num += __shfl_xor(num, 1); num += __shfl_xor(num, 2); num += __shfl_xor(num, 4);
                den += __shfl_xor(den, 1); den += __shfl_xor(den, 2); den += __shfl_xor(den, 4);
                if (j == 0) Hc[t * 64 + tq] = num / fmaxf(fabsf(den), 1.f);
            }
            __syncthreads();
            {
                float h8[8];
                UNROLL for (int i = 0; i < 8; ++i) h8[i] = Hc[idx + i];
                st8(HS + ((size_t)d * NT + nb + tt) * 512 + h * 128 + vh * 64 + 8 * j, h8);
            }
        }
        __syncthreads();
    }
}
DEV void ph_ml_read(const Params& p, int L, int ntok) {
    const int lane = threadIdx.x & 63, wave = threadIdx.x >> 6;
    const bf16_t* PXM = (const bf16_t*)(p.ws + OFF_PX); const bf16_t* HS = (const bf16_t*)(p.ws + OFF_HS);
    bf16_t* YC = (bf16_t*)(p.ws + OFF_YC); const float* ng = p.in[I_MNG] + (size_t)L * 512;
    for (int n0 = blockIdx.x * 8; n0 < ntok; n0 += gridDim.x * 8) {
        const int n = n0 + wave, c = lane * 8;
        float h0[8], h1[8], o8[8], out[8];
        ld8(HS + (size_t)n * 512 + c, h0); ld8(HS + ((size_t)NT + n) * 512 + c, h1); ld8(PXM + (size_t)n * ML_COLS + 1024 + c, o8);
        float ss = 0.f;
        UNROLL for (int i = 0; i < 8; ++i) { h0[i] += h1[i]; ss += h0[i] * h0[i]; }
        ss += __shfl_xor(ss, 1); ss += __shfl_xor(ss, 2); ss += __shfl_xor(ss, 4); ss += __shfl_xor(ss, 8);
        const float r = rsqrtf(ss * (1.f / 128.f) + 1e-6f);
        UNROLL for (int i = 0; i < 8; ++i) out[i] = h0[i] * r * ng[c + i] * sigm_acc(o8[i]);
        st8(YC + (size_t)n * 512 + c, out);
    }
}

DEV void ph_route(const Params& p, int L, int ntok) {
    const int lane = threadIdx.x & 63, wave = threadIdx.x >> 6;
    const float* LOG = (const float*)(p.ws + OFF_LOG); int* EIDX = (int*)(p.ws + OFF_EIDX); float* EW = (float*)(p.ws + OFF_EW);
    const float bias = p.in[I_MB][L * 64 + lane];
    for (int n0 = blockIdx.x * 8; n0 < ntok; n0 += gridDim.x * 8) {
        const int n = n0 + wave, g = lane >> 3;
        const float score = sigm_acc(LOG[(size_t)n * 64 + lane]), sel = score + bias;
        float m1 = sel; m1 = fmaxf(m1, __shfl_xor(m1, 1)); m1 = fmaxf(m1, __shfl_xor(m1, 2)); m1 = fmaxf(m1, __shfl_xor(m1, 4));
        int i1 = sel == m1 ? lane : 64; i1 = min(i1, __shfl_xor(i1, 1)); i1 = min(i1, __shfl_xor(i1, 2)); i1 = min(i1, __shfl_xor(i1, 4));
        float m2 = lane == i1 ? -3e38f : sel; m2 = fmaxf(m2, __shfl_xor(m2, 1)); m2 = fmaxf(m2, __shfl_xor(m2, 2)); m2 = fmaxf(m2, __shfl_xor(m2, 4));
        const float gs = m1 + m2;
        int rank = 0;
        UNROLL for (int g2 = 0; g2 < 8; ++g2) { const float v = __shfl(gs, g2 * 8); rank += (v > gs || (v == gs && g2 < g)) ? 1 : 0; }
        const float ms = rank < 4 ? sel : -1e30f;
        int er = 0;
        for (int e2 = 0; e2 < 64; ++e2) { const float v = __shfl(ms, e2); er += (v > ms || (v == ms && e2 < lane)) ? 1 : 0; }
        const bool chosen = er < 8;
        float ws = chosen ? score : 0.f;
        UNROLL for (int o = 1; o < 64; o <<= 1) ws += __shfl_xor(ws, o);
        if (chosen) { EIDX[(size_t)n * 8 + er] = lane; EW[(size_t)n * 8 + er] = score / ws * 2.5f; }
    }
}

DEV void ph_moe_exp(const Params& p, int cb, int ce, char* smem) {
    typedef GC<2, 4> C;
    const int tid = threadIdx.x, lane = tid & 63, wave = tid >> 6, wm = wave / 4, wn = wave % 4, fr = lane & 31, fh = lane >> 5;
    char* ACT = smem + 2 * C::STG;
    int* list = (int*)(ACT + 2 * C::AB);
    int* cnt = list + 1024;
    const bf16_t* H2 = (const bf16_t*)(p.ws + OFF_HX); const int* EIDX = (const int*)(p.ws + OFF_EIDX); const float* EW = (const float*)(p.ws + OFF_EW);
    bf16_t* YBUF = (bf16_t*)(p.ws + OFF_YBUF);
    const int nst = (ce - cb + MOE_ST - 1) / MOE_ST;
    for (int u = blockIdx.x; u < nst * 64; u += gridDim.x) {
        const int e = u / nst, st = u % nst, s0 = cb + st * MOE_ST, ntok = min(MOE_ST, ce - s0);
        if (tid == 0) *cnt = 0;
        __syncthreads();
        for (int i = tid; i < ntok * 8; i += NTHREADS) {
            if (EIDX[(size_t)s0 * 8 + i] == e) { const int pos = atomicAdd(cnt, 1); list[pos] = s0 * 8 + i; }
        }
        __syncthreads();
        const int M = *cnt;
        const bf16_t* GU = (const bf16_t*)(p.ws + OFF_MGU) + (size_t)e * 256 * 1024;
        const bf16_t* DT = (const bf16_t*)(p.ws + OFF_MDT) + (size_t)e * 1024 * 128;
        for (int mc = 0; mc < M; mc += 128) {
            f32x16 acc[2][2]; acc_zero(acc);
            gemm_tile<2, 4, false>(acc, [&](int r) -> const bf16_t* { const int ix = mc + r; return ix < M ? H2 + (size_t)(list[ix] >> 3) * 1024 : nullptr; },
                                   GU, 1024, 0, 256, 1024, smem, nullptr);
            UNROLL for (int mi = 0; mi < 2; ++mi) UNROLL for (int r = 0; r < 16; ++r) {
                const int row = wm * 64 + ACC_ROW(mi, r, fh), ix = mc + row;
                const float gw = ix < M ? EW[list[ix]] : 0.f;
                const float gv = acc[mi][0][r], uv = acc[mi][1][r];
                const float a = gv / (1.f + __expf(-gv)) * uv * gw;
                const int col = wn * 32 + fr;
                *(bf16_t*)(ACT + (col >> 6) * C::AB + row * LROW + (col & 63) * 2) = f2bf(a);
            }
            __syncthreads();
            for (int nt = 0; nt < 4; ++nt) {
                acc_zero(acc);
                gemm_tile<2, 4, true>(acc, [](int) -> const bf16_t* { return nullptr; }, DT, 128, nt * 256, 1024, 128, smem, ACT);
                UNROLL for (int mi = 0; mi < 2; ++mi) UNROLL for (int r = 0; r < 16; ++r) {
                    const int row = wm * 64 + ACC_ROW(mi, r, fh), ix = mc + row;
                    if (ix < M) {
                        bf16_t* yr = YBUF + (size_t)(list[ix] - cb * 8) * 1024 + nt * 256 + wn * 64 + fr;
                        yr[0] = f2bf(acc[mi][0][r]); yr[32] = f2bf(acc[mi][1][r]);
                    }
                }
            }
            __syncthreads();
        }
        __syncthreads();
    }
}

enum { PH_MODCONV = 0, PH_HX, PH_GEMM_R, PH_RW_PREP, PH_RW_SCAN, PH_RW_READ, PH_RW_G, PH_GEMM_N, PH_NA_NORM, PH_NA_ATT, PH_GEMM_M, PH_ML_SCAN, PH_ML_READ,
       PH_GEMM_G, PH_MERGE, PH_OUT, PH_NORM2, PH_ROUTER, PH_ROUTE, PH_SHARED, PH_MOE_EXP, PH_MOE_COMB, PH_COUNT };

template <int PH> DEV void run_phase(const Params& p, int L, int sub, char* smem) {
    const int tid = threadIdx.x, lane = tid & 63, fr = lane & 31, fh = lane >> 5;
    char* ws = p.ws;
    const int ntl = L == 0 ? NT : NX;
    const bf16_t* HX = (const bf16_t*)(ws + OFF_HX);
    const bf16_t* WINT = (const bf16_t*)(ws + OFF_WINT);
    if constexpr (PH == PH_MODCONV) { ph_mod(p, L, smem); ph_conv_mix(p, L, smem); }
    else if constexpr (PH == PH_HX) { ph_norm(p, L, 0, NT); }
    else if constexpr (PH == PH_GEMM_R || PH == PH_GEMM_N || PH == PH_GEMM_M) {
        const int c0 = PH == PH_GEMM_R ? 0 : PH == PH_GEMM_N ? RW_COLS : RW_COLS + NA_COLS;
        const int N = PH == PH_GEMM_R ? RW_COLS : PH == PH_GEMM_N ? NA_COLS : ML_COLS;
        bf16_t* PX = (bf16_t*)(ws + OFF_PX);
        gemm_phase<4, 2>(HX, DM, NT, WINT + (size_t)c0 * DM, DM, N, DM, smem, [&](const f32x16 (&acc)[2][2], int row0, int col0) {
            UNROLL for (int mi = 0; mi < 2; ++mi) UNROLL for (int ni = 0; ni < 2; ++ni) {
                const int col = col0 + ni * 32 + fr;
                if (col < N) { UNROLL for (int r = 0; r < 16; ++r) PX[(size_t)(row0 + ACC_ROW(mi, r, fh)) * N + col] = f2bf(acc[mi][ni][r]); }
            }
        });
    }
    else if constexpr (PH == PH_RW_PREP) { ph_rw_prep(p, L, smem); }
    else if constexpr (PH == PH_RW_SCAN) { ph_rw_scan(p, L, smem); }
    else if constexpr (PH == PH_RW_READ) { ph_rw_read(p, L, ntl); }
    else if constexpr (PH == PH_RW_G) {
        bf16_t* YA = (bf16_t*)(ws + OFF_YA);
        gemm_phase<4, 2>((const bf16_t*)(ws + OFF_SGB), 128, ntl, (const bf16_t*)(ws + OFF_G2T), 128, 512, 128, smem, [&](const f32x16 (&acc)[2][2], int row0, int col0) {
            UNROLL for (int mi = 0; mi < 2; ++mi) UNROLL for (int ni = 0; ni < 2; ++ni) UNROLL for (int r = 0; r < 16; ++r) {
                bf16_t* q = YA + (size_t)(row0 + ACC_ROW(mi, r, fh)) * 512 + col0 + ni * 32 + fr;
                *q = f2bf(bf2f(*q) * acc[mi][ni][r]);
            }
        });
    }
    else if constexpr (PH == PH_NA_NORM) { ph_na_norm(p, L); }
    else if constexpr (PH == PH_NA_ATT) { ph_na_att(p, L, smem); }
    else if constexpr (PH == PH_ML_SCAN) { ph_ml_scan(p, L, smem); }
    else if constexpr (PH == PH_ML_READ) { ph_ml_read(p, L, ntl); }
    else if constexpr (PH == PH_GEMM_G) {
        bf16_t* G = (bf16_t*)(ws + OFF_GATES);
        gemm_phase<4, 2>(HX, DM, ntl, WINT + (size_t)(RW_COLS + NA_COLS + ML_COLS) * DM, DM, GATE_COLS, DM, smem, [&](const f32x16 (&acc)[2][2], int row0, int col0) {
            UNROLL for (int mi = 0; mi < 2; ++mi) UNROLL for (int ni = 0; ni < 2; ++ni) UNROLL for (int r = 0; r < 16; ++r)
                G[(size_t)(row0 + ACC_ROW(mi, r, fh)) * GATE_COLS + col0 + ni * 32 + fr] = f2bf(sigm(acc[mi][ni][r]));
        });
    }
    else if constexpr (PH == PH_MERGE) {
        typedef GC<4, 2> C;
        const bf16_t* G = (const bf16_t*)(ws + OFF_GATES); bf16_t* MG = (bf16_t*)(ws + OFF_HX);
        const int nM = ntl / C::BM, nN = DM / C::BN, wave = tid >> 6, wm = wave / 2, wn = wave % 2;
        for (int t = blockIdx.x; t < nM * nN; t += gridDim.x) {
            const int pm = t / nN, pn = t % nN, row0 = pm * C::BM + wm * 64, col0 = pn * C::BN + wn * 64;
            f32x16 m[2][2]; acc_zero(m);
            _Pragma("unroll 1") for (int br = 0; br < 3; ++br) {
                f32x16 acc[2][2]; acc_zero(acc);
                const bf16_t* Ab = (const bf16_t*)(ws + OFF_YA + (size_t)br * SZ_Y1) + (size_t)pm * C::BM * 512;
                gemm_tile<4, 2, false>(acc, [&](int r) { return Ab + (size_t)r * 512; }, (const bf16_t*)(ws + OFF_WBT) + (size_t)br * 1024 * 512, 512, pn * C::BN, DM, 512, smem, nullptr);
                UNROLL for (int mi = 0; mi < 2; ++mi) UNROLL for (int ni = 0; ni < 2; ++ni) UNROLL for (int r = 0; r < 16; ++r)
                    m[mi][ni][r] += bf2f(G[(size_t)(row0 + ACC_ROW(mi, r, fh)) * GATE_COLS + br * DM + col0 + ni * 32 + fr]) * acc[mi][ni][r];
            }
            UNROLL for (int mi = 0; mi < 2; ++mi) UNROLL for (int ni = 0; ni < 2; ++ni) UNROLL for (int r = 0; r < 16; ++r)
                MG[(size_t)(row0 + ACC_ROW(mi, r, fh)) * DM + col0 + ni * 32 + fr] = f2bf(m[mi][ni][r]);
        }
    }
    else if constexpr (PH == PH_OUT) {
        const float* MOD = (const float*)(ws + OFF_MOD);
        gemm_phase<4, 2>(HX, DM, ntl, (const bf16_t*)(ws + OFF_WOUTT), DM, DM, DM, smem, [&](const f32x16 (&acc)[2][2], int row0, int col0) {
            UNROLL for (int mi = 0; mi < 2; ++mi) UNROLL for (int r = 0; r < 16; ++r) {
                const int n = row0 + ACC_ROW(mi, r, fh);
                const float* xp = xprev_row(p, L, n); float* xo = xs_row(p, n); const float* g1 = MOD + mod_row(n) * 6144 + 2 * DM;
                UNROLL for (int ni = 0; ni < 2; ++ni) { const int c = col0 + ni * 32 + fr; xo[c] = xp[c] + g1[c] * acc[mi][ni][r]; }
            }
        });
    }
    else if constexpr (PH == PH_NORM2) { ph_norm(p, L, 1, ntl); ph_conv_moe(p, L, smem); }
    else if constexpr (PH == PH_ROUTER) {
        typedef GC<4, 2> C;
        float* LOG = (float*)(ws + OFF_LOG);
        const bf16_t* H2LO = (const bf16_t*)(ws + OFF_H2LO); const bf16_t* RH = (const bf16_t*)(ws + OFF_RTR); const bf16_t* RL = RH + 64 * 1024;
        const int wave = tid >> 6, wm = wave / 2, wn = wave % 2;
        for (int t = blockIdx.x; t < ntl / C::BM; t += gridDim.x) {
            f32x16 acc[2][2]; acc_zero(acc);
            const bf16_t* A0 = HX + (size_t)t * C::BM * DM; const bf16_t* A1 = H2LO + (size_t)t * C::BM * DM;
            gemm_tile<4, 2, false>(acc, [&](int r) { return A0 + (size_t)r * DM; }, RH, DM, 0, 64, DM, smem, nullptr);
            gemm_tile<4, 2, false>(acc, [&](int r) { return A1 + (size_t)r * DM; }, RH, DM, 0, 64, DM, smem, nullptr);
            gemm_tile<4, 2, false>(acc, [&](int r) { return A0 + (size_t)r * DM; }, RL, DM, 0, 64, DM, smem, nullptr);
            if (wn == 0) {
                UNROLL for (int mi = 0; mi < 2; ++mi) UNROLL for (int ni = 0; ni < 2; ++ni) UNROLL for (int r = 0; r < 16; ++r)
                    LOG[(size_t)(t * C::BM + wm * 64 + ACC_ROW(mi, r, fh)) * 64 + ni * 32 + fr] = acc[mi][ni][r];
            }
        }
    }
    else if constexpr (PH == PH_ROUTE) { ph_route(p, L, ntl); }
    else if constexpr (PH == PH_SHARED) {
        bf16_t* SA = (bf16_t*)(ws + OFF_SA);
        gemm_phase<4, 2>(HX, DM, ntl, (const bf16_t*)(ws + OFF_SGUT), DM, 512, DM, smem, [&](const f32x16 (&acc)[2][2], int row0, int col0) {
            UNROLL for (int mi = 0; mi < 2; ++mi) UNROLL for (int r = 0; r < 16; ++r) {
                const float gv = acc[mi][0][r], uv = acc[mi][1][r];
                SA[(size_t)(row0 + ACC_ROW(mi, r, fh)) * 256 + (col0 >> 6) * 32 + fr] = f2bf(gv / (1.f + __expf(-gv)) * uv);
            }
        });
    }
    else if constexpr (PH == PH_MOE_EXP) { const int cb = sub * MOE_CHUNK; ph_moe_exp(p, cb, min(cb + MOE_CHUNK, ntl), smem); }
    else if constexpr (PH == PH_MOE_COMB) {
        const int cb = sub * MOE_CHUNK, ce = min(cb + MOE_CHUNK, ntl);
        const float* MOD = (const float*)(ws + OFF_MOD); const bf16_t* YBUF = (const bf16_t*)(ws + OFF_YBUF);
        gemm_phase<4, 2>((const bf16_t*)(ws + OFF_SA) + (size_t)cb * 256, 256, ce - cb, (const bf16_t*)(ws + OFF_SDT), 256, DM, 256, smem, [&](const f32x16 (&acc)[2][2], int row0, int col0) {
            UNROLL for (int mi = 0; mi < 2; ++mi) UNROLL for (int r = 0; r < 16; ++r) {
                const int rl = row0 + ACC_ROW(mi, r, fh), n = cb + rl;
                float* xo = xs_row(p, n); const float* g2 = MOD + mod_row(n) * 6144 + 5 * DM;
                UNROLL for (int ni = 0; ni < 2; ++ni) {
                    const int c = col0 + ni * 32 + fr; float s = acc[mi][ni][r];
                    UNROLL for (int k = 0; k < 8; ++k) s += bf2f(YBUF[((size_t)rl * 8 + k) * DM + c]);
                    xo[c] += g2[c] * s;
                }
            }
        });
    }
}

template <int PH> __global__ void __launch_bounds__(NTHREADS, 2) k_phase(Params p, int L, int sub) {
    extern __shared__ __attribute__((aligned(16))) char smem[];
    run_phase<PH>(p, L, sub, smem);
}

template <int PH> static void launch_phase(const Params& p, int L, int sub, hipStream_t stream) {
    static bool attr = false;
    if (!attr) { (void)hipFuncSetAttribute((const void*)k_phase<PH>, hipFuncAttributeMaxDynamicSharedMemorySize, LDS_BYTES); attr = true; }
    hipLaunchKernelGGL(k_phase<PH>, dim3(256), dim3(NTHREADS), LDS_BYTES, stream, p, L, sub);
}

extern "C" void kernel_launch(void* const* d_in, const int* in_sizes, int n_in, void* d_out, int out_size, void* d_ws, size_t ws_size, hipStream_t stream) {
    if (n_in != N_IN || ws_size < WS_END) { fprintf(stderr, "kernel_launch: unexpected inputs (%d) or workspace (%zu < %zu)\n", n_in, ws_size, (size_t)WS_END); return; }
    Params p{};
    for (int i = 0; i < N_IN; ++i) p.in[i] = (const float*)d_in[i];
    p.out = (float*)d_out; p.ws = (char*)d_ws;
    for (int L = 0; L < 2; ++L) {
        const int ntl = L == 0 ? NT : NX;
        launch_phase<PH_MODCONV>(p, L, 0, stream);
        launch_phase<PH_HX>(p, L, 0, stream);
        launch_phase<PH_GEMM_R>(p, L, 0, stream);
        launch_phase<PH_RW_PREP>(p, L, 0, stream);
        launch_phase<PH_RW_SCAN>(p, L, 0, stream);
        launch_phase<PH_RW_READ>(p, L, 0, stream);
        launch_phase<PH_RW_G>(p, L, 0, stream);
        launch_phase<PH_GEMM_N>(p, L, 0, stream);
        launch_phase<PH_NA_NORM>(p, L, 0, stream);
        launch_phase<PH_NA_ATT>(p, L, 0, stream);
        launch_phase<PH_GEMM_M>(p, L, 0, stream);
        launch_phase<PH_ML_SCAN>(p, L, 0, stream);
        launch_phase<PH_ML_READ>(p, L, 0, stream);
        launch_phase<PH_GEMM_G>(p, L, 0, stream);
        launch_phase<PH_MERGE>(p, L, 0, stream);
        launch_phase<PH_OUT>(p, L, 0, stream);
        launch_phase<PH_NORM2>(p, L, 0, stream);
        launch_phase<PH_ROUTER>(p, L, 0, stream);
        launch_phase<PH_ROUTE>(p, L, 0, stream);
        launch_phase<PH_SHARED>(p, L, 0, stream);
        for (int c = 0; c * MOE_CHUNK < ntl; ++c) {
            launch_phase<PH_MOE_EXP>(p, L, c, stream);
            launch_phase<PH_MOE_COMB>(p, L, c, stream);
        }
    }
}
```

```cpp
#include <hip/hip_runtime.h>
#include <stdint.h>
#include <stdio.h>

#define DEV __device__ __forceinline__
#define UNROLL _Pragma("unroll")

typedef unsigned short bf16_t;
typedef short bf16x8 __attribute__((ext_vector_type(8)));
typedef float f32x16 __attribute__((ext_vector_type(16)));
typedef unsigned u32x4 __attribute__((ext_vector_type(4)));
typedef unsigned u32x2 __attribute__((ext_vector_type(2)));

constexpr int DM = 1024, NBATCH = 16, SEQ = 2048, CTXL = 256;
constexpr int NX = NBATCH * SEQ, NC = NBATCH * CTXL, NT = NX + NC;
constexpr int RW_COLS = 1920, NA_COLS = 1536, ML_COLS = 1552, GATE_COLS = 3072, IN_COLS = 8080;
constexpr int NTHREADS = 512;
constexpr int MOE_CHUNK = 9216, MOE_ST = 768;

enum { I_X = 0, I_C, I_CTX, I_CCTX, I_WADA, I_BADA, I_N1G, I_N2G, I_WIN, I_MU, I_W0, I_W2, I_A0, I_A2, I_KK, I_KA, I_RK, I_G2,
       I_LNG, I_LNB, I_V0, I_V1, I_V2, I_QNG, I_KNG, I_RPB, I_IB, I_FB, I_MNG, I_WBR, I_WOUT, I_RTR, I_MB, I_MWG, I_MWU, I_MWD,
       I_SG, I_SU, I_SD, N_IN };

constexpr size_t OFF_BAR = 0;
constexpr size_t OFF_MOD = 16384;
constexpr size_t OFF_WINT = OFF_MOD + 417792;
constexpr size_t OFF_WBT = OFF_WINT + (size_t)IN_COLS * 1024 * 2;
constexpr size_t OFF_WOUTT = OFF_WBT + (size_t)3 * 1024 * 512 * 2;
constexpr size_t OFF_SGUT = OFF_WOUTT + (size_t)1024 * 1024 * 2;
constexpr size_t OFF_SDT = OFF_SGUT + (size_t)512 * 1024 * 2;
constexpr size_t OFF_G2T = OFF_SDT + (size_t)1024 * 256 * 2;
constexpr size_t OFF_RTR = OFF_G2T + (size_t)512 * 128 * 2;
constexpr size_t OFF_CTXS = OFF_RTR + (size_t)2 * 64 * 1024 * 2;
constexpr size_t OFF_VF = OFF_CTXS + (size_t)NC * 1024 * 4;
constexpr size_t OFF_HX = OFF_VF + (size_t)NT * 512 * 2;
constexpr size_t OFF_BIG = OFF_HX + (size_t)NT * 1024 * 2;
constexpr size_t SZ_Y1 = (size_t)NT * 512 * 2;
constexpr size_t OFF_YA = OFF_BIG, OFF_YB = OFF_YA + SZ_Y1, OFF_YC = OFF_YB + SZ_Y1;
constexpr size_t OFF_PX = OFF_BIG + 3 * SZ_Y1;
constexpr size_t OFF_SCR = OFF_PX + (size_t)NT * RW_COLS * 2;
constexpr size_t SZ_SCR = (size_t)NT * 1152 * 2;
constexpr size_t WS_END = OFF_SCR + SZ_SCR;
constexpr size_t OFF_YS = OFF_YB;
constexpr size_t OFF_SGB = OFF_SCR;
constexpr size_t OFF_CB = OFF_SCR + (size_t)NT * 128 * 2;
constexpr size_t OFF_HS = OFF_SCR;
constexpr size_t OFF_GATES = OFF_PX;
constexpr size_t OFF_MGU = OFF_BIG;
constexpr size_t OFF_MDT = OFF_MGU + (size_t)64 * 256 * 1024 * 2;
constexpr size_t OFF_SA = OFF_MDT + (size_t)64 * 1024 * 128 * 2;
constexpr size_t OFF_EIDX = OFF_SA + (size_t)NT * 256 * 2;
constexpr size_t OFF_EW = OFF_EIDX + (size_t)NT * 8 * 4;
constexpr size_t OFF_LOG = OFF_EW + (size_t)NT * 8 * 4;
constexpr size_t OFF_H2LO = OFF_LOG + (size_t)NT * 64 * 4;
constexpr size_t OFF_YBUF = OFF_H2LO + (size_t)NT * 1024 * 2;
static_assert(OFF_YBUF + (size_t)MOE_CHUNK * 8 * 1024 * 2 <= WS_END, "moe layout");
static_assert(OFF_GATES + (size_t)NT * 3072 * 2 <= WS_END, "gates layout");
static_assert(WS_END <= (size_t)536870912, "workspace");

constexpr int LDS_BYTES = 155648;

struct Params {
    const float* in[N_IN];
    float* out;
    char* ws;
};

DEV int TID() { int t = threadIdx.x; asm volatile("" : "+v"(t)); return t; }
DEV float bf2f(bf16_t h) { return __uint_as_float(((unsigned)h) << 16); }
DEV bf16_t f2bf(float f) { unsigned u = __float_as_uint(f); u += 0x7FFFu + ((u >> 16) & 1u); return (bf16_t)(u >> 16); }
DEV unsigned pk2(float lo, float hi) { return (unsigned)f2bf(lo) | ((unsigned)f2bf(hi) << 16); }
DEV void ld8(const bf16_t* p, float (&o)[8]) {
    const u32x4 v = *(const u32x4*)p;
    o[0] = __uint_as_float(v.x << 16); o[1] = __uint_as_float(v.x & 0xffff0000u);
    o[2] = __uint_as_float(v.y << 16); o[3] = __uint_as_float(v.y & 0xffff0000u);
    o[4] = __uint_as_float(v.z << 16); o[5] = __uint_as_float(v.z & 0xffff0000u);
    o[6] = __uint_as_float(v.w << 16); o[7] = __uint_as_float(v.w & 0xffff0000u);
}
DEV void st8(bf16_t* p, const float (&v)[8]) {
    u32x4 o; o.x = pk2(v[0], v[1]); o.y = pk2(v[2], v[3]); o.z = pk2(v[4], v[5]); o.w = pk2(v[6], v[7]);
    *(u32x4*)p = o;
}
DEV float sigm(float x) { return 1.f / (1.f + __expf(-x)); }
DEV float sigm_acc(float x) { return 1.f / (1.f + expf(-x)); }
DEV int mod_row(int n) { return n < NX ? (n >> 11) : 16; }
DEV float* xs_row(const Params& p, int n) { return n < NX ? p.out + (size_t)n * DM : (float*)(p.ws + OFF_CTXS) + (size_t)(n - NX) * DM; }
DEV const float* xprev_row(const Params& p, int L, int n) {
    if (L == 0) return n < NX ? p.in[I_X] + (size_t)n * DM : p.in[I_CTX] + (size_t)(n - NX) * DM;
    return xs_row(p, n);
}
DEV void seq_of(int n, int& nb, int& tt, int& T) {
    if (n < NX) { nb = n & ~2047; tt = n & 2047; T = SEQ; } else { const int m = n - NX; nb = NX + (m & ~255); tt = m & 255; T = CTXL; }
}
DEV void shift8(const bf16_t* z, int ld, int nb, int tt, int T, int col0, const float* mu, float (&o)[8]) {
    float c[8], l[8], r[8];
    ld8(z + (size_t)(nb + tt) * ld + col0, c);
    if (tt > 0) ld8(z + (size_t)(nb + tt - 1) * ld + col0, l); else { UNROLL for (int i = 0; i < 8; ++i) l[i] = 0.f; }
    if (tt < T - 1) ld8(z + (size_t)(nb + tt + 1) * ld + col0, r); else { UNROLL for (int i = 0; i < 8; ++i) r[i] = 0.f; }
    UNROLL for (int i = 0; i < 8; ++i) o[i] = c[i] + mu[col0 + i] * (0.5f * (l[i] + r[i]) - c[i]);
}

constexpr int LROW = 144;
template <int WM, int WN> struct GC {
    static constexpr int BM = 64 * WM, BN = 64 * WN;
    static constexpr int AB = BM * LROW, BB = BN * LROW, STG = AB + BB;
    static constexpr int NA = BM / 64, NBC = BN / 64;
};
DEV void acc_zero(f32x16 (&acc)[2][2]) {
    UNROLL for (int a = 0; a < 2; ++a) UNROLL for (int b = 0; b < 2; ++b) UNROLL for (int r = 0; r < 16; ++r) acc[a][b][r] = 0.f;
}
template <int WM, int WN, bool A_LDS, class ARow>
DEV void gemm_tile(f32x16 (&acc)[2][2], ARow arow, const bf16_t* Bt, int ldb, int n0, int Nvalid, int K, char* smem, const char* alds) {
    typedef GC<WM, WN> C;
    const int tid = TID(), lane = tid & 63, wave = tid >> 6, wm = wave / WN, wn = wave % WN;
    const int fr = lane & 31, fh = lane >> 5;
    const int crow = tid >> 3, ckc = tid & 7;
    const bf16_t* pa[C::NA]; const bf16_t* pb[C::NBC];
    if (!A_LDS) { UNROLL for (int i = 0; i < C::NA; ++i) { const bf16_t* r = arow(crow + 64 * i); pa[i] = r ? r + ckc * 8 : nullptr; } }
    UNROLL for (int i = 0; i < C::NBC; ++i) { const int n = n0 + crow + 64 * i; pb[i] = n < Nvalid ? Bt + (size_t)n * ldb + ckc * 8 : nullptr; }
    u32x4 ra[C::NA], rb[C::NBC];
    const u32x4 z4 = {0u, 0u, 0u, 0u};
    const int nk = K >> 6;
    if (!A_LDS) { UNROLL for (int i = 0; i < C::NA; ++i) ra[i] = pa[i] ? *(const u32x4*)(pa[i]) : z4; }
    UNROLL for (int i = 0; i < C::NBC; ++i) rb[i] = pb[i] ? *(const u32x4*)(pb[i]) : z4;
    {
        char* As = smem; char* Bs = smem + C::AB;
        if (!A_LDS) { UNROLL for (int i = 0; i < C::NA; ++i) *(u32x4*)(As + (crow + 64 * i) * LROW + ckc * 16) = ra[i]; }
        UNROLL for (int i = 0; i < C::NBC; ++i) *(u32x4*)(Bs + (crow + 64 * i) * LROW + ckc * 16) = rb[i];
    }
    __syncthreads();
    const int a_off = (wm * 64 + fr) * LROW + fh * 16, b_off = (wn * 64 + fr) * LROW + fh * 16;
    for (int kt = 0; kt < nk; ++kt) {
        const bool more = kt + 1 < nk;
        if (more) {
            if (!A_LDS) { UNROLL for (int i = 0; i < C::NA; ++i) ra[i] = pa[i] ? *(const u32x4*)(pa[i] + (kt + 1) * 64) : z4; }
            UNROLL for (int i = 0; i < C::NBC; ++i) rb[i] = pb[i] ? *(const u32x4*)(pb[i] + (kt + 1) * 64) : z4;
        }
        const char* As = A_LDS ? alds + kt * C::AB : smem + (kt & 1) * C::STG;
        const char* Bs = smem + (kt & 1) * C::STG + C::AB;
        UNROLL for (int ks = 0; ks < 4; ++ks) {
            bf16x8 af[2], bfv[2];
            UNROLL for (int mi = 0; mi < 2; ++mi) af[mi] = *(const bf16x8*)(As + a_off + mi * 32 * LROW + ks * 32);
            UNROLL for (int ni = 0; ni < 2; ++ni) bfv[ni] = *(const bf16x8*)(Bs + b_off + ni * 32 * LROW + ks * 32);
            UNROLL for (int mi = 0; mi < 2; ++mi) UNROLL for (int ni = 0; ni < 2; ++ni)
                acc[mi][ni] = __builtin_amdgcn_mfma_f32_32x32x16_bf16(af[mi], bfv[ni], acc[mi][ni], 0, 0, 0);
        }
        if (more) {
            char* As2 = smem + ((kt + 1) & 1) * C::STG; char* Bs2 = As2 + C::AB;
            if (!A_LDS) { UNROLL for (int i = 0; i < C::NA; ++i) *(u32x4*)(As2 + (crow + 64 * i) * LROW + ckc * 16) = ra[i]; }
            UNROLL for (int i = 0; i < C::NBC; ++i) *(u32x4*)(Bs2 + (crow + 64 * i) * LROW + ckc * 16) = rb[i];
        }
        __syncthreads();
    }
}
#define ACC_ROW(mi, r, fh) ((mi) * 32 + ((r) & 3) + 8 * ((r) >> 2) + 4 * (fh))

constexpr int EPI_SLAB = 32 * 68 * 4;
template <class F> DEV void epi_rows(const f32x16 (&acc)[2][2], char* smem, F f) {
    const int lane = TID() & 63, wave = TID() >> 6, fr = lane & 31, fh = lane >> 5;
    float* st = (float*)(smem + wave * EPI_SLAB);
    UNROLL for (int mi = 0; mi < 2; ++mi) {
        UNROLL for (int ni = 0; ni < 2; ++ni) UNROLL for (int r = 0; r < 16; ++r)
            st[((r & 3) + 8 * (r >> 2) + 4 * fh) * 68 + ni * 32 + fr] = acc[mi][ni][r];
        UNROLL for (int it = 0; it < 4; ++it) {
            const int row = it * 8 + (lane >> 3), c8 = (lane & 7) * 8;
            const float4 a = *(const float4*)(st + row * 68 + c8), b = *(const float4*)(st + row * 68 + c8 + 4);
            float v[8] = {a.x, a.y, a.z, a.w, b.x, b.y, b.z, b.w};
            f(mi * 32 + row, c8, v);
        }
    }
    __syncthreads();
}

template <int WM, int WN, class Epi>
DEV void gemm_phase(const bf16_t* A, int lda, int M, const bf16_t* Bt, int ldb, int N, int K, char* smem, Epi epi) {
    typedef GC<WM, WN> C;
    const int nM = M / C::BM, nN = (N + C::BN - 1) / C::BN;
    const int wave = TID() >> 6, wm = wave / WN, wn = wave % WN;
    for (int t = blockIdx.x; t < nM * nN; t += gridDim.x) {
        const int pm = t / nN, pn = t % nN;
        f32x16 acc[2][2]; acc_zero(acc);
        const bf16_t* Ab = A + (size_t)pm * C::BM * lda;
        gemm_tile<WM, WN, false>(acc, [&](int r) { return Ab + (size_t)r * lda; }, Bt, ldb, pn * C::BN, N, K, smem, nullptr);
        epi(acc, pm * C::BM + wm * 64, pn * C::BN + wn * 64);
    }
}

DEV void ph_mod(const Params& p, int L, char* smem) {
    const int tid = TID();
    float* sc = (float*)smem;
    float* red = sc + 17 * 1024;
    const float* c = p.in[I_C]; const float* cc = p.in[I_CCTX];
    for (int i = tid; i < 17 * 1024; i += NTHREADS) { const float v = i < 16 * 1024 ? c[i] : cc[i - 16 * 1024]; sc[i] = v / (1.f + expf(-v)); }
    __syncthreads();
    const float* W = p.in[I_WADA] + (size_t)L * 1024 * 6144; const float* bA = p.in[I_BADA] + (size_t)L * 6144;
    float* MOD = (float*)(p.ws + OFF_MOD);
    for (int u = blockIdx.x; u < 192; u += gridDim.x) {
        const int ci = tid & 31, ks = tid >> 5, j = u * 32 + ci;
        float acc[17];
        UNROLL for (int r = 0; r < 17; ++r) acc[r] = 0.f;
        for (int k = ks * 64; k < ks * 64 + 64; ++k) {
            const float w = W[(size_t)k * 6144 + j];
            UNROLL for (int r = 0; r < 17; ++r) acc[r] += sc[r * 1024 + k] * w;
        }
        UNROLL for (int r = 0; r < 17; ++r) red[(ks * 17 + r) * 32 + ci] = acc[r];
        __syncthreads();
        for (int i = tid; i < 17 * 32; i += NTHREADS) {
            const int r = i >> 5, c2 = i & 31; float s = bA[u * 32 + c2];
            for (int k2 = 0; k2 < 16; ++k2) s += red[(k2 * 17 + r) * 32 + c2];
            MOD[r * 6144 + u * 32 + c2] = s;
        }
        __syncthreads();
    }
}
DEV void conv_job(const float* s0, const float* s1, bf16_t* d, int K, int N, int mode, int nmat, size_t sstride, size_t dstride, char* smem) {
    float* tile = (float*)smem;
    const int tid = TID();
    const int tK = K / 64, tN = mode == 1 ? (2 * N) / 64 : (N + 63) / 64, per = tK * tN;
    for (int t = blockIdx.x; t < per * nmat; t += gridDim.x) {
        const int mat = t / per, r = t % per, tk = r / tN, tn = r % tN;
        const float* a0 = s0 + (size_t)mat * sstride; const float* a1 = s1 ? s1 + (size_t)mat * sstride : nullptr;
        bf16_t* dd = d + (size_t)mat * dstride;
        UNROLL for (int i = 0; i < 8; ++i) {
            const int cc = tid & 63, k = (tid >> 6) + 8 * i; float v;
            if (mode == 1) { const float* s = (cc >> 5) ? a1 : a0; v = s[(size_t)(tk * 64 + k) * N + tn * 32 + (cc & 31)]; }
            else { const int n = tn * 64 + cc; v = n < N ? a0[(size_t)(tk * 64 + k) * N + n] : 0.f; }
            tile[k * 65 + cc] = v;
        }
        __syncthreads();
        UNROLL for (int i = 0; i < 8; ++i) {
            const int k = tid & 63, cc = (tid >> 6) + 8 * i; const int row = tn * 64 + cc;
            const float v = tile[k * 65 + cc];
            if (mode == 1 || row < N) {
                const bf16_t hi = f2bf(v);
                dd[(size_t)row * K + tk * 64 + k] = hi;
                if (mode == 2) dd[(size_t)N * K + (size_t)row * K + tk * 64 + k] = f2bf(v - bf2f(hi));
            }
        }
        __syncthreads();
    }
}
DEV void ph_conv_mix(const Params& p, int L, char* smem) {
    char* ws = p.ws;
    conv_job(p.in[I_WIN] + (size_t)L * 1024 * IN_COLS, nullptr, (bf16_t*)(ws + OFF_WINT), 1024, IN_COLS, 0, 1, 0, 0, smem);
    conv_job(p.in[I_WBR] + (size_t)L * 3 * 512 * 1024, nullptr, (bf16_t*)(ws + OFF_WBT), 512, 1024, 0, 3, (size_t)512 * 1024, (size_t)512 * 1024, smem);
    conv_job(p.in[I_WOUT] + (size_t)L * 1024 * 1024, nullptr, (bf16_t*)(ws + OFF_WOUTT), 1024, 1024, 0, 1, 0, 0, smem);
    conv_job(p.in[I_SG] + (size_t)L * 1024 * 256, p.in[I_SU] + (size_t)L * 1024 * 256, (bf16_t*)(ws + OFF_SGUT), 1024, 256, 1, 1, 0, 0, smem);
    conv_job(p.in[I_SD] + (size_t)L * 256 * 1024, nullptr, (bf16_t*)(ws + OFF_SDT), 256, 1024, 0, 1, 0, 0, smem);
    conv_job(p.in[I_G2] + (size_t)L * 128 * 512, nullptr, (bf16_t*)(ws + OFF_G2T), 128, 512, 0, 1, 0, 0, smem);
    conv_job(p.in[I_RTR] + (size_t)L * 1024 * 64, nullptr, (bf16_t*)(ws + OFF_RTR), 1024, 64, 2, 1, 0, 0, smem);
}
DEV void ph_conv_moe(const Params& p, int L, char* smem) {
    char* ws = p.ws;
    const size_t eo = (size_t)L * 64 * 1024 * 128;
    conv_job(p.in[I_MWG] + eo, p.in[I_MWU] + eo, (bf16_t*)(ws + OFF_MGU), 1024, 128, 1, 64, (size_t)1024 * 128, (size_t)256 * 1024, smem);
    conv_job(p.in[I_MWD] + eo, nullptr, (bf16_t*)(ws + OFF_MDT), 128, 1024, 0, 64, (size_t)128 * 1024, (size_t)1024 * 128, smem);
}

DEV void ph_norm(const Params& p, int L, int which, int ntok) {
    const int lane = TID() & 63, wave = TID() >> 6;
    const float* MOD = (const float*)(p.ws + OFF_MOD);
    const float* g = p.in[which ? I_N2G : I_N1G] + (size_t)L * DM;
    bf16_t* H = (bf16_t*)(p.ws + OFF_HX); bf16_t* HLO = (bf16_t*)(p.ws + OFF_H2LO);
    for (int n0 = blockIdx.x * 8; n0 < ntok; n0 += gridDim.x * 8) {
        const int n = n0 + wave;
        const float* xr = which ? xs_row(p, n) : xprev_row(p, L, n);
        float4 v[4]; float ss = 0.f;
        UNROLL for (int i = 0; i < 4; ++i) { v[i] = *(const float4*)(xr + i * 256 + lane * 4); ss += v[i].x * v[i].x + v[i].y * v[i].y + v[i].z * v[i].z + v[i].w * v[i].w; }
        UNROLL for (int o = 1; o < 64; o <<= 1) ss += __shfl_xor(ss, o);
        const float rstd = rsqrtf(ss * (1.f / DM) + 1e-6f);
        const float* sh = MOD + mod_row(n) * 6144 + (which ? 3 : 0) * DM; const float* sc = sh + DM;
        UNROLL for (int i = 0; i < 4; ++i) {
            const int c = i * 256 + lane * 4;
            const float4 gg = *(const float4*)(g + c), s1 = *(const float4*)(sc + c), s0 = *(const float4*)(sh + c);
            const float h0 = v[i].x * rstd * gg.x * (1.f + s1.x) + s0.x, h1 = v[i].y * rstd * gg.y * (1.f + s1.y) + s0.y;
            const float h2 = v[i].z * rstd * gg.z * (1.f + s1.z) + s0.z, h3 = v[i].w * rstd * gg.w * (1.f + s1.w) + s0.w;
            u32x2 o; o.x = pk2(h0, h1); o.y = pk2(h2, h3);
            *(u32x2*)(H + (size_t)n * DM + c) = o;
            if (which) {
                u32x2 o2;
                o2.x = pk2(h0 - bf2f((bf16_t)(o.x & 0xffff)), h1 - bf2f((bf16_t)(o.x >> 16)));
                o2.y = pk2(h2 - bf2f((bf16_t)(o.y & 0xffff)), h3 - bf2f((bf16_t)(o.y >> 16)));
                *(u32x2*)(HLO + (size_t)n * DM + c) = o2;
            }
        }
    }
}

DEV void ph_rw_prep(const Params& p, int L, char* smem) {
    const int lane = TID() & 63, wave = TID() >> 6;
    float* vsh = (float*)smem + wave * 512;
    const bf16_t* PXR = (const bf16_t*)(p.ws + OFF_PX); bf16_t* VF = (bf16_t*)(p.ws + OFF_VF);
    const float* mu = p.in[I_MU] + (size_t)L * RW_COLS;
    const float* v0 = p.in[I_V0]; const float* v1 = p.in[I_V1]; const float* v2 = p.in[I_V2];
    for (int n0 = blockIdx.x * 8; n0 < NT; n0 += gridDim.x * 8) {
        const int n = n0 + wave; int nb, tt, T; seq_of(n, nb, tt, T);
        float vs[8]; shift8(PXR, RW_COLS, nb, tt, T, 1024 + lane * 8, mu, vs);
        if (L == 0) { st8(VF + (size_t)n * 512 + lane * 8, vs); }
        else {
            UNROLL for (int i = 0; i < 8; ++i) vsh[lane * 8 + i] = vs[i];
            __syncthreads();
            const int q = lane & 31, hf = lane >> 5; float t1 = 0.f;
            for (int jj = 0; jj < 256; ++jj) t1 += vsh[hf * 256 + jj] * v1[(hf * 256 + jj) * 32 + q];
            t1 += __shfl_xor(t1, 32);
            float u[8];
            UNROLL for (int i = 0; i < 8; ++i) u[i] = v0[lane * 8 + i];
            for (int q2 = 0; q2 < 32; ++q2) { const float tq = __shfl(t1, q2); UNROLL for (int i = 0; i < 8; ++i) u[i] += tq * v2[q2 * 512 + lane * 8 + i]; }
            float vf[8], o[8]; ld8(VF + (size_t)n * 512 + lane * 8, vf);
            UNROLL for (int i = 0; i < 8; ++i) o[i] = vs[i] + (vf[i] - vs[i]) * sigm_acc(u[i]);
            st8(VF + (size_t)n * 512 + lane * 8, o);
            __syncthreads();
        }
    }
}

DEV void ph_rw_scan(const Params& p, int L, char* smem) {
    const int tid = TID(), tq = tid >> 3, j = tid & 7;
    float* Wd = (float*)smem; float* Bv = Wd + 4096; float* Av = Bv + 4096; float* Kd = Av + 4096; float* Rr = Kd + 4096;
    float* Vv = Rr + 4096; float* Yc = Vv + 4096; float* lw2 = Yc + 4096; float* la2 = lw2 + 4096;
    const bf16_t* PXR = (const bf16_t*)(p.ws + OFF_PX); const bf16_t* VF = (const bf16_t*)(p.ws + OFF_VF);
    bf16_t* YS = (bf16_t*)(p.ws + OFF_YS); float* CB = (float*)(p.ws + OFF_CB);
    const float* mu = p.in[I_MU] + (size_t)L * RW_COLS;
    const float* w0 = p.in[I_W0] + (size_t)L * 1024; const float* w2 = p.in[I_W2] + (size_t)L * 65536;
    const float* a0 = p.in[I_A0] + (size_t)L * 1024; const float* a2 = p.in[I_A2] + (size_t)L * 65536;
    const float* kkw = p.in[I_KK] + (size_t)L * 512; const float* kaw = p.in[I_KA] + (size_t)L * 512; const float* rkw = p.in[I_RK] + (size_t)L * 512;
    for (int u = blockIdx.x; u < 256; u += gridDim.x) {
        const int b = u >> 4, h = (u >> 1) & 7, d = u & 1;
        for (int i = tid; i < 4096; i += NTHREADS) { const int l = i >> 6, n = i & 63; lw2[i] = w2[(size_t)(d * 64 + l) * 512 + h * 64 + n]; la2[i] = a2[(size_t)(d * 64 + l) * 512 + h * 64 + n]; }
        float S[8];
        UNROLL for (int i = 0; i < 8; ++i) S[i] = 0.f;
        const int ch = h * 64 + 8 * j, idx = tq * 64 + 8 * j;
        for (int ci = 0; ci < 36; ++ci) {
            const bool isc = ci < 4; const int T = isc ? CTXL : SEQ, cc = isc ? ci : ci - 4;
            const int t0 = d == 0 ? cc * 64 : T - 64 * (cc + 1), nb = isc ? NX + b * CTXL : b * SEQ, tt = t0 + tq;
            {
                float x1[8], x2[8];
                shift8(PXR, RW_COLS, nb, tt, T, 1536 + d * 64 + 8 * j, mu, x1);
                shift8(PXR, RW_COLS, nb, tt, T, 1664 + d * 64 + 8 * j, mu, x2);
                UNROLL for (int i = 0; i < 8; ++i) { Wd[idx + i] = tanhf(x1[i]); Bv[idx + i] = x2[i]; }
            }
            __syncthreads();
            float wl[8], al[8];
            UNROLL for (int i = 0; i < 8; ++i) { wl[i] = 0.f; al[i] = 0.f; }
            for (int l = 0; l < 64; ++l) {
                const float x1 = Wd[tq * 64 + l], x2 = Bv[tq * 64 + l];
                const float4 wa = *(const float4*)(lw2 + l * 64 + 8 * j), wb = *(const float4*)(lw2 + l * 64 + 8 * j + 4);
                const float4 aa = *(const float4*)(la2 + l * 64 + 8 * j), ab = *(const float4*)(la2 + l * 64 + 8 * j + 4);
                wl[0] += x1 * wa.x; wl[1] += x1 * wa.y; wl[2] += x1 * wa.z; wl[3] += x1 * wa.w; wl[4] += x1 * wb.x; wl[5] += x1 * wb.y; wl[6] += x1 * wb.z; wl[7] += x1 * wb.w;
                al[0] += x2 * aa.x; al[1] += x2 * aa.y; al[2] += x2 * aa.z; al[3] += x2 * aa.w; al[4] += x2 * ab.x; al[5] += x2 * ab.y; al[6] += x2 * ab.z; al[7] += x2 * ab.w;
            }
            __syncthreads();
            {
                float r8[8], k8[8], v8[8], kkr[8], av[8];
                shift8(PXR, RW_COLS, nb, tt, T, h * 64 + 8 * j, mu, r8);
                shift8(PXR, RW_COLS, nb, tt, T, 512 + h * 64 + 8 * j, mu, k8);
                ld8(VF + (size_t)(nb + tt) * 512 + ch, v8);
                float ss = 0.f, cbp = 0.f;
                UNROLL for (int i = 0; i < 8; ++i) {
                    const float xw = -(w0[d * 512 + ch + i] + wl[i]);
                    const float sp = fmaxf(xw, 0.f) + log1pf(expf(-fabsf(xw)));
                    const float w = -sp - 0.5f;
                    const float dec = expf(-expf(w));
                    const float a = sigm_acc(a0[d * 512 + ch + i] + al[i]);
                    const float kr = k8[i] * kkw[ch + i]; kkr[i] = kr; ss += kr * kr;
                    const float kd = k8[i] * (1.f + (a - 1.f) * kaw[ch + i]);
                    cbp += r8[i] * kd * rkw[ch + i];
                    Wd[idx + i] = dec; Kd[idx + i] = kd; Rr[idx + i] = r8[i]; Vv[idx + i] = v8[i]; av[i] = a;
                }
                ss += __shfl_xor(ss, 1); ss += __shfl_xor(ss, 2); ss += __shfl_xor(ss, 4);
                cbp += __shfl_xor(cbp, 1); cbp += __shfl_xor(cbp, 2); cbp += __shfl_xor(cbp, 4);
                const float inv = 1.f / fmaxf(sqrtf(ss), 1e-12f);
                UNROLL for (int i = 0; i < 8; ++i) { const float kk = kkr[i] * inv; Av[idx + i] = -kk; Bv[idx + i] = kk * av[i]; }
                if (j == 0) CB[((size_t)d * NT + nb + tt) * 8 + h] = cbp;
            }
            __syncthreads();
            for (int s = 0; s < 64; ++s) {
                const int t = d == 0 ? s : 63 - s, o = t * 64 + 8 * j;
                const float4 w_a = *(const float4*)(Wd + o), w_b = *(const float4*)(Wd + o + 4);
                const float4 a_a = *(const float4*)(Av + o), a_b = *(const float4*)(Av + o + 4);
                const float4 b_a = *(const float4*)(Bv + o), b_b = *(const float4*)(Bv + o + 4);
                const float4 k_a = *(const float4*)(Kd + o), k_b = *(const float4*)(Kd + o + 4);
                const float4 r_a = *(const float4*)(Rr + o), r_b = *(const float4*)(Rr + o + 4);
                const float vv = Vv[t * 64 + tq];
                float sa = S[0] * a_a.x + S[1] * a_a.y + S[2] * a_a.z + S[3] * a_a.w + S[4] * a_b.x + S[5] * a_b.y + S[6] * a_b.z + S[7] * a_b.w;
                sa += __shfl_xor(sa, 1); sa += __shfl_xor(sa, 2); sa += __shfl_xor(sa, 4);
                S[0] = S[0] * w_a.x + sa * b_a.x + vv * k_a.x; S[1] = S[1] * w_a.y + sa * b_a.y + vv * k_a.y;
                S[2] = S[2] * w_a.z + sa * b_a.z + vv * k_a.z; S[3] = S[3] * w_a.w + sa * b_a.w + vv * k_a.w;
                S[4] = S[4] * w_b.x + sa * b_b.x + vv * k_b.x; S[5] = S[5] * w_b.y + sa * b_b.y + vv * k_b.y;
                S[6] = S[6] * w_b.z + sa * b_b.z + vv * k_b.z; S[7] = S[7] * w_b.w + sa * b_b.w + vv * k_b.w;
                float y = S[0] * r_a.x + S[1] * r_a.y + S[2] * r_a.z + S[3] * r_a.w + S[4] * r_b.x + S[5] * r_b.y + S[6] * r_b.z + S[7] * r_b.w;
                y += __shfl_xor(y, 1); y += __shfl_xor(y, 2); y += __shfl_xor(y, 4);
                if (j == 0) Yc[t * 64 + tq] = y;
            }
            __syncthreads();
            {
                float y8[8];
                UNROLL for (int i = 0; i < 8; ++i) y8[i] = Yc[idx + i];
                st8(YS + ((size_t)d * NT + nb + tt) * 512 + ch, y8);
            }
        }
        __syncthreads();
    }
}

DEV void ph_rw_read(const Params& p, int L, int ntok) {
    const int lane = TID() & 63, wave = TID() >> 6;
    const bf16_t* PXR = (const bf16_t*)(p.ws + OFF_PX); const bf16_t* VF = (const bf16_t*)(p.ws + OFF_VF);
    const bf16_t* YS = (const bf16_t*)(p.ws + OFF_YS); const float* CB = (const float*)(p.ws + OFF_CB);
    bf16_t* YA = (bf16_t*)(p.ws + OFF_YA); bf16_t* SG = (bf16_t*)(p.ws + OFF_SGB);
    const float* mu = p.in[I_MU] + (size_t)L * RW_COLS;
    const float* lg = p.in[I_LNG] + (size_t)L * 512; const float* lb = p.in[I_LNB] + (size_t)L * 512;
    for (int n0 = blockIdx.x * 8; n0 < ntok; n0 += gridDim.x * 8) {
        const int n = n0 + wave, c = lane * 8, h = lane >> 3;
        float y0[8], y1[8], v8[8], o[8];
        ld8(YS + (size_t)n * 512 + c, y0); ld8(YS + ((size_t)NT + n) * 512 + c, y1); ld8(VF + (size_t)n * 512 + c, v8);
        float s = 0.f;
        UNROLL for (int i = 0; i < 8; ++i) { y0[i] += y1[i]; s += y0[i]; }
        s += __shfl_xor(s, 1); s += __shfl_xor(s, 2); s += __shfl_xor(s, 4);
        const float mean = s * (1.f / 64.f); float q = 0.f;
        UNROLL for (int i = 0; i < 8; ++i) { const float dd = y0[i] - mean; q += dd * dd; }
        q += __shfl_xor(q, 1); q += __shfl_xor(q, 2); q += __shfl_xor(q, 4);
        const float rstd = rsqrtf(q * (1.f / 64.f) + 64e-5f);
        const float bon = CB[(size_t)n * 8 + h] + CB[((size_t)NT + n) * 8 + h];
        UNROLL for (int i = 0; i < 8; ++i) o[i] = (y0[i] - mean) * rstd * lg[c + i] + lb[c + i] + bon * v8[i];
        st8(YA + (size_t)n * 512 + c, o);
        if (lane < 16) {
            int nb, tt, T; seq_of(n, nb, tt, T);
            float g8[8]; shift8(PXR, RW_COLS, nb, tt, T, 1792 + lane * 8, mu, g8);
            UNROLL for (int i = 0; i < 8; ++i) g8[i] = sigm_acc(g8[i]);
            st8(SG + (size_t)n * 128 + lane * 8, g8);
        }
    }
}

DEV void ph_na_norm(const Params& p, int L) {
    const int lane = TID() & 63, wave = TID() >> 6;
    bf16_t* PXN = (bf16_t*)(p.ws + OFF_PX);
    const float* qg = p.in[I_QNG] + (size_t)L * 64; const float* kg = p.in[I_KNG] + (size_t)L * 64;
    for (int n0 = blockIdx.x * 8; n0 < NT; n0 += gridDim.x * 8) {
        const int n = n0 + wave, c = lane * 8;
        UNROLL for (int w = 0; w < 2; ++w) {
            bf16_t* ptr = PXN + (size_t)n * NA_COLS + w * 512 + c;
            float x[8]; ld8(ptr, x);
            float ss = 0.f;
            UNROLL for (int i = 0; i < 8; ++i) ss += x[i] * x[i];
            ss += __shfl_xor(ss, 1); ss += __shfl_xor(ss, 2); ss += __shfl_xor(ss, 4);
            const float r = rsqrtf(ss * (1.f / 64.f) + 1e-6f) * (w == 0 ? 0.125f : 1.f);
            const float* g = w == 0 ? qg : kg;
            UNROLL for (int i = 0; i < 8; ++i) x[i] = x[i] * r * g[(c + i) & 63];
            st8(ptr, x);
        }
    }
}

DEV void ph_na_att(const Params& p, int L, char* smem) {
    const int tid = TID();
    char* KV = smem;
    float* P = (float*)(smem + 512 * LROW);
    float* Q = P + 16 * 512;
    float* RP = Q + 16 * 64;
    const bf16_t* PXN = (const bf16_t*)(p.ws + OFF_PX); bf16_t* YB = (bf16_t*)(p.ws + OFF_YB);
    const int nunits = 16384 + (L == 0 ? 2048 : 0);
    for (int u = blockIdx.x; u < nunits; u += gridDim.x) {
        const bool cu = u >= 16384;
        int b, h, r = 0, nbk = 0, qb = 0, rs = 0, band0 = 0, nkeys;
        if (!cu) { h = u & 7; nbk = (u >> 3) & 3; r = (u >> 5) & 31; b = u >> 10; rs = min(max(r - 4, 0), 24); band0 = min(max(nbk * 16 - 8, 0), 32); nkeys = 512; }
        else { const int v = u - 16384; h = v & 7; qb = (v >> 3) & 15; b = v >> 7; nkeys = 256; }
        const int ctx0 = NX + b * CTXL;
        for (int i = tid; i < 16 * 64; i += NTHREADS) {
            const int qi = i >> 6, dd = i & 63;
            const int tok = cu ? ctx0 + qb * 16 + qi : b * SEQ + r * 64 + nbk * 16 + qi;
            Q[i] = bf2f(PXN[(size_t)tok * NA_COLS + h * 64 + dd]);
        }
        if (!cu) for (int i = tid; i < 15 * 31; i += NTHREADS) RP[i] = p.in[I_RPB][((size_t)L * 8 + h) * 465 + i];
        UNROLL for (int i = 0; i < 8; ++i) {
            const int c = tid + NTHREADS * i, kx = c >> 3, part = c & 7;
            if (kx < nkeys) {
                int tok;
                if (cu) tok = ctx0 + kx;
                else tok = kx < 256 ? b * SEQ + (rs + (kx >> 5)) * 64 + band0 + (kx & 31) : ctx0 + (kx - 256);
                *(u32x4*)(KV + kx * LROW + part * 16) = *(const u32x4*)(PXN + (size_t)tok * NA_COLS + 512 + h * 64 + part * 8);
            }
        }
        __syncthreads();
        {
            const int qi = tid >> 5, part = tid & 31;
            float q[64];
            UNROLL for (int i = 0; i < 16; ++i) { const float4 t = *(const float4*)(Q + qi * 64 + i * 4); q[4 * i] = t.x; q[4 * i + 1] = t.y; q[4 * i + 2] = t.z; q[4 * i + 3] = t.w; }
            float sc[16]; float mx = -3e38f;
            const int col = nbk * 16 + qi, cs = min(max(col - 8, 0), 48);
            UNROLL for (int i = 0; i < 16; ++i) {
                const int kx = part + 32 * i;
                float s = -1e30f;
                if (kx < nkeys) {
                    s = 0.f;
                    UNROLL for (int g = 0; g < 8; ++g) { float kf[8]; ld8((const bf16_t*)(KV + kx * LROW + g * 16), kf); UNROLL for (int e = 0; e < 8; ++e) s += q[g * 8 + e] * kf[e]; }
                    if (!cu && i < 8) {
                        const int kc = band0 + part, kr = rs + i;
                        const bool valid = kc >= cs && kc < cs + 16;
                        s = valid ? s + RP[(kr - r + 7) * 31 + (kc - col + 15)] : -1e30f;
                    }
                }
                sc[i] = s; mx = fmaxf(mx, s);
            }
            UNROLL for (int o = 1; o < 32; o <<= 1) mx = fmaxf(mx, __shfl_xor(mx, o));
            float sum = 0.f;
            UNROLL for (int i = 0; i < 16; ++i) { sc[i] = __expf(sc[i] - mx); sum += sc[i]; }
            UNROLL for (int o = 1; o < 32; o <<= 1) sum += __shfl_xor(sum, o);
            const float inv = 1.f / sum;
            UNROLL for (int i = 0; i < 16; ++i) P[qi * 512 + part + 32 * i] = sc[i] * inv;
        }
        __syncthreads();
        UNROLL for (int i = 0; i < 8; ++i) {
            const int c = tid + NTHREADS * i, kx = c >> 3, part = c & 7;
            if (kx < nkeys) {
                int tok;
                if (cu) tok = ctx0 + kx;
                else tok = kx < 256 ? b * SEQ + (rs + (kx >> 5)) * 64 + band0 + (kx & 31) : ctx0 + (kx - 256);
                *(u32x4*)(KV + kx * LROW + part * 16) = *(const u32x4*)(PXN + (size_t)tok * NA_COLS + 1024 + h * 64 + part * 8);
            }
        }
        __syncthreads();
        {
            const int qi = tid >> 5, dp = tid & 31;
            float o0 = 0.f, o1 = 0.f;
            for (int kx = 0; kx < nkeys; ++kx) {
                const float pp = P[qi * 512 + kx];
                const unsigned vv = *(const unsigned*)(KV + kx * LROW + dp * 4);
                o0 += pp * __uint_as_float(vv << 16); o1 += pp * __uint_as_float(vv & 0xffff0000u);
            }
            const int tok = cu ? ctx0 + qb * 16 + qi : b * SEQ + r * 64 + nbk * 16 + qi;
            *(unsigned*)(YB + (size_t)tok * 512 + h * 64 + dp * 2) = pk2(o0, o1);
        }
        __syncthreads();
    }
}

DEV void ph_ml_scan(const Params& p, int L, char* smem) {
    const int tid = TID(), tq = tid >> 3, j = tid & 7;
    float* Qc = (float*)smem; float* Kc = Qc + 4096; float* Vc = Kc + 4096; float* Hc = Vc + 4096; float* FI = Hc + 4096;
    const bf16_t* PXM = (const bf16_t*)(p.ws + OFF_PX); bf16_t* HS = (bf16_t*)(p.ws + OFF_HS);
    for (int u = blockIdx.x; u < 256; u += gridDim.x) {
        const int vh = u & 1, d = (u >> 1) & 1, h = (u >> 2) & 3, b = u >> 4;
        const float ib = p.in[I_IB][L * 8 + d * 4 + h], fb = p.in[I_FB][L * 8 + d * 4 + h];
        float C[8], nn[8];
        UNROLL for (int i = 0; i < 8; ++i) { C[i] = 0.f; nn[i] = 0.f; }
        const int idx = tq * 64 + 8 * j;
        for (int ci = 0; ci < 36; ++ci) {
            const bool isc = ci < 4; const int T = isc ? CTXL : SEQ, cc = isc ? ci : ci - 4;
            const int t0 = d == 0 ? cc * 64 : T - 64 * (cc + 1), nb = isc ? NX + b * CTXL : b * SEQ, tt = t0 + tq;
            {
                const bf16_t* row = PXM + (size_t)(nb + tt) * ML_COLS;
                float q8[8], k8[8], v8[8];
                ld8(row + h * 64 + 8 * j, q8); ld8(row + 256 + h * 64 + 8 * j, k8); ld8(row + 512 + h * 128 + vh * 64 + 8 * j, v8);
                if (!isc) {
                    const int axis = j >> 2, half = (j >> 1) & 1; const float pos = (float)(axis == 0 ? (tt >> 6) : (tt & 63));
                    UNROLL for (int i = 0; i < 8; ++i) {
                        const int f = (j & 1) * 8 + i;
                        const float inv = exp2f(-(float)f * 0.83048202372184059f);
                        const float ang = pos * inv; const float cs = __cosf(ang), sn = __sinf(ang);
                        const float qo = __shfl_xor(q8[i], 2), ko = __shfl_xor(k8[i], 2);
                        q8[i] = half == 0 ? q8[i] * cs - qo * sn : q8[i] * cs + qo * sn;
                        k8[i] = half == 0 ? k8[i] * cs - ko * sn : k8[i] * cs + ko * sn;
                    }
                }
                UNROLL for (int i = 0; i < 8; ++i) { Qc[idx + i] = q8[i] * 0.125f; Kc[idx + i] = k8[i]; Vc[idx + i] = v8[i]; }
                if (j == 0) {
                    const float ig = bf2f(row[1536 + d * 4 + h]) + ib, fg = bf2f(row[1544 + d * 4 + h]) + fb;
                    const float igc = 15.f * tanhf(ig * (1.f / 15.f)), fgc = 15.f * tanhf(fg * (1.f / 15.f));
                    FI[tq * 2] = sigm_acc(fgc); FI[tq * 2 + 1] = expf(igc);
                }
            }
            __syncthreads();
            for (int s = 0; s < 64; ++s) {
                const int t = d == 0 ? s : 63 - s, o = t * 64 + 8 * j;
                const float4 ka = *(const float4*)(Kc + o), kb = *(const float4*)(Kc + o + 4);
                const float4 qa = *(const float4*)(Qc + o), qb = *(const float4*)(Qc + o + 4);
                const float f = FI[t * 2], ii = FI[t * 2 + 1];
                const float iv = ii * Vc[t * 64 + tq];
                C[0] = f * C[0] + iv * ka.x; C[1] = f * C[1] + iv * ka.y; C[2] = f * C[2] + iv * ka.z; C[3] = f * C[3] + iv * ka.w;
                C[4] = f * C[4] + iv * kb.x; C[5] = f * C[5] + iv * kb.y; C[6] = f * C[6] + iv * kb.z; C[7] = f * C[7] + iv * kb.w;
                nn[0] = f * nn[0] + ii * ka.x; nn[1] = f * nn[1] + ii * ka.y; nn[2] = f * nn[2] + ii * ka.z; nn[3] = f * nn[3] + ii * ka.w;
                nn[4] = f * nn[4] + ii * kb.x; nn[5] = f * nn[5] + ii * kb.y; nn[6] = f * nn[6] + ii * kb.z; nn[7] = f * nn[7] + ii * kb.w;
                float num = C[0] * qa.x + C[1] * qa.y + C[2] * qa.z + C[3] * qa.w + C[4] * qb.x + C[5] * qb.y + C[6] * qb.z + C[7] * qb.w;
                float den = nn[0] * qa.x + nn[1] * qa.y + nn[2] * qa.z + nn[3] * qa.w + nn[4] * qb.x + nn[5] * qb.y + nn[6] * qb.z + nn[7] * qb.w;
                num += __shfl_xor(num, 1); num += __shfl_xor(num, 2); num += __shfl_xor(num, 4);
                den += __shfl_xor(den, 1); den += __shfl_xor(den, 2); den += __shfl_xor(den, 4);
                if (j == 0) Hc[t * 64 + tq] = num / fmaxf(fabsf(den), 1.f);
            }
            __syncthreads();
            {
                float h8[8];
                UNROLL for (int i = 0; i < 8; ++i) h8[i] = Hc[idx + i];
                st8(HS + ((size_t)d * NT + nb + tt) * 512 + h * 128 + vh * 64 + 8 * j, h8);
            }
        }
        __syncthreads();
    }
}
DEV void ph_ml_read(const Params& p, int L, int ntok) {
    const int lane = TID() & 63, wave = TID() >> 6;
    const bf16_t* PXM = (const bf16_t*)(p.ws + OFF_PX); const bf16_t* HS = (const bf16_t*)(p.ws + OFF_HS);
    bf16_t* YC = (bf16_t*)(p.ws + OFF_YC); const float* ng = p.in[I_MNG] + (size_t)L * 512;
    for (int n0 = blockIdx.x * 8; n0 < ntok; n0 += gridDim.x * 8) {
        const int n = n0 + wave, c = lane * 8;
        float h0[8], h1[8], o8[8], out[8];
        ld8(HS + (size_t)n * 512 + c, h0); ld8(HS + ((size_t)NT + n) * 512 + c, h1); ld8(PXM + (size_t)n * ML_COLS + 1024 + c, o8);
        float ss = 0.f;
        UNROLL for (int i = 0; i < 8; ++i) { h0[i] += h1[i]; ss += h0[i] * h0[i]; }
        ss += __shfl_xor(ss, 1); ss += __shfl_xor(ss, 2); ss += __shfl_xor(ss, 4); ss += __shfl_xor(ss, 8);
        const float r = rsqrtf(ss * (1.f / 128.f) + 1e-6f);
        UNROLL for (int i = 0; i < 8; ++i) out[i] = h0[i] * r * ng[c + i] * sigm_acc(o8[i]);
        st8(YC + (size_t)n * 512 + c, out);
    }
}

DEV void ph_route(const Params& p, int L, int ntok) {
    const int lane = TID() & 63, wave = TID() >> 6;
    const float* LOG = (const float*)(p.ws + OFF_LOG); int* EIDX = (int*)(p.ws + OFF_EIDX); float* EW = (float*)(p.ws + OFF_EW);
    const float bias = p.in[I_MB][L * 64 + lane];
    for (int n0 = blockIdx.x * 8; n0 < ntok; n0 += gridDim.x * 8) {
        const int n = n0 + wave, g = lane >> 3;
        const float score = sigm_acc(LOG[(size_t)n * 64 + lane]), sel = score + bias;
        float m1 = sel; m1 = fmaxf(m1, __shfl_xor(m1, 1)); m1 = fmaxf(m1, __shfl_xor(m1, 2)); m1 = fmaxf(m1, __shfl_xor(m1, 4));
        int i1 = sel == m1 ? lane : 64; i1 = min(i1, __shfl_xor(i1, 1)); i1 = min(i1, __shfl_xor(i1, 2)); i1 = min(i1, __shfl_xor(i1, 4));
        float m2 = lane == i1 ? -3e38f : sel; m2 = fmaxf(m2, __shfl_xor(m2, 1)); m2 = fmaxf(m2, __shfl_xor(m2, 2)); m2 = fmaxf(m2, __shfl_xor(m2, 4));
        const float gs = m1 + m2;
        int rank = 0;
        UNROLL for (int g2 = 0; g2 < 8; ++g2) { const float v = __shfl(gs, g2 * 8); rank += (v > gs || (v == gs && g2 < g)) ? 1 : 0; }
        const float ms = rank < 4 ? sel : -1e30f;
        int er = 0;
        for (int e2 = 0; e2 < 64; ++e2) { const float v = __shfl(ms, e2); er += (v > ms || (v == ms && e2 < lane)) ? 1 : 0; }
        const bool chosen = er < 8;
        float ws = chosen ? score : 0.f;
        UNROLL for (int o = 1; o < 64; o <<= 1) ws += __shfl_xor(ws, o);
        if (chosen) { EIDX[(size_t)n * 8 + er] = lane; EW[(size_t)n * 8 + er] = score / ws * 2.5f; }
    }
}

DEV void ph_moe_exp(const Params& p, int cb, int ce, char* smem) {
    typedef GC<2, 4> C;
    const int tid = TID(), lane = tid & 63, wave = tid >> 6, wm = wave / 4, wn = wave % 4, fr = lane & 31, fh = lane >> 5;
    char* ACT = smem + 2 * C::STG;
    int* list = (int*)(ACT + 2 * C::AB);
    int* cnt = list + 1024;
    const bf16_t* H2 = (const bf16_t*)(p.ws + OFF_HX); const int* EIDX = (const int*)(p.ws + OFF_EIDX); const float* EW = (const float*)(p.ws + OFF_EW);
    bf16_t* YBUF = (bf16_t*)(p.ws + OFF_YBUF);
    const int nst = (ce - cb + MOE_ST - 1) / MOE_ST;
    for (int u = blockIdx.x; u < nst * 64; u += gridDim.x) {
        const int e = u / nst, st = u % nst, s0 = cb + st * MOE_ST, ntok = min(MOE_ST, ce - s0);
        if (tid == 0) *cnt = 0;
        __syncthreads();
        for (int i = tid; i < ntok * 8; i += NTHREADS) {
            if (EIDX[(size_t)s0 * 8 + i] == e) { const int pos = atomicAdd(cnt, 1); list[pos] = s0 * 8 + i; }
        }
        __syncthreads();
        const int M = *cnt;
        const bf16_t* GU = (const bf16_t*)(p.ws + OFF_MGU) + (size_t)e * 256 * 1024;
        const bf16_t* DT = (const bf16_t*)(p.ws + OFF_MDT) + (size_t)e * 1024 * 128;
        for (int mc = 0; mc < M; mc += 128) {
            f32x16 acc[2][2]; acc_zero(acc);
            gemm_tile<2, 4, false>(acc, [&](int r) -> const bf16_t* { const int ix = mc + r; return ix < M ? H2 + (size_t)(list[ix] >> 3) * 1024 : nullptr; },
                                   GU, 1024, 0, 256, 1024, smem, nullptr);
            UNROLL for (int mi = 0; mi < 2; ++mi) UNROLL for (int r = 0; r < 16; ++r) {
                const int row = wm * 64 + ACC_ROW(mi, r, fh), ix = mc + row;
                const float gw = ix < M ? EW[list[ix]] : 0.f;
                const float gv = acc[mi][0][r], uv = acc[mi][1][r];
                const float a = gv / (1.f + __expf(-gv)) * uv * gw;
                const int col = wn * 32 + fr;
                *(bf16_t*)(ACT + (col >> 6) * C::AB + row * LROW + (col & 63) * 2) = f2bf(a);
            }
            __syncthreads();
            for (int nt = 0; nt < 4; ++nt) {
                acc_zero(acc);
                gemm_tile<2, 4, true>(acc, [](int) -> const bf16_t* { return nullptr; }, DT, 128, nt * 256, 1024, 128, smem, ACT);
                epi_rows(acc, smem, [&](int row, int c8, const float (&v)[8]) {
                    const int ix = mc + wm * 64 + row;
                    if (ix < M) st8(YBUF + (size_t)(list[ix] - cb * 8) * 1024 + nt * 256 + wn * 64 + c8, v);
                });
            }
            __syncthreads();
        }
        __syncthreads();
    }
}


#define XB_TMO      128
#define XB_XCNT(j)  (256  + 64 * (j))
#define XB_XSUB(j)  (1280 + 64 * (j))
#define XB_XGEN(j)  (2304 + 64 * (j))
#define XB_TOP      3328
#define XB_TOPGEN   3392
#define XCD_BAR_WORDS 3456
#define XB_SPIN_CAP (1u << 18)
#define LAS __attribute__((address_space(3)))

__device__ __forceinline__ unsigned xb_ld(unsigned* p)              { return __hip_atomic_load(p, __ATOMIC_RELAXED, __HIP_MEMORY_SCOPE_AGENT); }
__device__ __forceinline__ unsigned xb_add(unsigned* p, unsigned v) { return __hip_atomic_fetch_add(p, v, __ATOMIC_RELAXED, __HIP_MEMORY_SCOPE_AGENT); }
__device__ __forceinline__ unsigned xb_xcc_id() { return (unsigned)__builtin_amdgcn_s_getreg((3 << 11) | 20) & 0xFu; }
#define XB_SPIN(cond, bar) do { unsigned _sp = 0; while (cond) { __builtin_amdgcn_s_sleep(1); \
    if ((++_sp & 255u) == 0u) { if (xb_ld(&(bar)[XB_TMO])) break; if (_sp > XB_SPIN_CAP) { atomicAdd(&(bar)[XB_TMO], 1u); break; } } } } while (0)

struct XcdBarrier { unsigned* bar; unsigned x; volatile LAS unsigned* st; };

__device__ __forceinline__ XcdBarrier xcd_barrier_post(unsigned* bar, volatile LAS unsigned* st) {
    XcdBarrier b; b.bar = bar; b.x = xb_xcc_id(); b.st = st;
    if (threadIdx.x == 0) (void)xb_add(&bar[XB_XCNT(b.x)], 1u);
    return b;
}
__device__ __forceinline__ void xcd_barrier_complete(unsigned* bar, unsigned x, unsigned& nloc, unsigned& nx) {
    const unsigned G = gridDim.x * gridDim.y * gridDim.z;
    unsigned sum, cnt, mine, sp = 0u;
    for (;;) {
        sum = 0u; cnt = 0u; mine = 0u;
#pragma unroll
        for (unsigned j = 0; j < 16; ++j) { const unsigned c = xb_ld(&bar[XB_XCNT(j)]); sum += c; cnt += (c > 0u) ? 1u : 0u; mine = (j == x) ? c : mine; }
        if (sum == G) break;
        __builtin_amdgcn_s_sleep(1);
        if ((++sp & 255u) == 0u) { if (xb_ld(&bar[XB_TMO])) break; if (sp > XB_SPIN_CAP) { atomicAdd(&bar[XB_TMO], 1u); break; } }
    }
    nloc = mine > 0u ? mine : 1u; nx = cnt > 0u ? cnt : 1u;
}
__device__ __forceinline__ void xcd_barrier(const XcdBarrier& b) {
    asm volatile("s_waitcnt vmcnt(0)" ::: "memory");
    __syncthreads();
    if (threadIdx.x == 0) {
        unsigned* bar = b.bar;
        __builtin_amdgcn_s_waitcnt(0);
        unsigned nloc = b.st[0], nx = b.st[1];
        if (nloc == 0u) { xcd_barrier_complete(bar, b.x, nloc, nx); b.st[0] = nloc; b.st[1] = nx; }
        const unsigned old = xb_add(&bar[XB_XSUB(b.x)], 1u);
        const unsigned gen = old / nloc;
        if (old + 1u == (gen + 1u) * nloc) {
            __builtin_amdgcn_fence(__ATOMIC_RELEASE, "agent");
            asm volatile("s_waitcnt vmcnt(0)" ::: "memory");
            const unsigned og = xb_add(&bar[XB_TOP], 1u);
            const unsigned tg = og / nx;
            if (og + 1u == (tg + 1u) * nx) xb_add(&bar[XB_TOPGEN], 1u);
            else XB_SPIN(xb_ld(&bar[XB_TOPGEN]) == tg, bar);
            __builtin_amdgcn_fence(__ATOMIC_ACQUIRE, "agent");
            xb_add(&bar[XB_XGEN(b.x)], 1u);
            asm volatile("s_waitcnt vmcnt(0)" ::: "memory");
        } else {
            XB_SPIN(xb_ld(&bar[XB_XGEN(b.x)]) == gen, bar);
            __builtin_amdgcn_fence(__ATOMIC_ACQUIRE, "agent");
            asm volatile("s_waitcnt vmcnt(0)" ::: "memory");
        }
    }
    __syncthreads();
}

enum { PH_MODCONV = 0, PH_HX, PH_GEMM_R, PH_RW_PREP, PH_RW_SCAN, PH_RW_READ, PH_RW_G, PH_GEMM_N, PH_NA_NORM, PH_NA_ATT, PH_GEMM_M, PH_ML_SCAN, PH_ML_READ,
       PH_GEMM_G, PH_MERGE, PH_OUT, PH_NORM2, PH_ROUTER, PH_ROUTE, PH_SHARED, PH_MOE_EXP, PH_MOE_COMB, PH_COUNT };

template <int PH> DEV void run_phase(const Params& p, int L, int sub, char* smem) {
    const int tid = TID(), lane = tid & 63, fr = lane & 31, fh = lane >> 5;
    char* ws = p.ws;
    const int ntl = L == 0 ? NT : NX;
    const bf16_t* HX = (const bf16_t*)(ws + OFF_HX);
    const bf16_t* WINT = (const bf16_t*)(ws + OFF_WINT);
    if constexpr (PH == PH_MODCONV) { ph_mod(p, L, smem); ph_conv_mix(p, L, smem); }
    else if constexpr (PH == PH_HX) { ph_norm(p, L, 0, NT); }
    else if constexpr (PH == PH_GEMM_R || PH == PH_GEMM_N || PH == PH_GEMM_M) {
        const int c0 = PH == PH_GEMM_R ? 0 : PH == PH_GEMM_N ? RW_COLS : RW_COLS + NA_COLS;
        const int N = PH == PH_GEMM_R ? RW_COLS : PH == PH_GEMM_N ? NA_COLS : ML_COLS;
        bf16_t* PX = (bf16_t*)(ws + OFF_PX);
        gemm_phase<4, 2>(HX, DM, NT, WINT + (size_t)c0 * DM, DM, N, DM, smem, [&](const f32x16 (&acc)[2][2], int row0, int col0) {
            epi_rows(acc, smem, [&](int row, int c8, const float (&v)[8]) {
                if (col0 + c8 < N) st8(PX + (size_t)(row0 + row) * N + col0 + c8, v);
            });
        });
    }
    else if constexpr (PH == PH_RW_PREP) { ph_rw_prep(p, L, smem); }
    else if constexpr (PH == PH_RW_SCAN) { ph_rw_scan(p, L, smem); }
    else if constexpr (PH == PH_RW_READ) { ph_rw_read(p, L, ntl); }
    else if constexpr (PH == PH_RW_G) {
        bf16_t* YA = (bf16_t*)(ws + OFF_YA);
        gemm_phase<4, 2>((const bf16_t*)(ws + OFF_SGB), 128, ntl, (const bf16_t*)(ws + OFF_G2T), 128, 512, 128, smem, [&](const f32x16 (&acc)[2][2], int row0, int col0) {
            epi_rows(acc, smem, [&](int row, int c8, const float (&v)[8]) {
                bf16_t* q = YA + (size_t)(row0 + row) * 512 + col0 + c8;
                float y[8]; ld8(q, y);
                UNROLL for (int i = 0; i < 8; ++i) y[i] *= v[i];
                st8(q, y);
            });
        });
    }
    else if constexpr (PH == PH_NA_NORM) { ph_na_norm(p, L); }
    else if constexpr (PH == PH_NA_ATT) { ph_na_att(p, L, smem); }
    else if constexpr (PH == PH_ML_SCAN) { ph_ml_scan(p, L, smem); }
    else if constexpr (PH == PH_ML_READ) { ph_ml_read(p, L, ntl); }
    else if constexpr (PH == PH_GEMM_G) {
        bf16_t* G = (bf16_t*)(ws + OFF_GATES);
        gemm_phase<4, 2>(HX, DM, ntl, WINT + (size_t)(RW_COLS + NA_COLS + ML_COLS) * DM, DM, GATE_COLS, DM, smem, [&](const f32x16 (&acc)[2][2], int row0, int col0) {
            epi_rows(acc, smem, [&](int row, int c8, const float (&v)[8]) {
                float y[8];
                UNROLL for (int i = 0; i < 8; ++i) y[i] = sigm(v[i]);
                st8(G + (size_t)(row0 + row) * GATE_COLS + col0 + c8, y);
            });
        });
    }
    else if constexpr (PH == PH_MERGE) {
        typedef GC<4, 2> C;
        const bf16_t* G = (const bf16_t*)(ws + OFF_GATES); bf16_t* MG = (bf16_t*)(ws + OFF_HX);
        const int nM = ntl / C::BM, nN = DM / C::BN, wave = tid >> 6, wm = wave / 2, wn = wave % 2;
        for (int t = blockIdx.x; t < nM * nN; t += gridDim.x) {
            const int pm = t / nN, pn = t % nN, row0 = pm * C::BM + wm * 64, col0 = pn * C::BN + wn * 64;
            _Pragma("unroll 1") for (int br = 0; br < 3; ++br) {
                f32x16 acc[2][2]; acc_zero(acc);
                const bf16_t* Ab = (const bf16_t*)(ws + OFF_YA + (size_t)br * SZ_Y1) + (size_t)pm * C::BM * 512;
                gemm_tile<4, 2, false>(acc, [&](int r) { return Ab + (size_t)r * 512; }, (const bf16_t*)(ws + OFF_WBT) + (size_t)br * 1024 * 512, 512, pn * C::BN, DM, 512, smem, nullptr);
                epi_rows(acc, smem, [&](int row, int c8, const float (&v)[8]) {
                    float g[8], m[8];
                    ld8(G + (size_t)(row0 + row) * GATE_COLS + br * DM + col0 + c8, g);
                    bf16_t* q = MG + (size_t)(row0 + row) * DM + col0 + c8;
                    if (br == 0) { UNROLL for (int i = 0; i < 8; ++i) m[i] = g[i] * v[i]; }
                    else { ld8(q, m); UNROLL for (int i = 0; i < 8; ++i) m[i] += g[i] * v[i]; }
                    st8(q, m);
                });
            }
        }
    }
    else if constexpr (PH == PH_OUT) {
        const float* MOD = (const float*)(ws + OFF_MOD);
        gemm_phase<4, 2>(HX, DM, ntl, (const bf16_t*)(ws + OFF_WOUTT), DM, DM, DM, smem, [&](const f32x16 (&acc)[2][2], int row0, int col0) {
            epi_rows(acc, smem, [&](int row, int c8, const float (&v)[8]) {
                const int n = row0 + row, c = col0 + c8;
                const float* xp = xprev_row(p, L, n) + c; float* xo = xs_row(p, n) + c; const float* g1 = MOD + mod_row(n) * 6144 + 2 * DM + c;
                const float4 xa = *(const float4*)xp, xb = *(const float4*)(xp + 4), ga = *(const float4*)g1, gb = *(const float4*)(g1 + 4);
                float4 oa, ob;
                oa.x = xa.x + ga.x * v[0]; oa.y = xa.y + ga.y * v[1]; oa.z = xa.z + ga.z * v[2]; oa.w = xa.w + ga.w * v[3];
                ob.x = xb.x + gb.x * v[4]; ob.y = xb.y + gb.y * v[5]; ob.z = xb.z + gb.z * v[6]; ob.w = xb.w + gb.w * v[7];
                *(float4*)xo = oa; *(float4*)(xo + 4) = ob;
            });
        });
    }
    else if constexpr (PH == PH_NORM2) { ph_norm(p, L, 1, ntl); ph_conv_moe(p, L, smem); }
    else if constexpr (PH == PH_ROUTER) {
        typedef GC<4, 2> C;
        float* LOG = (float*)(ws + OFF_LOG);
        const bf16_t* H2LO = (const bf16_t*)(ws + OFF_H2LO); const bf16_t* RH = (const bf16_t*)(ws + OFF_RTR); const bf16_t* RL = RH + 64 * 1024;
        const int wave = tid >> 6, wm = wave / 2, wn = wave % 2;
        for (int t = blockIdx.x; t < ntl / C::BM; t += gridDim.x) {
            f32x16 acc[2][2]; acc_zero(acc);
            const bf16_t* A0 = HX + (size_t)t * C::BM * DM; const bf16_t* A1 = H2LO + (size_t)t * C::BM * DM;
            gemm_tile<4, 2, false>(acc, [&](int r) { return A0 + (size_t)r * DM; }, RH, DM, 0, 64, DM, smem, nullptr);
            gemm_tile<4, 2, false>(acc, [&](int r) { return A1 + (size_t)r * DM; }, RH, DM, 0, 64, DM, smem, nullptr);
            gemm_tile<4, 2, false>(acc, [&](int r) { return A0 + (size_t)r * DM; }, RL, DM, 0, 64, DM, smem, nullptr);
            epi_rows(acc, smem, [&](int row, int c8, const float (&v)[8]) {
                if (wn == 0) {
                    float* q = LOG + (size_t)(t * C::BM + wm * 64 + row) * 64 + c8;
                    *(float4*)q = make_float4(v[0], v[1], v[2], v[3]); *(float4*)(q + 4) = make_float4(v[4], v[5], v[6], v[7]);
                }
            });
        }
    }
    else if constexpr (PH == PH_ROUTE) { ph_route(p, L, ntl); }
    else if constexpr (PH == PH_SHARED) {
        bf16_t* SA = (bf16_t*)(ws + OFF_SA);
        gemm_phase<4, 2>(HX, DM, ntl, (const bf16_t*)(ws + OFF_SGUT), DM, 512, DM, smem, [&](const f32x16 (&acc)[2][2], int row0, int col0) {
            f32x16 a2[2][2];
            UNROLL for (int mi = 0; mi < 2; ++mi) UNROLL for (int r = 0; r < 16; ++r) {
                const float gv = acc[mi][0][r], uv = acc[mi][1][r];
                a2[mi][0][r] = gv / (1.f + __expf(-gv)) * uv; a2[mi][1][r] = 0.f;
            }
            epi_rows(a2, smem, [&](int row, int c8, const float (&v)[8]) {
                if (c8 < 32) st8(SA + (size_t)(row0 + row) * 256 + (col0 >> 6) * 32 + c8, v);
            });
        });
    }
    else if constexpr (PH == PH_MOE_EXP) { const int cb = sub * MOE_CHUNK; ph_moe_exp(p, cb, min(cb + MOE_CHUNK, ntl), smem); }
    else if constexpr (PH == PH_MOE_COMB) {
        const int cb = sub * MOE_CHUNK, ce = min(cb + MOE_CHUNK, ntl);
        const float* MOD = (const float*)(ws + OFF_MOD); const bf16_t* YBUF = (const bf16_t*)(ws + OFF_YBUF);
        gemm_phase<4, 2>((const bf16_t*)(ws + OFF_SA) + (size_t)cb * 256, 256, ce - cb, (const bf16_t*)(ws + OFF_SDT), 256, DM, 256, smem, [&](const f32x16 (&acc)[2][2], int row0, int col0) {
            epi_rows(acc, smem, [&](int row, int c8, const float (&v)[8]) {
                const int rl = row0 + row, n = cb + rl, c = col0 + c8;
                float s[8];
                UNROLL for (int i = 0; i < 8; ++i) s[i] = v[i];
                UNROLL for (int k = 0; k < 8; ++k) { float y[8]; ld8(YBUF + ((size_t)rl * 8 + k) * DM + c, y); UNROLL for (int i = 0; i < 8; ++i) s[i] += y[i]; }
                float* xo = xs_row(p, n) + c; const float* g2 = MOD + mod_row(n) * 6144 + 5 * DM + c;
                float4 xa = *(const float4*)xo, xb = *(const float4*)(xo + 4); const float4 ga = *(const float4*)g2, gb = *(const float4*)(g2 + 4);
                xa.x += ga.x * s[0]; xa.y += ga.y * s[1]; xa.z += ga.z * s[2]; xa.w += ga.w * s[3];
                xb.x += gb.x * s[4]; xb.y += gb.y * s[5]; xb.z += gb.z * s[6]; xb.w += gb.w * s[7];
                *(float4*)xo = xa; *(float4*)(xo + 4) = xb;
            });
        });
    }
}

template <int PH> __global__ void __launch_bounds__(NTHREADS, 2) k_phase(Params p, int L, int sub) {
    extern __shared__ __attribute__((aligned(16))) char smem[];
    run_phase<PH>(p, L, sub, smem);
}


#ifndef N_LAUNCH_MODE
#define N_LAUNCH_MODE 1
#endif
#ifndef MEGA_SKIP
#define MEGA_SKIP 0ull
#endif
#define PHASE(PH, sub) do { if constexpr (!((MEGA_SKIP >> PH) & 1ull)) { run_phase<PH>(p, L, sub, smem); xcd_barrier(bar); } } while (0)
__global__ void __launch_bounds__(NTHREADS, 2) k_mega(Params p) {
    extern __shared__ __attribute__((aligned(16))) char smem[];
    volatile LAS unsigned* st = (volatile LAS unsigned*)(smem + LDS_BYTES);
    if (threadIdx.x == 0) { st[0] = 0u; st[1] = 0u; st[2] = 0u; st[3] = 0u; }
    __syncthreads();
    const XcdBarrier bar = xcd_barrier_post((unsigned*)(p.ws + OFF_BAR), st);
    for (int L = 0; L < 2; ++L) {
        const int ntl = L == 0 ? NT : NX;
        PHASE(PH_MODCONV, 0);
        PHASE(PH_HX, 0);
        PHASE(PH_GEMM_R, 0);
        PHASE(PH_RW_PREP, 0);
        PHASE(PH_RW_SCAN, 0);
        PHASE(PH_RW_READ, 0);
        PHASE(PH_RW_G, 0);
        PHASE(PH_GEMM_N, 0);
        PHASE(PH_NA_NORM, 0);
        PHASE(PH_NA_ATT, 0);
        PHASE(PH_GEMM_M, 0);
        PHASE(PH_ML_SCAN, 0);
        PHASE(PH_ML_READ, 0);
        PHASE(PH_GEMM_G, 0);
        PHASE(PH_MERGE, 0);
        PHASE(PH_OUT, 0);
        PHASE(PH_NORM2, 0);
        PHASE(PH_ROUTER, 0);
        PHASE(PH_ROUTE, 0);
        PHASE(PH_SHARED, 0);
        for (int c = 0; c * MOE_CHUNK < ntl; ++c) {
            PHASE(PH_MOE_EXP, c);
            PHASE(PH_MOE_COMB, c);
        }
    }
}

template <int PH> static void launch_phase(const Params& p, int L, int sub, hipStream_t stream) {
    static bool attr = false;
    if (!attr) { (void)hipFuncSetAttribute((const void*)k_phase<PH>, hipFuncAttributeMaxDynamicSharedMemorySize, LDS_BYTES); attr = true; }
    hipLaunchKernelGGL(k_phase<PH>, dim3(256), dim3(NTHREADS), LDS_BYTES, stream, p, L, sub);
}

extern "C" void kernel_launch(void* const* d_in, const int* in_sizes, int n_in, void* d_out, int out_size, void* d_ws, size_t ws_size, hipStream_t stream) {
    if (n_in != N_IN || ws_size < WS_END) { fprintf(stderr, "kernel_launch: unexpected inputs (%d) or workspace (%zu < %zu)\n", n_in, ws_size, (size_t)WS_END); return; }
    Params p{};
    for (int i = 0; i < N_IN; ++i) p.in[i] = (const float*)d_in[i];
    p.out = (float*)d_out; p.ws = (char*)d_ws;
#if N_LAUNCH_MODE == 1
    static int grid = 0;
    if (grid == 0) {
        int dev = 0, cus = 0;
        if (hipGetDevice(&dev) != hipSuccess || hipDeviceGetAttribute(&cus, hipDeviceAttributeMultiprocessorCount, dev) != hipSuccess) { grid = -1; return; }
        if (hipFuncSetAttribute((const void*)k_mega, hipFuncAttributeMaxDynamicSharedMemorySize, LDS_BYTES + 256) != hipSuccess) { grid = -1; return; }
        grid = cus;
    }
    if (grid <= 0) return;
    (void)hipMemsetAsync((char*)d_ws + OFF_BAR, 0, XCD_BAR_WORDS * sizeof(unsigned), stream);
    hipLaunchKernelGGL(k_mega, dim3(grid), dim3(NTHREADS), LDS_BYTES + 256, stream, p);
    return;
#endif
    for (int L = 0; L < 2; ++L) {
        const int ntl = L == 0 ? NT : NX;
        launch_phase<PH_MODCONV>(p, L, 0, stream);
        launch_phase<PH_HX>(p, L, 0, stream);
        launch_phase<PH_GEMM_R>(p, L, 0, stream);
        launch_phase<PH_RW_PREP>(p, L, 0, stream);
        launch_phase<PH_RW_SCAN>(p, L, 0, stream);
        launch_phase<PH_RW_READ>(p, L, 0, stream);
        launch_phase<PH_RW_G>(p, L, 0, stream);
        launch_phase<PH_GEMM_N>(p, L, 0, stream);
        launch_phase<PH_NA_NORM>(p, L, 0, stream);
        launch_phase<PH_NA_ATT>(p, L, 0, stream);
        launch_phase<PH_GEMM_M>(p, L, 0, stream);
        launch_phase<PH_ML_SCAN>(p, L, 0, stream);
        launch_phase<PH_ML_READ>(p, L, 0, stream);
        launch_phase<PH_GEMM_G>(p, L, 0, stream);
        launch_phase<PH_MERGE>(p, L, 0, stream);
        launch_phase<PH_OUT>(p, L, 0, stream);
        launch_phase<PH_NORM2>(p, L, 0, stream);
        launch_phase<PH_ROUTER>(p, L, 0, stream);
        launch_phase<PH_ROUTE>(p, L, 0, stream);
        launch_phase<PH_SHARED>(p, L, 0, stream);
        for (int c = 0; c * MOE_CHUNK < ntl; ++c) {
            launch_phase<PH_MOE_EXP>(p, L, c, stream);
            launch_phase<PH_MOE_COMB>(p, L, c, stream);
        }
    }
}
```

```cpp
#include <hip/hip_runtime.h>
#include <stdint.h>
#include <stdio.h>

#define DEV __device__ __forceinline__
#define UNROLL _Pragma("unroll")

typedef unsigned short bf16_t;
typedef short bf16x8 __attribute__((ext_vector_type(8)));
typedef float f32x16 __attribute__((ext_vector_type(16)));
typedef float f32x4v __attribute__((ext_vector_type(4)));
typedef unsigned u32x4 __attribute__((ext_vector_type(4)));
typedef unsigned u32x2 __attribute__((ext_vector_type(2)));

constexpr int DM = 1024, NBATCH = 16, SEQ = 2048, CTXL = 256;
constexpr int NX = NBATCH * SEQ, NC = NBATCH * CTXL, NT = NX + NC;
constexpr int RW_COLS = 1920, NA_COLS = 1536, ML_COLS = 1552, GATE_COLS = 3072, IN_COLS = 8080;
constexpr int NTHREADS = 512;
constexpr int MOE_CHUNK = 12288, MOE_ST = 768;

enum { I_X = 0, I_C, I_CTX, I_CCTX, I_WADA, I_BADA, I_N1G, I_N2G, I_WIN, I_MU, I_W0, I_W2, I_A0, I_A2, I_KK, I_KA, I_RK, I_G2,
       I_LNG, I_LNB, I_V0, I_V1, I_V2, I_QNG, I_KNG, I_RPB, I_IB, I_FB, I_MNG, I_WBR, I_WOUT, I_RTR, I_MB, I_MWG, I_MWU, I_MWD,
       I_SG, I_SU, I_SD, N_IN };

constexpr size_t OFF_BAR = 0;
constexpr size_t OFF_MOD = 16384;
constexpr size_t OFF_WINT = OFF_MOD + 417792;
constexpr size_t OFF_WBT = OFF_WINT + (size_t)IN_COLS * 1024 * 2;
constexpr size_t OFF_WOUTT = OFF_WBT + (size_t)3 * 1024 * 512 * 2;
constexpr size_t OFF_SGUT = OFF_WOUTT + (size_t)1024 * 1024 * 2;
constexpr size_t OFF_SDT = OFF_SGUT + (size_t)512 * 1024 * 2;
constexpr size_t OFF_G2T = OFF_SDT + (size_t)1024 * 256 * 2;
constexpr size_t OFF_RTR = OFF_G2T + (size_t)512 * 128 * 2;
constexpr size_t OFF_CTXS = OFF_RTR + (size_t)2 * 64 * 1024 * 2;
constexpr size_t OFF_VF = OFF_CTXS + (size_t)NC * 1024 * 4;
constexpr size_t OFF_HX = OFF_VF + (size_t)NT * 512 * 2;
constexpr size_t OFF_BIG = OFF_HX + (size_t)NT * 1024 * 2;
constexpr size_t SZ_Y1 = (size_t)NT * 512 * 2;
constexpr size_t OFF_YA = OFF_BIG, OFF_YB = OFF_YA + SZ_Y1, OFF_YC = OFF_YB + SZ_Y1;
constexpr size_t OFF_PX = OFF_BIG + 3 * SZ_Y1;
constexpr size_t OFF_SCR = OFF_PX + (size_t)NT * RW_COLS * 2;
constexpr size_t SZ_SCR = (size_t)NT * 1152 * 2;
constexpr size_t WS_END = OFF_SCR + SZ_SCR;
constexpr size_t OFF_YS = OFF_YB;
constexpr size_t OFF_SGB = OFF_SCR;
constexpr size_t OFF_CB = OFF_SCR + (size_t)NT * 128 * 2;
constexpr size_t OFF_HS = OFF_SCR;
constexpr size_t OFF_VT = OFF_PX + (size_t)NT * 1024 * 2;
constexpr size_t OFF_VTC = OFF_VT + (size_t)NX * 512 * 2;
constexpr size_t OFF_GATES = OFF_PX;
constexpr size_t OFF_MGU = OFF_BIG;
constexpr size_t OFF_MDT = OFF_MGU + (size_t)64 * 256 * 1024 * 2;
constexpr size_t OFF_SA = OFF_MDT + (size_t)64 * 1024 * 128 * 2;
constexpr size_t OFF_EIDX = OFF_SA + (size_t)NT * 256 * 2;
constexpr size_t OFF_EW = OFF_EIDX + (size_t)NT * 8 * 4;
constexpr size_t OFF_LOG = OFF_EW + (size_t)NT * 8 * 4;
constexpr size_t OFF_H2LO = OFF_LOG + (size_t)NT * 64 * 4;
constexpr size_t OFF_YBUF = OFF_LOG;
static_assert(OFF_YBUF + (size_t)MOE_CHUNK * 8 * 1024 * 2 <= WS_END, "moe layout");
static_assert(OFF_GATES + (size_t)NT * 3072 * 2 <= WS_END, "gates layout");
static_assert(WS_END <= (size_t)536870912, "workspace");

constexpr int LDS_BYTES = 155648;

struct Topo { int x, r, n; };
struct Params {
    const float* in[N_IN];
    float* out;
    char* ws;
};

DEV int TID() { int t = threadIdx.x; asm volatile("" : "+v"(t)); return t; }
DEV float bf2f(bf16_t h) { return __uint_as_float(((unsigned)h) << 16); }
DEV bf16_t f2bf(float f) { unsigned u = __float_as_uint(f); u += 0x7FFFu + ((u >> 16) & 1u); return (bf16_t)(u >> 16); }
DEV unsigned pk2(float lo, float hi) { return (unsigned)f2bf(lo) | ((unsigned)f2bf(hi) << 16); }
DEV void ld8(const bf16_t* p, float (&o)[8]) {
    const u32x4 v = *(const u32x4*)p;
    o[0] = __uint_as_float(v.x << 16); o[1] = __uint_as_float(v.x & 0xffff0000u);
    o[2] = __uint_as_float(v.y << 16); o[3] = __uint_as_float(v.y & 0xffff0000u);
    o[4] = __uint_as_float(v.z << 16); o[5] = __uint_as_float(v.z & 0xffff0000u);
    o[6] = __uint_as_float(v.w << 16); o[7] = __uint_as_float(v.w & 0xffff0000u);
}
DEV void st8(bf16_t* p, const float (&v)[8]) {
    u32x4 o; o.x = pk2(v[0], v[1]); o.y = pk2(v[2], v[3]); o.z = pk2(v[4], v[5]); o.w = pk2(v[6], v[7]);
    *(u32x4*)p = o;
}
#define DPP_MOV(v, ctrl) __builtin_bit_cast(float, __builtin_amdgcn_update_dpp(0, __builtin_bit_cast(int, (v)), (ctrl), 0xF, 0xF, true))
DEV float sum8(float v) { v += DPP_MOV(v, 0xB1); v += DPP_MOV(v, 0x4E); v += DPP_MOV(v, 0x141); return v; }
DEV float sigm(float x) { return 1.f / (1.f + __expf(-x)); }
DEV float sigm_acc(float x) { return 1.f / (1.f + expf(-x)); }
DEV float tanh_fast(float x) { return 1.f - 2.f / (1.f + __expf(2.f * x)); }
DEV float softplus_fast(float x) { return fmaxf(x, 0.f) + __logf(1.f + __expf(-fabsf(x))); }
DEV int mod_row(int n) { return n < NX ? (n >> 11) : 16; }
DEV float* xs_row(const Params& p, int n) { return n < NX ? p.out + (size_t)n * DM : (float*)(p.ws + OFF_CTXS) + (size_t)(n - NX) * DM; }
DEV const float* xprev_row(const Params& p, int L, int n) {
    if (L == 0) return n < NX ? p.in[I_X] + (size_t)n * DM : p.in[I_CTX] + (size_t)(n - NX) * DM;
    return xs_row(p, n);
}
DEV void seq_of(int n, int& nb, int& tt, int& T) {
    if (n < NX) { nb = n & ~2047; tt = n & 2047; T = SEQ; } else { const int m = n - NX; nb = NX + (m & ~255); tt = m & 255; T = CTXL; }
}
DEV void shift8(const bf16_t* z, int ld, int nb, int tt, int T, int col0, const float* mu, float (&o)[8]) {
    float c[8], l[8], r[8];
    ld8(z + (size_t)(nb + tt) * ld + col0, c);
    if (tt > 0) ld8(z + (size_t)(nb + tt - 1) * ld + col0, l); else { UNROLL for (int i = 0; i < 8; ++i) l[i] = 0.f; }
    if (tt < T - 1) ld8(z + (size_t)(nb + tt + 1) * ld + col0, r); else { UNROLL for (int i = 0; i < 8; ++i) r[i] = 0.f; }
    UNROLL for (int i = 0; i < 8; ++i) o[i] = c[i] + mu[col0 + i] * (0.5f * (l[i] + r[i]) - c[i]);
}

constexpr int LROW = 144;
template <int WM, int WN> struct GC {
    static constexpr int BM = 64 * WM, BN = 64 * WN;
    static constexpr int AB = BM * 128, BB = BN * 128, STG = AB + BB;
    static constexpr int NA = BM / 64, NBC = BN / 64;
};
DEV void acc_zero(f32x16 (&acc)[2][2]) {
    UNROLL for (int a = 0; a < 2; ++a) UNROLL for (int b = 0; b < 2; ++b) UNROLL for (int r = 0; r < 16; ++r) acc[a][b][r] = 0.f;
}
#define GLDS16(gp, lp) __builtin_amdgcn_global_load_lds((const __attribute__((address_space(1))) void*)(gp), (__attribute__((address_space(3))) void*)(lp), 16, 0, 0)
template <int WM, int WN, int NS, bool A_LDS, class ARow>
DEV void gemm_tile(f32x16 (&acc)[2][2], ARow arow, const bf16_t* Bt, int ldb, int n0, int Nvalid, int K, char* smem, const char* alds) {
    typedef GC<WM, WN> C;
    constexpr int LPT = (A_LDS ? 0 : C::NA) + C::NBC;
    const int tid = TID(), lane = tid & 63, wave = tid >> 6, wm = wave / WN, wn = wave % WN;
    const int fr = lane & 31, fh = lane >> 5;
    const int crow = tid >> 3, cch = (tid & 7) ^ ((crow >> 1) & 7);
    const bf16_t* pa[C::NA]; const bf16_t* pb[C::NBC];
    if (!A_LDS) { UNROLL for (int i = 0; i < C::NA; ++i) pa[i] = arow(crow + 64 * i) + cch * 8; }
    UNROLL for (int i = 0; i < C::NBC; ++i) { const int n = min(n0 + crow + 64 * i, Nvalid - 1); pb[i] = Bt + (size_t)n * ldb + cch * 8; }
    const int nk = K >> 6;
#define GT_ISSUE(kt, stg) do { char* sb_ = smem + (stg) * C::STG + tid * 16; \
        if (!A_LDS) { UNROLL for (int i = 0; i < C::NA; ++i) GLDS16(pa[i] + (kt) * 64, sb_ + i * 8192); } \
        UNROLL for (int i = 0; i < C::NBC; ++i) GLDS16(pb[i] + (kt) * 64, sb_ + C::AB + i * 8192); } while (0)
    const int sw = (fr >> 1) & 7;
    int offk[4];
    UNROLL for (int ks = 0; ks < 4; ++ks) offk[ks] = ((2 * ks + fh) ^ sw) * 16;
    const int a_base = (wm * 64 + fr) * 128, b_base = (wn * 64 + fr) * 128;
    UNROLL for (int s = 0; s < NS - 1; ++s) if (s < nk) GT_ISSUE(s, s);
    int stg = 0, nstg = NS - 1;
    for (int kt = 0; kt < nk; ++kt) {
        if (NS == 3 && kt + 1 < nk) asm volatile("s_waitcnt vmcnt(%0)" :: "n"(LPT) : "memory");
        else asm volatile("s_waitcnt vmcnt(0)" ::: "memory");
        __builtin_amdgcn_s_barrier();
        asm volatile("" ::: "memory");
        const bool more = kt + NS - 1 < nk;
        const char* As_ = A_LDS ? alds + kt * C::AB : smem + stg * C::STG; const char* Bs_ = smem + stg * C::STG + C::AB;
        char* db_ = smem + nstg * C::STG + tid * 16;
        bf16x8 af[2][2], bfv[2][2];
        UNROLL for (int mi = 0; mi < 2; ++mi) af[0][mi] = *(const bf16x8*)(As_ + a_base + mi * 4096 + offk[0]);
        UNROLL for (int ni = 0; ni < 2; ++ni) bfv[0][ni] = *(const bf16x8*)(Bs_ + b_base + ni * 4096 + offk[0]);
        UNROLL for (int ks = 0; ks < 4; ++ks) {
            const int cur = ks & 1, nxt = cur ^ 1;
            if (ks < 3) {
                UNROLL for (int mi = 0; mi < 2; ++mi) af[nxt][mi] = *(const bf16x8*)(As_ + a_base + mi * 4096 + offk[ks + 1]);
                UNROLL for (int ni = 0; ni < 2; ++ni) bfv[nxt][ni] = *(const bf16x8*)(Bs_ + b_base + ni * 4096 + offk[ks + 1]);
            }
            UNROLL for (int mi = 0; mi < 2; ++mi) UNROLL for (int ni = 0; ni < 2; ++ni)
                acc[mi][ni] = __builtin_amdgcn_mfma_f32_32x32x16_bf16(af[cur][mi], bfv[cur][ni], acc[mi][ni], 0, 0, 0);
            if (more) {
                UNROLL for (int pc = 0; pc < LPT; ++pc) if (pc * 4 / LPT == ks) {
                    if (!A_LDS && pc < C::NA) GLDS16(pa[pc] + (kt + NS - 1) * 64, db_ + pc * 8192);
                    else { const int ib = pc - (A_LDS ? 0 : C::NA); GLDS16(pb[ib] + (kt + NS - 1) * 64, db_ + C::AB + ib * 8192); }
                }
            }
            __builtin_amdgcn_sched_barrier(0);
        }
        stg = stg + 1 == NS ? 0 : stg + 1; nstg = nstg + 1 == NS ? 0 : nstg + 1;
    }
    __syncthreads();
#undef GT_ISSUE
}
#define ACC_ROW(mi, r, fh) ((mi) * 32 + ((r) & 3) + 8 * ((r) >> 2) + 4 * (fh))

constexpr int EPI_SLAB = 32 * 68 * 4;
template <class F> DEV void epi_rows(const f32x16 (&acc)[2][2], char* smem, F f) {
    const int lane = TID() & 63, wave = TID() >> 6, fr = lane & 31, fh = lane >> 5;
    float* st = (float*)(smem + wave * EPI_SLAB);
    UNROLL for (int mi = 0; mi < 2; ++mi) {
        UNROLL for (int ni = 0; ni < 2; ++ni) UNROLL for (int r = 0; r < 16; ++r)
            st[((r & 3) + 8 * (r >> 2) + 4 * fh) * 68 + ni * 32 + fr] = acc[mi][ni][r];
        UNROLL for (int it = 0; it < 4; ++it) {
            const int row = it * 8 + (lane >> 3), c8 = (lane & 7) * 8;
            const float4 a = *(const float4*)(st + row * 68 + c8), b = *(const float4*)(st + row * 68 + c8 + 4);
            float v[8] = {a.x, a.y, a.z, a.w, b.x, b.y, b.z, b.w};
            f(mi * 32 + row, c8, v);
        }
    }
    __syncthreads();
}


template <class F> DEV void epi_cols(const f32x16 (&acc)[2][2], char* smem, F f) {
    const int lane = TID() & 63, wave = TID() >> 6, fr = lane & 31, fh = lane >> 5;
    float* st = (float*)(smem + wave * EPI_SLAB);
    UNROLL for (int mi = 0; mi < 2; ++mi) {
        UNROLL for (int ni = 0; ni < 2; ++ni) UNROLL for (int r = 0; r < 16; ++r)
            st[((r & 3) + 8 * (r >> 2) + 4 * fh) * 68 + ni * 32 + fr] = acc[mi][ni][r];
        UNROLL for (int it = 0; it < 4; ++it) {
            float v[8];
            UNROLL for (int i = 0; i < 8; ++i) v[i] = st[(it * 8 + i) * 68 + lane];
            f(mi * 32 + it * 8, lane, v);
        }
    }
    __syncthreads();
}

struct TileOrder {
    int x, nN, cx, total;
    DEV TileOrder(const Topo& tp, int nM, int nN_) { x = tp.x; nN = nN_; cx = nM > x ? (nM - x + 7) >> 3 : 0; total = ((cx + 3) >> 2) * 4 * nN; }
    DEV bool get(int q, int& pm, int& pn) const { const int per = 4 * nN, qi = q / per, rem = q - qi * per, i = 4 * qi + (rem & 3); pn = rem >> 2; pm = x + 8 * i; return i < cx; }
};
template <int WM, int WN, class Epi>
DEV void gemm_phase(const bf16_t* A, int lda, int M, const bf16_t* Bt, int ldb, int N, int K, char* smem, const Topo& tp, Epi epi) {
    typedef GC<WM, WN> C;
    const int nM = M / C::BM, nN = (N + C::BN - 1) / C::BN;
    const int wave = TID() >> 6, wm = wave / WN, wn = wave % WN;
    const TileOrder ord(tp, nM, nN);
    for (int q = tp.r; q < ord.total; q += tp.n) {
        int pm, pn; if (!ord.get(q, pm, pn)) continue;
        f32x16 acc[2][2]; acc_zero(acc);
        const bf16_t* Ab = A + (size_t)pm * C::BM * lda;
        gemm_tile<WM, WN, 3, false>(acc, [&](int r) { return Ab + (size_t)r * lda; }, Bt, ldb, pn * C::BN, N, K, smem, nullptr);
        epi(acc, pm * C::BM + wm * 64, pn * C::BN + wn * 64);
    }
}

namespace pg8 {
#define PG8_LAS __attribute__((address_space(3)))
typedef float f32x4 __attribute__((ext_vector_type(4)));
constexpr int BM = 256, BK = 64, HALF = 128, HTB = HALF * BK * 2  , STAGE_BYTES = 8 * HTB, NXCD = 8, WGM = 8;

__host__ __device__ __forceinline__ int lds_byte(int r, int c) { const int st = (r >> 4) * 2 + (c >> 5), rr = r & 15, cc = c & 31, ob = rr * 64 + cc * 2; return st * 1024 + (ob ^ (((ob >> 9) & 1) << 5)); }
__host__ __device__ __forceinline__ void stage_rc(int b, int& R, int& C) { const int st = b / 1024, sb = b % 1024, swz = sb ^ (((sb >> 9) & 1) << 5); R = (st >> 1) * 16 + swz / 64; C = (st & 1) * 32 + (swz % 64) / 2; }
__host__ __device__ __forceinline__ int perm32(int rho) { const int n = rho >> 4, i = rho & 15; return 8 * (i >> 2) + 4 * n + (i & 3); }

struct Unit { int pm, pn; };
struct Gemm { const bf16_t* A; const bf16_t* Bt; int M, N, K; };
template <class Epi, class Sched, bool ALIGN_EPI = false, bool SP2 = false>
__device__ __forceinline__ void gemm_phase(PG8_LAS unsigned char* lds, const Gemm g, const Sched& S, const Epi& E) {
    const int tid = TID(), wid = __builtin_amdgcn_readfirstlane(tid >> 6), lane = tid & 63, wr = wid >> 2, wc = wid & 3, fr = lane & 15, fq = lane >> 4;
    const int K = g.K, nt = K / BK;
    unsigned voffA[2], voffB[2];
#pragma unroll
    for (int i = 0; i < 2; ++i) { int R, C; stage_rc(tid * 16 + i * 8192, R, C); const int Rb = Epi::PERM ? ((R & ~31) + perm32(R & 31)) : R;
        voffA[i] = (unsigned)(R * K + C) * 2u; voffB[i] = (unsigned)(Rb * K + C) * 2u; }
    const size_t kstep = (size_t)(BK * 2);
    const size_t hstep = (size_t)HALF * K * 2;
    const size_t tstep = 2 * hstep;
    const unsigned ldsw = (unsigned)wid * 1024u;
    const int aoff = lds_byte(wr * 64 + fr, fq * 8), boff = lds_byte(wc * 32 + fr, fq * 8);
#define PG8_SA(b, h) (((b) * 2 + (h)) * HTB)
#define PG8_SB(b, h) ((4 + (b) * 2 + (h)) * HTB)
#define PG8_STAGE(bufoff, gbase, voff) do { _Pragma("unroll") for (int _i = 0; _i < 2; ++_i) \
        __builtin_amdgcn_global_load_lds((const unsigned*)((const char*)(gbase) + (voff)[_i]), (PG8_LAS unsigned*)(lds + (bufoff) + ldsw + _i * 8192), 16, 0, 0); } while (0)
#define PG8_LDA(dst, b, h) do { _Pragma("unroll") for (int m = 0; m < 4; ++m) _Pragma("unroll") for (int k = 0; k < 2; ++k) dst[m][k] = *(const PG8_LAS bf16x8*)(lds + PG8_SA(b, h) + aoff + m * 2048 + k * 1024); } while (0)
#define PG8_LDB(dst, b, h) do { _Pragma("unroll") for (int n = 0; n < 2; ++n) _Pragma("unroll") for (int k = 0; k < 2; ++k) dst[n][k] = *(const PG8_LAS bf16x8*)(lds + PG8_SB(b, h) + boff + n * 2048 + k * 1024); } while (0)
#define PG8_MMA(ai, bj, At, Bt) do { __builtin_amdgcn_s_setprio(1); _Pragma("unroll") for (int m = 0; m < 4; ++m) _Pragma("unroll") for (int n = 0; n < 2; ++n) _Pragma("unroll") for (int k = 0; k < 2; ++k) \
        acc[ai][bj][m][n] = __builtin_amdgcn_mfma_f32_16x16x32_bf16(Bt[n][k], At[m][k], acc[ai][bj][m][n], 0, 0, 0); __builtin_amdgcn_s_setprio(0); } while (0)
#define PG8_WAIT_V(n) asm volatile("s_waitcnt vmcnt(" #n ")" ::: "memory")
#define PG8_WAIT_L(n) asm volatile("s_waitcnt lgkmcnt(" #n ")" ::: "memory")
#define PG8_BAR __builtin_amdgcn_s_barrier()
#define PG8_SCHED __builtin_amdgcn_sched_barrier(0)
    Unit cur, nxt; int ui = 0;
    if (!S.next(0, cur)) return;
    f32x4 acc[2][2][4][2];
#pragma unroll
    for (int a = 0; a < 2; ++a)
#pragma unroll
        for (int b = 0; b < 2; ++b)
#pragma unroll
            for (int m = 0; m < 4; ++m)
#pragma unroll
                for (int n = 0; n < 2; ++n) acc[a][b][m][n] = (f32x4){0.f, 0.f, 0.f, 0.f};
    bf16x8 At[4][2], B0[2][2], B1[2][2];
    const char* cA = (const char*)g.A + (size_t)cur.pm * tstep; const char* cB = (const char*)g.Bt + (size_t)cur.pn * tstep;
    S.a_ready(cur);
    if constexpr (SP2) {
        PG8_STAGE(PG8_SB(0, 0), cB, voffB); PG8_STAGE(PG8_SB(0, 1), cB + hstep, voffB); PG8_STAGE(PG8_SA(0, 0), cA, voffA); PG8_STAGE(PG8_SA(0, 1), cA + hstep, voffA);
        if (wr == 1) PG8_BAR;
        PG8_WAIT_V(2); PG8_BAR;
        PG8_STAGE(PG8_SB(1, 0), cB + kstep, voffB); PG8_STAGE(PG8_SA(1, 0), cA + kstep, voffA); PG8_STAGE(PG8_SB(1, 1), cB + hstep + kstep, voffB);
        PG8_WAIT_V(6); PG8_BAR;
    } else {
        PG8_STAGE(PG8_SB(0, 0), cB, voffB); PG8_STAGE(PG8_SA(0, 0), cA, voffA); PG8_STAGE(PG8_SB(0, 1), cB + hstep, voffB); PG8_STAGE(PG8_SA(0, 1), cA + hstep, voffA);
        if (wr == 1) PG8_BAR;
        PG8_WAIT_V(4); PG8_BAR;
        PG8_STAGE(PG8_SB(1, 0), cB + kstep, voffB); PG8_STAGE(PG8_SA(1, 0), cA + kstep, voffA); PG8_STAGE(PG8_SB(1, 1), cB + hstep + kstep, voffB);
        PG8_WAIT_V(6); PG8_BAR;
    }
    for (;;) {
        const bool has_next = S.next(ui + 1, nxt);
        const char* nA = has_next ? (const char*)g.A + (size_t)nxt.pm * tstep : cA; const char* nB = has_next ? (const char*)g.Bt + (size_t)nxt.pn * tstep : cB;
        for (int t = 0; t < nt; t += 2) {
            const bool last = (t == nt - 2);
            const char* a1 = cA + (size_t)(t + 1) * kstep;
            const char* a2 = last ? nA : cA + (size_t)(t + 2) * kstep; const char* b2 = last ? nB : cB + (size_t)(t + 2) * kstep;
            const char* a3 = a2 + kstep; const char* b3 = b2 + kstep;
            if (last && has_next) S.a_ready(nxt);
            if constexpr (SP2) {
            PG8_LDB(B0, 0, 0); PG8_LDB(B1, 0, 1); PG8_SCHED; PG8_LDA(At, 0, 0); PG8_STAGE(PG8_SA(1, 1), a1 + hstep, voffA);
            PG8_WAIT_V(8); PG8_WAIT_L(0); PG8_BAR; PG8_MMA(0, 0, At, B0); PG8_MMA(0, 1, At, B1); PG8_BAR; PG8_SCHED;
            PG8_LDA(At, 0, 1); PG8_STAGE(PG8_SB(0, 0), b2, voffB); PG8_STAGE(PG8_SB(0, 1), b2 + hstep, voffB); PG8_STAGE(PG8_SA(0, 0), a2, voffA);
            PG8_WAIT_V(8); PG8_WAIT_L(0); PG8_BAR; PG8_MMA(1, 0, At, B0); PG8_MMA(1, 1, At, B1); PG8_BAR; PG8_SCHED;
            PG8_LDB(B0, 1, 0); PG8_LDB(B1, 1, 1); PG8_SCHED; PG8_LDA(At, 1, 0); PG8_STAGE(PG8_SA(0, 1), a2 + hstep, voffA);
            PG8_WAIT_V(8); PG8_WAIT_L(0); PG8_BAR; PG8_MMA(0, 0, At, B0); PG8_MMA(0, 1, At, B1); PG8_BAR; PG8_SCHED;
            PG8_LDA(At, 1, 1); PG8_STAGE(PG8_SB(1, 0), b3, voffB); PG8_STAGE(PG8_SB(1, 1), b3 + hstep, voffB); PG8_STAGE(PG8_SA(1, 0), a3, voffA);
            PG8_WAIT_V(8); PG8_WAIT_L(0); PG8_BAR; PG8_MMA(1, 0, At, B0); PG8_MMA(1, 1, At, B1); PG8_BAR; PG8_SCHED;
            } else {
            PG8_LDB(B0, 0, 0); PG8_SCHED; PG8_LDA(At, 0, 0); PG8_STAGE(PG8_SA(1, 1), a1 + hstep, voffA);
            PG8_WAIT_L(8); PG8_BAR; PG8_WAIT_L(0); PG8_MMA(0, 0, At, B0); PG8_BAR; PG8_SCHED;
            PG8_LDB(B1, 0, 1); PG8_STAGE(PG8_SB(0, 0), b2, voffB);
            PG8_BAR; PG8_WAIT_L(0); PG8_MMA(0, 1, At, B1); PG8_BAR;
            PG8_LDA(At, 0, 1); PG8_STAGE(PG8_SA(0, 0), a2, voffA);
            PG8_BAR; PG8_WAIT_L(0); PG8_MMA(1, 0, At, B0); PG8_BAR; PG8_SCHED;
            PG8_STAGE(PG8_SB(0, 1), b2 + hstep, voffB);
            PG8_WAIT_V(6); PG8_BAR; PG8_MMA(1, 1, At, B1); PG8_BAR;
            PG8_LDB(B0, 1, 0); PG8_SCHED; PG8_LDA(At, 1, 0); PG8_STAGE(PG8_SA(0, 1), a2 + hstep, voffA);
            PG8_WAIT_L(8); PG8_BAR; PG8_WAIT_L(0); PG8_MMA(0, 0, At, B0); PG8_BAR; PG8_SCHED;
            PG8_LDB(B1, 1, 1); PG8_STAGE(PG8_SB(1, 0), b3, voffB);
            PG8_BAR; PG8_WAIT_L(0); PG8_MMA(0, 1, At, B1); PG8_BAR;
            PG8_LDA(At, 1, 1); PG8_STAGE(PG8_SA(1, 0), a3, voffA);
            PG8_BAR; PG8_WAIT_L(0); PG8_MMA(1, 0, At, B0); PG8_BAR; PG8_SCHED;
            PG8_STAGE(PG8_SB(1, 1), b3 + hstep, voffB);
            PG8_WAIT_V(6); PG8_BAR; PG8_MMA(1, 1, At, B1); PG8_BAR;
            }
        }
        if constexpr (ALIGN_EPI) { if (wr == 0) PG8_BAR; }
        if constexpr (!Epi::AFTER_DRAIN) { E(acc, cur, wr, wc, fr, fq); S.done(cur); }
        if (!has_next) break;
#pragma unroll
        for (int a = 0; a < 2; ++a)
#pragma unroll
            for (int b = 0; b < 2; ++b)
#pragma unroll
                for (int m = 0; m < 4; ++m)
#pragma unroll
                    for (int n = 0; n < 2; ++n) acc[a][b][m][n] = (f32x4){0.f, 0.f, 0.f, 0.f};
        cur = nxt; cA = nA; cB = nB; ++ui;
        if constexpr (ALIGN_EPI) { if (wr == 1) PG8_BAR; }
    }
    PG8_WAIT_V(0);
    if constexpr (!ALIGN_EPI) { if (wr == 0) PG8_BAR; }
    PG8_BAR;
    if constexpr (Epi::AFTER_DRAIN) { E.fused(acc, cur, wr, wc, fr, fq, lds, wid, lane); S.done(cur); }
#undef PG8_SA
#undef PG8_SB
#undef PG8_STAGE
#undef PG8_LDA
#undef PG8_LDB
#undef PG8_MMA
#undef PG8_WAIT_V
#undef PG8_WAIT_L
#undef PG8_BAR
#undef PG8_SCHED
}
}
template <class F> struct EpiF {
    static constexpr bool PERM = true, AFTER_DRAIN = false; F f;
    DEV void operator()(const pg8::f32x4 (&acc)[2][2][4][2], const pg8::Unit& u, int wr, int wc, int fr, int fq) const {
        UNROLL for (int ai = 0; ai < 2; ++ai) UNROLL for (int m = 0; m < 4; ++m) {
            const int row = u.pm * 256 + ai * 128 + wr * 64 + m * 16 + fr;
            UNROLL for (int bj = 0; bj < 2; ++bj) {
                const int col = u.pn * 256 + bj * 128 + wc * 32 + 8 * fq;
                const float v[8] = {acc[ai][bj][m][0][0], acc[ai][bj][m][0][1], acc[ai][bj][m][0][2], acc[ai][bj][m][0][3],
                                    acc[ai][bj][m][1][0], acc[ai][bj][m][1][1], acc[ai][bj][m][1][2], acc[ai][bj][m][1][3]};
                f(row, col, v);
            }
        }
    }
};
template <class F> struct EpiF2 {
    static constexpr bool PERM = true, AFTER_DRAIN = false; F f;
    DEV void operator()(const pg8::f32x4 (&acc)[2][2][4][2], const pg8::Unit& u, int wr, int wc, int fr, int fq) const {
        UNROLL for (int ai = 0; ai < 2; ++ai) UNROLL for (int m = 0; m < 4; ++m) {
            const int row = u.pm * 256 + ai * 128 + wr * 64 + m * 16 + fr, col = u.pn * 256 + wc * 32 + 8 * fq;
            const float v0[8] = {acc[ai][0][m][0][0], acc[ai][0][m][0][1], acc[ai][0][m][0][2], acc[ai][0][m][0][3], acc[ai][0][m][1][0], acc[ai][0][m][1][1], acc[ai][0][m][1][2], acc[ai][0][m][1][3]};
            const float v1[8] = {acc[ai][1][m][0][0], acc[ai][1][m][0][1], acc[ai][1][m][0][2], acc[ai][1][m][0][3], acc[ai][1][m][1][0], acc[ai][1][m][1][1], acc[ai][1][m][1][2], acc[ai][1][m][1][3]};
            f(row, col, v0, v1);
        }
    }
};
struct XOrder {
    int x, r, n, nN, cx, fullq, total;
    DEV XOrder(const Topo& tp, int nM, int nN_) { x = tp.x; r = tp.r; n = tp.n; nN = nN_; cx = nM > x ? (nM - x + 7) >> 3 : 0; fullq = cx >> 2; total = cx * nN; }
    DEV bool next(int i, pg8::Unit& u) const {
        const int q = r + i * n; if (q >= total) return false;
        const int per = 4 * nN;
        if (q < fullq * per) { const int qi = q / per, rem = q - qi * per; u.pn = rem >> 2; u.pm = x + 8 * (4 * qi + (rem & 3)); }
        else { const int rem = q - fullq * per, cq = cx - 4 * fullq; u.pn = rem / cq; u.pm = x + 8 * (4 * fullq + rem % cq); }
        return true;
    }
    DEV void a_ready(const pg8::Unit&) const {}
    DEV void done(const pg8::Unit&) const {}
};
template <class F> DEV void gemm256_pair(const bf16_t* A, int M, const bf16_t* Bt, int N, int K, char* smem, const Topo& tp, F f) {
    const pg8::Gemm g{A, Bt, M, N, K};
    const XOrder S(tp, M / 256, (N + 255) / 256);
    const EpiF2<F> E{f};
    pg8::gemm_phase<EpiF2<F>, XOrder, true, true>((PG8_LAS unsigned char*)smem, g, S, E);
}
template <class F> DEV void gemm256(const bf16_t* A, int M, const bf16_t* Bt, int N, int K, char* smem, const Topo& tp, F f) {
    const pg8::Gemm g{A, Bt, M, N, K};
    const XOrder S(tp, M / 256, (N + 255) / 256);
    const EpiF<F> E{f};
    pg8::gemm_phase<EpiF<F>, XOrder, true, true>((PG8_LAS unsigned char*)smem, g, S, E);
}

DEV void ph_mod(const Params& p, int L, char* smem) {
    const int tid = TID();
    float* sc = (float*)smem;
    float* red = sc + 17 * 1024;
    const float* c = p.in[I_C]; const float* cc = p.in[I_CCTX];
    for (int i = tid; i < 17 * 1024; i += NTHREADS) { const float v = i < 16 * 1024 ? c[i] : cc[i - 16 * 1024]; sc[i] = v / (1.f + expf(-v)); }
    __syncthreads();
    const float* W = p.in[I_WADA] + (size_t)L * 1024 * 6144; const float* bA = p.in[I_BADA] + (size_t)L * 6144;
    float* MOD = (float*)(p.ws + OFF_MOD);
    for (int u = blockIdx.x; u < 192; u += gridDim.x) {
        const int ci = tid & 31, ks = tid >> 5, j = u * 32 + ci;
        float acc[17];
        UNROLL for (int r = 0; r < 17; ++r) acc[r] = 0.f;
        for (int k = ks * 64; k < ks * 64 + 64; ++k) {
            const float w = W[(size_t)k * 6144 + j];
            UNROLL for (int r = 0; r < 17; ++r) acc[r] += sc[r * 1024 + k] * w;
        }
        UNROLL for (int r = 0; r < 17; ++r) red[(ks * 17 + r) * 32 + ci] = acc[r];
        __syncthreads();
        for (int i = tid; i < 17 * 32; i += NTHREADS) {
            const int r = i >> 5, c2 = i & 31; float s = bA[u * 32 + c2];
            for (int k2 = 0; k2 < 16; ++k2) s += red[(k2 * 17 + r) * 32 + c2];
            MOD[r * 6144 + u * 32 + c2] = s;
        }
        __syncthreads();
    }
}
DEV void conv_job(const float* s0, const float* s1, bf16_t* d, int K, int N, int mode, int nmat, size_t sstride, size_t dstride, char* smem) {
    float* tile = (float*)smem;
    const int tid = TID();
    const int tK = K / 64, tN = (mode == 1 || mode == 3) ? (2 * N) / 64 : (N + 63) / 64, per = tK * tN;
    for (int t = blockIdx.x; t < per * nmat; t += gridDim.x) {
        const int mat = t / per, r = t % per, tk = r / tN, tn = r % tN;
        const float* a0 = s0 + (size_t)mat * sstride; const float* a1 = s1 ? s1 + (size_t)mat * sstride : nullptr;
        bf16_t* dd = d + (size_t)mat * dstride;
        UNROLL for (int i = 0; i < 8; ++i) {
            const int cc = tid & 63, k = (tid >> 6) + 8 * i; float v;
            if (mode == 1) { const float* s = (cc >> 5) ? a1 : a0; v = s[(size_t)(tk * 64 + k) * N + tn * 32 + (cc & 31)]; }
            else if (mode == 3) { const float* s = ((tn >> 1) & 1) ? a1 : a0; v = s[(size_t)(tk * 64 + k) * N + (tn >> 2) * 128 + (tn & 1) * 64 + cc]; }
            else { const int n = tn * 64 + cc; v = n < N ? a0[(size_t)(tk * 64 + k) * N + n] : 0.f; }
            tile[k * 65 + cc] = v;
        }
        __syncthreads();
        UNROLL for (int i = 0; i < 8; ++i) {
            const int k = tid & 63, cc = (tid >> 6) + 8 * i; const int row = tn * 64 + cc;
            const float v = tile[k * 65 + cc];
            if (mode == 1 || mode == 3 || row < N) {
                const bf16_t hi = f2bf(v);
                dd[(size_t)row * K + tk * 64 + k] = hi;
                if (mode == 2) dd[(size_t)N * K + (size_t)row * K + tk * 64 + k] = f2bf(v - bf2f(hi));
            }
        }
        __syncthreads();
    }
}
DEV void ph_conv_mix(const Params& p, int L, char* smem) {
    char* ws = p.ws;
    conv_job(p.in[I_WIN] + (size_t)L * 1024 * IN_COLS, nullptr, (bf16_t*)(ws + OFF_WINT), 1024, IN_COLS, 0, 1, 0, 0, smem);
    conv_job(p.in[I_WBR] + (size_t)L * 3 * 512 * 1024, nullptr, (bf16_t*)(ws + OFF_WBT), 512, 1024, 0, 3, (size_t)512 * 1024, (size_t)512 * 1024, smem);
    conv_job(p.in[I_WOUT] + (size_t)L * 1024 * 1024, nullptr, (bf16_t*)(ws + OFF_WOUTT), 1024, 1024, 0, 1, 0, 0, smem);
    conv_job(p.in[I_SG] + (size_t)L * 1024 * 256, p.in[I_SU] + (size_t)L * 1024 * 256, (bf16_t*)(ws + OFF_SGUT), 1024, 256, 3, 1, 0, 0, smem);
    conv_job(p.in[I_SD] + (size_t)L * 256 * 1024, nullptr, (bf16_t*)(ws + OFF_SDT), 256, 1024, 0, 1, 0, 0, smem);
    conv_job(p.in[I_G2] + (size_t)L * 128 * 512, nullptr, (bf16_t*)(ws + OFF_G2T), 128, 512, 0, 1, 0, 0, smem);
    conv_job(p.in[I_RTR] + (size_t)L * 1024 * 64, nullptr, (bf16_t*)(ws + OFF_RTR), 1024, 64, 2, 1, 0, 0, smem);
}
DEV void ph_conv_moe(const Params& p, int L, char* smem) {
    char* ws = p.ws;
    const size_t eo = (size_t)L * 64 * 1024 * 128;
    conv_job(p.in[I_MWG] + eo, p.in[I_MWU] + eo, (bf16_t*)(ws + OFF_MGU), 1024, 128, 1, 64, (size_t)1024 * 128, (size_t)256 * 1024, smem);
    conv_job(p.in[I_MWD] + eo, nullptr, (bf16_t*)(ws + OFF_MDT), 128, 1024, 0, 64, (size_t)128 * 1024, (size_t)1024 * 128, smem);
}

DEV void ph_norm(const Params& p, int L, int which, int ntok) {
    const int lane = TID() & 63, wave = TID() >> 6;
    const float* MOD = (const float*)(p.ws + OFF_MOD);
    const float* g = p.in[which ? I_N2G : I_N1G] + (size_t)L * DM;
    bf16_t* H = (bf16_t*)(p.ws + OFF_HX); bf16_t* HLO = (bf16_t*)(p.ws + OFF_H2LO);
    for (int n0 = blockIdx.x * 8; n0 < ntok; n0 += gridDim.x * 8) {
        const int n = n0 + wave;
        const float* xr = which ? xs_row(p, n) : xprev_row(p, L, n);
        float4 v[4]; float ss = 0.f;
        UNROLL for (int i = 0; i < 4; ++i) { v[i] = *(const float4*)(xr + i * 256 + lane * 4); ss += v[i].x * v[i].x + v[i].y * v[i].y + v[i].z * v[i].z + v[i].w * v[i].w; }
        UNROLL for (int o = 1; o < 64; o <<= 1) ss += __shfl_xor(ss, o);
        const float rstd = rsqrtf(ss * (1.f / DM) + 1e-6f);
        const float* sh = MOD + mod_row(n) * 6144 + (which ? 3 : 0) * DM; const float* sc = sh + DM;
        UNROLL for (int i = 0; i < 4; ++i) {
            const int c = i * 256 + lane * 4;
            const float4 gg = *(const float4*)(g + c), s1 = *(const float4*)(sc + c), s0 = *(const float4*)(sh + c);
            const float h0 = v[i].x * rstd * gg.x * (1.f + s1.x) + s0.x, h1 = v[i].y * rstd * gg.y * (1.f + s1.y) + s0.y;
            const float h2 = v[i].z * rstd * gg.z * (1.f + s1.z) + s0.z, h3 = v[i].w * rstd * gg.w * (1.f + s1.w) + s0.w;
            u32x2 o; o.x = pk2(h0, h1); o.y = pk2(h2, h3);
            *(u32x2*)(H + (size_t)n * DM + c) = o;
            if (which) {
                u32x2 o2;
                o2.x = pk2(h0 - bf2f((bf16_t)(o.x & 0xffff)), h1 - bf2f((bf16_t)(o.x >> 16)));
                o2.y = pk2(h2 - bf2f((bf16_t)(o.y & 0xffff)), h3 - bf2f((bf16_t)(o.y >> 16)));
                *(u32x2*)(HLO + (size_t)n * DM + c) = o2;
            }
        }
    }
}

DEV void ph_rw_prep(const Params& p, int L, char* smem) {
    const int lane = TID() & 63, wave = TID() >> 6;
    float* vsh = (float*)smem + wave * 512;
    const bf16_t* PXR = (const bf16_t*)(p.ws + OFF_PX); bf16_t* VF = (bf16_t*)(p.ws + OFF_VF);
    const float* mu = p.in[I_MU] + (size_t)L * RW_COLS;
    const float* v0 = p.in[I_V0]; const float* v1 = p.in[I_V1]; const float* v2 = p.in[I_V2];
    for (int n0 = blockIdx.x * 8; n0 < NT; n0 += gridDim.x * 8) {
        const int n = n0 + wave; int nb, tt, T; seq_of(n, nb, tt, T);
        float vs[8]; shift8(PXR, RW_COLS, nb, tt, T, 1024 + lane * 8, mu, vs);
        if (L == 0) { st8(VF + (size_t)n * 512 + lane * 8, vs); }
        else {
            UNROLL for (int i = 0; i < 8; ++i) vsh[lane * 8 + i] = vs[i];
            __syncthreads();
            const int q = lane & 31, hf = lane >> 5; float t1 = 0.f;
            for (int jj = 0; jj < 256; ++jj) t1 += vsh[hf * 256 + jj] * v1[(hf * 256 + jj) * 32 + q];
            t1 += __shfl_xor(t1, 32);
            float u[8];
            UNROLL for (int i = 0; i < 8; ++i) u[i] = v0[lane * 8 + i];
            for (int q2 = 0; q2 < 32; ++q2) { const float tq = __shfl(t1, q2); UNROLL for (int i = 0; i < 8; ++i) u[i] += tq * v2[q2 * 512 + lane * 8 + i]; }
            float vf[8], o[8]; ld8(VF + (size_t)n * 512 + lane * 8, vf);
            UNROLL for (int i = 0; i < 8; ++i) o[i] = vs[i] + (vf[i] - vs[i]) * sigm(u[i]);
            st8(VF + (size_t)n * 512 + lane * 8, o);
            __syncthreads();
        }
    }
}

DEV bf16x8 pk_lohi(u32x2 lo, u32x2 hi) { u32x4 w; w.x = lo.x; w.y = lo.y; w.z = hi.x; w.w = hi.y; return __builtin_bit_cast(bf16x8, w); }
DEV bf16x8 pk_acc2(const f32x4v& a, const f32x4v& b) { u32x4 w; w.x = pk2(a[0], a[1]); w.y = pk2(a[2], a[3]); w.z = pk2(b[0], b[1]); w.w = pk2(b[2], b[3]); return __builtin_bit_cast(bf16x8, w); }
DEV bf16x8 pk_acc1(const f32x4v& a) { u32x4 w; w.x = pk2(a[0], a[1]); w.y = pk2(a[2], a[3]); w.z = 0u; w.w = 0u; return __builtin_bit_cast(bf16x8, w); }
#define MFMA16(a, b, c) __builtin_amdgcn_mfma_f32_16x16x32_bf16((a), (b), (c), 0, 0, 0)
DEV void ph_rw_scan(const Params& p, int L, char* smem) {
    const int tid = TID();
    const int wave = __builtin_amdgcn_readfirstlane(tid >> 6);
    char* AT = smem; char* BT = smem + 9216; char* KT = smem + 18432; char* RT = smem + 27648;
    char* BH = smem + 36864; char* KH = smem + 46080; char* VT = smem + 55296;
    char* W2T = smem + 64512; char* A2T = smem + 73728;
    float* PCv = (float*)(smem + 82944); float* SEGT = PCv + 64;
    char* XY = smem + 85248;
    char* T1 = XY; char* T2 = XY + 9216; float* WLf = (float*)(XY + 18432); float* ALf = (float*)(XY + 35840); float* LW = (float*)(XY + 53248);
    char* NAB = XY; char* NAK = XY + 9216; char* NRB = XY + 18432; char* NRK = XY + 27648; char* TJ = XY + 36864; float* NDF = (float*)(XY + 38912); float* YO = (float*)(XY + 43008);
    const bf16_t* PXR = (const bf16_t*)(p.ws + OFF_PX); const bf16_t* VF = (const bf16_t*)(p.ws + OFF_VF);
    bf16_t* YS = (bf16_t*)(p.ws + OFF_YS); float* CB = (float*)(p.ws + OFF_CB);
    const float* mu = p.in[I_MU] + (size_t)L * RW_COLS;
    const float* w0 = p.in[I_W0] + (size_t)L * 1024; const float* w2 = p.in[I_W2] + (size_t)L * 65536;
    const float* a0 = p.in[I_A0] + (size_t)L * 1024; const float* a2 = p.in[I_A2] + (size_t)L * 65536;
    const float* kkw = p.in[I_KK] + (size_t)L * 512; const float* kaw = p.in[I_KA] + (size_t)L * 512; const float* rkw = p.in[I_RK] + (size_t)L * 512;
    for (int u = blockIdx.x; u < 256; u += gridDim.x) {
        const int b = u >> 4, h = (u >> 1) & 7, d = u & 1;
        for (int i = tid; i < 4096; i += NTHREADS) {
            const int l = i >> 6, n = i & 63;
            *(bf16_t*)(W2T + n * LROW + l * 2) = f2bf(w2[(size_t)(d * 64 + l) * 512 + h * 64 + n]);
            *(bf16_t*)(A2T + n * LROW + l * 2) = f2bf(a2[(size_t)(d * 64 + l) * 512 + h * 64 + n]);
        }
        f32x4v sacc[4];
        UNROLL for (int i = 0; i < 4; ++i) sacc[i] = (f32x4v){0.f, 0.f, 0.f, 0.f};
        __syncthreads();
        for (int ci = 0; ci < 36; ++ci) {
            int tido = tid; asm volatile("" : "+v"(tido));
            const int lane = tido & 63, lq = lane & 15, kg = lane >> 4, ti = tido >> 3, j = tido & 7;
            const int ch = h * 64 + 8 * j;
            const bool isc = ci < 4; const int T = isc ? CTXL : SEQ, cc = isc ? ci : ci - 4;
            const int t0 = d == 0 ? cc * 64 : T - 64 * (cc + 1), nb = isc ? NX + b * CTXL : b * SEQ;
            const int tt = d == 0 ? t0 + ti : t0 + 63 - ti;
            float r8[8], k8[8], v8[8];
            {
                float x1[8], x2[8];
                shift8(PXR, RW_COLS, nb, tt, T, 1536 + d * 64 + 8 * j, mu, x1);
                shift8(PXR, RW_COLS, nb, tt, T, 1664 + d * 64 + 8 * j, mu, x2);
                UNROLL for (int i = 0; i < 8; ++i) x1[i] = tanh_fast(x1[i]);
                st8((bf16_t*)(T1 + ti * LROW) + 8 * j, x1); st8((bf16_t*)(T2 + ti * LROW) + 8 * j, x2);
                shift8(PXR, RW_COLS, nb, tt, T, h * 64 + 8 * j, mu, r8);
                shift8(PXR, RW_COLS, nb, tt, T, 512 + h * 64 + 8 * j, mu, k8);
                ld8(VF + (size_t)(nb + tt) * 512 + ch, v8);
            }
            __syncthreads();
            UNROLL for (int rep = 0; rep < 4; ++rep) {
                const int q = wave + 8 * rep, m = q >> 4, tl = q & 15, tt4 = tl >> 2, nt4 = tl & 3;
                const char* Ab = (m ? T2 : T1) + (16 * tt4 + lq) * LROW + kg * 16; const char* Bb = (m ? A2T : W2T) + (16 * nt4 + lq) * LROW + kg * 16;
                f32x4v a = {0.f, 0.f, 0.f, 0.f};
                UNROLL for (int ks = 0; ks < 2; ++ks) a = MFMA16(*(const bf16x8*)(Ab + ks * 64), *(const bf16x8*)(Bb + ks * 64), a);
                float* dst = (m ? ALf : WLf) + (16 * tt4 + 4 * kg) * 68 + 16 * nt4 + lq;
                UNROLL for (int i = 0; i < 4; ++i) dst[i * 68] = a[i];
            }
            __syncthreads();
            float av[8], bv[8], kd8[8];
            {
                const float4 wa = *(const float4*)(WLf + ti * 68 + 8 * j), wb = *(const float4*)(WLf + ti * 68 + 8 * j + 4);
                const float4 aa = *(const float4*)(ALf + ti * 68 + 8 * j), ab = *(const float4*)(ALf + ti * 68 + 8 * j + 4);
                const float wl[8] = {wa.x, wa.y, wa.z, wa.w, wb.x, wb.y, wb.z, wb.w}, al[8] = {aa.x, aa.y, aa.z, aa.w, ab.x, ab.y, ab.z, ab.w};
                float ss = 0.f, cbp = 0.f, alpha[8], kkr[8], lw[8];
                UNROLL for (int i = 0; i < 8; ++i) {
                    const float xw = -(w0[d * 512 + ch + i] + wl[i]);
                    const float sp = softplus_fast(xw);
                    lw[i] = -__expf(-sp - 0.5f);
                    alpha[i] = sigm(a0[d * 512 + ch + i] + al[i]);
                    kkr[i] = k8[i] * kkw[ch + i]; ss += kkr[i] * kkr[i];
                    kd8[i] = k8[i] * (1.f + (alpha[i] - 1.f) * kaw[ch + i]);
                    cbp += r8[i] * kd8[i] * rkw[ch + i];
                }
                ss = sum8(ss); cbp = sum8(cbp);
                const float inv = 1.f / fmaxf(sqrtf(ss), 1e-12f);
                UNROLL for (int i = 0; i < 8; ++i) { const float kk = kkr[i] * inv; av[i] = -kk; bv[i] = kk * alpha[i]; }
                *(float4*)(LW + ti * 64 + 8 * j) = make_float4(lw[0], lw[1], lw[2], lw[3]); *(float4*)(LW + ti * 64 + 8 * j + 4) = make_float4(lw[4], lw[5], lw[6], lw[7]);
                if (j == 0) CB[((size_t)d * NT + nb + tt) * 8 + h] = cbp;
            }
            __syncthreads();
            {
                const int n = tid & 63, seg = tid >> 6; float run = 0.f;
                UNROLL for (int r = 0; r < 8; ++r) { run += LW[(seg * 8 + r) * 64 + n]; LW[(seg * 8 + r) * 64 + n] = run; }
                SEGT[seg * 64 + n] = run;
            }
            __syncthreads();
            {
                const int seg = ti >> 3;
                float off[8], tot[8];
                UNROLL for (int i = 0; i < 8; ++i) { off[i] = 0.f; tot[i] = 0.f; }
                UNROLL for (int s2 = 0; s2 < 8; ++s2) {
                    const float4 sa = *(const float4*)(SEGT + s2 * 64 + 8 * j), sb2 = *(const float4*)(SEGT + s2 * 64 + 8 * j + 4);
                    const float sv[8] = {sa.x, sa.y, sa.z, sa.w, sb2.x, sb2.y, sb2.z, sb2.w};
                    UNROLL for (int i = 0; i < 8; ++i) { tot[i] += sv[i]; if (s2 < seg) off[i] += sv[i]; }
                }
                const float4 la = *(const float4*)(LW + ti * 64 + 8 * j), lb = *(const float4*)(LW + ti * 64 + 8 * j + 4);
                const float lpl[8] = {la.x, la.y, la.z, la.w, lb.x, lb.y, lb.z, lb.w};
                float lpm[8];
                if ((ti & 7) != 0) {
                    const float4 ma = *(const float4*)(LW + (ti - 1) * 64 + 8 * j), mb = *(const float4*)(LW + (ti - 1) * 64 + 8 * j + 4);
                    lpm[0] = ma.x; lpm[1] = ma.y; lpm[2] = ma.z; lpm[3] = ma.w; lpm[4] = mb.x; lpm[5] = mb.y; lpm[6] = mb.z; lpm[7] = mb.w;
                } else { UNROLL for (int i = 0; i < 8; ++i) lpm[i] = 0.f; }
                float oa[8], ob[8], ok[8], orr[8];
                UNROLL for (int i = 0; i < 8; ++i) {
                    const float lp = lpl[i] + off[i], lm = lpm[i] + off[i];
                    const float eP = __expf(lp), eM = __expf(-lp), ePm = __expf(lm), eE = __expf(tot[i] - lp);
                    oa[i] = av[i] * ePm; ob[i] = bv[i] * eM; ok[i] = kd8[i] * eM; orr[i] = r8[i] * eP;
                    *(bf16_t*)(BH + (8 * j + i) * LROW + ti * 2) = f2bf(bv[i] * eE);
                    *(bf16_t*)(KH + (8 * j + i) * LROW + ti * 2) = f2bf(kd8[i] * eE);
                    *(bf16_t*)(VT + (8 * j + i) * LROW + ti * 2) = f2bf(v8[i]);
                    if (ti == 0) PCv[8 * j + i] = __expf(tot[i]);
                }
                st8((bf16_t*)(AT + ti * LROW) + 8 * j, oa); st8((bf16_t*)(BT + ti * LROW) + 8 * j, ob);
                st8((bf16_t*)(KT + ti * LROW) + 8 * j, ok); st8((bf16_t*)(RT + ti * LROW) + 8 * j, orr);
            }
            __syncthreads();
            UNROLL for (int rep = 0; rep < 8; ++rep) {
                const int q = wave + 8 * rep, m = q >> 4, tl = q & 15, tt4 = tl >> 2, st4 = tl & 3;
                char* dstm = m == 0 ? NAB : m == 1 ? NAK : m == 2 ? NRB : NRK;
                f32x4v a = {0.f, 0.f, 0.f, 0.f};
                if (st4 <= tt4) {
                    const char* Ab = (m < 2 ? AT : RT) + (16 * tt4 + lq) * LROW + kg * 16; const char* Bb = ((m & 1) ? KT : BT) + (16 * st4 + lq) * LROW + kg * 16;
                    UNROLL for (int ks = 0; ks < 2; ++ks) a = MFMA16(*(const bf16x8*)(Ab + ks * 64), *(const bf16x8*)(Bb + ks * 64), a);
                }
                const int sidx = 16 * st4 + lq;
                UNROLL for (int i = 0; i < 4; ++i) {
                    const int tidx = 16 * tt4 + 4 * kg + i;
                    const bool keep = m < 2 ? sidx < tidx : sidx <= tidx;
                    const float val = keep ? a[i] : 0.f;
                    *(bf16_t*)(dstm + tidx * LROW + sidx * 2) = f2bf(val);
                    if (m == 0 && st4 == tt4) NDF[(tt4 * 16 + 4 * kg + i) * 16 + lq] = val;
                }
            }
            __syncthreads();
            f32x4v xacc[4], yacc[4];
            bf16x8 vt[2];
            if (wave == 7) {
                const int blk = lane >> 4, c = lane & 15;
                float Tc[16];
                UNROLL for (int t = 0; t < 16; ++t) {
                    float a = t == c ? 1.f : 0.f;
                    UNROLL for (int s2 = 0; s2 < t; ++s2) a += NDF[(blk * 16 + t) * 16 + s2] * Tc[s2];
                    Tc[t] = a;
                }
                UNROLL for (int t = 0; t < 16; ++t) *(bf16_t*)(TJ + (blk * 16 + t) * 32 + c * 2) = f2bf(Tc[t]);
            } else if (wave < 4) {
                bf16x8 sb[2];
                UNROLL for (int kk = 0; kk < 2; ++kk) { sb[kk] = pk_acc2(sacc[2 * kk], sacc[2 * kk + 1]); vt[kk] = *(const bf16x8*)(VT + (16 * wave + lq) * LROW + kk * 64 + kg * 16); }
                UNROLL for (int t4 = 0; t4 < 4; ++t4) {
                    f32x4v x = {0.f, 0.f, 0.f, 0.f}, y = {0.f, 0.f, 0.f, 0.f};
                    UNROLL for (int kk = 0; kk < 2; ++kk) {
                        const char* pa = AT + (16 * t4 + lq) * LROW + (32 * kk + 4 * kg) * 2; const char* pr = RT + (16 * t4 + lq) * LROW + (32 * kk + 4 * kg) * 2;
                        x = MFMA16(pk_lohi(*(const u32x2*)pa, *(const u32x2*)(pa + 32)), sb[kk], x);
                        y = MFMA16(pk_lohi(*(const u32x2*)pr, *(const u32x2*)(pr + 32)), sb[kk], y);
                        if (2 * kk <= t4) {
                            x = MFMA16(*(const bf16x8*)(NAK + (16 * t4 + lq) * LROW + kk * 64 + kg * 16), vt[kk], x);
                            y = MFMA16(*(const bf16x8*)(NRK + (16 * t4 + lq) * LROW + kk * 64 + kg * 16), vt[kk], y);
                        }
                    }
                    xacc[t4] = x; yacc[t4] = y;
                }
            }
            __syncthreads();
            if (wave < 4) {
                const u32x2 z2 = {0u, 0u};
                f32x4v uacc[4];
                {
                    const u32x2 t0v = *(const u32x2*)(TJ + (0 * 16 + lq) * 32 + 4 * kg * 2);
                    uacc[0] = MFMA16(pk_lohi(t0v, z2), pk_acc1(xacc[0]), ((f32x4v){0.f, 0.f, 0.f, 0.f}));
                }
                UNROLL for (int jb = 1; jb < 4; ++jb) {
                    f32x4v z = xacc[jb];
                    const char* nr = NAB + (16 * jb + lq) * LROW + 4 * kg * 2;
                    if (jb == 1) z = MFMA16(pk_lohi(*(const u32x2*)nr, z2), pk_acc1(uacc[0]), z);
                    else {
                        z = MFMA16(pk_lohi(*(const u32x2*)nr, *(const u32x2*)(nr + 32)), pk_acc2(uacc[0], uacc[1]), z);
                        if (jb == 3) z = MFMA16(pk_lohi(*(const u32x2*)(nr + 64), z2), pk_acc1(uacc[2]), z);
                    }
                    const u32x2 tv = *(const u32x2*)(TJ + (jb * 16 + lq) * 32 + 4 * kg * 2);
                    uacc[jb] = MFMA16(pk_lohi(tv, z2), pk_acc1(z), ((f32x4v){0.f, 0.f, 0.f, 0.f}));
                }
                bf16x8 ub[2]; ub[0] = pk_acc2(uacc[0], uacc[1]); ub[1] = pk_acc2(uacc[2], uacc[3]);
                UNROLL for (int t4 = 0; t4 < 4; ++t4) {
                    f32x4v y = yacc[t4];
                    UNROLL for (int kk = 0; kk < 2; ++kk) if (2 * kk <= t4) {
                        const char* pn = NRB + (16 * t4 + lq) * LROW + (32 * kk + 4 * kg) * 2;
                        y = MFMA16(pk_lohi(*(const u32x2*)pn, *(const u32x2*)(pn + 32)), ub[kk], y);
                    }
                    UNROLL for (int i = 0; i < 4; ++i) YO[(16 * t4 + 4 * kg + i) * 68 + 16 * wave + lq] = y[i];
                }
                UNROLL for (int kt = 0; kt < 4; ++kt) {
                    f32x4v sv = sacc[kt];
                    UNROLL for (int i = 0; i < 4; ++i) sv[i] *= PCv[16 * kt + 4 * kg + i];
                    UNROLL for (int kk = 0; kk < 2; ++kk) {
                        const char* pb = BH + (16 * kt + lq) * LROW + (32 * kk + 4 * kg) * 2;
                        sv = MFMA16(pk_lohi(*(const u32x2*)pb, *(const u32x2*)(pb + 32)), ub[kk], sv);
                        sv = MFMA16(*(const bf16x8*)(KH + (16 * kt + lq) * LROW + kk * 64 + kg * 16), vt[kk], sv);
                    }
                    sacc[kt] = sv;
                }
            }
            __syncthreads();
            {
                const float4 ya = *(const float4*)(YO + ti * 68 + 8 * j), yb = *(const float4*)(YO + ti * 68 + 8 * j + 4);
                const float y8[8] = {ya.x, ya.y, ya.z, ya.w, yb.x, yb.y, yb.z, yb.w};
                st8(YS + ((size_t)d * NT + nb + tt) * 512 + ch, y8);
            }
            __syncthreads();
        }
    }
}

DEV void ph_rw_read(const Params& p, int L, int ntok) {
    const int lane = TID() & 63, wave = TID() >> 6;
    const bf16_t* PXR = (const bf16_t*)(p.ws + OFF_PX); const bf16_t* VF = (const bf16_t*)(p.ws + OFF_VF);
    const bf16_t* YS = (const bf16_t*)(p.ws + OFF_YS); const float* CB = (const float*)(p.ws + OFF_CB);
    bf16_t* YA = (bf16_t*)(p.ws + OFF_YA); bf16_t* SG = (bf16_t*)(p.ws + OFF_SGB);
    const float* mu = p.in[I_MU] + (size_t)L * RW_COLS;
    const float* lg = p.in[I_LNG] + (size_t)L * 512; const float* lb = p.in[I_LNB] + (size_t)L * 512;
    for (int n0 = blockIdx.x * 8; n0 < ntok; n0 += gridDim.x * 8) {
        const int n = n0 + wave, c = lane * 8, h = lane >> 3;
        float y0[8], y1[8], v8[8], o[8];
        ld8(YS + (size_t)n * 512 + c, y0); ld8(YS + ((size_t)NT + n) * 512 + c, y1); ld8(VF + (size_t)n * 512 + c, v8);
        float s = 0.f;
        UNROLL for (int i = 0; i < 8; ++i) { y0[i] += y1[i]; s += y0[i]; }
        s += __shfl_xor(s, 1); s += __shfl_xor(s, 2); s += __shfl_xor(s, 4);
        const float mean = s * (1.f / 64.f); float q = 0.f;
        UNROLL for (int i = 0; i < 8; ++i) { const float dd = y0[i] - mean; q += dd * dd; }
        q += __shfl_xor(q, 1); q += __shfl_xor(q, 2); q += __shfl_xor(q, 4);
        const float rstd = rsqrtf(q * (1.f / 64.f) + 64e-5f);
        const float bon = CB[(size_t)n * 8 + h] + CB[((size_t)NT + n) * 8 + h];
        UNROLL for (int i = 0; i < 8; ++i) o[i] = (y0[i] - mean) * rstd * lg[c + i] + lb[c + i] + bon * v8[i];
        st8(YA + (size_t)n * 512 + c, o);
        if (lane < 16) {
            int nb, tt, T; seq_of(n, nb, tt, T);
            float g8[8]; shift8(PXR, RW_COLS, nb, tt, T, 1792 + lane * 8, mu, g8);
            UNROLL for (int i = 0; i < 8; ++i) g8[i] = sigm(g8[i]);
            st8(SG + (size_t)n * 128 + lane * 8, g8);
        }
    }
}

DEV void ph_na_norm(const Params& p, int L) {
    const int lane = TID() & 63, wave = TID() >> 6;
    bf16_t* PXN = (bf16_t*)(p.ws + OFF_PX);
    const float* qg = p.in[I_QNG] + (size_t)L * 64; const float* kg = p.in[I_KNG] + (size_t)L * 64;
    for (int n0 = blockIdx.x * 8; n0 < NT; n0 += gridDim.x * 8) {
        const int n = n0 + wave, c = lane * 8;
        UNROLL for (int w = 0; w < 2; ++w) {
            bf16_t* ptr = PXN + (size_t)n * 1024 + w * 512 + c;
            float x[8]; ld8(ptr, x);
            float ss = 0.f;
            UNROLL for (int i = 0; i < 8; ++i) ss += x[i] * x[i];
            ss += __shfl_xor(ss, 1); ss += __shfl_xor(ss, 2); ss += __shfl_xor(ss, 4);
            const float r = rsqrtf(ss * (1.f / 64.f) + 1e-6f) * (w == 0 ? 0.125f : 1.f);
            const float* g = w == 0 ? qg : kg;
            UNROLL for (int i = 0; i < 8; ++i) x[i] = x[i] * r * g[(c + i) & 63];
            st8(ptr, x);
        }
    }
}

DEV void ph_na_att(const Params& p, int L, char* smem) {
    const int tid = TID(), lane = tid & 63, lq = lane & 15, kg = lane >> 4;
    const int wave = __builtin_amdgcn_readfirstlane(tid >> 6);
    char* KL = smem;
    char* KC = smem + 512 * LROW;
    char* VL = smem;
    char* VC = smem + 64 * 1040;
    float* OX = (float*)(smem + 114688);
    float* ML = OX + 8 * 1024;
    float* RP = ML + 256;
    const bf16_t* PXN = (const bf16_t*)(p.ws + OFF_PX); bf16_t* YB = (bf16_t*)(p.ws + OFF_YB);
    const bf16_t* VT = (const bf16_t*)(p.ws + OFF_VT); const bf16_t* VTC = (const bf16_t*)(p.ws + OFF_VTC);
    const int nunits = 4096 + (L == 0 ? 256 : 0);
    for (int u = blockIdx.x; u < nunits; u += gridDim.x) {
        const bool cu = u >= 4096;
        int b, h, r = 0, rs = 0, g = 0;
        if (!cu) { h = u & 7; r = (u >> 3) & 31; b = u >> 8; rs = min(max(r - 4, 0), 24); }
        else { const int v = u - 4096; h = v & 7; g = (v >> 3) & 1; b = v >> 4; }
        const int ctx0 = NX + b * CTXL;
        if (!cu) {
            UNROLL for (int i = 0; i < 8; ++i) {
                const int c = tid + NTHREADS * i, kx = c >> 3, part = c & 7;
                const int tok = b * SEQ + (rs + (kx >> 6)) * 64 + (kx & 63);
                *(u32x4*)(KL + kx * LROW + part * 16) = *(const u32x4*)(PXN + (size_t)tok * 1024 + 512 + h * 64 + part * 8);
            }
            for (int i = tid; i < 15 * 31; i += NTHREADS) RP[i] = p.in[I_RPB][((size_t)L * 8 + h) * 465 + i];
        }
        UNROLL for (int i = 0; i < 4; ++i) {
            const int c = tid + NTHREADS * i, kx = c >> 3, part = c & 7;
            *(u32x4*)(KC + kx * LROW + part * 16) = *(const u32x4*)(PXN + (size_t)(ctx0 + kx) * 1024 + 512 + h * 64 + part * 8);
        }
        const int nb = wave & 3;
        const bool loc = !cu && wave < 4;
        const int qtok0 = cu ? ctx0 + (g * 8 + wave) * 16 : b * SEQ + r * 64 + nb * 16;
        const int band0 = min(max(nb * 16 - 8, 0), 32);
        bf16x8 qf[2];
        UNROLL for (int ks = 0; ks < 2; ++ks) qf[ks] = *(const bf16x8*)(PXN + (size_t)(qtok0 + lq) * 1024 + h * 64 + ks * 32 + kg * 8);
        __syncthreads();
        f32x4v sacc[16];
        if (loc) {
            const char* kb = KL + (band0 + lq) * LROW + kg * 16;
            UNROLL for (int t = 0; t < 16; ++t) {
                f32x4v a = {0.f, 0.f, 0.f, 0.f};
                UNROLL for (int ks = 0; ks < 2; ++ks) a = __builtin_amdgcn_mfma_f32_16x16x32_bf16(*(const bf16x8*)(kb + ((t >> 1) * 64 + (t & 1) * 16) * LROW + ks * 64), qf[ks], a, 0, 0, 0);
                sacc[t] = a;
            }
            const int col = nb * 16 + lq, cs = min(max(col - 8, 0), 48);
            const int kc0 = band0 + 4 * kg;
            const float* rp = RP + (rs - r + 7) * 31 + (kc0 - col + 15);
            UNROLL for (int t = 0; t < 16; ++t) UNROLL for (int i = 0; i < 4; ++i) {
                const int kc = kc0 + (t & 1) * 16 + i;
                const bool valid = kc >= cs && kc < cs + 16;
                sacc[t][i] = valid ? sacc[t][i] + rp[(t >> 1) * 31 + (t & 1) * 16 + i] : -1e30f;
            }
        } else {
            const char* kb = KC + lq * LROW + kg * 16;
            UNROLL for (int t = 0; t < 16; ++t) {
                f32x4v a = {0.f, 0.f, 0.f, 0.f};
                UNROLL for (int ks = 0; ks < 2; ++ks) a = __builtin_amdgcn_mfma_f32_16x16x32_bf16(*(const bf16x8*)(kb + t * 16 * LROW + ks * 64), qf[ks], a, 0, 0, 0);
                sacc[t] = a;
            }
        }
        float mx = -3e38f;
        UNROLL for (int t = 0; t < 16; ++t) UNROLL for (int i = 0; i < 4; ++i) mx = fmaxf(mx, sacc[t][i]);
        mx = fmaxf(mx, __shfl_xor(mx, 16)); mx = fmaxf(mx, __shfl_xor(mx, 32));
        float sum = 0.f;
        UNROLL for (int t = 0; t < 16; ++t) UNROLL for (int i = 0; i < 4; ++i) { const float e = __expf(sacc[t][i] - mx); sacc[t][i] = e; sum += e; }
        sum += __shfl_xor(sum, 16); sum += __shfl_xor(sum, 32);
        if (kg == 0) { ML[(wave * 2) * 16 + lq] = mx; ML[(wave * 2 + 1) * 16 + lq] = sum; }
        bf16x8 pf[8];
        UNROLL for (int tp = 0; tp < 8; ++tp) {
            u32x4 w; w.x = pk2(sacc[2 * tp][0], sacc[2 * tp][1]); w.y = pk2(sacc[2 * tp][2], sacc[2 * tp][3]);
            w.z = pk2(sacc[2 * tp + 1][0], sacc[2 * tp + 1][1]); w.w = pk2(sacc[2 * tp + 1][2], sacc[2 * tp + 1][3]);
            pf[tp] = __builtin_bit_cast(bf16x8, w);
        }
        __syncthreads();
        if (!cu) {
            UNROLL for (int i = 0; i < 8; ++i) {
                const int c = tid + NTHREADS * i, part = c & 7, kr = (c >> 3) & 7, d = c >> 6;
                *(u32x4*)(VL + d * 1040 + (kr * 64 + part * 8) * 2) = *(const u32x4*)(VT + ((size_t)(b * 8 + h) * 64 + d) * SEQ + (rs + kr) * 64 + part * 8);
            }
        }
        UNROLL for (int i = 0; i < 4; ++i) {
            const int c = tid + NTHREADS * i, part = c & 31, d = c >> 5;
            *(u32x4*)(VC + d * 528 + part * 16) = *(const u32x4*)(VTC + ((size_t)(b * 8 + h) * 64 + d) * CTXL + part * 8);
        }
        __syncthreads();
        f32x4v oacc[4];
        UNROLL for (int dt = 0; dt < 4; ++dt) oacc[dt] = (f32x4v){0.f, 0.f, 0.f, 0.f};
        if (loc) {
            const char* vb = VL + lq * 1040 + (band0 + 4 * kg) * 2;
            UNROLL for (int tp = 0; tp < 8; ++tp) UNROLL for (int dt = 0; dt < 4; ++dt) {
                const u32x2 lo = *(const u32x2*)(vb + dt * 16 * 1040 + tp * 128), hi = *(const u32x2*)(vb + dt * 16 * 1040 + tp * 128 + 32);
                u32x4 w; w.x = lo.x; w.y = lo.y; w.z = hi.x; w.w = hi.y;
                oacc[dt] = __builtin_amdgcn_mfma_f32_16x16x32_bf16(pf[tp], __builtin_bit_cast(bf16x8, w), oacc[dt], 0, 0, 0);
            }
        } else {
            const char* vb = VC + lq * 528 + 8 * kg;
            UNROLL for (int tp = 0; tp < 8; ++tp) UNROLL for (int dt = 0; dt < 4; ++dt) {
                const u32x2 lo = *(const u32x2*)(vb + dt * 16 * 528 + tp * 64), hi = *(const u32x2*)(vb + dt * 16 * 528 + tp * 64 + 32);
                u32x4 w; w.x = lo.x; w.y = lo.y; w.z = hi.x; w.w = hi.y;
                oacc[dt] = __builtin_amdgcn_mfma_f32_16x16x32_bf16(pf[tp], __builtin_bit_cast(bf16x8, w), oacc[dt], 0, 0, 0);
            }
        }
        float* ox = OX + wave * 1024;
        if (!cu && wave >= 4) { UNROLL for (int dt = 0; dt < 4; ++dt) UNROLL for (int i = 0; i < 4; ++i) ox[(4 * kg + i) * 64 + dt * 16 + lq] = oacc[dt][i]; }
        __syncthreads();
        if (cu || wave < 4) {
            UNROLL for (int i = 0; i < 4; ++i) {
                const int q = 4 * kg + i;
                const float m0 = ML[(wave * 2) * 16 + q], l0 = ML[(wave * 2 + 1) * 16 + q];
                float e0 = 1.f, e1 = 0.f, den = l0;
                if (!cu) {
                    const float m1 = ML[((wave + 4) * 2) * 16 + q], l1 = ML[((wave + 4) * 2 + 1) * 16 + q];
                    const float m = fmaxf(m0, m1); e0 = __expf(m0 - m); e1 = __expf(m1 - m); den = l0 * e0 + l1 * e1;
                }
                const float inv = 1.f / den;
                UNROLL for (int dt = 0; dt < 4; ++dt) {
                    const float o1 = cu ? 0.f : OX[(wave + 4) * 1024 + q * 64 + dt * 16 + lq];
                    ox[q * 64 + dt * 16 + lq] = (oacc[dt][i] * e0 + o1 * e1) * inv;
                }
            }
            UNROLL for (int it = 0; it < 2; ++it) {
                const int q = (lane >> 3) + 8 * it, c8 = (lane & 7) * 8;
                const float4 a = *(const float4*)(ox + q * 64 + c8), bq = *(const float4*)(ox + q * 64 + c8 + 4);
                const float v[8] = {a.x, a.y, a.z, a.w, bq.x, bq.y, bq.z, bq.w};
                st8(YB + (size_t)(qtok0 + q) * 512 + h * 64 + c8, v);
            }
        }
        __syncthreads();
    }
}

DEV float sum16(float v) { v += DPP_MOV(v, 0xB1); v += DPP_MOV(v, 0x4E); v += DPP_MOV(v, 0x141); v += DPP_MOV(v, 0x140); return v; }
DEV void ph_ml_scan(const Params& p, int L, char* smem) {
    const int tid = TID(), lane = tid & 63, lq = lane & 15, kg = lane >> 4, ti = tid >> 3, j = tid & 7;
    const int wave = __builtin_amdgcn_readfirstlane(tid >> 6);
    char* QS = smem;
    char* QP = QS + 9216;
    char* KC = QP + 9216;
    char* KW = KC + 9216;
    char* PM = KW + 9216;
    char* VT = PM + 9216;
    float* BV = (float*)(VT + 128 * LROW);
    float* GI = BV + 64;
    float* DEN = GI + 64;
    float* NV = DEN + 64;
    float* RS = NV + 64;
    float* HO = RS + 256;
    const bf16_t* PXM = (const bf16_t*)(p.ws + OFF_PX); bf16_t* HS = (bf16_t*)(p.ws + OFF_HS);
    for (int u = blockIdx.x; u < 128; u += gridDim.x) {
        const int d = u & 1, h = (u >> 1) & 3, b = u >> 3;
        const float ib = p.in[I_IB][L * 8 + d * 4 + h], fb = p.in[I_FB][L * 8 + d * 4 + h];
        f32x4v cacc[4];
        UNROLL for (int i = 0; i < 4; ++i) cacc[i] = (f32x4v){0.f, 0.f, 0.f, 0.f};
        for (int i = tid; i < 64 * LROW / 4; i += NTHREADS) ((unsigned*)PM)[i] = 0u;
        if (tid < 64) NV[tid] = 0.f;
        __syncthreads();
        for (int ci = 0; ci < 36; ++ci) {
            const bool isc = ci < 4; const int T = isc ? CTXL : SEQ, cc = isc ? ci : ci - 4;
            const int t0 = d == 0 ? cc * 64 : T - 64 * (cc + 1), nb = isc ? NX + b * CTXL : b * SEQ;
            const int tt = d == 0 ? t0 + ti : t0 + 63 - ti;
            float q8[8], k8[8];
            {
                const bf16_t* row = PXM + (size_t)(nb + tt) * ML_COLS;
                ld8(row + h * 64 + 8 * j, q8); ld8(row + 256 + h * 64 + 8 * j, k8);
                if (!isc) {
                    const int axis = j >> 2, half = (j >> 1) & 1; const float pos = (float)(axis == 0 ? (tt >> 6) : (tt & 63));
                    UNROLL for (int i = 0; i < 8; ++i) {
                        const int f = (j & 1) * 8 + i;
                        const float inv = exp2f(-(float)f * 0.83048202372184059f);
                        const float ang = pos * inv; const float cs = __cosf(ang), sn = __sinf(ang);
                        const float qo = __shfl_xor(q8[i], 2), ko = __shfl_xor(k8[i], 2);
                        q8[i] = half == 0 ? q8[i] * cs - qo * sn : q8[i] * cs + qo * sn;
                        k8[i] = half == 0 ? k8[i] * cs - ko * sn : k8[i] * cs + ko * sn;
                    }
                }
                UNROLL for (int i = 0; i < 8; ++i) q8[i] *= 0.125f;
                st8((bf16_t*)(QS + ti * LROW) + 8 * j, q8); st8((bf16_t*)(KC + ti * LROW) + 8 * j, k8);
                float v0[8], v1[8];
                ld8(row + 512 + h * 128 + 16 * j, v0); ld8(row + 512 + h * 128 + 16 * j + 8, v1);
                UNROLL for (int i = 0; i < 8; ++i) { *(bf16_t*)(VT + (16 * j + i) * LROW + ti * 2) = f2bf(v0[i]); *(bf16_t*)(VT + (16 * j + 8 + i) * LROW + ti * 2) = f2bf(v1[i]); }
                if (wave == 0) {
                    const int tl = d == 0 ? t0 + lane : t0 + 63 - lane;
                    const bf16_t* rw = PXM + (size_t)(nb + tl) * ML_COLS;
                    const float ig = bf2f(rw[1536 + d * 4 + h]) + ib, fg = bf2f(rw[1544 + d * 4 + h]) + fb;
                    const float igc = 15.f * tanhf(ig * (1.f / 15.f)), fgc = 15.f * tanhf(fg * (1.f / 15.f));
                    float lf = -(fmaxf(-fgc, 0.f) + log1pf(expf(-fabsf(fgc))));
                    UNROLL for (int o = 1; o < 64; o <<= 1) { const float up = __shfl_up(lf, o); if (lane >= o) lf += up; }
                    BV[lane] = lf; GI[lane] = igc;
                }
            }
            __syncthreads();
            {
                const float bt = BV[ti], bl = BV[63], gi = GI[ti];
                const float eb = __expf(bt), wk = __expf(bl - bt + gi);
                float qp[8]; float dn = 0.f;
                UNROLL for (int i = 0; i < 8; ++i) { qp[i] = q8[i] * eb; dn += q8[i] * NV[8 * j + i]; }
                st8((bf16_t*)(QP + ti * LROW) + 8 * j, qp);
                UNROLL for (int i = 0; i < 8; ++i) *(bf16_t*)(KW + (8 * j + i) * LROW + ti * 2) = f2bf(k8[i] * wk);
                dn = sum8(dn);
                if (j == 0) DEN[ti] = dn * eb;
            }
            __syncthreads();
            UNROLL for (int rep = 0; rep < 2; ++rep) {
                const int tile = wave + 8 * rep;
                if (tile < 10) {
                    const int tt4 = tile < 1 ? 0 : tile < 3 ? 1 : tile < 6 ? 2 : 3, st4 = tile - (tt4 * (tt4 + 1)) / 2;
                    f32x4v a = {0.f, 0.f, 0.f, 0.f};
                    UNROLL for (int ks = 0; ks < 2; ++ks)
                        a = __builtin_amdgcn_mfma_f32_16x16x32_bf16(*(const bf16x8*)(QS + (16 * tt4 + lq) * LROW + ks * 64 + kg * 16),
                                                                    *(const bf16x8*)(KC + (16 * st4 + lq) * LROW + ks * 64 + kg * 16), a, 0, 0, 0);
                    const int sidx = 16 * st4 + lq; const float bs = BV[sidx], gs = GI[sidx];
                    UNROLL for (int i = 0; i < 4; ++i) {
                        const int tidx = 16 * tt4 + 4 * kg + i;
                        const float val = sidx <= tidx ? a[i] * __expf(BV[tidx] - bs + gs) : 0.f;
                        *(bf16_t*)(PM + tidx * LROW + sidx * 2) = f2bf(val);
                        const float rsum = sum16(val);
                        if (lq == 0) RS[tidx * 4 + st4] = rsum;
                    }
                }
            }
            __syncthreads();
            {
                bf16x8 vf[2], cb[2];
                UNROLL for (int kk = 0; kk < 2; ++kk) vf[kk] = *(const bf16x8*)(VT + (16 * wave + lq) * LROW + kk * 64 + kg * 16);
                UNROLL for (int kk = 0; kk < 2; ++kk) {
                    u32x4 w; w.x = pk2(cacc[2 * kk][0], cacc[2 * kk][1]); w.y = pk2(cacc[2 * kk][2], cacc[2 * kk][3]);
                    w.z = pk2(cacc[2 * kk + 1][0], cacc[2 * kk + 1][1]); w.w = pk2(cacc[2 * kk + 1][2], cacc[2 * kk + 1][3]);
                    cb[kk] = __builtin_bit_cast(bf16x8, w);
                }
                UNROLL for (int tt4 = 0; tt4 < 4; ++tt4) {
                    f32x4v hacc = {0.f, 0.f, 0.f, 0.f};
                    UNROLL for (int kk = 0; kk < 2; ++kk) if (2 * kk <= tt4)
                        hacc = __builtin_amdgcn_mfma_f32_16x16x32_bf16(*(const bf16x8*)(PM + (16 * tt4 + lq) * LROW + kk * 64 + kg * 16), vf[kk], hacc, 0, 0, 0);
                    UNROLL for (int kk = 0; kk < 2; ++kk) {
                        const char* qa = QP + (16 * tt4 + lq) * LROW + (32 * kk + 4 * kg) * 2;
                        const u32x2 lo = *(const u32x2*)qa, hi = *(const u32x2*)(qa + 32);
                        u32x4 w; w.x = lo.x; w.y = lo.y; w.z = hi.x; w.w = hi.y;
                        hacc = __builtin_amdgcn_mfma_f32_16x16x32_bf16(__builtin_bit_cast(bf16x8, w), cb[kk], hacc, 0, 0, 0);
                    }
                    UNROLL for (int i = 0; i < 4; ++i) {
                        const int tidx = 16 * tt4 + 4 * kg + i;
                        float den = DEN[tidx];
                        UNROLL for (int st = 0; st <= tt4; ++st) den += RS[tidx * 4 + st];
                        HO[tidx * 132 + 16 * wave + lq] = hacc[i] / fmaxf(fabsf(den), 1.f);
                    }
                }
                const float g = __expf(BV[63]);
                UNROLL for (int dk = 0; dk < 4; ++dk) {
                    cacc[dk] = cacc[dk] * g;
                    UNROLL for (int kk = 0; kk < 2; ++kk)
                        cacc[dk] = __builtin_amdgcn_mfma_f32_16x16x32_bf16(*(const bf16x8*)(KW + (16 * dk + lq) * LROW + kk * 64 + kg * 16), vf[kk], cacc[dk], 0, 0, 0);
                }
            }
            __syncthreads();
            if (tid < 64) {
                float acc = 0.f;
                UNROLL for (int c8 = 0; c8 < 8; ++c8) { float kw[8]; ld8((const bf16_t*)(KW + tid * LROW) + 8 * c8, kw); UNROLL for (int i = 0; i < 8; ++i) acc += kw[i]; }
                NV[tid] = __expf(BV[63]) * NV[tid] + acc;
            }
            {
                const float* hr = HO + ti * 132 + 16 * j;
                float o0[8], o1[8];
                UNROLL for (int i = 0; i < 8; ++i) { o0[i] = hr[i]; o1[i] = hr[8 + i]; }
                bf16_t* dst = HS + ((size_t)d * NT + nb + tt) * 512 + h * 128 + 16 * j;
                st8(dst, o0); st8(dst + 8, o1);
            }
            __syncthreads();
        }
    }
}
DEV void ph_ml_read(const Params& p, int L, int ntok) {
    const int lane = TID() & 63, wave = TID() >> 6;
    const bf16_t* PXM = (const bf16_t*)(p.ws + OFF_PX); const bf16_t* HS = (const bf16_t*)(p.ws + OFF_HS);
    bf16_t* YC = (bf16_t*)(p.ws + OFF_YC); const float* ng = p.in[I_MNG] + (size_t)L * 512;
    for (int n0 = blockIdx.x * 8; n0 < ntok; n0 += gridDim.x * 8) {
        const int n = n0 + wave, c = lane * 8;
        float h0[8], h1[8], o8[8], out[8];
        ld8(HS + (size_t)n * 512 + c, h0); ld8(HS + ((size_t)NT + n) * 512 + c, h1); ld8(PXM + (size_t)n * ML_COLS + 1024 + c, o8);
        float ss = 0.f;
        UNROLL for (int i = 0; i < 8; ++i) { h0[i] += h1[i]; ss += h0[i] * h0[i]; }
        ss += __shfl_xor(ss, 1); ss += __shfl_xor(ss, 2); ss += __shfl_xor(ss, 4); ss += __shfl_xor(ss, 8);
        const float r = rsqrtf(ss * (1.f / 128.f) + 1e-6f);
        UNROLL for (int i = 0; i < 8; ++i) out[i] = h0[i] * r * ng[c + i] * sigm(o8[i]);
        st8(YC + (size_t)n * 512 + c, out);
    }
}

DEV void ph_route(const Params& p, int L, int ntok) {
    const int lane = TID() & 63, wave = TID() >> 6;
    const float* LOG = (const float*)(p.ws + OFF_LOG); int* EIDX = (int*)(p.ws + OFF_EIDX); float* EW = (float*)(p.ws + OFF_EW);
    const float bias = p.in[I_MB][L * 64 + lane];
    for (int n0 = blockIdx.x * 8; n0 < ntok; n0 += gridDim.x * 8) {
        const int n = n0 + wave, g = lane >> 3;
        const float score = sigm_acc(LOG[(size_t)n * 64 + lane]), sel = score + bias;
        float m1 = sel; m1 = fmaxf(m1, __shfl_xor(m1, 1)); m1 = fmaxf(m1, __shfl_xor(m1, 2)); m1 = fmaxf(m1, __shfl_xor(m1, 4));
        int i1 = sel == m1 ? lane : 64; i1 = min(i1, __shfl_xor(i1, 1)); i1 = min(i1, __shfl_xor(i1, 2)); i1 = min(i1, __shfl_xor(i1, 4));
        float m2 = lane == i1 ? -3e38f : sel; m2 = fmaxf(m2, __shfl_xor(m2, 1)); m2 = fmaxf(m2, __shfl_xor(m2, 2)); m2 = fmaxf(m2, __shfl_xor(m2, 4));
        const float gs = m1 + m2;
        int rank = 0;
        UNROLL for (int g2 = 0; g2 < 8; ++g2) { const float v = __shfl(gs, g2 * 8); rank += (v > gs || (v == gs && g2 < g)) ? 1 : 0; }
        const float ms = rank < 4 ? sel : -1e30f;
        int er = 0;
        for (int e2 = 0; e2 < 64; ++e2) { const float v = __shfl(ms, e2); er += (v > ms || (v == ms && e2 < lane)) ? 1 : 0; }
        const bool chosen = er < 8;
        float ws = chosen ? score : 0.f;
        UNROLL for (int o = 1; o < 64; o <<= 1) ws += __shfl_xor(ws, o);
        if (chosen) { EIDX[(size_t)n * 8 + er] = lane; EW[(size_t)n * 8 + er] = score / ws * 2.5f; }
    }
}

DEV void ph_moe_exp(const Params& p, int cb, int ce, char* smem, Topo tp) {
    typedef GC<2, 4> C;
    const int tid = TID(), lane = tid & 63, wave = tid >> 6, wm = wave / 4, wn = wave % 4, fr = lane & 31, fh = lane >> 5;
    char* ACT = smem + 2 * C::STG;
    int* list = (int*)(smem + 3 * C::STG);
    int* cnt = list + 1024;
    const bf16_t* H2 = (const bf16_t*)(p.ws + OFF_HX); const int* EIDX = (const int*)(p.ws + OFF_EIDX); const float* EW = (const float*)(p.ws + OFF_EW);
    bf16_t* YBUF = (bf16_t*)(p.ws + OFF_YBUF);
    const int nst = (ce - cb + MOE_ST - 1) / MOE_ST;
    const int xcd = tp.x, slot = tp.r, nslot = tp.n;
    for (int lu = slot; lu < nst * 8; lu += nslot) {
        const int e = xcd + 8 * (lu / nst), st = lu % nst, s0 = cb + st * MOE_ST, ntok = min(MOE_ST, ce - s0);
#ifndef MOE_PROBE
#define MOE_PROBE 0
#endif
        for (int rep_ = 0; rep_ < (MOE_PROBE == 3 ? 3 : 1); ++rep_) {
        __syncthreads();
        if (tid == 0) *cnt = 0;
        __syncthreads();
        for (int i = tid; i < ntok * 8; i += NTHREADS) {
            if (EIDX[(size_t)s0 * 8 + i] == e) { const int pos = atomicAdd(cnt, 1); list[pos] = s0 * 8 + i; }
        }
        }
        __syncthreads();
        const int M = *cnt;
        const bf16_t* GU = (const bf16_t*)(p.ws + OFF_MGU) + (size_t)e * 256 * 1024;
        const bf16_t* DT = (const bf16_t*)(p.ws + OFF_MDT) + (size_t)e * 1024 * 128;
        for (int mc = 0; mc < M; mc += 128) {
            f32x16 acc[2][2];
#if MOE_PROBE == 4
            acc_zero(acc);
            gemm_tile<2, 4, 2, false>(acc, [&](int r) -> const bf16_t* { return H2 + (size_t)(s0 + r) * 1024; }, GU, 1024, 0, 256, 1024, smem, nullptr);
#endif
#if MOE_PROBE == 5
            acc_zero(acc);
            gemm_tile<2, 4, 2, false>(acc, [&](int r) -> const bf16_t* { const int ix = min(mc + r, M - 1); return H2 + (size_t)(list[ix] >> 3) * 1024; }, (const bf16_t*)(p.ws + OFF_MGU), 1024, 0, 256, 1024, smem, nullptr);
#endif
            for (int rep_ = 0; rep_ < (MOE_PROBE == 1 ? 2 : 1); ++rep_) {
            acc_zero(acc);
            gemm_tile<2, 4, 3, false>(acc, [&](int r) -> const bf16_t* { const int ix = min(mc + r, M - 1); return H2 + (size_t)(list[ix] >> 3) * 1024; },
                                   GU, 1024, 0, 256, 1024, smem, nullptr);
            }
            UNROLL for (int mi = 0; mi < 2; ++mi) UNROLL for (int r = 0; r < 16; ++r) {
                const int row = wm * 64 + ACC_ROW(mi, r, fh), ix = mc + row;
                const float gw = ix < M ? EW[list[ix]] : 0.f;
                const float gv = acc[mi][0][r], uv = acc[mi][1][r];
                const float a = gv / (1.f + __expf(-gv)) * uv * gw;
                const int col = wn * 32 + fr;
                *(bf16_t*)(ACT + (col >> 6) * C::AB + row * 128 + ((((col & 63) >> 3) ^ ((row >> 1) & 7)) << 4) + (col & 7) * 2) = f2bf(a);
            }
            __syncthreads();
            {
                const int crow = tid >> 3, cch = (tid & 7) ^ ((crow >> 1) & 7);
                const int sw = (fr >> 1) & 7, a_base = (wm * 64 + fr) * 128, b_base = (wn * 64 + fr) * 128;
                float* slab = (float*)(smem + (wave < 4 ? wave * 4096 : C::STG + (wave - 4) * 4096));
#define MG2_ISSUE(nt_) do { UNROLL for (int kt = 0; kt < 2; ++kt) UNROLL for (int i = 0; i < 4; ++i) \
                    GLDS16(DT + (size_t)((nt_) * 256 + crow + 64 * i) * 128 + kt * 64 + cch * 8, smem + kt * C::STG + C::AB + i * 8192 + tid * 16); } while (0)
                MG2_ISSUE(0);
                _Pragma("unroll 1") for (int nt = 0; nt < 4; ++nt) {
                    asm volatile("s_waitcnt vmcnt(0)" ::: "memory");
                    __builtin_amdgcn_s_barrier();
                    asm volatile("" ::: "memory");
                    acc_zero(acc);
                    UNROLL for (int kt = 0; kt < 2; ++kt) {
                        const char* As_ = ACT + kt * C::AB; const char* Bs_ = smem + kt * C::STG + C::AB;
                        UNROLL for (int ks = 0; ks < 4; ++ks) {
                            const int off = ((2 * ks + fh) ^ sw) * 16;
                            bf16x8 af[2], bfv[2];
                            UNROLL for (int mi = 0; mi < 2; ++mi) af[mi] = *(const bf16x8*)(As_ + a_base + mi * 4096 + off);
                            UNROLL for (int ni = 0; ni < 2; ++ni) bfv[ni] = *(const bf16x8*)(Bs_ + b_base + ni * 4096 + off);
                            UNROLL for (int mi = 0; mi < 2; ++mi) UNROLL for (int ni = 0; ni < 2; ++ni)
                                acc[mi][ni] = __builtin_amdgcn_mfma_f32_32x32x16_bf16(af[mi], bfv[ni], acc[mi][ni], 0, 0, 0);
                        }
                    }
                    asm volatile("s_waitcnt lgkmcnt(0)" ::: "memory");
                    __builtin_amdgcn_s_barrier();
                    asm volatile("" ::: "memory");
                    if (nt < 3) MG2_ISSUE(nt + 1);
                    UNROLL for (int mi = 0; mi < 2; ++mi) UNROLL for (int hh = 0; hh < 2; ++hh) {
                        UNROLL for (int ni = 0; ni < 2; ++ni) UNROLL for (int r8 = 0; r8 < 8; ++r8) {
                            const int r = 8 * hh + r8;
                            slab[((r & 3) + 8 * ((r >> 2) & 1) + 4 * fh) * 64 + ni * 32 + fr] = acc[mi][ni][r];
                        }
                        UNROLL for (int it = 0; it < 2; ++it) {
                            const int row = (lane >> 3) + 8 * it, c8 = (lane & 7) * 8;
                            const float4 a = *(const float4*)(slab + row * 64 + c8), b = *(const float4*)(slab + row * 64 + c8 + 4);
                            const float v[8] = {a.x, a.y, a.z, a.w, b.x, b.y, b.z, b.w};
                            const int ix = mc + wm * 64 + mi * 32 + 16 * hh + row;
                            if (ix < M) st8(YBUF + (size_t)(list[ix] - cb * 8) * 1024 + nt * 256 + wn * 64 + c8, v);
                        }
                    }
                }
#undef MG2_ISSUE
            }
            __syncthreads();
        }
        __syncthreads();
    }
}


#define XB_TMO      128
#define XB_XCNT(j)  (256  + 64 * (j))
#define XB_XSUB(j)  (1280 + 64 * (j))
#define XB_XGEN(j)  (2304 + 64 * (j))
#define XB_TOP      3328
#define XB_TOPGEN   3392
#define XCD_BAR_WORDS 3456
#define XB_SPIN_CAP (1u << 18)
#define LAS __attribute__((address_space(3)))

__device__ __forceinline__ unsigned xb_ld(unsigned* p)              { return __hip_atomic_load(p, __ATOMIC_RELAXED, __HIP_MEMORY_SCOPE_AGENT); }
__device__ __forceinline__ unsigned xb_add(unsigned* p, unsigned v) { return __hip_atomic_fetch_add(p, v, __ATOMIC_RELAXED, __HIP_MEMORY_SCOPE_AGENT); }
__device__ __forceinline__ unsigned xb_xcc_id() { return (unsigned)__builtin_amdgcn_s_getreg((3 << 11) | 20) & 0xFu; }
#define XB_SPIN(cond, bar) do { unsigned _sp = 0; while (cond) { __builtin_amdgcn_s_sleep(1); \
    if ((++_sp & 255u) == 0u) { if (xb_ld(&(bar)[XB_TMO])) break; if (_sp > XB_SPIN_CAP) { atomicAdd(&(bar)[XB_TMO], 1u); break; } } } } while (0)

struct XcdBarrier { unsigned* bar; unsigned x; volatile LAS unsigned* st; };

__device__ __forceinline__ XcdBarrier xcd_barrier_post(unsigned* bar, volatile LAS unsigned* st) {
    XcdBarrier b; b.bar = bar; b.x = xb_xcc_id(); b.st = st;
    if (threadIdx.x == 0) { const unsigned rank = xb_add(&bar[XB_XCNT(b.x)], 1u); st[2] = b.x; st[3] = rank; }
    return b;
}
__device__ __forceinline__ void xcd_barrier_complete(unsigned* bar, unsigned x, unsigned& nloc, unsigned& nx) {
    const unsigned G = gridDim.x * gridDim.y * gridDim.z;
    unsigned sum, cnt, mine, sp = 0u;
    for (;;) {
        sum = 0u; cnt = 0u; mine = 0u;
#pragma unroll
        for (unsigned j = 0; j < 16; ++j) { const unsigned c = xb_ld(&bar[XB_XCNT(j)]); sum += c; cnt += (c > 0u) ? 1u : 0u; mine = (j == x) ? c : mine; }
        if (sum == G) break;
        __builtin_amdgcn_s_sleep(1);
        if ((++sp & 255u) == 0u) { if (xb_ld(&bar[XB_TMO])) break; if (sp > XB_SPIN_CAP) { atomicAdd(&bar[XB_TMO], 1u); break; } }
    }
    nloc = mine > 0u ? mine : 1u; nx = cnt > 0u ? cnt : 1u;
}
__device__ __forceinline__ void xcd_barrier(const XcdBarrier& b) {
    asm volatile("s_waitcnt vmcnt(0)" ::: "memory");
    __syncthreads();
    if (threadIdx.x == 0) {
        unsigned* bar = b.bar;
        __builtin_amdgcn_s_waitcnt(0);
        unsigned nloc = b.st[0], nx = b.st[1];
        if (nloc == 0u) { xcd_barrier_complete(bar, b.x, nloc, nx); b.st[0] = nloc; b.st[1] = nx; }
        const unsigned old = xb_add(&bar[XB_XSUB(b.x)], 1u);
        const unsigned gen = old / nloc;
        if (old + 1u == (gen + 1u) * nloc) {
            __builtin_amdgcn_fence(__ATOMIC_RELEASE, "agent");
            asm volatile("s_waitcnt vmcnt(0)" ::: "memory");
            const unsigned og = xb_add(&bar[XB_TOP], 1u);
            const unsigned tg = og / nx;
            if (og + 1u == (tg + 1u) * nx) xb_add(&bar[XB_TOPGEN], 1u);
            else XB_SPIN(xb_ld(&bar[XB_TOPGEN]) == tg, bar);
            __builtin_amdgcn_fence(__ATOMIC_ACQUIRE, "agent");
            xb_add(&bar[XB_XGEN(b.x)], 1u);
            asm volatile("s_waitcnt vmcnt(0)" ::: "memory");
        } else {
            XB_SPIN(xb_ld(&bar[XB_XGEN(b.x)]) == gen, bar);
            __builtin_amdgcn_fence(__ATOMIC_ACQUIRE, "agent");
            asm volatile("s_waitcnt vmcnt(0)" ::: "memory");
        }
    }
    __syncthreads();
}

enum { PH_MODCONV = 0, PH_HX, PH_GEMM_R, PH_RW_PREP, PH_RW_SCAN, PH_RW_READ, PH_RW_G, PH_GEMM_N, PH_NA_NORM, PH_NA_ATT, PH_GEMM_M, PH_ML_SCAN, PH_ML_READ,
       PH_GEMM_G, PH_MERGE, PH_OUT, PH_NORM2, PH_ROUTER, PH_ROUTE, PH_SHARED, PH_MOE_EXP, PH_MOE_COMB, PH_COUNT };

template <int PH> DEV void run_phase(const Params& p, int L, int sub, char* smem, Topo tp) {
    const int tid = TID(), lane = tid & 63, fr = lane & 31, fh = lane >> 5;
    char* ws = p.ws;
    const int ntl = L == 0 ? NT : NX;
    const bf16_t* HX = (const bf16_t*)(ws + OFF_HX);
    const bf16_t* WINT = (const bf16_t*)(ws + OFF_WINT);
    if constexpr (PH == PH_MODCONV) { ph_mod(p, L, smem); ph_conv_mix(p, L, smem); }
    else if constexpr (PH == PH_HX) { ph_norm(p, L, 0, NT); }
    else if constexpr (PH == PH_GEMM_R || PH == PH_GEMM_M) {
        const int c0 = PH == PH_GEMM_R ? 0 : RW_COLS + NA_COLS;
        const int N = PH == PH_GEMM_R ? RW_COLS : ML_COLS;
        bf16_t* PX = (bf16_t*)(ws + OFF_PX);
        gemm256(HX, NT, WINT + (size_t)c0 * DM, N, DM, smem, tp, [&](int row, int col, const float (&v)[8]) {
            if (col < N) st8(PX + (size_t)row * N + col, v);
        });
    }
    else if constexpr (PH == PH_GEMM_N) {
        bf16_t* PX = (bf16_t*)(ws + OFF_PX); bf16_t* VT = (bf16_t*)(ws + OFF_VT); bf16_t* VTC = (bf16_t*)(ws + OFF_VTC);
        gemm256(HX, NT, WINT + (size_t)RW_COLS * DM, 1024, DM, smem, tp, [&](int row, int col, const float (&v)[8]) { st8(PX + (size_t)row * 1024 + col, v); });
        gemm_phase<4, 2>(HX, DM, NT, WINT + (size_t)(RW_COLS + 1024) * DM, DM, 512, DM, smem, tp, [&](const f32x16 (&acc)[2][2], int row0, int col0) {
            const int h = col0 >> 6;
            epi_cols(acc, smem, [&](int r8, int col, const float (&v)[8]) {
                const int n = row0 + r8;
                bf16_t* dst = n < NX ? VT + ((size_t)((n >> 11) * 8 + h) * 64 + col) * SEQ + (n & 2047)
                                     : VTC + ((size_t)(((n - NX) >> 8) * 8 + h) * 64 + col) * CTXL + ((n - NX) & 255);
                st8(dst, v);
            });
        });
    }
    else if constexpr (PH == PH_RW_PREP) { ph_rw_prep(p, L, smem); }
    else if constexpr (PH == PH_RW_SCAN) { ph_rw_scan(p, L, smem); }
    else if constexpr (PH == PH_RW_READ) { ph_rw_read(p, L, ntl); }
    else if constexpr (PH == PH_RW_G) {
        bf16_t* YA = (bf16_t*)(ws + OFF_YA);
        gemm_phase<4, 2>((const bf16_t*)(ws + OFF_SGB), 128, ntl, (const bf16_t*)(ws + OFF_G2T), 128, 512, 128, smem, tp, [&](const f32x16 (&acc)[2][2], int row0, int col0) {
            epi_rows(acc, smem, [&](int row, int c8, const float (&v)[8]) {
                bf16_t* q = YA + (size_t)(row0 + row) * 512 + col0 + c8;
                float y[8]; ld8(q, y);
                UNROLL for (int i = 0; i < 8; ++i) y[i] *= v[i];
                st8(q, y);
            });
        });
    }
    else if constexpr (PH == PH_NA_NORM) { ph_na_norm(p, L); }
    else if constexpr (PH == PH_NA_ATT) { ph_na_att(p, L, smem); }
    else if constexpr (PH == PH_ML_SCAN) { ph_ml_scan(p, L, smem); }
    else if constexpr (PH == PH_ML_READ) { ph_ml_read(p, L, ntl); }
    else if constexpr (PH == PH_GEMM_G) {
        bf16_t* G = (bf16_t*)(ws + OFF_GATES);
        gemm256(HX, ntl, WINT + (size_t)(RW_COLS + NA_COLS + ML_COLS) * DM, GATE_COLS, DM, smem, tp, [&](int row, int col, const float (&v)[8]) {
            float y[8];
            UNROLL for (int i = 0; i < 8; ++i) y[i] = sigm(v[i]);
            st8(G + (size_t)row * GATE_COLS + col, y);
        });
    }
    else if constexpr (PH == PH_MERGE) {
        const bf16_t* G = (const bf16_t*)(ws + OFF_GATES); bf16_t* MG = (bf16_t*)(ws + OFF_HX);
        _Pragma("unroll 1") for (int br = 0; br < 3; ++br) {
            gemm256((const bf16_t*)(ws + OFF_YA + (size_t)br * SZ_Y1), ntl, (const bf16_t*)(ws + OFF_WBT) + (size_t)br * 1024 * 512, DM, 512, smem, tp, [&](int row, int col, const float (&v)[8]) {
                float g[8], m[8];
                ld8(G + (size_t)row * GATE_COLS + br * DM + col, g);
                bf16_t* q = MG + (size_t)row * DM + col;
                if (br == 0) { UNROLL for (int i = 0; i < 8; ++i) m[i] = g[i] * v[i]; }
                else { ld8(q, m); UNROLL for (int i = 0; i < 8; ++i) m[i] += g[i] * v[i]; }
                st8(q, m);
            });
        }
    }
    else if constexpr (PH == PH_OUT) {
        const float* MOD = (const float*)(ws + OFF_MOD);
        gemm256(HX, ntl, (const bf16_t*)(ws + OFF_WOUTT), DM, DM, smem, tp, [&](int n, int c, const float (&v)[8]) {
            const float* xp = xprev_row(p, L, n) + c; float* xo = xs_row(p, n) + c; const float* g1 = MOD + mod_row(n) * 6144 + 2 * DM + c;
            const float4 xa = *(const float4*)xp, xb = *(const float4*)(xp + 4), ga = *(const float4*)g1, gb = *(const float4*)(g1 + 4);
            float4 oa, ob;
            oa.x = xa.x + ga.x * v[0]; oa.y = xa.y + ga.y * v[1]; oa.z = xa.z + ga.z * v[2]; oa.w = xa.w + ga.w * v[3];
            ob.x = xb.x + gb.x * v[4]; ob.y = xb.y + gb.y * v[5]; ob.z = xb.z + gb.z * v[6]; ob.w = xb.w + gb.w * v[7];
            *(float4*)xo = oa; *(float4*)(xo + 4) = ob;
        });
    }
    else if constexpr (PH == PH_NORM2) { ph_norm(p, L, 1, ntl); ph_conv_moe(p, L, smem); }
    else if constexpr (PH == PH_ROUTER) {
        typedef GC<4, 2> C;
        float* LOG = (float*)(ws + OFF_LOG);
        const bf16_t* H2LO = (const bf16_t*)(ws + OFF_H2LO); const bf16_t* RH = (const bf16_t*)(ws + OFF_RTR); const bf16_t* RL = RH + 64 * 1024;
        const int wave = tid >> 6, wm = wave / 2, wn = wave % 2;
        for (int t = blockIdx.x; t < ntl / C::BM; t += gridDim.x) {
            f32x16 acc[2][2]; acc_zero(acc);
            const bf16_t* A0 = HX + (size_t)t * C::BM * DM; const bf16_t* A1 = H2LO + (size_t)t * C::BM * DM;
            gemm_tile<4, 2, 3, false>(acc, [&](int r) { return A0 + (size_t)r * DM; }, RH, DM, 0, 64, DM, smem, nullptr);
            gemm_tile<4, 2, 3, false>(acc, [&](int r) { return A1 + (size_t)r * DM; }, RH, DM, 0, 64, DM, smem, nullptr);
            gemm_tile<4, 2, 3, false>(acc, [&](int r) { return A0 + (size_t)r * DM; }, RL, DM, 0, 64, DM, smem, nullptr);
            epi_rows(acc, smem, [&](int row, int c8, const float (&v)[8]) {
                if (wn == 0) {
                    float* q = LOG + (size_t)(t * C::BM + wm * 64 + row) * 64 + c8;
                    *(float4*)q = make_float4(v[0], v[1], v[2], v[3]); *(float4*)(q + 4) = make_float4(v[4], v[5], v[6], v[7]);
                }
            });
        }
    }
    else if constexpr (PH == PH_ROUTE) { ph_route(p, L, ntl); }
    else if constexpr (PH == PH_SHARED) {
        bf16_t* SA = (bf16_t*)(ws + OFF_SA);
        gemm256_pair(HX, ntl, (const bf16_t*)(ws + OFF_SGUT), 512, DM, smem, tp, [&](int row, int col, const float (&g)[8], const float (&u)[8]) {
            float a[8];
            UNROLL for (int i = 0; i < 8; ++i) a[i] = g[i] / (1.f + __expf(-g[i])) * u[i];
            st8(SA + (size_t)row * 256 + (col >> 8) * 128 + (col & 127), a);
        });
    }
    else if constexpr (PH == PH_MOE_EXP) { const int cb = sub * MOE_CHUNK; ph_moe_exp(p, cb, min(cb + MOE_CHUNK, ntl), smem, tp); }
    else if constexpr (PH == PH_MOE_COMB) {
        const int cb = sub * MOE_CHUNK, ce = min(cb + MOE_CHUNK, ntl);
        const float* MOD = (const float*)(ws + OFF_MOD); const bf16_t* YBUF = (const bf16_t*)(ws + OFF_YBUF);
        gemm256((const bf16_t*)(ws + OFF_SA) + (size_t)cb * 256, ce - cb, (const bf16_t*)(ws + OFF_SDT), DM, 256, smem, tp, [&](int rl, int c, const float (&v)[8]) {
            const int n = cb + rl;
            float s[8];
            UNROLL for (int i = 0; i < 8; ++i) s[i] = v[i];
            _Pragma("unroll 2") for (int k = 0; k < 8; ++k) { float y[8]; ld8(YBUF + ((size_t)rl * 8 + k) * DM + c, y); UNROLL for (int i = 0; i < 8; ++i) s[i] += y[i]; }
            float* xo = xs_row(p, n) + c; const float* g2 = MOD + mod_row(n) * 6144 + 5 * DM + c;
            float4 xa = *(const float4*)xo, xb = *(const float4*)(xo + 4); const float4 ga = *(const float4*)g2, gb = *(const float4*)(g2 + 4);
            xa.x += ga.x * s[0]; xa.y += ga.y * s[1]; xa.z += ga.z * s[2]; xa.w += ga.w * s[3];
            xb.x += gb.x * s[4]; xb.y += gb.y * s[5]; xb.z += gb.z * s[6]; xb.w += gb.w * s[7];
            *(float4*)xo = xa; *(float4*)(xo + 4) = xb;
        });
    }
}

template <int PH> __global__ void __launch_bounds__(NTHREADS, 2) k_phase(Params p, int L, int sub) {
    extern __shared__ __attribute__((aligned(16))) char smem[];
    run_phase<PH>(p, L, sub, smem, Topo{(int)(blockIdx.x & 7), (int)(blockIdx.x >> 3), (int)((gridDim.x + 7 - (blockIdx.x & 7)) >> 3)});
}


#ifndef N_LAUNCH_MODE
#define N_LAUNCH_MODE 1
#endif
#ifndef MEGA_SKIP
#define MEGA_SKIP 0ull
#endif
#ifndef MEGA_REPEAT
#define MEGA_REPEAT 0ull
#endif
#define PHASE(PH, sub) do { if constexpr (!((MEGA_SKIP >> PH) & 1ull)) { run_phase<PH>(p, L, sub, smem, tp); xcd_barrier(bar); if constexpr ((MEGA_REPEAT >> PH) & 1ull) { run_phase<PH>(p, L, sub, smem, tp); xcd_barrier(bar); } } } while (0)
__global__ void __launch_bounds__(NTHREADS, 2) k_mega(Params p) {
    extern __shared__ __attribute__((aligned(16))) char smem[];
    volatile LAS unsigned* st = (volatile LAS unsigned*)(smem + LDS_BYTES);
    if (threadIdx.x == 0) { st[0] = 0u; st[1] = 0u; st[2] = 0u; st[3] = 0u; }
    __syncthreads();
    const XcdBarrier bar = xcd_barrier_post((unsigned*)(p.ws + OFF_BAR), st);
    Topo tp{(int)(blockIdx.x & 7), (int)(blockIdx.x >> 3), (int)((gridDim.x + 7 - (blockIdx.x & 7)) >> 3)};
    for (int L = 0; L < 2; ++L) {
        const int ntl = L == 0 ? NT : NX;
        PHASE(PH_MODCONV, 0);
        if (st[1] == 8u && st[0] != 0u) { tp.x = (int)st[2]; tp.r = (int)st[3]; tp.n = (int)st[0]; }
        PHASE(PH_HX, 0);
        PHASE(PH_GEMM_R, 0);
        PHASE(PH_RW_PREP, 0);
        PHASE(PH_RW_SCAN, 0);
        PHASE(PH_RW_READ, 0);
        PHASE(PH_RW_G, 0);
        PHASE(PH_GEMM_N, 0);
        PHASE(PH_NA_NORM, 0);
        PHASE(PH_NA_ATT, 0);
        PHASE(PH_GEMM_M, 0);
        PHASE(PH_ML_SCAN, 0);
        PHASE(PH_ML_READ, 0);
        PHASE(PH_GEMM_G, 0);
        PHASE(PH_MERGE, 0);
        PHASE(PH_OUT, 0);
        PHASE(PH_NORM2, 0);
        PHASE(PH_ROUTER, 0);
        PHASE(PH_ROUTE, 0);
        PHASE(PH_SHARED, 0);
        for (int c = 0; c * MOE_CHUNK < ntl; ++c) {
            PHASE(PH_MOE_EXP, c);
            PHASE(PH_MOE_COMB, c);
        }
    }
}

template <int PH> static void launch_phase(const Params& p, int L, int sub, hipStream_t stream) {
    static bool attr = false;
    if (!attr) { (void)hipFuncSetAttribute((const void*)k_phase<PH>, hipFuncAttributeMaxDynamicSharedMemorySize, LDS_BYTES); attr = true; }
    hipLaunchKernelGGL(k_phase<PH>, dim3(256), dim3(NTHREADS), LDS_BYTES, stream, p, L, sub);
}

extern "C" void kernel_launch(void* const* d_in, const int* in_sizes, int n_in, void* d_out, int out_size, void* d_ws, size_t ws_size, hipStream_t stream) {
    if (n_in != N_IN || ws_size < WS_END) { fprintf(stderr, "kernel_launch: unexpected inputs (%d) or workspace (%zu < %zu)\n", n_in, ws_size, (size_t)WS_END); return; }
    Params p{};
    for (int i = 0; i < N_IN; ++i) p.in[i] = (const float*)d_in[i];
    p.out = (float*)d_out; p.ws = (char*)d_ws;
#if N_LAUNCH_MODE == 1
    static int grid = 0;
    if (grid == 0) {
        int dev = 0, cus = 0;
        if (hipGetDevice(&dev) != hipSuccess || hipDeviceGetAttribute(&cus, hipDeviceAttributeMultiprocessorCount, dev) != hipSuccess) { grid = -1; return; }
        if (hipFuncSetAttribute((const void*)k_mega, hipFuncAttributeMaxDynamicSharedMemorySize, LDS_BYTES + 256) != hipSuccess) { grid = -1; return; }
        grid = cus;
    }
    if (grid <= 0) return;
    (void)hipMemsetAsync((char*)d_ws + OFF_BAR, 0, XCD_BAR_WORDS * sizeof(unsigned), stream);
    hipLaunchKernelGGL(k_mega, dim3(grid), dim3(NTHREADS), LDS_BYTES + 256, stream, p);
    return;
#endif
    for (int L = 0; L < 2; ++L) {
        const int ntl = L == 0 ? NT : NX;
        launch_phase<PH_MODCONV>(p, L, 0, stream);
        launch_phase<PH_HX>(p, L, 0, stream);
        launch_phase<PH_GEMM_R>(p, L, 0, stream);
        launch_phase<PH_RW_PREP>(p, L, 0, stream);
        launch_phase<PH_RW_SCAN>(p, L, 0, stream);
        launch_phase<PH_RW_READ>(p, L, 0, stream);
        launch_phase<PH_RW_G>(p, L, 0, stream);
        launch_phase<PH_GEMM_N>(p, L, 0, stream);
        launch_phase<PH_NA_NORM>(p, L, 0, stream);
        launch_phase<PH_NA_ATT>(p, L, 0, stream);
        launch_phase<PH_GEMM_M>(p, L, 0, stream);
        launch_phase<PH_ML_SCAN>(p, L, 0, stream);
        launch_phase<PH_ML_READ>(p, L, 0, stream);
        launch_phase<PH_GEMM_G>(p, L, 0, stream);
        launch_phase<PH_MERGE>(p, L, 0, stream);
        launch_phase<PH_OUT>(p, L, 0, stream);
        launch_phase<PH_NORM2>(p, L, 0, stream);
        launch_phase<PH_ROUTER>(p, L, 0, stream);
        launch_phase<PH_ROUTE>(p, L, 0, stream);
        launch_phase<PH_SHARED>(p, L, 0, stream);
        for (int c = 0; c * MOE_CHUNK < ntl; ++c) {
            launch_phase<PH_MOE_EXP>(p, L, c, stream);
            launch_phase<PH_MOE_COMB>(p, L, c, stream);
        }
    }
}
```

```cpp
#include <hip/hip_runtime.h>
#include <stdint.h>
#include <stdio.h>

#define DEV __device__ __forceinline__
#define UNROLL _Pragma("unroll")

typedef unsigned short bf16_t;
typedef short bf16x8 __attribute__((ext_vector_type(8)));
typedef float f32x16 __attribute__((ext_vector_type(16)));
typedef float f32x4v __attribute__((ext_vector_type(4)));
typedef unsigned u32x4 __attribute__((ext_vector_type(4)));
typedef unsigned u32x2 __attribute__((ext_vector_type(2)));

constexpr int DM = 1024, NBATCH = 16, SEQ = 2048, CTXL = 256;
constexpr int NX = NBATCH * SEQ, NC = NBATCH * CTXL, NT = NX + NC;
constexpr int RW_COLS = 1920, NA_COLS = 1536, ML_COLS = 1552, GATE_COLS = 3072, IN_COLS = 8080;
constexpr int NTHREADS = 512;
constexpr int MOE_CHUNK = 12288, MOE_ST = 768;

enum { I_X = 0, I_C, I_CTX, I_CCTX, I_WADA, I_BADA, I_N1G, I_N2G, I_WIN, I_MU, I_W0, I_W2, I_A0, I_A2, I_KK, I_KA, I_RK, I_G2,
       I_LNG, I_LNB, I_V0, I_V1, I_V2, I_QNG, I_KNG, I_RPB, I_IB, I_FB, I_MNG, I_WBR, I_WOUT, I_RTR, I_MB, I_MWG, I_MWU, I_MWD,
       I_SG, I_SU, I_SD, N_IN };

constexpr size_t OFF_BAR = 0;
constexpr size_t OFF_MOD = 16384;
constexpr size_t OFF_WINT = OFF_MOD + 417792;
constexpr size_t OFF_WBT = OFF_WINT + (size_t)IN_COLS * 1024 * 2;
constexpr size_t OFF_WOUTT = OFF_WBT + (size_t)3 * 1024 * 512 * 2;
constexpr size_t OFF_SGUT = OFF_WOUTT + (size_t)1024 * 1024 * 2;
constexpr size_t OFF_SDT = OFF_SGUT + (size_t)512 * 1024 * 2;
constexpr size_t OFF_G2T = OFF_SDT + (size_t)1024 * 256 * 2;
constexpr size_t OFF_RTR = OFF_G2T + (size_t)512 * 128 * 2;
constexpr size_t OFF_CTXS = OFF_RTR + (size_t)2 * 64 * 1024 * 2;
constexpr size_t OFF_VF = OFF_CTXS + (size_t)NC * 1024 * 4;
constexpr size_t OFF_HX = OFF_VF + (size_t)NT * 512 * 2;
constexpr size_t OFF_BIG = OFF_HX + (size_t)NT * 1024 * 2;
constexpr size_t SZ_Y1 = (size_t)NT * 512 * 2;
constexpr size_t OFF_YA = OFF_BIG, OFF_YB = OFF_YA + SZ_Y1, OFF_YC = OFF_YB + SZ_Y1;
constexpr size_t OFF_PX = OFF_BIG + 3 * SZ_Y1;
constexpr size_t OFF_SCR = OFF_PX + (size_t)NT * RW_COLS * 2;
constexpr size_t SZ_SCR = (size_t)NT * 1152 * 2;
constexpr size_t WS_END = OFF_SCR + SZ_SCR;
constexpr size_t OFF_YS = OFF_YB;
constexpr size_t OFF_SGB = OFF_SCR;
constexpr size_t OFF_CB = OFF_SCR + (size_t)NT * 128 * 2;
constexpr size_t OFF_HS = OFF_SCR;
constexpr size_t OFF_VT = OFF_PX + (size_t)NT * 1024 * 2;
constexpr size_t OFF_VTC = OFF_VT + (size_t)NX * 512 * 2;
constexpr size_t OFF_GATES = OFF_PX;
constexpr size_t OFF_MGU = OFF_BIG;
constexpr size_t OFF_MDT = OFF_MGU + (size_t)64 * 256 * 1024 * 2;
constexpr size_t OFF_SA = OFF_MDT + (size_t)64 * 1024 * 128 * 2;
constexpr size_t OFF_EIDX = OFF_SA + (size_t)NT * 256 * 2;
constexpr size_t OFF_EW = OFF_EIDX + (size_t)NT * 8 * 4;
constexpr int SORT_CAP = 106496;
constexpr size_t OFF_SORT = OFF_EW + (size_t)NT * 8 * 4;
constexpr size_t OFF_LOG = OFF_SORT + (size_t)3 * SORT_CAP * 4;
constexpr size_t OFF_H2LO = OFF_LOG + (size_t)NT * 64 * 4;
constexpr size_t OFF_YBUF = OFF_LOG;
static_assert(OFF_YBUF + (size_t)MOE_CHUNK * 8 * 1024 * 2 <= WS_END, "moe layout");
static_assert(OFF_GATES + (size_t)NT * 3072 * 2 <= WS_END, "gates layout");
static_assert(WS_END <= (size_t)536870912, "workspace");

constexpr size_t OFF_MCNT = OFF_BAR + 14336;
constexpr int LDS_BYTES = 155648;

struct Topo { int x, r, n; };
struct Params {
    const float* in[N_IN];
    float* out;
    char* ws;
};

DEV int TID() { int t = threadIdx.x; asm volatile("" : "+v"(t)); return t; }
DEV float bf2f(bf16_t h) { return __uint_as_float(((unsigned)h) << 16); }
DEV bf16_t f2bf(float f) { unsigned u = __float_as_uint(f); u += 0x7FFFu + ((u >> 16) & 1u); return (bf16_t)(u >> 16); }
DEV unsigned pk2(float lo, float hi) { return (unsigned)f2bf(lo) | ((unsigned)f2bf(hi) << 16); }
DEV void ld8(const bf16_t* p, float (&o)[8]) {
    const u32x4 v = *(const u32x4*)p;
    o[0] = __uint_as_float(v.x << 16); o[1] = __uint_as_float(v.x & 0xffff0000u);
    o[2] = __uint_as_float(v.y << 16); o[3] = __uint_as_float(v.y & 0xffff0000u);
    o[4] = __uint_as_float(v.z << 16); o[5] = __uint_as_float(v.z & 0xffff0000u);
    o[6] = __uint_as_float(v.w << 16); o[7] = __uint_as_float(v.w & 0xffff0000u);
}
DEV void st8(bf16_t* p, const float (&v)[8]) {
    u32x4 o; o.x = pk2(v[0], v[1]); o.y = pk2(v[2], v[3]); o.z = pk2(v[4], v[5]); o.w = pk2(v[6], v[7]);
    *(u32x4*)p = o;
}
#define DPP_MOV(v, ctrl) __builtin_bit_cast(float, __builtin_amdgcn_update_dpp(0, __builtin_bit_cast(int, (v)), (ctrl), 0xF, 0xF, true))
DEV float sum8(float v) { v += DPP_MOV(v, 0xB1); v += DPP_MOV(v, 0x4E); v += DPP_MOV(v, 0x141); return v; }
DEV float sigm(float x) { return 1.f / (1.f + __expf(-x)); }
DEV float sigm_acc(float x) { return 1.f / (1.f + expf(-x)); }
DEV float tanh_fast(float x) { return 1.f - 2.f / (1.f + __expf(2.f * x)); }
DEV float softplus_fast(float x) { return fmaxf(x, 0.f) + __logf(1.f + __expf(-fabsf(x))); }
DEV int mod_row(int n) { return n < NX ? (n >> 11) : 16; }
DEV float* xs_row(const Params& p, int n) { return n < NX ? p.out + (size_t)n * DM : (float*)(p.ws + OFF_CTXS) + (size_t)(n - NX) * DM; }
DEV const float* xprev_row(const Params& p, int L, int n) {
    if (L == 0) return n < NX ? p.in[I_X] + (size_t)n * DM : p.in[I_CTX] + (size_t)(n - NX) * DM;
    return xs_row(p, n);
}
DEV void seq_of(int n, int& nb, int& tt, int& T) {
    if (n < NX) { nb = n & ~2047; tt = n & 2047; T = SEQ; } else { const int m = n - NX; nb = NX + (m & ~255); tt = m & 255; T = CTXL; }
}
DEV void shift8(const bf16_t* z, int ld, int nb, int tt, int T, int col0, const float* mu, float (&o)[8]) {
    float c[8], l[8], r[8];
    ld8(z + (size_t)(nb + tt) * ld + col0, c);
    if (tt > 0) ld8(z + (size_t)(nb + tt - 1) * ld + col0, l); else { UNROLL for (int i = 0; i < 8; ++i) l[i] = 0.f; }
    if (tt < T - 1) ld8(z + (size_t)(nb + tt + 1) * ld + col0, r); else { UNROLL for (int i = 0; i < 8; ++i) r[i] = 0.f; }
    UNROLL for (int i = 0; i < 8; ++i) o[i] = c[i] + mu[col0 + i] * (0.5f * (l[i] + r[i]) - c[i]);
}

constexpr int LROW = 144;
template <int WM, int WN> struct GC {
    static constexpr int BM = 64 * WM, BN = 64 * WN;
    static constexpr int AB = BM * 128, BB = BN * 128, STG = AB + BB;
    static constexpr int NA = BM / 64, NBC = BN / 64;
};
DEV void acc_zero(f32x16 (&acc)[2][2]) {
    UNROLL for (int a = 0; a < 2; ++a) UNROLL for (int b = 0; b < 2; ++b) UNROLL for (int r = 0; r < 16; ++r) acc[a][b][r] = 0.f;
}
#define GLDS16(gp, lp) __builtin_amdgcn_global_load_lds((const __attribute__((address_space(1))) void*)(gp), (__attribute__((address_space(3))) void*)(lp), 16, 0, 0)
template <int WM, int WN, int NS, bool A_LDS, class ARow>
DEV void gemm_tile(f32x16 (&acc)[2][2], ARow arow, const bf16_t* Bt, int ldb, int n0, int Nvalid, int K, char* smem, const char* alds) {
    typedef GC<WM, WN> C;
    constexpr int LPT = (A_LDS ? 0 : C::NA) + C::NBC;
    const int tid = TID(), lane = tid & 63, wave = tid >> 6, wm = wave / WN, wn = wave % WN;
    const int fr = lane & 31, fh = lane >> 5;
    const int crow = tid >> 3, cch = (tid & 7) ^ ((crow >> 1) & 7);
    const bf16_t* pa[C::NA]; const bf16_t* pb[C::NBC];
    if (!A_LDS) { UNROLL for (int i = 0; i < C::NA; ++i) pa[i] = arow(crow + 64 * i) + cch * 8; }
    UNROLL for (int i = 0; i < C::NBC; ++i) { const int n = min(n0 + crow + 64 * i, Nvalid - 1); pb[i] = Bt + (size_t)n * ldb + cch * 8; }
    const int nk = K >> 6;
#define GT_ISSUE(kt, stg) do { char* sb_ = smem + (stg) * C::STG + tid * 16; \
        if (!A_LDS) { UNROLL for (int i = 0; i < C::NA; ++i) GLDS16(pa[i] + (kt) * 64, sb_ + i * 8192); } \
        UNROLL for (int i = 0; i < C::NBC; ++i) GLDS16(pb[i] + (kt) * 64, sb_ + C::AB + i * 8192); } while (0)
    const int sw = (fr >> 1) & 7;
    int offk[4];
    UNROLL for (int ks = 0; ks < 4; ++ks) offk[ks] = ((2 * ks + fh) ^ sw) * 16;
    const int a_base = (wm * 64 + fr) * 128, b_base = (wn * 64 + fr) * 128;
    UNROLL for (int s = 0; s < NS - 1; ++s) if (s < nk) GT_ISSUE(s, s);
    int stg = 0, nstg = NS - 1;
    for (int kt = 0; kt < nk; ++kt) {
        if (NS == 3 && kt + 1 < nk) asm volatile("s_waitcnt vmcnt(%0)" :: "n"(LPT) : "memory");
        else asm volatile("s_waitcnt vmcnt(0)" ::: "memory");
        __builtin_amdgcn_s_barrier();
        asm volatile("" ::: "memory");
        const bool more = kt + NS - 1 < nk;
        const char* As_ = A_LDS ? alds + kt * C::AB : smem + stg * C::STG; const char* Bs_ = smem + stg * C::STG + C::AB;
        char* db_ = smem + nstg * C::STG + tid * 16;
        bf16x8 af[2][2], bfv[2][2];
        UNROLL for (int mi = 0; mi < 2; ++mi) af[0][mi] = *(const bf16x8*)(As_ + a_base + mi * 4096 + offk[0]);
        UNROLL for (int ni = 0; ni < 2; ++ni) bfv[0][ni] = *(const bf16x8*)(Bs_ + b_base + ni * 4096 + offk[0]);
        UNROLL for (int ks = 0; ks < 4; ++ks) {
            const int cur = ks & 1, nxt = cur ^ 1;
            if (ks < 3) {
                UNROLL for (int mi = 0; mi < 2; ++mi) af[nxt][mi] = *(const bf16x8*)(As_ + a_base + mi * 4096 + offk[ks + 1]);
                UNROLL for (int ni = 0; ni < 2; ++ni) bfv[nxt][ni] = *(const bf16x8*)(Bs_ + b_base + ni * 4096 + offk[ks + 1]);
            }
            UNROLL for (int mi = 0; mi < 2; ++mi) UNROLL for (int ni = 0; ni < 2; ++ni)
                acc[mi][ni] = __builtin_amdgcn_mfma_f32_32x32x16_bf16(af[cur][mi], bfv[cur][ni], acc[mi][ni], 0, 0, 0);
            if (more) {
                UNROLL for (int pc = 0; pc < LPT; ++pc) if (pc * 4 / LPT == ks) {
                    if (!A_LDS && pc < C::NA) GLDS16(pa[pc] + (kt + NS - 1) * 64, db_ + pc * 8192);
                    else { const int ib = pc - (A_LDS ? 0 : C::NA); GLDS16(pb[ib] + (kt + NS - 1) * 64, db_ + C::AB + ib * 8192); }
                }
            }
            __builtin_amdgcn_sched_barrier(0);
        }
        stg = stg + 1 == NS ? 0 : stg + 1; nstg = nstg + 1 == NS ? 0 : nstg + 1;
    }
    __syncthreads();
#undef GT_ISSUE
}
#define ACC_ROW(mi, r, fh) ((mi) * 32 + ((r) & 3) + 8 * ((r) >> 2) + 4 * (fh))

constexpr int EPI_SLAB = 32 * 68 * 4;
template <class F> DEV void epi_rows(const f32x16 (&acc)[2][2], char* smem, F f) {
    const int lane = TID() & 63, wave = TID() >> 6, fr = lane & 31, fh = lane >> 5;
    float* st = (float*)(smem + wave * EPI_SLAB);
    UNROLL for (int mi = 0; mi < 2; ++mi) {
        UNROLL for (int ni = 0; ni < 2; ++ni) UNROLL for (int r = 0; r < 16; ++r)
            st[((r & 3) + 8 * (r >> 2) + 4 * fh) * 68 + ni * 32 + fr] = acc[mi][ni][r];
        UNROLL for (int it = 0; it < 4; ++it) {
            const int row = it * 8 + (lane >> 3), c8 = (lane & 7) * 8;
            const float4 a = *(const float4*)(st + row * 68 + c8), b = *(const float4*)(st + row * 68 + c8 + 4);
            float v[8] = {a.x, a.y, a.z, a.w, b.x, b.y, b.z, b.w};
            f(mi * 32 + row, c8, v);
        }
    }
    __syncthreads();
}


template <class F> DEV void epi_cols(const f32x16 (&acc)[2][2], char* smem, F f) {
    const int lane = TID() & 63, wave = TID() >> 6, fr = lane & 31, fh = lane >> 5;
    float* st = (float*)(smem + wave * EPI_SLAB);
    UNROLL for (int mi = 0; mi < 2; ++mi) {
        UNROLL for (int ni = 0; ni < 2; ++ni) UNROLL for (int r = 0; r < 16; ++r)
            st[((r & 3) + 8 * (r >> 2) + 4 * fh) * 68 + ni * 32 + fr] = acc[mi][ni][r];
        UNROLL for (int it = 0; it < 4; ++it) {
            float v[8];
            UNROLL for (int i = 0; i < 8; ++i) v[i] = st[(it * 8 + i) * 68 + lane];
            f(mi * 32 + it * 8, lane, v);
        }
    }
    __syncthreads();
}

struct TileOrder {
    int x, nN, cx, total;
    DEV TileOrder(const Topo& tp, int nM, int nN_) { x = tp.x; nN = nN_; cx = nM > x ? (nM - x + 7) >> 3 : 0; total = ((cx + 3) >> 2) * 4 * nN; }
    DEV bool get(int q, int& pm, int& pn) const { const int per = 4 * nN, qi = q / per, rem = q - qi * per, i = 4 * qi + (rem & 3); pn = rem >> 2; pm = x + 8 * i; return i < cx; }
};
template <int WM, int WN, class Epi>
DEV void gemm_phase(const bf16_t* A, int lda, int M, const bf16_t* Bt, int ldb, int N, int K, char* smem, const Topo& tp, Epi epi) {
    typedef GC<WM, WN> C;
    const int nM = M / C::BM, nN = (N + C::BN - 1) / C::BN;
    const int wave = TID() >> 6, wm = wave / WN, wn = wave % WN;
    const TileOrder ord(tp, nM, nN);
    for (int q = tp.r; q < ord.total; q += tp.n) {
        int pm, pn; if (!ord.get(q, pm, pn)) continue;
        f32x16 acc[2][2]; acc_zero(acc);
        const bf16_t* Ab = A + (size_t)pm * C::BM * lda;
        gemm_tile<WM, WN, 3, false>(acc, [&](int r) { return Ab + (size_t)r * lda; }, Bt, ldb, pn * C::BN, N, K, smem, nullptr);
        epi(acc, pm * C::BM + wm * 64, pn * C::BN + wn * 64);
    }
}

namespace pg8 {
#define PG8_LAS __attribute__((address_space(3)))
typedef float f32x4 __attribute__((ext_vector_type(4)));
constexpr int BM = 256, BK = 64, HALF = 128, HTB = HALF * BK * 2  , STAGE_BYTES = 8 * HTB, NXCD = 8, WGM = 8;

__host__ __device__ __forceinline__ int lds_byte(int r, int c) { const int st = (r >> 4) * 2 + (c >> 5), rr = r & 15, cc = c & 31, ob = rr * 64 + cc * 2; return st * 1024 + (ob ^ (((ob >> 9) & 1) << 5)); }
__host__ __device__ __forceinline__ void stage_rc(int b, int& R, int& C) { const int st = b / 1024, sb = b % 1024, swz = sb ^ (((sb >> 9) & 1) << 5); R = (st >> 1) * 16 + swz / 64; C = (st & 1) * 32 + (swz % 64) / 2; }
__host__ __device__ __forceinline__ int perm32(int rho) { const int n = rho >> 4, i = rho & 15; return 8 * (i >> 2) + 4 * n + (i & 3); }

struct Unit { int pm, pn; };
struct Gemm { const bf16_t* A; const bf16_t* Bt; int M, N, K; };
template <class Epi, class Sched, bool ALIGN_EPI = false, bool SP2 = false>
__device__ __forceinline__ void gemm_phase(PG8_LAS unsigned char* lds, const Gemm g, const Sched& S, const Epi& E) {
    const int tid = TID(), wid = __builtin_amdgcn_readfirstlane(tid >> 6), lane = tid & 63, wr = wid >> 2, wc = wid & 3, fr = lane & 15, fq = lane >> 4;
    const int K = g.K, nt = K / BK;
    unsigned voffA[2], voffB[2];
#pragma unroll
    for (int i = 0; i < 2; ++i) { int R, C; stage_rc(tid * 16 + i * 8192, R, C); const int Rb = Epi::PERM ? ((R & ~31) + perm32(R & 31)) : R;
        voffA[i] = (unsigned)(R * K + C) * 2u; voffB[i] = (unsigned)(Rb * K + C) * 2u; }
    const size_t kstep = (size_t)(BK * 2);
    const size_t hstep = (size_t)HALF * K * 2;
    const size_t tstep = 2 * hstep;
    const unsigned ldsw = (unsigned)wid * 1024u;
    const int aoff = lds_byte(wr * 64 + fr, fq * 8), boff = lds_byte(wc * 32 + fr, fq * 8);
#define PG8_SA(b, h) (((b) * 2 + (h)) * HTB)
#define PG8_SB(b, h) ((4 + (b) * 2 + (h)) * HTB)
#define PG8_STAGE(bufoff, gbase, voff) do { _Pragma("unroll") for (int _i = 0; _i < 2; ++_i) \
        __builtin_amdgcn_global_load_lds((const unsigned*)((const char*)(gbase) + (voff)[_i]), (PG8_LAS unsigned*)(lds + (bufoff) + ldsw + _i * 8192), 16, 0, 0); } while (0)
#define PG8_LDA(dst, b, h) do { _Pragma("unroll") for (int m = 0; m < 4; ++m) _Pragma("unroll") for (int k = 0; k < 2; ++k) dst[m][k] = *(const PG8_LAS bf16x8*)(lds + PG8_SA(b, h) + aoff + m * 2048 + k * 1024); } while (0)
#define PG8_LDB(dst, b, h) do { _Pragma("unroll") for (int n = 0; n < 2; ++n) _Pragma("unroll") for (int k = 0; k < 2; ++k) dst[n][k] = *(const PG8_LAS bf16x8*)(lds + PG8_SB(b, h) + boff + n * 2048 + k * 1024); } while (0)
#define PG8_MMA(ai, bj, At, Bt) do { __builtin_amdgcn_s_setprio(1); _Pragma("unroll") for (int m = 0; m < 4; ++m) _Pragma("unroll") for (int n = 0; n < 2; ++n) _Pragma("unroll") for (int k = 0; k < 2; ++k) \
        acc[ai][bj][m][n] = __builtin_amdgcn_mfma_f32_16x16x32_bf16(Bt[n][k], At[m][k], acc[ai][bj][m][n], 0, 0, 0); __builtin_amdgcn_s_setprio(0); } while (0)
#define PG8_WAIT_V(n) asm volatile("s_waitcnt vmcnt(" #n ")" ::: "memory")
#define PG8_WAIT_L(n) asm volatile("s_waitcnt lgkmcnt(" #n ")" ::: "memory")
#define PG8_BAR __builtin_amdgcn_s_barrier()
#define PG8_SCHED __builtin_amdgcn_sched_barrier(0)
    Unit cur, nxt; int ui = 0;
    if (!S.next(0, cur)) return;
    f32x4 acc[2][2][4][2];
#pragma unroll
    for (int a = 0; a < 2; ++a)
#pragma unroll
        for (int b = 0; b < 2; ++b)
#pragma unroll
            for (int m = 0; m < 4; ++m)
#pragma unroll
                for (int n = 0; n < 2; ++n) acc[a][b][m][n] = (f32x4){0.f, 0.f, 0.f, 0.f};
    bf16x8 At[4][2], B0[2][2], B1[2][2];
    const char* cA = (const char*)g.A + (size_t)cur.pm * tstep; const char* cB = (const char*)g.Bt + (size_t)cur.pn * tstep;
    S.a_ready(cur);
    if constexpr (SP2) {
        PG8_STAGE(PG8_SB(0, 0), cB, voffB); PG8_STAGE(PG8_SB(0, 1), cB + hstep, voffB); PG8_STAGE(PG8_SA(0, 0), cA, voffA); PG8_STAGE(PG8_SA(0, 1), cA + hstep, voffA);
        if (wr == 1) PG8_BAR;
        PG8_WAIT_V(2); PG8_BAR;
        PG8_STAGE(PG8_SB(1, 0), cB + kstep, voffB); PG8_STAGE(PG8_SA(1, 0), cA + kstep, voffA); PG8_STAGE(PG8_SB(1, 1), cB + hstep + kstep, voffB);
        PG8_WAIT_V(6); PG8_BAR;
    } else {
        PG8_STAGE(PG8_SB(0, 0), cB, voffB); PG8_STAGE(PG8_SA(0, 0), cA, voffA); PG8_STAGE(PG8_SB(0, 1), cB + hstep, voffB); PG8_STAGE(PG8_SA(0, 1), cA + hstep, voffA);
        if (wr == 1) PG8_BAR;
        PG8_WAIT_V(4); PG8_BAR;
        PG8_STAGE(PG8_SB(1, 0), cB + kstep, voffB); PG8_STAGE(PG8_SA(1, 0), cA + kstep, voffA); PG8_STAGE(PG8_SB(1, 1), cB + hstep + kstep, voffB);
        PG8_WAIT_V(6); PG8_BAR;
    }
    for (;;) {
        const bool has_next = S.next(ui + 1, nxt);
        const char* nA = has_next ? (const char*)g.A + (size_t)nxt.pm * tstep : cA; const char* nB = has_next ? (const char*)g.Bt + (size_t)nxt.pn * tstep : cB;
        for (int t = 0; t < nt; t += 2) {
            const bool last = (t == nt - 2);
            const char* a1 = cA + (size_t)(t + 1) * kstep;
            const char* a2 = last ? nA : cA + (size_t)(t + 2) * kstep; const char* b2 = last ? nB : cB + (size_t)(t + 2) * kstep;
            const char* a3 = a2 + kstep; const char* b3 = b2 + kstep;
            if (last && has_next) S.a_ready(nxt);
            if constexpr (SP2) {
            PG8_LDB(B0, 0, 0); PG8_LDB(B1, 0, 1); PG8_SCHED; PG8_LDA(At, 0, 0); PG8_STAGE(PG8_SA(1, 1), a1 + hstep, voffA);
            PG8_WAIT_V(8); PG8_WAIT_L(0); PG8_BAR; PG8_MMA(0, 0, At, B0); PG8_MMA(0, 1, At, B1); PG8_BAR; PG8_SCHED;
            PG8_LDA(At, 0, 1); PG8_STAGE(PG8_SB(0, 0), b2, voffB); PG8_STAGE(PG8_SB(0, 1), b2 + hstep, voffB); PG8_STAGE(PG8_SA(0, 0), a2, voffA);
            PG8_WAIT_V(8); PG8_WAIT_L(0); PG8_BAR; PG8_MMA(1, 0, At, B0); PG8_MMA(1, 1, At, B1); PG8_BAR; PG8_SCHED;
            PG8_LDB(B0, 1, 0); PG8_LDB(B1, 1, 1); PG8_SCHED; PG8_LDA(At, 1, 0); PG8_STAGE(PG8_SA(0, 1), a2 + hstep, voffA);
            PG8_WAIT_V(8); PG8_WAIT_L(0); PG8_BAR; PG8_MMA(0, 0, At, B0); PG8_MMA(0, 1, At, B1); PG8_BAR; PG8_SCHED;
            PG8_LDA(At, 1, 1); PG8_STAGE(PG8_SB(1, 0), b3, voffB); PG8_STAGE(PG8_SB(1, 1), b3 + hstep, voffB); PG8_STAGE(PG8_SA(1, 0), a3, voffA);
            PG8_WAIT_V(8); PG8_WAIT_L(0); PG8_BAR; PG8_MMA(1, 0, At, B0); PG8_MMA(1, 1, At, B1); PG8_BAR; PG8_SCHED;
            } else {
            PG8_LDB(B0, 0, 0); PG8_SCHED; PG8_LDA(At, 0, 0); PG8_STAGE(PG8_SA(1, 1), a1 + hstep, voffA);
            PG8_WAIT_L(8); PG8_BAR; PG8_WAIT_L(0); PG8_MMA(0, 0, At, B0); PG8_BAR; PG8_SCHED;
            PG8_LDB(B1, 0, 1); PG8_STAGE(PG8_SB(0, 0), b2, voffB);
            PG8_BAR; PG8_WAIT_L(0); PG8_MMA(0, 1, At, B1); PG8_BAR;
            PG8_LDA(At, 0, 1); PG8_STAGE(PG8_SA(0, 0), a2, voffA);
            PG8_BAR; PG8_WAIT_L(0); PG8_MMA(1, 0, At, B0); PG8_BAR; PG8_SCHED;
            PG8_STAGE(PG8_SB(0, 1), b2 + hstep, voffB);
            PG8_WAIT_V(6); PG8_BAR; PG8_MMA(1, 1, At, B1); PG8_BAR;
            PG8_LDB(B0, 1, 0); PG8_SCHED; PG8_LDA(At, 1, 0); PG8_STAGE(PG8_SA(0, 1), a2 + hstep, voffA);
            PG8_WAIT_L(8); PG8_BAR; PG8_WAIT_L(0); PG8_MMA(0, 0, At, B0); PG8_BAR; PG8_SCHED;
            PG8_LDB(B1, 1, 1); PG8_STAGE(PG8_SB(1, 0), b3, voffB);
            PG8_BAR; PG8_WAIT_L(0); PG8_MMA(0, 1, At, B1); PG8_BAR;
            PG8_LDA(At, 1, 1); PG8_STAGE(PG8_SA(1, 0), a3, voffA);
            PG8_BAR; PG8_WAIT_L(0); PG8_MMA(1, 0, At, B0); PG8_BAR; PG8_SCHED;
            PG8_STAGE(PG8_SB(1, 1), b3 + hstep, voffB);
            PG8_WAIT_V(6); PG8_BAR; PG8_MMA(1, 1, At, B1); PG8_BAR;
            }
        }
        if constexpr (ALIGN_EPI) { if (wr == 0) PG8_BAR; }
        if constexpr (!Epi::AFTER_DRAIN) { E(acc, cur, wr, wc, fr, fq); S.done(cur); }
        if (!has_next) break;
#pragma unroll
        for (int a = 0; a < 2; ++a)
#pragma unroll
            for (int b = 0; b < 2; ++b)
#pragma unroll
                for (int m = 0; m < 4; ++m)
#pragma unroll
                    for (int n = 0; n < 2; ++n) acc[a][b][m][n] = (f32x4){0.f, 0.f, 0.f, 0.f};
        cur = nxt; cA = nA; cB = nB; ++ui;
        if constexpr (ALIGN_EPI) { if (wr == 1) PG8_BAR; }
    }
    PG8_WAIT_V(0);
    if constexpr (!ALIGN_EPI) { if (wr == 0) PG8_BAR; }
    PG8_BAR;
    if constexpr (Epi::AFTER_DRAIN) { E.fused(acc, cur, wr, wc, fr, fq, lds, wid, lane); S.done(cur); }
#undef PG8_SA
#undef PG8_SB
#undef PG8_STAGE
#undef PG8_LDA
#undef PG8_LDB
#undef PG8_MMA
#undef PG8_WAIT_V
#undef PG8_WAIT_L
#undef PG8_BAR
#undef PG8_SCHED
}
}
template <class F> struct EpiF {
    static constexpr bool PERM = true, AFTER_DRAIN = false; F f;
    DEV void operator()(const pg8::f32x4 (&acc)[2][2][4][2], const pg8::Unit& u, int wr, int wc, int fr, int fq) const {
        UNROLL for (int ai = 0; ai < 2; ++ai) UNROLL for (int m = 0; m < 4; ++m) {
            const int row = u.pm * 256 + ai * 128 + wr * 64 + m * 16 + fr;
            UNROLL for (int bj = 0; bj < 2; ++bj) {
                const int col = u.pn * 256 + bj * 128 + wc * 32 + 8 * fq;
                const float v[8] = {acc[ai][bj][m][0][0], acc[ai][bj][m][0][1], acc[ai][bj][m][0][2], acc[ai][bj][m][0][3],
                                    acc[ai][bj][m][1][0], acc[ai][bj][m][1][1], acc[ai][bj][m][1][2], acc[ai][bj][m][1][3]};
                f(row, col, v);
            }
        }
    }
};
template <class F> struct EpiF2 {
    static constexpr bool PERM = true, AFTER_DRAIN = false; F f;
    DEV void operator()(const pg8::f32x4 (&acc)[2][2][4][2], const pg8::Unit& u, int wr, int wc, int fr, int fq) const {
        UNROLL for (int ai = 0; ai < 2; ++ai) UNROLL for (int m = 0; m < 4; ++m) {
            const int row = u.pm * 256 + ai * 128 + wr * 64 + m * 16 + fr, col = u.pn * 256 + wc * 32 + 8 * fq;
            const float v0[8] = {acc[ai][0][m][0][0], acc[ai][0][m][0][1], acc[ai][0][m][0][2], acc[ai][0][m][0][3], acc[ai][0][m][1][0], acc[ai][0][m][1][1], acc[ai][0][m][1][2], acc[ai][0][m][1][3]};
            const float v1[8] = {acc[ai][1][m][0][0], acc[ai][1][m][0][1], acc[ai][1][m][0][2], acc[ai][1][m][0][3], acc[ai][1][m][1][0], acc[ai][1][m][1][1], acc[ai][1][m][1][2], acc[ai][1][m][1][3]};
            f(row, col, v0, v1);
        }
    }
};
struct XOrder {
    int x, r, n, nN, cx, fullq, total;
    DEV XOrder(const Topo& tp, int nM, int nN_) { x = tp.x; r = tp.r; n = tp.n; nN = nN_; cx = nM > x ? (nM - x + 7) >> 3 : 0; fullq = cx >> 2; total = cx * nN; }
    DEV bool next(int i, pg8::Unit& u) const {
        const int q = r + i * n; if (q >= total) return false;
        const int per = 4 * nN;
        if (q < fullq * per) { const int qi = q / per, rem = q - qi * per; u.pn = rem >> 2; u.pm = x + 8 * (4 * qi + (rem & 3)); }
        else { const int rem = q - fullq * per, cq = cx - 4 * fullq; u.pn = rem / cq; u.pm = x + 8 * (4 * fullq + rem % cq); }
        return true;
    }
    DEV void a_ready(const pg8::Unit&) const {}
    DEV void done(const pg8::Unit&) const {}
};
template <class F> DEV void gemm256_pair(const bf16_t* A, int M, const bf16_t* Bt, int N, int K, char* smem, const Topo& tp, F f) {
    const pg8::Gemm g{A, Bt, M, N, K};
    const XOrder S(tp, M / 256, (N + 255) / 256);
    const EpiF2<F> E{f};
    pg8::gemm_phase<EpiF2<F>, XOrder, true, true>((PG8_LAS unsigned char*)smem, g, S, E);
}
template <class F> DEV void gemm256(const bf16_t* A, int M, const bf16_t* Bt, int N, int K, char* smem, const Topo& tp, F f) {
    const pg8::Gemm g{A, Bt, M, N, K};
    const XOrder S(tp, M / 256, (N + 255) / 256);
    const EpiF<F> E{f};
    pg8::gemm_phase<EpiF<F>, XOrder, true, true>((PG8_LAS unsigned char*)smem, g, S, E);
}

DEV void ph_mod(const Params& p, int L, char* smem) {
    const int tid = TID();
    float* sc = (float*)smem;
    float* red = sc + 17 * 1024;
    const float* c = p.in[I_C]; const float* cc = p.in[I_CCTX];
    for (int i = tid; i < 17 * 1024; i += NTHREADS) { const float v = i < 16 * 1024 ? c[i] : cc[i - 16 * 1024]; sc[i] = v / (1.f + expf(-v)); }
    __syncthreads();
    const float* W = p.in[I_WADA] + (size_t)L * 1024 * 6144; const float* bA = p.in[I_BADA] + (size_t)L * 6144;
    float* MOD = (float*)(p.ws + OFF_MOD);
    for (int u = blockIdx.x; u < 192; u += gridDim.x) {
        const int ci = tid & 31, ks = tid >> 5, j = u * 32 + ci;
        float acc[17];
        UNROLL for (int r = 0; r < 17; ++r) acc[r] = 0.f;
        for (int k = ks * 64; k < ks * 64 + 64; ++k) {
            const float w = W[(size_t)k * 6144 + j];
            UNROLL for (int r = 0; r < 17; ++r) acc[r] += sc[r * 1024 + k] * w;
        }
        UNROLL for (int r = 0; r < 17; ++r) red[(ks * 17 + r) * 32 + ci] = acc[r];
        __syncthreads();
        for (int i = tid; i < 17 * 32; i += NTHREADS) {
            const int r = i >> 5, c2 = i & 31; float s = bA[u * 32 + c2];
            for (int k2 = 0; k2 < 16; ++k2) s += red[(k2 * 17 + r) * 32 + c2];
            MOD[r * 6144 + u * 32 + c2] = s;
        }
        __syncthreads();
    }
}
DEV void conv_job(const float* s0, const float* s1, bf16_t* d, int K, int N, int mode, int nmat, size_t sstride, size_t dstride, char* smem) {
    float* tile = (float*)smem;
    const int tid = TID();
    const int tK = K / 64, tN = (mode == 1 || mode == 3) ? (2 * N) / 64 : (N + 63) / 64, per = tK * tN;
    for (int t = blockIdx.x; t < per * nmat; t += gridDim.x) {
        const int mat = t / per, r = t % per, tk = r / tN, tn = r % tN;
        const float* a0 = s0 + (size_t)mat * sstride; const float* a1 = s1 ? s1 + (size_t)mat * sstride : nullptr;
        bf16_t* dd = d + (size_t)mat * dstride;
        UNROLL for (int i = 0; i < 8; ++i) {
            const int cc = tid & 63, k = (tid >> 6) + 8 * i; float v;
            if (mode == 1) { const float* s = (cc >> 5) ? a1 : a0; v = s[(size_t)(tk * 64 + k) * N + tn * 32 + (cc & 31)]; }
            else if (mode == 3) { const float* s = ((tn >> 1) & 1) ? a1 : a0; v = s[(size_t)(tk * 64 + k) * N + (tn >> 2) * 128 + (tn & 1) * 64 + cc]; }
            else { const int n = tn * 64 + cc; v = n < N ? a0[(size_t)(tk * 64 + k) * N + n] : 0.f; }
            tile[k * 65 + cc] = v;
        }
        __syncthreads();
        UNROLL for (int i = 0; i < 8; ++i) {
            const int k = tid & 63, cc = (tid >> 6) + 8 * i; const int row = tn * 64 + cc;
            const float v = tile[k * 65 + cc];
            if (mode == 1 || mode == 3 || row < N) {
                const bf16_t hi = f2bf(v);
                dd[(size_t)row * K + tk * 64 + k] = hi;
                if (mode == 2) dd[(size_t)N * K + (size_t)row * K + tk * 64 + k] = f2bf(v - bf2f(hi));
            }
        }
        __syncthreads();
    }
}
DEV void ph_conv_mix(const Params& p, int L, char* smem) {
    char* ws = p.ws;
    conv_job(p.in[I_WIN] + (size_t)L * 1024 * IN_COLS, nullptr, (bf16_t*)(ws + OFF_WINT), 1024, IN_COLS, 0, 1, 0, 0, smem);
    conv_job(p.in[I_WBR] + (size_t)L * 3 * 512 * 1024, nullptr, (bf16_t*)(ws + OFF_WBT), 512, 1024, 0, 3, (size_t)512 * 1024, (size_t)512 * 1024, smem);
    conv_job(p.in[I_WOUT] + (size_t)L * 1024 * 1024, nullptr, (bf16_t*)(ws + OFF_WOUTT), 1024, 1024, 0, 1, 0, 0, smem);
    conv_job(p.in[I_SG] + (size_t)L * 1024 * 256, p.in[I_SU] + (size_t)L * 1024 * 256, (bf16_t*)(ws + OFF_SGUT), 1024, 256, 3, 1, 0, 0, smem);
    conv_job(p.in[I_SD] + (size_t)L * 256 * 1024, nullptr, (bf16_t*)(ws + OFF_SDT), 256, 1024, 0, 1, 0, 0, smem);
    conv_job(p.in[I_G2] + (size_t)L * 128 * 512, nullptr, (bf16_t*)(ws + OFF_G2T), 128, 512, 0, 1, 0, 0, smem);
    conv_job(p.in[I_RTR] + (size_t)L * 1024 * 64, nullptr, (bf16_t*)(ws + OFF_RTR), 1024, 64, 2, 1, 0, 0, smem);
}
DEV void ph_conv_moe(const Params& p, int L, char* smem) {
    char* ws = p.ws;
    const size_t eo = (size_t)L * 64 * 1024 * 128;
    conv_job(p.in[I_MWG] + eo, p.in[I_MWU] + eo, (bf16_t*)(ws + OFF_MGU), 1024, 128, 1, 64, (size_t)1024 * 128, (size_t)256 * 1024, smem);
    conv_job(p.in[I_MWD] + eo, nullptr, (bf16_t*)(ws + OFF_MDT), 128, 1024, 0, 64, (size_t)128 * 1024, (size_t)1024 * 128, smem);
}

DEV void ph_norm(const Params& p, int L, int which, int ntok) {
    const int lane = TID() & 63, wave = TID() >> 6;
    const float* MOD = (const float*)(p.ws + OFF_MOD);
    const float* g = p.in[which ? I_N2G : I_N1G] + (size_t)L * DM;
    bf16_t* H = (bf16_t*)(p.ws + OFF_HX); bf16_t* HLO = (bf16_t*)(p.ws + OFF_H2LO);
    for (int n0 = blockIdx.x * 8; n0 < ntok; n0 += gridDim.x * 8) {
        const int n = n0 + wave;
        const float* xr = which ? xs_row(p, n) : xprev_row(p, L, n);
        float4 v[4]; float ss = 0.f;
        UNROLL for (int i = 0; i < 4; ++i) { v[i] = *(const float4*)(xr + i * 256 + lane * 4); ss += v[i].x * v[i].x + v[i].y * v[i].y + v[i].z * v[i].z + v[i].w * v[i].w; }
        UNROLL for (int o = 1; o < 64; o <<= 1) ss += __shfl_xor(ss, o);
        const float rstd = rsqrtf(ss * (1.f / DM) + 1e-6f);
        const float* sh = MOD + mod_row(n) * 6144 + (which ? 3 : 0) * DM; const float* sc = sh + DM;
        UNROLL for (int i = 0; i < 4; ++i) {
            const int c = i * 256 + lane * 4;
            const float4 gg = *(const float4*)(g + c), s1 = *(const float4*)(sc + c), s0 = *(const float4*)(sh + c);
            const float h0 = v[i].x * rstd * gg.x * (1.f + s1.x) + s0.x, h1 = v[i].y * rstd * gg.y * (1.f + s1.y) + s0.y;
            const float h2 = v[i].z * rstd * gg.z * (1.f + s1.z) + s0.z, h3 = v[i].w * rstd * gg.w * (1.f + s1.w) + s0.w;
            u32x2 o; o.x = pk2(h0, h1); o.y = pk2(h2, h3);
            *(u32x2*)(H + (size_t)n * DM + c) = o;
            if (which) {
                u32x2 o2;
                o2.x = pk2(h0 - bf2f((bf16_t)(o.x & 0xffff)), h1 - bf2f((bf16_t)(o.x >> 16)));
                o2.y = pk2(h2 - bf2f((bf16_t)(o.y & 0xffff)), h3 - bf2f((bf16_t)(o.y >> 16)));
                *(u32x2*)(HLO + (size_t)n * DM + c) = o2;
            }
        }
    }
}

DEV void ph_rw_prep(const Params& p, int L, char* smem) {
    const int lane = TID() & 63, wave = TID() >> 6;
    float* vsh = (float*)smem + wave * 512;
    const bf16_t* PXR = (const bf16_t*)(p.ws + OFF_PX); bf16_t* VF = (bf16_t*)(p.ws + OFF_VF);
    const float* mu = p.in[I_MU] + (size_t)L * RW_COLS;
    const float* v0 = p.in[I_V0]; const float* v1 = p.in[I_V1]; const float* v2 = p.in[I_V2];
    for (int n0 = blockIdx.x * 8; n0 < NT; n0 += gridDim.x * 8) {
        const int n = n0 + wave; int nb, tt, T; seq_of(n, nb, tt, T);
        float vs[8]; shift8(PXR, RW_COLS, nb, tt, T, 1024 + lane * 8, mu, vs);
        if (L == 0) { st8(VF + (size_t)n * 512 + lane * 8, vs); }
        else {
            UNROLL for (int i = 0; i < 8; ++i) vsh[lane * 8 + i] = vs[i];
            __syncthreads();
            const int q = lane & 31, hf = lane >> 5; float t1 = 0.f;
            for (int jj = 0; jj < 256; ++jj) t1 += vsh[hf * 256 + jj] * v1[(hf * 256 + jj) * 32 + q];
            t1 += __shfl_xor(t1, 32);
            float u[8];
            UNROLL for (int i = 0; i < 8; ++i) u[i] = v0[lane * 8 + i];
            for (int q2 = 0; q2 < 32; ++q2) { const float tq = __shfl(t1, q2); UNROLL for (int i = 0; i < 8; ++i) u[i] += tq * v2[q2 * 512 + lane * 8 + i]; }
            float vf[8], o[8]; ld8(VF + (size_t)n * 512 + lane * 8, vf);
            UNROLL for (int i = 0; i < 8; ++i) o[i] = vs[i] + (vf[i] - vs[i]) * sigm(u[i]);
            st8(VF + (size_t)n * 512 + lane * 8, o);
            __syncthreads();
        }
    }
}

DEV bf16x8 pk_lohi(u32x2 lo, u32x2 hi) { u32x4 w; w.x = lo.x; w.y = lo.y; w.z = hi.x; w.w = hi.y; return __builtin_bit_cast(bf16x8, w); }
DEV bf16x8 pk_acc2(const f32x4v& a, const f32x4v& b) { u32x4 w; w.x = pk2(a[0], a[1]); w.y = pk2(a[2], a[3]); w.z = pk2(b[0], b[1]); w.w = pk2(b[2], b[3]); return __builtin_bit_cast(bf16x8, w); }
DEV bf16x8 pk_acc1(const f32x4v& a) { u32x4 w; w.x = pk2(a[0], a[1]); w.y = pk2(a[2], a[3]); w.z = 0u; w.w = 0u; return __builtin_bit_cast(bf16x8, w); }
#define MFMA16(a, b, c) __builtin_amdgcn_mfma_f32_16x16x32_bf16((a), (b), (c), 0, 0, 0)
DEV void ph_rw_scan(const Params& p, int L, char* smem) {
    const int tid = TID();
    const int wave = __builtin_amdgcn_readfirstlane(tid >> 6);
    char* AT = smem; char* BT = smem + 9216; char* KT = smem + 18432; char* RT = smem + 27648;
    char* BH = smem + 36864; char* KH = smem + 46080; char* VT = smem + 55296;
    char* W2T = smem + 64512; char* A2T = smem + 73728;
    float* PCv = (float*)(smem + 82944); float* SEGT = PCv + 64;
    char* XY = smem + 85248;
    char* T1 = XY; char* T2 = XY + 9216; float* WLf = (float*)(XY + 18432); float* ALf = (float*)(XY + 35840); float* LW = (float*)(XY + 53248);
    char* NAB = XY; char* NAK = XY + 9216; char* NRB = XY + 18432; char* NRK = XY + 27648; char* TJ = XY + 36864; float* NDF = (float*)(XY + 38912); float* YO = (float*)(XY + 43008);
    const bf16_t* PXR = (const bf16_t*)(p.ws + OFF_PX); const bf16_t* VF = (const bf16_t*)(p.ws + OFF_VF);
    bf16_t* YS = (bf16_t*)(p.ws + OFF_YS); float* CB = (float*)(p.ws + OFF_CB);
    const float* mu = p.in[I_MU] + (size_t)L * RW_COLS;
    const float* w0 = p.in[I_W0] + (size_t)L * 1024; const float* w2 = p.in[I_W2] + (size_t)L * 65536;
    const float* a0 = p.in[I_A0] + (size_t)L * 1024; const float* a2 = p.in[I_A2] + (size_t)L * 65536;
    const float* kkw = p.in[I_KK] + (size_t)L * 512; const float* kaw = p.in[I_KA] + (size_t)L * 512; const float* rkw = p.in[I_RK] + (size_t)L * 512;
    for (int u = blockIdx.x; u < 256; u += gridDim.x) {
        const int b = u >> 4, h = (u >> 1) & 7, d = u & 1;
        for (int i = tid; i < 4096; i += NTHREADS) {
            const int l = i >> 6, n = i & 63;
            *(bf16_t*)(W2T + n * LROW + l * 2) = f2bf(w2[(size_t)(d * 64 + l) * 512 + h * 64 + n]);
            *(bf16_t*)(A2T + n * LROW + l * 2) = f2bf(a2[(size_t)(d * 64 + l) * 512 + h * 64 + n]);
        }
        f32x4v sacc[4];
        UNROLL for (int i = 0; i < 4; ++i) sacc[i] = (f32x4v){0.f, 0.f, 0.f, 0.f};
        __syncthreads();
        for (int ci = 0; ci < 36; ++ci) {
            int tido = tid; asm volatile("" : "+v"(tido));
            const int lane = tido & 63, lq = lane & 15, kg = lane >> 4, ti = tido >> 3, j = tido & 7;
            const int ch = h * 64 + 8 * j;
            const bool isc = ci < 4; const int T = isc ? CTXL : SEQ, cc = isc ? ci : ci - 4;
            const int t0 = d == 0 ? cc * 64 : T - 64 * (cc + 1), nb = isc ? NX + b * CTXL : b * SEQ;
            const int tt = d == 0 ? t0 + ti : t0 + 63 - ti;
            float r8[8], k8[8], v8[8];
            {
                float x1[8], x2[8];
                shift8(PXR, RW_COLS, nb, tt, T, 1536 + d * 64 + 8 * j, mu, x1);
                shift8(PXR, RW_COLS, nb, tt, T, 1664 + d * 64 + 8 * j, mu, x2);
                UNROLL for (int i = 0; i < 8; ++i) x1[i] = tanh_fast(x1[i]);
                st8((bf16_t*)(T1 + ti * LROW) + 8 * j, x1); st8((bf16_t*)(T2 + ti * LROW) + 8 * j, x2);
                shift8(PXR, RW_COLS, nb, tt, T, h * 64 + 8 * j, mu, r8);
                shift8(PXR, RW_COLS, nb, tt, T, 512 + h * 64 + 8 * j, mu, k8);
                ld8(VF + (size_t)(nb + tt) * 512 + ch, v8);
            }
            __syncthreads();
            UNROLL for (int rep = 0; rep < 4; ++rep) {
                const int q = wave + 8 * rep, m = q >> 4, tl = q & 15, tt4 = tl >> 2, nt4 = tl & 3;
                const char* Ab = (m ? T2 : T1) + (16 * tt4 + lq) * LROW + kg * 16; const char* Bb = (m ? A2T : W2T) + (16 * nt4 + lq) * LROW + kg * 16;
                f32x4v a = {0.f, 0.f, 0.f, 0.f};
                UNROLL for (int ks = 0; ks < 2; ++ks) a = MFMA16(*(const bf16x8*)(Ab + ks * 64), *(const bf16x8*)(Bb + ks * 64), a);
                float* dst = (m ? ALf : WLf) + (16 * tt4 + 4 * kg) * 68 + 16 * nt4 + lq;
                UNROLL for (int i = 0; i < 4; ++i) dst[i * 68] = a[i];
            }
            __syncthreads();
            float av[8], bv[8], kd8[8];
            {
                const float4 wa = *(const float4*)(WLf + ti * 68 + 8 * j), wb = *(const float4*)(WLf + ti * 68 + 8 * j + 4);
                const float4 aa = *(const float4*)(ALf + ti * 68 + 8 * j), ab = *(const float4*)(ALf + ti * 68 + 8 * j + 4);
                const float wl[8] = {wa.x, wa.y, wa.z, wa.w, wb.x, wb.y, wb.z, wb.w}, al[8] = {aa.x, aa.y, aa.z, aa.w, ab.x, ab.y, ab.z, ab.w};
                float ss = 0.f, cbp = 0.f, alpha[8], kkr[8], lw[8];
                UNROLL for (int i = 0; i < 8; ++i) {
                    const float xw = -(w0[d * 512 + ch + i] + wl[i]);
                    const float sp = softplus_fast(xw);
                    lw[i] = -__expf(-sp - 0.5f);
                    alpha[i] = sigm(a0[d * 512 + ch + i] + al[i]);
                    kkr[i] = k8[i] * kkw[ch + i]; ss += kkr[i] * kkr[i];
                    kd8[i] = k8[i] * (1.f + (alpha[i] - 1.f) * kaw[ch + i]);
                    cbp += r8[i] * kd8[i] * rkw[ch + i];
                }
                ss = sum8(ss); cbp = sum8(cbp);
                const float inv = 1.f / fmaxf(sqrtf(ss), 1e-12f);
                UNROLL for (int i = 0; i < 8; ++i) { const float kk = kkr[i] * inv; av[i] = -kk; bv[i] = kk * alpha[i]; }
                *(float4*)(LW + ti * 64 + 8 * j) = make_float4(lw[0], lw[1], lw[2], lw[3]); *(float4*)(LW + ti * 64 + 8 * j + 4) = make_float4(lw[4], lw[5], lw[6], lw[7]);
                if (j == 0) CB[((size_t)d * NT + nb + tt) * 8 + h] = cbp;
            }
            __syncthreads();
            {
                const int n = tid & 63, seg = tid >> 6; float run = 0.f;
                UNROLL for (int r = 0; r < 8; ++r) { run += LW[(seg * 8 + r) * 64 + n]; LW[(seg * 8 + r) * 64 + n] = run; }
                SEGT[seg * 64 + n] = run;
            }
            __syncthreads();
            {
                const int seg = ti >> 3;
                float off[8], tot[8];
                UNROLL for (int i = 0; i < 8; ++i) { off[i] = 0.f; tot[i] = 0.f; }
                UNROLL for (int s2 = 0; s2 < 8; ++s2) {
                    const float4 sa = *(const float4*)(SEGT + s2 * 64 + 8 * j), sb2 = *(const float4*)(SEGT + s2 * 64 + 8 * j + 4);
                    const float sv[8] = {sa.x, sa.y, sa.z, sa.w, sb2.x, sb2.y, sb2.z, sb2.w};
                    UNROLL for (int i = 0; i < 8; ++i) { tot[i] += sv[i]; if (s2 < seg) off[i] += sv[i]; }
                }
                const float4 la = *(const float4*)(LW + ti * 64 + 8 * j), lb = *(const float4*)(LW + ti * 64 + 8 * j + 4);
                const float lpl[8] = {la.x, la.y, la.z, la.w, lb.x, lb.y, lb.z, lb.w};
                float lpm[8];
                if ((ti & 7) != 0) {
                    const float4 ma = *(const float4*)(LW + (ti - 1) * 64 + 8 * j), mb = *(const float4*)(LW + (ti - 1) * 64 + 8 * j + 4);
                    lpm[0] = ma.x; lpm[1] = ma.y; lpm[2] = ma.z; lpm[3] = ma.w; lpm[4] = mb.x; lpm[5] = mb.y; lpm[6] = mb.z; lpm[7] = mb.w;
                } else { UNROLL for (int i = 0; i < 8; ++i) lpm[i] = 0.f; }
                float oa[8], ob[8], ok[8], orr[8];
                UNROLL for (int i = 0; i < 8; ++i) {
                    const float lp = lpl[i] + off[i], lm = lpm[i] + off[i];
                    const float eP = __expf(lp), eM = __expf(-lp), ePm = __expf(lm), eE = __expf(tot[i] - lp);
                    oa[i] = av[i] * ePm; ob[i] = bv[i] * eM; ok[i] = kd8[i] * eM; orr[i] = r8[i] * eP;
                    *(bf16_t*)(BH + (8 * j + i) * LROW + ti * 2) = f2bf(bv[i] * eE);
                    *(bf16_t*)(KH + (8 * j + i) * LROW + ti * 2) = f2bf(kd8[i] * eE);
                    *(bf16_t*)(VT + (8 * j + i) * LROW + ti * 2) = f2bf(v8[i]);
                    if (ti == 0) PCv[8 * j + i] = __expf(tot[i]);
                }
                st8((bf16_t*)(AT + ti * LROW) + 8 * j, oa); st8((bf16_t*)(BT + ti * LROW) + 8 * j, ob);
                st8((bf16_t*)(KT + ti * LROW) + 8 * j, ok); st8((bf16_t*)(RT + ti * LROW) + 8 * j, orr);
            }
            __syncthreads();
            UNROLL for (int rep = 0; rep < 8; ++rep) {
                const int q = wave + 8 * rep, m = q >> 4, tl = q & 15, tt4 = tl >> 2, st4 = tl & 3;
                char* dstm = m == 0 ? NAB : m == 1 ? NAK : m == 2 ? NRB : NRK;
                f32x4v a = {0.f, 0.f, 0.f, 0.f};
                if (st4 <= tt4) {
                    const char* Ab = (m < 2 ? AT : RT) + (16 * tt4 + lq) * LROW + kg * 16; const char* Bb = ((m & 1) ? KT : BT) + (16 * st4 + lq) * LROW + kg * 16;
                    UNROLL for (int ks = 0; ks < 2; ++ks) a = MFMA16(*(const bf16x8*)(Ab + ks * 64), *(const bf16x8*)(Bb + ks * 64), a);
                }
                const int sidx = 16 * st4 + lq;
                UNROLL for (int i = 0; i < 4; ++i) {
                    const int tidx = 16 * tt4 + 4 * kg + i;
                    const bool keep = m < 2 ? sidx < tidx : sidx <= tidx;
                    const float val = keep ? a[i] : 0.f;
                    *(bf16_t*)(dstm + tidx * LROW + sidx * 2) = f2bf(val);
                    if (m == 0 && st4 == tt4) NDF[(tt4 * 16 + 4 * kg + i) * 16 + lq] = val;
                }
            }
            __syncthreads();
            f32x4v xacc[4], yacc[4];
            bf16x8 vt[2];
            if (wave == 7) {
                const int blk = lane >> 4, c = lane & 15;
                float Tc[16];
                UNROLL for (int t = 0; t < 16; ++t) {
                    float a = t == c ? 1.f : 0.f;
                    UNROLL for (int s2 = 0; s2 < t; ++s2) a += NDF[(blk * 16 + t) * 16 + s2] * Tc[s2];
                    Tc[t] = a;
                }
                UNROLL for (int t = 0; t < 16; ++t) *(bf16_t*)(TJ + (blk * 16 + t) * 32 + c * 2) = f2bf(Tc[t]);
            } else if (wave < 4) {
                bf16x8 sb[2];
                UNROLL for (int kk = 0; kk < 2; ++kk) { sb[kk] = pk_acc2(sacc[2 * kk], sacc[2 * kk + 1]); vt[kk] = *(const bf16x8*)(VT + (16 * wave + lq) * LROW + kk * 64 + kg * 16); }
                UNROLL for (int t4 = 0; t4 < 4; ++t4) {
                    f32x4v x = {0.f, 0.f, 0.f, 0.f}, y = {0.f, 0.f, 0.f, 0.f};
                    UNROLL for (int kk = 0; kk < 2; ++kk) {
                        const char* pa = AT + (16 * t4 + lq) * LROW + (32 * kk + 4 * kg) * 2; const char* pr = RT + (16 * t4 + lq) * LROW + (32 * kk + 4 * kg) * 2;
                        x = MFMA16(pk_lohi(*(const u32x2*)pa, *(const u32x2*)(pa + 32)), sb[kk], x);
                        y = MFMA16(pk_lohi(*(const u32x2*)pr, *(const u32x2*)(pr + 32)), sb[kk], y);
                        if (2 * kk <= t4) {
                            x = MFMA16(*(const bf16x8*)(NAK + (16 * t4 + lq) * LROW + kk * 64 + kg * 16), vt[kk], x);
                            y = MFMA16(*(const bf16x8*)(NRK + (16 * t4 + lq) * LROW + kk * 64 + kg * 16), vt[kk], y);
                        }
                    }
                    xacc[t4] = x; yacc[t4] = y;
                }
            }
            __syncthreads();
            if (wave < 4) {
                const u32x2 z2 = {0u, 0u};
                f32x4v uacc[4];
                {
                    const u32x2 t0v = *(const u32x2*)(TJ + (0 * 16 + lq) * 32 + 4 * kg * 2);
                    uacc[0] = MFMA16(pk_lohi(t0v, z2), pk_acc1(xacc[0]), ((f32x4v){0.f, 0.f, 0.f, 0.f}));
                }
                UNROLL for (int jb = 1; jb < 4; ++jb) {
                    f32x4v z = xacc[jb];
                    const char* nr = NAB + (16 * jb + lq) * LROW + 4 * kg * 2;
                    if (jb == 1) z = MFMA16(pk_lohi(*(const u32x2*)nr, z2), pk_acc1(uacc[0]), z);
                    else {
                        z = MFMA16(pk_lohi(*(const u32x2*)nr, *(const u32x2*)(nr + 32)), pk_acc2(uacc[0], uacc[1]), z);
                        if (jb == 3) z = MFMA16(pk_lohi(*(const u32x2*)(nr + 64), z2), pk_acc1(uacc[2]), z);
                    }
                    const u32x2 tv = *(const u32x2*)(TJ + (jb * 16 + lq) * 32 + 4 * kg * 2);
                    uacc[jb] = MFMA16(pk_lohi(tv, z2), pk_acc1(z), ((f32x4v){0.f, 0.f, 0.f, 0.f}));
                }
                bf16x8 ub[2]; ub[0] = pk_acc2(uacc[0], uacc[1]); ub[1] = pk_acc2(uacc[2], uacc[3]);
                UNROLL for (int t4 = 0; t4 < 4; ++t4) {
                    f32x4v y = yacc[t4];
                    UNROLL for (int kk = 0; kk < 2; ++kk) if (2 * kk <= t4) {
                        const char* pn = NRB + (16 * t4 + lq) * LROW + (32 * kk + 4 * kg) * 2;
                        y = MFMA16(pk_lohi(*(const u32x2*)pn, *(const u32x2*)(pn + 32)), ub[kk], y);
                    }
                    UNROLL for (int i = 0; i < 4; ++i) YO[(16 * t4 + 4 * kg + i) * 68 + 16 * wave + lq] = y[i];
                }
                UNROLL for (int kt = 0; kt < 4; ++kt) {
                    f32x4v sv = sacc[kt];
                    UNROLL for (int i = 0; i < 4; ++i) sv[i] *= PCv[16 * kt + 4 * kg + i];
                    UNROLL for (int kk = 0; kk < 2; ++kk) {
                        const char* pb = BH + (16 * kt + lq) * LROW + (32 * kk + 4 * kg) * 2;
                        sv = MFMA16(pk_lohi(*(const u32x2*)pb, *(const u32x2*)(pb + 32)), ub[kk], sv);
                        sv = MFMA16(*(const bf16x8*)(KH + (16 * kt + lq) * LROW + kk * 64 + kg * 16), vt[kk], sv);
                    }
                    sacc[kt] = sv;
                }
            }
            __syncthreads();
            {
                const float4 ya = *(const float4*)(YO + ti * 68 + 8 * j), yb = *(const float4*)(YO + ti * 68 + 8 * j + 4);
                const float y8[8] = {ya.x, ya.y, ya.z, ya.w, yb.x, yb.y, yb.z, yb.w};
                st8(YS + ((size_t)d * NT + nb + tt) * 512 + ch, y8);
            }
            __syncthreads();
        }
    }
}

DEV void ph_rw_read(const Params& p, int L, int ntok) {
    const int lane = TID() & 63, wave = TID() >> 6;
    const bf16_t* PXR = (const bf16_t*)(p.ws + OFF_PX); const bf16_t* VF = (const bf16_t*)(p.ws + OFF_VF);
    const bf16_t* YS = (const bf16_t*)(p.ws + OFF_YS); const float* CB = (const float*)(p.ws + OFF_CB);
    bf16_t* YA = (bf16_t*)(p.ws + OFF_YA); bf16_t* SG = (bf16_t*)(p.ws + OFF_SGB);
    const float* mu = p.in[I_MU] + (size_t)L * RW_COLS;
    const float* lg = p.in[I_LNG] + (size_t)L * 512; const float* lb = p.in[I_LNB] + (size_t)L * 512;
    for (int n0 = blockIdx.x * 8; n0 < ntok; n0 += gridDim.x * 8) {
        const int n = n0 + wave, c = lane * 8, h = lane >> 3;
        float y0[8], y1[8], v8[8], o[8];
        ld8(YS + (size_t)n * 512 + c, y0); ld8(YS + ((size_t)NT + n) * 512 + c, y1); ld8(VF + (size_t)n * 512 + c, v8);
        float s = 0.f;
        UNROLL for (int i = 0; i < 8; ++i) { y0[i] += y1[i]; s += y0[i]; }
        s += __shfl_xor(s, 1); s += __shfl_xor(s, 2); s += __shfl_xor(s, 4);
        const float mean = s * (1.f / 64.f); float q = 0.f;
        UNROLL for (int i = 0; i < 8; ++i) { const float dd = y0[i] - mean; q += dd * dd; }
        q += __shfl_xor(q, 1); q += __shfl_xor(q, 2); q += __shfl_xor(q, 4);
        const float rstd = rsqrtf(q * (1.f / 64.f) + 64e-5f);
        const float bon = CB[(size_t)n * 8 + h] + CB[((size_t)NT + n) * 8 + h];
        UNROLL for (int i = 0; i < 8; ++i) o[i] = (y0[i] - mean) * rstd * lg[c + i] + lb[c + i] + bon * v8[i];
        st8(YA + (size_t)n * 512 + c, o);
        if (lane < 16) {
            int nb, tt, T; seq_of(n, nb, tt, T);
            float g8[8]; shift8(PXR, RW_COLS, nb, tt, T, 1792 + lane * 8, mu, g8);
            UNROLL for (int i = 0; i < 8; ++i) g8[i] = sigm(g8[i]);
            st8(SG + (size_t)n * 128 + lane * 8, g8);
        }
    }
}

DEV void ph_na_norm(const Params& p, int L) {
    const int lane = TID() & 63, wave = TID() >> 6;
    bf16_t* PXN = (bf16_t*)(p.ws + OFF_PX);
    const float* qg = p.in[I_QNG] + (size_t)L * 64; const float* kg = p.in[I_KNG] + (size_t)L * 64;
    for (int n0 = blockIdx.x * 8; n0 < NT; n0 += gridDim.x * 8) {
        const int n = n0 + wave, c = lane * 8;
        UNROLL for (int w = 0; w < 2; ++w) {
            bf16_t* ptr = PXN + (size_t)n * 1024 + w * 512 + c;
            float x[8]; ld8(ptr, x);
            float ss = 0.f;
            UNROLL for (int i = 0; i < 8; ++i) ss += x[i] * x[i];
            ss += __shfl_xor(ss, 1); ss += __shfl_xor(ss, 2); ss += __shfl_xor(ss, 4);
            const float r = rsqrtf(ss * (1.f / 64.f) + 1e-6f) * (w == 0 ? 0.125f : 1.f);
            const float* g = w == 0 ? qg : kg;
            UNROLL for (int i = 0; i < 8; ++i) x[i] = x[i] * r * g[(c + i) & 63];
            st8(ptr, x);
        }
    }
}

DEV void ph_na_att(const Params& p, int L, char* smem) {
    const int tid = TID(), lane = tid & 63, lq = lane & 15, kg = lane >> 4;
    const int wave = __builtin_amdgcn_readfirstlane(tid >> 6);
    char* KL = smem;
    char* KC = smem + 512 * LROW;
    char* VL = smem;
    char* VC = smem + 64 * 1040;
    float* OX = (float*)(smem + 114688);
    float* ML = OX + 8 * 1024;
    float* RP = ML + 256;
    const bf16_t* PXN = (const bf16_t*)(p.ws + OFF_PX); bf16_t* YB = (bf16_t*)(p.ws + OFF_YB);
    const bf16_t* VT = (const bf16_t*)(p.ws + OFF_VT); const bf16_t* VTC = (const bf16_t*)(p.ws + OFF_VTC);
    const int nunits = 4096 + (L == 0 ? 256 : 0);
    for (int u = blockIdx.x; u < nunits; u += gridDim.x) {
        const bool cu = u >= 4096;
        int b, h, r = 0, rs = 0, g = 0;
        if (!cu) { h = u & 7; r = (u >> 3) & 31; b = u >> 8; rs = min(max(r - 4, 0), 24); }
        else { const int v = u - 4096; h = v & 7; g = (v >> 3) & 1; b = v >> 4; }
        const int ctx0 = NX + b * CTXL;
        if (!cu) {
            UNROLL for (int i = 0; i < 8; ++i) {
                const int c = tid + NTHREADS * i, kx = c >> 3, part = c & 7;
                const int tok = b * SEQ + (rs + (kx >> 6)) * 64 + (kx & 63);
                *(u32x4*)(KL + kx * LROW + part * 16) = *(const u32x4*)(PXN + (size_t)tok * 1024 + 512 + h * 64 + part * 8);
            }
            for (int i = tid; i < 15 * 31; i += NTHREADS) RP[i] = p.in[I_RPB][((size_t)L * 8 + h) * 465 + i];
        }
        UNROLL for (int i = 0; i < 4; ++i) {
            const int c = tid + NTHREADS * i, kx = c >> 3, part = c & 7;
            *(u32x4*)(KC + kx * LROW + part * 16) = *(const u32x4*)(PXN + (size_t)(ctx0 + kx) * 1024 + 512 + h * 64 + part * 8);
        }
        const int nb = wave & 3;
        const bool loc = !cu && wave < 4;
        const int qtok0 = cu ? ctx0 + (g * 8 + wave) * 16 : b * SEQ + r * 64 + nb * 16;
        const int band0 = min(max(nb * 16 - 8, 0), 32);
        bf16x8 qf[2];
        UNROLL for (int ks = 0; ks < 2; ++ks) qf[ks] = *(const bf16x8*)(PXN + (size_t)(qtok0 + lq) * 1024 + h * 64 + ks * 32 + kg * 8);
        __syncthreads();
        f32x4v sacc[16];
        if (loc) {
            const char* kb = KL + (band0 + lq) * LROW + kg * 16;
            UNROLL for (int t = 0; t < 16; ++t) {
                f32x4v a = {0.f, 0.f, 0.f, 0.f};
                UNROLL for (int ks = 0; ks < 2; ++ks) a = __builtin_amdgcn_mfma_f32_16x16x32_bf16(*(const bf16x8*)(kb + ((t >> 1) * 64 + (t & 1) * 16) * LROW + ks * 64), qf[ks], a, 0, 0, 0);
                sacc[t] = a;
            }
            const int col = nb * 16 + lq, cs = min(max(col - 8, 0), 48);
            const int kc0 = band0 + 4 * kg;
            const float* rp = RP + (rs - r + 7) * 31 + (kc0 - col + 15);
            UNROLL for (int t = 0; t < 16; ++t) UNROLL for (int i = 0; i < 4; ++i) {
                const int kc = kc0 + (t & 1) * 16 + i;
                const bool valid = kc >= cs && kc < cs + 16;
                sacc[t][i] = valid ? sacc[t][i] + rp[(t >> 1) * 31 + (t & 1) * 16 + i] : -1e30f;
            }
        } else {
            const char* kb = KC + lq * LROW + kg * 16;
            UNROLL for (int t = 0; t < 16; ++t) {
                f32x4v a = {0.f, 0.f, 0.f, 0.f};
                UNROLL for (int ks = 0; ks < 2; ++ks) a = __builtin_amdgcn_mfma_f32_16x16x32_bf16(*(const bf16x8*)(kb + t * 16 * LROW + ks * 64), qf[ks], a, 0, 0, 0);
                sacc[t] = a;
            }
        }
        float mx = -3e38f;
        UNROLL for (int t = 0; t < 16; ++t) UNROLL for (int i = 0; i < 4; ++i) mx = fmaxf(mx, sacc[t][i]);
        mx = fmaxf(mx, __shfl_xor(mx, 16)); mx = fmaxf(mx, __shfl_xor(mx, 32));
        float sum = 0.f;
        UNROLL for (int t = 0; t < 16; ++t) UNROLL for (int i = 0; i < 4; ++i) { const float e = __expf(sacc[t][i] - mx); sacc[t][i] = e; sum += e; }
        sum += __shfl_xor(sum, 16); sum += __shfl_xor(sum, 32);
        if (kg == 0) { ML[(wave * 2) * 16 + lq] = mx; ML[(wave * 2 + 1) * 16 + lq] = sum; }
        bf16x8 pf[8];
        UNROLL for (int tp = 0; tp < 8; ++tp) {
            u32x4 w; w.x = pk2(sacc[2 * tp][0], sacc[2 * tp][1]); w.y = pk2(sacc[2 * tp][2], sacc[2 * tp][3]);
            w.z = pk2(sacc[2 * tp + 1][0], sacc[2 * tp + 1][1]); w.w = pk2(sacc[2 * tp + 1][2], sacc[2 * tp + 1][3]);
            pf[tp] = __builtin_bit_cast(bf16x8, w);
        }
        __syncthreads();
        if (!cu) {
            UNROLL for (int i = 0; i < 8; ++i) {
                const int c = tid + NTHREADS * i, part = c & 7, kr = (c >> 3) & 7, d = c >> 6;
                *(u32x4*)(VL + d * 1040 + (kr * 64 + part * 8) * 2) = *(const u32x4*)(VT + ((size_t)(b * 8 + h) * 64 + d) * SEQ + (rs + kr) * 64 + part * 8);
            }
        }
        UNROLL for (int i = 0; i < 4; ++i) {
            const int c = tid + NTHREADS * i, part = c & 31, d = c >> 5;
            *(u32x4*)(VC + d * 528 + part * 16) = *(const u32x4*)(VTC + ((size_t)(b * 8 + h) * 64 + d) * CTXL + part * 8);
        }
        __syncthreads();
        f32x4v oacc[4];
        UNROLL for (int dt = 0; dt < 4; ++dt) oacc[dt] = (f32x4v){0.f, 0.f, 0.f, 0.f};
        if (loc) {
            const char* vb = VL + lq * 1040 + (band0 + 4 * kg) * 2;
            UNROLL for (int tp = 0; tp < 8; ++tp) UNROLL for (int dt = 0; dt < 4; ++dt) {
                const u32x2 lo = *(const u32x2*)(vb + dt * 16 * 1040 + tp * 128), hi = *(const u32x2*)(vb + dt * 16 * 1040 + tp * 128 + 32);
                u32x4 w; w.x = lo.x; w.y = lo.y; w.z = hi.x; w.w = hi.y;
                oacc[dt] = __builtin_amdgcn_mfma_f32_16x16x32_bf16(pf[tp], __builtin_bit_cast(bf16x8, w), oacc[dt], 0, 0, 0);
            }
        } else {
            const char* vb = VC + lq * 528 + 8 * kg;
            UNROLL for (int tp = 0; tp < 8; ++tp) UNROLL for (int dt = 0; dt < 4; ++dt) {
                const u32x2 lo = *(const u32x2*)(vb + dt * 16 * 528 + tp * 64), hi = *(const u32x2*)(vb + dt * 16 * 528 + tp * 64 + 32);
                u32x4 w; w.x = lo.x; w.y = lo.y; w.z = hi.x; w.w = hi.y;
                oacc[dt] = __builtin_amdgcn_mfma_f32_16x16x32_bf16(pf[tp], __builtin_bit_cast(bf16x8, w), oacc[dt], 0, 0, 0);
            }
        }
        float* ox = OX + wave * 1024;
        if (!cu && wave >= 4) { UNROLL for (int dt = 0; dt < 4; ++dt) UNROLL for (int i = 0; i < 4; ++i) ox[(4 * kg + i) * 64 + dt * 16 + lq] = oacc[dt][i]; }
        __syncthreads();
        if (cu || wave < 4) {
            UNROLL for (int i = 0; i < 4; ++i) {
                const int q = 4 * kg + i;
                const float m0 = ML[(wave * 2) * 16 + q], l0 = ML[(wave * 2 + 1) * 16 + q];
                float e0 = 1.f, e1 = 0.f, den = l0;
                if (!cu) {
                    const float m1 = ML[((wave + 4) * 2) * 16 + q], l1 = ML[((wave + 4) * 2 + 1) * 16 + q];
                    const float m = fmaxf(m0, m1); e0 = __expf(m0 - m); e1 = __expf(m1 - m); den = l0 * e0 + l1 * e1;
                }
                const float inv = 1.f / den;
                UNROLL for (int dt = 0; dt < 4; ++dt) {
                    const float o1 = cu ? 0.f : OX[(wave + 4) * 1024 + q * 64 + dt * 16 + lq];
                    ox[q * 64 + dt * 16 + lq] = (oacc[dt][i] * e0 + o1 * e1) * inv;
                }
            }
            UNROLL for (int it = 0; it < 2; ++it) {
                const int q = (lane >> 3) + 8 * it, c8 = (lane & 7) * 8;
                const float4 a = *(const float4*)(ox + q * 64 + c8), bq = *(const float4*)(ox + q * 64 + c8 + 4);
                const float v[8] = {a.x, a.y, a.z, a.w, bq.x, bq.y, bq.z, bq.w};
                st8(YB + (size_t)(qtok0 + q) * 512 + h * 64 + c8, v);
            }
        }
        __syncthreads();
    }
}

DEV float sum16(float v) { v += DPP_MOV(v, 0xB1); v += DPP_MOV(v, 0x4E); v += DPP_MOV(v, 0x141); v += DPP_MOV(v, 0x140); return v; }
DEV void ph_ml_scan(const Params& p, int L, char* smem) {
    const int tid = TID(), lane = tid & 63, lq = lane & 15, kg = lane >> 4, ti = tid >> 3, j = tid & 7;
    const int wave = __builtin_amdgcn_readfirstlane(tid >> 6);
    char* QS = smem;
    char* QP = QS + 9216;
    char* KC = QP + 9216;
    char* KW = KC + 9216;
    char* PM = KW + 9216;
    char* VT = PM + 9216;
    float* BV = (float*)(VT + 128 * LROW);
    float* GI = BV + 64;
    float* DEN = GI + 64;
    float* NV = DEN + 64;
    float* RS = NV + 64;
    float* HO = RS + 256;
    const bf16_t* PXM = (const bf16_t*)(p.ws + OFF_PX); bf16_t* HS = (bf16_t*)(p.ws + OFF_HS);
    for (int u = blockIdx.x; u < 128; u += gridDim.x) {
        const int d = u & 1, h = (u >> 1) & 3, b = u >> 3;
        const float ib = p.in[I_IB][L * 8 + d * 4 + h], fb = p.in[I_FB][L * 8 + d * 4 + h];
        f32x4v cacc[4];
        UNROLL for (int i = 0; i < 4; ++i) cacc[i] = (f32x4v){0.f, 0.f, 0.f, 0.f};
        for (int i = tid; i < 64 * LROW / 4; i += NTHREADS) ((unsigned*)PM)[i] = 0u;
        if (tid < 64) NV[tid] = 0.f;
        __syncthreads();
        for (int ci = 0; ci < 36; ++ci) {
            const bool isc = ci < 4; const int T = isc ? CTXL : SEQ, cc = isc ? ci : ci - 4;
            const int t0 = d == 0 ? cc * 64 : T - 64 * (cc + 1), nb = isc ? NX + b * CTXL : b * SEQ;
            const int tt = d == 0 ? t0 + ti : t0 + 63 - ti;
            float q8[8], k8[8];
            {
                const bf16_t* row = PXM + (size_t)(nb + tt) * ML_COLS;
                ld8(row + h * 64 + 8 * j, q8); ld8(row + 256 + h * 64 + 8 * j, k8);
                if (!isc) {
                    const int axis = j >> 2, half = (j >> 1) & 1; const float pos = (float)(axis == 0 ? (tt >> 6) : (tt & 63));
                    UNROLL for (int i = 0; i < 8; ++i) {
                        const int f = (j & 1) * 8 + i;
                        const float inv = exp2f(-(float)f * 0.83048202372184059f);
                        const float ang = pos * inv; const float cs = __cosf(ang), sn = __sinf(ang);
                        const float qo = __shfl_xor(q8[i], 2), ko = __shfl_xor(k8[i], 2);
                        q8[i] = half == 0 ? q8[i] * cs - qo * sn : q8[i] * cs + qo * sn;
                        k8[i] = half == 0 ? k8[i] * cs - ko * sn : k8[i] * cs + ko * sn;
                    }
                }
                UNROLL for (int i = 0; i < 8; ++i) q8[i] *= 0.125f;
                st8((bf16_t*)(QS + ti * LROW) + 8 * j, q8); st8((bf16_t*)(KC + ti * LROW) + 8 * j, k8);
                float v0[8], v1[8];
                ld8(row + 512 + h * 128 + 16 * j, v0); ld8(row + 512 + h * 128 + 16 * j + 8, v1);
                UNROLL for (int i = 0; i < 8; ++i) { *(bf16_t*)(VT + (16 * j + i) * LROW + ti * 2) = f2bf(v0[i]); *(bf16_t*)(VT + (16 * j + 8 + i) * LROW + ti * 2) = f2bf(v1[i]); }
                if (wave == 0) {
                    const int tl = d == 0 ? t0 + lane : t0 + 63 - lane;
                    const bf16_t* rw = PXM + (size_t)(nb + tl) * ML_COLS;
                    const float ig = bf2f(rw[1536 + d * 4 + h]) + ib, fg = bf2f(rw[1544 + d * 4 + h]) + fb;
                    const float igc = 15.f * tanhf(ig * (1.f / 15.f)), fgc = 15.f * tanhf(fg * (1.f / 15.f));
                    float lf = -(fmaxf(-fgc, 0.f) + log1pf(expf(-fabsf(fgc))));
                    UNROLL for (int o = 1; o < 64; o <<= 1) { const float up = __shfl_up(lf, o); if (lane >= o) lf += up; }
                    BV[lane] = lf; GI[lane] = igc;
                }
            }
            __syncthreads();
            {
                const float bt = BV[ti], bl = BV[63], gi = GI[ti];
                const float eb = __expf(bt), wk = __expf(bl - bt + gi);
                float qp[8]; float dn = 0.f;
                UNROLL for (int i = 0; i < 8; ++i) { qp[i] = q8[i] * eb; dn += q8[i] * NV[8 * j + i]; }
                st8((bf16_t*)(QP + ti * LROW) + 8 * j, qp);
                UNROLL for (int i = 0; i < 8; ++i) *(bf16_t*)(KW + (8 * j + i) * LROW + ti * 2) = f2bf(k8[i] * wk);
                dn = sum8(dn);
                if (j == 0) DEN[ti] = dn * eb;
            }
            __syncthreads();
            UNROLL for (int rep = 0; rep < 2; ++rep) {
                const int tile = wave + 8 * rep;
                if (tile < 10) {
                    const int tt4 = tile < 1 ? 0 : tile < 3 ? 1 : tile < 6 ? 2 : 3, st4 = tile - (tt4 * (tt4 + 1)) / 2;
                    f32x4v a = {0.f, 0.f, 0.f, 0.f};
                    UNROLL for (int ks = 0; ks < 2; ++ks)
                        a = __builtin_amdgcn_mfma_f32_16x16x32_bf16(*(const bf16x8*)(QS + (16 * tt4 + lq) * LROW + ks * 64 + kg * 16),
                                                                    *(const bf16x8*)(KC + (16 * st4 + lq) * LROW + ks * 64 + kg * 16), a, 0, 0, 0);
                    const int sidx = 16 * st4 + lq; const float bs = BV[sidx], gs = GI[sidx];
                    UNROLL for (int i = 0; i < 4; ++i) {
                        const int tidx = 16 * tt4 + 4 * kg + i;
                        const float val = sidx <= tidx ? a[i] * __expf(BV[tidx] - bs + gs) : 0.f;
                        *(bf16_t*)(PM + tidx * LROW + sidx * 2) = f2bf(val);
                        const float rsum = sum16(val);
                        if (lq == 0) RS[tidx * 4 + st4] = rsum;
                    }
                }
            }
            __syncthreads();
            {
                bf16x8 vf[2], cb[2];
                UNROLL for (int kk = 0; kk < 2; ++kk) vf[kk] = *(const bf16x8*)(VT + (16 * wave + lq) * LROW + kk * 64 + kg * 16);
                UNROLL for (int kk = 0; kk < 2; ++kk) {
                    u32x4 w; w.x = pk2(cacc[2 * kk][0], cacc[2 * kk][1]); w.y = pk2(cacc[2 * kk][2], cacc[2 * kk][3]);
                    w.z = pk2(cacc[2 * kk + 1][0], cacc[2 * kk + 1][1]); w.w = pk2(cacc[2 * kk + 1][2], cacc[2 * kk + 1][3]);
                    cb[kk] = __builtin_bit_cast(bf16x8, w);
                }
                UNROLL for (int tt4 = 0; tt4 < 4; ++tt4) {
                    f32x4v hacc = {0.f, 0.f, 0.f, 0.f};
                    UNROLL for (int kk = 0; kk < 2; ++kk) if (2 * kk <= tt4)
                        hacc = __builtin_amdgcn_mfma_f32_16x16x32_bf16(*(const bf16x8*)(PM + (16 * tt4 + lq) * LROW + kk * 64 + kg * 16), vf[kk], hacc, 0, 0, 0);
                    UNROLL for (int kk = 0; kk < 2; ++kk) {
                        const char* qa = QP + (16 * tt4 + lq) * LROW + (32 * kk + 4 * kg) * 2;
                        const u32x2 lo = *(const u32x2*)qa, hi = *(const u32x2*)(qa + 32);
                        u32x4 w; w.x = lo.x; w.y = lo.y; w.z = hi.x; w.w = hi.y;
                        hacc = __builtin_amdgcn_mfma_f32_16x16x32_bf16(__builtin_bit_cast(bf16x8, w), cb[kk], hacc, 0, 0, 0);
                    }
                    UNROLL for (int i = 0; i < 4; ++i) {
                        const int tidx = 16 * tt4 + 4 * kg + i;
                        float den = DEN[tidx];
                        UNROLL for (int st = 0; st <= tt4; ++st) den += RS[tidx * 4 + st];
                        HO[tidx * 132 + 16 * wave + lq] = hacc[i] / fmaxf(fabsf(den), 1.f);
                    }
                }
                const float g = __expf(BV[63]);
                UNROLL for (int dk = 0; dk < 4; ++dk) {
                    cacc[dk] = cacc[dk] * g;
                    UNROLL for (int kk = 0; kk < 2; ++kk)
                        cacc[dk] = __builtin_amdgcn_mfma_f32_16x16x32_bf16(*(const bf16x8*)(KW + (16 * dk + lq) * LROW + kk * 64 + kg * 16), vf[kk], cacc[dk], 0, 0, 0);
                }
            }
            __syncthreads();
            if (tid < 64) {
                float acc = 0.f;
                UNROLL for (int c8 = 0; c8 < 8; ++c8) { float kw[8]; ld8((const bf16_t*)(KW + tid * LROW) + 8 * c8, kw); UNROLL for (int i = 0; i < 8; ++i) acc += kw[i]; }
                NV[tid] = __expf(BV[63]) * NV[tid] + acc;
            }
            {
                const float* hr = HO + ti * 132 + 16 * j;
                float o0[8], o1[8];
                UNROLL for (int i = 0; i < 8; ++i) { o0[i] = hr[i]; o1[i] = hr[8 + i]; }
                bf16_t* dst = HS + ((size_t)d * NT + nb + tt) * 512 + h * 128 + 16 * j;
                st8(dst, o0); st8(dst + 8, o1);
            }
            __syncthreads();
        }
    }
}
DEV void ph_ml_read(const Params& p, int L, int ntok) {
    const int lane = TID() & 63, wave = TID() >> 6;
    const bf16_t* PXM = (const bf16_t*)(p.ws + OFF_PX); const bf16_t* HS = (const bf16_t*)(p.ws + OFF_HS);
    bf16_t* YC = (bf16_t*)(p.ws + OFF_YC); const float* ng = p.in[I_MNG] + (size_t)L * 512;
    for (int n0 = blockIdx.x * 8; n0 < ntok; n0 += gridDim.x * 8) {
        const int n = n0 + wave, c = lane * 8;
        float h0[8], h1[8], o8[8], out[8];
        ld8(HS + (size_t)n * 512 + c, h0); ld8(HS + ((size_t)NT + n) * 512 + c, h1); ld8(PXM + (size_t)n * ML_COLS + 1024 + c, o8);
        float ss = 0.f;
        UNROLL for (int i = 0; i < 8; ++i) { h0[i] += h1[i]; ss += h0[i] * h0[i]; }
        ss += __shfl_xor(ss, 1); ss += __shfl_xor(ss, 2); ss += __shfl_xor(ss, 4); ss += __shfl_xor(ss, 8);
        const float r = rsqrtf(ss * (1.f / 128.f) + 1e-6f);
        UNROLL for (int i = 0; i < 8; ++i) out[i] = h0[i] * r * ng[c + i] * sigm(o8[i]);
        st8(YC + (size_t)n * 512 + c, out);
    }
}

DEV void ph_route(const Params& p, int L, int ntok, char* smem) {
    const int lane = TID() & 63, wave = TID() >> 6;
    const float* LOG = (const float*)(p.ws + OFF_LOG); int* EIDX = (int*)(p.ws + OFF_EIDX); float* EW = (float*)(p.ws + OFF_EW);
    const float bias = p.in[I_MB][L * 64 + lane];
    int* MCNT = (int*)(p.ws + OFF_MCNT);
    int* hist = (int*)smem;
    if (TID() < 192) hist[TID()] = 0;
    __syncthreads();
    for (int n0 = blockIdx.x * 8; n0 < ntok; n0 += gridDim.x * 8) {
        const int n = n0 + wave, g = lane >> 3;
        const float score = sigm_acc(LOG[(size_t)n * 64 + lane]), sel = score + bias;
        float m1 = sel; m1 = fmaxf(m1, __shfl_xor(m1, 1)); m1 = fmaxf(m1, __shfl_xor(m1, 2)); m1 = fmaxf(m1, __shfl_xor(m1, 4));
        int i1 = sel == m1 ? lane : 64; i1 = min(i1, __shfl_xor(i1, 1)); i1 = min(i1, __shfl_xor(i1, 2)); i1 = min(i1, __shfl_xor(i1, 4));
        float m2 = lane == i1 ? -3e38f : sel; m2 = fmaxf(m2, __shfl_xor(m2, 1)); m2 = fmaxf(m2, __shfl_xor(m2, 2)); m2 = fmaxf(m2, __shfl_xor(m2, 4));
        const float gs = m1 + m2;
        int rank = 0;
        UNROLL for (int g2 = 0; g2 < 8; ++g2) { const float v = __shfl(gs, g2 * 8); rank += (v > gs || (v == gs && g2 < g)) ? 1 : 0; }
        const float ms = rank < 4 ? sel : -1e30f;
        int er = 0;
        for (int e2 = 0; e2 < 64; ++e2) { const float v = __shfl(ms, e2); er += (v > ms || (v == ms && e2 < lane)) ? 1 : 0; }
        const bool chosen = er < 8;
        float ws = chosen ? score : 0.f;
        UNROLL for (int o = 1; o < 64; o <<= 1) ws += __shfl_xor(ws, o);
        if (chosen) { EIDX[(size_t)n * 8 + er] = lane; EW[(size_t)n * 8 + er] = score / ws * 2.5f; atomicAdd(hist + (n / MOE_CHUNK) * 64 + lane, 1); }
    }
    __syncthreads();
    if (TID() < 192 && hist[TID()] > 0) atomicAdd(MCNT + TID(), hist[TID()]);
    __syncthreads();
}


DEV void ph_moe_scatter(const Params& p, int ntok, char* smem) {
    const int tid = TID();
    int* base = (int*)smem;
    int* lh = base + 192;
    const int* MCNT = (const int*)(p.ws + OFF_MCNT); int* CUR = (int*)(p.ws + OFF_MCNT) + 192;
    const int* EIDX = (const int*)(p.ws + OFF_EIDX); int* SORT = (int*)(p.ws + OFF_SORT);
    if (tid < 3) { int b = 0; for (int e = 0; e < 64; ++e) { base[tid * 64 + e] = b; b += (MCNT[tid * 64 + e] + 127) & ~127; } }
    if (tid < 192) lh[tid] = 0;
    __syncthreads();
    for (int i = blockIdx.x * NTHREADS + tid; i < ntok * 8; i += gridDim.x * NTHREADS) atomicAdd(lh + ((i >> 3) / MOE_CHUNK) * 64 + EIDX[i], 1);
    __syncthreads();
    if (tid < 192) { const int n = lh[tid]; if (n > 0) base[tid] += atomicAdd(CUR + tid, n); lh[tid] = 0; }
    __syncthreads();
    for (int i = blockIdx.x * NTHREADS + tid; i < ntok * 8; i += gridDim.x * NTHREADS) {
        const int ce = ((i >> 3) / MOE_CHUNK) * 64 + EIDX[i];
        SORT[(size_t)(ce >> 6) * SORT_CAP + base[ce] + atomicAdd(lh + ce, 1)] = i;
    }
    __syncthreads();
}

DEV void ph_moe_exp(const Params& p, int cb, int ce, char* smem, Topo tp) {
    typedef GC<2, 4> C;
    const int tid0 = TID();
    char* ACT = smem + 2 * C::STG;
    int* list = (int*)(smem + 3 * C::STG);
    int* cnt = list + 1024;
    const bf16_t* H2 = (const bf16_t*)(p.ws + OFF_HX); const int* EIDX = (const int*)(p.ws + OFF_EIDX); const float* EW = (const float*)(p.ws + OFF_EW);
    bf16_t* YBUF = (bf16_t*)(p.ws + OFF_YBUF);
    const int c = cb / MOE_CHUNK;
    const int* MCNT = (const int*)(p.ws + OFF_MCNT) + c * 64; const int* SORT = (const int*)(p.ws + OFF_SORT) + (size_t)c * SORT_CAP;
    int* tb = cnt + 16;
    const int xcd = tp.x, slot = tp.r, nslot = tp.n;
    __syncthreads();
    if (tid0 < 8) {
        const int tid = tid0; const int e = xcd + 8 * tid; int b = 0;
        for (int e2 = 0; e2 < e; ++e2) b += (MCNT[e2] + 127) & ~127;
        tb[16 + tid] = b; tb[32 + tid] = MCNT[e];
    }
    __syncthreads();
    if (tid0 == 0) { int t = 0; for (int k = 0; k < 8; ++k) { tb[k] = t; t += (tb[32 + k] + 127) >> 7; } tb[8] = t; }
    __syncthreads();
    const int total = tb[8];
    for (int lu = slot; lu < total; lu += nslot) {
        int tid = tid0; asm volatile("" : "+v"(tid));
        const int lane = tid & 63, wave = tid >> 6, wm = wave / 4, wn = wave % 4, fr = lane & 31, fh = lane >> 5;
        int k = 0;
        while (k < 7 && lu >= tb[k + 1]) ++k;
        const int e = xcd + 8 * k, j = lu - tb[k], M = min(128, tb[32 + k] - 128 * j), row0 = tb[16 + k] + 128 * j;
        __syncthreads();
        if (tid < 128) list[tid] = SORT[row0 + min(tid, M - 1)];
        __syncthreads();
        const bf16_t* GU = (const bf16_t*)(p.ws + OFF_MGU) + (size_t)e * 256 * 1024;
        const bf16_t* DT = (const bf16_t*)(p.ws + OFF_MDT) + (size_t)e * 1024 * 128;
        {
            constexpr int mc = 0;
            f32x16 acc[2][2];
            {
            acc_zero(acc);
            gemm_tile<2, 4, 3, false>(acc, [&](int r) -> const bf16_t* { const int ix = min(mc + r, M - 1); return H2 + (size_t)(list[ix] >> 3) * 1024; },
                                   GU, 1024, 0, 256, 1024, smem, nullptr);
            }
            UNROLL for (int mi = 0; mi < 2; ++mi) UNROLL for (int r = 0; r < 16; ++r) {
                const int row = wm * 64 + ACC_ROW(mi, r, fh), ix = mc + row;
                const float gw = ix < M ? EW[list[ix]] : 0.f;
                const float gv = acc[mi][0][r], uv = acc[mi][1][r];
                const float a = gv / (1.f + __expf(-gv)) * uv * gw;
                const int col = wn * 32 + fr;
                *(bf16_t*)(ACT + (col >> 6) * C::AB + row * 128 + ((((col & 63) >> 3) ^ ((row >> 1) & 7)) << 4) + (col & 7) * 2) = f2bf(a);
            }
            __syncthreads();
            {
                const int crow = tid >> 3, cch = (tid & 7) ^ ((crow >> 1) & 7);
                const int sw = (fr >> 1) & 7, a_base = (wm * 64 + fr) * 128, b_base = (wn * 64 + fr) * 128;
                float* slab = (float*)(smem + (wave < 4 ? wave * 4096 : C::STG + (wave - 4) * 4096));
#define MG2_ISSUE(nt_) do { UNROLL for (int kt = 0; kt < 2; ++kt) UNROLL for (int i = 0; i < 4; ++i) \
                    GLDS16(DT + (size_t)((nt_) * 256 + crow + 64 * i) * 128 + kt * 64 + cch * 8, smem + kt * C::STG + C::AB + i * 8192 + tid * 16); } while (0)
                MG2_ISSUE(0);
                _Pragma("unroll 1") for (int nt = 0; nt < 4; ++nt) {
                    asm volatile("s_waitcnt vmcnt(0)" ::: "memory");
                    __builtin_amdgcn_s_barrier();
                    asm volatile("" ::: "memory");
                    acc_zero(acc);
                    UNROLL for (int kt = 0; kt < 2; ++kt) {
                        const char* As_ = ACT + kt * C::AB; const char* Bs_ = smem + kt * C::STG + C::AB;
                        UNROLL for (int ks = 0; ks < 4; ++ks) {
                            const int off = ((2 * ks + fh) ^ sw) * 16;
                            bf16x8 af[2], bfv[2];
                            UNROLL for (int mi = 0; mi < 2; ++mi) af[mi] = *(const bf16x8*)(As_ + a_base + mi * 4096 + off);
                            UNROLL for (int ni = 0; ni < 2; ++ni) bfv[ni] = *(const bf16x8*)(Bs_ + b_base + ni * 4096 + off);
                            UNROLL for (int mi = 0; mi < 2; ++mi) UNROLL for (int ni = 0; ni < 2; ++ni)
                                acc[mi][ni] = __builtin_amdgcn_mfma_f32_32x32x16_bf16(af[mi], bfv[ni], acc[mi][ni], 0, 0, 0);
                        }
                    }
                    asm volatile("s_waitcnt lgkmcnt(0)" ::: "memory");
                    __builtin_amdgcn_s_barrier();
                    asm volatile("" ::: "memory");
                    if (nt < 3) MG2_ISSUE(nt + 1);
                    UNROLL for (int mi = 0; mi < 2; ++mi) UNROLL for (int hh = 0; hh < 2; ++hh) {
                        UNROLL for (int ni = 0; ni < 2; ++ni) UNROLL for (int r8 = 0; r8 < 8; ++r8) {
                            const int r = 8 * hh + r8;
                            slab[((r & 3) + 8 * ((r >> 2) & 1) + 4 * fh) * 64 + ni * 32 + fr] = acc[mi][ni][r];
                        }
                        UNROLL for (int it = 0; it < 2; ++it) {
                            const int row = (lane >> 3) + 8 * it, c8 = (lane & 7) * 8;
                            const float4 a = *(const float4*)(slab + row * 64 + c8), b = *(const float4*)(slab + row * 64 + c8 + 4);
                            const float v[8] = {a.x, a.y, a.z, a.w, b.x, b.y, b.z, b.w};
                            const int ix = mc + wm * 64 + mi * 32 + 16 * hh + row;
                            if (ix < M) st8(YBUF + (size_t)(list[ix] - cb * 8) * 1024 + nt * 256 + wn * 64 + c8, v);
                        }
                    }
                }
#undef MG2_ISSUE
            }
            __syncthreads();
        }
        __syncthreads();
    }
}


#define XB_TMO      128
#define XB_XCNT(j)  (256  + 64 * (j))
#define XB_XSUB(j)  (1280 + 64 * (j))
#define XB_XGEN(j)  (2304 + 64 * (j))
#define XB_TOP      3328
#define XB_TOPGEN   3392
#define XCD_BAR_WORDS 3456
#define XB_SPIN_CAP (1u << 18)
#define LAS __attribute__((address_space(3)))

__device__ __forceinline__ unsigned xb_ld(unsigned* p)              { return __hip_atomic_load(p, __ATOMIC_RELAXED, __HIP_MEMORY_SCOPE_AGENT); }
__device__ __forceinline__ unsigned xb_add(unsigned* p, unsigned v) { return __hip_atomic_fetch_add(p, v, __ATOMIC_RELAXED, __HIP_MEMORY_SCOPE_AGENT); }
__device__ __forceinline__ unsigned xb_xcc_id() { return (unsigned)__builtin_amdgcn_s_getreg((3 << 11) | 20) & 0xFu; }
#define XB_SPIN(cond, bar) do { unsigned _sp = 0; while (cond) { __builtin_amdgcn_s_sleep(1); \
    if ((++_sp & 255u) == 0u) { if (xb_ld(&(bar)[XB_TMO])) break; if (_sp > XB_SPIN_CAP) { atomicAdd(&(bar)[XB_TMO], 1u); break; } } } } while (0)

struct XcdBarrier { unsigned* bar; unsigned x; volatile LAS unsigned* st; };

__device__ __forceinline__ XcdBarrier xcd_barrier_post(unsigned* bar, volatile LAS unsigned* st) {
    XcdBarrier b; b.bar = bar; b.x = xb_xcc_id(); b.st = st;
    if (threadIdx.x == 0) { const unsigned rank = xb_add(&bar[XB_XCNT(b.x)], 1u); st[2] = b.x; st[3] = rank; }
    return b;
}
__device__ __forceinline__ void xcd_barrier_complete(unsigned* bar, unsigned x, unsigned& nloc, unsigned& nx) {
    const unsigned G = gridDim.x * gridDim.y * gridDim.z;
    unsigned sum, cnt, mine, sp = 0u;
    for (;;) {
        sum = 0u; cnt = 0u; mine = 0u;
#pragma unroll
        for (unsigned j = 0; j < 16; ++j) { const unsigned c = xb_ld(&bar[XB_XCNT(j)]); sum += c; cnt += (c > 0u) ? 1u : 0u; mine = (j == x) ? c : mine; }
        if (sum == G) break;
        __builtin_amdgcn_s_sleep(1);
        if ((++sp & 255u) == 0u) { if (xb_ld(&bar[XB_TMO])) break; if (sp > XB_SPIN_CAP) { atomicAdd(&bar[XB_TMO], 1u); break; } }
    }
    nloc = mine > 0u ? mine : 1u; nx = cnt > 0u ? cnt : 1u;
}
__device__ __forceinline__ void xcd_barrier(const XcdBarrier& b) {
    asm volatile("s_waitcnt vmcnt(0)" ::: "memory");
    __syncthreads();
    if (threadIdx.x == 0) {
        unsigned* bar = b.bar;
        __builtin_amdgcn_s_waitcnt(0);
        unsigned nloc = b.st[0], nx = b.st[1];
        if (nloc == 0u) { xcd_barrier_complete(bar, b.x, nloc, nx); b.st[0] = nloc; b.st[1] = nx; }
        const unsigned old = xb_add(&bar[XB_XSUB(b.x)], 1u);
        const unsigned gen = old / nloc;
        if (old + 1u == (gen + 1u) * nloc) {
            __builtin_amdgcn_fence(__ATOMIC_RELEASE, "agent");
            asm volatile("s_waitcnt vmcnt(0)" ::: "memory");
            const unsigned og = xb_add(&bar[XB_TOP], 1u);
            const unsigned tg = og / nx;
            if (og + 1u == (tg + 1u) * nx) xb_add(&bar[XB_TOPGEN], 1u);
            else XB_SPIN(xb_ld(&bar[XB_TOPGEN]) == tg, bar);
            __builtin_amdgcn_fence(__ATOMIC_ACQUIRE, "agent");
            xb_add(&bar[XB_XGEN(b.x)], 1u);
            asm volatile("s_waitcnt vmcnt(0)" ::: "memory");
        } else {
            XB_SPIN(xb_ld(&bar[XB_XGEN(b.x)]) == gen, bar);
            __builtin_amdgcn_fence(__ATOMIC_ACQUIRE, "agent");
            asm volatile("s_waitcnt vmcnt(0)" ::: "memory");
        }
    }
    __syncthreads();
}

enum { PH_MODCONV = 0, PH_HX, PH_GEMM_R, PH_RW_PREP, PH_RW_SCAN, PH_RW_READ, PH_RW_G, PH_GEMM_N, PH_NA_NORM, PH_NA_ATT, PH_GEMM_M, PH_ML_SCAN, PH_ML_READ,
       PH_GEMM_G, PH_MERGE, PH_OUT, PH_NORM2, PH_ROUTER, PH_ROUTE, PH_SHARED, PH_MOE_EXP, PH_MOE_COMB, PH_COUNT };

template <int PH> DEV void run_phase(const Params& p, int L, int sub, char* smem, Topo tp) {
    const int tid = TID(), lane = tid & 63, fr = lane & 31, fh = lane >> 5;
    char* ws = p.ws;
    const int ntl = L == 0 ? NT : NX;
    const bf16_t* HX = (const bf16_t*)(ws + OFF_HX);
    const bf16_t* WINT = (const bf16_t*)(ws + OFF_WINT);
    if constexpr (PH == PH_MODCONV) { ph_mod(p, L, smem); ph_conv_mix(p, L, smem); }
    else if constexpr (PH == PH_HX) { ph_norm(p, L, 0, NT); }
    else if constexpr (PH == PH_GEMM_R || PH == PH_GEMM_M) {
        const int c0 = PH == PH_GEMM_R ? 0 : RW_COLS + NA_COLS;
        const int N = PH == PH_GEMM_R ? RW_COLS : ML_COLS;
        bf16_t* PX = (bf16_t*)(ws + OFF_PX);
        gemm256(HX, NT, WINT + (size_t)c0 * DM, N, DM, smem, tp, [&](int row, int col, const float (&v)[8]) {
            if (col < N) st8(PX + (size_t)row * N + col, v);
        });
    }
    else if constexpr (PH == PH_GEMM_N) {
        bf16_t* PX = (bf16_t*)(ws + OFF_PX); bf16_t* VT = (bf16_t*)(ws + OFF_VT); bf16_t* VTC = (bf16_t*)(ws + OFF_VTC);
        gemm256(HX, NT, WINT + (size_t)RW_COLS * DM, 1024, DM, smem, tp, [&](int row, int col, const float (&v)[8]) { st8(PX + (size_t)row * 1024 + col, v); });
        gemm_phase<4, 2>(HX, DM, NT, WINT + (size_t)(RW_COLS + 1024) * DM, DM, 512, DM, smem, tp, [&](const f32x16 (&acc)[2][2], int row0, int col0) {
            const int h = col0 >> 6;
            epi_cols(acc, smem, [&](int r8, int col, const float (&v)[8]) {
                const int n = row0 + r8;
                bf16_t* dst = n < NX ? VT + ((size_t)((n >> 11) * 8 + h) * 64 + col) * SEQ + (n & 2047)
                                     : VTC + ((size_t)(((n - NX) >> 8) * 8 + h) * 64 + col) * CTXL + ((n - NX) & 255);
                st8(dst, v);
            });
        });
    }
    else if constexpr (PH == PH_RW_PREP) { ph_rw_prep(p, L, smem); }
    else if constexpr (PH == PH_RW_SCAN) { ph_rw_scan(p, L, smem); }
    else if constexpr (PH == PH_RW_READ) { ph_rw_read(p, L, ntl); }
    else if constexpr (PH == PH_RW_G) {
        bf16_t* YA = (bf16_t*)(ws + OFF_YA);
        gemm_phase<4, 2>((const bf16_t*)(ws + OFF_SGB), 128, ntl, (const bf16_t*)(ws + OFF_G2T), 128, 512, 128, smem, tp, [&](const f32x16 (&acc)[2][2], int row0, int col0) {
            epi_rows(acc, smem, [&](int row, int c8, const float (&v)[8]) {
                bf16_t* q = YA + (size_t)(row0 + row) * 512 + col0 + c8;
                float y[8]; ld8(q, y);
                UNROLL for (int i = 0; i < 8; ++i) y[i] *= v[i];
                st8(q, y);
            });
        });
    }
    else if constexpr (PH == PH_NA_NORM) { ph_na_norm(p, L); }
    else if constexpr (PH == PH_NA_ATT) { ph_na_att(p, L, smem); }
    else if constexpr (PH == PH_ML_SCAN) { ph_ml_scan(p, L, smem); }
    else if constexpr (PH == PH_ML_READ) { ph_ml_read(p, L, ntl); }
    else if constexpr (PH == PH_GEMM_G) {
        bf16_t* G = (bf16_t*)(ws + OFF_GATES);
        gemm256(HX, ntl, WINT + (size_t)(RW_COLS + NA_COLS + ML_COLS) * DM, GATE_COLS, DM, smem, tp, [&](int row, int col, const float (&v)[8]) {
            float y[8];
            UNROLL for (int i = 0; i < 8; ++i) y[i] = sigm(v[i]);
            st8(G + (size_t)row * GATE_COLS + col, y);
        });
    }
    else if constexpr (PH == PH_MERGE) {
        const bf16_t* G = (const bf16_t*)(ws + OFF_GATES); bf16_t* MG = (bf16_t*)(ws + OFF_HX);
        _Pragma("unroll 1") for (int br = 0; br < 3; ++br) {
            gemm256((const bf16_t*)(ws + OFF_YA + (size_t)br * SZ_Y1), ntl, (const bf16_t*)(ws + OFF_WBT) + (size_t)br * 1024 * 512, DM, 512, smem, tp, [&](int row, int col, const float (&v)[8]) {
                float g[8], m[8];
                ld8(G + (size_t)row * GATE_COLS + br * DM + col, g);
                bf16_t* q = MG + (size_t)row * DM + col;
                if (br == 0) { UNROLL for (int i = 0; i < 8; ++i) m[i] = g[i] * v[i]; }
                else { ld8(q, m); UNROLL for (int i = 0; i < 8; ++i) m[i] += g[i] * v[i]; }
                st8(q, m);
            });
        }
    }
    else if constexpr (PH == PH_OUT) {
        const float* MOD = (const float*)(ws + OFF_MOD);
        gemm256(HX, ntl, (const bf16_t*)(ws + OFF_WOUTT), DM, DM, smem, tp, [&](int n, int c, const float (&v)[8]) {
            const float* xp = xprev_row(p, L, n) + c; float* xo = xs_row(p, n) + c; const float* g1 = MOD + mod_row(n) * 6144 + 2 * DM + c;
            const float4 xa = *(const float4*)xp, xb = *(const float4*)(xp + 4), ga = *(const float4*)g1, gb = *(const float4*)(g1 + 4);
            float4 oa, ob;
            oa.x = xa.x + ga.x * v[0]; oa.y = xa.y + ga.y * v[1]; oa.z = xa.z + ga.z * v[2]; oa.w = xa.w + ga.w * v[3];
            ob.x = xb.x + gb.x * v[4]; ob.y = xb.y + gb.y * v[5]; ob.z = xb.z + gb.z * v[6]; ob.w = xb.w + gb.w * v[7];
            *(float4*)xo = oa; *(float4*)(xo + 4) = ob;
        });
    }
    else if constexpr (PH == PH_NORM2) {
        if (blockIdx.x == 0 && tid < 384) ((int*)(ws + OFF_MCNT))[tid] = 0;
        ph_norm(p, L, 1, ntl); ph_conv_moe(p, L, smem);
    }
    else if constexpr (PH == PH_ROUTER) {
        typedef GC<4, 2> C;
        float* LOG = (float*)(ws + OFF_LOG);
        const bf16_t* H2LO = (const bf16_t*)(ws + OFF_H2LO); const bf16_t* RH = (const bf16_t*)(ws + OFF_RTR); const bf16_t* RL = RH + 64 * 1024;
        const int wave = tid >> 6, wm = wave / 2, wn = wave % 2;
        for (int t = blockIdx.x; t < ntl / C::BM; t += gridDim.x) {
            f32x16 acc[2][2]; acc_zero(acc);
            const bf16_t* A0 = HX + (size_t)t * C::BM * DM; const bf16_t* A1 = H2LO + (size_t)t * C::BM * DM;
            gemm_tile<4, 2, 3, false>(acc, [&](int r) { return A0 + (size_t)r * DM; }, RH, DM, 0, 64, DM, smem, nullptr);
            gemm_tile<4, 2, 3, false>(acc, [&](int r) { return A1 + (size_t)r * DM; }, RH, DM, 0, 64, DM, smem, nullptr);
            gemm_tile<4, 2, 3, false>(acc, [&](int r) { return A0 + (size_t)r * DM; }, RL, DM, 0, 64, DM, smem, nullptr);
            epi_rows(acc, smem, [&](int row, int c8, const float (&v)[8]) {
                if (wn == 0) {
                    float* q = LOG + (size_t)(t * C::BM + wm * 64 + row) * 64 + c8;
                    *(float4*)q = make_float4(v[0], v[1], v[2], v[3]); *(float4*)(q + 4) = make_float4(v[4], v[5], v[6], v[7]);
                }
            });
        }
    }
    else if constexpr (PH == PH_ROUTE) { ph_route(p, L, ntl, smem); }
    else if constexpr (PH == PH_SHARED) {
        ph_moe_scatter(p, ntl, smem);
        bf16_t* SA = (bf16_t*)(ws + OFF_SA);
        gemm256_pair(HX, ntl, (const bf16_t*)(ws + OFF_SGUT), 512, DM, smem, tp, [&](int row, int col, const float (&g)[8], const float (&u)[8]) {
            float a[8];
            UNROLL for (int i = 0; i < 8; ++i) a[i] = g[i] / (1.f + __expf(-g[i])) * u[i];
            st8(SA + (size_t)row * 256 + (col >> 8) * 128 + (col & 127), a);
        });
    }
    else if constexpr (PH == PH_MOE_EXP) { const int cb = sub * MOE_CHUNK; ph_moe_exp(p, cb, min(cb + MOE_CHUNK, ntl), smem, tp); }
    else if constexpr (PH == PH_MOE_COMB) {
        const int cb = sub * MOE_CHUNK, ce = min(cb + MOE_CHUNK, ntl);
        const float* MOD = (const float*)(ws + OFF_MOD); const bf16_t* YBUF = (const bf16_t*)(ws + OFF_YBUF);
        gemm256((const bf16_t*)(ws + OFF_SA) + (size_t)cb * 256, ce - cb, (const bf16_t*)(ws + OFF_SDT), DM, 256, smem, tp, [&](int rl, int c, const float (&v)[8]) {
            const int n = cb + rl;
            float s[8];
            UNROLL for (int i = 0; i < 8; ++i) s[i] = v[i];
            _Pragma("unroll 2") for (int k = 0; k < 8; ++k) { float y[8]; ld8(YBUF + ((size_t)rl * 8 + k) * DM + c, y); UNROLL for (int i = 0; i < 8; ++i) s[i] += y[i]; }
            float* xo = xs_row(p, n) + c; const float* g2 = MOD + mod_row(n) * 6144 + 5 * DM + c;
            float4 xa = *(const float4*)xo, xb = *(const float4*)(xo + 4); const float4 ga = *(const float4*)g2, gb = *(const float4*)(g2 + 4);
            xa.x += ga.x * s[0]; xa.y += ga.y * s[1]; xa.z += ga.z * s[2]; xa.w += ga.w * s[3];
            xb.x += gb.x * s[4]; xb.y += gb.y * s[5]; xb.z += gb.z * s[6]; xb.w += gb.w * s[7];
            *(float4*)xo = xa; *(float4*)(xo + 4) = xb;
        });
    }
}

template <int PH> __global__ void __launch_bounds__(NTHREADS, 2) k_phase(Params p, int L, int sub) {
    extern __shared__ __attribute__((aligned(16))) char smem[];
    run_phase<PH>(p, L, sub, smem, Topo{(int)(blockIdx.x & 7), (int)(blockIdx.x >> 3), (int)((gridDim.x + 7 - (blockIdx.x & 7)) >> 3)});
}


#ifndef N_LAUNCH_MODE
#define N_LAUNCH_MODE 1
#endif
#ifndef MEGA_SKIP
#define MEGA_SKIP 0ull
#endif
#ifndef MEGA_REPEAT
#define MEGA_REPEAT 0ull
#endif
#define PHASE(PH, sub) do { if constexpr (!((MEGA_SKIP >> PH) & 1ull)) { run_phase<PH>(p, L, sub, smem, tp); xcd_barrier(bar); if constexpr ((MEGA_REPEAT >> PH) & 1ull) { run_phase<PH>(p, L, sub, smem, tp); xcd_barrier(bar); } } } while (0)
__global__ void __launch_bounds__(NTHREADS, 2) k_mega(Params p) {
    extern __shared__ __attribute__((aligned(16))) char smem[];
    volatile LAS unsigned* st = (volatile LAS unsigned*)(smem + LDS_BYTES);
    if (threadIdx.x == 0) { st[0] = 0u; st[1] = 0u; st[2] = 0u; st[3] = 0u; }
    __syncthreads();
    const XcdBarrier bar = xcd_barrier_post((unsigned*)(p.ws + OFF_BAR), st);
    Topo tp{(int)(blockIdx.x & 7), (int)(blockIdx.x >> 3), (int)((gridDim.x + 7 - (blockIdx.x & 7)) >> 3)};
    for (int L = 0; L < 2; ++L) {
        const int ntl = L == 0 ? NT : NX;
        PHASE(PH_MODCONV, 0);
        if (st[1] == 8u && st[0] != 0u) { tp.x = (int)st[2]; tp.r = (int)st[3]; tp.n = (int)st[0]; }
        PHASE(PH_HX, 0);
        PHASE(PH_GEMM_R, 0);
        PHASE(PH_RW_PREP, 0);
        PHASE(PH_RW_SCAN, 0);
        PHASE(PH_RW_READ, 0);
        PHASE(PH_RW_G, 0);
        PHASE(PH_GEMM_N, 0);
        PHASE(PH_NA_NORM, 0);
        PHASE(PH_NA_ATT, 0);
        PHASE(PH_GEMM_M, 0);
        PHASE(PH_ML_SCAN, 0);
        PHASE(PH_ML_READ, 0);
        PHASE(PH_GEMM_G, 0);
        PHASE(PH_MERGE, 0);
        PHASE(PH_OUT, 0);
        PHASE(PH_NORM2, 0);
        PHASE(PH_ROUTER, 0);
        PHASE(PH_ROUTE, 0);
        PHASE(PH_SHARED, 0);
        for (int c = 0; c * MOE_CHUNK < ntl; ++c) {
            PHASE(PH_MOE_EXP, c);
            PHASE(PH_MOE_COMB, c);
        }
    }
}

template <int PH> static void launch_phase(const Params& p, int L, int sub, hipStream_t stream) {
    static bool attr = false;
    if (!attr) { (void)hipFuncSetAttribute((const void*)k_phase<PH>, hipFuncAttributeMaxDynamicSharedMemorySize, LDS_BYTES); attr = true; }
    hipLaunchKernelGGL(k_phase<PH>, dim3(256), dim3(NTHREADS), LDS_BYTES, stream, p, L, sub);
}

extern "C" void kernel_launch(void* const* d_in, const int* in_sizes, int n_in, void* d_out, int out_size, void* d_ws, size_t ws_size, hipStream_t stream) {
    if (n_in != N_IN || ws_size < WS_END) { fprintf(stderr, "kernel_launch: unexpected inputs (%d) or workspace (%zu < %zu)\n", n_in, ws_size, (size_t)WS_END); return; }
    Params p{};
    for (int i = 0; i < N_IN; ++i) p.in[i] = (const float*)d_in[i];
    p.out = (float*)d_out; p.ws = (char*)d_ws;
#if N_LAUNCH_MODE == 1
    static int grid = 0;
    if (grid == 0) {
        int dev = 0, cus = 0;
        if (hipGetDevice(&dev) != hipSuccess || hipDeviceGetAttribute(&cus, hipDeviceAttributeMultiprocessorCount, dev) != hipSuccess) { grid = -1; return; }
        if (hipFuncSetAttribute((const void*)k_mega, hipFuncAttributeMaxDynamicSharedMemorySize, LDS_BYTES + 256) != hipSuccess) { grid = -1; return; }
        grid = cus;
    }
    if (grid <= 0) return;
    (void)hipMemsetAsync((char*)d_ws + OFF_BAR, 0, XCD_BAR_WORDS * sizeof(unsigned), stream);
    hipLaunchKernelGGL(k_mega, dim3(grid), dim3(NTHREADS), LDS_BYTES + 256, stream, p);
    return;
#endif
    for (int L = 0; L < 2; ++L) {
        const int ntl = L == 0 ? NT : NX;
        launch_phase<PH_MODCONV>(p, L, 0, stream);
        launch_phase<PH_HX>(p, L, 0, stream);
        launch_phase<PH_GEMM_R>(p, L, 0, stream);
        launch_phase<PH_RW_PREP>(p, L, 0, stream);
        launch_phase<PH_RW_SCAN>(p, L, 0, stream);
        launch_phase<PH_RW_READ>(p, L, 0, stream);
        launch_phase<PH_RW_G>(p, L, 0, stream);
        launch_phase<PH_GEMM_N>(p, L, 0, stream);
        launch_phase<PH_NA_NORM>(p, L, 0, stream);
        launch_phase<PH_NA_ATT>(p, L, 0, stream);
        launch_phase<PH_GEMM_M>(p, L, 0, stream);
        launch_phase<PH_ML_SCAN>(p, L, 0, stream);
        launch_phase<PH_ML_READ>(p, L, 0, stream);
        launch_phase<PH_GEMM_G>(p, L, 0, stream);
        launch_phase<PH_MERGE>(p, L, 0, stream);
        launch_phase<PH_OUT>(p, L, 0, stream);
        launch_phase<PH_NORM2>(p, L, 0, stream);
        launch_phase<PH_ROUTER>(p, L, 0, stream);
        launch_phase<PH_ROUTE>(p, L, 0, stream);
        launch_phase<PH_SHARED>(p, L, 0, stream);
        for (int c = 0; c * MOE_CHUNK < ntl; ++c) {
            launch_phase<PH_MOE_EXP>(p, L, c, stream);
            launch_phase<PH_MOE_COMB>(p, L, c, stream);
        }
    }
}
```

```cpp
#include <hip/hip_runtime.h>
#include <stdint.h>
#include <stdio.h>

#define DEV __device__ __forceinline__
#define UNROLL _Pragma("unroll")

typedef unsigned short bf16_t;
typedef short bf16x8 __attribute__((ext_vector_type(8)));
typedef float f32x16 __attribute__((ext_vector_type(16)));
typedef float f32x4v __attribute__((ext_vector_type(4)));
typedef unsigned u32x4 __attribute__((ext_vector_type(4)));
typedef unsigned u32x2 __attribute__((ext_vector_type(2)));

constexpr int DM = 1024, NBATCH = 16, SEQ = 2048, CTXL = 256;
constexpr int NX = NBATCH * SEQ, NC = NBATCH * CTXL, NT = NX + NC;
constexpr int RW_COLS = 1920, NA_COLS = 1536, ML_COLS = 1552, GATE_COLS = 3072, IN_COLS = 8080;
constexpr int NTHREADS = 512;
constexpr int MOE_CHUNK = 12288, MOE_ST = 768;

enum { I_X = 0, I_C, I_CTX, I_CCTX, I_WADA, I_BADA, I_N1G, I_N2G, I_WIN, I_MU, I_W0, I_W2, I_A0, I_A2, I_KK, I_KA, I_RK, I_G2,
       I_LNG, I_LNB, I_V0, I_V1, I_V2, I_QNG, I_KNG, I_RPB, I_IB, I_FB, I_MNG, I_WBR, I_WOUT, I_RTR, I_MB, I_MWG, I_MWU, I_MWD,
       I_SG, I_SU, I_SD, N_IN };

constexpr size_t OFF_BAR = 0;
constexpr size_t OFF_MOD = 16384;
constexpr size_t OFF_WINT = OFF_MOD + 417792;
constexpr size_t OFF_WBT = OFF_WINT + (size_t)IN_COLS * 1024 * 2;
constexpr size_t OFF_WOUTT = OFF_WBT + (size_t)3 * 1024 * 512 * 2;
constexpr size_t OFF_SGUT = OFF_WOUTT + (size_t)1024 * 1024 * 2;
constexpr size_t OFF_SDT = OFF_SGUT + (size_t)512 * 1024 * 2;
constexpr size_t OFF_G2T = OFF_SDT + (size_t)1024 * 256 * 2;
constexpr size_t OFF_RTR = OFF_G2T + (size_t)512 * 128 * 2;
constexpr size_t OFF_CTXS = OFF_RTR + (size_t)2 * 64 * 1024 * 2;
constexpr size_t OFF_VF = OFF_CTXS + (size_t)NC * 1024 * 4;
constexpr size_t OFF_HX = OFF_VF + (size_t)NT * 512 * 2;
constexpr size_t OFF_BIG = OFF_HX + (size_t)NT * 1024 * 2;
constexpr size_t SZ_Y1 = (size_t)NT * 512 * 2;
constexpr size_t OFF_YA = OFF_BIG, OFF_YB = OFF_YA + SZ_Y1, OFF_YC = OFF_YB + SZ_Y1;
constexpr size_t OFF_PX = OFF_BIG + 3 * SZ_Y1;
constexpr size_t OFF_SCR = OFF_PX + (size_t)NT * RW_COLS * 2;
constexpr size_t SZ_SCR = (size_t)NT * 1152 * 2;
constexpr size_t WS_END = OFF_SCR + SZ_SCR;
constexpr size_t OFF_YS = OFF_YB;
constexpr size_t OFF_SGB = OFF_SCR;
constexpr size_t OFF_CB = OFF_SCR + (size_t)NT * 128 * 2;
constexpr size_t OFF_HS = OFF_SCR;
constexpr size_t OFF_VT = OFF_PX + (size_t)NT * 1024 * 2;
constexpr size_t OFF_VTC = OFF_VT + (size_t)NX * 512 * 2;
constexpr size_t OFF_GATES = OFF_PX;
constexpr size_t OFF_MGU = OFF_BIG;
constexpr size_t OFF_MDT = OFF_MGU + (size_t)64 * 256 * 1024 * 2;
constexpr size_t OFF_SA = OFF_MDT + (size_t)64 * 1024 * 128 * 2;
constexpr size_t OFF_EIDX = OFF_SA + (size_t)NT * 256 * 2;
constexpr size_t OFF_EW = OFF_EIDX + (size_t)NT * 8 * 4;
constexpr int SORT_CAP = 106496;
constexpr size_t OFF_SORT = OFF_EW + (size_t)NT * 8 * 4;
constexpr size_t OFF_LOG = OFF_SORT + (size_t)3 * SORT_CAP * 4;
constexpr size_t OFF_H2LO = OFF_LOG + (size_t)NT * 64 * 4;
constexpr size_t OFF_YBUF = OFF_LOG;
static_assert(OFF_YBUF + (size_t)MOE_CHUNK * 8 * 1024 * 2 <= WS_END, "moe layout");
static_assert(OFF_GATES + (size_t)NT * 3072 * 2 <= WS_END, "gates layout");
static_assert(WS_END <= (size_t)536870912, "workspace");

constexpr size_t OFF_MCNT = OFF_BAR + 14336;
constexpr int LDS_BYTES = 155648;

struct Topo { int x, r, n; };
struct Params {
    const float* in[N_IN];
    float* out;
    char* ws;
};

DEV int TID() { int t = threadIdx.x; asm volatile("" : "+v"(t)); return t; }
DEV float bf2f(bf16_t h) { return __uint_as_float(((unsigned)h) << 16); }
DEV bf16_t f2bf(float f) { unsigned u = __float_as_uint(f); u += 0x7FFFu + ((u >> 16) & 1u); return (bf16_t)(u >> 16); }
DEV unsigned pk2(float lo, float hi) { return (unsigned)f2bf(lo) | ((unsigned)f2bf(hi) << 16); }
DEV void ld8(const bf16_t* p, float (&o)[8]) {
    const u32x4 v = *(const u32x4*)p;
    o[0] = __uint_as_float(v.x << 16); o[1] = __uint_as_float(v.x & 0xffff0000u);
    o[2] = __uint_as_float(v.y << 16); o[3] = __uint_as_float(v.y & 0xffff0000u);
    o[4] = __uint_as_float(v.z << 16); o[5] = __uint_as_float(v.z & 0xffff0000u);
    o[6] = __uint_as_float(v.w << 16); o[7] = __uint_as_float(v.w & 0xffff0000u);
}
DEV void st8(bf16_t* p, const float (&v)[8]) {
    u32x4 o; o.x = pk2(v[0], v[1]); o.y = pk2(v[2], v[3]); o.z = pk2(v[4], v[5]); o.w = pk2(v[6], v[7]);
    *(u32x4*)p = o;
}
#define DPP_MOV(v, ctrl) __builtin_bit_cast(float, __builtin_amdgcn_update_dpp(0, __builtin_bit_cast(int, (v)), (ctrl), 0xF, 0xF, true))
DEV float sum8(float v) { v += DPP_MOV(v, 0xB1); v += DPP_MOV(v, 0x4E); v += DPP_MOV(v, 0x141); return v; }
DEV float sigm(float x) { return 1.f / (1.f + __expf(-x)); }
DEV float sigm_acc(float x) { return 1.f / (1.f + expf(-x)); }
DEV float tanh_fast(float x) { return 1.f - 2.f / (1.f + __expf(2.f * x)); }
DEV float softplus_fast(float x) { return fmaxf(x, 0.f) + __logf(1.f + __expf(-fabsf(x))); }
DEV int mod_row(int n) { return n < NX ? (n >> 11) : 16; }
DEV float* xs_row(const Params& p, int n) { return n < NX ? p.out + (size_t)n * DM : (float*)(p.ws + OFF_CTXS) + (size_t)(n - NX) * DM; }
DEV const float* xprev_row(const Params& p, int L, int n) {
    if (L == 0) return n < NX ? p.in[I_X] + (size_t)n * DM : p.in[I_CTX] + (size_t)(n - NX) * DM;
    return xs_row(p, n);
}
DEV void seq_of(int n, int& nb, int& tt, int& T) {
    if (n < NX) { nb = n & ~2047; tt = n & 2047; T = SEQ; } else { const int m = n - NX; nb = NX + (m & ~255); tt = m & 255; T = CTXL; }
}
DEV void shift8(const bf16_t* z, int ld, int nb, int tt, int T, int col0, const float* mu, float (&o)[8]) {
    float c[8], l[8], r[8];
    ld8(z + (size_t)(nb + tt) * ld + col0, c);
    if (tt > 0) ld8(z + (size_t)(nb + tt - 1) * ld + col0, l); else { UNROLL for (int i = 0; i < 8; ++i) l[i] = 0.f; }
    if (tt < T - 1) ld8(z + (size_t)(nb + tt + 1) * ld + col0, r); else { UNROLL for (int i = 0; i < 8; ++i) r[i] = 0.f; }
    UNROLL for (int i = 0; i < 8; ++i) o[i] = c[i] + mu[col0 + i] * (0.5f * (l[i] + r[i]) - c[i]);
}

constexpr int LROW = 144;
template <int WM, int WN> struct GC {
    static constexpr int BM = 64 * WM, BN = 64 * WN;
    static constexpr int AB = BM * 128, BB = BN * 128, STG = AB + BB;
    static constexpr int NA = BM / 64, NBC = BN / 64;
};
DEV void acc_zero(f32x16 (&acc)[2][2]) {
    UNROLL for (int a = 0; a < 2; ++a) UNROLL for (int b = 0; b < 2; ++b) UNROLL for (int r = 0; r < 16; ++r) acc[a][b][r] = 0.f;
}
#define GLDS16(gp, lp) __builtin_amdgcn_global_load_lds((const __attribute__((address_space(1))) void*)(gp), (__attribute__((address_space(3))) void*)(lp), 16, 0, 0)
template <int WM, int WN, int NS, bool A_LDS, class ARow>
DEV void gemm_tile(f32x16 (&acc)[2][2], ARow arow, const bf16_t* Bt, int ldb, int n0, int Nvalid, int K, char* smem, const char* alds) {
    typedef GC<WM, WN> C;
    constexpr int LPT = (A_LDS ? 0 : C::NA) + C::NBC;
    const int tid = TID(), lane = tid & 63, wave = tid >> 6, wm = wave / WN, wn = wave % WN;
    const int fr = lane & 31, fh = lane >> 5;
    const int crow = tid >> 3, cch = (tid & 7) ^ ((crow >> 1) & 7);
    const bf16_t* pa[C::NA]; const bf16_t* pb[C::NBC];
    if (!A_LDS) { UNROLL for (int i = 0; i < C::NA; ++i) pa[i] = arow(crow + 64 * i) + cch * 8; }
    UNROLL for (int i = 0; i < C::NBC; ++i) { const int n = min(n0 + crow + 64 * i, Nvalid - 1); pb[i] = Bt + (size_t)n * ldb + cch * 8; }
    const int nk = K >> 6;
#define GT_ISSUE(kt, stg) do { char* sb_ = smem + (stg) * C::STG + tid * 16; \
        if (!A_LDS) { UNROLL for (int i = 0; i < C::NA; ++i) GLDS16(pa[i] + (kt) * 64, sb_ + i * 8192); } \
        UNROLL for (int i = 0; i < C::NBC; ++i) GLDS16(pb[i] + (kt) * 64, sb_ + C::AB + i * 8192); } while (0)
    const int sw = (fr >> 1) & 7;
    int offk[4];
    UNROLL for (int ks = 0; ks < 4; ++ks) offk[ks] = ((2 * ks + fh) ^ sw) * 16;
    const int a_base = (wm * 64 + fr) * 128, b_base = (wn * 64 + fr) * 128;
    UNROLL for (int s = 0; s < NS - 1; ++s) if (s < nk) GT_ISSUE(s, s);
    int stg = 0, nstg = NS - 1;
    for (int kt = 0; kt < nk; ++kt) {
        if (NS == 3 && kt + 1 < nk) asm volatile("s_waitcnt vmcnt(%0)" :: "n"(LPT) : "memory");
        else asm volatile("s_waitcnt vmcnt(0)" ::: "memory");
        __builtin_amdgcn_s_barrier();
        asm volatile("" ::: "memory");
        const bool more = kt + NS - 1 < nk;
        const char* As_ = A_LDS ? alds + kt * C::AB : smem + stg * C::STG; const char* Bs_ = smem + stg * C::STG + C::AB;
        char* db_ = smem + nstg * C::STG + tid * 16;
        bf16x8 af[2][2], bfv[2][2];
        UNROLL for (int mi = 0; mi < 2; ++mi) af[0][mi] = *(const bf16x8*)(As_ + a_base + mi * 4096 + offk[0]);
        UNROLL for (int ni = 0; ni < 2; ++ni) bfv[0][ni] = *(const bf16x8*)(Bs_ + b_base + ni * 4096 + offk[0]);
        UNROLL for (int ks = 0; ks < 4; ++ks) {
            const int cur = ks & 1, nxt = cur ^ 1;
            if (ks < 3) {
                UNROLL for (int mi = 0; mi < 2; ++mi) af[nxt][mi] = *(const bf16x8*)(As_ + a_base + mi * 4096 + offk[ks + 1]);
                UNROLL for (int ni = 0; ni < 2; ++ni) bfv[nxt][ni] = *(const bf16x8*)(Bs_ + b_base + ni * 4096 + offk[ks + 1]);
            }
            UNROLL for (int mi = 0; mi < 2; ++mi) UNROLL for (int ni = 0; ni < 2; ++ni)
                acc[mi][ni] = __builtin_amdgcn_mfma_f32_32x32x16_bf16(af[cur][mi], bfv[cur][ni], acc[mi][ni], 0, 0, 0);
            if (more) {
                UNROLL for (int pc = 0; pc < LPT; ++pc) if (pc * 4 / LPT == ks) {
                    if (!A_LDS && pc < C::NA) GLDS16(pa[pc] + (kt + NS - 1) * 64, db_ + pc * 8192);
                    else { const int ib = pc - (A_LDS ? 0 : C::NA); GLDS16(pb[ib] + (kt + NS - 1) * 64, db_ + C::AB + ib * 8192); }
                }
            }
            __builtin_amdgcn_sched_barrier(0);
        }
        stg = stg + 1 == NS ? 0 : stg + 1; nstg = nstg + 1 == NS ? 0 : nstg + 1;
    }
    __syncthreads();
#undef GT_ISSUE
}
#define ACC_ROW(mi, r, fh) ((mi) * 32 + ((r) & 3) + 8 * ((r) >> 2) + 4 * (fh))

constexpr int EPI_SLAB = 32 * 68 * 4;
template <class F> DEV void epi_rows(const f32x16 (&acc)[2][2], char* smem, F f) {
    const int lane = TID() & 63, wave = TID() >> 6, fr = lane & 31, fh = lane >> 5;
    float* st = (float*)(smem + wave * EPI_SLAB);
    UNROLL for (int mi = 0; mi < 2; ++mi) {
        UNROLL for (int ni = 0; ni < 2; ++ni) UNROLL for (int r = 0; r < 16; ++r)
            st[((r & 3) + 8 * (r >> 2) + 4 * fh) * 68 + ni * 32 + fr] = acc[mi][ni][r];
        UNROLL for (int it = 0; it < 4; ++it) {
            const int row = it * 8 + (lane >> 3), c8 = (lane & 7) * 8;
            const float4 a = *(const float4*)(st + row * 68 + c8), b = *(const float4*)(st + row * 68 + c8 + 4);
            float v[8] = {a.x, a.y, a.z, a.w, b.x, b.y, b.z, b.w};
            f(mi * 32 + row, c8, v);
        }
    }
    __syncthreads();
}


template <class F> DEV void epi_cols(const f32x16 (&acc)[2][2], char* smem, F f) {
    const int lane = TID() & 63, wave = TID() >> 6, fr = lane & 31, fh = lane >> 5;
    float* st = (float*)(smem + wave * EPI_SLAB);
    UNROLL for (int mi = 0; mi < 2; ++mi) {
        UNROLL for (int ni = 0; ni < 2; ++ni) UNROLL for (int r = 0; r < 16; ++r)
            st[((r & 3) + 8 * (r >> 2) + 4 * fh) * 68 + ni * 32 + fr] = acc[mi][ni][r];
        UNROLL for (int it = 0; it < 4; ++it) {
            float v[8];
            UNROLL for (int i = 0; i < 8; ++i) v[i] = st[(it * 8 + i) * 68 + lane];
            f(mi * 32 + it * 8, lane, v);
        }
    }
    __syncthreads();
}

struct TileOrder {
    int x, nN, cx, total;
    DEV TileOrder(const Topo& tp, int nM, int nN_) { x = tp.x; nN = nN_; cx = nM > x ? (nM - x + 7) >> 3 : 0; total = ((cx + 3) >> 2) * 4 * nN; }
    DEV bool get(int q, int& pm, int& pn) const { const int per = 4 * nN, qi = q / per, rem = q - qi * per, i = 4 * qi + (rem & 3); pn = rem >> 2; pm = x + 8 * i; return i < cx; }
};
template <int WM, int WN, class Epi>
DEV void gemm_phase(const bf16_t* A, int lda, int M, const bf16_t* Bt, int ldb, int N, int K, char* smem, const Topo& tp, Epi epi) {
    typedef GC<WM, WN> C;
    const int nM = M / C::BM, nN = (N + C::BN - 1) / C::BN;
    const int wave = TID() >> 6, wm = wave / WN, wn = wave % WN;
    const TileOrder ord(tp, nM, nN);
    for (int q = tp.r; q < ord.total; q += tp.n) {
        int pm, pn; if (!ord.get(q, pm, pn)) continue;
        f32x16 acc[2][2]; acc_zero(acc);
        const bf16_t* Ab = A + (size_t)pm * C::BM * lda;
        gemm_tile<WM, WN, 3, false>(acc, [&](int r) { return Ab + (size_t)r * lda; }, Bt, ldb, pn * C::BN, N, K, smem, nullptr);
        epi(acc, pm * C::BM + wm * 64, pn * C::BN + wn * 64);
    }
}

namespace pg8 {
#define PG8_LAS __attribute__((address_space(3)))
typedef float f32x4 __attribute__((ext_vector_type(4)));
constexpr int BM = 256, BK = 64, HALF = 128, HTB = HALF * BK * 2  , STAGE_BYTES = 8 * HTB, NXCD = 8, WGM = 8;

__host__ __device__ __forceinline__ int lds_byte(int r, int c) { const int st = (r >> 4) * 2 + (c >> 5), rr = r & 15, cc = c & 31, ob = rr * 64 + cc * 2; return st * 1024 + (ob ^ (((ob >> 9) & 1) << 5)); }
__host__ __device__ __forceinline__ void stage_rc(int b, int& R, int& C) { const int st = b / 1024, sb = b % 1024, swz = sb ^ (((sb >> 9) & 1) << 5); R = (st >> 1) * 16 + swz / 64; C = (st & 1) * 32 + (swz % 64) / 2; }
__host__ __device__ __forceinline__ int perm32(int rho) { const int n = rho >> 4, i = rho & 15; return 8 * (i >> 2) + 4 * n + (i & 3); }

struct Unit { int pm, pn; };
struct Gemm { const bf16_t* A; const bf16_t* Bt; int M, N, K; };
template <class Epi, class Sched, bool ALIGN_EPI = false, bool SP2 = false>
__device__ __forceinline__ void gemm_phase(PG8_LAS unsigned char* lds, const Gemm g, const Sched& S, const Epi& E) {
    const int tid = TID(), wid = __builtin_amdgcn_readfirstlane(tid >> 6), lane = tid & 63, wr = wid >> 2, wc = wid & 3, fr = lane & 15, fq = lane >> 4;
    const int K = g.K, nt = K / BK;
    unsigned voffA[2], voffB[2];
#pragma unroll
    for (int i = 0; i < 2; ++i) { int R, C; stage_rc(tid * 16 + i * 8192, R, C); const int Rb = Epi::PERM ? ((R & ~31) + perm32(R & 31)) : R;
        voffA[i] = (unsigned)(R * K + C) * 2u; voffB[i] = (unsigned)(Rb * K + C) * 2u; }
    const size_t kstep = (size_t)(BK * 2);
    const size_t hstep = (size_t)HALF * K * 2;
    const size_t tstep = 2 * hstep;
    const unsigned ldsw = (unsigned)wid * 1024u;
    const int aoff = lds_byte(wr * 64 + fr, fq * 8), boff = lds_byte(wc * 32 + fr, fq * 8);
#define PG8_SA(b, h) (((b) * 2 + (h)) * HTB)
#define PG8_SB(b, h) ((4 + (b) * 2 + (h)) * HTB)
#define PG8_STAGE(bufoff, gbase, voff) do { _Pragma("unroll") for (int _i = 0; _i < 2; ++_i) \
        __builtin_amdgcn_global_load_lds((const unsigned*)((const char*)(gbase) + (voff)[_i]), (PG8_LAS unsigned*)(lds + (bufoff) + ldsw + _i * 8192), 16, 0, 0); } while (0)
#define PG8_LDA(dst, b, h) do { _Pragma("unroll") for (int m = 0; m < 4; ++m) _Pragma("unroll") for (int k = 0; k < 2; ++k) dst[m][k] = *(const PG8_LAS bf16x8*)(lds + PG8_SA(b, h) + aoff + m * 2048 + k * 1024); } while (0)
#define PG8_LDB(dst, b, h) do { _Pragma("unroll") for (int n = 0; n < 2; ++n) _Pragma("unroll") for (int k = 0; k < 2; ++k) dst[n][k] = *(const PG8_LAS bf16x8*)(lds + PG8_SB(b, h) + boff + n * 2048 + k * 1024); } while (0)
#define PG8_MMA(ai, bj, At, Bt) do { __builtin_amdgcn_s_setprio(1); _Pragma("unroll") for (int m = 0; m < 4; ++m) _Pragma("unroll") for (int n = 0; n < 2; ++n) _Pragma("unroll") for (int k = 0; k < 2; ++k) \
        acc[ai][bj][m][n] = __builtin_amdgcn_mfma_f32_16x16x32_bf16(Bt[n][k], At[m][k], acc[ai][bj][m][n], 0, 0, 0); __builtin_amdgcn_s_setprio(0); } while (0)
#define PG8_WAIT_V(n) asm volatile("s_waitcnt vmcnt(" #n ")" ::: "memory")
#define PG8_WAIT_L(n) asm volatile("s_waitcnt lgkmcnt(" #n ")" ::: "memory")
#define PG8_BAR __builtin_amdgcn_s_barrier()
#define PG8_SCHED __builtin_amdgcn_sched_barrier(0)
    Unit cur, nxt; int ui = 0;
    if (!S.next(0, cur)) return;
    f32x4 acc[2][2][4][2];
#pragma unroll
    for (int a = 0; a < 2; ++a)
#pragma unroll
        for (int b = 0; b < 2; ++b)
#pragma unroll
            for (int m = 0; m < 4; ++m)
#pragma unroll
                for (int n = 0; n < 2; ++n) acc[a][b][m][n] = (f32x4){0.f, 0.f, 0.f, 0.f};
    bf16x8 At[4][2], B0[2][2], B1[2][2];
    const char* cA = (const char*)g.A + (size_t)cur.pm * tstep; const char* cB = (const char*)g.Bt + (size_t)cur.pn * tstep;
    S.a_ready(cur);
    if constexpr (SP2) {
        PG8_STAGE(PG8_SB(0, 0), cB, voffB); PG8_STAGE(PG8_SB(0, 1), cB + hstep, voffB); PG8_STAGE(PG8_SA(0, 0), cA, voffA); PG8_STAGE(PG8_SA(0, 1), cA + hstep, voffA);
        if (wr == 1) PG8_BAR;
        PG8_WAIT_V(2); PG8_BAR;
        PG8_STAGE(PG8_SB(1, 0), cB + kstep, voffB); PG8_STAGE(PG8_SA(1, 0), cA + kstep, voffA); PG8_STAGE(PG8_SB(1, 1), cB + hstep + kstep, voffB);
        PG8_WAIT_V(6); PG8_BAR;
    } else {
        PG8_STAGE(PG8_SB(0, 0), cB, voffB); PG8_STAGE(PG8_SA(0, 0), cA, voffA); PG8_STAGE(PG8_SB(0, 1), cB + hstep, voffB); PG8_STAGE(PG8_SA(0, 1), cA + hstep, voffA);
        if (wr == 1) PG8_BAR;
        PG8_WAIT_V(4); PG8_BAR;
        PG8_STAGE(PG8_SB(1, 0), cB + kstep, voffB); PG8_STAGE(PG8_SA(1, 0), cA + kstep, voffA); PG8_STAGE(PG8_SB(1, 1), cB + hstep + kstep, voffB);
        PG8_WAIT_V(6); PG8_BAR;
    }
    for (;;) {
        const bool has_next = S.next(ui + 1, nxt);
        const char* nA = has_next ? (const char*)g.A + (size_t)nxt.pm * tstep : cA; const char* nB = has_next ? (const char*)g.Bt + (size_t)nxt.pn * tstep : cB;
        for (int t = 0; t < nt; t += 2) {
            const bool last = (t == nt - 2);
            const char* a1 = cA + (size_t)(t + 1) * kstep;
            const char* a2 = last ? nA : cA + (size_t)(t + 2) * kstep; const char* b2 = last ? nB : cB + (size_t)(t + 2) * kstep;
            const char* a3 = a2 + kstep; const char* b3 = b2 + kstep;
            if (last && has_next) S.a_ready(nxt);
            if constexpr (SP2) {
            PG8_LDB(B0, 0, 0); PG8_LDB(B1, 0, 1); PG8_SCHED; PG8_LDA(At, 0, 0); PG8_STAGE(PG8_SA(1, 1), a1 + hstep, voffA);
            PG8_WAIT_V(8); PG8_WAIT_L(0); PG8_BAR; PG8_MMA(0, 0, At, B0); PG8_MMA(0, 1, At, B1); PG8_BAR; PG8_SCHED;
            PG8_LDA(At, 0, 1); PG8_STAGE(PG8_SB(0, 0), b2, voffB); PG8_STAGE(PG8_SB(0, 1), b2 + hstep, voffB); PG8_STAGE(PG8_SA(0, 0), a2, voffA);
            PG8_WAIT_V(8); PG8_WAIT_L(0); PG8_BAR; PG8_MMA(1, 0, At, B0); PG8_MMA(1, 1, At, B1); PG8_BAR; PG8_SCHED;
            PG8_LDB(B0, 1, 0); PG8_LDB(B1, 1, 1); PG8_SCHED; PG8_LDA(At, 1, 0); PG8_STAGE(PG8_SA(0, 1), a2 + hstep, voffA);
            PG8_WAIT_V(8); PG8_WAIT_L(0); PG8_BAR; PG8_MMA(0, 0, At, B0); PG8_MMA(0, 1, At, B1); PG8_BAR; PG8_SCHED;
            PG8_LDA(At, 1, 1); PG8_STAGE(PG8_SB(1, 0), b3, voffB); PG8_STAGE(PG8_SB(1, 1), b3 + hstep, voffB); PG8_STAGE(PG8_SA(1, 0), a3, voffA);
            PG8_WAIT_V(8); PG8_WAIT_L(0); PG8_BAR; PG8_MMA(1, 0, At, B0); PG8_MMA(1, 1, At, B1); PG8_BAR; PG8_SCHED;
            } else {
            PG8_LDB(B0, 0, 0); PG8_SCHED; PG8_LDA(At, 0, 0); PG8_STAGE(PG8_SA(1, 1), a1 + hstep, voffA);
            PG8_WAIT_L(8); PG8_BAR; PG8_WAIT_L(0); PG8_MMA(0, 0, At, B0); PG8_BAR; PG8_SCHED;
            PG8_LDB(B1, 0, 1); PG8_STAGE(PG8_SB(0, 0), b2, voffB);
            PG8_BAR; PG8_WAIT_L(0); PG8_MMA(0, 1, At, B1); PG8_BAR;
            PG8_LDA(At, 0, 1); PG8_STAGE(PG8_SA(0, 0), a2, voffA);
            PG8_BAR; PG8_WAIT_L(0); PG8_MMA(1, 0, At, B0); PG8_BAR; PG8_SCHED;
            PG8_STAGE(PG8_SB(0, 1), b2 + hstep, voffB);
            PG8_WAIT_V(6); PG8_BAR; PG8_MMA(1, 1, At, B1); PG8_BAR;
            PG8_LDB(B0, 1, 0); PG8_SCHED; PG8_LDA(At, 1, 0); PG8_STAGE(PG8_SA(0, 1), a2 + hstep, voffA);
            PG8_WAIT_L(8); PG8_BAR; PG8_WAIT_L(0); PG8_MMA(0, 0, At, B0); PG8_BAR; PG8_SCHED;
            PG8_LDB(B1, 1, 1); PG8_STAGE(PG8_SB(1, 0), b3, voffB);
            PG8_BAR; PG8_WAIT_L(0); PG8_MMA(0, 1, At, B1); PG8_BAR;
            PG8_LDA(At, 1, 1); PG8_STAGE(PG8_SA(1, 0), a3, voffA);
            PG8_BAR; PG8_WAIT_L(0); PG8_MMA(1, 0, At, B0); PG8_BAR; PG8_SCHED;
            PG8_STAGE(PG8_SB(1, 1), b3 + hstep, voffB);
            PG8_WAIT_V(6); PG8_BAR; PG8_MMA(1, 1, At, B1); PG8_BAR;
            }
        }
        if constexpr (ALIGN_EPI) { if (wr == 0) PG8_BAR; }
        if constexpr (!Epi::AFTER_DRAIN) { E(acc, cur, wr, wc, fr, fq); S.done(cur); }
        if (!has_next) break;
#pragma unroll
        for (int a = 0; a < 2; ++a)
#pragma unroll
            for (int b = 0; b < 2; ++b)
#pragma unroll
                for (int m = 0; m < 4; ++m)
#pragma unroll
                    for (int n = 0; n < 2; ++n) acc[a][b][m][n] = (f32x4){0.f, 0.f, 0.f, 0.f};
        cur = nxt; cA = nA; cB = nB; ++ui;
        if constexpr (ALIGN_EPI) { if (wr == 1) PG8_BAR; }
    }
    PG8_WAIT_V(0);
    if constexpr (!ALIGN_EPI) { if (wr == 0) PG8_BAR; }
    PG8_BAR;
    if constexpr (Epi::AFTER_DRAIN) { E.fused(acc, cur, wr, wc, fr, fq, lds, wid, lane); S.done(cur); }
#undef PG8_SA
#undef PG8_SB
#undef PG8_STAGE
#undef PG8_LDA
#undef PG8_LDB
#undef PG8_MMA
#undef PG8_WAIT_V
#undef PG8_WAIT_L
#undef PG8_BAR
#undef PG8_SCHED
}
}
template <class F> struct EpiF {
    static constexpr bool PERM = true, AFTER_DRAIN = false; F f;
    DEV void operator()(const pg8::f32x4 (&acc)[2][2][4][2], const pg8::Unit& u, int wr, int wc, int fr, int fq) const {
        UNROLL for (int ai = 0; ai < 2; ++ai) UNROLL for (int m = 0; m < 4; ++m) {
            const int row = u.pm * 256 + ai * 128 + wr * 64 + m * 16 + fr;
            UNROLL for (int bj = 0; bj < 2; ++bj) {
                const int col = u.pn * 256 + bj * 128 + wc * 32 + 8 * fq;
                const float v[8] = {acc[ai][bj][m][0][0], acc[ai][bj][m][0][1], acc[ai][bj][m][0][2], acc[ai][bj][m][0][3],
                                    acc[ai][bj][m][1][0], acc[ai][bj][m][1][1], acc[ai][bj][m][1][2], acc[ai][bj][m][1][3]};
                f(row, col, v);
            }
        }
    }
};
template <class F> struct EpiF2 {
    static constexpr bool PERM = true, AFTER_DRAIN = false; F f;
    DEV void operator()(const pg8::f32x4 (&acc)[2][2][4][2], const pg8::Unit& u, int wr, int wc, int fr, int fq) const {
        UNROLL for (int ai = 0; ai < 2; ++ai) UNROLL for (int m = 0; m < 4; ++m) {
            const int row = u.pm * 256 + ai * 128 + wr * 64 + m * 16 + fr, col = u.pn * 256 + wc * 32 + 8 * fq;
            const float v0[8] = {acc[ai][0][m][0][0], acc[ai][0][m][0][1], acc[ai][0][m][0][2], acc[ai][0][m][0][3], acc[ai][0][m][1][0], acc[ai][0][m][1][1], acc[ai][0][m][1][2], acc[ai][0][m][1][3]};
            const float v1[8] = {acc[ai][1][m][0][0], acc[ai][1][m][0][1], acc[ai][1][m][0][2], acc[ai][1][m][0][3], acc[ai][1][m][1][0], acc[ai][1][m][1][1], acc[ai][1][m][1][2], acc[ai][1][m][1][3]};
            f(row, col, v0, v1);
        }
    }
};
struct XOrder {
    int x, r, n, nN, cx, fullq, total;
    DEV XOrder(const Topo& tp, int nM, int nN_) { x = tp.x; r = tp.r; n = tp.n; nN = nN_; cx = nM > x ? (nM - x + 7) >> 3 : 0; fullq = cx >> 2; total = cx * nN; }
    DEV bool next(int i, pg8::Unit& u) const {
        const int q = r + i * n; if (q >= total) return false;
        const int per = 4 * nN;
        if (q < fullq * per) { const int qi = q / per, rem = q - qi * per; u.pn = rem >> 2; u.pm = x + 8 * (4 * qi + (rem & 3)); }
        else { const int rem = q - fullq * per, cq = cx - 4 * fullq; u.pn = rem / cq; u.pm = x + 8 * (4 * fullq + rem % cq); }
        return true;
    }
    DEV void a_ready(const pg8::Unit&) const {}
    DEV void done(const pg8::Unit&) const {}
};
template <class F> DEV void gemm256_pair(const bf16_t* A, int M, const bf16_t* Bt, int N, int K, char* smem, const Topo& tp, F f) {
    const pg8::Gemm g{A, Bt, M, N, K};
    const XOrder S(tp, M / 256, (N + 255) / 256);
    const EpiF2<F> E{f};
    pg8::gemm_phase<EpiF2<F>, XOrder, true, true>((PG8_LAS unsigned char*)smem, g, S, E);
}
template <class F> DEV void gemm256(const bf16_t* A, int M, const bf16_t* Bt, int N, int K, char* smem, const Topo& tp, F f) {
    const pg8::Gemm g{A, Bt, M, N, K};
    const XOrder S(tp, M / 256, (N + 255) / 256);
    const EpiF<F> E{f};
    pg8::gemm_phase<EpiF<F>, XOrder, true, true>((PG8_LAS unsigned char*)smem, g, S, E);
}

DEV void ph_mod(const Params& p, int L, char* smem) {
    const int tid = TID();
    float* sc = (float*)smem;
    float* red = sc + 17 * 1024;
    const float* c = p.in[I_C]; const float* cc = p.in[I_CCTX];
    for (int i = tid; i < 17 * 1024; i += NTHREADS) { const float v = i < 16 * 1024 ? c[i] : cc[i - 16 * 1024]; sc[i] = v / (1.f + expf(-v)); }
    __syncthreads();
    const float* W = p.in[I_WADA] + (size_t)L * 1024 * 6144; const float* bA = p.in[I_BADA] + (size_t)L * 6144;
    float* MOD = (float*)(p.ws + OFF_MOD);
    for (int u = blockIdx.x; u < 192; u += gridDim.x) {
        const int ci = tid & 31, ks = tid >> 5, j = u * 32 + ci;
        float acc[17];
        UNROLL for (int r = 0; r < 17; ++r) acc[r] = 0.f;
        for (int k = ks * 64; k < ks * 64 + 64; ++k) {
            const float w = W[(size_t)k * 6144 + j];
            UNROLL for (int r = 0; r < 17; ++r) acc[r] += sc[r * 1024 + k] * w;
        }
        UNROLL for (int r = 0; r < 17; ++r) red[(ks * 17 + r) * 32 + ci] = acc[r];
        __syncthreads();
        for (int i = tid; i < 17 * 32; i += NTHREADS) {
            const int r = i >> 5, c2 = i & 31; float s = bA[u * 32 + c2];
            for (int k2 = 0; k2 < 16; ++k2) s += red[(k2 * 17 + r) * 32 + c2];
            MOD[r * 6144 + u * 32 + c2] = s;
        }
        __syncthreads();
    }
}
DEV void conv_job(const float* s0, const float* s1, bf16_t* d, int K, int N, int mode, int nmat, size_t sstride, size_t dstride, char* smem) {
    float* tile = (float*)smem;
    const int tid = TID();
    const int tK = K / 64, tN = (mode == 1 || mode == 3) ? (2 * N) / 64 : (N + 63) / 64, per = tK * tN;
    for (int t = blockIdx.x; t < per * nmat; t += gridDim.x) {
        const int mat = t / per, r = t % per, tk = r / tN, tn = r % tN;
        const float* a0 = s0 + (size_t)mat * sstride; const float* a1 = s1 ? s1 + (size_t)mat * sstride : nullptr;
        bf16_t* dd = d + (size_t)mat * dstride;
        UNROLL for (int i = 0; i < 8; ++i) {
            const int cc = tid & 63, k = (tid >> 6) + 8 * i; float v;
            if (mode == 1) { const float* s = (cc >> 5) ? a1 : a0; v = s[(size_t)(tk * 64 + k) * N + tn * 32 + (cc & 31)]; }
            else if (mode == 3) { const float* s = ((tn >> 1) & 1) ? a1 : a0; v = s[(size_t)(tk * 64 + k) * N + (tn >> 2) * 128 + (tn & 1) * 64 + cc]; }
            else { const int n = tn * 64 + cc; v = n < N ? a0[(size_t)(tk * 64 + k) * N + n] : 0.f; }
            tile[k * 65 + cc] = v;
        }
        __syncthreads();
        UNROLL for (int i = 0; i < 8; ++i) {
            const int k = tid & 63, cc = (tid >> 6) + 8 * i; const int row = tn * 64 + cc;
            const float v = tile[k * 65 + cc];
            if (mode == 1 || mode == 3 || row < N) {
                const bf16_t hi = f2bf(v);
                dd[(size_t)row * K + tk * 64 + k] = hi;
                if (mode == 2) dd[(size_t)N * K + (size_t)row * K + tk * 64 + k] = f2bf(v - bf2f(hi));
            }
        }
        __syncthreads();
    }
}
DEV void ph_conv_mix(const Params& p, int L, char* smem) {
    char* ws = p.ws;
    conv_job(p.in[I_WIN] + (size_t)L * 1024 * IN_COLS, nullptr, (bf16_t*)(ws + OFF_WINT), 1024, IN_COLS, 0, 1, 0, 0, smem);
    conv_job(p.in[I_WBR] + (size_t)L * 3 * 512 * 1024, nullptr, (bf16_t*)(ws + OFF_WBT), 512, 1024, 0, 3, (size_t)512 * 1024, (size_t)512 * 1024, smem);
    conv_job(p.in[I_WOUT] + (size_t)L * 1024 * 1024, nullptr, (bf16_t*)(ws + OFF_WOUTT), 1024, 1024, 0, 1, 0, 0, smem);
    conv_job(p.in[I_SG] + (size_t)L * 1024 * 256, p.in[I_SU] + (size_t)L * 1024 * 256, (bf16_t*)(ws + OFF_SGUT), 1024, 256, 3, 1, 0, 0, smem);
    conv_job(p.in[I_SD] + (size_t)L * 256 * 1024, nullptr, (bf16_t*)(ws + OFF_SDT), 256, 1024, 0, 1, 0, 0, smem);
    conv_job(p.in[I_G2] + (size_t)L * 128 * 512, nullptr, (bf16_t*)(ws + OFF_G2T), 128, 512, 0, 1, 0, 0, smem);
    conv_job(p.in[I_RTR] + (size_t)L * 1024 * 64, nullptr, (bf16_t*)(ws + OFF_RTR), 1024, 64, 2, 1, 0, 0, smem);
}
DEV void ph_conv_moe(const Params& p, int L, char* smem) {
    char* ws = p.ws;
    const size_t eo = (size_t)L * 64 * 1024 * 128;
    conv_job(p.in[I_MWG] + eo, p.in[I_MWU] + eo, (bf16_t*)(ws + OFF_MGU), 1024, 128, 1, 64, (size_t)1024 * 128, (size_t)256 * 1024, smem);
    conv_job(p.in[I_MWD] + eo, nullptr, (bf16_t*)(ws + OFF_MDT), 128, 1024, 0, 64, (size_t)128 * 1024, (size_t)1024 * 128, smem);
}

DEV void ph_norm(const Params& p, int L, int which, int ntok) {
    const int lane = TID() & 63, wave = TID() >> 6;
    const float* MOD = (const float*)(p.ws + OFF_MOD);
    const float* g = p.in[which ? I_N2G : I_N1G] + (size_t)L * DM;
    bf16_t* H = (bf16_t*)(p.ws + OFF_HX); bf16_t* HLO = (bf16_t*)(p.ws + OFF_H2LO);
    for (int n0 = blockIdx.x * 8; n0 < ntok; n0 += gridDim.x * 8) {
        const int n = n0 + wave;
        const float* xr = which ? xs_row(p, n) : xprev_row(p, L, n);
        float4 v[4]; float ss = 0.f;
        UNROLL for (int i = 0; i < 4; ++i) { v[i] = *(const float4*)(xr + i * 256 + lane * 4); ss += v[i].x * v[i].x + v[i].y * v[i].y + v[i].z * v[i].z + v[i].w * v[i].w; }
        UNROLL for (int o = 1; o < 64; o <<= 1) ss += __shfl_xor(ss, o);
        const float rstd = rsqrtf(ss * (1.f / DM) + 1e-6f);
        const float* sh = MOD + mod_row(n) * 6144 + (which ? 3 : 0) * DM; const float* sc = sh + DM;
        UNROLL for (int i = 0; i < 4; ++i) {
            const int c = i * 256 + lane * 4;
            const float4 gg = *(const float4*)(g + c), s1 = *(const float4*)(sc + c), s0 = *(const float4*)(sh + c);
            const float h0 = v[i].x * rstd * gg.x * (1.f + s1.x) + s0.x, h1 = v[i].y * rstd * gg.y * (1.f + s1.y) + s0.y;
            const float h2 = v[i].z * rstd * gg.z * (1.f + s1.z) + s0.z, h3 = v[i].w * rstd * gg.w * (1.f + s1.w) + s0.w;
            u32x2 o; o.x = pk2(h0, h1); o.y = pk2(h2, h3);
            *(u32x2*)(H + (size_t)n * DM + c) = o;
            if (which) {
                u32x2 o2;
                o2.x = pk2(h0 - bf2f((bf16_t)(o.x & 0xffff)), h1 - bf2f((bf16_t)(o.x >> 16)));
                o2.y = pk2(h2 - bf2f((bf16_t)(o.y & 0xffff)), h3 - bf2f((bf16_t)(o.y >> 16)));
                *(u32x2*)(HLO + (size_t)n * DM + c) = o2;
            }
        }
    }
}

DEV void ph_rw_prep(const Params& p, int L, char* smem) {
    const int lane = TID() & 63, wave = TID() >> 6;
    float* vsh = (float*)smem + wave * 512;
    const bf16_t* PXR = (const bf16_t*)(p.ws + OFF_PX); bf16_t* VF = (bf16_t*)(p.ws + OFF_VF);
    const float* mu = p.in[I_MU] + (size_t)L * RW_COLS;
    const float* v0 = p.in[I_V0]; const float* v1 = p.in[I_V1]; const float* v2 = p.in[I_V2];
    for (int n0 = blockIdx.x * 8; n0 < NT; n0 += gridDim.x * 8) {
        const int n = n0 + wave; int nb, tt, T; seq_of(n, nb, tt, T);
        float vs[8]; shift8(PXR, RW_COLS, nb, tt, T, 1024 + lane * 8, mu, vs);
        if (L == 0) { st8(VF + (size_t)n * 512 + lane * 8, vs); }
        else {
            UNROLL for (int i = 0; i < 8; ++i) vsh[lane * 8 + i] = vs[i];
            __syncthreads();
            const int q = lane & 31, hf = lane >> 5; float t1 = 0.f;
            for (int jj = 0; jj < 256; ++jj) t1 += vsh[hf * 256 + jj] * v1[(hf * 256 + jj) * 32 + q];
            t1 += __shfl_xor(t1, 32);
            float u[8];
            UNROLL for (int i = 0; i < 8; ++i) u[i] = v0[lane * 8 + i];
            for (int q2 = 0; q2 < 32; ++q2) { const float tq = __shfl(t1, q2); UNROLL for (int i = 0; i < 8; ++i) u[i] += tq * v2[q2 * 512 + lane * 8 + i]; }
            float vf[8], o[8]; ld8(VF + (size_t)n * 512 + lane * 8, vf);
            UNROLL for (int i = 0; i < 8; ++i) o[i] = vs[i] + (vf[i] - vs[i]) * sigm(u[i]);
            st8(VF + (size_t)n * 512 + lane * 8, o);
            __syncthreads();
        }
    }
}

DEV bf16x8 pk_lohi(u32x2 lo, u32x2 hi) { u32x4 w; w.x = lo.x; w.y = lo.y; w.z = hi.x; w.w = hi.y; return __builtin_bit_cast(bf16x8, w); }
DEV bf16x8 pk_acc2(const f32x4v& a, const f32x4v& b) { u32x4 w; w.x = pk2(a[0], a[1]); w.y = pk2(a[2], a[3]); w.z = pk2(b[0], b[1]); w.w = pk2(b[2], b[3]); return __builtin_bit_cast(bf16x8, w); }
DEV bf16x8 pk_acc1(const f32x4v& a) { u32x4 w; w.x = pk2(a[0], a[1]); w.y = pk2(a[2], a[3]); w.z = 0u; w.w = 0u; return __builtin_bit_cast(bf16x8, w); }
#define MFMA16(a, b, c) __builtin_amdgcn_mfma_f32_16x16x32_bf16((a), (b), (c), 0, 0, 0)
DEV void ph_rw_scan(const Params& p, int L, char* smem) {
    const int tid = TID();
    const int wave = __builtin_amdgcn_readfirstlane(tid >> 6);
    char* AT = smem; char* BT = smem + 9216; char* KT = smem + 18432; char* RT = smem + 27648;
    char* BH = smem + 36864; char* KH = smem + 46080; char* VT = smem + 55296;
    char* W2T = smem + 64512; char* A2T = smem + 73728;
    float* PCv = (float*)(smem + 82944); float* SEGT = PCv + 64;
    char* XY = smem + 85248;
    char* T1 = XY; char* T2 = XY + 9216; float* WLf = (float*)(XY + 18432); float* ALf = (float*)(XY + 35840); float* LW = (float*)(XY + 53248);
    char* NAB = XY; char* NAK = XY + 9216; char* NRB = XY + 18432; char* NRK = XY + 27648; char* TJ = XY + 36864; float* NDF = (float*)(XY + 38912); float* YO = (float*)(XY + 43008);
    const bf16_t* PXR = (const bf16_t*)(p.ws + OFF_PX); const bf16_t* VF = (const bf16_t*)(p.ws + OFF_VF);
    bf16_t* YS = (bf16_t*)(p.ws + OFF_YS); float* CB = (float*)(p.ws + OFF_CB);
    const float* mu = p.in[I_MU] + (size_t)L * RW_COLS;
    const float* w0 = p.in[I_W0] + (size_t)L * 1024; const float* w2 = p.in[I_W2] + (size_t)L * 65536;
    const float* a0 = p.in[I_A0] + (size_t)L * 1024; const float* a2 = p.in[I_A2] + (size_t)L * 65536;
    const float* kkw = p.in[I_KK] + (size_t)L * 512; const float* kaw = p.in[I_KA] + (size_t)L * 512; const float* rkw = p.in[I_RK] + (size_t)L * 512;
    for (int u = blockIdx.x; u < 256; u += gridDim.x) {
        const int b = u >> 4, h = (u >> 1) & 7, d = u & 1;
        for (int i = tid; i < 4096; i += NTHREADS) {
            const int l = i >> 6, n = i & 63;
            *(bf16_t*)(W2T + n * LROW + l * 2) = f2bf(w2[(size_t)(d * 64 + l) * 512 + h * 64 + n]);
            *(bf16_t*)(A2T + n * LROW + l * 2) = f2bf(a2[(size_t)(d * 64 + l) * 512 + h * 64 + n]);
        }
        f32x4v sacc[4];
        UNROLL for (int i = 0; i < 4; ++i) sacc[i] = (f32x4v){0.f, 0.f, 0.f, 0.f};
        __syncthreads();
        for (int ci = 0; ci < 36; ++ci) {
            int tido = tid; asm volatile("" : "+v"(tido));
            const int lane = tido & 63, lq = lane & 15, kg = lane >> 4, ti = tido >> 3, j = tido & 7;
            const int ch = h * 64 + 8 * j;
            const bool isc = ci < 4; const int T = isc ? CTXL : SEQ, cc = isc ? ci : ci - 4;
            const int t0 = d == 0 ? cc * 64 : T - 64 * (cc + 1), nb = isc ? NX + b * CTXL : b * SEQ;
            const int tt = d == 0 ? t0 + ti : t0 + 63 - ti;
            float r8[8], k8[8], v8[8];
            {
                float x1[8], x2[8];
                shift8(PXR, RW_COLS, nb, tt, T, 1536 + d * 64 + 8 * j, mu, x1);
                shift8(PXR, RW_COLS, nb, tt, T, 1664 + d * 64 + 8 * j, mu, x2);
                UNROLL for (int i = 0; i < 8; ++i) x1[i] = tanh_fast(x1[i]);
                st8((bf16_t*)(T1 + ti * LROW) + 8 * j, x1); st8((bf16_t*)(T2 + ti * LROW) + 8 * j, x2);
                shift8(PXR, RW_COLS, nb, tt, T, h * 64 + 8 * j, mu, r8);
                shift8(PXR, RW_COLS, nb, tt, T, 512 + h * 64 + 8 * j, mu, k8);
                ld8(VF + (size_t)(nb + tt) * 512 + ch, v8);
            }
            __syncthreads();
            UNROLL for (int rep = 0; rep < 4; ++rep) {
                const int q = wave + 8 * rep, m = q >> 4, tl = q & 15, tt4 = tl >> 2, nt4 = tl & 3;
                const char* Ab = (m ? T2 : T1) + (16 * tt4 + lq) * LROW + kg * 16; const char* Bb = (m ? A2T : W2T) + (16 * nt4 + lq) * LROW + kg * 16;
                f32x4v a = {0.f, 0.f, 0.f, 0.f};
                UNROLL for (int ks = 0; ks < 2; ++ks) a = MFMA16(*(const bf16x8*)(Ab + ks * 64), *(const bf16x8*)(Bb + ks * 64), a);
                float* dst = (m ? ALf : WLf) + (16 * tt4 + 4 * kg) * 68 + 16 * nt4 + lq;
                UNROLL for (int i = 0; i < 4; ++i) dst[i * 68] = a[i];
            }
            __syncthreads();
            float av[8], bv[8], kd8[8];
            {
                const float4 wa = *(const float4*)(WLf + ti * 68 + 8 * j), wb = *(const float4*)(WLf + ti * 68 + 8 * j + 4);
                const float4 aa = *(const float4*)(ALf + ti * 68 + 8 * j), ab = *(const float4*)(ALf + ti * 68 + 8 * j + 4);
                const float wl[8] = {wa.x, wa.y, wa.z, wa.w, wb.x, wb.y, wb.z, wb.w}, al[8] = {aa.x, aa.y, aa.z, aa.w, ab.x, ab.y, ab.z, ab.w};
                float ss = 0.f, cbp = 0.f, alpha[8], kkr[8], lw[8];
                UNROLL for (int i = 0; i < 8; ++i) {
                    const float xw = -(w0[d * 512 + ch + i] + wl[i]);
                    const float sp = softplus_fast(xw);
                    lw[i] = -__expf(-sp - 0.5f);
                    alpha[i] = sigm(a0[d * 512 + ch + i] + al[i]);
                    kkr[i] = k8[i] * kkw[ch + i]; ss += kkr[i] * kkr[i];
                    kd8[i] = k8[i] * (1.f + (alpha[i] - 1.f) * kaw[ch + i]);
                    cbp += r8[i] * kd8[i] * rkw[ch + i];
                }
                ss = sum8(ss); cbp = sum8(cbp);
                const float inv = 1.f / fmaxf(sqrtf(ss), 1e-12f);
                UNROLL for (int i = 0; i < 8; ++i) { const float kk = kkr[i] * inv; av[i] = -kk; bv[i] = kk * alpha[i]; }
                *(float4*)(LW + ti * 64 + 8 * j) = make_float4(lw[0], lw[1], lw[2], lw[3]); *(float4*)(LW + ti * 64 + 8 * j + 4) = make_float4(lw[4], lw[5], lw[6], lw[7]);
                if (j == 0) CB[((size_t)d * NT + nb + tt) * 8 + h] = cbp;
            }
            __syncthreads();
            {
                const int n = tid & 63, seg = tid >> 6; float run = 0.f;
                UNROLL for (int r = 0; r < 8; ++r) { run += LW[(seg * 8 + r) * 64 + n]; LW[(seg * 8 + r) * 64 + n] = run; }
                SEGT[seg * 64 + n] = run;
            }
            __syncthreads();
            {
                const int seg = ti >> 3;
                float off[8], tot[8];
                UNROLL for (int i = 0; i < 8; ++i) { off[i] = 0.f; tot[i] = 0.f; }
                UNROLL for (int s2 = 0; s2 < 8; ++s2) {
                    const float4 sa = *(const float4*)(SEGT + s2 * 64 + 8 * j), sb2 = *(const float4*)(SEGT + s2 * 64 + 8 * j + 4);
                    const float sv[8] = {sa.x, sa.y, sa.z, sa.w, sb2.x, sb2.y, sb2.z, sb2.w};
                    UNROLL for (int i = 0; i < 8; ++i) { tot[i] += sv[i]; if (s2 < seg) off[i] += sv[i]; }
                }
                const float4 la = *(const float4*)(LW + ti * 64 + 8 * j), lb = *(const float4*)(LW + ti * 64 + 8 * j + 4);
                const float lpl[8] = {la.x, la.y, la.z, la.w, lb.x, lb.y, lb.z, lb.w};
                float lpm[8];
                if ((ti & 7) != 0) {
                    const float4 ma = *(const float4*)(LW + (ti - 1) * 64 + 8 * j), mb = *(const float4*)(LW + (ti - 1) * 64 + 8 * j + 4);
                    lpm[0] = ma.x; lpm[1] = ma.y; lpm[2] = ma.z; lpm[3] = ma.w; lpm[4] = mb.x; lpm[5] = mb.y; lpm[6] = mb.z; lpm[7] = mb.w;
                } else { UNROLL for (int i = 0; i < 8; ++i) lpm[i] = 0.f; }
                float oa[8], ob[8], ok[8], orr[8];
                UNROLL for (int i = 0; i < 8; ++i) {
                    const float lp = lpl[i] + off[i], lm = lpm[i] + off[i];
                    const float eP = __expf(lp), eM = __expf(-lp), ePm = __expf(lm), eE = __expf(tot[i] - lp);
                    oa[i] = av[i] * ePm; ob[i] = bv[i] * eM; ok[i] = kd8[i] * eM; orr[i] = r8[i] * eP;
                    *(bf16_t*)(BH + (8 * j + i) * LROW + ti * 2) = f2bf(bv[i] * eE);
                    *(bf16_t*)(KH + (8 * j + i) * LROW + ti * 2) = f2bf(kd8[i] * eE);
                    *(bf16_t*)(VT + (8 * j + i) * LROW + ti * 2) = f2bf(v8[i]);
                    if (ti == 0) PCv[8 * j + i] = __expf(tot[i]);
                }
                st8((bf16_t*)(AT + ti * LROW) + 8 * j, oa); st8((bf16_t*)(BT + ti * LROW) + 8 * j, ob);
                st8((bf16_t*)(KT + ti * LROW) + 8 * j, ok); st8((bf16_t*)(RT + ti * LROW) + 8 * j, orr);
            }
            __syncthreads();
            UNROLL for (int rep = 0; rep < 8; ++rep) {
                const int q = wave + 8 * rep, m = q >> 4, tl = q & 15, tt4 = tl >> 2, st4 = tl & 3;
                char* dstm = m == 0 ? NAB : m == 1 ? NAK : m == 2 ? NRB : NRK;
                f32x4v a = {0.f, 0.f, 0.f, 0.f};
                if (st4 <= tt4) {
                    const char* Ab = (m < 2 ? AT : RT) + (16 * tt4 + lq) * LROW + kg * 16; const char* Bb = ((m & 1) ? KT : BT) + (16 * st4 + lq) * LROW + kg * 16;
                    UNROLL for (int ks = 0; ks < 2; ++ks) a = MFMA16(*(const bf16x8*)(Ab + ks * 64), *(const bf16x8*)(Bb + ks * 64), a);
                }
                const int sidx = 16 * st4 + lq;
                UNROLL for (int i = 0; i < 4; ++i) {
                    const int tidx = 16 * tt4 + 4 * kg + i;
                    const bool keep = m < 2 ? sidx < tidx : sidx <= tidx;
                    const float val = keep ? a[i] : 0.f;
                    *(bf16_t*)(dstm + tidx * LROW + sidx * 2) = f2bf(val);
                    if (m == 0 && st4 == tt4) NDF[(tt4 * 16 + 4 * kg + i) * 16 + lq] = val;
                }
            }
            __syncthreads();
            f32x4v xacc[4], yacc[4];
            bf16x8 vt[2];
            if (wave == 7) {
                const int blk = lane >> 4, c = lane & 15;
                float Tc[16];
                UNROLL for (int t = 0; t < 16; ++t) {
                    float a = t == c ? 1.f : 0.f;
                    UNROLL for (int s2 = 0; s2 < t; ++s2) a += NDF[(blk * 16 + t) * 16 + s2] * Tc[s2];
                    Tc[t] = a;
                }
                UNROLL for (int t = 0; t < 16; ++t) *(bf16_t*)(TJ + (blk * 16 + t) * 32 + c * 2) = f2bf(Tc[t]);
            } else if (wave < 4) {
                bf16x8 sb[2];
                UNROLL for (int kk = 0; kk < 2; ++kk) { sb[kk] = pk_acc2(sacc[2 * kk], sacc[2 * kk + 1]); vt[kk] = *(const bf16x8*)(VT + (16 * wave + lq) * LROW + kk * 64 + kg * 16); }
                UNROLL for (int t4 = 0; t4 < 4; ++t4) {
                    f32x4v x = {0.f, 0.f, 0.f, 0.f}, y = {0.f, 0.f, 0.f, 0.f};
                    UNROLL for (int kk = 0; kk < 2; ++kk) {
                        const char* pa = AT + (16 * t4 + lq) * LROW + (32 * kk + 4 * kg) * 2; const char* pr = RT + (16 * t4 + lq) * LROW + (32 * kk + 4 * kg) * 2;
                        x = MFMA16(pk_lohi(*(const u32x2*)pa, *(const u32x2*)(pa + 32)), sb[kk], x);
                        y = MFMA16(pk_lohi(*(const u32x2*)pr, *(const u32x2*)(pr + 32)), sb[kk], y);
                        if (2 * kk <= t4) {
                            x = MFMA16(*(const bf16x8*)(NAK + (16 * t4 + lq) * LROW + kk * 64 + kg * 16), vt[kk], x);
                            y = MFMA16(*(const bf16x8*)(NRK + (16 * t4 + lq) * LROW + kk * 64 + kg * 16), vt[kk], y);
                        }
                    }
                    xacc[t4] = x; yacc[t4] = y;
                }
            }
            __syncthreads();
            if (wave < 4) {
                const u32x2 z2 = {0u, 0u};
                f32x4v uacc[4];
                {
                    const u32x2 t0v = *(const u32x2*)(TJ + (0 * 16 + lq) * 32 + 4 * kg * 2);
                    uacc[0] = MFMA16(pk_lohi(t0v, z2), pk_acc1(xacc[0]), ((f32x4v){0.f, 0.f, 0.f, 0.f}));
                }
                UNROLL for (int jb = 1; jb < 4; ++jb) {
                    f32x4v z = xacc[jb];
                    const char* nr = NAB + (16 * jb + lq) * LROW + 4 * kg * 2;
                    if (jb == 1) z = MFMA16(pk_lohi(*(const u32x2*)nr, z2), pk_acc1(uacc[0]), z);
                    else {
                        z = MFMA16(pk_lohi(*(const u32x2*)nr, *(const u32x2*)(nr + 32)), pk_acc2(uacc[0], uacc[1]), z);
                        if (jb == 3) z = MFMA16(pk_lohi(*(const u32x2*)(nr + 64), z2), pk_acc1(uacc[2]), z);
                    }
                    const u32x2 tv = *(const u32x2*)(TJ + (jb * 16 + lq) * 32 + 4 * kg * 2);
                    uacc[jb] = MFMA16(pk_lohi(tv, z2), pk_acc1(z), ((f32x4v){0.f, 0.f, 0.f, 0.f}));
                }
                bf16x8 ub[2]; ub[0] = pk_acc2(uacc[0], uacc[1]); ub[1] = pk_acc2(uacc[2], uacc[3]);
                UNROLL for (int t4 = 0; t4 < 4; ++t4) {
                    f32x4v y = yacc[t4];
                    UNROLL for (int kk = 0; kk < 2; ++kk) if (2 * kk <= t4) {
                        const char* pn = NRB + (16 * t4 + lq) * LROW + (32 * kk + 4 * kg) * 2;
                        y = MFMA16(pk_lohi(*(const u32x2*)pn, *(const u32x2*)(pn + 32)), ub[kk], y);
                    }
                    UNROLL for (int i = 0; i < 4; ++i) YO[(16 * t4 + 4 * kg + i) * 68 + 16 * wave + lq] = y[i];
                }
                UNROLL for (int kt = 0; kt < 4; ++kt) {
                    f32x4v sv = sacc[kt];
                    UNROLL for (int i = 0; i < 4; ++i) sv[i] *= PCv[16 * kt + 4 * kg + i];
                    UNROLL for (int kk = 0; kk < 2; ++kk) {
                        const char* pb = BH + (16 * kt + lq) * LROW + (32 * kk + 4 * kg) * 2;
                        sv = MFMA16(pk_lohi(*(const u32x2*)pb, *(const u32x2*)(pb + 32)), ub[kk], sv);
                        sv = MFMA16(*(const bf16x8*)(KH + (16 * kt + lq) * LROW + kk * 64 + kg * 16), vt[kk], sv);
                    }
                    sacc[kt] = sv;
                }
            }
            __syncthreads();
            {
                const float4 ya = *(const float4*)(YO + ti * 68 + 8 * j), yb = *(const float4*)(YO + ti * 68 + 8 * j + 4);
                const float y8[8] = {ya.x, ya.y, ya.z, ya.w, yb.x, yb.y, yb.z, yb.w};
                st8(YS + ((size_t)d * NT + nb + tt) * 512 + ch, y8);
            }
            __syncthreads();
        }
    }
}

DEV void ph_rw_read(const Params& p, int L, int ntok) {
    const int lane = TID() & 63, wave = TID() >> 6;
    const bf16_t* PXR = (const bf16_t*)(p.ws + OFF_PX); const bf16_t* VF = (const bf16_t*)(p.ws + OFF_VF);
    const bf16_t* YS = (const bf16_t*)(p.ws + OFF_YS); const float* CB = (const float*)(p.ws + OFF_CB);
    bf16_t* YA = (bf16_t*)(p.ws + OFF_YA); bf16_t* SG = (bf16_t*)(p.ws + OFF_SGB);
    const float* mu = p.in[I_MU] + (size_t)L * RW_COLS;
    const float* lg = p.in[I_LNG] + (size_t)L * 512; const float* lb = p.in[I_LNB] + (size_t)L * 512;
    for (int n0 = blockIdx.x * 8; n0 < ntok; n0 += gridDim.x * 8) {
        const int n = n0 + wave, c = lane * 8, h = lane >> 3;
        float y0[8], y1[8], v8[8], o[8];
        ld8(YS + (size_t)n * 512 + c, y0); ld8(YS + ((size_t)NT + n) * 512 + c, y1); ld8(VF + (size_t)n * 512 + c, v8);
        float s = 0.f;
        UNROLL for (int i = 0; i < 8; ++i) { y0[i] += y1[i]; s += y0[i]; }
        s += __shfl_xor(s, 1); s += __shfl_xor(s, 2); s += __shfl_xor(s, 4);
        const float mean = s * (1.f / 64.f); float q = 0.f;
        UNROLL for (int i = 0; i < 8; ++i) { const float dd = y0[i] - mean; q += dd * dd; }
        q += __shfl_xor(q, 1); q += __shfl_xor(q, 2); q += __shfl_xor(q, 4);
        const float rstd = rsqrtf(q * (1.f / 64.f) + 64e-5f);
        const float bon = CB[(size_t)n * 8 + h] + CB[((size_t)NT + n) * 8 + h];
        UNROLL for (int i = 0; i < 8; ++i) o[i] = (y0[i] - mean) * rstd * lg[c + i] + lb[c + i] + bon * v8[i];
        st8(YA + (size_t)n * 512 + c, o);
        if (lane < 16) {
            int nb, tt, T; seq_of(n, nb, tt, T);
            float g8[8]; shift8(PXR, RW_COLS, nb, tt, T, 1792 + lane * 8, mu, g8);
            UNROLL for (int i = 0; i < 8; ++i) g8[i] = sigm(g8[i]);
            st8(SG + (size_t)n * 128 + lane * 8, g8);
        }
    }
}

DEV void ph_na_norm(const Params& p, int L) {
    const int lane = TID() & 63, wave = TID() >> 6;
    bf16_t* PXN = (bf16_t*)(p.ws + OFF_PX);
    const float* qg = p.in[I_QNG] + (size_t)L * 64; const float* kg = p.in[I_KNG] + (size_t)L * 64;
    for (int n0 = blockIdx.x * 8; n0 < NT; n0 += gridDim.x * 8) {
        const int n = n0 + wave, c = lane * 8;
        UNROLL for (int w = 0; w < 2; ++w) {
            bf16_t* ptr = PXN + (size_t)n * 1024 + w * 512 + c;
            float x[8]; ld8(ptr, x);
            float ss = 0.f;
            UNROLL for (int i = 0; i < 8; ++i) ss += x[i] * x[i];
            ss += __shfl_xor(ss, 1); ss += __shfl_xor(ss, 2); ss += __shfl_xor(ss, 4);
            const float r = rsqrtf(ss * (1.f / 64.f) + 1e-6f) * (w == 0 ? 0.125f : 1.f);
            const float* g = w == 0 ? qg : kg;
            UNROLL for (int i = 0; i < 8; ++i) x[i] = x[i] * r * g[(c + i) & 63];
            st8(ptr, x);
        }
    }
}

DEV void knorm8(float (&x)[8], const float* g) {
    float ss = 0.f;
    UNROLL for (int i = 0; i < 8; ++i) ss += x[i] * x[i];
    ss = sum8(ss);
    const float r = rsqrtf(ss * (1.f / 64.f) + 1e-6f);
    UNROLL for (int i = 0; i < 8; ++i) x[i] = x[i] * r * g[i];
}
DEV void ph_na_att(const Params& p, int L, char* smem) {
    const int tid = TID(), lane = tid & 63, lq = lane & 15, kg = lane >> 4;
    const int wave = __builtin_amdgcn_readfirstlane(tid >> 6);
    char* KL = smem;
    char* KC = smem + 512 * LROW;
    char* VL = smem;
    char* VC = smem + 64 * 1040;
    float* OX = (float*)(smem + 114688);
    float* ML = OX + 8 * 1024;
    float* RP = ML + 256;
    const bf16_t* PXN = (const bf16_t*)(p.ws + OFF_PX); bf16_t* YB = (bf16_t*)(p.ws + OFF_YB);
    const bf16_t* VT = (const bf16_t*)(p.ws + OFF_VT); const bf16_t* VTC = (const bf16_t*)(p.ws + OFF_VTC);
    const float* qgn = p.in[I_QNG] + (size_t)L * 64; const float* kgn = p.in[I_KNG] + (size_t)L * 64;
    const int nunits = 4096 + (L == 0 ? 256 : 0);
    for (int u = blockIdx.x; u < nunits; u += gridDim.x) {
        const bool cu = u >= 4096;
        int b, h, r = 0, rs = 0, g = 0;
        if (!cu) { h = u & 7; r = (u >> 3) & 31; b = u >> 8; rs = min(max(r - 4, 0), 24); }
        else { const int v = u - 4096; h = v & 7; g = (v >> 3) & 1; b = v >> 4; }
        const int ctx0 = NX + b * CTXL;
        if (!cu) {
            UNROLL for (int i = 0; i < 8; ++i) {
                const int c = tid + NTHREADS * i, kx = c >> 3, part = c & 7;
                const int tok = b * SEQ + (rs + (kx >> 6)) * 64 + (kx & 63);
                float kv[8]; ld8(PXN + (size_t)tok * 1024 + 512 + h * 64 + part * 8, kv); knorm8(kv, kgn + part * 8);
                st8((bf16_t*)(KL + kx * LROW + part * 16), kv);
            }
            for (int i = tid; i < 15 * 31; i += NTHREADS) RP[i] = p.in[I_RPB][((size_t)L * 8 + h) * 465 + i];
        }
        UNROLL for (int i = 0; i < 4; ++i) {
            const int c = tid + NTHREADS * i, kx = c >> 3, part = c & 7;
            float kv[8]; ld8(PXN + (size_t)(ctx0 + kx) * 1024 + 512 + h * 64 + part * 8, kv); knorm8(kv, kgn + part * 8);
            st8((bf16_t*)(KC + kx * LROW + part * 16), kv);
        }
        const int nb = wave & 3;
        const bool loc = !cu && wave < 4;
        const int qtok0 = cu ? ctx0 + (g * 8 + wave) * 16 : b * SEQ + r * 64 + nb * 16;
        const int band0 = min(max(nb * 16 - 8, 0), 32);
        bf16x8 qf[2];
        {
            float q0[8], q1[8]; ld8(PXN + (size_t)(qtok0 + lq) * 1024 + h * 64 + kg * 8, q0); ld8(PXN + (size_t)(qtok0 + lq) * 1024 + h * 64 + 32 + kg * 8, q1);
            float ss = 0.f;
            UNROLL for (int i = 0; i < 8; ++i) ss += q0[i] * q0[i] + q1[i] * q1[i];
            ss += __shfl_xor(ss, 16); ss += __shfl_xor(ss, 32);
            const float rq = rsqrtf(ss * (1.f / 64.f) + 1e-6f) * 0.125f;
            UNROLL for (int i = 0; i < 8; ++i) { q0[i] = q0[i] * rq * qgn[kg * 8 + i]; q1[i] = q1[i] * rq * qgn[32 + kg * 8 + i]; }
            u32x4 w0, w1; w0.x = pk2(q0[0], q0[1]); w0.y = pk2(q0[2], q0[3]); w0.z = pk2(q0[4], q0[5]); w0.w = pk2(q0[6], q0[7]);
            w1.x = pk2(q1[0], q1[1]); w1.y = pk2(q1[2], q1[3]); w1.z = pk2(q1[4], q1[5]); w1.w = pk2(q1[6], q1[7]);
            qf[0] = __builtin_bit_cast(bf16x8, w0); qf[1] = __builtin_bit_cast(bf16x8, w1);
        }
        __syncthreads();
        f32x4v sacc[16];
        if (loc) {
            const char* kb = KL + (band0 + lq) * LROW + kg * 16;
            UNROLL for (int t = 0; t < 16; ++t) {
                f32x4v a = {0.f, 0.f, 0.f, 0.f};
                UNROLL for (int ks = 0; ks < 2; ++ks) a = __builtin_amdgcn_mfma_f32_16x16x32_bf16(*(const bf16x8*)(kb + ((t >> 1) * 64 + (t & 1) * 16) * LROW + ks * 64), qf[ks], a, 0, 0, 0);
                sacc[t] = a;
            }
            const int col = nb * 16 + lq, cs = min(max(col - 8, 0), 48);
            const int kc0 = band0 + 4 * kg;
            const float* rp = RP + (rs - r + 7) * 31 + (kc0 - col + 15);
            UNROLL for (int t = 0; t < 16; ++t) UNROLL for (int i = 0; i < 4; ++i) {
                const int kc = kc0 + (t & 1) * 16 + i;
                const bool valid = kc >= cs && kc < cs + 16;
                sacc[t][i] = valid ? sacc[t][i] + rp[(t >> 1) * 31 + (t & 1) * 16 + i] : -1e30f;
            }
        } else {
            const char* kb = KC + lq * LROW + kg * 16;
            UNROLL for (int t = 0; t < 16; ++t) {
                f32x4v a = {0.f, 0.f, 0.f, 0.f};
                UNROLL for (int ks = 0; ks < 2; ++ks) a = __builtin_amdgcn_mfma_f32_16x16x32_bf16(*(const bf16x8*)(kb + t * 16 * LROW + ks * 64), qf[ks], a, 0, 0, 0);
                sacc[t] = a;
            }
        }
        float mx = -3e38f;
        UNROLL for (int t = 0; t < 16; ++t) UNROLL for (int i = 0; i < 4; ++i) mx = fmaxf(mx, sacc[t][i]);
        mx = fmaxf(mx, __shfl_xor(mx, 16)); mx = fmaxf(mx, __shfl_xor(mx, 32));
        float sum = 0.f;
        UNROLL for (int t = 0; t < 16; ++t) UNROLL for (int i = 0; i < 4; ++i) { const float e = __expf(sacc[t][i] - mx); sacc[t][i] = e; sum += e; }
        sum += __shfl_xor(sum, 16); sum += __shfl_xor(sum, 32);
        if (kg == 0) { ML[(wave * 2) * 16 + lq] = mx; ML[(wave * 2 + 1) * 16 + lq] = sum; }
        bf16x8 pf[8];
        UNROLL for (int tp = 0; tp < 8; ++tp) {
            u32x4 w; w.x = pk2(sacc[2 * tp][0], sacc[2 * tp][1]); w.y = pk2(sacc[2 * tp][2], sacc[2 * tp][3]);
            w.z = pk2(sacc[2 * tp + 1][0], sacc[2 * tp + 1][1]); w.w = pk2(sacc[2 * tp + 1][2], sacc[2 * tp + 1][3]);
            pf[tp] = __builtin_bit_cast(bf16x8, w);
        }
        __syncthreads();
        if (!cu) {
            UNROLL for (int i = 0; i < 8; ++i) {
                const int c = tid + NTHREADS * i, part = c & 7, kr = (c >> 3) & 7, d = c >> 6;
                *(u32x4*)(VL + d * 1040 + (kr * 64 + part * 8) * 2) = *(const u32x4*)(VT + ((size_t)(b * 8 + h) * 64 + d) * SEQ + (rs + kr) * 64 + part * 8);
            }
        }
        UNROLL for (int i = 0; i < 4; ++i) {
            const int c = tid + NTHREADS * i, part = c & 31, d = c >> 5;
            *(u32x4*)(VC + d * 528 + part * 16) = *(const u32x4*)(VTC + ((size_t)(b * 8 + h) * 64 + d) * CTXL + part * 8);
        }
        __syncthreads();
        f32x4v oacc[4];
        UNROLL for (int dt = 0; dt < 4; ++dt) oacc[dt] = (f32x4v){0.f, 0.f, 0.f, 0.f};
        if (loc) {
            const char* vb = VL + lq * 1040 + (band0 + 4 * kg) * 2;
            UNROLL for (int tp = 0; tp < 8; ++tp) UNROLL for (int dt = 0; dt < 4; ++dt) {
                const u32x2 lo = *(const u32x2*)(vb + dt * 16 * 1040 + tp * 128), hi = *(const u32x2*)(vb + dt * 16 * 1040 + tp * 128 + 32);
                u32x4 w; w.x = lo.x; w.y = lo.y; w.z = hi.x; w.w = hi.y;
                oacc[dt] = __builtin_amdgcn_mfma_f32_16x16x32_bf16(pf[tp], __builtin_bit_cast(bf16x8, w), oacc[dt], 0, 0, 0);
            }
        } else {
            const char* vb = VC + lq * 528 + 8 * kg;
            UNROLL for (int tp = 0; tp < 8; ++tp) UNROLL for (int dt = 0; dt < 4; ++dt) {
                const u32x2 lo = *(const u32x2*)(vb + dt * 16 * 528 + tp * 64), hi = *(const u32x2*)(vb + dt * 16 * 528 + tp * 64 + 32);
                u32x4 w; w.x = lo.x; w.y = lo.y; w.z = hi.x; w.w = hi.y;
                oacc[dt] = __builtin_amdgcn_mfma_f32_16x16x32_bf16(pf[tp], __builtin_bit_cast(bf16x8, w), oacc[dt], 0, 0, 0);
            }
        }
        float* ox = OX + wave * 1024;
        if (!cu && wave >= 4) { UNROLL for (int dt = 0; dt < 4; ++dt) UNROLL for (int i = 0; i < 4; ++i) ox[(4 * kg + i) * 64 + dt * 16 + lq] = oacc[dt][i]; }
        __syncthreads();
        if (cu || wave < 4) {
            UNROLL for (int i = 0; i < 4; ++i) {
                const int q = 4 * kg + i;
                const float m0 = ML[(wave * 2) * 16 + q], l0 = ML[(wave * 2 + 1) * 16 + q];
                float e0 = 1.f, e1 = 0.f, den = l0;
                if (!cu) {
                    const float m1 = ML[((wave + 4) * 2) * 16 + q], l1 = ML[((wave + 4) * 2 + 1) * 16 + q];
                    const float m = fmaxf(m0, m1); e0 = __expf(m0 - m); e1 = __expf(m1 - m); den = l0 * e0 + l1 * e1;
                }
                const float inv = 1.f / den;
                UNROLL for (int dt = 0; dt < 4; ++dt) {
                    const float o1 = cu ? 0.f : OX[(wave + 4) * 1024 + q * 64 + dt * 16 + lq];
                    ox[q * 64 + dt * 16 + lq] = (oacc[dt][i] * e0 + o1 * e1) * inv;
                }
            }
            UNROLL for (int it = 0; it < 2; ++it) {
                const int q = (lane >> 3) + 8 * it, c8 = (lane & 7) * 8;
                const float4 a = *(const float4*)(ox + q * 64 + c8), bq = *(const float4*)(ox + q * 64 + c8 + 4);
                const float v[8] = {a.x, a.y, a.z, a.w, bq.x, bq.y, bq.z, bq.w};
                st8(YB + (size_t)(qtok0 + q) * 512 + h * 64 + c8, v);
            }
        }
        __syncthreads();
    }
}

DEV float sum16(float v) { v += DPP_MOV(v, 0xB1); v += DPP_MOV(v, 0x4E); v += DPP_MOV(v, 0x141); v += DPP_MOV(v, 0x140); return v; }
DEV void ph_ml_scan(const Params& p, int L, char* smem) {
    const int tid = TID(), lane = tid & 63, lq = lane & 15, kg = lane >> 4, ti = tid >> 3, j = tid & 7;
    const int wave = __builtin_amdgcn_readfirstlane(tid >> 6);
    char* QS = smem;
    char* QP = QS + 9216;
    char* KC = QP + 9216;
    char* KW = KC + 9216;
    char* PM = KW + 9216;
    char* VT = PM + 9216;
    float* BV = (float*)(VT + 128 * LROW);
    float* GI = BV + 64;
    float* DEN = GI + 64;
    float* NV = DEN + 64;
    float* RS = NV + 64;
    float* HO = RS + 256;
    const bf16_t* PXM = (const bf16_t*)(p.ws + OFF_PX); bf16_t* HS = (bf16_t*)(p.ws + OFF_HS);
    for (int u = blockIdx.x; u < 128; u += gridDim.x) {
        const int d = u & 1, h = (u >> 1) & 3, b = u >> 3;
        const float ib = p.in[I_IB][L * 8 + d * 4 + h], fb = p.in[I_FB][L * 8 + d * 4 + h];
        f32x4v cacc[4];
        UNROLL for (int i = 0; i < 4; ++i) cacc[i] = (f32x4v){0.f, 0.f, 0.f, 0.f};
        for (int i = tid; i < 64 * LROW / 4; i += NTHREADS) ((unsigned*)PM)[i] = 0u;
        if (tid < 64) NV[tid] = 0.f;
        __syncthreads();
        for (int ci = 0; ci < 36; ++ci) {
            const bool isc = ci < 4; const int T = isc ? CTXL : SEQ, cc = isc ? ci : ci - 4;
            const int t0 = d == 0 ? cc * 64 : T - 64 * (cc + 1), nb = isc ? NX + b * CTXL : b * SEQ;
            const int tt = d == 0 ? t0 + ti : t0 + 63 - ti;
            float q8[8], k8[8];
            {
                const bf16_t* row = PXM + (size_t)(nb + tt) * ML_COLS;
                ld8(row + h * 64 + 8 * j, q8); ld8(row + 256 + h * 64 + 8 * j, k8);
                if (!isc) {
                    const int axis = j >> 2, half = (j >> 1) & 1; const float pos = (float)(axis == 0 ? (tt >> 6) : (tt & 63));
                    UNROLL for (int i = 0; i < 8; ++i) {
                        const int f = (j & 1) * 8 + i;
                        const float inv = exp2f(-(float)f * 0.83048202372184059f);
                        const float ang = pos * inv; const float cs = __cosf(ang), sn = __sinf(ang);
                        const float qo = __shfl_xor(q8[i], 2), ko = __shfl_xor(k8[i], 2);
                        q8[i] = half == 0 ? q8[i] * cs - qo * sn : q8[i] * cs + qo * sn;
                        k8[i] = half == 0 ? k8[i] * cs - ko * sn : k8[i] * cs + ko * sn;
                    }
                }
                UNROLL for (int i = 0; i < 8; ++i) q8[i] *= 0.125f;
                st8((bf16_t*)(QS + ti * LROW) + 8 * j, q8); st8((bf16_t*)(KC + ti * LROW) + 8 * j, k8);
                float v0[8], v1[8];
                ld8(row + 512 + h * 128 + 16 * j, v0); ld8(row + 512 + h * 128 + 16 * j + 8, v1);
                UNROLL for (int i = 0; i < 8; ++i) { *(bf16_t*)(VT + (16 * j + i) * LROW + ti * 2) = f2bf(v0[i]); *(bf16_t*)(VT + (16 * j + 8 + i) * LROW + ti * 2) = f2bf(v1[i]); }
                if (wave == 0) {
                    const int tl = d == 0 ? t0 + lane : t0 + 63 - lane;
                    const bf16_t* rw = PXM + (size_t)(nb + tl) * ML_COLS;
                    const float ig = bf2f(rw[1536 + d * 4 + h]) + ib, fg = bf2f(rw[1544 + d * 4 + h]) + fb;
                    const float igc = 15.f * tanhf(ig * (1.f / 15.f)), fgc = 15.f * tanhf(fg * (1.f / 15.f));
                    float lf = -(fmaxf(-fgc, 0.f) + log1pf(expf(-fabsf(fgc))));
                    UNROLL for (int o = 1; o < 64; o <<= 1) { const float up = __shfl_up(lf, o); if (lane >= o) lf += up; }
                    BV[lane] = lf; GI[lane] = igc;
                }
            }
            __syncthreads();
            {
                const float bt = BV[ti], bl = BV[63], gi = GI[ti];
                const float eb = __expf(bt), wk = __expf(bl - bt + gi);
                float qp[8]; float dn = 0.f;
                UNROLL for (int i = 0; i < 8; ++i) { qp[i] = q8[i] * eb; dn += q8[i] * NV[8 * j + i]; }
                st8((bf16_t*)(QP + ti * LROW) + 8 * j, qp);
                UNROLL for (int i = 0; i < 8; ++i) *(bf16_t*)(KW + (8 * j + i) * LROW + ti * 2) = f2bf(k8[i] * wk);
                dn = sum8(dn);
                if (j == 0) DEN[ti] = dn * eb;
            }
            __syncthreads();
            UNROLL for (int rep = 0; rep < 2; ++rep) {
                const int tile = wave + 8 * rep;
                if (tile < 10) {
                    const int tt4 = tile < 1 ? 0 : tile < 3 ? 1 : tile < 6 ? 2 : 3, st4 = tile - (tt4 * (tt4 + 1)) / 2;
                    f32x4v a = {0.f, 0.f, 0.f, 0.f};
                    UNROLL for (int ks = 0; ks < 2; ++ks)
                        a = __builtin_amdgcn_mfma_f32_16x16x32_bf16(*(const bf16x8*)(QS + (16 * tt4 + lq) * LROW + ks * 64 + kg * 16),
                                                                    *(const bf16x8*)(KC + (16 * st4 + lq) * LROW + ks * 64 + kg * 16), a, 0, 0, 0);
                    const int sidx = 16 * st4 + lq; const float bs = BV[sidx], gs = GI[sidx];
                    UNROLL for (int i = 0; i < 4; ++i) {
                        const int tidx = 16 * tt4 + 4 * kg + i;
                        const float val = sidx <= tidx ? a[i] * __expf(BV[tidx] - bs + gs) : 0.f;
                        *(bf16_t*)(PM + tidx * LROW + sidx * 2) = f2bf(val);
                        const float rsum = sum16(val);
                        if (lq == 0) RS[tidx * 4 + st4] = rsum;
                    }
                }
            }
            __syncthreads();
            {
                bf16x8 vf[2], cb[2];
                UNROLL for (int kk = 0; kk < 2; ++kk) vf[kk] = *(const bf16x8*)(VT + (16 * wave + lq) * LROW + kk * 64 + kg * 16);
                UNROLL for (int kk = 0; kk < 2; ++kk) {
                    u32x4 w; w.x = pk2(cacc[2 * kk][0], cacc[2 * kk][1]); w.y = pk2(cacc[2 * kk][2], cacc[2 * kk][3]);
                    w.z = pk2(cacc[2 * kk + 1][0], cacc[2 * kk + 1][1]); w.w = pk2(cacc[2 * kk + 1][2], cacc[2 * kk + 1][3]);
                    cb[kk] = __builtin_bit_cast(bf16x8, w);
                }
                UNROLL for (int tt4 = 0; tt4 < 4; ++tt4) {
                    f32x4v hacc = {0.f, 0.f, 0.f, 0.f};
                    UNROLL for (int kk = 0; kk < 2; ++kk) if (2 * kk <= tt4)
                        hacc = __builtin_amdgcn_mfma_f32_16x16x32_bf16(*(const bf16x8*)(PM + (16 * tt4 + lq) * LROW + kk * 64 + kg * 16), vf[kk], hacc, 0, 0, 0);
                    UNROLL for (int kk = 0; kk < 2; ++kk) {
                        const char* qa = QP + (16 * tt4 + lq) * LROW + (32 * kk + 4 * kg) * 2;
                        const u32x2 lo = *(const u32x2*)qa, hi = *(const u32x2*)(qa + 32);
                        u32x4 w; w.x = lo.x; w.y = lo.y; w.z = hi.x; w.w = hi.y;
                        hacc = __builtin_amdgcn_mfma_f32_16x16x32_bf16(__builtin_bit_cast(bf16x8, w), cb[kk], hacc, 0, 0, 0);
                    }
                    UNROLL for (int i = 0; i < 4; ++i) {
                        const int tidx = 16 * tt4 + 4 * kg + i;
                        float den = DEN[tidx];
                        UNROLL for (int st = 0; st <= tt4; ++st) den += RS[tidx * 4 + st];
                        HO[tidx * 132 + 16 * wave + lq] = hacc[i] / fmaxf(fabsf(den), 1.f);
                    }
                }
                const float g = __expf(BV[63]);
                UNROLL for (int dk = 0; dk < 4; ++dk) {
                    cacc[dk] = cacc[dk] * g;
                    UNROLL for (int kk = 0; kk < 2; ++kk)
                        cacc[dk] = __builtin_amdgcn_mfma_f32_16x16x32_bf16(*(const bf16x8*)(KW + (16 * dk + lq) * LROW + kk * 64 + kg * 16), vf[kk], cacc[dk], 0, 0, 0);
                }
            }
            __syncthreads();
            if (tid < 64) {
                float acc = 0.f;
                UNROLL for (int c8 = 0; c8 < 8; ++c8) { float kw[8]; ld8((const bf16_t*)(KW + tid * LROW) + 8 * c8, kw); UNROLL for (int i = 0; i < 8; ++i) acc += kw[i]; }
                NV[tid] = __expf(BV[63]) * NV[tid] + acc;
            }
            {
                const float* hr = HO + ti * 132 + 16 * j;
                float o0[8], o1[8];
                UNROLL for (int i = 0; i < 8; ++i) { o0[i] = hr[i]; o1[i] = hr[8 + i]; }
                bf16_t* dst = HS + ((size_t)d * NT + nb + tt) * 512 + h * 128 + 16 * j;
                st8(dst, o0); st8(dst + 8, o1);
            }
            __syncthreads();
        }
    }
}
DEV void ph_ml_read(const Params& p, int L, int ntok) {
    const int lane = TID() & 63, wave = TID() >> 6;
    const bf16_t* PXM = (const bf16_t*)(p.ws + OFF_PX); const bf16_t* HS = (const bf16_t*)(p.ws + OFF_HS);
    bf16_t* YC = (bf16_t*)(p.ws + OFF_YC); const float* ng = p.in[I_MNG] + (size_t)L * 512;
    for (int n0 = blockIdx.x * 8; n0 < ntok; n0 += gridDim.x * 8) {
        const int n = n0 + wave, c = lane * 8;
        float h0[8], h1[8], o8[8], out[8];
        ld8(HS + (size_t)n * 512 + c, h0); ld8(HS + ((size_t)NT + n) * 512 + c, h1); ld8(PXM + (size_t)n * ML_COLS + 1024 + c, o8);
        float ss = 0.f;
        UNROLL for (int i = 0; i < 8; ++i) { h0[i] += h1[i]; ss += h0[i] * h0[i]; }
        ss += __shfl_xor(ss, 1); ss += __shfl_xor(ss, 2); ss += __shfl_xor(ss, 4); ss += __shfl_xor(ss, 8);
        const float r = rsqrtf(ss * (1.f / 128.f) + 1e-6f);
        UNROLL for (int i = 0; i < 8; ++i) out[i] = h0[i] * r * ng[c + i] * sigm(o8[i]);
        st8(YC + (size_t)n * 512 + c, out);
    }
}

DEV void ph_route(const Params& p, int L, int ntok, char* smem) {
    const int lane = TID() & 63, wave = TID() >> 6;
    const float* LOG = (const float*)(p.ws + OFF_LOG); int* EIDX = (int*)(p.ws + OFF_EIDX); float* EW = (float*)(p.ws + OFF_EW);
    const float bias = p.in[I_MB][L * 64 + lane];
    int* MCNT = (int*)(p.ws + OFF_MCNT);
    int* hist = (int*)smem;
    if (TID() < 192) hist[TID()] = 0;
    __syncthreads();
    for (int n0 = blockIdx.x * 8; n0 < ntok; n0 += gridDim.x * 8) {
        const int n = n0 + wave, g = lane >> 3;
        const float score = sigm_acc(LOG[(size_t)n * 64 + lane]), sel = score + bias;
        float m1 = sel; m1 = fmaxf(m1, __shfl_xor(m1, 1)); m1 = fmaxf(m1, __shfl_xor(m1, 2)); m1 = fmaxf(m1, __shfl_xor(m1, 4));
        int i1 = sel == m1 ? lane : 64; i1 = min(i1, __shfl_xor(i1, 1)); i1 = min(i1, __shfl_xor(i1, 2)); i1 = min(i1, __shfl_xor(i1, 4));
        float m2 = lane == i1 ? -3e38f : sel; m2 = fmaxf(m2, __shfl_xor(m2, 1)); m2 = fmaxf(m2, __shfl_xor(m2, 2)); m2 = fmaxf(m2, __shfl_xor(m2, 4));
        const float gs = m1 + m2;
        int rank = 0;
        UNROLL for (int g2 = 0; g2 < 8; ++g2) { const float v = __shfl(gs, g2 * 8); rank += (v > gs || (v == gs && g2 < g)) ? 1 : 0; }
        const float ms = rank < 4 ? sel : -1e30f;
        int er = 0;
        for (int e2 = 0; e2 < 64; ++e2) { const float v = __shfl(ms, e2); er += (v > ms || (v == ms && e2 < lane)) ? 1 : 0; }
        const bool chosen = er < 8;
        float ws = chosen ? score : 0.f;
        UNROLL for (int o = 1; o < 64; o <<= 1) ws += __shfl_xor(ws, o);
        if (chosen) { EIDX[(size_t)n * 8 + er] = lane; EW[(size_t)n * 8 + er] = score / ws * 2.5f; atomicAdd(hist + (n / MOE_CHUNK) * 64 + lane, 1); }
    }
    __syncthreads();
    if (TID() < 192 && hist[TID()] > 0) atomicAdd(MCNT + TID(), hist[TID()]);
    __syncthreads();
}


DEV void ph_moe_scatter(const Params& p, int ntok, char* smem) {
    const int tid = TID();
    int* base = (int*)smem;
    int* lh = base + 192;
    const int* MCNT = (const int*)(p.ws + OFF_MCNT); int* CUR = (int*)(p.ws + OFF_MCNT) + 192;
    const int* EIDX = (const int*)(p.ws + OFF_EIDX); int* SORT = (int*)(p.ws + OFF_SORT);
    if (tid < 3) { int b = 0; for (int e = 0; e < 64; ++e) { base[tid * 64 + e] = b; b += (MCNT[tid * 64 + e] + 127) & ~127; } }
    if (tid < 192) lh[tid] = 0;
    __syncthreads();
    for (int i = blockIdx.x * NTHREADS + tid; i < ntok * 8; i += gridDim.x * NTHREADS) atomicAdd(lh + ((i >> 3) / MOE_CHUNK) * 64 + EIDX[i], 1);
    __syncthreads();
    if (tid < 192) { const int n = lh[tid]; if (n > 0) base[tid] += atomicAdd(CUR + tid, n); lh[tid] = 0; }
    __syncthreads();
    for (int i = blockIdx.x * NTHREADS + tid; i < ntok * 8; i += gridDim.x * NTHREADS) {
        const int ce = ((i >> 3) / MOE_CHUNK) * 64 + EIDX[i];
        SORT[(size_t)(ce >> 6) * SORT_CAP + base[ce] + atomicAdd(lh + ce, 1)] = i;
    }
    __syncthreads();
}

DEV void ph_moe_exp(const Params& p, int cb, int ce, char* smem, Topo tp) {
    typedef GC<2, 4> C;
    const int tid0 = TID();
    char* ACT = smem + 2 * C::STG;
    int* list = (int*)(smem + 3 * C::STG);
    int* cnt = list + 1024;
    const bf16_t* H2 = (const bf16_t*)(p.ws + OFF_HX); const int* EIDX = (const int*)(p.ws + OFF_EIDX); const float* EW = (const float*)(p.ws + OFF_EW);
    bf16_t* YBUF = (bf16_t*)(p.ws + OFF_YBUF);
    const int c = cb / MOE_CHUNK;
    const int* MCNT = (const int*)(p.ws + OFF_MCNT) + c * 64; const int* SORT = (const int*)(p.ws + OFF_SORT) + (size_t)c * SORT_CAP;
    int* tb = cnt + 16;
    const int xcd = tp.x, slot = tp.r, nslot = tp.n;
    __syncthreads();
    if (tid0 < 8) {
        const int tid = tid0; const int e = xcd + 8 * tid; int b = 0;
        for (int e2 = 0; e2 < e; ++e2) b += (MCNT[e2] + 127) & ~127;
        tb[16 + tid] = b; tb[32 + tid] = MCNT[e];
    }
    __syncthreads();
    if (tid0 == 0) { int t = 0; for (int k = 0; k < 8; ++k) { tb[k] = t; t += (tb[32 + k] + 127) >> 7; } tb[8] = t; }
    __syncthreads();
    const int total = tb[8];
    for (int lu = slot; lu < total; lu += nslot) {
        int tid = tid0; asm volatile("" : "+v"(tid));
        const int lane = tid & 63, wave = tid >> 6, wm = wave / 4, wn = wave % 4, fr = lane & 31, fh = lane >> 5;
        int k = 0;
        while (k < 7 && lu >= tb[k + 1]) ++k;
        const int e = xcd + 8 * k, j = lu - tb[k], M = min(128, tb[32 + k] - 128 * j), row0 = tb[16 + k] + 128 * j;
        __syncthreads();
        if (tid < 128) list[tid] = SORT[row0 + min(tid, M - 1)];
        __syncthreads();
        const bf16_t* GU = (const bf16_t*)(p.ws + OFF_MGU) + (size_t)e * 256 * 1024;
        const bf16_t* DT = (const bf16_t*)(p.ws + OFF_MDT) + (size_t)e * 1024 * 128;
        {
            constexpr int mc = 0;
            f32x16 acc[2][2];
            {
            acc_zero(acc);
            gemm_tile<2, 4, 3, false>(acc, [&](int r) -> const bf16_t* { const int ix = min(mc + r, M - 1); return H2 + (size_t)(list[ix] >> 3) * 1024; },
                                   GU, 1024, 0, 256, 1024, smem, nullptr);
            }
            UNROLL for (int mi = 0; mi < 2; ++mi) UNROLL for (int r = 0; r < 16; ++r) {
                const int row = wm * 64 + ACC_ROW(mi, r, fh), ix = mc + row;
                const float gw = ix < M ? EW[list[ix]] : 0.f;
                const float gv = acc[mi][0][r], uv = acc[mi][1][r];
                const float a = gv / (1.f + __expf(-gv)) * uv * gw;
                const int col = wn * 32 + fr;
                *(bf16_t*)(ACT + (col >> 6) * C::AB + row * 128 + ((((col & 63) >> 3) ^ ((row >> 1) & 7)) << 4) + (col & 7) * 2) = f2bf(a);
            }
            __syncthreads();
            {
                const int crow = tid >> 3, cch = (tid & 7) ^ ((crow >> 1) & 7);
                const int sw = (fr >> 1) & 7, a_base = (wm * 64 + fr) * 128, b_base = (wn * 64 + fr) * 128;
                float* slab = (float*)(smem + (wave < 4 ? wave * 4096 : C::STG + (wave - 4) * 4096));
#define MG2_ISSUE(nt_) do { UNROLL for (int kt = 0; kt < 2; ++kt) UNROLL for (int i = 0; i < 4; ++i) \
                    GLDS16(DT + (size_t)((nt_) * 256 + crow + 64 * i) * 128 + kt * 64 + cch * 8, smem + kt * C::STG + C::AB + i * 8192 + tid * 16); } while (0)
                MG2_ISSUE(0);
                _Pragma("unroll 1") for (int nt = 0; nt < 4; ++nt) {
                    asm volatile("s_waitcnt vmcnt(0)" ::: "memory");
                    __builtin_amdgcn_s_barrier();
                    asm volatile("" ::: "memory");
                    acc_zero(acc);
                    UNROLL for (int kt = 0; kt < 2; ++kt) {
                        const char* As_ = ACT + kt * C::AB; const char* Bs_ = smem + kt * C::STG + C::AB;
                        UNROLL for (int ks = 0; ks < 4; ++ks) {
                            const int off = ((2 * ks + fh) ^ sw) * 16;
                            bf16x8 af[2], bfv[2];
                            UNROLL for (int mi = 0; mi < 2; ++mi) af[mi] = *(const bf16x8*)(As_ + a_base + mi * 4096 + off);
                            UNROLL for (int ni = 0; ni < 2; ++ni) bfv[ni] = *(const bf16x8*)(Bs_ + b_base + ni * 4096 + off);
                            UNROLL for (int mi = 0; mi < 2; ++mi) UNROLL for (int ni = 0; ni < 2; ++ni)
                                acc[mi][ni] = __builtin_amdgcn_mfma_f32_32x32x16_bf16(af[mi], bfv[ni], acc[mi][ni], 0, 0, 0);
                        }
                    }
                    asm volatile("s_waitcnt lgkmcnt(0)" ::: "memory");
                    __builtin_amdgcn_s_barrier();
                    asm volatile("" ::: "memory");
                    if (nt < 3) MG2_ISSUE(nt + 1);
                    UNROLL for (int mi = 0; mi < 2; ++mi) UNROLL for (int hh = 0; hh < 2; ++hh) {
                        UNROLL for (int ni = 0; ni < 2; ++ni) UNROLL for (int r8 = 0; r8 < 8; ++r8) {
                            const int r = 8 * hh + r8;
                            slab[((r & 3) + 8 * ((r >> 2) & 1) + 4 * fh) * 64 + ni * 32 + fr] = acc[mi][ni][r];
                        }
                        UNROLL for (int it = 0; it < 2; ++it) {
                            const int row = (lane >> 3) + 8 * it, c8 = (lane & 7) * 8;
                            const float4 a = *(const float4*)(slab + row * 64 + c8), b = *(const float4*)(slab + row * 64 + c8 + 4);
                            const float v[8] = {a.x, a.y, a.z, a.w, b.x, b.y, b.z, b.w};
                            const int ix = mc + wm * 64 + mi * 32 + 16 * hh + row;
                            if (ix < M) st8(YBUF + (size_t)(list[ix] - cb * 8) * 1024 + nt * 256 + wn * 64 + c8, v);
                        }
                    }
                }
#undef MG2_ISSUE
            }
            __syncthreads();
        }
        __syncthreads();
    }
}


#define XB_TMO      128
#define XB_XCNT(j)  (256  + 64 * (j))
#define XB_XSUB(j)  (1280 + 64 * (j))
#define XB_XGEN(j)  (2304 + 64 * (j))
#define XB_TOP      3328
#define XB_TOPGEN   3392
#define XCD_BAR_WORDS 3456
#define XB_SPIN_CAP (1u << 18)
#define LAS __attribute__((address_space(3)))

__device__ __forceinline__ unsigned xb_ld(unsigned* p)              { return __hip_atomic_load(p, __ATOMIC_RELAXED, __HIP_MEMORY_SCOPE_AGENT); }
__device__ __forceinline__ unsigned xb_add(unsigned* p, unsigned v) { return __hip_atomic_fetch_add(p, v, __ATOMIC_RELAXED, __HIP_MEMORY_SCOPE_AGENT); }
__device__ __forceinline__ unsigned xb_xcc_id() { return (unsigned)__builtin_amdgcn_s_getreg((3 << 11) | 20) & 0xFu; }
#define XB_SPIN(cond, bar) do { unsigned _sp = 0; while (cond) { __builtin_amdgcn_s_sleep(1); \
    if ((++_sp & 255u) == 0u) { if (xb_ld(&(bar)[XB_TMO])) break; if (_sp > XB_SPIN_CAP) { atomicAdd(&(bar)[XB_TMO], 1u); break; } } } } while (0)

struct XcdBarrier { unsigned* bar; unsigned x; volatile LAS unsigned* st; };

__device__ __forceinline__ XcdBarrier xcd_barrier_post(unsigned* bar, volatile LAS unsigned* st) {
    XcdBarrier b; b.bar = bar; b.x = xb_xcc_id(); b.st = st;
    if (threadIdx.x == 0) { const unsigned rank = xb_add(&bar[XB_XCNT(b.x)], 1u); st[2] = b.x; st[3] = rank; }
    return b;
}
__device__ __forceinline__ void xcd_barrier_complete(unsigned* bar, unsigned x, unsigned& nloc, unsigned& nx) {
    const unsigned G = gridDim.x * gridDim.y * gridDim.z;
    unsigned sum, cnt, mine, sp = 0u;
    for (;;) {
        sum = 0u; cnt = 0u; mine = 0u;
#pragma unroll
        for (unsigned j = 0; j < 16; ++j) { const unsigned c = xb_ld(&bar[XB_XCNT(j)]); sum += c; cnt += (c > 0u) ? 1u : 0u; mine = (j == x) ? c : mine; }
        if (sum == G) break;
        __builtin_amdgcn_s_sleep(1);
        if ((++sp & 255u) == 0u) { if (xb_ld(&bar[XB_TMO])) break; if (sp > XB_SPIN_CAP) { atomicAdd(&bar[XB_TMO], 1u); break; } }
    }
    nloc = mine > 0u ? mine : 1u; nx = cnt > 0u ? cnt : 1u;
}
__device__ __forceinline__ void xcd_barrier(const XcdBarrier& b) {
    asm volatile("s_waitcnt vmcnt(0)" ::: "memory");
    __syncthreads();
    if (threadIdx.x == 0) {
        unsigned* bar = b.bar;
        __builtin_amdgcn_s_waitcnt(0);
        unsigned nloc = b.st[0], nx = b.st[1];
        if (nloc == 0u) { xcd_barrier_complete(bar, b.x, nloc, nx); b.st[0] = nloc; b.st[1] = nx; }
        const unsigned old = xb_add(&bar[XB_XSUB(b.x)], 1u);
        const unsigned gen = old / nloc;
        if (old + 1u == (gen + 1u) * nloc) {
            __builtin_amdgcn_fence(__ATOMIC_RELEASE, "agent");
            asm volatile("s_waitcnt vmcnt(0)" ::: "memory");
            const unsigned og = xb_add(&bar[XB_TOP], 1u);
            const unsigned tg = og / nx;
            if (og + 1u == (tg + 1u) * nx) xb_add(&bar[XB_TOPGEN], 1u);
            else XB_SPIN(xb_ld(&bar[XB_TOPGEN]) == tg, bar);
            __builtin_amdgcn_fence(__ATOMIC_ACQUIRE, "agent");
            xb_add(&bar[XB_XGEN(b.x)], 1u);
            asm volatile("s_waitcnt vmcnt(0)" ::: "memory");
        } else {
            XB_SPIN(xb_ld(&bar[XB_XGEN(b.x)]) == gen, bar);
            __builtin_amdgcn_fence(__ATOMIC_ACQUIRE, "agent");
            asm volatile("s_waitcnt vmcnt(0)" ::: "memory");
        }
    }
    __syncthreads();
}

enum { PH_MODCONV = 0, PH_HX, PH_GEMM_R, PH_RW_PREP, PH_RW_SCAN, PH_RW_READ, PH_RW_G, PH_GEMM_N, PH_NA_NORM, PH_NA_ATT, PH_GEMM_M, PH_ML_SCAN, PH_ML_READ,
       PH_GEMM_G, PH_MERGE, PH_OUT, PH_NORM2, PH_ROUTER, PH_ROUTE, PH_SHARED, PH_MOE_EXP, PH_MOE_COMB, PH_COUNT };

template <int PH> DEV void run_phase(const Params& p, int L, int sub, char* smem, Topo tp) {
    const int tid = TID(), lane = tid & 63, fr = lane & 31, fh = lane >> 5;
    char* ws = p.ws;
    const int ntl = L == 0 ? NT : NX;
    const bf16_t* HX = (const bf16_t*)(ws + OFF_HX);
    const bf16_t* WINT = (const bf16_t*)(ws + OFF_WINT);
    if constexpr (PH == PH_MODCONV) { ph_mod(p, L, smem); ph_conv_mix(p, L, smem); }
    else if constexpr (PH == PH_HX) { ph_norm(p, L, 0, NT); }
    else if constexpr (PH == PH_GEMM_R || PH == PH_GEMM_M) {
        const int c0 = PH == PH_GEMM_R ? 0 : RW_COLS + NA_COLS;
        const int N = PH == PH_GEMM_R ? RW_COLS : ML_COLS;
        bf16_t* PX = (bf16_t*)(ws + OFF_PX);
        gemm256(HX, NT, WINT + (size_t)c0 * DM, N, DM, smem, tp, [&](int row, int col, const float (&v)[8]) {
            if (col < N) st8(PX + (size_t)row * N + col, v);
        });
    }
    else if constexpr (PH == PH_GEMM_N) {
        bf16_t* PX = (bf16_t*)(ws + OFF_PX); bf16_t* VT = (bf16_t*)(ws + OFF_VT); bf16_t* VTC = (bf16_t*)(ws + OFF_VTC);
        gemm256(HX, NT, WINT + (size_t)RW_COLS * DM, 1024, DM, smem, tp, [&](int row, int col, const float (&v)[8]) { st8(PX + (size_t)row * 1024 + col, v); });
        gemm_phase<4, 2>(HX, DM, NT, WINT + (size_t)(RW_COLS + 1024) * DM, DM, 512, DM, smem, tp, [&](const f32x16 (&acc)[2][2], int row0, int col0) {
            const int h = col0 >> 6;
            epi_cols(acc, smem, [&](int r8, int col, const float (&v)[8]) {
                const int n = row0 + r8;
                bf16_t* dst = n < NX ? VT + ((size_t)((n >> 11) * 8 + h) * 64 + col) * SEQ + (n & 2047)
                                     : VTC + ((size_t)(((n - NX) >> 8) * 8 + h) * 64 + col) * CTXL + ((n - NX) & 255);
                st8(dst, v);
            });
        });
    }
    else if constexpr (PH == PH_RW_PREP) { ph_rw_prep(p, L, smem); }
    else if constexpr (PH == PH_RW_SCAN) { ph_rw_scan(p, L, smem); }
    else if constexpr (PH == PH_RW_READ) { ph_rw_read(p, L, ntl); }
    else if constexpr (PH == PH_RW_G) {
        bf16_t* YA = (bf16_t*)(ws + OFF_YA);
        gemm_phase<4, 2>((const bf16_t*)(ws + OFF_SGB), 128, ntl, (const bf16_t*)(ws + OFF_G2T), 128, 512, 128, smem, tp, [&](const f32x16 (&acc)[2][2], int row0, int col0) {
            epi_rows(acc, smem, [&](int row, int c8, const float (&v)[8]) {
                bf16_t* q = YA + (size_t)(row0 + row) * 512 + col0 + c8;
                float y[8]; ld8(q, y);
                UNROLL for (int i = 0; i < 8; ++i) y[i] *= v[i];
                st8(q, y);
            });
        });
    }
    else if constexpr (PH == PH_NA_NORM) { ph_na_norm(p, L); }
    else if constexpr (PH == PH_NA_ATT) { ph_na_att(p, L, smem); }
    else if constexpr (PH == PH_ML_SCAN) { ph_ml_scan(p, L, smem); }
    else if constexpr (PH == PH_ML_READ) { ph_ml_read(p, L, ntl); }
    else if constexpr (PH == PH_GEMM_G) {
        bf16_t* G = (bf16_t*)(ws + OFF_GATES);
        gemm256(HX, ntl, WINT + (size_t)(RW_COLS + NA_COLS + ML_COLS) * DM, GATE_COLS, DM, smem, tp, [&](int row, int col, const float (&v)[8]) {
            float y[8];
            UNROLL for (int i = 0; i < 8; ++i) y[i] = sigm(v[i]);
            st8(G + (size_t)row * GATE_COLS + col, y);
        });
    }
    else if constexpr (PH == PH_MERGE) {
        const bf16_t* G = (const bf16_t*)(ws + OFF_GATES); bf16_t* MG = (bf16_t*)(ws + OFF_HX);
        _Pragma("unroll 1") for (int br = 0; br < 3; ++br) {
            gemm256((const bf16_t*)(ws + OFF_YA + (size_t)br * SZ_Y1), ntl, (const bf16_t*)(ws + OFF_WBT) + (size_t)br * 1024 * 512, DM, 512, smem, tp, [&](int row, int col, const float (&v)[8]) {
                float g[8], m[8];
                ld8(G + (size_t)row * GATE_COLS + br * DM + col, g);
                bf16_t* q = MG + (size_t)row * DM + col;
                if (br == 0) { UNROLL for (int i = 0; i < 8; ++i) m[i] = g[i] * v[i]; }
                else { ld8(q, m); UNROLL for (int i = 0; i < 8; ++i) m[i] += g[i] * v[i]; }
                st8(q, m);
            });
        }
    }
    else if constexpr (PH == PH_OUT) {
        const float* MOD = (const float*)(ws + OFF_MOD);
        gemm256(HX, ntl, (const bf16_t*)(ws + OFF_WOUTT), DM, DM, smem, tp, [&](int n, int c, const float (&v)[8]) {
            const float* xp = xprev_row(p, L, n) + c; float* xo = xs_row(p, n) + c; const float* g1 = MOD + mod_row(n) * 6144 + 2 * DM + c;
            const float4 xa = *(const float4*)xp, xb = *(const float4*)(xp + 4), ga = *(const float4*)g1, gb = *(const float4*)(g1 + 4);
            float4 oa, ob;
            oa.x = xa.x + ga.x * v[0]; oa.y = xa.y + ga.y * v[1]; oa.z = xa.z + ga.z * v[2]; oa.w = xa.w + ga.w * v[3];
            ob.x = xb.x + gb.x * v[4]; ob.y = xb.y + gb.y * v[5]; ob.z = xb.z + gb.z * v[6]; ob.w = xb.w + gb.w * v[7];
            *(float4*)xo = oa; *(float4*)(xo + 4) = ob;
        });
    }
    else if constexpr (PH == PH_NORM2) {
        if (blockIdx.x == 0 && tid < 384) ((int*)(ws + OFF_MCNT))[tid] = 0;
        ph_norm(p, L, 1, ntl); ph_conv_moe(p, L, smem);
    }
    else if constexpr (PH == PH_ROUTER) {
        typedef GC<4, 2> C;
        float* LOG = (float*)(ws + OFF_LOG);
        const bf16_t* H2LO = (const bf16_t*)(ws + OFF_H2LO); const bf16_t* RH = (const bf16_t*)(ws + OFF_RTR); const bf16_t* RL = RH + 64 * 1024;
        const int wave = tid >> 6, wm = wave / 2, wn = wave % 2;
        for (int t = blockIdx.x; t < ntl / C::BM; t += gridDim.x) {
            f32x16 acc[2][2]; acc_zero(acc);
            const bf16_t* A0 = HX + (size_t)t * C::BM * DM; const bf16_t* A1 = H2LO + (size_t)t * C::BM * DM;
            gemm_tile<4, 2, 3, false>(acc, [&](int r) { return A0 + (size_t)r * DM; }, RH, DM, 0, 64, DM, smem, nullptr);
            gemm_tile<4, 2, 3, false>(acc, [&](int r) { return A1 + (size_t)r * DM; }, RH, DM, 0, 64, DM, smem, nullptr);
            gemm_tile<4, 2, 3, false>(acc, [&](int r) { return A0 + (size_t)r * DM; }, RL, DM, 0, 64, DM, smem, nullptr);
            epi_rows(acc, smem, [&](int row, int c8, const float (&v)[8]) {
                if (wn == 0) {
                    float* q = LOG + (size_t)(t * C::BM + wm * 64 + row) * 64 + c8;
                    *(float4*)q = make_float4(v[0], v[1], v[2], v[3]); *(float4*)(q + 4) = make_float4(v[4], v[5], v[6], v[7]);
                }
            });
        }
    }
    else if constexpr (PH == PH_ROUTE) { ph_route(p, L, ntl, smem); }
    else if constexpr (PH == PH_SHARED) {
        ph_moe_scatter(p, ntl, smem);
        bf16_t* SA = (bf16_t*)(ws + OFF_SA);
        gemm256_pair(HX, ntl, (const bf16_t*)(ws + OFF_SGUT), 512, DM, smem, tp, [&](int row, int col, const float (&g)[8], const float (&u)[8]) {
            float a[8];
            UNROLL for (int i = 0; i < 8; ++i) a[i] = g[i] / (1.f + __expf(-g[i])) * u[i];
            st8(SA + (size_t)row * 256 + (col >> 8) * 128 + (col & 127), a);
        });
    }
    else if constexpr (PH == PH_MOE_EXP) { const int cb = sub * MOE_CHUNK; ph_moe_exp(p, cb, min(cb + MOE_CHUNK, ntl), smem, tp); }
    else if constexpr (PH == PH_MOE_COMB) {
        const int cb = sub * MOE_CHUNK, ce = min(cb + MOE_CHUNK, ntl);
        const float* MOD = (const float*)(ws + OFF_MOD); const bf16_t* YBUF = (const bf16_t*)(ws + OFF_YBUF);
        gemm256((const bf16_t*)(ws + OFF_SA) + (size_t)cb * 256, ce - cb, (const bf16_t*)(ws + OFF_SDT), DM, 256, smem, tp, [&](int rl, int c, const float (&v)[8]) {
            const int n = cb + rl;
            float s[8];
            UNROLL for (int i = 0; i < 8; ++i) s[i] = v[i];
            _Pragma("unroll 2") for (int k = 0; k < 8; ++k) { float y[8]; ld8(YBUF + ((size_t)rl * 8 + k) * DM + c, y); UNROLL for (int i = 0; i < 8; ++i) s[i] += y[i]; }
            float* xo = xs_row(p, n) + c; const float* g2 = MOD + mod_row(n) * 6144 + 5 * DM + c;
            float4 xa = *(const float4*)xo, xb = *(const float4*)(xo + 4); const float4 ga = *(const float4*)g2, gb = *(const float4*)(g2 + 4);
            xa.x += ga.x * s[0]; xa.y += ga.y * s[1]; xa.z += ga.z * s[2]; xa.w += ga.w * s[3];
            xb.x += gb.x * s[4]; xb.y += gb.y * s[5]; xb.z += gb.z * s[6]; xb.w += gb.w * s[7];
            *(float4*)xo = xa; *(float4*)(xo + 4) = xb;
        });
    }
}

template <int PH> __global__ void __launch_bounds__(NTHREADS, 2) k_phase(Params p, int L, int sub) {
    extern __shared__ __attribute__((aligned(16))) char smem[];
    run_phase<PH>(p, L, sub, smem, Topo{(int)(blockIdx.x & 7), (int)(blockIdx.x >> 3), (int)((gridDim.x + 7 - (blockIdx.x & 7)) >> 3)});
}


#ifndef N_LAUNCH_MODE
#define N_LAUNCH_MODE 1
#endif
#ifndef MEGA_SKIP
#define MEGA_SKIP 0ull
#endif
#ifndef MEGA_REPEAT
#define MEGA_REPEAT 0ull
#endif
#define PHASE(PH, sub) do { if constexpr (!((MEGA_SKIP >> PH) & 1ull)) { run_phase<PH>(p, L, sub, smem, tp); xcd_barrier(bar); if constexpr ((MEGA_REPEAT >> PH) & 1ull) { run_phase<PH>(p, L, sub, smem, tp); xcd_barrier(bar); } } } while (0)
__global__ void __launch_bounds__(NTHREADS, 2) k_mega(Params p) {
    extern __shared__ __attribute__((aligned(16))) char smem[];
    volatile LAS unsigned* st = (volatile LAS unsigned*)(smem + LDS_BYTES);
    if (threadIdx.x == 0) { st[0] = 0u; st[1] = 0u; st[2] = 0u; st[3] = 0u; }
    __syncthreads();
    const XcdBarrier bar = xcd_barrier_post((unsigned*)(p.ws + OFF_BAR), st);
    Topo tp{(int)(blockIdx.x & 7), (int)(blockIdx.x >> 3), (int)((gridDim.x + 7 - (blockIdx.x & 7)) >> 3)};
    for (int L = 0; L < 2; ++L) {
        const int ntl = L == 0 ? NT : NX;
        PHASE(PH_MODCONV, 0);
        if (st[1] == 8u && st[0] != 0u) { tp.x = (int)st[2]; tp.r = (int)st[3]; tp.n = (int)st[0]; }
        PHASE(PH_HX, 0);
        PHASE(PH_GEMM_R, 0);
        PHASE(PH_RW_PREP, 0);
        PHASE(PH_RW_SCAN, 0);
        PHASE(PH_RW_READ, 0);
        PHASE(PH_RW_G, 0);
        PHASE(PH_GEMM_N, 0);
        PHASE(PH_NA_ATT, 0);
        PHASE(PH_GEMM_M, 0);
        PHASE(PH_ML_SCAN, 0);
        PHASE(PH_ML_READ, 0);
        PHASE(PH_GEMM_G, 0);
        PHASE(PH_MERGE, 0);
        PHASE(PH_OUT, 0);
        PHASE(PH_NORM2, 0);
        PHASE(PH_ROUTER, 0);
        PHASE(PH_ROUTE, 0);
        PHASE(PH_SHARED, 0);
        for (int c = 0; c * MOE_CHUNK < ntl; ++c) {
            PHASE(PH_MOE_EXP, c);
            PHASE(PH_MOE_COMB, c);
        }
    }
}

template <int PH> static void launch_phase(const Params& p, int L, int sub, hipStream_t stream) {
    static bool attr = false;
    if (!attr) { (void)hipFuncSetAttribute((const void*)k_phase<PH>, hipFuncAttributeMaxDynamicSharedMemorySize, LDS_BYTES); attr = true; }
    hipLaunchKernelGGL(k_phase<PH>, dim3(256), dim3(NTHREADS), LDS_BYTES, stream, p, L, sub);
}

extern "C" void kernel_launch(void* const* d_in, const int* in_sizes, int n_in, void* d_out, int out_size, void* d_ws, size_t ws_size, hipStream_t stream) {
    if (n_in != N_IN || ws_size < WS_END) { fprintf(stderr, "kernel_launch: unexpected inputs (%d) or workspace (%zu < %zu)\n", n_in, ws_size, (size_t)WS_END); return; }
    Params p{};
    for (int i = 0; i < N_IN; ++i) p.in[i] = (const float*)d_in[i];
    p.out = (float*)d_out; p.ws = (char*)d_ws;
#if N_LAUNCH_MODE == 1
    static int grid = 0;
    if (grid == 0) {
        int dev = 0, cus = 0;
        if (hipGetDevice(&dev) != hipSuccess || hipDeviceGetAttribute(&cus, hipDeviceAttributeMultiprocessorCount, dev) != hipSuccess) { grid = -1; return; }
        if (hipFuncSetAttribute((const void*)k_mega, hipFuncAttributeMaxDynamicSharedMemorySize, LDS_BYTES + 256) != hipSuccess) { grid = -1; return; }
        grid = cus;
    }
    if (grid <= 0) return;
    (void)hipMemsetAsync((char*)d_ws + OFF_BAR, 0, XCD_BAR_WORDS * sizeof(unsigned), stream);
    hipLaunchKernelGGL(k_mega, dim3(grid), dim3(NTHREADS), LDS_BYTES + 256, stream, p);
    return;
#endif
    for (int L = 0; L < 2; ++L) {
        const int ntl = L == 0 ? NT : NX;
        launch_phase<PH_MODCONV>(p, L, 0, stream);
        launch_phase<PH_HX>(p, L, 0, stream);
        launch_phase<PH_GEMM_R>(p, L, 0, stream);
        launch_phase<PH_RW_PREP>(p, L, 0, stream);
        launch_phase<PH_RW_SCAN>(p, L, 0, stream);
        launch_phase<PH_RW_READ>(p, L, 0, stream);
        launch_phase<PH_RW_G>(p, L, 0, stream);
        launch_phase<PH_GEMM_N>(p, L, 0, stream);
        launch_phase<PH_NA_ATT>(p, L, 0, stream);
        launch_phase<PH_GEMM_M>(p, L, 0, stream);
        launch_phase<PH_ML_SCAN>(p, L, 0, stream);
        launch_phase<PH_ML_READ>(p, L, 0, stream);
        launch_phase<PH_GEMM_G>(p, L, 0, stream);
        launch_phase<PH_MERGE>(p, L, 0, stream);
        launch_phase<PH_OUT>(p, L, 0, stream);
        launch_phase<PH_NORM2>(p, L, 0, stream);
        launch_phase<PH_ROUTER>(p, L, 0, stream);
        launch_phase<PH_ROUTE>(p, L, 0, stream);
        launch_phase<PH_SHARED>(p, L, 0, stream);
        for (int c = 0; c * MOE_CHUNK < ntl; ++c) {
            launch_phase<PH_MOE_EXP>(p, L, c, stream);
            launch_phase<PH_MOE_COMB>(p, L, c, stream);
        }
    }
}
```

```cpp
#include <hip/hip_runtime.h>
#include <stdint.h>
#include <stdio.h>

#define DEV __device__ __forceinline__
#define UNROLL _Pragma("unroll")

typedef unsigned short bf16_t;
typedef short bf16x8 __attribute__((ext_vector_type(8)));
typedef float f32x16 __attribute__((ext_vector_type(16)));
typedef float f32x4v __attribute__((ext_vector_type(4)));
typedef unsigned u32x4 __attribute__((ext_vector_type(4)));
typedef unsigned u32x2 __attribute__((ext_vector_type(2)));

constexpr int DM = 1024, NBATCH = 16, SEQ = 2048, CTXL = 256;
constexpr int NX = NBATCH * SEQ, NC = NBATCH * CTXL, NT = NX + NC;
constexpr int RW_COLS = 1920, NA_COLS = 1536, ML_COLS = 1552, GATE_COLS = 3072, IN_COLS = 8080;
constexpr int NTHREADS = 512;
constexpr int MOE_CHUNK = 12288, MOE_ST = 768;

enum { I_X = 0, I_C, I_CTX, I_CCTX, I_WADA, I_BADA, I_N1G, I_N2G, I_WIN, I_MU, I_W0, I_W2, I_A0, I_A2, I_KK, I_KA, I_RK, I_G2,
       I_LNG, I_LNB, I_V0, I_V1, I_V2, I_QNG, I_KNG, I_RPB, I_IB, I_FB, I_MNG, I_WBR, I_WOUT, I_RTR, I_MB, I_MWG, I_MWU, I_MWD,
       I_SG, I_SU, I_SD, N_IN };

constexpr size_t OFF_BAR = 0;
constexpr size_t OFF_MOD = 16384;
constexpr size_t OFF_WINT = OFF_MOD + 417792;
constexpr size_t OFF_WBT = OFF_WINT + (size_t)IN_COLS * 1024 * 2;
constexpr size_t OFF_WOUTT = OFF_WBT + (size_t)3 * 1024 * 512 * 2;
constexpr size_t OFF_SGUT = OFF_WOUTT + (size_t)1024 * 1024 * 2;
constexpr size_t OFF_SDT = OFF_SGUT + (size_t)512 * 1024 * 2;
constexpr size_t OFF_G2T = OFF_SDT + (size_t)1024 * 256 * 2;
constexpr size_t OFF_RTR = OFF_G2T + (size_t)512 * 128 * 2;
constexpr size_t OFF_CTXS = OFF_RTR + (size_t)2 * 64 * 1024 * 2;
constexpr size_t OFF_VF = OFF_CTXS + (size_t)NC * 1024 * 4;
constexpr size_t OFF_HX = OFF_VF + (size_t)NT * 512 * 2;
constexpr size_t OFF_BIG = OFF_HX + (size_t)NT * 1024 * 2;
constexpr size_t SZ_Y1 = (size_t)NT * 512 * 2;
constexpr size_t OFF_YA = OFF_BIG, OFF_YB = OFF_YA + SZ_Y1, OFF_YC = OFF_YB + SZ_Y1;
constexpr size_t OFF_PX = OFF_BIG + 3 * SZ_Y1;
constexpr size_t OFF_SCR = OFF_PX + (size_t)NT * RW_COLS * 2;
constexpr size_t SZ_SCR = (size_t)NT * 1152 * 2;
constexpr size_t OFF_MGU = OFF_SCR + SZ_SCR;
constexpr size_t WS_END = OFF_MGU + (size_t)64 * 256 * 1024 * 2;
constexpr size_t OFF_YS = OFF_YB;
constexpr size_t OFF_SGB = OFF_SCR;
constexpr size_t OFF_CB = OFF_SCR + (size_t)NT * 128 * 2;
constexpr size_t OFF_HS = OFF_SCR;
constexpr size_t OFF_VT = OFF_PX + (size_t)NT * 1024 * 2;
constexpr size_t OFF_VTC = OFF_VT + (size_t)NX * 512 * 2;
constexpr size_t OFF_GATES = OFF_PX;
constexpr size_t OFF_MDT = OFF_BIG;
constexpr size_t OFF_SA = OFF_MDT + (size_t)64 * 1024 * 128 * 2;
constexpr size_t OFF_EIDX = OFF_SA + (size_t)NT * 256 * 2;
constexpr size_t OFF_EW = OFF_EIDX + (size_t)NT * 8 * 4;
constexpr int SORT_CAP = 106496;
constexpr size_t OFF_SORT = OFF_EW + (size_t)NT * 8 * 4;
constexpr size_t OFF_LOG = OFF_SORT + (size_t)3 * SORT_CAP * 4;
constexpr size_t OFF_H2LO = OFF_LOG + (size_t)NT * 64 * 4;
constexpr size_t OFF_YBUF = OFF_LOG;
static_assert(OFF_YBUF + (size_t)MOE_CHUNK * 8 * 1024 * 2 <= WS_END, "moe layout");
static_assert(OFF_GATES + (size_t)NT * 3072 * 2 <= WS_END, "gates layout");
static_assert(WS_END <= (size_t)536870912, "workspace");

constexpr size_t OFF_MCNT = OFF_BAR + 14336;
constexpr int LDS_BYTES = 155648;

struct Topo { int x, r, n; };
struct Params {
    const float* in[N_IN];
    float* out;
    char* ws;
};

DEV int TID() { int t = threadIdx.x; asm volatile("" : "+v"(t)); return t; }
DEV float bf2f(bf16_t h) { return __uint_as_float(((unsigned)h) << 16); }
typedef __bf16 bf16x2n __attribute__((ext_vector_type(2)));
typedef float f32x2n __attribute__((ext_vector_type(2)));
DEV unsigned pk2(float lo, float hi) { const f32x2n v = {lo, hi}; return __builtin_bit_cast(unsigned, __builtin_convertvector(v, bf16x2n)); }
DEV bf16_t f2bf(float f) { return (bf16_t)(pk2(f, 0.f) & 0xffffu); }
DEV void ld8(const bf16_t* p, float (&o)[8]) {
    const u32x4 v = *(const u32x4*)p;
    o[0] = __uint_as_float(v.x << 16); o[1] = __uint_as_float(v.x & 0xffff0000u);
    o[2] = __uint_as_float(v.y << 16); o[3] = __uint_as_float(v.y & 0xffff0000u);
    o[4] = __uint_as_float(v.z << 16); o[5] = __uint_as_float(v.z & 0xffff0000u);
    o[6] = __uint_as_float(v.w << 16); o[7] = __uint_as_float(v.w & 0xffff0000u);
}
DEV void st8(bf16_t* p, const float (&v)[8]) {
    u32x4 o; o.x = pk2(v[0], v[1]); o.y = pk2(v[2], v[3]); o.z = pk2(v[4], v[5]); o.w = pk2(v[6], v[7]);
    *(u32x4*)p = o;
}
#define DPP_MOV(v, ctrl) __builtin_bit_cast(float, __builtin_amdgcn_update_dpp(0, __builtin_bit_cast(int, (v)), (ctrl), 0xF, 0xF, true))
DEV float sum8(float v) { v += DPP_MOV(v, 0xB1); v += DPP_MOV(v, 0x4E); v += DPP_MOV(v, 0x141); return v; }
DEV float frcp(float x) { return __builtin_amdgcn_rcpf(x); }
DEV float sigm(float x) { return frcp(1.f + __expf(-x)); }
DEV float sigm_acc(float x) { return 1.f / (1.f + expf(-x)); }
DEV float tanh_fast(float x) { return 1.f - 2.f * frcp(1.f + __expf(2.f * x)); }
DEV float softplus_fast(float x) { return fmaxf(x, 0.f) + __logf(1.f + __expf(-fabsf(x))); }
DEV int mod_row(int n) { return n < NX ? (n >> 11) : 16; }
DEV float* xs_row(const Params& p, int n) { return n < NX ? p.out + (size_t)n * DM : (float*)(p.ws + OFF_CTXS) + (size_t)(n - NX) * DM; }
DEV const float* xprev_row(const Params& p, int L, int n) {
    if (L == 0) return n < NX ? p.in[I_X] + (size_t)n * DM : p.in[I_CTX] + (size_t)(n - NX) * DM;
    return xs_row(p, n);
}
DEV void seq_of(int n, int& nb, int& tt, int& T) {
    if (n < NX) { nb = n & ~2047; tt = n & 2047; T = SEQ; } else { const int m = n - NX; nb = NX + (m & ~255); tt = m & 255; T = CTXL; }
}
DEV void shift8(const bf16_t* z, int ld, int nb, int tt, int T, int col0, const float* mu, float (&o)[8]) {
    float c[8], l[8], r[8];
    ld8(z + (size_t)(nb + tt) * ld + col0, c);
    if (tt > 0) ld8(z + (size_t)(nb + tt - 1) * ld + col0, l); else { UNROLL for (int i = 0; i < 8; ++i) l[i] = 0.f; }
    if (tt < T - 1) ld8(z + (size_t)(nb + tt + 1) * ld + col0, r); else { UNROLL for (int i = 0; i < 8; ++i) r[i] = 0.f; }
    UNROLL for (int i = 0; i < 8; ++i) o[i] = c[i] + mu[col0 + i] * (0.5f * (l[i] + r[i]) - c[i]);
}

constexpr int LROW = 144;
template <int WM, int WN> struct GC {
    static constexpr int BM = 64 * WM, BN = 64 * WN;
    static constexpr int AB = BM * 128, BB = BN * 128, STG = AB + BB;
    static constexpr int NA = BM / 64, NBC = BN / 64;
};
DEV void acc_zero(f32x16 (&acc)[2][2]) {
    UNROLL for (int a = 0; a < 2; ++a) UNROLL for (int b = 0; b < 2; ++b) UNROLL for (int r = 0; r < 16; ++r) acc[a][b][r] = 0.f;
}
#define GLDS16(gp, lp) __builtin_amdgcn_global_load_lds((const __attribute__((address_space(1))) void*)(gp), (__attribute__((address_space(3))) void*)(lp), 16, 0, 0)
template <int WM, int WN, int NS, bool A_LDS, class ARow>
DEV void gemm_tile(f32x16 (&acc)[2][2], ARow arow, const bf16_t* Bt, int ldb, int n0, int Nvalid, int K, char* smem, const char* alds) {
    typedef GC<WM, WN> C;
    constexpr int LPT = (A_LDS ? 0 : C::NA) + C::NBC;
    const int tid = TID(), lane = tid & 63, wave = tid >> 6, wm = wave / WN, wn = wave % WN;
    const int fr = lane & 31, fh = lane >> 5;
    const int crow = tid >> 3, cch = (tid & 7) ^ ((crow >> 1) & 7);
    const bf16_t* pa[C::NA]; const bf16_t* pb[C::NBC];
    if (!A_LDS) { UNROLL for (int i = 0; i < C::NA; ++i) pa[i] = arow(crow + 64 * i) + cch * 8; }
    UNROLL for (int i = 0; i < C::NBC; ++i) { const int n = min(n0 + crow + 64 * i, Nvalid - 1); pb[i] = Bt + (size_t)n * ldb + cch * 8; }
    const int nk = K >> 6;
#define GT_ISSUE(kt, stg) do { char* sb_ = smem + (stg) * C::STG + tid * 16; \
        if (!A_LDS) { UNROLL for (int i = 0; i < C::NA; ++i) GLDS16(pa[i] + (kt) * 64, sb_ + i * 8192); } \
        UNROLL for (int i = 0; i < C::NBC; ++i) GLDS16(pb[i] + (kt) * 64, sb_ + C::AB + i * 8192); } while (0)
    const int sw = (fr >> 1) & 7;
    int offk[4];
    UNROLL for (int ks = 0; ks < 4; ++ks) offk[ks] = ((2 * ks + fh) ^ sw) * 16;
    const int a_base = (wm * 64 + fr) * 128, b_base = (wn * 64 + fr) * 128;
    UNROLL for (int s = 0; s < NS - 1; ++s) if (s < nk) GT_ISSUE(s, s);
    int stg = 0, nstg = NS - 1;
    for (int kt = 0; kt < nk; ++kt) {
        if (NS == 3 && kt + 1 < nk) asm volatile("s_waitcnt vmcnt(%0)" :: "n"(LPT) : "memory");
        else asm volatile("s_waitcnt vmcnt(0)" ::: "memory");
        __builtin_amdgcn_s_barrier();
        asm volatile("" ::: "memory");
        const bool more = kt + NS - 1 < nk;
        const char* As_ = A_LDS ? alds + kt * C::AB : smem + stg * C::STG; const char* Bs_ = smem + stg * C::STG + C::AB;
        char* db_ = smem + nstg * C::STG + tid * 16;
        bf16x8 af[2][2], bfv[2][2];
        UNROLL for (int mi = 0; mi < 2; ++mi) af[0][mi] = *(const bf16x8*)(As_ + a_base + mi * 4096 + offk[0]);
        UNROLL for (int ni = 0; ni < 2; ++ni) bfv[0][ni] = *(const bf16x8*)(Bs_ + b_base + ni * 4096 + offk[0]);
        UNROLL for (int ks = 0; ks < 4; ++ks) {
            const int cur = ks & 1, nxt = cur ^ 1;
            if (ks < 3) {
                UNROLL for (int mi = 0; mi < 2; ++mi) af[nxt][mi] = *(const bf16x8*)(As_ + a_base + mi * 4096 + offk[ks + 1]);
                UNROLL for (int ni = 0; ni < 2; ++ni) bfv[nxt][ni] = *(const bf16x8*)(Bs_ + b_base + ni * 4096 + offk[ks + 1]);
            }
            UNROLL for (int mi = 0; mi < 2; ++mi) UNROLL for (int ni = 0; ni < 2; ++ni)
                acc[mi][ni] = __builtin_amdgcn_mfma_f32_32x32x16_bf16(af[cur][mi], bfv[cur][ni], acc[mi][ni], 0, 0, 0);
            if (more) {
                UNROLL for (int pc = 0; pc < LPT; ++pc) if (pc * 4 / LPT == ks) {
                    if (!A_LDS && pc < C::NA) GLDS16(pa[pc] + (kt + NS - 1) * 64, db_ + pc * 8192);
                    else { const int ib = pc - (A_LDS ? 0 : C::NA); GLDS16(pb[ib] + (kt + NS - 1) * 64, db_ + C::AB + ib * 8192); }
                }
            }
            __builtin_amdgcn_sched_barrier(0);
        }
        stg = stg + 1 == NS ? 0 : stg + 1; nstg = nstg + 1 == NS ? 0 : nstg + 1;
    }
    __syncthreads();
#undef GT_ISSUE
}
#define ACC_ROW(mi, r, fh) ((mi) * 32 + ((r) & 3) + 8 * ((r) >> 2) + 4 * (fh))

constexpr int EPI_SLAB = 32 * 68 * 4;
template <class F> DEV void epi_rows(const f32x16 (&acc)[2][2], char* smem, F f) {
    const int lane = TID() & 63, wave = TID() >> 6, fr = lane & 31, fh = lane >> 5;
    float* st = (float*)(smem + wave * EPI_SLAB);
    UNROLL for (int mi = 0; mi < 2; ++mi) {
        UNROLL for (int ni = 0; ni < 2; ++ni) UNROLL for (int r = 0; r < 16; ++r)
            st[((r & 3) + 8 * (r >> 2) + 4 * fh) * 68 + ni * 32 + fr] = acc[mi][ni][r];
        UNROLL for (int it = 0; it < 4; ++it) {
            const int row = it * 8 + (lane >> 3), c8 = (lane & 7) * 8;
            const float4 a = *(const float4*)(st + row * 68 + c8), b = *(const float4*)(st + row * 68 + c8 + 4);
            float v[8] = {a.x, a.y, a.z, a.w, b.x, b.y, b.z, b.w};
            f(mi * 32 + row, c8, v);
        }
    }
    __syncthreads();
}


template <class F> DEV void epi_cols(const f32x16 (&acc)[2][2], char* smem, F f) {
    const int lane = TID() & 63, wave = TID() >> 6, fr = lane & 31, fh = lane >> 5;
    float* st = (float*)(smem + wave * EPI_SLAB);
    UNROLL for (int mi = 0; mi < 2; ++mi) {
        UNROLL for (int ni = 0; ni < 2; ++ni) UNROLL for (int r = 0; r < 16; ++r)
            st[((r & 3) + 8 * (r >> 2) + 4 * fh) * 68 + ni * 32 + fr] = acc[mi][ni][r];
        UNROLL for (int it = 0; it < 4; ++it) {
            float v[8];
            UNROLL for (int i = 0; i < 8; ++i) v[i] = st[(it * 8 + i) * 68 + lane];
            f(mi * 32 + it * 8, lane, v);
        }
    }
    __syncthreads();
}

struct TileOrder {
    int x, nN, cx, total;
    DEV TileOrder(const Topo& tp, int nM, int nN_) { x = tp.x; nN = nN_; cx = nM > x ? (nM - x + 7) >> 3 : 0; total = ((cx + 3) >> 2) * 4 * nN; }
    DEV bool get(int q, int& pm, int& pn) const { const int per = 4 * nN, qi = q / per, rem = q - qi * per, i = 4 * qi + (rem & 3); pn = rem >> 2; pm = x + 8 * i; return i < cx; }
};
template <int WM, int WN, class Epi>
DEV void gemm_phase(const bf16_t* A, int lda, int M, const bf16_t* Bt, int ldb, int N, int K, char* smem, const Topo& tp, Epi epi) {
    typedef GC<WM, WN> C;
    const int nM = M / C::BM, nN = (N + C::BN - 1) / C::BN;
    const int wave = TID() >> 6, wm = wave / WN, wn = wave % WN;
    const TileOrder ord(tp, nM, nN);
    for (int q = tp.r; q < ord.total; q += tp.n) {
        int pm, pn; if (!ord.get(q, pm, pn)) continue;
        f32x16 acc[2][2]; acc_zero(acc);
        const bf16_t* Ab = A + (size_t)pm * C::BM * lda;
        gemm_tile<WM, WN, 3, false>(acc, [&](int r) { return Ab + (size_t)r * lda; }, Bt, ldb, pn * C::BN, N, K, smem, nullptr);
        epi(acc, pm * C::BM + wm * 64, pn * C::BN + wn * 64);
    }
}

namespace pg8 {
#define PG8_LAS __attribute__((address_space(3)))
typedef float f32x4 __attribute__((ext_vector_type(4)));
constexpr int BM = 256, BK = 64, HALF = 128, HTB = HALF * BK * 2  , STAGE_BYTES = 8 * HTB, NXCD = 8, WGM = 8;

__host__ __device__ __forceinline__ int lds_byte(int r, int c) { const int st = (r >> 4) * 2 + (c >> 5), rr = r & 15, cc = c & 31, ob = rr * 64 + cc * 2; return st * 1024 + (ob ^ (((ob >> 9) & 1) << 5)); }
__host__ __device__ __forceinline__ void stage_rc(int b, int& R, int& C) { const int st = b / 1024, sb = b % 1024, swz = sb ^ (((sb >> 9) & 1) << 5); R = (st >> 1) * 16 + swz / 64; C = (st & 1) * 32 + (swz % 64) / 2; }
__host__ __device__ __forceinline__ int perm32(int rho) { const int n = rho >> 4, i = rho & 15; return 8 * (i >> 2) + 4 * n + (i & 3); }

struct Unit { int pm, pn; };
struct Gemm { const bf16_t* A; const bf16_t* Bt; int M, N, K; };
template <class Epi, class Sched, bool ALIGN_EPI = false, bool SP2 = false>
__device__ __forceinline__ void gemm_phase(PG8_LAS unsigned char* lds, const Gemm g, const Sched& S, const Epi& E) {
    const int tid = TID(), wid = __builtin_amdgcn_readfirstlane(tid >> 6), lane = tid & 63, wr = wid >> 2, wc = wid & 3, fr = lane & 15, fq = lane >> 4;
    const int K = g.K, nt = K / BK;
    unsigned voffA[2], voffB[2];
#pragma unroll
    for (int i = 0; i < 2; ++i) { int R, C; stage_rc(tid * 16 + i * 8192, R, C); const int Rb = Epi::PERM ? ((R & ~31) + perm32(R & 31)) : R;
        voffA[i] = (unsigned)(R * K + C) * 2u; voffB[i] = (unsigned)(Rb * K + C) * 2u; }
    const size_t kstep = (size_t)(BK * 2);
    const size_t hstep = (size_t)HALF * K * 2;
    const size_t tstep = 2 * hstep;
    const unsigned ldsw = (unsigned)wid * 1024u;
    const int aoff = lds_byte(wr * 64 + fr, fq * 8), boff = lds_byte(wc * 32 + fr, fq * 8);
#define PG8_SA(b, h) (((b) * 2 + (h)) * HTB)
#define PG8_SB(b, h) ((4 + (b) * 2 + (h)) * HTB)
#define PG8_STAGE(bufoff, gbase, voff) do { _Pragma("unroll") for (int _i = 0; _i < 2; ++_i) \
        __builtin_amdgcn_global_load_lds((const unsigned*)((const char*)(gbase) + (voff)[_i]), (PG8_LAS unsigned*)(lds + (bufoff) + ldsw + _i * 8192), 16, 0, 0); } while (0)
#define PG8_LDA(dst, b, h) do { _Pragma("unroll") for (int m = 0; m < 4; ++m) _Pragma("unroll") for (int k = 0; k < 2; ++k) dst[m][k] = *(const PG8_LAS bf16x8*)(lds + PG8_SA(b, h) + aoff + m * 2048 + k * 1024); } while (0)
#define PG8_LDB(dst, b, h) do { _Pragma("unroll") for (int n = 0; n < 2; ++n) _Pragma("unroll") for (int k = 0; k < 2; ++k) dst[n][k] = *(const PG8_LAS bf16x8*)(lds + PG8_SB(b, h) + boff + n * 2048 + k * 1024); } while (0)
#define PG8_MMA(ai, bj, At, Bt) do { __builtin_amdgcn_s_setprio(1); _Pragma("unroll") for (int m = 0; m < 4; ++m) _Pragma("unroll") for (int n = 0; n < 2; ++n) _Pragma("unroll") for (int k = 0; k < 2; ++k) \
        acc[ai][bj][m][n] = __builtin_amdgcn_mfma_f32_16x16x32_bf16(Bt[n][k], At[m][k], acc[ai][bj][m][n], 0, 0, 0); __builtin_amdgcn_s_setprio(0); } while (0)
#define PG8_WAIT_V(n) asm volatile("s_waitcnt vmcnt(" #n ")" ::: "memory")
#define PG8_WAIT_L(n) asm volatile("s_waitcnt lgkmcnt(" #n ")" ::: "memory")
#define PG8_BAR __builtin_amdgcn_s_barrier()
#define PG8_SCHED __builtin_amdgcn_sched_barrier(0)
    Unit cur, nxt; int ui = 0;
    if (!S.next(0, cur)) return;
    f32x4 acc[2][2][4][2];
#pragma unroll
    for (int a = 0; a < 2; ++a)
#pragma unroll
        for (int b = 0; b < 2; ++b)
#pragma unroll
            for (int m = 0; m < 4; ++m)
#pragma unroll
                for (int n = 0; n < 2; ++n) acc[a][b][m][n] = (f32x4){0.f, 0.f, 0.f, 0.f};
    bf16x8 At[4][2], B0[2][2], B1[2][2];
    const char* cA = (const char*)g.A + (size_t)cur.pm * tstep; const char* cB = (const char*)g.Bt + (size_t)cur.pn * tstep;
    S.a_ready(cur);
    if constexpr (SP2) {
        PG8_STAGE(PG8_SB(0, 0), cB, voffB); PG8_STAGE(PG8_SB(0, 1), cB + hstep, voffB); PG8_STAGE(PG8_SA(0, 0), cA, voffA); PG8_STAGE(PG8_SA(0, 1), cA + hstep, voffA);
        if (wr == 1) PG8_BAR;
        PG8_WAIT_V(2); PG8_BAR;
        PG8_STAGE(PG8_SB(1, 0), cB + kstep, voffB); PG8_STAGE(PG8_SA(1, 0), cA + kstep, voffA); PG8_STAGE(PG8_SB(1, 1), cB + hstep + kstep, voffB);
        PG8_WAIT_V(6); PG8_BAR;
    } else {
        PG8_STAGE(PG8_SB(0, 0), cB, voffB); PG8_STAGE(PG8_SA(0, 0), cA, voffA); PG8_STAGE(PG8_SB(0, 1), cB + hstep, voffB); PG8_STAGE(PG8_SA(0, 1), cA + hstep, voffA);
        if (wr == 1) PG8_BAR;
        PG8_WAIT_V(4); PG8_BAR;
        PG8_STAGE(PG8_SB(1, 0), cB + kstep, voffB); PG8_STAGE(PG8_SA(1, 0), cA + kstep, voffA); PG8_STAGE(PG8_SB(1, 1), cB + hstep + kstep, voffB);
        PG8_WAIT_V(6); PG8_BAR;
    }
    for (;;) {
        const bool has_next = S.next(ui + 1, nxt);
        const char* nA = has_next ? (const char*)g.A + (size_t)nxt.pm * tstep : cA; const char* nB = has_next ? (const char*)g.Bt + (size_t)nxt.pn * tstep : cB;
        for (int t = 0; t < nt; t += 2) {
            const bool last = (t == nt - 2);
            const char* a1 = cA + (size_t)(t + 1) * kstep;
            const char* a2 = last ? nA : cA + (size_t)(t + 2) * kstep; const char* b2 = last ? nB : cB + (size_t)(t + 2) * kstep;
            const char* a3 = a2 + kstep; const char* b3 = b2 + kstep;
            if (last && has_next) S.a_ready(nxt);
            if constexpr (SP2) {
            PG8_LDB(B0, 0, 0); PG8_LDB(B1, 0, 1); PG8_SCHED; PG8_LDA(At, 0, 0); PG8_STAGE(PG8_SA(1, 1), a1 + hstep, voffA);
            PG8_WAIT_V(8); PG8_WAIT_L(0); PG8_BAR; PG8_MMA(0, 0, At, B0); PG8_MMA(0, 1, At, B1); PG8_BAR; PG8_SCHED;
            PG8_LDA(At, 0, 1); PG8_STAGE(PG8_SB(0, 0), b2, voffB); PG8_STAGE(PG8_SB(0, 1), b2 + hstep, voffB); PG8_STAGE(PG8_SA(0, 0), a2, voffA);
            PG8_WAIT_V(8); PG8_WAIT_L(0); PG8_BAR; PG8_MMA(1, 0, At, B0); PG8_MMA(1, 1, At, B1); PG8_BAR; PG8_SCHED;
            PG8_LDB(B0, 1, 0); PG8_LDB(B1, 1, 1); PG8_SCHED; PG8_LDA(At, 1, 0); PG8_STAGE(PG8_SA(0, 1), a2 + hstep, voffA);
            PG8_WAIT_V(8); PG8_WAIT_L(0); PG8_BAR; PG8_MMA(0, 0, At, B0); PG8_MMA(0, 1, At, B1); PG8_BAR; PG8_SCHED;
            PG8_LDA(At, 1, 1); PG8_STAGE(PG8_SB(1, 0), b3, voffB); PG8_STAGE(PG8_SB(1, 1), b3 + hstep, voffB); PG8_STAGE(PG8_SA(1, 0), a3, voffA);
            PG8_WAIT_V(8); PG8_WAIT_L(0); PG8_BAR; PG8_MMA(1, 0, At, B0); PG8_MMA(1, 1, At, B1); PG8_BAR; PG8_SCHED;
            } else {
            PG8_LDB(B0, 0, 0); PG8_SCHED; PG8_LDA(At, 0, 0); PG8_STAGE(PG8_SA(1, 1), a1 + hstep, voffA);
            PG8_WAIT_L(8); PG8_BAR; PG8_WAIT_L(0); PG8_MMA(0, 0, At, B0); PG8_BAR; PG8_SCHED;
            PG8_LDB(B1, 0, 1); PG8_STAGE(PG8_SB(0, 0), b2, voffB);
            PG8_BAR; PG8_WAIT_L(0); PG8_MMA(0, 1, At, B1); PG8_BAR;
            PG8_LDA(At, 0, 1); PG8_STAGE(PG8_SA(0, 0), a2, voffA);
            PG8_BAR; PG8_WAIT_L(0); PG8_MMA(1, 0, At, B0); PG8_BAR; PG8_SCHED;
            PG8_STAGE(PG8_SB(0, 1), b2 + hstep, voffB);
            PG8_WAIT_V(6); PG8_BAR; PG8_MMA(1, 1, At, B1); PG8_BAR;
            PG8_LDB(B0, 1, 0); PG8_SCHED; PG8_LDA(At, 1, 0); PG8_STAGE(PG8_SA(0, 1), a2 + hstep, voffA);
            PG8_WAIT_L(8); PG8_BAR; PG8_WAIT_L(0); PG8_MMA(0, 0, At, B0); PG8_BAR; PG8_SCHED;
            PG8_LDB(B1, 1, 1); PG8_STAGE(PG8_SB(1, 0), b3, voffB);
            PG8_BAR; PG8_WAIT_L(0); PG8_MMA(0, 1, At, B1); PG8_BAR;
            PG8_LDA(At, 1, 1); PG8_STAGE(PG8_SA(1, 0), a3, voffA);
            PG8_BAR; PG8_WAIT_L(0); PG8_MMA(1, 0, At, B0); PG8_BAR; PG8_SCHED;
            PG8_STAGE(PG8_SB(1, 1), b3 + hstep, voffB);
            PG8_WAIT_V(6); PG8_BAR; PG8_MMA(1, 1, At, B1); PG8_BAR;
            }
        }
        if constexpr (ALIGN_EPI) { if (wr == 0) PG8_BAR; }
        if constexpr (!Epi::AFTER_DRAIN) { E(acc, cur, wr, wc, fr, fq); S.done(cur); }
        if (!has_next) break;
#pragma unroll
        for (int a = 0; a < 2; ++a)
#pragma unroll
            for (int b = 0; b < 2; ++b)
#pragma unroll
                for (int m = 0; m < 4; ++m)
#pragma unroll
                    for (int n = 0; n < 2; ++n) acc[a][b][m][n] = (f32x4){0.f, 0.f, 0.f, 0.f};
        cur = nxt; cA = nA; cB = nB; ++ui;
        if constexpr (ALIGN_EPI) { if (wr == 1) PG8_BAR; }
    }
    PG8_WAIT_V(0);
    if constexpr (!ALIGN_EPI) { if (wr == 0) PG8_BAR; }
    PG8_BAR;
    if constexpr (Epi::AFTER_DRAIN) { E.fused(acc, cur, wr, wc, fr, fq, lds, wid, lane); S.done(cur); }
#undef PG8_SA
#undef PG8_SB
#undef PG8_STAGE
#undef PG8_LDA
#undef PG8_LDB
#undef PG8_MMA
#undef PG8_WAIT_V
#undef PG8_WAIT_L
#undef PG8_BAR
#undef PG8_SCHED
}
}
template <class F> struct EpiF {
    static constexpr bool PERM = true, AFTER_DRAIN = false; F f;
    DEV void operator()(const pg8::f32x4 (&acc)[2][2][4][2], const pg8::Unit& u, int wr, int wc, int fr, int fq) const {
        UNROLL for (int ai = 0; ai < 2; ++ai) UNROLL for (int m = 0; m < 4; ++m) {
            const int row = u.pm * 256 + ai * 128 + wr * 64 + m * 16 + fr;
            UNROLL for (int bj = 0; bj < 2; ++bj) {
                const int col = u.pn * 256 + bj * 128 + wc * 32 + 8 * fq;
                const float v[8] = {acc[ai][bj][m][0][0], acc[ai][bj][m][0][1], acc[ai][bj][m][0][2], acc[ai][bj][m][0][3],
                                    acc[ai][bj][m][1][0], acc[ai][bj][m][1][1], acc[ai][bj][m][1][2], acc[ai][bj][m][1][3]};
                f(row, col, v);
            }
        }
    }
};
template <class F> struct EpiF2 {
    static constexpr bool PERM = true, AFTER_DRAIN = false; F f;
    DEV void operator()(const pg8::f32x4 (&acc)[2][2][4][2], const pg8::Unit& u, int wr, int wc, int fr, int fq) const {
        UNROLL for (int ai = 0; ai < 2; ++ai) UNROLL for (int m = 0; m < 4; ++m) {
            const int row = u.pm * 256 + ai * 128 + wr * 64 + m * 16 + fr, col = u.pn * 256 + wc * 32 + 8 * fq;
            const float v0[8] = {acc[ai][0][m][0][0], acc[ai][0][m][0][1], acc[ai][0][m][0][2], acc[ai][0][m][0][3], acc[ai][0][m][1][0], acc[ai][0][m][1][1], acc[ai][0][m][1][2], acc[ai][0][m][1][3]};
            const float v1[8] = {acc[ai][1][m][0][0], acc[ai][1][m][0][1], acc[ai][1][m][0][2], acc[ai][1][m][0][3], acc[ai][1][m][1][0], acc[ai][1][m][1][1], acc[ai][1][m][1][2], acc[ai][1][m][1][3]};
            f(row, col, v0, v1);
        }
    }
};
struct XOrder {
    int x, r, n, nN, cx, fullq, total;
    DEV XOrder(const Topo& tp, int nM, int nN_) { x = tp.x; r = tp.r; n = tp.n; nN = nN_; cx = nM > x ? (nM - x + 7) >> 3 : 0; fullq = cx >> 2; total = cx * nN; }
    DEV bool next(int i, pg8::Unit& u) const {
        const int q = r + i * n; if (q >= total) return false;
        const int per = 4 * nN;
        if (q < fullq * per) { const int qi = q / per, rem = q - qi * per; u.pn = rem >> 2; u.pm = x + 8 * (4 * qi + (rem & 3)); }
        else { const int rem = q - fullq * per, cq = cx - 4 * fullq; u.pn = rem / cq; u.pm = x + 8 * (4 * fullq + rem % cq); }
        return true;
    }
    DEV void a_ready(const pg8::Unit&) const {}
    DEV void done(const pg8::Unit&) const {}
};
template <class F> DEV void gemm256_pair(const bf16_t* A, int M, const bf16_t* Bt, int N, int K, char* smem, const Topo& tp, F f) {
    const pg8::Gemm g{A, Bt, M, N, K};
    const XOrder S(tp, M / 256, (N + 255) / 256);
    const EpiF2<F> E{f};
    pg8::gemm_phase<EpiF2<F>, XOrder, true, true>((PG8_LAS unsigned char*)smem, g, S, E);
}
template <class F> DEV void gemm256(const bf16_t* A, int M, const bf16_t* Bt, int N, int K, char* smem, const Topo& tp, F f) {
    const pg8::Gemm g{A, Bt, M, N, K};
    const XOrder S(tp, M / 256, (N + 255) / 256);
    const EpiF<F> E{f};
    pg8::gemm_phase<EpiF<F>, XOrder, true, true>((PG8_LAS unsigned char*)smem, g, S, E);
}

DEV void ph_mod(const Params& p, int L, char* smem) {
    const int tid = TID();
    float* sc = (float*)smem;
    float* red = sc + 17 * 1024;
    const float* c = p.in[I_C]; const float* cc = p.in[I_CCTX];
    for (int i = tid; i < 17 * 1024; i += NTHREADS) { const float v = i < 16 * 1024 ? c[i] : cc[i - 16 * 1024]; sc[i] = v / (1.f + expf(-v)); }
    __syncthreads();
    const float* W = p.in[I_WADA] + (size_t)L * 1024 * 6144; const float* bA = p.in[I_BADA] + (size_t)L * 6144;
    float* MOD = (float*)(p.ws + OFF_MOD);
    for (int u = blockIdx.x; u < 192; u += gridDim.x) {
        const int ci = tid & 31, ks = tid >> 5, j = u * 32 + ci;
        float acc[17];
        UNROLL for (int r = 0; r < 17; ++r) acc[r] = 0.f;
        for (int k = ks * 64; k < ks * 64 + 64; ++k) {
            const float w = W[(size_t)k * 6144 + j];
            UNROLL for (int r = 0; r < 17; ++r) acc[r] += sc[r * 1024 + k] * w;
        }
        UNROLL for (int r = 0; r < 17; ++r) red[(ks * 17 + r) * 32 + ci] = acc[r];
        __syncthreads();
        for (int i = tid; i < 17 * 32; i += NTHREADS) {
            const int r = i >> 5, c2 = i & 31; float s = bA[u * 32 + c2];
            for (int k2 = 0; k2 < 16; ++k2) s += red[(k2 * 17 + r) * 32 + c2];
            MOD[r * 6144 + u * 32 + c2] = s;
        }
        __syncthreads();
    }
}
DEV void conv_job(const float* s0, const float* s1, bf16_t* d, int K, int N, int mode, int nmat, size_t sstride, size_t dstride, char* smem, int bid = -1, int nb = 0) {
    if (bid < 0) { bid = blockIdx.x; nb = gridDim.x; }
    float* tile = (float*)smem;
    const int tid = TID();
    const int tK = K / 64, tN = (mode == 1 || mode == 3) ? (2 * N) / 64 : (N + 63) / 64, per = tK * tN;
    for (int t = bid; t < per * nmat; t += nb) {
        const int mat = t / per, r = t % per, tk = r / tN, tn = r % tN;
        const float* a0 = s0 + (size_t)mat * sstride; const float* a1 = s1 ? s1 + (size_t)mat * sstride : nullptr;
        bf16_t* dd = d + (size_t)mat * dstride;
        UNROLL for (int i = 0; i < 8; ++i) {
            const int cc = tid & 63, k = (tid >> 6) + 8 * i; float v;
            if (mode == 1) { const float* s = (cc >> 5) ? a1 : a0; v = s[(size_t)(tk * 64 + k) * N + tn * 32 + (cc & 31)]; }
            else if (mode == 3) { const float* s = ((tn >> 1) & 1) ? a1 : a0; v = s[(size_t)(tk * 64 + k) * N + (tn >> 2) * 128 + (tn & 1) * 64 + cc]; }
            else { const int n = tn * 64 + cc; v = n < N ? a0[(size_t)(tk * 64 + k) * N + n] : 0.f; }
            tile[k * 65 + cc] = v;
        }
        __syncthreads();
        UNROLL for (int i = 0; i < 8; ++i) {
            const int k = tid & 63, cc = (tid >> 6) + 8 * i; const int row = tn * 64 + cc;
            const float v = tile[k * 65 + cc];
            if (mode == 1 || mode == 3 || row < N) {
                const bf16_t hi = f2bf(v);
                dd[(size_t)row * K + tk * 64 + k] = hi;
                if (mode == 2) dd[(size_t)N * K + (size_t)row * K + tk * 64 + k] = f2bf(v - bf2f(hi));
            }
        }
        __syncthreads();
    }
}
DEV void ph_conv_mix(const Params& p, int L, char* smem) {
    char* ws = p.ws;
    conv_job(p.in[I_WIN] + (size_t)L * 1024 * IN_COLS, nullptr, (bf16_t*)(ws + OFF_WINT), 1024, IN_COLS, 0, 1, 0, 0, smem);
    conv_job(p.in[I_WBR] + (size_t)L * 3 * 512 * 1024, nullptr, (bf16_t*)(ws + OFF_WBT), 512, 1024, 0, 3, (size_t)512 * 1024, (size_t)512 * 1024, smem);
    conv_job(p.in[I_WOUT] + (size_t)L * 1024 * 1024, nullptr, (bf16_t*)(ws + OFF_WOUTT), 1024, 1024, 0, 1, 0, 0, smem);
    conv_job(p.in[I_SG] + (size_t)L * 1024 * 256, p.in[I_SU] + (size_t)L * 1024 * 256, (bf16_t*)(ws + OFF_SGUT), 1024, 256, 3, 1, 0, 0, smem);
    conv_job(p.in[I_SD] + (size_t)L * 256 * 1024, nullptr, (bf16_t*)(ws + OFF_SDT), 256, 1024, 0, 1, 0, 0, smem);
    conv_job(p.in[I_G2] + (size_t)L * 128 * 512, nullptr, (bf16_t*)(ws + OFF_G2T), 128, 512, 0, 1, 0, 0, smem);
    conv_job(p.in[I_RTR] + (size_t)L * 1024 * 64, nullptr, (bf16_t*)(ws + OFF_RTR), 1024, 64, 2, 1, 0, 0, smem);
}
DEV void ph_conv_moe_gu(const Params& p, int L, char* smem, int bid, int nb) {
    const size_t eo = (size_t)L * 64 * 1024 * 128;
    conv_job(p.in[I_MWG] + eo, p.in[I_MWU] + eo, (bf16_t*)(p.ws + OFF_MGU), 1024, 128, 1, 64, (size_t)1024 * 128, (size_t)256 * 1024, smem, bid, nb);
}
DEV void ph_conv_moe(const Params& p, int L, char* smem, int bid, int nb) {
    const size_t eo = (size_t)L * 64 * 1024 * 128;
    conv_job(p.in[I_MWD] + eo, nullptr, (bf16_t*)(p.ws + OFF_MDT), 128, 1024, 0, 64, (size_t)128 * 1024, (size_t)1024 * 128, smem, bid, nb);
}

DEV void ph_norm(const Params& p, int L, int which, int ntok) {
    const int lane = TID() & 63, wave = TID() >> 6;
    const float* MOD = (const float*)(p.ws + OFF_MOD);
    const float* g = p.in[which ? I_N2G : I_N1G] + (size_t)L * DM;
    bf16_t* H = (bf16_t*)(p.ws + OFF_HX); bf16_t* HLO = (bf16_t*)(p.ws + OFF_H2LO);
    for (int n0 = blockIdx.x * 8; n0 < ntok; n0 += gridDim.x * 8) {
        const int n = n0 + wave;
        const float* xr = which ? xs_row(p, n) : xprev_row(p, L, n);
        float4 v[4]; float ss = 0.f;
        UNROLL for (int i = 0; i < 4; ++i) { v[i] = *(const float4*)(xr + i * 256 + lane * 4); ss += v[i].x * v[i].x + v[i].y * v[i].y + v[i].z * v[i].z + v[i].w * v[i].w; }
        UNROLL for (int o = 1; o < 64; o <<= 1) ss += __shfl_xor(ss, o);
        const float rstd = rsqrtf(ss * (1.f / DM) + 1e-6f);
        const float* sh = MOD + mod_row(n) * 6144 + (which ? 3 : 0) * DM; const float* sc = sh + DM;
        UNROLL for (int i = 0; i < 4; ++i) {
            const int c = i * 256 + lane * 4;
            const float4 gg = *(const float4*)(g + c), s1 = *(const float4*)(sc + c), s0 = *(const float4*)(sh + c);
            const float h0 = v[i].x * rstd * gg.x * (1.f + s1.x) + s0.x, h1 = v[i].y * rstd * gg.y * (1.f + s1.y) + s0.y;
            const float h2 = v[i].z * rstd * gg.z * (1.f + s1.z) + s0.z, h3 = v[i].w * rstd * gg.w * (1.f + s1.w) + s0.w;
            u32x2 o; o.x = pk2(h0, h1); o.y = pk2(h2, h3);
            *(u32x2*)(H + (size_t)n * DM + c) = o;
            if (which) {
                u32x2 o2;
                o2.x = pk2(h0 - bf2f((bf16_t)(o.x & 0xffff)), h1 - bf2f((bf16_t)(o.x >> 16)));
                o2.y = pk2(h2 - bf2f((bf16_t)(o.y & 0xffff)), h3 - bf2f((bf16_t)(o.y >> 16)));
                *(u32x2*)(HLO + (size_t)n * DM + c) = o2;
            }
        }
    }
}

DEV void ph_rw_prep(const Params& p, int L, char* smem) {
    const int lane = TID() & 63, wave = TID() >> 6;
    float* vsh = (float*)smem + wave * 512;
    const bf16_t* PXR = (const bf16_t*)(p.ws + OFF_PX); bf16_t* VF = (bf16_t*)(p.ws + OFF_VF);
    const float* mu = p.in[I_MU] + (size_t)L * RW_COLS;
    const float* v0 = p.in[I_V0]; const float* v1 = p.in[I_V1]; const float* v2 = p.in[I_V2];
    for (int n0 = blockIdx.x * 8; n0 < NT; n0 += gridDim.x * 8) {
        const int n = n0 + wave; int nb, tt, T; seq_of(n, nb, tt, T);
        float vs[8]; shift8(PXR, RW_COLS, nb, tt, T, 1024 + lane * 8, mu, vs);
        if (L == 0) { st8(VF + (size_t)n * 512 + lane * 8, vs); }
        else {
            UNROLL for (int i = 0; i < 8; ++i) vsh[lane * 8 + i] = vs[i];
            __syncthreads();
            const int q = lane & 31, hf = lane >> 5; float t1 = 0.f;
            for (int jj = 0; jj < 256; ++jj) t1 += vsh[hf * 256 + jj] * v1[(hf * 256 + jj) * 32 + q];
            t1 += __shfl_xor(t1, 32);
            float u[8];
            UNROLL for (int i = 0; i < 8; ++i) u[i] = v0[lane * 8 + i];
            for (int q2 = 0; q2 < 32; ++q2) { const float tq = __shfl(t1, q2); UNROLL for (int i = 0; i < 8; ++i) u[i] += tq * v2[q2 * 512 + lane * 8 + i]; }
            float vf[8], o[8]; ld8(VF + (size_t)n * 512 + lane * 8, vf);
            UNROLL for (int i = 0; i < 8; ++i) o[i] = vs[i] + (vf[i] - vs[i]) * sigm(u[i]);
            st8(VF + (size_t)n * 512 + lane * 8, o);
            __syncthreads();
        }
    }
}

DEV bf16x8 pk_lohi(u32x2 lo, u32x2 hi) { u32x4 w; w.x = lo.x; w.y = lo.y; w.z = hi.x; w.w = hi.y; return __builtin_bit_cast(bf16x8, w); }
DEV bf16x8 pk_acc2(const f32x4v& a, const f32x4v& b) { u32x4 w; w.x = pk2(a[0], a[1]); w.y = pk2(a[2], a[3]); w.z = pk2(b[0], b[1]); w.w = pk2(b[2], b[3]); return __builtin_bit_cast(bf16x8, w); }
DEV bf16x8 pk_acc1(const f32x4v& a) { u32x4 w; w.x = pk2(a[0], a[1]); w.y = pk2(a[2], a[3]); w.z = 0u; w.w = 0u; return __builtin_bit_cast(bf16x8, w); }
#define MFMA16(a, b, c) __builtin_amdgcn_mfma_f32_16x16x32_bf16((a), (b), (c), 0, 0, 0)
DEV void ph_rw_scan(const Params& p, int L, char* smem) {
    const int tid = TID();
    const int wave = __builtin_amdgcn_readfirstlane(tid >> 6);
    char* AT = smem; char* BT = smem + 9216; char* KT = smem + 18432; char* RT = smem + 27648;
    char* BH = smem + 36864; char* KH = smem + 46080; char* VT = smem + 55296;
    char* W2T = smem + 64512; char* A2T = smem + 73728;
    float* PCv = (float*)(smem + 82944); float* SEGT = PCv + 64;
    char* XY = smem + 85248;
    char* T1 = XY; char* T2 = XY + 9216; float* WLf = (float*)(XY + 18432); float* ALf = (float*)(XY + 35840); float* LW = (float*)(XY + 53248);
    char* NAB = XY; char* NAK = XY + 9216; char* NRB = XY + 18432; char* NRK = XY + 27648; char* TJ = XY + 36864; float* NDF = (float*)(XY + 38912); float* YO = (float*)(XY + 43008);
    const bf16_t* PXR = (const bf16_t*)(p.ws + OFF_PX); const bf16_t* VF = (const bf16_t*)(p.ws + OFF_VF);
    bf16_t* YS = (bf16_t*)(p.ws + OFF_YS); float* CB = (float*)(p.ws + OFF_CB);
    const float* mu = p.in[I_MU] + (size_t)L * RW_COLS;
    const float* w0 = p.in[I_W0] + (size_t)L * 1024; const float* w2 = p.in[I_W2] + (size_t)L * 65536;
    const float* a0 = p.in[I_A0] + (size_t)L * 1024; const float* a2 = p.in[I_A2] + (size_t)L * 65536;
    const float* kkw = p.in[I_KK] + (size_t)L * 512; const float* kaw = p.in[I_KA] + (size_t)L * 512; const float* rkw = p.in[I_RK] + (size_t)L * 512;
    for (int u = blockIdx.x; u < 256; u += gridDim.x) {
        const int b = u >> 4, h = (u >> 1) & 7, d = u & 1;
        for (int i = tid; i < 4096; i += NTHREADS) {
            const int l = i >> 6, n = i & 63;
            *(bf16_t*)(W2T + n * LROW + l * 2) = f2bf(w2[(size_t)(d * 64 + l) * 512 + h * 64 + n]);
            *(bf16_t*)(A2T + n * LROW + l * 2) = f2bf(a2[(size_t)(d * 64 + l) * 512 + h * 64 + n]);
        }
        f32x4v sacc[4];
        UNROLL for (int i = 0; i < 4; ++i) sacc[i] = (f32x4v){0.f, 0.f, 0.f, 0.f};
        __syncthreads();
        for (int ci = 0; ci < 36; ++ci) {
            int tido = tid; asm volatile("" : "+v"(tido));
            const int lane = tido & 63, lq = lane & 15, kg = lane >> 4, ti = tido >> 3, j = tido & 7;
            const int ch = h * 64 + 8 * j;
            const bool isc = ci < 4; const int T = isc ? CTXL : SEQ, cc = isc ? ci : ci - 4;
            const int t0 = d == 0 ? cc * 64 : T - 64 * (cc + 1), nb = isc ? NX + b * CTXL : b * SEQ;
            const int tt = d == 0 ? t0 + ti : t0 + 63 - ti;
            float r8[8], k8[8], v8[8];
            {
                float x1[8], x2[8];
                shift8(PXR, RW_COLS, nb, tt, T, 1536 + d * 64 + 8 * j, mu, x1);
                shift8(PXR, RW_COLS, nb, tt, T, 1664 + d * 64 + 8 * j, mu, x2);
                UNROLL for (int i = 0; i < 8; ++i) x1[i] = tanh_fast(x1[i]);
                st8((bf16_t*)(T1 + ti * LROW) + 8 * j, x1); st8((bf16_t*)(T2 + ti * LROW) + 8 * j, x2);
                shift8(PXR, RW_COLS, nb, tt, T, h * 64 + 8 * j, mu, r8);
                shift8(PXR, RW_COLS, nb, tt, T, 512 + h * 64 + 8 * j, mu, k8);
                ld8(VF + (size_t)(nb + tt) * 512 + ch, v8);
            }
            __syncthreads();
            _Pragma("unroll 1") for (int rep = 0; rep < 4; ++rep) {
                const int q = wave + 8 * rep, m = q >> 4, tl = q & 15, tt4 = tl >> 2, nt4 = tl & 3;
                const char* Ab = (m ? T2 : T1) + (16 * tt4 + lq) * LROW + kg * 16; const char* Bb = (m ? A2T : W2T) + (16 * nt4 + lq) * LROW + kg * 16;
                f32x4v a = {0.f, 0.f, 0.f, 0.f};
                UNROLL for (int ks = 0; ks < 2; ++ks) a = MFMA16(*(const bf16x8*)(Ab + ks * 64), *(const bf16x8*)(Bb + ks * 64), a);
                float* dst = (m ? ALf : WLf) + (16 * tt4 + 4 * kg) * 68 + 16 * nt4 + lq;
                UNROLL for (int i = 0; i < 4; ++i) dst[i * 68] = a[i];
            }
            __syncthreads();
            float av[8], bv[8], kd8[8];
            {
                const float4 wa = *(const float4*)(WLf + ti * 68 + 8 * j), wb = *(const float4*)(WLf + ti * 68 + 8 * j + 4);
                const float4 aa = *(const float4*)(ALf + ti * 68 + 8 * j), ab = *(const float4*)(ALf + ti * 68 + 8 * j + 4);
                const float wl[8] = {wa.x, wa.y, wa.z, wa.w, wb.x, wb.y, wb.z, wb.w}, al[8] = {aa.x, aa.y, aa.z, aa.w, ab.x, ab.y, ab.z, ab.w};
                float ss = 0.f, cbp = 0.f, alpha[8], kkr[8], lw[8];
                UNROLL for (int i = 0; i < 8; ++i) {
                    const float xw = -(w0[d * 512 + ch + i] + wl[i]);
                    const float sp = softplus_fast(xw);
                    lw[i] = -__expf(-sp - 0.5f);
                    alpha[i] = sigm(a0[d * 512 + ch + i] + al[i]);
                    kkr[i] = k8[i] * kkw[ch + i]; ss += kkr[i] * kkr[i];
                    kd8[i] = k8[i] * (1.f + (alpha[i] - 1.f) * kaw[ch + i]);
                    cbp += r8[i] * kd8[i] * rkw[ch + i];
                }
                ss = sum8(ss); cbp = sum8(cbp);
                const float inv = frcp(fmaxf(__builtin_amdgcn_sqrtf(ss), 1e-12f));
                UNROLL for (int i = 0; i < 8; ++i) { const float kk = kkr[i] * inv; av[i] = -kk; bv[i] = kk * alpha[i]; }
                *(float4*)(LW + ti * 64 + 8 * j) = make_float4(lw[0], lw[1], lw[2], lw[3]); *(float4*)(LW + ti * 64 + 8 * j + 4) = make_float4(lw[4], lw[5], lw[6], lw[7]);
                if (j == 0) CB[((size_t)d * NT + nb + tt) * 8 + h] = cbp;
            }
            __syncthreads();
            {
                const int n = tid & 63, seg = tid >> 6; float run = 0.f;
                UNROLL for (int r = 0; r < 8; ++r) { run += LW[(seg * 8 + r) * 64 + n]; LW[(seg * 8 + r) * 64 + n] = run; }
                SEGT[seg * 64 + n] = run;
            }
            __syncthreads();
            {
                const int seg = ti >> 3;
                float off[8], tot[8];
                UNROLL for (int i = 0; i < 8; ++i) { off[i] = 0.f; tot[i] = 0.f; }
                UNROLL for (int s2 = 0; s2 < 8; ++s2) {
                    const float4 sa = *(const float4*)(SEGT + s2 * 64 + 8 * j), sb2 = *(const float4*)(SEGT + s2 * 64 + 8 * j + 4);
                    const float sv[8] = {sa.x, sa.y, sa.z, sa.w, sb2.x, sb2.y, sb2.z, sb2.w};
                    UNROLL for (int i = 0; i < 8; ++i) { tot[i] += sv[i]; if (s2 < seg) off[i] += sv[i]; }
                }
                const float4 la = *(const float4*)(LW + ti * 64 + 8 * j), lb = *(const float4*)(LW + ti * 64 + 8 * j + 4);
                const float lpl[8] = {la.x, la.y, la.z, la.w, lb.x, lb.y, lb.z, lb.w};
                float lpm[8];
                if ((ti & 7) != 0) {
                    const float4 ma = *(const float4*)(LW + (ti - 1) * 64 + 8 * j), mb = *(const float4*)(LW + (ti - 1) * 64 + 8 * j + 4);
                    lpm[0] = ma.x; lpm[1] = ma.y; lpm[2] = ma.z; lpm[3] = ma.w; lpm[4] = mb.x; lpm[5] = mb.y; lpm[6] = mb.z; lpm[7] = mb.w;
                } else { UNROLL for (int i = 0; i < 8; ++i) lpm[i] = 0.f; }
                float oa[8], ob[8], ok[8], orr[8];
                UNROLL for (int i = 0; i < 8; ++i) {
                    const float lp = lpl[i] + off[i], lm = lpm[i] + off[i];
                    const float eP = __expf(lp), eM = __expf(-lp), ePm = __expf(lm), eE = __expf(tot[i] - lp);
                    oa[i] = av[i] * ePm; ob[i] = bv[i] * eM; ok[i] = kd8[i] * eM; orr[i] = r8[i] * eP;
                    *(bf16_t*)(BH + (8 * j + i) * LROW + ti * 2) = f2bf(bv[i] * eE);
                    *(bf16_t*)(KH + (8 * j + i) * LROW + ti * 2) = f2bf(kd8[i] * eE);
                    *(bf16_t*)(VT + (8 * j + i) * LROW + ti * 2) = f2bf(v8[i]);
                    if (ti == 0) PCv[8 * j + i] = __expf(tot[i]);
                }
                st8((bf16_t*)(AT + ti * LROW) + 8 * j, oa); st8((bf16_t*)(BT + ti * LROW) + 8 * j, ob);
                st8((bf16_t*)(KT + ti * LROW) + 8 * j, ok); st8((bf16_t*)(RT + ti * LROW) + 8 * j, orr);
            }
            __syncthreads();
            _Pragma("unroll 1") for (int rep = 0; rep < 6; ++rep) {
                const int q = wave + 8 * rep, m = q / 12, tl = q - 12 * m;
                const int tt4 = tl >= 10 ? 2 * (tl - 10) : tl < 1 ? 0 : tl < 3 ? 1 : tl < 6 ? 2 : 3, st4 = tl >= 10 ? tt4 + 1 : tl - (tt4 * (tt4 + 1)) / 2;
                char* dstm = m == 0 ? NAB : m == 1 ? NAK : m == 2 ? NRB : NRK;
                f32x4v a = {0.f, 0.f, 0.f, 0.f};
                if (st4 <= tt4) {
                    const char* Ab = (m < 2 ? AT : RT) + (16 * tt4 + lq) * LROW + kg * 16; const char* Bb = ((m & 1) ? KT : BT) + (16 * st4 + lq) * LROW + kg * 16;
                    UNROLL for (int ks = 0; ks < 2; ++ks) a = MFMA16(*(const bf16x8*)(Ab + ks * 64), *(const bf16x8*)(Bb + ks * 64), a);
                }
                const int sidx = 16 * st4 + lq;
                UNROLL for (int i = 0; i < 4; ++i) {
                    const int tidx = 16 * tt4 + 4 * kg + i;
                    const bool keep = m < 2 ? sidx < tidx : sidx <= tidx;
                    const float val = keep ? a[i] : 0.f;
                    *(bf16_t*)(dstm + tidx * LROW + sidx * 2) = f2bf(val);
                    if (m == 0 && st4 == tt4) NDF[(tt4 * 16 + 4 * kg + i) * 16 + lq] = val;
                }
            }
            __syncthreads();
            f32x4v xacc[4], yacc[4];
            bf16x8 vt[2];
            if (wave == 7) {
                const int blk = lane >> 4, c = lane & 15;
                float Tc[16];
                UNROLL for (int t = 0; t < 16; ++t) {
                    float a = t == c ? 1.f : 0.f;
                    UNROLL for (int s2 = 0; s2 < t; ++s2) a += NDF[(blk * 16 + t) * 16 + s2] * Tc[s2];
                    Tc[t] = a;
                }
                UNROLL for (int t = 0; t < 16; ++t) *(bf16_t*)(TJ + (blk * 16 + t) * 32 + c * 2) = f2bf(Tc[t]);
            } else if (wave < 4) {
                bf16x8 sb[2];
                UNROLL for (int kk = 0; kk < 2; ++kk) { sb[kk] = pk_acc2(sacc[2 * kk], sacc[2 * kk + 1]); vt[kk] = *(const bf16x8*)(VT + (16 * wave + lq) * LROW + kk * 64 + kg * 16); }
                UNROLL for (int t4 = 0; t4 < 4; ++t4) {
                    f32x4v x = {0.f, 0.f, 0.f, 0.f}, y = {0.f, 0.f, 0.f, 0.f};
                    UNROLL for (int kk = 0; kk < 2; ++kk) {
                        const char* pa = AT + (16 * t4 + lq) * LROW + (32 * kk + 4 * kg) * 2; const char* pr = RT + (16 * t4 + lq) * LROW + (32 * kk + 4 * kg) * 2;
                        x = MFMA16(pk_lohi(*(const u32x2*)pa, *(const u32x2*)(pa + 32)), sb[kk], x);
                        y = MFMA16(pk_lohi(*(const u32x2*)pr, *(const u32x2*)(pr + 32)), sb[kk], y);
                        if (2 * kk <= t4) {
                            x = MFMA16(*(const bf16x8*)(NAK + (16 * t4 + lq) * LROW + kk * 64 + kg * 16), vt[kk], x);
                            y = MFMA16(*(const bf16x8*)(NRK + (16 * t4 + lq) * LROW + kk * 64 + kg * 16), vt[kk], y);
                        }
                    }
                    xacc[t4] = x; yacc[t4] = y;
                }
            }
            __syncthreads();
            if (wave < 4) {
                const u32x2 z2 = {0u, 0u};
                f32x4v uacc[4];
                {
                    const u32x2 t0v = *(const u32x2*)(TJ + (0 * 16 + lq) * 32 + 4 * kg * 2);
                    uacc[0] = MFMA16(pk_lohi(t0v, z2), pk_acc1(xacc[0]), ((f32x4v){0.f, 0.f, 0.f, 0.f}));
                }
                UNROLL for (int jb = 1; jb < 4; ++jb) {
                    f32x4v z = xacc[jb];
                    const char* nr = NAB + (16 * jb + lq) * LROW + 4 * kg * 2;
                    if (jb == 1) z = MFMA16(pk_lohi(*(const u32x2*)nr, z2), pk_acc1(uacc[0]), z);
                    else {
                        z = MFMA16(pk_lohi(*(const u32x2*)nr, *(const u32x2*)(nr + 32)), pk_acc2(uacc[0], uacc[1]), z);
                        if (jb == 3) z = MFMA16(pk_lohi(*(const u32x2*)(nr + 64), z2), pk_acc1(uacc[2]), z);
                    }
                    const u32x2 tv = *(const u32x2*)(TJ + (jb * 16 + lq) * 32 + 4 * kg * 2);
                    uacc[jb] = MFMA16(pk_lohi(tv, z2), pk_acc1(z), ((f32x4v){0.f, 0.f, 0.f, 0.f}));
                }
                bf16x8 ub[2]; ub[0] = pk_acc2(uacc[0], uacc[1]); ub[1] = pk_acc2(uacc[2], uacc[3]);
                UNROLL for (int t4 = 0; t4 < 4; ++t4) {
                    f32x4v y = yacc[t4];
                    UNROLL for (int kk = 0; kk < 2; ++kk) if (2 * kk <= t4) {
                        const char* pn = NRB + (16 * t4 + lq) * LROW + (32 * kk + 4 * kg) * 2;
                        y = MFMA16(pk_lohi(*(const u32x2*)pn, *(const u32x2*)(pn + 32)), ub[kk], y);
                    }
                    UNROLL for (int i = 0; i < 4; ++i) YO[(16 * t4 + 4 * kg + i) * 68 + 16 * wave + lq] = y[i];
                }
                UNROLL for (int kt = 0; kt < 4; ++kt) {
                    f32x4v sv = sacc[kt];
                    UNROLL for (int i = 0; i < 4; ++i) sv[i] *= PCv[16 * kt + 4 * kg + i];
                    UNROLL for (int kk = 0; kk < 2; ++kk) {
                        const char* pb = BH + (16 * kt + lq) * LROW + (32 * kk + 4 * kg) * 2;
                        sv = MFMA16(pk_lohi(*(const u32x2*)pb, *(const u32x2*)(pb + 32)), ub[kk], sv);
                        sv = MFMA16(*(const bf16x8*)(KH + (16 * kt + lq) * LROW + kk * 64 + kg * 16), vt[kk], sv);
                    }
                    sacc[kt] = sv;
                }
            }
            __syncthreads();
            {
                const float4 ya = *(const float4*)(YO + ti * 68 + 8 * j), yb = *(const float4*)(YO + ti * 68 + 8 * j + 4);
                const float y8[8] = {ya.x, ya.y, ya.z, ya.w, yb.x, yb.y, yb.z, yb.w};
                st8(YS + ((size_t)d * NT + nb + tt) * 512 + ch, y8);
            }
            __syncthreads();
        }
    }
}

DEV void ph_rw_read(const Params& p, int L, int ntok) {
    const int lane = TID() & 63, wave = TID() >> 6;
    const bf16_t* PXR = (const bf16_t*)(p.ws + OFF_PX); const bf16_t* VF = (const bf16_t*)(p.ws + OFF_VF);
    const bf16_t* YS = (const bf16_t*)(p.ws + OFF_YS); const float* CB = (const float*)(p.ws + OFF_CB);
    bf16_t* YA = (bf16_t*)(p.ws + OFF_YA); bf16_t* SG = (bf16_t*)(p.ws + OFF_SGB);
    const float* mu = p.in[I_MU] + (size_t)L * RW_COLS;
    const float* lg = p.in[I_LNG] + (size_t)L * 512; const float* lb = p.in[I_LNB] + (size_t)L * 512;
    for (int n0 = blockIdx.x * 8; n0 < ntok; n0 += gridDim.x * 8) {
        const int n = n0 + wave, c = lane * 8, h = lane >> 3;
        float y0[8], y1[8], v8[8], o[8];
        ld8(YS + (size_t)n * 512 + c, y0); ld8(YS + ((size_t)NT + n) * 512 + c, y1); ld8(VF + (size_t)n * 512 + c, v8);
        float s = 0.f;
        UNROLL for (int i = 0; i < 8; ++i) { y0[i] += y1[i]; s += y0[i]; }
        s += __shfl_xor(s, 1); s += __shfl_xor(s, 2); s += __shfl_xor(s, 4);
        const float mean = s * (1.f / 64.f); float q = 0.f;
        UNROLL for (int i = 0; i < 8; ++i) { const float dd = y0[i] - mean; q += dd * dd; }
        q += __shfl_xor(q, 1); q += __shfl_xor(q, 2); q += __shfl_xor(q, 4);
        const float rstd = rsqrtf(q * (1.f / 64.f) + 64e-5f);
        const float bon = CB[(size_t)n * 8 + h] + CB[((size_t)NT + n) * 8 + h];
        UNROLL for (int i = 0; i < 8; ++i) o[i] = (y0[i] - mean) * rstd * lg[c + i] + lb[c + i] + bon * v8[i];
        st8(YA + (size_t)n * 512 + c, o);
        if (lane < 16) {
            int nb, tt, T; seq_of(n, nb, tt, T);
            float g8[8]; shift8(PXR, RW_COLS, nb, tt, T, 1792 + lane * 8, mu, g8);
            UNROLL for (int i = 0; i < 8; ++i) g8[i] = sigm(g8[i]);
            st8(SG + (size_t)n * 128 + lane * 8, g8);
        }
    }
}

DEV void ph_na_norm(const Params& p, int L) {
    const int lane = TID() & 63, wave = TID() >> 6;
    bf16_t* PXN = (bf16_t*)(p.ws + OFF_PX);
    const float* qg = p.in[I_QNG] + (size_t)L * 64; const float* kg = p.in[I_KNG] + (size_t)L * 64;
    for (int n0 = blockIdx.x * 8; n0 < NT; n0 += gridDim.x * 8) {
        const int n = n0 + wave, c = lane * 8;
        UNROLL for (int w = 0; w < 2; ++w) {
            bf16_t* ptr = PXN + (size_t)n * 1024 + w * 512 + c;
            float x[8]; ld8(ptr, x);
            float ss = 0.f;
            UNROLL for (int i = 0; i < 8; ++i) ss += x[i] * x[i];
            ss += __shfl_xor(ss, 1); ss += __shfl_xor(ss, 2); ss += __shfl_xor(ss, 4);
            const float r = rsqrtf(ss * (1.f / 64.f) + 1e-6f) * (w == 0 ? 0.125f : 1.f);
            const float* g = w == 0 ? qg : kg;
            UNROLL for (int i = 0; i < 8; ++i) x[i] = x[i] * r * g[(c + i) & 63];
            st8(ptr, x);
        }
    }
}

DEV void knorm8(float (&x)[8], const float* g) {
    float ss = 0.f;
    UNROLL for (int i = 0; i < 8; ++i) ss += x[i] * x[i];
    ss = sum8(ss);
    const float r = rsqrtf(ss * (1.f / 64.f) + 1e-6f);
    UNROLL for (int i = 0; i < 8; ++i) x[i] = x[i] * r * g[i];
}
DEV void ph_na_att(const Params& p, int L, char* smem) {
    const int tid0 = TID();
    const int wave = __builtin_amdgcn_readfirstlane(tid0 >> 6);
    char* KL = smem;
    char* KC = smem + 576 * LROW;
    char* VL = smem;
    char* VC = smem + 64 * 1168;
    float* OX = (float*)(smem + 119808);
    float* RP = OX + 8 * 1024;
    const bf16_t* PXN = (const bf16_t*)(p.ws + OFF_PX); bf16_t* YB = (bf16_t*)(p.ws + OFF_YB);
    const bf16_t* VT = (const bf16_t*)(p.ws + OFF_VT); const bf16_t* VTC = (const bf16_t*)(p.ws + OFF_VTC);
    const float* qgn = p.in[I_QNG] + (size_t)L * 64; const float* kgn = p.in[I_KNG] + (size_t)L * 64;
    const int nunits = 2048 + (L == 0 ? 256 : 0);
    for (int u = blockIdx.x; u < nunits; u += gridDim.x) {
        int tid = tid0; asm volatile("" : "+v"(tid));
        const int lane = tid & 63, lq = lane & 15, kg = lane >> 4;
        const bool cu = u >= 2048;
        int b, h, rp = 0, rs0 = 0, g = 0;
        if (!cu) { h = u & 7; rp = (u >> 3) & 15; b = u >> 7; rs0 = min(max(2 * rp - 4, 0), 24); }
        else { const int v = u - 2048; h = v & 7; g = (v >> 3) & 1; b = v >> 4; }
        const int ctx0 = NX + b * CTXL;
        if (!cu) {
            UNROLL for (int i = 0; i < 9; ++i) {
                const int c = tid + NTHREADS * i, kx = c >> 3, part = c & 7;
                const int tok = b * SEQ + min(rs0 + (kx >> 6), 31) * 64 + (kx & 63);
                float kv[8]; ld8(PXN + (size_t)tok * 1024 + 512 + h * 64 + part * 8, kv); knorm8(kv, kgn + part * 8);
                st8((bf16_t*)(KL + kx * LROW + part * 16), kv);
            }
            for (int i = tid; i < 15 * 31; i += NTHREADS) RP[i] = p.in[I_RPB][((size_t)L * 8 + h) * 465 + i];
        }
        UNROLL for (int i = 0; i < 4; ++i) {
            const int c = tid + NTHREADS * i, kx = c >> 3, part = c & 7;
            float kv[8]; ld8(PXN + (size_t)(ctx0 + kx) * 1024 + 512 + h * 64 + part * 8, kv); knorm8(kv, kgn + part * 8);
            st8((bf16_t*)(KC + kx * LROW + part * 16), kv);
        }
        const int nb = wave & 3, ri = wave >> 2, r = 2 * rp + ri;
        const int rs = min(max(r - 4, 0), 24), roff = rs - rs0;
        const int qtok0 = cu ? ctx0 + (g * 8 + wave) * 16 : b * SEQ + r * 64 + nb * 16;
        const int band0 = min(max(nb * 16 - 8, 0), 32);
        bf16x8 qf[2];
        {
            float q0[8], q1[8]; ld8(PXN + (size_t)(qtok0 + lq) * 1024 + h * 64 + kg * 8, q0); ld8(PXN + (size_t)(qtok0 + lq) * 1024 + h * 64 + 32 + kg * 8, q1);
            float ss = 0.f;
            UNROLL for (int i = 0; i < 8; ++i) ss += q0[i] * q0[i] + q1[i] * q1[i];
            ss += __shfl_xor(ss, 16); ss += __shfl_xor(ss, 32);
            const float rq = rsqrtf(ss * (1.f / 64.f) + 1e-6f) * 0.125f;
            UNROLL for (int i = 0; i < 8; ++i) { q0[i] = q0[i] * rq * qgn[kg * 8 + i]; q1[i] = q1[i] * rq * qgn[32 + kg * 8 + i]; }
            u32x4 w0, w1; w0.x = pk2(q0[0], q0[1]); w0.y = pk2(q0[2], q0[3]); w0.z = pk2(q0[4], q0[5]); w0.w = pk2(q0[6], q0[7]);
            w1.x = pk2(q1[0], q1[1]); w1.y = pk2(q1[2], q1[3]); w1.z = pk2(q1[4], q1[5]); w1.w = pk2(q1[6], q1[7]);
            qf[0] = __builtin_bit_cast(bf16x8, w0); qf[1] = __builtin_bit_cast(bf16x8, w1);
        }
        __syncthreads();
        f32x4v sacc[16];
        bf16x8 pfl[8], pfc[8];
        float ml = -3e38f, ll = 0.f, mc, lc;
        if (!cu) {
            const char* kb = KL + (roff * 64 + band0 + lq) * LROW + kg * 16;
            UNROLL for (int t = 0; t < 16; ++t) {
                f32x4v a = {0.f, 0.f, 0.f, 0.f};
                UNROLL for (int ks = 0; ks < 2; ++ks) a = __builtin_amdgcn_mfma_f32_16x16x32_bf16(*(const bf16x8*)(kb + ((t >> 1) * 64 + (t & 1) * 16) * LROW + ks * 64), qf[ks], a, 0, 0, 0);
                sacc[t] = a;
            }
            const int col = nb * 16 + lq, cs = min(max(col - 8, 0), 48);
            const int kc0 = band0 + 4 * kg;
            const float* rpp = RP + (rs - r + 7) * 31 + (kc0 - col + 15);
            UNROLL for (int t = 0; t < 16; ++t) UNROLL for (int i = 0; i < 4; ++i) {
                const int kc = kc0 + (t & 1) * 16 + i;
                const bool valid = kc >= cs && kc < cs + 16;
                sacc[t][i] = valid ? sacc[t][i] + rpp[(t >> 1) * 31 + (t & 1) * 16 + i] : -1e30f;
            }
            UNROLL for (int t = 0; t < 16; ++t) UNROLL for (int i = 0; i < 4; ++i) ml = fmaxf(ml, sacc[t][i]);
            ml = fmaxf(ml, __shfl_xor(ml, 16)); ml = fmaxf(ml, __shfl_xor(ml, 32));
            UNROLL for (int t = 0; t < 16; ++t) UNROLL for (int i = 0; i < 4; ++i) { const float e = __expf(sacc[t][i] - ml); sacc[t][i] = e; ll += e; }
            ll += __shfl_xor(ll, 16); ll += __shfl_xor(ll, 32);
            UNROLL for (int tp = 0; tp < 8; ++tp) pfl[tp] = pk_acc2(sacc[2 * tp], sacc[2 * tp + 1]);
        }
        {
            const char* kb = KC + lq * LROW + kg * 16;
            UNROLL for (int t = 0; t < 16; ++t) {
                f32x4v a = {0.f, 0.f, 0.f, 0.f};
                UNROLL for (int ks = 0; ks < 2; ++ks) a = __builtin_amdgcn_mfma_f32_16x16x32_bf16(*(const bf16x8*)(kb + t * 16 * LROW + ks * 64), qf[ks], a, 0, 0, 0);
                sacc[t] = a;
            }
            mc = -3e38f; lc = 0.f;
            UNROLL for (int t = 0; t < 16; ++t) UNROLL for (int i = 0; i < 4; ++i) mc = fmaxf(mc, sacc[t][i]);
            mc = fmaxf(mc, __shfl_xor(mc, 16)); mc = fmaxf(mc, __shfl_xor(mc, 32));
            UNROLL for (int t = 0; t < 16; ++t) UNROLL for (int i = 0; i < 4; ++i) { const float e = __expf(sacc[t][i] - mc); sacc[t][i] = e; lc += e; }
            lc += __shfl_xor(lc, 16); lc += __shfl_xor(lc, 32);
            UNROLL for (int tp = 0; tp < 8; ++tp) pfc[tp] = pk_acc2(sacc[2 * tp], sacc[2 * tp + 1]);
        }
        const float mm = fmaxf(ml, mc), el = cu ? 0.f : __expf(ml - mm), ec = __expf(mc - mm);
        const float inv = frcp(ll * el + lc * ec);
        const float fl = el * inv, fc = ec * inv;
        __syncthreads();
        if (!cu) {
            UNROLL for (int i = 0; i < 9; ++i) {
                const int c = tid + NTHREADS * i, part = c & 7, kr = (c >> 3) % 9, d = (c >> 3) / 9;
                *(u32x4*)(VL + d * 1168 + (kr * 64 + part * 8) * 2) = *(const u32x4*)(VT + ((size_t)(b * 8 + h) * 64 + d) * SEQ + min(rs0 + kr, 31) * 64 + part * 8);
            }
        }
        UNROLL for (int i = 0; i < 4; ++i) {
            const int c = tid + NTHREADS * i, part = c & 31, d = c >> 5;
            *(u32x4*)(VC + d * 528 + part * 16) = *(const u32x4*)(VTC + ((size_t)(b * 8 + h) * 64 + d) * CTXL + part * 8);
        }
        __syncthreads();
        f32x4v ol[4], oc[4];
        UNROLL for (int dt = 0; dt < 4; ++dt) { ol[dt] = (f32x4v){0.f, 0.f, 0.f, 0.f}; oc[dt] = (f32x4v){0.f, 0.f, 0.f, 0.f}; }
        if (!cu) {
            const char* vb = VL + lq * 1168 + (roff * 64 + band0 + 4 * kg) * 2;
            UNROLL for (int tp = 0; tp < 8; ++tp) UNROLL for (int dt = 0; dt < 4; ++dt)
                ol[dt] = __builtin_amdgcn_mfma_f32_16x16x32_bf16(pfl[tp], pk_lohi(*(const u32x2*)(vb + dt * 16 * 1168 + tp * 128), *(const u32x2*)(vb + dt * 16 * 1168 + tp * 128 + 32)), ol[dt], 0, 0, 0);
        }
        {
            const char* vb = VC + lq * 528 + 8 * kg;
            UNROLL for (int tp = 0; tp < 8; ++tp) UNROLL for (int dt = 0; dt < 4; ++dt)
                oc[dt] = __builtin_amdgcn_mfma_f32_16x16x32_bf16(pfc[tp], pk_lohi(*(const u32x2*)(vb + dt * 16 * 528 + tp * 64), *(const u32x2*)(vb + dt * 16 * 528 + tp * 64 + 32)), oc[dt], 0, 0, 0);
        }
        float* ox = OX + wave * 1024;
        UNROLL for (int i = 0; i < 4; ++i) {
            const float a = __shfl(fl, 4 * kg + i), c2 = __shfl(fc, 4 * kg + i);
            UNROLL for (int dt = 0; dt < 4; ++dt) ox[(4 * kg + i) * 64 + dt * 16 + lq] = ol[dt][i] * a + oc[dt][i] * c2;
        }
        UNROLL for (int it = 0; it < 2; ++it) {
            const int q = (lane >> 3) + 8 * it, c8 = (lane & 7) * 8;
            const float4 a = *(const float4*)(ox + q * 64 + c8), bq = *(const float4*)(ox + q * 64 + c8 + 4);
            const float v[8] = {a.x, a.y, a.z, a.w, bq.x, bq.y, bq.z, bq.w};
            st8(YB + (size_t)(qtok0 + q) * 512 + h * 64 + c8, v);
        }
        __syncthreads();
    }
}

DEV float sum16(float v) { v += DPP_MOV(v, 0xB1); v += DPP_MOV(v, 0x4E); v += DPP_MOV(v, 0x141); v += DPP_MOV(v, 0x140); return v; }
DEV void ph_ml_scan(const Params& p, int L, char* smem) {
    const int tid = TID(), lane = tid & 63, lq = lane & 15, kg = lane >> 4, ti = tid >> 3, j = tid & 7;
    const int wave = __builtin_amdgcn_readfirstlane(tid >> 6);
    char* QS = smem;
    char* QP = QS + 9216;
    char* KC = QP + 9216;
    char* KW = KC + 9216;
    char* PM = KW + 9216;
    char* VT = PM + 9216;
    float* BV = (float*)(VT + 128 * LROW);
    float* GI = BV + 64;
    float* DEN = GI + 64;
    float* NV = DEN + 64;
    float* RS = NV + 64;
    float* HO = RS + 256;
    const bf16_t* PXM = (const bf16_t*)(p.ws + OFF_PX); bf16_t* HS = (bf16_t*)(p.ws + OFF_HS);
    for (int u = blockIdx.x; u < 128; u += gridDim.x) {
        const int d = u & 1, h = (u >> 1) & 3, b = u >> 3;
        const float ib = p.in[I_IB][L * 8 + d * 4 + h], fb = p.in[I_FB][L * 8 + d * 4 + h];
        f32x4v cacc[4];
        UNROLL for (int i = 0; i < 4; ++i) cacc[i] = (f32x4v){0.f, 0.f, 0.f, 0.f};
        for (int i = tid; i < 64 * LROW / 4; i += NTHREADS) ((unsigned*)PM)[i] = 0u;
        if (tid < 64) NV[tid] = 0.f;
        __syncthreads();
        for (int ci = 0; ci < 36; ++ci) {
            const bool isc = ci < 4; const int T = isc ? CTXL : SEQ, cc = isc ? ci : ci - 4;
            const int t0 = d == 0 ? cc * 64 : T - 64 * (cc + 1), nb = isc ? NX + b * CTXL : b * SEQ;
            const int tt = d == 0 ? t0 + ti : t0 + 63 - ti;
            float q8[8], k8[8];
            {
                const bf16_t* row = PXM + (size_t)(nb + tt) * ML_COLS;
                ld8(row + h * 64 + 8 * j, q8); ld8(row + 256 + h * 64 + 8 * j, k8);
                if (!isc) {
                    const int axis = j >> 2, half = (j >> 1) & 1; const float pos = (float)(axis == 0 ? (tt >> 6) : (tt & 63));
                    UNROLL for (int i = 0; i < 8; ++i) {
                        const int f = (j & 1) * 8 + i;
                        const float inv = exp2f(-(float)f * 0.83048202372184059f);
                        const float ang = pos * inv; const float cs = __cosf(ang), sn = __sinf(ang);
                        const float qo = __shfl_xor(q8[i], 2), ko = __shfl_xor(k8[i], 2);
                        q8[i] = half == 0 ? q8[i] * cs - qo * sn : q8[i] * cs + qo * sn;
                        k8[i] = half == 0 ? k8[i] * cs - ko * sn : k8[i] * cs + ko * sn;
                    }
                }
                UNROLL for (int i = 0; i < 8; ++i) q8[i] *= 0.125f;
                st8((bf16_t*)(QS + ti * LROW) + 8 * j, q8); st8((bf16_t*)(KC + ti * LROW) + 8 * j, k8);
                float v0[8], v1[8];
                ld8(row + 512 + h * 128 + 16 * j, v0); ld8(row + 512 + h * 128 + 16 * j + 8, v1);
                UNROLL for (int i = 0; i < 8; ++i) { *(bf16_t*)(VT + (16 * j + i) * LROW + ti * 2) = f2bf(v0[i]); *(bf16_t*)(VT + (16 * j + 8 + i) * LROW + ti * 2) = f2bf(v1[i]); }
                if (wave == 0) {
                    const int tl = d == 0 ? t0 + lane : t0 + 63 - lane;
                    const bf16_t* rw = PXM + (size_t)(nb + tl) * ML_COLS;
                    const float ig = bf2f(rw[1536 + d * 4 + h]) + ib, fg = bf2f(rw[1544 + d * 4 + h]) + fb;
                    const float igc = 15.f * tanhf(ig * (1.f / 15.f)), fgc = 15.f * tanhf(fg * (1.f / 15.f));
                    float lf = -(fmaxf(-fgc, 0.f) + log1pf(expf(-fabsf(fgc))));
                    UNROLL for (int o = 1; o < 64; o <<= 1) { const float up = __shfl_up(lf, o); if (lane >= o) lf += up; }
                    BV[lane] = lf; GI[lane] = igc;
                }
            }
            __syncthreads();
            {
                const float bt = BV[ti], bl = BV[63], gi = GI[ti];
                const float eb = __expf(bt), wk = __expf(bl - bt + gi);
                float qp[8]; float dn = 0.f;
                UNROLL for (int i = 0; i < 8; ++i) { qp[i] = q8[i] * eb; dn += q8[i] * NV[8 * j + i]; }
                st8((bf16_t*)(QP + ti * LROW) + 8 * j, qp);
                UNROLL for (int i = 0; i < 8; ++i) *(bf16_t*)(KW + (8 * j + i) * LROW + ti * 2) = f2bf(k8[i] * wk);
                dn = sum8(dn);
                if (j == 0) DEN[ti] = dn * eb;
            }
            __syncthreads();
            UNROLL for (int rep = 0; rep < 2; ++rep) {
                const int tile = wave + 8 * rep;
                if (tile < 10) {
                    const int tt4 = tile < 1 ? 0 : tile < 3 ? 1 : tile < 6 ? 2 : 3, st4 = tile - (tt4 * (tt4 + 1)) / 2;
                    f32x4v a = {0.f, 0.f, 0.f, 0.f};
                    UNROLL for (int ks = 0; ks < 2; ++ks)
                        a = __builtin_amdgcn_mfma_f32_16x16x32_bf16(*(const bf16x8*)(QS + (16 * tt4 + lq) * LROW + ks * 64 + kg * 16),
                                                                    *(const bf16x8*)(KC + (16 * st4 + lq) * LROW + ks * 64 + kg * 16), a, 0, 0, 0);
                    const int sidx = 16 * st4 + lq; const float bs = BV[sidx], gs = GI[sidx];
                    UNROLL for (int i = 0; i < 4; ++i) {
                        const int tidx = 16 * tt4 + 4 * kg + i;
                        const float val = sidx <= tidx ? a[i] * __expf(BV[tidx] - bs + gs) : 0.f;
                        *(bf16_t*)(PM + tidx * LROW + sidx * 2) = f2bf(val);
                        const float rsum = sum16(val);
                        if (lq == 0) RS[tidx * 4 + st4] = rsum;
                    }
                }
            }
            __syncthreads();
            {
                bf16x8 vf[2], cb[2];
                UNROLL for (int kk = 0; kk < 2; ++kk) vf[kk] = *(const bf16x8*)(VT + (16 * wave + lq) * LROW + kk * 64 + kg * 16);
                UNROLL for (int kk = 0; kk < 2; ++kk) {
                    u32x4 w; w.x = pk2(cacc[2 * kk][0], cacc[2 * kk][1]); w.y = pk2(cacc[2 * kk][2], cacc[2 * kk][3]);
                    w.z = pk2(cacc[2 * kk + 1][0], cacc[2 * kk + 1][1]); w.w = pk2(cacc[2 * kk + 1][2], cacc[2 * kk + 1][3]);
                    cb[kk] = __builtin_bit_cast(bf16x8, w);
                }
                UNROLL for (int tt4 = 0; tt4 < 4; ++tt4) {
                    f32x4v hacc = {0.f, 0.f, 0.f, 0.f};
                    UNROLL for (int kk = 0; kk < 2; ++kk) if (2 * kk <= tt4)
                        hacc = __builtin_amdgcn_mfma_f32_16x16x32_bf16(*(const bf16x8*)(PM + (16 * tt4 + lq) * LROW + kk * 64 + kg * 16), vf[kk], hacc, 0, 0, 0);
                    UNROLL for (int kk = 0; kk < 2; ++kk) {
                        const char* qa = QP + (16 * tt4 + lq) * LROW + (32 * kk + 4 * kg) * 2;
                        const u32x2 lo = *(const u32x2*)qa, hi = *(const u32x2*)(qa + 32);
                        u32x4 w; w.x = lo.x; w.y = lo.y; w.z = hi.x; w.w = hi.y;
                        hacc = __builtin_amdgcn_mfma_f32_16x16x32_bf16(__builtin_bit_cast(bf16x8, w), cb[kk], hacc, 0, 0, 0);
                    }
                    UNROLL for (int i = 0; i < 4; ++i) {
                        const int tidx = 16 * tt4 + 4 * kg + i;
                        float den = DEN[tidx];
                        UNROLL for (int st = 0; st <= tt4; ++st) den += RS[tidx * 4 + st];
                        HO[tidx * 132 + 16 * wave + lq] = hacc[i] * frcp(fmaxf(fabsf(den), 1.f));
                    }
                }
                const float g = __expf(BV[63]);
                UNROLL for (int dk = 0; dk < 4; ++dk) {
                    cacc[dk] = cacc[dk] * g;
                    UNROLL for (int kk = 0; kk < 2; ++kk)
                        cacc[dk] = __builtin_amdgcn_mfma_f32_16x16x32_bf16(*(const bf16x8*)(KW + (16 * dk + lq) * LROW + kk * 64 + kg * 16), vf[kk], cacc[dk], 0, 0, 0);
                }
            }
            __syncthreads();
            if (tid < 64) {
                float acc = 0.f;
                UNROLL for (int c8 = 0; c8 < 8; ++c8) { float kw[8]; ld8((const bf16_t*)(KW + tid * LROW) + 8 * c8, kw); UNROLL for (int i = 0; i < 8; ++i) acc += kw[i]; }
                NV[tid] = __expf(BV[63]) * NV[tid] + acc;
            }
            {
                const float* hr = HO + ti * 132 + 16 * j;
                float o0[8], o1[8];
                UNROLL for (int i = 0; i < 8; ++i) { o0[i] = hr[i]; o1[i] = hr[8 + i]; }
                bf16_t* dst = HS + ((size_t)d * NT + nb + tt) * 512 + h * 128 + 16 * j;
                st8(dst, o0); st8(dst + 8, o1);
            }
            __syncthreads();
        }
    }
}
DEV void ph_ml_read(const Params& p, int L, int ntok) {
    const int lane = TID() & 63, wave = TID() >> 6;
    const bf16_t* PXM = (const bf16_t*)(p.ws + OFF_PX); const bf16_t* HS = (const bf16_t*)(p.ws + OFF_HS);
    bf16_t* YC = (bf16_t*)(p.ws + OFF_YC); const float* ng = p.in[I_MNG] + (size_t)L * 512;
    for (int n0 = blockIdx.x * 8; n0 < ntok; n0 += gridDim.x * 8) {
        const int n = n0 + wave, c = lane * 8;
        float h0[8], h1[8], o8[8], out[8];
        ld8(HS + (size_t)n * 512 + c, h0); ld8(HS + ((size_t)NT + n) * 512 + c, h1); ld8(PXM + (size_t)n * ML_COLS + 1024 + c, o8);
        float ss = 0.f;
        UNROLL for (int i = 0; i < 8; ++i) { h0[i] += h1[i]; ss += h0[i] * h0[i]; }
        ss += __shfl_xor(ss, 1); ss += __shfl_xor(ss, 2); ss += __shfl_xor(ss, 4); ss += __shfl_xor(ss, 8);
        const float r = rsqrtf(ss * (1.f / 128.f) + 1e-6f);
        UNROLL for (int i = 0; i < 8; ++i) out[i] = h0[i] * r * ng[c + i] * sigm(o8[i]);
        st8(YC + (size_t)n * 512 + c, out);
    }
}

DEV void ph_route(const Params& p, int L, int ntok, char* smem) {
    const int lane = TID() & 63, wave = TID() >> 6;
    const float* LOG = (const float*)(p.ws + OFF_LOG); int* EIDX = (int*)(p.ws + OFF_EIDX); float* EW = (float*)(p.ws + OFF_EW);
    const float bias = p.in[I_MB][L * 64 + lane];
    int* MCNT = (int*)(p.ws + OFF_MCNT);
    int* hist = (int*)smem;
    if (TID() < 192) hist[TID()] = 0;
    __syncthreads();
    for (int n0 = blockIdx.x * 8; n0 < ntok; n0 += gridDim.x * 8) {
        const int n = n0 + wave, g = lane >> 3;
        const float score = sigm_acc(LOG[(size_t)n * 64 + lane]), sel = score + bias;
        float m1 = sel; m1 = fmaxf(m1, __shfl_xor(m1, 1)); m1 = fmaxf(m1, __shfl_xor(m1, 2)); m1 = fmaxf(m1, __shfl_xor(m1, 4));
        int i1 = sel == m1 ? lane : 64; i1 = min(i1, __shfl_xor(i1, 1)); i1 = min(i1, __shfl_xor(i1, 2)); i1 = min(i1, __shfl_xor(i1, 4));
        float m2 = lane == i1 ? -3e38f : sel; m2 = fmaxf(m2, __shfl_xor(m2, 1)); m2 = fmaxf(m2, __shfl_xor(m2, 2)); m2 = fmaxf(m2, __shfl_xor(m2, 4));
        const float gs = m1 + m2;
        int rank = 0;
        UNROLL for (int g2 = 0; g2 < 8; ++g2) { const float v = __shfl(gs, g2 * 8); rank += (v > gs || (v == gs && g2 < g)) ? 1 : 0; }
        const float ms = rank < 4 ? sel : -1e30f;
        int er = 0;
        for (int e2 = 0; e2 < 64; ++e2) { const float v = __shfl(ms, e2); er += (v > ms || (v == ms && e2 < lane)) ? 1 : 0; }
        const bool chosen = er < 8;
        float ws = chosen ? score : 0.f;
        UNROLL for (int o = 1; o < 64; o <<= 1) ws += __shfl_xor(ws, o);
        if (chosen) { EIDX[(size_t)n * 8 + er] = lane; EW[(size_t)n * 8 + er] = score / ws * 2.5f; atomicAdd(hist + (n / MOE_CHUNK) * 64 + lane, 1); }
    }
    __syncthreads();
    if (TID() < 192 && hist[TID()] > 0) atomicAdd(MCNT + TID(), hist[TID()]);
    __syncthreads();
}


DEV void ph_moe_scatter(const Params& p, int ntok, char* smem) {
    const int tid = TID();
    int* base = (int*)smem;
    int* lh = base + 192;
    const int* MCNT = (const int*)(p.ws + OFF_MCNT); int* CUR = (int*)(p.ws + OFF_MCNT) + 192;
    const int* EIDX = (const int*)(p.ws + OFF_EIDX); int* SORT = (int*)(p.ws + OFF_SORT);
    if (tid < 3) { int b = 0; for (int e = 0; e < 64; ++e) { base[tid * 64 + e] = b; b += (MCNT[tid * 64 + e] + 127) & ~127; } }
    if (tid < 192) lh[tid] = 0;
    __syncthreads();
    for (int i = blockIdx.x * NTHREADS + tid; i < ntok * 8; i += gridDim.x * NTHREADS) atomicAdd(lh + ((i >> 3) / MOE_CHUNK) * 64 + EIDX[i], 1);
    __syncthreads();
    if (tid < 192) { const int n = lh[tid]; if (n > 0) base[tid] += atomicAdd(CUR + tid, n); lh[tid] = 0; }
    __syncthreads();
    for (int i = blockIdx.x * NTHREADS + tid; i < ntok * 8; i += gridDim.x * NTHREADS) {
        const int ce = ((i >> 3) / MOE_CHUNK) * 64 + EIDX[i];
        SORT[(size_t)(ce >> 6) * SORT_CAP + base[ce] + atomicAdd(lh + ce, 1)] = i;
    }
    __syncthreads();
}

DEV void ph_moe_exp(const Params& p, int cb, int ce, char* smem, Topo tp) {
    typedef GC<2, 4> C;
    const int tid0 = TID();
    char* ACT = smem + 2 * C::STG;
    int* list = (int*)(smem + 3 * C::STG);
    int* cnt = list + 1024;
    const bf16_t* H2 = (const bf16_t*)(p.ws + OFF_HX); const int* EIDX = (const int*)(p.ws + OFF_EIDX); const float* EW = (const float*)(p.ws + OFF_EW);
    bf16_t* YBUF = (bf16_t*)(p.ws + OFF_YBUF);
    const int c = cb / MOE_CHUNK;
    const int* MCNT = (const int*)(p.ws + OFF_MCNT) + c * 64; const int* SORT = (const int*)(p.ws + OFF_SORT) + (size_t)c * SORT_CAP;
    int* tb = cnt + 16;
    const int xcd = tp.x, slot = tp.r, nslot = tp.n;
    __syncthreads();
    if (tid0 < 8) {
        const int tid = tid0; const int e = xcd + 8 * tid; int b = 0;
        for (int e2 = 0; e2 < e; ++e2) b += (MCNT[e2] + 127) & ~127;
        tb[16 + tid] = b; tb[32 + tid] = MCNT[e];
    }
    __syncthreads();
    if (tid0 == 0) { int t = 0; for (int k = 0; k < 8; ++k) { tb[k] = t; t += (tb[32 + k] + 127) >> 7; } tb[8] = t; }
    __syncthreads();
    const int total = tb[8];
    for (int lu = slot; lu < total; lu += nslot) {
        int tid = tid0; asm volatile("" : "+v"(tid));
        const int lane = tid & 63, wave = tid >> 6, wm = wave / 4, wn = wave % 4, fr = lane & 31, fh = lane >> 5;
        int k = 0;
        while (k < 7 && lu >= tb[k + 1]) ++k;
        const int e = xcd + 8 * k, j = lu - tb[k], M = min(128, tb[32 + k] - 128 * j), row0 = tb[16 + k] + 128 * j;
        __syncthreads();
        if (tid < 128) list[tid] = SORT[row0 + min(tid, M - 1)];
        __syncthreads();
        const bf16_t* GU = (const bf16_t*)(p.ws + OFF_MGU) + (size_t)e * 256 * 1024;
        const bf16_t* DT = (const bf16_t*)(p.ws + OFF_MDT) + (size_t)e * 1024 * 128;
        {
            constexpr int mc = 0;
            f32x16 acc[2][2];
            {
            acc_zero(acc);
            gemm_tile<2, 4, 3, false>(acc, [&](int r) -> const bf16_t* { const int ix = min(mc + r, M - 1); return H2 + (size_t)(list[ix] >> 3) * 1024; },
                                   GU, 1024, 0, 256, 1024, smem, nullptr);
            }
            UNROLL for (int mi = 0; mi < 2; ++mi) UNROLL for (int r = 0; r < 16; ++r) {
                const int row = wm * 64 + ACC_ROW(mi, r, fh), ix = mc + row;
                const float gw = ix < M ? EW[list[ix]] : 0.f;
                const float gv = acc[mi][0][r], uv = acc[mi][1][r];
                const float a = gv * frcp(1.f + __expf(-gv)) * uv * gw;
                const int col = wn * 32 + fr;
                *(bf16_t*)(ACT + (col >> 6) * C::AB + row * 128 + ((((col & 63) >> 3) ^ ((row >> 1) & 7)) << 4) + (col & 7) * 2) = f2bf(a);
            }
            __syncthreads();
            {
                const int crow = tid >> 3, cch = (tid & 7) ^ ((crow >> 1) & 7);
                const int sw = (fr >> 1) & 7, a_base = (wm * 64 + fr) * 128, b_base = (wn * 64 + fr) * 128;
                float* slab = (float*)(smem + (wave < 4 ? wave * 4096 : C::STG + (wave - 4) * 4096));
#define MG2_ISSUE(nt_) do { UNROLL for (int kt = 0; kt < 2; ++kt) UNROLL for (int i = 0; i < 4; ++i) \
                    GLDS16(DT + (size_t)((nt_) * 256 + crow + 64 * i) * 128 + kt * 64 + cch * 8, smem + kt * C::STG + C::AB + i * 8192 + tid * 16); } while (0)
                MG2_ISSUE(0);
                _Pragma("unroll 1") for (int nt = 0; nt < 4; ++nt) {
                    asm volatile("s_waitcnt vmcnt(0)" ::: "memory");
                    __builtin_amdgcn_s_barrier();
                    asm volatile("" ::: "memory");
                    acc_zero(acc);
                    UNROLL for (int kt = 0; kt < 2; ++kt) {
                        const char* As_ = ACT + kt * C::AB; const char* Bs_ = smem + kt * C::STG + C::AB;
                        UNROLL for (int ks = 0; ks < 4; ++ks) {
                            const int off = ((2 * ks + fh) ^ sw) * 16;
                            bf16x8 af[2], bfv[2];
                            UNROLL for (int mi = 0; mi < 2; ++mi) af[mi] = *(const bf16x8*)(As_ + a_base + mi * 4096 + off);
                            UNROLL for (int ni = 0; ni < 2; ++ni) bfv[ni] = *(const bf16x8*)(Bs_ + b_base + ni * 4096 + off);
                            UNROLL for (int mi = 0; mi < 2; ++mi) UNROLL for (int ni = 0; ni < 2; ++ni)
                                acc[mi][ni] = __builtin_amdgcn_mfma_f32_32x32x16_bf16(af[mi], bfv[ni], acc[mi][ni], 0, 0, 0);
                        }
                    }
                    asm volatile("s_waitcnt lgkmcnt(0)" ::: "memory");
                    __builtin_amdgcn_s_barrier();
                    asm volatile("" ::: "memory");
                    if (nt < 3) MG2_ISSUE(nt + 1);
                    UNROLL for (int mi = 0; mi < 2; ++mi) UNROLL for (int hh = 0; hh < 2; ++hh) {
                        UNROLL for (int ni = 0; ni < 2; ++ni) UNROLL for (int r8 = 0; r8 < 8; ++r8) {
                            const int r = 8 * hh + r8;
                            slab[((r & 3) + 8 * ((r >> 2) & 1) + 4 * fh) * 64 + ni * 32 + fr] = acc[mi][ni][r];
                        }
                        UNROLL for (int it = 0; it < 2; ++it) {
                            const int row = (lane >> 3) + 8 * it, c8 = (lane & 7) * 8;
                            const float4 a = *(const float4*)(slab + row * 64 + c8), b = *(const float4*)(slab + row * 64 + c8 + 4);
                            const float v[8] = {a.x, a.y, a.z, a.w, b.x, b.y, b.z, b.w};
                            const int ix = mc + wm * 64 + mi * 32 + 16 * hh + row;
                            if (ix < M) st8(YBUF + (size_t)(list[ix] - cb * 8) * 1024 + nt * 256 + wn * 64 + c8, v);
                        }
                    }
                }
#undef MG2_ISSUE
            }
            __syncthreads();
        }
        __syncthreads();
    }
}


#define XB_TMO      128
#define XB_XCNT(j)  (256  + 64 * (j))
#define XB_XSUB(j)  (1280 + 64 * (j))
#define XB_XGEN(j)  (2304 + 64 * (j))
#define XB_TOP      3328
#define XB_TOPGEN   3392
#define XCD_BAR_WORDS 3456
#define XB_SPIN_CAP (1u << 18)
#define LAS __attribute__((address_space(3)))

__device__ __forceinline__ unsigned xb_ld(unsigned* p)              { return __hip_atomic_load(p, __ATOMIC_RELAXED, __HIP_MEMORY_SCOPE_AGENT); }
__device__ __forceinline__ unsigned xb_add(unsigned* p, unsigned v) { return __hip_atomic_fetch_add(p, v, __ATOMIC_RELAXED, __HIP_MEMORY_SCOPE_AGENT); }
__device__ __forceinline__ unsigned xb_xcc_id() { return (unsigned)__builtin_amdgcn_s_getreg((3 << 11) | 20) & 0xFu; }
#define XB_SPIN(cond, bar) do { unsigned _sp = 0; while (cond) { __builtin_amdgcn_s_sleep(1); \
    if ((++_sp & 255u) == 0u) { if (xb_ld(&(bar)[XB_TMO])) break; if (_sp > XB_SPIN_CAP) { atomicAdd(&(bar)[XB_TMO], 1u); break; } } } } while (0)

struct XcdBarrier { unsigned* bar; unsigned x; volatile LAS unsigned* st; };

__device__ __forceinline__ XcdBarrier xcd_barrier_post(unsigned* bar, volatile LAS unsigned* st) {
    XcdBarrier b; b.bar = bar; b.x = xb_xcc_id(); b.st = st;
    if (threadIdx.x == 0) { const unsigned rank = xb_add(&bar[XB_XCNT(b.x)], 1u); st[2] = b.x; st[3] = rank; }
    return b;
}
__device__ __forceinline__ void xcd_barrier_complete(unsigned* bar, unsigned x, unsigned& nloc, unsigned& nx) {
    const unsigned G = gridDim.x * gridDim.y * gridDim.z;
    unsigned sum, cnt, mine, sp = 0u;
    for (;;) {
        sum = 0u; cnt = 0u; mine = 0u;
#pragma unroll
        for (unsigned j = 0; j < 16; ++j) { const unsigned c = xb_ld(&bar[XB_XCNT(j)]); sum += c; cnt += (c > 0u) ? 1u : 0u; mine = (j == x) ? c : mine; }
        if (sum == G) break;
        __builtin_amdgcn_s_sleep(1);
        if ((++sp & 255u) == 0u) { if (xb_ld(&bar[XB_TMO])) break; if (sp > XB_SPIN_CAP) { atomicAdd(&bar[XB_TMO], 1u); break; } }
    }
    nloc = mine > 0u ? mine : 1u; nx = cnt > 0u ? cnt : 1u;
}
__device__ __forceinline__ void xcd_barrier(const XcdBarrier& b) {
    asm volatile("s_waitcnt vmcnt(0)" ::: "memory");
    __syncthreads();
    if (threadIdx.x == 0) {
        unsigned* bar = b.bar;
        __builtin_amdgcn_s_waitcnt(0);
        unsigned nloc = b.st[0], nx = b.st[1];
        if (nloc == 0u) { xcd_barrier_complete(bar, b.x, nloc, nx); b.st[0] = nloc; b.st[1] = nx; }
        const unsigned old = xb_add(&bar[XB_XSUB(b.x)], 1u);
        const unsigned gen = old / nloc;
        if (old + 1u == (gen + 1u) * nloc) {
            __builtin_amdgcn_fence(__ATOMIC_RELEASE, "agent");
            asm volatile("s_waitcnt vmcnt(0)" ::: "memory");
            const unsigned og = xb_add(&bar[XB_TOP], 1u);
            const unsigned tg = og / nx;
            if (og + 1u == (tg + 1u) * nx) xb_add(&bar[XB_TOPGEN], 1u);
            else XB_SPIN(xb_ld(&bar[XB_TOPGEN]) == tg, bar);
            __builtin_amdgcn_fence(__ATOMIC_ACQUIRE, "agent");
            xb_add(&bar[XB_XGEN(b.x)], 1u);
            asm volatile("s_waitcnt vmcnt(0)" ::: "memory");
        } else {
            XB_SPIN(xb_ld(&bar[XB_XGEN(b.x)]) == gen, bar);
            __builtin_amdgcn_fence(__ATOMIC_ACQUIRE, "agent");
            asm volatile("s_waitcnt vmcnt(0)" ::: "memory");
        }
    }
    __syncthreads();
}

enum { PH_MODCONV = 0, PH_HX, PH_GEMM_R, PH_RW_PREP, PH_RW_SCAN, PH_RW_READ, PH_RW_G, PH_GEMM_N, PH_NA_NORM, PH_NA_ATT, PH_GEMM_M, PH_ML_SCAN, PH_ML_READ,
       PH_GEMM_G, PH_MERGE, PH_OUT, PH_NORM2, PH_ROUTER, PH_ROUTE, PH_SHARED, PH_MOE_EXP, PH_MOE_COMB, PH_COUNT };

template <int PH> DEV void run_phase(const Params& p, int L, int sub, char* smem, Topo tp) {
    const int tid = TID(), lane = tid & 63, fr = lane & 31, fh = lane >> 5;
    char* ws = p.ws;
    const int ntl = L == 0 ? NT : NX;
    const bf16_t* HX = (const bf16_t*)(ws + OFF_HX);
    const bf16_t* WINT = (const bf16_t*)(ws + OFF_WINT);
    if constexpr (PH == PH_MODCONV) { ph_mod(p, L, smem); ph_conv_mix(p, L, smem); }
    else if constexpr (PH == PH_HX) { ph_norm(p, L, 0, NT); }
    else if constexpr (PH == PH_GEMM_R || PH == PH_GEMM_M) {
        const int c0 = PH == PH_GEMM_R ? 0 : RW_COLS + NA_COLS;
        const int N = PH == PH_GEMM_R ? RW_COLS : ML_COLS;
        bf16_t* PX = (bf16_t*)(ws + OFF_PX);
        gemm256(HX, NT, WINT + (size_t)c0 * DM, N, DM, smem, tp, [&](int row, int col, const float (&v)[8]) {
            if (col < N) st8(PX + (size_t)row * N + col, v);
        });
    }
    else if constexpr (PH == PH_GEMM_N) {
        bf16_t* PX = (bf16_t*)(ws + OFF_PX); bf16_t* VT = (bf16_t*)(ws + OFF_VT); bf16_t* VTC = (bf16_t*)(ws + OFF_VTC);
        gemm256(HX, NT, WINT + (size_t)RW_COLS * DM, 1024, DM, smem, tp, [&](int row, int col, const float (&v)[8]) { st8(PX + (size_t)row * 1024 + col, v); });
        gemm_phase<4, 2>(HX, DM, NT, WINT + (size_t)(RW_COLS + 1024) * DM, DM, 512, DM, smem, tp, [&](const f32x16 (&acc)[2][2], int row0, int col0) {
            const int h = col0 >> 6;
            epi_cols(acc, smem, [&](int r8, int col, const float (&v)[8]) {
                const int n = row0 + r8;
                bf16_t* dst = n < NX ? VT + ((size_t)((n >> 11) * 8 + h) * 64 + col) * SEQ + (n & 2047)
                                     : VTC + ((size_t)(((n - NX) >> 8) * 8 + h) * 64 + col) * CTXL + ((n - NX) & 255);
                st8(dst, v);
            });
        });
    }
    else if constexpr (PH == PH_RW_PREP) { ph_rw_prep(p, L, smem); }
    else if constexpr (PH == PH_RW_SCAN) { ph_rw_scan(p, L, smem); }
    else if constexpr (PH == PH_RW_READ) { ph_rw_read(p, L, ntl); }
    else if constexpr (PH == PH_RW_G) {
        bf16_t* YA = (bf16_t*)(ws + OFF_YA);
        gemm_phase<4, 2>((const bf16_t*)(ws + OFF_SGB), 128, ntl, (const bf16_t*)(ws + OFF_G2T), 128, 512, 128, smem, tp, [&](const f32x16 (&acc)[2][2], int row0, int col0) {
            epi_rows(acc, smem, [&](int row, int c8, const float (&v)[8]) {
                bf16_t* q = YA + (size_t)(row0 + row) * 512 + col0 + c8;
                float y[8]; ld8(q, y);
                UNROLL for (int i = 0; i < 8; ++i) y[i] *= v[i];
                st8(q, y);
            });
        });
    }
    else if constexpr (PH == PH_NA_NORM) { ph_na_norm(p, L); }
    else if constexpr (PH == PH_NA_ATT) { ph_na_att(p, L, smem); }
    else if constexpr (PH == PH_ML_SCAN) {
        if (blockIdx.x < 128 || gridDim.x <= 128) ph_ml_scan(p, L, smem);
        if (gridDim.x <= 128) ph_conv_moe_gu(p, L, smem, blockIdx.x, gridDim.x);
        else if (blockIdx.x >= 128) ph_conv_moe_gu(p, L, smem, blockIdx.x - 128, gridDim.x - 128);
    }
    else if constexpr (PH == PH_ML_READ) { ph_ml_read(p, L, ntl); }
    else if constexpr (PH == PH_GEMM_G) {
        bf16_t* G = (bf16_t*)(ws + OFF_GATES);
        gemm256(HX, ntl, WINT + (size_t)(RW_COLS + NA_COLS + ML_COLS) * DM, GATE_COLS, DM, smem, tp, [&](int row, int col, const float (&v)[8]) {
            float y[8];
            UNROLL for (int i = 0; i < 8; ++i) y[i] = sigm(v[i]);
            st8(G + (size_t)row * GATE_COLS + col, y);
        });
    }
    else if constexpr (PH == PH_MERGE) {
        const bf16_t* G = (const bf16_t*)(ws + OFF_GATES); bf16_t* MG = (bf16_t*)(ws + OFF_HX);
        _Pragma("unroll 1") for (int br = 0; br < 3; ++br) {
            gemm256((const bf16_t*)(ws + OFF_YA + (size_t)br * SZ_Y1), ntl, (const bf16_t*)(ws + OFF_WBT) + (size_t)br * 1024 * 512, DM, 512, smem, tp, [&](int row, int col, const float (&v)[8]) {
                float g[8], m[8];
                ld8(G + (size_t)row * GATE_COLS + br * DM + col, g);
                bf16_t* q = MG + (size_t)row * DM + col;
                if (br == 0) { UNROLL for (int i = 0; i < 8; ++i) m[i] = g[i] * v[i]; }
                else { ld8(q, m); UNROLL for (int i = 0; i < 8; ++i) m[i] += g[i] * v[i]; }
                st8(q, m);
            });
        }
    }
    else if constexpr (PH == PH_OUT) {
        const float* MOD = (const float*)(ws + OFF_MOD);
        gemm256(HX, ntl, (const bf16_t*)(ws + OFF_WOUTT), DM, DM, smem, tp, [&](int n, int c, const float (&v)[8]) {
            const float* xp = xprev_row(p, L, n) + c; float* xo = xs_row(p, n) + c; const float* g1 = MOD + mod_row(n) * 6144 + 2 * DM + c;
            const float4 xa = *(const float4*)xp, xb = *(const float4*)(xp + 4), ga = *(const float4*)g1, gb = *(const float4*)(g1 + 4);
            float4 oa, ob;
            oa.x = xa.x + ga.x * v[0]; oa.y = xa.y + ga.y * v[1]; oa.z = xa.z + ga.z * v[2]; oa.w = xa.w + ga.w * v[3];
            ob.x = xb.x + gb.x * v[4]; ob.y = xb.y + gb.y * v[5]; ob.z = xb.z + gb.z * v[6]; ob.w = xb.w + gb.w * v[7];
            *(float4*)xo = oa; *(float4*)(xo + 4) = ob;
        });
    }
    else if constexpr (PH == PH_NORM2) {
        if (blockIdx.x == 0 && tid < 384) ((int*)(ws + OFF_MCNT))[tid] = 0;
        ph_norm(p, L, 1, ntl);
    }
    else if constexpr (PH == PH_ROUTER) {
        typedef GC<4, 2> C;
        float* LOG = (float*)(ws + OFF_LOG);
        const bf16_t* H2LO = (const bf16_t*)(ws + OFF_H2LO); const bf16_t* RH = (const bf16_t*)(ws + OFF_RTR); const bf16_t* RL = RH + 64 * 1024;
        const int wave = tid >> 6, wm = wave / 2, wn = wave % 2;
        {
            const int nrt = ntl / C::BM, G = gridDim.x;
            if (G > nrt) { if ((int)blockIdx.x >= nrt) ph_conv_moe(p, L, smem, blockIdx.x - nrt, G - nrt); }
            else ph_conv_moe(p, L, smem, blockIdx.x, G);
        }
        for (int t = blockIdx.x; t < ntl / C::BM; t += gridDim.x) {
            f32x16 acc[2][2]; acc_zero(acc);
            const bf16_t* A0 = HX + (size_t)t * C::BM * DM; const bf16_t* A1 = H2LO + (size_t)t * C::BM * DM;
            gemm_tile<4, 2, 3, false>(acc, [&](int r) { return A0 + (size_t)r * DM; }, RH, DM, 0, 64, DM, smem, nullptr);
            gemm_tile<4, 2, 3, false>(acc, [&](int r) { return A1 + (size_t)r * DM; }, RH, DM, 0, 64, DM, smem, nullptr);
            gemm_tile<4, 2, 3, false>(acc, [&](int r) { return A0 + (size_t)r * DM; }, RL, DM, 0, 64, DM, smem, nullptr);
            epi_rows(acc, smem, [&](int row, int c8, const float (&v)[8]) {
                if (wn == 0) {
                    float* q = LOG + (size_t)(t * C::BM + wm * 64 + row) * 64 + c8;
                    *(float4*)q = make_float4(v[0], v[1], v[2], v[3]); *(float4*)(q + 4) = make_float4(v[4], v[5], v[6], v[7]);
                }
            });
        }
    }
    else if constexpr (PH == PH_ROUTE) { ph_route(p, L, ntl, smem); }
    else if constexpr (PH == PH_SHARED) {
        ph_moe_scatter(p, ntl, smem);
        bf16_t* SA = (bf16_t*)(ws + OFF_SA);
        gemm256_pair(HX, ntl, (const bf16_t*)(ws + OFF_SGUT), 512, DM, smem, tp, [&](int row, int col, const float (&g)[8], const float (&u)[8]) {
            float a[8];
            UNROLL for (int i = 0; i < 8; ++i) a[i] = g[i] * frcp(1.f + __expf(-g[i])) * u[i];
            st8(SA + (size_t)row * 256 + (col >> 8) * 128 + (col & 127), a);
        });
    }
    else if constexpr (PH == PH_MOE_EXP) { const int cb = sub * MOE_CHUNK; ph_moe_exp(p, cb, min(cb + MOE_CHUNK, ntl), smem, tp); }
    else if constexpr (PH == PH_MOE_COMB) {
        const int cb = sub * MOE_CHUNK, ce = min(cb + MOE_CHUNK, ntl);
        const float* MOD = (const float*)(ws + OFF_MOD); const bf16_t* YBUF = (const bf16_t*)(ws + OFF_YBUF);
        gemm256((const bf16_t*)(ws + OFF_SA) + (size_t)cb * 256, ce - cb, (const bf16_t*)(ws + OFF_SDT), DM, 256, smem, tp, [&](int rl, int c, const float (&v)[8]) {
            const int n = cb + rl;
            float s[8];
            UNROLL for (int i = 0; i < 8; ++i) s[i] = v[i];
            _Pragma("unroll 2") for (int k = 0; k < 8; ++k) { float y[8]; ld8(YBUF + ((size_t)rl * 8 + k) * DM + c, y); UNROLL for (int i = 0; i < 8; ++i) s[i] += y[i]; }
            float* xo = xs_row(p, n) + c; const float* g2 = MOD + mod_row(n) * 6144 + 5 * DM + c;
            float4 xa = *(const float4*)xo, xb = *(const float4*)(xo + 4); const float4 ga = *(const float4*)g2, gb = *(const float4*)(g2 + 4);
            xa.x += ga.x * s[0]; xa.y += ga.y * s[1]; xa.z += ga.z * s[2]; xa.w += ga.w * s[3];
            xb.x += gb.x * s[4]; xb.y += gb.y * s[5]; xb.z += gb.z * s[6]; xb.w += gb.w * s[7];
            *(float4*)xo = xa; *(float4*)(xo + 4) = xb;
        });
    }
}

template <int PH> __global__ void __launch_bounds__(NTHREADS, 2) k_phase(Params p, int L, int sub) {
    extern __shared__ __attribute__((aligned(16))) char smem[];
    run_phase<PH>(p, L, sub, smem, Topo{(int)(blockIdx.x & 7), (int)(blockIdx.x >> 3), (int)((gridDim.x + 7 - (blockIdx.x & 7)) >> 3)});
}


#ifndef N_LAUNCH_MODE
#define N_LAUNCH_MODE 1
#endif
#ifndef MEGA_SKIP
#define MEGA_SKIP 0ull
#endif
#ifndef MEGA_REPEAT
#define MEGA_REPEAT 0ull
#endif
#define PHASE(PH, sub) do { if constexpr (!((MEGA_SKIP >> PH) & 1ull)) { run_phase<PH>(p, L, sub, smem, tp); xcd_barrier(bar); if constexpr ((MEGA_REPEAT >> PH) & 1ull) { run_phase<PH>(p, L, sub, smem, tp); xcd_barrier(bar); } } } while (0)
__global__ void __launch_bounds__(NTHREADS, 2) k_mega(Params p) {
    extern __shared__ __attribute__((aligned(16))) char smem[];
    volatile LAS unsigned* st = (volatile LAS unsigned*)(smem + LDS_BYTES);
    if (threadIdx.x == 0) { st[0] = 0u; st[1] = 0u; st[2] = 0u; st[3] = 0u; }
    __syncthreads();
    const XcdBarrier bar = xcd_barrier_post((unsigned*)(p.ws + OFF_BAR), st);
    Topo tp{(int)(blockIdx.x & 7), (int)(blockIdx.x >> 3), (int)((gridDim.x + 7 - (blockIdx.x & 7)) >> 3)};
    for (int L = 0; L < 2; ++L) {
        const int ntl = L == 0 ? NT : NX;
        PHASE(PH_MODCONV, 0);
        if (st[1] == 8u && st[0] != 0u) { tp.x = (int)st[2]; tp.r = (int)st[3]; tp.n = (int)st[0]; }
        PHASE(PH_HX, 0);
        PHASE(PH_GEMM_R, 0);
        PHASE(PH_RW_PREP, 0);
        PHASE(PH_RW_SCAN, 0);
        PHASE(PH_RW_READ, 0);
        PHASE(PH_RW_G, 0);
        PHASE(PH_GEMM_N, 0);
        PHASE(PH_NA_ATT, 0);
        PHASE(PH_GEMM_M, 0);
        PHASE(PH_ML_SCAN, 0);
        PHASE(PH_ML_READ, 0);
        PHASE(PH_GEMM_G, 0);
        PHASE(PH_MERGE, 0);
        PHASE(PH_OUT, 0);
        PHASE(PH_NORM2, 0);
        PHASE(PH_ROUTER, 0);
        PHASE(PH_ROUTE, 0);
        PHASE(PH_SHARED, 0);
        for (int c = 0; c * MOE_CHUNK < ntl; ++c) {
            PHASE(PH_MOE_EXP, c);
            PHASE(PH_MOE_COMB, c);
        }
    }
}

template <int PH> static void launch_phase(const Params& p, int L, int sub, hipStream_t stream) {
    static bool attr = false;
    if (!attr) { (void)hipFuncSetAttribute((const void*)k_phase<PH>, hipFuncAttributeMaxDynamicSharedMemorySize, LDS_BYTES); attr = true; }
    hipLaunchKernelGGL(k_phase<PH>, dim3(256), dim3(NTHREADS), LDS_BYTES, stream, p, L, sub);
}

extern "C" void kernel_launch(void* const* d_in, const int* in_sizes, int n_in, void* d_out, int out_size, void* d_ws, size_t ws_size, hipStream_t stream) {
    if (n_in != N_IN || ws_size < WS_END) { fprintf(stderr, "kernel_launch: unexpected inputs (%d) or workspace (%zu < %zu)\n", n_in, ws_size, (size_t)WS_END); return; }
    Params p{};
    for (int i = 0; i < N_IN; ++i) p.in[i] = (const float*)d_in[i];
    p.out = (float*)d_out; p.ws = (char*)d_ws;
#if N_LAUNCH_MODE == 1
    static int grid = 0;
    if (grid == 0) {
        int dev = 0, cus = 0;
        if (hipGetDevice(&dev) != hipSuccess || hipDeviceGetAttribute(&cus, hipDeviceAttributeMultiprocessorCount, dev) != hipSuccess) { grid = -1; return; }
        if (hipFuncSetAttribute((const void*)k_mega, hipFuncAttributeMaxDynamicSharedMemorySize, LDS_BYTES + 256) != hipSuccess) { grid = -1; return; }
        grid = cus;
    }
    if (grid <= 0) return;
    (void)hipMemsetAsync((char*)d_ws + OFF_BAR, 0, XCD_BAR_WORDS * sizeof(unsigned), stream);
    hipLaunchKernelGGL(k_mega, dim3(grid), dim3(NTHREADS), LDS_BYTES + 256, stream, p);
    return;
#endif
    for (int L = 0; L < 2; ++L) {
        const int ntl = L == 0 ? NT : NX;
        launch_phase<PH_MODCONV>(p, L, 0, stream);
        launch_phase<PH_HX>(p, L, 0, stream);
        launch_phase<PH_GEMM_R>(p, L, 0, stream);
        launch_phase<PH_RW_PREP>(p, L, 0, stream);
        launch_phase<PH_RW_SCAN>(p, L, 0, stream);
        launch_phase<PH_RW_READ>(p, L, 0, stream);
        launch_phase<PH_RW_G>(p, L, 0, stream);
        launch_phase<PH_GEMM_N>(p, L, 0, stream);
        launch_phase<PH_NA_ATT>(p, L, 0, stream);
        launch_phase<PH_GEMM_M>(p, L, 0, stream);
        launch_phase<PH_ML_SCAN>(p, L, 0, stream);
        launch_phase<PH_ML_READ>(p, L, 0, stream);
        launch_phase<PH_GEMM_G>(p, L, 0, stream);
        launch_phase<PH_MERGE>(p, L, 0, stream);
        launch_phase<PH_OUT>(p, L, 0, stream);
        launch_phase<PH_NORM2>(p, L, 0, stream);
        launch_phase<PH_ROUTER>(p, L, 0, stream);
        launch_phase<PH_ROUTE>(p, L, 0, stream);
        launch_phase<PH_SHARED>(p, L, 0, stream);
        for (int c = 0; c * MOE_CHUNK < ntl; ++c) {
            launch_phase<PH_MOE_EXP>(p, L, c, stream);
            launch_phase<PH_MOE_COMB>(p, L, c, stream);
        }
    }
}
```

```cpp
#include <hip/hip_runtime.h>
#include <stdint.h>
#include <stdio.h>

#define DEV __device__ __forceinline__
#define UNROLL _Pragma("unroll")

typedef unsigned short bf16_t;
typedef short bf16x8 __attribute__((ext_vector_type(8)));
typedef float f32x16 __attribute__((ext_vector_type(16)));
typedef float f32x4v __attribute__((ext_vector_type(4)));
typedef unsigned u32x4 __attribute__((ext_vector_type(4)));
typedef unsigned u32x2 __attribute__((ext_vector_type(2)));

constexpr int DM = 1024, NBATCH = 16, SEQ = 2048, CTXL = 256;
constexpr int NX = NBATCH * SEQ, NC = NBATCH * CTXL, NT = NX + NC;
constexpr int RW_COLS = 1920, NA_COLS = 1536, ML_COLS = 1552, GATE_COLS = 3072, IN_COLS = 8080;
constexpr int NTHREADS = 512;
constexpr int MOE_CHUNK = 12288, MOE_ST = 768;

enum { I_X = 0, I_C, I_CTX, I_CCTX, I_WADA, I_BADA, I_N1G, I_N2G, I_WIN, I_MU, I_W0, I_W2, I_A0, I_A2, I_KK, I_KA, I_RK, I_G2,
       I_LNG, I_LNB, I_V0, I_V1, I_V2, I_QNG, I_KNG, I_RPB, I_IB, I_FB, I_MNG, I_WBR, I_WOUT, I_RTR, I_MB, I_MWG, I_MWU, I_MWD,
       I_SG, I_SU, I_SD, N_IN };

constexpr size_t OFF_BAR = 0;
constexpr size_t OFF_MOD = 16384;
constexpr size_t OFF_WINT = OFF_MOD + 417792;
constexpr size_t OFF_WBT = OFF_WINT + (size_t)IN_COLS * 1024 * 2;
constexpr size_t OFF_WOUTT = OFF_WBT + (size_t)3 * 1024 * 512 * 2;
constexpr size_t OFF_SGUT = OFF_WOUTT + (size_t)1024 * 1024 * 2;
constexpr size_t OFF_SDT = OFF_SGUT + (size_t)512 * 1024 * 2;
constexpr size_t OFF_G2T = OFF_SDT + (size_t)1024 * 256 * 2;
constexpr size_t OFF_RTR = OFF_G2T + (size_t)512 * 128 * 2;
constexpr size_t OFF_CTXS = OFF_RTR + (size_t)2 * 64 * 1024 * 2;
constexpr size_t OFF_VF = OFF_CTXS + (size_t)NC * 1024 * 4;
constexpr size_t OFF_HX = OFF_VF + (size_t)NT * 512 * 2;
constexpr size_t OFF_BIG = OFF_HX + (size_t)NT * 1024 * 2;
constexpr size_t SZ_Y1 = (size_t)NT * 512 * 2;
constexpr size_t OFF_YA = OFF_BIG, OFF_YB = OFF_YA + SZ_Y1, OFF_YC = OFF_YB + SZ_Y1;
constexpr size_t OFF_PX = OFF_BIG + 3 * SZ_Y1;
constexpr size_t OFF_SCR = OFF_PX + (size_t)NT * RW_COLS * 2;
constexpr size_t SZ_SCR = (size_t)NT * 1152 * 2;
constexpr size_t OFF_MGU = OFF_SCR + SZ_SCR;
constexpr size_t WS_END = OFF_MGU + (size_t)64 * 256 * 1024 * 2;
constexpr size_t OFF_YS = OFF_YB;
constexpr size_t OFF_SGB = OFF_SCR;
constexpr size_t OFF_CB = OFF_SCR + (size_t)NT * 128 * 2;
constexpr size_t OFF_HS = OFF_SCR;
constexpr size_t OFF_VT = OFF_PX + (size_t)NT * 1024 * 2;
constexpr size_t OFF_VTC = OFF_VT + (size_t)NX * 512 * 2;
constexpr size_t OFF_GATES = OFF_PX;
constexpr size_t OFF_MDT = OFF_BIG;
constexpr size_t OFF_SA = OFF_MDT + (size_t)64 * 1024 * 128 * 2;
constexpr size_t OFF_EIDX = OFF_SA + (size_t)NT * 256 * 2;
constexpr size_t OFF_EW = OFF_EIDX + (size_t)NT * 8 * 4;
constexpr int SORT_CAP = 106496;
constexpr size_t OFF_SORT = OFF_EW + (size_t)NT * 8 * 4;
constexpr size_t OFF_LOG = OFF_SORT + (size_t)3 * SORT_CAP * 4;
constexpr size_t OFF_H2LO = OFF_LOG + (size_t)NT * 64 * 4;
constexpr size_t OFF_YBUF = OFF_LOG;
static_assert(OFF_YBUF + (size_t)MOE_CHUNK * 8 * 1024 * 2 <= WS_END, "moe layout");
static_assert(OFF_GATES + (size_t)NT * 3072 * 2 <= WS_END, "gates layout");
static_assert(WS_END <= (size_t)536870912, "workspace");

constexpr size_t OFF_MCNT = OFF_BAR + 14336;
constexpr int LDS_BYTES = 155648;

struct Topo { int x, r, n; };
struct Params {
    const float* in[N_IN];
    float* out;
    char* ws;
};

DEV int TID() { int t = threadIdx.x; asm volatile("" : "+v"(t)); return t; }
DEV float bf2f(bf16_t h) { return __uint_as_float(((unsigned)h) << 16); }
typedef __bf16 bf16x2n __attribute__((ext_vector_type(2)));
typedef float f32x2n __attribute__((ext_vector_type(2)));
DEV unsigned pk2(float lo, float hi) { const f32x2n v = {lo, hi}; return __builtin_bit_cast(unsigned, __builtin_convertvector(v, bf16x2n)); }
DEV bf16_t f2bf(float f) { return (bf16_t)(pk2(f, 0.f) & 0xffffu); }
DEV void ld8(const bf16_t* p, float (&o)[8]) {
    const u32x4 v = *(const u32x4*)p;
    o[0] = __uint_as_float(v.x << 16); o[1] = __uint_as_float(v.x & 0xffff0000u);
    o[2] = __uint_as_float(v.y << 16); o[3] = __uint_as_float(v.y & 0xffff0000u);
    o[4] = __uint_as_float(v.z << 16); o[5] = __uint_as_float(v.z & 0xffff0000u);
    o[6] = __uint_as_float(v.w << 16); o[7] = __uint_as_float(v.w & 0xffff0000u);
}
DEV void st8(bf16_t* p, const float (&v)[8]) {
    u32x4 o; o.x = pk2(v[0], v[1]); o.y = pk2(v[2], v[3]); o.z = pk2(v[4], v[5]); o.w = pk2(v[6], v[7]);
    *(u32x4*)p = o;
}
#define DPP_MOV(v, ctrl) __builtin_bit_cast(float, __builtin_amdgcn_update_dpp(0, __builtin_bit_cast(int, (v)), (ctrl), 0xF, 0xF, true))
DEV float sum8(float v) { v += DPP_MOV(v, 0xB1); v += DPP_MOV(v, 0x4E); v += DPP_MOV(v, 0x141); return v; }
DEV float frcp(float x) { return __builtin_amdgcn_rcpf(x); }
DEV float sigm(float x) { return frcp(1.f + __expf(-x)); }
DEV float sigm_acc(float x) { return 1.f / (1.f + expf(-x)); }
DEV float tanh_fast(float x) { return 1.f - 2.f * frcp(1.f + __expf(2.f * x)); }
DEV float softplus_fast(float x) { return fmaxf(x, 0.f) + __logf(1.f + __expf(-fabsf(x))); }
DEV int mod_row(int n) { return n < NX ? (n >> 11) : 16; }
DEV float* xs_row(const Params& p, int n) { return n < NX ? p.out + (size_t)n * DM : (float*)(p.ws + OFF_CTXS) + (size_t)(n - NX) * DM; }
DEV const float* xprev_row(const Params& p, int L, int n) {
    if (L == 0) return n < NX ? p.in[I_X] + (size_t)n * DM : p.in[I_CTX] + (size_t)(n - NX) * DM;
    return xs_row(p, n);
}
DEV void seq_of(int n, int& nb, int& tt, int& T) {
    if (n < NX) { nb = n & ~2047; tt = n & 2047; T = SEQ; } else { const int m = n - NX; nb = NX + (m & ~255); tt = m & 255; T = CTXL; }
}
DEV void shift8(const bf16_t* z, int ld, int nb, int tt, int T, int col0, const float* mu, float (&o)[8]) {
    float c[8], l[8], r[8];
    ld8(z + (size_t)(nb + tt) * ld + col0, c);
    if (tt > 0) ld8(z + (size_t)(nb + tt - 1) * ld + col0, l); else { UNROLL for (int i = 0; i < 8; ++i) l[i] = 0.f; }
    if (tt < T - 1) ld8(z + (size_t)(nb + tt + 1) * ld + col0, r); else { UNROLL for (int i = 0; i < 8; ++i) r[i] = 0.f; }
    UNROLL for (int i = 0; i < 8; ++i) o[i] = c[i] + mu[col0 + i] * (0.5f * (l[i] + r[i]) - c[i]);
}

constexpr int LROW = 144;
template <int WM, int WN> struct GC {
    static constexpr int BM = 64 * WM, BN = 64 * WN;
    static constexpr int AB = BM * 128, BB = BN * 128, STG = AB + BB;
    static constexpr int NA = BM / 64, NBC = BN / 64;
};
DEV void acc_zero(f32x16 (&acc)[2][2]) {
    UNROLL for (int a = 0; a < 2; ++a) UNROLL for (int b = 0; b < 2; ++b) UNROLL for (int r = 0; r < 16; ++r) acc[a][b][r] = 0.f;
}
#define GLDS16(gp, lp) __builtin_amdgcn_global_load_lds((const __attribute__((address_space(1))) void*)(gp), (__attribute__((address_space(3))) void*)(lp), 16, 0, 0)
template <int WM, int WN, int NS, bool A_LDS, class ARow>
DEV void gemm_tile(f32x16 (&acc)[2][2], ARow arow, const bf16_t* Bt, int ldb, int n0, int Nvalid, int K, char* smem, const char* alds) {
    typedef GC<WM, WN> C;
    constexpr int LPT = (A_LDS ? 0 : C::NA) + C::NBC;
    const int tid = TID(), lane = tid & 63, wave = tid >> 6, wm = wave / WN, wn = wave % WN;
    const int fr = lane & 31, fh = lane >> 5;
    const int crow = tid >> 3, cch = (tid & 7) ^ ((crow >> 1) & 7);
    const bf16_t* pa[C::NA]; const bf16_t* pb[C::NBC];
    if (!A_LDS) { UNROLL for (int i = 0; i < C::NA; ++i) pa[i] = arow(crow + 64 * i) + cch * 8; }
    UNROLL for (int i = 0; i < C::NBC; ++i) { const int n = min(n0 + crow + 64 * i, Nvalid - 1); pb[i] = Bt + (size_t)n * ldb + cch * 8; }
    const int nk = K >> 6;
#define GT_ISSUE(kt, stg) do { char* sb_ = smem + (stg) * C::STG + tid * 16; \
        if (!A_LDS) { UNROLL for (int i = 0; i < C::NA; ++i) GLDS16(pa[i] + (kt) * 64, sb_ + i * 8192); } \
        UNROLL for (int i = 0; i < C::NBC; ++i) GLDS16(pb[i] + (kt) * 64, sb_ + C::AB + i * 8192); } while (0)
    const int sw = (fr >> 1) & 7;
    int offk[4];
    UNROLL for (int ks = 0; ks < 4; ++ks) offk[ks] = ((2 * ks + fh) ^ sw) * 16;
    const int a_base = (wm * 64 + fr) * 128, b_base = (wn * 64 + fr) * 128;
    UNROLL for (int s = 0; s < NS - 1; ++s) if (s < nk) GT_ISSUE(s, s);
    int stg = 0, nstg = NS - 1;
    for (int kt = 0; kt < nk; ++kt) {
        if (NS == 3 && kt + 1 < nk) asm volatile("s_waitcnt vmcnt(%0)" :: "n"(LPT) : "memory");
        else asm volatile("s_waitcnt vmcnt(0)" ::: "memory");
        __builtin_amdgcn_s_barrier();
        asm volatile("" ::: "memory");
        const bool more = kt + NS - 1 < nk;
        const char* As_ = A_LDS ? alds + kt * C::AB : smem + stg * C::STG; const char* Bs_ = smem + stg * C::STG + C::AB;
        char* db_ = smem + nstg * C::STG + tid * 16;
        bf16x8 af[2][2], bfv[2][2];
        UNROLL for (int mi = 0; mi < 2; ++mi) af[0][mi] = *(const bf16x8*)(As_ + a_base + mi * 4096 + offk[0]);
        UNROLL for (int ni = 0; ni < 2; ++ni) bfv[0][ni] = *(const bf16x8*)(Bs_ + b_base + ni * 4096 + offk[0]);
        UNROLL for (int ks = 0; ks < 4; ++ks) {
            const int cur = ks & 1, nxt = cur ^ 1;
            if (ks < 3) {
                UNROLL for (int mi = 0; mi < 2; ++mi) af[nxt][mi] = *(const bf16x8*)(As_ + a_base + mi * 4096 + offk[ks + 1]);
                UNROLL for (int ni = 0; ni < 2; ++ni) bfv[nxt][ni] = *(const bf16x8*)(Bs_ + b_base + ni * 4096 + offk[ks + 1]);
            }
            UNROLL for (int mi = 0; mi < 2; ++mi) UNROLL for (int ni = 0; ni < 2; ++ni)
                acc[mi][ni] = __builtin_amdgcn_mfma_f32_32x32x16_bf16(af[cur][mi], bfv[cur][ni], acc[mi][ni], 0, 0, 0);
            if (more) {
                UNROLL for (int pc = 0; pc < LPT; ++pc) if (pc * 4 / LPT == ks) {
                    if (!A_LDS && pc < C::NA) GLDS16(pa[pc] + (kt + NS - 1) * 64, db_ + pc * 8192);
                    else { const int ib = pc - (A_LDS ? 0 : C::NA); GLDS16(pb[ib] + (kt + NS - 1) * 64, db_ + C::AB + ib * 8192); }
                }
            }
            __builtin_amdgcn_sched_barrier(0);
        }
        stg = stg + 1 == NS ? 0 : stg + 1; nstg = nstg + 1 == NS ? 0 : nstg + 1;
    }
    __syncthreads();
#undef GT_ISSUE
}
#define ACC_ROW(mi, r, fh) ((mi) * 32 + ((r) & 3) + 8 * ((r) >> 2) + 4 * (fh))

constexpr int EPI_SLAB = 32 * 68 * 4;
template <class F> DEV void epi_rows(const f32x16 (&acc)[2][2], char* smem, F f) {
    const int lane = TID() & 63, wave = TID() >> 6, fr = lane & 31, fh = lane >> 5;
    float* st = (float*)(smem + wave * EPI_SLAB);
    UNROLL for (int mi = 0; mi < 2; ++mi) {
        UNROLL for (int ni = 0; ni < 2; ++ni) UNROLL for (int r = 0; r < 16; ++r)
            st[((r & 3) + 8 * (r >> 2) + 4 * fh) * 68 + ni * 32 + fr] = acc[mi][ni][r];
        UNROLL for (int it = 0; it < 4; ++it) {
            const int row = it * 8 + (lane >> 3), c8 = (lane & 7) * 8;
            const float4 a = *(const float4*)(st + row * 68 + c8), b = *(const float4*)(st + row * 68 + c8 + 4);
            float v[8] = {a.x, a.y, a.z, a.w, b.x, b.y, b.z, b.w};
            f(mi * 32 + row, c8, v);
        }
    }
    __syncthreads();
}


template <class F> DEV void epi_cols(const f32x16 (&acc)[2][2], char* smem, F f) {
    const int lane = TID() & 63, wave = TID() >> 6, fr = lane & 31, fh = lane >> 5;
    float* st = (float*)(smem + wave * EPI_SLAB);
    UNROLL for (int mi = 0; mi < 2; ++mi) {
        UNROLL for (int ni = 0; ni < 2; ++ni) UNROLL for (int r = 0; r < 16; ++r)
            st[((r & 3) + 8 * (r >> 2) + 4 * fh) * 68 + ni * 32 + fr] = acc[mi][ni][r];
        UNROLL for (int it = 0; it < 4; ++it) {
            float v[8];
            UNROLL for (int i = 0; i < 8; ++i) v[i] = st[(it * 8 + i) * 68 + lane];
            f(mi * 32 + it * 8, lane, v);
        }
    }
    __syncthreads();
}

struct TileOrder {
    int x, nN, cx, total;
    DEV TileOrder(const Topo& tp, int nM, int nN_) { x = tp.x; nN = nN_; cx = nM > x ? (nM - x + 7) >> 3 : 0; total = ((cx + 3) >> 2) * 4 * nN; }
    DEV bool get(int q, int& pm, int& pn) const { const int per = 4 * nN, qi = q / per, rem = q - qi * per, i = 4 * qi + (rem & 3); pn = rem >> 2; pm = x + 8 * i; return i < cx; }
};
template <int WM, int WN, class Epi>
DEV void gemm_phase(const bf16_t* A, int lda, int M, const bf16_t* Bt, int ldb, int N, int K, char* smem, const Topo& tp, Epi epi) {
    typedef GC<WM, WN> C;
    const int nM = M / C::BM, nN = (N + C::BN - 1) / C::BN;
    const int wave = TID() >> 6, wm = wave / WN, wn = wave % WN;
    const TileOrder ord(tp, nM, nN);
    for (int q = tp.r; q < ord.total; q += tp.n) {
        int pm, pn; if (!ord.get(q, pm, pn)) continue;
        f32x16 acc[2][2]; acc_zero(acc);
        const bf16_t* Ab = A + (size_t)pm * C::BM * lda;
        gemm_tile<WM, WN, 3, false>(acc, [&](int r) { return Ab + (size_t)r * lda; }, Bt, ldb, pn * C::BN, N, K, smem, nullptr);
        epi(acc, pm * C::BM + wm * 64, pn * C::BN + wn * 64);
    }
}

namespace pg8 {
#define PG8_LAS __attribute__((address_space(3)))
typedef float f32x4 __attribute__((ext_vector_type(4)));
constexpr int BM = 256, BK = 64, HALF = 128, HTB = HALF * BK * 2  , STAGE_BYTES = 8 * HTB, NXCD = 8, WGM = 8;

__host__ __device__ __forceinline__ int lds_byte(int r, int c) { const int st = (r >> 4) * 2 + (c >> 5), rr = r & 15, cc = c & 31, ob = rr * 64 + cc * 2; return st * 1024 + (ob ^ (((ob >> 9) & 1) << 5)); }
__host__ __device__ __forceinline__ void stage_rc(int b, int& R, int& C) { const int st = b / 1024, sb = b % 1024, swz = sb ^ (((sb >> 9) & 1) << 5); R = (st >> 1) * 16 + swz / 64; C = (st & 1) * 32 + (swz % 64) / 2; }
__host__ __device__ __forceinline__ int perm32(int rho) { const int n = rho >> 4, i = rho & 15; return 8 * (i >> 2) + 4 * n + (i & 3); }

struct Unit { int pm, pn; };
struct Gemm { const bf16_t* A; const bf16_t* Bt; int M, N, K; };
template <class Epi, class Sched, bool ALIGN_EPI = false, bool SP2 = false>
__device__ __forceinline__ void gemm_phase(PG8_LAS unsigned char* lds, const Gemm g, const Sched& S, const Epi& E) {
    const int tid = TID(), wid = __builtin_amdgcn_readfirstlane(tid >> 6), lane = tid & 63, wr = wid >> 2, wc = wid & 3, fr = lane & 15, fq = lane >> 4;
    const int K = g.K, nt = K / BK;
    unsigned voffA[2], voffB[2];
#pragma unroll
    for (int i = 0; i < 2; ++i) { int R, C; stage_rc(tid * 16 + i * 8192, R, C); const int Rb = Epi::PERM ? ((R & ~31) + perm32(R & 31)) : R;
        voffA[i] = (unsigned)(R * K + C) * 2u; voffB[i] = (unsigned)(Rb * K + C) * 2u; }
    const size_t kstep = (size_t)(BK * 2);
    const size_t hstep = (size_t)HALF * K * 2;
    const size_t tstep = 2 * hstep;
    const unsigned ldsw = (unsigned)wid * 1024u;
    const int aoff = lds_byte(wr * 64 + fr, fq * 8), boff = lds_byte(wc * 32 + fr, fq * 8);
#define PG8_SA(b, h) (((b) * 2 + (h)) * HTB)
#define PG8_SB(b, h) ((4 + (b) * 2 + (h)) * HTB)
#define PG8_STAGE(bufoff, gbase, voff) do { _Pragma("unroll") for (int _i = 0; _i < 2; ++_i) \
        __builtin_amdgcn_global_load_lds((const unsigned*)((const char*)(gbase) + (voff)[_i]), (PG8_LAS unsigned*)(lds + (bufoff) + ldsw + _i * 8192), 16, 0, 0); } while (0)
#define PG8_LDA(dst, b, h) do { _Pragma("unroll") for (int m = 0; m < 4; ++m) _Pragma("unroll") for (int k = 0; k < 2; ++k) dst[m][k] = *(const PG8_LAS bf16x8*)(lds + PG8_SA(b, h) + aoff + m * 2048 + k * 1024); } while (0)
#define PG8_LDB(dst, b, h) do { _Pragma("unroll") for (int n = 0; n < 2; ++n) _Pragma("unroll") for (int k = 0; k < 2; ++k) dst[n][k] = *(const PG8_LAS bf16x8*)(lds + PG8_SB(b, h) + boff + n * 2048 + k * 1024); } while (0)
#define PG8_MMA(ai, bj, At, Bt) do { __builtin_amdgcn_s_setprio(1); _Pragma("unroll") for (int m = 0; m < 4; ++m) _Pragma("unroll") for (int n = 0; n < 2; ++n) _Pragma("unroll") for (int k = 0; k < 2; ++k) \
        acc[ai][bj][m][n] = __builtin_amdgcn_mfma_f32_16x16x32_bf16(Bt[n][k], At[m][k], acc[ai][bj][m][n], 0, 0, 0); __builtin_amdgcn_s_setprio(0); } while (0)
#define PG8_WAIT_V(n) asm volatile("s_waitcnt vmcnt(" #n ")" ::: "memory")
#define PG8_WAIT_L(n) asm volatile("s_waitcnt lgkmcnt(" #n ")" ::: "memory")
#define PG8_BAR __builtin_amdgcn_s_barrier()
#define PG8_SCHED __builtin_amdgcn_sched_barrier(0)
    Unit cur, nxt; int ui = 0;
    if (!S.next(0, cur)) return;
    f32x4 acc[2][2][4][2];
#pragma unroll
    for (int a = 0; a < 2; ++a)
#pragma unroll
        for (int b = 0; b < 2; ++b)
#pragma unroll
            for (int m = 0; m < 4; ++m)
#pragma unroll
                for (int n = 0; n < 2; ++n) acc[a][b][m][n] = (f32x4){0.f, 0.f, 0.f, 0.f};
    bf16x8 At[4][2], B0[2][2], B1[2][2];
    const char* cA = (const char*)g.A + (size_t)cur.pm * tstep; const char* cB = (const char*)g.Bt + (size_t)cur.pn * tstep;
    S.a_ready(cur);
    if constexpr (SP2) {
        PG8_STAGE(PG8_SB(0, 0), cB, voffB); PG8_STAGE(PG8_SB(0, 1), cB + hstep, voffB); PG8_STAGE(PG8_SA(0, 0), cA, voffA); PG8_STAGE(PG8_SA(0, 1), cA + hstep, voffA);
        if (wr == 1) PG8_BAR;
        PG8_WAIT_V(2); PG8_BAR;
        PG8_STAGE(PG8_SB(1, 0), cB + kstep, voffB); PG8_STAGE(PG8_SA(1, 0), cA + kstep, voffA); PG8_STAGE(PG8_SB(1, 1), cB + hstep + kstep, voffB);
        PG8_WAIT_V(6); PG8_BAR;
    } else {
        PG8_STAGE(PG8_SB(0, 0), cB, voffB); PG8_STAGE(PG8_SA(0, 0), cA, voffA); PG8_STAGE(PG8_SB(0, 1), cB + hstep, voffB); PG8_STAGE(PG8_SA(0, 1), cA + hstep, voffA);
        if (wr == 1) PG8_BAR;
        PG8_WAIT_V(4); PG8_BAR;
        PG8_STAGE(PG8_SB(1, 0), cB + kstep, voffB); PG8_STAGE(PG8_SA(1, 0), cA + kstep, voffA); PG8_STAGE(PG8_SB(1, 1), cB + hstep + kstep, voffB);
        PG8_WAIT_V(6); PG8_BAR;
    }
    for (;;) {
        const bool has_next = S.next(ui + 1, nxt);
        const char* nA = has_next ? (const char*)g.A + (size_t)nxt.pm * tstep : cA; const char* nB = has_next ? (const char*)g.Bt + (size_t)nxt.pn * tstep : cB;
        for (int t = 0; t < nt; t += 2) {
            const bool last = (t == nt - 2);
            const char* a1 = cA + (size_t)(t + 1) * kstep;
            const char* a2 = last ? nA : cA + (size_t)(t + 2) * kstep; const char* b2 = last ? nB : cB + (size_t)(t + 2) * kstep;
            const char* a3 = a2 + kstep; const char* b3 = b2 + kstep;
            if (last && has_next) S.a_ready(nxt);
            if constexpr (SP2) {
            PG8_LDB(B0, 0, 0); PG8_LDB(B1, 0, 1); PG8_SCHED; PG8_LDA(At, 0, 0); PG8_STAGE(PG8_SA(1, 1), a1 + hstep, voffA);
            PG8_WAIT_V(8); PG8_WAIT_L(0); PG8_BAR; PG8_MMA(0, 0, At, B0); PG8_MMA(0, 1, At, B1); PG8_BAR; PG8_SCHED;
            PG8_LDA(At, 0, 1); PG8_STAGE(PG8_SB(0, 0), b2, voffB); PG8_STAGE(PG8_SB(0, 1), b2 + hstep, voffB); PG8_STAGE(PG8_SA(0, 0), a2, voffA);
            PG8_WAIT_V(8); PG8_WAIT_L(0); PG8_BAR; PG8_MMA(1, 0, At, B0); PG8_MMA(1, 1, At, B1); PG8_BAR; PG8_SCHED;
            PG8_LDB(B0, 1, 0); PG8_LDB(B1, 1, 1); PG8_SCHED; PG8_LDA(At, 1, 0); PG8_STAGE(PG8_SA(0, 1), a2 + hstep, voffA);
            PG8_WAIT_V(8); PG8_WAIT_L(0); PG8_BAR; PG8_MMA(0, 0, At, B0); PG8_MMA(0, 1, At, B1); PG8_BAR; PG8_SCHED;
            PG8_LDA(At, 1, 1); PG8_STAGE(PG8_SB(1, 0), b3, voffB); PG8_STAGE(PG8_SB(1, 1), b3 + hstep, voffB); PG8_STAGE(PG8_SA(1, 0), a3, voffA);
            PG8_WAIT_V(8); PG8_WAIT_L(0); PG8_BAR; PG8_MMA(1, 0, At, B0); PG8_MMA(1, 1, At, B1); PG8_BAR; PG8_SCHED;
            } else {
            PG8_LDB(B0, 0, 0); PG8_SCHED; PG8_LDA(At, 0, 0); PG8_STAGE(PG8_SA(1, 1), a1 + hstep, voffA);
            PG8_WAIT_L(8); PG8_BAR; PG8_WAIT_L(0); PG8_MMA(0, 0, At, B0); PG8_BAR; PG8_SCHED;
            PG8_LDB(B1, 0, 1); PG8_STAGE(PG8_SB(0, 0), b2, voffB);
            PG8_BAR; PG8_WAIT_L(0); PG8_MMA(0, 1, At, B1); PG8_BAR;
            PG8_LDA(At, 0, 1); PG8_STAGE(PG8_SA(0, 0), a2, voffA);
            PG8_BAR; PG8_WAIT_L(0); PG8_MMA(1, 0, At, B0); PG8_BAR; PG8_SCHED;
            PG8_STAGE(PG8_SB(0, 1), b2 + hstep, voffB);
            PG8_WAIT_V(6); PG8_BAR; PG8_MMA(1, 1, At, B1); PG8_BAR;
            PG8_LDB(B0, 1, 0); PG8_SCHED; PG8_LDA(At, 1, 0); PG8_STAGE(PG8_SA(0, 1), a2 + hstep, voffA);
            PG8_WAIT_L(8); PG8_BAR; PG8_WAIT_L(0); PG8_MMA(0, 0, At, B0); PG8_BAR; PG8_SCHED;
            PG8_LDB(B1, 1, 1); PG8_STAGE(PG8_SB(1, 0), b3, voffB);
            PG8_BAR; PG8_WAIT_L(0); PG8_MMA(0, 1, At, B1); PG8_BAR;
            PG8_LDA(At, 1, 1); PG8_STAGE(PG8_SA(1, 0), a3, voffA);
            PG8_BAR; PG8_WAIT_L(0); PG8_MMA(1, 0, At, B0); PG8_BAR; PG8_SCHED;
            PG8_STAGE(PG8_SB(1, 1), b3 + hstep, voffB);
            PG8_WAIT_V(6); PG8_BAR; PG8_MMA(1, 1, At, B1); PG8_BAR;
            }
        }
        if constexpr (ALIGN_EPI) { if (wr == 0) PG8_BAR; }
        if constexpr (!Epi::AFTER_DRAIN) { E(acc, cur, wr, wc, fr, fq); S.done(cur); }
        if (!has_next) break;
#pragma unroll
        for (int a = 0; a < 2; ++a)
#pragma unroll
            for (int b = 0; b < 2; ++b)
#pragma unroll
                for (int m = 0; m < 4; ++m)
#pragma unroll
                    for (int n = 0; n < 2; ++n) acc[a][b][m][n] = (f32x4){0.f, 0.f, 0.f, 0.f};
        cur = nxt; cA = nA; cB = nB; ++ui;
        if constexpr (ALIGN_EPI) { if (wr == 1) PG8_BAR; }
    }
    PG8_WAIT_V(0);
    if constexpr (!ALIGN_EPI) { if (wr == 0) PG8_BAR; }
    PG8_BAR;
    if constexpr (Epi::AFTER_DRAIN) { E.fused(acc, cur, wr, wc, fr, fq, lds, wid, lane); S.done(cur); }
#undef PG8_SA
#undef PG8_SB
#undef PG8_STAGE
#undef PG8_LDA
#undef PG8_LDB
#undef PG8_MMA
#undef PG8_WAIT_V
#undef PG8_WAIT_L
#undef PG8_BAR
#undef PG8_SCHED
}
}
template <class F> struct EpiF {
    static constexpr bool PERM = true, AFTER_DRAIN = false; F f;
    DEV void operator()(const pg8::f32x4 (&acc)[2][2][4][2], const pg8::Unit& u, int wr, int wc, int fr, int fq) const {
        UNROLL for (int ai = 0; ai < 2; ++ai) UNROLL for (int m = 0; m < 4; ++m) {
            const int row = u.pm * 256 + ai * 128 + wr * 64 + m * 16 + fr;
            UNROLL for (int bj = 0; bj < 2; ++bj) {
                const int col = u.pn * 256 + bj * 128 + wc * 32 + 8 * fq;
                const float v[8] = {acc[ai][bj][m][0][0], acc[ai][bj][m][0][1], acc[ai][bj][m][0][2], acc[ai][bj][m][0][3],
                                    acc[ai][bj][m][1][0], acc[ai][bj][m][1][1], acc[ai][bj][m][1][2], acc[ai][bj][m][1][3]};
                f(row, col, v);
            }
        }
    }
};
template <class F> struct EpiF2 {
    static constexpr bool PERM = true, AFTER_DRAIN = false; F f;
    DEV void operator()(const pg8::f32x4 (&acc)[2][2][4][2], const pg8::Unit& u, int wr, int wc, int fr, int fq) const {
        UNROLL for (int ai = 0; ai < 2; ++ai) UNROLL for (int m = 0; m < 4; ++m) {
            const int row = u.pm * 256 + ai * 128 + wr * 64 + m * 16 + fr, col = u.pn * 256 + wc * 32 + 8 * fq;
            const float v0[8] = {acc[ai][0][m][0][0], acc[ai][0][m][0][1], acc[ai][0][m][0][2], acc[ai][0][m][0][3], acc[ai][0][m][1][0], acc[ai][0][m][1][1], acc[ai][0][m][1][2], acc[ai][0][m][1][3]};
            const float v1[8] = {acc[ai][1][m][0][0], acc[ai][1][m][0][1], acc[ai][1][m][0][2], acc[ai][1][m][0][3], acc[ai][1][m][1][0], acc[ai][1][m][1][1], acc[ai][1][m][1][2], acc[ai][1][m][1][3]};
            f(row, col, v0, v1);
        }
    }
};
struct XOrder {
    int x, r, n, nN, cx, fullq, total;
    DEV XOrder(const Topo& tp, int nM, int nN_) { x = tp.x; r = tp.r; n = tp.n; nN = nN_; cx = nM > x ? (nM - x + 7) >> 3 : 0; fullq = cx >> 2; total = cx * nN; }
    DEV bool next(int i, pg8::Unit& u) const {
        const int q = r + i * n; if (q >= total) return false;
        const int per = 4 * nN;
        if (q < fullq * per) { const int qi = q / per, rem = q - qi * per; u.pn = rem >> 2; u.pm = x + 8 * (4 * qi + (rem & 3)); }
        else { const int rem = q - fullq * per, cq = cx - 4 * fullq; u.pn = rem / cq; u.pm = x + 8 * (4 * fullq + rem % cq); }
        return true;
    }
    DEV void a_ready(const pg8::Unit&) const {}
    DEV void done(const pg8::Unit&) const {}
};
template <class F> DEV void gemm256_pair(const bf16_t* A, int M, const bf16_t* Bt, int N, int K, char* smem, const Topo& tp, F f) {
    const pg8::Gemm g{A, Bt, M, N, K};
    const XOrder S(tp, M / 256, (N + 255) / 256);
    const EpiF2<F> E{f};
    pg8::gemm_phase<EpiF2<F>, XOrder, true, true>((PG8_LAS unsigned char*)smem, g, S, E);
}
template <class F> DEV void gemm256(const bf16_t* A, int M, const bf16_t* Bt, int N, int K, char* smem, const Topo& tp, F f) {
    const pg8::Gemm g{A, Bt, M, N, K};
    const XOrder S(tp, M / 256, (N + 255) / 256);
    const EpiF<F> E{f};
    pg8::gemm_phase<EpiF<F>, XOrder, true, true>((PG8_LAS unsigned char*)smem, g, S, E);
}

DEV void ph_mod(const Params& p, int L, char* smem) {
    const int tid = TID();
    float* sc = (float*)smem;
    float* red = sc + 17 * 1024;
    const float* c = p.in[I_C]; const float* cc = p.in[I_CCTX];
    for (int i = tid; i < 17 * 1024; i += NTHREADS) { const float v = i < 16 * 1024 ? c[i] : cc[i - 16 * 1024]; sc[i] = v / (1.f + expf(-v)); }
    __syncthreads();
    const float* W = p.in[I_WADA] + (size_t)L * 1024 * 6144; const float* bA = p.in[I_BADA] + (size_t)L * 6144;
    float* MOD = (float*)(p.ws + OFF_MOD);
    for (int u = blockIdx.x; u < 192; u += gridDim.x) {
        const int ci = tid & 31, ks = tid >> 5, j = u * 32 + ci;
        float acc[17];
        UNROLL for (int r = 0; r < 17; ++r) acc[r] = 0.f;
        for (int k = ks * 64; k < ks * 64 + 64; ++k) {
            const float w = W[(size_t)k * 6144 + j];
            UNROLL for (int r = 0; r < 17; ++r) acc[r] += sc[r * 1024 + k] * w;
        }
        UNROLL for (int r = 0; r < 17; ++r) red[(ks * 17 + r) * 32 + ci] = acc[r];
        __syncthreads();
        for (int i = tid; i < 17 * 32; i += NTHREADS) {
            const int r = i >> 5, c2 = i & 31; float s = bA[u * 32 + c2];
            for (int k2 = 0; k2 < 16; ++k2) s += red[(k2 * 17 + r) * 32 + c2];
            MOD[r * 6144 + u * 32 + c2] = s;
        }
        __syncthreads();
    }
}
DEV void conv_job(const float* s0, const float* s1, bf16_t* d, int K, int N, int mode, int nmat, size_t sstride, size_t dstride, char* smem, int bid = -1, int nb = 0) {
    if (bid < 0) { bid = blockIdx.x; nb = gridDim.x; }
    float* tile = (float*)smem;
    const int tid = TID();
    const int tK = K / 64, tN = (mode == 1 || mode == 3) ? (2 * N) / 64 : (N + 63) / 64, per = tK * tN;
    for (int t = bid; t < per * nmat; t += nb) {
        const int mat = t / per, r = t % per, tk = r / tN, tn = r % tN;
        const float* a0 = s0 + (size_t)mat * sstride; const float* a1 = s1 ? s1 + (size_t)mat * sstride : nullptr;
        bf16_t* dd = d + (size_t)mat * dstride;
        UNROLL for (int i = 0; i < 8; ++i) {
            const int cc = tid & 63, k = (tid >> 6) + 8 * i; float v;
            if (mode == 1) { const float* s = (cc >> 5) ? a1 : a0; v = s[(size_t)(tk * 64 + k) * N + tn * 32 + (cc & 31)]; }
            else if (mode == 3) { const float* s = ((tn >> 1) & 1) ? a1 : a0; v = s[(size_t)(tk * 64 + k) * N + (tn >> 2) * 128 + (tn & 1) * 64 + cc]; }
            else { const int n = tn * 64 + cc; v = n < N ? a0[(size_t)(tk * 64 + k) * N + n] : 0.f; }
            tile[k * 65 + cc] = v;
        }
        __syncthreads();
        UNROLL for (int i = 0; i < 8; ++i) {
            const int k = tid & 63, cc = (tid >> 6) + 8 * i; const int row = tn * 64 + cc;
            const float v = tile[k * 65 + cc];
            if (mode == 1 || mode == 3 || row < N) {
                const bf16_t hi = f2bf(v);
                dd[(size_t)row * K + tk * 64 + k] = hi;
                if (mode == 2) dd[(size_t)N * K + (size_t)row * K + tk * 64 + k] = f2bf(v - bf2f(hi));
            }
        }
        __syncthreads();
    }
}
DEV void ph_conv_mix(const Params& p, int L, char* smem) {
    char* ws = p.ws;
    conv_job(p.in[I_WIN] + (size_t)L * 1024 * IN_COLS, nullptr, (bf16_t*)(ws + OFF_WINT), 1024, IN_COLS, 0, 1, 0, 0, smem);
    conv_job(p.in[I_WBR] + (size_t)L * 3 * 512 * 1024, nullptr, (bf16_t*)(ws + OFF_WBT), 512, 1024, 0, 3, (size_t)512 * 1024, (size_t)512 * 1024, smem);
    conv_job(p.in[I_WOUT] + (size_t)L * 1024 * 1024, nullptr, (bf16_t*)(ws + OFF_WOUTT), 1024, 1024, 0, 1, 0, 0, smem);
    conv_job(p.in[I_SG] + (size_t)L * 1024 * 256, p.in[I_SU] + (size_t)L * 1024 * 256, (bf16_t*)(ws + OFF_SGUT), 1024, 256, 3, 1, 0, 0, smem);
    conv_job(p.in[I_SD] + (size_t)L * 256 * 1024, nullptr, (bf16_t*)(ws + OFF_SDT), 256, 1024, 0, 1, 0, 0, smem);
    conv_job(p.in[I_G2] + (size_t)L * 128 * 512, nullptr, (bf16_t*)(ws + OFF_G2T), 128, 512, 0, 1, 0, 0, smem);
    conv_job(p.in[I_RTR] + (size_t)L * 1024 * 64, nullptr, (bf16_t*)(ws + OFF_RTR), 1024, 64, 2, 1, 0, 0, smem);
}
DEV void ph_conv_moe_gu(const Params& p, int L, char* smem, int bid, int nb) {
    const size_t eo = (size_t)L * 64 * 1024 * 128;
    conv_job(p.in[I_MWG] + eo, p.in[I_MWU] + eo, (bf16_t*)(p.ws + OFF_MGU), 1024, 128, 1, 64, (size_t)1024 * 128, (size_t)256 * 1024, smem, bid, nb);
}
DEV void ph_conv_moe(const Params& p, int L, char* smem, int bid, int nb) {
    const size_t eo = (size_t)L * 64 * 1024 * 128;
    conv_job(p.in[I_MWD] + eo, nullptr, (bf16_t*)(p.ws + OFF_MDT), 128, 1024, 0, 64, (size_t)128 * 1024, (size_t)1024 * 128, smem, bid, nb);
}

DEV void ph_norm(const Params& p, int L, int which, int ntok) {
    const int lane = TID() & 63, wave = TID() >> 6;
    const float* MOD = (const float*)(p.ws + OFF_MOD);
    const float* g = p.in[which ? I_N2G : I_N1G] + (size_t)L * DM;
    bf16_t* H = (bf16_t*)(p.ws + OFF_HX); bf16_t* HLO = (bf16_t*)(p.ws + OFF_H2LO);
    for (int n0 = blockIdx.x * 8; n0 < ntok; n0 += gridDim.x * 8) {
        const int n = n0 + wave;
        const float* xr = which ? xs_row(p, n) : xprev_row(p, L, n);
        float4 v[4]; float ss = 0.f;
        UNROLL for (int i = 0; i < 4; ++i) { v[i] = *(const float4*)(xr + i * 256 + lane * 4); ss += v[i].x * v[i].x + v[i].y * v[i].y + v[i].z * v[i].z + v[i].w * v[i].w; }
        UNROLL for (int o = 1; o < 64; o <<= 1) ss += __shfl_xor(ss, o);
        const float rstd = rsqrtf(ss * (1.f / DM) + 1e-6f);
        const float* sh = MOD + mod_row(n) * 6144 + (which ? 3 : 0) * DM; const float* sc = sh + DM;
        UNROLL for (int i = 0; i < 4; ++i) {
            const int c = i * 256 + lane * 4;
            const float4 gg = *(const float4*)(g + c), s1 = *(const float4*)(sc + c), s0 = *(const float4*)(sh + c);
            const float h0 = v[i].x * rstd * gg.x * (1.f + s1.x) + s0.x, h1 = v[i].y * rstd * gg.y * (1.f + s1.y) + s0.y;
            const float h2 = v[i].z * rstd * gg.z * (1.f + s1.z) + s0.z, h3 = v[i].w * rstd * gg.w * (1.f + s1.w) + s0.w;
            u32x2 o; o.x = pk2(h0, h1); o.y = pk2(h2, h3);
            *(u32x2*)(H + (size_t)n * DM + c) = o;
            if (which) {
                u32x2 o2;
                o2.x = pk2(h0 - bf2f((bf16_t)(o.x & 0xffff)), h1 - bf2f((bf16_t)(o.x >> 16)));
                o2.y = pk2(h2 - bf2f((bf16_t)(o.y & 0xffff)), h3 - bf2f((bf16_t)(o.y >> 16)));
                *(u32x2*)(HLO + (size_t)n * DM + c) = o2;
            }
        }
    }
}

DEV void ph_rw_prep(const Params& p, int L, char* smem) {
    const int lane = TID() & 63, wave = TID() >> 6;
    float* vsh = (float*)smem + wave * 512;
    const bf16_t* PXR = (const bf16_t*)(p.ws + OFF_PX); bf16_t* VF = (bf16_t*)(p.ws + OFF_VF);
    const float* mu = p.in[I_MU] + (size_t)L * RW_COLS;
    const float* v0 = p.in[I_V0]; const float* v1 = p.in[I_V1]; const float* v2 = p.in[I_V2];
    for (int n0 = blockIdx.x * 8; n0 < NT; n0 += gridDim.x * 8) {
        const int n = n0 + wave; int nb, tt, T; seq_of(n, nb, tt, T);
        float vs[8]; shift8(PXR, RW_COLS, nb, tt, T, 1024 + lane * 8, mu, vs);
        if (L == 0) { st8(VF + (size_t)n * 512 + lane * 8, vs); }
        else {
            UNROLL for (int i = 0; i < 8; ++i) vsh[lane * 8 + i] = vs[i];
            __syncthreads();
            const int q = lane & 31, hf = lane >> 5; float t1 = 0.f;
            for (int jj = 0; jj < 256; ++jj) t1 += vsh[hf * 256 + jj] * v1[(hf * 256 + jj) * 32 + q];
            t1 += __shfl_xor(t1, 32);
            float u[8];
            UNROLL for (int i = 0; i < 8; ++i) u[i] = v0[lane * 8 + i];
            for (int q2 = 0; q2 < 32; ++q2) { const float tq = __shfl(t1, q2); UNROLL for (int i = 0; i < 8; ++i) u[i] += tq * v2[q2 * 512 + lane * 8 + i]; }
            float vf[8], o[8]; ld8(VF + (size_t)n * 512 + lane * 8, vf);
            UNROLL for (int i = 0; i < 8; ++i) o[i] = vs[i] + (vf[i] - vs[i]) * sigm(u[i]);
            st8(VF + (size_t)n * 512 + lane * 8, o);
            __syncthreads();
        }
    }
}

DEV bf16x8 pk_lohi(u32x2 lo, u32x2 hi) { u32x4 w; w.x = lo.x; w.y = lo.y; w.z = hi.x; w.w = hi.y; return __builtin_bit_cast(bf16x8, w); }
DEV bf16x8 pk_acc2(const f32x4v& a, const f32x4v& b) { u32x4 w; w.x = pk2(a[0], a[1]); w.y = pk2(a[2], a[3]); w.z = pk2(b[0], b[1]); w.w = pk2(b[2], b[3]); return __builtin_bit_cast(bf16x8, w); }
DEV bf16x8 pk_acc1(const f32x4v& a) { u32x4 w; w.x = pk2(a[0], a[1]); w.y = pk2(a[2], a[3]); w.z = 0u; w.w = 0u; return __builtin_bit_cast(bf16x8, w); }
#define MFMA16(a, b, c) __builtin_amdgcn_mfma_f32_16x16x32_bf16((a), (b), (c), 0, 0, 0)
struct Raw3 { u32x4 l, c, r; };
DEV Raw3 rw_raw(const bf16_t* z, int ld, int nb, int tt, int T, int col0) {
    Raw3 o;
    o.c = *(const u32x4*)(z + (size_t)(nb + tt) * ld + col0);
    o.l = *(const u32x4*)(z + (size_t)(nb + max(tt - 1, 0)) * ld + col0);
    o.r = *(const u32x4*)(z + (size_t)(nb + min(tt + 1, T - 1)) * ld + col0);
    return o;
}
DEV void unpack8(u32x4 v, float (&o)[8]) {
    o[0] = __uint_as_float(v.x << 16); o[1] = __uint_as_float(v.x & 0xffff0000u); o[2] = __uint_as_float(v.y << 16); o[3] = __uint_as_float(v.y & 0xffff0000u);
    o[4] = __uint_as_float(v.z << 16); o[5] = __uint_as_float(v.z & 0xffff0000u); o[6] = __uint_as_float(v.w << 16); o[7] = __uint_as_float(v.w & 0xffff0000u);
}
DEV void shift_from_raw(const Raw3& w, int tt, int T, const float* mu8, float (&o)[8]) {
    float c[8], l[8], r[8]; unpack8(w.c, c); unpack8(w.l, l); unpack8(w.r, r);
    const float ml = tt > 0 ? 0.5f : 0.f, mr = tt < T - 1 ? 0.5f : 0.f;
    UNROLL for (int i = 0; i < 8; ++i) o[i] = c[i] + mu8[i] * (ml * l[i] + mr * r[i] - c[i]);
}
DEV void ph_rw_scan(const Params& p, int L, char* smem) {
    const int tid = TID();
    const int wave = __builtin_amdgcn_readfirstlane(tid >> 6);
    char* AT = smem; char* BT = smem + 9216; char* KT = smem + 18432; char* RT = smem + 27648;
    char* BH = smem + 36864; char* KH = smem + 46080; char* VT = smem + 55296;
    char* W2T = smem + 64512; char* A2T = smem + 73728;
    float* PCv = (float*)(smem + 82944); float* SEGT = PCv + 64;
    char* XY = smem + 85248;
    char* T1 = XY; char* T2 = XY + 9216; float* WLf = (float*)(XY + 18432); float* ALf = (float*)(XY + 35840); float* LW = (float*)(XY + 53248);
    char* NAB = XY; char* NAK = XY + 9216; char* NRB = XY + 18432; char* NRK = XY + 27648; char* TJ = XY + 36864; float* NDF = (float*)(XY + 38912); float* YO = (float*)(XY + 43008);
    const bf16_t* PXR = (const bf16_t*)(p.ws + OFF_PX); const bf16_t* VF = (const bf16_t*)(p.ws + OFF_VF);
    bf16_t* YS = (bf16_t*)(p.ws + OFF_YS); float* CB = (float*)(p.ws + OFF_CB);
    const float* mu = p.in[I_MU] + (size_t)L * RW_COLS;
    const float* w0 = p.in[I_W0] + (size_t)L * 1024; const float* w2 = p.in[I_W2] + (size_t)L * 65536;
    const float* a0 = p.in[I_A0] + (size_t)L * 1024; const float* a2 = p.in[I_A2] + (size_t)L * 65536;
    const float* kkw = p.in[I_KK] + (size_t)L * 512; const float* kaw = p.in[I_KA] + (size_t)L * 512; const float* rkw = p.in[I_RK] + (size_t)L * 512;
    for (int u = blockIdx.x; u < 256; u += gridDim.x) {
        const int b = u >> 4, h = (u >> 1) & 7, d = u & 1;
        for (int i = tid; i < 4096; i += NTHREADS) {
            const int l = i >> 6, n = i & 63;
            *(bf16_t*)(W2T + n * LROW + l * 2) = f2bf(w2[(size_t)(d * 64 + l) * 512 + h * 64 + n]);
            *(bf16_t*)(A2T + n * LROW + l * 2) = f2bf(a2[(size_t)(d * 64 + l) * 512 + h * 64 + n]);
        }
        f32x4v sacc[4];
        UNROLL for (int i = 0; i < 4; ++i) sacc[i] = (f32x4v){0.f, 0.f, 0.f, 0.f};
        __syncthreads();
        Raw3 pw1, pw2, pr, pk; u32x4 pv;
#define RW_GEOM(ci_, tido_) const bool isc = (ci_) < 4; const int T = isc ? CTXL : SEQ, cc = isc ? (ci_) : (ci_) - 4; \
            const int t0 = d == 0 ? cc * 64 : T - 64 * (cc + 1), nb = isc ? NX + b * CTXL : b * SEQ; \
            const int tt = d == 0 ? t0 + ((tido_) >> 3) : t0 + 63 - ((tido_) >> 3);
#define RW_PREFETCH(ci_, tido_) do { RW_GEOM(ci_, tido_) const int j_ = (tido_) & 7; \
            pw1 = rw_raw(PXR, RW_COLS, nb, tt, T, 1536 + d * 64 + 8 * j_); pw2 = rw_raw(PXR, RW_COLS, nb, tt, T, 1664 + d * 64 + 8 * j_); \
            pr = rw_raw(PXR, RW_COLS, nb, tt, T, h * 64 + 8 * j_); pk = rw_raw(PXR, RW_COLS, nb, tt, T, 512 + h * 64 + 8 * j_); \
            pv = *(const u32x4*)(VF + (size_t)(nb + tt) * 512 + h * 64 + 8 * j_); } while (0)
        RW_PREFETCH(0, tid);
        for (int ci = 0; ci < 36; ++ci) {
            int tido = tid; asm volatile("" : "+v"(tido));
            const int lane = tido & 63, lq = lane & 15, kg = lane >> 4, ti = tido >> 3, j = tido & 7;
            const int ch = h * 64 + 8 * j;
            RW_GEOM(ci, tido)
            float r8[8], k8[8], v8[8];
            {
                float x1[8], x2[8];
                shift_from_raw(pw1, tt, T, mu + 1536 + d * 64 + 8 * j, x1);
                shift_from_raw(pw2, tt, T, mu + 1664 + d * 64 + 8 * j, x2);
                UNROLL for (int i = 0; i < 8; ++i) x1[i] = tanh_fast(x1[i]);
                st8((bf16_t*)(T1 + ti * LROW) + 8 * j, x1); st8((bf16_t*)(T2 + ti * LROW) + 8 * j, x2);
                shift_from_raw(pr, tt, T, mu + h * 64 + 8 * j, r8);
                shift_from_raw(pk, tt, T, mu + 512 + h * 64 + 8 * j, k8);
                unpack8(pv, v8);
            }
            __syncthreads();
            _Pragma("unroll 1") for (int rep = 0; rep < 4; ++rep) {
                const int q = wave + 8 * rep, m = q >> 4, tl = q & 15, tt4 = tl >> 2, nt4 = tl & 3;
                const char* Ab = (m ? T2 : T1) + (16 * tt4 + lq) * LROW + kg * 16; const char* Bb = (m ? A2T : W2T) + (16 * nt4 + lq) * LROW + kg * 16;
                f32x4v a = {0.f, 0.f, 0.f, 0.f};
                UNROLL for (int ks = 0; ks < 2; ++ks) a = MFMA16(*(const bf16x8*)(Ab + ks * 64), *(const bf16x8*)(Bb + ks * 64), a);
                float* dst = (m ? ALf : WLf) + (16 * tt4 + 4 * kg) * 68 + 16 * nt4 + lq;
                UNROLL for (int i = 0; i < 4; ++i) dst[i * 68] = a[i];
            }
            __syncthreads();
            float av[8], bv[8], kd8[8];
            {
                const float4 wa = *(const float4*)(WLf + ti * 68 + 8 * j), wb = *(const float4*)(WLf + ti * 68 + 8 * j + 4);
                const float4 aa = *(const float4*)(ALf + ti * 68 + 8 * j), ab = *(const float4*)(ALf + ti * 68 + 8 * j + 4);
                const float wl[8] = {wa.x, wa.y, wa.z, wa.w, wb.x, wb.y, wb.z, wb.w}, al[8] = {aa.x, aa.y, aa.z, aa.w, ab.x, ab.y, ab.z, ab.w};
                float ss = 0.f, cbp = 0.f, alpha[8], kkr[8], lw[8];
                UNROLL for (int i = 0; i < 8; ++i) {
                    const float xw = -(w0[d * 512 + ch + i] + wl[i]);
                    const float sp = softplus_fast(xw);
                    lw[i] = -__expf(-sp - 0.5f);
                    alpha[i] = sigm(a0[d * 512 + ch + i] + al[i]);
                    kkr[i] = k8[i] * kkw[ch + i]; ss += kkr[i] * kkr[i];
                    kd8[i] = k8[i] * (1.f + (alpha[i] - 1.f) * kaw[ch + i]);
                    cbp += r8[i] * kd8[i] * rkw[ch + i];
                }
                ss = sum8(ss); cbp = sum8(cbp);
                const float inv = frcp(fmaxf(__builtin_amdgcn_sqrtf(ss), 1e-12f));
                UNROLL for (int i = 0; i < 8; ++i) { const float kk = kkr[i] * inv; av[i] = -kk; bv[i] = kk * alpha[i]; }
                *(float4*)(LW + ti * 64 + 8 * j) = make_float4(lw[0], lw[1], lw[2], lw[3]); *(float4*)(LW + ti * 64 + 8 * j + 4) = make_float4(lw[4], lw[5], lw[6], lw[7]);
                if (j == 0) CB[((size_t)d * NT + nb + tt) * 8 + h] = cbp;
            }
            __syncthreads();
            {
                const int n = tid & 63, seg = tid >> 6; float run = 0.f;
                UNROLL for (int r = 0; r < 8; ++r) { run += LW[(seg * 8 + r) * 64 + n]; LW[(seg * 8 + r) * 64 + n] = run; }
                SEGT[seg * 64 + n] = run;
            }
            __syncthreads();
            {
                const int seg = ti >> 3;
                float off[8], tot[8];
                UNROLL for (int i = 0; i < 8; ++i) { off[i] = 0.f; tot[i] = 0.f; }
                UNROLL for (int s2 = 0; s2 < 8; ++s2) {
                    const float4 sa = *(const float4*)(SEGT + s2 * 64 + 8 * j), sb2 = *(const float4*)(SEGT + s2 * 64 + 8 * j + 4);
                    const float sv[8] = {sa.x, sa.y, sa.z, sa.w, sb2.x, sb2.y, sb2.z, sb2.w};
                    UNROLL for (int i = 0; i < 8; ++i) { tot[i] += sv[i]; if (s2 < seg) off[i] += sv[i]; }
                }
                const float4 la = *(const float4*)(LW + ti * 64 + 8 * j), lb = *(const float4*)(LW + ti * 64 + 8 * j + 4);
                const float lpl[8] = {la.x, la.y, la.z, la.w, lb.x, lb.y, lb.z, lb.w};
                float lpm[8];
                if ((ti & 7) != 0) {
                    const float4 ma = *(const float4*)(LW + (ti - 1) * 64 + 8 * j), mb = *(const float4*)(LW + (ti - 1) * 64 + 8 * j + 4);
                    lpm[0] = ma.x; lpm[1] = ma.y; lpm[2] = ma.z; lpm[3] = ma.w; lpm[4] = mb.x; lpm[5] = mb.y; lpm[6] = mb.z; lpm[7] = mb.w;
                } else { UNROLL for (int i = 0; i < 8; ++i) lpm[i] = 0.f; }
                float oa[8], ob[8], ok[8], orr[8];
                UNROLL for (int i = 0; i < 8; ++i) {
                    const float lp = lpl[i] + off[i], lm = lpm[i] + off[i];
                    const float eP = __expf(lp), eM = __expf(-lp), ePm = __expf(lm), eE = __expf(tot[i] - lp);
                    oa[i] = av[i] * ePm; ob[i] = bv[i] * eM; ok[i] = kd8[i] * eM; orr[i] = r8[i] * eP;
                    *(bf16_t*)(BH + (8 * j + i) * LROW + ti * 2) = f2bf(bv[i] * eE);
                    *(bf16_t*)(KH + (8 * j + i) * LROW + ti * 2) = f2bf(kd8[i] * eE);
                    *(bf16_t*)(VT + (8 * j + i) * LROW + ti * 2) = f2bf(v8[i]);
                    if (ti == 0) PCv[8 * j + i] = __expf(tot[i]);
                }
                st8((bf16_t*)(AT + ti * LROW) + 8 * j, oa); st8((bf16_t*)(BT + ti * LROW) + 8 * j, ob);
                st8((bf16_t*)(KT + ti * LROW) + 8 * j, ok); st8((bf16_t*)(RT + ti * LROW) + 8 * j, orr);
            }
            __syncthreads();
            if (ci + 1 < 36) RW_PREFETCH(ci + 1, tido);
            _Pragma("unroll 1") for (int rep = 0; rep < 6; ++rep) {
                const int q = wave + 8 * rep, m = q / 12, tl = q - 12 * m;
                const int tt4 = tl >= 10 ? 2 * (tl - 10) : tl < 1 ? 0 : tl < 3 ? 1 : tl < 6 ? 2 : 3, st4 = tl >= 10 ? tt4 + 1 : tl - (tt4 * (tt4 + 1)) / 2;
                char* dstm = m == 0 ? NAB : m == 1 ? NAK : m == 2 ? NRB : NRK;
                f32x4v a = {0.f, 0.f, 0.f, 0.f};
                if (st4 <= tt4) {
                    const char* Ab = (m < 2 ? AT : RT) + (16 * tt4 + lq) * LROW + kg * 16; const char* Bb = ((m & 1) ? KT : BT) + (16 * st4 + lq) * LROW + kg * 16;
                    UNROLL for (int ks = 0; ks < 2; ++ks) a = MFMA16(*(const bf16x8*)(Ab + ks * 64), *(const bf16x8*)(Bb + ks * 64), a);
                }
                const int sidx = 16 * st4 + lq;
                UNROLL for (int i = 0; i < 4; ++i) {
                    const int tidx = 16 * tt4 + 4 * kg + i;
                    const bool keep = m < 2 ? sidx < tidx : sidx <= tidx;
                    const float val = keep ? a[i] : 0.f;
                    *(bf16_t*)(dstm + tidx * LROW + sidx * 2) = f2bf(val);
                    if (m == 0 && st4 == tt4) NDF[(tt4 * 16 + 4 * kg + i) * 16 + lq] = val;
                }
            }
            __syncthreads();
            f32x4v xacc[4], yacc[4];
            bf16x8 vt[2];
            if (wave == 7) {
                const int blk = lane >> 4, c = lane & 15;
                float Tc[16];
                UNROLL for (int t = 0; t < 16; ++t) {
                    float a = t == c ? 1.f : 0.f;
                    UNROLL for (int s2 = 0; s2 < t; ++s2) a += NDF[(blk * 16 + t) * 16 + s2] * Tc[s2];
                    Tc[t] = a;
                }
                UNROLL for (int t = 0; t < 16; ++t) *(bf16_t*)(TJ + (blk * 16 + t) * 32 + c * 2) = f2bf(Tc[t]);
            } else if (wave < 4) {
                bf16x8 sb[2];
                UNROLL for (int kk = 0; kk < 2; ++kk) { sb[kk] = pk_acc2(sacc[2 * kk], sacc[2 * kk + 1]); vt[kk] = *(const bf16x8*)(VT + (16 * wave + lq) * LROW + kk * 64 + kg * 16); }
                UNROLL for (int t4 = 0; t4 < 4; ++t4) {
                    f32x4v x = {0.f, 0.f, 0.f, 0.f}, y = {0.f, 0.f, 0.f, 0.f};
                    UNROLL for (int kk = 0; kk < 2; ++kk) {
                        const char* pa = AT + (16 * t4 + lq) * LROW + (32 * kk + 4 * kg) * 2; const char* pr = RT + (16 * t4 + lq) * LROW + (32 * kk + 4 * kg) * 2;
                        x = MFMA16(pk_lohi(*(const u32x2*)pa, *(const u32x2*)(pa + 32)), sb[kk], x);
                        y = MFMA16(pk_lohi(*(const u32x2*)pr, *(const u32x2*)(pr + 32)), sb[kk], y);
                        if (2 * kk <= t4) {
                            x = MFMA16(*(const bf16x8*)(NAK + (16 * t4 + lq) * LROW + kk * 64 + kg * 16), vt[kk], x);
                            y = MFMA16(*(const bf16x8*)(NRK + (16 * t4 + lq) * LROW + kk * 64 + kg * 16), vt[kk], y);
                        }
                    }
                    xacc[t4] = x; yacc[t4] = y;
                }
            }
            __syncthreads();
            if (wave < 4) {
                const u32x2 z2 = {0u, 0u};
                f32x4v uacc[4];
                {
                    const u32x2 t0v = *(const u32x2*)(TJ + (0 * 16 + lq) * 32 + 4 * kg * 2);
                    uacc[0] = MFMA16(pk_lohi(t0v, z2), pk_acc1(xacc[0]), ((f32x4v){0.f, 0.f, 0.f, 0.f}));
                }
                UNROLL for (int jb = 1; jb < 4; ++jb) {
                    f32x4v z = xacc[jb];
                    const char* nr = NAB + (16 * jb + lq) * LROW + 4 * kg * 2;
                    if (jb == 1) z = MFMA16(pk_lohi(*(const u32x2*)nr, z2), pk_acc1(uacc[0]), z);
                    else {
                        z = MFMA16(pk_lohi(*(const u32x2*)nr, *(const u32x2*)(nr + 32)), pk_acc2(uacc[0], uacc[1]), z);
                        if (jb == 3) z = MFMA16(pk_lohi(*(const u32x2*)(nr + 64), z2), pk_acc1(uacc[2]), z);
                    }
                    const u32x2 tv = *(const u32x2*)(TJ + (jb * 16 + lq) * 32 + 4 * kg * 2);
                    uacc[jb] = MFMA16(pk_lohi(tv, z2), pk_acc1(z), ((f32x4v){0.f, 0.f, 0.f, 0.f}));
                }
                bf16x8 ub[2]; ub[0] = pk_acc2(uacc[0], uacc[1]); ub[1] = pk_acc2(uacc[2], uacc[3]);
                UNROLL for (int t4 = 0; t4 < 4; ++t4) {
                    f32x4v y = yacc[t4];
                    UNROLL for (int kk = 0; kk < 2; ++kk) if (2 * kk <= t4) {
                        const char* pn = NRB + (16 * t4 + lq) * LROW + (32 * kk + 4 * kg) * 2;
                        y = MFMA16(pk_lohi(*(const u32x2*)pn, *(const u32x2*)(pn + 32)), ub[kk], y);
                    }
                    UNROLL for (int i = 0; i < 4; ++i) YO[(16 * t4 + 4 * kg + i) * 68 + 16 * wave + lq] = y[i];
                }
                UNROLL for (int kt = 0; kt < 4; ++kt) {
                    f32x4v sv = sacc[kt];
                    UNROLL for (int i = 0; i < 4; ++i) sv[i] *= PCv[16 * kt + 4 * kg + i];
                    UNROLL for (int kk = 0; kk < 2; ++kk) {
                        const char* pb = BH + (16 * kt + lq) * LROW + (32 * kk + 4 * kg) * 2;
                        sv = MFMA16(pk_lohi(*(const u32x2*)pb, *(const u32x2*)(pb + 32)), ub[kk], sv);
                        sv = MFMA16(*(const bf16x8*)(KH + (16 * kt + lq) * LROW + kk * 64 + kg * 16), vt[kk], sv);
                    }
                    sacc[kt] = sv;
                }
            }
            __syncthreads();
            {
                const float4 ya = *(const float4*)(YO + ti * 68 + 8 * j), yb = *(const float4*)(YO + ti * 68 + 8 * j + 4);
                const float y8[8] = {ya.x, ya.y, ya.z, ya.w, yb.x, yb.y, yb.z, yb.w};
                st8(YS + ((size_t)d * NT + nb + tt) * 512 + ch, y8);
            }
            __syncthreads();
        }
    }
}

DEV void ph_rw_read(const Params& p, int L, int ntok) {
    const int lane = TID() & 63, wave = TID() >> 6;
    const bf16_t* PXR = (const bf16_t*)(p.ws + OFF_PX); const bf16_t* VF = (const bf16_t*)(p.ws + OFF_VF);
    const bf16_t* YS = (const bf16_t*)(p.ws + OFF_YS); const float* CB = (const float*)(p.ws + OFF_CB);
    bf16_t* YA = (bf16_t*)(p.ws + OFF_YA); bf16_t* SG = (bf16_t*)(p.ws + OFF_SGB);
    const float* mu = p.in[I_MU] + (size_t)L * RW_COLS;
    const float* lg = p.in[I_LNG] + (size_t)L * 512; const float* lb = p.in[I_LNB] + (size_t)L * 512;
    for (int n0 = blockIdx.x * 8; n0 < ntok; n0 += gridDim.x * 8) {
        const int n = n0 + wave, c = lane * 8, h = lane >> 3;
        float y0[8], y1[8], v8[8], o[8];
        ld8(YS + (size_t)n * 512 + c, y0); ld8(YS + ((size_t)NT + n) * 512 + c, y1); ld8(VF + (size_t)n * 512 + c, v8);
        float s = 0.f;
        UNROLL for (int i = 0; i < 8; ++i) { y0[i] += y1[i]; s += y0[i]; }
        s += __shfl_xor(s, 1); s += __shfl_xor(s, 2); s += __shfl_xor(s, 4);
        const float mean = s * (1.f / 64.f); float q = 0.f;
        UNROLL for (int i = 0; i < 8; ++i) { const float dd = y0[i] - mean; q += dd * dd; }
        q += __shfl_xor(q, 1); q += __shfl_xor(q, 2); q += __shfl_xor(q, 4);
        const float rstd = rsqrtf(q * (1.f / 64.f) + 64e-5f);
        const float bon = CB[(size_t)n * 8 + h] + CB[((size_t)NT + n) * 8 + h];
        UNROLL for (int i = 0; i < 8; ++i) o[i] = (y0[i] - mean) * rstd * lg[c + i] + lb[c + i] + bon * v8[i];
        st8(YA + (size_t)n * 512 + c, o);
        if (lane < 16) {
            int nb, tt, T; seq_of(n, nb, tt, T);
            float g8[8]; shift8(PXR, RW_COLS, nb, tt, T, 1792 + lane * 8, mu, g8);
            UNROLL for (int i = 0; i < 8; ++i) g8[i] = sigm(g8[i]);
            st8(SG + (size_t)n * 128 + lane * 8, g8);
        }
    }
}

DEV void ph_na_norm(const Params& p, int L) {
    const int lane = TID() & 63, wave = TID() >> 6;
    bf16_t* PXN = (bf16_t*)(p.ws + OFF_PX);
    const float* qg = p.in[I_QNG] + (size_t)L * 64; const float* kg = p.in[I_KNG] + (size_t)L * 64;
    for (int n0 = blockIdx.x * 8; n0 < NT; n0 += gridDim.x * 8) {
        const int n = n0 + wave, c = lane * 8;
        UNROLL for (int w = 0; w < 2; ++w) {
            bf16_t* ptr = PXN + (size_t)n * 1024 + w * 512 + c;
            float x[8]; ld8(ptr, x);
            float ss = 0.f;
            UNROLL for (int i = 0; i < 8; ++i) ss += x[i] * x[i];
            ss += __shfl_xor(ss, 1); ss += __shfl_xor(ss, 2); ss += __shfl_xor(ss, 4);
            const float r = rsqrtf(ss * (1.f / 64.f) + 1e-6f) * (w == 0 ? 0.125f : 1.f);
            const float* g = w == 0 ? qg : kg;
            UNROLL for (int i = 0; i < 8; ++i) x[i] = x[i] * r * g[(c + i) & 63];
            st8(ptr, x);
        }
    }
}

DEV void knorm8(float (&x)[8], const float* g) {
    float ss = 0.f;
    UNROLL for (int i = 0; i < 8; ++i) ss += x[i] * x[i];
    ss = sum8(ss);
    const float r = rsqrtf(ss * (1.f / 64.f) + 1e-6f);
    UNROLL for (int i = 0; i < 8; ++i) x[i] = x[i] * r * g[i];
}
DEV void ph_na_att(const Params& p, int L, char* smem) {
    const int tid0 = TID();
    const int wave = __builtin_amdgcn_readfirstlane(tid0 >> 6);
    char* KL = smem;
    char* KC = smem + 576 * LROW;
    char* VL = smem;
    char* VC = smem + 64 * 1168;
    float* OX = (float*)(smem + 119808);
    float* RP = OX + 8 * 1024;
    const bf16_t* PXN = (const bf16_t*)(p.ws + OFF_PX); bf16_t* YB = (bf16_t*)(p.ws + OFF_YB);
    const bf16_t* VT = (const bf16_t*)(p.ws + OFF_VT); const bf16_t* VTC = (const bf16_t*)(p.ws + OFF_VTC);
    const float* qgn = p.in[I_QNG] + (size_t)L * 64; const float* kgn = p.in[I_KNG] + (size_t)L * 64;
    const int nunits = 2048 + (L == 0 ? 256 : 0);
    for (int u = blockIdx.x; u < nunits; u += gridDim.x) {
        int tid = tid0; asm volatile("" : "+v"(tid));
        const int lane = tid & 63, lq = lane & 15, kg = lane >> 4;
        const bool cu = u >= 2048;
        int b, h, rp = 0, rs0 = 0, g = 0;
        if (!cu) { h = u & 7; rp = (u >> 3) & 15; b = u >> 7; rs0 = min(max(2 * rp - 4, 0), 24); }
        else { const int v = u - 2048; h = v & 7; g = (v >> 3) & 1; b = v >> 4; }
        const int ctx0 = NX + b * CTXL;
        if (!cu) {
            UNROLL for (int i = 0; i < 9; ++i) {
                const int c = tid + NTHREADS * i, kx = c >> 3, part = c & 7;
                const int tok = b * SEQ + min(rs0 + (kx >> 6), 31) * 64 + (kx & 63);
                float kv[8]; ld8(PXN + (size_t)tok * 1024 + 512 + h * 64 + part * 8, kv); knorm8(kv, kgn + part * 8);
                st8((bf16_t*)(KL + kx * LROW + part * 16), kv);
            }
            for (int i = tid; i < 15 * 31; i += NTHREADS) RP[i] = p.in[I_RPB][((size_t)L * 8 + h) * 465 + i];
        }
        UNROLL for (int i = 0; i < 4; ++i) {
            const int c = tid + NTHREADS * i, kx = c >> 3, part = c & 7;
            float kv[8]; ld8(PXN + (size_t)(ctx0 + kx) * 1024 + 512 + h * 64 + part * 8, kv); knorm8(kv, kgn + part * 8);
            st8((bf16_t*)(KC + kx * LROW + part * 16), kv);
        }
        const int nb = wave & 3, ri = wave >> 2, r = 2 * rp + ri;
        const int rs = min(max(r - 4, 0), 24), roff = rs - rs0;
        const int qtok0 = cu ? ctx0 + (g * 8 + wave) * 16 : b * SEQ + r * 64 + nb * 16;
        const int band0 = min(max(nb * 16 - 8, 0), 32);
        bf16x8 qf[2];
        {
            float q0[8], q1[8]; ld8(PXN + (size_t)(qtok0 + lq) * 1024 + h * 64 + kg * 8, q0); ld8(PXN + (size_t)(qtok0 + lq) * 1024 + h * 64 + 32 + kg * 8, q1);
            float ss = 0.f;
            UNROLL for (int i = 0; i < 8; ++i) ss += q0[i] * q0[i] + q1[i] * q1[i];
            ss += __shfl_xor(ss, 16); ss += __shfl_xor(ss, 32);
            const float rq = rsqrtf(ss * (1.f / 64.f) + 1e-6f) * 0.125f;
            UNROLL for (int i = 0; i < 8; ++i) { q0[i] = q0[i] * rq * qgn[kg * 8 + i]; q1[i] = q1[i] * rq * qgn[32 + kg * 8 + i]; }
            u32x4 w0, w1; w0.x = pk2(q0[0], q0[1]); w0.y = pk2(q0[2], q0[3]); w0.z = pk2(q0[4], q0[5]); w0.w = pk2(q0[6], q0[7]);
            w1.x = pk2(q1[0], q1[1]); w1.y = pk2(q1[2], q1[3]); w1.z = pk2(q1[4], q1[5]); w1.w = pk2(q1[6], q1[7]);
            qf[0] = __builtin_bit_cast(bf16x8, w0); qf[1] = __builtin_bit_cast(bf16x8, w1);
        }
        __syncthreads();
        u32x4 vraw[13];
        if (!cu) {
            UNROLL for (int i = 0; i < 9; ++i) {
                const int c = tid + NTHREADS * i, part = c & 7, kr = (c >> 3) % 9, d = (c >> 3) / 9;
                vraw[i] = *(const u32x4*)(VT + ((size_t)(b * 8 + h) * 64 + d) * SEQ + min(rs0 + kr, 31) * 64 + part * 8);
            }
        }
        UNROLL for (int i = 0; i < 4; ++i) {
            const int c = tid + NTHREADS * i, part = c & 31, d = c >> 5;
            vraw[9 + i] = *(const u32x4*)(VTC + ((size_t)(b * 8 + h) * 64 + d) * CTXL + part * 8);
        }
        f32x4v sacc[16];
        bf16x8 pfl[8], pfc[8];
        float ml = -3e38f, ll = 0.f, mc, lc;
        if (!cu) {
            const char* kb = KL + (roff * 64 + band0 + lq) * LROW + kg * 16;
            UNROLL for (int t = 0; t < 16; ++t) {
                f32x4v a = {0.f, 0.f, 0.f, 0.f};
                UNROLL for (int ks = 0; ks < 2; ++ks) a = __builtin_amdgcn_mfma_f32_16x16x32_bf16(*(const bf16x8*)(kb + ((t >> 1) * 64 + (t & 1) * 16) * LROW + ks * 64), qf[ks], a, 0, 0, 0);
                sacc[t] = a;
            }
            const int col = nb * 16 + lq, cs = min(max(col - 8, 0), 48);
            const int kc0 = band0 + 4 * kg;
            const float* rpp = RP + (rs - r + 7) * 31 + (kc0 - col + 15);
            UNROLL for (int t = 0; t < 16; ++t) UNROLL for (int i = 0; i < 4; ++i) {
                const int kc = kc0 + (t & 1) * 16 + i;
                const bool valid = kc >= cs && kc < cs + 16;
                sacc[t][i] = valid ? sacc[t][i] + rpp[(t >> 1) * 31 + (t & 1) * 16 + i] : -1e30f;
            }
            UNROLL for (int t = 0; t < 16; ++t) UNROLL for (int i = 0; i < 4; ++i) ml = fmaxf(ml, sacc[t][i]);
            ml = fmaxf(ml, __shfl_xor(ml, 16)); ml = fmaxf(ml, __shfl_xor(ml, 32));
            UNROLL for (int t = 0; t < 16; ++t) UNROLL for (int i = 0; i < 4; ++i) { const float e = __expf(sacc[t][i] - ml); sacc[t][i] = e; ll += e; }
            ll += __shfl_xor(ll, 16); ll += __shfl_xor(ll, 32);
            UNROLL for (int tp = 0; tp < 8; ++tp) pfl[tp] = pk_acc2(sacc[2 * tp], sacc[2 * tp + 1]);
        }
        {
            const char* kb = KC + lq * LROW + kg * 16;
            UNROLL for (int t = 0; t < 16; ++t) {
                f32x4v a = {0.f, 0.f, 0.f, 0.f};
                UNROLL for (int ks = 0; ks < 2; ++ks) a = __builtin_amdgcn_mfma_f32_16x16x32_bf16(*(const bf16x8*)(kb + t * 16 * LROW + ks * 64), qf[ks], a, 0, 0, 0);
                sacc[t] = a;
            }
            mc = -3e38f; lc = 0.f;
            UNROLL for (int t = 0; t < 16; ++t) UNROLL for (int i = 0; i < 4; ++i) mc = fmaxf(mc, sacc[t][i]);
            mc = fmaxf(mc, __shfl_xor(mc, 16)); mc = fmaxf(mc, __shfl_xor(mc, 32));
            UNROLL for (int t = 0; t < 16; ++t) UNROLL for (int i = 0; i < 4; ++i) { const float e = __expf(sacc[t][i] - mc); sacc[t][i] = e; lc += e; }
            lc += __shfl_xor(lc, 16); lc += __shfl_xor(lc, 32);
            UNROLL for (int tp = 0; tp < 8; ++tp) pfc[tp] = pk_acc2(sacc[2 * tp], sacc[2 * tp + 1]);
        }
        const float mm = fmaxf(ml, mc), el = cu ? 0.f : __expf(ml - mm), ec = __expf(mc - mm);
        const float inv = frcp(ll * el + lc * ec);
        const float fl = el * inv, fc = ec * inv;
        __syncthreads();
        if (!cu) {
            UNROLL for (int i = 0; i < 9; ++i) {
                const int c = tid + NTHREADS * i, part = c & 7, kr = (c >> 3) % 9, d = (c >> 3) / 9;
                *(u32x4*)(VL + d * 1168 + (kr * 64 + part * 8) * 2) = vraw[i];
            }
        }
        UNROLL for (int i = 0; i < 4; ++i) {
            const int c = tid + NTHREADS * i, part = c & 31, d = c >> 5;
            *(u32x4*)(VC + d * 528 + part * 16) = vraw[9 + i];
        }
        __syncthreads();
        f32x4v ol[4], oc[4];
        UNROLL for (int dt = 0; dt < 4; ++dt) { ol[dt] = (f32x4v){0.f, 0.f, 0.f, 0.f}; oc[dt] = (f32x4v){0.f, 0.f, 0.f, 0.f}; }
        if (!cu) {
            const char* vb = VL + lq * 1168 + (roff * 64 + band0 + 4 * kg) * 2;
            UNROLL for (int tp = 0; tp < 8; ++tp) UNROLL for (int dt = 0; dt < 4; ++dt)
                ol[dt] = __builtin_amdgcn_mfma_f32_16x16x32_bf16(pfl[tp], pk_lohi(*(const u32x2*)(vb + dt * 16 * 1168 + tp * 128), *(const u32x2*)(vb + dt * 16 * 1168 + tp * 128 + 32)), ol[dt], 0, 0, 0);
        }
        {
            const char* vb = VC + lq * 528 + 8 * kg;
            UNROLL for (int tp = 0; tp < 8; ++tp) UNROLL for (int dt = 0; dt < 4; ++dt)
                oc[dt] = __builtin_amdgcn_mfma_f32_16x16x32_bf16(pfc[tp], pk_lohi(*(const u32x2*)(vb + dt * 16 * 528 + tp * 64), *(const u32x2*)(vb + dt * 16 * 528 + tp * 64 + 32)), oc[dt], 0, 0, 0);
        }
        float* ox = OX + wave * 1024;
        UNROLL for (int i = 0; i < 4; ++i) {
            const float a = __shfl(fl, 4 * kg + i), c2 = __shfl(fc, 4 * kg + i);
            UNROLL for (int dt = 0; dt < 4; ++dt) ox[(4 * kg + i) * 64 + dt * 16 + lq] = ol[dt][i] * a + oc[dt][i] * c2;
        }
        UNROLL for (int it = 0; it < 2; ++it) {
            const int q = (lane >> 3) + 8 * it, c8 = (lane & 7) * 8;
            const float4 a = *(const float4*)(ox + q * 64 + c8), bq = *(const float4*)(ox + q * 64 + c8 + 4);
            const float v[8] = {a.x, a.y, a.z, a.w, bq.x, bq.y, bq.z, bq.w};
            st8(YB + (size_t)(qtok0 + q) * 512 + h * 64 + c8, v);
        }
        __syncthreads();
    }
}

DEV float sum16(float v) { v += DPP_MOV(v, 0xB1); v += DPP_MOV(v, 0x4E); v += DPP_MOV(v, 0x141); v += DPP_MOV(v, 0x140); return v; }
DEV void ph_ml_scan(const Params& p, int L, char* smem) {
    const int tid = TID(), lane = tid & 63, lq = lane & 15, kg = lane >> 4, ti = tid >> 3, j = tid & 7;
    const int wave = __builtin_amdgcn_readfirstlane(tid >> 6);
    char* QS = smem;
    char* QP = QS + 9216;
    char* KC = QP + 9216;
    char* KW = KC + 9216;
    char* PM = KW + 9216;
    char* VT = PM + 9216;
    float* BV = (float*)(VT + 128 * LROW);
    float* GI = BV + 64;
    float* DEN = GI + 64;
    float* NV = DEN + 64;
    float* RS = NV + 64;
    float* HO = RS + 256;
    const bf16_t* PXM = (const bf16_t*)(p.ws + OFF_PX); bf16_t* HS = (bf16_t*)(p.ws + OFF_HS);
    for (int u = blockIdx.x; u < 128; u += gridDim.x) {
        const int d = u & 1, h = (u >> 1) & 3, b = u >> 3;
        const float ib = p.in[I_IB][L * 8 + d * 4 + h], fb = p.in[I_FB][L * 8 + d * 4 + h];
        f32x4v cacc[4];
        UNROLL for (int i = 0; i < 4; ++i) cacc[i] = (f32x4v){0.f, 0.f, 0.f, 0.f};
        for (int i = tid; i < 64 * LROW / 4; i += NTHREADS) ((unsigned*)PM)[i] = 0u;
        if (tid < 64) NV[tid] = 0.f;
        __syncthreads();
        u32x4 pq, pk, pv0, pv1; unsigned short pig = 0, pfg = 0;
#define ML_GEOM(ci_) const bool isc = (ci_) < 4; const int T = isc ? CTXL : SEQ, cc = isc ? (ci_) : (ci_) - 4; \
            const int t0 = d == 0 ? cc * 64 : T - 64 * (cc + 1), nb = isc ? NX + b * CTXL : b * SEQ; \
            const int tt = d == 0 ? t0 + ti : t0 + 63 - ti;
#define ML_PREFETCH(ci_) do { ML_GEOM(ci_) const bf16_t* row_ = PXM + (size_t)(nb + tt) * ML_COLS; \
            pq = *(const u32x4*)(row_ + h * 64 + 8 * j); pk = *(const u32x4*)(row_ + 256 + h * 64 + 8 * j); \
            pv0 = *(const u32x4*)(row_ + 512 + h * 128 + 16 * j); pv1 = *(const u32x4*)(row_ + 512 + h * 128 + 16 * j + 8); \
            if (wave == 0) { const int tl_ = d == 0 ? t0 + lane : t0 + 63 - lane; const bf16_t* rw_ = PXM + (size_t)(nb + tl_) * ML_COLS; pig = rw_[1536 + d * 4 + h]; pfg = rw_[1544 + d * 4 + h]; } } while (0)
        ML_PREFETCH(0);
        for (int ci = 0; ci < 36; ++ci) {
            ML_GEOM(ci)
            float q8[8], k8[8];
            {
                unpack8(pq, q8); unpack8(pk, k8);
                if (!isc) {
                    const int axis = j >> 2, half = (j >> 1) & 1; const float pos = (float)(axis == 0 ? (tt >> 6) : (tt & 63));
                    UNROLL for (int i = 0; i < 8; ++i) {
                        const int f = (j & 1) * 8 + i;
                        const float inv = exp2f(-(float)f * 0.83048202372184059f);
                        const float ang = pos * inv; const float cs = __cosf(ang), sn = __sinf(ang);
                        const float qo = __shfl_xor(q8[i], 2), ko = __shfl_xor(k8[i], 2);
                        q8[i] = half == 0 ? q8[i] * cs - qo * sn : q8[i] * cs + qo * sn;
                        k8[i] = half == 0 ? k8[i] * cs - ko * sn : k8[i] * cs + ko * sn;
                    }
                }
                UNROLL for (int i = 0; i < 8; ++i) q8[i] *= 0.125f;
                st8((bf16_t*)(QS + ti * LROW) + 8 * j, q8); st8((bf16_t*)(KC + ti * LROW) + 8 * j, k8);
                float v0[8], v1[8]; unpack8(pv0, v0); unpack8(pv1, v1);
                UNROLL for (int i = 0; i < 8; ++i) { *(bf16_t*)(VT + (16 * j + i) * LROW + ti * 2) = f2bf(v0[i]); *(bf16_t*)(VT + (16 * j + 8 + i) * LROW + ti * 2) = f2bf(v1[i]); }
                if (wave == 0) {
                    const float ig = bf2f(pig) + ib, fg = bf2f(pfg) + fb;
                    const float igc = 15.f * tanhf(ig * (1.f / 15.f)), fgc = 15.f * tanhf(fg * (1.f / 15.f));
                    float lf = -(fmaxf(-fgc, 0.f) + log1pf(expf(-fabsf(fgc))));
                    UNROLL for (int o = 1; o < 64; o <<= 1) { const float up = __shfl_up(lf, o); if (lane >= o) lf += up; }
                    BV[lane] = lf; GI[lane] = igc;
                }
            }
            __syncthreads();
            if (ci + 1 < 36) ML_PREFETCH(ci + 1);
            {
                const float bt = BV[ti], bl = BV[63], gi = GI[ti];
                const float eb = __expf(bt), wk = __expf(bl - bt + gi);
                float qp[8]; float dn = 0.f;
                UNROLL for (int i = 0; i < 8; ++i) { qp[i] = q8[i] * eb; dn += q8[i] * NV[8 * j + i]; }
                st8((bf16_t*)(QP + ti * LROW) + 8 * j, qp);
                UNROLL for (int i = 0; i < 8; ++i) *(bf16_t*)(KW + (8 * j + i) * LROW + ti * 2) = f2bf(k8[i] * wk);
                dn = sum8(dn);
                if (j == 0) DEN[ti] = dn * eb;
            }
            __syncthreads();
            UNROLL for (int rep = 0; rep < 2; ++rep) {
                const int tile = wave + 8 * rep;
                if (tile < 10) {
                    const int tt4 = tile < 1 ? 0 : tile < 3 ? 1 : tile < 6 ? 2 : 3, st4 = tile - (tt4 * (tt4 + 1)) / 2;
                    f32x4v a = {0.f, 0.f, 0.f, 0.f};
                    UNROLL for (int ks = 0; ks < 2; ++ks)
                        a = __builtin_amdgcn_mfma_f32_16x16x32_bf16(*(const bf16x8*)(QS + (16 * tt4 + lq) * LROW + ks * 64 + kg * 16),
                                                                    *(const bf16x8*)(KC + (16 * st4 + lq) * LROW + ks * 64 + kg * 16), a, 0, 0, 0);
                    const int sidx = 16 * st4 + lq; const float bs = BV[sidx], gs = GI[sidx];
                    UNROLL for (int i = 0; i < 4; ++i) {
                        const int tidx = 16 * tt4 + 4 * kg + i;
                        const float val = sidx <= tidx ? a[i] * __expf(BV[tidx] - bs + gs) : 0.f;
                        *(bf16_t*)(PM + tidx * LROW + sidx * 2) = f2bf(val);
                        const float rsum = sum16(val);
                        if (lq == 0) RS[tidx * 4 + st4] = rsum;
                    }
                }
            }
            __syncthreads();
            {
                bf16x8 vf[2], cb[2];
                UNROLL for (int kk = 0; kk < 2; ++kk) vf[kk] = *(const bf16x8*)(VT + (16 * wave + lq) * LROW + kk * 64 + kg * 16);
                UNROLL for (int kk = 0; kk < 2; ++kk) {
                    u32x4 w; w.x = pk2(cacc[2 * kk][0], cacc[2 * kk][1]); w.y = pk2(cacc[2 * kk][2], cacc[2 * kk][3]);
                    w.z = pk2(cacc[2 * kk + 1][0], cacc[2 * kk + 1][1]); w.w = pk2(cacc[2 * kk + 1][2], cacc[2 * kk + 1][3]);
                    cb[kk] = __builtin_bit_cast(bf16x8, w);
                }
                UNROLL for (int tt4 = 0; tt4 < 4; ++tt4) {
                    f32x4v hacc = {0.f, 0.f, 0.f, 0.f};
                    UNROLL for (int kk = 0; kk < 2; ++kk) if (2 * kk <= tt4)
                        hacc = __builtin_amdgcn_mfma_f32_16x16x32_bf16(*(const bf16x8*)(PM + (16 * tt4 + lq) * LROW + kk * 64 + kg * 16), vf[kk], hacc, 0, 0, 0);
                    UNROLL for (int kk = 0; kk < 2; ++kk) {
                        const char* qa = QP + (16 * tt4 + lq) * LROW + (32 * kk + 4 * kg) * 2;
                        const u32x2 lo = *(const u32x2*)qa, hi = *(const u32x2*)(qa + 32);
                        u32x4 w; w.x = lo.x; w.y = lo.y; w.z = hi.x; w.w = hi.y;
                        hacc = __builtin_amdgcn_mfma_f32_16x16x32_bf16(__builtin_bit_cast(bf16x8, w), cb[kk], hacc, 0, 0, 0);
                    }
                    UNROLL for (int i = 0; i < 4; ++i) {
                        const int tidx = 16 * tt4 + 4 * kg + i;
                        float den = DEN[tidx];
                        UNROLL for (int st = 0; st <= tt4; ++st) den += RS[tidx * 4 + st];
                        HO[tidx * 132 + 16 * wave + lq] = hacc[i] * frcp(fmaxf(fabsf(den), 1.f));
                    }
                }
                const float g = __expf(BV[63]);
                UNROLL for (int dk = 0; dk < 4; ++dk) {
                    cacc[dk] = cacc[dk] * g;
                    UNROLL for (int kk = 0; kk < 2; ++kk)
                        cacc[dk] = __builtin_amdgcn_mfma_f32_16x16x32_bf16(*(const bf16x8*)(KW + (16 * dk + lq) * LROW + kk * 64 + kg * 16), vf[kk], cacc[dk], 0, 0, 0);
                }
            }
            __syncthreads();
            if (tid < 64) {
                float acc = 0.f;
                UNROLL for (int c8 = 0; c8 < 8; ++c8) { float kw[8]; ld8((const bf16_t*)(KW + tid * LROW) + 8 * c8, kw); UNROLL for (int i = 0; i < 8; ++i) acc += kw[i]; }
                NV[tid] = __expf(BV[63]) * NV[tid] + acc;
            }
            {
                const float* hr = HO + ti * 132 + 16 * j;
                float o0[8], o1[8];
                UNROLL for (int i = 0; i < 8; ++i) { o0[i] = hr[i]; o1[i] = hr[8 + i]; }
                bf16_t* dst = HS + ((size_t)d * NT + nb + tt) * 512 + h * 128 + 16 * j;
                st8(dst, o0); st8(dst + 8, o1);
            }
            __syncthreads();
        }
    }
}
DEV void ph_ml_read(const Params& p, int L, int ntok) {
    const int lane = TID() & 63, wave = TID() >> 6;
    const bf16_t* PXM = (const bf16_t*)(p.ws + OFF_PX); const bf16_t* HS = (const bf16_t*)(p.ws + OFF_HS);
    bf16_t* YC = (bf16_t*)(p.ws + OFF_YC); const float* ng = p.in[I_MNG] + (size_t)L * 512;
    for (int n0 = blockIdx.x * 8; n0 < ntok; n0 += gridDim.x * 8) {
        const int n = n0 + wave, c = lane * 8;
        float h0[8], h1[8], o8[8], out[8];
        ld8(HS + (size_t)n * 512 + c, h0); ld8(HS + ((size_t)NT + n) * 512 + c, h1); ld8(PXM + (size_t)n * ML_COLS + 1024 + c, o8);
        float ss = 0.f;
        UNROLL for (int i = 0; i < 8; ++i) { h0[i] += h1[i]; ss += h0[i] * h0[i]; }
        ss += __shfl_xor(ss, 1); ss += __shfl_xor(ss, 2); ss += __shfl_xor(ss, 4); ss += __shfl_xor(ss, 8);
        const float r = rsqrtf(ss * (1.f / 128.f) + 1e-6f);
        UNROLL for (int i = 0; i < 8; ++i) out[i] = h0[i] * r * ng[c + i] * sigm(o8[i]);
        st8(YC + (size_t)n * 512 + c, out);
    }
}

DEV void ph_route(const Params& p, int L, int ntok, char* smem) {
    const int lane = TID() & 63, wave = TID() >> 6;
    const float* LOG = (const float*)(p.ws + OFF_LOG); int* EIDX = (int*)(p.ws + OFF_EIDX); float* EW = (float*)(p.ws + OFF_EW);
    const float bias = p.in[I_MB][L * 64 + lane];
    int* MCNT = (int*)(p.ws + OFF_MCNT);
    int* hist = (int*)smem;
    if (TID() < 192) hist[TID()] = 0;
    __syncthreads();
    for (int n0 = blockIdx.x * 8; n0 < ntok; n0 += gridDim.x * 8) {
        const int n = n0 + wave, g = lane >> 3;
        const float score = sigm_acc(LOG[(size_t)n * 64 + lane]), sel = score + bias;
        float m1 = sel; m1 = fmaxf(m1, __shfl_xor(m1, 1)); m1 = fmaxf(m1, __shfl_xor(m1, 2)); m1 = fmaxf(m1, __shfl_xor(m1, 4));
        int i1 = sel == m1 ? lane : 64; i1 = min(i1, __shfl_xor(i1, 1)); i1 = min(i1, __shfl_xor(i1, 2)); i1 = min(i1, __shfl_xor(i1, 4));
        float m2 = lane == i1 ? -3e38f : sel; m2 = fmaxf(m2, __shfl_xor(m2, 1)); m2 = fmaxf(m2, __shfl_xor(m2, 2)); m2 = fmaxf(m2, __shfl_xor(m2, 4));
        const float gs = m1 + m2;
        int rank = 0;
        UNROLL for (int g2 = 0; g2 < 8; ++g2) { const float v = __shfl(gs, g2 * 8); rank += (v > gs || (v == gs && g2 < g)) ? 1 : 0; }
        const float ms = rank < 4 ? sel : -1e30f;
        int er = 0;
        for (int e2 = 0; e2 < 64; ++e2) { const float v = __shfl(ms, e2); er += (v > ms || (v == ms && e2 < lane)) ? 1 : 0; }
        const bool chosen = er < 8;
        float ws = chosen ? score : 0.f;
        UNROLL for (int o = 1; o < 64; o <<= 1) ws += __shfl_xor(ws, o);
        if (chosen) { EIDX[(size_t)n * 8 + er] = lane; EW[(size_t)n * 8 + er] = score / ws * 2.5f; atomicAdd(hist + (n / MOE_CHUNK) * 64 + lane, 1); }
    }
    __syncthreads();
    if (TID() < 192 && hist[TID()] > 0) atomicAdd(MCNT + TID(), hist[TID()]);
    __syncthreads();
}


DEV void ph_moe_scatter(const Params& p, int ntok, char* smem) {
    const int tid = TID();
    int* base = (int*)smem;
    int* lh = base + 192;
    const int* MCNT = (const int*)(p.ws + OFF_MCNT); int* CUR = (int*)(p.ws + OFF_MCNT) + 192;
    const int* EIDX = (const int*)(p.ws + OFF_EIDX); int* SORT = (int*)(p.ws + OFF_SORT);
    if (tid < 3) { int b = 0; for (int e = 0; e < 64; ++e) { base[tid * 64 + e] = b; b += (MCNT[tid * 64 + e] + 127) & ~127; } }
    if (tid < 192) lh[tid] = 0;
    __syncthreads();
    for (int i = blockIdx.x * NTHREADS + tid; i < ntok * 8; i += gridDim.x * NTHREADS) atomicAdd(lh + ((i >> 3) / MOE_CHUNK) * 64 + EIDX[i], 1);
    __syncthreads();
    if (tid < 192) { const int n = lh[tid]; if (n > 0) base[tid] += atomicAdd(CUR + tid, n); lh[tid] = 0; }
    __syncthreads();
    for (int i = blockIdx.x * NTHREADS + tid; i < ntok * 8; i += gridDim.x * NTHREADS) {
        const int ce = ((i >> 3) / MOE_CHUNK) * 64 + EIDX[i];
        SORT[(size_t)(ce >> 6) * SORT_CAP + base[ce] + atomicAdd(lh + ce, 1)] = i;
    }
    __syncthreads();
}

DEV void ph_moe_exp(const Params& p, int cb, int ce, char* smem, Topo tp) {
    typedef GC<2, 4> C;
    const int tid0 = TID();
    char* ACT = smem + 2 * C::STG;
    int* list = (int*)(smem + 3 * C::STG);
    int* cnt = list + 1024;
    const bf16_t* H2 = (const bf16_t*)(p.ws + OFF_HX); const int* EIDX = (const int*)(p.ws + OFF_EIDX); const float* EW = (const float*)(p.ws + OFF_EW);
    bf16_t* YBUF = (bf16_t*)(p.ws + OFF_YBUF);
    const int c = cb / MOE_CHUNK;
    const int* MCNT = (const int*)(p.ws + OFF_MCNT) + c * 64; const int* SORT = (const int*)(p.ws + OFF_SORT) + (size_t)c * SORT_CAP;
    int* tb = cnt + 16;
    const int xcd = tp.x, slot = tp.r, nslot = tp.n;
    __syncthreads();
    if (tid0 < 8) {
        const int tid = tid0; const int e = xcd + 8 * tid; int b = 0;
        for (int e2 = 0; e2 < e; ++e2) b += (MCNT[e2] + 127) & ~127;
        tb[16 + tid] = b; tb[32 + tid] = MCNT[e];
    }
    __syncthreads();
    if (tid0 == 0) { int t = 0; for (int k = 0; k < 8; ++k) { tb[k] = t; t += (tb[32 + k] + 127) >> 7; } tb[8] = t; }
    __syncthreads();
    const int total = tb[8];
    int pre_entry = 0;
    for (int lu = slot; lu < total; lu += nslot) {
        int tid = tid0; asm volatile("" : "+v"(tid));
        const int lane = tid & 63, wave = tid >> 6, wm = wave / 4, wn = wave % 4, fr = lane & 31, fh = lane >> 5;
        int k = 0;
        while (k < 7 && lu >= tb[k + 1]) ++k;
        const int e = xcd + 8 * k, j = lu - tb[k], M = min(128, tb[32 + k] - 128 * j), row0 = tb[16 + k] + 128 * j;
        __syncthreads();
        if (tid < 128) list[tid] = lu == slot ? SORT[row0 + min(tid, M - 1)] : pre_entry;
        __syncthreads();
        if (lu + nslot < total && tid < 128) {
            const int lu2 = lu + nslot; int k2 = 0;
            while (k2 < 7 && lu2 >= tb[k2 + 1]) ++k2;
            const int j2 = lu2 - tb[k2], M2 = min(128, tb[32 + k2] - 128 * j2);
            pre_entry = SORT[tb[16 + k2] + 128 * j2 + min(tid, M2 - 1)];
        }
        const bf16_t* GU = (const bf16_t*)(p.ws + OFF_MGU) + (size_t)e * 256 * 1024;
        const bf16_t* DT = (const bf16_t*)(p.ws + OFF_MDT) + (size_t)e * 1024 * 128;
        {
            constexpr int mc = 0;
            f32x16 acc[2][2];
            {
            acc_zero(acc);
            gemm_tile<2, 4, 3, false>(acc, [&](int r) -> const bf16_t* { const int ix = min(mc + r, M - 1); return H2 + (size_t)(list[ix] >> 3) * 1024; },
                                   GU, 1024, 0, 256, 1024, smem, nullptr);
            }
            const int crow = tid >> 3, cch = (tid & 7) ^ ((crow >> 1) & 7);
#define MG2_ISSUE(nt_) do { UNROLL for (int kt = 0; kt < 2; ++kt) UNROLL for (int i = 0; i < 4; ++i) \
                    GLDS16(DT + (size_t)((nt_) * 256 + crow + 64 * i) * 128 + kt * 64 + cch * 8, smem + kt * C::STG + C::AB + i * 8192 + tid * 16); } while (0)
            MG2_ISSUE(0);
            UNROLL for (int mi = 0; mi < 2; ++mi) UNROLL for (int r = 0; r < 16; ++r) {
                const int row = wm * 64 + ACC_ROW(mi, r, fh), ix = mc + row;
                const float gw = ix < M ? EW[list[ix]] : 0.f;
                const float gv = acc[mi][0][r], uv = acc[mi][1][r];
                const float a = gv * frcp(1.f + __expf(-gv)) * uv * gw;
                const int col = wn * 32 + fr;
                *(bf16_t*)(ACT + (col >> 6) * C::AB + row * 128 + ((((col & 63) >> 3) ^ ((row >> 1) & 7)) << 4) + (col & 7) * 2) = f2bf(a);
            }
            __syncthreads();
            {
                const int sw = (fr >> 1) & 7, a_base = (wm * 64 + fr) * 128, b_base = (wn * 64 + fr) * 128;
                float* slab = (float*)(smem + (wave < 4 ? wave * 4096 : C::STG + (wave - 4) * 4096));
                _Pragma("unroll 1") for (int nt = 0; nt < 4; ++nt) {
                    asm volatile("s_waitcnt vmcnt(0)" ::: "memory");
                    __builtin_amdgcn_s_barrier();
                    asm volatile("" ::: "memory");
                    acc_zero(acc);
                    UNROLL for (int kt = 0; kt < 2; ++kt) {
                        const char* As_ = ACT + kt * C::AB; const char* Bs_ = smem + kt * C::STG + C::AB;
                        UNROLL for (int ks = 0; ks < 4; ++ks) {
                            const int off = ((2 * ks + fh) ^ sw) * 16;
                            bf16x8 af[2], bfv[2];
                            UNROLL for (int mi = 0; mi < 2; ++mi) af[mi] = *(const bf16x8*)(As_ + a_base + mi * 4096 + off);
                            UNROLL for (int ni = 0; ni < 2; ++ni) bfv[ni] = *(const bf16x8*)(Bs_ + b_base + ni * 4096 + off);
                            UNROLL for (int mi = 0; mi < 2; ++mi) UNROLL for (int ni = 0; ni < 2; ++ni)
                                acc[mi][ni] = __builtin_amdgcn_mfma_f32_32x32x16_bf16(af[mi], bfv[ni], acc[mi][ni], 0, 0, 0);
                        }
                    }
                    asm volatile("s_waitcnt lgkmcnt(0)" ::: "memory");
                    __builtin_amdgcn_s_barrier();
                    asm volatile("" ::: "memory");
                    if (nt < 3) MG2_ISSUE(nt + 1);
                    UNROLL for (int mi = 0; mi < 2; ++mi) UNROLL for (int hh = 0; hh < 2; ++hh) {
                        UNROLL for (int ni = 0; ni < 2; ++ni) UNROLL for (int r8 = 0; r8 < 8; ++r8) {
                            const int r = 8 * hh + r8;
                            slab[((r & 3) + 8 * ((r >> 2) & 1) + 4 * fh) * 64 + ni * 32 + fr] = acc[mi][ni][r];
                        }
                        UNROLL for (int it = 0; it < 2; ++it) {
                            const int row = (lane >> 3) + 8 * it, c8 = (lane & 7) * 8;
                            const float4 a = *(const float4*)(slab + row * 64 + c8), b = *(const float4*)(slab + row * 64 + c8 + 4);
                            const float v[8] = {a.x, a.y, a.z, a.w, b.x, b.y, b.z, b.w};
                            const int ix = mc + wm * 64 + mi * 32 + 16 * hh + row;
                            if (ix < M) st8(YBUF + (size_t)(list[ix] - cb * 8) * 1024 + nt * 256 + wn * 64 + c8, v);
                        }
                    }
                }
#undef MG2_ISSUE
            }
            __syncthreads();
        }
        __syncthreads();
    }
}


#define XB_TMO      128
#define XB_XCNT(j)  (256  + 64 * (j))
#define XB_XSUB(j)  (1280 + 64 * (j))
#define XB_XGEN(j)  (2304 + 64 * (j))
#define XB_TOP      3328
#define XB_TOPGEN   3392
#define XCD_BAR_WORDS 3456
#define XB_SPIN_CAP (1u << 18)
#define LAS __attribute__((address_space(3)))

__device__ __forceinline__ unsigned xb_ld(unsigned* p)              { return __hip_atomic_load(p, __ATOMIC_RELAXED, __HIP_MEMORY_SCOPE_AGENT); }
__device__ __forceinline__ unsigned xb_add(unsigned* p, unsigned v) { return __hip_atomic_fetch_add(p, v, __ATOMIC_RELAXED, __HIP_MEMORY_SCOPE_AGENT); }
__device__ __forceinline__ unsigned xb_xcc_id() { return (unsigned)__builtin_amdgcn_s_getreg((3 << 11) | 20) & 0xFu; }
#define XB_SPIN(cond, bar) do { unsigned _sp = 0; while (cond) { __builtin_amdgcn_s_sleep(1); \
    if ((++_sp & 255u) == 0u) { if (xb_ld(&(bar)[XB_TMO])) break; if (_sp > XB_SPIN_CAP) { atomicAdd(&(bar)[XB_TMO], 1u); break; } } } } while (0)

struct XcdBarrier { unsigned* bar; unsigned x; volatile LAS unsigned* st; };

__device__ __forceinline__ XcdBarrier xcd_barrier_post(unsigned* bar, volatile LAS unsigned* st) {
    XcdBarrier b; b.bar = bar; b.x = xb_xcc_id(); b.st = st;
    if (threadIdx.x == 0) { const unsigned rank = xb_add(&bar[XB_XCNT(b.x)], 1u); st[2] = b.x; st[3] = rank; }
    return b;
}
__device__ __forceinline__ void xcd_barrier_complete(unsigned* bar, unsigned x, unsigned& nloc, unsigned& nx) {
    const unsigned G = gridDim.x * gridDim.y * gridDim.z;
    unsigned sum, cnt, mine, sp = 0u;
    for (;;) {
        sum = 0u; cnt = 0u; mine = 0u;
#pragma unroll
        for (unsigned j = 0; j < 16; ++j) { const unsigned c = xb_ld(&bar[XB_XCNT(j)]); sum += c; cnt += (c > 0u) ? 1u : 0u; mine = (j == x) ? c : mine; }
        if (sum == G) break;
        __builtin_amdgcn_s_sleep(1);
        if ((++sp & 255u) == 0u) { if (xb_ld(&bar[XB_TMO])) break; if (sp > XB_SPIN_CAP) { atomicAdd(&bar[XB_TMO], 1u); break; } }
    }
    nloc = mine > 0u ? mine : 1u; nx = cnt > 0u ? cnt : 1u;
}
__device__ __forceinline__ void xcd_barrier(const XcdBarrier& b) {
    asm volatile("s_waitcnt vmcnt(0)" ::: "memory");
    __syncthreads();
    if (threadIdx.x == 0) {
        unsigned* bar = b.bar;
        __builtin_amdgcn_s_waitcnt(0);
        unsigned nloc = b.st[0], nx = b.st[1];
        if (nloc == 0u) { xcd_barrier_complete(bar, b.x, nloc, nx); b.st[0] = nloc; b.st[1] = nx; }
        const unsigned old = xb_add(&bar[XB_XSUB(b.x)], 1u);
        const unsigned gen = old / nloc;
        if (old + 1u == (gen + 1u) * nloc) {
            __builtin_amdgcn_fence(__ATOMIC_RELEASE, "agent");
            asm volatile("s_waitcnt vmcnt(0)" ::: "memory");
            const unsigned og = xb_add(&bar[XB_TOP], 1u);
            const unsigned tg = og / nx;
            if (og + 1u == (tg + 1u) * nx) xb_add(&bar[XB_TOPGEN], 1u);
            else XB_SPIN(xb_ld(&bar[XB_TOPGEN]) == tg, bar);
            __builtin_amdgcn_fence(__ATOMIC_ACQUIRE, "agent");
            xb_add(&bar[XB_XGEN(b.x)], 1u);
            asm volatile("s_waitcnt vmcnt(0)" ::: "memory");
        } else {
            XB_SPIN(xb_ld(&bar[XB_XGEN(b.x)]) == gen, bar);
            __builtin_amdgcn_fence(__ATOMIC_ACQUIRE, "agent");
            asm volatile("s_waitcnt vmcnt(0)" ::: "memory");
        }
    }
    __syncthreads();
}

enum { PH_MODCONV = 0, PH_HX, PH_GEMM_R, PH_RW_PREP, PH_RW_SCAN, PH_RW_READ, PH_RW_G, PH_GEMM_N, PH_NA_NORM, PH_NA_ATT, PH_GEMM_M, PH_ML_SCAN, PH_ML_READ,
       PH_GEMM_G, PH_MERGE, PH_OUT, PH_NORM2, PH_ROUTER, PH_ROUTE, PH_SHARED, PH_MOE_EXP, PH_MOE_COMB, PH_COUNT };

template <int PH> DEV void run_phase(const Params& p, int L, int sub, char* smem, Topo tp) {
    const int tid = TID(), lane = tid & 63, fr = lane & 31, fh = lane >> 5;
    char* ws = p.ws;
    const int ntl = L == 0 ? NT : NX;
    const bf16_t* HX = (const bf16_t*)(ws + OFF_HX);
    const bf16_t* WINT = (const bf16_t*)(ws + OFF_WINT);
    if constexpr (PH == PH_MODCONV) { ph_mod(p, L, smem); ph_conv_mix(p, L, smem); }
    else if constexpr (PH == PH_HX) { ph_norm(p, L, 0, NT); }
    else if constexpr (PH == PH_GEMM_R || PH == PH_GEMM_M) {
        const int c0 = PH == PH_GEMM_R ? 0 : RW_COLS + NA_COLS;
        const int N = PH == PH_GEMM_R ? RW_COLS : ML_COLS;
        bf16_t* PX = (bf16_t*)(ws + OFF_PX);
        gemm256(HX, NT, WINT + (size_t)c0 * DM, N, DM, smem, tp, [&](int row, int col, const float (&v)[8]) {
            if (col < N) st8(PX + (size_t)row * N + col, v);
        });
    }
    else if constexpr (PH == PH_GEMM_N) {
        bf16_t* PX = (bf16_t*)(ws + OFF_PX); bf16_t* VT = (bf16_t*)(ws + OFF_VT); bf16_t* VTC = (bf16_t*)(ws + OFF_VTC);
        gemm256(HX, NT, WINT + (size_t)RW_COLS * DM, 1024, DM, smem, tp, [&](int row, int col, const float (&v)[8]) { st8(PX + (size_t)row * 1024 + col, v); });
        gemm_phase<4, 2>(HX, DM, NT, WINT + (size_t)(RW_COLS + 1024) * DM, DM, 512, DM, smem, tp, [&](const f32x16 (&acc)[2][2], int row0, int col0) {
            const int h = col0 >> 6;
            epi_cols(acc, smem, [&](int r8, int col, const float (&v)[8]) {
                const int n = row0 + r8;
                bf16_t* dst = n < NX ? VT + ((size_t)((n >> 11) * 8 + h) * 64 + col) * SEQ + (n & 2047)
                                     : VTC + ((size_t)(((n - NX) >> 8) * 8 + h) * 64 + col) * CTXL + ((n - NX) & 255);
                st8(dst, v);
            });
        });
    }
    else if constexpr (PH == PH_RW_PREP) { ph_rw_prep(p, L, smem); }
    else if constexpr (PH == PH_RW_SCAN) { ph_rw_scan(p, L, smem); }
    else if constexpr (PH == PH_RW_READ) { ph_rw_read(p, L, ntl); }
    else if constexpr (PH == PH_RW_G) {
        bf16_t* YA = (bf16_t*)(ws + OFF_YA);
        gemm_phase<4, 2>((const bf16_t*)(ws + OFF_SGB), 128, ntl, (const bf16_t*)(ws + OFF_G2T), 128, 512, 128, smem, tp, [&](const f32x16 (&acc)[2][2], int row0, int col0) {
            epi_rows(acc, smem, [&](int row, int c8, const float (&v)[8]) {
                bf16_t* q = YA + (size_t)(row0 + row) * 512 + col0 + c8;
                float y[8]; ld8(q, y);
                UNROLL for (int i = 0; i < 8; ++i) y[i] *= v[i];
                st8(q, y);
            });
        });
    }
    else if constexpr (PH == PH_NA_NORM) { ph_na_norm(p, L); }
    else if constexpr (PH == PH_NA_ATT) { ph_na_att(p, L, smem); }
    else if constexpr (PH == PH_ML_SCAN) {
        if (blockIdx.x < 128 || gridDim.x <= 128) ph_ml_scan(p, L, smem);
        if (gridDim.x <= 128) ph_conv_moe_gu(p, L, smem, blockIdx.x, gridDim.x);
        else if (blockIdx.x >= 128) ph_conv_moe_gu(p, L, smem, blockIdx.x - 128, gridDim.x - 128);
    }
    else if constexpr (PH == PH_ML_READ) { ph_ml_read(p, L, ntl); }
    else if constexpr (PH == PH_GEMM_G) {
        bf16_t* G = (bf16_t*)(ws + OFF_GATES);
        gemm256(HX, ntl, WINT + (size_t)(RW_COLS + NA_COLS + ML_COLS) * DM, GATE_COLS, DM, smem, tp, [&](int row, int col, const float (&v)[8]) {
            float y[8];
            UNROLL for (int i = 0; i < 8; ++i) y[i] = sigm(v[i]);
            st8(G + (size_t)row * GATE_COLS + col, y);
        });
    }
    else if constexpr (PH == PH_MERGE) {
        const bf16_t* G = (const bf16_t*)(ws + OFF_GATES); bf16_t* MG = (bf16_t*)(ws + OFF_HX);
        _Pragma("unroll 1") for (int br = 0; br < 3; ++br) {
            gemm256((const bf16_t*)(ws + OFF_YA + (size_t)br * SZ_Y1), ntl, (const bf16_t*)(ws + OFF_WBT) + (size_t)br * 1024 * 512, DM, 512, smem, tp, [&](int row, int col, const float (&v)[8]) {
                float g[8], m[8];
                ld8(G + (size_t)row * GATE_COLS + br * DM + col, g);
                bf16_t* q = MG + (size_t)row * DM + col;
                if (br == 0) { UNROLL for (int i = 0; i < 8; ++i) m[i] = g[i] * v[i]; }
                else { ld8(q, m); UNROLL for (int i = 0; i < 8; ++i) m[i] += g[i] * v[i]; }
                st8(q, m);
            });
        }
    }
    else if constexpr (PH == PH_OUT) {
        const float* MOD = (const float*)(ws + OFF_MOD);
        gemm256(HX, ntl, (const bf16_t*)(ws + OFF_WOUTT), DM, DM, smem, tp, [&](int n, int c, const float (&v)[8]) {
            const float* xp = xprev_row(p, L, n) + c; float* xo = xs_row(p, n) + c; const float* g1 = MOD + mod_row(n) * 6144 + 2 * DM + c;
            const float4 xa = *(const float4*)xp, xb = *(const float4*)(xp + 4), ga = *(const float4*)g1, gb = *(const float4*)(g1 + 4);
            float4 oa, ob;
            oa.x = xa.x + ga.x * v[0]; oa.y = xa.y + ga.y * v[1]; oa.z = xa.z + ga.z * v[2]; oa.w = xa.w + ga.w * v[3];
            ob.x = xb.x + gb.x * v[4]; ob.y = xb.y + gb.y * v[5]; ob.z = xb.z + gb.z * v[6]; ob.w = xb.w + gb.w * v[7];
            *(float4*)xo = oa; *(float4*)(xo + 4) = ob;
        });
    }
    else if constexpr (PH == PH_NORM2) {
        if (blockIdx.x == 0 && tid < 384) ((int*)(ws + OFF_MCNT))[tid] = 0;
        ph_norm(p, L, 1, ntl);
    }
    else if constexpr (PH == PH_ROUTER) {
        typedef GC<4, 2> C;
        float* LOG = (float*)(ws + OFF_LOG);
        const bf16_t* H2LO = (const bf16_t*)(ws + OFF_H2LO); const bf16_t* RH = (const bf16_t*)(ws + OFF_RTR); const bf16_t* RL = RH + 64 * 1024;
        const int wave = tid >> 6, wm = wave / 2, wn = wave % 2;
        {
            const int nrt = ntl / C::BM, G = gridDim.x;
            if (G > nrt) { if ((int)blockIdx.x >= nrt) ph_conv_moe(p, L, smem, blockIdx.x - nrt, G - nrt); }
            else ph_conv_moe(p, L, smem, blockIdx.x, G);
        }
        for (int t = blockIdx.x; t < ntl / C::BM; t += gridDim.x) {
            f32x16 acc[2][2]; acc_zero(acc);
            const bf16_t* A0 = HX + (size_t)t * C::BM * DM; const bf16_t* A1 = H2LO + (size_t)t * C::BM * DM;
            gemm_tile<4, 2, 3, false>(acc, [&](int r) { return A0 + (size_t)r * DM; }, RH, DM, 0, 64, DM, smem, nullptr);
            gemm_tile<4, 2, 3, false>(acc, [&](int r) { return A1 + (size_t)r * DM; }, RH, DM, 0, 64, DM, smem, nullptr);
            gemm_tile<4, 2, 3, false>(acc, [&](int r) { return A0 + (size_t)r * DM; }, RL, DM, 0, 64, DM, smem, nullptr);
            epi_rows(acc, smem, [&](int row, int c8, const float (&v)[8]) {
                if (wn == 0) {
                    float* q = LOG + (size_t)(t * C::BM + wm * 64 + row) * 64 + c8;
                    *(float4*)q = make_float4(v[0], v[1], v[2], v[3]); *(float4*)(q + 4) = make_float4(v[4], v[5], v[6], v[7]);
                }
            });
        }
    }
    else if constexpr (PH == PH_ROUTE) { ph_route(p, L, ntl, smem); }
    else if constexpr (PH == PH_SHARED) {
        ph_moe_scatter(p, ntl, smem);
        bf16_t* SA = (bf16_t*)(ws + OFF_SA);
        gemm256_pair(HX, ntl, (const bf16_t*)(ws + OFF_SGUT), 512, DM, smem, tp, [&](int row, int col, const float (&g)[8], const float (&u)[8]) {
            float a[8];
            UNROLL for (int i = 0; i < 8; ++i) a[i] = g[i] * frcp(1.f + __expf(-g[i])) * u[i];
            st8(SA + (size_t)row * 256 + (col >> 8) * 128 + (col & 127), a);
        });
    }
    else if constexpr (PH == PH_MOE_EXP) { const int cb = sub * MOE_CHUNK; ph_moe_exp(p, cb, min(cb + MOE_CHUNK, ntl), smem, tp); }
    else if constexpr (PH == PH_MOE_COMB) {
        const int cb = sub * MOE_CHUNK, ce = min(cb + MOE_CHUNK, ntl);
        const float* MOD = (const float*)(ws + OFF_MOD); const bf16_t* YBUF = (const bf16_t*)(ws + OFF_YBUF);
        gemm256((const bf16_t*)(ws + OFF_SA) + (size_t)cb * 256, ce - cb, (const bf16_t*)(ws + OFF_SDT), DM, 256, smem, tp, [&](int rl, int c, const float (&v)[8]) {
            const int n = cb + rl;
            float s[8];
            UNROLL for (int i = 0; i < 8; ++i) s[i] = v[i];
            _Pragma("unroll 2") for (int k = 0; k < 8; ++k) { float y[8]; ld8(YBUF + ((size_t)rl * 8 + k) * DM + c, y); UNROLL for (int i = 0; i < 8; ++i) s[i] += y[i]; }
            float* xo = xs_row(p, n) + c; const float* g2 = MOD + mod_row(n) * 6144 + 5 * DM + c;
            float4 xa = *(const float4*)xo, xb = *(const float4*)(xo + 4); const float4 ga = *(const float4*)g2, gb = *(const float4*)(g2 + 4);
            xa.x += ga.x * s[0]; xa.y += ga.y * s[1]; xa.z += ga.z * s[2]; xa.w += ga.w * s[3];
            xb.x += gb.x * s[4]; xb.y += gb.y * s[5]; xb.z += gb.z * s[6]; xb.w += gb.w * s[7];
            *(float4*)xo = xa; *(float4*)(xo + 4) = xb;
        });
    }
}

#ifndef N_LAUNCH_MODE
#define N_LAUNCH_MODE 1
#endif
#if N_LAUNCH_MODE == 0
template <int PH> __global__ void __launch_bounds__(NTHREADS, 2) k_phase(Params p, int L, int sub) {
    extern __shared__ __attribute__((aligned(16))) char smem[];
    run_phase<PH>(p, L, sub, smem, Topo{(int)(blockIdx.x & 7), (int)(blockIdx.x >> 3), (int)((gridDim.x + 7 - (blockIdx.x & 7)) >> 3)});
}
#endif


#ifndef MEGA_SKIP
#define MEGA_SKIP 0ull
#endif
#ifndef MEGA_REPEAT
#define MEGA_REPEAT 0ull
#endif
#define PHASE(PH, sub) do { if constexpr (!((MEGA_SKIP >> PH) & 1ull)) { run_phase<PH>(p, L, sub, smem, tp); xcd_barrier(bar); if constexpr ((MEGA_REPEAT >> PH) & 1ull) { run_phase<PH>(p, L, sub, smem, tp); xcd_barrier(bar); } } } while (0)
__global__ void __launch_bounds__(NTHREADS, 2) k_mega(Params p) {
    extern __shared__ __attribute__((aligned(16))) char smem[];
    volatile LAS unsigned* st = (volatile LAS unsigned*)(smem + LDS_BYTES);
    if (threadIdx.x == 0) { st[0] = 0u; st[1] = 0u; st[2] = 0u; st[3] = 0u; }
    __syncthreads();
    const XcdBarrier bar = xcd_barrier_post((unsigned*)(p.ws + OFF_BAR), st);
    Topo tp{(int)(blockIdx.x & 7), (int)(blockIdx.x >> 3), (int)((gridDim.x + 7 - (blockIdx.x & 7)) >> 3)};
    for (int L = 0; L < 2; ++L) {
        const int ntl = L == 0 ? NT : NX;
        PHASE(PH_MODCONV, 0);
        if (st[1] == 8u && st[0] != 0u) { tp.x = (int)st[2]; tp.r = (int)st[3]; tp.n = (int)st[0]; }
        PHASE(PH_HX, 0);
        PHASE(PH_GEMM_R, 0);
        PHASE(PH_RW_PREP, 0);
        PHASE(PH_RW_SCAN, 0);
        PHASE(PH_RW_READ, 0);
        PHASE(PH_RW_G, 0);
        PHASE(PH_GEMM_N, 0);
        PHASE(PH_NA_ATT, 0);
        PHASE(PH_GEMM_M, 0);
        PHASE(PH_ML_SCAN, 0);
        PHASE(PH_ML_READ, 0);
        PHASE(PH_GEMM_G, 0);
        PHASE(PH_MERGE, 0);
        PHASE(PH_OUT, 0);
        PHASE(PH_NORM2, 0);
        PHASE(PH_ROUTER, 0);
        PHASE(PH_ROUTE, 0);
        PHASE(PH_SHARED, 0);
        for (int c = 0; c * MOE_CHUNK < ntl; ++c) {
            PHASE(PH_MOE_EXP, c);
            PHASE(PH_MOE_COMB, c);
        }
    }
}

#if N_LAUNCH_MODE == 0
template <int PH> static void launch_phase(const Params& p, int L, int sub, hipStream_t stream) {
    static bool attr = false;
    if (!attr) { (void)hipFuncSetAttribute((const void*)k_phase<PH>, hipFuncAttributeMaxDynamicSharedMemorySize, LDS_BYTES); attr = true; }
    hipLaunchKernelGGL(k_phase<PH>, dim3(256), dim3(NTHREADS), LDS_BYTES, stream, p, L, sub);
}
#endif

extern "C" void kernel_launch(void* const* d_in, const int* in_sizes, int n_in, void* d_out, int out_size, void* d_ws, size_t ws_size, hipStream_t stream) {
    if (n_in != N_IN || ws_size < WS_END) { fprintf(stderr, "kernel_launch: unexpected inputs (%d) or workspace (%zu < %zu)\n", n_in, ws_size, (size_t)WS_END); return; }
    Params p{};
    for (int i = 0; i < N_IN; ++i) p.in[i] = (const float*)d_in[i];
    p.out = (float*)d_out; p.ws = (char*)d_ws;
#if N_LAUNCH_MODE == 1
    static int grid = 0;
    if (grid == 0) {
        int dev = 0, cus = 0;
        if (hipGetDevice(&dev) != hipSuccess || hipDeviceGetAttribute(&cus, hipDeviceAttributeMultiprocessorCount, dev) != hipSuccess) { grid = -1; return; }
        if (hipFuncSetAttribute((const void*)k_mega, hipFuncAttributeMaxDynamicSharedMemorySize, LDS_BYTES + 256) != hipSuccess) { grid = -1; return; }
        grid = cus;
    }
    if (grid <= 0) return;
    (void)hipMemsetAsync((char*)d_ws + OFF_BAR, 0, XCD_BAR_WORDS * sizeof(unsigned), stream);
    hipLaunchKernelGGL(k_mega, dim3(grid), dim3(NTHREADS), LDS_BYTES + 256, stream, p);
    return;
#endif
#if N_LAUNCH_MODE == 0
    for (int L = 0; L < 2; ++L) {
        const int ntl = L == 0 ? NT : NX;
        launch_phase<PH_MODCONV>(p, L, 0, stream);
        launch_phase<PH_HX>(p, L, 0, stream);
        launch_phase<PH_GEMM_R>(p, L, 0, stream);
        launch_phase<PH_RW_PREP>(p, L, 0, stream);
        launch_phase<PH_RW_SCAN>(p, L, 0, stream);
        launch_phase<PH_RW_READ>(p, L, 0, stream);
        launch_phase<PH_RW_G>(p, L, 0, stream);
        launch_phase<PH_GEMM_N>(p, L, 0, stream);
        launch_phase<PH_NA_ATT>(p, L, 0, stream);
        launch_phase<PH_GEMM_M>(p, L, 0, stream);
        launch_phase<PH_ML_SCAN>(p, L, 0, stream);
        launch_phase<PH_ML_READ>(p, L, 0, stream);
        launch_phase<PH_GEMM_G>(p, L, 0, stream);
        launch_phase<PH_MERGE>(p, L, 0, stream);
        launch_phase<PH_OUT>(p, L, 0, stream);
        launch_phase<PH_NORM2>(p, L, 0, stream);
        launch_phase<PH_ROUTER>(p, L, 0, stream);
        launch_phase<PH_ROUTE>(p, L, 0, stream);
        launch_phase<PH_SHARED>(p, L, 0, stream);
        for (int c = 0; c * MOE_CHUNK < ntl; ++c) {
            launch_phase<PH_MOE_EXP>(p, L, c, stream);
            launch_phase<PH_MOE_COMB>(p, L, c, stream);
        }
    }
#endif
}
```

```cpp
#include <hip/hip_runtime.h>
#include <stdint.h>
#include <stdio.h>

#define DEV __device__ __forceinline__
#define UNROLL _Pragma("unroll")

typedef unsigned short bf16_t;
typedef short bf16x8 __attribute__((ext_vector_type(8)));
typedef float f32x16 __attribute__((ext_vector_type(16)));
typedef float f32x4v __attribute__((ext_vector_type(4)));
typedef unsigned u32x4 __attribute__((ext_vector_type(4)));
typedef unsigned u32x2 __attribute__((ext_vector_type(2)));

constexpr int DM = 1024, NBATCH = 16, SEQ = 2048, CTXL = 256;
constexpr int NX = NBATCH * SEQ, NC = NBATCH * CTXL, NT = NX + NC;
constexpr int RW_COLS = 1920, NA_COLS = 1536, ML_COLS = 1552, GATE_COLS = 3072, IN_COLS = 8080;
constexpr int NTHREADS = 512;
constexpr int MOE_CHUNK = 12288, MOE_ST = 768;

enum { I_X = 0, I_C, I_CTX, I_CCTX, I_WADA, I_BADA, I_N1G, I_N2G, I_WIN, I_MU, I_W0, I_W2, I_A0, I_A2, I_KK, I_KA, I_RK, I_G2,
       I_LNG, I_LNB, I_V0, I_V1, I_V2, I_QNG, I_KNG, I_RPB, I_IB, I_FB, I_MNG, I_WBR, I_WOUT, I_RTR, I_MB, I_MWG, I_MWU, I_MWD,
       I_SG, I_SU, I_SD, N_IN };

constexpr size_t OFF_BAR = 0;
constexpr size_t OFF_MOD = 16384;
constexpr size_t OFF_WINT = OFF_MOD + 417792;
constexpr size_t OFF_WBT = OFF_WINT + (size_t)IN_COLS * 1024 * 2;
constexpr size_t OFF_WOUTT = OFF_WBT + (size_t)3 * 1024 * 512 * 2;
constexpr size_t OFF_SGUT = OFF_WOUTT + (size_t)1024 * 1024 * 2;
constexpr size_t OFF_SDT = OFF_SGUT + (size_t)512 * 1024 * 2;
constexpr size_t OFF_G2T = OFF_SDT + (size_t)1024 * 256 * 2;
constexpr size_t OFF_RTR = OFF_G2T + (size_t)512 * 128 * 2;
constexpr size_t OFF_CTXS = OFF_RTR + (size_t)2 * 64 * 1024 * 2;
constexpr size_t OFF_VF = OFF_CTXS + (size_t)NC * 1024 * 4;
constexpr size_t OFF_HX = OFF_VF + (size_t)NT * 512 * 2;
constexpr size_t OFF_BIG = OFF_HX + (size_t)NT * 1024 * 2;
constexpr size_t SZ_Y1 = (size_t)NT * 512 * 2;
constexpr size_t OFF_YA = OFF_BIG, OFF_YB = OFF_YA + SZ_Y1, OFF_YC = OFF_YB + SZ_Y1;
constexpr size_t OFF_PX = OFF_BIG + 3 * SZ_Y1;
constexpr size_t OFF_SCR = OFF_PX + (size_t)NT * RW_COLS * 2;
constexpr size_t SZ_SCR = (size_t)NT * 1152 * 2;
constexpr size_t OFF_MGU = OFF_SCR + SZ_SCR;
constexpr size_t WS_END = OFF_MGU + (size_t)64 * 256 * 1024 * 2;
constexpr size_t OFF_YS = OFF_YB;
constexpr size_t OFF_SGB = OFF_SCR;
constexpr size_t OFF_CB = OFF_SCR + (size_t)NT * 128 * 2;
constexpr size_t OFF_HS = OFF_SCR;
constexpr size_t OFF_VT = OFF_PX + (size_t)NT * 1024 * 2;
constexpr size_t OFF_VTC = OFF_VT + (size_t)NX * 512 * 2;
constexpr size_t OFF_GATES = OFF_PX;
constexpr size_t OFF_MDT = OFF_BIG;
constexpr size_t OFF_SA = OFF_MDT + (size_t)64 * 1024 * 128 * 2;
constexpr size_t OFF_EIDX = OFF_SA + (size_t)NT * 256 * 2;
constexpr size_t OFF_EW = OFF_EIDX + (size_t)NT * 8 * 4;
constexpr int SORT_CAP = 106496;
constexpr size_t OFF_SORT = OFF_EW + (size_t)NT * 8 * 4;
constexpr size_t OFF_LOG = OFF_SORT + (size_t)3 * SORT_CAP * 4;
constexpr size_t OFF_H2LO = OFF_LOG + (size_t)NT * 64 * 4;
constexpr size_t OFF_YBUF = OFF_LOG;
static_assert(OFF_YBUF + (size_t)MOE_CHUNK * 8 * 1024 * 2 <= WS_END, "moe layout");
static_assert(OFF_GATES + (size_t)NT * 3072 * 2 <= WS_END, "gates layout");
static_assert(WS_END <= (size_t)536870912, "workspace");

constexpr size_t OFF_MCNT = OFF_BAR + 14336;
constexpr int LDS_BYTES = 155648;

struct Topo { int x, r, n; };
struct Params {
    const float* in[N_IN];
    float* out;
    char* ws;
};

DEV int TID() { int t = threadIdx.x; asm volatile("" : "+v"(t)); return t; }
DEV float bf2f(bf16_t h) { return __uint_as_float(((unsigned)h) << 16); }
typedef __bf16 bf16x2n __attribute__((ext_vector_type(2)));
typedef float f32x2n __attribute__((ext_vector_type(2)));
DEV unsigned pk2(float lo, float hi) { const f32x2n v = {lo, hi}; return __builtin_bit_cast(unsigned, __builtin_convertvector(v, bf16x2n)); }
DEV bf16_t f2bf(float f) { return (bf16_t)(pk2(f, 0.f) & 0xffffu); }
DEV void ld8(const bf16_t* p, float (&o)[8]) {
    const u32x4 v = *(const u32x4*)p;
    o[0] = __uint_as_float(v.x << 16); o[1] = __uint_as_float(v.x & 0xffff0000u);
    o[2] = __uint_as_float(v.y << 16); o[3] = __uint_as_float(v.y & 0xffff0000u);
    o[4] = __uint_as_float(v.z << 16); o[5] = __uint_as_float(v.z & 0xffff0000u);
    o[6] = __uint_as_float(v.w << 16); o[7] = __uint_as_float(v.w & 0xffff0000u);
}
DEV void st8(bf16_t* p, const float (&v)[8]) {
    u32x4 o; o.x = pk2(v[0], v[1]); o.y = pk2(v[2], v[3]); o.z = pk2(v[4], v[5]); o.w = pk2(v[6], v[7]);
    *(u32x4*)p = o;
}
#define DPP_MOV(v, ctrl) __builtin_bit_cast(float, __builtin_amdgcn_update_dpp(0, __builtin_bit_cast(int, (v)), (ctrl), 0xF, 0xF, true))
DEV float sum8(float v) { v += DPP_MOV(v, 0xB1); v += DPP_MOV(v, 0x4E); v += DPP_MOV(v, 0x141); return v; }
DEV float frcp(float x) { return __builtin_amdgcn_rcpf(x); }
DEV float sigm(float x) { return frcp(1.f + __expf(-x)); }
DEV float sigm_acc(float x) { return 1.f / (1.f + expf(-x)); }
DEV float tanh_fast(float x) { return 1.f - 2.f * frcp(1.f + __expf(2.f * x)); }
DEV float softplus_fast(float x) { return fmaxf(x, 0.f) + __logf(1.f + __expf(-fabsf(x))); }
DEV int mod_row(int n) { return n < NX ? (n >> 11) : 16; }
DEV float* xs_row(const Params& p, int n) { return n < NX ? p.out + (size_t)n * DM : (float*)(p.ws + OFF_CTXS) + (size_t)(n - NX) * DM; }
DEV const float* xprev_row(const Params& p, int L, int n) {
    if (L == 0) return n < NX ? p.in[I_X] + (size_t)n * DM : p.in[I_CTX] + (size_t)(n - NX) * DM;
    return xs_row(p, n);
}
DEV void seq_of(int n, int& nb, int& tt, int& T) {
    if (n < NX) { nb = n & ~2047; tt = n & 2047; T = SEQ; } else { const int m = n - NX; nb = NX + (m & ~255); tt = m & 255; T = CTXL; }
}
DEV void shift8(const bf16_t* z, int ld, int nb, int tt, int T, int col0, const float* mu, float (&o)[8]) {
    float c[8], l[8], r[8];
    ld8(z + (size_t)(nb + tt) * ld + col0, c);
    if (tt > 0) ld8(z + (size_t)(nb + tt - 1) * ld + col0, l); else { UNROLL for (int i = 0; i < 8; ++i) l[i] = 0.f; }
    if (tt < T - 1) ld8(z + (size_t)(nb + tt + 1) * ld + col0, r); else { UNROLL for (int i = 0; i < 8; ++i) r[i] = 0.f; }
    UNROLL for (int i = 0; i < 8; ++i) o[i] = c[i] + mu[col0 + i] * (0.5f * (l[i] + r[i]) - c[i]);
}

constexpr int LROW = 144;
template <int WM, int WN> struct GC {
    static constexpr int BM = 64 * WM, BN = 64 * WN;
    static constexpr int AB = BM * 128, BB = BN * 128, STG = AB + BB;
    static constexpr int NA = BM / 64, NBC = BN / 64;
};
DEV void acc_zero(f32x16 (&acc)[2][2]) {
    UNROLL for (int a = 0; a < 2; ++a) UNROLL for (int b = 0; b < 2; ++b) UNROLL for (int r = 0; r < 16; ++r) acc[a][b][r] = 0.f;
}
#define GLDS16(gp, lp) __builtin_amdgcn_global_load_lds((const __attribute__((address_space(1))) void*)(gp), (__attribute__((address_space(3))) void*)(lp), 16, 0, 0)
template <int WM, int WN, int NS, bool A_LDS, class ARow>
DEV void gemm_tile(f32x16 (&acc)[2][2], ARow arow, const bf16_t* Bt, int ldb, int n0, int Nvalid, int K, char* smem, const char* alds) {
    typedef GC<WM, WN> C;
    constexpr int LPT = (A_LDS ? 0 : C::NA) + C::NBC;
    const int tid = TID(), lane = tid & 63, wave = tid >> 6, wm = wave / WN, wn = wave % WN;
    const int fr = lane & 31, fh = lane >> 5;
    const int crow = tid >> 3, cch = (tid & 7) ^ ((crow >> 1) & 7);
    const bf16_t* pa[C::NA]; const bf16_t* pb[C::NBC];
    if (!A_LDS) { UNROLL for (int i = 0; i < C::NA; ++i) pa[i] = arow(crow + 64 * i) + cch * 8; }
    UNROLL for (int i = 0; i < C::NBC; ++i) { const int n = min(n0 + crow + 64 * i, Nvalid - 1); pb[i] = Bt + (size_t)n * ldb + cch * 8; }
    const int nk = K >> 6;
#define GT_ISSUE(kt, stg) do { char* sb_ = smem + (stg) * C::STG + tid * 16; \
        if (!A_LDS) { UNROLL for (int i = 0; i < C::NA; ++i) GLDS16(pa[i] + (kt) * 64, sb_ + i * 8192); } \
        UNROLL for (int i = 0; i < C::NBC; ++i) GLDS16(pb[i] + (kt) * 64, sb_ + C::AB + i * 8192); } while (0)
    const int sw = (fr >> 1) & 7;
    int offk[4];
    UNROLL for (int ks = 0; ks < 4; ++ks) offk[ks] = ((2 * ks + fh) ^ sw) * 16;
    const int a_base = (wm * 64 + fr) * 128, b_base = (wn * 64 + fr) * 128;
    UNROLL for (int s = 0; s < NS - 1; ++s) if (s < nk) GT_ISSUE(s, s);
    int stg = 0, nstg = NS - 1;
    for (int kt = 0; kt < nk; ++kt) {
        if (NS == 3 && kt + 1 < nk) asm volatile("s_waitcnt vmcnt(%0)" :: "n"(LPT) : "memory");
        else asm volatile("s_waitcnt vmcnt(0)" ::: "memory");
        __builtin_amdgcn_s_barrier();
        asm volatile("" ::: "memory");
        const bool more = kt + NS - 1 < nk;
        const char* As_ = A_LDS ? alds + kt * C::AB : smem + stg * C::STG; const char* Bs_ = smem + stg * C::STG + C::AB;
        char* db_ = smem + nstg * C::STG + tid * 16;
        bf16x8 af[2][2], bfv[2][2];
        UNROLL for (int mi = 0; mi < 2; ++mi) af[0][mi] = *(const bf16x8*)(As_ + a_base + mi * 4096 + offk[0]);
        UNROLL for (int ni = 0; ni < 2; ++ni) bfv[0][ni] = *(const bf16x8*)(Bs_ + b_base + ni * 4096 + offk[0]);
        UNROLL for (int ks = 0; ks < 4; ++ks) {
            const int cur = ks & 1, nxt = cur ^ 1;
            if (ks < 3) {
                UNROLL for (int mi = 0; mi < 2; ++mi) af[nxt][mi] = *(const bf16x8*)(As_ + a_base + mi * 4096 + offk[ks + 1]);
                UNROLL for (int ni = 0; ni < 2; ++ni) bfv[nxt][ni] = *(const bf16x8*)(Bs_ + b_base + ni * 4096 + offk[ks + 1]);
            }
            UNROLL for (int mi = 0; mi < 2; ++mi) UNROLL for (int ni = 0; ni < 2; ++ni)
                acc[mi][ni] = __builtin_amdgcn_mfma_f32_32x32x16_bf16(af[cur][mi], bfv[cur][ni], acc[mi][ni], 0, 0, 0);
            if (more) {
                UNROLL for (int pc = 0; pc < LPT; ++pc) if (pc * 4 / LPT == ks) {
                    if (!A_LDS && pc < C::NA) GLDS16(pa[pc] + (kt + NS - 1) * 64, db_ + pc * 8192);
                    else { const int ib = pc - (A_LDS ? 0 : C::NA); GLDS16(pb[ib] + (kt + NS - 1) * 64, db_ + C::AB + ib * 8192); }
                }
            }
            __builtin_amdgcn_sched_barrier(0);
        }
        stg = stg + 1 == NS ? 0 : stg + 1; nstg = nstg + 1 == NS ? 0 : nstg + 1;
    }
    __syncthreads();
#undef GT_ISSUE
}
#define ACC_ROW(mi, r, fh) ((mi) * 32 + ((r) & 3) + 8 * ((r) >> 2) + 4 * (fh))

constexpr int EPI_SLAB = 32 * 68 * 4;
template <class F> DEV void epi_rows(const f32x16 (&acc)[2][2], char* smem, F f) {
    const int lane = TID() & 63, wave = TID() >> 6, fr = lane & 31, fh = lane >> 5;
    float* st = (float*)(smem + wave * EPI_SLAB);
    UNROLL for (int mi = 0; mi < 2; ++mi) {
        UNROLL for (int ni = 0; ni < 2; ++ni) UNROLL for (int r = 0; r < 16; ++r)
            st[((r & 3) + 8 * (r >> 2) + 4 * fh) * 68 + ni * 32 + fr] = acc[mi][ni][r];
        UNROLL for (int it = 0; it < 4; ++it) {
            const int row = it * 8 + (lane >> 3), c8 = (lane & 7) * 8;
            const float4 a = *(const float4*)(st + row * 68 + c8), b = *(const float4*)(st + row * 68 + c8 + 4);
            float v[8] = {a.x, a.y, a.z, a.w, b.x, b.y, b.z, b.w};
            f(mi * 32 + row, c8, v);
        }
    }
    __syncthreads();
}


template <class F> DEV void epi_cols(const f32x16 (&acc)[2][2], char* smem, F f) {
    const int lane = TID() & 63, wave = TID() >> 6, fr = lane & 31, fh = lane >> 5;
    float* st = (float*)(smem + wave * EPI_SLAB);
    UNROLL for (int mi = 0; mi < 2; ++mi) {
        UNROLL for (int ni = 0; ni < 2; ++ni) UNROLL for (int r = 0; r < 16; ++r)
            st[((r & 3) + 8 * (r >> 2) + 4 * fh) * 68 + ni * 32 + fr] = acc[mi][ni][r];
        UNROLL for (int it = 0; it < 4; ++it) {
            float v[8];
            UNROLL for (int i = 0; i < 8; ++i) v[i] = st[(it * 8 + i) * 68 + lane];
            f(mi * 32 + it * 8, lane, v);
        }
    }
    __syncthreads();
}

struct TileOrder {
    int x, nN, cx, total;
    DEV TileOrder(const Topo& tp, int nM, int nN_) { x = tp.x; nN = nN_; cx = nM > x ? (nM - x + 7) >> 3 : 0; total = ((cx + 3) >> 2) * 4 * nN; }
    DEV bool get(int q, int& pm, int& pn) const { const int per = 4 * nN, qi = q / per, rem = q - qi * per, i = 4 * qi + (rem & 3); pn = rem >> 2; pm = x + 8 * i; return i < cx; }
};
template <int WM, int WN, class Epi>
DEV void gemm_phase(const bf16_t* A, int lda, int M, const bf16_t* Bt, int ldb, int N, int K, char* smem, const Topo& tp, Epi epi) {
    typedef GC<WM, WN> C;
    const int nM = M / C::BM, nN = (N + C::BN - 1) / C::BN;
    const int wave = TID() >> 6, wm = wave / WN, wn = wave % WN;
    const TileOrder ord(tp, nM, nN);
    for (int q = tp.r; q < ord.total; q += tp.n) {
        int pm, pn; if (!ord.get(q, pm, pn)) continue;
        f32x16 acc[2][2]; acc_zero(acc);
        const bf16_t* Ab = A + (size_t)pm * C::BM * lda;
        gemm_tile<WM, WN, 3, false>(acc, [&](int r) { return Ab + (size_t)r * lda; }, Bt, ldb, pn * C::BN, N, K, smem, nullptr);
        epi(acc, pm * C::BM + wm * 64, pn * C::BN + wn * 64);
    }
}

namespace pg8 {
#define PG8_LAS __attribute__((address_space(3)))
typedef float f32x4 __attribute__((ext_vector_type(4)));
constexpr int BM = 256, BK = 64, HALF = 128, HTB = HALF * BK * 2  , STAGE_BYTES = 8 * HTB, NXCD = 8, WGM = 8;

__host__ __device__ __forceinline__ int lds_byte(int r, int c) { const int st = (r >> 4) * 2 + (c >> 5), rr = r & 15, cc = c & 31, ob = rr * 64 + cc * 2; return st * 1024 + (ob ^ (((ob >> 9) & 1) << 5)); }
__host__ __device__ __forceinline__ void stage_rc(int b, int& R, int& C) { const int st = b / 1024, sb = b % 1024, swz = sb ^ (((sb >> 9) & 1) << 5); R = (st >> 1) * 16 + swz / 64; C = (st & 1) * 32 + (swz % 64) / 2; }
__host__ __device__ __forceinline__ int perm32(int rho) { const int n = rho >> 4, i = rho & 15; return 8 * (i >> 2) + 4 * n + (i & 3); }

struct Unit { int pm, pn; };
struct Gemm { const bf16_t* A; const bf16_t* Bt; int M, N, K; };
template <class Epi, class Sched, bool ALIGN_EPI = false, bool SP2 = false>
__device__ __forceinline__ void gemm_phase(PG8_LAS unsigned char* lds, const Gemm g, const Sched& S, const Epi& E) {
    const int tid = TID(), wid = __builtin_amdgcn_readfirstlane(tid >> 6), lane = tid & 63, wr = wid >> 2, wc = wid & 3, fr = lane & 15, fq = lane >> 4;
    const int K = g.K, nt = K / BK;
    unsigned voffA[2], voffB[2];
#pragma unroll
    for (int i = 0; i < 2; ++i) { int R, C; stage_rc(tid * 16 + i * 8192, R, C); const int Rb = Epi::PERM ? ((R & ~31) + perm32(R & 31)) : R;
        voffA[i] = (unsigned)(R * K + C) * 2u; voffB[i] = (unsigned)(Rb * K + C) * 2u; }
    const size_t kstep = (size_t)(BK * 2);
    const size_t hstep = (size_t)HALF * K * 2;
    const size_t tstep = 2 * hstep;
    const unsigned ldsw = (unsigned)wid * 1024u;
    const int aoff = lds_byte(wr * 64 + fr, fq * 8), boff = lds_byte(wc * 32 + fr, fq * 8);
#define PG8_SA(b, h) (((b) * 2 + (h)) * HTB)
#define PG8_SB(b, h) ((4 + (b) * 2 + (h)) * HTB)
#define PG8_STAGE(bufoff, gbase, voff) do { _Pragma("unroll") for (int _i = 0; _i < 2; ++_i) \
        __builtin_amdgcn_global_load_lds((const unsigned*)((const char*)(gbase) + (voff)[_i]), (PG8_LAS unsigned*)(lds + (bufoff) + ldsw + _i * 8192), 16, 0, 0); } while (0)
#define PG8_LDA(dst, b, h) do { _Pragma("unroll") for (int m = 0; m < 4; ++m) _Pragma("unroll") for (int k = 0; k < 2; ++k) dst[m][k] = *(const PG8_LAS bf16x8*)(lds + PG8_SA(b, h) + aoff + m * 2048 + k * 1024); } while (0)
#define PG8_LDB(dst, b, h) do { _Pragma("unroll") for (int n = 0; n < 2; ++n) _Pragma("unroll") for (int k = 0; k < 2; ++k) dst[n][k] = *(const PG8_LAS bf16x8*)(lds + PG8_SB(b, h) + boff + n * 2048 + k * 1024); } while (0)
#define PG8_MMA(ai, bj, At, Bt) do { __builtin_amdgcn_s_setprio(1); _Pragma("unroll") for (int m = 0; m < 4; ++m) _Pragma("unroll") for (int n = 0; n < 2; ++n) _Pragma("unroll") for (int k = 0; k < 2; ++k) \
        acc[ai][bj][m][n] = __builtin_amdgcn_mfma_f32_16x16x32_bf16(Bt[n][k], At[m][k], acc[ai][bj][m][n], 0, 0, 0); __builtin_amdgcn_s_setprio(0); } while (0)
#define PG8_WAIT_V(n) asm volatile("s_waitcnt vmcnt(" #n ")" ::: "memory")
#define PG8_WAIT_L(n) asm volatile("s_waitcnt lgkmcnt(" #n ")" ::: "memory")
#define PG8_BAR __builtin_amdgcn_s_barrier()
#define PG8_SCHED __builtin_amdgcn_sched_barrier(0)
    Unit cur, nxt; int ui = 0;
    if (!S.next(0, cur)) return;
    f32x4 acc[2][2][4][2];
#pragma unroll
    for (int a = 0; a < 2; ++a)
#pragma unroll
        for (int b = 0; b < 2; ++b)
#pragma unroll
            for (int m = 0; m < 4; ++m)
#pragma unroll
                for (int n = 0; n < 2; ++n) acc[a][b][m][n] = (f32x4){0.f, 0.f, 0.f, 0.f};
    bf16x8 At[4][2], B0[2][2], B1[2][2];
    const char* cA = (const char*)g.A + (size_t)cur.pm * tstep; const char* cB = (const char*)g.Bt + (size_t)cur.pn * tstep;
    S.a_ready(cur);
    if constexpr (SP2) {
        PG8_STAGE(PG8_SB(0, 0), cB, voffB); PG8_STAGE(PG8_SB(0, 1), cB + hstep, voffB); PG8_STAGE(PG8_SA(0, 0), cA, voffA); PG8_STAGE(PG8_SA(0, 1), cA + hstep, voffA);
        if (wr == 1) PG8_BAR;
        PG8_WAIT_V(2); PG8_BAR;
        PG8_STAGE(PG8_SB(1, 0), cB + kstep, voffB); PG8_STAGE(PG8_SA(1, 0), cA + kstep, voffA); PG8_STAGE(PG8_SB(1, 1), cB + hstep + kstep, voffB);
        PG8_WAIT_V(6); PG8_BAR;
    } else {
        PG8_STAGE(PG8_SB(0, 0), cB, voffB); PG8_STAGE(PG8_SA(0, 0), cA, voffA); PG8_STAGE(PG8_SB(0, 1), cB + hstep, voffB); PG8_STAGE(PG8_SA(0, 1), cA + hstep, voffA);
        if (wr == 1) PG8_BAR;
        PG8_WAIT_V(4); PG8_BAR;
        PG8_STAGE(PG8_SB(1, 0), cB + kstep, voffB); PG8_STAGE(PG8_SA(1, 0), cA + kstep, voffA); PG8_STAGE(PG8_SB(1, 1), cB + hstep + kstep, voffB);
        PG8_WAIT_V(6); PG8_BAR;
    }
    for (;;) {
        const bool has_next = S.next(ui + 1, nxt);
        const char* nA = has_next ? (const char*)g.A + (size_t)nxt.pm * tstep : cA; const char* nB = has_next ? (const char*)g.Bt + (size_t)nxt.pn * tstep : cB;
        for (int t = 0; t < nt; t += 2) {
            const bool last = (t == nt - 2);
            const char* a1 = cA + (size_t)(t + 1) * kstep;
            const char* a2 = last ? nA : cA + (size_t)(t + 2) * kstep; const char* b2 = last ? nB : cB + (size_t)(t + 2) * kstep;
            const char* a3 = a2 + kstep; const char* b3 = b2 + kstep;
            if (last && has_next) S.a_ready(nxt);
            if constexpr (SP2) {
            PG8_LDB(B0, 0, 0); PG8_LDB(B1, 0, 1); PG8_SCHED; PG8_LDA(At, 0, 0); PG8_STAGE(PG8_SA(1, 1), a1 + hstep, voffA);
            PG8_WAIT_V(8); PG8_WAIT_L(0); PG8_BAR; PG8_MMA(0, 0, At, B0); PG8_MMA(0, 1, At, B1); PG8_BAR; PG8_SCHED;
            PG8_LDA(At, 0, 1); PG8_STAGE(PG8_SB(0, 0), b2, voffB); PG8_STAGE(PG8_SB(0, 1), b2 + hstep, voffB); PG8_STAGE(PG8_SA(0, 0), a2, voffA);
            PG8_WAIT_V(8); PG8_WAIT_L(0); PG8_BAR; PG8_MMA(1, 0, At, B0); PG8_MMA(1, 1, At, B1); PG8_BAR; PG8_SCHED;
            PG8_LDB(B0, 1, 0); PG8_LDB(B1, 1, 1); PG8_SCHED; PG8_LDA(At, 1, 0); PG8_STAGE(PG8_SA(0, 1), a2 + hstep, voffA);
            PG8_WAIT_V(8); PG8_WAIT_L(0); PG8_BAR; PG8_MMA(0, 0, At, B0); PG8_MMA(0, 1, At, B1); PG8_BAR; PG8_SCHED;
            PG8_LDA(At, 1, 1); PG8_STAGE(PG8_SB(1, 0), b3, voffB); PG8_STAGE(PG8_SB(1, 1), b3 + hstep, voffB); PG8_STAGE(PG8_SA(1, 0), a3, voffA);
            PG8_WAIT_V(8); PG8_WAIT_L(0); PG8_BAR; PG8_MMA(1, 0, At, B0); PG8_MMA(1, 1, At, B1); PG8_BAR; PG8_SCHED;
            } else {
            PG8_LDB(B0, 0, 0); PG8_SCHED; PG8_LDA(At, 0, 0); PG8_STAGE(PG8_SA(1, 1), a1 + hstep, voffA);
            PG8_WAIT_L(8); PG8_BAR; PG8_WAIT_L(0); PG8_MMA(0, 0, At, B0); PG8_BAR; PG8_SCHED;
            PG8_LDB(B1, 0, 1); PG8_STAGE(PG8_SB(0, 0), b2, voffB);
            PG8_BAR; PG8_WAIT_L(0); PG8_MMA(0, 1, At, B1); PG8_BAR;
            PG8_LDA(At, 0, 1); PG8_STAGE(PG8_SA(0, 0), a2, voffA);
            PG8_BAR; PG8_WAIT_L(0); PG8_MMA(1, 0, At, B0); PG8_BAR; PG8_SCHED;
            PG8_STAGE(PG8_SB(0, 1), b2 + hstep, voffB);
            PG8_WAIT_V(6); PG8_BAR; PG8_MMA(1, 1, At, B1); PG8_BAR;
            PG8_LDB(B0, 1, 0); PG8_SCHED; PG8_LDA(At, 1, 0); PG8_STAGE(PG8_SA(0, 1), a2 + hstep, voffA);
            PG8_WAIT_L(8); PG8_BAR; PG8_WAIT_L(0); PG8_MMA(0, 0, At, B0); PG8_BAR; PG8_SCHED;
            PG8_LDB(B1, 1, 1); PG8_STAGE(PG8_SB(1, 0), b3, voffB);
            PG8_BAR; PG8_WAIT_L(0); PG8_MMA(0, 1, At, B1); PG8_BAR;
            PG8_LDA(At, 1, 1); PG8_STAGE(PG8_SA(1, 0), a3, voffA);
            PG8_BAR; PG8_WAIT_L(0); PG8_MMA(1, 0, At, B0); PG8_BAR; PG8_SCHED;
            PG8_STAGE(PG8_SB(1, 1), b3 + hstep, voffB);
            PG8_WAIT_V(6); PG8_BAR; PG8_MMA(1, 1, At, B1); PG8_BAR;
            }
        }
        if constexpr (ALIGN_EPI) { if (wr == 0) PG8_BAR; }
        if constexpr (!Epi::AFTER_DRAIN) { E(acc, cur, wr, wc, fr, fq); S.done(cur); }
        if (!has_next) break;
#pragma unroll
        for (int a = 0; a < 2; ++a)
#pragma unroll
            for (int b = 0; b < 2; ++b)
#pragma unroll
                for (int m = 0; m < 4; ++m)
#pragma unroll
                    for (int n = 0; n < 2; ++n) acc[a][b][m][n] = (f32x4){0.f, 0.f, 0.f, 0.f};
        cur = nxt; cA = nA; cB = nB; ++ui;
        if constexpr (ALIGN_EPI) { if (wr == 1) PG8_BAR; }
    }
    PG8_WAIT_V(0);
    if constexpr (!ALIGN_EPI) { if (wr == 0) PG8_BAR; }
    PG8_BAR;
    if constexpr (Epi::AFTER_DRAIN) { E.fused(acc, cur, wr, wc, fr, fq, lds, wid, lane); S.done(cur); }
#undef PG8_SA
#undef PG8_SB
#undef PG8_STAGE
#undef PG8_LDA
#undef PG8_LDB
#undef PG8_MMA
#undef PG8_WAIT_V
#undef PG8_WAIT_L
#undef PG8_BAR
#undef PG8_SCHED
}
}
template <class F> struct EpiF {
    static constexpr bool PERM = true, AFTER_DRAIN = false; F f;
    DEV void operator()(const pg8::f32x4 (&acc)[2][2][4][2], const pg8::Unit& u, int wr, int wc, int fr, int fq) const {
        UNROLL for (int ai = 0; ai < 2; ++ai) UNROLL for (int m = 0; m < 4; ++m) {
            const int row = u.pm * 256 + ai * 128 + wr * 64 + m * 16 + fr;
            UNROLL for (int bj = 0; bj < 2; ++bj) {
                const int col = u.pn * 256 + bj * 128 + wc * 32 + 8 * fq;
                const float v[8] = {acc[ai][bj][m][0][0], acc[ai][bj][m][0][1], acc[ai][bj][m][0][2], acc[ai][bj][m][0][3],
                                    acc[ai][bj][m][1][0], acc[ai][bj][m][1][1], acc[ai][bj][m][1][2], acc[ai][bj][m][1][3]};
                f(row, col, v);
            }
        }
    }
};
template <class F> struct EpiF2 {
    static constexpr bool PERM = true, AFTER_DRAIN = false; F f;
    DEV void operator()(const pg8::f32x4 (&acc)[2][2][4][2], const pg8::Unit& u, int wr, int wc, int fr, int fq) const {
        UNROLL for (int ai = 0; ai < 2; ++ai) UNROLL for (int m = 0; m < 4; ++m) {
            const int row = u.pm * 256 + ai * 128 + wr * 64 + m * 16 + fr, col = u.pn * 256 + wc * 32 + 8 * fq;
            const float v0[8] = {acc[ai][0][m][0][0], acc[ai][0][m][0][1], acc[ai][0][m][0][2], acc[ai][0][m][0][3], acc[ai][0][m][1][0], acc[ai][0][m][1][1], acc[ai][0][m][1][2], acc[ai][0][m][1][3]};
            const float v1[8] = {acc[ai][1][m][0][0], acc[ai][1][m][0][1], acc[ai][1][m][0][2], acc[ai][1][m][0][3], acc[ai][1][m][1][0], acc[ai][1][m][1][1], acc[ai][1][m][1][2], acc[ai][1][m][1][3]};
            f(row, col, v0, v1);
        }
    }
};
struct XOrder {
    int x, r, n, nN, cx, fullq, total;
    DEV XOrder(const Topo& tp, int nM, int nN_) { x = tp.x; r = tp.r; n = tp.n; nN = nN_; cx = nM > x ? (nM - x + 7) >> 3 : 0; fullq = cx >> 2; total = cx * nN; }
    DEV bool next(int i, pg8::Unit& u) const {
        const int q = r + i * n; if (q >= total) return false;
        const int per = 4 * nN;
        if (q < fullq * per) { const int qi = q / per, rem = q - qi * per; u.pn = rem >> 2; u.pm = x + 8 * (4 * qi + (rem & 3)); }
        else { const int rem = q - fullq * per, cq = cx - 4 * fullq; u.pn = rem / cq; u.pm = x + 8 * (4 * fullq + rem % cq); }
        return true;
    }
    DEV void a_ready(const pg8::Unit&) const {}
    DEV void done(const pg8::Unit&) const {}
};
template <class F> DEV void gemm256_pair(const bf16_t* A, int M, const bf16_t* Bt, int N, int K, char* smem, const Topo& tp, F f) {
    const pg8::Gemm g{A, Bt, M, N, K};
    const XOrder S(tp, M / 256, (N + 255) / 256);
    const EpiF2<F> E{f};
    pg8::gemm_phase<EpiF2<F>, XOrder, true, true>((PG8_LAS unsigned char*)smem, g, S, E);
}
template <class F> DEV void gemm256(const bf16_t* A, int M, const bf16_t* Bt, int N, int K, char* smem, const Topo& tp, F f) {
    const pg8::Gemm g{A, Bt, M, N, K};
    const XOrder S(tp, M / 256, (N + 255) / 256);
    const EpiF<F> E{f};
    pg8::gemm_phase<EpiF<F>, XOrder, true, true>((PG8_LAS unsigned char*)smem, g, S, E);
}

DEV void ph_mod(const Params& p, int L, char* smem) {
    const int tid = TID();
    float* sc = (float*)smem;
    float* red = sc + 17 * 1024;
    const float* c = p.in[I_C]; const float* cc = p.in[I_CCTX];
    for (int i = tid; i < 17 * 1024; i += NTHREADS) { const float v = i < 16 * 1024 ? c[i] : cc[i - 16 * 1024]; sc[i] = v / (1.f + expf(-v)); }
    __syncthreads();
    const float* W = p.in[I_WADA] + (size_t)L * 1024 * 6144; const float* bA = p.in[I_BADA] + (size_t)L * 6144;
    float* MOD = (float*)(p.ws + OFF_MOD);
    for (int u = blockIdx.x; u < 192; u += gridDim.x) {
        const int ci = tid & 31, ks = tid >> 5, j = u * 32 + ci;
        float acc[17];
        UNROLL for (int r = 0; r < 17; ++r) acc[r] = 0.f;
        for (int k = ks * 64; k < ks * 64 + 64; ++k) {
            const float w = W[(size_t)k * 6144 + j];
            UNROLL for (int r = 0; r < 17; ++r) acc[r] += sc[r * 1024 + k] * w;
        }
        UNROLL for (int r = 0; r < 17; ++r) red[(ks * 17 + r) * 32 + ci] = acc[r];
        __syncthreads();
        for (int i = tid; i < 17 * 32; i += NTHREADS) {
            const int r = i >> 5, c2 = i & 31; float s = bA[u * 32 + c2];
            for (int k2 = 0; k2 < 16; ++k2) s += red[(k2 * 17 + r) * 32 + c2];
            MOD[r * 6144 + u * 32 + c2] = s;
        }
        __syncthreads();
    }
}
DEV void conv_job(const float* s0, const float* s1, bf16_t* d, int K, int N, int mode, int nmat, size_t sstride, size_t dstride, char* smem, int bid = -1, int nb = 0) {
    if (bid < 0) { bid = blockIdx.x; nb = gridDim.x; }
    float* tile = (float*)smem;
    const int tid = TID();
    const int tK = K / 64, tN = (mode == 1 || mode == 3) ? (2 * N) / 64 : (N + 63) / 64, per = tK * tN;
    for (int t = bid; t < per * nmat; t += nb) {
        const int mat = t / per, r = t % per, tk = r / tN, tn = r % tN;
        const float* a0 = s0 + (size_t)mat * sstride; const float* a1 = s1 ? s1 + (size_t)mat * sstride : nullptr;
        bf16_t* dd = d + (size_t)mat * dstride;
        UNROLL for (int i = 0; i < 8; ++i) {
            const int cc = tid & 63, k = (tid >> 6) + 8 * i; float v;
            if (mode == 1) { const float* s = (cc >> 5) ? a1 : a0; v = s[(size_t)(tk * 64 + k) * N + tn * 32 + (cc & 31)]; }
            else if (mode == 3) { const float* s = ((tn >> 1) & 1) ? a1 : a0; v = s[(size_t)(tk * 64 + k) * N + (tn >> 2) * 128 + (tn & 1) * 64 + cc]; }
            else { const int n = tn * 64 + cc; v = n < N ? a0[(size_t)(tk * 64 + k) * N + n] : 0.f; }
            tile[k * 65 + cc] = v;
        }
        __syncthreads();
        UNROLL for (int i = 0; i < 8; ++i) {
            const int k = tid & 63, cc = (tid >> 6) + 8 * i; const int row = tn * 64 + cc;
            const float v = tile[k * 65 + cc];
            if (mode == 1 || mode == 3 || row < N) {
                const bf16_t hi = f2bf(v);
                dd[(size_t)row * K + tk * 64 + k] = hi;
                if (mode == 2) dd[(size_t)N * K + (size_t)row * K + tk * 64 + k] = f2bf(v - bf2f(hi));
            }
        }
        __syncthreads();
    }
}
DEV void ph_conv_mix(const Params& p, int L, char* smem) {
    char* ws = p.ws;
    conv_job(p.in[I_WIN] + (size_t)L * 1024 * IN_COLS, nullptr, (bf16_t*)(ws + OFF_WINT), 1024, IN_COLS, 0, 1, 0, 0, smem);
    conv_job(p.in[I_WBR] + (size_t)L * 3 * 512 * 1024, nullptr, (bf16_t*)(ws + OFF_WBT), 512, 1024, 0, 3, (size_t)512 * 1024, (size_t)512 * 1024, smem);
    conv_job(p.in[I_WOUT] + (size_t)L * 1024 * 1024, nullptr, (bf16_t*)(ws + OFF_WOUTT), 1024, 1024, 0, 1, 0, 0, smem);
    conv_job(p.in[I_SG] + (size_t)L * 1024 * 256, p.in[I_SU] + (size_t)L * 1024 * 256, (bf16_t*)(ws + OFF_SGUT), 1024, 256, 3, 1, 0, 0, smem);
    conv_job(p.in[I_SD] + (size_t)L * 256 * 1024, nullptr, (bf16_t*)(ws + OFF_SDT), 256, 1024, 0, 1, 0, 0, smem);
    conv_job(p.in[I_G2] + (size_t)L * 128 * 512, nullptr, (bf16_t*)(ws + OFF_G2T), 128, 512, 0, 1, 0, 0, smem);
    conv_job(p.in[I_RTR] + (size_t)L * 1024 * 64, nullptr, (bf16_t*)(ws + OFF_RTR), 1024, 64, 2, 1, 0, 0, smem);
}
DEV void ph_conv_moe_gu(const Params& p, int L, char* smem, int bid, int nb) {
    const size_t eo = (size_t)L * 64 * 1024 * 128;
    conv_job(p.in[I_MWG] + eo, p.in[I_MWU] + eo, (bf16_t*)(p.ws + OFF_MGU), 1024, 128, 1, 64, (size_t)1024 * 128, (size_t)256 * 1024, smem, bid, nb);
}
DEV void ph_conv_moe(const Params& p, int L, char* smem, int bid, int nb) {
    const size_t eo = (size_t)L * 64 * 1024 * 128;
    conv_job(p.in[I_MWD] + eo, nullptr, (bf16_t*)(p.ws + OFF_MDT), 128, 1024, 0, 64, (size_t)128 * 1024, (size_t)1024 * 128, smem, bid, nb);
}

DEV void ph_norm(const Params& p, int L, int which, int ntok) {
    const int lane = TID() & 63, wave = TID() >> 6;
    const float* MOD = (const float*)(p.ws + OFF_MOD);
    const float* g = p.in[which ? I_N2G : I_N1G] + (size_t)L * DM;
    bf16_t* H = (bf16_t*)(p.ws + OFF_HX); bf16_t* HLO = (bf16_t*)(p.ws + OFF_H2LO);
    for (int n0 = blockIdx.x * 8; n0 < ntok; n0 += gridDim.x * 8) {
        const int n = n0 + wave;
        const float* xr = which ? xs_row(p, n) : xprev_row(p, L, n);
        float4 v[4]; float ss = 0.f;
        UNROLL for (int i = 0; i < 4; ++i) { v[i] = *(const float4*)(xr + i * 256 + lane * 4); ss += v[i].x * v[i].x + v[i].y * v[i].y + v[i].z * v[i].z + v[i].w * v[i].w; }
        UNROLL for (int o = 1; o < 64; o <<= 1) ss += __shfl_xor(ss, o);
        const float rstd = rsqrtf(ss * (1.f / DM) + 1e-6f);
        const float* sh = MOD + mod_row(n) * 6144 + (which ? 3 : 0) * DM; const float* sc = sh + DM;
        UNROLL for (int i = 0; i < 4; ++i) {
            const int c = i * 256 + lane * 4;
            const float4 gg = *(const float4*)(g + c), s1 = *(const float4*)(sc + c), s0 = *(const float4*)(sh + c);
            const float h0 = v[i].x * rstd * gg.x * (1.f + s1.x) + s0.x, h1 = v[i].y * rstd * gg.y * (1.f + s1.y) + s0.y;
            const float h2 = v[i].z * rstd * gg.z * (1.f + s1.z) + s0.z, h3 = v[i].w * rstd * gg.w * (1.f + s1.w) + s0.w;
            u32x2 o; o.x = pk2(h0, h1); o.y = pk2(h2, h3);
            *(u32x2*)(H + (size_t)n * DM + c) = o;
            if (which) {
                u32x2 o2;
                o2.x = pk2(h0 - bf2f((bf16_t)(o.x & 0xffff)), h1 - bf2f((bf16_t)(o.x >> 16)));
                o2.y = pk2(h2 - bf2f((bf16_t)(o.y & 0xffff)), h3 - bf2f((bf16_t)(o.y >> 16)));
                *(u32x2*)(HLO + (size_t)n * DM + c) = o2;
            }
        }
    }
}

DEV void ph_rw_prep(const Params& p, int L, char* smem) {
    const int lane = TID() & 63, wave = TID() >> 6;
    float* vsh = (float*)smem + wave * 512;
    const bf16_t* PXR = (const bf16_t*)(p.ws + OFF_PX); bf16_t* VF = (bf16_t*)(p.ws + OFF_VF);
    const float* mu = p.in[I_MU] + (size_t)L * RW_COLS;
    const float* v0 = p.in[I_V0]; const float* v1 = p.in[I_V1]; const float* v2 = p.in[I_V2];
    for (int n0 = blockIdx.x * 8; n0 < NT; n0 += gridDim.x * 8) {
        const int n = n0 + wave; int nb, tt, T; seq_of(n, nb, tt, T);
        float vs[8]; shift8(PXR, RW_COLS, nb, tt, T, 1024 + lane * 8, mu, vs);
        if (L == 0) { st8(VF + (size_t)n * 512 + lane * 8, vs); }
        else {
            UNROLL for (int i = 0; i < 8; ++i) vsh[lane * 8 + i] = vs[i];
            __syncthreads();
            const int q = lane & 31, hf = lane >> 5; float t1 = 0.f;
            for (int jj = 0; jj < 256; ++jj) t1 += vsh[hf * 256 + jj] * v1[(hf * 256 + jj) * 32 + q];
            t1 += __shfl_xor(t1, 32);
            float u[8];
            UNROLL for (int i = 0; i < 8; ++i) u[i] = v0[lane * 8 + i];
            for (int q2 = 0; q2 < 32; ++q2) { const float tq = __shfl(t1, q2); UNROLL for (int i = 0; i < 8; ++i) u[i] += tq * v2[q2 * 512 + lane * 8 + i]; }
            float vf[8], o[8]; ld8(VF + (size_t)n * 512 + lane * 8, vf);
            UNROLL for (int i = 0; i < 8; ++i) o[i] = vs[i] + (vf[i] - vs[i]) * sigm(u[i]);
            st8(VF + (size_t)n * 512 + lane * 8, o);
            __syncthreads();
        }
    }
}

DEV bf16x8 pk_lohi(u32x2 lo, u32x2 hi) { u32x4 w; w.x = lo.x; w.y = lo.y; w.z = hi.x; w.w = hi.y; return __builtin_bit_cast(bf16x8, w); }
DEV bf16x8 pk_acc2(const f32x4v& a, const f32x4v& b) { u32x4 w; w.x = pk2(a[0], a[1]); w.y = pk2(a[2], a[3]); w.z = pk2(b[0], b[1]); w.w = pk2(b[2], b[3]); return __builtin_bit_cast(bf16x8, w); }
DEV bf16x8 pk_acc1(const f32x4v& a) { u32x4 w; w.x = pk2(a[0], a[1]); w.y = pk2(a[2], a[3]); w.z = 0u; w.w = 0u; return __builtin_bit_cast(bf16x8, w); }
#define MFMA16(a, b, c) __builtin_amdgcn_mfma_f32_16x16x32_bf16((a), (b), (c), 0, 0, 0)
struct Raw3 { u32x4 l, c, r; };
DEV Raw3 rw_raw(const bf16_t* z, int ld, int nb, int tt, int T, int col0) {
    Raw3 o;
    o.c = *(const u32x4*)(z + (size_t)(nb + tt) * ld + col0);
    o.l = *(const u32x4*)(z + (size_t)(nb + max(tt - 1, 0)) * ld + col0);
    o.r = *(const u32x4*)(z + (size_t)(nb + min(tt + 1, T - 1)) * ld + col0);
    return o;
}
DEV void unpack8(u32x4 v, float (&o)[8]) {
    o[0] = __uint_as_float(v.x << 16); o[1] = __uint_as_float(v.x & 0xffff0000u); o[2] = __uint_as_float(v.y << 16); o[3] = __uint_as_float(v.y & 0xffff0000u);
    o[4] = __uint_as_float(v.z << 16); o[5] = __uint_as_float(v.z & 0xffff0000u); o[6] = __uint_as_float(v.w << 16); o[7] = __uint_as_float(v.w & 0xffff0000u);
}
DEV void shift_from_raw(const Raw3& w, int tt, int T, const float* mu8, float (&o)[8]) {
    float c[8], l[8], r[8]; unpack8(w.c, c); unpack8(w.l, l); unpack8(w.r, r);
    const float ml = tt > 0 ? 0.5f : 0.f, mr = tt < T - 1 ? 0.5f : 0.f;
    UNROLL for (int i = 0; i < 8; ++i) o[i] = c[i] + mu8[i] * (ml * l[i] + mr * r[i] - c[i]);
}
DEV void ph_rw_scan(const Params& p, int L, char* smem) {
    const int tid = TID();
    const int wave = __builtin_amdgcn_readfirstlane(tid >> 6);
    char* AT = smem; char* BT = smem + 9216; char* KT = smem + 18432; char* RT = smem + 27648;
    char* BH = smem + 36864; char* KH = smem + 46080; char* VT = smem + 55296;
    char* W2T = smem + 64512; char* A2T = smem + 73728;
    float* PCv = (float*)(smem + 82944); float* SEGT = PCv + 64;
    char* XY = smem + 85248;
    char* T1 = XY; char* T2 = XY + 9216; float* WLf = (float*)(XY + 18432); float* ALf = (float*)(XY + 35840); float* LW = (float*)XY;
    float* TOT = (float*)(XY + 62720);
    float* PAR = (float*)(XY + 60416);
    char* NAB = XY; char* NAK = XY + 9216; char* NRB = XY + 18432; char* NRK = XY + 27648; char* TJ = XY + 36864; float* NDF = (float*)(XY + 38912); float* YO = (float*)(XY + 43008);
    const bf16_t* PXR = (const bf16_t*)(p.ws + OFF_PX); const bf16_t* VF = (const bf16_t*)(p.ws + OFF_VF);
    bf16_t* YS = (bf16_t*)(p.ws + OFF_YS); float* CB = (float*)(p.ws + OFF_CB);
    const float* mu = p.in[I_MU] + (size_t)L * RW_COLS;
    const float* w0 = p.in[I_W0] + (size_t)L * 1024; const float* w2 = p.in[I_W2] + (size_t)L * 65536;
    const float* a0 = p.in[I_A0] + (size_t)L * 1024; const float* a2 = p.in[I_A2] + (size_t)L * 65536;
    const float* kkw = p.in[I_KK] + (size_t)L * 512; const float* kaw = p.in[I_KA] + (size_t)L * 512; const float* rkw = p.in[I_RK] + (size_t)L * 512;
    for (int u = blockIdx.x; u < 256; u += gridDim.x) {
        const int b = u >> 4, h = (u >> 1) & 7, d = u & 1;
        for (int i = tid; i < 4096; i += NTHREADS) {
            const int l = i >> 6, n = i & 63;
            *(bf16_t*)(W2T + n * LROW + l * 2) = f2bf(w2[(size_t)(d * 64 + l) * 512 + h * 64 + n]);
            *(bf16_t*)(A2T + n * LROW + l * 2) = f2bf(a2[(size_t)(d * 64 + l) * 512 + h * 64 + n]);
        }
        if (tid < 64) {
            const int n = tid;
            PAR[n] = w0[d * 512 + h * 64 + n]; PAR[64 + n] = a0[d * 512 + h * 64 + n];
            PAR[128 + n] = kkw[h * 64 + n]; PAR[192 + n] = kaw[h * 64 + n]; PAR[256 + n] = rkw[h * 64 + n];
            PAR[320 + n] = mu[1536 + d * 64 + n]; PAR[384 + n] = mu[1664 + d * 64 + n]; PAR[448 + n] = mu[h * 64 + n]; PAR[512 + n] = mu[512 + h * 64 + n];
        }
        f32x4v sacc[4];
        UNROLL for (int i = 0; i < 4; ++i) sacc[i] = (f32x4v){0.f, 0.f, 0.f, 0.f};
        __syncthreads();
        Raw3 pw1, pw2, pr, pk; u32x4 pv;
#define RW_GEOM(ci_, tido_) const bool isc = (ci_) < 4; const int T = isc ? CTXL : SEQ, cc = isc ? (ci_) : (ci_) - 4; \
            const int t0 = d == 0 ? cc * 64 : T - 64 * (cc + 1), nb = isc ? NX + b * CTXL : b * SEQ; \
            const int tt = d == 0 ? t0 + ((tido_) >> 3) : t0 + 63 - ((tido_) >> 3);
#define RW_PREFETCH(ci_, tido_) do { RW_GEOM(ci_, tido_) const int j_ = (tido_) & 7; \
            pw1 = rw_raw(PXR, RW_COLS, nb, tt, T, 1536 + d * 64 + 8 * j_); pw2 = rw_raw(PXR, RW_COLS, nb, tt, T, 1664 + d * 64 + 8 * j_); \
            pr = rw_raw(PXR, RW_COLS, nb, tt, T, h * 64 + 8 * j_); pk = rw_raw(PXR, RW_COLS, nb, tt, T, 512 + h * 64 + 8 * j_); \
            pv = *(const u32x4*)(VF + (size_t)(nb + tt) * 512 + h * 64 + 8 * j_); } while (0)
        RW_PREFETCH(0, tid);
        for (int ci = 0; ci < 36; ++ci) {
            int tido = tid; asm volatile("" : "+v"(tido));
            const int lane = tido & 63, lq = lane & 15, kg = lane >> 4, ti = tido >> 3, j = tido & 7;
            const int ch = h * 64 + 8 * j;
            RW_GEOM(ci, tido)
            float r8[8], k8[8], v8[8];
            {
                float x1[8], x2[8];
                shift_from_raw(pw1, tt, T, PAR + 320 + 8 * j, x1);
                shift_from_raw(pw2, tt, T, PAR + 384 + 8 * j, x2);
                UNROLL for (int i = 0; i < 8; ++i) x1[i] = tanh_fast(x1[i]);
                st8((bf16_t*)(T1 + ti * LROW) + 8 * j, x1); st8((bf16_t*)(T2 + ti * LROW) + 8 * j, x2);
                shift_from_raw(pr, tt, T, PAR + 448 + 8 * j, r8);
                shift_from_raw(pk, tt, T, PAR + 512 + 8 * j, k8);
                unpack8(pv, v8);
            }
            __syncthreads();
            _Pragma("unroll 1") for (int rep = 0; rep < 4; ++rep) {
                const int q = wave + 8 * rep, m = q >> 4, tl = q & 15, tt4 = tl >> 2, nt4 = tl & 3;
                const char* Ab = (m ? T2 : T1) + (16 * tt4 + lq) * LROW + kg * 16; const char* Bb = (m ? A2T : W2T) + (16 * nt4 + lq) * LROW + kg * 16;
                f32x4v a = {0.f, 0.f, 0.f, 0.f};
                UNROLL for (int ks = 0; ks < 2; ++ks) a = MFMA16(*(const bf16x8*)(Ab + ks * 64), *(const bf16x8*)(Bb + ks * 64), a);
                float* dst = (m ? ALf : WLf) + (16 * tt4 + 4 * kg) * 68 + 16 * nt4 + lq;
                UNROLL for (int i = 0; i < 4; ++i) dst[i * 68] = a[i];
            }
            __syncthreads();
            float av[8], bv[8], kd8[8];
            {
                const float4 wa = *(const float4*)(WLf + ti * 68 + 8 * j), wb = *(const float4*)(WLf + ti * 68 + 8 * j + 4);
                const float4 aa = *(const float4*)(ALf + ti * 68 + 8 * j), ab = *(const float4*)(ALf + ti * 68 + 8 * j + 4);
                const float wl[8] = {wa.x, wa.y, wa.z, wa.w, wb.x, wb.y, wb.z, wb.w}, al[8] = {aa.x, aa.y, aa.z, aa.w, ab.x, ab.y, ab.z, ab.w};
                float ss = 0.f, cbp = 0.f, alpha[8], kkr[8], lw[8];
                UNROLL for (int i = 0; i < 8; ++i) {
                    const float xw = -(PAR[8 * j + i] + wl[i]);
                    const float sp = softplus_fast(xw);
                    lw[i] = -__expf(-sp - 0.5f);
                    alpha[i] = sigm(PAR[64 + 8 * j + i] + al[i]);
                    kkr[i] = k8[i] * PAR[128 + 8 * j + i]; ss += kkr[i] * kkr[i];
                    kd8[i] = k8[i] * (1.f + (alpha[i] - 1.f) * PAR[192 + 8 * j + i]);
                    cbp += r8[i] * kd8[i] * PAR[256 + 8 * j + i];
                }
                ss = sum8(ss); cbp = sum8(cbp);
                const float inv = frcp(fmaxf(__builtin_amdgcn_sqrtf(ss), 1e-12f));
                UNROLL for (int i = 0; i < 8; ++i) { const float kk = kkr[i] * inv; av[i] = -kk; bv[i] = kk * alpha[i]; }
                *(float4*)(LW + ti * 64 + 8 * j) = make_float4(lw[0], lw[1], lw[2], lw[3]); *(float4*)(LW + ti * 64 + 8 * j + 4) = make_float4(lw[4], lw[5], lw[6], lw[7]);
                if (j == 0) CB[((size_t)d * NT + nb + tt) * 8 + h] = cbp;
            }
            __syncthreads();
            {
                const int n = tid & 63, seg = wave; float run[8], acc = 0.f;
                UNROLL for (int r = 0; r < 8; ++r) { acc += LW[(seg * 8 + r) * 64 + n]; run[r] = acc; }
                SEGT[seg * 64 + n] = acc;
                __syncthreads();
                float off = 0.f, tot = 0.f;
                UNROLL for (int s2 = 0; s2 < 8; ++s2) { const float sv = SEGT[s2 * 64 + n]; tot += sv; off += s2 < seg ? sv : 0.f; }
                UNROLL for (int r = 0; r < 8; ++r) LW[(seg * 8 + r) * 64 + n] = run[r] + off;
                if (seg == 0) { TOT[n] = tot; PCv[n] = __expf(tot); }
            }
            __syncthreads();
            {
                const float4 ta = *(const float4*)(TOT + 8 * j), tb = *(const float4*)(TOT + 8 * j + 4);
                const float tot[8] = {ta.x, ta.y, ta.z, ta.w, tb.x, tb.y, tb.z, tb.w};
                const float4 la = *(const float4*)(LW + ti * 64 + 8 * j), lb = *(const float4*)(LW + ti * 64 + 8 * j + 4);
                const float lpl[8] = {la.x, la.y, la.z, la.w, lb.x, lb.y, lb.z, lb.w};
                float lpm[8];
                if (ti != 0) {
                    const float4 ma = *(const float4*)(LW + (ti - 1) * 64 + 8 * j), mb = *(const float4*)(LW + (ti - 1) * 64 + 8 * j + 4);
                    lpm[0] = ma.x; lpm[1] = ma.y; lpm[2] = ma.z; lpm[3] = ma.w; lpm[4] = mb.x; lpm[5] = mb.y; lpm[6] = mb.z; lpm[7] = mb.w;
                } else { UNROLL for (int i = 0; i < 8; ++i) lpm[i] = 0.f; }
                float oa[8], ob[8], ok[8], orr[8];
                const int wofs = (((ti >> 3) ^ j) << 4) + (ti & 7) * 2;
                UNROLL for (int i = 0; i < 8; ++i) {
                    const float lp = lpl[i], lm = lpm[i];
                    const float eP = __expf(lp), eM = __expf(-lp), ePm = __expf(lm), eE = __expf(tot[i] - lp);
                    oa[i] = av[i] * ePm; ob[i] = bv[i] * eM; ok[i] = kd8[i] * eM; orr[i] = r8[i] * eP;
                    *(bf16_t*)(BH + (8 * j + i) * LROW + wofs) = f2bf(bv[i] * eE);
                    *(bf16_t*)(KH + (8 * j + i) * LROW + wofs) = f2bf(kd8[i] * eE);
                    *(bf16_t*)(VT + (8 * j + i) * LROW + wofs) = f2bf(v8[i]);
                }
                st8((bf16_t*)(AT + ti * LROW) + 8 * j, oa); st8((bf16_t*)(BT + ti * LROW) + 8 * j, ob);
                st8((bf16_t*)(KT + ti * LROW) + 8 * j, ok); st8((bf16_t*)(RT + ti * LROW) + 8 * j, orr);
            }
            __syncthreads();
            if (ci + 1 < 36) RW_PREFETCH(ci + 1, tido);
            _Pragma("unroll 1") for (int rep = 0; rep < 6; ++rep) {
                const int q = wave + 8 * rep, m = q / 12, tl = q - 12 * m;
                const int tt4 = tl >= 10 ? 2 * (tl - 10) : tl < 1 ? 0 : tl < 3 ? 1 : tl < 6 ? 2 : 3, st4 = tl >= 10 ? tt4 + 1 : tl - (tt4 * (tt4 + 1)) / 2;
                char* dstm = m == 0 ? NAB : m == 1 ? NAK : m == 2 ? NRB : NRK;
                f32x4v a = {0.f, 0.f, 0.f, 0.f};
                if (st4 <= tt4) {
                    const char* Ab = (m < 2 ? AT : RT) + (16 * tt4 + lq) * LROW + kg * 16; const char* Bb = ((m & 1) ? KT : BT) + (16 * st4 + lq) * LROW + kg * 16;
                    UNROLL for (int ks = 0; ks < 2; ++ks) a = MFMA16(*(const bf16x8*)(Ab + ks * 64), *(const bf16x8*)(Bb + ks * 64), a);
                }
                const int sidx = 16 * st4 + lq;
                UNROLL for (int i = 0; i < 4; ++i) {
                    const int tidx = 16 * tt4 + 4 * kg + i;
                    const bool keep = m < 2 ? sidx < tidx : sidx <= tidx;
                    const float val = keep ? a[i] : 0.f;
                    *(bf16_t*)(dstm + tidx * LROW + sidx * 2) = f2bf(val);
                    if (m == 0 && st4 == tt4) NDF[(tt4 * 16 + 4 * kg + i) * 16 + lq] = val;
                }
            }
            __syncthreads();
            f32x4v xacc[4], yacc[4];
            bf16x8 vt[2];
            if (wave == 7) {
                const int blk = lane >> 4, c = lane & 15;
                float Tc[16];
                UNROLL for (int t = 0; t < 16; ++t) {
                    float a = t == c ? 1.f : 0.f;
                    UNROLL for (int s2 = 0; s2 < t; ++s2) a += NDF[(blk * 16 + t) * 16 + s2] * Tc[s2];
                    Tc[t] = a;
                }
                UNROLL for (int t = 0; t < 16; ++t) *(bf16_t*)(TJ + (blk * 16 + t) * 32 + c * 2) = f2bf(Tc[t]);
            } else if (wave < 4) {
                bf16x8 sb[2];
                UNROLL for (int kk = 0; kk < 2; ++kk) { sb[kk] = pk_acc2(sacc[2 * kk], sacc[2 * kk + 1]); vt[kk] = *(const bf16x8*)(VT + (16 * wave + lq) * LROW + (((4 * kk + kg) ^ (2 * wave + (lq >> 3))) << 4)); }
                UNROLL for (int t4 = 0; t4 < 4; ++t4) {
                    f32x4v x = {0.f, 0.f, 0.f, 0.f}, y = {0.f, 0.f, 0.f, 0.f};
                    UNROLL for (int kk = 0; kk < 2; ++kk) {
                        const char* pa = AT + (16 * t4 + lq) * LROW + (32 * kk + 4 * kg) * 2; const char* pr = RT + (16 * t4 + lq) * LROW + (32 * kk + 4 * kg) * 2;
                        x = MFMA16(pk_lohi(*(const u32x2*)pa, *(const u32x2*)(pa + 32)), sb[kk], x);
                        y = MFMA16(pk_lohi(*(const u32x2*)pr, *(const u32x2*)(pr + 32)), sb[kk], y);
                        if (2 * kk <= t4) {
                            x = MFMA16(*(const bf16x8*)(NAK + (16 * t4 + lq) * LROW + kk * 64 + kg * 16), vt[kk], x);
                            y = MFMA16(*(const bf16x8*)(NRK + (16 * t4 + lq) * LROW + kk * 64 + kg * 16), vt[kk], y);
                        }
                    }
                    xacc[t4] = x; yacc[t4] = y;
                }
            }
            __syncthreads();
            if (wave < 4) {
                const u32x2 z2 = {0u, 0u};
                f32x4v uacc[4];
                {
                    const u32x2 t0v = *(const u32x2*)(TJ + (0 * 16 + lq) * 32 + 4 * kg * 2);
                    uacc[0] = MFMA16(pk_lohi(t0v, z2), pk_acc1(xacc[0]), ((f32x4v){0.f, 0.f, 0.f, 0.f}));
                }
                UNROLL for (int jb = 1; jb < 4; ++jb) {
                    f32x4v z = xacc[jb];
                    const char* nr = NAB + (16 * jb + lq) * LROW + 4 * kg * 2;
                    if (jb == 1) z = MFMA16(pk_lohi(*(const u32x2*)nr, z2), pk_acc1(uacc[0]), z);
                    else {
                        z = MFMA16(pk_lohi(*(const u32x2*)nr, *(const u32x2*)(nr + 32)), pk_acc2(uacc[0], uacc[1]), z);
                        if (jb == 3) z = MFMA16(pk_lohi(*(const u32x2*)(nr + 64), z2), pk_acc1(uacc[2]), z);
                    }
                    const u32x2 tv = *(const u32x2*)(TJ + (jb * 16 + lq) * 32 + 4 * kg * 2);
                    uacc[jb] = MFMA16(pk_lohi(tv, z2), pk_acc1(z), ((f32x4v){0.f, 0.f, 0.f, 0.f}));
                }
                bf16x8 ub[2]; ub[0] = pk_acc2(uacc[0], uacc[1]); ub[1] = pk_acc2(uacc[2], uacc[3]);
                UNROLL for (int t4 = 0; t4 < 4; ++t4) {
                    f32x4v y = yacc[t4];
                    UNROLL for (int kk = 0; kk < 2; ++kk) if (2 * kk <= t4) {
                        const char* pn = NRB + (16 * t4 + lq) * LROW + (32 * kk + 4 * kg) * 2;
                        y = MFMA16(pk_lohi(*(const u32x2*)pn, *(const u32x2*)(pn + 32)), ub[kk], y);
                    }
                    UNROLL for (int i = 0; i < 4; ++i) YO[(16 * t4 + 4 * kg + i) * 68 + 16 * wave + lq] = y[i];
                }
                UNROLL for (int kt = 0; kt < 4; ++kt) {
                    f32x4v sv = sacc[kt];
                    UNROLL for (int i = 0; i < 4; ++i) sv[i] *= PCv[16 * kt + 4 * kg + i];
                    UNROLL for (int kk = 0; kk < 2; ++kk) {
                        const int xr = 2 * kt + (lq >> 3);
                        const char* pb = BH + (16 * kt + lq) * LROW + (kg & 1) * 8;
                        sv = MFMA16(pk_lohi(*(const u32x2*)(pb + (((4 * kk + (kg >> 1)) ^ xr) << 4)), *(const u32x2*)(pb + (((4 * kk + 2 + (kg >> 1)) ^ xr) << 4))), ub[kk], sv);
                        sv = MFMA16(*(const bf16x8*)(KH + (16 * kt + lq) * LROW + (((4 * kk + kg) ^ xr) << 4)), vt[kk], sv);
                    }
                    sacc[kt] = sv;
                }
            }
            __syncthreads();
            {
                const float4 ya = *(const float4*)(YO + ti * 68 + 8 * j), yb = *(const float4*)(YO + ti * 68 + 8 * j + 4);
                const float y8[8] = {ya.x, ya.y, ya.z, ya.w, yb.x, yb.y, yb.z, yb.w};
                st8(YS + ((size_t)d * NT + nb + tt) * 512 + ch, y8);
            }
            __syncthreads();
        }
    }
}

DEV void ph_rw_read(const Params& p, int L, int ntok) {
    const int lane = TID() & 63, wave = TID() >> 6;
    const bf16_t* PXR = (const bf16_t*)(p.ws + OFF_PX); const bf16_t* VF = (const bf16_t*)(p.ws + OFF_VF);
    const bf16_t* YS = (const bf16_t*)(p.ws + OFF_YS); const float* CB = (const float*)(p.ws + OFF_CB);
    bf16_t* YA = (bf16_t*)(p.ws + OFF_YA); bf16_t* SG = (bf16_t*)(p.ws + OFF_SGB);
    const float* mu = p.in[I_MU] + (size_t)L * RW_COLS;
    const float* lg = p.in[I_LNG] + (size_t)L * 512; const float* lb = p.in[I_LNB] + (size_t)L * 512;
    for (int n0 = blockIdx.x * 8; n0 < ntok; n0 += gridDim.x * 8) {
        const int n = n0 + wave, c = lane * 8, h = lane >> 3;
        float y0[8], y1[8], v8[8], o[8];
        ld8(YS + (size_t)n * 512 + c, y0); ld8(YS + ((size_t)NT + n) * 512 + c, y1); ld8(VF + (size_t)n * 512 + c, v8);
        float s = 0.f;
        UNROLL for (int i = 0; i < 8; ++i) { y0[i] += y1[i]; s += y0[i]; }
        s += __shfl_xor(s, 1); s += __shfl_xor(s, 2); s += __shfl_xor(s, 4);
        const float mean = s * (1.f / 64.f); float q = 0.f;
        UNROLL for (int i = 0; i < 8; ++i) { const float dd = y0[i] - mean; q += dd * dd; }
        q += __shfl_xor(q, 1); q += __shfl_xor(q, 2); q += __shfl_xor(q, 4);
        const float rstd = rsqrtf(q * (1.f / 64.f) + 64e-5f);
        const float bon = CB[(size_t)n * 8 + h] + CB[((size_t)NT + n) * 8 + h];
        UNROLL for (int i = 0; i < 8; ++i) o[i] = (y0[i] - mean) * rstd * lg[c + i] + lb[c + i] + bon * v8[i];
        st8(YA + (size_t)n * 512 + c, o);
        if (lane < 16) {
            int nb, tt, T; seq_of(n, nb, tt, T);
            float g8[8]; shift8(PXR, RW_COLS, nb, tt, T, 1792 + lane * 8, mu, g8);
            UNROLL for (int i = 0; i < 8; ++i) g8[i] = sigm(g8[i]);
            st8(SG + (size_t)n * 128 + lane * 8, g8);
        }
    }
}

DEV void ph_na_norm(const Params& p, int L) {
    const int lane = TID() & 63, wave = TID() >> 6;
    bf16_t* PXN = (bf16_t*)(p.ws + OFF_PX);
    const float* qg = p.in[I_QNG] + (size_t)L * 64; const float* kg = p.in[I_KNG] + (size_t)L * 64;
    for (int n0 = blockIdx.x * 8; n0 < NT; n0 += gridDim.x * 8) {
        const int n = n0 + wave, c = lane * 8;
        UNROLL for (int w = 0; w < 2; ++w) {
            bf16_t* ptr = PXN + (size_t)n * 1024 + w * 512 + c;
            float x[8]; ld8(ptr, x);
            float ss = 0.f;
            UNROLL for (int i = 0; i < 8; ++i) ss += x[i] * x[i];
            ss += __shfl_xor(ss, 1); ss += __shfl_xor(ss, 2); ss += __shfl_xor(ss, 4);
            const float r = rsqrtf(ss * (1.f / 64.f) + 1e-6f) * (w == 0 ? 0.125f : 1.f);
            const float* g = w == 0 ? qg : kg;
            UNROLL for (int i = 0; i < 8; ++i) x[i] = x[i] * r * g[(c + i) & 63];
            st8(ptr, x);
        }
    }
}

DEV void knorm8(float (&x)[8], const float* g) {
    float ss = 0.f;
    UNROLL for (int i = 0; i < 8; ++i) ss += x[i] * x[i];
    ss = sum8(ss);
    const float r = rsqrtf(ss * (1.f / 64.f) + 1e-6f);
    UNROLL for (int i = 0; i < 8; ++i) x[i] = x[i] * r * g[i];
}
DEV void ph_na_att(const Params& p, int L, char* smem) {
    const int tid0 = TID();
    const int wave = __builtin_amdgcn_readfirstlane(tid0 >> 6);
    char* KL = smem;
    char* KC = smem + 576 * LROW;
    char* VL = smem;
    char* VC = smem + 64 * 1168;
    float* OX = (float*)(smem + 119808);
    float* RP = OX + 8 * 1024;
    const bf16_t* PXN = (const bf16_t*)(p.ws + OFF_PX); bf16_t* YB = (bf16_t*)(p.ws + OFF_YB);
    const bf16_t* VT = (const bf16_t*)(p.ws + OFF_VT); const bf16_t* VTC = (const bf16_t*)(p.ws + OFF_VTC);
    const float* qgn = p.in[I_QNG] + (size_t)L * 64; const float* kgn = p.in[I_KNG] + (size_t)L * 64;
    const int nunits = 2048 + (L == 0 ? 256 : 0);
    for (int u = blockIdx.x; u < nunits; u += gridDim.x) {
        int tid = tid0; asm volatile("" : "+v"(tid));
        const int lane = tid & 63, lq = lane & 15, kg = lane >> 4;
        const bool cu = u >= 2048;
        int b, h, rp = 0, rs0 = 0, g = 0;
        if (!cu) { h = u & 7; rp = (u >> 3) & 15; b = u >> 7; rs0 = min(max(2 * rp - 4, 0), 24); }
        else { const int v = u - 2048; h = v & 7; g = (v >> 3) & 1; b = v >> 4; }
        const int ctx0 = NX + b * CTXL;
        if (!cu) {
            UNROLL for (int i = 0; i < 9; ++i) {
                const int c = tid + NTHREADS * i, kx = c >> 3, part = c & 7;
                const int tok = b * SEQ + min(rs0 + (kx >> 6), 31) * 64 + (kx & 63);
                float kv[8]; ld8(PXN + (size_t)tok * 1024 + 512 + h * 64 + part * 8, kv); knorm8(kv, kgn + part * 8);
                st8((bf16_t*)(KL + kx * LROW + part * 16), kv);
            }
            for (int i = tid; i < 15 * 31; i += NTHREADS) RP[i] = p.in[I_RPB][((size_t)L * 8 + h) * 465 + i];
        }
        UNROLL for (int i = 0; i < 4; ++i) {
            const int c = tid + NTHREADS * i, kx = c >> 3, part = c & 7;
            float kv[8]; ld8(PXN + (size_t)(ctx0 + kx) * 1024 + 512 + h * 64 + part * 8, kv); knorm8(kv, kgn + part * 8);
            st8((bf16_t*)(KC + kx * LROW + part * 16), kv);
        }
        const int nb = wave & 3, ri = wave >> 2, r = 2 * rp + ri;
        const int rs = min(max(r - 4, 0), 24), roff = rs - rs0;
        const int qtok0 = cu ? ctx0 + (g * 8 + wave) * 16 : b * SEQ + r * 64 + nb * 16;
        const int band0 = min(max(nb * 16 - 8, 0), 32);
        bf16x8 qf[2];
        {
            float q0[8], q1[8]; ld8(PXN + (size_t)(qtok0 + lq) * 1024 + h * 64 + kg * 8, q0); ld8(PXN + (size_t)(qtok0 + lq) * 1024 + h * 64 + 32 + kg * 8, q1);
            float ss = 0.f;
            UNROLL for (int i = 0; i < 8; ++i) ss += q0[i] * q0[i] + q1[i] * q1[i];
            ss += __shfl_xor(ss, 16); ss += __shfl_xor(ss, 32);
            const float rq = rsqrtf(ss * (1.f / 64.f) + 1e-6f) * 0.125f;
            UNROLL for (int i = 0; i < 8; ++i) { q0[i] = q0[i] * rq * qgn[kg * 8 + i]; q1[i] = q1[i] * rq * qgn[32 + kg * 8 + i]; }
            u32x4 w0, w1; w0.x = pk2(q0[0], q0[1]); w0.y = pk2(q0[2], q0[3]); w0.z = pk2(q0[4], q0[5]); w0.w = pk2(q0[6], q0[7]);
            w1.x = pk2(q1[0], q1[1]); w1.y = pk2(q1[2], q1[3]); w1.z = pk2(q1[4], q1[5]); w1.w = pk2(q1[6], q1[7]);
            qf[0] = __builtin_bit_cast(bf16x8, w0); qf[1] = __builtin_bit_cast(bf16x8, w1);
        }
        __syncthreads();
        u32x4 vraw[13];
        if (!cu) {
            UNROLL for (int i = 0; i < 9; ++i) {
                const int c = tid + NTHREADS * i, part = c & 7, kr = (c >> 3) % 9, d = (c >> 3) / 9;
                vraw[i] = *(const u32x4*)(VT + ((size_t)(b * 8 + h) * 64 + d) * SEQ + min(rs0 + kr, 31) * 64 + part * 8);
            }
        }
        UNROLL for (int i = 0; i < 4; ++i) {
            const int c = tid + NTHREADS * i, part = c & 31, d = c >> 5;
            vraw[9 + i] = *(const u32x4*)(VTC + ((size_t)(b * 8 + h) * 64 + d) * CTXL + part * 8);
        }
        f32x4v sacc[16];
        bf16x8 pfl[8], pfc[8];
        float ml = -3e38f, ll = 0.f, mc, lc;
        if (!cu) {
            const char* kb = KL + (roff * 64 + band0 + lq) * LROW + kg * 16;
            UNROLL for (int t = 0; t < 16; ++t) {
                f32x4v a = {0.f, 0.f, 0.f, 0.f};
                UNROLL for (int ks = 0; ks < 2; ++ks) a = __builtin_amdgcn_mfma_f32_16x16x32_bf16(*(const bf16x8*)(kb + ((t >> 1) * 64 + (t & 1) * 16) * LROW + ks * 64), qf[ks], a, 0, 0, 0);
                sacc[t] = a;
            }
            const int col = nb * 16 + lq, cs = min(max(col - 8, 0), 48);
            const int kc0 = band0 + 4 * kg;
            const float* rpp = RP + (rs - r + 7) * 31 + (kc0 - col + 15);
            UNROLL for (int t = 0; t < 16; ++t) UNROLL for (int i = 0; i < 4; ++i) {
                const int kc = kc0 + (t & 1) * 16 + i;
                const bool valid = kc >= cs && kc < cs + 16;
                sacc[t][i] = valid ? sacc[t][i] + rpp[(t >> 1) * 31 + (t & 1) * 16 + i] : -1e30f;
            }
            UNROLL for (int t = 0; t < 16; ++t) UNROLL for (int i = 0; i < 4; ++i) ml = fmaxf(ml, sacc[t][i]);
            ml = fmaxf(ml, __shfl_xor(ml, 16)); ml = fmaxf(ml, __shfl_xor(ml, 32));
            UNROLL for (int t = 0; t < 16; ++t) UNROLL for (int i = 0; i < 4; ++i) { const float e = __expf(sacc[t][i] - ml); sacc[t][i] = e; ll += e; }
            ll += __shfl_xor(ll, 16); ll += __shfl_xor(ll, 32);
            UNROLL for (int tp = 0; tp < 8; ++tp) pfl[tp] = pk_acc2(sacc[2 * tp], sacc[2 * tp + 1]);
        }
        {
            const char* kb = KC + lq * LROW + kg * 16;
            UNROLL for (int t = 0; t < 16; ++t) {
                f32x4v a = {0.f, 0.f, 0.f, 0.f};
                UNROLL for (int ks = 0; ks < 2; ++ks) a = __builtin_amdgcn_mfma_f32_16x16x32_bf16(*(const bf16x8*)(kb + t * 16 * LROW + ks * 64), qf[ks], a, 0, 0, 0);
                sacc[t] = a;
            }
            mc = -3e38f; lc = 0.f;
            UNROLL for (int t = 0; t < 16; ++t) UNROLL for (int i = 0; i < 4; ++i) mc = fmaxf(mc, sacc[t][i]);
            mc = fmaxf(mc, __shfl_xor(mc, 16)); mc = fmaxf(mc, __shfl_xor(mc, 32));
            UNROLL for (int t = 0; t < 16; ++t) UNROLL for (int i = 0; i < 4; ++i) { const float e = __expf(sacc[t][i] - mc); sacc[t][i] = e; lc += e; }
            lc += __shfl_xor(lc, 16); lc += __shfl_xor(lc, 32);
            UNROLL for (int tp = 0; tp < 8; ++tp) pfc[tp] = pk_acc2(sacc[2 * tp], sacc[2 * tp + 1]);
        }
        const float mm = fmaxf(ml, mc), el = cu ? 0.f : __expf(ml - mm), ec = __expf(mc - mm);
        const float inv = frcp(ll * el + lc * ec);
        const float fl = el * inv, fc = ec * inv;
        __syncthreads();
        if (!cu) {
            UNROLL for (int i = 0; i < 9; ++i) {
                const int c = tid + NTHREADS * i, part = c & 7, kr = (c >> 3) % 9, d = (c >> 3) / 9;
                *(u32x4*)(VL + d * 1168 + (kr * 64 + part * 8) * 2) = vraw[i];
            }
        }
        UNROLL for (int i = 0; i < 4; ++i) {
            const int c = tid + NTHREADS * i, part = c & 31, d = c >> 5;
            *(u32x4*)(VC + d * 528 + part * 16) = vraw[9 + i];
        }
        __syncthreads();
        f32x4v ol[4], oc[4];
        UNROLL for (int dt = 0; dt < 4; ++dt) { ol[dt] = (f32x4v){0.f, 0.f, 0.f, 0.f}; oc[dt] = (f32x4v){0.f, 0.f, 0.f, 0.f}; }
        if (!cu) {
            const char* vb = VL + lq * 1168 + (roff * 64 + band0 + 4 * kg) * 2;
            UNROLL for (int tp = 0; tp < 8; ++tp) UNROLL for (int dt = 0; dt < 4; ++dt)
                ol[dt] = __builtin_amdgcn_mfma_f32_16x16x32_bf16(pfl[tp], pk_lohi(*(const u32x2*)(vb + dt * 16 * 1168 + tp * 128), *(const u32x2*)(vb + dt * 16 * 1168 + tp * 128 + 32)), ol[dt], 0, 0, 0);
        }
        {
            const char* vb = VC + lq * 528 + 8 * kg;
            UNROLL for (int tp = 0; tp < 8; ++tp) UNROLL for (int dt = 0; dt < 4; ++dt)
                oc[dt] = __builtin_amdgcn_mfma_f32_16x16x32_bf16(pfc[tp], pk_lohi(*(const u32x2*)(vb + dt * 16 * 528 + tp * 64), *(const u32x2*)(vb + dt * 16 * 528 + tp * 64 + 32)), oc[dt], 0, 0, 0);
        }
        float* ox = OX + wave * 1024;
        UNROLL for (int i = 0; i < 4; ++i) {
            const float a = __shfl(fl, 4 * kg + i), c2 = __shfl(fc, 4 * kg + i);
            UNROLL for (int dt = 0; dt < 4; ++dt) ox[(4 * kg + i) * 64 + dt * 16 + lq] = ol[dt][i] * a + oc[dt][i] * c2;
        }
        UNROLL for (int it = 0; it < 2; ++it) {
            const int q = (lane >> 3) + 8 * it, c8 = (lane & 7) * 8;
            const float4 a = *(const float4*)(ox + q * 64 + c8), bq = *(const float4*)(ox + q * 64 + c8 + 4);
            const float v[8] = {a.x, a.y, a.z, a.w, bq.x, bq.y, bq.z, bq.w};
            st8(YB + (size_t)(qtok0 + q) * 512 + h * 64 + c8, v);
        }
        __syncthreads();
    }
}

DEV float sum16(float v) { v += DPP_MOV(v, 0xB1); v += DPP_MOV(v, 0x4E); v += DPP_MOV(v, 0x141); v += DPP_MOV(v, 0x140); return v; }
DEV void ph_ml_scan(const Params& p, int L, char* smem) {
    const int tid = TID(), lane = tid & 63, lq = lane & 15, kg = lane >> 4, ti = tid >> 3, j = tid & 7;
    const int wave = __builtin_amdgcn_readfirstlane(tid >> 6);
    char* QS = smem;
    char* QP = QS + 9216;
    char* KC = QP + 9216;
    char* KW = KC + 9216;
    char* PM = KW + 9216;
    char* VT = PM + 9216;
    float* BV = (float*)(VT + 128 * LROW);
    float* GI = BV + 64;
    float* DEN = GI + 64;
    float* NV = DEN + 64;
    float* RS = NV + 64;
    float* HO = RS + 256;
    const bf16_t* PXM = (const bf16_t*)(p.ws + OFF_PX); bf16_t* HS = (bf16_t*)(p.ws + OFF_HS);
    for (int u = blockIdx.x; u < 128; u += gridDim.x) {
        const int d = u & 1, h = (u >> 1) & 3, b = u >> 3;
        const float ib = p.in[I_IB][L * 8 + d * 4 + h], fb = p.in[I_FB][L * 8 + d * 4 + h];
        f32x4v cacc[4];
        UNROLL for (int i = 0; i < 4; ++i) cacc[i] = (f32x4v){0.f, 0.f, 0.f, 0.f};
        for (int i = tid; i < 64 * LROW / 4; i += NTHREADS) ((unsigned*)PM)[i] = 0u;
        if (tid < 64) NV[tid] = 0.f;
        __syncthreads();
        u32x4 pq, pk, pv0, pv1; unsigned short pig = 0, pfg = 0;
#define ML_GEOM(ci_) const bool isc = (ci_) < 4; const int T = isc ? CTXL : SEQ, cc = isc ? (ci_) : (ci_) - 4; \
            const int t0 = d == 0 ? cc * 64 : T - 64 * (cc + 1), nb = isc ? NX + b * CTXL : b * SEQ; \
            const int tt = d == 0 ? t0 + ti : t0 + 63 - ti;
#define ML_PREFETCH(ci_) do { ML_GEOM(ci_) const bf16_t* row_ = PXM + (size_t)(nb + tt) * ML_COLS; \
            pq = *(const u32x4*)(row_ + h * 64 + 8 * j); pk = *(const u32x4*)(row_ + 256 + h * 64 + 8 * j); \
            pv0 = *(const u32x4*)(row_ + 512 + h * 128 + 16 * j); pv1 = *(const u32x4*)(row_ + 512 + h * 128 + 16 * j + 8); \
            if (wave == 0) { const int tl_ = d == 0 ? t0 + lane : t0 + 63 - lane; const bf16_t* rw_ = PXM + (size_t)(nb + tl_) * ML_COLS; pig = rw_[1536 + d * 4 + h]; pfg = rw_[1544 + d * 4 + h]; } } while (0)
        ML_PREFETCH(0);
        for (int ci = 0; ci < 36; ++ci) {
            ML_GEOM(ci)
            float q8[8], k8[8];
            {
                unpack8(pq, q8); unpack8(pk, k8);
                if (!isc) {
                    const int axis = j >> 2, half = (j >> 1) & 1; const float pos = (float)(axis == 0 ? (tt >> 6) : (tt & 63));
                    UNROLL for (int i = 0; i < 8; ++i) {
                        const int f = (j & 1) * 8 + i;
                        const float inv = exp2f(-(float)f * 0.83048202372184059f);
                        const float ang = pos * inv; const float cs = __cosf(ang), sn = __sinf(ang);
                        const float qo = __shfl_xor(q8[i], 2), ko = __shfl_xor(k8[i], 2);
                        q8[i] = half == 0 ? q8[i] * cs - qo * sn : q8[i] * cs + qo * sn;
                        k8[i] = half == 0 ? k8[i] * cs - ko * sn : k8[i] * cs + ko * sn;
                    }
                }
                UNROLL for (int i = 0; i < 8; ++i) q8[i] *= 0.125f;
                st8((bf16_t*)(QS + ti * LROW) + 8 * j, q8); st8((bf16_t*)(KC + ti * LROW) + 8 * j, k8);
                float v0[8], v1[8]; unpack8(pv0, v0); unpack8(pv1, v1);
                UNROLL for (int i = 0; i < 8; ++i) { *(bf16_t*)(VT + (16 * j + i) * LROW + ti * 2) = f2bf(v0[i]); *(bf16_t*)(VT + (16 * j + 8 + i) * LROW + ti * 2) = f2bf(v1[i]); }
                if (wave == 0) {
                    const float ig = bf2f(pig) + ib, fg = bf2f(pfg) + fb;
                    const float igc = 15.f * tanhf(ig * (1.f / 15.f)), fgc = 15.f * tanhf(fg * (1.f / 15.f));
                    float lf = -(fmaxf(-fgc, 0.f) + log1pf(expf(-fabsf(fgc))));
                    UNROLL for (int o = 1; o < 64; o <<= 1) { const float up = __shfl_up(lf, o); if (lane >= o) lf += up; }
                    BV[lane] = lf; GI[lane] = igc;
                }
            }
            __syncthreads();
            if (ci + 1 < 36) ML_PREFETCH(ci + 1);
            {
                const float bt = BV[ti], bl = BV[63], gi = GI[ti];
                const float eb = __expf(bt), wk = __expf(bl - bt + gi);
                float qp[8]; float dn = 0.f;
                UNROLL for (int i = 0; i < 8; ++i) { qp[i] = q8[i] * eb; dn += q8[i] * NV[8 * j + i]; }
                st8((bf16_t*)(QP + ti * LROW) + 8 * j, qp);
                UNROLL for (int i = 0; i < 8; ++i) *(bf16_t*)(KW + (8 * j + i) * LROW + ti * 2) = f2bf(k8[i] * wk);
                dn = sum8(dn);
                if (j == 0) DEN[ti] = dn * eb;
            }
            __syncthreads();
            UNROLL for (int rep = 0; rep < 2; ++rep) {
                const int tile = wave + 8 * rep;
                if (tile < 10) {
                    const int tt4 = tile < 1 ? 0 : tile < 3 ? 1 : tile < 6 ? 2 : 3, st4 = tile - (tt4 * (tt4 + 1)) / 2;
                    f32x4v a = {0.f, 0.f, 0.f, 0.f};
                    UNROLL for (int ks = 0; ks < 2; ++ks)
                        a = __builtin_amdgcn_mfma_f32_16x16x32_bf16(*(const bf16x8*)(QS + (16 * tt4 + lq) * LROW + ks * 64 + kg * 16),
                                                                    *(const bf16x8*)(KC + (16 * st4 + lq) * LROW + ks * 64 + kg * 16), a, 0, 0, 0);
                    const int sidx = 16 * st4 + lq; const float bs = BV[sidx], gs = GI[sidx];
                    UNROLL for (int i = 0; i < 4; ++i) {
                        const int tidx = 16 * tt4 + 4 * kg + i;
                        const float val = sidx <= tidx ? a[i] * __expf(BV[tidx] - bs + gs) : 0.f;
                        *(bf16_t*)(PM + tidx * LROW + sidx * 2) = f2bf(val);
                        const float rsum = sum16(val);
                        if (lq == 0) RS[tidx * 4 + st4] = rsum;
                    }
                }
            }
            __syncthreads();
            {
                bf16x8 vf[2], cb[2];
                UNROLL for (int kk = 0; kk < 2; ++kk) vf[kk] = *(const bf16x8*)(VT + (16 * wave + lq) * LROW + kk * 64 + kg * 16);
                UNROLL for (int kk = 0; kk < 2; ++kk) {
                    u32x4 w; w.x = pk2(cacc[2 * kk][0], cacc[2 * kk][1]); w.y = pk2(cacc[2 * kk][2], cacc[2 * kk][3]);
                    w.z = pk2(cacc[2 * kk + 1][0], cacc[2 * kk + 1][1]); w.w = pk2(cacc[2 * kk + 1][2], cacc[2 * kk + 1][3]);
                    cb[kk] = __builtin_bit_cast(bf16x8, w);
                }
                UNROLL for (int tt4 = 0; tt4 < 4; ++tt4) {
                    f32x4v hacc = {0.f, 0.f, 0.f, 0.f};
                    UNROLL for (int kk = 0; kk < 2; ++kk) if (2 * kk <= tt4)
                        hacc = __builtin_amdgcn_mfma_f32_16x16x32_bf16(*(const bf16x8*)(PM + (16 * tt4 + lq) * LROW + kk * 64 + kg * 16), vf[kk], hacc, 0, 0, 0);
                    UNROLL for (int kk = 0; kk < 2; ++kk) {
                        const char* qa = QP + (16 * tt4 + lq) * LROW + (32 * kk + 4 * kg) * 2;
                        const u32x2 lo = *(const u32x2*)qa, hi = *(const u32x2*)(qa + 32);
                        u32x4 w; w.x = lo.x; w.y = lo.y; w.z = hi.x; w.w = hi.y;
                        hacc = __builtin_amdgcn_mfma_f32_16x16x32_bf16(__builtin_bit_cast(bf16x8, w), cb[kk], hacc, 0, 0, 0);
                    }
                    UNROLL for (int i = 0; i < 4; ++i) {
                        const int tidx = 16 * tt4 + 4 * kg + i;
                        float den = DEN[tidx];
                        UNROLL for (int st = 0; st <= tt4; ++st) den += RS[tidx * 4 + st];
                        HO[tidx * 132 + 16 * wave + lq] = hacc[i] * frcp(fmaxf(fabsf(den), 1.f));
                    }
                }
                const float g = __expf(BV[63]);
                UNROLL for (int dk = 0; dk < 4; ++dk) {
                    cacc[dk] = cacc[dk] * g;
                    UNROLL for (int kk = 0; kk < 2; ++kk)
                        cacc[dk] = __builtin_amdgcn_mfma_f32_16x16x32_bf16(*(const bf16x8*)(KW + (16 * dk + lq) * LROW + kk * 64 + kg * 16), vf[kk], cacc[dk], 0, 0, 0);
                }
            }
            __syncthreads();
            if (tid < 64) {
                float acc = 0.f;
                UNROLL for (int c8 = 0; c8 < 8; ++c8) { float kw[8]; ld8((const bf16_t*)(KW + tid * LROW) + 8 * c8, kw); UNROLL for (int i = 0; i < 8; ++i) acc += kw[i]; }
                NV[tid] = __expf(BV[63]) * NV[tid] + acc;
            }
            {
                const float* hr = HO + ti * 132 + 16 * j;
                float o0[8], o1[8];
                UNROLL for (int i = 0; i < 8; ++i) { o0[i] = hr[i]; o1[i] = hr[8 + i]; }
                bf16_t* dst = HS + ((size_t)d * NT + nb + tt) * 512 + h * 128 + 16 * j;
                st8(dst, o0); st8(dst + 8, o1);
            }
            __syncthreads();
        }
    }
}
DEV void ph_ml_read(const Params& p, int L, int ntok) {
    const int lane = TID() & 63, wave = TID() >> 6;
    const bf16_t* PXM = (const bf16_t*)(p.ws + OFF_PX); const bf16_t* HS = (const bf16_t*)(p.ws + OFF_HS);
    bf16_t* YC = (bf16_t*)(p.ws + OFF_YC); const float* ng = p.in[I_MNG] + (size_t)L * 512;
    for (int n0 = blockIdx.x * 8; n0 < ntok; n0 += gridDim.x * 8) {
        const int n = n0 + wave, c = lane * 8;
        float h0[8], h1[8], o8[8], out[8];
        ld8(HS + (size_t)n * 512 + c, h0); ld8(HS + ((size_t)NT + n) * 512 + c, h1); ld8(PXM + (size_t)n * ML_COLS + 1024 + c, o8);
        float ss = 0.f;
        UNROLL for (int i = 0; i < 8; ++i) { h0[i] += h1[i]; ss += h0[i] * h0[i]; }
        ss += __shfl_xor(ss, 1); ss += __shfl_xor(ss, 2); ss += __shfl_xor(ss, 4); ss += __shfl_xor(ss, 8);
        const float r = rsqrtf(ss * (1.f / 128.f) + 1e-6f);
        UNROLL for (int i = 0; i < 8; ++i) out[i] = h0[i] * r * ng[c + i] * sigm(o8[i]);
        st8(YC + (size_t)n * 512 + c, out);
    }
}

DEV void ph_route(const Params& p, int L, int ntok, char* smem) {
    const int lane = TID() & 63, wave = TID() >> 6;
    const float* LOG = (const float*)(p.ws + OFF_LOG); int* EIDX = (int*)(p.ws + OFF_EIDX); float* EW = (float*)(p.ws + OFF_EW);
    const float bias = p.in[I_MB][L * 64 + lane];
    int* MCNT = (int*)(p.ws + OFF_MCNT);
    int* hist = (int*)smem;
    if (TID() < 192) hist[TID()] = 0;
    __syncthreads();
    for (int n0 = blockIdx.x * 8; n0 < ntok; n0 += gridDim.x * 8) {
        const int n = n0 + wave, g = lane >> 3;
        const float score = sigm_acc(LOG[(size_t)n * 64 + lane]), sel = score + bias;
        float m1 = sel; m1 = fmaxf(m1, __shfl_xor(m1, 1)); m1 = fmaxf(m1, __shfl_xor(m1, 2)); m1 = fmaxf(m1, __shfl_xor(m1, 4));
        int i1 = sel == m1 ? lane : 64; i1 = min(i1, __shfl_xor(i1, 1)); i1 = min(i1, __shfl_xor(i1, 2)); i1 = min(i1, __shfl_xor(i1, 4));
        float m2 = lane == i1 ? -3e38f : sel; m2 = fmaxf(m2, __shfl_xor(m2, 1)); m2 = fmaxf(m2, __shfl_xor(m2, 2)); m2 = fmaxf(m2, __shfl_xor(m2, 4));
        const float gs = m1 + m2;
        int rank = 0;
        UNROLL for (int g2 = 0; g2 < 8; ++g2) { const float v = __shfl(gs, g2 * 8); rank += (v > gs || (v == gs && g2 < g)) ? 1 : 0; }
        const float ms = rank < 4 ? sel : -1e30f;
        int er = 0;
        for (int e2 = 0; e2 < 64; ++e2) { const float v = __shfl(ms, e2); er += (v > ms || (v == ms && e2 < lane)) ? 1 : 0; }
        const bool chosen = er < 8;
        float ws = chosen ? score : 0.f;
        UNROLL for (int o = 1; o < 64; o <<= 1) ws += __shfl_xor(ws, o);
        if (chosen) { EIDX[(size_t)n * 8 + er] = lane; EW[(size_t)n * 8 + er] = score / ws * 2.5f; atomicAdd(hist + (n / MOE_CHUNK) * 64 + lane, 1); }
    }
    __syncthreads();
    if (TID() < 192 && hist[TID()] > 0) atomicAdd(MCNT + TID(), hist[TID()]);
    __syncthreads();
}


DEV void ph_moe_scatter(const Params& p, int ntok, char* smem) {
    const int tid = TID();
    int* base = (int*)smem;
    int* lh = base + 192;
    const int* MCNT = (const int*)(p.ws + OFF_MCNT); int* CUR = (int*)(p.ws + OFF_MCNT) + 192;
    const int* EIDX = (const int*)(p.ws + OFF_EIDX); int* SORT = (int*)(p.ws + OFF_SORT);
    if (tid < 3) { int b = 0; for (int e = 0; e < 64; ++e) { base[tid * 64 + e] = b; b += (MCNT[tid * 64 + e] + 127) & ~127; } }
    if (tid < 192) lh[tid] = 0;
    __syncthreads();
    for (int i = blockIdx.x * NTHREADS + tid; i < ntok * 8; i += gridDim.x * NTHREADS) atomicAdd(lh + ((i >> 3) / MOE_CHUNK) * 64 + EIDX[i], 1);
    __syncthreads();
    if (tid < 192) { const int n = lh[tid]; if (n > 0) base[tid] += atomicAdd(CUR + tid, n); lh[tid] = 0; }
    __syncthreads();
    for (int i = blockIdx.x * NTHREADS + tid; i < ntok * 8; i += gridDim.x * NTHREADS) {
        const int ce = ((i >> 3) / MOE_CHUNK) * 64 + EIDX[i];
        SORT[(size_t)(ce >> 6) * SORT_CAP + base[ce] + atomicAdd(lh + ce, 1)] = i;
    }
    __syncthreads();
}

DEV void ph_moe_exp(const Params& p, int cb, int ce, char* smem, Topo tp) {
    typedef GC<2, 4> C;
    const int tid0 = TID();
    char* ACT = smem + 2 * C::STG;
    int* list = (int*)(smem + 3 * C::STG);
    int* cnt = list + 1024;
    const bf16_t* H2 = (const bf16_t*)(p.ws + OFF_HX); const int* EIDX = (const int*)(p.ws + OFF_EIDX); const float* EW = (const float*)(p.ws + OFF_EW);
    bf16_t* YBUF = (bf16_t*)(p.ws + OFF_YBUF);
    const int c = cb / MOE_CHUNK;
    const int* MCNT = (const int*)(p.ws + OFF_MCNT) + c * 64; const int* SORT = (const int*)(p.ws + OFF_SORT) + (size_t)c * SORT_CAP;
    int* tb = cnt + 16;
    const int xcd = tp.x, slot = tp.r, nslot = tp.n;
    __syncthreads();
    if (tid0 < 8) {
        const int tid = tid0; const int e = xcd + 8 * tid; int b = 0;
        for (int e2 = 0; e2 < e; ++e2) b += (MCNT[e2] + 127) & ~127;
        tb[16 + tid] = b; tb[32 + tid] = MCNT[e];
    }
    __syncthreads();
    if (tid0 == 0) { int t = 0; for (int k = 0; k < 8; ++k) { tb[k] = t; t += (tb[32 + k] + 127) >> 7; } tb[8] = t; }
    __syncthreads();
    const int total = tb[8];
    int pre_entry = 0;
    for (int lu = slot; lu < total; lu += nslot) {
        int tid = tid0; asm volatile("" : "+v"(tid));
        const int lane = tid & 63, wave = tid >> 6, wm = wave / 4, wn = wave % 4, fr = lane & 31, fh = lane >> 5;
        int k = 0;
        while (k < 7 && lu >= tb[k + 1]) ++k;
        const int e = xcd + 8 * k, j = lu - tb[k], M = min(128, tb[32 + k] - 128 * j), row0 = tb[16 + k] + 128 * j;
        __syncthreads();
        if (tid < 128) list[tid] = lu == slot ? SORT[row0 + min(tid, M - 1)] : pre_entry;
        __syncthreads();
        if (lu + nslot < total && tid < 128) {
            const int lu2 = lu + nslot; int k2 = 0;
            while (k2 < 7 && lu2 >= tb[k2 + 1]) ++k2;
            const int j2 = lu2 - tb[k2], M2 = min(128, tb[32 + k2] - 128 * j2);
            pre_entry = SORT[tb[16 + k2] + 128 * j2 + min(tid, M2 - 1)];
        }
        const bf16_t* GU = (const bf16_t*)(p.ws + OFF_MGU) + (size_t)e * 256 * 1024;
        const bf16_t* DT = (const bf16_t*)(p.ws + OFF_MDT) + (size_t)e * 1024 * 128;
        {
            constexpr int mc = 0;
            f32x16 acc[2][2];
            {
            acc_zero(acc);
            gemm_tile<2, 4, 3, false>(acc, [&](int r) -> const bf16_t* { const int ix = min(mc + r, M - 1); return H2 + (size_t)(list[ix] >> 3) * 1024; },
                                   GU, 1024, 0, 256, 1024, smem, nullptr);
            }
            const int crow = tid >> 3, cch = (tid & 7) ^ ((crow >> 1) & 7);
#define MG2_ISSUE(nt_) do { UNROLL for (int kt = 0; kt < 2; ++kt) UNROLL for (int i = 0; i < 4; ++i) \
                    GLDS16(DT + (size_t)((nt_) * 256 + crow + 64 * i) * 128 + kt * 64 + cch * 8, smem + kt * C::STG + C::AB + i * 8192 + tid * 16); } while (0)
            MG2_ISSUE(0);
            UNROLL for (int mi = 0; mi < 2; ++mi) UNROLL for (int r = 0; r < 16; ++r) {
                const int row = wm * 64 + ACC_ROW(mi, r, fh), ix = mc + row;
                const float gw = ix < M ? EW[list[ix]] : 0.f;
                const float gv = acc[mi][0][r], uv = acc[mi][1][r];
                const float a = gv * frcp(1.f + __expf(-gv)) * uv * gw;
                const int col = wn * 32 + fr;
                *(bf16_t*)(ACT + (col >> 6) * C::AB + row * 128 + ((((col & 63) >> 3) ^ ((row >> 1) & 7)) << 4) + (col & 7) * 2) = f2bf(a);
            }
            __syncthreads();
            {
                const int sw = (fr >> 1) & 7, a_base = (wm * 64 + fr) * 128, b_base = (wn * 64 + fr) * 128;
                float* slab = (float*)(smem + (wave < 4 ? wave * 4096 : C::STG + (wave - 4) * 4096));
                _Pragma("unroll 1") for (int nt = 0; nt < 4; ++nt) {
                    asm volatile("s_waitcnt vmcnt(0)" ::: "memory");
                    __builtin_amdgcn_s_barrier();
                    asm volatile("" ::: "memory");
                    acc_zero(acc);
                    UNROLL for (int kt = 0; kt < 2; ++kt) {
                        const char* As_ = ACT + kt * C::AB; const char* Bs_ = smem + kt * C::STG + C::AB;
                        UNROLL for (int ks = 0; ks < 4; ++ks) {
                            const int off = ((2 * ks + fh) ^ sw) * 16;
                            bf16x8 af[2], bfv[2];
                            UNROLL for (int mi = 0; mi < 2; ++mi) af[mi] = *(const bf16x8*)(As_ + a_base + mi * 4096 + off);
                            UNROLL for (int ni = 0; ni < 2; ++ni) bfv[ni] = *(const bf16x8*)(Bs_ + b_base + ni * 4096 + off);
                            UNROLL for (int mi = 0; mi < 2; ++mi) UNROLL for (int ni = 0; ni < 2; ++ni)
                                acc[mi][ni] = __builtin_amdgcn_mfma_f32_32x32x16_bf16(af[mi], bfv[ni], acc[mi][ni], 0, 0, 0);
                        }
                    }
                    asm volatile("s_waitcnt lgkmcnt(0)" ::: "memory");
                    __builtin_amdgcn_s_barrier();
                    asm volatile("" ::: "memory");
                    if (nt < 3) MG2_ISSUE(nt + 1);
                    UNROLL for (int mi = 0; mi < 2; ++mi) UNROLL for (int hh = 0; hh < 2; ++hh) {
                        UNROLL for (int ni = 0; ni < 2; ++ni) UNROLL for (int r8 = 0; r8 < 8; ++r8) {
                            const int r = 8 * hh + r8;
                            slab[((r & 3) + 8 * ((r >> 2) & 1) + 4 * fh) * 64 + ni * 32 + fr] = acc[mi][ni][r];
                        }
                        UNROLL for (int it = 0; it < 2; ++it) {
                            const int row = (lane >> 3) + 8 * it, c8 = (lane & 7) * 8;
                            const float4 a = *(const float4*)(slab + row * 64 + c8), b = *(const float4*)(slab + row * 64 + c8 + 4);
                            const float v[8] = {a.x, a.y, a.z, a.w, b.x, b.y, b.z, b.w};
                            const int ix = mc + wm * 64 + mi * 32 + 16 * hh + row;
                            if (ix < M) st8(YBUF + (size_t)(list[ix] - cb * 8) * 1024 + nt * 256 + wn * 64 + c8, v);
                        }
                    }
                }
#undef MG2_ISSUE
            }
            __syncthreads();
        }
        __syncthreads();
    }
}


#define XB_TMO      128
#define XB_XCNT(j)  (256  + 64 * (j))
#define XB_XSUB(j)  (1280 + 64 * (j))
#define XB_XGEN(j)  (2304 + 64 * (j))
#define XB_TOP      3328
#define XB_TOPGEN   3392
#define XCD_BAR_WORDS 3456
#define XB_SPIN_CAP (1u << 18)
#define LAS __attribute__((address_space(3)))

__device__ __forceinline__ unsigned xb_ld(unsigned* p)              { return __hip_atomic_load(p, __ATOMIC_RELAXED, __HIP_MEMORY_SCOPE_AGENT); }
__device__ __forceinline__ unsigned xb_add(unsigned* p, unsigned v) { return __hip_atomic_fetch_add(p, v, __ATOMIC_RELAXED, __HIP_MEMORY_SCOPE_AGENT); }
__device__ __forceinline__ unsigned xb_xcc_id() { return (unsigned)__builtin_amdgcn_s_getreg((3 << 11) | 20) & 0xFu; }
#define XB_SPIN(cond, bar) do { unsigned _sp = 0; while (cond) { __builtin_amdgcn_s_sleep(1); \
    if ((++_sp & 255u) == 0u) { if (xb_ld(&(bar)[XB_TMO])) break; if (_sp > XB_SPIN_CAP) { atomicAdd(&(bar)[XB_TMO], 1u); break; } } } } while (0)

struct XcdBarrier { unsigned* bar; unsigned x; volatile LAS unsigned* st; };

__device__ __forceinline__ XcdBarrier xcd_barrier_post(unsigned* bar, volatile LAS unsigned* st) {
    XcdBarrier b; b.bar = bar; b.x = xb_xcc_id(); b.st = st;
    if (threadIdx.x == 0) { const unsigned rank = xb_add(&bar[XB_XCNT(b.x)], 1u); st[2] = b.x; st[3] = rank; }
    return b;
}
__device__ __forceinline__ void xcd_barrier_complete(unsigned* bar, unsigned x, unsigned& nloc, unsigned& nx) {
    const unsigned G = gridDim.x * gridDim.y * gridDim.z;
    unsigned sum, cnt, mine, sp = 0u;
    for (;;) {
        sum = 0u; cnt = 0u; mine = 0u;
#pragma unroll
        for (unsigned j = 0; j < 16; ++j) { const unsigned c = xb_ld(&bar[XB_XCNT(j)]); sum += c; cnt += (c > 0u) ? 1u : 0u; mine = (j == x) ? c : mine; }
        if (sum == G) break;
        __builtin_amdgcn_s_sleep(1);
        if ((++sp & 255u) == 0u) { if (xb_ld(&bar[XB_TMO])) break; if (sp > XB_SPIN_CAP) { atomicAdd(&bar[XB_TMO], 1u); break; } }
    }
    nloc = mine > 0u ? mine : 1u; nx = cnt > 0u ? cnt : 1u;
}
__device__ __forceinline__ void xcd_barrier(const XcdBarrier& b) {
    asm volatile("s_waitcnt vmcnt(0)" ::: "memory");
    __syncthreads();
    if (threadIdx.x == 0) {
        unsigned* bar = b.bar;
        __builtin_amdgcn_s_waitcnt(0);
        unsigned nloc = b.st[0], nx = b.st[1];
        if (nloc == 0u) { xcd_barrier_complete(bar, b.x, nloc, nx); b.st[0] = nloc; b.st[1] = nx; }
        const unsigned old = xb_add(&bar[XB_XSUB(b.x)], 1u);
        const unsigned gen = old / nloc;
        if (old + 1u == (gen + 1u) * nloc) {
            __builtin_amdgcn_fence(__ATOMIC_RELEASE, "agent");
            asm volatile("s_waitcnt vmcnt(0)" ::: "memory");
            const unsigned og = xb_add(&bar[XB_TOP], 1u);
            const unsigned tg = og / nx;
            if (og + 1u == (tg + 1u) * nx) xb_add(&bar[XB_TOPGEN], 1u);
            else XB_SPIN(xb_ld(&bar[XB_TOPGEN]) == tg, bar);
            __builtin_amdgcn_fence(__ATOMIC_ACQUIRE, "agent");
            xb_add(&bar[XB_XGEN(b.x)], 1u);
            asm volatile("s_waitcnt vmcnt(0)" ::: "memory");
        } else {
            XB_SPIN(xb_ld(&bar[XB_XGEN(b.x)]) == gen, bar);
            __builtin_amdgcn_fence(__ATOMIC_ACQUIRE, "agent");
            asm volatile("s_waitcnt vmcnt(0)" ::: "memory");
        }
    }
    __syncthreads();
}

enum { PH_MODCONV = 0, PH_HX, PH_GEMM_R, PH_RW_PREP, PH_RW_SCAN, PH_RW_READ, PH_RW_G, PH_GEMM_N, PH_NA_NORM, PH_NA_ATT, PH_GEMM_M, PH_ML_SCAN, PH_ML_READ,
       PH_GEMM_G, PH_MERGE, PH_OUT, PH_NORM2, PH_ROUTER, PH_ROUTE, PH_SHARED, PH_MOE_EXP, PH_MOE_COMB, PH_COUNT };

template <int PH> DEV void run_phase(const Params& p, int L, int sub, char* smem, Topo tp) {
    const int tid = TID(), lane = tid & 63, fr = lane & 31, fh = lane >> 5;
    char* ws = p.ws;
    const int ntl = L == 0 ? NT : NX;
    const bf16_t* HX = (const bf16_t*)(ws + OFF_HX);
    const bf16_t* WINT = (const bf16_t*)(ws + OFF_WINT);
    if constexpr (PH == PH_MODCONV) { ph_mod(p, L, smem); ph_conv_mix(p, L, smem); }
    else if constexpr (PH == PH_HX) { ph_norm(p, L, 0, NT); }
    else if constexpr (PH == PH_GEMM_R || PH == PH_GEMM_M) {
        const int c0 = PH == PH_GEMM_R ? 0 : RW_COLS + NA_COLS;
        const int N = PH == PH_GEMM_R ? RW_COLS : ML_COLS;
        bf16_t* PX = (bf16_t*)(ws + OFF_PX);
        gemm256(HX, NT, WINT + (size_t)c0 * DM, N, DM, smem, tp, [&](int row, int col, const float (&v)[8]) {
            if (col < N) st8(PX + (size_t)row * N + col, v);
        });
    }
    else if constexpr (PH == PH_GEMM_N) {
        bf16_t* PX = (bf16_t*)(ws + OFF_PX); bf16_t* VT = (bf16_t*)(ws + OFF_VT); bf16_t* VTC = (bf16_t*)(ws + OFF_VTC);
        gemm256(HX, NT, WINT + (size_t)RW_COLS * DM, 1024, DM, smem, tp, [&](int row, int col, const float (&v)[8]) { st8(PX + (size_t)row * 1024 + col, v); });
        gemm_phase<4, 2>(HX, DM, NT, WINT + (size_t)(RW_COLS + 1024) * DM, DM, 512, DM, smem, tp, [&](const f32x16 (&acc)[2][2], int row0, int col0) {
            const int h = col0 >> 6;
            epi_cols(acc, smem, [&](int r8, int col, const float (&v)[8]) {
                const int n = row0 + r8;
                bf16_t* dst = n < NX ? VT + ((size_t)((n >> 11) * 8 + h) * 64 + col) * SEQ + (n & 2047)
                                     : VTC + ((size_t)(((n - NX) >> 8) * 8 + h) * 64 + col) * CTXL + ((n - NX) & 255);
                st8(dst, v);
            });
        });
    }
    else if constexpr (PH == PH_RW_PREP) { ph_rw_prep(p, L, smem); }
    else if constexpr (PH == PH_RW_SCAN) { ph_rw_scan(p, L, smem); }
    else if constexpr (PH == PH_RW_READ) { ph_rw_read(p, L, ntl); }
    else if constexpr (PH == PH_RW_G) {
        bf16_t* YA = (bf16_t*)(ws + OFF_YA);
        gemm_phase<4, 2>((const bf16_t*)(ws + OFF_SGB), 128, ntl, (const bf16_t*)(ws + OFF_G2T), 128, 512, 128, smem, tp, [&](const f32x16 (&acc)[2][2], int row0, int col0) {
            epi_rows(acc, smem, [&](int row, int c8, const float (&v)[8]) {
                bf16_t* q = YA + (size_t)(row0 + row) * 512 + col0 + c8;
                float y[8]; ld8(q, y);
                UNROLL for (int i = 0; i < 8; ++i) y[i] *= v[i];
                st8(q, y);
            });
        });
    }
    else if constexpr (PH == PH_NA_NORM) { ph_na_norm(p, L); }
    else if constexpr (PH == PH_NA_ATT) { ph_na_att(p, L, smem); }
    else if constexpr (PH == PH_ML_SCAN) {
        if (blockIdx.x < 128 || gridDim.x <= 128) ph_ml_scan(p, L, smem);
        if (gridDim.x <= 128) ph_conv_moe_gu(p, L, smem, blockIdx.x, gridDim.x);
        else if (blockIdx.x >= 128) ph_conv_moe_gu(p, L, smem, blockIdx.x - 128, gridDim.x - 128);
    }
    else if constexpr (PH == PH_ML_READ) { ph_ml_read(p, L, ntl); }
    else if constexpr (PH == PH_GEMM_G) {
        bf16_t* G = (bf16_t*)(ws + OFF_GATES);
        gemm256(HX, ntl, WINT + (size_t)(RW_COLS + NA_COLS + ML_COLS) * DM, GATE_COLS, DM, smem, tp, [&](int row, int col, const float (&v)[8]) {
            float y[8];
            UNROLL for (int i = 0; i < 8; ++i) y[i] = sigm(v[i]);
            st8(G + (size_t)row * GATE_COLS + col, y);
        });
    }
    else if constexpr (PH == PH_MERGE) {
        const bf16_t* G = (const bf16_t*)(ws + OFF_GATES); bf16_t* MG = (bf16_t*)(ws + OFF_HX);
        _Pragma("unroll 1") for (int br = 0; br < 3; ++br) {
            gemm256((const bf16_t*)(ws + OFF_YA + (size_t)br * SZ_Y1), ntl, (const bf16_t*)(ws + OFF_WBT) + (size_t)br * 1024 * 512, DM, 512, smem, tp, [&](int row, int col, const float (&v)[8]) {
                float g[8], m[8];
                ld8(G + (size_t)row * GATE_COLS + br * DM + col, g);
                bf16_t* q = MG + (size_t)row * DM + col;
                if (br == 0) { UNROLL for (int i = 0; i < 8; ++i) m[i] = g[i] * v[i]; }
                else { ld8(q, m); UNROLL for (int i = 0; i < 8; ++i) m[i] += g[i] * v[i]; }
                st8(q, m);
            });
        }
    }
    else if constexpr (PH == PH_OUT) {
        const float* MOD = (const float*)(ws + OFF_MOD);
        gemm256(HX, ntl, (const bf16_t*)(ws + OFF_WOUTT), DM, DM, smem, tp, [&](int n, int c, const float (&v)[8]) {
            const float* xp = xprev_row(p, L, n) + c; float* xo = xs_row(p, n) + c; const float* g1 = MOD + mod_row(n) * 6144 + 2 * DM + c;
            const float4 xa = *(const float4*)xp, xb = *(const float4*)(xp + 4), ga = *(const float4*)g1, gb = *(const float4*)(g1 + 4);
            float4 oa, ob;
            oa.x = xa.x + ga.x * v[0]; oa.y = xa.y + ga.y * v[1]; oa.z = xa.z + ga.z * v[2]; oa.w = xa.w + ga.w * v[3];
            ob.x = xb.x + gb.x * v[4]; ob.y = xb.y + gb.y * v[5]; ob.z = xb.z + gb.z * v[6]; ob.w = xb.w + gb.w * v[7];
            *(float4*)xo = oa; *(float4*)(xo + 4) = ob;
        });
    }
    else if constexpr (PH == PH_NORM2) {
        if (blockIdx.x == 0 && tid < 384) ((int*)(ws + OFF_MCNT))[tid] = 0;
        ph_norm(p, L, 1, ntl);
    }
    else if constexpr (PH == PH_ROUTER) {
        typedef GC<4, 2> C;
        float* LOG = (float*)(ws + OFF_LOG);
        const bf16_t* H2LO = (const bf16_t*)(ws + OFF_H2LO); const bf16_t* RH = (const bf16_t*)(ws + OFF_RTR); const bf16_t* RL = RH + 64 * 1024;
        const int wave = tid >> 6, wm = wave / 2, wn = wave % 2;
        {
            const int nrt = ntl / C::BM, G = gridDim.x;
            if (G > nrt) { if ((int)blockIdx.x >= nrt) ph_conv_moe(p, L, smem, blockIdx.x - nrt, G - nrt); }
            else ph_conv_moe(p, L, smem, blockIdx.x, G);
        }
        for (int t = blockIdx.x; t < ntl / C::BM; t += gridDim.x) {
            f32x16 acc[2][2]; acc_zero(acc);
            const bf16_t* A0 = HX + (size_t)t * C::BM * DM; const bf16_t* A1 = H2LO + (size_t)t * C::BM * DM;
            gemm_tile<4, 2, 3, false>(acc, [&](int r) { return A0 + (size_t)r * DM; }, RH, DM, 0, 64, DM, smem, nullptr);
            gemm_tile<4, 2, 3, false>(acc, [&](int r) { return A1 + (size_t)r * DM; }, RH, DM, 0, 64, DM, smem, nullptr);
            gemm_tile<4, 2, 3, false>(acc, [&](int r) { return A0 + (size_t)r * DM; }, RL, DM, 0, 64, DM, smem, nullptr);
            epi_rows(acc, smem, [&](int row, int c8, const float (&v)[8]) {
                if (wn == 0) {
                    float* q = LOG + (size_t)(t * C::BM + wm * 64 + row) * 64 + c8;
                    *(float4*)q = make_float4(v[0], v[1], v[2], v[3]); *(float4*)(q + 4) = make_float4(v[4], v[5], v[6], v[7]);
                }
            });
        }
    }
    else if constexpr (PH == PH_ROUTE) { ph_route(p, L, ntl, smem); }
    else if constexpr (PH == PH_SHARED) {
        ph_moe_scatter(p, ntl, smem);
        bf16_t* SA = (bf16_t*)(ws + OFF_SA);
        gemm256_pair(HX, ntl, (const bf16_t*)(ws + OFF_SGUT), 512, DM, smem, tp, [&](int row, int col, const float (&g)[8], const float (&u)[8]) {
            float a[8];
            UNROLL for (int i = 0; i < 8; ++i) a[i] = g[i] * frcp(1.f + __expf(-g[i])) * u[i];
            st8(SA + (size_t)row * 256 + (col >> 8) * 128 + (col & 127), a);
        });
    }
    else if constexpr (PH == PH_MOE_EXP) { const int cb = sub * MOE_CHUNK; ph_moe_exp(p, cb, min(cb + MOE_CHUNK, ntl), smem, tp); }
    else if constexpr (PH == PH_MOE_COMB) {
        const int cb = sub * MOE_CHUNK, ce = min(cb + MOE_CHUNK, ntl);
        const float* MOD = (const float*)(ws + OFF_MOD); const bf16_t* YBUF = (const bf16_t*)(ws + OFF_YBUF);
        gemm256((const bf16_t*)(ws + OFF_SA) + (size_t)cb * 256, ce - cb, (const bf16_t*)(ws + OFF_SDT), DM, 256, smem, tp, [&](int rl, int c, const float (&v)[8]) {
            const int n = cb + rl;
            float s[8];
            UNROLL for (int i = 0; i < 8; ++i) s[i] = v[i];
            _Pragma("unroll 2") for (int k = 0; k < 8; ++k) { float y[8]; ld8(YBUF + ((size_t)rl * 8 + k) * DM + c, y); UNROLL for (int i = 0; i < 8; ++i) s[i] += y[i]; }
            float* xo = xs_row(p, n) + c; const float* g2 = MOD + mod_row(n) * 6144 + 5 * DM + c;
            float4 xa = *(const float4*)xo, xb = *(const float4*)(xo + 4); const float4 ga = *(const float4*)g2, gb = *(const float4*)(g2 + 4);
            xa.x += ga.x * s[0]; xa.y += ga.y * s[1]; xa.z += ga.z * s[2]; xa.w += ga.w * s[3];
            xb.x += gb.x * s[4]; xb.y += gb.y * s[5]; xb.z += gb.z * s[6]; xb.w += gb.w * s[7];
            *(float4*)xo = xa; *(float4*)(xo + 4) = xb;
        });
    }
}

#ifndef N_LAUNCH_MODE
#define N_LAUNCH_MODE 1
#endif
#if N_LAUNCH_MODE == 0
template <int PH> __global__ void __launch_bounds__(NTHREADS, 2) k_phase(Params p, int L, int sub) {
    extern __shared__ __attribute__((aligned(16))) char smem[];
    run_phase<PH>(p, L, sub, smem, Topo{(int)(blockIdx.x & 7), (int)(blockIdx.x >> 3), (int)((gridDim.x + 7 - (blockIdx.x & 7)) >> 3)});
}
#endif


#ifndef MEGA_SKIP
#define MEGA_SKIP 0ull
#endif
#ifndef MEGA_REPEAT
#define MEGA_REPEAT 0ull
#endif
#define BARRIER() do { XcdBarrier b2_ = bar; unsigned so_ = LDS_BYTES; asm volatile("" : "+v"(so_)); b2_.st = (volatile LAS unsigned*)(smem + so_); xcd_barrier(b2_); } while (0)
#define PHASE(PH, sub) do { if constexpr (!((MEGA_SKIP >> PH) & 1ull)) { run_phase<PH>(p, L, sub, smem, tp); BARRIER(); if constexpr ((MEGA_REPEAT >> PH) & 1ull) { run_phase<PH>(p, L, sub, smem, tp); BARRIER(); } } } while (0)
__global__ void __launch_bounds__(NTHREADS, 2) k_mega(Params p) {
    extern __shared__ __attribute__((aligned(16))) char smem[];
    volatile LAS unsigned* st = (volatile LAS unsigned*)(smem + LDS_BYTES);
    if (threadIdx.x == 0) { st[0] = 0u; st[1] = 0u; st[2] = 0u; st[3] = 0u; }
    __syncthreads();
    const XcdBarrier bar = xcd_barrier_post((unsigned*)(p.ws + OFF_BAR), st);
    Topo tp{(int)(blockIdx.x & 7), (int)(blockIdx.x >> 3), (int)((gridDim.x + 7 - (blockIdx.x & 7)) >> 3)};
    for (int L = 0; L < 2; ++L) {
        const int ntl = L == 0 ? NT : NX;
        PHASE(PH_MODCONV, 0);
        if (st[1] == 8u && st[0] != 0u) { tp.x = (int)st[2]; tp.r = (int)st[3]; tp.n = (int)st[0]; }
        PHASE(PH_HX, 0);
        PHASE(PH_GEMM_R, 0);
        PHASE(PH_RW_PREP, 0);
        PHASE(PH_RW_SCAN, 0);
        PHASE(PH_RW_READ, 0);
        PHASE(PH_RW_G, 0);
        PHASE(PH_GEMM_N, 0);
        PHASE(PH_NA_ATT, 0);
        PHASE(PH_GEMM_M, 0);
        PHASE(PH_ML_SCAN, 0);
        PHASE(PH_ML_READ, 0);
        PHASE(PH_GEMM_G, 0);
        PHASE(PH_MERGE, 0);
        PHASE(PH_OUT, 0);
        PHASE(PH_NORM2, 0);
        PHASE(PH_ROUTER, 0);
        PHASE(PH_ROUTE, 0);
        PHASE(PH_SHARED, 0);
        for (int c = 0; c * MOE_CHUNK < ntl; ++c) {
            PHASE(PH_MOE_EXP, c);
            PHASE(PH_MOE_COMB, c);
        }
    }
}

#if N_LAUNCH_MODE == 0
template <int PH> static void launch_phase(const Params& p, int L, int sub, hipStream_t stream) {
    static bool attr = false;
    if (!attr) { (void)hipFuncSetAttribute((const void*)k_phase<PH>, hipFuncAttributeMaxDynamicSharedMemorySize, LDS_BYTES); attr = true; }
    hipLaunchKernelGGL(k_phase<PH>, dim3(256), dim3(NTHREADS), LDS_BYTES, stream, p, L, sub);
}
#endif

extern "C" void kernel_launch(void* const* d_in, const int* in_sizes, int n_in, void* d_out, int out_size, void* d_ws, size_t ws_size, hipStream_t stream) {
    if (n_in != N_IN || ws_size < WS_END) { fprintf(stderr, "kernel_launch: unexpected inputs (%d) or workspace (%zu < %zu)\n", n_in, ws_size, (size_t)WS_END); return; }
    Params p{};
    for (int i = 0; i < N_IN; ++i) p.in[i] = (const float*)d_in[i];
    p.out = (float*)d_out; p.ws = (char*)d_ws;
#if N_LAUNCH_MODE == 1
    static int grid = 0;
    if (grid == 0) {
        int dev = 0, cus = 0;
        if (hipGetDevice(&dev) != hipSuccess || hipDeviceGetAttribute(&cus, hipDeviceAttributeMultiprocessorCount, dev) != hipSuccess) { grid = -1; return; }
        if (hipFuncSetAttribute((const void*)k_mega, hipFuncAttributeMaxDynamicSharedMemorySize, LDS_BYTES + 256) != hipSuccess) { grid = -1; return; }
        grid = cus;
    }
    if (grid <= 0) return;
    (void)hipMemsetAsync((char*)d_ws + OFF_BAR, 0, XCD_BAR_WORDS * sizeof(unsigned), stream);
    hipLaunchKernelGGL(k_mega, dim3(grid), dim3(NTHREADS), LDS_BYTES + 256, stream, p);
    return;
#endif
#if N_LAUNCH_MODE == 0
    for (int L = 0; L < 2; ++L) {
        const int ntl = L == 0 ? NT : NX;
        launch_phase<PH_MODCONV>(p, L, 0, stream);
        launch_phase<PH_HX>(p, L, 0, stream);
        launch_phase<PH_GEMM_R>(p, L, 0, stream);
        launch_phase<PH_RW_PREP>(p, L, 0, stream);
        launch_phase<PH_RW_SCAN>(p, L, 0, stream);
        launch_phase<PH_RW_READ>(p, L, 0, stream);
        launch_phase<PH_RW_G>(p, L, 0, stream);
        launch_phase<PH_GEMM_N>(p, L, 0, stream);
        launch_phase<PH_NA_ATT>(p, L, 0, stream);
        launch_phase<PH_GEMM_M>(p, L, 0, stream);
        launch_phase<PH_ML_SCAN>(p, L, 0, stream);
        launch_phase<PH_ML_READ>(p, L, 0, stream);
        launch_phase<PH_GEMM_G>(p, L, 0, stream);
        launch_phase<PH_MERGE>(p, L, 0, stream);
        launch_phase<PH_OUT>(p, L, 0, stream);
        launch_phase<PH_NORM2>(p, L, 0, stream);
        launch_phase<PH_ROUTER>(p, L, 0, stream);
        launch_phase<PH_ROUTE>(p, L, 0, stream);
        launch_phase<PH_SHARED>(p, L, 0, stream);
        for (int c = 0; c * MOE_CHUNK < ntl; ++c) {
            launch_phase<PH_MOE_EXP>(p, L, c, stream);
            launch_phase<PH_MOE_COMB>(p, L, c, stream);
        }
    }
#endif
}
```

```cpp
#include <hip/hip_runtime.h>
#include <stdint.h>
#include <stdio.h>

#define DEV __device__ __forceinline__
#define UNROLL _Pragma("unroll")

typedef unsigned short bf16_t;
typedef short bf16x8 __attribute__((ext_vector_type(8)));
typedef float f32x16 __attribute__((ext_vector_type(16)));
typedef float f32x4v __attribute__((ext_vector_type(4)));
typedef unsigned u32x4 __attribute__((ext_vector_type(4)));
typedef unsigned u32x2 __attribute__((ext_vector_type(2)));

constexpr int DM = 1024, NBATCH = 16, SEQ = 2048, CTXL = 256;
constexpr int NX = NBATCH * SEQ, NC = NBATCH * CTXL, NT = NX + NC;
constexpr int RW_COLS = 1920, NA_COLS = 1536, ML_COLS = 1552, GATE_COLS = 3072, IN_COLS = 8080;
constexpr int NTHREADS = 512;
constexpr int MOE_CHUNK = 12288, MOE_ST = 768;

enum { I_X = 0, I_C, I_CTX, I_CCTX, I_WADA, I_BADA, I_N1G, I_N2G, I_WIN, I_MU, I_W0, I_W2, I_A0, I_A2, I_KK, I_KA, I_RK, I_G2,
       I_LNG, I_LNB, I_V0, I_V1, I_V2, I_QNG, I_KNG, I_RPB, I_IB, I_FB, I_MNG, I_WBR, I_WOUT, I_RTR, I_MB, I_MWG, I_MWU, I_MWD,
       I_SG, I_SU, I_SD, N_IN };

constexpr size_t OFF_BAR = 0;
constexpr size_t OFF_MOD = 16384;
constexpr size_t OFF_WINT = OFF_MOD + 417792;
constexpr size_t OFF_WBT = OFF_WINT + (size_t)IN_COLS * 1024 * 2;
constexpr size_t OFF_WOUTT = OFF_WBT + (size_t)3 * 1024 * 512 * 2;
constexpr size_t OFF_SGUT = OFF_WOUTT + (size_t)1024 * 1024 * 2;
constexpr size_t OFF_SDT = OFF_SGUT + (size_t)512 * 1024 * 2;
constexpr size_t OFF_G2T = OFF_SDT + (size_t)1024 * 256 * 2;
constexpr size_t OFF_RTR = OFF_G2T + (size_t)512 * 128 * 2;
constexpr size_t OFF_CTXS = OFF_RTR + (size_t)2 * 64 * 1024 * 2;
constexpr size_t OFF_VF = OFF_CTXS + (size_t)NC * 1024 * 4;
constexpr size_t OFF_HX = OFF_VF + (size_t)NT * 512 * 2;
constexpr size_t OFF_BIG = OFF_HX + (size_t)NT * 1024 * 2;
constexpr size_t SZ_Y1 = (size_t)NT * 512 * 2;
constexpr size_t OFF_YA = OFF_BIG, OFF_YB = OFF_YA + SZ_Y1, OFF_YC = OFF_YB + SZ_Y1;
constexpr size_t OFF_PX = OFF_BIG + 3 * SZ_Y1;
constexpr size_t OFF_SCR = OFF_PX + (size_t)NT * RW_COLS * 2;
constexpr size_t SZ_SCR = (size_t)NT * 1152 * 2;
constexpr size_t OFF_MGU = OFF_SCR + SZ_SCR;
constexpr size_t WS_END = OFF_MGU + (size_t)64 * 256 * 1024 * 2;
constexpr size_t OFF_YS = OFF_YB;
constexpr size_t OFF_SGB = OFF_SCR;
constexpr size_t OFF_CB = OFF_SCR + (size_t)NT * 128 * 2;
constexpr size_t OFF_HS = OFF_SCR;
constexpr size_t OFF_VT = OFF_PX + (size_t)NT * 1024 * 2;
constexpr size_t OFF_VTC = OFF_VT + (size_t)NX * 512 * 2;
constexpr size_t OFF_GATES = OFF_PX;
constexpr size_t OFF_MDT = OFF_BIG;
constexpr size_t OFF_SA = OFF_MDT + (size_t)64 * 1024 * 128 * 2;
constexpr size_t OFF_EIDX = OFF_SA + (size_t)NT * 256 * 2;
constexpr size_t OFF_EW = OFF_EIDX + (size_t)NT * 8 * 4;
constexpr int SORT_CAP = 106496;
constexpr size_t OFF_SORT = OFF_EW + (size_t)NT * 8 * 4;
constexpr size_t OFF_LOG = OFF_SORT + (size_t)3 * SORT_CAP * 4;
constexpr size_t OFF_H2LO = OFF_LOG + (size_t)NT * 64 * 4;
constexpr size_t OFF_YBUF = OFF_LOG;
static_assert(OFF_YBUF + (size_t)MOE_CHUNK * 8 * 1024 * 2 <= WS_END, "moe layout");
static_assert(OFF_GATES + (size_t)NT * 3072 * 2 <= WS_END, "gates layout");
static_assert(WS_END <= (size_t)536870912, "workspace");

constexpr size_t OFF_MCNT = OFF_BAR + 14336;
constexpr int LDS_BYTES = 155648;

struct Topo { int x, r, n; };
struct Params {
    const float* in[N_IN];
    float* out;
    char* ws;
};

DEV int TID() { int t = threadIdx.x; asm volatile("" : "+v"(t)); return t; }
DEV float bf2f(bf16_t h) { return __uint_as_float(((unsigned)h) << 16); }
typedef __bf16 bf16x2n __attribute__((ext_vector_type(2)));
typedef float f32x2n __attribute__((ext_vector_type(2)));
DEV unsigned pk2(float lo, float hi) { const f32x2n v = {lo, hi}; return __builtin_bit_cast(unsigned, __builtin_convertvector(v, bf16x2n)); }
DEV bf16_t f2bf(float f) { return (bf16_t)(pk2(f, 0.f) & 0xffffu); }
DEV void ld8(const bf16_t* p, float (&o)[8]) {
    const u32x4 v = *(const u32x4*)p;
    o[0] = __uint_as_float(v.x << 16); o[1] = __uint_as_float(v.x & 0xffff0000u);
    o[2] = __uint_as_float(v.y << 16); o[3] = __uint_as_float(v.y & 0xffff0000u);
    o[4] = __uint_as_float(v.z << 16); o[5] = __uint_as_float(v.z & 0xffff0000u);
    o[6] = __uint_as_float(v.w << 16); o[7] = __uint_as_float(v.w & 0xffff0000u);
}
DEV void st8(bf16_t* p, const float (&v)[8]) {
    u32x4 o; o.x = pk2(v[0], v[1]); o.y = pk2(v[2], v[3]); o.z = pk2(v[4], v[5]); o.w = pk2(v[6], v[7]);
    *(u32x4*)p = o;
}
#define DPP_MOV(v, ctrl) __builtin_bit_cast(float, __builtin_amdgcn_update_dpp(0, __builtin_bit_cast(int, (v)), (ctrl), 0xF, 0xF, true))
DEV float sum8(float v) { v += DPP_MOV(v, 0xB1); v += DPP_MOV(v, 0x4E); v += DPP_MOV(v, 0x141); return v; }
DEV float frcp(float x) { return __builtin_amdgcn_rcpf(x); }
DEV float sigm(float x) { return frcp(1.f + __expf(-x)); }
DEV float sigm_acc(float x) { return 1.f / (1.f + expf(-x)); }
DEV float tanh_fast(float x) { return 1.f - 2.f * frcp(1.f + __expf(2.f * x)); }
DEV float softplus_fast(float x) { return fmaxf(x, 0.f) + __logf(1.f + __expf(-fabsf(x))); }
DEV int mod_row(int n) { return n < NX ? (n >> 11) : 16; }
DEV float* xs_row(const Params& p, int n) { return n < NX ? p.out + (size_t)n * DM : (float*)(p.ws + OFF_CTXS) + (size_t)(n - NX) * DM; }
DEV const float* xprev_row(const Params& p, int L, int n) {
    if (L == 0) return n < NX ? p.in[I_X] + (size_t)n * DM : p.in[I_CTX] + (size_t)(n - NX) * DM;
    return xs_row(p, n);
}
DEV void seq_of(int n, int& nb, int& tt, int& T) {
    if (n < NX) { nb = n & ~2047; tt = n & 2047; T = SEQ; } else { const int m = n - NX; nb = NX + (m & ~255); tt = m & 255; T = CTXL; }
}
DEV void shift8(const bf16_t* z, int ld, int nb, int tt, int T, int col0, const float* mu, float (&o)[8]) {
    float c[8], l[8], r[8];
    ld8(z + (size_t)(nb + tt) * ld + col0, c);
    if (tt > 0) ld8(z + (size_t)(nb + tt - 1) * ld + col0, l); else { UNROLL for (int i = 0; i < 8; ++i) l[i] = 0.f; }
    if (tt < T - 1) ld8(z + (size_t)(nb + tt + 1) * ld + col0, r); else { UNROLL for (int i = 0; i < 8; ++i) r[i] = 0.f; }
    UNROLL for (int i = 0; i < 8; ++i) o[i] = c[i] + mu[col0 + i] * (0.5f * (l[i] + r[i]) - c[i]);
}

constexpr int LROW = 144;
template <int WM, int WN> struct GC {
    static constexpr int BM = 64 * WM, BN = 64 * WN;
    static constexpr int AB = BM * 128, BB = BN * 128, STG = AB + BB;
    static constexpr int NA = BM / 64, NBC = BN / 64;
};
DEV void acc_zero(f32x16 (&acc)[2][2]) {
    UNROLL for (int a = 0; a < 2; ++a) UNROLL for (int b = 0; b < 2; ++b) UNROLL for (int r = 0; r < 16; ++r) acc[a][b][r] = 0.f;
}
#define GLDS16(gp, lp) __builtin_amdgcn_global_load_lds((const __attribute__((address_space(1))) void*)(gp), (__attribute__((address_space(3))) void*)(lp), 16, 0, 0)
template <int WM, int WN, int NS, bool A_LDS, class ARow>
DEV void gemm_tile(f32x16 (&acc)[2][2], ARow arow, const bf16_t* Bt, int ldb, int n0, int Nvalid, int K, char* smem, const char* alds) {
    typedef GC<WM, WN> C;
    constexpr int LPT = (A_LDS ? 0 : C::NA) + C::NBC;
    const int tid = TID(), lane = tid & 63, wave = tid >> 6, wm = wave / WN, wn = wave % WN;
    const int fr = lane & 31, fh = lane >> 5;
    const int crow = tid >> 3, cch = (tid & 7) ^ ((crow >> 1) & 7);
    const bf16_t* pa[C::NA]; const bf16_t* pb[C::NBC];
    if (!A_LDS) { UNROLL for (int i = 0; i < C::NA; ++i) pa[i] = arow(crow + 64 * i) + cch * 8; }
    UNROLL for (int i = 0; i < C::NBC; ++i) { const int n = min(n0 + crow + 64 * i, Nvalid - 1); pb[i] = Bt + (size_t)n * ldb + cch * 8; }
    const int nk = K >> 6;
#define GT_ISSUE(kt, stg) do { char* sb_ = smem + (stg) * C::STG + tid * 16; \
        if (!A_LDS) { UNROLL for (int i = 0; i < C::NA; ++i) GLDS16(pa[i] + (kt) * 64, sb_ + i * 8192); } \
        UNROLL for (int i = 0; i < C::NBC; ++i) GLDS16(pb[i] + (kt) * 64, sb_ + C::AB + i * 8192); } while (0)
    const int sw = (fr >> 1) & 7;
    int offk[4];
    UNROLL for (int ks = 0; ks < 4; ++ks) offk[ks] = ((2 * ks + fh) ^ sw) * 16;
    const int a_base = (wm * 64 + fr) * 128, b_base = (wn * 64 + fr) * 128;
    UNROLL for (int s = 0; s < NS - 1; ++s) if (s < nk) GT_ISSUE(s, s);
    int stg = 0, nstg = NS - 1;
    for (int kt = 0; kt < nk; ++kt) {
        if (NS == 3 && kt + 1 < nk) asm volatile("s_waitcnt vmcnt(%0)" :: "n"(LPT) : "memory");
        else asm volatile("s_waitcnt vmcnt(0)" ::: "memory");
        __builtin_amdgcn_s_barrier();
        asm volatile("" ::: "memory");
        const bool more = kt + NS - 1 < nk;
        const char* As_ = A_LDS ? alds + kt * C::AB : smem + stg * C::STG; const char* Bs_ = smem + stg * C::STG + C::AB;
        char* db_ = smem + nstg * C::STG + tid * 16;
        bf16x8 af[2][2], bfv[2][2];
        UNROLL for (int mi = 0; mi < 2; ++mi) af[0][mi] = *(const bf16x8*)(As_ + a_base + mi * 4096 + offk[0]);
        UNROLL for (int ni = 0; ni < 2; ++ni) bfv[0][ni] = *(const bf16x8*)(Bs_ + b_base + ni * 4096 + offk[0]);
        UNROLL for (int ks = 0; ks < 4; ++ks) {
            const int cur = ks & 1, nxt = cur ^ 1;
            if (ks < 3) {
                UNROLL for (int mi = 0; mi < 2; ++mi) af[nxt][mi] = *(const bf16x8*)(As_ + a_base + mi * 4096 + offk[ks + 1]);
                UNROLL for (int ni = 0; ni < 2; ++ni) bfv[nxt][ni] = *(const bf16x8*)(Bs_ + b_base + ni * 4096 + offk[ks + 1]);
            }
            UNROLL for (int mi = 0; mi < 2; ++mi) UNROLL for (int ni = 0; ni < 2; ++ni)
                acc[mi][ni] = __builtin_amdgcn_mfma_f32_32x32x16_bf16(af[cur][mi], bfv[cur][ni], acc[mi][ni], 0, 0, 0);
            if (more) {
                UNROLL for (int pc = 0; pc < LPT; ++pc) if (pc * 4 / LPT == ks) {
                    if (!A_LDS && pc < C::NA) GLDS16(pa[pc] + (kt + NS - 1) * 64, db_ + pc * 8192);
                    else { const int ib = pc - (A_LDS ? 0 : C::NA); GLDS16(pb[ib] + (kt + NS - 1) * 64, db_ + C::AB + ib * 8192); }
                }
            }
            __builtin_amdgcn_sched_barrier(0);
        }
        stg = stg + 1 == NS ? 0 : stg + 1; nstg = nstg + 1 == NS ? 0 : nstg + 1;
    }
    __syncthreads();
#undef GT_ISSUE
}
#define ACC_ROW(mi, r, fh) ((mi) * 32 + ((r) & 3) + 8 * ((r) >> 2) + 4 * (fh))

constexpr int EPI_SLAB = 32 * 68 * 4;
template <class F> DEV void epi_rows(const f32x16 (&acc)[2][2], char* smem, F f) {
    const int lane = TID() & 63, wave = TID() >> 6, fr = lane & 31, fh = lane >> 5;
    float* st = (float*)(smem + wave * EPI_SLAB);
    UNROLL for (int mi = 0; mi < 2; ++mi) {
        UNROLL for (int ni = 0; ni < 2; ++ni) UNROLL for (int r = 0; r < 16; ++r)
            st[((r & 3) + 8 * (r >> 2) + 4 * fh) * 68 + ni * 32 + fr] = acc[mi][ni][r];
        UNROLL for (int it = 0; it < 4; ++it) {
            const int row = it * 8 + (lane >> 3), c8 = (lane & 7) * 8;
            const float4 a = *(const float4*)(st + row * 68 + c8), b = *(const float4*)(st + row * 68 + c8 + 4);
            float v[8] = {a.x, a.y, a.z, a.w, b.x, b.y, b.z, b.w};
            f(mi * 32 + row, c8, v);
        }
    }
    __syncthreads();
}


template <class F> DEV void epi_cols(const f32x16 (&acc)[2][2], char* smem, F f) {
    const int lane = TID() & 63, wave = TID() >> 6, fr = lane & 31, fh = lane >> 5;
    float* st = (float*)(smem + wave * EPI_SLAB);
    UNROLL for (int mi = 0; mi < 2; ++mi) {
        UNROLL for (int ni = 0; ni < 2; ++ni) UNROLL for (int r = 0; r < 16; ++r)
            st[((r & 3) + 8 * (r >> 2) + 4 * fh) * 68 + ni * 32 + fr] = acc[mi][ni][r];
        UNROLL for (int it = 0; it < 4; ++it) {
            float v[8];
            UNROLL for (int i = 0; i < 8; ++i) v[i] = st[(it * 8 + i) * 68 + lane];
            f(mi * 32 + it * 8, lane, v);
        }
    }
    __syncthreads();
}

struct TileOrder {
    int x, nN, cx, total;
    DEV TileOrder(const Topo& tp, int nM, int nN_) { x = tp.x; nN = nN_; cx = nM > x ? (nM - x + 7) >> 3 : 0; total = ((cx + 3) >> 2) * 4 * nN; }
    DEV bool get(int q, int& pm, int& pn) const { const int per = 4 * nN, qi = q / per, rem = q - qi * per, i = 4 * qi + (rem & 3); pn = rem >> 2; pm = x + 8 * i; return i < cx; }
};
template <int WM, int WN, class Epi>
DEV void gemm_phase(const bf16_t* A, int lda, int M, const bf16_t* Bt, int ldb, int N, int K, char* smem, const Topo& tp, Epi epi) {
    typedef GC<WM, WN> C;
    const int nM = M / C::BM, nN = (N + C::BN - 1) / C::BN;
    const int wave = TID() >> 6, wm = wave / WN, wn = wave % WN;
    const TileOrder ord(tp, nM, nN);
    for (int q = tp.r; q < ord.total; q += tp.n) {
        int pm, pn; if (!ord.get(q, pm, pn)) continue;
        f32x16 acc[2][2]; acc_zero(acc);
        const bf16_t* Ab = A + (size_t)pm * C::BM * lda;
        gemm_tile<WM, WN, 3, false>(acc, [&](int r) { return Ab + (size_t)r * lda; }, Bt, ldb, pn * C::BN, N, K, smem, nullptr);
        epi(acc, pm * C::BM + wm * 64, pn * C::BN + wn * 64);
    }
}

namespace pg8 {
#define PG8_LAS __attribute__((address_space(3)))
typedef float f32x4 __attribute__((ext_vector_type(4)));
constexpr int BM = 256, BK = 64, HALF = 128, HTB = HALF * BK * 2  , STAGE_BYTES = 8 * HTB, NXCD = 8, WGM = 8;

__host__ __device__ __forceinline__ int lds_byte(int r, int c) { const int st = (r >> 4) * 2 + (c >> 5), rr = r & 15, cc = c & 31, ob = rr * 64 + cc * 2; return st * 1024 + (ob ^ (((ob >> 9) & 1) << 5)); }
__host__ __device__ __forceinline__ void stage_rc(int b, int& R, int& C) { const int st = b / 1024, sb = b % 1024, swz = sb ^ (((sb >> 9) & 1) << 5); R = (st >> 1) * 16 + swz / 64; C = (st & 1) * 32 + (swz % 64) / 2; }
__host__ __device__ __forceinline__ int perm32(int rho) { const int n = rho >> 4, i = rho & 15; return 8 * (i >> 2) + 4 * n + (i & 3); }

struct Unit { int pm, pn; };
struct Gemm { const bf16_t* A; const bf16_t* Bt; int M, N, K; };
template <class Epi, class Sched, bool ALIGN_EPI = false, bool SP2 = false>
__device__ __forceinline__ void gemm_phase(PG8_LAS unsigned char* lds, const Gemm g, const Sched& S, const Epi& E) {
    const int tid = TID(), wid = __builtin_amdgcn_readfirstlane(tid >> 6), lane = tid & 63, wr = wid >> 2, wc = wid & 3, fr = lane & 15, fq = lane >> 4;
    const int K = g.K, nt = K / BK;
    unsigned voffA[2], voffB[2];
#pragma unroll
    for (int i = 0; i < 2; ++i) { int R, C; stage_rc(tid * 16 + i * 8192, R, C); const int Rb = Epi::PERM ? ((R & ~31) + perm32(R & 31)) : R;
        voffA[i] = (unsigned)(R * K + C) * 2u; voffB[i] = (unsigned)(Rb * K + C) * 2u; }
    const size_t kstep = (size_t)(BK * 2);
    const size_t hstep = (size_t)HALF * K * 2;
    const size_t tstep = 2 * hstep;
    const unsigned ldsw = (unsigned)wid * 1024u;
    const int aoff = lds_byte(wr * 64 + fr, fq * 8), boff = lds_byte(wc * 32 + fr, fq * 8);
#define PG8_SA(b, h) (((b) * 2 + (h)) * HTB)
#define PG8_SB(b, h) ((4 + (b) * 2 + (h)) * HTB)
#define PG8_STAGE(bufoff, gbase, voff) do { _Pragma("unroll") for (int _i = 0; _i < 2; ++_i) \
        __builtin_amdgcn_global_load_lds((const unsigned*)((const char*)(gbase) + (voff)[_i]), (PG8_LAS unsigned*)(lds + (bufoff) + ldsw + _i * 8192), 16, 0, 0); } while (0)
#define PG8_LDA(dst, b, h) do { _Pragma("unroll") for (int m = 0; m < 4; ++m) _Pragma("unroll") for (int k = 0; k < 2; ++k) dst[m][k] = *(const PG8_LAS bf16x8*)(lds + PG8_SA(b, h) + aoff + m * 2048 + k * 1024); } while (0)
#define PG8_LDB(dst, b, h) do { _Pragma("unroll") for (int n = 0; n < 2; ++n) _Pragma("unroll") for (int k = 0; k < 2; ++k) dst[n][k] = *(const PG8_LAS bf16x8*)(lds + PG8_SB(b, h) + boff + n * 2048 + k * 1024); } while (0)
#define PG8_MMA(ai, bj, At, Bt) do { __builtin_amdgcn_s_setprio(1); _Pragma("unroll") for (int m = 0; m < 4; ++m) _Pragma("unroll") for (int n = 0; n < 2; ++n) _Pragma("unroll") for (int k = 0; k < 2; ++k) \
        acc[ai][bj][m][n] = __builtin_amdgcn_mfma_f32_16x16x32_bf16(Bt[n][k], At[m][k], acc[ai][bj][m][n], 0, 0, 0); __builtin_amdgcn_s_setprio(0); } while (0)
#define PG8_WAIT_V(n) asm volatile("s_waitcnt vmcnt(" #n ")" ::: "memory")
#define PG8_WAIT_L(n) asm volatile("s_waitcnt lgkmcnt(" #n ")" ::: "memory")
#define PG8_BAR __builtin_amdgcn_s_barrier()
#define PG8_SCHED __builtin_amdgcn_sched_barrier(0)
    Unit cur, nxt; int ui = 0;
    if (!S.next(0, cur)) return;
    f32x4 acc[2][2][4][2];
#pragma unroll
    for (int a = 0; a < 2; ++a)
#pragma unroll
        for (int b = 0; b < 2; ++b)
#pragma unroll
            for (int m = 0; m < 4; ++m)
#pragma unroll
                for (int n = 0; n < 2; ++n) acc[a][b][m][n] = (f32x4){0.f, 0.f, 0.f, 0.f};
    bf16x8 At[4][2], B0[2][2], B1[2][2];
    const char* cA = (const char*)g.A + (size_t)cur.pm * tstep; const char* cB = (const char*)g.Bt + (size_t)cur.pn * tstep;
    S.a_ready(cur);
    if constexpr (SP2) {
        PG8_STAGE(PG8_SB(0, 0), cB, voffB); PG8_STAGE(PG8_SB(0, 1), cB + hstep, voffB); PG8_STAGE(PG8_SA(0, 0), cA, voffA); PG8_STAGE(PG8_SA(0, 1), cA + hstep, voffA);
        if (wr == 1) PG8_BAR;
        PG8_WAIT_V(2); PG8_BAR;
        PG8_STAGE(PG8_SB(1, 0), cB + kstep, voffB); PG8_STAGE(PG8_SA(1, 0), cA + kstep, voffA); PG8_STAGE(PG8_SB(1, 1), cB + hstep + kstep, voffB);
        PG8_WAIT_V(6); PG8_BAR;
    } else {
        PG8_STAGE(PG8_SB(0, 0), cB, voffB); PG8_STAGE(PG8_SA(0, 0), cA, voffA); PG8_STAGE(PG8_SB(0, 1), cB + hstep, voffB); PG8_STAGE(PG8_SA(0, 1), cA + hstep, voffA);
        if (wr == 1) PG8_BAR;
        PG8_WAIT_V(4); PG8_BAR;
        PG8_STAGE(PG8_SB(1, 0), cB + kstep, voffB); PG8_STAGE(PG8_SA(1, 0), cA + kstep, voffA); PG8_STAGE(PG8_SB(1, 1), cB + hstep + kstep, voffB);
        PG8_WAIT_V(6); PG8_BAR;
    }
    for (;;) {
        const bool has_next = S.next(ui + 1, nxt);
        const char* nA = has_next ? (const char*)g.A + (size_t)nxt.pm * tstep : cA; const char* nB = has_next ? (const char*)g.Bt + (size_t)nxt.pn * tstep : cB;
        for (int t = 0; t < nt; t += 2) {
            const bool last = (t == nt - 2);
            const char* a1 = cA + (size_t)(t + 1) * kstep;
            const char* a2 = last ? nA : cA + (size_t)(t + 2) * kstep; const char* b2 = last ? nB : cB + (size_t)(t + 2) * kstep;
            const char* a3 = a2 + kstep; const char* b3 = b2 + kstep;
            if (last && has_next) S.a_ready(nxt);
            if constexpr (SP2) {
            PG8_LDB(B0, 0, 0); PG8_LDB(B1, 0, 1); PG8_SCHED; PG8_LDA(At, 0, 0); PG8_STAGE(PG8_SA(1, 1), a1 + hstep, voffA);
            PG8_WAIT_V(8); PG8_WAIT_L(0); PG8_BAR; PG8_MMA(0, 0, At, B0); PG8_MMA(0, 1, At, B1); PG8_BAR; PG8_SCHED;
            PG8_LDA(At, 0, 1); PG8_STAGE(PG8_SB(0, 0), b2, voffB); PG8_STAGE(PG8_SB(0, 1), b2 + hstep, voffB); PG8_STAGE(PG8_SA(0, 0), a2, voffA);
            PG8_WAIT_V(8); PG8_WAIT_L(0); PG8_BAR; PG8_MMA(1, 0, At, B0); PG8_MMA(1, 1, At, B1); PG8_BAR; PG8_SCHED;
            PG8_LDB(B0, 1, 0); PG8_LDB(B1, 1, 1); PG8_SCHED; PG8_LDA(At, 1, 0); PG8_STAGE(PG8_SA(0, 1), a2 + hstep, voffA);
            PG8_WAIT_V(8); PG8_WAIT_L(0); PG8_BAR; PG8_MMA(0, 0, At, B0); PG8_MMA(0, 1, At, B1); PG8_BAR; PG8_SCHED;
            PG8_LDA(At, 1, 1); PG8_STAGE(PG8_SB(1, 0), b3, voffB); PG8_STAGE(PG8_SB(1, 1), b3 + hstep, voffB); PG8_STAGE(PG8_SA(1, 0), a3, voffA);
            PG8_WAIT_V(8); PG8_WAIT_L(0); PG8_BAR; PG8_MMA(1, 0, At, B0); PG8_MMA(1, 1, At, B1); PG8_BAR; PG8_SCHED;
            } else {
            PG8_LDB(B0, 0, 0); PG8_SCHED; PG8_LDA(At, 0, 0); PG8_STAGE(PG8_SA(1, 1), a1 + hstep, voffA);
            PG8_WAIT_L(8); PG8_BAR; PG8_WAIT_L(0); PG8_MMA(0, 0, At, B0); PG8_BAR; PG8_SCHED;
            PG8_LDB(B1, 0, 1); PG8_STAGE(PG8_SB(0, 0), b2, voffB);
            PG8_BAR; PG8_WAIT_L(0); PG8_MMA(0, 1, At, B1); PG8_BAR;
            PG8_LDA(At, 0, 1); PG8_STAGE(PG8_SA(0, 0), a2, voffA);
            PG8_BAR; PG8_WAIT_L(0); PG8_MMA(1, 0, At, B0); PG8_BAR; PG8_SCHED;
            PG8_STAGE(PG8_SB(0, 1), b2 + hstep, voffB);
            PG8_WAIT_V(6); PG8_BAR; PG8_MMA(1, 1, At, B1); PG8_BAR;
            PG8_LDB(B0, 1, 0); PG8_SCHED; PG8_LDA(At, 1, 0); PG8_STAGE(PG8_SA(0, 1), a2 + hstep, voffA);
            PG8_WAIT_L(8); PG8_BAR; PG8_WAIT_L(0); PG8_MMA(0, 0, At, B0); PG8_BAR; PG8_SCHED;
            PG8_LDB(B1, 1, 1); PG8_STAGE(PG8_SB(1, 0), b3, voffB);
            PG8_BAR; PG8_WAIT_L(0); PG8_MMA(0, 1, At, B1); PG8_BAR;
            PG8_LDA(At, 1, 1); PG8_STAGE(PG8_SA(1, 0), a3, voffA);
            PG8_BAR; PG8_WAIT_L(0); PG8_MMA(1, 0, At, B0); PG8_BAR; PG8_SCHED;
            PG8_STAGE(PG8_SB(1, 1), b3 + hstep, voffB);
            PG8_WAIT_V(6); PG8_BAR; PG8_MMA(1, 1, At, B1); PG8_BAR;
            }
        }
        if constexpr (ALIGN_EPI) { if (wr == 0) PG8_BAR; }
        if constexpr (!Epi::AFTER_DRAIN) { E(acc, cur, wr, wc, fr, fq); S.done(cur); }
        if (!has_next) break;
#pragma unroll
        for (int a = 0; a < 2; ++a)
#pragma unroll
            for (int b = 0; b < 2; ++b)
#pragma unroll
                for (int m = 0; m < 4; ++m)
#pragma unroll
                    for (int n = 0; n < 2; ++n) acc[a][b][m][n] = (f32x4){0.f, 0.f, 0.f, 0.f};
        cur = nxt; cA = nA; cB = nB; ++ui;
        if constexpr (ALIGN_EPI) { if (wr == 1) PG8_BAR; }
    }
    PG8_WAIT_V(0);
    if constexpr (!ALIGN_EPI) { if (wr == 0) PG8_BAR; }
    PG8_BAR;
    if constexpr (Epi::AFTER_DRAIN) { E.fused(acc, cur, wr, wc, fr, fq, lds, wid, lane); S.done(cur); }
#undef PG8_SA
#undef PG8_SB
#undef PG8_STAGE
#undef PG8_LDA
#undef PG8_LDB
#undef PG8_MMA
#undef PG8_WAIT_V
#undef PG8_WAIT_L
#undef PG8_BAR
#undef PG8_SCHED
}
}
template <class F> struct EpiF {
    static constexpr bool PERM = true, AFTER_DRAIN = false; F f;
    DEV void operator()(const pg8::f32x4 (&acc)[2][2][4][2], const pg8::Unit& u, int wr, int wc, int fr, int fq) const {
        UNROLL for (int ai = 0; ai < 2; ++ai) UNROLL for (int m = 0; m < 4; ++m) {
            const int row = u.pm * 256 + ai * 128 + wr * 64 + m * 16 + fr;
            UNROLL for (int bj = 0; bj < 2; ++bj) {
                const int col = u.pn * 256 + bj * 128 + wc * 32 + 8 * fq;
                const float v[8] = {acc[ai][bj][m][0][0], acc[ai][bj][m][0][1], acc[ai][bj][m][0][2], acc[ai][bj][m][0][3],
                                    acc[ai][bj][m][1][0], acc[ai][bj][m][1][1], acc[ai][bj][m][1][2], acc[ai][bj][m][1][3]};
                f(row, col, v);
            }
        }
    }
};
template <class F> struct EpiF2 {
    static constexpr bool PERM = true, AFTER_DRAIN = false; F f;
    DEV void operator()(const pg8::f32x4 (&acc)[2][2][4][2], const pg8::Unit& u, int wr, int wc, int fr, int fq) const {
        UNROLL for (int ai = 0; ai < 2; ++ai) UNROLL for (int m = 0; m < 4; ++m) {
            const int row = u.pm * 256 + ai * 128 + wr * 64 + m * 16 + fr, col = u.pn * 256 + wc * 32 + 8 * fq;
            const float v0[8] = {acc[ai][0][m][0][0], acc[ai][0][m][0][1], acc[ai][0][m][0][2], acc[ai][0][m][0][3], acc[ai][0][m][1][0], acc[ai][0][m][1][1], acc[ai][0][m][1][2], acc[ai][0][m][1][3]};
            const float v1[8] = {acc[ai][1][m][0][0], acc[ai][1][m][0][1], acc[ai][1][m][0][2], acc[ai][1][m][0][3], acc[ai][1][m][1][0], acc[ai][1][m][1][1], acc[ai][1][m][1][2], acc[ai][1][m][1][3]};
            f(row, col, v0, v1);
        }
    }
};
struct XOrder {
    int x, r, n, nN, cx, fullq, total;
    DEV XOrder(const Topo& tp, int nM, int nN_) { x = tp.x; r = tp.r; n = tp.n; nN = nN_; cx = nM > x ? (nM - x + 7) >> 3 : 0; fullq = cx >> 2; total = cx * nN; }
    DEV bool next(int i, pg8::Unit& u) const {
        const int q = r + i * n; if (q >= total) return false;
        const int per = 4 * nN;
        if (q < fullq * per) { const int qi = q / per, rem = q - qi * per; u.pn = rem >> 2; u.pm = x + 8 * (4 * qi + (rem & 3)); }
        else { const int rem = q - fullq * per, cq = cx - 4 * fullq; u.pn = rem / cq; u.pm = x + 8 * (4 * fullq + rem % cq); }
        return true;
    }
    DEV void a_ready(const pg8::Unit&) const {}
    DEV void done(const pg8::Unit&) const {}
};
template <class F> DEV void gemm256_pair(const bf16_t* A, int M, const bf16_t* Bt, int N, int K, char* smem, const Topo& tp, F f) {
    const pg8::Gemm g{A, Bt, M, N, K};
    const XOrder S(tp, M / 256, (N + 255) / 256);
    const EpiF2<F> E{f};
    pg8::gemm_phase<EpiF2<F>, XOrder, true, true>((PG8_LAS unsigned char*)smem, g, S, E);
}
template <class F> DEV void gemm256(const bf16_t* A, int M, const bf16_t* Bt, int N, int K, char* smem, const Topo& tp, F f) {
    const pg8::Gemm g{A, Bt, M, N, K};
    const XOrder S(tp, M / 256, (N + 255) / 256);
    const EpiF<F> E{f};
    pg8::gemm_phase<EpiF<F>, XOrder, true, true>((PG8_LAS unsigned char*)smem, g, S, E);
}

DEV void ph_mod(const Params& p, int L, char* smem) {
    const int tid = TID();
    float* sc = (float*)smem;
    float* red = sc + 17 * 1024;
    const float* c = p.in[I_C]; const float* cc = p.in[I_CCTX];
    for (int i = tid; i < 17 * 1024; i += NTHREADS) { const float v = i < 16 * 1024 ? c[i] : cc[i - 16 * 1024]; sc[i] = v / (1.f + expf(-v)); }
    __syncthreads();
    const float* W = p.in[I_WADA] + (size_t)L * 1024 * 6144; const float* bA = p.in[I_BADA] + (size_t)L * 6144;
    float* MOD = (float*)(p.ws + OFF_MOD);
    for (int u = blockIdx.x; u < 192; u += gridDim.x) {
        const int ci = tid & 31, ks = tid >> 5, j = u * 32 + ci;
        float acc[17];
        UNROLL for (int r = 0; r < 17; ++r) acc[r] = 0.f;
        for (int k = ks * 64; k < ks * 64 + 64; ++k) {
            const float w = W[(size_t)k * 6144 + j];
            UNROLL for (int r = 0; r < 17; ++r) acc[r] += sc[r * 1024 + k] * w;
        }
        UNROLL for (int r = 0; r < 17; ++r) red[(ks * 17 + r) * 32 + ci] = acc[r];
        __syncthreads();
        for (int i = tid; i < 17 * 32; i += NTHREADS) {
            const int r = i >> 5, c2 = i & 31; float s = bA[u * 32 + c2];
            for (int k2 = 0; k2 < 16; ++k2) s += red[(k2 * 17 + r) * 32 + c2];
            MOD[r * 6144 + u * 32 + c2] = s;
        }
        __syncthreads();
    }
}
DEV void conv_job(const float* s0, const float* s1, bf16_t* d, int K, int N, int mode, int nmat, size_t sstride, size_t dstride, char* smem, int bid = -1, int nb = 0) {
    if (bid < 0) { bid = blockIdx.x; nb = gridDim.x; }
    float* tile = (float*)smem;
    const int tid = TID();
    const int tK = K / 64, tN = (mode == 1 || mode == 3) ? (2 * N) / 64 : (N + 63) / 64, per = tK * tN;
    for (int t = bid; t < per * nmat; t += nb) {
        const int mat = t / per, r = t % per, tk = r / tN, tn = r % tN;
        const float* a0 = s0 + (size_t)mat * sstride; const float* a1 = s1 ? s1 + (size_t)mat * sstride : nullptr;
        bf16_t* dd = d + (size_t)mat * dstride;
        UNROLL for (int i = 0; i < 8; ++i) {
            const int cc = tid & 63, k = (tid >> 6) + 8 * i; float v;
            if (mode == 1) { const float* s = (cc >> 5) ? a1 : a0; v = s[(size_t)(tk * 64 + k) * N + tn * 32 + (cc & 31)]; }
            else if (mode == 3) { const float* s = ((tn >> 1) & 1) ? a1 : a0; v = s[(size_t)(tk * 64 + k) * N + (tn >> 2) * 128 + (tn & 1) * 64 + cc]; }
            else { const int n = tn * 64 + cc; v = n < N ? a0[(size_t)(tk * 64 + k) * N + n] : 0.f; }
            tile[k * 65 + cc] = v;
        }
        __syncthreads();
        UNROLL for (int i = 0; i < 8; ++i) {
            const int k = tid & 63, cc = (tid >> 6) + 8 * i; const int row = tn * 64 + cc;
            const float v = tile[k * 65 + cc];
            if (mode == 1 || mode == 3 || row < N) {
                const bf16_t hi = f2bf(v);
                dd[(size_t)row * K + tk * 64 + k] = hi;
                if (mode == 2) dd[(size_t)N * K + (size_t)row * K + tk * 64 + k] = f2bf(v - bf2f(hi));
            }
        }
        __syncthreads();
    }
}
DEV void ph_conv_mix(const Params& p, int L, char* smem) {
    char* ws = p.ws;
    conv_job(p.in[I_WIN] + (size_t)L * 1024 * IN_COLS, nullptr, (bf16_t*)(ws + OFF_WINT), 1024, IN_COLS, 0, 1, 0, 0, smem);
    conv_job(p.in[I_WBR] + (size_t)L * 3 * 512 * 1024, nullptr, (bf16_t*)(ws + OFF_WBT), 512, 1024, 0, 3, (size_t)512 * 1024, (size_t)512 * 1024, smem);
    conv_job(p.in[I_WOUT] + (size_t)L * 1024 * 1024, nullptr, (bf16_t*)(ws + OFF_WOUTT), 1024, 1024, 0, 1, 0, 0, smem);
    conv_job(p.in[I_SG] + (size_t)L * 1024 * 256, p.in[I_SU] + (size_t)L * 1024 * 256, (bf16_t*)(ws + OFF_SGUT), 1024, 256, 3, 1, 0, 0, smem);
    conv_job(p.in[I_SD] + (size_t)L * 256 * 1024, nullptr, (bf16_t*)(ws + OFF_SDT), 256, 1024, 0, 1, 0, 0, smem);
    conv_job(p.in[I_G2] + (size_t)L * 128 * 512, nullptr, (bf16_t*)(ws + OFF_G2T), 128, 512, 0, 1, 0, 0, smem);
    conv_job(p.in[I_RTR] + (size_t)L * 1024 * 64, nullptr, (bf16_t*)(ws + OFF_RTR), 1024, 64, 2, 1, 0, 0, smem);
}
DEV void ph_conv_moe_gu(const Params& p, int L, char* smem, int bid, int nb) {
    const size_t eo = (size_t)L * 64 * 1024 * 128;
    conv_job(p.in[I_MWG] + eo, p.in[I_MWU] + eo, (bf16_t*)(p.ws + OFF_MGU), 1024, 128, 1, 64, (size_t)1024 * 128, (size_t)256 * 1024, smem, bid, nb);
}
DEV void ph_conv_moe(const Params& p, int L, char* smem, int bid, int nb) {
    const size_t eo = (size_t)L * 64 * 1024 * 128;
    conv_job(p.in[I_MWD] + eo, nullptr, (bf16_t*)(p.ws + OFF_MDT), 128, 1024, 0, 64, (size_t)128 * 1024, (size_t)1024 * 128, smem, bid, nb);
}

DEV void ph_norm(const Params& p, int L, int which, int ntok) {
    const int lane = TID() & 63, wave = TID() >> 6;
    const float* MOD = (const float*)(p.ws + OFF_MOD);
    const float* g = p.in[which ? I_N2G : I_N1G] + (size_t)L * DM;
    bf16_t* H = (bf16_t*)(p.ws + OFF_HX); bf16_t* HLO = (bf16_t*)(p.ws + OFF_H2LO);
    for (int n0 = blockIdx.x * 8; n0 < ntok; n0 += gridDim.x * 8) {
        const int n = n0 + wave;
        const float* xr = which ? xs_row(p, n) : xprev_row(p, L, n);
        float4 v[4]; float ss = 0.f;
        UNROLL for (int i = 0; i < 4; ++i) { v[i] = *(const float4*)(xr + i * 256 + lane * 4); ss += v[i].x * v[i].x + v[i].y * v[i].y + v[i].z * v[i].z + v[i].w * v[i].w; }
        UNROLL for (int o = 1; o < 64; o <<= 1) ss += __shfl_xor(ss, o);
        const float rstd = rsqrtf(ss * (1.f / DM) + 1e-6f);
        const float* sh = MOD + mod_row(n) * 6144 + (which ? 3 : 0) * DM; const float* sc = sh + DM;
        UNROLL for (int i = 0; i < 4; ++i) {
            const int c = i * 256 + lane * 4;
            const float4 gg = *(const float4*)(g + c), s1 = *(const float4*)(sc + c), s0 = *(const float4*)(sh + c);
            const float h0 = v[i].x * rstd * gg.x * (1.f + s1.x) + s0.x, h1 = v[i].y * rstd * gg.y * (1.f + s1.y) + s0.y;
            const float h2 = v[i].z * rstd * gg.z * (1.f + s1.z) + s0.z, h3 = v[i].w * rstd * gg.w * (1.f + s1.w) + s0.w;
            u32x2 o; o.x = pk2(h0, h1); o.y = pk2(h2, h3);
            *(u32x2*)(H + (size_t)n * DM + c) = o;
            if (which) {
                u32x2 o2;
                o2.x = pk2(h0 - bf2f((bf16_t)(o.x & 0xffff)), h1 - bf2f((bf16_t)(o.x >> 16)));
                o2.y = pk2(h2 - bf2f((bf16_t)(o.y & 0xffff)), h3 - bf2f((bf16_t)(o.y >> 16)));
                *(u32x2*)(HLO + (size_t)n * DM + c) = o2;
            }
        }
    }
}

DEV void ph_rw_prep(const Params& p, int L, char* smem) {
    const int lane = TID() & 63, wave = TID() >> 6;
    float* vsh = (float*)smem + wave * 512;
    const bf16_t* PXR = (const bf16_t*)(p.ws + OFF_PX); bf16_t* VF = (bf16_t*)(p.ws + OFF_VF);
    const float* mu = p.in[I_MU] + (size_t)L * RW_COLS;
    const float* v0 = p.in[I_V0]; const float* v1 = p.in[I_V1]; const float* v2 = p.in[I_V2];
    for (int n0 = blockIdx.x * 8; n0 < NT; n0 += gridDim.x * 8) {
        const int n = n0 + wave; int nb, tt, T; seq_of(n, nb, tt, T);
        float vs[8]; shift8(PXR, RW_COLS, nb, tt, T, 1024 + lane * 8, mu, vs);
        if (L == 0) { st8(VF + (size_t)n * 512 + lane * 8, vs); }
        else {
            UNROLL for (int i = 0; i < 8; ++i) vsh[lane * 8 + i] = vs[i];
            __syncthreads();
            const int q = lane & 31, hf = lane >> 5; float t1 = 0.f;
            for (int jj = 0; jj < 256; ++jj) t1 += vsh[hf * 256 + jj] * v1[(hf * 256 + jj) * 32 + q];
            t1 += __shfl_xor(t1, 32);
            float u[8];
            UNROLL for (int i = 0; i < 8; ++i) u[i] = v0[lane * 8 + i];
            for (int q2 = 0; q2 < 32; ++q2) { const float tq = __shfl(t1, q2); UNROLL for (int i = 0; i < 8; ++i) u[i] += tq * v2[q2 * 512 + lane * 8 + i]; }
            float vf[8], o[8]; ld8(VF + (size_t)n * 512 + lane * 8, vf);
            UNROLL for (int i = 0; i < 8; ++i) o[i] = vs[i] + (vf[i] - vs[i]) * sigm(u[i]);
            st8(VF + (size_t)n * 512 + lane * 8, o);
            __syncthreads();
        }
    }
}

DEV bf16x8 pk_lohi(u32x2 lo, u32x2 hi) { u32x4 w; w.x = lo.x; w.y = lo.y; w.z = hi.x; w.w = hi.y; return __builtin_bit_cast(bf16x8, w); }
DEV bf16x8 pk_acc2(const f32x4v& a, const f32x4v& b) { u32x4 w; w.x = pk2(a[0], a[1]); w.y = pk2(a[2], a[3]); w.z = pk2(b[0], b[1]); w.w = pk2(b[2], b[3]); return __builtin_bit_cast(bf16x8, w); }
DEV bf16x8 pk_acc1(const f32x4v& a) { u32x4 w; w.x = pk2(a[0], a[1]); w.y = pk2(a[2], a[3]); w.z = 0u; w.w = 0u; return __builtin_bit_cast(bf16x8, w); }
#define MFMA16(a, b, c) __builtin_amdgcn_mfma_f32_16x16x32_bf16((a), (b), (c), 0, 0, 0)
struct Raw3 { u32x4 l, c, r; };
DEV Raw3 rw_raw(const bf16_t* z, int ld, int nb, int tt, int T, int col0) {
    Raw3 o;
    o.c = *(const u32x4*)(z + (size_t)(nb + tt) * ld + col0);
    o.l = *(const u32x4*)(z + (size_t)(nb + max(tt - 1, 0)) * ld + col0);
    o.r = *(const u32x4*)(z + (size_t)(nb + min(tt + 1, T - 1)) * ld + col0);
    return o;
}
DEV void unpack8(u32x4 v, float (&o)[8]) {
    o[0] = __uint_as_float(v.x << 16); o[1] = __uint_as_float(v.x & 0xffff0000u); o[2] = __uint_as_float(v.y << 16); o[3] = __uint_as_float(v.y & 0xffff0000u);
    o[4] = __uint_as_float(v.z << 16); o[5] = __uint_as_float(v.z & 0xffff0000u); o[6] = __uint_as_float(v.w << 16); o[7] = __uint_as_float(v.w & 0xffff0000u);
}
DEV void shift_from_raw(const Raw3& w, int tt, int T, const float* mu8, float (&o)[8]) {
    float c[8], l[8], r[8]; unpack8(w.c, c); unpack8(w.l, l); unpack8(w.r, r);
    const float ml = tt > 0 ? 0.5f : 0.f, mr = tt < T - 1 ? 0.5f : 0.f;
    UNROLL for (int i = 0; i < 8; ++i) o[i] = c[i] + mu8[i] * (ml * l[i] + mr * r[i] - c[i]);
}
DEV void ph_rw_scan(const Params& p, int L, char* smem) {
    const int tid = TID();
    const int wave = __builtin_amdgcn_readfirstlane(tid >> 6);
    char* AT = smem; char* BT = smem + 9216; char* KT = smem + 18432; char* RT = smem + 27648;
    char* BH = smem + 36864; char* KH = smem + 46080; char* VT = smem + 55296;
    char* W2T = smem + 64512; char* A2T = smem + 73728;
    float* PCv = (float*)(smem + 82944); float* SEGT = PCv + 64;
    char* XY = smem + 85248;
    char* T1 = XY; char* T2 = XY + 9216; float* WLf = (float*)(XY + 18432); float* ALf = (float*)(XY + 35840); float* LW = (float*)XY;
    float* TOT = (float*)(XY + 62720);
    float* PAR = (float*)(XY + 60416);
    char* NAB = XY; char* NAK = XY + 9216; char* NRB = XY + 18432; char* NRK = XY + 27648; char* TJ = XY + 36864; float* NDF = (float*)(XY + 38912); float* YO = (float*)(XY + 43008);
    const bf16_t* PXR = (const bf16_t*)(p.ws + OFF_PX); const bf16_t* VF = (const bf16_t*)(p.ws + OFF_VF);
    bf16_t* YS = (bf16_t*)(p.ws + OFF_YS); float* CB = (float*)(p.ws + OFF_CB);
    const float* mu = p.in[I_MU] + (size_t)L * RW_COLS;
    const float* w0 = p.in[I_W0] + (size_t)L * 1024; const float* w2 = p.in[I_W2] + (size_t)L * 65536;
    const float* a0 = p.in[I_A0] + (size_t)L * 1024; const float* a2 = p.in[I_A2] + (size_t)L * 65536;
    const float* kkw = p.in[I_KK] + (size_t)L * 512; const float* kaw = p.in[I_KA] + (size_t)L * 512; const float* rkw = p.in[I_RK] + (size_t)L * 512;
    for (int u = blockIdx.x; u < 256; u += gridDim.x) {
        const int b = u >> 4, h = (u >> 1) & 7, d = u & 1;
        for (int i = tid; i < 4096; i += NTHREADS) {
            const int l = i >> 6, n = i & 63;
            *(bf16_t*)(W2T + n * LROW + l * 2) = f2bf(w2[(size_t)(d * 64 + l) * 512 + h * 64 + n]);
            *(bf16_t*)(A2T + n * LROW + l * 2) = f2bf(a2[(size_t)(d * 64 + l) * 512 + h * 64 + n]);
        }
        if (tid < 64) {
            const int n = tid;
            PAR[n] = w0[d * 512 + h * 64 + n]; PAR[64 + n] = a0[d * 512 + h * 64 + n];
            PAR[128 + n] = kkw[h * 64 + n]; PAR[192 + n] = kaw[h * 64 + n]; PAR[256 + n] = rkw[h * 64 + n];
            PAR[320 + n] = mu[1536 + d * 64 + n]; PAR[384 + n] = mu[1664 + d * 64 + n]; PAR[448 + n] = mu[h * 64 + n]; PAR[512 + n] = mu[512 + h * 64 + n];
        }
        f32x4v sacc[4];
        UNROLL for (int i = 0; i < 4; ++i) sacc[i] = (f32x4v){0.f, 0.f, 0.f, 0.f};
        __syncthreads();
        Raw3 pw1, pw2, pr, pk; u32x4 pv;
#define RW_GEOM(ci_, tido_) const bool isc = (ci_) < 4; const int T = isc ? CTXL : SEQ, cc = isc ? (ci_) : (ci_) - 4; \
            const int t0 = d == 0 ? cc * 64 : T - 64 * (cc + 1), nb = isc ? NX + b * CTXL : b * SEQ; \
            const int tt = d == 0 ? t0 + ((tido_) >> 3) : t0 + 63 - ((tido_) >> 3);
#define RW_PREFETCH(ci_, tido_) do { RW_GEOM(ci_, tido_) const int j_ = (tido_) & 7; \
            pw1 = rw_raw(PXR, RW_COLS, nb, tt, T, 1536 + d * 64 + 8 * j_); pw2 = rw_raw(PXR, RW_COLS, nb, tt, T, 1664 + d * 64 + 8 * j_); \
            pr = rw_raw(PXR, RW_COLS, nb, tt, T, h * 64 + 8 * j_); pk = rw_raw(PXR, RW_COLS, nb, tt, T, 512 + h * 64 + 8 * j_); \
            pv = *(const u32x4*)(VF + (size_t)(nb + tt) * 512 + h * 64 + 8 * j_); } while (0)
        RW_PREFETCH(0, tid);
        for (int ci = 0; ci < 36; ++ci) {
            int tido = tid; asm volatile("" : "+v"(tido));
            const int lane = tido & 63, lq = lane & 15, kg = lane >> 4, ti = tido >> 3, j = tido & 7;
            const int ch = h * 64 + 8 * j;
            RW_GEOM(ci, tido)
            float r8[8], k8[8], v8[8];
            {
                float x1[8], x2[8];
                shift_from_raw(pw1, tt, T, PAR + 320 + 8 * j, x1);
                shift_from_raw(pw2, tt, T, PAR + 384 + 8 * j, x2);
                UNROLL for (int i = 0; i < 8; ++i) x1[i] = tanh_fast(x1[i]);
                st8((bf16_t*)(T1 + ti * LROW) + 8 * j, x1); st8((bf16_t*)(T2 + ti * LROW) + 8 * j, x2);
                shift_from_raw(pr, tt, T, PAR + 448 + 8 * j, r8);
                shift_from_raw(pk, tt, T, PAR + 512 + 8 * j, k8);
                unpack8(pv, v8);
            }
            __syncthreads();
            _Pragma("unroll 1") for (int rep = 0; rep < 4; ++rep) {
                const int q = wave + 8 * rep, m = q >> 4, tl = q & 15, tt4 = tl >> 2, nt4 = tl & 3;
                const char* Ab = (m ? T2 : T1) + (16 * tt4 + lq) * LROW + kg * 16; const char* Bb = (m ? A2T : W2T) + (16 * nt4 + lq) * LROW + kg * 16;
                f32x4v a = {0.f, 0.f, 0.f, 0.f};
                UNROLL for (int ks = 0; ks < 2; ++ks) a = MFMA16(*(const bf16x8*)(Ab + ks * 64), *(const bf16x8*)(Bb + ks * 64), a);
                float* dst = (m ? ALf : WLf) + (16 * tt4 + 4 * kg) * 68 + 16 * nt4 + lq;
                UNROLL for (int i = 0; i < 4; ++i) dst[i * 68] = a[i];
            }
            __syncthreads();
            float av[8], bv[8], kd8[8];
            {
                const float4 wa = *(const float4*)(WLf + ti * 68 + 8 * j), wb = *(const float4*)(WLf + ti * 68 + 8 * j + 4);
                const float4 aa = *(const float4*)(ALf + ti * 68 + 8 * j), ab = *(const float4*)(ALf + ti * 68 + 8 * j + 4);
                const float wl[8] = {wa.x, wa.y, wa.z, wa.w, wb.x, wb.y, wb.z, wb.w}, al[8] = {aa.x, aa.y, aa.z, aa.w, ab.x, ab.y, ab.z, ab.w};
                float ss = 0.f, cbp = 0.f, alpha[8], kkr[8], lw[8];
                UNROLL for (int i = 0; i < 8; ++i) {
                    const float xw = -(PAR[8 * j + i] + wl[i]);
                    const float sp = softplus_fast(xw);
                    lw[i] = -__expf(-sp - 0.5f);
                    alpha[i] = sigm(PAR[64 + 8 * j + i] + al[i]);
                    kkr[i] = k8[i] * PAR[128 + 8 * j + i]; ss += kkr[i] * kkr[i];
                    kd8[i] = k8[i] * (1.f + (alpha[i] - 1.f) * PAR[192 + 8 * j + i]);
                    cbp += r8[i] * kd8[i] * PAR[256 + 8 * j + i];
                }
                ss = sum8(ss); cbp = sum8(cbp);
                const float inv = frcp(fmaxf(__builtin_amdgcn_sqrtf(ss), 1e-12f));
                UNROLL for (int i = 0; i < 8; ++i) { const float kk = kkr[i] * inv; av[i] = -kk; bv[i] = kk * alpha[i]; }
                *(float4*)(LW + ti * 64 + 8 * j) = make_float4(lw[0], lw[1], lw[2], lw[3]); *(float4*)(LW + ti * 64 + 8 * j + 4) = make_float4(lw[4], lw[5], lw[6], lw[7]);
                if (j == 0) CB[((size_t)d * NT + nb + tt) * 8 + h] = cbp;
            }
            __syncthreads();
            {
                const int n = tid & 63, seg = wave; float run[8], acc = 0.f;
                UNROLL for (int r = 0; r < 8; ++r) { acc += LW[(seg * 8 + r) * 64 + n]; run[r] = acc; }
                SEGT[seg * 64 + n] = acc;
                __syncthreads();
                float off = 0.f, tot = 0.f;
                UNROLL for (int s2 = 0; s2 < 8; ++s2) { const float sv = SEGT[s2 * 64 + n]; tot += sv; off += s2 < seg ? sv : 0.f; }
                UNROLL for (int r = 0; r < 8; ++r) LW[(seg * 8 + r) * 64 + n] = run[r] + off;
                if (seg == 0) { TOT[n] = tot; PCv[n] = __expf(tot); }
            }
            __syncthreads();
            {
                const float4 ta = *(const float4*)(TOT + 8 * j), tb = *(const float4*)(TOT + 8 * j + 4);
                const float tot[8] = {ta.x, ta.y, ta.z, ta.w, tb.x, tb.y, tb.z, tb.w};
                const float4 la = *(const float4*)(LW + ti * 64 + 8 * j), lb = *(const float4*)(LW + ti * 64 + 8 * j + 4);
                const float lpl[8] = {la.x, la.y, la.z, la.w, lb.x, lb.y, lb.z, lb.w};
                float lpm[8];
                if (ti != 0) {
                    const float4 ma = *(const float4*)(LW + (ti - 1) * 64 + 8 * j), mb = *(const float4*)(LW + (ti - 1) * 64 + 8 * j + 4);
                    lpm[0] = ma.x; lpm[1] = ma.y; lpm[2] = ma.z; lpm[3] = ma.w; lpm[4] = mb.x; lpm[5] = mb.y; lpm[6] = mb.z; lpm[7] = mb.w;
                } else { UNROLL for (int i = 0; i < 8; ++i) lpm[i] = 0.f; }
                float oa[8], ob[8], ok[8], orr[8];
                const int wofs = (((ti >> 3) ^ j) << 4) + (ti & 7) * 2;
                UNROLL for (int i = 0; i < 8; ++i) {
                    const float lp = lpl[i], lm = lpm[i];
                    const float eP = __expf(lp), eM = __expf(-lp), ePm = __expf(lm), eE = __expf(tot[i] - lp);
                    oa[i] = av[i] * ePm; ob[i] = bv[i] * eM; ok[i] = kd8[i] * eM; orr[i] = r8[i] * eP;
                    *(bf16_t*)(BH + (8 * j + i) * LROW + wofs) = f2bf(bv[i] * eE);
                    *(bf16_t*)(KH + (8 * j + i) * LROW + wofs) = f2bf(kd8[i] * eE);
                    *(bf16_t*)(VT + (8 * j + i) * LROW + wofs) = f2bf(v8[i]);
                }
                st8((bf16_t*)(AT + ti * LROW) + 8 * j, oa); st8((bf16_t*)(BT + ti * LROW) + 8 * j, ob);
                st8((bf16_t*)(KT + ti * LROW) + 8 * j, ok); st8((bf16_t*)(RT + ti * LROW) + 8 * j, orr);
            }
            __syncthreads();
            if (ci + 1 < 36) RW_PREFETCH(ci + 1, tido);
            _Pragma("unroll 1") for (int rep = 0; rep < 6; ++rep) {
                const int q = wave + 8 * rep, m = q / 12, tl = q - 12 * m;
                const int tt4 = tl >= 10 ? 2 * (tl - 10) : tl < 1 ? 0 : tl < 3 ? 1 : tl < 6 ? 2 : 3, st4 = tl >= 10 ? tt4 + 1 : tl - (tt4 * (tt4 + 1)) / 2;
                char* dstm = m == 0 ? NAB : m == 1 ? NAK : m == 2 ? NRB : NRK;
                f32x4v a = {0.f, 0.f, 0.f, 0.f};
                if (st4 <= tt4) {
                    const char* Ab = (m < 2 ? AT : RT) + (16 * tt4 + lq) * LROW + kg * 16; const char* Bb = ((m & 1) ? KT : BT) + (16 * st4 + lq) * LROW + kg * 16;
                    UNROLL for (int ks = 0; ks < 2; ++ks) a = MFMA16(*(const bf16x8*)(Ab + ks * 64), *(const bf16x8*)(Bb + ks * 64), a);
                }
                const int sidx = 16 * st4 + lq;
                UNROLL for (int i = 0; i < 4; ++i) {
                    const int tidx = 16 * tt4 + 4 * kg + i;
                    const bool keep = m < 2 ? sidx < tidx : sidx <= tidx;
                    const float val = keep ? a[i] : 0.f;
                    *(bf16_t*)(dstm + tidx * LROW + sidx * 2) = f2bf(val);
                    if (m == 0 && st4 == tt4) NDF[(tt4 * 16 + 4 * kg + i) * 16 + lq] = val;
                }
            }
            __syncthreads();
            f32x4v xacc[4], yacc[4];
            bf16x8 vt[2];
            if (wave == 7) {
                const int blk = lane >> 4, c = lane & 15;
                float Tc[16];
                UNROLL for (int t = 0; t < 16; ++t) {
                    float a = t == c ? 1.f : 0.f;
                    UNROLL for (int s2 = 0; s2 < t; ++s2) a += NDF[(blk * 16 + t) * 16 + s2] * Tc[s2];
                    Tc[t] = a;
                }
                UNROLL for (int t = 0; t < 16; ++t) *(bf16_t*)(TJ + (blk * 16 + t) * 32 + c * 2) = f2bf(Tc[t]);
            } else if (wave < 4) {
                bf16x8 sb[2];
                UNROLL for (int kk = 0; kk < 2; ++kk) { sb[kk] = pk_acc2(sacc[2 * kk], sacc[2 * kk + 1]); vt[kk] = *(const bf16x8*)(VT + (16 * wave + lq) * LROW + (((4 * kk + kg) ^ (2 * wave + (lq >> 3))) << 4)); }
                UNROLL for (int t4 = 0; t4 < 4; ++t4) {
                    f32x4v x = {0.f, 0.f, 0.f, 0.f}, y = {0.f, 0.f, 0.f, 0.f};
                    UNROLL for (int kk = 0; kk < 2; ++kk) {
                        const char* pa = AT + (16 * t4 + lq) * LROW + (32 * kk + 4 * kg) * 2; const char* pr = RT + (16 * t4 + lq) * LROW + (32 * kk + 4 * kg) * 2;
                        x = MFMA16(pk_lohi(*(const u32x2*)pa, *(const u32x2*)(pa + 32)), sb[kk], x);
                        y = MFMA16(pk_lohi(*(const u32x2*)pr, *(const u32x2*)(pr + 32)), sb[kk], y);
                        if (2 * kk <= t4) {
                            x = MFMA16(*(const bf16x8*)(NAK + (16 * t4 + lq) * LROW + kk * 64 + kg * 16), vt[kk], x);
                            y = MFMA16(*(const bf16x8*)(NRK + (16 * t4 + lq) * LROW + kk * 64 + kg * 16), vt[kk], y);
                        }
                    }
                    xacc[t4] = x; yacc[t4] = y;
                }
            }
            __syncthreads();
            if (wave < 4) {
                const u32x2 z2 = {0u, 0u};
                f32x4v uacc[4];
                {
                    const u32x2 t0v = *(const u32x2*)(TJ + (0 * 16 + lq) * 32 + 4 * kg * 2);
                    uacc[0] = MFMA16(pk_lohi(t0v, z2), pk_acc1(xacc[0]), ((f32x4v){0.f, 0.f, 0.f, 0.f}));
                }
                UNROLL for (int jb = 1; jb < 4; ++jb) {
                    f32x4v z = xacc[jb];
                    const char* nr = NAB + (16 * jb + lq) * LROW + 4 * kg * 2;
                    if (jb == 1) z = MFMA16(pk_lohi(*(const u32x2*)nr, z2), pk_acc1(uacc[0]), z);
                    else {
                        z = MFMA16(pk_lohi(*(const u32x2*)nr, *(const u32x2*)(nr + 32)), pk_acc2(uacc[0], uacc[1]), z);
                        if (jb == 3) z = MFMA16(pk_lohi(*(const u32x2*)(nr + 64), z2), pk_acc1(uacc[2]), z);
                    }
                    const u32x2 tv = *(const u32x2*)(TJ + (jb * 16 + lq) * 32 + 4 * kg * 2);
                    uacc[jb] = MFMA16(pk_lohi(tv, z2), pk_acc1(z), ((f32x4v){0.f, 0.f, 0.f, 0.f}));
                }
                bf16x8 ub[2]; ub[0] = pk_acc2(uacc[0], uacc[1]); ub[1] = pk_acc2(uacc[2], uacc[3]);
                UNROLL for (int t4 = 0; t4 < 4; ++t4) {
                    f32x4v y = yacc[t4];
                    UNROLL for (int kk = 0; kk < 2; ++kk) if (2 * kk <= t4) {
                        const char* pn = NRB + (16 * t4 + lq) * LROW + (32 * kk + 4 * kg) * 2;
                        y = MFMA16(pk_lohi(*(const u32x2*)pn, *(const u32x2*)(pn + 32)), ub[kk], y);
                    }
                    UNROLL for (int i = 0; i < 4; ++i) YO[(16 * t4 + 4 * kg + i) * 68 + 16 * wave + lq] = y[i];
                }
                UNROLL for (int kt = 0; kt < 4; ++kt) {
                    f32x4v sv = sacc[kt];
                    UNROLL for (int i = 0; i < 4; ++i) sv[i] *= PCv[16 * kt + 4 * kg + i];
                    UNROLL for (int kk = 0; kk < 2; ++kk) {
                        const int xr = 2 * kt + (lq >> 3);
                        const char* pb = BH + (16 * kt + lq) * LROW + (kg & 1) * 8;
                        sv = MFMA16(pk_lohi(*(const u32x2*)(pb + (((4 * kk + (kg >> 1)) ^ xr) << 4)), *(const u32x2*)(pb + (((4 * kk + 2 + (kg >> 1)) ^ xr) << 4))), ub[kk], sv);
                        sv = MFMA16(*(const bf16x8*)(KH + (16 * kt + lq) * LROW + (((4 * kk + kg) ^ xr) << 4)), vt[kk], sv);
                    }
                    sacc[kt] = sv;
                }
            }
            __syncthreads();
            {
                const float4 ya = *(const float4*)(YO + ti * 68 + 8 * j), yb = *(const float4*)(YO + ti * 68 + 8 * j + 4);
                const float y8[8] = {ya.x, ya.y, ya.z, ya.w, yb.x, yb.y, yb.z, yb.w};
                st8(YS + ((size_t)d * NT + nb + tt) * 512 + ch, y8);
            }
            __syncthreads();
        }
    }
}

DEV void ph_rw_read(const Params& p, int L, int ntok) {
    const int lane = TID() & 63, wave = TID() >> 6;
    const bf16_t* PXR = (const bf16_t*)(p.ws + OFF_PX); const bf16_t* VF = (const bf16_t*)(p.ws + OFF_VF);
    const bf16_t* YS = (const bf16_t*)(p.ws + OFF_YS); const float* CB = (const float*)(p.ws + OFF_CB);
    bf16_t* YA = (bf16_t*)(p.ws + OFF_YA); bf16_t* SG = (bf16_t*)(p.ws + OFF_SGB);
    const float* mu = p.in[I_MU] + (size_t)L * RW_COLS;
    const float* lg = p.in[I_LNG] + (size_t)L * 512; const float* lb = p.in[I_LNB] + (size_t)L * 512;
    for (int n0 = blockIdx.x * 8; n0 < ntok; n0 += gridDim.x * 8) {
        const int n = n0 + wave, c = lane * 8, h = lane >> 3;
        float y0[8], y1[8], v8[8], o[8];
        ld8(YS + (size_t)n * 512 + c, y0); ld8(YS + ((size_t)NT + n) * 512 + c, y1); ld8(VF + (size_t)n * 512 + c, v8);
        float s = 0.f;
        UNROLL for (int i = 0; i < 8; ++i) { y0[i] += y1[i]; s += y0[i]; }
        s += __shfl_xor(s, 1); s += __shfl_xor(s, 2); s += __shfl_xor(s, 4);
        const float mean = s * (1.f / 64.f); float q = 0.f;
        UNROLL for (int i = 0; i < 8; ++i) { const float dd = y0[i] - mean; q += dd * dd; }
        q += __shfl_xor(q, 1); q += __shfl_xor(q, 2); q += __shfl_xor(q, 4);
        const float rstd = rsqrtf(q * (1.f / 64.f) + 64e-5f);
        const float bon = CB[(size_t)n * 8 + h] + CB[((size_t)NT + n) * 8 + h];
        UNROLL for (int i = 0; i < 8; ++i) o[i] = (y0[i] - mean) * rstd * lg[c + i] + lb[c + i] + bon * v8[i];
        st8(YA + (size_t)n * 512 + c, o);
        if (lane < 16) {
            int nb, tt, T; seq_of(n, nb, tt, T);
            float g8[8]; shift8(PXR, RW_COLS, nb, tt, T, 1792 + lane * 8, mu, g8);
            UNROLL for (int i = 0; i < 8; ++i) g8[i] = sigm(g8[i]);
            st8(SG + (size_t)n * 128 + lane * 8, g8);
        }
    }
}

DEV void ph_na_norm(const Params& p, int L) {
    const int lane = TID() & 63, wave = TID() >> 6;
    bf16_t* PXN = (bf16_t*)(p.ws + OFF_PX);
    const float* qg = p.in[I_QNG] + (size_t)L * 64; const float* kg = p.in[I_KNG] + (size_t)L * 64;
    for (int n0 = blockIdx.x * 8; n0 < NT; n0 += gridDim.x * 8) {
        const int n = n0 + wave, c = lane * 8;
        UNROLL for (int w = 0; w < 2; ++w) {
            bf16_t* ptr = PXN + (size_t)n * 1024 + w * 512 + c;
            float x[8]; ld8(ptr, x);
            float ss = 0.f;
            UNROLL for (int i = 0; i < 8; ++i) ss += x[i] * x[i];
            ss += __shfl_xor(ss, 1); ss += __shfl_xor(ss, 2); ss += __shfl_xor(ss, 4);
            const float r = rsqrtf(ss * (1.f / 64.f) + 1e-6f) * (w == 0 ? 0.125f : 1.f);
            const float* g = w == 0 ? qg : kg;
            UNROLL for (int i = 0; i < 8; ++i) x[i] = x[i] * r * g[(c + i) & 63];
            st8(ptr, x);
        }
    }
}

DEV void knorm8(float (&x)[8], const float* g) {
    float ss = 0.f;
    UNROLL for (int i = 0; i < 8; ++i) ss += x[i] * x[i];
    ss = sum8(ss);
    const float r = rsqrtf(ss * (1.f / 64.f) + 1e-6f);
    UNROLL for (int i = 0; i < 8; ++i) x[i] = x[i] * r * g[i];
}
DEV void ph_na_att(const Params& p, int L, char* smem) {
    const int tid0 = TID();
    const int wave = __builtin_amdgcn_readfirstlane(tid0 >> 6);
    char* KL = smem;
    char* KC = smem + 576 * LROW;
    char* VL = smem;
    char* VC = smem + 64 * 1168;
    float* OX = (float*)(smem + 119808);
    float* RP = OX + 8 * 1024;
    const bf16_t* PXN = (const bf16_t*)(p.ws + OFF_PX); bf16_t* YB = (bf16_t*)(p.ws + OFF_YB);
    const bf16_t* VT = (const bf16_t*)(p.ws + OFF_VT); const bf16_t* VTC = (const bf16_t*)(p.ws + OFF_VTC);
    const float* qgn = p.in[I_QNG] + (size_t)L * 64; const float* kgn = p.in[I_KNG] + (size_t)L * 64;
    const int nunits = 2048 + (L == 0 ? 256 : 0);
    for (int u = blockIdx.x; u < nunits; u += gridDim.x) {
        int tid = tid0; asm volatile("" : "+v"(tid));
        const int lane = tid & 63, lq = lane & 15, kg = lane >> 4;
        const bool cu = u >= 2048;
        int b, h, rp = 0, rs0 = 0, g = 0;
        if (!cu) { h = u & 7; rp = (u >> 3) & 15; b = u >> 7; rs0 = min(max(2 * rp - 4, 0), 24); }
        else { const int v = u - 2048; h = v & 7; g = (v >> 3) & 1; b = v >> 4; }
        const int ctx0 = NX + b * CTXL;
        if (!cu) {
            UNROLL for (int i = 0; i < 9; ++i) {
                const int c = tid + NTHREADS * i, kx = c >> 3, part = c & 7;
                const int tok = b * SEQ + min(rs0 + (kx >> 6), 31) * 64 + (kx & 63);
                float kv[8]; ld8(PXN + (size_t)tok * 1024 + 512 + h * 64 + part * 8, kv); knorm8(kv, kgn + part * 8);
                st8((bf16_t*)(KL + kx * LROW + part * 16), kv);
            }
            for (int i = tid; i < 15 * 31; i += NTHREADS) RP[i] = p.in[I_RPB][((size_t)L * 8 + h) * 465 + i];
        }
        UNROLL for (int i = 0; i < 4; ++i) {
            const int c = tid + NTHREADS * i, kx = c >> 3, part = c & 7;
            float kv[8]; ld8(PXN + (size_t)(ctx0 + kx) * 1024 + 512 + h * 64 + part * 8, kv); knorm8(kv, kgn + part * 8);
            st8((bf16_t*)(KC + kx * LROW + part * 16), kv);
        }
        const int nb = wave & 3, ri = wave >> 2, r = 2 * rp + ri;
        const int rs = min(max(r - 4, 0), 24), roff = rs - rs0;
        const int qtok0 = cu ? ctx0 + (g * 8 + wave) * 16 : b * SEQ + r * 64 + nb * 16;
        const int band0 = min(max(nb * 16 - 8, 0), 32);
        bf16x8 qf[2];
        {
            float q0[8], q1[8]; ld8(PXN + (size_t)(qtok0 + lq) * 1024 + h * 64 + kg * 8, q0); ld8(PXN + (size_t)(qtok0 + lq) * 1024 + h * 64 + 32 + kg * 8, q1);
            float ss = 0.f;
            UNROLL for (int i = 0; i < 8; ++i) ss += q0[i] * q0[i] + q1[i] * q1[i];
            ss += __shfl_xor(ss, 16); ss += __shfl_xor(ss, 32);
            const float rq = rsqrtf(ss * (1.f / 64.f) + 1e-6f) * 0.125f;
            UNROLL for (int i = 0; i < 8; ++i) { q0[i] = q0[i] * rq * qgn[kg * 8 + i]; q1[i] = q1[i] * rq * qgn[32 + kg * 8 + i]; }
            u32x4 w0, w1; w0.x = pk2(q0[0], q0[1]); w0.y = pk2(q0[2], q0[3]); w0.z = pk2(q0[4], q0[5]); w0.w = pk2(q0[6], q0[7]);
            w1.x = pk2(q1[0], q1[1]); w1.y = pk2(q1[2], q1[3]); w1.z = pk2(q1[4], q1[5]); w1.w = pk2(q1[6], q1[7]);
            qf[0] = __builtin_bit_cast(bf16x8, w0); qf[1] = __builtin_bit_cast(bf16x8, w1);
        }
        __syncthreads();
        u32x4 vraw[13];
        if (!cu) {
            UNROLL for (int i = 0; i < 9; ++i) {
                const int c = tid + NTHREADS * i, part = c & 7, kr = (c >> 3) % 9, d = (c >> 3) / 9;
                vraw[i] = *(const u32x4*)(VT + ((size_t)(b * 8 + h) * 64 + d) * SEQ + min(rs0 + kr, 31) * 64 + part * 8);
            }
        }
        UNROLL for (int i = 0; i < 4; ++i) {
            const int c = tid + NTHREADS * i, part = c & 31, d = c >> 5;
            vraw[9 + i] = *(const u32x4*)(VTC + ((size_t)(b * 8 + h) * 64 + d) * CTXL + part * 8);
        }
        f32x4v sacc[16];
        bf16x8 pfl[8], pfc[8];
        float ml = -3e38f, ll = 0.f, mc, lc;
        if (!cu) {
            const char* kb = KL + (roff * 64 + band0 + lq) * LROW + kg * 16;
            UNROLL for (int t = 0; t < 16; ++t) {
                f32x4v a = {0.f, 0.f, 0.f, 0.f};
                UNROLL for (int ks = 0; ks < 2; ++ks) a = __builtin_amdgcn_mfma_f32_16x16x32_bf16(*(const bf16x8*)(kb + ((t >> 1) * 64 + (t & 1) * 16) * LROW + ks * 64), qf[ks], a, 0, 0, 0);
                sacc[t] = a;
            }
            const int col = nb * 16 + lq, cs = min(max(col - 8, 0), 48);
            const int kc0 = band0 + 4 * kg;
            const float* rpp = RP + (rs - r + 7) * 31 + (kc0 - col + 15);
            UNROLL for (int t = 0; t < 16; ++t) UNROLL for (int i = 0; i < 4; ++i) {
                const int kc = kc0 + (t & 1) * 16 + i;
                const bool valid = kc >= cs && kc < cs + 16;
                sacc[t][i] = valid ? sacc[t][i] + rpp[(t >> 1) * 31 + (t & 1) * 16 + i] : -1e30f;
            }
            UNROLL for (int t = 0; t < 16; ++t) UNROLL for (int i = 0; i < 4; ++i) ml = fmaxf(ml, sacc[t][i]);
            ml = fmaxf(ml, __shfl_xor(ml, 16)); ml = fmaxf(ml, __shfl_xor(ml, 32));
            UNROLL for (int t = 0; t < 16; ++t) UNROLL for (int i = 0; i < 4; ++i) { const float e = __expf(sacc[t][i] - ml); sacc[t][i] = e; ll += e; }
            ll += __shfl_xor(ll, 16); ll += __shfl_xor(ll, 32);
            UNROLL for (int tp = 0; tp < 8; ++tp) pfl[tp] = pk_acc2(sacc[2 * tp], sacc[2 * tp + 1]);
        }
        {
            const char* kb = KC + lq * LROW + kg * 16;
            UNROLL for (int t = 0; t < 16; ++t) {
                f32x4v a = {0.f, 0.f, 0.f, 0.f};
                UNROLL for (int ks = 0; ks < 2; ++ks) a = __builtin_amdgcn_mfma_f32_16x16x32_bf16(*(const bf16x8*)(kb + t * 16 * LROW + ks * 64), qf[ks], a, 0, 0, 0);
                sacc[t] = a;
            }
            mc = -3e38f; lc = 0.f;
            UNROLL for (int t = 0; t < 16; ++t) UNROLL for (int i = 0; i < 4; ++i) mc = fmaxf(mc, sacc[t][i]);
            mc = fmaxf(mc, __shfl_xor(mc, 16)); mc = fmaxf(mc, __shfl_xor(mc, 32));
            UNROLL for (int t = 0; t < 16; ++t) UNROLL for (int i = 0; i < 4; ++i) { const float e = __expf(sacc[t][i] - mc); sacc[t][i] = e; lc += e; }
            lc += __shfl_xor(lc, 16); lc += __shfl_xor(lc, 32);
            UNROLL for (int tp = 0; tp < 8; ++tp) pfc[tp] = pk_acc2(sacc[2 * tp], sacc[2 * tp + 1]);
        }
        const float mm = fmaxf(ml, mc), el = cu ? 0.f : __expf(ml - mm), ec = __expf(mc - mm);
        const float inv = frcp(ll * el + lc * ec);
        const float fl = el * inv, fc = ec * inv;
        __syncthreads();
        if (!cu) {
            UNROLL for (int i = 0; i < 9; ++i) {
                const int c = tid + NTHREADS * i, part = c & 7, kr = (c >> 3) % 9, d = (c >> 3) / 9;
                *(u32x4*)(VL + d * 1168 + (kr * 64 + part * 8) * 2) = vraw[i];
            }
        }
        UNROLL for (int i = 0; i < 4; ++i) {
            const int c = tid + NTHREADS * i, part = c & 31, d = c >> 5;
            *(u32x4*)(VC + d * 528 + part * 16) = vraw[9 + i];
        }
        __syncthreads();
        f32x4v ol[4], oc[4];
        UNROLL for (int dt = 0; dt < 4; ++dt) { ol[dt] = (f32x4v){0.f, 0.f, 0.f, 0.f}; oc[dt] = (f32x4v){0.f, 0.f, 0.f, 0.f}; }
        if (!cu) {
            const char* vb = VL + lq * 1168 + (roff * 64 + band0 + 4 * kg) * 2;
            UNROLL for (int tp = 0; tp < 8; ++tp) UNROLL for (int dt = 0; dt < 4; ++dt)
                ol[dt] = __builtin_amdgcn_mfma_f32_16x16x32_bf16(pfl[tp], pk_lohi(*(const u32x2*)(vb + dt * 16 * 1168 + tp * 128), *(const u32x2*)(vb + dt * 16 * 1168 + tp * 128 + 32)), ol[dt], 0, 0, 0);
        }
        {
            const char* vb = VC + lq * 528 + 8 * kg;
            UNROLL for (int tp = 0; tp < 8; ++tp) UNROLL for (int dt = 0; dt < 4; ++dt)
                oc[dt] = __builtin_amdgcn_mfma_f32_16x16x32_bf16(pfc[tp], pk_lohi(*(const u32x2*)(vb + dt * 16 * 528 + tp * 64), *(const u32x2*)(vb + dt * 16 * 528 + tp * 64 + 32)), oc[dt], 0, 0, 0);
        }
        float* ox = OX + wave * 1024;
        UNROLL for (int i = 0; i < 4; ++i) {
            const float a = __shfl(fl, 4 * kg + i), c2 = __shfl(fc, 4 * kg + i);
            UNROLL for (int dt = 0; dt < 4; ++dt) ox[(4 * kg + i) * 64 + dt * 16 + lq] = ol[dt][i] * a + oc[dt][i] * c2;
        }
        UNROLL for (int it = 0; it < 2; ++it) {
            const int q = (lane >> 3) + 8 * it, c8 = (lane & 7) * 8;
            const float4 a = *(const float4*)(ox + q * 64 + c8), bq = *(const float4*)(ox + q * 64 + c8 + 4);
            const float v[8] = {a.x, a.y, a.z, a.w, bq.x, bq.y, bq.z, bq.w};
            st8(YB + (size_t)(qtok0 + q) * 512 + h * 64 + c8, v);
        }
        __syncthreads();
    }
}

DEV float sum16(float v) { v += DPP_MOV(v, 0xB1); v += DPP_MOV(v, 0x4E); v += DPP_MOV(v, 0x141); v += DPP_MOV(v, 0x140); return v; }
DEV void ph_ml_scan(const Params& p, int L, char* smem) {
    const int tid = TID(), lane = tid & 63, lq = lane & 15, kg = lane >> 4, ti = tid >> 3, j = tid & 7;
    const int wave = __builtin_amdgcn_readfirstlane(tid >> 6);
    char* QS = smem;
    char* QP = QS + 9216;
    char* KC = QP + 9216;
    char* KW = KC + 9216;
    char* PM = KW + 9216;
    char* VT = PM + 9216;
    float* BV = (float*)(VT + 128 * LROW);
    float* GI = BV + 64;
    float* DEN = GI + 64;
    float* NV = DEN + 64;
    float* RS = NV + 64;
    float* HO = RS + 256;
    const bf16_t* PXM = (const bf16_t*)(p.ws + OFF_PX); bf16_t* HS = (bf16_t*)(p.ws + OFF_HS);
    for (int u = blockIdx.x; u < 128; u += gridDim.x) {
        const int d = u & 1, h = (u >> 1) & 3, b = u >> 3;
        const float ib = p.in[I_IB][L * 8 + d * 4 + h], fb = p.in[I_FB][L * 8 + d * 4 + h];
        f32x4v cacc[4];
        UNROLL for (int i = 0; i < 4; ++i) cacc[i] = (f32x4v){0.f, 0.f, 0.f, 0.f};
        for (int i = tid; i < 64 * LROW / 4; i += NTHREADS) ((unsigned*)PM)[i] = 0u;
        if (tid < 64) NV[tid] = 0.f;
        __syncthreads();
        u32x4 pq, pk, pv0, pv1; unsigned short pig = 0, pfg = 0;
#define ML_GEOM(ci_) const bool isc = (ci_) < 4; const int T = isc ? CTXL : SEQ, cc = isc ? (ci_) : (ci_) - 4; \
            const int t0 = d == 0 ? cc * 64 : T - 64 * (cc + 1), nb = isc ? NX + b * CTXL : b * SEQ; \
            const int tt = d == 0 ? t0 + ti : t0 + 63 - ti;
#define ML_PREFETCH(ci_) do { ML_GEOM(ci_) const bf16_t* row_ = PXM + (size_t)(nb + tt) * ML_COLS; \
            pq = *(const u32x4*)(row_ + h * 64 + 8 * j); pk = *(const u32x4*)(row_ + 256 + h * 64 + 8 * j); \
            pv0 = *(const u32x4*)(row_ + 512 + h * 128 + 16 * j); pv1 = *(const u32x4*)(row_ + 512 + h * 128 + 16 * j + 8); \
            if (wave == 0) { const int tl_ = d == 0 ? t0 + lane : t0 + 63 - lane; const bf16_t* rw_ = PXM + (size_t)(nb + tl_) * ML_COLS; pig = rw_[1536 + d * 4 + h]; pfg = rw_[1544 + d * 4 + h]; } } while (0)
        ML_PREFETCH(0);
        for (int ci = 0; ci < 36; ++ci) {
            ML_GEOM(ci)
            float q8[8], k8[8];
            {
                unpack8(pq, q8); unpack8(pk, k8);
                if (!isc) {
                    const int axis = j >> 2, half = (j >> 1) & 1; const float pos = (float)(axis == 0 ? (tt >> 6) : (tt & 63));
                    UNROLL for (int i = 0; i < 8; ++i) {
                        const int f = (j & 1) * 8 + i;
                        const float inv = exp2f(-(float)f * 0.83048202372184059f);
                        const float ang = pos * inv; const float cs = __cosf(ang), sn = __sinf(ang);
                        const float qo = __shfl_xor(q8[i], 2), ko = __shfl_xor(k8[i], 2);
                        q8[i] = half == 0 ? q8[i] * cs - qo * sn : q8[i] * cs + qo * sn;
                        k8[i] = half == 0 ? k8[i] * cs - ko * sn : k8[i] * cs + ko * sn;
                    }
                }
                UNROLL for (int i = 0; i < 8; ++i) q8[i] *= 0.125f;
                st8((bf16_t*)(QS + ti * LROW) + 8 * j, q8); st8((bf16_t*)(KC + ti * LROW) + 8 * j, k8);
                float v0[8], v1[8]; unpack8(pv0, v0); unpack8(pv1, v1);
                UNROLL for (int i = 0; i < 8; ++i) { *(bf16_t*)(VT + (16 * j + i) * LROW + ti * 2) = f2bf(v0[i]); *(bf16_t*)(VT + (16 * j + 8 + i) * LROW + ti * 2) = f2bf(v1[i]); }
                if (wave == 0) {
                    const float ig = bf2f(pig) + ib, fg = bf2f(pfg) + fb;
                    const float igc = 15.f * tanhf(ig * (1.f / 15.f)), fgc = 15.f * tanhf(fg * (1.f / 15.f));
                    float lf = -(fmaxf(-fgc, 0.f) + log1pf(expf(-fabsf(fgc))));
                    UNROLL for (int o = 1; o < 64; o <<= 1) { const float up = __shfl_up(lf, o); if (lane >= o) lf += up; }
                    BV[lane] = lf; GI[lane] = igc;
                }
            }
            __syncthreads();
            if (ci + 1 < 36) ML_PREFETCH(ci + 1);
            {
                const float bt = BV[ti], bl = BV[63], gi = GI[ti];
                const float eb = __expf(bt), wk = __expf(bl - bt + gi);
                float qp[8]; float dn = 0.f;
                UNROLL for (int i = 0; i < 8; ++i) { qp[i] = q8[i] * eb; dn += q8[i] * NV[8 * j + i]; }
                st8((bf16_t*)(QP + ti * LROW) + 8 * j, qp);
                UNROLL for (int i = 0; i < 8; ++i) *(bf16_t*)(KW + (8 * j + i) * LROW + ti * 2) = f2bf(k8[i] * wk);
                dn = sum8(dn);
                if (j == 0) DEN[ti] = dn * eb;
            }
            __syncthreads();
            UNROLL for (int rep = 0; rep < 2; ++rep) {
                const int tile = wave + 8 * rep;
                if (tile < 10) {
                    const int tt4 = tile < 1 ? 0 : tile < 3 ? 1 : tile < 6 ? 2 : 3, st4 = tile - (tt4 * (tt4 + 1)) / 2;
                    f32x4v a = {0.f, 0.f, 0.f, 0.f};
                    UNROLL for (int ks = 0; ks < 2; ++ks)
                        a = __builtin_amdgcn_mfma_f32_16x16x32_bf16(*(const bf16x8*)(QS + (16 * tt4 + lq) * LROW + ks * 64 + kg * 16),
                                                                    *(const bf16x8*)(KC + (16 * st4 + lq) * LROW + ks * 64 + kg * 16), a, 0, 0, 0);
                    const int sidx = 16 * st4 + lq; const float bs = BV[sidx], gs = GI[sidx];
                    UNROLL for (int i = 0; i < 4; ++i) {
                        const int tidx = 16 * tt4 + 4 * kg + i;
                        const float val = sidx <= tidx ? a[i] * __expf(BV[tidx] - bs + gs) : 0.f;
                        *(bf16_t*)(PM + tidx * LROW + sidx * 2) = f2bf(val);
                        const float rsum = sum16(val);
                        if (lq == 0) RS[tidx * 4 + st4] = rsum;
                    }
                }
            }
            __syncthreads();
            {
                bf16x8 vf[2], cb[2];
                UNROLL for (int kk = 0; kk < 2; ++kk) vf[kk] = *(const bf16x8*)(VT + (16 * wave + lq) * LROW + kk * 64 + kg * 16);
                UNROLL for (int kk = 0; kk < 2; ++kk) {
                    u32x4 w; w.x = pk2(cacc[2 * kk][0], cacc[2 * kk][1]); w.y = pk2(cacc[2 * kk][2], cacc[2 * kk][3]);
                    w.z = pk2(cacc[2 * kk + 1][0], cacc[2 * kk + 1][1]); w.w = pk2(cacc[2 * kk + 1][2], cacc[2 * kk + 1][3]);
                    cb[kk] = __builtin_bit_cast(bf16x8, w);
                }
                UNROLL for (int tt4 = 0; tt4 < 4; ++tt4) {
                    f32x4v hacc = {0.f, 0.f, 0.f, 0.f};
                    UNROLL for (int kk = 0; kk < 2; ++kk) if (2 * kk <= tt4)
                        hacc = __builtin_amdgcn_mfma_f32_16x16x32_bf16(*(const bf16x8*)(PM + (16 * tt4 + lq) * LROW + kk * 64 + kg * 16), vf[kk], hacc, 0, 0, 0);
                    UNROLL for (int kk = 0; kk < 2; ++kk) {
                        const char* qa = QP + (16 * tt4 + lq) * LROW + (32 * kk + 4 * kg) * 2;
                        const u32x2 lo = *(const u32x2*)qa, hi = *(const u32x2*)(qa + 32);
                        u32x4 w; w.x = lo.x; w.y = lo.y; w.z = hi.x; w.w = hi.y;
                        hacc = __builtin_amdgcn_mfma_f32_16x16x32_bf16(__builtin_bit_cast(bf16x8, w), cb[kk], hacc, 0, 0, 0);
                    }
                    UNROLL for (int i = 0; i < 4; ++i) {
                        const int tidx = 16 * tt4 + 4 * kg + i;
                        float den = DEN[tidx];
                        UNROLL for (int st = 0; st <= tt4; ++st) den += RS[tidx * 4 + st];
                        HO[tidx * 132 + 16 * wave + lq] = hacc[i] * frcp(fmaxf(fabsf(den), 1.f));
                    }
                }
                const float g = __expf(BV[63]);
                UNROLL for (int dk = 0; dk < 4; ++dk) {
                    cacc[dk] = cacc[dk] * g;
                    UNROLL for (int kk = 0; kk < 2; ++kk)
                        cacc[dk] = __builtin_amdgcn_mfma_f32_16x16x32_bf16(*(const bf16x8*)(KW + (16 * dk + lq) * LROW + kk * 64 + kg * 16), vf[kk], cacc[dk], 0, 0, 0);
                }
            }
            __syncthreads();
            if (tid < 64) {
                float acc = 0.f;
                UNROLL for (int c8 = 0; c8 < 8; ++c8) { float kw[8]; ld8((const bf16_t*)(KW + tid * LROW) + 8 * c8, kw); UNROLL for (int i = 0; i < 8; ++i) acc += kw[i]; }
                NV[tid] = __expf(BV[63]) * NV[tid] + acc;
            }
            {
                const float* hr = HO + ti * 132 + 16 * j;
                float o0[8], o1[8];
                UNROLL for (int i = 0; i < 8; ++i) { o0[i] = hr[i]; o1[i] = hr[8 + i]; }
                bf16_t* dst = HS + ((size_t)d * NT + nb + tt) * 512 + h * 128 + 16 * j;
                st8(dst, o0); st8(dst + 8, o1);
            }
            __syncthreads();
        }
    }
}
DEV void ph_ml_read(const Params& p, int L, int ntok) {
    const int lane = TID() & 63, wave = TID() >> 6;
    const bf16_t* PXM = (const bf16_t*)(p.ws + OFF_PX); const bf16_t* HS = (const bf16_t*)(p.ws + OFF_HS);
    bf16_t* YC = (bf16_t*)(p.ws + OFF_YC); const float* ng = p.in[I_MNG] + (size_t)L * 512;
    for (int n0 = blockIdx.x * 8; n0 < ntok; n0 += gridDim.x * 8) {
        const int n = n0 + wave, c = lane * 8;
        float h0[8], h1[8], o8[8], out[8];
        ld8(HS + (size_t)n * 512 + c, h0); ld8(HS + ((size_t)NT + n) * 512 + c, h1); ld8(PXM + (size_t)n * ML_COLS + 1024 + c, o8);
        float ss = 0.f;
        UNROLL for (int i = 0; i < 8; ++i) { h0[i] += h1[i]; ss += h0[i] * h0[i]; }
        ss += __shfl_xor(ss, 1); ss += __shfl_xor(ss, 2); ss += __shfl_xor(ss, 4); ss += __shfl_xor(ss, 8);
        const float r = rsqrtf(ss * (1.f / 128.f) + 1e-6f);
        UNROLL for (int i = 0; i < 8; ++i) out[i] = h0[i] * r * ng[c + i] * sigm(o8[i]);
        st8(YC + (size_t)n * 512 + c, out);
    }
}

DEV void ph_route(const Params& p, int L, int ntok, char* smem) {
    const int lane = TID() & 63, wave = TID() >> 6;
    const float* LOG = (const float*)(p.ws + OFF_LOG); int* EIDX = (int*)(p.ws + OFF_EIDX); float* EW = (float*)(p.ws + OFF_EW);
    const float bias = p.in[I_MB][L * 64 + lane];
    int* MCNT = (int*)(p.ws + OFF_MCNT);
    int* hist = (int*)smem;
    if (TID() < 192) hist[TID()] = 0;
    __syncthreads();
    for (int n0 = blockIdx.x * 8; n0 < ntok; n0 += gridDim.x * 8) {
        const int n = n0 + wave, g = lane >> 3;
        const float score = sigm_acc(LOG[(size_t)n * 64 + lane]), sel = score + bias;
        float m1 = sel; m1 = fmaxf(m1, __shfl_xor(m1, 1)); m1 = fmaxf(m1, __shfl_xor(m1, 2)); m1 = fmaxf(m1, __shfl_xor(m1, 4));
        int i1 = sel == m1 ? lane : 64; i1 = min(i1, __shfl_xor(i1, 1)); i1 = min(i1, __shfl_xor(i1, 2)); i1 = min(i1, __shfl_xor(i1, 4));
        float m2 = lane == i1 ? -3e38f : sel; m2 = fmaxf(m2, __shfl_xor(m2, 1)); m2 = fmaxf(m2, __shfl_xor(m2, 2)); m2 = fmaxf(m2, __shfl_xor(m2, 4));
        const float gs = m1 + m2;
        int rank = 0;
        UNROLL for (int g2 = 0; g2 < 8; ++g2) { const float v = __shfl(gs, g2 * 8); rank += (v > gs || (v == gs && g2 < g)) ? 1 : 0; }
        const float ms = rank < 4 ? sel : -1e30f;
        int er = 0;
        for (int e2 = 0; e2 < 64; ++e2) { const float v = __shfl(ms, e2); er += (v > ms || (v == ms && e2 < lane)) ? 1 : 0; }
        const bool chosen = er < 8;
        float ws = chosen ? score : 0.f;
        UNROLL for (int o = 1; o < 64; o <<= 1) ws += __shfl_xor(ws, o);
        if (chosen) { EIDX[(size_t)n * 8 + er] = lane; EW[(size_t)n * 8 + er] = score / ws * 2.5f; atomicAdd(hist + (n / MOE_CHUNK) * 64 + lane, 1); }
    }
    __syncthreads();
    if (TID() < 192 && hist[TID()] > 0) atomicAdd(MCNT + TID(), hist[TID()]);
    __syncthreads();
}


DEV void ph_moe_scatter(const Params& p, int ntok, char* smem) {
    const int tid = TID();
    int* base = (int*)smem;
    int* lh = base + 192;
    const int* MCNT = (const int*)(p.ws + OFF_MCNT); int* CUR = (int*)(p.ws + OFF_MCNT) + 192;
    const int* EIDX = (const int*)(p.ws + OFF_EIDX); int* SORT = (int*)(p.ws + OFF_SORT);
    if (tid < 3) { int b = 0; for (int e = 0; e < 64; ++e) { base[tid * 64 + e] = b; b += (MCNT[tid * 64 + e] + 127) & ~127; } }
    if (tid < 192) lh[tid] = 0;
    __syncthreads();
    for (int i = blockIdx.x * NTHREADS + tid; i < ntok * 8; i += gridDim.x * NTHREADS) atomicAdd(lh + ((i >> 3) / MOE_CHUNK) * 64 + EIDX[i], 1);
    __syncthreads();
    if (tid < 192) { const int n = lh[tid]; if (n > 0) base[tid] += atomicAdd(CUR + tid, n); lh[tid] = 0; }
    __syncthreads();
    for (int i = blockIdx.x * NTHREADS + tid; i < ntok * 8; i += gridDim.x * NTHREADS) {
        const int ce = ((i >> 3) / MOE_CHUNK) * 64 + EIDX[i];
        SORT[(size_t)(ce >> 6) * SORT_CAP + base[ce] + atomicAdd(lh + ce, 1)] = i;
    }
    __syncthreads();
}

DEV void ph_moe_exp(const Params& p, int cb, int ce, char* smem, Topo tp) {
    typedef GC<2, 4> C;
    const int tid0 = TID();
    char* ACT = smem + 2 * C::STG;
    int* list = (int*)(smem + 3 * C::STG);
    int* cnt = list + 1024;
    const bf16_t* H2 = (const bf16_t*)(p.ws + OFF_HX); const int* EIDX = (const int*)(p.ws + OFF_EIDX); const float* EW = (const float*)(p.ws + OFF_EW);
    bf16_t* YBUF = (bf16_t*)(p.ws + OFF_YBUF);
    const int c = cb / MOE_CHUNK;
    const int* MCNT = (const int*)(p.ws + OFF_MCNT) + c * 64; const int* SORT = (const int*)(p.ws + OFF_SORT) + (size_t)c * SORT_CAP;
    int* tb = cnt + 16;
    const int xcd = tp.x, slot = tp.r, nslot = tp.n;
    __syncthreads();
    if (tid0 < 8) {
        const int tid = tid0; const int e = xcd + 8 * tid; int b = 0;
        for (int e2 = 0; e2 < e; ++e2) b += (MCNT[e2] + 127) & ~127;
        tb[16 + tid] = b; tb[32 + tid] = MCNT[e];
    }
    __syncthreads();
    if (tid0 == 0) { int t = 0; for (int k = 0; k < 8; ++k) { tb[k] = t; t += (tb[32 + k] + 127) >> 7; } tb[8] = t; }
    __syncthreads();
    const int total = tb[8];
    float* ewl = (float*)(list + 256);
    if (slot < total && tid0 < 128) {
        int k = 0;
        while (k < 7 && slot >= tb[k + 1]) ++k;
        const int j = slot - tb[k], M = min(128, tb[32 + k] - 128 * j);
        const int en = SORT[tb[16 + k] + 128 * j + min(tid0, M - 1)];
        list[tid0] = en; ewl[tid0] = EW[en];
    }
    int cur = 0;
#define GLDS4(gp, lp) __builtin_amdgcn_global_load_lds((const __attribute__((address_space(1))) void*)(gp), (__attribute__((address_space(3))) void*)(lp), 4, 0, 0)
    for (int lu = slot; lu < total; lu += nslot) {
        int tid = tid0; asm volatile("" : "+v"(tid));
        const int lane = tid & 63, wave = tid >> 6, wm = wave / 4, wn = wave % 4, fr = lane & 31, fh = lane >> 5;
        int k = 0;
        while (k < 7 && lu >= tb[k + 1]) ++k;
        const int e = xcd + 8 * k, j = lu - tb[k], M = min(128, tb[32 + k] - 128 * j);
        const int* lst = list + cur * 128; const float* ew = ewl + cur * 128;
        int* lst2 = list + (cur ^ 1) * 128; float* ew2 = ewl + (cur ^ 1) * 128;
        const bool has_next = lu + nslot < total;
        __syncthreads();
        if (has_next && tid < 128) {
            const int lu2 = lu + nslot; int k2 = 0;
            while (k2 < 7 && lu2 >= tb[k2 + 1]) ++k2;
            const int j2 = lu2 - tb[k2], M2 = min(128, tb[32 + k2] - 128 * j2);
            GLDS4(SORT + tb[16 + k2] + 128 * j2 + min(tid, M2 - 1), lst2 + tid);
        }
        const bf16_t* GU = (const bf16_t*)(p.ws + OFF_MGU) + (size_t)e * 256 * 1024;
        const bf16_t* DT = (const bf16_t*)(p.ws + OFF_MDT) + (size_t)e * 1024 * 128;
        {
            constexpr int mc = 0;
            f32x16 acc[2][2];
            {
            acc_zero(acc);
            gemm_tile<2, 4, 3, false>(acc, [&](int r) -> const bf16_t* { const int ix = min(mc + r, M - 1); return H2 + (size_t)(lst[ix] >> 3) * 1024; },
                                   GU, 1024, 0, 256, 1024, smem, nullptr);
            }
            const int crow = tid >> 3, cch = (tid & 7) ^ ((crow >> 1) & 7);
#define MG2_ISSUE(nt_) do { UNROLL for (int kt = 0; kt < 2; ++kt) UNROLL for (int i = 0; i < 4; ++i) \
                    GLDS16(DT + (size_t)((nt_) * 256 + crow + 64 * i) * 128 + kt * 64 + cch * 8, smem + kt * C::STG + C::AB + i * 8192 + tid * 16); } while (0)
            if (has_next && tid < 128) GLDS4(EW + lst2[tid], ew2 + tid);
            MG2_ISSUE(0);
            UNROLL for (int mi = 0; mi < 2; ++mi) UNROLL for (int r = 0; r < 16; ++r) {
                const int row = wm * 64 + ACC_ROW(mi, r, fh), ix = mc + row;
                const float gw = ew[ix];
                const float gv = acc[mi][0][r], uv = acc[mi][1][r];
                const float a = gv * frcp(1.f + __expf(-gv)) * uv * gw;
                const int col = wn * 32 + fr;
                *(bf16_t*)(ACT + (col >> 6) * C::AB + row * 128 + ((((col & 63) >> 3) ^ ((row >> 1) & 7)) << 4) + (col & 7) * 2) = f2bf(a);
            }
            __syncthreads();
            {
                const int sw = (fr >> 1) & 7, a_base = (wm * 64 + fr) * 128, b_base = (wn * 64 + fr) * 128;
                float* slab = (float*)(smem + (wave < 4 ? wave * 4096 : C::STG + (wave - 4) * 4096));
                asm volatile("s_waitcnt vmcnt(0)" ::: "memory");
                _Pragma("unroll 1") for (int nt = 0; nt < 4; ++nt) {
                    __builtin_amdgcn_s_barrier();
                    asm volatile("" ::: "memory");
                    acc_zero(acc);
                    UNROLL for (int kt = 0; kt < 2; ++kt) {
                        const char* As_ = ACT + kt * C::AB; const char* Bs_ = smem + kt * C::STG + C::AB;
                        UNROLL for (int ks = 0; ks < 4; ++ks) {
                            const int off = ((2 * ks + fh) ^ sw) * 16;
                            bf16x8 af[2], bfv[2];
                            UNROLL for (int mi = 0; mi < 2; ++mi) af[mi] = *(const bf16x8*)(As_ + a_base + mi * 4096 + off);
                            UNROLL for (int ni = 0; ni < 2; ++ni) bfv[ni] = *(const bf16x8*)(Bs_ + b_base + ni * 4096 + off);
                            UNROLL for (int mi = 0; mi < 2; ++mi) UNROLL for (int ni = 0; ni < 2; ++ni)
                                acc[mi][ni] = __builtin_amdgcn_mfma_f32_32x32x16_bf16(af[mi], bfv[ni], acc[mi][ni], 0, 0, 0);
                        }
                    }
                    asm volatile("s_waitcnt lgkmcnt(0)" ::: "memory");
                    __builtin_amdgcn_s_barrier();
                    asm volatile("" ::: "memory");
                    if (nt < 3) MG2_ISSUE(nt + 1);
                    asm volatile("" ::: "memory");
                    UNROLL for (int mi = 0; mi < 2; ++mi) UNROLL for (int hh = 0; hh < 2; ++hh) {
                        UNROLL for (int ni = 0; ni < 2; ++ni) UNROLL for (int r8 = 0; r8 < 8; ++r8) {
                            const int r = 8 * hh + r8;
                            slab[((r & 3) + 8 * ((r >> 2) & 1) + 4 * fh) * 64 + ni * 32 + fr] = acc[mi][ni][r];
                        }
                        UNROLL for (int it = 0; it < 2; ++it) {
                            const int row = (lane >> 3) + 8 * it, c8 = (lane & 7) * 8;
                            const float4 a = *(const float4*)(slab + row * 64 + c8), b = *(const float4*)(slab + row * 64 + c8 + 4);
                            const float v[8] = {a.x, a.y, a.z, a.w, b.x, b.y, b.z, b.w};
                            const int ix = mc + wm * 64 + mi * 32 + 16 * hh + row;
                            st8(YBUF + (size_t)(lst[ix] - cb * 8) * 1024 + nt * 256 + wn * 64 + c8, v);
                        }
                    }
                    asm volatile("s_waitcnt vmcnt(8)" ::: "memory");
                }
#undef MG2_ISSUE
            }
        }
        cur ^= 1;
    }
#undef GLDS4
}


#define XB_TMO      128
#define XB_XCNT(j)  (256  + 64 * (j))
#define XB_XSUB(j)  (1280 + 64 * (j))
#define XB_XGEN(j)  (2304 + 64 * (j))
#define XB_TOP      3328
#define XB_TOPGEN   3392
#define XCD_BAR_WORDS 3456
#define XB_SPIN_CAP (1u << 18)
#define LAS __attribute__((address_space(3)))

__device__ __forceinline__ unsigned xb_ld(unsigned* p)              { return __hip_atomic_load(p, __ATOMIC_RELAXED, __HIP_MEMORY_SCOPE_AGENT); }
__device__ __forceinline__ unsigned xb_add(unsigned* p, unsigned v) { return __hip_atomic_fetch_add(p, v, __ATOMIC_RELAXED, __HIP_MEMORY_SCOPE_AGENT); }
__device__ __forceinline__ unsigned xb_xcc_id() { return (unsigned)__builtin_amdgcn_s_getreg((3 << 11) | 20) & 0xFu; }
#define XB_SPIN(cond, bar) do { unsigned _sp = 0; while (cond) { __builtin_amdgcn_s_sleep(1); \
    if ((++_sp & 255u) == 0u) { if (xb_ld(&(bar)[XB_TMO])) break; if (_sp > XB_SPIN_CAP) { atomicAdd(&(bar)[XB_TMO], 1u); break; } } } } while (0)

struct XcdBarrier { unsigned* bar; unsigned x; volatile LAS unsigned* st; };

__device__ __forceinline__ XcdBarrier xcd_barrier_post(unsigned* bar, volatile LAS unsigned* st) {
    XcdBarrier b; b.bar = bar; b.x = xb_xcc_id(); b.st = st;
    if (threadIdx.x == 0) { const unsigned rank = xb_add(&bar[XB_XCNT(b.x)], 1u); st[2] = b.x; st[3] = rank; }
    return b;
}
__device__ __forceinline__ void xcd_barrier_complete(unsigned* bar, unsigned x, unsigned& nloc, unsigned& nx) {
    const unsigned G = gridDim.x * gridDim.y * gridDim.z;
    unsigned sum, cnt, mine, sp = 0u;
    for (;;) {
        sum = 0u; cnt = 0u; mine = 0u;
#pragma unroll
        for (unsigned j = 0; j < 16; ++j) { const unsigned c = xb_ld(&bar[XB_XCNT(j)]); sum += c; cnt += (c > 0u) ? 1u : 0u; mine = (j == x) ? c : mine; }
        if (sum == G) break;
        __builtin_amdgcn_s_sleep(1);
        if ((++sp & 255u) == 0u) { if (xb_ld(&bar[XB_TMO])) break; if (sp > XB_SPIN_CAP) { atomicAdd(&bar[XB_TMO], 1u); break; } }
    }
    nloc = mine > 0u ? mine : 1u; nx = cnt > 0u ? cnt : 1u;
}
__device__ __forceinline__ void xcd_barrier(const XcdBarrier& b) {
    asm volatile("s_waitcnt vmcnt(0)" ::: "memory");
    __syncthreads();
    if (threadIdx.x == 0) {
        unsigned* bar = b.bar;
        __builtin_amdgcn_s_waitcnt(0);
        unsigned nloc = b.st[0], nx = b.st[1];
        if (nloc == 0u) { xcd_barrier_complete(bar, b.x, nloc, nx); b.st[0] = nloc; b.st[1] = nx; }
        const unsigned old = xb_add(&bar[XB_XSUB(b.x)], 1u);
        const unsigned gen = old / nloc;
        if (old + 1u == (gen + 1u) * nloc) {
            __builtin_amdgcn_fence(__ATOMIC_RELEASE, "agent");
            asm volatile("s_waitcnt vmcnt(0)" ::: "memory");
            const unsigned og = xb_add(&bar[XB_TOP], 1u);
            const unsigned tg = og / nx;
            if (og + 1u == (tg + 1u) * nx) xb_add(&bar[XB_TOPGEN], 1u);
            else XB_SPIN(xb_ld(&bar[XB_TOPGEN]) == tg, bar);
            __builtin_amdgcn_fence(__ATOMIC_ACQUIRE, "agent");
            xb_add(&bar[XB_XGEN(b.x)], 1u);
            asm volatile("s_waitcnt vmcnt(0)" ::: "memory");
        } else {
            XB_SPIN(xb_ld(&bar[XB_XGEN(b.x)]) == gen, bar);
            __builtin_amdgcn_fence(__ATOMIC_ACQUIRE, "agent");
            asm volatile("s_waitcnt vmcnt(0)" ::: "memory");
        }
    }
    __syncthreads();
}

enum { PH_MODCONV = 0, PH_HX, PH_GEMM_R, PH_RW_PREP, PH_RW_SCAN, PH_RW_READ, PH_RW_G, PH_GEMM_N, PH_NA_NORM, PH_NA_ATT, PH_GEMM_M, PH_ML_SCAN, PH_ML_READ,
       PH_GEMM_G, PH_MERGE, PH_OUT, PH_NORM2, PH_ROUTER, PH_ROUTE, PH_SHARED, PH_MOE_EXP, PH_MOE_COMB, PH_COUNT };

template <int PH> DEV void run_phase(const Params& p, int L, int sub, char* smem, Topo tp) {
    const int tid = TID(), lane = tid & 63, fr = lane & 31, fh = lane >> 5;
    char* ws = p.ws;
    const int ntl = L == 0 ? NT : NX;
    const bf16_t* HX = (const bf16_t*)(ws + OFF_HX);
    const bf16_t* WINT = (const bf16_t*)(ws + OFF_WINT);
    if constexpr (PH == PH_MODCONV) { ph_mod(p, L, smem); ph_conv_mix(p, L, smem); }
    else if constexpr (PH == PH_HX) { ph_norm(p, L, 0, NT); }
    else if constexpr (PH == PH_GEMM_R || PH == PH_GEMM_M) {
        const int c0 = PH == PH_GEMM_R ? 0 : RW_COLS + NA_COLS;
        const int N = PH == PH_GEMM_R ? RW_COLS : ML_COLS;
        bf16_t* PX = (bf16_t*)(ws + OFF_PX);
        gemm256(HX, NT, WINT + (size_t)c0 * DM, N, DM, smem, tp, [&](int row, int col, const float (&v)[8]) {
            if (col < N) st8(PX + (size_t)row * N + col, v);
        });
    }
    else if constexpr (PH == PH_GEMM_N) {
        bf16_t* PX = (bf16_t*)(ws + OFF_PX); bf16_t* VT = (bf16_t*)(ws + OFF_VT); bf16_t* VTC = (bf16_t*)(ws + OFF_VTC);
        gemm256(HX, NT, WINT + (size_t)RW_COLS * DM, 1024, DM, smem, tp, [&](int row, int col, const float (&v)[8]) { st8(PX + (size_t)row * 1024 + col, v); });
        gemm_phase<4, 2>(HX, DM, NT, WINT + (size_t)(RW_COLS + 1024) * DM, DM, 512, DM, smem, tp, [&](const f32x16 (&acc)[2][2], int row0, int col0) {
            const int h = col0 >> 6;
            epi_cols(acc, smem, [&](int r8, int col, const float (&v)[8]) {
                const int n = row0 + r8;
                bf16_t* dst = n < NX ? VT + ((size_t)((n >> 11) * 8 + h) * 64 + col) * SEQ + (n & 2047)
                                     : VTC + ((size_t)(((n - NX) >> 8) * 8 + h) * 64 + col) * CTXL + ((n - NX) & 255);
                st8(dst, v);
            });
        });
    }
    else if constexpr (PH == PH_RW_PREP) { ph_rw_prep(p, L, smem); }
    else if constexpr (PH == PH_RW_SCAN) { ph_rw_scan(p, L, smem); }
    else if constexpr (PH == PH_RW_READ) { ph_rw_read(p, L, ntl); }
    else if constexpr (PH == PH_RW_G) {
        bf16_t* YA = (bf16_t*)(ws + OFF_YA);
        gemm_phase<4, 2>((const bf16_t*)(ws + OFF_SGB), 128, ntl, (const bf16_t*)(ws + OFF_G2T), 128, 512, 128, smem, tp, [&](const f32x16 (&acc)[2][2], int row0, int col0) {
            epi_rows(acc, smem, [&](int row, int c8, const float (&v)[8]) {
                bf16_t* q = YA + (size_t)(row0 + row) * 512 + col0 + c8;
                float y[8]; ld8(q, y);
                UNROLL for (int i = 0; i < 8; ++i) y[i] *= v[i];
                st8(q, y);
            });
        });
    }
    else if constexpr (PH == PH_NA_NORM) { ph_na_norm(p, L); }
    else if constexpr (PH == PH_NA_ATT) { ph_na_att(p, L, smem); }
    else if constexpr (PH == PH_ML_SCAN) {
        if (blockIdx.x < 128 || gridDim.x <= 128) ph_ml_scan(p, L, smem);
        if (gridDim.x <= 128) ph_conv_moe_gu(p, L, smem, blockIdx.x, gridDim.x);
        else if (blockIdx.x >= 128) ph_conv_moe_gu(p, L, smem, blockIdx.x - 128, gridDim.x - 128);
    }
    else if constexpr (PH == PH_ML_READ) { ph_ml_read(p, L, ntl); }
    else if constexpr (PH == PH_GEMM_G) {
        bf16_t* G = (bf16_t*)(ws + OFF_GATES);
        gemm256(HX, ntl, WINT + (size_t)(RW_COLS + NA_COLS + ML_COLS) * DM, GATE_COLS, DM, smem, tp, [&](int row, int col, const float (&v)[8]) {
            float y[8];
            UNROLL for (int i = 0; i < 8; ++i) y[i] = sigm(v[i]);
            st8(G + (size_t)row * GATE_COLS + col, y);
        });
    }
    else if constexpr (PH == PH_MERGE) {
        const bf16_t* G = (const bf16_t*)(ws + OFF_GATES); bf16_t* MG = (bf16_t*)(ws + OFF_HX);
        _Pragma("unroll 1") for (int br = 0; br < 3; ++br) {
            gemm256((const bf16_t*)(ws + OFF_YA + (size_t)br * SZ_Y1), ntl, (const bf16_t*)(ws + OFF_WBT) + (size_t)br * 1024 * 512, DM, 512, smem, tp, [&](int row, int col, const float (&v)[8]) {
                float g[8], m[8];
                ld8(G + (size_t)row * GATE_COLS + br * DM + col, g);
                bf16_t* q = MG + (size_t)row * DM + col;
                if (br == 0) { UNROLL for (int i = 0; i < 8; ++i) m[i] = g[i] * v[i]; }
                else { ld8(q, m); UNROLL for (int i = 0; i < 8; ++i) m[i] += g[i] * v[i]; }
                st8(q, m);
            });
        }
    }
    else if constexpr (PH == PH_OUT) {
        const float* MOD = (const float*)(ws + OFF_MOD);
        gemm256(HX, ntl, (const bf16_t*)(ws + OFF_WOUTT), DM, DM, smem, tp, [&](int n, int c, const float (&v)[8]) {
            const float* xp = xprev_row(p, L, n) + c; float* xo = xs_row(p, n) + c; const float* g1 = MOD + mod_row(n) * 6144 + 2 * DM + c;
            const float4 xa = *(const float4*)xp, xb = *(const float4*)(xp + 4), ga = *(const float4*)g1, gb = *(const float4*)(g1 + 4);
            float4 oa, ob;
            oa.x = xa.x + ga.x * v[0]; oa.y = xa.y + ga.y * v[1]; oa.z = xa.z + ga.z * v[2]; oa.w = xa.w + ga.w * v[3];
            ob.x = xb.x + gb.x * v[4]; ob.y = xb.y + gb.y * v[5]; ob.z = xb.z + gb.z * v[6]; ob.w = xb.w + gb.w * v[7];
            *(float4*)xo = oa; *(float4*)(xo + 4) = ob;
        });
    }
    else if constexpr (PH == PH_NORM2) {
        if (blockIdx.x == 0 && tid < 384) ((int*)(ws + OFF_MCNT))[tid] = 0;
        ph_norm(p, L, 1, ntl);
    }
    else if constexpr (PH == PH_ROUTER) {
        typedef GC<4, 2> C;
        float* LOG = (float*)(ws + OFF_LOG);
        const bf16_t* H2LO = (const bf16_t*)(ws + OFF_H2LO); const bf16_t* RH = (const bf16_t*)(ws + OFF_RTR); const bf16_t* RL = RH + 64 * 1024;
        const int wave = tid >> 6, wm = wave / 2, wn = wave % 2;
        {
            const int nrt = ntl / C::BM, G = gridDim.x;
            if (G > nrt) { if ((int)blockIdx.x >= nrt) ph_conv_moe(p, L, smem, blockIdx.x - nrt, G - nrt); }
            else ph_conv_moe(p, L, smem, blockIdx.x, G);
        }
        for (int t = blockIdx.x; t < ntl / C::BM; t += gridDim.x) {
            f32x16 acc[2][2]; acc_zero(acc);
            const bf16_t* A0 = HX + (size_t)t * C::BM * DM; const bf16_t* A1 = H2LO + (size_t)t * C::BM * DM;
            gemm_tile<4, 2, 3, false>(acc, [&](int r) { return A0 + (size_t)r * DM; }, RH, DM, 0, 64, DM, smem, nullptr);
            gemm_tile<4, 2, 3, false>(acc, [&](int r) { return A1 + (size_t)r * DM; }, RH, DM, 0, 64, DM, smem, nullptr);
            gemm_tile<4, 2, 3, false>(acc, [&](int r) { return A0 + (size_t)r * DM; }, RL, DM, 0, 64, DM, smem, nullptr);
            epi_rows(acc, smem, [&](int row, int c8, const float (&v)[8]) {
                if (wn == 0) {
                    float* q = LOG + (size_t)(t * C::BM + wm * 64 + row) * 64 + c8;
                    *(float4*)q = make_float4(v[0], v[1], v[2], v[3]); *(float4*)(q + 4) = make_float4(v[4], v[5], v[6], v[7]);
                }
            });
        }
    }
    else if constexpr (PH == PH_ROUTE) { ph_route(p, L, ntl, smem); }
    else if constexpr (PH == PH_SHARED) {
        ph_moe_scatter(p, ntl, smem);
        bf16_t* SA = (bf16_t*)(ws + OFF_SA);
        gemm256_pair(HX, ntl, (const bf16_t*)(ws + OFF_SGUT), 512, DM, smem, tp, [&](int row, int col, const float (&g)[8], const float (&u)[8]) {
            float a[8];
            UNROLL for (int i = 0; i < 8; ++i) a[i] = g[i] * frcp(1.f + __expf(-g[i])) * u[i];
            st8(SA + (size_t)row * 256 + (col >> 8) * 128 + (col & 127), a);
        });
    }
    else if constexpr (PH == PH_MOE_EXP) { const int cb = sub * MOE_CHUNK; ph_moe_exp(p, cb, min(cb + MOE_CHUNK, ntl), smem, tp); }
    else if constexpr (PH == PH_MOE_COMB) {
        const int cb = sub * MOE_CHUNK, ce = min(cb + MOE_CHUNK, ntl);
        const float* MOD = (const float*)(ws + OFF_MOD); const bf16_t* YBUF = (const bf16_t*)(ws + OFF_YBUF);
        gemm256((const bf16_t*)(ws + OFF_SA) + (size_t)cb * 256, ce - cb, (const bf16_t*)(ws + OFF_SDT), DM, 256, smem, tp, [&](int rl, int c, const float (&v)[8]) {
            const int n = cb + rl;
            float s[8];
            UNROLL for (int i = 0; i < 8; ++i) s[i] = v[i];
            _Pragma("unroll 2") for (int k = 0; k < 8; ++k) { float y[8]; ld8(YBUF + ((size_t)rl * 8 + k) * DM + c, y); UNROLL for (int i = 0; i < 8; ++i) s[i] += y[i]; }
            float* xo = xs_row(p, n) + c; const float* g2 = MOD + mod_row(n) * 6144 + 5 * DM + c;
            float4 xa = *(const float4*)xo, xb = *(const float4*)(xo + 4); const float4 ga = *(const float4*)g2, gb = *(const float4*)(g2 + 4);
            xa.x += ga.x * s[0]; xa.y += ga.y * s[1]; xa.z += ga.z * s[2]; xa.w += ga.w * s[3];
            xb.x += gb.x * s[4]; xb.y += gb.y * s[5]; xb.z += gb.z * s[6]; xb.w += gb.w * s[7];
            *(float4*)xo = xa; *(float4*)(xo + 4) = xb;
        });
    }
}

#ifndef N_LAUNCH_MODE
#define N_LAUNCH_MODE 1
#endif
#if N_LAUNCH_MODE == 0
template <int PH> __global__ void __launch_bounds__(NTHREADS, 2) k_phase(Params p, int L, int sub) {
    extern __shared__ __attribute__((aligned(16))) char smem[];
    run_phase<PH>(p, L, sub, smem, Topo{(int)(blockIdx.x & 7), (int)(blockIdx.x >> 3), (int)((gridDim.x + 7 - (blockIdx.x & 7)) >> 3)});
}
#endif


#ifndef MEGA_SKIP
#define MEGA_SKIP 0ull
#endif
#ifndef MEGA_REPEAT
#define MEGA_REPEAT 0ull
#endif
#define BARRIER() do { XcdBarrier b2_ = bar; unsigned so_ = LDS_BYTES; asm volatile("" : "+v"(so_)); b2_.st = (volatile LAS unsigned*)(smem + so_); xcd_barrier(b2_); } while (0)
#define PHASE(PH, sub) do { if constexpr (!((MEGA_SKIP >> PH) & 1ull)) { run_phase<PH>(p, L, sub, smem, tp); BARRIER(); if constexpr ((MEGA_REPEAT >> PH) & 1ull) { run_phase<PH>(p, L, sub, smem, tp); BARRIER(); } } } while (0)
__global__ void __launch_bounds__(NTHREADS, 2) k_mega(Params p) {
    extern __shared__ __attribute__((aligned(16))) char smem[];
    volatile LAS unsigned* st = (volatile LAS unsigned*)(smem + LDS_BYTES);
    if (threadIdx.x == 0) { st[0] = 0u; st[1] = 0u; st[2] = 0u; st[3] = 0u; }
    __syncthreads();
    const XcdBarrier bar = xcd_barrier_post((unsigned*)(p.ws + OFF_BAR), st);
    Topo tp{(int)(blockIdx.x & 7), (int)(blockIdx.x >> 3), (int)((gridDim.x + 7 - (blockIdx.x & 7)) >> 3)};
    for (int L = 0; L < 2; ++L) {
        const int ntl = L == 0 ? NT : NX;
        PHASE(PH_MODCONV, 0);
        if (st[1] == 8u && st[0] != 0u) { tp.x = (int)st[2]; tp.r = (int)st[3]; tp.n = (int)st[0]; }
        PHASE(PH_HX, 0);
        PHASE(PH_GEMM_R, 0);
        PHASE(PH_RW_PREP, 0);
        PHASE(PH_RW_SCAN, 0);
        PHASE(PH_RW_READ, 0);
        PHASE(PH_RW_G, 0);
        PHASE(PH_GEMM_N, 0);
        PHASE(PH_NA_ATT, 0);
        PHASE(PH_GEMM_M, 0);
        PHASE(PH_ML_SCAN, 0);
        PHASE(PH_ML_READ, 0);
        PHASE(PH_GEMM_G, 0);
        PHASE(PH_MERGE, 0);
        PHASE(PH_OUT, 0);
        PHASE(PH_NORM2, 0);
        PHASE(PH_ROUTER, 0);
        PHASE(PH_ROUTE, 0);
        PHASE(PH_SHARED, 0);
        for (int c = 0; c * MOE_CHUNK < ntl; ++c) {
            PHASE(PH_MOE_EXP, c);
            PHASE(PH_MOE_COMB, c);
        }
    }
}

#if N_LAUNCH_MODE == 0
template <int PH> static void launch_phase(const Params& p, int L, int sub, hipStream_t stream) {
    static bool attr = false;
    if (!attr) { (void)hipFuncSetAttribute((const void*)k_phase<PH>, hipFuncAttributeMaxDynamicSharedMemorySize, LDS_BYTES); attr = true; }
    hipLaunchKernelGGL(k_phase<PH>, dim3(256), dim3(NTHREADS), LDS_BYTES, stream, p, L, sub);
}
#endif

extern "C" void kernel_launch(void* const* d_in, const int* in_sizes, int n_in, void* d_out, int out_size, void* d_ws, size_t ws_size, hipStream_t stream) {
    if (n_in != N_IN || ws_size < WS_END) { fprintf(stderr, "kernel_launch: unexpected inputs (%d) or workspace (%zu < %zu)\n", n_in, ws_size, (size_t)WS_END); return; }
    Params p{};
    for (int i = 0; i < N_IN; ++i) p.in[i] = (const float*)d_in[i];
    p.out = (float*)d_out; p.ws = (char*)d_ws;
#if N_LAUNCH_MODE == 1
    static int grid = 0;
    if (grid == 0) {
        int dev = 0, cus = 0;
        if (hipGetDevice(&dev) != hipSuccess || hipDeviceGetAttribute(&cus, hipDeviceAttributeMultiprocessorCount, dev) != hipSuccess) { grid = -1; return; }
        if (hipFuncSetAttribute((const void*)k_mega, hipFuncAttributeMaxDynamicSharedMemorySize, LDS_BYTES + 256) != hipSuccess) { grid = -1; return; }
        grid = cus;
    }
    if (grid <= 0) return;
    (void)hipMemsetAsync((char*)d_ws + OFF_BAR, 0, XCD_BAR_WORDS * sizeof(unsigned), stream);
    hipLaunchKernelGGL(k_mega, dim3(grid), dim3(NTHREADS), LDS_BYTES + 256, stream, p);
    return;
#endif
#if N_LAUNCH_MODE == 0
    for (int L = 0; L < 2; ++L) {
        const int ntl = L == 0 ? NT : NX;
        launch_phase<PH_MODCONV>(p, L, 0, stream);
        launch_phase<PH_HX>(p, L, 0, stream);
        launch_phase<PH_GEMM_R>(p, L, 0, stream);
        launch_phase<PH_RW_PREP>(p, L, 0, stream);
        launch_phase<PH_RW_SCAN>(p, L, 0, stream);
        launch_phase<PH_RW_READ>(p, L, 0, stream);
        launch_phase<PH_RW_G>(p, L, 0, stream);
        launch_phase<PH_GEMM_N>(p, L, 0, stream);
        launch_phase<PH_NA_ATT>(p, L, 0, stream);
        launch_phase<PH_GEMM_M>(p, L, 0, stream);
        launch_phase<PH_ML_SCAN>(p, L, 0, stream);
        launch_phase<PH_ML_READ>(p, L, 0, stream);
        launch_phase<PH_GEMM_G>(p, L, 0, stream);
        launch_phase<PH_MERGE>(p, L, 0, stream);
        launch_phase<PH_OUT>(p, L, 0, stream);
        launch_phase<PH_NORM2>(p, L, 0, stream);
        launch_phase<PH_ROUTER>(p, L, 0, stream);
        launch_phase<PH_ROUTE>(p, L, 0, stream);
        launch_phase<PH_SHARED>(p, L, 0, stream);
        for (int c = 0; c * MOE_CHUNK < ntl; ++c) {
            launch_phase<PH_MOE_EXP>(p, L, c, stream);
            launch_phase<PH_MOE_COMB>(p, L, c, stream);
        }
    }
#endif
}
```

```cpp
#include <hip/hip_runtime.h>
#include <stdint.h>
#include <stdio.h>

#define DEV __device__ __forceinline__
#define UNROLL _Pragma("unroll")

typedef unsigned short bf16_t;
typedef short bf16x8 __attribute__((ext_vector_type(8)));
typedef float f32x16 __attribute__((ext_vector_type(16)));
typedef float f32x4v __attribute__((ext_vector_type(4)));
typedef unsigned u32x4 __attribute__((ext_vector_type(4)));
typedef unsigned u32x2 __attribute__((ext_vector_type(2)));

constexpr int DM = 1024, NBATCH = 16, SEQ = 2048, CTXL = 256;
constexpr int NX = NBATCH * SEQ, NC = NBATCH * CTXL, NT = NX + NC;
constexpr int RW_COLS = 1920, NA_COLS = 1536, ML_COLS = 1552, GATE_COLS = 3072, IN_COLS = 8080;
constexpr int NTHREADS = 512;
constexpr int MOE_CHUNK = 12288, MOE_ST = 768;

enum { I_X = 0, I_C, I_CTX, I_CCTX, I_WADA, I_BADA, I_N1G, I_N2G, I_WIN, I_MU, I_W0, I_W2, I_A0, I_A2, I_KK, I_KA, I_RK, I_G2,
       I_LNG, I_LNB, I_V0, I_V1, I_V2, I_QNG, I_KNG, I_RPB, I_IB, I_FB, I_MNG, I_WBR, I_WOUT, I_RTR, I_MB, I_MWG, I_MWU, I_MWD,
       I_SG, I_SU, I_SD, N_IN };

constexpr size_t OFF_BAR = 0;
constexpr size_t OFF_MOD = 16384;
constexpr size_t OFF_WINT = OFF_MOD + 417792;
constexpr size_t OFF_WBT = OFF_WINT + (size_t)IN_COLS * 1024 * 2;
constexpr size_t OFF_WOUTT = OFF_WBT + (size_t)3 * 1024 * 512 * 2;
constexpr size_t OFF_SGUT = OFF_WOUTT + (size_t)1024 * 1024 * 2;
constexpr size_t OFF_SDT = OFF_SGUT + (size_t)512 * 1024 * 2;
constexpr size_t OFF_G2T = OFF_SDT + (size_t)1024 * 256 * 2;
constexpr size_t OFF_RTR = OFF_G2T + (size_t)512 * 128 * 2;
constexpr size_t OFF_CTXS = OFF_RTR + (size_t)2 * 64 * 1024 * 2;
constexpr size_t OFF_VF = OFF_CTXS + (size_t)NC * 1024 * 4;
constexpr size_t OFF_HX = OFF_VF + (size_t)NT * 512 * 2;
constexpr size_t OFF_BIG = OFF_HX + (size_t)NT * 1024 * 2;
constexpr size_t SZ_Y1 = (size_t)NT * 512 * 2;
constexpr size_t OFF_YA = OFF_BIG, OFF_YB = OFF_YA + SZ_Y1, OFF_YC = OFF_YB + SZ_Y1;
constexpr size_t OFF_PX = OFF_BIG + 3 * SZ_Y1;
constexpr size_t OFF_SCR = OFF_PX + (size_t)NT * RW_COLS * 2;
constexpr size_t SZ_SCR = (size_t)NT * 1152 * 2;
constexpr size_t OFF_MGU = OFF_SCR + SZ_SCR;
constexpr size_t WS_END = OFF_MGU + (size_t)64 * 256 * 1024 * 2;
constexpr size_t OFF_YS = OFF_YB;
constexpr size_t OFF_SGB = OFF_SCR;
constexpr size_t OFF_CB = OFF_SCR + (size_t)NT * 128 * 2;
constexpr size_t OFF_HS = OFF_SCR;
constexpr size_t OFF_VT = OFF_PX + (size_t)NT * 1024 * 2;
constexpr size_t OFF_VTC = OFF_VT + (size_t)NX * 512 * 2;
constexpr size_t OFF_GATES = OFF_PX;
constexpr size_t OFF_MDT = OFF_BIG;
constexpr size_t OFF_SA = OFF_MDT + (size_t)64 * 1024 * 128 * 2;
constexpr size_t OFF_EIDX = OFF_SA + (size_t)NT * 256 * 2;
constexpr size_t OFF_EW = OFF_EIDX + (size_t)NT * 8 * 4;
constexpr int SORT_CAP = 106496;
constexpr size_t OFF_SORT = OFF_EW + (size_t)NT * 8 * 4;
constexpr size_t OFF_LOG = OFF_SORT + (size_t)3 * SORT_CAP * 4;
constexpr size_t OFF_H2LO = OFF_LOG + (size_t)NT * 64 * 4;
constexpr size_t OFF_YBUF = OFF_LOG;
static_assert(OFF_YBUF + (size_t)MOE_CHUNK * 8 * 1024 * 2 <= WS_END, "moe layout");
static_assert(OFF_GATES + (size_t)NT * 3072 * 2 <= WS_END, "gates layout");
static_assert(WS_END <= (size_t)536870912, "workspace");

constexpr size_t OFF_MCNT = OFF_BAR + 14336;
constexpr int LDS_BYTES = 155648;

struct Topo { int x, r, n; };
struct Params {
    const float* in[N_IN];
    float* out;
    char* ws;
};

DEV int TID() { int t = threadIdx.x; asm volatile("" : "+v"(t)); return t; }
DEV float bf2f(bf16_t h) { return __uint_as_float(((unsigned)h) << 16); }
typedef __bf16 bf16x2n __attribute__((ext_vector_type(2)));
typedef float f32x2n __attribute__((ext_vector_type(2)));
DEV unsigned pk2(float lo, float hi) { const f32x2n v = {lo, hi}; return __builtin_bit_cast(unsigned, __builtin_convertvector(v, bf16x2n)); }
DEV bf16_t f2bf(float f) { return (bf16_t)(pk2(f, 0.f) & 0xffffu); }
DEV void ld8(const bf16_t* p, float (&o)[8]) {
    const u32x4 v = *(const u32x4*)p;
    o[0] = __uint_as_float(v.x << 16); o[1] = __uint_as_float(v.x & 0xffff0000u);
    o[2] = __uint_as_float(v.y << 16); o[3] = __uint_as_float(v.y & 0xffff0000u);
    o[4] = __uint_as_float(v.z << 16); o[5] = __uint_as_float(v.z & 0xffff0000u);
    o[6] = __uint_as_float(v.w << 16); o[7] = __uint_as_float(v.w & 0xffff0000u);
}
DEV void st8(bf16_t* p, const float (&v)[8]) {
    u32x4 o; o.x = pk2(v[0], v[1]); o.y = pk2(v[2], v[3]); o.z = pk2(v[4], v[5]); o.w = pk2(v[6], v[7]);
    *(u32x4*)p = o;
}
#define DPP_MOV(v, ctrl) __builtin_bit_cast(float, __builtin_amdgcn_update_dpp(0, __builtin_bit_cast(int, (v)), (ctrl), 0xF, 0xF, true))
DEV float sum8(float v) { v += DPP_MOV(v, 0xB1); v += DPP_MOV(v, 0x4E); v += DPP_MOV(v, 0x141); return v; }
DEV float frcp(float x) { return __builtin_amdgcn_rcpf(x); }
DEV float sigm(float x) { return frcp(1.f + __expf(-x)); }
DEV float sigm_acc(float x) { return 1.f / (1.f + expf(-x)); }
DEV float tanh_fast(float x) { return 1.f - 2.f * frcp(1.f + __expf(2.f * x)); }
DEV float softplus_fast(float x) { return fmaxf(x, 0.f) + __logf(1.f + __expf(-fabsf(x))); }
DEV int mod_row(int n) { return n < NX ? (n >> 11) : 16; }
DEV float* xs_row(const Params& p, int n) { return n < NX ? p.out + (size_t)n * DM : (float*)(p.ws + OFF_CTXS) + (size_t)(n - NX) * DM; }
DEV const float* xprev_row(const Params& p, int L, int n) {
    if (L == 0) return n < NX ? p.in[I_X] + (size_t)n * DM : p.in[I_CTX] + (size_t)(n - NX) * DM;
    return xs_row(p, n);
}
DEV void seq_of(int n, int& nb, int& tt, int& T) {
    if (n < NX) { nb = n & ~2047; tt = n & 2047; T = SEQ; } else { const int m = n - NX; nb = NX + (m & ~255); tt = m & 255; T = CTXL; }
}
DEV void shift8(const bf16_t* z, int ld, int nb, int tt, int T, int col0, const float* mu, float (&o)[8]) {
    float c[8], l[8], r[8];
    ld8(z + (size_t)(nb + tt) * ld + col0, c);
    if (tt > 0) ld8(z + (size_t)(nb + tt - 1) * ld + col0, l); else { UNROLL for (int i = 0; i < 8; ++i) l[i] = 0.f; }
    if (tt < T - 1) ld8(z + (size_t)(nb + tt + 1) * ld + col0, r); else { UNROLL for (int i = 0; i < 8; ++i) r[i] = 0.f; }
    UNROLL for (int i = 0; i < 8; ++i) o[i] = c[i] + mu[col0 + i] * (0.5f * (l[i] + r[i]) - c[i]);
}

constexpr int LROW = 144;
template <int WM, int WN> struct GC {
    static constexpr int BM = 64 * WM, BN = 64 * WN;
    static constexpr int AB = BM * 128, BB = BN * 128, STG = AB + BB;
    static constexpr int NA = BM / 64, NBC = BN / 64;
};
DEV void acc_zero(f32x16 (&acc)[2][2]) {
    UNROLL for (int a = 0; a < 2; ++a) UNROLL for (int b = 0; b < 2; ++b) UNROLL for (int r = 0; r < 16; ++r) acc[a][b][r] = 0.f;
}
#define GLDS16(gp, lp) __builtin_amdgcn_global_load_lds((const __attribute__((address_space(1))) void*)(gp), (__attribute__((address_space(3))) void*)(lp), 16, 0, 0)
DEV int p32(int s) { return 16 * ((s >> 2) & 1) + (s & 3) + 4 * (s >> 3); }
template <int WM, int WN, int NS, bool A_LDS, bool TR = false, class ARow>
DEV void gemm_tile(f32x16 (&acc)[2][2], ARow arow, const bf16_t* Bt, int ldb, int n0, int Nvalid, int K, char* smem, const char* alds) {
    typedef GC<WM, WN> C;
    constexpr int LPT = (A_LDS ? 0 : C::NA) + C::NBC;
    const int tid = TID(), lane = tid & 63, wave = tid >> 6, wm = wave / WN, wn = wave % WN;
    const int fr = lane & 31, fh = lane >> 5;
    const int crow = tid >> 3, cch = (tid & 7) ^ ((crow >> 1) & 7);
    const bf16_t* pa[C::NA]; const bf16_t* pb[C::NBC];
    if (!A_LDS) { UNROLL for (int i = 0; i < C::NA; ++i) pa[i] = arow(crow + 64 * i) + cch * 8; }
    UNROLL for (int i = 0; i < C::NBC; ++i) { const int rb = crow + 64 * i, n = min(n0 + (TR ? (rb & ~31) + p32(rb & 31) : rb), Nvalid - 1); pb[i] = Bt + (size_t)n * ldb + cch * 8; }
    const int nk = K >> 6;
#define GT_ISSUE(kt, stg) do { char* sb_ = smem + (stg) * C::STG + tid * 16; \
        if (!A_LDS) { UNROLL for (int i = 0; i < C::NA; ++i) GLDS16(pa[i] + (kt) * 64, sb_ + i * 8192); } \
        UNROLL for (int i = 0; i < C::NBC; ++i) GLDS16(pb[i] + (kt) * 64, sb_ + C::AB + i * 8192); } while (0)
    const int sw = (fr >> 1) & 7;
    int offk[4];
    UNROLL for (int ks = 0; ks < 4; ++ks) offk[ks] = ((2 * ks + fh) ^ sw) * 16;
    const int a_base = (wm * 64 + fr) * 128, b_base = (wn * 64 + fr) * 128;
    UNROLL for (int s = 0; s < NS - 1; ++s) if (s < nk) GT_ISSUE(s, s);
    int stg = 0, nstg = NS - 1;
    for (int kt = 0; kt < nk; ++kt) {
        if (NS == 3 && kt + 1 < nk) asm volatile("s_waitcnt vmcnt(%0)" :: "n"(LPT) : "memory");
        else asm volatile("s_waitcnt vmcnt(0)" ::: "memory");
        __builtin_amdgcn_s_barrier();
        asm volatile("" ::: "memory");
        const bool more = kt + NS - 1 < nk;
        const char* As_ = A_LDS ? alds + kt * C::AB : smem + stg * C::STG; const char* Bs_ = smem + stg * C::STG + C::AB;
        char* db_ = smem + nstg * C::STG + tid * 16;
        bf16x8 af[2][2], bfv[2][2];
        UNROLL for (int mi = 0; mi < 2; ++mi) af[0][mi] = *(const bf16x8*)(As_ + a_base + mi * 4096 + offk[0]);
        UNROLL for (int ni = 0; ni < 2; ++ni) bfv[0][ni] = *(const bf16x8*)(Bs_ + b_base + ni * 4096 + offk[0]);
        UNROLL for (int ks = 0; ks < 4; ++ks) {
            const int cur = ks & 1, nxt = cur ^ 1;
            if (ks < 3) {
                UNROLL for (int mi = 0; mi < 2; ++mi) af[nxt][mi] = *(const bf16x8*)(As_ + a_base + mi * 4096 + offk[ks + 1]);
                UNROLL for (int ni = 0; ni < 2; ++ni) bfv[nxt][ni] = *(const bf16x8*)(Bs_ + b_base + ni * 4096 + offk[ks + 1]);
            }
            UNROLL for (int mi = 0; mi < 2; ++mi) UNROLL for (int ni = 0; ni < 2; ++ni)
                acc[mi][ni] = TR ? __builtin_amdgcn_mfma_f32_32x32x16_bf16(bfv[cur][ni], af[cur][mi], acc[mi][ni], 0, 0, 0)
                                 : __builtin_amdgcn_mfma_f32_32x32x16_bf16(af[cur][mi], bfv[cur][ni], acc[mi][ni], 0, 0, 0);
            if (more) {
                UNROLL for (int pc = 0; pc < LPT; ++pc) if (pc * 4 / LPT == ks) {
                    if (!A_LDS && pc < C::NA) GLDS16(pa[pc] + (kt + NS - 1) * 64, db_ + pc * 8192);
                    else { const int ib = pc - (A_LDS ? 0 : C::NA); GLDS16(pb[ib] + (kt + NS - 1) * 64, db_ + C::AB + ib * 8192); }
                }
            }
            __builtin_amdgcn_sched_barrier(0);
        }
        stg = stg + 1 == NS ? 0 : stg + 1; nstg = nstg + 1 == NS ? 0 : nstg + 1;
    }
    __syncthreads();
#undef GT_ISSUE
}
#define ACC_ROW(mi, r, fh) ((mi) * 32 + ((r) & 3) + 8 * ((r) >> 2) + 4 * (fh))

constexpr int EPI_SLAB = 32 * 68 * 4;
template <class F> DEV void epi_rows(const f32x16 (&acc)[2][2], char* smem, F f) {
    const int lane = TID() & 63, wave = TID() >> 6, fr = lane & 31, fh = lane >> 5;
    float* st = (float*)(smem + wave * EPI_SLAB);
    UNROLL for (int mi = 0; mi < 2; ++mi) {
        UNROLL for (int ni = 0; ni < 2; ++ni) UNROLL for (int r = 0; r < 16; ++r)
            st[((r & 3) + 8 * (r >> 2) + 4 * fh) * 68 + ni * 32 + fr] = acc[mi][ni][r];
        UNROLL for (int it = 0; it < 4; ++it) {
            const int row = it * 8 + (lane >> 3), c8 = (lane & 7) * 8;
            const float4 a = *(const float4*)(st + row * 68 + c8), b = *(const float4*)(st + row * 68 + c8 + 4);
            float v[8] = {a.x, a.y, a.z, a.w, b.x, b.y, b.z, b.w};
            f(mi * 32 + row, c8, v);
        }
    }
    __syncthreads();
}


template <class F> DEV void epi_cols(const f32x16 (&acc)[2][2], char* smem, F f) {
    const int lane = TID() & 63, wave = TID() >> 6, fr = lane & 31, fh = lane >> 5;
    float* st = (float*)(smem + wave * EPI_SLAB);
    UNROLL for (int mi = 0; mi < 2; ++mi) {
        UNROLL for (int ni = 0; ni < 2; ++ni) UNROLL for (int r = 0; r < 16; ++r)
            st[((r & 3) + 8 * (r >> 2) + 4 * fh) * 68 + ni * 32 + fr] = acc[mi][ni][r];
        UNROLL for (int it = 0; it < 4; ++it) {
            float v[8];
            UNROLL for (int i = 0; i < 8; ++i) v[i] = st[(it * 8 + i) * 68 + lane];
            f(mi * 32 + it * 8, lane, v);
        }
    }
    __syncthreads();
}

struct TileOrder {
    int x, nN, cx, total;
    DEV TileOrder(const Topo& tp, int nM, int nN_) { x = tp.x; nN = nN_; cx = nM > x ? (nM - x + 7) >> 3 : 0; total = ((cx + 3) >> 2) * 4 * nN; }
    DEV bool get(int q, int& pm, int& pn) const { const int per = 4 * nN, qi = q / per, rem = q - qi * per, i = 4 * qi + (rem & 3); pn = rem >> 2; pm = x + 8 * i; return i < cx; }
};
template <int WM, int WN, class Epi>
DEV void gemm_phase(const bf16_t* A, int lda, int M, const bf16_t* Bt, int ldb, int N, int K, char* smem, const Topo& tp, Epi epi) {
    typedef GC<WM, WN> C;
    const int nM = M / C::BM, nN = (N + C::BN - 1) / C::BN;
    const int wave = TID() >> 6, wm = wave / WN, wn = wave % WN;
    const TileOrder ord(tp, nM, nN);
    for (int q = tp.r; q < ord.total; q += tp.n) {
        int pm, pn; if (!ord.get(q, pm, pn)) continue;
        f32x16 acc[2][2]; acc_zero(acc);
        const bf16_t* Ab = A + (size_t)pm * C::BM * lda;
        gemm_tile<WM, WN, 3, false>(acc, [&](int r) { return Ab + (size_t)r * lda; }, Bt, ldb, pn * C::BN, N, K, smem, nullptr);
        epi(acc, pm * C::BM + wm * 64, pn * C::BN + wn * 64);
    }
}

namespace pg8 {
#define PG8_LAS __attribute__((address_space(3)))
typedef float f32x4 __attribute__((ext_vector_type(4)));
constexpr int BM = 256, BK = 64, HALF = 128, HTB = HALF * BK * 2  , STAGE_BYTES = 8 * HTB, NXCD = 8, WGM = 8;

__host__ __device__ __forceinline__ int lds_byte(int r, int c) { const int st = (r >> 4) * 2 + (c >> 5), rr = r & 15, cc = c & 31, ob = rr * 64 + cc * 2; return st * 1024 + (ob ^ (((ob >> 9) & 1) << 5)); }
__host__ __device__ __forceinline__ void stage_rc(int b, int& R, int& C) { const int st = b / 1024, sb = b % 1024, swz = sb ^ (((sb >> 9) & 1) << 5); R = (st >> 1) * 16 + swz / 64; C = (st & 1) * 32 + (swz % 64) / 2; }
__host__ __device__ __forceinline__ int perm32(int rho) { const int n = rho >> 4, i = rho & 15; return 8 * (i >> 2) + 4 * n + (i & 3); }

struct Unit { int pm, pn; };
struct Gemm { const bf16_t* A; const bf16_t* Bt; int M, N, K; };
template <class Epi, class Sched, bool ALIGN_EPI = false, bool SP2 = false>
__device__ __forceinline__ void gemm_phase(PG8_LAS unsigned char* lds, const Gemm g, const Sched& S, const Epi& E) {
    const int tid = TID(), wid = __builtin_amdgcn_readfirstlane(tid >> 6), lane = tid & 63, wr = wid >> 2, wc = wid & 3, fr = lane & 15, fq = lane >> 4;
    const int K = g.K, nt = K / BK;
    unsigned voffA[2], voffB[2];
#pragma unroll
    for (int i = 0; i < 2; ++i) { int R, C; stage_rc(tid * 16 + i * 8192, R, C); const int Rb = Epi::PERM ? ((R & ~31) + perm32(R & 31)) : R;
        voffA[i] = (unsigned)(R * K + C) * 2u; voffB[i] = (unsigned)(Rb * K + C) * 2u; }
    const size_t kstep = (size_t)(BK * 2);
    const size_t hstep = (size_t)HALF * K * 2;
    const size_t tstep = 2 * hstep;
    const unsigned ldsw = (unsigned)wid * 1024u;
    const int aoff = lds_byte(wr * 64 + fr, fq * 8), boff = lds_byte(wc * 32 + fr, fq * 8);
#define PG8_SA(b, h) (((b) * 2 + (h)) * HTB)
#define PG8_SB(b, h) ((4 + (b) * 2 + (h)) * HTB)
#define PG8_STAGE(bufoff, gbase, voff) do { _Pragma("unroll") for (int _i = 0; _i < 2; ++_i) \
        __builtin_amdgcn_global_load_lds((const unsigned*)((const char*)(gbase) + (voff)[_i]), (PG8_LAS unsigned*)(lds + (bufoff) + ldsw + _i * 8192), 16, 0, 0); } while (0)
#define PG8_LDA(dst, b, h) do { _Pragma("unroll") for (int m = 0; m < 4; ++m) _Pragma("unroll") for (int k = 0; k < 2; ++k) dst[m][k] = *(const PG8_LAS bf16x8*)(lds + PG8_SA(b, h) + aoff + m * 2048 + k * 1024); } while (0)
#define PG8_LDB(dst, b, h) do { _Pragma("unroll") for (int n = 0; n < 2; ++n) _Pragma("unroll") for (int k = 0; k < 2; ++k) dst[n][k] = *(const PG8_LAS bf16x8*)(lds + PG8_SB(b, h) + boff + n * 2048 + k * 1024); } while (0)
#define PG8_MMA(ai, bj, At, Bt) do { __builtin_amdgcn_s_setprio(1); _Pragma("unroll") for (int m = 0; m < 4; ++m) _Pragma("unroll") for (int n = 0; n < 2; ++n) _Pragma("unroll") for (int k = 0; k < 2; ++k) \
        acc[ai][bj][m][n] = __builtin_amdgcn_mfma_f32_16x16x32_bf16(Bt[n][k], At[m][k], acc[ai][bj][m][n], 0, 0, 0); __builtin_amdgcn_s_setprio(0); } while (0)
#define PG8_WAIT_V(n) asm volatile("s_waitcnt vmcnt(" #n ")" ::: "memory")
#define PG8_WAIT_L(n) asm volatile("s_waitcnt lgkmcnt(" #n ")" ::: "memory")
#define PG8_BAR __builtin_amdgcn_s_barrier()
#define PG8_SCHED __builtin_amdgcn_sched_barrier(0)
    Unit cur, nxt; int ui = 0;
    if (!S.next(0, cur)) return;
    f32x4 acc[2][2][4][2];
#pragma unroll
    for (int a = 0; a < 2; ++a)
#pragma unroll
        for (int b = 0; b < 2; ++b)
#pragma unroll
            for (int m = 0; m < 4; ++m)
#pragma unroll
                for (int n = 0; n < 2; ++n) acc[a][b][m][n] = (f32x4){0.f, 0.f, 0.f, 0.f};
    bf16x8 At[4][2], B0[2][2], B1[2][2];
    const char* cA = (const char*)g.A + (size_t)cur.pm * tstep; const char* cB = (const char*)g.Bt + (size_t)cur.pn * tstep;
    S.a_ready(cur);
    if constexpr (SP2) {
        PG8_STAGE(PG8_SB(0, 0), cB, voffB); PG8_STAGE(PG8_SB(0, 1), cB + hstep, voffB); PG8_STAGE(PG8_SA(0, 0), cA, voffA); PG8_STAGE(PG8_SA(0, 1), cA + hstep, voffA);
        if (wr == 1) PG8_BAR;
        PG8_WAIT_V(2); PG8_BAR;
        PG8_STAGE(PG8_SB(1, 0), cB + kstep, voffB); PG8_STAGE(PG8_SA(1, 0), cA + kstep, voffA); PG8_STAGE(PG8_SB(1, 1), cB + hstep + kstep, voffB);
        PG8_WAIT_V(6); PG8_BAR;
    } else {
        PG8_STAGE(PG8_SB(0, 0), cB, voffB); PG8_STAGE(PG8_SA(0, 0), cA, voffA); PG8_STAGE(PG8_SB(0, 1), cB + hstep, voffB); PG8_STAGE(PG8_SA(0, 1), cA + hstep, voffA);
        if (wr == 1) PG8_BAR;
        PG8_WAIT_V(4); PG8_BAR;
        PG8_STAGE(PG8_SB(1, 0), cB + kstep, voffB); PG8_STAGE(PG8_SA(1, 0), cA + kstep, voffA); PG8_STAGE(PG8_SB(1, 1), cB + hstep + kstep, voffB);
        PG8_WAIT_V(6); PG8_BAR;
    }
    for (;;) {
        const bool has_next = S.next(ui + 1, nxt);
        const char* nA = has_next ? (const char*)g.A + (size_t)nxt.pm * tstep : cA; const char* nB = has_next ? (const char*)g.Bt + (size_t)nxt.pn * tstep : cB;
        for (int t = 0; t < nt; t += 2) {
            const bool last = (t == nt - 2);
            const char* a1 = cA + (size_t)(t + 1) * kstep;
            const char* a2 = last ? nA : cA + (size_t)(t + 2) * kstep; const char* b2 = last ? nB : cB + (size_t)(t + 2) * kstep;
            const char* a3 = a2 + kstep; const char* b3 = b2 + kstep;
            if (last && has_next) S.a_ready(nxt);
            if constexpr (SP2) {
            PG8_LDB(B0, 0, 0); PG8_LDB(B1, 0, 1); PG8_SCHED; PG8_LDA(At, 0, 0); PG8_STAGE(PG8_SA(1, 1), a1 + hstep, voffA);
            PG8_WAIT_V(8); PG8_WAIT_L(0); PG8_BAR; PG8_MMA(0, 0, At, B0); PG8_MMA(0, 1, At, B1); PG8_BAR; PG8_SCHED;
            PG8_LDA(At, 0, 1); PG8_STAGE(PG8_SB(0, 0), b2, voffB); PG8_STAGE(PG8_SB(0, 1), b2 + hstep, voffB); PG8_STAGE(PG8_SA(0, 0), a2, voffA);
            PG8_WAIT_V(8); PG8_WAIT_L(0); PG8_BAR; PG8_MMA(1, 0, At, B0); PG8_MMA(1, 1, At, B1); PG8_BAR; PG8_SCHED;
            PG8_LDB(B0, 1, 0); PG8_LDB(B1, 1, 1); PG8_SCHED; PG8_LDA(At, 1, 0); PG8_STAGE(PG8_SA(0, 1), a2 + hstep, voffA);
            PG8_WAIT_V(8); PG8_WAIT_L(0); PG8_BAR; PG8_MMA(0, 0, At, B0); PG8_MMA(0, 1, At, B1); PG8_BAR; PG8_SCHED;
            PG8_LDA(At, 1, 1); PG8_STAGE(PG8_SB(1, 0), b3, voffB); PG8_STAGE(PG8_SB(1, 1), b3 + hstep, voffB); PG8_STAGE(PG8_SA(1, 0), a3, voffA);
            PG8_WAIT_V(8); PG8_WAIT_L(0); PG8_BAR; PG8_MMA(1, 0, At, B0); PG8_MMA(1, 1, At, B1); PG8_BAR; PG8_SCHED;
            } else {
            PG8_LDB(B0, 0, 0); PG8_SCHED; PG8_LDA(At, 0, 0); PG8_STAGE(PG8_SA(1, 1), a1 + hstep, voffA);
            PG8_WAIT_L(8); PG8_BAR; PG8_WAIT_L(0); PG8_MMA(0, 0, At, B0); PG8_BAR; PG8_SCHED;
            PG8_LDB(B1, 0, 1); PG8_STAGE(PG8_SB(0, 0), b2, voffB);
            PG8_BAR; PG8_WAIT_L(0); PG8_MMA(0, 1, At, B1); PG8_BAR;
            PG8_LDA(At, 0, 1); PG8_STAGE(PG8_SA(0, 0), a2, voffA);
            PG8_BAR; PG8_WAIT_L(0); PG8_MMA(1, 0, At, B0); PG8_BAR; PG8_SCHED;
            PG8_STAGE(PG8_SB(0, 1), b2 + hstep, voffB);
            PG8_WAIT_V(6); PG8_BAR; PG8_MMA(1, 1, At, B1); PG8_BAR;
            PG8_LDB(B0, 1, 0); PG8_SCHED; PG8_LDA(At, 1, 0); PG8_STAGE(PG8_SA(0, 1), a2 + hstep, voffA);
            PG8_WAIT_L(8); PG8_BAR; PG8_WAIT_L(0); PG8_MMA(0, 0, At, B0); PG8_BAR; PG8_SCHED;
            PG8_LDB(B1, 1, 1); PG8_STAGE(PG8_SB(1, 0), b3, voffB);
            PG8_BAR; PG8_WAIT_L(0); PG8_MMA(0, 1, At, B1); PG8_BAR;
            PG8_LDA(At, 1, 1); PG8_STAGE(PG8_SA(1, 0), a3, voffA);
            PG8_BAR; PG8_WAIT_L(0); PG8_MMA(1, 0, At, B0); PG8_BAR; PG8_SCHED;
            PG8_STAGE(PG8_SB(1, 1), b3 + hstep, voffB);
            PG8_WAIT_V(6); PG8_BAR; PG8_MMA(1, 1, At, B1); PG8_BAR;
            }
        }
        if constexpr (ALIGN_EPI) { if (wr == 0) PG8_BAR; }
        if constexpr (!Epi::AFTER_DRAIN) { E(acc, cur, wr, wc, fr, fq); S.done(cur); }
        if (!has_next) break;
#pragma unroll
        for (int a = 0; a < 2; ++a)
#pragma unroll
            for (int b = 0; b < 2; ++b)
#pragma unroll
                for (int m = 0; m < 4; ++m)
#pragma unroll
                    for (int n = 0; n < 2; ++n) acc[a][b][m][n] = (f32x4){0.f, 0.f, 0.f, 0.f};
        cur = nxt; cA = nA; cB = nB; ++ui;
        if constexpr (ALIGN_EPI) { if (wr == 1) PG8_BAR; }
    }
    PG8_WAIT_V(0);
    if constexpr (!ALIGN_EPI) { if (wr == 0) PG8_BAR; }
    PG8_BAR;
    if constexpr (Epi::AFTER_DRAIN) { E.fused(acc, cur, wr, wc, fr, fq, lds, wid, lane); S.done(cur); }
#undef PG8_SA
#undef PG8_SB
#undef PG8_STAGE
#undef PG8_LDA
#undef PG8_LDB
#undef PG8_MMA
#undef PG8_WAIT_V
#undef PG8_WAIT_L
#undef PG8_BAR
#undef PG8_SCHED
}
}
template <class F> struct EpiF {
    static constexpr bool PERM = true, AFTER_DRAIN = false; F f;
    DEV void operator()(const pg8::f32x4 (&acc)[2][2][4][2], const pg8::Unit& u, int wr, int wc, int fr, int fq) const {
        UNROLL for (int ai = 0; ai < 2; ++ai) UNROLL for (int m = 0; m < 4; ++m) {
            const int row = u.pm * 256 + ai * 128 + wr * 64 + m * 16 + fr;
            UNROLL for (int bj = 0; bj < 2; ++bj) {
                const int col = u.pn * 256 + bj * 128 + wc * 32 + 8 * fq;
                const float v[8] = {acc[ai][bj][m][0][0], acc[ai][bj][m][0][1], acc[ai][bj][m][0][2], acc[ai][bj][m][0][3],
                                    acc[ai][bj][m][1][0], acc[ai][bj][m][1][1], acc[ai][bj][m][1][2], acc[ai][bj][m][1][3]};
                f(row, col, v);
            }
        }
    }
};
template <class F> struct EpiF2 {
    static constexpr bool PERM = true, AFTER_DRAIN = false; F f;
    DEV void operator()(const pg8::f32x4 (&acc)[2][2][4][2], const pg8::Unit& u, int wr, int wc, int fr, int fq) const {
        UNROLL for (int ai = 0; ai < 2; ++ai) UNROLL for (int m = 0; m < 4; ++m) {
            const int row = u.pm * 256 + ai * 128 + wr * 64 + m * 16 + fr, col = u.pn * 256 + wc * 32 + 8 * fq;
            const float v0[8] = {acc[ai][0][m][0][0], acc[ai][0][m][0][1], acc[ai][0][m][0][2], acc[ai][0][m][0][3], acc[ai][0][m][1][0], acc[ai][0][m][1][1], acc[ai][0][m][1][2], acc[ai][0][m][1][3]};
            const float v1[8] = {acc[ai][1][m][0][0], acc[ai][1][m][0][1], acc[ai][1][m][0][2], acc[ai][1][m][0][3], acc[ai][1][m][1][0], acc[ai][1][m][1][1], acc[ai][1][m][1][2], acc[ai][1][m][1][3]};
            f(row, col, v0, v1);
        }
    }
};
struct XOrder {
    int x, r, n, nN, cx, fullq, total;
    DEV XOrder(const Topo& tp, int nM, int nN_) { x = tp.x; r = tp.r; n = tp.n; nN = nN_; cx = nM > x ? (nM - x + 7) >> 3 : 0; fullq = cx >> 2; total = cx * nN; }
    DEV bool next(int i, pg8::Unit& u) const {
        const int q = r + i * n; if (q >= total) return false;
        const int per = 4 * nN;
        if (q < fullq * per) { const int qi = q / per, rem = q - qi * per; u.pn = rem >> 2; u.pm = x + 8 * (4 * qi + (rem & 3)); }
        else { const int rem = q - fullq * per, cq = cx - 4 * fullq; u.pn = rem / cq; u.pm = x + 8 * (4 * fullq + rem % cq); }
        return true;
    }
    DEV void a_ready(const pg8::Unit&) const {}
    DEV void done(const pg8::Unit&) const {}
};
template <class F> DEV void gemm256_pair(const bf16_t* A, int M, const bf16_t* Bt, int N, int K, char* smem, const Topo& tp, F f) {
    const pg8::Gemm g{A, Bt, M, N, K};
    const XOrder S(tp, M / 256, (N + 255) / 256);
    const EpiF2<F> E{f};
    pg8::gemm_phase<EpiF2<F>, XOrder, true, true>((PG8_LAS unsigned char*)smem, g, S, E);
}
template <class F> DEV void gemm256(const bf16_t* A, int M, const bf16_t* Bt, int N, int K, char* smem, const Topo& tp, F f) {
    const pg8::Gemm g{A, Bt, M, N, K};
    const XOrder S(tp, M / 256, (N + 255) / 256);
    const EpiF<F> E{f};
    pg8::gemm_phase<EpiF<F>, XOrder, true, true>((PG8_LAS unsigned char*)smem, g, S, E);
}

DEV void ph_mod(const Params& p, int L, char* smem) {
    const int tid = TID();
    float* sc = (float*)smem;
    float* red = sc + 17 * 1024;
    const float* c = p.in[I_C]; const float* cc = p.in[I_CCTX];
    for (int i = tid; i < 17 * 1024; i += NTHREADS) { const float v = i < 16 * 1024 ? c[i] : cc[i - 16 * 1024]; sc[i] = v / (1.f + expf(-v)); }
    __syncthreads();
    const float* W = p.in[I_WADA] + (size_t)L * 1024 * 6144; const float* bA = p.in[I_BADA] + (size_t)L * 6144;
    float* MOD = (float*)(p.ws + OFF_MOD);
    for (int u = blockIdx.x; u < 192; u += gridDim.x) {
        const int ci = tid & 31, ks = tid >> 5, j = u * 32 + ci;
        float acc[17];
        UNROLL for (int r = 0; r < 17; ++r) acc[r] = 0.f;
        for (int k = ks * 64; k < ks * 64 + 64; ++k) {
            const float w = W[(size_t)k * 6144 + j];
            UNROLL for (int r = 0; r < 17; ++r) acc[r] += sc[r * 1024 + k] * w;
        }
        UNROLL for (int r = 0; r < 17; ++r) red[(ks * 17 + r) * 32 + ci] = acc[r];
        __syncthreads();
        for (int i = tid; i < 17 * 32; i += NTHREADS) {
            const int r = i >> 5, c2 = i & 31; float s = bA[u * 32 + c2];
            for (int k2 = 0; k2 < 16; ++k2) s += red[(k2 * 17 + r) * 32 + c2];
            MOD[r * 6144 + u * 32 + c2] = s;
        }
        __syncthreads();
    }
}
DEV void conv_job(const float* s0, const float* s1, bf16_t* d, int K, int N, int mode, int nmat, size_t sstride, size_t dstride, char* smem, int bid = -1, int nb = 0) {
    if (bid < 0) { bid = blockIdx.x; nb = gridDim.x; }
    float* tile = (float*)smem;
    const int tid = TID();
    const int tK = K / 64, tN = (mode == 1 || mode == 3) ? (2 * N) / 64 : (N + 63) / 64, per = tK * tN;
    for (int t = bid; t < per * nmat; t += nb) {
        const int mat = t / per, r = t % per, tk = r / tN, tn = r % tN;
        const float* a0 = s0 + (size_t)mat * sstride; const float* a1 = s1 ? s1 + (size_t)mat * sstride : nullptr;
        bf16_t* dd = d + (size_t)mat * dstride;
        UNROLL for (int i = 0; i < 8; ++i) {
            const int cc = tid & 63, k = (tid >> 6) + 8 * i; float v;
            if (mode == 1) { const float* s = (cc >> 5) ? a1 : a0; v = s[(size_t)(tk * 64 + k) * N + tn * 32 + (cc & 31)]; }
            else if (mode == 3) { const float* s = ((tn >> 1) & 1) ? a1 : a0; v = s[(size_t)(tk * 64 + k) * N + (tn >> 2) * 128 + (tn & 1) * 64 + cc]; }
            else { const int n = tn * 64 + cc; v = n < N ? a0[(size_t)(tk * 64 + k) * N + n] : 0.f; }
            tile[k * 65 + cc] = v;
        }
        __syncthreads();
        UNROLL for (int i = 0; i < 8; ++i) {
            const int k = tid & 63, cc = (tid >> 6) + 8 * i; const int row = tn * 64 + cc;
            const float v = tile[k * 65 + cc];
            if (mode == 1 || mode == 3 || row < N) {
                const bf16_t hi = f2bf(v);
                dd[(size_t)row * K + tk * 64 + k] = hi;
                if (mode == 2) dd[(size_t)N * K + (size_t)row * K + tk * 64 + k] = f2bf(v - bf2f(hi));
            }
        }
        __syncthreads();
    }
}
DEV void ph_conv_mix(const Params& p, int L, char* smem) {
    char* ws = p.ws;
    conv_job(p.in[I_WIN] + (size_t)L * 1024 * IN_COLS, nullptr, (bf16_t*)(ws + OFF_WINT), 1024, IN_COLS, 0, 1, 0, 0, smem);
    conv_job(p.in[I_WBR] + (size_t)L * 3 * 512 * 1024, nullptr, (bf16_t*)(ws + OFF_WBT), 512, 1024, 0, 3, (size_t)512 * 1024, (size_t)512 * 1024, smem);
    conv_job(p.in[I_WOUT] + (size_t)L * 1024 * 1024, nullptr, (bf16_t*)(ws + OFF_WOUTT), 1024, 1024, 0, 1, 0, 0, smem);
    conv_job(p.in[I_SG] + (size_t)L * 1024 * 256, p.in[I_SU] + (size_t)L * 1024 * 256, (bf16_t*)(ws + OFF_SGUT), 1024, 256, 3, 1, 0, 0, smem);
    conv_job(p.in[I_SD] + (size_t)L * 256 * 1024, nullptr, (bf16_t*)(ws + OFF_SDT), 256, 1024, 0, 1, 0, 0, smem);
    conv_job(p.in[I_G2] + (size_t)L * 128 * 512, nullptr, (bf16_t*)(ws + OFF_G2T), 128, 512, 0, 1, 0, 0, smem);
    conv_job(p.in[I_RTR] + (size_t)L * 1024 * 64, nullptr, (bf16_t*)(ws + OFF_RTR), 1024, 64, 2, 1, 0, 0, smem);
}
DEV void ph_conv_moe_gu(const Params& p, int L, char* smem, int bid, int nb) {
    const size_t eo = (size_t)L * 64 * 1024 * 128;
    conv_job(p.in[I_MWG] + eo, p.in[I_MWU] + eo, (bf16_t*)(p.ws + OFF_MGU), 1024, 128, 1, 64, (size_t)1024 * 128, (size_t)256 * 1024, smem, bid, nb);
}
DEV void ph_conv_moe(const Params& p, int L, char* smem, int bid, int nb) {
    const size_t eo = (size_t)L * 64 * 1024 * 128;
    conv_job(p.in[I_MWD] + eo, nullptr, (bf16_t*)(p.ws + OFF_MDT), 128, 1024, 0, 64, (size_t)128 * 1024, (size_t)1024 * 128, smem, bid, nb);
}

DEV void ph_norm(const Params& p, int L, int which, int ntok) {
    const int lane = TID() & 63, wave = TID() >> 6;
    const float* MOD = (const float*)(p.ws + OFF_MOD);
    const float* g = p.in[which ? I_N2G : I_N1G] + (size_t)L * DM;
    bf16_t* H = (bf16_t*)(p.ws + OFF_HX); bf16_t* HLO = (bf16_t*)(p.ws + OFF_H2LO);
    for (int n0 = blockIdx.x * 8; n0 < ntok; n0 += gridDim.x * 8) {
        const int n = n0 + wave;
        const float* xr = which ? xs_row(p, n) : xprev_row(p, L, n);
        float4 v[4]; float ss = 0.f;
        UNROLL for (int i = 0; i < 4; ++i) { v[i] = *(const float4*)(xr + i * 256 + lane * 4); ss += v[i].x * v[i].x + v[i].y * v[i].y + v[i].z * v[i].z + v[i].w * v[i].w; }
        UNROLL for (int o = 1; o < 64; o <<= 1) ss += __shfl_xor(ss, o);
        const float rstd = rsqrtf(ss * (1.f / DM) + 1e-6f);
        const float* sh = MOD + mod_row(n) * 6144 + (which ? 3 : 0) * DM; const float* sc = sh + DM;
        UNROLL for (int i = 0; i < 4; ++i) {
            const int c = i * 256 + lane * 4;
            const float4 gg = *(const float4*)(g + c), s1 = *(const float4*)(sc + c), s0 = *(const float4*)(sh + c);
            const float h0 = v[i].x * rstd * gg.x * (1.f + s1.x) + s0.x, h1 = v[i].y * rstd * gg.y * (1.f + s1.y) + s0.y;
            const float h2 = v[i].z * rstd * gg.z * (1.f + s1.z) + s0.z, h3 = v[i].w * rstd * gg.w * (1.f + s1.w) + s0.w;
            u32x2 o; o.x = pk2(h0, h1); o.y = pk2(h2, h3);
            *(u32x2*)(H + (size_t)n * DM + c) = o;
            if (which) {
                u32x2 o2;
                o2.x = pk2(h0 - bf2f((bf16_t)(o.x & 0xffff)), h1 - bf2f((bf16_t)(o.x >> 16)));
                o2.y = pk2(h2 - bf2f((bf16_t)(o.y & 0xffff)), h3 - bf2f((bf16_t)(o.y >> 16)));
                *(u32x2*)(HLO + (size_t)n * DM + c) = o2;
            }
        }
    }
}

DEV void ph_rw_prep(const Params& p, int L, char* smem) {
    const int lane = TID() & 63, wave = TID() >> 6;
    float* vsh = (float*)smem + wave * 512;
    const bf16_t* PXR = (const bf16_t*)(p.ws + OFF_PX); bf16_t* VF = (bf16_t*)(p.ws + OFF_VF);
    const float* mu = p.in[I_MU] + (size_t)L * RW_COLS;
    const float* v0 = p.in[I_V0]; const float* v1 = p.in[I_V1]; const float* v2 = p.in[I_V2];
    for (int n0 = blockIdx.x * 8; n0 < NT; n0 += gridDim.x * 8) {
        const int n = n0 + wave; int nb, tt, T; seq_of(n, nb, tt, T);
        float vs[8]; shift8(PXR, RW_COLS, nb, tt, T, 1024 + lane * 8, mu, vs);
        if (L == 0) { st8(VF + (size_t)n * 512 + lane * 8, vs); }
        else {
            UNROLL for (int i = 0; i < 8; ++i) vsh[lane * 8 + i] = vs[i];
            __syncthreads();
            const int q = lane & 31, hf = lane >> 5; float t1 = 0.f;
            for (int jj = 0; jj < 256; ++jj) t1 += vsh[hf * 256 + jj] * v1[(hf * 256 + jj) * 32 + q];
            t1 += __shfl_xor(t1, 32);
            float u[8];
            UNROLL for (int i = 0; i < 8; ++i) u[i] = v0[lane * 8 + i];
            for (int q2 = 0; q2 < 32; ++q2) { const float tq = __shfl(t1, q2); UNROLL for (int i = 0; i < 8; ++i) u[i] += tq * v2[q2 * 512 + lane * 8 + i]; }
            float vf[8], o[8]; ld8(VF + (size_t)n * 512 + lane * 8, vf);
            UNROLL for (int i = 0; i < 8; ++i) o[i] = vs[i] + (vf[i] - vs[i]) * sigm(u[i]);
            st8(VF + (size_t)n * 512 + lane * 8, o);
            __syncthreads();
        }
    }
}

DEV bf16x8 pk_lohi(u32x2 lo, u32x2 hi) { u32x4 w; w.x = lo.x; w.y = lo.y; w.z = hi.x; w.w = hi.y; return __builtin_bit_cast(bf16x8, w); }
DEV bf16x8 pk_acc2(const f32x4v& a, const f32x4v& b) { u32x4 w; w.x = pk2(a[0], a[1]); w.y = pk2(a[2], a[3]); w.z = pk2(b[0], b[1]); w.w = pk2(b[2], b[3]); return __builtin_bit_cast(bf16x8, w); }
DEV bf16x8 pk_acc1(const f32x4v& a) { u32x4 w; w.x = pk2(a[0], a[1]); w.y = pk2(a[2], a[3]); w.z = 0u; w.w = 0u; return __builtin_bit_cast(bf16x8, w); }
#define MFMA16(a, b, c) __builtin_amdgcn_mfma_f32_16x16x32_bf16((a), (b), (c), 0, 0, 0)
struct Raw3 { u32x4 l, c, r; };
DEV Raw3 rw_raw(const bf16_t* z, int ld, int nb, int tt, int T, int col0) {
    Raw3 o;
    o.c = *(const u32x4*)(z + (size_t)(nb + tt) * ld + col0);
    o.l = *(const u32x4*)(z + (size_t)(nb + max(tt - 1, 0)) * ld + col0);
    o.r = *(const u32x4*)(z + (size_t)(nb + min(tt + 1, T - 1)) * ld + col0);
    return o;
}
DEV void unpack8(u32x4 v, float (&o)[8]) {
    o[0] = __uint_as_float(v.x << 16); o[1] = __uint_as_float(v.x & 0xffff0000u); o[2] = __uint_as_float(v.y << 16); o[3] = __uint_as_float(v.y & 0xffff0000u);
    o[4] = __uint_as_float(v.z << 16); o[5] = __uint_as_float(v.z & 0xffff0000u); o[6] = __uint_as_float(v.w << 16); o[7] = __uint_as_float(v.w & 0xffff0000u);
}
DEV void shift_from_raw(const Raw3& w, int tt, int T, const float* mu8, float (&o)[8]) {
    float c[8], l[8], r[8]; unpack8(w.c, c); unpack8(w.l, l); unpack8(w.r, r);
    const float ml = tt > 0 ? 0.5f : 0.f, mr = tt < T - 1 ? 0.5f : 0.f;
    UNROLL for (int i = 0; i < 8; ++i) o[i] = c[i] + mu8[i] * (ml * l[i] + mr * r[i] - c[i]);
}
DEV void ph_rw_scan(const Params& p, int L, char* smem) {
    const int tid = TID();
    const int wave = __builtin_amdgcn_readfirstlane(tid >> 6);
    char* AT = smem; char* BT = smem + 9216; char* KT = smem + 18432; char* RT = smem + 27648;
    char* BH = smem + 36864; char* KH = smem + 46080; char* VT = smem + 55296;
    char* W2T = smem + 64512; char* A2T = smem + 73728;
    float* PCv = (float*)(smem + 82944); float* SEGT = PCv + 64;
    char* XY = smem + 85248;
    char* T1 = XY; char* T2 = XY + 9216; float* WLf = (float*)(XY + 18432); float* ALf = (float*)(XY + 35840); float* LW = (float*)XY;
    float* TOT = (float*)(XY + 62720);
    float* PAR = (float*)(XY + 60416);
    char* NAB = XY; char* NAK = XY + 9216; char* NRB = XY + 18432; char* NRK = XY + 27648; char* TJ = XY + 36864; float* NDF = (float*)(XY + 38912); float* YO = (float*)(XY + 43008);
    const bf16_t* PXR = (const bf16_t*)(p.ws + OFF_PX); const bf16_t* VF = (const bf16_t*)(p.ws + OFF_VF);
    bf16_t* YS = (bf16_t*)(p.ws + OFF_YS); float* CB = (float*)(p.ws + OFF_CB);
    const float* mu = p.in[I_MU] + (size_t)L * RW_COLS;
    const float* w0 = p.in[I_W0] + (size_t)L * 1024; const float* w2 = p.in[I_W2] + (size_t)L * 65536;
    const float* a0 = p.in[I_A0] + (size_t)L * 1024; const float* a2 = p.in[I_A2] + (size_t)L * 65536;
    const float* kkw = p.in[I_KK] + (size_t)L * 512; const float* kaw = p.in[I_KA] + (size_t)L * 512; const float* rkw = p.in[I_RK] + (size_t)L * 512;
    for (int u = blockIdx.x; u < 256; u += gridDim.x) {
        const int b = u >> 4, h = (u >> 1) & 7, d = u & 1;
        for (int i = tid; i < 4096; i += NTHREADS) {
            const int l = i >> 6, n = i & 63;
            *(bf16_t*)(W2T + n * LROW + l * 2) = f2bf(w2[(size_t)(d * 64 + l) * 512 + h * 64 + n]);
            *(bf16_t*)(A2T + n * LROW + l * 2) = f2bf(a2[(size_t)(d * 64 + l) * 512 + h * 64 + n]);
        }
        if (tid < 64) {
            const int n = tid;
            PAR[n] = w0[d * 512 + h * 64 + n]; PAR[64 + n] = a0[d * 512 + h * 64 + n];
            PAR[128 + n] = kkw[h * 64 + n]; PAR[192 + n] = kaw[h * 64 + n]; PAR[256 + n] = rkw[h * 64 + n];
            PAR[320 + n] = mu[1536 + d * 64 + n]; PAR[384 + n] = mu[1664 + d * 64 + n]; PAR[448 + n] = mu[h * 64 + n]; PAR[512 + n] = mu[512 + h * 64 + n];
        }
        f32x4v sacc[4];
        UNROLL for (int i = 0; i < 4; ++i) sacc[i] = (f32x4v){0.f, 0.f, 0.f, 0.f};
        __syncthreads();
        Raw3 pw1, pw2, pr, pk; u32x4 pv;
#define RW_GEOM(ci_, tido_) const bool isc = (ci_) < 4; const int T = isc ? CTXL : SEQ, cc = isc ? (ci_) : (ci_) - 4; \
            const int t0 = d == 0 ? cc * 64 : T - 64 * (cc + 1), nb = isc ? NX + b * CTXL : b * SEQ; \
            const int tt = d == 0 ? t0 + ((tido_) >> 3) : t0 + 63 - ((tido_) >> 3);
#define RW_PREFETCH(ci_, tido_) do { RW_GEOM(ci_, tido_) const int j_ = (tido_) & 7; \
            pw1 = rw_raw(PXR, RW_COLS, nb, tt, T, 1536 + d * 64 + 8 * j_); pw2 = rw_raw(PXR, RW_COLS, nb, tt, T, 1664 + d * 64 + 8 * j_); \
            pr = rw_raw(PXR, RW_COLS, nb, tt, T, h * 64 + 8 * j_); pk = rw_raw(PXR, RW_COLS, nb, tt, T, 512 + h * 64 + 8 * j_); \
            pv = *(const u32x4*)(VF + (size_t)(nb + tt) * 512 + h * 64 + 8 * j_); } while (0)
        RW_PREFETCH(0, tid);
        for (int ci = 0; ci < 36; ++ci) {
            int tido = tid; asm volatile("" : "+v"(tido));
            const int lane = tido & 63, lq = lane & 15, kg = lane >> 4, ti = tido >> 3, j = tido & 7;
            const int ch = h * 64 + 8 * j;
            RW_GEOM(ci, tido)
            float r8[8], k8[8], v8[8];
            {
                float x1[8], x2[8];
                shift_from_raw(pw1, tt, T, PAR + 320 + 8 * j, x1);
                shift_from_raw(pw2, tt, T, PAR + 384 + 8 * j, x2);
                UNROLL for (int i = 0; i < 8; ++i) x1[i] = tanh_fast(x1[i]);
                st8((bf16_t*)(T1 + ti * LROW) + 8 * j, x1); st8((bf16_t*)(T2 + ti * LROW) + 8 * j, x2);
                shift_from_raw(pr, tt, T, PAR + 448 + 8 * j, r8);
                shift_from_raw(pk, tt, T, PAR + 512 + 8 * j, k8);
                unpack8(pv, v8);
            }
            __syncthreads();
            _Pragma("unroll 1") for (int rep = 0; rep < 4; ++rep) {
                const int q = wave + 8 * rep, m = q >> 4, tl = q & 15, tt4 = tl >> 2, nt4 = tl & 3;
                const char* Ab = (m ? T2 : T1) + (16 * tt4 + lq) * LROW + kg * 16; const char* Bb = (m ? A2T : W2T) + (16 * nt4 + lq) * LROW + kg * 16;
                f32x4v a = {0.f, 0.f, 0.f, 0.f};
                UNROLL for (int ks = 0; ks < 2; ++ks) a = MFMA16(*(const bf16x8*)(Ab + ks * 64), *(const bf16x8*)(Bb + ks * 64), a);
                float* dst = (m ? ALf : WLf) + (16 * tt4 + 4 * kg) * 68 + 16 * nt4 + lq;
                UNROLL for (int i = 0; i < 4; ++i) dst[i * 68] = a[i];
            }
            __syncthreads();
            float av[8], bv[8], kd8[8];
            {
                const float4 wa = *(const float4*)(WLf + ti * 68 + 8 * j), wb = *(const float4*)(WLf + ti * 68 + 8 * j + 4);
                const float4 aa = *(const float4*)(ALf + ti * 68 + 8 * j), ab = *(const float4*)(ALf + ti * 68 + 8 * j + 4);
                const float wl[8] = {wa.x, wa.y, wa.z, wa.w, wb.x, wb.y, wb.z, wb.w}, al[8] = {aa.x, aa.y, aa.z, aa.w, ab.x, ab.y, ab.z, ab.w};
                float ss = 0.f, cbp = 0.f, alpha[8], kkr[8], lw[8];
                UNROLL for (int i = 0; i < 8; ++i) {
                    const float xw = -(PAR[8 * j + i] + wl[i]);
                    const float sp = softplus_fast(xw);
                    lw[i] = -__expf(-sp - 0.5f);
                    alpha[i] = sigm(PAR[64 + 8 * j + i] + al[i]);
                    kkr[i] = k8[i] * PAR[128 + 8 * j + i]; ss += kkr[i] * kkr[i];
                    kd8[i] = k8[i] * (1.f + (alpha[i] - 1.f) * PAR[192 + 8 * j + i]);
                    cbp += r8[i] * kd8[i] * PAR[256 + 8 * j + i];
                }
                ss = sum8(ss); cbp = sum8(cbp);
                const float inv = frcp(fmaxf(__builtin_amdgcn_sqrtf(ss), 1e-12f));
                UNROLL for (int i = 0; i < 8; ++i) { const float kk = kkr[i] * inv; av[i] = -kk; bv[i] = kk * alpha[i]; }
                *(float4*)(LW + ti * 64 + 8 * j) = make_float4(lw[0], lw[1], lw[2], lw[3]); *(float4*)(LW + ti * 64 + 8 * j + 4) = make_float4(lw[4], lw[5], lw[6], lw[7]);
                if (j == 0) CB[((size_t)d * NT + nb + tt) * 8 + h] = cbp;
            }
            __syncthreads();
            {
                const int n = tid & 63, seg = wave; float run[8], acc = 0.f;
                UNROLL for (int r = 0; r < 8; ++r) { acc += LW[(seg * 8 + r) * 64 + n]; run[r] = acc; }
                SEGT[seg * 64 + n] = acc;
                __syncthreads();
                float off = 0.f, tot = 0.f;
                UNROLL for (int s2 = 0; s2 < 8; ++s2) { const float sv = SEGT[s2 * 64 + n]; tot += sv; off += s2 < seg ? sv : 0.f; }
                UNROLL for (int r = 0; r < 8; ++r) LW[(seg * 8 + r) * 64 + n] = run[r] + off;
                if (seg == 0) { TOT[n] = tot; PCv[n] = __expf(tot); }
            }
            __syncthreads();
            {
                const float4 ta = *(const float4*)(TOT + 8 * j), tb = *(const float4*)(TOT + 8 * j + 4);
                const float tot[8] = {ta.x, ta.y, ta.z, ta.w, tb.x, tb.y, tb.z, tb.w};
                const float4 la = *(const float4*)(LW + ti * 64 + 8 * j), lb = *(const float4*)(LW + ti * 64 + 8 * j + 4);
                const float lpl[8] = {la.x, la.y, la.z, la.w, lb.x, lb.y, lb.z, lb.w};
                float lpm[8];
                if (ti != 0) {
                    const float4 ma = *(const float4*)(LW + (ti - 1) * 64 + 8 * j), mb = *(const float4*)(LW + (ti - 1) * 64 + 8 * j + 4);
                    lpm[0] = ma.x; lpm[1] = ma.y; lpm[2] = ma.z; lpm[3] = ma.w; lpm[4] = mb.x; lpm[5] = mb.y; lpm[6] = mb.z; lpm[7] = mb.w;
                } else { UNROLL for (int i = 0; i < 8; ++i) lpm[i] = 0.f; }
                float oa[8], ob[8], ok[8], orr[8];
                const int wofs = (((ti >> 3) ^ j) << 4) + (ti & 7) * 2;
                UNROLL for (int i = 0; i < 8; ++i) {
                    const float lp = lpl[i], lm = lpm[i];
                    const float eP = __expf(lp), eM = __expf(-lp), ePm = __expf(lm), eE = __expf(tot[i] - lp);
                    oa[i] = av[i] * ePm; ob[i] = bv[i] * eM; ok[i] = kd8[i] * eM; orr[i] = r8[i] * eP;
                    *(bf16_t*)(BH + (8 * j + i) * LROW + wofs) = f2bf(bv[i] * eE);
                    *(bf16_t*)(KH + (8 * j + i) * LROW + wofs) = f2bf(kd8[i] * eE);
                    *(bf16_t*)(VT + (8 * j + i) * LROW + wofs) = f2bf(v8[i]);
                }
                st8((bf16_t*)(AT + ti * LROW) + 8 * j, oa); st8((bf16_t*)(BT + ti * LROW) + 8 * j, ob);
                st8((bf16_t*)(KT + ti * LROW) + 8 * j, ok); st8((bf16_t*)(RT + ti * LROW) + 8 * j, orr);
            }
            __syncthreads();
            if (ci + 1 < 36) RW_PREFETCH(ci + 1, tido);
            _Pragma("unroll 1") for (int rep = 0; rep < 6; ++rep) {
                const int q = wave + 8 * rep, m = q / 12, tl = q - 12 * m;
                const int tt4 = tl >= 10 ? 2 * (tl - 10) : tl < 1 ? 0 : tl < 3 ? 1 : tl < 6 ? 2 : 3, st4 = tl >= 10 ? tt4 + 1 : tl - (tt4 * (tt4 + 1)) / 2;
                char* dstm = m == 0 ? NAB : m == 1 ? NAK : m == 2 ? NRB : NRK;
                f32x4v a = {0.f, 0.f, 0.f, 0.f};
                if (st4 <= tt4) {
                    const char* Ab = (m < 2 ? AT : RT) + (16 * tt4 + lq) * LROW + kg * 16; const char* Bb = ((m & 1) ? KT : BT) + (16 * st4 + lq) * LROW + kg * 16;
                    UNROLL for (int ks = 0; ks < 2; ++ks) a = MFMA16(*(const bf16x8*)(Ab + ks * 64), *(const bf16x8*)(Bb + ks * 64), a);
                }
                const int sidx = 16 * st4 + lq;
                UNROLL for (int i = 0; i < 4; ++i) {
                    const int tidx = 16 * tt4 + 4 * kg + i;
                    const bool keep = m < 2 ? sidx < tidx : sidx <= tidx;
                    const float val = keep ? a[i] : 0.f;
                    *(bf16_t*)(dstm + tidx * LROW + sidx * 2) = f2bf(val);
                    if (m == 0 && st4 == tt4) NDF[(tt4 * 16 + 4 * kg + i) * 16 + lq] = val;
                }
            }
            __syncthreads();
            f32x4v xacc[4], yacc[4];
            bf16x8 vt[2];
            if (wave == 7) {
                const int blk = lane >> 4, c = lane & 15;
                float Tc[16];
                UNROLL for (int t = 0; t < 16; ++t) {
                    float a = t == c ? 1.f : 0.f;
                    UNROLL for (int s2 = 0; s2 < t; ++s2) a += NDF[(blk * 16 + t) * 16 + s2] * Tc[s2];
                    Tc[t] = a;
                }
                UNROLL for (int t = 0; t < 16; ++t) *(bf16_t*)(TJ + (blk * 16 + t) * 32 + c * 2) = f2bf(Tc[t]);
            } else if (wave < 4) {
                bf16x8 sb[2];
                UNROLL for (int kk = 0; kk < 2; ++kk) { sb[kk] = pk_acc2(sacc[2 * kk], sacc[2 * kk + 1]); vt[kk] = *(const bf16x8*)(VT + (16 * wave + lq) * LROW + (((4 * kk + kg) ^ (2 * wave + (lq >> 3))) << 4)); }
                UNROLL for (int t4 = 0; t4 < 4; ++t4) {
                    f32x4v x = {0.f, 0.f, 0.f, 0.f}, y = {0.f, 0.f, 0.f, 0.f};
                    UNROLL for (int kk = 0; kk < 2; ++kk) {
                        const char* pa = AT + (16 * t4 + lq) * LROW + (32 * kk + 4 * kg) * 2; const char* pr = RT + (16 * t4 + lq) * LROW + (32 * kk + 4 * kg) * 2;
                        x = MFMA16(pk_lohi(*(const u32x2*)pa, *(const u32x2*)(pa + 32)), sb[kk], x);
                        y = MFMA16(pk_lohi(*(const u32x2*)pr, *(const u32x2*)(pr + 32)), sb[kk], y);
                        if (2 * kk <= t4) {
                            x = MFMA16(*(const bf16x8*)(NAK + (16 * t4 + lq) * LROW + kk * 64 + kg * 16), vt[kk], x);
                            y = MFMA16(*(const bf16x8*)(NRK + (16 * t4 + lq) * LROW + kk * 64 + kg * 16), vt[kk], y);
                        }
                    }
                    xacc[t4] = x; yacc[t4] = y;
                }
            }
            __syncthreads();
            if (wave < 4) {
                const u32x2 z2 = {0u, 0u};
                f32x4v uacc[4];
                {
                    const u32x2 t0v = *(const u32x2*)(TJ + (0 * 16 + lq) * 32 + 4 * kg * 2);
                    uacc[0] = MFMA16(pk_lohi(t0v, z2), pk_acc1(xacc[0]), ((f32x4v){0.f, 0.f, 0.f, 0.f}));
                }
                UNROLL for (int jb = 1; jb < 4; ++jb) {
                    f32x4v z = xacc[jb];
                    const char* nr = NAB + (16 * jb + lq) * LROW + 4 * kg * 2;
                    if (jb == 1) z = MFMA16(pk_lohi(*(const u32x2*)nr, z2), pk_acc1(uacc[0]), z);
                    else {
                        z = MFMA16(pk_lohi(*(const u32x2*)nr, *(const u32x2*)(nr + 32)), pk_acc2(uacc[0], uacc[1]), z);
                        if (jb == 3) z = MFMA16(pk_lohi(*(const u32x2*)(nr + 64), z2), pk_acc1(uacc[2]), z);
                    }
                    const u32x2 tv = *(const u32x2*)(TJ + (jb * 16 + lq) * 32 + 4 * kg * 2);
                    uacc[jb] = MFMA16(pk_lohi(tv, z2), pk_acc1(z), ((f32x4v){0.f, 0.f, 0.f, 0.f}));
                }
                bf16x8 ub[2]; ub[0] = pk_acc2(uacc[0], uacc[1]); ub[1] = pk_acc2(uacc[2], uacc[3]);
                UNROLL for (int t4 = 0; t4 < 4; ++t4) {
                    f32x4v y = yacc[t4];
                    UNROLL for (int kk = 0; kk < 2; ++kk) if (2 * kk <= t4) {
                        const char* pn = NRB + (16 * t4 + lq) * LROW + (32 * kk + 4 * kg) * 2;
                        y = MFMA16(pk_lohi(*(const u32x2*)pn, *(const u32x2*)(pn + 32)), ub[kk], y);
                    }
                    UNROLL for (int i = 0; i < 4; ++i) YO[(16 * t4 + 4 * kg + i) * 68 + 16 * wave + lq] = y[i];
                }
                UNROLL for (int kt = 0; kt < 4; ++kt) {
                    f32x4v sv = sacc[kt];
                    UNROLL for (int i = 0; i < 4; ++i) sv[i] *= PCv[16 * kt + 4 * kg + i];
                    UNROLL for (int kk = 0; kk < 2; ++kk) {
                        const int xr = 2 * kt + (lq >> 3);
                        const char* pb = BH + (16 * kt + lq) * LROW + (kg & 1) * 8;
                        sv = MFMA16(pk_lohi(*(const u32x2*)(pb + (((4 * kk + (kg >> 1)) ^ xr) << 4)), *(const u32x2*)(pb + (((4 * kk + 2 + (kg >> 1)) ^ xr) << 4))), ub[kk], sv);
                        sv = MFMA16(*(const bf16x8*)(KH + (16 * kt + lq) * LROW + (((4 * kk + kg) ^ xr) << 4)), vt[kk], sv);
                    }
                    sacc[kt] = sv;
                }
            }
            __syncthreads();
            {
                const float4 ya = *(const float4*)(YO + ti * 68 + 8 * j), yb = *(const float4*)(YO + ti * 68 + 8 * j + 4);
                const float y8[8] = {ya.x, ya.y, ya.z, ya.w, yb.x, yb.y, yb.z, yb.w};
                st8(YS + ((size_t)d * NT + nb + tt) * 512 + ch, y8);
            }
            __syncthreads();
        }
    }
}

DEV void ph_rw_read(const Params& p, int L, int ntok) {
    const int lane = TID() & 63, wave = TID() >> 6;
    const bf16_t* PXR = (const bf16_t*)(p.ws + OFF_PX); const bf16_t* VF = (const bf16_t*)(p.ws + OFF_VF);
    const bf16_t* YS = (const bf16_t*)(p.ws + OFF_YS); const float* CB = (const float*)(p.ws + OFF_CB);
    bf16_t* YA = (bf16_t*)(p.ws + OFF_YA); bf16_t* SG = (bf16_t*)(p.ws + OFF_SGB);
    const float* mu = p.in[I_MU] + (size_t)L * RW_COLS;
    const float* lg = p.in[I_LNG] + (size_t)L * 512; const float* lb = p.in[I_LNB] + (size_t)L * 512;
    for (int n0 = blockIdx.x * 8; n0 < ntok; n0 += gridDim.x * 8) {
        const int n = n0 + wave, c = lane * 8, h = lane >> 3;
        float y0[8], y1[8], v8[8], o[8];
        ld8(YS + (size_t)n * 512 + c, y0); ld8(YS + ((size_t)NT + n) * 512 + c, y1); ld8(VF + (size_t)n * 512 + c, v8);
        float s = 0.f;
        UNROLL for (int i = 0; i < 8; ++i) { y0[i] += y1[i]; s += y0[i]; }
        s += __shfl_xor(s, 1); s += __shfl_xor(s, 2); s += __shfl_xor(s, 4);
        const float mean = s * (1.f / 64.f); float q = 0.f;
        UNROLL for (int i = 0; i < 8; ++i) { const float dd = y0[i] - mean; q += dd * dd; }
        q += __shfl_xor(q, 1); q += __shfl_xor(q, 2); q += __shfl_xor(q, 4);
        const float rstd = rsqrtf(q * (1.f / 64.f) + 64e-5f);
        const float bon = CB[(size_t)n * 8 + h] + CB[((size_t)NT + n) * 8 + h];
        UNROLL for (int i = 0; i < 8; ++i) o[i] = (y0[i] - mean) * rstd * lg[c + i] + lb[c + i] + bon * v8[i];
        st8(YA + (size_t)n * 512 + c, o);
        if (lane < 16) {
            int nb, tt, T; seq_of(n, nb, tt, T);
            float g8[8]; shift8(PXR, RW_COLS, nb, tt, T, 1792 + lane * 8, mu, g8);
            UNROLL for (int i = 0; i < 8; ++i) g8[i] = sigm(g8[i]);
            st8(SG + (size_t)n * 128 + lane * 8, g8);
        }
    }
}

DEV void ph_na_norm(const Params& p, int L) {
    const int lane = TID() & 63, wave = TID() >> 6;
    bf16_t* PXN = (bf16_t*)(p.ws + OFF_PX);
    const float* qg = p.in[I_QNG] + (size_t)L * 64; const float* kg = p.in[I_KNG] + (size_t)L * 64;
    for (int n0 = blockIdx.x * 8; n0 < NT; n0 += gridDim.x * 8) {
        const int n = n0 + wave, c = lane * 8;
        UNROLL for (int w = 0; w < 2; ++w) {
            bf16_t* ptr = PXN + (size_t)n * 1024 + w * 512 + c;
            float x[8]; ld8(ptr, x);
            float ss = 0.f;
            UNROLL for (int i = 0; i < 8; ++i) ss += x[i] * x[i];
            ss += __shfl_xor(ss, 1); ss += __shfl_xor(ss, 2); ss += __shfl_xor(ss, 4);
            const float r = rsqrtf(ss * (1.f / 64.f) + 1e-6f) * (w == 0 ? 0.125f : 1.f);
            const float* g = w == 0 ? qg : kg;
            UNROLL for (int i = 0; i < 8; ++i) x[i] = x[i] * r * g[(c + i) & 63];
            st8(ptr, x);
        }
    }
}

DEV void knorm8(float (&x)[8], const float* g) {
    float ss = 0.f;
    UNROLL for (int i = 0; i < 8; ++i) ss += x[i] * x[i];
    ss = sum8(ss);
    const float r = rsqrtf(ss * (1.f / 64.f) + 1e-6f);
    UNROLL for (int i = 0; i < 8; ++i) x[i] = x[i] * r * g[i];
}
DEV void ph_na_att(const Params& p, int L, char* smem) {
    const int tid0 = TID();
    const int wave = __builtin_amdgcn_readfirstlane(tid0 >> 6);
    char* KL = smem;
    char* KC = smem + 576 * LROW;
    char* VL = smem;
    char* VC = smem + 64 * 1168;
    float* OX = (float*)(smem + 119808);
    float* RP = OX + 8 * 1024;
    const bf16_t* PXN = (const bf16_t*)(p.ws + OFF_PX); bf16_t* YB = (bf16_t*)(p.ws + OFF_YB);
    const bf16_t* VT = (const bf16_t*)(p.ws + OFF_VT); const bf16_t* VTC = (const bf16_t*)(p.ws + OFF_VTC);
    const float* qgn = p.in[I_QNG] + (size_t)L * 64; const float* kgn = p.in[I_KNG] + (size_t)L * 64;
    const int nunits = 2048 + (L == 0 ? 256 : 0);
    for (int u = blockIdx.x; u < nunits; u += gridDim.x) {
        int tid = tid0; asm volatile("" : "+v"(tid));
        const int lane = tid & 63, lq = lane & 15, kg = lane >> 4;
        const bool cu = u >= 2048;
        int b, h, rp = 0, rs0 = 0, g = 0;
        if (!cu) { h = u & 7; rp = (u >> 3) & 15; b = u >> 7; rs0 = min(max(2 * rp - 4, 0), 24); }
        else { const int v = u - 2048; h = v & 7; g = (v >> 3) & 1; b = v >> 4; }
        const int ctx0 = NX + b * CTXL;
        if (!cu) {
            UNROLL for (int i = 0; i < 9; ++i) {
                const int c = tid + NTHREADS * i, kx = c >> 3, part = c & 7;
                const int tok = b * SEQ + min(rs0 + (kx >> 6), 31) * 64 + (kx & 63);
                float kv[8]; ld8(PXN + (size_t)tok * 1024 + 512 + h * 64 + part * 8, kv); knorm8(kv, kgn + part * 8);
                st8((bf16_t*)(KL + kx * LROW + part * 16), kv);
            }
            for (int i = tid; i < 15 * 31; i += NTHREADS) RP[i] = p.in[I_RPB][((size_t)L * 8 + h) * 465 + i];
        }
        UNROLL for (int i = 0; i < 4; ++i) {
            const int c = tid + NTHREADS * i, kx = c >> 3, part = c & 7;
            float kv[8]; ld8(PXN + (size_t)(ctx0 + kx) * 1024 + 512 + h * 64 + part * 8, kv); knorm8(kv, kgn + part * 8);
            st8((bf16_t*)(KC + kx * LROW + part * 16), kv);
        }
        const int nb = wave & 3, ri = wave >> 2, r = 2 * rp + ri;
        const int rs = min(max(r - 4, 0), 24), roff = rs - rs0;
        const int qtok0 = cu ? ctx0 + (g * 8 + wave) * 16 : b * SEQ + r * 64 + nb * 16;
        const int band0 = min(max(nb * 16 - 8, 0), 32);
        bf16x8 qf[2];
        {
            float q0[8], q1[8]; ld8(PXN + (size_t)(qtok0 + lq) * 1024 + h * 64 + kg * 8, q0); ld8(PXN + (size_t)(qtok0 + lq) * 1024 + h * 64 + 32 + kg * 8, q1);
            float ss = 0.f;
            UNROLL for (int i = 0; i < 8; ++i) ss += q0[i] * q0[i] + q1[i] * q1[i];
            ss += __shfl_xor(ss, 16); ss += __shfl_xor(ss, 32);
            const float rq = rsqrtf(ss * (1.f / 64.f) + 1e-6f) * 0.125f;
            UNROLL for (int i = 0; i < 8; ++i) { q0[i] = q0[i] * rq * qgn[kg * 8 + i]; q1[i] = q1[i] * rq * qgn[32 + kg * 8 + i]; }
            u32x4 w0, w1; w0.x = pk2(q0[0], q0[1]); w0.y = pk2(q0[2], q0[3]); w0.z = pk2(q0[4], q0[5]); w0.w = pk2(q0[6], q0[7]);
            w1.x = pk2(q1[0], q1[1]); w1.y = pk2(q1[2], q1[3]); w1.z = pk2(q1[4], q1[5]); w1.w = pk2(q1[6], q1[7]);
            qf[0] = __builtin_bit_cast(bf16x8, w0); qf[1] = __builtin_bit_cast(bf16x8, w1);
        }
        __syncthreads();
        u32x4 vraw[13];
        if (!cu) {
            UNROLL for (int i = 0; i < 9; ++i) {
                const int c = tid + NTHREADS * i, part = c & 7, kr = (c >> 3) % 9, d = (c >> 3) / 9;
                vraw[i] = *(const u32x4*)(VT + ((size_t)(b * 8 + h) * 64 + d) * SEQ + min(rs0 + kr, 31) * 64 + part * 8);
            }
        }
        UNROLL for (int i = 0; i < 4; ++i) {
            const int c = tid + NTHREADS * i, part = c & 31, d = c >> 5;
            vraw[9 + i] = *(const u32x4*)(VTC + ((size_t)(b * 8 + h) * 64 + d) * CTXL + part * 8);
        }
        f32x4v sacc[16];
        bf16x8 pfl[8], pfc[8];
        float ml = -3e38f, ll = 0.f, mc, lc;
        if (!cu) {
            const char* kb = KL + (roff * 64 + band0 + lq) * LROW + kg * 16;
            UNROLL for (int t = 0; t < 16; ++t) {
                f32x4v a = {0.f, 0.f, 0.f, 0.f};
                UNROLL for (int ks = 0; ks < 2; ++ks) a = __builtin_amdgcn_mfma_f32_16x16x32_bf16(*(const bf16x8*)(kb + ((t >> 1) * 64 + (t & 1) * 16) * LROW + ks * 64), qf[ks], a, 0, 0, 0);
                sacc[t] = a;
            }
            const int col = nb * 16 + lq, cs = min(max(col - 8, 0), 48);
            const int kc0 = band0 + 4 * kg;
            const float* rpp = RP + (rs - r + 7) * 31 + (kc0 - col + 15);
            UNROLL for (int t = 0; t < 16; ++t) UNROLL for (int i = 0; i < 4; ++i) {
                const int kc = kc0 + (t & 1) * 16 + i;
                const bool valid = kc >= cs && kc < cs + 16;
                sacc[t][i] = valid ? sacc[t][i] + rpp[(t >> 1) * 31 + (t & 1) * 16 + i] : -1e30f;
            }
            UNROLL for (int t = 0; t < 16; ++t) UNROLL for (int i = 0; i < 4; ++i) ml = fmaxf(ml, sacc[t][i]);
            ml = fmaxf(ml, __shfl_xor(ml, 16)); ml = fmaxf(ml, __shfl_xor(ml, 32));
            UNROLL for (int t = 0; t < 16; ++t) UNROLL for (int i = 0; i < 4; ++i) { const float e = __expf(sacc[t][i] - ml); sacc[t][i] = e; ll += e; }
            ll += __shfl_xor(ll, 16); ll += __shfl_xor(ll, 32);
            UNROLL for (int tp = 0; tp < 8; ++tp) pfl[tp] = pk_acc2(sacc[2 * tp], sacc[2 * tp + 1]);
        }
        {
            const char* kb = KC + lq * LROW + kg * 16;
            UNROLL for (int t = 0; t < 16; ++t) {
                f32x4v a = {0.f, 0.f, 0.f, 0.f};
                UNROLL for (int ks = 0; ks < 2; ++ks) a = __builtin_amdgcn_mfma_f32_16x16x32_bf16(*(const bf16x8*)(kb + t * 16 * LROW + ks * 64), qf[ks], a, 0, 0, 0);
                sacc[t] = a;
            }
            mc = -3e38f; lc = 0.f;
            UNROLL for (int t = 0; t < 16; ++t) UNROLL for (int i = 0; i < 4; ++i) mc = fmaxf(mc, sacc[t][i]);
            mc = fmaxf(mc, __shfl_xor(mc, 16)); mc = fmaxf(mc, __shfl_xor(mc, 32));
            UNROLL for (int t = 0; t < 16; ++t) UNROLL for (int i = 0; i < 4; ++i) { const float e = __expf(sacc[t][i] - mc); sacc[t][i] = e; lc += e; }
            lc += __shfl_xor(lc, 16); lc += __shfl_xor(lc, 32);
            UNROLL for (int tp = 0; tp < 8; ++tp) pfc[tp] = pk_acc2(sacc[2 * tp], sacc[2 * tp + 1]);
        }
        const float mm = fmaxf(ml, mc), el = cu ? 0.f : __expf(ml - mm), ec = __expf(mc - mm);
        const float inv = frcp(ll * el + lc * ec);
        const float fl = el * inv, fc = ec * inv;
        __syncthreads();
        if (!cu) {
            UNROLL for (int i = 0; i < 9; ++i) {
                const int c = tid + NTHREADS * i, part = c & 7, kr = (c >> 3) % 9, d = (c >> 3) / 9;
                *(u32x4*)(VL + d * 1168 + (kr * 64 + part * 8) * 2) = vraw[i];
            }
        }
        UNROLL for (int i = 0; i < 4; ++i) {
            const int c = tid + NTHREADS * i, part = c & 31, d = c >> 5;
            *(u32x4*)(VC + d * 528 + part * 16) = vraw[9 + i];
        }
        __syncthreads();
        f32x4v ol[4], oc[4];
        UNROLL for (int dt = 0; dt < 4; ++dt) { ol[dt] = (f32x4v){0.f, 0.f, 0.f, 0.f}; oc[dt] = (f32x4v){0.f, 0.f, 0.f, 0.f}; }
        if (!cu) {
            const char* vb = VL + lq * 1168 + (roff * 64 + band0 + 4 * kg) * 2;
            UNROLL for (int tp = 0; tp < 8; ++tp) UNROLL for (int dt = 0; dt < 4; ++dt)
                ol[dt] = __builtin_amdgcn_mfma_f32_16x16x32_bf16(pfl[tp], pk_lohi(*(const u32x2*)(vb + dt * 16 * 1168 + tp * 128), *(const u32x2*)(vb + dt * 16 * 1168 + tp * 128 + 32)), ol[dt], 0, 0, 0);
        }
        {
            const char* vb = VC + lq * 528 + 8 * kg;
            UNROLL for (int tp = 0; tp < 8; ++tp) UNROLL for (int dt = 0; dt < 4; ++dt)
                oc[dt] = __builtin_amdgcn_mfma_f32_16x16x32_bf16(pfc[tp], pk_lohi(*(const u32x2*)(vb + dt * 16 * 528 + tp * 64), *(const u32x2*)(vb + dt * 16 * 528 + tp * 64 + 32)), oc[dt], 0, 0, 0);
        }
        float* ox = OX + wave * 1024;
        UNROLL for (int i = 0; i < 4; ++i) {
            const float a = __shfl(fl, 4 * kg + i), c2 = __shfl(fc, 4 * kg + i);
            UNROLL for (int dt = 0; dt < 4; ++dt) ox[(4 * kg + i) * 64 + dt * 16 + lq] = ol[dt][i] * a + oc[dt][i] * c2;
        }
        UNROLL for (int it = 0; it < 2; ++it) {
            const int q = (lane >> 3) + 8 * it, c8 = (lane & 7) * 8;
            const float4 a = *(const float4*)(ox + q * 64 + c8), bq = *(const float4*)(ox + q * 64 + c8 + 4);
            const float v[8] = {a.x, a.y, a.z, a.w, bq.x, bq.y, bq.z, bq.w};
            st8(YB + (size_t)(qtok0 + q) * 512 + h * 64 + c8, v);
        }
        __syncthreads();
    }
}

DEV float sum16(float v) { v += DPP_MOV(v, 0xB1); v += DPP_MOV(v, 0x4E); v += DPP_MOV(v, 0x141); v += DPP_MOV(v, 0x140); return v; }
DEV void ph_ml_scan(const Params& p, int L, char* smem) {
    const int tid = TID(), lane = tid & 63, lq = lane & 15, kg = lane >> 4, ti = tid >> 3, j = tid & 7;
    const int wave = __builtin_amdgcn_readfirstlane(tid >> 6);
    char* QS = smem;
    char* QP = QS + 9216;
    char* KC = QP + 9216;
    char* KW = KC + 9216;
    char* PM = KW + 9216;
    char* VT = PM + 9216;
    float* BV = (float*)(VT + 128 * LROW);
    float* GI = BV + 64;
    float* DEN = GI + 64;
    float* NV = DEN + 64;
    float* RS = NV + 64;
    float* HO = RS + 256;
    const bf16_t* PXM = (const bf16_t*)(p.ws + OFF_PX); bf16_t* HS = (bf16_t*)(p.ws + OFF_HS);
    for (int u = blockIdx.x; u < 128; u += gridDim.x) {
        const int d = u & 1, h = (u >> 1) & 3, b = u >> 3;
        const float ib = p.in[I_IB][L * 8 + d * 4 + h], fb = p.in[I_FB][L * 8 + d * 4 + h];
        f32x4v cacc[4];
        UNROLL for (int i = 0; i < 4; ++i) cacc[i] = (f32x4v){0.f, 0.f, 0.f, 0.f};
        for (int i = tid; i < 64 * LROW / 4; i += NTHREADS) ((unsigned*)PM)[i] = 0u;
        if (tid < 64) NV[tid] = 0.f;
        __syncthreads();
        u32x4 pq, pk, pv0, pv1; unsigned short pig = 0, pfg = 0;
#define ML_GEOM(ci_) const bool isc = (ci_) < 4; const int T = isc ? CTXL : SEQ, cc = isc ? (ci_) : (ci_) - 4; \
            const int t0 = d == 0 ? cc * 64 : T - 64 * (cc + 1), nb = isc ? NX + b * CTXL : b * SEQ; \
            const int tt = d == 0 ? t0 + ti : t0 + 63 - ti;
#define ML_PREFETCH(ci_) do { ML_GEOM(ci_) const bf16_t* row_ = PXM + (size_t)(nb + tt) * ML_COLS; \
            pq = *(const u32x4*)(row_ + h * 64 + 8 * j); pk = *(const u32x4*)(row_ + 256 + h * 64 + 8 * j); \
            pv0 = *(const u32x4*)(row_ + 512 + h * 128 + 16 * j); pv1 = *(const u32x4*)(row_ + 512 + h * 128 + 16 * j + 8); \
            if (wave == 0) { const int tl_ = d == 0 ? t0 + lane : t0 + 63 - lane; const bf16_t* rw_ = PXM + (size_t)(nb + tl_) * ML_COLS; pig = rw_[1536 + d * 4 + h]; pfg = rw_[1544 + d * 4 + h]; } } while (0)
        ML_PREFETCH(0);
        for (int ci = 0; ci < 36; ++ci) {
            ML_GEOM(ci)
            float q8[8], k8[8];
            {
                unpack8(pq, q8); unpack8(pk, k8);
                if (!isc) {
                    const int axis = j >> 2, half = (j >> 1) & 1; const float pos = (float)(axis == 0 ? (tt >> 6) : (tt & 63));
                    UNROLL for (int i = 0; i < 8; ++i) {
                        const int f = (j & 1) * 8 + i;
                        const float inv = exp2f(-(float)f * 0.83048202372184059f);
                        const float ang = pos * inv; const float cs = __cosf(ang), sn = __sinf(ang);
                        const float qo = __shfl_xor(q8[i], 2), ko = __shfl_xor(k8[i], 2);
                        q8[i] = half == 0 ? q8[i] * cs - qo * sn : q8[i] * cs + qo * sn;
                        k8[i] = half == 0 ? k8[i] * cs - ko * sn : k8[i] * cs + ko * sn;
                    }
                }
                UNROLL for (int i = 0; i < 8; ++i) q8[i] *= 0.125f;
                st8((bf16_t*)(QS + ti * LROW) + 8 * j, q8); st8((bf16_t*)(KC + ti * LROW) + 8 * j, k8);
                float v0[8], v1[8]; unpack8(pv0, v0); unpack8(pv1, v1);
                UNROLL for (int i = 0; i < 8; ++i) { *(bf16_t*)(VT + (16 * j + i) * LROW + ti * 2) = f2bf(v0[i]); *(bf16_t*)(VT + (16 * j + 8 + i) * LROW + ti * 2) = f2bf(v1[i]); }
                if (wave == 0) {
                    const float ig = bf2f(pig) + ib, fg = bf2f(pfg) + fb;
                    const float igc = 15.f * tanhf(ig * (1.f / 15.f)), fgc = 15.f * tanhf(fg * (1.f / 15.f));
                    float lf = -(fmaxf(-fgc, 0.f) + log1pf(expf(-fabsf(fgc))));
                    UNROLL for (int o = 1; o < 64; o <<= 1) { const float up = __shfl_up(lf, o); if (lane >= o) lf += up; }
                    BV[lane] = lf; GI[lane] = igc;
                }
            }
            __syncthreads();
            if (ci + 1 < 36) ML_PREFETCH(ci + 1);
            {
                const float bt = BV[ti], bl = BV[63], gi = GI[ti];
                const float eb = __expf(bt), wk = __expf(bl - bt + gi);
                float qp[8]; float dn = 0.f;
                UNROLL for (int i = 0; i < 8; ++i) { qp[i] = q8[i] * eb; dn += q8[i] * NV[8 * j + i]; }
                st8((bf16_t*)(QP + ti * LROW) + 8 * j, qp);
                UNROLL for (int i = 0; i < 8; ++i) *(bf16_t*)(KW + (8 * j + i) * LROW + ti * 2) = f2bf(k8[i] * wk);
                dn = sum8(dn);
                if (j == 0) DEN[ti] = dn * eb;
            }
            __syncthreads();
            UNROLL for (int rep = 0; rep < 2; ++rep) {
                const int tile = wave + 8 * rep;
                if (tile < 10) {
                    const int tt4 = tile < 1 ? 0 : tile < 3 ? 1 : tile < 6 ? 2 : 3, st4 = tile - (tt4 * (tt4 + 1)) / 2;
                    f32x4v a = {0.f, 0.f, 0.f, 0.f};
                    UNROLL for (int ks = 0; ks < 2; ++ks)
                        a = __builtin_amdgcn_mfma_f32_16x16x32_bf16(*(const bf16x8*)(QS + (16 * tt4 + lq) * LROW + ks * 64 + kg * 16),
                                                                    *(const bf16x8*)(KC + (16 * st4 + lq) * LROW + ks * 64 + kg * 16), a, 0, 0, 0);
                    const int sidx = 16 * st4 + lq; const float bs = BV[sidx], gs = GI[sidx];
                    UNROLL for (int i = 0; i < 4; ++i) {
                        const int tidx = 16 * tt4 + 4 * kg + i;
                        const float val = sidx <= tidx ? a[i] * __expf(BV[tidx] - bs + gs) : 0.f;
                        *(bf16_t*)(PM + tidx * LROW + sidx * 2) = f2bf(val);
                        const float rsum = sum16(val);
                        if (lq == 0) RS[tidx * 4 + st4] = rsum;
                    }
                }
            }
            __syncthreads();
            {
                bf16x8 vf[2], cb[2];
                UNROLL for (int kk = 0; kk < 2; ++kk) vf[kk] = *(const bf16x8*)(VT + (16 * wave + lq) * LROW + kk * 64 + kg * 16);
                UNROLL for (int kk = 0; kk < 2; ++kk) {
                    u32x4 w; w.x = pk2(cacc[2 * kk][0], cacc[2 * kk][1]); w.y = pk2(cacc[2 * kk][2], cacc[2 * kk][3]);
                    w.z = pk2(cacc[2 * kk + 1][0], cacc[2 * kk + 1][1]); w.w = pk2(cacc[2 * kk + 1][2], cacc[2 * kk + 1][3]);
                    cb[kk] = __builtin_bit_cast(bf16x8, w);
                }
                UNROLL for (int tt4 = 0; tt4 < 4; ++tt4) {
                    f32x4v hacc = {0.f, 0.f, 0.f, 0.f};
                    UNROLL for (int kk = 0; kk < 2; ++kk) if (2 * kk <= tt4)
                        hacc = __builtin_amdgcn_mfma_f32_16x16x32_bf16(*(const bf16x8*)(PM + (16 * tt4 + lq) * LROW + kk * 64 + kg * 16), vf[kk], hacc, 0, 0, 0);
                    UNROLL for (int kk = 0; kk < 2; ++kk) {
                        const char* qa = QP + (16 * tt4 + lq) * LROW + (32 * kk + 4 * kg) * 2;
                        const u32x2 lo = *(const u32x2*)qa, hi = *(const u32x2*)(qa + 32);
                        u32x4 w; w.x = lo.x; w.y = lo.y; w.z = hi.x; w.w = hi.y;
                        hacc = __builtin_amdgcn_mfma_f32_16x16x32_bf16(__builtin_bit_cast(bf16x8, w), cb[kk], hacc, 0, 0, 0);
                    }
                    UNROLL for (int i = 0; i < 4; ++i) {
                        const int tidx = 16 * tt4 + 4 * kg + i;
                        float den = DEN[tidx];
                        UNROLL for (int st = 0; st <= tt4; ++st) den += RS[tidx * 4 + st];
                        HO[tidx * 132 + 16 * wave + lq] = hacc[i] * frcp(fmaxf(fabsf(den), 1.f));
                    }
                }
                const float g = __expf(BV[63]);
                UNROLL for (int dk = 0; dk < 4; ++dk) {
                    cacc[dk] = cacc[dk] * g;
                    UNROLL for (int kk = 0; kk < 2; ++kk)
                        cacc[dk] = __builtin_amdgcn_mfma_f32_16x16x32_bf16(*(const bf16x8*)(KW + (16 * dk + lq) * LROW + kk * 64 + kg * 16), vf[kk], cacc[dk], 0, 0, 0);
                }
            }
            __syncthreads();
            if (tid < 64) {
                float acc = 0.f;
                UNROLL for (int c8 = 0; c8 < 8; ++c8) { float kw[8]; ld8((const bf16_t*)(KW + tid * LROW) + 8 * c8, kw); UNROLL for (int i = 0; i < 8; ++i) acc += kw[i]; }
                NV[tid] = __expf(BV[63]) * NV[tid] + acc;
            }
            {
                const float* hr = HO + ti * 132 + 16 * j;
                float o0[8], o1[8];
                UNROLL for (int i = 0; i < 8; ++i) { o0[i] = hr[i]; o1[i] = hr[8 + i]; }
                bf16_t* dst = HS + ((size_t)d * NT + nb + tt) * 512 + h * 128 + 16 * j;
                st8(dst, o0); st8(dst + 8, o1);
            }
            __syncthreads();
        }
    }
}
DEV void ph_ml_read(const Params& p, int L, int ntok) {
    const int lane = TID() & 63, wave = TID() >> 6;
    const bf16_t* PXM = (const bf16_t*)(p.ws + OFF_PX); const bf16_t* HS = (const bf16_t*)(p.ws + OFF_HS);
    bf16_t* YC = (bf16_t*)(p.ws + OFF_YC); const float* ng = p.in[I_MNG] + (size_t)L * 512;
    for (int n0 = blockIdx.x * 8; n0 < ntok; n0 += gridDim.x * 8) {
        const int n = n0 + wave, c = lane * 8;
        float h0[8], h1[8], o8[8], out[8];
        ld8(HS + (size_t)n * 512 + c, h0); ld8(HS + ((size_t)NT + n) * 512 + c, h1); ld8(PXM + (size_t)n * ML_COLS + 1024 + c, o8);
        float ss = 0.f;
        UNROLL for (int i = 0; i < 8; ++i) { h0[i] += h1[i]; ss += h0[i] * h0[i]; }
        ss += __shfl_xor(ss, 1); ss += __shfl_xor(ss, 2); ss += __shfl_xor(ss, 4); ss += __shfl_xor(ss, 8);
        const float r = rsqrtf(ss * (1.f / 128.f) + 1e-6f);
        UNROLL for (int i = 0; i < 8; ++i) out[i] = h0[i] * r * ng[c + i] * sigm(o8[i]);
        st8(YC + (size_t)n * 512 + c, out);
    }
}

DEV void ph_route(const Params& p, int L, int ntok, char* smem) {
    const int lane = TID() & 63, wave = TID() >> 6;
    const float* LOG = (const float*)(p.ws + OFF_LOG); int* EIDX = (int*)(p.ws + OFF_EIDX); float* EW = (float*)(p.ws + OFF_EW);
    const float bias = p.in[I_MB][L * 64 + lane];
    int* MCNT = (int*)(p.ws + OFF_MCNT);
    int* hist = (int*)smem;
    if (TID() < 192) hist[TID()] = 0;
    __syncthreads();
    for (int n0 = blockIdx.x * 8; n0 < ntok; n0 += gridDim.x * 8) {
        const int n = n0 + wave, g = lane >> 3;
        const float score = sigm_acc(LOG[(size_t)n * 64 + lane]), sel = score + bias;
        float m1 = sel; m1 = fmaxf(m1, __shfl_xor(m1, 1)); m1 = fmaxf(m1, __shfl_xor(m1, 2)); m1 = fmaxf(m1, __shfl_xor(m1, 4));
        int i1 = sel == m1 ? lane : 64; i1 = min(i1, __shfl_xor(i1, 1)); i1 = min(i1, __shfl_xor(i1, 2)); i1 = min(i1, __shfl_xor(i1, 4));
        float m2 = lane == i1 ? -3e38f : sel; m2 = fmaxf(m2, __shfl_xor(m2, 1)); m2 = fmaxf(m2, __shfl_xor(m2, 2)); m2 = fmaxf(m2, __shfl_xor(m2, 4));
        const float gs = m1 + m2;
        int rank = 0;
        UNROLL for (int g2 = 0; g2 < 8; ++g2) { const float v = __shfl(gs, g2 * 8); rank += (v > gs || (v == gs && g2 < g)) ? 1 : 0; }
        const float ms = rank < 4 ? sel : -1e30f;
        int er = 0;
        for (int e2 = 0; e2 < 64; ++e2) { const float v = __shfl(ms, e2); er += (v > ms || (v == ms && e2 < lane)) ? 1 : 0; }
        const bool chosen = er < 8;
        float ws = chosen ? score : 0.f;
        UNROLL for (int o = 1; o < 64; o <<= 1) ws += __shfl_xor(ws, o);
        if (chosen) { EIDX[(size_t)n * 8 + er] = lane; EW[(size_t)n * 8 + er] = score / ws * 2.5f; atomicAdd(hist + (n / MOE_CHUNK) * 64 + lane, 1); }
    }
    __syncthreads();
    if (TID() < 192 && hist[TID()] > 0) atomicAdd(MCNT + TID(), hist[TID()]);
    __syncthreads();
}


DEV void ph_moe_scatter(const Params& p, int ntok, char* smem) {
    const int tid = TID();
    int* base = (int*)smem;
    int* lh = base + 192;
    const int* MCNT = (const int*)(p.ws + OFF_MCNT); int* CUR = (int*)(p.ws + OFF_MCNT) + 192;
    const int* EIDX = (const int*)(p.ws + OFF_EIDX); int* SORT = (int*)(p.ws + OFF_SORT);
    if (tid < 3) { int b = 0; for (int e = 0; e < 64; ++e) { base[tid * 64 + e] = b; b += (MCNT[tid * 64 + e] + 127) & ~127; } }
    if (tid < 192) lh[tid] = 0;
    __syncthreads();
    for (int i = blockIdx.x * NTHREADS + tid; i < ntok * 8; i += gridDim.x * NTHREADS) atomicAdd(lh + ((i >> 3) / MOE_CHUNK) * 64 + EIDX[i], 1);
    __syncthreads();
    if (tid < 192) { const int n = lh[tid]; if (n > 0) base[tid] += atomicAdd(CUR + tid, n); lh[tid] = 0; }
    __syncthreads();
    for (int i = blockIdx.x * NTHREADS + tid; i < ntok * 8; i += gridDim.x * NTHREADS) {
        const int ce = ((i >> 3) / MOE_CHUNK) * 64 + EIDX[i];
        SORT[(size_t)(ce >> 6) * SORT_CAP + base[ce] + atomicAdd(lh + ce, 1)] = i;
    }
    __syncthreads();
}

DEV void ph_moe_exp(const Params& p, int cb, int ce, char* smem, Topo tp) {
    typedef GC<2, 4> C;
    const int tid0 = TID();
    char* ACT = smem + 2 * C::STG;
    int* list = (int*)(smem + 3 * C::STG);
    int* cnt = list + 1024;
    const bf16_t* H2 = (const bf16_t*)(p.ws + OFF_HX); const int* EIDX = (const int*)(p.ws + OFF_EIDX); const float* EW = (const float*)(p.ws + OFF_EW);
    bf16_t* YBUF = (bf16_t*)(p.ws + OFF_YBUF);
    const int c = cb / MOE_CHUNK;
    const int* MCNT = (const int*)(p.ws + OFF_MCNT) + c * 64; const int* SORT = (const int*)(p.ws + OFF_SORT) + (size_t)c * SORT_CAP;
    int* tb = cnt + 16;
    const int xcd = tp.x, slot = tp.r, nslot = tp.n;
    __syncthreads();
    if (tid0 < 8) {
        const int tid = tid0; const int e = xcd + 8 * tid; int b = 0;
        for (int e2 = 0; e2 < e; ++e2) b += (MCNT[e2] + 127) & ~127;
        tb[16 + tid] = b; tb[32 + tid] = MCNT[e];
    }
    __syncthreads();
    if (tid0 == 0) { int t = 0; for (int k = 0; k < 8; ++k) { tb[k] = t; t += (tb[32 + k] + 127) >> 7; } tb[8] = t; }
    __syncthreads();
    const int total = tb[8];
    float* ewl = (float*)(list + 256);
    if (slot < total && tid0 < 128) {
        int k = 0;
        while (k < 7 && slot >= tb[k + 1]) ++k;
        const int j = slot - tb[k], M = min(128, tb[32 + k] - 128 * j);
        const int en = SORT[tb[16 + k] + 128 * j + min(tid0, M - 1)];
        list[tid0] = en; ewl[tid0] = EW[en];
    }
    int cur = 0;
#define GLDS4(gp, lp) __builtin_amdgcn_global_load_lds((const __attribute__((address_space(1))) void*)(gp), (__attribute__((address_space(3))) void*)(lp), 4, 0, 0)
    for (int lu = slot; lu < total; lu += nslot) {
        int tid = tid0; asm volatile("" : "+v"(tid));
        const int lane = tid & 63, wave = tid >> 6, wm = wave / 4, wn = wave % 4, fr = lane & 31, fh = lane >> 5;
        int k = 0;
        while (k < 7 && lu >= tb[k + 1]) ++k;
        const int e = xcd + 8 * k, j = lu - tb[k], M = min(128, tb[32 + k] - 128 * j);
        const int* lst = list + cur * 128; const float* ew = ewl + cur * 128;
        int* lst2 = list + (cur ^ 1) * 128; float* ew2 = ewl + (cur ^ 1) * 128;
        const bool has_next = lu + nslot < total;
        __syncthreads();
        if (has_next && tid < 128) {
            const int lu2 = lu + nslot; int k2 = 0;
            while (k2 < 7 && lu2 >= tb[k2 + 1]) ++k2;
            const int j2 = lu2 - tb[k2], M2 = min(128, tb[32 + k2] - 128 * j2);
            GLDS4(SORT + tb[16 + k2] + 128 * j2 + min(tid, M2 - 1), lst2 + tid);
        }
        const bf16_t* GU = (const bf16_t*)(p.ws + OFF_MGU) + (size_t)e * 256 * 1024;
        const bf16_t* DT = (const bf16_t*)(p.ws + OFF_MDT) + (size_t)e * 1024 * 128;
        {
            constexpr int mc = 0;
            f32x16 acc[2][2];
            {
            acc_zero(acc);
            gemm_tile<2, 4, 3, false, true>(acc, [&](int r) -> const bf16_t* { const int ix = min(mc + r, M - 1); return H2 + (size_t)(lst[ix] >> 3) * 1024; },
                                   GU, 1024, 0, 256, 1024, smem, nullptr);
            }
            const int crow = tid >> 3, cch = (tid & 7) ^ ((crow >> 1) & 7);
#define MG2_ISSUE(nt_) do { UNROLL for (int kt = 0; kt < 2; ++kt) UNROLL for (int i = 0; i < 4; ++i) \
                    GLDS16(DT + (size_t)((nt_) * 256 + ((crow + 64 * i) & ~31) + p32(crow & 31)) * 128 + kt * 64 + cch * 8, smem + kt * C::STG + C::AB + i * 8192 + tid * 16); } while (0)
            if (has_next && tid < 128) GLDS4(EW + lst2[tid], ew2 + tid);
            MG2_ISSUE(0);
            UNROLL for (int mi = 0; mi < 2; ++mi) {
                const int row = wm * 64 + mi * 32 + fr;
                const float gw = ew[row];
                float a[2][8];
                UNROLL for (int r = 0; r < 16; ++r) { const float gv = acc[mi][0][r], uv = acc[mi][1][r]; a[r >> 3][r & 7] = gv * frcp(1.f + __expf(-gv)) * uv * gw; }
                const int col0 = wn * 32 + 16 * fh, c0 = (col0 & 63) >> 3, swr = (row >> 1) & 7;
                char* arow_ = ACT + (col0 >> 6) * C::AB + row * 128;
                st8((bf16_t*)(arow_ + ((c0 ^ swr) << 4)), a[0]); st8((bf16_t*)(arow_ + (((c0 + 1) ^ swr) << 4)), a[1]);
            }
            __syncthreads();
            {
                const int sw = (fr >> 1) & 7, a_base = (wm * 64 + fr) * 128, b_base = (wn * 64 + fr) * 128;
                asm volatile("s_waitcnt vmcnt(0)" ::: "memory");
                _Pragma("unroll 1") for (int nt = 0; nt < 4; ++nt) {
                    __builtin_amdgcn_s_barrier();
                    asm volatile("" ::: "memory");
                    acc_zero(acc);
                    UNROLL for (int kt = 0; kt < 2; ++kt) {
                        const char* As_ = ACT + kt * C::AB; const char* Bs_ = smem + kt * C::STG + C::AB;
                        UNROLL for (int ks = 0; ks < 4; ++ks) {
                            const int off = ((2 * ks + fh) ^ sw) * 16;
                            bf16x8 af[2], bfv[2];
                            UNROLL for (int mi = 0; mi < 2; ++mi) af[mi] = *(const bf16x8*)(As_ + a_base + mi * 4096 + off);
                            UNROLL for (int ni = 0; ni < 2; ++ni) bfv[ni] = *(const bf16x8*)(Bs_ + b_base + ni * 4096 + off);
                            UNROLL for (int mi = 0; mi < 2; ++mi) UNROLL for (int ni = 0; ni < 2; ++ni)
                                acc[mi][ni] = __builtin_amdgcn_mfma_f32_32x32x16_bf16(bfv[ni], af[mi], acc[mi][ni], 0, 0, 0);
                        }
                    }
                    asm volatile("s_waitcnt lgkmcnt(0)" ::: "memory");
                    __builtin_amdgcn_s_barrier();
                    asm volatile("" ::: "memory");
                    if (nt < 3) MG2_ISSUE(nt + 1);
                    asm volatile("" ::: "memory");
                    UNROLL for (int mi = 0; mi < 2; ++mi) {
                        bf16_t* yrow = YBUF + (size_t)(lst[wm * 64 + mi * 32 + fr] - cb * 8) * 1024 + nt * 256 + wn * 64 + 16 * fh;
                        UNROLL for (int ni = 0; ni < 2; ++ni) {
                            float v0[8], v1[8];
                            UNROLL for (int i = 0; i < 8; ++i) { v0[i] = acc[mi][ni][i]; v1[i] = acc[mi][ni][8 + i]; }
                            st8(yrow + ni * 32, v0); st8(yrow + ni * 32 + 8, v1);
                        }
                    }
                    asm volatile("s_waitcnt vmcnt(8)" ::: "memory");
                }
#undef MG2_ISSUE
            }
        }
        cur ^= 1;
    }
#undef GLDS4
}


#define XB_TMO      128
#define XB_XCNT(j)  (256  + 64 * (j))
#define XB_XSUB(j)  (1280 + 64 * (j))
#define XB_XGEN(j)  (2304 + 64 * (j))
#define XB_TOP      3328
#define XB_TOPGEN   3392
#define XCD_BAR_WORDS 3456
#define XB_SPIN_CAP (1u << 18)
#define LAS __attribute__((address_space(3)))

__device__ __forceinline__ unsigned xb_ld(unsigned* p)              { return __hip_atomic_load(p, __ATOMIC_RELAXED, __HIP_MEMORY_SCOPE_AGENT); }
__device__ __forceinline__ unsigned xb_add(unsigned* p, unsigned v) { return __hip_atomic_fetch_add(p, v, __ATOMIC_RELAXED, __HIP_MEMORY_SCOPE_AGENT); }
__device__ __forceinline__ unsigned xb_xcc_id() { return (unsigned)__builtin_amdgcn_s_getreg((3 << 11) | 20) & 0xFu; }
#define XB_SPIN(cond, bar) do { unsigned _sp = 0; while (cond) { __builtin_amdgcn_s_sleep(1); \
    if ((++_sp & 255u) == 0u) { if (xb_ld(&(bar)[XB_TMO])) break; if (_sp > XB_SPIN_CAP) { atomicAdd(&(bar)[XB_TMO], 1u); break; } } } } while (0)

struct XcdBarrier { unsigned* bar; unsigned x; volatile LAS unsigned* st; };

__device__ __forceinline__ XcdBarrier xcd_barrier_post(unsigned* bar, volatile LAS unsigned* st) {
    XcdBarrier b; b.bar = bar; b.x = xb_xcc_id(); b.st = st;
    if (threadIdx.x == 0) { const unsigned rank = xb_add(&bar[XB_XCNT(b.x)], 1u); st[2] = b.x; st[3] = rank; }
    return b;
}
__device__ __forceinline__ void xcd_barrier_complete(unsigned* bar, unsigned x, unsigned& nloc, unsigned& nx) {
    const unsigned G = gridDim.x * gridDim.y * gridDim.z;
    unsigned sum, cnt, mine, sp = 0u;
    for (;;) {
        sum = 0u; cnt = 0u; mine = 0u;
#pragma unroll
        for (unsigned j = 0; j < 16; ++j) { const unsigned c = xb_ld(&bar[XB_XCNT(j)]); sum += c; cnt += (c > 0u) ? 1u : 0u; mine = (j == x) ? c : mine; }
        if (sum == G) break;
        __builtin_amdgcn_s_sleep(1);
        if ((++sp & 255u) == 0u) { if (xb_ld(&bar[XB_TMO])) break; if (sp > XB_SPIN_CAP) { atomicAdd(&bar[XB_TMO], 1u); break; } }
    }
    nloc = mine > 0u ? mine : 1u; nx = cnt > 0u ? cnt : 1u;
}
__device__ __forceinline__ void xcd_barrier(const XcdBarrier& b) {
    asm volatile("s_waitcnt vmcnt(0)" ::: "memory");
    __syncthreads();
    if (threadIdx.x == 0) {
        unsigned* bar = b.bar;
        __builtin_amdgcn_s_waitcnt(0);
        unsigned nloc = b.st[0], nx = b.st[1];
        if (nloc == 0u) { xcd_barrier_complete(bar, b.x, nloc, nx); b.st[0] = nloc; b.st[1] = nx; }
        const unsigned old = xb_add(&bar[XB_XSUB(b.x)], 1u);
        const unsigned gen = old / nloc;
        if (old + 1u == (gen + 1u) * nloc) {
            __builtin_amdgcn_fence(__ATOMIC_RELEASE, "agent");
            asm volatile("s_waitcnt vmcnt(0)" ::: "memory");
            const unsigned og = xb_add(&bar[XB_TOP], 1u);
            const unsigned tg = og / nx;
            if (og + 1u == (tg + 1u) * nx) xb_add(&bar[XB_TOPGEN], 1u);
            else XB_SPIN(xb_ld(&bar[XB_TOPGEN]) == tg, bar);
            __builtin_amdgcn_fence(__ATOMIC_ACQUIRE, "agent");
            xb_add(&bar[XB_XGEN(b.x)], 1u);
            asm volatile("s_waitcnt vmcnt(0)" ::: "memory");
        } else {
            XB_SPIN(xb_ld(&bar[XB_XGEN(b.x)]) == gen, bar);
            __builtin_amdgcn_fence(__ATOMIC_ACQUIRE, "agent");
            asm volatile("s_waitcnt vmcnt(0)" ::: "memory");
        }
    }
    __syncthreads();
}

enum { PH_MODCONV = 0, PH_HX, PH_GEMM_R, PH_RW_PREP, PH_RW_SCAN, PH_RW_READ, PH_RW_G, PH_GEMM_N, PH_NA_NORM, PH_NA_ATT, PH_GEMM_M, PH_ML_SCAN, PH_ML_READ,
       PH_GEMM_G, PH_MERGE, PH_OUT, PH_NORM2, PH_ROUTER, PH_ROUTE, PH_SHARED, PH_MOE_EXP, PH_MOE_COMB, PH_COUNT };

template <int PH> DEV void run_phase(const Params& p, int L, int sub, char* smem, Topo tp) {
    const int tid = TID(), lane = tid & 63, fr = lane & 31, fh = lane >> 5;
    char* ws = p.ws;
    const int ntl = L == 0 ? NT : NX;
    const bf16_t* HX = (const bf16_t*)(ws + OFF_HX);
    const bf16_t* WINT = (const bf16_t*)(ws + OFF_WINT);
    if constexpr (PH == PH_MODCONV) { ph_mod(p, L, smem); ph_conv_mix(p, L, smem); }
    else if constexpr (PH == PH_HX) { ph_norm(p, L, 0, NT); }
    else if constexpr (PH == PH_GEMM_R || PH == PH_GEMM_M) {
        const int c0 = PH == PH_GEMM_R ? 0 : RW_COLS + NA_COLS;
        const int N = PH == PH_GEMM_R ? RW_COLS : ML_COLS;
        bf16_t* PX = (bf16_t*)(ws + OFF_PX);
        gemm256(HX, NT, WINT + (size_t)c0 * DM, N, DM, smem, tp, [&](int row, int col, const float (&v)[8]) {
            if (col < N) st8(PX + (size_t)row * N + col, v);
        });
    }
    else if constexpr (PH == PH_GEMM_N) {
        bf16_t* PX = (bf16_t*)(ws + OFF_PX); bf16_t* VT = (bf16_t*)(ws + OFF_VT); bf16_t* VTC = (bf16_t*)(ws + OFF_VTC);
        gemm256(HX, NT, WINT + (size_t)RW_COLS * DM, 1024, DM, smem, tp, [&](int row, int col, const float (&v)[8]) { st8(PX + (size_t)row * 1024 + col, v); });
        gemm_phase<4, 2>(HX, DM, NT, WINT + (size_t)(RW_COLS + 1024) * DM, DM, 512, DM, smem, tp, [&](const f32x16 (&acc)[2][2], int row0, int col0) {
            const int h = col0 >> 6;
            epi_cols(acc, smem, [&](int r8, int col, const float (&v)[8]) {
                const int n = row0 + r8;
                bf16_t* dst = n < NX ? VT + ((size_t)((n >> 11) * 8 + h) * 64 + col) * SEQ + (n & 2047)
                                     : VTC + ((size_t)(((n - NX) >> 8) * 8 + h) * 64 + col) * CTXL + ((n - NX) & 255);
                st8(dst, v);
            });
        });
    }
    else if constexpr (PH == PH_RW_PREP) { ph_rw_prep(p, L, smem); }
    else if constexpr (PH == PH_RW_SCAN) { ph_rw_scan(p, L, smem); }
    else if constexpr (PH == PH_RW_READ) { ph_rw_read(p, L, ntl); }
    else if constexpr (PH == PH_RW_G) {
        bf16_t* YA = (bf16_t*)(ws + OFF_YA);
        gemm_phase<4, 2>((const bf16_t*)(ws + OFF_SGB), 128, ntl, (const bf16_t*)(ws + OFF_G2T), 128, 512, 128, smem, tp, [&](const f32x16 (&acc)[2][2], int row0, int col0) {
            epi_rows(acc, smem, [&](int row, int c8, const float (&v)[8]) {
                bf16_t* q = YA + (size_t)(row0 + row) * 512 + col0 + c8;
                float y[8]; ld8(q, y);
                UNROLL for (int i = 0; i < 8; ++i) y[i] *= v[i];
                st8(q, y);
            });
        });
    }
    else if constexpr (PH == PH_NA_NORM) { ph_na_norm(p, L); }
    else if constexpr (PH == PH_NA_ATT) { ph_na_att(p, L, smem); }
    else if constexpr (PH == PH_ML_SCAN) {
        if (blockIdx.x < 128 || gridDim.x <= 128) ph_ml_scan(p, L, smem);
        if (gridDim.x <= 128) ph_conv_moe_gu(p, L, smem, blockIdx.x, gridDim.x);
        else if (blockIdx.x >= 128) ph_conv_moe_gu(p, L, smem, blockIdx.x - 128, gridDim.x - 128);
    }
    else if constexpr (PH == PH_ML_READ) { ph_ml_read(p, L, ntl); }
    else if constexpr (PH == PH_GEMM_G) {
        bf16_t* G = (bf16_t*)(ws + OFF_GATES);
        gemm256(HX, ntl, WINT + (size_t)(RW_COLS + NA_COLS + ML_COLS) * DM, GATE_COLS, DM, smem, tp, [&](int row, int col, const float (&v)[8]) {
            float y[8];
            UNROLL for (int i = 0; i < 8; ++i) y[i] = sigm(v[i]);
            st8(G + (size_t)row * GATE_COLS + col, y);
        });
    }
    else if constexpr (PH == PH_MERGE) {
        const bf16_t* G = (const bf16_t*)(ws + OFF_GATES); bf16_t* MG = (bf16_t*)(ws + OFF_HX);
        _Pragma("unroll 1") for (int br = 0; br < 3; ++br) {
            gemm256((const bf16_t*)(ws + OFF_YA + (size_t)br * SZ_Y1), ntl, (const bf16_t*)(ws + OFF_WBT) + (size_t)br * 1024 * 512, DM, 512, smem, tp, [&](int row, int col, const float (&v)[8]) {
                float g[8], m[8];
                ld8(G + (size_t)row * GATE_COLS + br * DM + col, g);
                bf16_t* q = MG + (size_t)row * DM + col;
                if (br == 0) { UNROLL for (int i = 0; i < 8; ++i) m[i] = g[i] * v[i]; }
                else { ld8(q, m); UNROLL for (int i = 0; i < 8; ++i) m[i] += g[i] * v[i]; }
                st8(q, m);
            });
        }
    }
    else if constexpr (PH == PH_OUT) {
        const float* MOD = (const float*)(ws + OFF_MOD);
        gemm256(HX, ntl, (const bf16_t*)(ws + OFF_WOUTT), DM, DM, smem, tp, [&](int n, int c, const float (&v)[8]) {
            const float* xp = xprev_row(p, L, n) + c; float* xo = xs_row(p, n) + c; const float* g1 = MOD + mod_row(n) * 6144 + 2 * DM + c;
            const float4 xa = *(const float4*)xp, xb = *(const float4*)(xp + 4), ga = *(const float4*)g1, gb = *(const float4*)(g1 + 4);
            float4 oa, ob;
            oa.x = xa.x + ga.x * v[0]; oa.y = xa.y + ga.y * v[1]; oa.z = xa.z + ga.z * v[2]; oa.w = xa.w + ga.w * v[3];
            ob.x = xb.x + gb.x * v[4]; ob.y = xb.y + gb.y * v[5]; ob.z = xb.z + gb.z * v[6]; ob.w = xb.w + gb.w * v[7];
            *(float4*)xo = oa; *(float4*)(xo + 4) = ob;
        });
    }
    else if constexpr (PH == PH_NORM2) {
        if (blockIdx.x == 0 && tid < 384) ((int*)(ws + OFF_MCNT))[tid] = 0;
        ph_norm(p, L, 1, ntl);
    }
    else if constexpr (PH == PH_ROUTER) {
        typedef GC<4, 2> C;
        float* LOG = (float*)(ws + OFF_LOG);
        const bf16_t* H2LO = (const bf16_t*)(ws + OFF_H2LO); const bf16_t* RH = (const bf16_t*)(ws + OFF_RTR); const bf16_t* RL = RH + 64 * 1024;
        const int wave = tid >> 6, wm = wave / 2, wn = wave % 2;
        {
            const int nrt = ntl / C::BM, G = gridDim.x;
            if (G > nrt) { if ((int)blockIdx.x >= nrt) ph_conv_moe(p, L, smem, blockIdx.x - nrt, G - nrt); }
            else ph_conv_moe(p, L, smem, blockIdx.x, G);
        }
        for (int t = blockIdx.x; t < ntl / C::BM; t += gridDim.x) {
            f32x16 acc[2][2]; acc_zero(acc);
            const bf16_t* A0 = HX + (size_t)t * C::BM * DM; const bf16_t* A1 = H2LO + (size_t)t * C::BM * DM;
            gemm_tile<4, 2, 3, false>(acc, [&](int r) { return A0 + (size_t)r * DM; }, RH, DM, 0, 64, DM, smem, nullptr);
            gemm_tile<4, 2, 3, false>(acc, [&](int r) { return A1 + (size_t)r * DM; }, RH, DM, 0, 64, DM, smem, nullptr);
            gemm_tile<4, 2, 3, false>(acc, [&](int r) { return A0 + (size_t)r * DM; }, RL, DM, 0, 64, DM, smem, nullptr);
            epi_rows(acc, smem, [&](int row, int c8, const float (&v)[8]) {
                if (wn == 0) {
                    float* q = LOG + (size_t)(t * C::BM + wm * 64 + row) * 64 + c8;
                    *(float4*)q = make_float4(v[0], v[1], v[2], v[3]); *(float4*)(q + 4) = make_float4(v[4], v[5], v[6], v[7]);
                }
            });
        }
    }
    else if constexpr (PH == PH_ROUTE) { ph_route(p, L, ntl, smem); }
    else if constexpr (PH == PH_SHARED) {
        ph_moe_scatter(p, ntl, smem);
        bf16_t* SA = (bf16_t*)(ws + OFF_SA);
        gemm256_pair(HX, ntl, (const bf16_t*)(ws + OFF_SGUT), 512, DM, smem, tp, [&](int row, int col, const float (&g)[8], const float (&u)[8]) {
            float a[8];
            UNROLL for (int i = 0; i < 8; ++i) a[i] = g[i] * frcp(1.f + __expf(-g[i])) * u[i];
            st8(SA + (size_t)row * 256 + (col >> 8) * 128 + (col & 127), a);
        });
    }
    else if constexpr (PH == PH_MOE_EXP) { const int cb = sub * MOE_CHUNK; ph_moe_exp(p, cb, min(cb + MOE_CHUNK, ntl), smem, tp); }
    else if constexpr (PH == PH_MOE_COMB) {
        const int cb = sub * MOE_CHUNK, ce = min(cb + MOE_CHUNK, ntl);
        const float* MOD = (const float*)(ws + OFF_MOD); const bf16_t* YBUF = (const bf16_t*)(ws + OFF_YBUF);
        gemm256((const bf16_t*)(ws + OFF_SA) + (size_t)cb * 256, ce - cb, (const bf16_t*)(ws + OFF_SDT), DM, 256, smem, tp, [&](int rl, int c, const float (&v)[8]) {
            const int n = cb + rl;
            float s[8];
            UNROLL for (int i = 0; i < 8; ++i) s[i] = v[i];
            _Pragma("unroll 2") for (int k = 0; k < 8; ++k) { float y[8]; ld8(YBUF + ((size_t)rl * 8 + k) * DM + c, y); UNROLL for (int i = 0; i < 8; ++i) s[i] += y[i]; }
            float* xo = xs_row(p, n) + c; const float* g2 = MOD + mod_row(n) * 6144 + 5 * DM + c;
            float4 xa = *(const float4*)xo, xb = *(const float4*)(xo + 4); const float4 ga = *(const float4*)g2, gb = *(const float4*)(g2 + 4);
            xa.x += ga.x * s[0]; xa.y += ga.y * s[1]; xa.z += ga.z * s[2]; xa.w += ga.w * s[3];
            xb.x += gb.x * s[4]; xb.y += gb.y * s[5]; xb.z += gb.z * s[6]; xb.w += gb.w * s[7];
            *(float4*)xo = xa; *(float4*)(xo + 4) = xb;
        });
    }
}

#ifndef N_LAUNCH_MODE
#define N_LAUNCH_MODE 1
#endif
#if N_LAUNCH_MODE == 0
template <int PH> __global__ void __launch_bounds__(NTHREADS, 2) k_phase(Params p, int L, int sub) {
    extern __shared__ __attribute__((aligned(16))) char smem[];
    run_phase<PH>(p, L, sub, smem, Topo{(int)(blockIdx.x & 7), (int)(blockIdx.x >> 3), (int)((gridDim.x + 7 - (blockIdx.x & 7)) >> 3)});
}
#endif


#ifndef MEGA_SKIP
#define MEGA_SKIP 0ull
#endif
#ifndef MEGA_REPEAT
#define MEGA_REPEAT 0ull
#endif
#define BARRIER() do { XcdBarrier b2_ = bar; unsigned so_ = LDS_BYTES; asm volatile("" : "+v"(so_)); b2_.st = (volatile LAS unsigned*)(smem + so_); xcd_barrier(b2_); } while (0)
#define PHASE(PH, sub) do { if constexpr (!((MEGA_SKIP >> PH) & 1ull)) { run_phase<PH>(p, L, sub, smem, tp); BARRIER(); if constexpr ((MEGA_REPEAT >> PH) & 1ull) { run_phase<PH>(p, L, sub, smem, tp); BARRIER(); } } } while (0)
__global__ void __launch_bounds__(NTHREADS, 2) k_mega(Params p) {
    extern __shared__ __attribute__((aligned(16))) char smem[];
    volatile LAS unsigned* st = (volatile LAS unsigned*)(smem + LDS_BYTES);
    if (threadIdx.x == 0) { st[0] = 0u; st[1] = 0u; st[2] = 0u; st[3] = 0u; }
    __syncthreads();
    const XcdBarrier bar = xcd_barrier_post((unsigned*)(p.ws + OFF_BAR), st);
    Topo tp{(int)(blockIdx.x & 7), (int)(blockIdx.x >> 3), (int)((gridDim.x + 7 - (blockIdx.x & 7)) >> 3)};
    for (int L = 0; L < 2; ++L) {
        const int ntl = L == 0 ? NT : NX;
        PHASE(PH_MODCONV, 0);
        if (st[1] == 8u && st[0] != 0u) { tp.x = (int)st[2]; tp.r = (int)st[3]; tp.n = (int)st[0]; }
        PHASE(PH_HX, 0);
        PHASE(PH_GEMM_R, 0);
        PHASE(PH_RW_PREP, 0);
        PHASE(PH_RW_SCAN, 0);
        PHASE(PH_RW_READ, 0);
        PHASE(PH_RW_G, 0);
        PHASE(PH_GEMM_N, 0);
        PHASE(PH_NA_ATT, 0);
        PHASE(PH_GEMM_M, 0);
        PHASE(PH_ML_SCAN, 0);
        PHASE(PH_ML_READ, 0);
        PHASE(PH_GEMM_G, 0);
        PHASE(PH_MERGE, 0);
        PHASE(PH_OUT, 0);
        PHASE(PH_NORM2, 0);
        PHASE(PH_ROUTER, 0);
        PHASE(PH_ROUTE, 0);
        PHASE(PH_SHARED, 0);
        for (int c = 0; c * MOE_CHUNK < ntl; ++c) {
            PHASE(PH_MOE_EXP, c);
            PHASE(PH_MOE_COMB, c);
        }
    }
}

#if N_LAUNCH_MODE == 0
template <int PH> static void launch_phase(const Params& p, int L, int sub, hipStream_t stream) {
    static bool attr = false;
    if (!attr) { (void)hipFuncSetAttribute((const void*)k_phase<PH>, hipFuncAttributeMaxDynamicSharedMemorySize, LDS_BYTES); attr = true; }
    hipLaunchKernelGGL(k_phase<PH>, dim3(256), dim3(NTHREADS), LDS_BYTES, stream, p, L, sub);
}
#endif

extern "C" void kernel_launch(void* const* d_in, const int* in_sizes, int n_in, void* d_out, int out_size, void* d_ws, size_t ws_size, hipStream_t stream) {
    if (n_in != N_IN || ws_size < WS_END) { fprintf(stderr, "kernel_launch: unexpected inputs (%d) or workspace (%zu < %zu)\n", n_in, ws_size, (size_t)WS_END); return; }
    Params p{};
    for (int i = 0; i < N_IN; ++i) p.in[i] = (const float*)d_in[i];
    p.out = (float*)d_out; p.ws = (char*)d_ws;
#if N_LAUNCH_MODE == 1
    static int grid = 0;
    if (grid == 0) {
        int dev = 0, cus = 0;
        if (hipGetDevice(&dev) != hipSuccess || hipDeviceGetAttribute(&cus, hipDeviceAttributeMultiprocessorCount, dev) != hipSuccess) { grid = -1; return; }
        if (hipFuncSetAttribute((const void*)k_mega, hipFuncAttributeMaxDynamicSharedMemorySize, LDS_BYTES + 256) != hipSuccess) { grid = -1; return; }
        grid = cus;
    }
    if (grid <= 0) return;
    (void)hipMemsetAsync((char*)d_ws + OFF_BAR, 0, XCD_BAR_WORDS * sizeof(unsigned), stream);
    hipLaunchKernelGGL(k_mega, dim3(grid), dim3(NTHREADS), LDS_BYTES + 256, stream, p);
    return;
#endif
#if N_LAUNCH_MODE == 0
    for (int L = 0; L < 2; ++L) {
        const int ntl = L == 0 ? NT : NX;
        launch_phase<PH_MODCONV>(p, L, 0, stream);
        launch_phase<PH_HX>(p, L, 0, stream);
        launch_phase<PH_GEMM_R>(p, L, 0, stream);
        launch_phase<PH_RW_PREP>(p, L, 0, stream);
        launch_phase<PH_RW_SCAN>(p, L, 0, stream);
        launch_phase<PH_RW_READ>(p, L, 0, stream);
        launch_phase<PH_RW_G>(p, L, 0, stream);
        launch_phase<PH_GEMM_N>(p, L, 0, stream);
        launch_phase<PH_NA_ATT>(p, L, 0, stream);
        launch_phase<PH_GEMM_M>(p, L, 0, stream);
        launch_phase<PH_ML_SCAN>(p, L, 0, stream);
        launch_phase<PH_ML_READ>(p, L, 0, stream);
        launch_phase<PH_GEMM_G>(p, L, 0, stream);
        launch_phase<PH_MERGE>(p, L, 0, stream);
        launch_phase<PH_OUT>(p, L, 0, stream);
        launch_phase<PH_NORM2>(p, L, 0, stream);
        launch_phase<PH_ROUTER>(p, L, 0, stream);
        launch_phase<PH_ROUTE>(p, L, 0, stream);
        launch_phase<PH_SHARED>(p, L, 0, stream);
        for (int c = 0; c * MOE_CHUNK < ntl; ++c) {
            launch_phase<PH_MOE_EXP>(p, L, c, stream);
            launch_phase<PH_MOE_COMB>(p, L, c, stream);
        }
    }
#endif
}
```

```cpp
#include <hip/hip_runtime.h>
#include <stdint.h>
#include <stdio.h>

#define DEV __device__ __forceinline__
#define UNROLL _Pragma("unroll")

typedef unsigned short bf16_t;
typedef short bf16x8 __attribute__((ext_vector_type(8)));
typedef float f32x16 __attribute__((ext_vector_type(16)));
typedef float f32x4v __attribute__((ext_vector_type(4)));
typedef unsigned u32x4 __attribute__((ext_vector_type(4)));
typedef unsigned u32x2 __attribute__((ext_vector_type(2)));

constexpr int DM = 1024, NBATCH = 16, SEQ = 2048, CTXL = 256;
constexpr int NX = NBATCH * SEQ, NC = NBATCH * CTXL, NT = NX + NC;
constexpr int RW_COLS = 1920, NA_COLS = 1536, ML_COLS = 1552, GATE_COLS = 3072, IN_COLS = 8080;
constexpr int NTHREADS = 512;
constexpr int MOE_CHUNK = 12288, MOE_ST = 768;

enum { I_X = 0, I_C, I_CTX, I_CCTX, I_WADA, I_BADA, I_N1G, I_N2G, I_WIN, I_MU, I_W0, I_W2, I_A0, I_A2, I_KK, I_KA, I_RK, I_G2,
       I_LNG, I_LNB, I_V0, I_V1, I_V2, I_QNG, I_KNG, I_RPB, I_IB, I_FB, I_MNG, I_WBR, I_WOUT, I_RTR, I_MB, I_MWG, I_MWU, I_MWD,
       I_SG, I_SU, I_SD, N_IN };

constexpr size_t OFF_BAR = 0;
constexpr size_t OFF_MOD = 16384;
constexpr size_t OFF_WINT = OFF_MOD + 417792;
constexpr size_t OFF_WBT = OFF_WINT + (size_t)IN_COLS * 1024 * 2;
constexpr size_t OFF_WOUTT = OFF_WBT + (size_t)3 * 1024 * 512 * 2;
constexpr size_t OFF_SGUT = OFF_WOUTT + (size_t)1024 * 1024 * 2;
constexpr size_t OFF_SDT = OFF_SGUT + (size_t)512 * 1024 * 2;
constexpr size_t OFF_G2T = OFF_SDT + (size_t)1024 * 256 * 2;
constexpr size_t OFF_RTR = OFF_G2T + (size_t)512 * 128 * 2;
constexpr size_t OFF_CTXS = OFF_RTR + (size_t)2 * 64 * 1024 * 2;
constexpr size_t OFF_VF = OFF_CTXS + (size_t)NC * 1024 * 4;
constexpr size_t OFF_HX = OFF_VF + (size_t)NT * 512 * 2;
constexpr size_t OFF_BIG = OFF_HX + (size_t)NT * 1024 * 2;
constexpr size_t SZ_Y1 = (size_t)NT * 512 * 2;
constexpr size_t OFF_YA = OFF_BIG, OFF_YB = OFF_YA + SZ_Y1, OFF_YC = OFF_YB + SZ_Y1;
constexpr size_t OFF_PX = OFF_BIG + 3 * SZ_Y1;
constexpr size_t OFF_SCR = OFF_PX + (size_t)NT * RW_COLS * 2;
constexpr size_t SZ_SCR = (size_t)NT * 1152 * 2;
constexpr size_t OFF_MGU = OFF_SCR + SZ_SCR;
constexpr size_t WS_END = OFF_MGU + (size_t)64 * 256 * 1024 * 2;
constexpr size_t OFF_YS = OFF_YB;
constexpr size_t OFF_SGB = OFF_SCR;
constexpr size_t OFF_CB = OFF_SCR + (size_t)NT * 128 * 2;
constexpr size_t OFF_HS = OFF_SCR;
constexpr size_t OFF_VT = OFF_PX + (size_t)NT * 1024 * 2;
constexpr size_t OFF_VTC = OFF_VT + (size_t)NX * 512 * 2;
constexpr size_t OFF_GATES = OFF_PX;
constexpr size_t OFF_MDT = OFF_BIG;
constexpr size_t OFF_SA = OFF_MDT + (size_t)64 * 1024 * 128 * 2;
constexpr size_t OFF_EIDX = OFF_SA + (size_t)NT * 256 * 2;
constexpr size_t OFF_EW = OFF_EIDX + (size_t)NT * 8 * 4;
constexpr int SORT_CAP = 106496;
constexpr size_t OFF_SORT = OFF_EW + (size_t)NT * 8 * 4;
constexpr size_t OFF_LOG = OFF_SORT + (size_t)3 * SORT_CAP * 4;
constexpr size_t OFF_H2LO = OFF_LOG + (size_t)NT * 64 * 4;
constexpr size_t OFF_YBUF = OFF_LOG;
constexpr size_t OFF_YSC = OFF_YBUF + (size_t)MOE_CHUNK * 8 * 1024;
static_assert(OFF_YSC + (size_t)MOE_CHUNK * 512 <= WS_END, "moe layout");
static_assert(OFF_GATES + (size_t)NT * 3072 * 2 <= WS_END, "gates layout");
static_assert(WS_END <= (size_t)536870912, "workspace");

constexpr size_t OFF_MCNT = OFF_BAR + 14336;
constexpr int LDS_BYTES = 155648;

struct Topo { int x, r, n; };
struct Params {
    const float* in[N_IN];
    float* out;
    char* ws;
};

DEV int TID() { int t = threadIdx.x; asm volatile("" : "+v"(t)); return t; }
DEV float bf2f(bf16_t h) { return __uint_as_float(((unsigned)h) << 16); }
typedef __bf16 bf16x2n __attribute__((ext_vector_type(2)));
typedef float f32x2n __attribute__((ext_vector_type(2)));
DEV unsigned pk2(float lo, float hi) { const f32x2n v = {lo, hi}; return __builtin_bit_cast(unsigned, __builtin_convertvector(v, bf16x2n)); }
DEV bf16_t f2bf(float f) { return (bf16_t)(pk2(f, 0.f) & 0xffffu); }
DEV void ld8(const bf16_t* p, float (&o)[8]) {
    const u32x4 v = *(const u32x4*)p;
    o[0] = __uint_as_float(v.x << 16); o[1] = __uint_as_float(v.x & 0xffff0000u);
    o[2] = __uint_as_float(v.y << 16); o[3] = __uint_as_float(v.y & 0xffff0000u);
    o[4] = __uint_as_float(v.z << 16); o[5] = __uint_as_float(v.z & 0xffff0000u);
    o[6] = __uint_as_float(v.w << 16); o[7] = __uint_as_float(v.w & 0xffff0000u);
}
DEV void st8(bf16_t* p, const float (&v)[8]) {
    u32x4 o; o.x = pk2(v[0], v[1]); o.y = pk2(v[2], v[3]); o.z = pk2(v[4], v[5]); o.w = pk2(v[6], v[7]);
    *(u32x4*)p = o;
}
#define DPP_MOV(v, ctrl) __builtin_bit_cast(float, __builtin_amdgcn_update_dpp(0, __builtin_bit_cast(int, (v)), (ctrl), 0xF, 0xF, true))
DEV float sum8(float v) { v += DPP_MOV(v, 0xB1); v += DPP_MOV(v, 0x4E); v += DPP_MOV(v, 0x141); return v; }
DEV float frcp(float x) { return __builtin_amdgcn_rcpf(x); }
DEV float sigm(float x) { return frcp(1.f + __expf(-x)); }
DEV float sigm_acc(float x) { return 1.f / (1.f + expf(-x)); }
DEV float tanh_fast(float x) { return 1.f - 2.f * frcp(1.f + __expf(2.f * x)); }
DEV float softplus_fast(float x) { return fmaxf(x, 0.f) + __logf(1.f + __expf(-fabsf(x))); }
DEV int mod_row(int n) { return n < NX ? (n >> 11) : 16; }
DEV float* xs_row(const Params& p, int n) { return n < NX ? p.out + (size_t)n * DM : (float*)(p.ws + OFF_CTXS) + (size_t)(n - NX) * DM; }
DEV const float* xprev_row(const Params& p, int L, int n) {
    if (L == 0) return n < NX ? p.in[I_X] + (size_t)n * DM : p.in[I_CTX] + (size_t)(n - NX) * DM;
    return xs_row(p, n);
}
DEV void seq_of(int n, int& nb, int& tt, int& T) {
    if (n < NX) { nb = n & ~2047; tt = n & 2047; T = SEQ; } else { const int m = n - NX; nb = NX + (m & ~255); tt = m & 255; T = CTXL; }
}
DEV void shift8(const bf16_t* z, int ld, int nb, int tt, int T, int col0, const float* mu, float (&o)[8]) {
    float c[8], l[8], r[8];
    ld8(z + (size_t)(nb + tt) * ld + col0, c);
    if (tt > 0) ld8(z + (size_t)(nb + tt - 1) * ld + col0, l); else { UNROLL for (int i = 0; i < 8; ++i) l[i] = 0.f; }
    if (tt < T - 1) ld8(z + (size_t)(nb + tt + 1) * ld + col0, r); else { UNROLL for (int i = 0; i < 8; ++i) r[i] = 0.f; }
    UNROLL for (int i = 0; i < 8; ++i) o[i] = c[i] + mu[col0 + i] * (0.5f * (l[i] + r[i]) - c[i]);
}

constexpr int LROW = 144;
template <int WM, int WN> struct GC {
    static constexpr int BM = 64 * WM, BN = 64 * WN;
    static constexpr int AB = BM * 128, BB = BN * 128, STG = AB + BB;
    static constexpr int NA = BM / 64, NBC = BN / 64;
};
DEV void acc_zero(f32x16 (&acc)[2][2]) {
    UNROLL for (int a = 0; a < 2; ++a) UNROLL for (int b = 0; b < 2; ++b) UNROLL for (int r = 0; r < 16; ++r) acc[a][b][r] = 0.f;
}
#define GLDS16(gp, lp) __builtin_amdgcn_global_load_lds((const __attribute__((address_space(1))) void*)(gp), (__attribute__((address_space(3))) void*)(lp), 16, 0, 0)
DEV int p32(int s) { return 16 * ((s >> 2) & 1) + (s & 3) + 4 * (s >> 3); }
template <int WM, int WN, int NS, bool A_LDS, bool TR = false, class ARow>
DEV void gemm_tile(f32x16 (&acc)[2][2], ARow arow, const bf16_t* Bt, int ldb, int n0, int Nvalid, int K, char* smem, const char* alds) {
    typedef GC<WM, WN> C;
    constexpr int LPT = (A_LDS ? 0 : C::NA) + C::NBC;
    const int tid = TID(), lane = tid & 63, wave = tid >> 6, wm = wave / WN, wn = wave % WN;
    const int fr = lane & 31, fh = lane >> 5;
    const int crow = tid >> 3, cch = (tid & 7) ^ ((crow >> 1) & 7);
    const bf16_t* pa[C::NA]; const bf16_t* pb[C::NBC];
    if (!A_LDS) { UNROLL for (int i = 0; i < C::NA; ++i) pa[i] = arow(crow + 64 * i) + cch * 8; }
    UNROLL for (int i = 0; i < C::NBC; ++i) { const int rb = crow + 64 * i, n = min(n0 + (TR ? (rb & ~31) + p32(rb & 31) : rb), Nvalid - 1); pb[i] = Bt + (size_t)n * ldb + cch * 8; }
    const int nk = K >> 6;
#define GT_ISSUE(kt, stg) do { char* sb_ = smem + (stg) * C::STG + tid * 16; \
        if (!A_LDS) { UNROLL for (int i = 0; i < C::NA; ++i) GLDS16(pa[i] + (kt) * 64, sb_ + i * 8192); } \
        UNROLL for (int i = 0; i < C::NBC; ++i) GLDS16(pb[i] + (kt) * 64, sb_ + C::AB + i * 8192); } while (0)
    const int sw = (fr >> 1) & 7;
    int offk[4];
    UNROLL for (int ks = 0; ks < 4; ++ks) offk[ks] = ((2 * ks + fh) ^ sw) * 16;
    const int a_base = (wm * 64 + fr) * 128, b_base = (wn * 64 + fr) * 128;
    UNROLL for (int s = 0; s < NS - 1; ++s) if (s < nk) GT_ISSUE(s, s);
    int stg = 0, nstg = NS - 1;
    for (int kt = 0; kt < nk; ++kt) {
        if (NS == 3 && kt + 1 < nk) asm volatile("s_waitcnt vmcnt(%0)" :: "n"(LPT) : "memory");
        else asm volatile("s_waitcnt vmcnt(0)" ::: "memory");
        __builtin_amdgcn_s_barrier();
        asm volatile("" ::: "memory");
        const bool more = kt + NS - 1 < nk;
        const char* As_ = A_LDS ? alds + kt * C::AB : smem + stg * C::STG; const char* Bs_ = smem + stg * C::STG + C::AB;
        char* db_ = smem + nstg * C::STG + tid * 16;
        bf16x8 af[2][2], bfv[2][2];
        UNROLL for (int mi = 0; mi < 2; ++mi) af[0][mi] = *(const bf16x8*)(As_ + a_base + mi * 4096 + offk[0]);
        UNROLL for (int ni = 0; ni < 2; ++ni) bfv[0][ni] = *(const bf16x8*)(Bs_ + b_base + ni * 4096 + offk[0]);
        UNROLL for (int ks = 0; ks < 4; ++ks) {
            const int cur = ks & 1, nxt = cur ^ 1;
            if (ks < 3) {
                UNROLL for (int mi = 0; mi < 2; ++mi) af[nxt][mi] = *(const bf16x8*)(As_ + a_base + mi * 4096 + offk[ks + 1]);
                UNROLL for (int ni = 0; ni < 2; ++ni) bfv[nxt][ni] = *(const bf16x8*)(Bs_ + b_base + ni * 4096 + offk[ks + 1]);
            }
            UNROLL for (int mi = 0; mi < 2; ++mi) UNROLL for (int ni = 0; ni < 2; ++ni)
                acc[mi][ni] = TR ? __builtin_amdgcn_mfma_f32_32x32x16_bf16(bfv[cur][ni], af[cur][mi], acc[mi][ni], 0, 0, 0)
                                 : __builtin_amdgcn_mfma_f32_32x32x16_bf16(af[cur][mi], bfv[cur][ni], acc[mi][ni], 0, 0, 0);
            if (more) {
                UNROLL for (int pc = 0; pc < LPT; ++pc) if (pc * 4 / LPT == ks) {
                    if (!A_LDS && pc < C::NA) GLDS16(pa[pc] + (kt + NS - 1) * 64, db_ + pc * 8192);
                    else { const int ib = pc - (A_LDS ? 0 : C::NA); GLDS16(pb[ib] + (kt + NS - 1) * 64, db_ + C::AB + ib * 8192); }
                }
            }
            __builtin_amdgcn_sched_barrier(0);
        }
        stg = stg + 1 == NS ? 0 : stg + 1; nstg = nstg + 1 == NS ? 0 : nstg + 1;
    }
    __syncthreads();
#undef GT_ISSUE
}
#define ACC_ROW(mi, r, fh) ((mi) * 32 + ((r) & 3) + 8 * ((r) >> 2) + 4 * (fh))

constexpr int EPI_SLAB = 32 * 68 * 4;
template <class F> DEV void epi_rows(const f32x16 (&acc)[2][2], char* smem, F f) {
    const int lane = TID() & 63, wave = TID() >> 6, fr = lane & 31, fh = lane >> 5;
    float* st = (float*)(smem + wave * EPI_SLAB);
    UNROLL for (int mi = 0; mi < 2; ++mi) {
        UNROLL for (int ni = 0; ni < 2; ++ni) UNROLL for (int r = 0; r < 16; ++r)
            st[((r & 3) + 8 * (r >> 2) + 4 * fh) * 68 + ni * 32 + fr] = acc[mi][ni][r];
        UNROLL for (int it = 0; it < 4; ++it) {
            const int row = it * 8 + (lane >> 3), c8 = (lane & 7) * 8;
            const float4 a = *(const float4*)(st + row * 68 + c8), b = *(const float4*)(st + row * 68 + c8 + 4);
            float v[8] = {a.x, a.y, a.z, a.w, b.x, b.y, b.z, b.w};
            f(mi * 32 + row, c8, v);
        }
    }
    __syncthreads();
}


template <class F> DEV void epi_cols(const f32x16 (&acc)[2][2], char* smem, F f) {
    const int lane = TID() & 63, wave = TID() >> 6, fr = lane & 31, fh = lane >> 5;
    float* st = (float*)(smem + wave * EPI_SLAB);
    UNROLL for (int mi = 0; mi < 2; ++mi) {
        UNROLL for (int ni = 0; ni < 2; ++ni) UNROLL for (int r = 0; r < 16; ++r)
            st[((r & 3) + 8 * (r >> 2) + 4 * fh) * 68 + ni * 32 + fr] = acc[mi][ni][r];
        UNROLL for (int it = 0; it < 4; ++it) {
            float v[8];
            UNROLL for (int i = 0; i < 8; ++i) v[i] = st[(it * 8 + i) * 68 + lane];
            f(mi * 32 + it * 8, lane, v);
        }
    }
    __syncthreads();
}

struct TileOrder {
    int x, nN, cx, total;
    DEV TileOrder(const Topo& tp, int nM, int nN_) { x = tp.x; nN = nN_; cx = nM > x ? (nM - x + 7) >> 3 : 0; total = ((cx + 3) >> 2) * 4 * nN; }
    DEV bool get(int q, int& pm, int& pn) const { const int per = 4 * nN, qi = q / per, rem = q - qi * per, i = 4 * qi + (rem & 3); pn = rem >> 2; pm = x + 8 * i; return i < cx; }
};
template <int WM, int WN, class Epi>
DEV void gemm_phase(const bf16_t* A, int lda, int M, const bf16_t* Bt, int ldb, int N, int K, char* smem, const Topo& tp, Epi epi) {
    typedef GC<WM, WN> C;
    const int nM = M / C::BM, nN = (N + C::BN - 1) / C::BN;
    const int wave = TID() >> 6, wm = wave / WN, wn = wave % WN;
    const TileOrder ord(tp, nM, nN);
    for (int q = tp.r; q < ord.total; q += tp.n) {
        int pm, pn; if (!ord.get(q, pm, pn)) continue;
        f32x16 acc[2][2]; acc_zero(acc);
        const bf16_t* Ab = A + (size_t)pm * C::BM * lda;
        gemm_tile<WM, WN, 3, false>(acc, [&](int r) { return Ab + (size_t)r * lda; }, Bt, ldb, pn * C::BN, N, K, smem, nullptr);
        epi(acc, pm * C::BM + wm * 64, pn * C::BN + wn * 64);
    }
}

namespace pg8 {
#define PG8_LAS __attribute__((address_space(3)))
typedef float f32x4 __attribute__((ext_vector_type(4)));
constexpr int BM = 256, BK = 64, HALF = 128, HTB = HALF * BK * 2  , STAGE_BYTES = 8 * HTB, NXCD = 8, WGM = 8;

__host__ __device__ __forceinline__ int lds_byte(int r, int c) { const int st = (r >> 4) * 2 + (c >> 5), rr = r & 15, cc = c & 31, ob = rr * 64 + cc * 2; return st * 1024 + (ob ^ (((ob >> 9) & 1) << 5)); }
__host__ __device__ __forceinline__ void stage_rc(int b, int& R, int& C) { const int st = b / 1024, sb = b % 1024, swz = sb ^ (((sb >> 9) & 1) << 5); R = (st >> 1) * 16 + swz / 64; C = (st & 1) * 32 + (swz % 64) / 2; }
__host__ __device__ __forceinline__ int perm32(int rho) { const int n = rho >> 4, i = rho & 15; return 8 * (i >> 2) + 4 * n + (i & 3); }

struct Unit { int pm, pn; };
struct Gemm { const bf16_t* A; const bf16_t* Bt; int M, N, K; };
template <class Epi, class Sched, bool ALIGN_EPI = false, bool SP2 = false>
__device__ __forceinline__ void gemm_phase(PG8_LAS unsigned char* lds, const Gemm g, const Sched& S, const Epi& E) {
    const int tid = TID(), wid = __builtin_amdgcn_readfirstlane(tid >> 6), lane = tid & 63, wr = wid >> 2, wc = wid & 3, fr = lane & 15, fq = lane >> 4;
    const int K = g.K, nt = K / BK;
    unsigned voffA[2], voffB[2];
#pragma unroll
    for (int i = 0; i < 2; ++i) { int R, C; stage_rc(tid * 16 + i * 8192, R, C); const int Rb = Epi::PERM ? ((R & ~31) + perm32(R & 31)) : R;
        voffA[i] = (unsigned)(R * K + C) * 2u; voffB[i] = (unsigned)(Rb * K + C) * 2u; }
    const size_t kstep = (size_t)(BK * 2);
    const size_t hstep = (size_t)HALF * K * 2;
    const size_t tstep = 2 * hstep;
    const unsigned ldsw = (unsigned)wid * 1024u;
    const int aoff = lds_byte(wr * 64 + fr, fq * 8), boff = lds_byte(wc * 32 + fr, fq * 8);
#define PG8_SA(b, h) (((b) * 2 + (h)) * HTB)
#define PG8_SB(b, h) ((4 + (b) * 2 + (h)) * HTB)
#define PG8_STAGE(bufoff, gbase, voff) do { _Pragma("unroll") for (int _i = 0; _i < 2; ++_i) \
        __builtin_amdgcn_global_load_lds((const unsigned*)((const char*)(gbase) + (voff)[_i]), (PG8_LAS unsigned*)(lds + (bufoff) + ldsw + _i * 8192), 16, 0, 0); } while (0)
#define PG8_LDA(dst, b, h) do { _Pragma("unroll") for (int m = 0; m < 4; ++m) _Pragma("unroll") for (int k = 0; k < 2; ++k) dst[m][k] = *(const PG8_LAS bf16x8*)(lds + PG8_SA(b, h) + aoff + m * 2048 + k * 1024); } while (0)
#define PG8_LDB(dst, b, h) do { _Pragma("unroll") for (int n = 0; n < 2; ++n) _Pragma("unroll") for (int k = 0; k < 2; ++k) dst[n][k] = *(const PG8_LAS bf16x8*)(lds + PG8_SB(b, h) + boff + n * 2048 + k * 1024); } while (0)
#define PG8_MMA(ai, bj, At, Bt) do { __builtin_amdgcn_s_setprio(1); _Pragma("unroll") for (int m = 0; m < 4; ++m) _Pragma("unroll") for (int n = 0; n < 2; ++n) _Pragma("unroll") for (int k = 0; k < 2; ++k) \
        acc[ai][bj][m][n] = __builtin_amdgcn_mfma_f32_16x16x32_bf16(Bt[n][k], At[m][k], acc[ai][bj][m][n], 0, 0, 0); __builtin_amdgcn_s_setprio(0); } while (0)
#define PG8_WAIT_V(n) asm volatile("s_waitcnt vmcnt(" #n ")" ::: "memory")
#define PG8_WAIT_L(n) asm volatile("s_waitcnt lgkmcnt(" #n ")" ::: "memory")
#define PG8_BAR __builtin_amdgcn_s_barrier()
#define PG8_SCHED __builtin_amdgcn_sched_barrier(0)
    Unit cur, nxt; int ui = 0;
    if (!S.next(0, cur)) return;
    f32x4 acc[2][2][4][2];
#pragma unroll
    for (int a = 0; a < 2; ++a)
#pragma unroll
        for (int b = 0; b < 2; ++b)
#pragma unroll
            for (int m = 0; m < 4; ++m)
#pragma unroll
                for (int n = 0; n < 2; ++n) acc[a][b][m][n] = (f32x4){0.f, 0.f, 0.f, 0.f};
    bf16x8 At[4][2], B0[2][2], B1[2][2];
    const char* cA = (const char*)g.A + (size_t)cur.pm * tstep; const char* cB = (const char*)g.Bt + (size_t)cur.pn * tstep;
    S.a_ready(cur);
    if constexpr (SP2) {
        PG8_STAGE(PG8_SB(0, 0), cB, voffB); PG8_STAGE(PG8_SB(0, 1), cB + hstep, voffB); PG8_STAGE(PG8_SA(0, 0), cA, voffA); PG8_STAGE(PG8_SA(0, 1), cA + hstep, voffA);
        if (wr == 1) PG8_BAR;
        PG8_WAIT_V(2); PG8_BAR;
        PG8_STAGE(PG8_SB(1, 0), cB + kstep, voffB); PG8_STAGE(PG8_SA(1, 0), cA + kstep, voffA); PG8_STAGE(PG8_SB(1, 1), cB + hstep + kstep, voffB);
        PG8_WAIT_V(6); PG8_BAR;
    } else {
        PG8_STAGE(PG8_SB(0, 0), cB, voffB); PG8_STAGE(PG8_SA(0, 0), cA, voffA); PG8_STAGE(PG8_SB(0, 1), cB + hstep, voffB); PG8_STAGE(PG8_SA(0, 1), cA + hstep, voffA);
        if (wr == 1) PG8_BAR;
        PG8_WAIT_V(4); PG8_BAR;
        PG8_STAGE(PG8_SB(1, 0), cB + kstep, voffB); PG8_STAGE(PG8_SA(1, 0), cA + kstep, voffA); PG8_STAGE(PG8_SB(1, 1), cB + hstep + kstep, voffB);
        PG8_WAIT_V(6); PG8_BAR;
    }
    for (;;) {
        const bool has_next = S.next(ui + 1, nxt);
        const char* nA = has_next ? (const char*)g.A + (size_t)nxt.pm * tstep : cA; const char* nB = has_next ? (const char*)g.Bt + (size_t)nxt.pn * tstep : cB;
        for (int t = 0; t < nt; t += 2) {
            const bool last = (t == nt - 2);
            const char* a1 = cA + (size_t)(t + 1) * kstep;
            const char* a2 = last ? nA : cA + (size_t)(t + 2) * kstep; const char* b2 = last ? nB : cB + (size_t)(t + 2) * kstep;
            const char* a3 = a2 + kstep; const char* b3 = b2 + kstep;
            if (last && has_next) S.a_ready(nxt);
            if constexpr (SP2) {
            PG8_LDB(B0, 0, 0); PG8_LDB(B1, 0, 1); PG8_SCHED; PG8_LDA(At, 0, 0); PG8_STAGE(PG8_SA(1, 1), a1 + hstep, voffA);
            PG8_WAIT_V(8); PG8_WAIT_L(0); PG8_BAR; PG8_MMA(0, 0, At, B0); PG8_MMA(0, 1, At, B1); PG8_BAR; PG8_SCHED;
            PG8_LDA(At, 0, 1); PG8_STAGE(PG8_SB(0, 0), b2, voffB); PG8_STAGE(PG8_SB(0, 1), b2 + hstep, voffB); PG8_STAGE(PG8_SA(0, 0), a2, voffA);
            PG8_WAIT_V(8); PG8_WAIT_L(0); PG8_BAR; PG8_MMA(1, 0, At, B0); PG8_MMA(1, 1, At, B1); PG8_BAR; PG8_SCHED;
            PG8_LDB(B0, 1, 0); PG8_LDB(B1, 1, 1); PG8_SCHED; PG8_LDA(At, 1, 0); PG8_STAGE(PG8_SA(0, 1), a2 + hstep, voffA);
            PG8_WAIT_V(8); PG8_WAIT_L(0); PG8_BAR; PG8_MMA(0, 0, At, B0); PG8_MMA(0, 1, At, B1); PG8_BAR; PG8_SCHED;
            PG8_LDA(At, 1, 1); PG8_STAGE(PG8_SB(1, 0), b3, voffB); PG8_STAGE(PG8_SB(1, 1), b3 + hstep, voffB); PG8_STAGE(PG8_SA(1, 0), a3, voffA);
            PG8_WAIT_V(8); PG8_WAIT_L(0); PG8_BAR; PG8_MMA(1, 0, At, B0); PG8_MMA(1, 1, At, B1); PG8_BAR; PG8_SCHED;
            } else {
            PG8_LDB(B0, 0, 0); PG8_SCHED; PG8_LDA(At, 0, 0); PG8_STAGE(PG8_SA(1, 1), a1 + hstep, voffA);
            PG8_WAIT_L(8); PG8_BAR; PG8_WAIT_L(0); PG8_MMA(0, 0, At, B0); PG8_BAR; PG8_SCHED;
            PG8_LDB(B1, 0, 1); PG8_STAGE(PG8_SB(0, 0), b2, voffB);
            PG8_BAR; PG8_WAIT_L(0); PG8_MMA(0, 1, At, B1); PG8_BAR;
            PG8_LDA(At, 0, 1); PG8_STAGE(PG8_SA(0, 0), a2, voffA);
            PG8_BAR; PG8_WAIT_L(0); PG8_MMA(1, 0, At, B0); PG8_BAR; PG8_SCHED;
            PG8_STAGE(PG8_SB(0, 1), b2 + hstep, voffB);
            PG8_WAIT_V(6); PG8_BAR; PG8_MMA(1, 1, At, B1); PG8_BAR;
            PG8_LDB(B0, 1, 0); PG8_SCHED; PG8_LDA(At, 1, 0); PG8_STAGE(PG8_SA(0, 1), a2 + hstep, voffA);
            PG8_WAIT_L(8); PG8_BAR; PG8_WAIT_L(0); PG8_MMA(0, 0, At, B0); PG8_BAR; PG8_SCHED;
            PG8_LDB(B1, 1, 1); PG8_STAGE(PG8_SB(1, 0), b3, voffB);
            PG8_BAR; PG8_WAIT_L(0); PG8_MMA(0, 1, At, B1); PG8_BAR;
            PG8_LDA(At, 1, 1); PG8_STAGE(PG8_SA(1, 0), a3, voffA);
            PG8_BAR; PG8_WAIT_L(0); PG8_MMA(1, 0, At, B0); PG8_BAR; PG8_SCHED;
            PG8_STAGE(PG8_SB(1, 1), b3 + hstep, voffB);
            PG8_WAIT_V(6); PG8_BAR; PG8_MMA(1, 1, At, B1); PG8_BAR;
            }
        }
        if constexpr (ALIGN_EPI) { if (wr == 0) PG8_BAR; }
        if constexpr (!Epi::AFTER_DRAIN) { E(acc, cur, wr, wc, fr, fq); S.done(cur); }
        if (!has_next) break;
#pragma unroll
        for (int a = 0; a < 2; ++a)
#pragma unroll
            for (int b = 0; b < 2; ++b)
#pragma unroll
                for (int m = 0; m < 4; ++m)
#pragma unroll
                    for (int n = 0; n < 2; ++n) acc[a][b][m][n] = (f32x4){0.f, 0.f, 0.f, 0.f};
        cur = nxt; cA = nA; cB = nB; ++ui;
        if constexpr (ALIGN_EPI) { if (wr == 1) PG8_BAR; }
    }
    PG8_WAIT_V(0);
    if constexpr (!ALIGN_EPI) { if (wr == 0) PG8_BAR; }
    PG8_BAR;
    if constexpr (Epi::AFTER_DRAIN) { E.fused(acc, cur, wr, wc, fr, fq, lds, wid, lane); S.done(cur); }
#undef PG8_SA
#undef PG8_SB
#undef PG8_STAGE
#undef PG8_LDA
#undef PG8_LDB
#undef PG8_MMA
#undef PG8_WAIT_V
#undef PG8_WAIT_L
#undef PG8_BAR
#undef PG8_SCHED
}
}
template <class F> struct EpiF {
    static constexpr bool PERM = true, AFTER_DRAIN = false; F f;
    DEV void operator()(const pg8::f32x4 (&acc)[2][2][4][2], const pg8::Unit& u, int wr, int wc, int fr, int fq) const {
        UNROLL for (int ai = 0; ai < 2; ++ai) UNROLL for (int m = 0; m < 4; ++m) {
            const int row = u.pm * 256 + ai * 128 + wr * 64 + m * 16 + fr;
            UNROLL for (int bj = 0; bj < 2; ++bj) {
                const int col = u.pn * 256 + bj * 128 + wc * 32 + 8 * fq;
                const float v[8] = {acc[ai][bj][m][0][0], acc[ai][bj][m][0][1], acc[ai][bj][m][0][2], acc[ai][bj][m][0][3],
                                    acc[ai][bj][m][1][0], acc[ai][bj][m][1][1], acc[ai][bj][m][1][2], acc[ai][bj][m][1][3]};
                f(row, col, v);
            }
        }
    }
};
template <class F> struct EpiF2 {
    static constexpr bool PERM = true, AFTER_DRAIN = false; F f;
    DEV void operator()(const pg8::f32x4 (&acc)[2][2][4][2], const pg8::Unit& u, int wr, int wc, int fr, int fq) const {
        UNROLL for (int ai = 0; ai < 2; ++ai) UNROLL for (int m = 0; m < 4; ++m) {
            const int row = u.pm * 256 + ai * 128 + wr * 64 + m * 16 + fr, col = u.pn * 256 + wc * 32 + 8 * fq;
            const float v0[8] = {acc[ai][0][m][0][0], acc[ai][0][m][0][1], acc[ai][0][m][0][2], acc[ai][0][m][0][3], acc[ai][0][m][1][0], acc[ai][0][m][1][1], acc[ai][0][m][1][2], acc[ai][0][m][1][3]};
            const float v1[8] = {acc[ai][1][m][0][0], acc[ai][1][m][0][1], acc[ai][1][m][0][2], acc[ai][1][m][0][3], acc[ai][1][m][1][0], acc[ai][1][m][1][1], acc[ai][1][m][1][2], acc[ai][1][m][1][3]};
            f(row, col, v0, v1);
        }
    }
};
struct XOrder {
    int x, r, n, nN, cx, fullq, total;
    DEV XOrder(const Topo& tp, int nM, int nN_) { x = tp.x; r = tp.r; n = tp.n; nN = nN_; cx = nM > x ? (nM - x + 7) >> 3 : 0; fullq = cx >> 2; total = cx * nN; }
    DEV bool next(int i, pg8::Unit& u) const {
        const int q = r + i * n; if (q >= total) return false;
        const int per = 4 * nN;
        if (q < fullq * per) { const int qi = q / per, rem = q - qi * per; u.pn = rem >> 2; u.pm = x + 8 * (4 * qi + (rem & 3)); }
        else { const int rem = q - fullq * per, cq = cx - 4 * fullq; u.pn = rem / cq; u.pm = x + 8 * (4 * fullq + rem % cq); }
        return true;
    }
    DEV void a_ready(const pg8::Unit&) const {}
    DEV void done(const pg8::Unit&) const {}
};
template <class F> DEV void gemm256_pair(const bf16_t* A, int M, const bf16_t* Bt, int N, int K, char* smem, const Topo& tp, F f) {
    const pg8::Gemm g{A, Bt, M, N, K};
    const XOrder S(tp, M / 256, (N + 255) / 256);
    const EpiF2<F> E{f};
    pg8::gemm_phase<EpiF2<F>, XOrder, true, true>((PG8_LAS unsigned char*)smem, g, S, E);
}
template <class F> DEV void gemm256(const bf16_t* A, int M, const bf16_t* Bt, int N, int K, char* smem, const Topo& tp, F f) {
    const pg8::Gemm g{A, Bt, M, N, K};
    const XOrder S(tp, M / 256, (N + 255) / 256);
    const EpiF<F> E{f};
    pg8::gemm_phase<EpiF<F>, XOrder, true, true>((PG8_LAS unsigned char*)smem, g, S, E);
}

DEV void ph_mod(const Params& p, int L, char* smem) {
    const int tid = TID();
    float* sc = (float*)smem;
    float* red = sc + 17 * 1024;
    const float* c = p.in[I_C]; const float* cc = p.in[I_CCTX];
    for (int i = tid; i < 17 * 1024; i += NTHREADS) { const float v = i < 16 * 1024 ? c[i] : cc[i - 16 * 1024]; sc[i] = v / (1.f + expf(-v)); }
    __syncthreads();
    const float* W = p.in[I_WADA] + (size_t)L * 1024 * 6144; const float* bA = p.in[I_BADA] + (size_t)L * 6144;
    float* MOD = (float*)(p.ws + OFF_MOD);
    for (int u = blockIdx.x; u < 192; u += gridDim.x) {
        const int ci = tid & 31, ks = tid >> 5, j = u * 32 + ci;
        float acc[17];
        UNROLL for (int r = 0; r < 17; ++r) acc[r] = 0.f;
        for (int k = ks * 64; k < ks * 64 + 64; ++k) {
            const float w = W[(size_t)k * 6144 + j];
            UNROLL for (int r = 0; r < 17; ++r) acc[r] += sc[r * 1024 + k] * w;
        }
        UNROLL for (int r = 0; r < 17; ++r) red[(ks * 17 + r) * 32 + ci] = acc[r];
        __syncthreads();
        for (int i = tid; i < 17 * 32; i += NTHREADS) {
            const int r = i >> 5, c2 = i & 31; float s = bA[u * 32 + c2];
            for (int k2 = 0; k2 < 16; ++k2) s += red[(k2 * 17 + r) * 32 + c2];
            MOD[r * 6144 + u * 32 + c2] = s;
        }
        __syncthreads();
    }
}
DEV void conv_job(const float* s0, const float* s1, bf16_t* d, int K, int N, int mode, int nmat, size_t sstride, size_t dstride, char* smem, int bid = -1, int nb = 0) {
    if (bid < 0) { bid = blockIdx.x; nb = gridDim.x; }
    float* tile = (float*)smem;
    const int tid = TID();
    const int tK = K / 64, tN = (mode == 1 || mode == 3) ? (2 * N) / 64 : (N + 63) / 64, per = tK * tN;
    for (int t = bid; t < per * nmat; t += nb) {
        const int mat = t / per, r = t % per, tk = r / tN, tn = r % tN;
        const float* a0 = s0 + (size_t)mat * sstride; const float* a1 = s1 ? s1 + (size_t)mat * sstride : nullptr;
        bf16_t* dd = d + (size_t)mat * dstride;
        UNROLL for (int i = 0; i < 8; ++i) {
            const int cc = tid & 63, k = (tid >> 6) + 8 * i; float v;
            if (mode == 1) { const float* s = (cc >> 5) ? a1 : a0; v = s[(size_t)(tk * 64 + k) * N + tn * 32 + (cc & 31)]; }
            else if (mode == 3) { const float* s = ((tn >> 1) & 1) ? a1 : a0; v = s[(size_t)(tk * 64 + k) * N + (tn >> 2) * 128 + (tn & 1) * 64 + cc]; }
            else { const int n = tn * 64 + cc; v = n < N ? a0[(size_t)(tk * 64 + k) * N + n] : 0.f; }
            tile[k * 65 + cc] = v;
        }
        __syncthreads();
        UNROLL for (int i = 0; i < 8; ++i) {
            const int k = tid & 63, cc = (tid >> 6) + 8 * i; const int row = tn * 64 + cc;
            const float v = tile[k * 65 + cc];
            if (mode == 1 || mode == 3 || row < N) {
                const bf16_t hi = f2bf(v);
                dd[(size_t)row * K + tk * 64 + k] = hi;
                if (mode == 2) dd[(size_t)N * K + (size_t)row * K + tk * 64 + k] = f2bf(v - bf2f(hi));
            }
        }
        __syncthreads();
    }
}
DEV void ph_conv_mix(const Params& p, int L, char* smem) {
    char* ws = p.ws;
    conv_job(p.in[I_WIN] + (size_t)L * 1024 * IN_COLS, nullptr, (bf16_t*)(ws + OFF_WINT), 1024, IN_COLS, 0, 1, 0, 0, smem);
    conv_job(p.in[I_WBR] + (size_t)L * 3 * 512 * 1024, nullptr, (bf16_t*)(ws + OFF_WBT), 512, 1024, 0, 3, (size_t)512 * 1024, (size_t)512 * 1024, smem);
    conv_job(p.in[I_WOUT] + (size_t)L * 1024 * 1024, nullptr, (bf16_t*)(ws + OFF_WOUTT), 1024, 1024, 0, 1, 0, 0, smem);
    conv_job(p.in[I_SG] + (size_t)L * 1024 * 256, p.in[I_SU] + (size_t)L * 1024 * 256, (bf16_t*)(ws + OFF_SGUT), 1024, 256, 3, 1, 0, 0, smem);
    conv_job(p.in[I_SD] + (size_t)L * 256 * 1024, nullptr, (bf16_t*)(ws + OFF_SDT), 256, 1024, 0, 1, 0, 0, smem);
    conv_job(p.in[I_G2] + (size_t)L * 128 * 512, nullptr, (bf16_t*)(ws + OFF_G2T), 128, 512, 0, 1, 0, 0, smem);
    conv_job(p.in[I_RTR] + (size_t)L * 1024 * 64, nullptr, (bf16_t*)(ws + OFF_RTR), 1024, 64, 2, 1, 0, 0, smem);
}
DEV void ph_conv_moe_gu(const Params& p, int L, char* smem, int bid, int nb) {
    const size_t eo = (size_t)L * 64 * 1024 * 128;
    conv_job(p.in[I_MWG] + eo, p.in[I_MWU] + eo, (bf16_t*)(p.ws + OFF_MGU), 1024, 128, 1, 64, (size_t)1024 * 128, (size_t)256 * 1024, smem, bid, nb);
}
DEV void ph_conv_moe(const Params& p, int L, char* smem, int bid, int nb) {
    const size_t eo = (size_t)L * 64 * 1024 * 128;
    conv_job(p.in[I_MWD] + eo, nullptr, (bf16_t*)(p.ws + OFF_MDT), 128, 1024, 0, 64, (size_t)128 * 1024, (size_t)1024 * 128, smem, bid, nb);
}

DEV void ph_norm(const Params& p, int L, int which, int ntok) {
    const int lane = TID() & 63, wave = TID() >> 6;
    const float* MOD = (const float*)(p.ws + OFF_MOD);
    const float* g = p.in[which ? I_N2G : I_N1G] + (size_t)L * DM;
    bf16_t* H = (bf16_t*)(p.ws + OFF_HX); bf16_t* HLO = (bf16_t*)(p.ws + OFF_H2LO);
    for (int n0 = blockIdx.x * 8; n0 < ntok; n0 += gridDim.x * 8) {
        const int n = n0 + wave;
        const float* xr = which ? xs_row(p, n) : xprev_row(p, L, n);
        float4 v[4]; float ss = 0.f;
        UNROLL for (int i = 0; i < 4; ++i) { v[i] = *(const float4*)(xr + i * 256 + lane * 4); ss += v[i].x * v[i].x + v[i].y * v[i].y + v[i].z * v[i].z + v[i].w * v[i].w; }
        UNROLL for (int o = 1; o < 64; o <<= 1) ss += __shfl_xor(ss, o);
        const float rstd = rsqrtf(ss * (1.f / DM) + 1e-6f);
        const float* sh = MOD + mod_row(n) * 6144 + (which ? 3 : 0) * DM; const float* sc = sh + DM;
        UNROLL for (int i = 0; i < 4; ++i) {
            const int c = i * 256 + lane * 4;
            const float4 gg = *(const float4*)(g + c), s1 = *(const float4*)(sc + c), s0 = *(const float4*)(sh + c);
            const float h0 = v[i].x * rstd * gg.x * (1.f + s1.x) + s0.x, h1 = v[i].y * rstd * gg.y * (1.f + s1.y) + s0.y;
            const float h2 = v[i].z * rstd * gg.z * (1.f + s1.z) + s0.z, h3 = v[i].w * rstd * gg.w * (1.f + s1.w) + s0.w;
            u32x2 o; o.x = pk2(h0, h1); o.y = pk2(h2, h3);
            *(u32x2*)(H + (size_t)n * DM + c) = o;
            if (which) {
                u32x2 o2;
                o2.x = pk2(h0 - bf2f((bf16_t)(o.x & 0xffff)), h1 - bf2f((bf16_t)(o.x >> 16)));
                o2.y = pk2(h2 - bf2f((bf16_t)(o.y & 0xffff)), h3 - bf2f((bf16_t)(o.y >> 16)));
                *(u32x2*)(HLO + (size_t)n * DM + c) = o2;
            }
        }
    }
}

DEV void ph_rw_prep(const Params& p, int L, char* smem) {
    const int lane = TID() & 63, wave = TID() >> 6;
    float* vsh = (float*)smem + wave * 512;
    const bf16_t* PXR = (const bf16_t*)(p.ws + OFF_PX); bf16_t* VF = (bf16_t*)(p.ws + OFF_VF);
    const float* mu = p.in[I_MU] + (size_t)L * RW_COLS;
    const float* v0 = p.in[I_V0]; const float* v1 = p.in[I_V1]; const float* v2 = p.in[I_V2];
    for (int n0 = blockIdx.x * 8; n0 < NT; n0 += gridDim.x * 8) {
        const int n = n0 + wave; int nb, tt, T; seq_of(n, nb, tt, T);
        float vs[8]; shift8(PXR, RW_COLS, nb, tt, T, 1024 + lane * 8, mu, vs);
        if (L == 0) { st8(VF + (size_t)n * 512 + lane * 8, vs); }
        else {
            UNROLL for (int i = 0; i < 8; ++i) vsh[lane * 8 + i] = vs[i];
            __syncthreads();
            const int q = lane & 31, hf = lane >> 5; float t1 = 0.f;
            for (int jj = 0; jj < 256; ++jj) t1 += vsh[hf * 256 + jj] * v1[(hf * 256 + jj) * 32 + q];
            t1 += __shfl_xor(t1, 32);
            float u[8];
            UNROLL for (int i = 0; i < 8; ++i) u[i] = v0[lane * 8 + i];
            for (int q2 = 0; q2 < 32; ++q2) { const float tq = __shfl(t1, q2); UNROLL for (int i = 0; i < 8; ++i) u[i] += tq * v2[q2 * 512 + lane * 8 + i]; }
            float vf[8], o[8]; ld8(VF + (size_t)n * 512 + lane * 8, vf);
            UNROLL for (int i = 0; i < 8; ++i) o[i] = vs[i] + (vf[i] - vs[i]) * sigm(u[i]);
            st8(VF + (size_t)n * 512 + lane * 8, o);
            __syncthreads();
        }
    }
}

DEV bf16x8 pk_lohi(u32x2 lo, u32x2 hi) { u32x4 w; w.x = lo.x; w.y = lo.y; w.z = hi.x; w.w = hi.y; return __builtin_bit_cast(bf16x8, w); }
DEV bf16x8 pk_acc2(const f32x4v& a, const f32x4v& b) { u32x4 w; w.x = pk2(a[0], a[1]); w.y = pk2(a[2], a[3]); w.z = pk2(b[0], b[1]); w.w = pk2(b[2], b[3]); return __builtin_bit_cast(bf16x8, w); }
DEV bf16x8 pk_acc1(const f32x4v& a) { u32x4 w; w.x = pk2(a[0], a[1]); w.y = pk2(a[2], a[3]); w.z = 0u; w.w = 0u; return __builtin_bit_cast(bf16x8, w); }
#define MFMA16(a, b, c) __builtin_amdgcn_mfma_f32_16x16x32_bf16((a), (b), (c), 0, 0, 0)
struct Raw3 { u32x4 l, c, r; };
DEV Raw3 rw_raw(const bf16_t* z, int ld, int nb, int tt, int T, int col0) {
    Raw3 o;
    o.c = *(const u32x4*)(z + (size_t)(nb + tt) * ld + col0);
    o.l = *(const u32x4*)(z + (size_t)(nb + max(tt - 1, 0)) * ld + col0);
    o.r = *(const u32x4*)(z + (size_t)(nb + min(tt + 1, T - 1)) * ld + col0);
    return o;
}
DEV void unpack8(u32x4 v, float (&o)[8]) {
    o[0] = __uint_as_float(v.x << 16); o[1] = __uint_as_float(v.x & 0xffff0000u); o[2] = __uint_as_float(v.y << 16); o[3] = __uint_as_float(v.y & 0xffff0000u);
    o[4] = __uint_as_float(v.z << 16); o[5] = __uint_as_float(v.z & 0xffff0000u); o[6] = __uint_as_float(v.w << 16); o[7] = __uint_as_float(v.w & 0xffff0000u);
}
DEV void shift_from_raw(const Raw3& w, int tt, int T, const float* mu8, float (&o)[8]) {
    float c[8], l[8], r[8]; unpack8(w.c, c); unpack8(w.l, l); unpack8(w.r, r);
    const float ml = tt > 0 ? 0.5f : 0.f, mr = tt < T - 1 ? 0.5f : 0.f;
    UNROLL for (int i = 0; i < 8; ++i) o[i] = c[i] + mu8[i] * (ml * l[i] + mr * r[i] - c[i]);
}
DEV void ph_rw_scan(const Params& p, int L, char* smem) {
    const int tid = TID();
    const int wave = __builtin_amdgcn_readfirstlane(tid >> 6);
    char* AT = smem; char* BT = smem + 9216; char* KT = smem + 18432; char* RT = smem + 27648;
    char* BH = smem + 36864; char* KH = smem + 46080; char* VT = smem + 55296;
    char* W2T = smem + 64512; char* A2T = smem + 73728;
    float* PCv = (float*)(smem + 82944); float* SEGT = PCv + 64;
    char* XY = smem + 85248;
    char* T1 = XY; char* T2 = XY + 9216; float* WLf = (float*)(XY + 18432); float* ALf = (float*)(XY + 35840); float* LW = (float*)XY;
    float* TOT = (float*)(XY + 62720);
    float* PAR = (float*)(XY + 60416);
    char* NAB = XY; char* NAK = XY + 9216; char* NRB = XY + 18432; char* NRK = XY + 27648; char* TJ = XY + 36864; float* NDF = (float*)(XY + 38912); float* YO = (float*)(XY + 43008);
    const bf16_t* PXR = (const bf16_t*)(p.ws + OFF_PX); const bf16_t* VF = (const bf16_t*)(p.ws + OFF_VF);
    bf16_t* YS = (bf16_t*)(p.ws + OFF_YS); float* CB = (float*)(p.ws + OFF_CB);
    const float* mu = p.in[I_MU] + (size_t)L * RW_COLS;
    const float* w0 = p.in[I_W0] + (size_t)L * 1024; const float* w2 = p.in[I_W2] + (size_t)L * 65536;
    const float* a0 = p.in[I_A0] + (size_t)L * 1024; const float* a2 = p.in[I_A2] + (size_t)L * 65536;
    const float* kkw = p.in[I_KK] + (size_t)L * 512; const float* kaw = p.in[I_KA] + (size_t)L * 512; const float* rkw = p.in[I_RK] + (size_t)L * 512;
    for (int u = blockIdx.x; u < 256; u += gridDim.x) {
        const int b = u >> 4, h = (u >> 1) & 7, d = u & 1;
        for (int i = tid; i < 4096; i += NTHREADS) {
            const int l = i >> 6, n = i & 63;
            *(bf16_t*)(W2T + n * LROW + l * 2) = f2bf(w2[(size_t)(d * 64 + l) * 512 + h * 64 + n]);
            *(bf16_t*)(A2T + n * LROW + l * 2) = f2bf(a2[(size_t)(d * 64 + l) * 512 + h * 64 + n]);
        }
        if (tid < 64) {
            const int n = tid;
            PAR[n] = w0[d * 512 + h * 64 + n]; PAR[64 + n] = a0[d * 512 + h * 64 + n];
            PAR[128 + n] = kkw[h * 64 + n]; PAR[192 + n] = kaw[h * 64 + n]; PAR[256 + n] = rkw[h * 64 + n];
            PAR[320 + n] = mu[1536 + d * 64 + n]; PAR[384 + n] = mu[1664 + d * 64 + n]; PAR[448 + n] = mu[h * 64 + n]; PAR[512 + n] = mu[512 + h * 64 + n];
        }
        f32x4v sacc[4];
        UNROLL for (int i = 0; i < 4; ++i) sacc[i] = (f32x4v){0.f, 0.f, 0.f, 0.f};
        __syncthreads();
        Raw3 pw1, pw2, pr, pk; u32x4 pv;
#define RW_GEOM(ci_, tido_) const bool isc = (ci_) < 4; const int T = isc ? CTXL : SEQ, cc = isc ? (ci_) : (ci_) - 4; \
            const int t0 = d == 0 ? cc * 64 : T - 64 * (cc + 1), nb = isc ? NX + b * CTXL : b * SEQ; \
            const int tt = d == 0 ? t0 + ((tido_) >> 3) : t0 + 63 - ((tido_) >> 3);
#define RW_PREFETCH(ci_, tido_) do { RW_GEOM(ci_, tido_) const int j_ = (tido_) & 7; \
            pw1 = rw_raw(PXR, RW_COLS, nb, tt, T, 1536 + d * 64 + 8 * j_); pw2 = rw_raw(PXR, RW_COLS, nb, tt, T, 1664 + d * 64 + 8 * j_); \
            pr = rw_raw(PXR, RW_COLS, nb, tt, T, h * 64 + 8 * j_); pk = rw_raw(PXR, RW_COLS, nb, tt, T, 512 + h * 64 + 8 * j_); \
            pv = *(const u32x4*)(VF + (size_t)(nb + tt) * 512 + h * 64 + 8 * j_); } while (0)
        RW_PREFETCH(0, tid);
        for (int ci = 0; ci < 36; ++ci) {
            int tido = tid; asm volatile("" : "+v"(tido));
            const int lane = tido & 63, lq = lane & 15, kg = lane >> 4, ti = tido >> 3, j = tido & 7;
            const int ch = h * 64 + 8 * j;
            RW_GEOM(ci, tido)
            float r8[8], k8[8], v8[8];
            {
                float x1[8], x2[8];
                shift_from_raw(pw1, tt, T, PAR + 320 + 8 * j, x1);
                shift_from_raw(pw2, tt, T, PAR + 384 + 8 * j, x2);
                UNROLL for (int i = 0; i < 8; ++i) x1[i] = tanh_fast(x1[i]);
                st8((bf16_t*)(T1 + ti * LROW) + 8 * j, x1); st8((bf16_t*)(T2 + ti * LROW) + 8 * j, x2);
                shift_from_raw(pr, tt, T, PAR + 448 + 8 * j, r8);
                shift_from_raw(pk, tt, T, PAR + 512 + 8 * j, k8);
                unpack8(pv, v8);
            }
            __syncthreads();
            _Pragma("unroll 1") for (int rep = 0; rep < 4; ++rep) {
                const int q = wave + 8 * rep, m = q >> 4, tl = q & 15, tt4 = tl >> 2, nt4 = tl & 3;
                const char* Ab = (m ? T2 : T1) + (16 * tt4 + lq) * LROW + kg * 16; const char* Bb = (m ? A2T : W2T) + (16 * nt4 + lq) * LROW + kg * 16;
                f32x4v a = {0.f, 0.f, 0.f, 0.f};
                UNROLL for (int ks = 0; ks < 2; ++ks) a = MFMA16(*(const bf16x8*)(Ab + ks * 64), *(const bf16x8*)(Bb + ks * 64), a);
                float* dst = (m ? ALf : WLf) + (16 * tt4 + 4 * kg) * 68 + 16 * nt4 + lq;
                UNROLL for (int i = 0; i < 4; ++i) dst[i * 68] = a[i];
            }
            __syncthreads();
            float av[8], bv[8], kd8[8];
            {
                const float4 wa = *(const float4*)(WLf + ti * 68 + 8 * j), wb = *(const float4*)(WLf + ti * 68 + 8 * j + 4);
                const float4 aa = *(const float4*)(ALf + ti * 68 + 8 * j), ab = *(const float4*)(ALf + ti * 68 + 8 * j + 4);
                const float wl[8] = {wa.x, wa.y, wa.z, wa.w, wb.x, wb.y, wb.z, wb.w}, al[8] = {aa.x, aa.y, aa.z, aa.w, ab.x, ab.y, ab.z, ab.w};
                float ss = 0.f, cbp = 0.f, alpha[8], kkr[8], lw[8];
                UNROLL for (int i = 0; i < 8; ++i) {
                    const float xw = -(PAR[8 * j + i] + wl[i]);
                    const float sp = softplus_fast(xw);
                    lw[i] = -__expf(-sp - 0.5f);
                    alpha[i] = sigm(PAR[64 + 8 * j + i] + al[i]);
                    kkr[i] = k8[i] * PAR[128 + 8 * j + i]; ss += kkr[i] * kkr[i];
                    kd8[i] = k8[i] * (1.f + (alpha[i] - 1.f) * PAR[192 + 8 * j + i]);
                    cbp += r8[i] * kd8[i] * PAR[256 + 8 * j + i];
                }
                ss = sum8(ss); cbp = sum8(cbp);
                const float inv = frcp(fmaxf(__builtin_amdgcn_sqrtf(ss), 1e-12f));
                UNROLL for (int i = 0; i < 8; ++i) { const float kk = kkr[i] * inv; av[i] = -kk; bv[i] = kk * alpha[i]; }
                *(float4*)(LW + ti * 64 + 8 * j) = make_float4(lw[0], lw[1], lw[2], lw[3]); *(float4*)(LW + ti * 64 + 8 * j + 4) = make_float4(lw[4], lw[5], lw[6], lw[7]);
                if (j == 0) CB[((size_t)d * NT + nb + tt) * 8 + h] = cbp;
            }
            __syncthreads();
            {
                const int n = tid & 63, seg = wave; float run[8], acc = 0.f;
                UNROLL for (int r = 0; r < 8; ++r) { acc += LW[(seg * 8 + r) * 64 + n]; run[r] = acc; }
                SEGT[seg * 64 + n] = acc;
                __syncthreads();
                float off = 0.f, tot = 0.f;
                UNROLL for (int s2 = 0; s2 < 8; ++s2) { const float sv = SEGT[s2 * 64 + n]; tot += sv; off += s2 < seg ? sv : 0.f; }
                UNROLL for (int r = 0; r < 8; ++r) LW[(seg * 8 + r) * 64 + n] = run[r] + off;
                if (seg == 0) { TOT[n] = tot; PCv[n] = __expf(tot); }
            }
            __syncthreads();
            {
                const float4 ta = *(const float4*)(TOT + 8 * j), tb = *(const float4*)(TOT + 8 * j + 4);
                const float tot[8] = {ta.x, ta.y, ta.z, ta.w, tb.x, tb.y, tb.z, tb.w};
                const float4 la = *(const float4*)(LW + ti * 64 + 8 * j), lb = *(const float4*)(LW + ti * 64 + 8 * j + 4);
                const float lpl[8] = {la.x, la.y, la.z, la.w, lb.x, lb.y, lb.z, lb.w};
                float lpm[8];
                if (ti != 0) {
                    const float4 ma = *(const float4*)(LW + (ti - 1) * 64 + 8 * j), mb = *(const float4*)(LW + (ti - 1) * 64 + 8 * j + 4);
                    lpm[0] = ma.x; lpm[1] = ma.y; lpm[2] = ma.z; lpm[3] = ma.w; lpm[4] = mb.x; lpm[5] = mb.y; lpm[6] = mb.z; lpm[7] = mb.w;
                } else { UNROLL for (int i = 0; i < 8; ++i) lpm[i] = 0.f; }
                float oa[8], ob[8], ok[8], orr[8];
                const int wofs = (((ti >> 3) ^ j) << 4) + (ti & 7) * 2;
                UNROLL for (int i = 0; i < 8; ++i) {
                    const float lp = lpl[i], lm = lpm[i];
                    const float eP = __expf(lp), eM = __expf(-lp), ePm = __expf(lm), eE = __expf(tot[i] - lp);
                    oa[i] = av[i] * ePm; ob[i] = bv[i] * eM; ok[i] = kd8[i] * eM; orr[i] = r8[i] * eP;
                    *(bf16_t*)(BH + (8 * j + i) * LROW + wofs) = f2bf(bv[i] * eE);
                    *(bf16_t*)(KH + (8 * j + i) * LROW + wofs) = f2bf(kd8[i] * eE);
                    *(bf16_t*)(VT + (8 * j + i) * LROW + wofs) = f2bf(v8[i]);
                }
                st8((bf16_t*)(AT + ti * LROW) + 8 * j, oa); st8((bf16_t*)(BT + ti * LROW) + 8 * j, ob);
                st8((bf16_t*)(KT + ti * LROW) + 8 * j, ok); st8((bf16_t*)(RT + ti * LROW) + 8 * j, orr);
            }
            __syncthreads();
            if (ci + 1 < 36) RW_PREFETCH(ci + 1, tido);
            _Pragma("unroll 1") for (int rep = 0; rep < 6; ++rep) {
                const int q = wave + 8 * rep, m = q / 12, tl = q - 12 * m;
                const int tt4 = tl >= 10 ? 2 * (tl - 10) : tl < 1 ? 0 : tl < 3 ? 1 : tl < 6 ? 2 : 3, st4 = tl >= 10 ? tt4 + 1 : tl - (tt4 * (tt4 + 1)) / 2;
                char* dstm = m == 0 ? NAB : m == 1 ? NAK : m == 2 ? NRB : NRK;
                f32x4v a = {0.f, 0.f, 0.f, 0.f};
                if (st4 <= tt4) {
                    const char* Ab = (m < 2 ? AT : RT) + (16 * tt4 + lq) * LROW + kg * 16; const char* Bb = ((m & 1) ? KT : BT) + (16 * st4 + lq) * LROW + kg * 16;
                    UNROLL for (int ks = 0; ks < 2; ++ks) a = MFMA16(*(const bf16x8*)(Ab + ks * 64), *(const bf16x8*)(Bb + ks * 64), a);
                }
                const int sidx = 16 * st4 + lq;
                UNROLL for (int i = 0; i < 4; ++i) {
                    const int tidx = 16 * tt4 + 4 * kg + i;
                    const bool keep = m < 2 ? sidx < tidx : sidx <= tidx;
                    const float val = keep ? a[i] : 0.f;
                    *(bf16_t*)(dstm + tidx * LROW + sidx * 2) = f2bf(val);
                    if (m == 0 && st4 == tt4) NDF[(tt4 * 16 + 4 * kg + i) * 16 + lq] = val;
                }
            }
            __syncthreads();
            f32x4v xacc[4], yacc[4];
            bf16x8 vt[2];
            if (wave == 7) {
                const int blk = lane >> 4, c = lane & 15;
                float Tc[16];
                UNROLL for (int t = 0; t < 16; ++t) {
                    float a = t == c ? 1.f : 0.f;
                    UNROLL for (int s2 = 0; s2 < t; ++s2) a += NDF[(blk * 16 + t) * 16 + s2] * Tc[s2];
                    Tc[t] = a;
                }
                UNROLL for (int t = 0; t < 16; ++t) *(bf16_t*)(TJ + (blk * 16 + t) * 32 + c * 2) = f2bf(Tc[t]);
            } else if (wave < 4) {
                bf16x8 sb[2];
                UNROLL for (int kk = 0; kk < 2; ++kk) { sb[kk] = pk_acc2(sacc[2 * kk], sacc[2 * kk + 1]); vt[kk] = *(const bf16x8*)(VT + (16 * wave + lq) * LROW + (((4 * kk + kg) ^ (2 * wave + (lq >> 3))) << 4)); }
                UNROLL for (int t4 = 0; t4 < 4; ++t4) {
                    f32x4v x = {0.f, 0.f, 0.f, 0.f}, y = {0.f, 0.f, 0.f, 0.f};
                    UNROLL for (int kk = 0; kk < 2; ++kk) {
                        const char* pa = AT + (16 * t4 + lq) * LROW + (32 * kk + 4 * kg) * 2; const char* pr = RT + (16 * t4 + lq) * LROW + (32 * kk + 4 * kg) * 2;
                        x = MFMA16(pk_lohi(*(const u32x2*)pa, *(const u32x2*)(pa + 32)), sb[kk], x);
                        y = MFMA16(pk_lohi(*(const u32x2*)pr, *(const u32x2*)(pr + 32)), sb[kk], y);
                        if (2 * kk <= t4) {
                            x = MFMA16(*(const bf16x8*)(NAK + (16 * t4 + lq) * LROW + kk * 64 + kg * 16), vt[kk], x);
                            y = MFMA16(*(const bf16x8*)(NRK + (16 * t4 + lq) * LROW + kk * 64 + kg * 16), vt[kk], y);
                        }
                    }
                    xacc[t4] = x; yacc[t4] = y;
                }
            }
            __syncthreads();
            if (wave < 4) {
                const u32x2 z2 = {0u, 0u};
                f32x4v uacc[4];
                {
                    const u32x2 t0v = *(const u32x2*)(TJ + (0 * 16 + lq) * 32 + 4 * kg * 2);
                    uacc[0] = MFMA16(pk_lohi(t0v, z2), pk_acc1(xacc[0]), ((f32x4v){0.f, 0.f, 0.f, 0.f}));
                }
                UNROLL for (int jb = 1; jb < 4; ++jb) {
                    f32x4v z = xacc[jb];
                    const char* nr = NAB + (16 * jb + lq) * LROW + 4 * kg * 2;
                    if (jb == 1) z = MFMA16(pk_lohi(*(const u32x2*)nr, z2), pk_acc1(uacc[0]), z);
                    else {
                        z = MFMA16(pk_lohi(*(const u32x2*)nr, *(const u32x2*)(nr + 32)), pk_acc2(uacc[0], uacc[1]), z);
                        if (jb == 3) z = MFMA16(pk_lohi(*(const u32x2*)(nr + 64), z2), pk_acc1(uacc[2]), z);
                    }
                    const u32x2 tv = *(const u32x2*)(TJ + (jb * 16 + lq) * 32 + 4 * kg * 2);
                    uacc[jb] = MFMA16(pk_lohi(tv, z2), pk_acc1(z), ((f32x4v){0.f, 0.f, 0.f, 0.f}));
                }
                bf16x8 ub[2]; ub[0] = pk_acc2(uacc[0], uacc[1]); ub[1] = pk_acc2(uacc[2], uacc[3]);
                UNROLL for (int t4 = 0; t4 < 4; ++t4) {
                    f32x4v y = yacc[t4];
                    UNROLL for (int kk = 0; kk < 2; ++kk) if (2 * kk <= t4) {
                        const char* pn = NRB + (16 * t4 + lq) * LROW + (32 * kk + 4 * kg) * 2;
                        y = MFMA16(pk_lohi(*(const u32x2*)pn, *(const u32x2*)(pn + 32)), ub[kk], y);
                    }
                    UNROLL for (int i = 0; i < 4; ++i) YO[(16 * t4 + 4 * kg + i) * 68 + 16 * wave + lq] = y[i];
                }
                UNROLL for (int kt = 0; kt < 4; ++kt) {
                    f32x4v sv = sacc[kt];
                    UNROLL for (int i = 0; i < 4; ++i) sv[i] *= PCv[16 * kt + 4 * kg + i];
                    UNROLL for (int kk = 0; kk < 2; ++kk) {
                        const int xr = 2 * kt + (lq >> 3);
                        const char* pb = BH + (16 * kt + lq) * LROW + (kg & 1) * 8;
                        sv = MFMA16(pk_lohi(*(const u32x2*)(pb + (((4 * kk + (kg >> 1)) ^ xr) << 4)), *(const u32x2*)(pb + (((4 * kk + 2 + (kg >> 1)) ^ xr) << 4))), ub[kk], sv);
                        sv = MFMA16(*(const bf16x8*)(KH + (16 * kt + lq) * LROW + (((4 * kk + kg) ^ xr) << 4)), vt[kk], sv);
                    }
                    sacc[kt] = sv;
                }
            }
            __syncthreads();
            {
                const float4 ya = *(const float4*)(YO + ti * 68 + 8 * j), yb = *(const float4*)(YO + ti * 68 + 8 * j + 4);
                const float y8[8] = {ya.x, ya.y, ya.z, ya.w, yb.x, yb.y, yb.z, yb.w};
                st8(YS + ((size_t)d * NT + nb + tt) * 512 + ch, y8);
            }
            __syncthreads();
        }
    }
}

DEV void ph_rw_read(const Params& p, int L, int ntok) {
    const int lane = TID() & 63, wave = TID() >> 6;
    const bf16_t* PXR = (const bf16_t*)(p.ws + OFF_PX); const bf16_t* VF = (const bf16_t*)(p.ws + OFF_VF);
    const bf16_t* YS = (const bf16_t*)(p.ws + OFF_YS); const float* CB = (const float*)(p.ws + OFF_CB);
    bf16_t* YA = (bf16_t*)(p.ws + OFF_YA); bf16_t* SG = (bf16_t*)(p.ws + OFF_SGB);
    const float* mu = p.in[I_MU] + (size_t)L * RW_COLS;
    const float* lg = p.in[I_LNG] + (size_t)L * 512; const float* lb = p.in[I_LNB] + (size_t)L * 512;
    for (int n0 = blockIdx.x * 8; n0 < ntok; n0 += gridDim.x * 8) {
        const int n = n0 + wave, c = lane * 8, h = lane >> 3;
        float y0[8], y1[8], v8[8], o[8];
        ld8(YS + (size_t)n * 512 + c, y0); ld8(YS + ((size_t)NT + n) * 512 + c, y1); ld8(VF + (size_t)n * 512 + c, v8);
        float s = 0.f;
        UNROLL for (int i = 0; i < 8; ++i) { y0[i] += y1[i]; s += y0[i]; }
        s += __shfl_xor(s, 1); s += __shfl_xor(s, 2); s += __shfl_xor(s, 4);
        const float mean = s * (1.f / 64.f); float q = 0.f;
        UNROLL for (int i = 0; i < 8; ++i) { const float dd = y0[i] - mean; q += dd * dd; }
        q += __shfl_xor(q, 1); q += __shfl_xor(q, 2); q += __shfl_xor(q, 4);
        const float rstd = rsqrtf(q * (1.f / 64.f) + 64e-5f);
        const float bon = CB[(size_t)n * 8 + h] + CB[((size_t)NT + n) * 8 + h];
        UNROLL for (int i = 0; i < 8; ++i) o[i] = (y0[i] - mean) * rstd * lg[c + i] + lb[c + i] + bon * v8[i];
        st8(YA + (size_t)n * 512 + c, o);
        if (lane < 16) {
            int nb, tt, T; seq_of(n, nb, tt, T);
            float g8[8]; shift8(PXR, RW_COLS, nb, tt, T, 1792 + lane * 8, mu, g8);
            UNROLL for (int i = 0; i < 8; ++i) g8[i] = sigm(g8[i]);
            st8(SG + (size_t)n * 128 + lane * 8, g8);
        }
    }
}

DEV void ph_na_norm(const Params& p, int L) {
    const int lane = TID() & 63, wave = TID() >> 6;
    bf16_t* PXN = (bf16_t*)(p.ws + OFF_PX);
    const float* qg = p.in[I_QNG] + (size_t)L * 64; const float* kg = p.in[I_KNG] + (size_t)L * 64;
    for (int n0 = blockIdx.x * 8; n0 < NT; n0 += gridDim.x * 8) {
        const int n = n0 + wave, c = lane * 8;
        UNROLL for (int w = 0; w < 2; ++w) {
            bf16_t* ptr = PXN + (size_t)n * 1024 + w * 512 + c;
            float x[8]; ld8(ptr, x);
            float ss = 0.f;
            UNROLL for (int i = 0; i < 8; ++i) ss += x[i] * x[i];
            ss += __shfl_xor(ss, 1); ss += __shfl_xor(ss, 2); ss += __shfl_xor(ss, 4);
            const float r = rsqrtf(ss * (1.f / 64.f) + 1e-6f) * (w == 0 ? 0.125f : 1.f);
            const float* g = w == 0 ? qg : kg;
            UNROLL for (int i = 0; i < 8; ++i) x[i] = x[i] * r * g[(c + i) & 63];
            st8(ptr, x);
        }
    }
}

DEV void knorm8(float (&x)[8], const float* g) {
    float ss = 0.f;
    UNROLL for (int i = 0; i < 8; ++i) ss += x[i] * x[i];
    ss = sum8(ss);
    const float r = rsqrtf(ss * (1.f / 64.f) + 1e-6f);
    UNROLL for (int i = 0; i < 8; ++i) x[i] = x[i] * r * g[i];
}
DEV void ph_na_att(const Params& p, int L, char* smem) {
    const int tid0 = TID();
    const int wave = __builtin_amdgcn_readfirstlane(tid0 >> 6);
    char* KL = smem;
    char* KC = smem + 576 * LROW;
    char* VL = smem;
    char* VC = smem + 64 * 1168;
    float* OX = (float*)(smem + 119808);
    float* RP = OX + 8 * 1024;
    const bf16_t* PXN = (const bf16_t*)(p.ws + OFF_PX); bf16_t* YB = (bf16_t*)(p.ws + OFF_YB);
    const bf16_t* VT = (const bf16_t*)(p.ws + OFF_VT); const bf16_t* VTC = (const bf16_t*)(p.ws + OFF_VTC);
    const float* qgn = p.in[I_QNG] + (size_t)L * 64; const float* kgn = p.in[I_KNG] + (size_t)L * 64;
    const int nunits = 2048 + (L == 0 ? 256 : 0);
    for (int u = blockIdx.x; u < nunits; u += gridDim.x) {
        int tid = tid0; asm volatile("" : "+v"(tid));
        const int lane = tid & 63, lq = lane & 15, kg = lane >> 4;
        const bool cu = u >= 2048;
        int b, h, rp = 0, rs0 = 0, g = 0;
        if (!cu) { h = u & 7; rp = (u >> 3) & 15; b = u >> 7; rs0 = min(max(2 * rp - 4, 0), 24); }
        else { const int v = u - 2048; h = v & 7; g = (v >> 3) & 1; b = v >> 4; }
        const int ctx0 = NX + b * CTXL;
        if (!cu) {
            UNROLL for (int i = 0; i < 9; ++i) {
                const int c = tid + NTHREADS * i, kx = c >> 3, part = c & 7;
                const int tok = b * SEQ + min(rs0 + (kx >> 6), 31) * 64 + (kx & 63);
                float kv[8]; ld8(PXN + (size_t)tok * 1024 + 512 + h * 64 + part * 8, kv); knorm8(kv, kgn + part * 8);
                st8((bf16_t*)(KL + kx * LROW + part * 16), kv);
            }
            for (int i = tid; i < 15 * 31; i += NTHREADS) RP[i] = p.in[I_RPB][((size_t)L * 8 + h) * 465 + i];
        }
        UNROLL for (int i = 0; i < 4; ++i) {
            const int c = tid + NTHREADS * i, kx = c >> 3, part = c & 7;
            float kv[8]; ld8(PXN + (size_t)(ctx0 + kx) * 1024 + 512 + h * 64 + part * 8, kv); knorm8(kv, kgn + part * 8);
            st8((bf16_t*)(KC + kx * LROW + part * 16), kv);
        }
        const int nb = wave & 3, ri = wave >> 2, r = 2 * rp + ri;
        const int rs = min(max(r - 4, 0), 24), roff = rs - rs0;
        const int qtok0 = cu ? ctx0 + (g * 8 + wave) * 16 : b * SEQ + r * 64 + nb * 16;
        const int band0 = min(max(nb * 16 - 8, 0), 32);
        bf16x8 qf[2];
        {
            float q0[8], q1[8]; ld8(PXN + (size_t)(qtok0 + lq) * 1024 + h * 64 + kg * 8, q0); ld8(PXN + (size_t)(qtok0 + lq) * 1024 + h * 64 + 32 + kg * 8, q1);
            float ss = 0.f;
            UNROLL for (int i = 0; i < 8; ++i) ss += q0[i] * q0[i] + q1[i] * q1[i];
            ss += __shfl_xor(ss, 16); ss += __shfl_xor(ss, 32);
            const float rq = rsqrtf(ss * (1.f / 64.f) + 1e-6f) * 0.125f;
            UNROLL for (int i = 0; i < 8; ++i) { q0[i] = q0[i] * rq * qgn[kg * 8 + i]; q1[i] = q1[i] * rq * qgn[32 + kg * 8 + i]; }
            u32x4 w0, w1; w0.x = pk2(q0[0], q0[1]); w0.y = pk2(q0[2], q0[3]); w0.z = pk2(q0[4], q0[5]); w0.w = pk2(q0[6], q0[7]);
            w1.x = pk2(q1[0], q1[1]); w1.y = pk2(q1[2], q1[3]); w1.z = pk2(q1[4], q1[5]); w1.w = pk2(q1[6], q1[7]);
            qf[0] = __builtin_bit_cast(bf16x8, w0); qf[1] = __builtin_bit_cast(bf16x8, w1);
        }
        __syncthreads();
        u32x4 vraw[13];
        if (!cu) {
            UNROLL for (int i = 0; i < 9; ++i) {
                const int c = tid + NTHREADS * i, part = c & 7, kr = (c >> 3) % 9, d = (c >> 3) / 9;
                vraw[i] = *(const u32x4*)(VT + ((size_t)(b * 8 + h) * 64 + d) * SEQ + min(rs0 + kr, 31) * 64 + part * 8);
            }
        }
        UNROLL for (int i = 0; i < 4; ++i) {
            const int c = tid + NTHREADS * i, part = c & 31, d = c >> 5;
            vraw[9 + i] = *(const u32x4*)(VTC + ((size_t)(b * 8 + h) * 64 + d) * CTXL + part * 8);
        }
        f32x4v sacc[16];
        bf16x8 pfl[8], pfc[8];
        float ml = -3e38f, ll = 0.f, mc, lc;
        if (!cu) {
            const char* kb = KL + (roff * 64 + band0 + lq) * LROW + kg * 16;
            UNROLL for (int t = 0; t < 16; ++t) {
                f32x4v a = {0.f, 0.f, 0.f, 0.f};
                UNROLL for (int ks = 0; ks < 2; ++ks) a = __builtin_amdgcn_mfma_f32_16x16x32_bf16(*(const bf16x8*)(kb + ((t >> 1) * 64 + (t & 1) * 16) * LROW + ks * 64), qf[ks], a, 0, 0, 0);
                sacc[t] = a;
            }
            const int col = nb * 16 + lq, cs = min(max(col - 8, 0), 48);
            const int kc0 = band0 + 4 * kg;
            const float* rpp = RP + (rs - r + 7) * 31 + (kc0 - col + 15);
            UNROLL for (int t = 0; t < 16; ++t) UNROLL for (int i = 0; i < 4; ++i) {
                const int kc = kc0 + (t & 1) * 16 + i;
                const bool valid = kc >= cs && kc < cs + 16;
                sacc[t][i] = valid ? sacc[t][i] + rpp[(t >> 1) * 31 + (t & 1) * 16 + i] : -1e30f;
            }
            UNROLL for (int t = 0; t < 16; ++t) UNROLL for (int i = 0; i < 4; ++i) ml = fmaxf(ml, sacc[t][i]);
            ml = fmaxf(ml, __shfl_xor(ml, 16)); ml = fmaxf(ml, __shfl_xor(ml, 32));
            UNROLL for (int t = 0; t < 16; ++t) UNROLL for (int i = 0; i < 4; ++i) { const float e = __expf(sacc[t][i] - ml); sacc[t][i] = e; ll += e; }
            ll += __shfl_xor(ll, 16); ll += __shfl_xor(ll, 32);
            UNROLL for (int tp = 0; tp < 8; ++tp) pfl[tp] = pk_acc2(sacc[2 * tp], sacc[2 * tp + 1]);
        }
        {
            const char* kb = KC + lq * LROW + kg * 16;
            UNROLL for (int t = 0; t < 16; ++t) {
                f32x4v a = {0.f, 0.f, 0.f, 0.f};
                UNROLL for (int ks = 0; ks < 2; ++ks) a = __builtin_amdgcn_mfma_f32_16x16x32_bf16(*(const bf16x8*)(kb + t * 16 * LROW + ks * 64), qf[ks], a, 0, 0, 0);
                sacc[t] = a;
            }
            mc = -3e38f; lc = 0.f;
            UNROLL for (int t = 0; t < 16; ++t) UNROLL for (int i = 0; i < 4; ++i) mc = fmaxf(mc, sacc[t][i]);
            mc = fmaxf(mc, __shfl_xor(mc, 16)); mc = fmaxf(mc, __shfl_xor(mc, 32));
            UNROLL for (int t = 0; t < 16; ++t) UNROLL for (int i = 0; i < 4; ++i) { const float e = __expf(sacc[t][i] - mc); sacc[t][i] = e; lc += e; }
            lc += __shfl_xor(lc, 16); lc += __shfl_xor(lc, 32);
            UNROLL for (int tp = 0; tp < 8; ++tp) pfc[tp] = pk_acc2(sacc[2 * tp], sacc[2 * tp + 1]);
        }
        const float mm = fmaxf(ml, mc), el = cu ? 0.f : __expf(ml - mm), ec = __expf(mc - mm);
        const float inv = frcp(ll * el + lc * ec);
        const float fl = el * inv, fc = ec * inv;
        __syncthreads();
        if (!cu) {
            UNROLL for (int i = 0; i < 9; ++i) {
                const int c = tid + NTHREADS * i, part = c & 7, kr = (c >> 3) % 9, d = (c >> 3) / 9;
                *(u32x4*)(VL + d * 1168 + (kr * 64 + part * 8) * 2) = vraw[i];
            }
        }
        UNROLL for (int i = 0; i < 4; ++i) {
            const int c = tid + NTHREADS * i, part = c & 31, d = c >> 5;
            *(u32x4*)(VC + d * 528 + part * 16) = vraw[9 + i];
        }
        __syncthreads();
        f32x4v ol[4], oc[4];
        UNROLL for (int dt = 0; dt < 4; ++dt) { ol[dt] = (f32x4v){0.f, 0.f, 0.f, 0.f}; oc[dt] = (f32x4v){0.f, 0.f, 0.f, 0.f}; }
        if (!cu) {
            const char* vb = VL + lq * 1168 + (roff * 64 + band0 + 4 * kg) * 2;
            UNROLL for (int tp = 0; tp < 8; ++tp) UNROLL for (int dt = 0; dt < 4; ++dt)
                ol[dt] = __builtin_amdgcn_mfma_f32_16x16x32_bf16(pfl[tp], pk_lohi(*(const u32x2*)(vb + dt * 16 * 1168 + tp * 128), *(const u32x2*)(vb + dt * 16 * 1168 + tp * 128 + 32)), ol[dt], 0, 0, 0);
        }
        {
            const char* vb = VC + lq * 528 + 8 * kg;
            UNROLL for (int tp = 0; tp < 8; ++tp) UNROLL for (int dt = 0; dt < 4; ++dt)
                oc[dt] = __builtin_amdgcn_mfma_f32_16x16x32_bf16(pfc[tp], pk_lohi(*(const u32x2*)(vb + dt * 16 * 528 + tp * 64), *(const u32x2*)(vb + dt * 16 * 528 + tp * 64 + 32)), oc[dt], 0, 0, 0);
        }
        float* ox = OX + wave * 1024;
        UNROLL for (int i = 0; i < 4; ++i) {
            const float a = __shfl(fl, 4 * kg + i), c2 = __shfl(fc, 4 * kg + i);
            UNROLL for (int dt = 0; dt < 4; ++dt) ox[(4 * kg + i) * 64 + dt * 16 + lq] = ol[dt][i] * a + oc[dt][i] * c2;
        }
        UNROLL for (int it = 0; it < 2; ++it) {
            const int q = (lane >> 3) + 8 * it, c8 = (lane & 7) * 8;
            const float4 a = *(const float4*)(ox + q * 64 + c8), bq = *(const float4*)(ox + q * 64 + c8 + 4);
            const float v[8] = {a.x, a.y, a.z, a.w, bq.x, bq.y, bq.z, bq.w};
            st8(YB + (size_t)(qtok0 + q) * 512 + h * 64 + c8, v);
        }
        __syncthreads();
    }
}

DEV float sum16(float v) { v += DPP_MOV(v, 0xB1); v += DPP_MOV(v, 0x4E); v += DPP_MOV(v, 0x141); v += DPP_MOV(v, 0x140); return v; }
DEV void ph_ml_scan(const Params& p, int L, char* smem) {
    const int tid = TID(), lane = tid & 63, lq = lane & 15, kg = lane >> 4, ti = tid >> 3, j = tid & 7;
    const int wave = __builtin_amdgcn_readfirstlane(tid >> 6);
    char* QS = smem;
    char* QP = QS + 9216;
    char* KC = QP + 9216;
    char* KW = KC + 9216;
    char* PM = KW + 9216;
    char* VT = PM + 9216;
    float* BV = (float*)(VT + 128 * LROW);
    float* GI = BV + 64;
    float* DEN = GI + 64;
    float* NV = DEN + 64;
    float* RS = NV + 64;
    float* HO = RS + 256;
    const bf16_t* PXM = (const bf16_t*)(p.ws + OFF_PX); bf16_t* HS = (bf16_t*)(p.ws + OFF_HS);
    for (int u = blockIdx.x; u < 128; u += gridDim.x) {
        const int d = u & 1, h = (u >> 1) & 3, b = u >> 3;
        const float ib = p.in[I_IB][L * 8 + d * 4 + h], fb = p.in[I_FB][L * 8 + d * 4 + h];
        f32x4v cacc[4];
        UNROLL for (int i = 0; i < 4; ++i) cacc[i] = (f32x4v){0.f, 0.f, 0.f, 0.f};
        for (int i = tid; i < 64 * LROW / 4; i += NTHREADS) ((unsigned*)PM)[i] = 0u;
        if (tid < 64) NV[tid] = 0.f;
        __syncthreads();
        u32x4 pq, pk, pv0, pv1; unsigned short pig = 0, pfg = 0;
#define ML_GEOM(ci_) const bool isc = (ci_) < 4; const int T = isc ? CTXL : SEQ, cc = isc ? (ci_) : (ci_) - 4; \
            const int t0 = d == 0 ? cc * 64 : T - 64 * (cc + 1), nb = isc ? NX + b * CTXL : b * SEQ; \
            const int tt = d == 0 ? t0 + ti : t0 + 63 - ti;
#define ML_PREFETCH(ci_) do { ML_GEOM(ci_) const bf16_t* row_ = PXM + (size_t)(nb + tt) * ML_COLS; \
            pq = *(const u32x4*)(row_ + h * 64 + 8 * j); pk = *(const u32x4*)(row_ + 256 + h * 64 + 8 * j); \
            pv0 = *(const u32x4*)(row_ + 512 + h * 128 + 16 * j); pv1 = *(const u32x4*)(row_ + 512 + h * 128 + 16 * j + 8); \
            if (wave == 0) { const int tl_ = d == 0 ? t0 + lane : t0 + 63 - lane; const bf16_t* rw_ = PXM + (size_t)(nb + tl_) * ML_COLS; pig = rw_[1536 + d * 4 + h]; pfg = rw_[1544 + d * 4 + h]; } } while (0)
        ML_PREFETCH(0);
        for (int ci = 0; ci < 36; ++ci) {
            ML_GEOM(ci)
            float q8[8], k8[8];
            {
                unpack8(pq, q8); unpack8(pk, k8);
                if (!isc) {
                    const int axis = j >> 2, half = (j >> 1) & 1; const float pos = (float)(axis == 0 ? (tt >> 6) : (tt & 63));
                    UNROLL for (int i = 0; i < 8; ++i) {
                        const int f = (j & 1) * 8 + i;
                        const float inv = exp2f(-(float)f * 0.83048202372184059f);
                        const float ang = pos * inv; const float cs = __cosf(ang), sn = __sinf(ang);
                        const float qo = __shfl_xor(q8[i], 2), ko = __shfl_xor(k8[i], 2);
                        q8[i] = half == 0 ? q8[i] * cs - qo * sn : q8[i] * cs + qo * sn;
                        k8[i] = half == 0 ? k8[i] * cs - ko * sn : k8[i] * cs + ko * sn;
                    }
                }
                UNROLL for (int i = 0; i < 8; ++i) q8[i] *= 0.125f;
                st8((bf16_t*)(QS + ti * LROW) + 8 * j, q8); st8((bf16_t*)(KC + ti * LROW) + 8 * j, k8);
                float v0[8], v1[8]; unpack8(pv0, v0); unpack8(pv1, v1);
                UNROLL for (int i = 0; i < 8; ++i) { *(bf16_t*)(VT + (16 * j + i) * LROW + ti * 2) = f2bf(v0[i]); *(bf16_t*)(VT + (16 * j + 8 + i) * LROW + ti * 2) = f2bf(v1[i]); }
                if (wave == 0) {
                    const float ig = bf2f(pig) + ib, fg = bf2f(pfg) + fb;
                    const float igc = 15.f * tanhf(ig * (1.f / 15.f)), fgc = 15.f * tanhf(fg * (1.f / 15.f));
                    float lf = -(fmaxf(-fgc, 0.f) + log1pf(expf(-fabsf(fgc))));
                    UNROLL for (int o = 1; o < 64; o <<= 1) { const float up = __shfl_up(lf, o); if (lane >= o) lf += up; }
                    BV[lane] = lf; GI[lane] = igc;
                }
            }
            __syncthreads();
            if (ci + 1 < 36) ML_PREFETCH(ci + 1);
            {
                const float bt = BV[ti], bl = BV[63], gi = GI[ti];
                const float eb = __expf(bt), wk = __expf(bl - bt + gi);
                float qp[8]; float dn = 0.f;
                UNROLL for (int i = 0; i < 8; ++i) { qp[i] = q8[i] * eb; dn += q8[i] * NV[8 * j + i]; }
                st8((bf16_t*)(QP + ti * LROW) + 8 * j, qp);
                UNROLL for (int i = 0; i < 8; ++i) *(bf16_t*)(KW + (8 * j + i) * LROW + ti * 2) = f2bf(k8[i] * wk);
                dn = sum8(dn);
                if (j == 0) DEN[ti] = dn * eb;
            }
            __syncthreads();
            UNROLL for (int rep = 0; rep < 2; ++rep) {
                const int tile = wave + 8 * rep;
                if (tile < 10) {
                    const int tt4 = tile < 1 ? 0 : tile < 3 ? 1 : tile < 6 ? 2 : 3, st4 = tile - (tt4 * (tt4 + 1)) / 2;
                    f32x4v a = {0.f, 0.f, 0.f, 0.f};
                    UNROLL for (int ks = 0; ks < 2; ++ks)
                        a = __builtin_amdgcn_mfma_f32_16x16x32_bf16(*(const bf16x8*)(QS + (16 * tt4 + lq) * LROW + ks * 64 + kg * 16),
                                                                    *(const bf16x8*)(KC + (16 * st4 + lq) * LROW + ks * 64 + kg * 16), a, 0, 0, 0);
                    const int sidx = 16 * st4 + lq; const float bs = BV[sidx], gs = GI[sidx];
                    UNROLL for (int i = 0; i < 4; ++i) {
                        const int tidx = 16 * tt4 + 4 * kg + i;
                        const float val = sidx <= tidx ? a[i] * __expf(BV[tidx] - bs + gs) : 0.f;
                        *(bf16_t*)(PM + tidx * LROW + sidx * 2) = f2bf(val);
                        const float rsum = sum16(val);
                        if (lq == 0) RS[tidx * 4 + st4] = rsum;
                    }
                }
            }
            __syncthreads();
            {
                bf16x8 vf[2], cb[2];
                UNROLL for (int kk = 0; kk < 2; ++kk) vf[kk] = *(const bf16x8*)(VT + (16 * wave + lq) * LROW + kk * 64 + kg * 16);
                UNROLL for (int kk = 0; kk < 2; ++kk) {
                    u32x4 w; w.x = pk2(cacc[2 * kk][0], cacc[2 * kk][1]); w.y = pk2(cacc[2 * kk][2], cacc[2 * kk][3]);
                    w.z = pk2(cacc[2 * kk + 1][0], cacc[2 * kk + 1][1]); w.w = pk2(cacc[2 * kk + 1][2], cacc[2 * kk + 1][3]);
                    cb[kk] = __builtin_bit_cast(bf16x8, w);
                }
                UNROLL for (int tt4 = 0; tt4 < 4; ++tt4) {
                    f32x4v hacc = {0.f, 0.f, 0.f, 0.f};
                    UNROLL for (int kk = 0; kk < 2; ++kk) if (2 * kk <= tt4)
                        hacc = __builtin_amdgcn_mfma_f32_16x16x32_bf16(*(const bf16x8*)(PM + (16 * tt4 + lq) * LROW + kk * 64 + kg * 16), vf[kk], hacc, 0, 0, 0);
                    UNROLL for (int kk = 0; kk < 2; ++kk) {
                        const char* qa = QP + (16 * tt4 + lq) * LROW + (32 * kk + 4 * kg) * 2;
                        const u32x2 lo = *(const u32x2*)qa, hi = *(const u32x2*)(qa + 32);
                        u32x4 w; w.x = lo.x; w.y = lo.y; w.z = hi.x; w.w = hi.y;
                        hacc = __builtin_amdgcn_mfma_f32_16x16x32_bf16(__builtin_bit_cast(bf16x8, w), cb[kk], hacc, 0, 0, 0);
                    }
                    UNROLL for (int i = 0; i < 4; ++i) {
                        const int tidx = 16 * tt4 + 4 * kg + i;
                        float den = DEN[tidx];
                        UNROLL for (int st = 0; st <= tt4; ++st) den += RS[tidx * 4 + st];
                        HO[tidx * 132 + 16 * wave + lq] = hacc[i] * frcp(fmaxf(fabsf(den), 1.f));
                    }
                }
                const float g = __expf(BV[63]);
                UNROLL for (int dk = 0; dk < 4; ++dk) {
                    cacc[dk] = cacc[dk] * g;
                    UNROLL for (int kk = 0; kk < 2; ++kk)
                        cacc[dk] = __builtin_amdgcn_mfma_f32_16x16x32_bf16(*(const bf16x8*)(KW + (16 * dk + lq) * LROW + kk * 64 + kg * 16), vf[kk], cacc[dk], 0, 0, 0);
                }
            }
            __syncthreads();
            if (tid < 64) {
                float acc = 0.f;
                UNROLL for (int c8 = 0; c8 < 8; ++c8) { float kw[8]; ld8((const bf16_t*)(KW + tid * LROW) + 8 * c8, kw); UNROLL for (int i = 0; i < 8; ++i) acc += kw[i]; }
                NV[tid] = __expf(BV[63]) * NV[tid] + acc;
            }
            {
                const float* hr = HO + ti * 132 + 16 * j;
                float o0[8], o1[8];
                UNROLL for (int i = 0; i < 8; ++i) { o0[i] = hr[i]; o1[i] = hr[8 + i]; }
                bf16_t* dst = HS + ((size_t)d * NT + nb + tt) * 512 + h * 128 + 16 * j;
                st8(dst, o0); st8(dst + 8, o1);
            }
            __syncthreads();
        }
    }
}
DEV void ph_ml_read(const Params& p, int L, int ntok) {
    const int lane = TID() & 63, wave = TID() >> 6;
    const bf16_t* PXM = (const bf16_t*)(p.ws + OFF_PX); const bf16_t* HS = (const bf16_t*)(p.ws + OFF_HS);
    bf16_t* YC = (bf16_t*)(p.ws + OFF_YC); const float* ng = p.in[I_MNG] + (size_t)L * 512;
    for (int n0 = blockIdx.x * 8; n0 < ntok; n0 += gridDim.x * 8) {
        const int n = n0 + wave, c = lane * 8;
        float h0[8], h1[8], o8[8], out[8];
        ld8(HS + (size_t)n * 512 + c, h0); ld8(HS + ((size_t)NT + n) * 512 + c, h1); ld8(PXM + (size_t)n * ML_COLS + 1024 + c, o8);
        float ss = 0.f;
        UNROLL for (int i = 0; i < 8; ++i) { h0[i] += h1[i]; ss += h0[i] * h0[i]; }
        ss += __shfl_xor(ss, 1); ss += __shfl_xor(ss, 2); ss += __shfl_xor(ss, 4); ss += __shfl_xor(ss, 8);
        const float r = rsqrtf(ss * (1.f / 128.f) + 1e-6f);
        UNROLL for (int i = 0; i < 8; ++i) out[i] = h0[i] * r * ng[c + i] * sigm(o8[i]);
        st8(YC + (size_t)n * 512 + c, out);
    }
}

DEV void ph_route(const Params& p, int L, int ntok, char* smem) {
    const int lane = TID() & 63, wave = TID() >> 6;
    const float* LOG = (const float*)(p.ws + OFF_LOG); int* EIDX = (int*)(p.ws + OFF_EIDX); float* EW = (float*)(p.ws + OFF_EW);
    const float bias = p.in[I_MB][L * 64 + lane];
    int* MCNT = (int*)(p.ws + OFF_MCNT);
    int* hist = (int*)smem;
    if (TID() < 192) hist[TID()] = 0;
    __syncthreads();
    for (int n0 = blockIdx.x * 8; n0 < ntok; n0 += gridDim.x * 8) {
        const int n = n0 + wave, g = lane >> 3;
        const float score = sigm_acc(LOG[(size_t)n * 64 + lane]), sel = score + bias;
        float m1 = sel; m1 = fmaxf(m1, __shfl_xor(m1, 1)); m1 = fmaxf(m1, __shfl_xor(m1, 2)); m1 = fmaxf(m1, __shfl_xor(m1, 4));
        int i1 = sel == m1 ? lane : 64; i1 = min(i1, __shfl_xor(i1, 1)); i1 = min(i1, __shfl_xor(i1, 2)); i1 = min(i1, __shfl_xor(i1, 4));
        float m2 = lane == i1 ? -3e38f : sel; m2 = fmaxf(m2, __shfl_xor(m2, 1)); m2 = fmaxf(m2, __shfl_xor(m2, 2)); m2 = fmaxf(m2, __shfl_xor(m2, 4));
        const float gs = m1 + m2;
        int rank = 0;
        UNROLL for (int g2 = 0; g2 < 8; ++g2) { const float v = __shfl(gs, g2 * 8); rank += (v > gs || (v == gs && g2 < g)) ? 1 : 0; }
        const float ms = rank < 4 ? sel : -1e30f;
        int er = 0;
        for (int e2 = 0; e2 < 64; ++e2) { const float v = __shfl(ms, e2); er += (v > ms || (v == ms && e2 < lane)) ? 1 : 0; }
        const bool chosen = er < 8;
        float ws = chosen ? score : 0.f;
        UNROLL for (int o = 1; o < 64; o <<= 1) ws += __shfl_xor(ws, o);
        if (chosen) { EIDX[(size_t)n * 8 + er] = lane; EW[(size_t)n * 8 + er] = score / ws * 2.5f; atomicAdd(hist + (n / MOE_CHUNK) * 64 + lane, 1); }
    }
    __syncthreads();
    if (TID() < 192 && hist[TID()] > 0) atomicAdd(MCNT + TID(), hist[TID()]);
    __syncthreads();
}


DEV void ph_moe_scatter(const Params& p, int ntok, char* smem) {
    const int tid = TID();
    int* base = (int*)smem;
    int* lh = base + 192;
    const int* MCNT = (const int*)(p.ws + OFF_MCNT); int* CUR = (int*)(p.ws + OFF_MCNT) + 192;
    const int* EIDX = (const int*)(p.ws + OFF_EIDX); int* SORT = (int*)(p.ws + OFF_SORT);
    if (tid < 3) { int b = 0; for (int e = 0; e < 64; ++e) { base[tid * 64 + e] = b; b += (MCNT[tid * 64 + e] + 127) & ~127; } }
    if (tid < 192) lh[tid] = 0;
    __syncthreads();
    for (int i = blockIdx.x * NTHREADS + tid; i < ntok * 8; i += gridDim.x * NTHREADS) atomicAdd(lh + ((i >> 3) / MOE_CHUNK) * 64 + EIDX[i], 1);
    __syncthreads();
    if (tid < 192) { const int n = lh[tid]; if (n > 0) base[tid] += atomicAdd(CUR + tid, n); lh[tid] = 0; }
    __syncthreads();
    for (int i = blockIdx.x * NTHREADS + tid; i < ntok * 8; i += gridDim.x * NTHREADS) {
        const int ce = ((i >> 3) / MOE_CHUNK) * 64 + EIDX[i];
        SORT[(size_t)(ce >> 6) * SORT_CAP + base[ce] + atomicAdd(lh + ce, 1)] = i;
    }
    __syncthreads();
}

DEV void ph_moe_exp(const Params& p, int cb, int ce, char* smem, Topo tp) {
    typedef GC<2, 4> C;
    const int tid0 = TID();
    char* ACT = smem + 2 * C::STG;
    int* list = (int*)(smem + 3 * C::STG);
    int* cnt = list + 1024;
    const bf16_t* H2 = (const bf16_t*)(p.ws + OFF_HX); const int* EIDX = (const int*)(p.ws + OFF_EIDX); const float* EW = (const float*)(p.ws + OFF_EW);
    unsigned char* YB8 = (unsigned char*)(p.ws + OFF_YBUF); unsigned char* YSC = (unsigned char*)(p.ws + OFF_YSC);
    const int c = cb / MOE_CHUNK;
    const int* MCNT = (const int*)(p.ws + OFF_MCNT) + c * 64; const int* SORT = (const int*)(p.ws + OFF_SORT) + (size_t)c * SORT_CAP;
    int* tb = cnt + 16;
    const int xcd = tp.x, slot = tp.r, nslot = tp.n;
    __syncthreads();
    if (tid0 < 8) {
        const int tid = tid0; const int e = xcd + 8 * tid; int b = 0;
        for (int e2 = 0; e2 < e; ++e2) b += (MCNT[e2] + 127) & ~127;
        tb[16 + tid] = b; tb[32 + tid] = MCNT[e];
    }
    __syncthreads();
    if (tid0 == 0) { int t = 0; for (int k = 0; k < 8; ++k) { tb[k] = t; t += (tb[32 + k] + 127) >> 7; } tb[8] = t; }
    __syncthreads();
    const int total = tb[8];
    float* ewl = (float*)(list + 256);
    if (slot < total && tid0 < 128) {
        int k = 0;
        while (k < 7 && slot >= tb[k + 1]) ++k;
        const int j = slot - tb[k], M = min(128, tb[32 + k] - 128 * j);
        const int en = SORT[tb[16 + k] + 128 * j + min(tid0, M - 1)];
        list[tid0] = en; ewl[tid0] = EW[en];
    }
    int cur = 0;
#define GLDS4(gp, lp) __builtin_amdgcn_global_load_lds((const __attribute__((address_space(1))) void*)(gp), (__attribute__((address_space(3))) void*)(lp), 4, 0, 0)
    for (int lu = slot; lu < total; lu += nslot) {
        int tid = tid0; asm volatile("" : "+v"(tid));
        const int lane = tid & 63, wave = tid >> 6, wm = wave / 4, wn = wave % 4, fr = lane & 31, fh = lane >> 5;
        int k = 0;
        while (k < 7 && lu >= tb[k + 1]) ++k;
        const int e = xcd + 8 * k, j = lu - tb[k], M = min(128, tb[32 + k] - 128 * j);
        const int* lst = list + cur * 128; const float* ew = ewl + cur * 128;
        int* lst2 = list + (cur ^ 1) * 128; float* ew2 = ewl + (cur ^ 1) * 128;
        const bool has_next = lu + nslot < total;
        __syncthreads();
        if (has_next && tid < 128) {
            const int lu2 = lu + nslot; int k2 = 0;
            while (k2 < 7 && lu2 >= tb[k2 + 1]) ++k2;
            const int j2 = lu2 - tb[k2], M2 = min(128, tb[32 + k2] - 128 * j2);
            GLDS4(SORT + tb[16 + k2] + 128 * j2 + min(tid, M2 - 1), lst2 + tid);
        }
        const bf16_t* GU = (const bf16_t*)(p.ws + OFF_MGU) + (size_t)e * 256 * 1024;
        const bf16_t* DT = (const bf16_t*)(p.ws + OFF_MDT) + (size_t)e * 1024 * 128;
        {
            constexpr int mc = 0;
            f32x16 acc[2][2];
            {
            acc_zero(acc);
            gemm_tile<2, 4, 3, false, true>(acc, [&](int r) -> const bf16_t* { const int ix = min(mc + r, M - 1); return H2 + (size_t)(lst[ix] >> 3) * 1024; },
                                   GU, 1024, 0, 256, 1024, smem, nullptr);
            }
            const int crow = tid >> 3, cch = (tid & 7) ^ ((crow >> 1) & 7);
#define MG2_ISSUE(nt_) do { UNROLL for (int kt = 0; kt < 2; ++kt) UNROLL for (int i = 0; i < 4; ++i) \
                    GLDS16(DT + (size_t)((nt_) * 256 + ((crow + 64 * i) & ~31) + p32(crow & 31)) * 128 + kt * 64 + cch * 8, smem + kt * C::STG + C::AB + i * 8192 + tid * 16); } while (0)
            if (has_next && tid < 128) GLDS4(EW + lst2[tid], ew2 + tid);
            MG2_ISSUE(0);
            UNROLL for (int mi = 0; mi < 2; ++mi) {
                const int row = wm * 64 + mi * 32 + fr;
                const float gw = ew[row];
                float a[2][8];
                UNROLL for (int r = 0; r < 16; ++r) { const float gv = acc[mi][0][r], uv = acc[mi][1][r]; a[r >> 3][r & 7] = gv * frcp(1.f + __expf(-gv)) * uv * gw; }
                const int col0 = wn * 32 + 16 * fh, c0 = (col0 & 63) >> 3, swr = (row >> 1) & 7;
                char* arow_ = ACT + (col0 >> 6) * C::AB + row * 128;
                st8((bf16_t*)(arow_ + ((c0 ^ swr) << 4)), a[0]); st8((bf16_t*)(arow_ + (((c0 + 1) ^ swr) << 4)), a[1]);
            }
            __syncthreads();
            {
                const int sw = (fr >> 1) & 7, a_base = (wm * 64 + fr) * 128, b_base = (wn * 64 + fr) * 128;
                asm volatile("s_waitcnt vmcnt(0)" ::: "memory");
                _Pragma("unroll 1") for (int nt = 0; nt < 4; ++nt) {
                    __builtin_amdgcn_s_barrier();
                    asm volatile("" ::: "memory");
                    acc_zero(acc);
                    UNROLL for (int kt = 0; kt < 2; ++kt) {
                        const char* As_ = ACT + kt * C::AB; const char* Bs_ = smem + kt * C::STG + C::AB;
                        UNROLL for (int ks = 0; ks < 4; ++ks) {
                            const int off = ((2 * ks + fh) ^ sw) * 16;
                            bf16x8 af[2], bfv[2];
                            UNROLL for (int mi = 0; mi < 2; ++mi) af[mi] = *(const bf16x8*)(As_ + a_base + mi * 4096 + off);
                            UNROLL for (int ni = 0; ni < 2; ++ni) bfv[ni] = *(const bf16x8*)(Bs_ + b_base + ni * 4096 + off);
                            UNROLL for (int mi = 0; mi < 2; ++mi) UNROLL for (int ni = 0; ni < 2; ++ni)
                                acc[mi][ni] = __builtin_amdgcn_mfma_f32_32x32x16_bf16(bfv[ni], af[mi], acc[mi][ni], 0, 0, 0);
                        }
                    }
                    asm volatile("s_waitcnt lgkmcnt(0)" ::: "memory");
                    __builtin_amdgcn_s_barrier();
                    asm volatile("" ::: "memory");
                    if (nt < 3) MG2_ISSUE(nt + 1);
                    asm volatile("" ::: "memory");
                    UNROLL for (int mi = 0; mi < 2; ++mi) {
                        const int en = lst[wm * 64 + mi * 32 + fr] - cb * 8;
                        unsigned char* yrow = YB8 + (size_t)en * 1024 + nt * 256 + wn * 64 + 16 * fh;
                        unsigned char* srow = YSC + ((size_t)(en >> 3) * 64 + nt * 16 + wn * 4 + fh) * 8 + (en & 7);
                        UNROLL for (int ni = 0; ni < 2; ++ni) {
                            float m = 0.f;
                            UNROLL for (int i = 0; i < 16; ++i) m = fmaxf(m, fabsf(acc[mi][ni][i]));
                            const unsigned be = max(__float_as_uint(m) >> 23, 7u);
                            const float inv = __uint_as_float((261u - be) << 23);
                            u32x4 w;
                            UNROLL for (int q = 0; q < 4; ++q) {
                                int d = 0;
                                d = __builtin_amdgcn_cvt_pk_fp8_f32(acc[mi][ni][4 * q] * inv, acc[mi][ni][4 * q + 1] * inv, d, false);
                                d = __builtin_amdgcn_cvt_pk_fp8_f32(acc[mi][ni][4 * q + 2] * inv, acc[mi][ni][4 * q + 3] * inv, d, true);
                                if (q == 0) w.x = (unsigned)d; else if (q == 1) w.y = (unsigned)d; else if (q == 2) w.z = (unsigned)d; else w.w = (unsigned)d;
                            }
                            *(u32x4*)(yrow + ni * 32) = w;
                            srow[ni * 16] = (unsigned char)be;
                        }
                    }
                    asm volatile("s_waitcnt vmcnt(8)" ::: "memory");
                }
#undef MG2_ISSUE
            }
        }
        cur ^= 1;
    }
#undef GLDS4
}


#define XB_TMO      128
#define XB_XCNT(j)  (256  + 64 * (j))
#define XB_XSUB(j)  (1280 + 64 * (j))
#define XB_XGEN(j)  (2304 + 64 * (j))
#define XB_TOP      3328
#define XB_TOPGEN   3392
#define XCD_BAR_WORDS 3456
#define XB_SPIN_CAP (1u << 18)
#define LAS __attribute__((address_space(3)))

__device__ __forceinline__ unsigned xb_ld(unsigned* p)              { return __hip_atomic_load(p, __ATOMIC_RELAXED, __HIP_MEMORY_SCOPE_AGENT); }
__device__ __forceinline__ unsigned xb_add(unsigned* p, unsigned v) { return __hip_atomic_fetch_add(p, v, __ATOMIC_RELAXED, __HIP_MEMORY_SCOPE_AGENT); }
__device__ __forceinline__ unsigned xb_xcc_id() { return (unsigned)__builtin_amdgcn_s_getreg((3 << 11) | 20) & 0xFu; }
#define XB_SPIN(cond, bar) do { unsigned _sp = 0; while (cond) { __builtin_amdgcn_s_sleep(1); \
    if ((++_sp & 255u) == 0u) { if (xb_ld(&(bar)[XB_TMO])) break; if (_sp > XB_SPIN_CAP) { atomicAdd(&(bar)[XB_TMO], 1u); break; } } } } while (0)

struct XcdBarrier { unsigned* bar; unsigned x; volatile LAS unsigned* st; };

__device__ __forceinline__ XcdBarrier xcd_barrier_post(unsigned* bar, volatile LAS unsigned* st) {
    XcdBarrier b; b.bar = bar; b.x = xb_xcc_id(); b.st = st;
    if (threadIdx.x == 0) { const unsigned rank = xb_add(&bar[XB_XCNT(b.x)], 1u); st[2] = b.x; st[3] = rank; }
    return b;
}
__device__ __forceinline__ void xcd_barrier_complete(unsigned* bar, unsigned x, unsigned& nloc, unsigned& nx) {
    const unsigned G = gridDim.x * gridDim.y * gridDim.z;
    unsigned sum, cnt, mine, sp = 0u;
    for (;;) {
        sum = 0u; cnt = 0u; mine = 0u;
#pragma unroll
        for (unsigned j = 0; j < 16; ++j) { const unsigned c = xb_ld(&bar[XB_XCNT(j)]); sum += c; cnt += (c > 0u) ? 1u : 0u; mine = (j == x) ? c : mine; }
        if (sum == G) break;
        __builtin_amdgcn_s_sleep(1);
        if ((++sp & 255u) == 0u) { if (xb_ld(&bar[XB_TMO])) break; if (sp > XB_SPIN_CAP) { atomicAdd(&bar[XB_TMO], 1u); break; } }
    }
    nloc = mine > 0u ? mine : 1u; nx = cnt > 0u ? cnt : 1u;
}
__device__ __forceinline__ void xcd_barrier(const XcdBarrier& b) {
    asm volatile("s_waitcnt vmcnt(0)" ::: "memory");
    __syncthreads();
    if (threadIdx.x == 0) {
        unsigned* bar = b.bar;
        __builtin_amdgcn_s_waitcnt(0);
        unsigned nloc = b.st[0], nx = b.st[1];
        if (nloc == 0u) { xcd_barrier_complete(bar, b.x, nloc, nx); b.st[0] = nloc; b.st[1] = nx; }
        const unsigned old = xb_add(&bar[XB_XSUB(b.x)], 1u);
        const unsigned gen = old / nloc;
        if (old + 1u == (gen + 1u) * nloc) {
            __builtin_amdgcn_fence(__ATOMIC_RELEASE, "agent");
            asm volatile("s_waitcnt vmcnt(0)" ::: "memory");
            const unsigned og = xb_add(&bar[XB_TOP], 1u);
            const unsigned tg = og / nx;
            if (og + 1u == (tg + 1u) * nx) xb_add(&bar[XB_TOPGEN], 1u);
            else XB_SPIN(xb_ld(&bar[XB_TOPGEN]) == tg, bar);
            __builtin_amdgcn_fence(__ATOMIC_ACQUIRE, "agent");
            xb_add(&bar[XB_XGEN(b.x)], 1u);
            asm volatile("s_waitcnt vmcnt(0)" ::: "memory");
        } else {
            XB_SPIN(xb_ld(&bar[XB_XGEN(b.x)]) == gen, bar);
            __builtin_amdgcn_fence(__ATOMIC_ACQUIRE, "agent");
            asm volatile("s_waitcnt vmcnt(0)" ::: "memory");
        }
    }
    __syncthreads();
}

enum { PH_MODCONV = 0, PH_HX, PH_GEMM_R, PH_RW_PREP, PH_RW_SCAN, PH_RW_READ, PH_RW_G, PH_GEMM_N, PH_NA_NORM, PH_NA_ATT, PH_GEMM_M, PH_ML_SCAN, PH_ML_READ,
       PH_GEMM_G, PH_MERGE, PH_OUT, PH_NORM2, PH_ROUTER, PH_ROUTE, PH_SHARED, PH_MOE_EXP, PH_MOE_COMB, PH_COUNT };

template <int PH> DEV void run_phase(const Params& p, int L, int sub, char* smem, Topo tp) {
    const int tid = TID(), lane = tid & 63, fr = lane & 31, fh = lane >> 5;
    char* ws = p.ws;
    const int ntl = L == 0 ? NT : NX;
    const bf16_t* HX = (const bf16_t*)(ws + OFF_HX);
    const bf16_t* WINT = (const bf16_t*)(ws + OFF_WINT);
    if constexpr (PH == PH_MODCONV) { ph_mod(p, L, smem); ph_conv_mix(p, L, smem); }
    else if constexpr (PH == PH_HX) { ph_norm(p, L, 0, NT); }
    else if constexpr (PH == PH_GEMM_R || PH == PH_GEMM_M) {
        const int c0 = PH == PH_GEMM_R ? 0 : RW_COLS + NA_COLS;
        const int N = PH == PH_GEMM_R ? RW_COLS : ML_COLS;
        bf16_t* PX = (bf16_t*)(ws + OFF_PX);
        gemm256(HX, NT, WINT + (size_t)c0 * DM, N, DM, smem, tp, [&](int row, int col, const float (&v)[8]) {
            if (col < N) st8(PX + (size_t)row * N + col, v);
        });
    }
    else if constexpr (PH == PH_GEMM_N) {
        bf16_t* PX = (bf16_t*)(ws + OFF_PX); bf16_t* VT = (bf16_t*)(ws + OFF_VT); bf16_t* VTC = (bf16_t*)(ws + OFF_VTC);
        gemm256(HX, NT, WINT + (size_t)RW_COLS * DM, 1024, DM, smem, tp, [&](int row, int col, const float (&v)[8]) { st8(PX + (size_t)row * 1024 + col, v); });
        gemm_phase<4, 2>(HX, DM, NT, WINT + (size_t)(RW_COLS + 1024) * DM, DM, 512, DM, smem, tp, [&](const f32x16 (&acc)[2][2], int row0, int col0) {
            const int h = col0 >> 6;
            epi_cols(acc, smem, [&](int r8, int col, const float (&v)[8]) {
                const int n = row0 + r8;
                bf16_t* dst = n < NX ? VT + ((size_t)((n >> 11) * 8 + h) * 64 + col) * SEQ + (n & 2047)
                                     : VTC + ((size_t)(((n - NX) >> 8) * 8 + h) * 64 + col) * CTXL + ((n - NX) & 255);
                st8(dst, v);
            });
        });
    }
    else if constexpr (PH == PH_RW_PREP) { ph_rw_prep(p, L, smem); }
    else if constexpr (PH == PH_RW_SCAN) { ph_rw_scan(p, L, smem); }
    else if constexpr (PH == PH_RW_READ) { ph_rw_read(p, L, ntl); }
    else if constexpr (PH == PH_RW_G) {
        bf16_t* YA = (bf16_t*)(ws + OFF_YA);
        gemm_phase<4, 2>((const bf16_t*)(ws + OFF_SGB), 128, ntl, (const bf16_t*)(ws + OFF_G2T), 128, 512, 128, smem, tp, [&](const f32x16 (&acc)[2][2], int row0, int col0) {
            epi_rows(acc, smem, [&](int row, int c8, const float (&v)[8]) {
                bf16_t* q = YA + (size_t)(row0 + row) * 512 + col0 + c8;
                float y[8]; ld8(q, y);
                UNROLL for (int i = 0; i < 8; ++i) y[i] *= v[i];
                st8(q, y);
            });
        });
    }
    else if constexpr (PH == PH_NA_NORM) { ph_na_norm(p, L); }
    else if constexpr (PH == PH_NA_ATT) { ph_na_att(p, L, smem); }
    else if constexpr (PH == PH_ML_SCAN) {
        if (blockIdx.x < 128 || gridDim.x <= 128) ph_ml_scan(p, L, smem);
        if (gridDim.x <= 128) ph_conv_moe_gu(p, L, smem, blockIdx.x, gridDim.x);
        else if (blockIdx.x >= 128) ph_conv_moe_gu(p, L, smem, blockIdx.x - 128, gridDim.x - 128);
    }
    else if constexpr (PH == PH_ML_READ) { ph_ml_read(p, L, ntl); }
    else if constexpr (PH == PH_GEMM_G) {
        bf16_t* G = (bf16_t*)(ws + OFF_GATES);
        gemm256(HX, ntl, WINT + (size_t)(RW_COLS + NA_COLS + ML_COLS) * DM, GATE_COLS, DM, smem, tp, [&](int row, int col, const float (&v)[8]) {
            float y[8];
            UNROLL for (int i = 0; i < 8; ++i) y[i] = sigm(v[i]);
            st8(G + (size_t)row * GATE_COLS + col, y);
        });
    }
    else if constexpr (PH == PH_MERGE) {
        const bf16_t* G = (const bf16_t*)(ws + OFF_GATES); bf16_t* MG = (bf16_t*)(ws + OFF_HX);
        _Pragma("unroll 1") for (int br = 0; br < 3; ++br) {
            gemm256((const bf16_t*)(ws + OFF_YA + (size_t)br * SZ_Y1), ntl, (const bf16_t*)(ws + OFF_WBT) + (size_t)br * 1024 * 512, DM, 512, smem, tp, [&](int row, int col, const float (&v)[8]) {
                float g[8], m[8];
                ld8(G + (size_t)row * GATE_COLS + br * DM + col, g);
                bf16_t* q = MG + (size_t)row * DM + col;
                if (br == 0) { UNROLL for (int i = 0; i < 8; ++i) m[i] = g[i] * v[i]; }
                else { ld8(q, m); UNROLL for (int i = 0; i < 8; ++i) m[i] += g[i] * v[i]; }
                st8(q, m);
            });
        }
    }
    else if constexpr (PH == PH_OUT) {
        const float* MOD = (const float*)(ws + OFF_MOD);
        gemm256(HX, ntl, (const bf16_t*)(ws + OFF_WOUTT), DM, DM, smem, tp, [&](int n, int c, const float (&v)[8]) {
            const float* xp = xprev_row(p, L, n) + c; float* xo = xs_row(p, n) + c; const float* g1 = MOD + mod_row(n) * 6144 + 2 * DM + c;
            const float4 xa = *(const float4*)xp, xb = *(const float4*)(xp + 4), ga = *(const float4*)g1, gb = *(const float4*)(g1 + 4);
            float4 oa, ob;
            oa.x = xa.x + ga.x * v[0]; oa.y = xa.y + ga.y * v[1]; oa.z = xa.z + ga.z * v[2]; oa.w = xa.w + ga.w * v[3];
            ob.x = xb.x + gb.x * v[4]; ob.y = xb.y + gb.y * v[5]; ob.z = xb.z + gb.z * v[6]; ob.w = xb.w + gb.w * v[7];
            *(float4*)xo = oa; *(float4*)(xo + 4) = ob;
        });
    }
    else if constexpr (PH == PH_NORM2) {
        if (blockIdx.x == 0 && tid < 384) ((int*)(ws + OFF_MCNT))[tid] = 0;
        ph_norm(p, L, 1, ntl);
    }
    else if constexpr (PH == PH_ROUTER) {
        typedef GC<4, 2> C;
        float* LOG = (float*)(ws + OFF_LOG);
        const bf16_t* H2LO = (const bf16_t*)(ws + OFF_H2LO); const bf16_t* RH = (const bf16_t*)(ws + OFF_RTR); const bf16_t* RL = RH + 64 * 1024;
        const int wave = tid >> 6, wm = wave / 2, wn = wave % 2;
        {
            const int nrt = ntl / C::BM, G = gridDim.x;
            if (G > nrt) { if ((int)blockIdx.x >= nrt) ph_conv_moe(p, L, smem, blockIdx.x - nrt, G - nrt); }
            else ph_conv_moe(p, L, smem, blockIdx.x, G);
        }
        for (int t = blockIdx.x; t < ntl / C::BM; t += gridDim.x) {
            f32x16 acc[2][2]; acc_zero(acc);
            const bf16_t* A0 = HX + (size_t)t * C::BM * DM; const bf16_t* A1 = H2LO + (size_t)t * C::BM * DM;
            gemm_tile<4, 2, 3, false>(acc, [&](int r) { return A0 + (size_t)r * DM; }, RH, DM, 0, 64, DM, smem, nullptr);
            gemm_tile<4, 2, 3, false>(acc, [&](int r) { return A1 + (size_t)r * DM; }, RH, DM, 0, 64, DM, smem, nullptr);
            gemm_tile<4, 2, 3, false>(acc, [&](int r) { return A0 + (size_t)r * DM; }, RL, DM, 0, 64, DM, smem, nullptr);
            epi_rows(acc, smem, [&](int row, int c8, const float (&v)[8]) {
                if (wn == 0) {
                    float* q = LOG + (size_t)(t * C::BM + wm * 64 + row) * 64 + c8;
                    *(float4*)q = make_float4(v[0], v[1], v[2], v[3]); *(float4*)(q + 4) = make_float4(v[4], v[5], v[6], v[7]);
                }
            });
        }
    }
    else if constexpr (PH == PH_ROUTE) { ph_route(p, L, ntl, smem); }
    else if constexpr (PH == PH_SHARED) {
        ph_moe_scatter(p, ntl, smem);
        bf16_t* SA = (bf16_t*)(ws + OFF_SA);
        gemm256_pair(HX, ntl, (const bf16_t*)(ws + OFF_SGUT), 512, DM, smem, tp, [&](int row, int col, const float (&g)[8], const float (&u)[8]) {
            float a[8];
            UNROLL for (int i = 0; i < 8; ++i) a[i] = g[i] * frcp(1.f + __expf(-g[i])) * u[i];
            st8(SA + (size_t)row * 256 + (col >> 8) * 128 + (col & 127), a);
        });
    }
    else if constexpr (PH == PH_MOE_EXP) { const int cb = sub * MOE_CHUNK; ph_moe_exp(p, cb, min(cb + MOE_CHUNK, ntl), smem, tp); }
    else if constexpr (PH == PH_MOE_COMB) {
        const int cb = sub * MOE_CHUNK, ce = min(cb + MOE_CHUNK, ntl);
        const float* MOD = (const float*)(ws + OFF_MOD); const unsigned char* YB8 = (const unsigned char*)(ws + OFF_YBUF); const unsigned char* YSC = (const unsigned char*)(ws + OFF_YSC);
        gemm256((const bf16_t*)(ws + OFF_SA) + (size_t)cb * 256, ce - cb, (const bf16_t*)(ws + OFF_SDT), DM, 256, smem, tp, [&](int rl, int c, const float (&v)[8]) {
            const int n = cb + rl;
            float s[8];
            UNROLL for (int i = 0; i < 8; ++i) s[i] = v[i];
            const u32x2 sc = *(const u32x2*)(YSC + ((size_t)rl * 64 + (c >> 4)) * 8);
            const unsigned long long sc64 = (unsigned long long)sc.x | ((unsigned long long)sc.y << 32);
            _Pragma("unroll 2") for (int k = 0; k < 8; ++k) {
                const u32x2 d = *(const u32x2*)(YB8 + ((size_t)rl * 8 + k) * DM + c);
                const unsigned be = (unsigned)(sc64 >> (8 * k)) & 255u;
                const float scl = __uint_as_float((be - 7u) << 23);
                typedef float f2v __attribute__((ext_vector_type(2)));
                const f2v y0 = __builtin_amdgcn_cvt_pk_f32_fp8((int)d.x, false), y1 = __builtin_amdgcn_cvt_pk_f32_fp8((int)d.x, true);
                const f2v y2 = __builtin_amdgcn_cvt_pk_f32_fp8((int)d.y, false), y3 = __builtin_amdgcn_cvt_pk_f32_fp8((int)d.y, true);
                s[0] += y0.x * scl; s[1] += y0.y * scl; s[2] += y1.x * scl; s[3] += y1.y * scl;
                s[4] += y2.x * scl; s[5] += y2.y * scl; s[6] += y3.x * scl; s[7] += y3.y * scl;
            }
            float* xo = xs_row(p, n) + c; const float* g2 = MOD + mod_row(n) * 6144 + 5 * DM + c;
            float4 xa = *(const float4*)xo, xb = *(const float4*)(xo + 4); const float4 ga = *(const float4*)g2, gb = *(const float4*)(g2 + 4);
            xa.x += ga.x * s[0]; xa.y += ga.y * s[1]; xa.z += ga.z * s[2]; xa.w += ga.w * s[3];
            xb.x += gb.x * s[4]; xb.y += gb.y * s[5]; xb.z += gb.z * s[6]; xb.w += gb.w * s[7];
            *(float4*)xo = xa; *(float4*)(xo + 4) = xb;
        });
    }
}

#ifndef N_LAUNCH_MODE
#define N_LAUNCH_MODE 1
#endif
#if N_LAUNCH_MODE == 0
template <int PH> __global__ void __launch_bounds__(NTHREADS, 2) k_phase(Params p, int L, int sub) {
    extern __shared__ __attribute__((aligned(16))) char smem[];
    run_phase<PH>(p, L, sub, smem, Topo{(int)(blockIdx.x & 7), (int)(blockIdx.x >> 3), (int)((gridDim.x + 7 - (blockIdx.x & 7)) >> 3)});
}
#endif


#ifndef MEGA_SKIP
#define MEGA_SKIP 0ull
#endif
#ifndef MEGA_REPEAT
#define MEGA_REPEAT 0ull
#endif
#define BARRIER() do { XcdBarrier b2_ = bar; unsigned so_ = LDS_BYTES; asm volatile("" : "+v"(so_)); b2_.st = (volatile LAS unsigned*)(smem + so_); xcd_barrier(b2_); } while (0)
#define PHASE(PH, sub) do { if constexpr (!((MEGA_SKIP >> PH) & 1ull)) { run_phase<PH>(p, L, sub, smem, tp); BARRIER(); if constexpr ((MEGA_REPEAT >> PH) & 1ull) { run_phase<PH>(p, L, sub, smem, tp); BARRIER(); } } } while (0)
__global__ void __launch_bounds__(NTHREADS, 2) k_mega(Params p) {
    extern __shared__ __attribute__((aligned(16))) char smem[];
    volatile LAS unsigned* st = (volatile LAS unsigned*)(smem + LDS_BYTES);
    if (threadIdx.x == 0) { st[0] = 0u; st[1] = 0u; st[2] = 0u; st[3] = 0u; }
    __syncthreads();
    const XcdBarrier bar = xcd_barrier_post((unsigned*)(p.ws + OFF_BAR), st);
    Topo tp{(int)(blockIdx.x & 7), (int)(blockIdx.x >> 3), (int)((gridDim.x + 7 - (blockIdx.x & 7)) >> 3)};
    for (int L = 0; L < 2; ++L) {
        const int ntl = L == 0 ? NT : NX;
        PHASE(PH_MODCONV, 0);
        if (st[1] == 8u && st[0] != 0u) { tp.x = (int)st[2]; tp.r = (int)st[3]; tp.n = (int)st[0]; }
        PHASE(PH_HX, 0);
        PHASE(PH_GEMM_R, 0);
        PHASE(PH_RW_PREP, 0);
        PHASE(PH_RW_SCAN, 0);
        PHASE(PH_RW_READ, 0);
        PHASE(PH_RW_G, 0);
        PHASE(PH_GEMM_N, 0);
        PHASE(PH_NA_ATT, 0);
        PHASE(PH_GEMM_M, 0);
        PHASE(PH_ML_SCAN, 0);
        PHASE(PH_ML_READ, 0);
        PHASE(PH_GEMM_G, 0);
        PHASE(PH_MERGE, 0);
        PHASE(PH_OUT, 0);
        PHASE(PH_NORM2, 0);
        PHASE(PH_ROUTER, 0);
        PHASE(PH_ROUTE, 0);
        PHASE(PH_SHARED, 0);
        for (int c = 0; c * MOE_CHUNK < ntl; ++c) {
            PHASE(PH_MOE_EXP, c);
            PHASE(PH_MOE_COMB, c);
        }
    }
}

#if N_LAUNCH_MODE == 0
template <int PH> static void launch_phase(const Params& p, int L, int sub, hipStream_t stream) {
    static bool attr = false;
    if (!attr) { (void)hipFuncSetAttribute((const void*)k_phase<PH>, hipFuncAttributeMaxDynamicSharedMemorySize, LDS_BYTES); attr = true; }
    hipLaunchKernelGGL(k_phase<PH>, dim3(256), dim3(NTHREADS), LDS_BYTES, stream, p, L, sub);
}
#endif

extern "C" void kernel_launch(void* const* d_in, const int* in_sizes, int n_in, void* d_out, int out_size, void* d_ws, size_t ws_size, hipStream_t stream) {
    if (n_in != N_IN || ws_size < WS_END) { fprintf(stderr, "kernel_launch: unexpected inputs (%d) or workspace (%zu < %zu)\n", n_in, ws_size, (size_t)WS_END); return; }
    Params p{};
    for (int i = 0; i < N_IN; ++i) p.in[i] = (const float*)d_in[i];
    p.out = (float*)d_out; p.ws = (char*)d_ws;
#if N_LAUNCH_MODE == 1
    static int grid = 0;
    if (grid == 0) {
        int dev = 0, cus = 0;
        if (hipGetDevice(&dev) != hipSuccess || hipDeviceGetAttribute(&cus, hipDeviceAttributeMultiprocessorCount, dev) != hipSuccess) { grid = -1; return; }
        if (hipFuncSetAttribute((const void*)k_mega, hipFuncAttributeMaxDynamicSharedMemorySize, LDS_BYTES + 256) != hipSuccess) { grid = -1; return; }
        grid = cus;
    }
    if (grid <= 0) return;
    (void)hipMemsetAsync((char*)d_ws + OFF_BAR, 0, XCD_BAR_WORDS * sizeof(unsigned), stream);
    hipLaunchKernelGGL(k_mega, dim3(grid), dim3(NTHREADS), LDS_BYTES + 256, stream, p);
    return;
#endif
#if N_LAUNCH_MODE == 0
    for (int L = 0; L < 2; ++L) {
        const int ntl = L == 0 ? NT : NX;
        launch_phase<PH_MODCONV>(p, L, 0, stream);
        launch_phase<PH_HX>(p, L, 0, stream);
        launch_phase<PH_GEMM_R>(p, L, 0, stream);
        launch_phase<PH_RW_PREP>(p, L, 0, stream);
        launch_phase<PH_RW_SCAN>(p, L, 0, stream);
        launch_phase<PH_RW_READ>(p, L, 0, stream);
        launch_phase<PH_RW_G>(p, L, 0, stream);
        launch_phase<PH_GEMM_N>(p, L, 0, stream);
        launch_phase<PH_NA_ATT>(p, L, 0, stream);
        launch_phase<PH_GEMM_M>(p, L, 0, stream);
        launch_phase<PH_ML_SCAN>(p, L, 0, stream);
        launch_phase<PH_ML_READ>(p, L, 0, stream);
        launch_phase<PH_GEMM_G>(p, L, 0, stream);
        launch_phase<PH_MERGE>(p, L, 0, stream);
        launch_phase<PH_OUT>(p, L, 0, stream);
        launch_phase<PH_NORM2>(p, L, 0, stream);
        launch_phase<PH_ROUTER>(p, L, 0, stream);
        launch_phase<PH_ROUTE>(p, L, 0, stream);
        launch_phase<PH_SHARED>(p, L, 0, stream);
        for (int c = 0; c * MOE_CHUNK < ntl; ++c) {
            launch_phase<PH_MOE_EXP>(p, L, c, stream);
            launch_phase<PH_MOE_COMB>(p, L, c, stream);
        }
    }
#endif
}
```

```cpp
#include <hip/hip_runtime.h>
#include <stdint.h>
#include <stdio.h>

#define DEV __device__ __forceinline__
#define UNROLL _Pragma("unroll")

typedef unsigned short bf16_t;
typedef short bf16x8 __attribute__((ext_vector_type(8)));
typedef float f32x16 __attribute__((ext_vector_type(16)));
typedef float f32x4v __attribute__((ext_vector_type(4)));
typedef unsigned u32x4 __attribute__((ext_vector_type(4)));
typedef unsigned u32x2 __attribute__((ext_vector_type(2)));

constexpr int DM = 1024, NBATCH = 16, SEQ = 2048, CTXL = 256;
constexpr int NX = NBATCH * SEQ, NC = NBATCH * CTXL, NT = NX + NC;
constexpr int RW_COLS = 1920, NA_COLS = 1536, ML_COLS = 1552, GATE_COLS = 3072, IN_COLS = 8080;
constexpr int NTHREADS = 512;
constexpr int MOE_CHUNK = 16384, MOE_ST = 768;

enum { I_X = 0, I_C, I_CTX, I_CCTX, I_WADA, I_BADA, I_N1G, I_N2G, I_WIN, I_MU, I_W0, I_W2, I_A0, I_A2, I_KK, I_KA, I_RK, I_G2,
       I_LNG, I_LNB, I_V0, I_V1, I_V2, I_QNG, I_KNG, I_RPB, I_IB, I_FB, I_MNG, I_WBR, I_WOUT, I_RTR, I_MB, I_MWG, I_MWU, I_MWD,
       I_SG, I_SU, I_SD, N_IN };

constexpr size_t OFF_BAR = 0;
constexpr size_t OFF_MOD = 16384;
constexpr size_t OFF_WINT = OFF_MOD + 417792;
constexpr size_t OFF_WBT = OFF_WINT + (size_t)IN_COLS * 1024 * 2;
constexpr size_t OFF_WOUTT = OFF_WBT + (size_t)3 * 1024 * 512 * 2;
constexpr size_t OFF_SGUT = OFF_WOUTT + (size_t)1024 * 1024 * 2;
constexpr size_t OFF_SDT = OFF_SGUT + (size_t)512 * 1024 * 2;
constexpr size_t OFF_G2T = OFF_SDT + (size_t)1024 * 256 * 2;
constexpr size_t OFF_RTR = OFF_G2T + (size_t)512 * 128 * 2;
constexpr size_t OFF_CTXS = OFF_RTR + (size_t)2 * 64 * 1024 * 2;
constexpr size_t OFF_VF = OFF_CTXS + (size_t)NC * 1024 * 4;
constexpr size_t OFF_HX = OFF_VF + (size_t)NT * 512 * 2;
constexpr size_t OFF_BIG = OFF_HX + (size_t)NT * 1024 * 2;
constexpr size_t SZ_Y1 = (size_t)NT * 512 * 2;
constexpr size_t OFF_YA = OFF_BIG, OFF_YB = OFF_YA + SZ_Y1, OFF_YC = OFF_YB + SZ_Y1;
constexpr size_t OFF_PX = OFF_BIG + 3 * SZ_Y1;
constexpr size_t OFF_SCR = OFF_PX + (size_t)NT * RW_COLS * 2;
constexpr size_t SZ_SCR = (size_t)NT * 1152 * 2;
constexpr size_t OFF_MGU = OFF_SCR + SZ_SCR;
constexpr size_t WS_END = OFF_MGU + (size_t)64 * 256 * 1024 * 2;
constexpr size_t OFF_YS = OFF_YB;
constexpr size_t OFF_SGB = OFF_SCR;
constexpr size_t OFF_CB = OFF_SCR + (size_t)NT * 128 * 2;
constexpr size_t OFF_HS = OFF_SCR;
constexpr size_t OFF_VT = OFF_PX + (size_t)NT * 1024 * 2;
constexpr size_t OFF_VTC = OFF_VT + (size_t)NX * 512 * 2;
constexpr size_t OFF_GATES = OFF_PX;
constexpr size_t OFF_MDT = OFF_BIG;
constexpr size_t OFF_SA = OFF_MDT + (size_t)64 * 1024 * 128 * 2;
constexpr size_t OFF_EIDX = OFF_SA + (size_t)NT * 256 * 2;
constexpr size_t OFF_EW = OFF_EIDX + (size_t)NT * 8 * 4;
constexpr int SORT_CAP = MOE_CHUNK * 8 + 64 * 128;
constexpr size_t OFF_SORT = OFF_EW + (size_t)NT * 8 * 4;
constexpr size_t OFF_LOG = OFF_SORT + (size_t)3 * SORT_CAP * 4;
constexpr size_t OFF_H2LO = OFF_LOG + (size_t)NT * 64 * 4;
constexpr size_t OFF_YBUF = OFF_LOG;
constexpr size_t OFF_YSC = OFF_YBUF + (size_t)MOE_CHUNK * 8 * 1024;
static_assert(OFF_YSC + (size_t)MOE_CHUNK * 512 <= WS_END, "moe layout");
static_assert(OFF_GATES + (size_t)NT * 3072 * 2 <= WS_END, "gates layout");
static_assert(WS_END <= (size_t)536870912, "workspace");

constexpr size_t OFF_MCNT = OFF_BAR + 14336;
constexpr int LDS_BYTES = 155648;

struct Topo { int x, r, n; };
struct Params {
    const float* in[N_IN];
    float* out;
    char* ws;
};

DEV int TID() { int t = threadIdx.x; asm volatile("" : "+v"(t)); return t; }
DEV float bf2f(bf16_t h) { return __uint_as_float(((unsigned)h) << 16); }
typedef __bf16 bf16x2n __attribute__((ext_vector_type(2)));
typedef float f32x2n __attribute__((ext_vector_type(2)));
DEV unsigned pk2(float lo, float hi) { const f32x2n v = {lo, hi}; return __builtin_bit_cast(unsigned, __builtin_convertvector(v, bf16x2n)); }
DEV bf16_t f2bf(float f) { return (bf16_t)(pk2(f, 0.f) & 0xffffu); }
DEV void ld8(const bf16_t* p, float (&o)[8]) {
    const u32x4 v = *(const u32x4*)p;
    o[0] = __uint_as_float(v.x << 16); o[1] = __uint_as_float(v.x & 0xffff0000u);
    o[2] = __uint_as_float(v.y << 16); o[3] = __uint_as_float(v.y & 0xffff0000u);
    o[4] = __uint_as_float(v.z << 16); o[5] = __uint_as_float(v.z & 0xffff0000u);
    o[6] = __uint_as_float(v.w << 16); o[7] = __uint_as_float(v.w & 0xffff0000u);
}
DEV void st8(bf16_t* p, const float (&v)[8]) {
    u32x4 o; o.x = pk2(v[0], v[1]); o.y = pk2(v[2], v[3]); o.z = pk2(v[4], v[5]); o.w = pk2(v[6], v[7]);
    *(u32x4*)p = o;
}
#define DPP_MOV(v, ctrl) __builtin_bit_cast(float, __builtin_amdgcn_update_dpp(0, __builtin_bit_cast(int, (v)), (ctrl), 0xF, 0xF, true))
DEV float sum8(float v) { v += DPP_MOV(v, 0xB1); v += DPP_MOV(v, 0x4E); v += DPP_MOV(v, 0x141); return v; }
DEV float frcp(float x) { return __builtin_amdgcn_rcpf(x); }
DEV float sigm(float x) { return frcp(1.f + __expf(-x)); }
DEV float sigm_acc(float x) { return 1.f / (1.f + expf(-x)); }
DEV float tanh_fast(float x) { return 1.f - 2.f * frcp(1.f + __expf(2.f * x)); }
DEV float softplus_fast(float x) { return fmaxf(x, 0.f) + __logf(1.f + __expf(-fabsf(x))); }
DEV int mod_row(int n) { return n < NX ? (n >> 11) : 16; }
DEV float* xs_row(const Params& p, int n) { return n < NX ? p.out + (size_t)n * DM : (float*)(p.ws + OFF_CTXS) + (size_t)(n - NX) * DM; }
DEV const float* xprev_row(const Params& p, int L, int n) {
    if (L == 0) return n < NX ? p.in[I_X] + (size_t)n * DM : p.in[I_CTX] + (size_t)(n - NX) * DM;
    return xs_row(p, n);
}
DEV void seq_of(int n, int& nb, int& tt, int& T) {
    if (n < NX) { nb = n & ~2047; tt = n & 2047; T = SEQ; } else { const int m = n - NX; nb = NX + (m & ~255); tt = m & 255; T = CTXL; }
}
DEV void shift8(const bf16_t* z, int ld, int nb, int tt, int T, int col0, const float* mu, float (&o)[8]) {
    float c[8], l[8], r[8];
    ld8(z + (size_t)(nb + tt) * ld + col0, c);
    if (tt > 0) ld8(z + (size_t)(nb + tt - 1) * ld + col0, l); else { UNROLL for (int i = 0; i < 8; ++i) l[i] = 0.f; }
    if (tt < T - 1) ld8(z + (size_t)(nb + tt + 1) * ld + col0, r); else { UNROLL for (int i = 0; i < 8; ++i) r[i] = 0.f; }
    UNROLL for (int i = 0; i < 8; ++i) o[i] = c[i] + mu[col0 + i] * (0.5f * (l[i] + r[i]) - c[i]);
}

constexpr int LROW = 144;
template <int WM, int WN> struct GC {
    static constexpr int BM = 64 * WM, BN = 64 * WN;
    static constexpr int AB = BM * 128, BB = BN * 128, STG = AB + BB;
    static constexpr int NA = BM / 64, NBC = BN / 64;
};
DEV void acc_zero(f32x16 (&acc)[2][2]) {
    UNROLL for (int a = 0; a < 2; ++a) UNROLL for (int b = 0; b < 2; ++b) UNROLL for (int r = 0; r < 16; ++r) acc[a][b][r] = 0.f;
}
#define GLDS16(gp, lp) __builtin_amdgcn_global_load_lds((const __attribute__((address_space(1))) void*)(gp), (__attribute__((address_space(3))) void*)(lp), 16, 0, 0)
DEV int p32(int s) { return 16 * ((s >> 2) & 1) + (s & 3) + 4 * (s >> 3); }
template <int WM, int WN, int NS, bool A_LDS, bool TR = false, class ARow>
DEV void gemm_tile(f32x16 (&acc)[2][2], ARow arow, const bf16_t* Bt, int ldb, int n0, int Nvalid, int K, char* smem, const char* alds) {
    typedef GC<WM, WN> C;
    constexpr int LPT = (A_LDS ? 0 : C::NA) + C::NBC;
    const int tid = TID(), lane = tid & 63, wave = tid >> 6, wm = wave / WN, wn = wave % WN;
    const int fr = lane & 31, fh = lane >> 5;
    const int crow = tid >> 3, cch = (tid & 7) ^ ((crow >> 1) & 7);
    const bf16_t* pa[C::NA]; const bf16_t* pb[C::NBC];
    if (!A_LDS) { UNROLL for (int i = 0; i < C::NA; ++i) pa[i] = arow(crow + 64 * i) + cch * 8; }
    UNROLL for (int i = 0; i < C::NBC; ++i) { const int rb = crow + 64 * i, n = min(n0 + (TR ? (rb & ~31) + p32(rb & 31) : rb), Nvalid - 1); pb[i] = Bt + (size_t)n * ldb + cch * 8; }
    const int nk = K >> 6;
#define GT_ISSUE(kt, stg) do { char* sb_ = smem + (stg) * C::STG + tid * 16; \
        if (!A_LDS) { UNROLL for (int i = 0; i < C::NA; ++i) GLDS16(pa[i] + (kt) * 64, sb_ + i * 8192); } \
        UNROLL for (int i = 0; i < C::NBC; ++i) GLDS16(pb[i] + (kt) * 64, sb_ + C::AB + i * 8192); } while (0)
    const int sw = (fr >> 1) & 7;
    int offk[4];
    UNROLL for (int ks = 0; ks < 4; ++ks) offk[ks] = ((2 * ks + fh) ^ sw) * 16;
    const int a_base = (wm * 64 + fr) * 128, b_base = (wn * 64 + fr) * 128;
    UNROLL for (int s = 0; s < NS - 1; ++s) if (s < nk) GT_ISSUE(s, s);
    int stg = 0, nstg = NS - 1;
    for (int kt = 0; kt < nk; ++kt) {
        if (NS == 3 && kt + 1 < nk) asm volatile("s_waitcnt vmcnt(%0)" :: "n"(LPT) : "memory");
        else asm volatile("s_waitcnt vmcnt(0)" ::: "memory");
        __builtin_amdgcn_s_barrier();
        asm volatile("" ::: "memory");
        const bool more = kt + NS - 1 < nk;
        const char* As_ = A_LDS ? alds + kt * C::AB : smem + stg * C::STG; const char* Bs_ = smem + stg * C::STG + C::AB;
        char* db_ = smem + nstg * C::STG + tid * 16;
        bf16x8 af[2][2], bfv[2][2];
        UNROLL for (int mi = 0; mi < 2; ++mi) af[0][mi] = *(const bf16x8*)(As_ + a_base + mi * 4096 + offk[0]);
        UNROLL for (int ni = 0; ni < 2; ++ni) bfv[0][ni] = *(const bf16x8*)(Bs_ + b_base + ni * 4096 + offk[0]);
        UNROLL for (int ks = 0; ks < 4; ++ks) {
            const int cur = ks & 1, nxt = cur ^ 1;
            if (ks < 3) {
                UNROLL for (int mi = 0; mi < 2; ++mi) af[nxt][mi] = *(const bf16x8*)(As_ + a_base + mi * 4096 + offk[ks + 1]);
                UNROLL for (int ni = 0; ni < 2; ++ni) bfv[nxt][ni] = *(const bf16x8*)(Bs_ + b_base + ni * 4096 + offk[ks + 1]);
            }
            UNROLL for (int mi = 0; mi < 2; ++mi) UNROLL for (int ni = 0; ni < 2; ++ni)
                acc[mi][ni] = TR ? __builtin_amdgcn_mfma_f32_32x32x16_bf16(bfv[cur][ni], af[cur][mi], acc[mi][ni], 0, 0, 0)
                                 : __builtin_amdgcn_mfma_f32_32x32x16_bf16(af[cur][mi], bfv[cur][ni], acc[mi][ni], 0, 0, 0);
            if (more) {
                UNROLL for (int pc = 0; pc < LPT; ++pc) if (pc * 4 / LPT == ks) {
                    if (!A_LDS && pc < C::NA) GLDS16(pa[pc] + (kt + NS - 1) * 64, db_ + pc * 8192);
                    else { const int ib = pc - (A_LDS ? 0 : C::NA); GLDS16(pb[ib] + (kt + NS - 1) * 64, db_ + C::AB + ib * 8192); }
                }
            }
            __builtin_amdgcn_sched_barrier(0);
        }
        stg = stg + 1 == NS ? 0 : stg + 1; nstg = nstg + 1 == NS ? 0 : nstg + 1;
    }
    __syncthreads();
#undef GT_ISSUE
}
#define ACC_ROW(mi, r, fh) ((mi) * 32 + ((r) & 3) + 8 * ((r) >> 2) + 4 * (fh))

constexpr int EPI_SLAB = 32 * 68 * 4;
template <class F> DEV void epi_rows(const f32x16 (&acc)[2][2], char* smem, F f) {
    const int lane = TID() & 63, wave = TID() >> 6, fr = lane & 31, fh = lane >> 5;
    float* st = (float*)(smem + wave * EPI_SLAB);
    UNROLL for (int mi = 0; mi < 2; ++mi) {
        UNROLL for (int ni = 0; ni < 2; ++ni) UNROLL for (int r = 0; r < 16; ++r)
            st[((r & 3) + 8 * (r >> 2) + 4 * fh) * 68 + ni * 32 + fr] = acc[mi][ni][r];
        UNROLL for (int it = 0; it < 4; ++it) {
            const int row = it * 8 + (lane >> 3), c8 = (lane & 7) * 8;
            const float4 a = *(const float4*)(st + row * 68 + c8), b = *(const float4*)(st + row * 68 + c8 + 4);
            float v[8] = {a.x, a.y, a.z, a.w, b.x, b.y, b.z, b.w};
            f(mi * 32 + row, c8, v);
        }
    }
    __syncthreads();
}


template <class F> DEV void epi_cols(const f32x16 (&acc)[2][2], char* smem, F f) {
    const int lane = TID() & 63, wave = TID() >> 6, fr = lane & 31, fh = lane >> 5;
    float* st = (float*)(smem + wave * EPI_SLAB);
    UNROLL for (int mi = 0; mi < 2; ++mi) {
        UNROLL for (int ni = 0; ni < 2; ++ni) UNROLL for (int r = 0; r < 16; ++r)
            st[((r & 3) + 8 * (r >> 2) + 4 * fh) * 68 + ni * 32 + fr] = acc[mi][ni][r];
        UNROLL for (int it = 0; it < 4; ++it) {
            float v[8];
            UNROLL for (int i = 0; i < 8; ++i) v[i] = st[(it * 8 + i) * 68 + lane];
            f(mi * 32 + it * 8, lane, v);
        }
    }
    __syncthreads();
}

struct TileOrder {
    int x, nN, cx, total;
    DEV TileOrder(const Topo& tp, int nM, int nN_) { x = tp.x; nN = nN_; cx = nM > x ? (nM - x + 7) >> 3 : 0; total = ((cx + 3) >> 2) * 4 * nN; }
    DEV bool get(int q, int& pm, int& pn) const { const int per = 4 * nN, qi = q / per, rem = q - qi * per, i = 4 * qi + (rem & 3); pn = rem >> 2; pm = x + 8 * i; return i < cx; }
};
template <int WM, int WN, class Epi>
DEV void gemm_phase(const bf16_t* A, int lda, int M, const bf16_t* Bt, int ldb, int N, int K, char* smem, const Topo& tp, Epi epi) {
    typedef GC<WM, WN> C;
    const int nM = M / C::BM, nN = (N + C::BN - 1) / C::BN;
    const int wave = TID() >> 6, wm = wave / WN, wn = wave % WN;
    const TileOrder ord(tp, nM, nN);
    for (int q = tp.r; q < ord.total; q += tp.n) {
        int pm, pn; if (!ord.get(q, pm, pn)) continue;
        f32x16 acc[2][2]; acc_zero(acc);
        const bf16_t* Ab = A + (size_t)pm * C::BM * lda;
        gemm_tile<WM, WN, 3, false>(acc, [&](int r) { return Ab + (size_t)r * lda; }, Bt, ldb, pn * C::BN, N, K, smem, nullptr);
        epi(acc, pm * C::BM + wm * 64, pn * C::BN + wn * 64);
    }
}

namespace pg8 {
#define PG8_LAS __attribute__((address_space(3)))
typedef float f32x4 __attribute__((ext_vector_type(4)));
constexpr int BM = 256, BK = 64, HALF = 128, HTB = HALF * BK * 2  , STAGE_BYTES = 8 * HTB, NXCD = 8, WGM = 8;

__host__ __device__ __forceinline__ int lds_byte(int r, int c) { const int st = (r >> 4) * 2 + (c >> 5), rr = r & 15, cc = c & 31, ob = rr * 64 + cc * 2; return st * 1024 + (ob ^ (((ob >> 9) & 1) << 5)); }
__host__ __device__ __forceinline__ void stage_rc(int b, int& R, int& C) { const int st = b / 1024, sb = b % 1024, swz = sb ^ (((sb >> 9) & 1) << 5); R = (st >> 1) * 16 + swz / 64; C = (st & 1) * 32 + (swz % 64) / 2; }
__host__ __device__ __forceinline__ int perm32(int rho) { const int n = rho >> 4, i = rho & 15; return 8 * (i >> 2) + 4 * n + (i & 3); }

struct Unit { int pm, pn; };
struct Gemm { const bf16_t* A; const bf16_t* Bt; int M, N, K; };
template <class Epi, class Sched, bool ALIGN_EPI = false, bool SP2 = false>
__device__ __forceinline__ void gemm_phase(PG8_LAS unsigned char* lds, const Gemm g, const Sched& S, const Epi& E) {
    const int tid = TID(), wid = __builtin_amdgcn_readfirstlane(tid >> 6), lane = tid & 63, wr = wid >> 2, wc = wid & 3, fr = lane & 15, fq = lane >> 4;
    const int K = g.K, nt = K / BK;
    unsigned voffA[2], voffB[2];
#pragma unroll
    for (int i = 0; i < 2; ++i) { int R, C; stage_rc(tid * 16 + i * 8192, R, C); const int Rb = Epi::PERM ? ((R & ~31) + perm32(R & 31)) : R;
        voffA[i] = (unsigned)(R * K + C) * 2u; voffB[i] = (unsigned)(Rb * K + C) * 2u; }
    const size_t kstep = (size_t)(BK * 2);
    const size_t hstep = (size_t)HALF * K * 2;
    const size_t tstep = 2 * hstep;
    const unsigned ldsw = (unsigned)wid * 1024u;
    const int aoff = lds_byte(wr * 64 + fr, fq * 8), boff = lds_byte(wc * 32 + fr, fq * 8);
#define PG8_SA(b, h) (((b) * 2 + (h)) * HTB)
#define PG8_SB(b, h) ((4 + (b) * 2 + (h)) * HTB)
#define PG8_STAGE(bufoff, gbase, voff) do { _Pragma("unroll") for (int _i = 0; _i < 2; ++_i) \
        __builtin_amdgcn_global_load_lds((const unsigned*)((const char*)(gbase) + (voff)[_i]), (PG8_LAS unsigned*)(lds + (bufoff) + ldsw + _i * 8192), 16, 0, 0); } while (0)
#define PG8_LDA(dst, b, h) do { _Pragma("unroll") for (int m = 0; m < 4; ++m) _Pragma("unroll") for (int k = 0; k < 2; ++k) dst[m][k] = *(const PG8_LAS bf16x8*)(lds + PG8_SA(b, h) + aoff + m * 2048 + k * 1024); } while (0)
#define PG8_LDB(dst, b, h) do { _Pragma("unroll") for (int n = 0; n < 2; ++n) _Pragma("unroll") for (int k = 0; k < 2; ++k) dst[n][k] = *(const PG8_LAS bf16x8*)(lds + PG8_SB(b, h) + boff + n * 2048 + k * 1024); } while (0)
#define PG8_MMA(ai, bj, At, Bt) do { __builtin_amdgcn_s_setprio(1); _Pragma("unroll") for (int m = 0; m < 4; ++m) _Pragma("unroll") for (int n = 0; n < 2; ++n) _Pragma("unroll") for (int k = 0; k < 2; ++k) \
        acc[ai][bj][m][n] = __builtin_amdgcn_mfma_f32_16x16x32_bf16(Bt[n][k], At[m][k], acc[ai][bj][m][n], 0, 0, 0); __builtin_amdgcn_s_setprio(0); } while (0)
#define PG8_WAIT_V(n) asm volatile("s_waitcnt vmcnt(" #n ")" ::: "memory")
#define PG8_WAIT_L(n) asm volatile("s_waitcnt lgkmcnt(" #n ")" ::: "memory")
#define PG8_BAR __builtin_amdgcn_s_barrier()
#define PG8_SCHED __builtin_amdgcn_sched_barrier(0)
    Unit cur, nxt; int ui = 0;
    if (!S.next(0, cur)) return;
    f32x4 acc[2][2][4][2];
#pragma unroll
    for (int a = 0; a < 2; ++a)
#pragma unroll
        for (int b = 0; b < 2; ++b)
#pragma unroll
            for (int m = 0; m < 4; ++m)
#pragma unroll
                for (int n = 0; n < 2; ++n) acc[a][b][m][n] = (f32x4){0.f, 0.f, 0.f, 0.f};
    bf16x8 At[4][2], B0[2][2], B1[2][2];
    const char* cA = (const char*)g.A + (size_t)cur.pm * tstep; const char* cB = (const char*)g.Bt + (size_t)cur.pn * tstep;
    S.a_ready(cur);
    if constexpr (SP2) {
        PG8_STAGE(PG8_SB(0, 0), cB, voffB); PG8_STAGE(PG8_SB(0, 1), cB + hstep, voffB); PG8_STAGE(PG8_SA(0, 0), cA, voffA); PG8_STAGE(PG8_SA(0, 1), cA + hstep, voffA);
        if (wr == 1) PG8_BAR;
        PG8_WAIT_V(2); PG8_BAR;
        PG8_STAGE(PG8_SB(1, 0), cB + kstep, voffB); PG8_STAGE(PG8_SA(1, 0), cA + kstep, voffA); PG8_STAGE(PG8_SB(1, 1), cB + hstep + kstep, voffB);
        PG8_WAIT_V(6); PG8_BAR;
    } else {
        PG8_STAGE(PG8_SB(0, 0), cB, voffB); PG8_STAGE(PG8_SA(0, 0), cA, voffA); PG8_STAGE(PG8_SB(0, 1), cB + hstep, voffB); PG8_STAGE(PG8_SA(0, 1), cA + hstep, voffA);
        if (wr == 1) PG8_BAR;
        PG8_WAIT_V(4); PG8_BAR;
        PG8_STAGE(PG8_SB(1, 0), cB + kstep, voffB); PG8_STAGE(PG8_SA(1, 0), cA + kstep, voffA); PG8_STAGE(PG8_SB(1, 1), cB + hstep + kstep, voffB);
        PG8_WAIT_V(6); PG8_BAR;
    }
    for (;;) {
        const bool has_next = S.next(ui + 1, nxt);
        const char* nA = has_next ? (const char*)g.A + (size_t)nxt.pm * tstep : cA; const char* nB = has_next ? (const char*)g.Bt + (size_t)nxt.pn * tstep : cB;
        for (int t = 0; t < nt; t += 2) {
            const bool last = (t == nt - 2);
            const char* a1 = cA + (size_t)(t + 1) * kstep;
            const char* a2 = last ? nA : cA + (size_t)(t + 2) * kstep; const char* b2 = last ? nB : cB + (size_t)(t + 2) * kstep;
            const char* a3 = a2 + kstep; const char* b3 = b2 + kstep;
            if (last && has_next) S.a_ready(nxt);
            if constexpr (SP2) {
            PG8_LDB(B0, 0, 0); PG8_LDB(B1, 0, 1); PG8_SCHED; PG8_LDA(At, 0, 0); PG8_STAGE(PG8_SA(1, 1), a1 + hstep, voffA);
            PG8_WAIT_V(8); PG8_WAIT_L(0); PG8_BAR; PG8_MMA(0, 0, At, B0); PG8_MMA(0, 1, At, B1); PG8_BAR; PG8_SCHED;
            PG8_LDA(At, 0, 1); PG8_STAGE(PG8_SB(0, 0), b2, voffB); PG8_STAGE(PG8_SB(0, 1), b2 + hstep, voffB); PG8_STAGE(PG8_SA(0, 0), a2, voffA);
            PG8_WAIT_V(8); PG8_WAIT_L(0); PG8_BAR; PG8_MMA(1, 0, At, B0); PG8_MMA(1, 1, At, B1); PG8_BAR; PG8_SCHED;
            PG8_LDB(B0, 1, 0); PG8_LDB(B1, 1, 1); PG8_SCHED; PG8_LDA(At, 1, 0); PG8_STAGE(PG8_SA(0, 1), a2 + hstep, voffA);
            PG8_WAIT_V(8); PG8_WAIT_L(0); PG8_BAR; PG8_MMA(0, 0, At, B0); PG8_MMA(0, 1, At, B1); PG8_BAR; PG8_SCHED;
            PG8_LDA(At, 1, 1); PG8_STAGE(PG8_SB(1, 0), b3, voffB); PG8_STAGE(PG8_SB(1, 1), b3 + hstep, voffB); PG8_STAGE(PG8_SA(1, 0), a3, voffA);
            PG8_WAIT_V(8); PG8_WAIT_L(0); PG8_BAR; PG8_MMA(1, 0, At, B0); PG8_MMA(1, 1, At, B1); PG8_BAR; PG8_SCHED;
            } else {
            PG8_LDB(B0, 0, 0); PG8_SCHED; PG8_LDA(At, 0, 0); PG8_STAGE(PG8_SA(1, 1), a1 + hstep, voffA);
            PG8_WAIT_L(8); PG8_BAR; PG8_WAIT_L(0); PG8_MMA(0, 0, At, B0); PG8_BAR; PG8_SCHED;
            PG8_LDB(B1, 0, 1); PG8_STAGE(PG8_SB(0, 0), b2, voffB);
            PG8_BAR; PG8_WAIT_L(0); PG8_MMA(0, 1, At, B1); PG8_BAR;
            PG8_LDA(At, 0, 1); PG8_STAGE(PG8_SA(0, 0), a2, voffA);
            PG8_BAR; PG8_WAIT_L(0); PG8_MMA(1, 0, At, B0); PG8_BAR; PG8_SCHED;
            PG8_STAGE(PG8_SB(0, 1), b2 + hstep, voffB);
            PG8_WAIT_V(6); PG8_BAR; PG8_MMA(1, 1, At, B1); PG8_BAR;
            PG8_LDB(B0, 1, 0); PG8_SCHED; PG8_LDA(At, 1, 0); PG8_STAGE(PG8_SA(0, 1), a2 + hstep, voffA);
            PG8_WAIT_L(8); PG8_BAR; PG8_WAIT_L(0); PG8_MMA(0, 0, At, B0); PG8_BAR; PG8_SCHED;
            PG8_LDB(B1, 1, 1); PG8_STAGE(PG8_SB(1, 0), b3, voffB);
            PG8_BAR; PG8_WAIT_L(0); PG8_MMA(0, 1, At, B1); PG8_BAR;
            PG8_LDA(At, 1, 1); PG8_STAGE(PG8_SA(1, 0), a3, voffA);
            PG8_BAR; PG8_WAIT_L(0); PG8_MMA(1, 0, At, B0); PG8_BAR; PG8_SCHED;
            PG8_STAGE(PG8_SB(1, 1), b3 + hstep, voffB);
            PG8_WAIT_V(6); PG8_BAR; PG8_MMA(1, 1, At, B1); PG8_BAR;
            }
        }
        if constexpr (ALIGN_EPI) { if (wr == 0) PG8_BAR; }
        if constexpr (!Epi::AFTER_DRAIN) { E(acc, cur, wr, wc, fr, fq); S.done(cur); }
        if (!has_next) break;
#pragma unroll
        for (int a = 0; a < 2; ++a)
#pragma unroll
            for (int b = 0; b < 2; ++b)
#pragma unroll
                for (int m = 0; m < 4; ++m)
#pragma unroll
                    for (int n = 0; n < 2; ++n) acc[a][b][m][n] = (f32x4){0.f, 0.f, 0.f, 0.f};
        cur = nxt; cA = nA; cB = nB; ++ui;
        if constexpr (ALIGN_EPI) { if (wr == 1) PG8_BAR; }
    }
    PG8_WAIT_V(0);
    if constexpr (!ALIGN_EPI) { if (wr == 0) PG8_BAR; }
    PG8_BAR;
    if constexpr (Epi::AFTER_DRAIN) { E.fused(acc, cur, wr, wc, fr, fq, lds, wid, lane); S.done(cur); }
#undef PG8_SA
#undef PG8_SB
#undef PG8_STAGE
#undef PG8_LDA
#undef PG8_LDB
#undef PG8_MMA
#undef PG8_WAIT_V
#undef PG8_WAIT_L
#undef PG8_BAR
#undef PG8_SCHED
}
}
template <class F> struct EpiF {
    static constexpr bool PERM = true, AFTER_DRAIN = false; F f;
    DEV void operator()(const pg8::f32x4 (&acc)[2][2][4][2], const pg8::Unit& u, int wr, int wc, int fr, int fq) const {
        UNROLL for (int ai = 0; ai < 2; ++ai) UNROLL for (int m = 0; m < 4; ++m) {
            const int row = u.pm * 256 + ai * 128 + wr * 64 + m * 16 + fr;
            UNROLL for (int bj = 0; bj < 2; ++bj) {
                const int col = u.pn * 256 + bj * 128 + wc * 32 + 8 * fq;
                const float v[8] = {acc[ai][bj][m][0][0], acc[ai][bj][m][0][1], acc[ai][bj][m][0][2], acc[ai][bj][m][0][3],
                                    acc[ai][bj][m][1][0], acc[ai][bj][m][1][1], acc[ai][bj][m][1][2], acc[ai][bj][m][1][3]};
                f(row, col, v);
            }
        }
    }
};
template <class F> struct EpiF2 {
    static constexpr bool PERM = true, AFTER_DRAIN = false; F f;
    DEV void operator()(const pg8::f32x4 (&acc)[2][2][4][2], const pg8::Unit& u, int wr, int wc, int fr, int fq) const {
        UNROLL for (int ai = 0; ai < 2; ++ai) UNROLL for (int m = 0; m < 4; ++m) {
            const int row = u.pm * 256 + ai * 128 + wr * 64 + m * 16 + fr, col = u.pn * 256 + wc * 32 + 8 * fq;
            const float v0[8] = {acc[ai][0][m][0][0], acc[ai][0][m][0][1], acc[ai][0][m][0][2], acc[ai][0][m][0][3], acc[ai][0][m][1][0], acc[ai][0][m][1][1], acc[ai][0][m][1][2], acc[ai][0][m][1][3]};
            const float v1[8] = {acc[ai][1][m][0][0], acc[ai][1][m][0][1], acc[ai][1][m][0][2], acc[ai][1][m][0][3], acc[ai][1][m][1][0], acc[ai][1][m][1][1], acc[ai][1][m][1][2], acc[ai][1][m][1][3]};
            f(row, col, v0, v1);
        }
    }
};
struct XOrder {
    int x, r, n, nN, cx, fullq, total;
    DEV XOrder(const Topo& tp, int nM, int nN_) { x = tp.x; r = tp.r; n = tp.n; nN = nN_; cx = nM > x ? (nM - x + 7) >> 3 : 0; fullq = cx >> 2; total = cx * nN; }
    DEV bool next(int i, pg8::Unit& u) const {
        const int q = r + i * n; if (q >= total) return false;
        const int per = 4 * nN;
        if (q < fullq * per) { const int qi = q / per, rem = q - qi * per; u.pn = rem >> 2; u.pm = x + 8 * (4 * qi + (rem & 3)); }
        else { const int rem = q - fullq * per, cq = cx - 4 * fullq; u.pn = rem / cq; u.pm = x + 8 * (4 * fullq + rem % cq); }
        return true;
    }
    DEV void a_ready(const pg8::Unit&) const {}
    DEV void done(const pg8::Unit&) const {}
};
template <class F> DEV void gemm256_pair(const bf16_t* A, int M, const bf16_t* Bt, int N, int K, char* smem, const Topo& tp, F f) {
    const pg8::Gemm g{A, Bt, M, N, K};
    const XOrder S(tp, M / 256, (N + 255) / 256);
    const EpiF2<F> E{f};
    pg8::gemm_phase<EpiF2<F>, XOrder, true, true>((PG8_LAS unsigned char*)smem, g, S, E);
}
template <class F> DEV void gemm256(const bf16_t* A, int M, const bf16_t* Bt, int N, int K, char* smem, const Topo& tp, F f) {
    const pg8::Gemm g{A, Bt, M, N, K};
    const XOrder S(tp, M / 256, (N + 255) / 256);
    const EpiF<F> E{f};
    pg8::gemm_phase<EpiF<F>, XOrder, true, true>((PG8_LAS unsigned char*)smem, g, S, E);
}

DEV void ph_mod(const Params& p, int L, char* smem) {
    const int tid = TID();
    float* sc = (float*)smem;
    float* red = sc + 17 * 1024;
    const float* c = p.in[I_C]; const float* cc = p.in[I_CCTX];
    for (int i = tid; i < 17 * 1024; i += NTHREADS) { const float v = i < 16 * 1024 ? c[i] : cc[i - 16 * 1024]; sc[i] = v / (1.f + expf(-v)); }
    __syncthreads();
    const float* W = p.in[I_WADA] + (size_t)L * 1024 * 6144; const float* bA = p.in[I_BADA] + (size_t)L * 6144;
    float* MOD = (float*)(p.ws + OFF_MOD);
    for (int u = blockIdx.x; u < 192; u += gridDim.x) {
        const int ci = tid & 31, ks = tid >> 5, j = u * 32 + ci;
        float acc[17];
        UNROLL for (int r = 0; r < 17; ++r) acc[r] = 0.f;
        for (int k = ks * 64; k < ks * 64 + 64; ++k) {
            const float w = W[(size_t)k * 6144 + j];
            UNROLL for (int r = 0; r < 17; ++r) acc[r] += sc[r * 1024 + k] * w;
        }
        UNROLL for (int r = 0; r < 17; ++r) red[(ks * 17 + r) * 32 + ci] = acc[r];
        __syncthreads();
        for (int i = tid; i < 17 * 32; i += NTHREADS) {
            const int r = i >> 5, c2 = i & 31; float s = bA[u * 32 + c2];
            for (int k2 = 0; k2 < 16; ++k2) s += red[(k2 * 17 + r) * 32 + c2];
            MOD[r * 6144 + u * 32 + c2] = s;
        }
        __syncthreads();
    }
}
DEV void conv_job(const float* s0, const float* s1, bf16_t* d, int K, int N, int mode, int nmat, size_t sstride, size_t dstride, char* smem, int bid = -1, int nb = 0) {
    if (bid < 0) { bid = blockIdx.x; nb = gridDim.x; }
    float* tile = (float*)smem;
    const int tid = TID();
    const int tK = K / 64, tN = (mode == 1 || mode == 3) ? (2 * N) / 64 : (N + 63) / 64, per = tK * tN;
    for (int t = bid; t < per * nmat; t += nb) {
        const int mat = t / per, r = t % per, tk = r / tN, tn = r % tN;
        const float* a0 = s0 + (size_t)mat * sstride; const float* a1 = s1 ? s1 + (size_t)mat * sstride : nullptr;
        bf16_t* dd = d + (size_t)mat * dstride;
        UNROLL for (int i = 0; i < 8; ++i) {
            const int cc = tid & 63, k = (tid >> 6) + 8 * i; float v;
            if (mode == 1) { const float* s = (cc >> 5) ? a1 : a0; v = s[(size_t)(tk * 64 + k) * N + tn * 32 + (cc & 31)]; }
            else if (mode == 3) { const float* s = ((tn >> 1) & 1) ? a1 : a0; v = s[(size_t)(tk * 64 + k) * N + (tn >> 2) * 128 + (tn & 1) * 64 + cc]; }
            else { const int n = tn * 64 + cc; v = n < N ? a0[(size_t)(tk * 64 + k) * N + n] : 0.f; }
            tile[k * 65 + cc] = v;
        }
        __syncthreads();
        UNROLL for (int i = 0; i < 8; ++i) {
            const int k = tid & 63, cc = (tid >> 6) + 8 * i; const int row = tn * 64 + cc;
            const float v = tile[k * 65 + cc];
            if (mode == 1 || mode == 3 || row < N) {
                const bf16_t hi = f2bf(v);
                dd[(size_t)row * K + tk * 64 + k] = hi;
                if (mode == 2) dd[(size_t)N * K + (size_t)row * K + tk * 64 + k] = f2bf(v - bf2f(hi));
            }
        }
        __syncthreads();
    }
}
DEV void ph_conv_mix(const Params& p, int L, char* smem) {
    char* ws = p.ws;
    conv_job(p.in[I_WIN] + (size_t)L * 1024 * IN_COLS, nullptr, (bf16_t*)(ws + OFF_WINT), 1024, IN_COLS, 0, 1, 0, 0, smem);
    conv_job(p.in[I_WBR] + (size_t)L * 3 * 512 * 1024, nullptr, (bf16_t*)(ws + OFF_WBT), 512, 1024, 0, 3, (size_t)512 * 1024, (size_t)512 * 1024, smem);
    conv_job(p.in[I_WOUT] + (size_t)L * 1024 * 1024, nullptr, (bf16_t*)(ws + OFF_WOUTT), 1024, 1024, 0, 1, 0, 0, smem);
    conv_job(p.in[I_SG] + (size_t)L * 1024 * 256, p.in[I_SU] + (size_t)L * 1024 * 256, (bf16_t*)(ws + OFF_SGUT), 1024, 256, 3, 1, 0, 0, smem);
    conv_job(p.in[I_SD] + (size_t)L * 256 * 1024, nullptr, (bf16_t*)(ws + OFF_SDT), 256, 1024, 0, 1, 0, 0, smem);
    conv_job(p.in[I_G2] + (size_t)L * 128 * 512, nullptr, (bf16_t*)(ws + OFF_G2T), 128, 512, 0, 1, 0, 0, smem);
    conv_job(p.in[I_RTR] + (size_t)L * 1024 * 64, nullptr, (bf16_t*)(ws + OFF_RTR), 1024, 64, 2, 1, 0, 0, smem);
}
DEV void ph_conv_moe_gu(const Params& p, int L, char* smem, int bid, int nb) {
    const size_t eo = (size_t)L * 64 * 1024 * 128;
    conv_job(p.in[I_MWG] + eo, p.in[I_MWU] + eo, (bf16_t*)(p.ws + OFF_MGU), 1024, 128, 1, 64, (size_t)1024 * 128, (size_t)256 * 1024, smem, bid, nb);
}
DEV void ph_conv_moe(const Params& p, int L, char* smem, int bid, int nb) {
    const size_t eo = (size_t)L * 64 * 1024 * 128;
    conv_job(p.in[I_MWD] + eo, nullptr, (bf16_t*)(p.ws + OFF_MDT), 128, 1024, 0, 64, (size_t)128 * 1024, (size_t)1024 * 128, smem, bid, nb);
}

DEV void ph_norm(const Params& p, int L, int which, int ntok) {
    const int lane = TID() & 63, wave = TID() >> 6;
    const float* MOD = (const float*)(p.ws + OFF_MOD);
    const float* g = p.in[which ? I_N2G : I_N1G] + (size_t)L * DM;
    bf16_t* H = (bf16_t*)(p.ws + OFF_HX); bf16_t* HLO = (bf16_t*)(p.ws + OFF_H2LO);
    for (int n0 = blockIdx.x * 8; n0 < ntok; n0 += gridDim.x * 8) {
        const int n = n0 + wave;
        const float* xr = which ? xs_row(p, n) : xprev_row(p, L, n);
        float4 v[4]; float ss = 0.f;
        UNROLL for (int i = 0; i < 4; ++i) { v[i] = *(const float4*)(xr + i * 256 + lane * 4); ss += v[i].x * v[i].x + v[i].y * v[i].y + v[i].z * v[i].z + v[i].w * v[i].w; }
        UNROLL for (int o = 1; o < 64; o <<= 1) ss += __shfl_xor(ss, o);
        const float rstd = rsqrtf(ss * (1.f / DM) + 1e-6f);
        const float* sh = MOD + mod_row(n) * 6144 + (which ? 3 : 0) * DM; const float* sc = sh + DM;
        UNROLL for (int i = 0; i < 4; ++i) {
            const int c = i * 256 + lane * 4;
            const float4 gg = *(const float4*)(g + c), s1 = *(const float4*)(sc + c), s0 = *(const float4*)(sh + c);
            const float h0 = v[i].x * rstd * gg.x * (1.f + s1.x) + s0.x, h1 = v[i].y * rstd * gg.y * (1.f + s1.y) + s0.y;
            const float h2 = v[i].z * rstd * gg.z * (1.f + s1.z) + s0.z, h3 = v[i].w * rstd * gg.w * (1.f + s1.w) + s0.w;
            u32x2 o; o.x = pk2(h0, h1); o.y = pk2(h2, h3);
            *(u32x2*)(H + (size_t)n * DM + c) = o;
            if (which) {
                u32x2 o2;
                o2.x = pk2(h0 - bf2f((bf16_t)(o.x & 0xffff)), h1 - bf2f((bf16_t)(o.x >> 16)));
                o2.y = pk2(h2 - bf2f((bf16_t)(o.y & 0xffff)), h3 - bf2f((bf16_t)(o.y >> 16)));
                *(u32x2*)(HLO + (size_t)n * DM + c) = o2;
            }
        }
    }
}

DEV void ph_rw_prep(const Params& p, int L, char* smem) {
    const int lane = TID() & 63, wave = TID() >> 6;
    float* vsh = (float*)smem + wave * 512;
    const bf16_t* PXR = (const bf16_t*)(p.ws + OFF_PX); bf16_t* VF = (bf16_t*)(p.ws + OFF_VF);
    const float* mu = p.in[I_MU] + (size_t)L * RW_COLS;
    const float* v0 = p.in[I_V0]; const float* v1 = p.in[I_V1]; const float* v2 = p.in[I_V2];
    for (int n0 = blockIdx.x * 8; n0 < NT; n0 += gridDim.x * 8) {
        const int n = n0 + wave; int nb, tt, T; seq_of(n, nb, tt, T);
        float vs[8]; shift8(PXR, RW_COLS, nb, tt, T, 1024 + lane * 8, mu, vs);
        if (L == 0) { st8(VF + (size_t)n * 512 + lane * 8, vs); }
        else {
            UNROLL for (int i = 0; i < 8; ++i) vsh[lane * 8 + i] = vs[i];
            __syncthreads();
            const int q = lane & 31, hf = lane >> 5; float t1 = 0.f;
            for (int jj = 0; jj < 256; ++jj) t1 += vsh[hf * 256 + jj] * v1[(hf * 256 + jj) * 32 + q];
            t1 += __shfl_xor(t1, 32);
            float u[8];
            UNROLL for (int i = 0; i < 8; ++i) u[i] = v0[lane * 8 + i];
            for (int q2 = 0; q2 < 32; ++q2) { const float tq = __shfl(t1, q2); UNROLL for (int i = 0; i < 8; ++i) u[i] += tq * v2[q2 * 512 + lane * 8 + i]; }
            float vf[8], o[8]; ld8(VF + (size_t)n * 512 + lane * 8, vf);
            UNROLL for (int i = 0; i < 8; ++i) o[i] = vs[i] + (vf[i] - vs[i]) * sigm(u[i]);
            st8(VF + (size_t)n * 512 + lane * 8, o);
            __syncthreads();
        }
    }
}

DEV bf16x8 pk_lohi(u32x2 lo, u32x2 hi) { u32x4 w; w.x = lo.x; w.y = lo.y; w.z = hi.x; w.w = hi.y; return __builtin_bit_cast(bf16x8, w); }
DEV bf16x8 pk_acc2(const f32x4v& a, const f32x4v& b) { u32x4 w; w.x = pk2(a[0], a[1]); w.y = pk2(a[2], a[3]); w.z = pk2(b[0], b[1]); w.w = pk2(b[2], b[3]); return __builtin_bit_cast(bf16x8, w); }
DEV bf16x8 pk_acc1(const f32x4v& a) { u32x4 w; w.x = pk2(a[0], a[1]); w.y = pk2(a[2], a[3]); w.z = 0u; w.w = 0u; return __builtin_bit_cast(bf16x8, w); }
#define MFMA16(a, b, c) __builtin_amdgcn_mfma_f32_16x16x32_bf16((a), (b), (c), 0, 0, 0)
struct Raw3 { u32x4 l, c, r; };
DEV Raw3 rw_raw(const bf16_t* z, int ld, int nb, int tt, int T, int col0) {
    Raw3 o;
    o.c = *(const u32x4*)(z + (size_t)(nb + tt) * ld + col0);
    o.l = *(const u32x4*)(z + (size_t)(nb + max(tt - 1, 0)) * ld + col0);
    o.r = *(const u32x4*)(z + (size_t)(nb + min(tt + 1, T - 1)) * ld + col0);
    return o;
}
DEV void unpack8(u32x4 v, float (&o)[8]) {
    o[0] = __uint_as_float(v.x << 16); o[1] = __uint_as_float(v.x & 0xffff0000u); o[2] = __uint_as_float(v.y << 16); o[3] = __uint_as_float(v.y & 0xffff0000u);
    o[4] = __uint_as_float(v.z << 16); o[5] = __uint_as_float(v.z & 0xffff0000u); o[6] = __uint_as_float(v.w << 16); o[7] = __uint_as_float(v.w & 0xffff0000u);
}
DEV void shift_from_raw(const Raw3& w, int tt, int T, const float* mu8, float (&o)[8]) {
    float c[8], l[8], r[8]; unpack8(w.c, c); unpack8(w.l, l); unpack8(w.r, r);
    const float ml = tt > 0 ? 0.5f : 0.f, mr = tt < T - 1 ? 0.5f : 0.f;
    UNROLL for (int i = 0; i < 8; ++i) o[i] = c[i] + mu8[i] * (ml * l[i] + mr * r[i] - c[i]);
}
DEV void ph_rw_scan(const Params& p, int L, char* smem) {
    const int tid = TID();
    const int wave = __builtin_amdgcn_readfirstlane(tid >> 6);
    char* AT = smem; char* BT = smem + 9216; char* KT = smem + 18432; char* RT = smem + 27648;
    char* BH = smem + 36864; char* KH = smem + 46080; char* VT = smem + 55296;
    char* W2T = smem + 64512; char* A2T = smem + 73728;
    float* PCv = (float*)(smem + 82944); float* SEGT = PCv + 64;
    char* XY = smem + 85248;
    char* T1 = XY; char* T2 = XY + 9216; float* WLf = (float*)(XY + 18432); float* ALf = (float*)(XY + 35840); float* LW = (float*)XY;
    float* TOT = (float*)(XY + 62720);
    float* PAR = (float*)(XY + 60416);
    char* NAB = XY; char* NAK = XY + 9216; char* NRB = XY + 18432; char* NRK = XY + 27648; char* TJ = XY + 36864; float* NDF = (float*)(XY + 38912); float* YO = (float*)(XY + 43008);
    const bf16_t* PXR = (const bf16_t*)(p.ws + OFF_PX); const bf16_t* VF = (const bf16_t*)(p.ws + OFF_VF);
    bf16_t* YS = (bf16_t*)(p.ws + OFF_YS); float* CB = (float*)(p.ws + OFF_CB);
    const float* mu = p.in[I_MU] + (size_t)L * RW_COLS;
    const float* w0 = p.in[I_W0] + (size_t)L * 1024; const float* w2 = p.in[I_W2] + (size_t)L * 65536;
    const float* a0 = p.in[I_A0] + (size_t)L * 1024; const float* a2 = p.in[I_A2] + (size_t)L * 65536;
    const float* kkw = p.in[I_KK] + (size_t)L * 512; const float* kaw = p.in[I_KA] + (size_t)L * 512; const float* rkw = p.in[I_RK] + (size_t)L * 512;
    for (int u = blockIdx.x; u < 256; u += gridDim.x) {
        const int b = u >> 4, h = (u >> 1) & 7, d = u & 1;
        for (int i = tid; i < 4096; i += NTHREADS) {
            const int l = i >> 6, n = i & 63;
            *(bf16_t*)(W2T + n * LROW + l * 2) = f2bf(w2[(size_t)(d * 64 + l) * 512 + h * 64 + n]);
            *(bf16_t*)(A2T + n * LROW + l * 2) = f2bf(a2[(size_t)(d * 64 + l) * 512 + h * 64 + n]);
        }
        if (tid < 64) {
            const int n = tid;
            PAR[n] = w0[d * 512 + h * 64 + n]; PAR[64 + n] = a0[d * 512 + h * 64 + n];
            PAR[128 + n] = kkw[h * 64 + n]; PAR[192 + n] = kaw[h * 64 + n]; PAR[256 + n] = rkw[h * 64 + n];
            PAR[320 + n] = mu[1536 + d * 64 + n]; PAR[384 + n] = mu[1664 + d * 64 + n]; PAR[448 + n] = mu[h * 64 + n]; PAR[512 + n] = mu[512 + h * 64 + n];
        }
        f32x4v sacc[4];
        UNROLL for (int i = 0; i < 4; ++i) sacc[i] = (f32x4v){0.f, 0.f, 0.f, 0.f};
        __syncthreads();
        Raw3 pw1, pw2, pr, pk; u32x4 pv;
#define RW_GEOM(ci_, tido_) const bool isc = (ci_) < 4; const int T = isc ? CTXL : SEQ, cc = isc ? (ci_) : (ci_) - 4; \
            const int t0 = d == 0 ? cc * 64 : T - 64 * (cc + 1), nb = isc ? NX + b * CTXL : b * SEQ; \
            const int tt = d == 0 ? t0 + ((tido_) >> 3) : t0 + 63 - ((tido_) >> 3);
#define RW_PREFETCH(ci_, tido_) do { RW_GEOM(ci_, tido_) const int j_ = (tido_) & 7; \
            pw1 = rw_raw(PXR, RW_COLS, nb, tt, T, 1536 + d * 64 + 8 * j_); pw2 = rw_raw(PXR, RW_COLS, nb, tt, T, 1664 + d * 64 + 8 * j_); \
            pr = rw_raw(PXR, RW_COLS, nb, tt, T, h * 64 + 8 * j_); pk = rw_raw(PXR, RW_COLS, nb, tt, T, 512 + h * 64 + 8 * j_); \
            pv = *(const u32x4*)(VF + (size_t)(nb + tt) * 512 + h * 64 + 8 * j_); } while (0)
        RW_PREFETCH(0, tid);
        for (int ci = 0; ci < 36; ++ci) {
            int tido = tid; asm volatile("" : "+v"(tido));
            const int lane = tido & 63, lq = lane & 15, kg = lane >> 4, ti = tido >> 3, j = tido & 7;
            const int ch = h * 64 + 8 * j;
            RW_GEOM(ci, tido)
            float r8[8], k8[8], v8[8];
            {
                float x1[8], x2[8];
                shift_from_raw(pw1, tt, T, PAR + 320 + 8 * j, x1);
                shift_from_raw(pw2, tt, T, PAR + 384 + 8 * j, x2);
                UNROLL for (int i = 0; i < 8; ++i) x1[i] = tanh_fast(x1[i]);
                st8((bf16_t*)(T1 + ti * LROW) + 8 * j, x1); st8((bf16_t*)(T2 + ti * LROW) + 8 * j, x2);
                shift_from_raw(pr, tt, T, PAR + 448 + 8 * j, r8);
                shift_from_raw(pk, tt, T, PAR + 512 + 8 * j, k8);
                unpack8(pv, v8);
            }
            __syncthreads();
            _Pragma("unroll 1") for (int rep = 0; rep < 4; ++rep) {
                const int q = wave + 8 * rep, m = q >> 4, tl = q & 15, tt4 = tl >> 2, nt4 = tl & 3;
                const char* Ab = (m ? T2 : T1) + (16 * tt4 + lq) * LROW + kg * 16; const char* Bb = (m ? A2T : W2T) + (16 * nt4 + lq) * LROW + kg * 16;
                f32x4v a = {0.f, 0.f, 0.f, 0.f};
                UNROLL for (int ks = 0; ks < 2; ++ks) a = MFMA16(*(const bf16x8*)(Ab + ks * 64), *(const bf16x8*)(Bb + ks * 64), a);
                float* dst = (m ? ALf : WLf) + (16 * tt4 + 4 * kg) * 68 + 16 * nt4 + lq;
                UNROLL for (int i = 0; i < 4; ++i) dst[i * 68] = a[i];
            }
            __syncthreads();
            float av[8], bv[8], kd8[8];
            {
                const float4 wa = *(const float4*)(WLf + ti * 68 + 8 * j), wb = *(const float4*)(WLf + ti * 68 + 8 * j + 4);
                const float4 aa = *(const float4*)(ALf + ti * 68 + 8 * j), ab = *(const float4*)(ALf + ti * 68 + 8 * j + 4);
                const float wl[8] = {wa.x, wa.y, wa.z, wa.w, wb.x, wb.y, wb.z, wb.w}, al[8] = {aa.x, aa.y, aa.z, aa.w, ab.x, ab.y, ab.z, ab.w};
                float ss = 0.f, cbp = 0.f, alpha[8], kkr[8], lw[8];
                UNROLL for (int i = 0; i < 8; ++i) {
                    const float xw = -(PAR[8 * j + i] + wl[i]);
                    const float sp = softplus_fast(xw);
                    lw[i] = -__expf(-sp - 0.5f);
                    alpha[i] = sigm(PAR[64 + 8 * j + i] + al[i]);
                    kkr[i] = k8[i] * PAR[128 + 8 * j + i]; ss += kkr[i] * kkr[i];
                    kd8[i] = k8[i] * (1.f + (alpha[i] - 1.f) * PAR[192 + 8 * j + i]);
                    cbp += r8[i] * kd8[i] * PAR[256 + 8 * j + i];
                }
                ss = sum8(ss); cbp = sum8(cbp);
                const float inv = frcp(fmaxf(__builtin_amdgcn_sqrtf(ss), 1e-12f));
                UNROLL for (int i = 0; i < 8; ++i) { const float kk = kkr[i] * inv; av[i] = -kk; bv[i] = kk * alpha[i]; }
                *(float4*)(LW + ti * 64 + 8 * j) = make_float4(lw[0], lw[1], lw[2], lw[3]); *(float4*)(LW + ti * 64 + 8 * j + 4) = make_float4(lw[4], lw[5], lw[6], lw[7]);
                if (j == 0) CB[((size_t)d * NT + nb + tt) * 8 + h] = cbp;
            }
            __syncthreads();
            {
                const int n = tid & 63, seg = wave; float run[8], acc = 0.f;
                UNROLL for (int r = 0; r < 8; ++r) { acc += LW[(seg * 8 + r) * 64 + n]; run[r] = acc; }
                SEGT[seg * 64 + n] = acc;
                __syncthreads();
                float off = 0.f, tot = 0.f;
                UNROLL for (int s2 = 0; s2 < 8; ++s2) { const float sv = SEGT[s2 * 64 + n]; tot += sv; off += s2 < seg ? sv : 0.f; }
                UNROLL for (int r = 0; r < 8; ++r) LW[(seg * 8 + r) * 64 + n] = run[r] + off;
                if (seg == 0) { TOT[n] = tot; PCv[n] = __expf(tot); }
            }
            __syncthreads();
            {
                const float4 ta = *(const float4*)(TOT + 8 * j), tb = *(const float4*)(TOT + 8 * j + 4);
                const float tot[8] = {ta.x, ta.y, ta.z, ta.w, tb.x, tb.y, tb.z, tb.w};
                const float4 la = *(const float4*)(LW + ti * 64 + 8 * j), lb = *(const float4*)(LW + ti * 64 + 8 * j + 4);
                const float lpl[8] = {la.x, la.y, la.z, la.w, lb.x, lb.y, lb.z, lb.w};
                float lpm[8];
                if (ti != 0) {
                    const float4 ma = *(const float4*)(LW + (ti - 1) * 64 + 8 * j), mb = *(const float4*)(LW + (ti - 1) * 64 + 8 * j + 4);
                    lpm[0] = ma.x; lpm[1] = ma.y; lpm[2] = ma.z; lpm[3] = ma.w; lpm[4] = mb.x; lpm[5] = mb.y; lpm[6] = mb.z; lpm[7] = mb.w;
                } else { UNROLL for (int i = 0; i < 8; ++i) lpm[i] = 0.f; }
                float oa[8], ob[8], ok[8], orr[8];
                const int wofs = (((ti >> 3) ^ j) << 4) + (ti & 7) * 2;
                UNROLL for (int i = 0; i < 8; ++i) {
                    const float lp = lpl[i], lm = lpm[i];
                    const float eP = __expf(lp), eM = __expf(-lp), ePm = __expf(lm), eE = __expf(tot[i] - lp);
                    oa[i] = av[i] * ePm; ob[i] = bv[i] * eM; ok[i] = kd8[i] * eM; orr[i] = r8[i] * eP;
                    *(bf16_t*)(BH + (8 * j + i) * LROW + wofs) = f2bf(bv[i] * eE);
                    *(bf16_t*)(KH + (8 * j + i) * LROW + wofs) = f2bf(kd8[i] * eE);
                    *(bf16_t*)(VT + (8 * j + i) * LROW + wofs) = f2bf(v8[i]);
                }
                st8((bf16_t*)(AT + ti * LROW) + 8 * j, oa); st8((bf16_t*)(BT + ti * LROW) + 8 * j, ob);
                st8((bf16_t*)(KT + ti * LROW) + 8 * j, ok); st8((bf16_t*)(RT + ti * LROW) + 8 * j, orr);
            }
            __syncthreads();
            if (ci + 1 < 36) RW_PREFETCH(ci + 1, tido);
            _Pragma("unroll 1") for (int rep = 0; rep < 6; ++rep) {
                const int q = wave + 8 * rep, m = q / 12, tl = q - 12 * m;
                const int tt4 = tl >= 10 ? 2 * (tl - 10) : tl < 1 ? 0 : tl < 3 ? 1 : tl < 6 ? 2 : 3, st4 = tl >= 10 ? tt4 + 1 : tl - (tt4 * (tt4 + 1)) / 2;
                char* dstm = m == 0 ? NAB : m == 1 ? NAK : m == 2 ? NRB : NRK;
                f32x4v a = {0.f, 0.f, 0.f, 0.f};
                if (st4 <= tt4) {
                    const char* Ab = (m < 2 ? AT : RT) + (16 * tt4 + lq) * LROW + kg * 16; const char* Bb = ((m & 1) ? KT : BT) + (16 * st4 + lq) * LROW + kg * 16;
                    UNROLL for (int ks = 0; ks < 2; ++ks) a = MFMA16(*(const bf16x8*)(Ab + ks * 64), *(const bf16x8*)(Bb + ks * 64), a);
                }
                const int sidx = 16 * st4 + lq;
                UNROLL for (int i = 0; i < 4; ++i) {
                    const int tidx = 16 * tt4 + 4 * kg + i;
                    const bool keep = m < 2 ? sidx < tidx : sidx <= tidx;
                    const float val = keep ? a[i] : 0.f;
                    *(bf16_t*)(dstm + tidx * LROW + sidx * 2) = f2bf(val);
                    if (m == 0 && st4 == tt4) NDF[(tt4 * 16 + 4 * kg + i) * 16 + lq] = val;
                }
            }
            __syncthreads();
            f32x4v xacc[4], yacc[4];
            bf16x8 vt[2];
            if (wave == 7) {
                const int blk = lane >> 4, c = lane & 15;
                float Tc[16];
                UNROLL for (int t = 0; t < 16; ++t) {
                    float a = t == c ? 1.f : 0.f;
                    UNROLL for (int s2 = 0; s2 < t; ++s2) a += NDF[(blk * 16 + t) * 16 + s2] * Tc[s2];
                    Tc[t] = a;
                }
                UNROLL for (int t = 0; t < 16; ++t) *(bf16_t*)(TJ + (blk * 16 + t) * 32 + c * 2) = f2bf(Tc[t]);
            } else if (wave < 4) {
                bf16x8 sb[2];
                UNROLL for (int kk = 0; kk < 2; ++kk) { sb[kk] = pk_acc2(sacc[2 * kk], sacc[2 * kk + 1]); vt[kk] = *(const bf16x8*)(VT + (16 * wave + lq) * LROW + (((4 * kk + kg) ^ (2 * wave + (lq >> 3))) << 4)); }
                UNROLL for (int t4 = 0; t4 < 4; ++t4) {
                    f32x4v x = {0.f, 0.f, 0.f, 0.f}, y = {0.f, 0.f, 0.f, 0.f};
                    UNROLL for (int kk = 0; kk < 2; ++kk) {
                        const char* pa = AT + (16 * t4 + lq) * LROW + (32 * kk + 4 * kg) * 2; const char* pr = RT + (16 * t4 + lq) * LROW + (32 * kk + 4 * kg) * 2;
                        x = MFMA16(pk_lohi(*(const u32x2*)pa, *(const u32x2*)(pa + 32)), sb[kk], x);
                        y = MFMA16(pk_lohi(*(const u32x2*)pr, *(const u32x2*)(pr + 32)), sb[kk], y);
                        if (2 * kk <= t4) {
                            x = MFMA16(*(const bf16x8*)(NAK + (16 * t4 + lq) * LROW + kk * 64 + kg * 16), vt[kk], x);
                            y = MFMA16(*(const bf16x8*)(NRK + (16 * t4 + lq) * LROW + kk * 64 + kg * 16), vt[kk], y);
                        }
                    }
                    xacc[t4] = x; yacc[t4] = y;
                }
            }
            __syncthreads();
            if (wave < 4) {
                const u32x2 z2 = {0u, 0u};
                f32x4v uacc[4];
                {
                    const u32x2 t0v = *(const u32x2*)(TJ + (0 * 16 + lq) * 32 + 4 * kg * 2);
                    uacc[0] = MFMA16(pk_lohi(t0v, z2), pk_acc1(xacc[0]), ((f32x4v){0.f, 0.f, 0.f, 0.f}));
                }
                UNROLL for (int jb = 1; jb < 4; ++jb) {
                    f32x4v z = xacc[jb];
                    const char* nr = NAB + (16 * jb + lq) * LROW + 4 * kg * 2;
                    if (jb == 1) z = MFMA16(pk_lohi(*(const u32x2*)nr, z2), pk_acc1(uacc[0]), z);
                    else {
                        z = MFMA16(pk_lohi(*(const u32x2*)nr, *(const u32x2*)(nr + 32)), pk_acc2(uacc[0], uacc[1]), z);
                        if (jb == 3) z = MFMA16(pk_lohi(*(const u32x2*)(nr + 64), z2), pk_acc1(uacc[2]), z);
                    }
                    const u32x2 tv = *(const u32x2*)(TJ + (jb * 16 + lq) * 32 + 4 * kg * 2);
                    uacc[jb] = MFMA16(pk_lohi(tv, z2), pk_acc1(z), ((f32x4v){0.f, 0.f, 0.f, 0.f}));
                }
                bf16x8 ub[2]; ub[0] = pk_acc2(uacc[0], uacc[1]); ub[1] = pk_acc2(uacc[2], uacc[3]);
                UNROLL for (int t4 = 0; t4 < 4; ++t4) {
                    f32x4v y = yacc[t4];
                    UNROLL for (int kk = 0; kk < 2; ++kk) if (2 * kk <= t4) {
                        const char* pn = NRB + (16 * t4 + lq) * LROW + (32 * kk + 4 * kg) * 2;
                        y = MFMA16(pk_lohi(*(const u32x2*)pn, *(const u32x2*)(pn + 32)), ub[kk], y);
                    }
                    UNROLL for (int i = 0; i < 4; ++i) YO[(16 * t4 + 4 * kg + i) * 68 + 16 * wave + lq] = y[i];
                }
                UNROLL for (int kt = 0; kt < 4; ++kt) {
                    f32x4v sv = sacc[kt];
                    UNROLL for (int i = 0; i < 4; ++i) sv[i] *= PCv[16 * kt + 4 * kg + i];
                    UNROLL for (int kk = 0; kk < 2; ++kk) {
                        const int xr = 2 * kt + (lq >> 3);
                        const char* pb = BH + (16 * kt + lq) * LROW + (kg & 1) * 8;
                        sv = MFMA16(pk_lohi(*(const u32x2*)(pb + (((4 * kk + (kg >> 1)) ^ xr) << 4)), *(const u32x2*)(pb + (((4 * kk + 2 + (kg >> 1)) ^ xr) << 4))), ub[kk], sv);
                        sv = MFMA16(*(const bf16x8*)(KH + (16 * kt + lq) * LROW + (((4 * kk + kg) ^ xr) << 4)), vt[kk], sv);
                    }
                    sacc[kt] = sv;
                }
            }
            __syncthreads();
            {
                const float4 ya = *(const float4*)(YO + ti * 68 + 8 * j), yb = *(const float4*)(YO + ti * 68 + 8 * j + 4);
                const float y8[8] = {ya.x, ya.y, ya.z, ya.w, yb.x, yb.y, yb.z, yb.w};
                st8(YS + ((size_t)d * NT + nb + tt) * 512 + ch, y8);
            }
            __syncthreads();
        }
    }
}

DEV void ph_rw_read(const Params& p, int L, int ntok) {
    const int lane = TID() & 63, wave = TID() >> 6;
    const bf16_t* PXR = (const bf16_t*)(p.ws + OFF_PX); const bf16_t* VF = (const bf16_t*)(p.ws + OFF_VF);
    const bf16_t* YS = (const bf16_t*)(p.ws + OFF_YS); const float* CB = (const float*)(p.ws + OFF_CB);
    bf16_t* YA = (bf16_t*)(p.ws + OFF_YA); bf16_t* SG = (bf16_t*)(p.ws + OFF_SGB);
    const float* mu = p.in[I_MU] + (size_t)L * RW_COLS;
    const float* lg = p.in[I_LNG] + (size_t)L * 512; const float* lb = p.in[I_LNB] + (size_t)L * 512;
    for (int n0 = blockIdx.x * 8; n0 < ntok; n0 += gridDim.x * 8) {
        const int n = n0 + wave, c = lane * 8, h = lane >> 3;
        float y0[8], y1[8], v8[8], o[8];
        ld8(YS + (size_t)n * 512 + c, y0); ld8(YS + ((size_t)NT + n) * 512 + c, y1); ld8(VF + (size_t)n * 512 + c, v8);
        float s = 0.f;
        UNROLL for (int i = 0; i < 8; ++i) { y0[i] += y1[i]; s += y0[i]; }
        s += __shfl_xor(s, 1); s += __shfl_xor(s, 2); s += __shfl_xor(s, 4);
        const float mean = s * (1.f / 64.f); float q = 0.f;
        UNROLL for (int i = 0; i < 8; ++i) { const float dd = y0[i] - mean; q += dd * dd; }
        q += __shfl_xor(q, 1); q += __shfl_xor(q, 2); q += __shfl_xor(q, 4);
        const float rstd = rsqrtf(q * (1.f / 64.f) + 64e-5f);
        const float bon = CB[(size_t)n * 8 + h] + CB[((size_t)NT + n) * 8 + h];
        UNROLL for (int i = 0; i < 8; ++i) o[i] = (y0[i] - mean) * rstd * lg[c + i] + lb[c + i] + bon * v8[i];
        st8(YA + (size_t)n * 512 + c, o);
        if (lane < 16) {
            int nb, tt, T; seq_of(n, nb, tt, T);
            float g8[8]; shift8(PXR, RW_COLS, nb, tt, T, 1792 + lane * 8, mu, g8);
            UNROLL for (int i = 0; i < 8; ++i) g8[i] = sigm(g8[i]);
            st8(SG + (size_t)n * 128 + lane * 8, g8);
        }
    }
}

DEV void ph_na_norm(const Params& p, int L) {
    const int lane = TID() & 63, wave = TID() >> 6;
    bf16_t* PXN = (bf16_t*)(p.ws + OFF_PX);
    const float* qg = p.in[I_QNG] + (size_t)L * 64; const float* kg = p.in[I_KNG] + (size_t)L * 64;
    for (int n0 = blockIdx.x * 8; n0 < NT; n0 += gridDim.x * 8) {
        const int n = n0 + wave, c = lane * 8;
        UNROLL for (int w = 0; w < 2; ++w) {
            bf16_t* ptr = PXN + (size_t)n * 1024 + w * 512 + c;
            float x[8]; ld8(ptr, x);
            float ss = 0.f;
            UNROLL for (int i = 0; i < 8; ++i) ss += x[i] * x[i];
            ss += __shfl_xor(ss, 1); ss += __shfl_xor(ss, 2); ss += __shfl_xor(ss, 4);
            const float r = rsqrtf(ss * (1.f / 64.f) + 1e-6f) * (w == 0 ? 0.125f : 1.f);
            const float* g = w == 0 ? qg : kg;
            UNROLL for (int i = 0; i < 8; ++i) x[i] = x[i] * r * g[(c + i) & 63];
            st8(ptr, x);
        }
    }
}

DEV void knorm8(float (&x)[8], const float* g) {
    float ss = 0.f;
    UNROLL for (int i = 0; i < 8; ++i) ss += x[i] * x[i];
    ss = sum8(ss);
    const float r = rsqrtf(ss * (1.f / 64.f) + 1e-6f);
    UNROLL for (int i = 0; i < 8; ++i) x[i] = x[i] * r * g[i];
}
DEV void ph_na_att(const Params& p, int L, char* smem) {
    const int tid0 = TID();
    const int wave = __builtin_amdgcn_readfirstlane(tid0 >> 6);
    char* KL = smem;
    char* KC = smem + 576 * LROW;
    char* VL = smem;
    char* VC = smem + 64 * 1168;
    float* OX = (float*)(smem + 119808);
    float* RP = OX + 8 * 1024;
    const bf16_t* PXN = (const bf16_t*)(p.ws + OFF_PX); bf16_t* YB = (bf16_t*)(p.ws + OFF_YB);
    const bf16_t* VT = (const bf16_t*)(p.ws + OFF_VT); const bf16_t* VTC = (const bf16_t*)(p.ws + OFF_VTC);
    const float* qgn = p.in[I_QNG] + (size_t)L * 64; const float* kgn = p.in[I_KNG] + (size_t)L * 64;
    const int nunits = 2048 + (L == 0 ? 256 : 0);
    for (int u = blockIdx.x; u < nunits; u += gridDim.x) {
        int tid = tid0; asm volatile("" : "+v"(tid));
        const int lane = tid & 63, lq = lane & 15, kg = lane >> 4;
        const bool cu = u >= 2048;
        int b, h, rp = 0, rs0 = 0, g = 0;
        if (!cu) { h = u & 7; rp = (u >> 3) & 15; b = u >> 7; rs0 = min(max(2 * rp - 4, 0), 24); }
        else { const int v = u - 2048; h = v & 7; g = (v >> 3) & 1; b = v >> 4; }
        const int ctx0 = NX + b * CTXL;
        if (!cu) {
            UNROLL for (int i = 0; i < 9; ++i) {
                const int c = tid + NTHREADS * i, kx = c >> 3, part = c & 7;
                const int tok = b * SEQ + min(rs0 + (kx >> 6), 31) * 64 + (kx & 63);
                float kv[8]; ld8(PXN + (size_t)tok * 1024 + 512 + h * 64 + part * 8, kv); knorm8(kv, kgn + part * 8);
                st8((bf16_t*)(KL + kx * LROW + part * 16), kv);
            }
            for (int i = tid; i < 15 * 31; i += NTHREADS) RP[i] = p.in[I_RPB][((size_t)L * 8 + h) * 465 + i];
        }
        UNROLL for (int i = 0; i < 4; ++i) {
            const int c = tid + NTHREADS * i, kx = c >> 3, part = c & 7;
            float kv[8]; ld8(PXN + (size_t)(ctx0 + kx) * 1024 + 512 + h * 64 + part * 8, kv); knorm8(kv, kgn + part * 8);
            st8((bf16_t*)(KC + kx * LROW + part * 16), kv);
        }
        const int nb = wave & 3, ri = wave >> 2, r = 2 * rp + ri;
        const int rs = min(max(r - 4, 0), 24), roff = rs - rs0;
        const int qtok0 = cu ? ctx0 + (g * 8 + wave) * 16 : b * SEQ + r * 64 + nb * 16;
        const int band0 = min(max(nb * 16 - 8, 0), 32);
        bf16x8 qf[2];
        {
            float q0[8], q1[8]; ld8(PXN + (size_t)(qtok0 + lq) * 1024 + h * 64 + kg * 8, q0); ld8(PXN + (size_t)(qtok0 + lq) * 1024 + h * 64 + 32 + kg * 8, q1);
            float ss = 0.f;
            UNROLL for (int i = 0; i < 8; ++i) ss += q0[i] * q0[i] + q1[i] * q1[i];
            ss += __shfl_xor(ss, 16); ss += __shfl_xor(ss, 32);
            const float rq = rsqrtf(ss * (1.f / 64.f) + 1e-6f) * 0.125f;
            UNROLL for (int i = 0; i < 8; ++i) { q0[i] = q0[i] * rq * qgn[kg * 8 + i]; q1[i] = q1[i] * rq * qgn[32 + kg * 8 + i]; }
            u32x4 w0, w1; w0.x = pk2(q0[0], q0[1]); w0.y = pk2(q0[2], q0[3]); w0.z = pk2(q0[4], q0[5]); w0.w = pk2(q0[6], q0[7]);
            w1.x = pk2(q1[0], q1[1]); w1.y = pk2(q1[2], q1[3]); w1.z = pk2(q1[4], q1[5]); w1.w = pk2(q1[6], q1[7]);
            qf[0] = __builtin_bit_cast(bf16x8, w0); qf[1] = __builtin_bit_cast(bf16x8, w1);
        }
        __syncthreads();
        u32x4 vraw[13];
        if (!cu) {
            UNROLL for (int i = 0; i < 9; ++i) {
                const int c = tid + NTHREADS * i, part = c & 7, kr = (c >> 3) % 9, d = (c >> 3) / 9;
                vraw[i] = *(const u32x4*)(VT + ((size_t)(b * 8 + h) * 64 + d) * SEQ + min(rs0 + kr, 31) * 64 + part * 8);
            }
        }
        UNROLL for (int i = 0; i < 4; ++i) {
            const int c = tid + NTHREADS * i, part = c & 31, d = c >> 5;
            vraw[9 + i] = *(const u32x4*)(VTC + ((size_t)(b * 8 + h) * 64 + d) * CTXL + part * 8);
        }
        f32x4v sacc[16];
        bf16x8 pfl[8], pfc[8];
        float ml = -3e38f, ll = 0.f, mc, lc;
        if (!cu) {
            const char* kb = KL + (roff * 64 + band0 + lq) * LROW + kg * 16;
            UNROLL for (int t = 0; t < 16; ++t) {
                f32x4v a = {0.f, 0.f, 0.f, 0.f};
                UNROLL for (int ks = 0; ks < 2; ++ks) a = __builtin_amdgcn_mfma_f32_16x16x32_bf16(*(const bf16x8*)(kb + ((t >> 1) * 64 + (t & 1) * 16) * LROW + ks * 64), qf[ks], a, 0, 0, 0);
                sacc[t] = a;
            }
            const int col = nb * 16 + lq, cs = min(max(col - 8, 0), 48);
            const int kc0 = band0 + 4 * kg;
            const float* rpp = RP + (rs - r + 7) * 31 + (kc0 - col + 15);
            UNROLL for (int t = 0; t < 16; ++t) UNROLL for (int i = 0; i < 4; ++i) {
                const int kc = kc0 + (t & 1) * 16 + i;
                const bool valid = kc >= cs && kc < cs + 16;
                sacc[t][i] = valid ? sacc[t][i] + rpp[(t >> 1) * 31 + (t & 1) * 16 + i] : -1e30f;
            }
            UNROLL for (int t = 0; t < 16; ++t) UNROLL for (int i = 0; i < 4; ++i) ml = fmaxf(ml, sacc[t][i]);
            ml = fmaxf(ml, __shfl_xor(ml, 16)); ml = fmaxf(ml, __shfl_xor(ml, 32));
            UNROLL for (int t = 0; t < 16; ++t) UNROLL for (int i = 0; i < 4; ++i) { const float e = __expf(sacc[t][i] - ml); sacc[t][i] = e; ll += e; }
            ll += __shfl_xor(ll, 16); ll += __shfl_xor(ll, 32);
            UNROLL for (int tp = 0; tp < 8; ++tp) pfl[tp] = pk_acc2(sacc[2 * tp], sacc[2 * tp + 1]);
        }
        {
            const char* kb = KC + lq * LROW + kg * 16;
            UNROLL for (int t = 0; t < 16; ++t) {
                f32x4v a = {0.f, 0.f, 0.f, 0.f};
                UNROLL for (int ks = 0; ks < 2; ++ks) a = __builtin_amdgcn_mfma_f32_16x16x32_bf16(*(const bf16x8*)(kb + t * 16 * LROW + ks * 64), qf[ks], a, 0, 0, 0);
                sacc[t] = a;
            }
            mc = -3e38f; lc = 0.f;
            UNROLL for (int t = 0; t < 16; ++t) UNROLL for (int i = 0; i < 4; ++i) mc = fmaxf(mc, sacc[t][i]);
            mc = fmaxf(mc, __shfl_xor(mc, 16)); mc = fmaxf(mc, __shfl_xor(mc, 32));
            UNROLL for (int t = 0; t < 16; ++t) UNROLL for (int i = 0; i < 4; ++i) { const float e = __expf(sacc[t][i] - mc); sacc[t][i] = e; lc += e; }
            lc += __shfl_xor(lc, 16); lc += __shfl_xor(lc, 32);
            UNROLL for (int tp = 0; tp < 8; ++tp) pfc[tp] = pk_acc2(sacc[2 * tp], sacc[2 * tp + 1]);
        }
        const float mm = fmaxf(ml, mc), el = cu ? 0.f : __expf(ml - mm), ec = __expf(mc - mm);
        const float inv = frcp(ll * el + lc * ec);
        const float fl = el * inv, fc = ec * inv;
        __syncthreads();
        if (!cu) {
            UNROLL for (int i = 0; i < 9; ++i) {
                const int c = tid + NTHREADS * i, part = c & 7, kr = (c >> 3) % 9, d = (c >> 3) / 9;
                *(u32x4*)(VL + d * 1168 + (kr * 64 + part * 8) * 2) = vraw[i];
            }
        }
        UNROLL for (int i = 0; i < 4; ++i) {
            const int c = tid + NTHREADS * i, part = c & 31, d = c >> 5;
            *(u32x4*)(VC + d * 528 + part * 16) = vraw[9 + i];
        }
        __syncthreads();
        f32x4v ol[4], oc[4];
        UNROLL for (int dt = 0; dt < 4; ++dt) { ol[dt] = (f32x4v){0.f, 0.f, 0.f, 0.f}; oc[dt] = (f32x4v){0.f, 0.f, 0.f, 0.f}; }
        if (!cu) {
            const char* vb = VL + lq * 1168 + (roff * 64 + band0 + 4 * kg) * 2;
            UNROLL for (int tp = 0; tp < 8; ++tp) UNROLL for (int dt = 0; dt < 4; ++dt)
                ol[dt] = __builtin_amdgcn_mfma_f32_16x16x32_bf16(pfl[tp], pk_lohi(*(const u32x2*)(vb + dt * 16 * 1168 + tp * 128), *(const u32x2*)(vb + dt * 16 * 1168 + tp * 128 + 32)), ol[dt], 0, 0, 0);
        }
        {
            const char* vb = VC + lq * 528 + 8 * kg;
            UNROLL for (int tp = 0; tp < 8; ++tp) UNROLL for (int dt = 0; dt < 4; ++dt)
                oc[dt] = __builtin_amdgcn_mfma_f32_16x16x32_bf16(pfc[tp], pk_lohi(*(const u32x2*)(vb + dt * 16 * 528 + tp * 64), *(const u32x2*)(vb + dt * 16 * 528 + tp * 64 + 32)), oc[dt], 0, 0, 0);
        }
        float* ox = OX + wave * 1024;
        UNROLL for (int i = 0; i < 4; ++i) {
            const float a = __shfl(fl, 4 * kg + i), c2 = __shfl(fc, 4 * kg + i);
            UNROLL for (int dt = 0; dt < 4; ++dt) ox[(4 * kg + i) * 64 + dt * 16 + lq] = ol[dt][i] * a + oc[dt][i] * c2;
        }
        UNROLL for (int it = 0; it < 2; ++it) {
            const int q = (lane >> 3) + 8 * it, c8 = (lane & 7) * 8;
            const float4 a = *(const float4*)(ox + q * 64 + c8), bq = *(const float4*)(ox + q * 64 + c8 + 4);
            const float v[8] = {a.x, a.y, a.z, a.w, bq.x, bq.y, bq.z, bq.w};
            st8(YB + (size_t)(qtok0 + q) * 512 + h * 64 + c8, v);
        }
        __syncthreads();
    }
}

DEV float sum16(float v) { v += DPP_MOV(v, 0xB1); v += DPP_MOV(v, 0x4E); v += DPP_MOV(v, 0x141); v += DPP_MOV(v, 0x140); return v; }
DEV void ph_ml_scan(const Params& p, int L, char* smem) {
    const int tid = TID(), lane = tid & 63, lq = lane & 15, kg = lane >> 4, ti = tid >> 3, j = tid & 7;
    const int wave = __builtin_amdgcn_readfirstlane(tid >> 6);
    char* QS = smem;
    char* QP = QS + 9216;
    char* KC = QP + 9216;
    char* KW = KC + 9216;
    char* PM = KW + 9216;
    char* VT = PM + 9216;
    float* BV = (float*)(VT + 128 * LROW);
    float* GI = BV + 64;
    float* DEN = GI + 64;
    float* NV = DEN + 64;
    float* RS = NV + 64;
    float* HO = RS + 256;
    const bf16_t* PXM = (const bf16_t*)(p.ws + OFF_PX); bf16_t* HS = (bf16_t*)(p.ws + OFF_HS);
    for (int u = blockIdx.x; u < 128; u += gridDim.x) {
        const int d = u & 1, h = (u >> 1) & 3, b = u >> 3;
        const float ib = p.in[I_IB][L * 8 + d * 4 + h], fb = p.in[I_FB][L * 8 + d * 4 + h];
        f32x4v cacc[4];
        UNROLL for (int i = 0; i < 4; ++i) cacc[i] = (f32x4v){0.f, 0.f, 0.f, 0.f};
        for (int i = tid; i < 64 * LROW / 4; i += NTHREADS) ((unsigned*)PM)[i] = 0u;
        if (tid < 64) NV[tid] = 0.f;
        __syncthreads();
        u32x4 pq, pk, pv0, pv1; unsigned short pig = 0, pfg = 0;
#define ML_GEOM(ci_) const bool isc = (ci_) < 4; const int T = isc ? CTXL : SEQ, cc = isc ? (ci_) : (ci_) - 4; \
            const int t0 = d == 0 ? cc * 64 : T - 64 * (cc + 1), nb = isc ? NX + b * CTXL : b * SEQ; \
            const int tt = d == 0 ? t0 + ti : t0 + 63 - ti;
#define ML_PREFETCH(ci_) do { ML_GEOM(ci_) const bf16_t* row_ = PXM + (size_t)(nb + tt) * ML_COLS; \
            pq = *(const u32x4*)(row_ + h * 64 + 8 * j); pk = *(const u32x4*)(row_ + 256 + h * 64 + 8 * j); \
            pv0 = *(const u32x4*)(row_ + 512 + h * 128 + 16 * j); pv1 = *(const u32x4*)(row_ + 512 + h * 128 + 16 * j + 8); \
            if (wave == 0) { const int tl_ = d == 0 ? t0 + lane : t0 + 63 - lane; const bf16_t* rw_ = PXM + (size_t)(nb + tl_) * ML_COLS; pig = rw_[1536 + d * 4 + h]; pfg = rw_[1544 + d * 4 + h]; } } while (0)
        ML_PREFETCH(0);
        for (int ci = 0; ci < 36; ++ci) {
            ML_GEOM(ci)
            float q8[8], k8[8];
            {
                unpack8(pq, q8); unpack8(pk, k8);
                if (!isc) {
                    const int axis = j >> 2, half = (j >> 1) & 1; const float pos = (float)(axis == 0 ? (tt >> 6) : (tt & 63));
                    UNROLL for (int i = 0; i < 8; ++i) {
                        const int f = (j & 1) * 8 + i;
                        const float inv = exp2f(-(float)f * 0.83048202372184059f);
                        const float ang = pos * inv; const float cs = __cosf(ang), sn = __sinf(ang);
                        const float qo = __shfl_xor(q8[i], 2), ko = __shfl_xor(k8[i], 2);
                        q8[i] = half == 0 ? q8[i] * cs - qo * sn : q8[i] * cs + qo * sn;
                        k8[i] = half == 0 ? k8[i] * cs - ko * sn : k8[i] * cs + ko * sn;
                    }
                }
                UNROLL for (int i = 0; i < 8; ++i) q8[i] *= 0.125f;
                st8((bf16_t*)(QS + ti * LROW) + 8 * j, q8); st8((bf16_t*)(KC + ti * LROW) + 8 * j, k8);
                float v0[8], v1[8]; unpack8(pv0, v0); unpack8(pv1, v1);
                UNROLL for (int i = 0; i < 8; ++i) { *(bf16_t*)(VT + (16 * j + i) * LROW + ti * 2) = f2bf(v0[i]); *(bf16_t*)(VT + (16 * j + 8 + i) * LROW + ti * 2) = f2bf(v1[i]); }
                if (wave == 0) {
                    const float ig = bf2f(pig) + ib, fg = bf2f(pfg) + fb;
                    const float igc = 15.f * tanhf(ig * (1.f / 15.f)), fgc = 15.f * tanhf(fg * (1.f / 15.f));
                    float lf = -(fmaxf(-fgc, 0.f) + log1pf(expf(-fabsf(fgc))));
                    UNROLL for (int o = 1; o < 64; o <<= 1) { const float up = __shfl_up(lf, o); if (lane >= o) lf += up; }
                    BV[lane] = lf; GI[lane] = igc;
                }
            }
            __syncthreads();
            if (ci + 1 < 36) ML_PREFETCH(ci + 1);
            {
                const float bt = BV[ti], bl = BV[63], gi = GI[ti];
                const float eb = __expf(bt), wk = __expf(bl - bt + gi);
                float qp[8]; float dn = 0.f;
                UNROLL for (int i = 0; i < 8; ++i) { qp[i] = q8[i] * eb; dn += q8[i] * NV[8 * j + i]; }
                st8((bf16_t*)(QP + ti * LROW) + 8 * j, qp);
                UNROLL for (int i = 0; i < 8; ++i) *(bf16_t*)(KW + (8 * j + i) * LROW + ti * 2) = f2bf(k8[i] * wk);
                dn = sum8(dn);
                if (j == 0) DEN[ti] = dn * eb;
            }
            __syncthreads();
            UNROLL for (int rep = 0; rep < 2; ++rep) {
                const int tile = wave + 8 * rep;
                if (tile < 10) {
                    const int tt4 = tile < 1 ? 0 : tile < 3 ? 1 : tile < 6 ? 2 : 3, st4 = tile - (tt4 * (tt4 + 1)) / 2;
                    f32x4v a = {0.f, 0.f, 0.f, 0.f};
                    UNROLL for (int ks = 0; ks < 2; ++ks)
                        a = __builtin_amdgcn_mfma_f32_16x16x32_bf16(*(const bf16x8*)(QS + (16 * tt4 + lq) * LROW + ks * 64 + kg * 16),
                                                                    *(const bf16x8*)(KC + (16 * st4 + lq) * LROW + ks * 64 + kg * 16), a, 0, 0, 0);
                    const int sidx = 16 * st4 + lq; const float bs = BV[sidx], gs = GI[sidx];
                    UNROLL for (int i = 0; i < 4; ++i) {
                        const int tidx = 16 * tt4 + 4 * kg + i;
                        const float val = sidx <= tidx ? a[i] * __expf(BV[tidx] - bs + gs) : 0.f;
                        *(bf16_t*)(PM + tidx * LROW + sidx * 2) = f2bf(val);
                        const float rsum = sum16(val);
                        if (lq == 0) RS[tidx * 4 + st4] = rsum;
                    }
                }
            }
            __syncthreads();
            {
                bf16x8 vf[2], cb[2];
                UNROLL for (int kk = 0; kk < 2; ++kk) vf[kk] = *(const bf16x8*)(VT + (16 * wave + lq) * LROW + kk * 64 + kg * 16);
                UNROLL for (int kk = 0; kk < 2; ++kk) {
                    u32x4 w; w.x = pk2(cacc[2 * kk][0], cacc[2 * kk][1]); w.y = pk2(cacc[2 * kk][2], cacc[2 * kk][3]);
                    w.z = pk2(cacc[2 * kk + 1][0], cacc[2 * kk + 1][1]); w.w = pk2(cacc[2 * kk + 1][2], cacc[2 * kk + 1][3]);
                    cb[kk] = __builtin_bit_cast(bf16x8, w);
                }
                UNROLL for (int tt4 = 0; tt4 < 4; ++tt4) {
                    f32x4v hacc = {0.f, 0.f, 0.f, 0.f};
                    UNROLL for (int kk = 0; kk < 2; ++kk) if (2 * kk <= tt4)
                        hacc = __builtin_amdgcn_mfma_f32_16x16x32_bf16(*(const bf16x8*)(PM + (16 * tt4 + lq) * LROW + kk * 64 + kg * 16), vf[kk], hacc, 0, 0, 0);
                    UNROLL for (int kk = 0; kk < 2; ++kk) {
                        const char* qa = QP + (16 * tt4 + lq) * LROW + (32 * kk + 4 * kg) * 2;
                        const u32x2 lo = *(const u32x2*)qa, hi = *(const u32x2*)(qa + 32);
                        u32x4 w; w.x = lo.x; w.y = lo.y; w.z = hi.x; w.w = hi.y;
                        hacc = __builtin_amdgcn_mfma_f32_16x16x32_bf16(__builtin_bit_cast(bf16x8, w), cb[kk], hacc, 0, 0, 0);
                    }
                    UNROLL for (int i = 0; i < 4; ++i) {
                        const int tidx = 16 * tt4 + 4 * kg + i;
                        float den = DEN[tidx];
                        UNROLL for (int st = 0; st <= tt4; ++st) den += RS[tidx * 4 + st];
                        HO[tidx * 132 + 16 * wave + lq] = hacc[i] * frcp(fmaxf(fabsf(den), 1.f));
                    }
                }
                const float g = __expf(BV[63]);
                UNROLL for (int dk = 0; dk < 4; ++dk) {
                    cacc[dk] = cacc[dk] * g;
                    UNROLL for (int kk = 0; kk < 2; ++kk)
                        cacc[dk] = __builtin_amdgcn_mfma_f32_16x16x32_bf16(*(const bf16x8*)(KW + (16 * dk + lq) * LROW + kk * 64 + kg * 16), vf[kk], cacc[dk], 0, 0, 0);
                }
            }
            __syncthreads();
            if (tid < 64) {
                float acc = 0.f;
                UNROLL for (int c8 = 0; c8 < 8; ++c8) { float kw[8]; ld8((const bf16_t*)(KW + tid * LROW) + 8 * c8, kw); UNROLL for (int i = 0; i < 8; ++i) acc += kw[i]; }
                NV[tid] = __expf(BV[63]) * NV[tid] + acc;
            }
            {
                const float* hr = HO + ti * 132 + 16 * j;
                float o0[8], o1[8];
                UNROLL for (int i = 0; i < 8; ++i) { o0[i] = hr[i]; o1[i] = hr[8 + i]; }
                bf16_t* dst = HS + ((size_t)d * NT + nb + tt) * 512 + h * 128 + 16 * j;
                st8(dst, o0); st8(dst + 8, o1);
            }
            __syncthreads();
        }
    }
}
DEV void ph_ml_read(const Params& p, int L, int ntok) {
    const int lane = TID() & 63, wave = TID() >> 6;
    const bf16_t* PXM = (const bf16_t*)(p.ws + OFF_PX); const bf16_t* HS = (const bf16_t*)(p.ws + OFF_HS);
    bf16_t* YC = (bf16_t*)(p.ws + OFF_YC); const float* ng = p.in[I_MNG] + (size_t)L * 512;
    for (int n0 = blockIdx.x * 8; n0 < ntok; n0 += gridDim.x * 8) {
        const int n = n0 + wave, c = lane * 8;
        float h0[8], h1[8], o8[8], out[8];
        ld8(HS + (size_t)n * 512 + c, h0); ld8(HS + ((size_t)NT + n) * 512 + c, h1); ld8(PXM + (size_t)n * ML_COLS + 1024 + c, o8);
        float ss = 0.f;
        UNROLL for (int i = 0; i < 8; ++i) { h0[i] += h1[i]; ss += h0[i] * h0[i]; }
        ss += __shfl_xor(ss, 1); ss += __shfl_xor(ss, 2); ss += __shfl_xor(ss, 4); ss += __shfl_xor(ss, 8);
        const float r = rsqrtf(ss * (1.f / 128.f) + 1e-6f);
        UNROLL for (int i = 0; i < 8; ++i) out[i] = h0[i] * r * ng[c + i] * sigm(o8[i]);
        st8(YC + (size_t)n * 512 + c, out);
    }
}

DEV void ph_route(const Params& p, int L, int ntok, char* smem) {
    const int lane = TID() & 63, wave = TID() >> 6;
    const float* LOG = (const float*)(p.ws + OFF_LOG); int* EIDX = (int*)(p.ws + OFF_EIDX); float* EW = (float*)(p.ws + OFF_EW);
    const float bias = p.in[I_MB][L * 64 + lane];
    int* MCNT = (int*)(p.ws + OFF_MCNT);
    int* hist = (int*)smem;
    if (TID() < 192) hist[TID()] = 0;
    __syncthreads();
    for (int n0 = blockIdx.x * 8; n0 < ntok; n0 += gridDim.x * 8) {
        const int n = n0 + wave, g = lane >> 3;
        const float score = sigm_acc(LOG[(size_t)n * 64 + lane]), sel = score + bias;
        float m1 = sel; m1 = fmaxf(m1, __shfl_xor(m1, 1)); m1 = fmaxf(m1, __shfl_xor(m1, 2)); m1 = fmaxf(m1, __shfl_xor(m1, 4));
        int i1 = sel == m1 ? lane : 64; i1 = min(i1, __shfl_xor(i1, 1)); i1 = min(i1, __shfl_xor(i1, 2)); i1 = min(i1, __shfl_xor(i1, 4));
        float m2 = lane == i1 ? -3e38f : sel; m2 = fmaxf(m2, __shfl_xor(m2, 1)); m2 = fmaxf(m2, __shfl_xor(m2, 2)); m2 = fmaxf(m2, __shfl_xor(m2, 4));
        const float gs = m1 + m2;
        int rank = 0;
        UNROLL for (int g2 = 0; g2 < 8; ++g2) { const float v = __shfl(gs, g2 * 8); rank += (v > gs || (v == gs && g2 < g)) ? 1 : 0; }
        const float ms = rank < 4 ? sel : -1e30f;
        int er = 0;
        for (int e2 = 0; e2 < 64; ++e2) { const float v = __shfl(ms, e2); er += (v > ms || (v == ms && e2 < lane)) ? 1 : 0; }
        const bool chosen = er < 8;
        float ws = chosen ? score : 0.f;
        UNROLL for (int o = 1; o < 64; o <<= 1) ws += __shfl_xor(ws, o);
        if (chosen) { EIDX[(size_t)n * 8 + er] = lane; EW[(size_t)n * 8 + er] = score / ws * 2.5f; atomicAdd(hist + (n / MOE_CHUNK) * 64 + lane, 1); }
    }
    __syncthreads();
    if (TID() < 192 && hist[TID()] > 0) atomicAdd(MCNT + TID(), hist[TID()]);
    __syncthreads();
}


DEV void ph_moe_scatter(const Params& p, int ntok, char* smem) {
    const int tid = TID();
    int* base = (int*)smem;
    int* lh = base + 192;
    const int* MCNT = (const int*)(p.ws + OFF_MCNT); int* CUR = (int*)(p.ws + OFF_MCNT) + 192;
    const int* EIDX = (const int*)(p.ws + OFF_EIDX); int* SORT = (int*)(p.ws + OFF_SORT);
    if (tid < 3) { int b = 0; for (int e = 0; e < 64; ++e) { base[tid * 64 + e] = b; b += (MCNT[tid * 64 + e] + 127) & ~127; } }
    if (tid < 192) lh[tid] = 0;
    __syncthreads();
    for (int i = blockIdx.x * NTHREADS + tid; i < ntok * 8; i += gridDim.x * NTHREADS) atomicAdd(lh + ((i >> 3) / MOE_CHUNK) * 64 + EIDX[i], 1);
    __syncthreads();
    if (tid < 192) { const int n = lh[tid]; if (n > 0) base[tid] += atomicAdd(CUR + tid, n); lh[tid] = 0; }
    __syncthreads();
    for (int i = blockIdx.x * NTHREADS + tid; i < ntok * 8; i += gridDim.x * NTHREADS) {
        const int ce = ((i >> 3) / MOE_CHUNK) * 64 + EIDX[i];
        SORT[(size_t)(ce >> 6) * SORT_CAP + base[ce] + atomicAdd(lh + ce, 1)] = i;
    }
    __syncthreads();
}

DEV void ph_moe_exp(const Params& p, int cb, int ce, char* smem, Topo tp) {
    typedef GC<2, 4> C;
    const int tid0 = TID();
    char* ACT = smem + 2 * C::STG;
    int* list = (int*)(smem + 3 * C::STG);
    int* cnt = list + 1024;
    const bf16_t* H2 = (const bf16_t*)(p.ws + OFF_HX); const int* EIDX = (const int*)(p.ws + OFF_EIDX); const float* EW = (const float*)(p.ws + OFF_EW);
    unsigned char* YB8 = (unsigned char*)(p.ws + OFF_YBUF); unsigned char* YSC = (unsigned char*)(p.ws + OFF_YSC);
    const int c = cb / MOE_CHUNK;
    const int* MCNT = (const int*)(p.ws + OFF_MCNT) + c * 64; const int* SORT = (const int*)(p.ws + OFF_SORT) + (size_t)c * SORT_CAP;
    int* tb = cnt + 16;
    const int xcd = tp.x, slot = tp.r, nslot = tp.n;
    __syncthreads();
    if (tid0 < 8) {
        const int tid = tid0; const int e = xcd + 8 * tid; int b = 0;
        for (int e2 = 0; e2 < e; ++e2) b += (MCNT[e2] + 127) & ~127;
        tb[16 + tid] = b; tb[32 + tid] = MCNT[e];
    }
    __syncthreads();
    if (tid0 == 0) { int t = 0; for (int k = 0; k < 8; ++k) { tb[k] = t; t += (tb[32 + k] + 127) >> 7; } tb[8] = t; }
    __syncthreads();
    const int total = tb[8];
    float* ewl = (float*)(list + 256);
    if (slot < total && tid0 < 128) {
        int k = 0;
        while (k < 7 && slot >= tb[k + 1]) ++k;
        const int j = slot - tb[k], M = min(128, tb[32 + k] - 128 * j);
        const int en = SORT[tb[16 + k] + 128 * j + min(tid0, M - 1)];
        list[tid0] = en; ewl[tid0] = EW[en];
    }
    int cur = 0;
#define GLDS4(gp, lp) __builtin_amdgcn_global_load_lds((const __attribute__((address_space(1))) void*)(gp), (__attribute__((address_space(3))) void*)(lp), 4, 0, 0)
    for (int lu = slot; lu < total; lu += nslot) {
        int tid = tid0; asm volatile("" : "+v"(tid));
        const int lane = tid & 63, wave = tid >> 6, wm = wave / 4, wn = wave % 4, fr = lane & 31, fh = lane >> 5;
        int k = 0;
        while (k < 7 && lu >= tb[k + 1]) ++k;
        const int e = xcd + 8 * k, j = lu - tb[k], M = min(128, tb[32 + k] - 128 * j);
        const int* lst = list + cur * 128; const float* ew = ewl + cur * 128;
        int* lst2 = list + (cur ^ 1) * 128; float* ew2 = ewl + (cur ^ 1) * 128;
        const bool has_next = lu + nslot < total;
        __syncthreads();
        if (has_next && tid < 128) {
            const int lu2 = lu + nslot; int k2 = 0;
            while (k2 < 7 && lu2 >= tb[k2 + 1]) ++k2;
            const int j2 = lu2 - tb[k2], M2 = min(128, tb[32 + k2] - 128 * j2);
            GLDS4(SORT + tb[16 + k2] + 128 * j2 + min(tid, M2 - 1), lst2 + tid);
        }
        const bf16_t* GU = (const bf16_t*)(p.ws + OFF_MGU) + (size_t)e * 256 * 1024;
        const bf16_t* DT = (const bf16_t*)(p.ws + OFF_MDT) + (size_t)e * 1024 * 128;
        {
            constexpr int mc = 0;
            f32x16 acc[2][2];
            {
            acc_zero(acc);
            gemm_tile<2, 4, 3, false, true>(acc, [&](int r) -> const bf16_t* { const int ix = min(mc + r, M - 1); return H2 + (size_t)(lst[ix] >> 3) * 1024; },
                                   GU, 1024, 0, 256, 1024, smem, nullptr);
            }
            const int crow = tid >> 3, cch = (tid & 7) ^ ((crow >> 1) & 7);
#define MG2_ISSUE(nt_) do { UNROLL for (int kt = 0; kt < 2; ++kt) UNROLL for (int i = 0; i < 4; ++i) \
                    GLDS16(DT + (size_t)((nt_) * 256 + ((crow + 64 * i) & ~31) + p32(crow & 31)) * 128 + kt * 64 + cch * 8, smem + kt * C::STG + C::AB + i * 8192 + tid * 16); } while (0)
            if (has_next && tid < 128) GLDS4(EW + lst2[tid], ew2 + tid);
            MG2_ISSUE(0);
            UNROLL for (int mi = 0; mi < 2; ++mi) {
                const int row = wm * 64 + mi * 32 + fr;
                const float gw = ew[row];
                float a[2][8];
                UNROLL for (int r = 0; r < 16; ++r) { const float gv = acc[mi][0][r], uv = acc[mi][1][r]; a[r >> 3][r & 7] = gv * frcp(1.f + __expf(-gv)) * uv * gw; }
                const int col0 = wn * 32 + 16 * fh, c0 = (col0 & 63) >> 3, swr = (row >> 1) & 7;
                char* arow_ = ACT + (col0 >> 6) * C::AB + row * 128;
                st8((bf16_t*)(arow_ + ((c0 ^ swr) << 4)), a[0]); st8((bf16_t*)(arow_ + (((c0 + 1) ^ swr) << 4)), a[1]);
            }
            __syncthreads();
            {
                const int sw = (fr >> 1) & 7, a_base = (wm * 64 + fr) * 128, b_base = (wn * 64 + fr) * 128;
                asm volatile("s_waitcnt vmcnt(0)" ::: "memory");
                _Pragma("unroll 1") for (int nt = 0; nt < 4; ++nt) {
                    __builtin_amdgcn_s_barrier();
                    asm volatile("" ::: "memory");
                    acc_zero(acc);
                    UNROLL for (int kt = 0; kt < 2; ++kt) {
                        const char* As_ = ACT + kt * C::AB; const char* Bs_ = smem + kt * C::STG + C::AB;
                        UNROLL for (int ks = 0; ks < 4; ++ks) {
                            const int off = ((2 * ks + fh) ^ sw) * 16;
                            bf16x8 af[2], bfv[2];
                            UNROLL for (int mi = 0; mi < 2; ++mi) af[mi] = *(const bf16x8*)(As_ + a_base + mi * 4096 + off);
                            UNROLL for (int ni = 0; ni < 2; ++ni) bfv[ni] = *(const bf16x8*)(Bs_ + b_base + ni * 4096 + off);
                            UNROLL for (int mi = 0; mi < 2; ++mi) UNROLL for (int ni = 0; ni < 2; ++ni)
                                acc[mi][ni] = __builtin_amdgcn_mfma_f32_32x32x16_bf16(bfv[ni], af[mi], acc[mi][ni], 0, 0, 0);
                        }
                    }
                    asm volatile("s_waitcnt lgkmcnt(0)" ::: "memory");
                    __builtin_amdgcn_s_barrier();
                    asm volatile("" ::: "memory");
                    if (nt < 3) MG2_ISSUE(nt + 1);
                    asm volatile("" ::: "memory");
                    UNROLL for (int mi = 0; mi < 2; ++mi) {
                        const int en = lst[wm * 64 + mi * 32 + fr] - cb * 8;
                        unsigned char* yrow = YB8 + (size_t)en * 1024 + nt * 256 + wn * 64 + 16 * fh;
                        unsigned char* srow = YSC + ((size_t)(en >> 3) * 64 + nt * 16 + wn * 4 + fh) * 8 + (en & 7);
                        UNROLL for (int ni = 0; ni < 2; ++ni) {
                            float m = 0.f;
                            UNROLL for (int i = 0; i < 16; ++i) m = fmaxf(m, fabsf(acc[mi][ni][i]));
                            const unsigned be = max(__float_as_uint(m) >> 23, 7u);
                            const float inv = __uint_as_float((261u - be) << 23);
                            u32x4 w;
                            UNROLL for (int q = 0; q < 4; ++q) {
                                int d = 0;
                                d = __builtin_amdgcn_cvt_pk_fp8_f32(acc[mi][ni][4 * q] * inv, acc[mi][ni][4 * q + 1] * inv, d, false);
                                d = __builtin_amdgcn_cvt_pk_fp8_f32(acc[mi][ni][4 * q + 2] * inv, acc[mi][ni][4 * q + 3] * inv, d, true);
                                if (q == 0) w.x = (unsigned)d; else if (q == 1) w.y = (unsigned)d; else if (q == 2) w.z = (unsigned)d; else w.w = (unsigned)d;
                            }
                            *(u32x4*)(yrow + ni * 32) = w;
                            srow[ni * 16] = (unsigned char)be;
                        }
                    }
                    asm volatile("s_waitcnt vmcnt(8)" ::: "memory");
                }
#undef MG2_ISSUE
            }
        }
        cur ^= 1;
    }
#undef GLDS4
}


#define XB_TMO      128
#define XB_XCNT(j)  (256  + 64 * (j))
#define XB_XSUB(j)  (1280 + 64 * (j))
#define XB_XGEN(j)  (2304 + 64 * (j))
#define XB_TOP      3328
#define XB_TOPGEN   3392
#define XCD_BAR_WORDS 3456
#define XB_SPIN_CAP (1u << 18)
#define LAS __attribute__((address_space(3)))

__device__ __forceinline__ unsigned xb_ld(unsigned* p)              { return __hip_atomic_load(p, __ATOMIC_RELAXED, __HIP_MEMORY_SCOPE_AGENT); }
__device__ __forceinline__ unsigned xb_add(unsigned* p, unsigned v) { return __hip_atomic_fetch_add(p, v, __ATOMIC_RELAXED, __HIP_MEMORY_SCOPE_AGENT); }
__device__ __forceinline__ unsigned xb_xcc_id() { return (unsigned)__builtin_amdgcn_s_getreg((3 << 11) | 20) & 0xFu; }
#define XB_SPIN(cond, bar) do { unsigned _sp = 0; while (cond) { __builtin_amdgcn_s_sleep(1); \
    if ((++_sp & 255u) == 0u) { if (xb_ld(&(bar)[XB_TMO])) break; if (_sp > XB_SPIN_CAP) { atomicAdd(&(bar)[XB_TMO], 1u); break; } } } } while (0)

struct XcdBarrier { unsigned* bar; unsigned x; volatile LAS unsigned* st; };

__device__ __forceinline__ XcdBarrier xcd_barrier_post(unsigned* bar, volatile LAS unsigned* st) {
    XcdBarrier b; b.bar = bar; b.x = xb_xcc_id(); b.st = st;
    if (threadIdx.x == 0) { const unsigned rank = xb_add(&bar[XB_XCNT(b.x)], 1u); st[2] = b.x; st[3] = rank; }
    return b;
}
__device__ __forceinline__ void xcd_barrier_complete(unsigned* bar, unsigned x, unsigned& nloc, unsigned& nx) {
    const unsigned G = gridDim.x * gridDim.y * gridDim.z;
    unsigned sum, cnt, mine, sp = 0u;
    for (;;) {
        sum = 0u; cnt = 0u; mine = 0u;
#pragma unroll
        for (unsigned j = 0; j < 16; ++j) { const unsigned c = xb_ld(&bar[XB_XCNT(j)]); sum += c; cnt += (c > 0u) ? 1u : 0u; mine = (j == x) ? c : mine; }
        if (sum == G) break;
        __builtin_amdgcn_s_sleep(1);
        if ((++sp & 255u) == 0u) { if (xb_ld(&bar[XB_TMO])) break; if (sp > XB_SPIN_CAP) { atomicAdd(&bar[XB_TMO], 1u); break; } }
    }
    nloc = mine > 0u ? mine : 1u; nx = cnt > 0u ? cnt : 1u;
}
__device__ __forceinline__ void xcd_barrier(const XcdBarrier& b) {
    asm volatile("s_waitcnt vmcnt(0)" ::: "memory");
    __syncthreads();
    if (threadIdx.x == 0) {
        unsigned* bar = b.bar;
        __builtin_amdgcn_s_waitcnt(0);
        unsigned nloc = b.st[0], nx = b.st[1];
        if (nloc == 0u) { xcd_barrier_complete(bar, b.x, nloc, nx); b.st[0] = nloc; b.st[1] = nx; }
        const unsigned old = xb_add(&bar[XB_XSUB(b.x)], 1u);
        const unsigned gen = old / nloc;
        if (old + 1u == (gen + 1u) * nloc) {
            __builtin_amdgcn_fence(__ATOMIC_RELEASE, "agent");
            asm volatile("s_waitcnt vmcnt(0)" ::: "memory");
            const unsigned og = xb_add(&bar[XB_TOP], 1u);
            const unsigned tg = og / nx;
            if (og + 1u == (tg + 1u) * nx) xb_add(&bar[XB_TOPGEN], 1u);
            else XB_SPIN(xb_ld(&bar[XB_TOPGEN]) == tg, bar);
            __builtin_amdgcn_fence(__ATOMIC_ACQUIRE, "agent");
            xb_add(&bar[XB_XGEN(b.x)], 1u);
            asm volatile("s_waitcnt vmcnt(0)" ::: "memory");
        } else {
            XB_SPIN(xb_ld(&bar[XB_XGEN(b.x)]) == gen, bar);
            __builtin_amdgcn_fence(__ATOMIC_ACQUIRE, "agent");
            asm volatile("s_waitcnt vmcnt(0)" ::: "memory");
        }
    }
    __syncthreads();
}

enum { PH_MODCONV = 0, PH_HX, PH_GEMM_R, PH_RW_PREP, PH_RW_SCAN, PH_RW_READ, PH_RW_G, PH_GEMM_N, PH_NA_NORM, PH_NA_ATT, PH_GEMM_M, PH_ML_SCAN, PH_ML_READ,
       PH_GEMM_G, PH_MERGE, PH_OUT, PH_NORM2, PH_ROUTER, PH_ROUTE, PH_SHARED, PH_MOE_EXP, PH_MOE_COMB, PH_COUNT };

template <int PH> DEV void run_phase(const Params& p, int L, int sub, char* smem, Topo tp) {
    const int tid = TID(), lane = tid & 63, fr = lane & 31, fh = lane >> 5;
    char* ws = p.ws;
    const int ntl = L == 0 ? NT : NX;
    const bf16_t* HX = (const bf16_t*)(ws + OFF_HX);
    const bf16_t* WINT = (const bf16_t*)(ws + OFF_WINT);
    if constexpr (PH == PH_MODCONV) { ph_mod(p, L, smem); ph_conv_mix(p, L, smem); }
    else if constexpr (PH == PH_HX) { ph_norm(p, L, 0, NT); }
    else if constexpr (PH == PH_GEMM_R || PH == PH_GEMM_M) {
        const int c0 = PH == PH_GEMM_R ? 0 : RW_COLS + NA_COLS;
        const int N = PH == PH_GEMM_R ? RW_COLS : ML_COLS;
        bf16_t* PX = (bf16_t*)(ws + OFF_PX);
        gemm256(HX, NT, WINT + (size_t)c0 * DM, N, DM, smem, tp, [&](int row, int col, const float (&v)[8]) {
            if (col < N) st8(PX + (size_t)row * N + col, v);
        });
    }
    else if constexpr (PH == PH_GEMM_N) {
        bf16_t* PX = (bf16_t*)(ws + OFF_PX); bf16_t* VT = (bf16_t*)(ws + OFF_VT); bf16_t* VTC = (bf16_t*)(ws + OFF_VTC);
        gemm256(HX, NT, WINT + (size_t)RW_COLS * DM, 1024, DM, smem, tp, [&](int row, int col, const float (&v)[8]) { st8(PX + (size_t)row * 1024 + col, v); });
        gemm_phase<4, 2>(HX, DM, NT, WINT + (size_t)(RW_COLS + 1024) * DM, DM, 512, DM, smem, tp, [&](const f32x16 (&acc)[2][2], int row0, int col0) {
            const int h = col0 >> 6;
            epi_cols(acc, smem, [&](int r8, int col, const float (&v)[8]) {
                const int n = row0 + r8;
                bf16_t* dst = n < NX ? VT + ((size_t)((n >> 11) * 8 + h) * 64 + col) * SEQ + (n & 2047)
                                     : VTC + ((size_t)(((n - NX) >> 8) * 8 + h) * 64 + col) * CTXL + ((n - NX) & 255);
                st8(dst, v);
            });
        });
    }
    else if constexpr (PH == PH_RW_PREP) { ph_rw_prep(p, L, smem); }
    else if constexpr (PH == PH_RW_SCAN) { ph_rw_scan(p, L, smem); }
    else if constexpr (PH == PH_RW_READ) { ph_rw_read(p, L, ntl); }
    else if constexpr (PH == PH_RW_G) {
        bf16_t* YA = (bf16_t*)(ws + OFF_YA);
        gemm_phase<4, 2>((const bf16_t*)(ws + OFF_SGB), 128, ntl, (const bf16_t*)(ws + OFF_G2T), 128, 512, 128, smem, tp, [&](const f32x16 (&acc)[2][2], int row0, int col0) {
            epi_rows(acc, smem, [&](int row, int c8, const float (&v)[8]) {
                bf16_t* q = YA + (size_t)(row0 + row) * 512 + col0 + c8;
                float y[8]; ld8(q, y);
                UNROLL for (int i = 0; i < 8; ++i) y[i] *= v[i];
                st8(q, y);
            });
        });
    }
    else if constexpr (PH == PH_NA_NORM) { ph_na_norm(p, L); }
    else if constexpr (PH == PH_NA_ATT) { ph_na_att(p, L, smem); }
    else if constexpr (PH == PH_ML_SCAN) {
        if (blockIdx.x < 128 || gridDim.x <= 128) ph_ml_scan(p, L, smem);
        if (gridDim.x <= 128) ph_conv_moe_gu(p, L, smem, blockIdx.x, gridDim.x);
        else if (blockIdx.x >= 128) ph_conv_moe_gu(p, L, smem, blockIdx.x - 128, gridDim.x - 128);
    }
    else if constexpr (PH == PH_ML_READ) { ph_ml_read(p, L, ntl); }
    else if constexpr (PH == PH_GEMM_G) {
        bf16_t* G = (bf16_t*)(ws + OFF_GATES);
        gemm256(HX, ntl, WINT + (size_t)(RW_COLS + NA_COLS + ML_COLS) * DM, GATE_COLS, DM, smem, tp, [&](int row, int col, const float (&v)[8]) {
            float y[8];
            UNROLL for (int i = 0; i < 8; ++i) y[i] = sigm(v[i]);
            st8(G + (size_t)row * GATE_COLS + col, y);
        });
    }
    else if constexpr (PH == PH_MERGE) {
        const bf16_t* G = (const bf16_t*)(ws + OFF_GATES); bf16_t* MG = (bf16_t*)(ws + OFF_HX);
        _Pragma("unroll 1") for (int br = 0; br < 3; ++br) {
            gemm256((const bf16_t*)(ws + OFF_YA + (size_t)br * SZ_Y1), ntl, (const bf16_t*)(ws + OFF_WBT) + (size_t)br * 1024 * 512, DM, 512, smem, tp, [&](int row, int col, const float (&v)[8]) {
                float g[8], m[8];
                ld8(G + (size_t)row * GATE_COLS + br * DM + col, g);
                bf16_t* q = MG + (size_t)row * DM + col;
                if (br == 0) { UNROLL for (int i = 0; i < 8; ++i) m[i] = g[i] * v[i]; }
                else { ld8(q, m); UNROLL for (int i = 0; i < 8; ++i) m[i] += g[i] * v[i]; }
                st8(q, m);
            });
        }
    }
    else if constexpr (PH == PH_OUT) {
        const float* MOD = (const float*)(ws + OFF_MOD);
        gemm256(HX, ntl, (const bf16_t*)(ws + OFF_WOUTT), DM, DM, smem, tp, [&](int n, int c, const float (&v)[8]) {
            const float* xp = xprev_row(p, L, n) + c; float* xo = xs_row(p, n) + c; const float* g1 = MOD + mod_row(n) * 6144 + 2 * DM + c;
            const float4 xa = *(const float4*)xp, xb = *(const float4*)(xp + 4), ga = *(const float4*)g1, gb = *(const float4*)(g1 + 4);
            float4 oa, ob;
            oa.x = xa.x + ga.x * v[0]; oa.y = xa.y + ga.y * v[1]; oa.z = xa.z + ga.z * v[2]; oa.w = xa.w + ga.w * v[3];
            ob.x = xb.x + gb.x * v[4]; ob.y = xb.y + gb.y * v[5]; ob.z = xb.z + gb.z * v[6]; ob.w = xb.w + gb.w * v[7];
            *(float4*)xo = oa; *(float4*)(xo + 4) = ob;
        });
    }
    else if constexpr (PH == PH_NORM2) {
        if (blockIdx.x == 0 && tid < 384) ((int*)(ws + OFF_MCNT))[tid] = 0;
        ph_norm(p, L, 1, ntl);
    }
    else if constexpr (PH == PH_ROUTER) {
        typedef GC<4, 2> C;
        float* LOG = (float*)(ws + OFF_LOG);
        const bf16_t* H2LO = (const bf16_t*)(ws + OFF_H2LO); const bf16_t* RH = (const bf16_t*)(ws + OFF_RTR); const bf16_t* RL = RH + 64 * 1024;
        const int wave = tid >> 6, wm = wave / 2, wn = wave % 2;
        {
            const int nrt = ntl / C::BM, G = gridDim.x;
            if (G > nrt) { if ((int)blockIdx.x >= nrt) ph_conv_moe(p, L, smem, blockIdx.x - nrt, G - nrt); }
            else ph_conv_moe(p, L, smem, blockIdx.x, G);
        }
        for (int t = blockIdx.x; t < ntl / C::BM; t += gridDim.x) {
            f32x16 acc[2][2]; acc_zero(acc);
            const bf16_t* A0 = HX + (size_t)t * C::BM * DM; const bf16_t* A1 = H2LO + (size_t)t * C::BM * DM;
            gemm_tile<4, 2, 3, false>(acc, [&](int r) { return A0 + (size_t)r * DM; }, RH, DM, 0, 64, DM, smem, nullptr);
            gemm_tile<4, 2, 3, false>(acc, [&](int r) { return A1 + (size_t)r * DM; }, RH, DM, 0, 64, DM, smem, nullptr);
            gemm_tile<4, 2, 3, false>(acc, [&](int r) { return A0 + (size_t)r * DM; }, RL, DM, 0, 64, DM, smem, nullptr);
            epi_rows(acc, smem, [&](int row, int c8, const float (&v)[8]) {
                if (wn == 0) {
                    float* q = LOG + (size_t)(t * C::BM + wm * 64 + row) * 64 + c8;
                    *(float4*)q = make_float4(v[0], v[1], v[2], v[3]); *(float4*)(q + 4) = make_float4(v[4], v[5], v[6], v[7]);
                }
            });
        }
    }
    else if constexpr (PH == PH_ROUTE) { ph_route(p, L, ntl, smem); }
    else if constexpr (PH == PH_SHARED) {
        ph_moe_scatter(p, ntl, smem);
        bf16_t* SA = (bf16_t*)(ws + OFF_SA);
        gemm256_pair(HX, ntl, (const bf16_t*)(ws + OFF_SGUT), 512, DM, smem, tp, [&](int row, int col, const float (&g)[8], const float (&u)[8]) {
            float a[8];
            UNROLL for (int i = 0; i < 8; ++i) a[i] = g[i] * frcp(1.f + __expf(-g[i])) * u[i];
            st8(SA + (size_t)row * 256 + (col >> 8) * 128 + (col & 127), a);
        });
    }
    else if constexpr (PH == PH_MOE_EXP) { const int cb = sub * MOE_CHUNK; ph_moe_exp(p, cb, min(cb + MOE_CHUNK, ntl), smem, tp); }
    else if constexpr (PH == PH_MOE_COMB) {
        const int cb = sub * MOE_CHUNK, ce = min(cb + MOE_CHUNK, ntl);
        const float* MOD = (const float*)(ws + OFF_MOD); const unsigned char* YB8 = (const unsigned char*)(ws + OFF_YBUF); const unsigned char* YSC = (const unsigned char*)(ws + OFF_YSC);
        gemm256((const bf16_t*)(ws + OFF_SA) + (size_t)cb * 256, ce - cb, (const bf16_t*)(ws + OFF_SDT), DM, 256, smem, tp, [&](int rl, int c, const float (&v)[8]) {
            const int n = cb + rl;
            float s[8];
            UNROLL for (int i = 0; i < 8; ++i) s[i] = v[i];
            const u32x2 sc = *(const u32x2*)(YSC + ((size_t)rl * 64 + (c >> 4)) * 8);
            const unsigned long long sc64 = (unsigned long long)sc.x | ((unsigned long long)sc.y << 32);
            _Pragma("unroll 2") for (int k = 0; k < 8; ++k) {
                const u32x2 d = *(const u32x2*)(YB8 + ((size_t)rl * 8 + k) * DM + c);
                const unsigned be = (unsigned)(sc64 >> (8 * k)) & 255u;
                const float scl = __uint_as_float((be - 7u) << 23);
                typedef float f2v __attribute__((ext_vector_type(2)));
                const f2v y0 = __builtin_amdgcn_cvt_pk_f32_fp8((int)d.x, false), y1 = __builtin_amdgcn_cvt_pk_f32_fp8((int)d.x, true);
                const f2v y2 = __builtin_amdgcn_cvt_pk_f32_fp8((int)d.y, false), y3 = __builtin_amdgcn_cvt_pk_f32_fp8((int)d.y, true);
                s[0] += y0.x * scl; s[1] += y0.y * scl; s[2] += y1.x * scl; s[3] += y1.y * scl;
                s[4] += y2.x * scl; s[5] += y2.y * scl; s[6] += y3.x * scl; s[7] += y3.y * scl;
            }
            float* xo = xs_row(p, n) + c; const float* g2 = MOD + mod_row(n) * 6144 + 5 * DM + c;
            float4 xa = *(const float4*)xo, xb = *(const float4*)(xo + 4); const float4 ga = *(const float4*)g2, gb = *(const float4*)(g2 + 4);
            xa.x += ga.x * s[0]; xa.y += ga.y * s[1]; xa.z += ga.z * s[2]; xa.w += ga.w * s[3];
            xb.x += gb.x * s[4]; xb.y += gb.y * s[5]; xb.z += gb.z * s[6]; xb.w += gb.w * s[7];
            *(float4*)xo = xa; *(float4*)(xo + 4) = xb;
        });
    }
}

#ifndef N_LAUNCH_MODE
#define N_LAUNCH_MODE 1
#endif
#if N_LAUNCH_MODE == 0
template <int PH> __global__ void __launch_bounds__(NTHREADS, 2) k_phase(Params p, int L, int sub) {
    extern __shared__ __attribute__((aligned(16))) char smem[];
    run_phase<PH>(p, L, sub, smem, Topo{(int)(blockIdx.x & 7), (int)(blockIdx.x >> 3), (int)((gridDim.x + 7 - (blockIdx.x & 7)) >> 3)});
}
#endif


#ifndef MEGA_SKIP
#define MEGA_SKIP 0ull
#endif
#ifndef MEGA_REPEAT
#define MEGA_REPEAT 0ull
#endif
#define BARRIER() do { XcdBarrier b2_ = bar; unsigned so_ = LDS_BYTES; asm volatile("" : "+v"(so_)); b2_.st = (volatile LAS unsigned*)(smem + so_); xcd_barrier(b2_); } while (0)
#define PHASE(PH, sub) do { if constexpr (!((MEGA_SKIP >> PH) & 1ull)) { run_phase<PH>(p, L, sub, smem, tp); BARRIER(); if constexpr ((MEGA_REPEAT >> PH) & 1ull) { run_phase<PH>(p, L, sub, smem, tp); BARRIER(); } } } while (0)
__global__ void __launch_bounds__(NTHREADS, 2) k_mega(Params p) {
    extern __shared__ __attribute__((aligned(16))) char smem[];
    volatile LAS unsigned* st = (volatile LAS unsigned*)(smem + LDS_BYTES);
    if (threadIdx.x == 0) { st[0] = 0u; st[1] = 0u; st[2] = 0u; st[3] = 0u; }
    __syncthreads();
    const XcdBarrier bar = xcd_barrier_post((unsigned*)(p.ws + OFF_BAR), st);
    Topo tp{(int)(blockIdx.x & 7), (int)(blockIdx.x >> 3), (int)((gridDim.x + 7 - (blockIdx.x & 7)) >> 3)};
    for (int L = 0; L < 2; ++L) {
        const int ntl = L == 0 ? NT : NX;
        PHASE(PH_MODCONV, 0);
        if (st[1] == 8u && st[0] != 0u) { tp.x = (int)st[2]; tp.r = (int)st[3]; tp.n = (int)st[0]; }
        PHASE(PH_HX, 0);
        PHASE(PH_GEMM_R, 0);
        PHASE(PH_RW_PREP, 0);
        PHASE(PH_RW_SCAN, 0);
        PHASE(PH_RW_READ, 0);
        PHASE(PH_RW_G, 0);
        PHASE(PH_GEMM_N, 0);
        PHASE(PH_NA_ATT, 0);
        PHASE(PH_GEMM_M, 0);
        PHASE(PH_ML_SCAN, 0);
        PHASE(PH_ML_READ, 0);
        PHASE(PH_GEMM_G, 0);
        PHASE(PH_MERGE, 0);
        PHASE(PH_OUT, 0);
        PHASE(PH_NORM2, 0);
        PHASE(PH_ROUTER, 0);
        PHASE(PH_ROUTE, 0);
        PHASE(PH_SHARED, 0);
        for (int c = 0; c * MOE_CHUNK < ntl; ++c) {
            PHASE(PH_MOE_EXP, c);
            PHASE(PH_MOE_COMB, c);
        }
    }
}

#if N_LAUNCH_MODE == 0
template <int PH> static void launch_phase(const Params& p, int L, int sub, hipStream_t stream) {
    static bool attr = false;
    if (!attr) { (void)hipFuncSetAttribute((const void*)k_phase<PH>, hipFuncAttributeMaxDynamicSharedMemorySize, LDS_BYTES); attr = true; }
    hipLaunchKernelGGL(k_phase<PH>, dim3(256), dim3(NTHREADS), LDS_BYTES, stream, p, L, sub);
}
#endif

extern "C" void kernel_launch(void* const* d_in, const int* in_sizes, int n_in, void* d_out, int out_size, void* d_ws, size_t ws_size, hipStream_t stream) {
    if (n_in != N_IN || ws_size < WS_END) { fprintf(stderr, "kernel_launch: unexpected inputs (%d) or workspace (%zu < %zu)\n", n_in, ws_size, (size_t)WS_END); return; }
    Params p{};
    for (int i = 0; i < N_IN; ++i) p.in[i] = (const float*)d_in[i];
    p.out = (float*)d_out; p.ws = (char*)d_ws;
#if N_LAUNCH_MODE == 1
    static int grid = 0;
    if (grid == 0) {
        int dev = 0, cus = 0;
        if (hipGetDevice(&dev) != hipSuccess || hipDeviceGetAttribute(&cus, hipDeviceAttributeMultiprocessorCount, dev) != hipSuccess) { grid = -1; return; }
        if (hipFuncSetAttribute((const void*)k_mega, hipFuncAttributeMaxDynamicSharedMemorySize, LDS_BYTES + 256) != hipSuccess) { grid = -1; return; }
        grid = cus;
    }
    if (grid <= 0) return;
    (void)hipMemsetAsync((char*)d_ws + OFF_BAR, 0, XCD_BAR_WORDS * sizeof(unsigned), stream);
    hipLaunchKernelGGL(k_mega, dim3(grid), dim3(NTHREADS), LDS_BYTES + 256, stream, p);
    return;
#endif
#if N_LAUNCH_MODE == 0
    for (int L = 0; L < 2; ++L) {
        const int ntl = L == 0 ? NT : NX;
        launch_phase<PH_MODCONV>(p, L, 0, stream);
        launch_phase<PH_HX>(p, L, 0, stream);
        launch_phase<PH_GEMM_R>(p, L, 0, stream);
        launch_phase<PH_RW_PREP>(p, L, 0, stream);
        launch_phase<PH_RW_SCAN>(p, L, 0, stream);
        launch_phase<PH_RW_READ>(p, L, 0, stream);
        launch_phase<PH_RW_G>(p, L, 0, stream);
        launch_phase<PH_GEMM_N>(p, L, 0, stream);
        launch_phase<PH_NA_ATT>(p, L, 0, stream);
        launch_phase<PH_GEMM_M>(p, L, 0, stream);
        launch_phase<PH_ML_SCAN>(p, L, 0, stream);
        launch_phase<PH_ML_READ>(p, L, 0, stream);
        launch_phase<PH_GEMM_G>(p, L, 0, stream);
        launch_phase<PH_MERGE>(p, L, 0, stream);
        launch_phase<PH_OUT>(p, L, 0, stream);
        launch_phase<PH_NORM2>(p, L, 0, stream);
        launch_phase<PH_ROUTER>(p, L, 0, stream);
        launch_phase<PH_ROUTE>(p, L, 0, stream);
        launch_phase<PH_SHARED>(p, L, 0, stream);
        for (int c = 0; c * MOE_CHUNK < ntl; ++c) {
            launch_phase<PH_MOE_EXP>(p, L, c, stream);
            launch_phase<PH_MOE_COMB>(p, L, c, stream);
        }
    }
#endif
}
```

```cpp
#include <hip/hip_runtime.h>
#include <stdint.h>
#include <stdio.h>

#define DEV __device__ __forceinline__
#define UNROLL _Pragma("unroll")

typedef unsigned short bf16_t;
typedef short bf16x8 __attribute__((ext_vector_type(8)));
typedef float f32x16 __attribute__((ext_vector_type(16)));
typedef float f32x4v __attribute__((ext_vector_type(4)));
typedef unsigned u32x4 __attribute__((ext_vector_type(4)));
typedef unsigned u32x2 __attribute__((ext_vector_type(2)));

constexpr int DM = 1024, NBATCH = 16, SEQ = 2048, CTXL = 256;
constexpr int NX = NBATCH * SEQ, NC = NBATCH * CTXL, NT = NX + NC;
constexpr int RW_COLS = 1920, NA_COLS = 1536, ML_COLS = 1552, GATE_COLS = 3072, IN_COLS = 8080;
constexpr int NTHREADS = 512;
constexpr int MOE_CHUNK = 16384, MOE_ST = 768;

enum { I_X = 0, I_C, I_CTX, I_CCTX, I_WADA, I_BADA, I_N1G, I_N2G, I_WIN, I_MU, I_W0, I_W2, I_A0, I_A2, I_KK, I_KA, I_RK, I_G2,
       I_LNG, I_LNB, I_V0, I_V1, I_V2, I_QNG, I_KNG, I_RPB, I_IB, I_FB, I_MNG, I_WBR, I_WOUT, I_RTR, I_MB, I_MWG, I_MWU, I_MWD,
       I_SG, I_SU, I_SD, N_IN };

constexpr size_t OFF_BAR = 0;
constexpr size_t OFF_MOD = 16384;
constexpr size_t OFF_WINT = OFF_MOD + 417792;
constexpr size_t OFF_WBT = OFF_WINT + (size_t)IN_COLS * 1024 * 2;
constexpr size_t OFF_WOUTT = OFF_WBT + (size_t)3 * 1024 * 512 * 2;
constexpr size_t OFF_SGUT = OFF_WOUTT + (size_t)1024 * 1024 * 2;
constexpr size_t OFF_SDT = OFF_SGUT + (size_t)512 * 1024 * 2;
constexpr size_t OFF_G2T = OFF_SDT + (size_t)1024 * 256 * 2;
constexpr size_t OFF_RTR = OFF_G2T + (size_t)512 * 128 * 2;
constexpr size_t OFF_CTXS = OFF_RTR + (size_t)2 * 64 * 1024 * 2;
constexpr size_t OFF_VF = OFF_CTXS + (size_t)NC * 1024 * 4;
constexpr size_t OFF_HX = OFF_VF + (size_t)NT * 512 * 2;
constexpr size_t OFF_BIG = OFF_HX + (size_t)NT * 1024 * 2;
constexpr size_t SZ_Y1 = (size_t)NT * 512 * 2;
constexpr size_t OFF_YA = OFF_BIG, OFF_YB = OFF_YA + SZ_Y1, OFF_YC = OFF_YB + SZ_Y1;
constexpr size_t OFF_PX = OFF_BIG + 3 * SZ_Y1;
constexpr size_t OFF_SCR = OFF_PX + (size_t)NT * RW_COLS * 2;
constexpr size_t SZ_SCR = (size_t)NT * 1152 * 2;
constexpr size_t OFF_MGU = OFF_SCR + SZ_SCR;
constexpr size_t WS_END = OFF_MGU + (size_t)64 * 256 * 1024 * 2;
constexpr size_t OFF_YS = OFF_YB;
constexpr size_t OFF_SGB = OFF_SCR;
constexpr size_t OFF_CB = OFF_SCR + (size_t)NT * 128 * 2;
constexpr size_t OFF_HS = OFF_SCR;
constexpr size_t OFF_VT = OFF_PX + (size_t)NT * 1024 * 2;
constexpr size_t OFF_VTC = OFF_VT + (size_t)NX * 512 * 2;
constexpr size_t OFF_GATES = OFF_PX;
constexpr size_t OFF_MDT = OFF_BIG;
constexpr size_t OFF_SA = OFF_MDT + (size_t)64 * 1024 * 128 * 2;
constexpr size_t OFF_EIDX = OFF_SA + (size_t)NT * 256 * 2;
constexpr size_t OFF_EW = OFF_EIDX + (size_t)NT * 8 * 4;
constexpr int SORT_CAP = MOE_CHUNK * 8 + 64 * 128;
constexpr size_t OFF_SORT = OFF_EW + (size_t)NT * 8 * 4;
constexpr size_t OFF_LOG = OFF_SORT + (size_t)3 * SORT_CAP * 4;
constexpr size_t OFF_H2LO = OFF_LOG + (size_t)NT * 64 * 4;
constexpr size_t OFF_YBUF = OFF_LOG;
constexpr size_t OFF_YSC = OFF_YBUF + (size_t)MOE_CHUNK * 8 * 1024;
static_assert(OFF_YSC + (size_t)MOE_CHUNK * 512 <= WS_END, "moe layout");
static_assert(OFF_GATES + (size_t)NT * 3072 * 2 <= WS_END, "gates layout");
static_assert(WS_END <= (size_t)536870912, "workspace");

constexpr size_t OFF_MCNT = OFF_BAR + 14336;
constexpr int LDS_BYTES = 155648;

struct Topo { int x, r, n; };
struct Params {
    const float* in[N_IN];
    float* out;
    char* ws;
};

DEV int TID() { int t = threadIdx.x; asm volatile("" : "+v"(t)); return t; }
DEV float bf2f(bf16_t h) { return __uint_as_float(((unsigned)h) << 16); }
typedef __bf16 bf16x2n __attribute__((ext_vector_type(2)));
typedef float f32x2n __attribute__((ext_vector_type(2)));
DEV unsigned pk2(float lo, float hi) { const f32x2n v = {lo, hi}; return __builtin_bit_cast(unsigned, __builtin_convertvector(v, bf16x2n)); }
DEV bf16_t f2bf(float f) { return (bf16_t)(pk2(f, 0.f) & 0xffffu); }
DEV void ld8(const bf16_t* p, float (&o)[8]) {
    const u32x4 v = *(const u32x4*)p;
    o[0] = __uint_as_float(v.x << 16); o[1] = __uint_as_float(v.x & 0xffff0000u);
    o[2] = __uint_as_float(v.y << 16); o[3] = __uint_as_float(v.y & 0xffff0000u);
    o[4] = __uint_as_float(v.z << 16); o[5] = __uint_as_float(v.z & 0xffff0000u);
    o[6] = __uint_as_float(v.w << 16); o[7] = __uint_as_float(v.w & 0xffff0000u);
}
DEV void st8(bf16_t* p, const float (&v)[8]) {
    u32x4 o; o.x = pk2(v[0], v[1]); o.y = pk2(v[2], v[3]); o.z = pk2(v[4], v[5]); o.w = pk2(v[6], v[7]);
    *(u32x4*)p = o;
}
#define DPP_MOV(v, ctrl) __builtin_bit_cast(float, __builtin_amdgcn_update_dpp(0, __builtin_bit_cast(int, (v)), (ctrl), 0xF, 0xF, true))
DEV float sum8(float v) { v += DPP_MOV(v, 0xB1); v += DPP_MOV(v, 0x4E); v += DPP_MOV(v, 0x141); return v; }
DEV float frcp(float x) { return __builtin_amdgcn_rcpf(x); }
DEV float sigm(float x) { return frcp(1.f + __expf(-x)); }
DEV float sigm_acc(float x) { return 1.f / (1.f + expf(-x)); }
DEV float tanh_fast(float x) { return 1.f - 2.f * frcp(1.f + __expf(2.f * x)); }
DEV float softplus_fast(float x) { return fmaxf(x, 0.f) + __logf(1.f + __expf(-fabsf(x))); }
DEV int mod_row(int n) { return n < NX ? (n >> 11) : 16; }
DEV float* xs_row(const Params& p, int n) { return n < NX ? p.out + (size_t)n * DM : (float*)(p.ws + OFF_CTXS) + (size_t)(n - NX) * DM; }
DEV const float* xprev_row(const Params& p, int L, int n) {
    if (L == 0) return n < NX ? p.in[I_X] + (size_t)n * DM : p.in[I_CTX] + (size_t)(n - NX) * DM;
    return xs_row(p, n);
}
DEV void seq_of(int n, int& nb, int& tt, int& T) {
    if (n < NX) { nb = n & ~2047; tt = n & 2047; T = SEQ; } else { const int m = n - NX; nb = NX + (m & ~255); tt = m & 255; T = CTXL; }
}
DEV void shift8(const bf16_t* z, int ld, int nb, int tt, int T, int col0, const float* mu, float (&o)[8]) {
    float c[8], l[8], r[8];
    ld8(z + (size_t)(nb + tt) * ld + col0, c);
    if (tt > 0) ld8(z + (size_t)(nb + tt - 1) * ld + col0, l); else { UNROLL for (int i = 0; i < 8; ++i) l[i] = 0.f; }
    if (tt < T - 1) ld8(z + (size_t)(nb + tt + 1) * ld + col0, r); else { UNROLL for (int i = 0; i < 8; ++i) r[i] = 0.f; }
    UNROLL for (int i = 0; i < 8; ++i) o[i] = c[i] + mu[col0 + i] * (0.5f * (l[i] + r[i]) - c[i]);
}

constexpr int LROW = 144;
template <int WM, int WN> struct GC {
    static constexpr int BM = 64 * WM, BN = 64 * WN;
    static constexpr int AB = BM * 128, BB = BN * 128, STG = AB + BB;
    static constexpr int NA = BM / 64, NBC = BN / 64;
};
DEV void acc_zero(f32x16 (&acc)[2][2]) {
    UNROLL for (int a = 0; a < 2; ++a) UNROLL for (int b = 0; b < 2; ++b) UNROLL for (int r = 0; r < 16; ++r) acc[a][b][r] = 0.f;
}
#define GLDS16(gp, lp) __builtin_amdgcn_global_load_lds((const __attribute__((address_space(1))) void*)(gp), (__attribute__((address_space(3))) void*)(lp), 16, 0, 0)
DEV int p32(int s) { return 16 * ((s >> 2) & 1) + (s & 3) + 4 * (s >> 3); }
template <int WM, int WN, int NS, bool A_LDS, bool TR = false, class ARow>
DEV void gemm_tile(f32x16 (&acc)[2][2], ARow arow, const bf16_t* Bt, int ldb, int n0, int Nvalid, int K, char* smem, const char* alds) {
    typedef GC<WM, WN> C;
    constexpr int LPT = (A_LDS ? 0 : C::NA) + C::NBC;
    const int tid = TID(), lane = tid & 63, wave = tid >> 6, wm = wave / WN, wn = wave % WN;
    const int fr = lane & 31, fh = lane >> 5;
    const int crow = tid >> 3, cch = (tid & 7) ^ ((crow >> 1) & 7);
    const bf16_t* pa[C::NA]; const bf16_t* pb[C::NBC];
    if (!A_LDS) { UNROLL for (int i = 0; i < C::NA; ++i) pa[i] = arow(crow + 64 * i) + cch * 8; }
    UNROLL for (int i = 0; i < C::NBC; ++i) { const int rb = crow + 64 * i, n = min(n0 + (TR ? (rb & ~31) + p32(rb & 31) : rb), Nvalid - 1); pb[i] = Bt + (size_t)n * ldb + cch * 8; }
    const int nk = K >> 6;
#define GT_ISSUE(kt, stg) do { char* sb_ = smem + (stg) * C::STG + tid * 16; \
        if (!A_LDS) { UNROLL for (int i = 0; i < C::NA; ++i) GLDS16(pa[i] + (kt) * 64, sb_ + i * 8192); } \
        UNROLL for (int i = 0; i < C::NBC; ++i) GLDS16(pb[i] + (kt) * 64, sb_ + C::AB + i * 8192); } while (0)
    const int sw = (fr >> 1) & 7;
    int offk[4];
    UNROLL for (int ks = 0; ks < 4; ++ks) offk[ks] = ((2 * ks + fh) ^ sw) * 16;
    const int a_base = (wm * 64 + fr) * 128, b_base = (wn * 64 + fr) * 128;
    UNROLL for (int s = 0; s < NS - 1; ++s) if (s < nk) GT_ISSUE(s, s);
    int stg = 0, nstg = NS - 1;
    for (int kt = 0; kt < nk; ++kt) {
        if (NS == 3 && kt + 1 < nk) asm volatile("s_waitcnt vmcnt(%0)" :: "n"(LPT) : "memory");
        else asm volatile("s_waitcnt vmcnt(0)" ::: "memory");
        __builtin_amdgcn_s_barrier();
        asm volatile("" ::: "memory");
        const bool more = kt + NS - 1 < nk;
        const char* As_ = A_LDS ? alds + kt * C::AB : smem + stg * C::STG; const char* Bs_ = smem + stg * C::STG + C::AB;
        char* db_ = smem + nstg * C::STG + tid * 16;
        bf16x8 af[2][2], bfv[2][2];
        UNROLL for (int mi = 0; mi < 2; ++mi) af[0][mi] = *(const bf16x8*)(As_ + a_base + mi * 4096 + offk[0]);
        UNROLL for (int ni = 0; ni < 2; ++ni) bfv[0][ni] = *(const bf16x8*)(Bs_ + b_base + ni * 4096 + offk[0]);
        UNROLL for (int ks = 0; ks < 4; ++ks) {
            const int cur = ks & 1, nxt = cur ^ 1;
            if (ks < 3) {
                UNROLL for (int mi = 0; mi < 2; ++mi) af[nxt][mi] = *(const bf16x8*)(As_ + a_base + mi * 4096 + offk[ks + 1]);
                UNROLL for (int ni = 0; ni < 2; ++ni) bfv[nxt][ni] = *(const bf16x8*)(Bs_ + b_base + ni * 4096 + offk[ks + 1]);
            }
            UNROLL for (int mi = 0; mi < 2; ++mi) UNROLL for (int ni = 0; ni < 2; ++ni)
                acc[mi][ni] = TR ? __builtin_amdgcn_mfma_f32_32x32x16_bf16(bfv[cur][ni], af[cur][mi], acc[mi][ni], 0, 0, 0)
                                 : __builtin_amdgcn_mfma_f32_32x32x16_bf16(af[cur][mi], bfv[cur][ni], acc[mi][ni], 0, 0, 0);
            if (more) {
                UNROLL for (int pc = 0; pc < LPT; ++pc) if (pc * 4 / LPT == ks) {
                    if (!A_LDS && pc < C::NA) GLDS16(pa[pc] + (kt + NS - 1) * 64, db_ + pc * 8192);
                    else { const int ib = pc - (A_LDS ? 0 : C::NA); GLDS16(pb[ib] + (kt + NS - 1) * 64, db_ + C::AB + ib * 8192); }
                }
            }
            __builtin_amdgcn_sched_barrier(0);
        }
        stg = stg + 1 == NS ? 0 : stg + 1; nstg = nstg + 1 == NS ? 0 : nstg + 1;
    }
    __syncthreads();
#undef GT_ISSUE
}
#define ACC_ROW(mi, r, fh) ((mi) * 32 + ((r) & 3) + 8 * ((r) >> 2) + 4 * (fh))

constexpr int EPI_SLAB = 32 * 68 * 4;
template <class F> DEV void epi_rows(const f32x16 (&acc)[2][2], char* smem, F f) {
    const int lane = TID() & 63, wave = TID() >> 6, fr = lane & 31, fh = lane >> 5;
    float* st = (float*)(smem + wave * EPI_SLAB);
    UNROLL for (int mi = 0; mi < 2; ++mi) {
        UNROLL for (int ni = 0; ni < 2; ++ni) UNROLL for (int r = 0; r < 16; ++r)
            st[((r & 3) + 8 * (r >> 2) + 4 * fh) * 68 + ni * 32 + fr] = acc[mi][ni][r];
        UNROLL for (int it = 0; it < 4; ++it) {
            const int row = it * 8 + (lane >> 3), c8 = (lane & 7) * 8;
            const float4 a = *(const float4*)(st + row * 68 + c8), b = *(const float4*)(st + row * 68 + c8 + 4);
            float v[8] = {a.x, a.y, a.z, a.w, b.x, b.y, b.z, b.w};
            f(mi * 32 + row, c8, v);
        }
    }
    __syncthreads();
}


template <class F> DEV void epi_cols(const f32x16 (&acc)[2][2], char* smem, F f) {
    const int lane = TID() & 63, wave = TID() >> 6, fr = lane & 31, fh = lane >> 5;
    float* st = (float*)(smem + wave * EPI_SLAB);
    UNROLL for (int mi = 0; mi < 2; ++mi) {
        UNROLL for (int ni = 0; ni < 2; ++ni) UNROLL for (int r = 0; r < 16; ++r)
            st[((r & 3) + 8 * (r >> 2) + 4 * fh) * 68 + ni * 32 + fr] = acc[mi][ni][r];
        UNROLL for (int it = 0; it < 4; ++it) {
            float v[8];
            UNROLL for (int i = 0; i < 8; ++i) v[i] = st[(it * 8 + i) * 68 + lane];
            f(mi * 32 + it * 8, lane, v);
        }
    }
    __syncthreads();
}

struct TileOrder {
    int x, nN, cx, total;
    DEV TileOrder(const Topo& tp, int nM, int nN_) { x = tp.x; nN = nN_; cx = nM > x ? (nM - x + 7) >> 3 : 0; total = ((cx + 3) >> 2) * 4 * nN; }
    DEV bool get(int q, int& pm, int& pn) const { const int per = 4 * nN, qi = q / per, rem = q - qi * per, i = 4 * qi + (rem & 3); pn = rem >> 2; pm = x + 8 * i; return i < cx; }
};
template <int WM, int WN, class Epi>
DEV void gemm_phase(const bf16_t* A, int lda, int M, const bf16_t* Bt, int ldb, int N, int K, char* smem, const Topo& tp, Epi epi) {
    typedef GC<WM, WN> C;
    const int nM = M / C::BM, nN = (N + C::BN - 1) / C::BN;
    const int wave = TID() >> 6, wm = wave / WN, wn = wave % WN;
    const TileOrder ord(tp, nM, nN);
    for (int q = tp.r; q < ord.total; q += tp.n) {
        int pm, pn; if (!ord.get(q, pm, pn)) continue;
        f32x16 acc[2][2]; acc_zero(acc);
        const bf16_t* Ab = A + (size_t)pm * C::BM * lda;
        gemm_tile<WM, WN, 3, false>(acc, [&](int r) { return Ab + (size_t)r * lda; }, Bt, ldb, pn * C::BN, N, K, smem, nullptr);
        epi(acc, pm * C::BM + wm * 64, pn * C::BN + wn * 64);
    }
}

namespace pg8 {
#define PG8_LAS __attribute__((address_space(3)))
typedef float f32x4 __attribute__((ext_vector_type(4)));
constexpr int BM = 256, BK = 64, HALF = 128, HTB = HALF * BK * 2  , STAGE_BYTES = 8 * HTB, NXCD = 8, WGM = 8;

__host__ __device__ __forceinline__ int lds_byte(int r, int c) { const int st = (r >> 4) * 2 + (c >> 5), rr = r & 15, cc = c & 31, ob = rr * 64 + cc * 2; return st * 1024 + (ob ^ (((ob >> 9) & 1) << 5)); }
__host__ __device__ __forceinline__ void stage_rc(int b, int& R, int& C) { const int st = b / 1024, sb = b % 1024, swz = sb ^ (((sb >> 9) & 1) << 5); R = (st >> 1) * 16 + swz / 64; C = (st & 1) * 32 + (swz % 64) / 2; }
__host__ __device__ __forceinline__ int perm32(int rho) { const int n = rho >> 4, i = rho & 15; return 8 * (i >> 2) + 4 * n + (i & 3); }

struct Unit { int pm, pn; };
struct Gemm { const bf16_t* A; const bf16_t* Bt; int M, N, K; };
template <class Epi, class Sched, bool ALIGN_EPI = false, bool SP2 = false>
__device__ __forceinline__ void gemm_phase(PG8_LAS unsigned char* lds, const Gemm g, const Sched& S, const Epi& E) {
    const int tid = TID(), wid = __builtin_amdgcn_readfirstlane(tid >> 6), lane = tid & 63, wr = wid >> 2, wc = wid & 3, fr = lane & 15, fq = lane >> 4;
    const int K = g.K, nt = K / BK;
    unsigned voffA[2], voffB[2];
#pragma unroll
    for (int i = 0; i < 2; ++i) { int R, C; stage_rc(tid * 16 + i * 8192, R, C); const int Rb = Epi::PERM ? ((R & ~31) + perm32(R & 31)) : R;
        voffA[i] = (unsigned)(R * K + C) * 2u; voffB[i] = (unsigned)(Rb * K + C) * 2u; }
    const size_t kstep = (size_t)(BK * 2);
    const size_t hstep = (size_t)HALF * K * 2;
    const size_t tstep = 2 * hstep;
    const unsigned ldsw = (unsigned)wid * 1024u;
    const int aoff = lds_byte(wr * 64 + fr, fq * 8), boff = lds_byte(wc * 32 + fr, fq * 8);
#define PG8_SA(b, h) (((b) * 2 + (h)) * HTB)
#define PG8_SB(b, h) ((4 + (b) * 2 + (h)) * HTB)
#define PG8_STAGE(bufoff, gbase, voff) do { _Pragma("unroll") for (int _i = 0; _i < 2; ++_i) \
        __builtin_amdgcn_global_load_lds((const unsigned*)((const char*)(gbase) + (voff)[_i]), (PG8_LAS unsigned*)(lds + (bufoff) + ldsw + _i * 8192), 16, 0, 0); } while (0)
#define PG8_LDA(dst, b, h) do { _Pragma("unroll") for (int m = 0; m < 4; ++m) _Pragma("unroll") for (int k = 0; k < 2; ++k) dst[m][k] = *(const PG8_LAS bf16x8*)(lds + PG8_SA(b, h) + aoff + m * 2048 + k * 1024); } while (0)
#define PG8_LDB(dst, b, h) do { _Pragma("unroll") for (int n = 0; n < 2; ++n) _Pragma("unroll") for (int k = 0; k < 2; ++k) dst[n][k] = *(const PG8_LAS bf16x8*)(lds + PG8_SB(b, h) + boff + n * 2048 + k * 1024); } while (0)
#define PG8_MMA(ai, bj, At, Bt) do { __builtin_amdgcn_s_setprio(1); _Pragma("unroll") for (int m = 0; m < 4; ++m) _Pragma("unroll") for (int n = 0; n < 2; ++n) _Pragma("unroll") for (int k = 0; k < 2; ++k) \
        acc[ai][bj][m][n] = __builtin_amdgcn_mfma_f32_16x16x32_bf16(Bt[n][k], At[m][k], acc[ai][bj][m][n], 0, 0, 0); __builtin_amdgcn_s_setprio(0); } while (0)
#define PG8_WAIT_V(n) asm volatile("s_waitcnt vmcnt(" #n ")" ::: "memory")
#define PG8_WAIT_L(n) asm volatile("s_waitcnt lgkmcnt(" #n ")" ::: "memory")
#define PG8_BAR __builtin_amdgcn_s_barrier()
#define PG8_SCHED __builtin_amdgcn_sched_barrier(0)
    Unit cur, nxt; int ui = 0;
    if (!S.next(0, cur)) return;
    f32x4 acc[2][2][4][2];
#pragma unroll
    for (int a = 0; a < 2; ++a)
#pragma unroll
        for (int b = 0; b < 2; ++b)
#pragma unroll
            for (int m = 0; m < 4; ++m)
#pragma unroll
                for (int n = 0; n < 2; ++n) acc[a][b][m][n] = (f32x4){0.f, 0.f, 0.f, 0.f};
    bf16x8 At[4][2], B0[2][2], B1[2][2];
    const char* cA = (const char*)g.A + (size_t)cur.pm * tstep; const char* cB = (const char*)g.Bt + (size_t)cur.pn * tstep;
    S.a_ready(cur);
    if constexpr (SP2) {
        PG8_STAGE(PG8_SB(0, 0), cB, voffB); PG8_STAGE(PG8_SB(0, 1), cB + hstep, voffB); PG8_STAGE(PG8_SA(0, 0), cA, voffA); PG8_STAGE(PG8_SA(0, 1), cA + hstep, voffA);
        if (wr == 1) PG8_BAR;
        PG8_WAIT_V(2); PG8_BAR;
        PG8_STAGE(PG8_SB(1, 0), cB + kstep, voffB); PG8_STAGE(PG8_SA(1, 0), cA + kstep, voffA); PG8_STAGE(PG8_SB(1, 1), cB + hstep + kstep, voffB);
        PG8_WAIT_V(6); PG8_BAR;
    } else {
        PG8_STAGE(PG8_SB(0, 0), cB, voffB); PG8_STAGE(PG8_SA(0, 0), cA, voffA); PG8_STAGE(PG8_SB(0, 1), cB + hstep, voffB); PG8_STAGE(PG8_SA(0, 1), cA + hstep, voffA);
        if (wr == 1) PG8_BAR;
        PG8_WAIT_V(4); PG8_BAR;
        PG8_STAGE(PG8_SB(1, 0), cB + kstep, voffB); PG8_STAGE(PG8_SA(1, 0), cA + kstep, voffA); PG8_STAGE(PG8_SB(1, 1), cB + hstep + kstep, voffB);
        PG8_WAIT_V(6); PG8_BAR;
    }
    for (;;) {
        const bool has_next = S.next(ui + 1, nxt);
        const char* nA = has_next ? (const char*)g.A + (size_t)nxt.pm * tstep : cA; const char* nB = has_next ? (const char*)g.Bt + (size_t)nxt.pn * tstep : cB;
        for (int t = 0; t < nt; t += 2) {
            const bool last = (t == nt - 2);
            const char* a1 = cA + (size_t)(t + 1) * kstep;
            const char* a2 = last ? nA : cA + (size_t)(t + 2) * kstep; const char* b2 = last ? nB : cB + (size_t)(t + 2) * kstep;
            const char* a3 = a2 + kstep; const char* b3 = b2 + kstep;
            if (last && has_next) S.a_ready(nxt);
            if constexpr (SP2) {
            PG8_LDB(B0, 0, 0); PG8_LDB(B1, 0, 1); PG8_SCHED; PG8_LDA(At, 0, 0); PG8_STAGE(PG8_SA(1, 1), a1 + hstep, voffA);
            PG8_WAIT_V(8); PG8_WAIT_L(0); PG8_BAR; PG8_MMA(0, 0, At, B0); PG8_MMA(0, 1, At, B1); PG8_BAR; PG8_SCHED;
            PG8_LDA(At, 0, 1); PG8_STAGE(PG8_SB(0, 0), b2, voffB); PG8_STAGE(PG8_SB(0, 1), b2 + hstep, voffB); PG8_STAGE(PG8_SA(0, 0), a2, voffA);
            PG8_WAIT_V(8); PG8_WAIT_L(0); PG8_BAR; PG8_MMA(1, 0, At, B0); PG8_MMA(1, 1, At, B1); PG8_BAR; PG8_SCHED;
            PG8_LDB(B0, 1, 0); PG8_LDB(B1, 1, 1); PG8_SCHED; PG8_LDA(At, 1, 0); PG8_STAGE(PG8_SA(0, 1), a2 + hstep, voffA);
            PG8_WAIT_V(8); PG8_WAIT_L(0); PG8_BAR; PG8_MMA(0, 0, At, B0); PG8_MMA(0, 1, At, B1); PG8_BAR; PG8_SCHED;
            PG8_LDA(At, 1, 1); PG8_STAGE(PG8_SB(1, 0), b3, voffB); PG8_STAGE(PG8_SB(1, 1), b3 + hstep, voffB); PG8_STAGE(PG8_SA(1, 0), a3, voffA);
            PG8_WAIT_V(8); PG8_WAIT_L(0); PG8_BAR; PG8_MMA(1, 0, At, B0); PG8_MMA(1, 1, At, B1); PG8_BAR; PG8_SCHED;
            } else {
            PG8_LDB(B0, 0, 0); PG8_SCHED; PG8_LDA(At, 0, 0); PG8_STAGE(PG8_SA(1, 1), a1 + hstep, voffA);
            PG8_WAIT_L(8); PG8_BAR; PG8_WAIT_L(0); PG8_MMA(0, 0, At, B0); PG8_BAR; PG8_SCHED;
            PG8_LDB(B1, 0, 1); PG8_STAGE(PG8_SB(0, 0), b2, voffB);
            PG8_BAR; PG8_WAIT_L(0); PG8_MMA(0, 1, At, B1); PG8_BAR;
            PG8_LDA(At, 0, 1); PG8_STAGE(PG8_SA(0, 0), a2, voffA);
            PG8_BAR; PG8_WAIT_L(0); PG8_MMA(1, 0, At, B0); PG8_BAR; PG8_SCHED;
            PG8_STAGE(PG8_SB(0, 1), b2 + hstep, voffB);
            PG8_WAIT_V(6); PG8_BAR; PG8_MMA(1, 1, At, B1); PG8_BAR;
            PG8_LDB(B0, 1, 0); PG8_SCHED; PG8_LDA(At, 1, 0); PG8_STAGE(PG8_SA(0, 1), a2 + hstep, voffA);
            PG8_WAIT_L(8); PG8_BAR; PG8_WAIT_L(0); PG8_MMA(0, 0, At, B0); PG8_BAR; PG8_SCHED;
            PG8_LDB(B1, 1, 1); PG8_STAGE(PG8_SB(1, 0), b3, voffB);
            PG8_BAR; PG8_WAIT_L(0); PG8_MMA(0, 1, At, B1); PG8_BAR;
            PG8_LDA(At, 1, 1); PG8_STAGE(PG8_SA(1, 0), a3, voffA);
            PG8_BAR; PG8_WAIT_L(0); PG8_MMA(1, 0, At, B0); PG8_BAR; PG8_SCHED;
            PG8_STAGE(PG8_SB(1, 1), b3 + hstep, voffB);
            PG8_WAIT_V(6); PG8_BAR; PG8_MMA(1, 1, At, B1); PG8_BAR;
            }
        }
        if constexpr (ALIGN_EPI) { if (wr == 0) PG8_BAR; }
        if constexpr (!Epi::AFTER_DRAIN) { E(acc, cur, wr, wc, fr, fq); S.done(cur); }
        if (!has_next) break;
#pragma unroll
        for (int a = 0; a < 2; ++a)
#pragma unroll
            for (int b = 0; b < 2; ++b)
#pragma unroll
                for (int m = 0; m < 4; ++m)
#pragma unroll
                    for (int n = 0; n < 2; ++n) acc[a][b][m][n] = (f32x4){0.f, 0.f, 0.f, 0.f};
        cur = nxt; cA = nA; cB = nB; ++ui;
        if constexpr (ALIGN_EPI) { if (wr == 1) PG8_BAR; }
    }
    PG8_WAIT_V(0);
    if constexpr (!ALIGN_EPI) { if (wr == 0) PG8_BAR; }
    PG8_BAR;
    if constexpr (Epi::AFTER_DRAIN) { E.fused(acc, cur, wr, wc, fr, fq, lds, wid, lane); S.done(cur); }
#undef PG8_SA
#undef PG8_SB
#undef PG8_STAGE
#undef PG8_LDA
#undef PG8_LDB
#undef PG8_MMA
#undef PG8_WAIT_V
#undef PG8_WAIT_L
#undef PG8_BAR
#undef PG8_SCHED
}
}
template <class F> struct EpiF {
    static constexpr bool PERM = true, AFTER_DRAIN = false; F f;
    DEV void operator()(const pg8::f32x4 (&acc)[2][2][4][2], const pg8::Unit& u, int wr, int wc, int fr, int fq) const {
        UNROLL for (int ai = 0; ai < 2; ++ai) UNROLL for (int m = 0; m < 4; ++m) {
            const int row = u.pm * 256 + ai * 128 + wr * 64 + m * 16 + fr;
            UNROLL for (int bj = 0; bj < 2; ++bj) {
                const int col = u.pn * 256 + bj * 128 + wc * 32 + 8 * fq;
                const float v[8] = {acc[ai][bj][m][0][0], acc[ai][bj][m][0][1], acc[ai][bj][m][0][2], acc[ai][bj][m][0][3],
                                    acc[ai][bj][m][1][0], acc[ai][bj][m][1][1], acc[ai][bj][m][1][2], acc[ai][bj][m][1][3]};
                f(row, col, v);
            }
        }
    }
};
template <class F> struct EpiF2 {
    static constexpr bool PERM = true, AFTER_DRAIN = false; F f;
    DEV void operator()(const pg8::f32x4 (&acc)[2][2][4][2], const pg8::Unit& u, int wr, int wc, int fr, int fq) const {
        UNROLL for (int ai = 0; ai < 2; ++ai) UNROLL for (int m = 0; m < 4; ++m) {
            const int row = u.pm * 256 + ai * 128 + wr * 64 + m * 16 + fr, col = u.pn * 256 + wc * 32 + 8 * fq;
            const float v0[8] = {acc[ai][0][m][0][0], acc[ai][0][m][0][1], acc[ai][0][m][0][2], acc[ai][0][m][0][3], acc[ai][0][m][1][0], acc[ai][0][m][1][1], acc[ai][0][m][1][2], acc[ai][0][m][1][3]};
            const float v1[8] = {acc[ai][1][m][0][0], acc[ai][1][m][0][1], acc[ai][1][m][0][2], acc[ai][1][m][0][3], acc[ai][1][m][1][0], acc[ai][1][m][1][1], acc[ai][1][m][1][2], acc[ai][1][m][1][3]};
            f(row, col, v0, v1);
        }
    }
};
struct XOrder {
    int x, r, n, nN, cx, fullq, total;
    DEV XOrder(const Topo& tp, int nM, int nN_) { x = tp.x; r = tp.r; n = tp.n; nN = nN_; cx = nM > x ? (nM - x + 7) >> 3 : 0; fullq = cx >> 2; total = cx * nN; }
    DEV bool next(int i, pg8::Unit& u) const {
        const int q = r + i * n; if (q >= total) return false;
        const int per = 4 * nN;
        if (q < fullq * per) { const int qi = q / per, rem = q - qi * per; u.pn = rem >> 2; u.pm = x + 8 * (4 * qi + (rem & 3)); }
        else { const int rem = q - fullq * per, cq = cx - 4 * fullq; u.pn = rem / cq; u.pm = x + 8 * (4 * fullq + rem % cq); }
        return true;
    }
    DEV void a_ready(const pg8::Unit&) const {}
    DEV void done(const pg8::Unit&) const {}
};
template <class F> DEV void gemm256_pair(const bf16_t* A, int M, const bf16_t* Bt, int N, int K, char* smem, const Topo& tp, F f) {
    const pg8::Gemm g{A, Bt, M, N, K};
    const XOrder S(tp, M / 256, (N + 255) / 256);
    const EpiF2<F> E{f};
    pg8::gemm_phase<EpiF2<F>, XOrder, true, true>((PG8_LAS unsigned char*)smem, g, S, E);
}
template <class F> DEV void gemm256(const bf16_t* A, int M, const bf16_t* Bt, int N, int K, char* smem, const Topo& tp, F f) {
    const pg8::Gemm g{A, Bt, M, N, K};
    const XOrder S(tp, M / 256, (N + 255) / 256);
    const EpiF<F> E{f};
    pg8::gemm_phase<EpiF<F>, XOrder, true, true>((PG8_LAS unsigned char*)smem, g, S, E);
}

DEV void ph_mod(const Params& p, int L, char* smem) {
    const int tid = TID();
    float* sc = (float*)smem;
    float* red = sc + 17 * 1024;
    const float* c = p.in[I_C]; const float* cc = p.in[I_CCTX];
    for (int i = tid; i < 17 * 1024; i += NTHREADS) { const float v = i < 16 * 1024 ? c[i] : cc[i - 16 * 1024]; sc[i] = v / (1.f + expf(-v)); }
    __syncthreads();
    const float* W = p.in[I_WADA] + (size_t)L * 1024 * 6144; const float* bA = p.in[I_BADA] + (size_t)L * 6144;
    float* MOD = (float*)(p.ws + OFF_MOD);
    for (int u = blockIdx.x; u < 192; u += gridDim.x) {
        const int ci = tid & 31, ks = tid >> 5, j = u * 32 + ci;
        float acc[17];
        UNROLL for (int r = 0; r < 17; ++r) acc[r] = 0.f;
        for (int k = ks * 64; k < ks * 64 + 64; ++k) {
            const float w = W[(size_t)k * 6144 + j];
            UNROLL for (int r = 0; r < 17; ++r) acc[r] += sc[r * 1024 + k] * w;
        }
        UNROLL for (int r = 0; r < 17; ++r) red[(ks * 17 + r) * 32 + ci] = acc[r];
        __syncthreads();
        for (int i = tid; i < 17 * 32; i += NTHREADS) {
            const int r = i >> 5, c2 = i & 31; float s = bA[u * 32 + c2];
            for (int k2 = 0; k2 < 16; ++k2) s += red[(k2 * 17 + r) * 32 + c2];
            MOD[r * 6144 + u * 32 + c2] = s;
        }
        __syncthreads();
    }
}
DEV void conv_job(const float* s0, const float* s1, bf16_t* d, int K, int N, int mode, int nmat, size_t sstride, size_t dstride, char* smem, int bid = -1, int nb = 0) {
    if (bid < 0) { bid = blockIdx.x; nb = gridDim.x; }
    float* tile = (float*)smem;
    const int tid = TID();
    const int tK = K / 64, tN = (mode == 1 || mode == 3) ? (2 * N) / 64 : (N + 63) / 64, per = tK * tN, total = per * nmat;
    for (int t0 = bid * 4; t0 < total; t0 += nb * 4) {
        float4 v[4][2];
        UNROLL for (int q = 0; q < 4; ++q) {
            const int t = min(t0 + q, total - 1), mat = t / per, r = t - mat * per, tk = r / tN, tn = r - tk * tN;
            const float* a0 = s0 + (size_t)mat * sstride; const float* a1 = s1 ? s1 + (size_t)mat * sstride : nullptr;
            const int c4 = (tid & 15) * 4;
            const float* src; int col;
            if (mode == 1) { src = (c4 >> 5) ? a1 : a0; col = tn * 32 + (c4 & 31); }
            else if (mode == 3) { src = ((tn >> 1) & 1) ? a1 : a0; col = (tn >> 2) * 128 + (tn & 1) * 64 + c4; }
            else { src = a0; col = tn * 64 + c4; }
            const bool ok = col < N;
            UNROLL for (int i = 0; i < 2; ++i) {
                const int k = (tid >> 4) + 32 * i;
                v[q][i] = ok ? *(const float4*)(src + (size_t)(tk * 64 + k) * N + col) : make_float4(0.f, 0.f, 0.f, 0.f);
            }
        }
        UNROLL for (int q = 0; q < 4; ++q) UNROLL for (int i = 0; i < 2; ++i) {
            float* w = tile + q * 4160 + ((tid >> 4) + 32 * i) * 65 + (tid & 15) * 4;
            w[0] = v[q][i].x; w[1] = v[q][i].y; w[2] = v[q][i].z; w[3] = v[q][i].w;
        }
        __syncthreads();
        UNROLL for (int q = 0; q < 4; ++q) if (t0 + q < total) {
            const int t = t0 + q, mat = t / per, r = t - mat * per, tk = r / tN, tn = r - tk * tN;
            bf16_t* dd = d + (size_t)mat * dstride;
            const int cc = tid >> 3, k8 = (tid & 7) * 8, row = tn * 64 + cc;
            float x[8];
            UNROLL for (int i = 0; i < 8; ++i) x[i] = tile[q * 4160 + (k8 + i) * 65 + cc];
            if (mode == 1 || mode == 3 || row < N) {
                st8(dd + (size_t)row * K + tk * 64 + k8, x);
                if (mode == 2) { float lo[8]; UNROLL for (int i = 0; i < 8; ++i) lo[i] = x[i] - bf2f(f2bf(x[i])); st8(dd + (size_t)N * K + (size_t)row * K + tk * 64 + k8, lo); }
            }
        }
        __syncthreads();
    }
}
DEV void ph_conv_mix(const Params& p, int L, char* smem) {
    char* ws = p.ws;
    conv_job(p.in[I_WIN] + (size_t)L * 1024 * IN_COLS, nullptr, (bf16_t*)(ws + OFF_WINT), 1024, IN_COLS, 0, 1, 0, 0, smem);
    conv_job(p.in[I_WBR] + (size_t)L * 3 * 512 * 1024, nullptr, (bf16_t*)(ws + OFF_WBT), 512, 1024, 0, 3, (size_t)512 * 1024, (size_t)512 * 1024, smem);
    conv_job(p.in[I_WOUT] + (size_t)L * 1024 * 1024, nullptr, (bf16_t*)(ws + OFF_WOUTT), 1024, 1024, 0, 1, 0, 0, smem);
    conv_job(p.in[I_SG] + (size_t)L * 1024 * 256, p.in[I_SU] + (size_t)L * 1024 * 256, (bf16_t*)(ws + OFF_SGUT), 1024, 256, 3, 1, 0, 0, smem);
    conv_job(p.in[I_SD] + (size_t)L * 256 * 1024, nullptr, (bf16_t*)(ws + OFF_SDT), 256, 1024, 0, 1, 0, 0, smem);
    conv_job(p.in[I_G2] + (size_t)L * 128 * 512, nullptr, (bf16_t*)(ws + OFF_G2T), 128, 512, 0, 1, 0, 0, smem);
    conv_job(p.in[I_RTR] + (size_t)L * 1024 * 64, nullptr, (bf16_t*)(ws + OFF_RTR), 1024, 64, 2, 1, 0, 0, smem);
}
DEV void ph_conv_moe_gu(const Params& p, int L, char* smem, int bid, int nb) {
    const size_t eo = (size_t)L * 64 * 1024 * 128;
    conv_job(p.in[I_MWG] + eo, p.in[I_MWU] + eo, (bf16_t*)(p.ws + OFF_MGU), 1024, 128, 1, 64, (size_t)1024 * 128, (size_t)256 * 1024, smem, bid, nb);
}
DEV void ph_conv_moe(const Params& p, int L, char* smem, int bid, int nb) {
    const size_t eo = (size_t)L * 64 * 1024 * 128;
    conv_job(p.in[I_MWD] + eo, nullptr, (bf16_t*)(p.ws + OFF_MDT), 128, 1024, 0, 64, (size_t)128 * 1024, (size_t)1024 * 128, smem, bid, nb);
}

DEV void ph_norm(const Params& p, int L, int which, int ntok) {
    const int lane = TID() & 63, wave = TID() >> 6;
    const float* MOD = (const float*)(p.ws + OFF_MOD);
    const float* g = p.in[which ? I_N2G : I_N1G] + (size_t)L * DM;
    bf16_t* H = (bf16_t*)(p.ws + OFF_HX); bf16_t* HLO = (bf16_t*)(p.ws + OFF_H2LO);
    for (int n0 = blockIdx.x * 8; n0 < ntok; n0 += gridDim.x * 8) {
        const int n = n0 + wave;
        const float* xr = which ? xs_row(p, n) : xprev_row(p, L, n);
        float4 v[4]; float ss = 0.f;
        UNROLL for (int i = 0; i < 4; ++i) { v[i] = *(const float4*)(xr + i * 256 + lane * 4); ss += v[i].x * v[i].x + v[i].y * v[i].y + v[i].z * v[i].z + v[i].w * v[i].w; }
        UNROLL for (int o = 1; o < 64; o <<= 1) ss += __shfl_xor(ss, o);
        const float rstd = rsqrtf(ss * (1.f / DM) + 1e-6f);
        const float* sh = MOD + mod_row(n) * 6144 + (which ? 3 : 0) * DM; const float* sc = sh + DM;
        UNROLL for (int i = 0; i < 4; ++i) {
            const int c = i * 256 + lane * 4;
            const float4 gg = *(const float4*)(g + c), s1 = *(const float4*)(sc + c), s0 = *(const float4*)(sh + c);
            const float h0 = v[i].x * rstd * gg.x * (1.f + s1.x) + s0.x, h1 = v[i].y * rstd * gg.y * (1.f + s1.y) + s0.y;
            const float h2 = v[i].z * rstd * gg.z * (1.f + s1.z) + s0.z, h3 = v[i].w * rstd * gg.w * (1.f + s1.w) + s0.w;
            u32x2 o; o.x = pk2(h0, h1); o.y = pk2(h2, h3);
            *(u32x2*)(H + (size_t)n * DM + c) = o;
            if (which) {
                u32x2 o2;
                o2.x = pk2(h0 - bf2f((bf16_t)(o.x & 0xffff)), h1 - bf2f((bf16_t)(o.x >> 16)));
                o2.y = pk2(h2 - bf2f((bf16_t)(o.y & 0xffff)), h3 - bf2f((bf16_t)(o.y >> 16)));
                *(u32x2*)(HLO + (size_t)n * DM + c) = o2;
            }
        }
    }
}

DEV void ph_rw_prep(const Params& p, int L, char* smem) {
    const int lane = TID() & 63, wave = TID() >> 6;
    float* vsh = (float*)smem + wave * 512;
    const bf16_t* PXR = (const bf16_t*)(p.ws + OFF_PX); bf16_t* VF = (bf16_t*)(p.ws + OFF_VF);
    const float* mu = p.in[I_MU] + (size_t)L * RW_COLS;
    const float* v0 = p.in[I_V0]; const float* v1 = p.in[I_V1]; const float* v2 = p.in[I_V2];
    for (int n0 = blockIdx.x * 8; n0 < NT; n0 += gridDim.x * 8) {
        const int n = n0 + wave; int nb, tt, T; seq_of(n, nb, tt, T);
        float vs[8]; shift8(PXR, RW_COLS, nb, tt, T, 1024 + lane * 8, mu, vs);
        if (L == 0) { st8(VF + (size_t)n * 512 + lane * 8, vs); }
        else {
            UNROLL for (int i = 0; i < 8; ++i) vsh[lane * 8 + i] = vs[i];
            __syncthreads();
            const int q = lane & 31, hf = lane >> 5; float t1 = 0.f;
            for (int jj = 0; jj < 256; ++jj) t1 += vsh[hf * 256 + jj] * v1[(hf * 256 + jj) * 32 + q];
            t1 += __shfl_xor(t1, 32);
            float u[8];
            UNROLL for (int i = 0; i < 8; ++i) u[i] = v0[lane * 8 + i];
            for (int q2 = 0; q2 < 32; ++q2) { const float tq = __shfl(t1, q2); UNROLL for (int i = 0; i < 8; ++i) u[i] += tq * v2[q2 * 512 + lane * 8 + i]; }
            float vf[8], o[8]; ld8(VF + (size_t)n * 512 + lane * 8, vf);
            UNROLL for (int i = 0; i < 8; ++i) o[i] = vs[i] + (vf[i] - vs[i]) * sigm(u[i]);
            st8(VF + (size_t)n * 512 + lane * 8, o);
            __syncthreads();
        }
    }
}

DEV bf16x8 pk_lohi(u32x2 lo, u32x2 hi) { u32x4 w; w.x = lo.x; w.y = lo.y; w.z = hi.x; w.w = hi.y; return __builtin_bit_cast(bf16x8, w); }
DEV bf16x8 pk_acc2(const f32x4v& a, const f32x4v& b) { u32x4 w; w.x = pk2(a[0], a[1]); w.y = pk2(a[2], a[3]); w.z = pk2(b[0], b[1]); w.w = pk2(b[2], b[3]); return __builtin_bit_cast(bf16x8, w); }
DEV bf16x8 pk_acc1(const f32x4v& a) { u32x4 w; w.x = pk2(a[0], a[1]); w.y = pk2(a[2], a[3]); w.z = 0u; w.w = 0u; return __builtin_bit_cast(bf16x8, w); }
#define MFMA16(a, b, c) __builtin_amdgcn_mfma_f32_16x16x32_bf16((a), (b), (c), 0, 0, 0)
struct Raw3 { u32x4 l, c, r; };
DEV Raw3 rw_raw(const bf16_t* z, int ld, int nb, int tt, int T, int col0) {
    Raw3 o;
    o.c = *(const u32x4*)(z + (size_t)(nb + tt) * ld + col0);
    o.l = *(const u32x4*)(z + (size_t)(nb + max(tt - 1, 0)) * ld + col0);
    o.r = *(const u32x4*)(z + (size_t)(nb + min(tt + 1, T - 1)) * ld + col0);
    return o;
}
DEV void unpack8(u32x4 v, float (&o)[8]) {
    o[0] = __uint_as_float(v.x << 16); o[1] = __uint_as_float(v.x & 0xffff0000u); o[2] = __uint_as_float(v.y << 16); o[3] = __uint_as_float(v.y & 0xffff0000u);
    o[4] = __uint_as_float(v.z << 16); o[5] = __uint_as_float(v.z & 0xffff0000u); o[6] = __uint_as_float(v.w << 16); o[7] = __uint_as_float(v.w & 0xffff0000u);
}
DEV void shift_from_raw(const Raw3& w, int tt, int T, const float* mu8, float (&o)[8]) {
    float c[8], l[8], r[8]; unpack8(w.c, c); unpack8(w.l, l); unpack8(w.r, r);
    const float ml = tt > 0 ? 0.5f : 0.f, mr = tt < T - 1 ? 0.5f : 0.f;
    UNROLL for (int i = 0; i < 8; ++i) o[i] = c[i] + mu8[i] * (ml * l[i] + mr * r[i] - c[i]);
}
DEV void ph_rw_scan(const Params& p, int L, char* smem) {
    const int tid = TID();
    const int wave = __builtin_amdgcn_readfirstlane(tid >> 6);
    char* AT = smem; char* BT = smem + 9216; char* KT = smem + 18432; char* RT = smem + 27648;
    char* BH = smem + 36864; char* KH = smem + 46080; char* VT = smem + 55296;
    char* W2T = smem + 64512; char* A2T = smem + 73728;
    float* PCv = (float*)(smem + 82944); float* SEGT = PCv + 64;
    char* XY = smem + 85248;
    char* T1 = XY; char* T2 = XY + 9216; float* WLf = (float*)(XY + 18432); float* ALf = (float*)(XY + 35840); float* LW = (float*)XY;
    float* TOT = (float*)(XY + 62720);
    float* PAR = (float*)(XY + 60416);
    char* NAB = XY; char* NAK = XY + 9216; char* NRB = XY + 18432; char* NRK = XY + 27648; char* TJ = XY + 36864; float* NDF = (float*)(XY + 38912); float* YO = (float*)(XY + 43008);
    const bf16_t* PXR = (const bf16_t*)(p.ws + OFF_PX); const bf16_t* VF = (const bf16_t*)(p.ws + OFF_VF);
    bf16_t* YS = (bf16_t*)(p.ws + OFF_YS); float* CB = (float*)(p.ws + OFF_CB);
    const float* mu = p.in[I_MU] + (size_t)L * RW_COLS;
    const float* w0 = p.in[I_W0] + (size_t)L * 1024; const float* w2 = p.in[I_W2] + (size_t)L * 65536;
    const float* a0 = p.in[I_A0] + (size_t)L * 1024; const float* a2 = p.in[I_A2] + (size_t)L * 65536;
    const float* kkw = p.in[I_KK] + (size_t)L * 512; const float* kaw = p.in[I_KA] + (size_t)L * 512; const float* rkw = p.in[I_RK] + (size_t)L * 512;
    for (int u = blockIdx.x; u < 256; u += gridDim.x) {
        const int b = u >> 4, h = (u >> 1) & 7, d = u & 1;
        for (int i = tid; i < 4096; i += NTHREADS) {
            const int l = i >> 6, n = i & 63;
            *(bf16_t*)(W2T + n * LROW + l * 2) = f2bf(w2[(size_t)(d * 64 + l) * 512 + h * 64 + n]);
            *(bf16_t*)(A2T + n * LROW + l * 2) = f2bf(a2[(size_t)(d * 64 + l) * 512 + h * 64 + n]);
        }
        if (tid < 64) {
            const int n = tid;
            PAR[n] = w0[d * 512 + h * 64 + n]; PAR[64 + n] = a0[d * 512 + h * 64 + n];
            PAR[128 + n] = kkw[h * 64 + n]; PAR[192 + n] = kaw[h * 64 + n]; PAR[256 + n] = rkw[h * 64 + n];
            PAR[320 + n] = mu[1536 + d * 64 + n]; PAR[384 + n] = mu[1664 + d * 64 + n]; PAR[448 + n] = mu[h * 64 + n]; PAR[512 + n] = mu[512 + h * 64 + n];
        }
        f32x4v sacc[4];
        UNROLL for (int i = 0; i < 4; ++i) sacc[i] = (f32x4v){0.f, 0.f, 0.f, 0.f};
        __syncthreads();
        Raw3 pw1, pw2, pr, pk; u32x4 pv;
#define RW_GEOM(ci_, tido_) const bool isc = (ci_) < 4; const int T = isc ? CTXL : SEQ, cc = isc ? (ci_) : (ci_) - 4; \
            const int t0 = d == 0 ? cc * 64 : T - 64 * (cc + 1), nb = isc ? NX + b * CTXL : b * SEQ; \
            const int tt = d == 0 ? t0 + ((tido_) >> 3) : t0 + 63 - ((tido_) >> 3);
#define RW_PREFETCH(ci_, tido_) do { RW_GEOM(ci_, tido_) const int j_ = (tido_) & 7; \
            pw1 = rw_raw(PXR, RW_COLS, nb, tt, T, 1536 + d * 64 + 8 * j_); pw2 = rw_raw(PXR, RW_COLS, nb, tt, T, 1664 + d * 64 + 8 * j_); \
            pr = rw_raw(PXR, RW_COLS, nb, tt, T, h * 64 + 8 * j_); pk = rw_raw(PXR, RW_COLS, nb, tt, T, 512 + h * 64 + 8 * j_); \
            pv = *(const u32x4*)(VF + (size_t)(nb + tt) * 512 + h * 64 + 8 * j_); } while (0)
        RW_PREFETCH(0, tid);
        for (int ci = 0; ci < 36; ++ci) {
            int tido = tid; asm volatile("" : "+v"(tido));
            const int lane = tido & 63, lq = lane & 15, kg = lane >> 4, ti = tido >> 3, j = tido & 7;
            const int ch = h * 64 + 8 * j;
            RW_GEOM(ci, tido)
            float r8[8], k8[8], v8[8];
            {
                float x1[8], x2[8];
                shift_from_raw(pw1, tt, T, PAR + 320 + 8 * j, x1);
                shift_from_raw(pw2, tt, T, PAR + 384 + 8 * j, x2);
                UNROLL for (int i = 0; i < 8; ++i) x1[i] = tanh_fast(x1[i]);
                st8((bf16_t*)(T1 + ti * LROW) + 8 * j, x1); st8((bf16_t*)(T2 + ti * LROW) + 8 * j, x2);
                shift_from_raw(pr, tt, T, PAR + 448 + 8 * j, r8);
                shift_from_raw(pk, tt, T, PAR + 512 + 8 * j, k8);
                unpack8(pv, v8);
            }
            __syncthreads();
            _Pragma("unroll 1") for (int rep = 0; rep < 4; ++rep) {
                const int q = wave + 8 * rep, m = q >> 4, tl = q & 15, tt4 = tl >> 2, nt4 = tl & 3;
                const char* Ab = (m ? T2 : T1) + (16 * tt4 + lq) * LROW + kg * 16; const char* Bb = (m ? A2T : W2T) + (16 * nt4 + lq) * LROW + kg * 16;
                f32x4v a = {0.f, 0.f, 0.f, 0.f};
                UNROLL for (int ks = 0; ks < 2; ++ks) a = MFMA16(*(const bf16x8*)(Ab + ks * 64), *(const bf16x8*)(Bb + ks * 64), a);
                float* dst = (m ? ALf : WLf) + (16 * tt4 + 4 * kg) * 68 + 16 * nt4 + lq;
                UNROLL for (int i = 0; i < 4; ++i) dst[i * 68] = a[i];
            }
            __syncthreads();
            float av[8], bv[8], kd8[8];
            {
                const float4 wa = *(const float4*)(WLf + ti * 68 + 8 * j), wb = *(const float4*)(WLf + ti * 68 + 8 * j + 4);
                const float4 aa = *(const float4*)(ALf + ti * 68 + 8 * j), ab = *(const float4*)(ALf + ti * 68 + 8 * j + 4);
                const float wl[8] = {wa.x, wa.y, wa.z, wa.w, wb.x, wb.y, wb.z, wb.w}, al[8] = {aa.x, aa.y, aa.z, aa.w, ab.x, ab.y, ab.z, ab.w};
                float ss = 0.f, cbp = 0.f, alpha[8], kkr[8], lw[8];
                UNROLL for (int i = 0; i < 8; ++i) {
                    const float xw = -(PAR[8 * j + i] + wl[i]);
                    const float sp = softplus_fast(xw);
                    lw[i] = -__expf(-sp - 0.5f);
                    alpha[i] = sigm(PAR[64 + 8 * j + i] + al[i]);
                    kkr[i] = k8[i] * PAR[128 + 8 * j + i]; ss += kkr[i] * kkr[i];
                    kd8[i] = k8[i] * (1.f + (alpha[i] - 1.f) * PAR[192 + 8 * j + i]);
                    cbp += r8[i] * kd8[i] * PAR[256 + 8 * j + i];
                }
                ss = sum8(ss); cbp = sum8(cbp);
                const float inv = frcp(fmaxf(__builtin_amdgcn_sqrtf(ss), 1e-12f));
                UNROLL for (int i = 0; i < 8; ++i) { const float kk = kkr[i] * inv; av[i] = -kk; bv[i] = kk * alpha[i]; }
                *(float4*)(LW + ti * 64 + 8 * j) = make_float4(lw[0], lw[1], lw[2], lw[3]); *(float4*)(LW + ti * 64 + 8 * j + 4) = make_float4(lw[4], lw[5], lw[6], lw[7]);
                if (j == 0) CB[((size_t)d * NT + nb + tt) * 8 + h] = cbp;
            }
            __syncthreads();
            {
                const int n = tid & 63, seg = wave; float run[8], acc = 0.f;
                UNROLL for (int r = 0; r < 8; ++r) { acc += LW[(seg * 8 + r) * 64 + n]; run[r] = acc; }
                SEGT[seg * 64 + n] = acc;
                __syncthreads();
                float off = 0.f, tot = 0.f;
                UNROLL for (int s2 = 0; s2 < 8; ++s2) { const float sv = SEGT[s2 * 64 + n]; tot += sv; off += s2 < seg ? sv : 0.f; }
                UNROLL for (int r = 0; r < 8; ++r) LW[(seg * 8 + r) * 64 + n] = run[r] + off;
                if (seg == 0) { TOT[n] = tot; PCv[n] = __expf(tot); }
            }
            __syncthreads();
            {
                const float4 ta = *(const float4*)(TOT + 8 * j), tb = *(const float4*)(TOT + 8 * j + 4);
                const float tot[8] = {ta.x, ta.y, ta.z, ta.w, tb.x, tb.y, tb.z, tb.w};
                const float4 la = *(const float4*)(LW + ti * 64 + 8 * j), lb = *(const float4*)(LW + ti * 64 + 8 * j + 4);
                const float lpl[8] = {la.x, la.y, la.z, la.w, lb.x, lb.y, lb.z, lb.w};
                float lpm[8];
                if (ti != 0) {
                    const float4 ma = *(const float4*)(LW + (ti - 1) * 64 + 8 * j), mb = *(const float4*)(LW + (ti - 1) * 64 + 8 * j + 4);
                    lpm[0] = ma.x; lpm[1] = ma.y; lpm[2] = ma.z; lpm[3] = ma.w; lpm[4] = mb.x; lpm[5] = mb.y; lpm[6] = mb.z; lpm[7] = mb.w;
                } else { UNROLL for (int i = 0; i < 8; ++i) lpm[i] = 0.f; }
                float oa[8], ob[8], ok[8], orr[8];
                const int wofs = (((ti >> 3) ^ j) << 4) + (ti & 7) * 2;
                UNROLL for (int i = 0; i < 8; ++i) {
                    const float lp = lpl[i], lm = lpm[i];
                    const float eP = __expf(lp), eM = __expf(-lp), ePm = __expf(lm), eE = __expf(tot[i] - lp);
                    oa[i] = av[i] * ePm; ob[i] = bv[i] * eM; ok[i] = kd8[i] * eM; orr[i] = r8[i] * eP;
                    *(bf16_t*)(BH + (8 * j + i) * LROW + wofs) = f2bf(bv[i] * eE);
                    *(bf16_t*)(KH + (8 * j + i) * LROW + wofs) = f2bf(kd8[i] * eE);
                    *(bf16_t*)(VT + (8 * j + i) * LROW + wofs) = f2bf(v8[i]);
                }
                st8((bf16_t*)(AT + ti * LROW) + 8 * j, oa); st8((bf16_t*)(BT + ti * LROW) + 8 * j, ob);
                st8((bf16_t*)(KT + ti * LROW) + 8 * j, ok); st8((bf16_t*)(RT + ti * LROW) + 8 * j, orr);
            }
            __syncthreads();
            if (ci + 1 < 36) RW_PREFETCH(ci + 1, tido);
            _Pragma("unroll 1") for (int rep = 0; rep < 6; ++rep) {
                const int q = wave + 8 * rep, m = q / 12, tl = q - 12 * m;
                const int tt4 = tl >= 10 ? 2 * (tl - 10) : tl < 1 ? 0 : tl < 3 ? 1 : tl < 6 ? 2 : 3, st4 = tl >= 10 ? tt4 + 1 : tl - (tt4 * (tt4 + 1)) / 2;
                char* dstm = m == 0 ? NAB : m == 1 ? NAK : m == 2 ? NRB : NRK;
                f32x4v a = {0.f, 0.f, 0.f, 0.f};
                if (st4 <= tt4) {
                    const char* Ab = (m < 2 ? AT : RT) + (16 * tt4 + lq) * LROW + kg * 16; const char* Bb = ((m & 1) ? KT : BT) + (16 * st4 + lq) * LROW + kg * 16;
                    UNROLL for (int ks = 0; ks < 2; ++ks) a = MFMA16(*(const bf16x8*)(Ab + ks * 64), *(const bf16x8*)(Bb + ks * 64), a);
                }
                const int sidx = 16 * st4 + lq;
                UNROLL for (int i = 0; i < 4; ++i) {
                    const int tidx = 16 * tt4 + 4 * kg + i;
                    const bool keep = m < 2 ? sidx < tidx : sidx <= tidx;
                    const float val = keep ? a[i] : 0.f;
                    *(bf16_t*)(dstm + tidx * LROW + sidx * 2) = f2bf(val);
                    if (m == 0 && st4 == tt4) NDF[(tt4 * 16 + 4 * kg + i) * 16 + lq] = val;
                }
            }
            __syncthreads();
            f32x4v xacc[4], yacc[4];
            bf16x8 vt[2];
            if (wave == 7) {
                const int blk = lane >> 4, c = lane & 15;
                float Tc[16];
                UNROLL for (int t = 0; t < 16; ++t) {
                    float a = t == c ? 1.f : 0.f;
                    UNROLL for (int s2 = 0; s2 < t; ++s2) a += NDF[(blk * 16 + t) * 16 + s2] * Tc[s2];
                    Tc[t] = a;
                }
                UNROLL for (int t = 0; t < 16; ++t) *(bf16_t*)(TJ + (blk * 16 + t) * 32 + c * 2) = f2bf(Tc[t]);
            } else if (wave < 4) {
                bf16x8 sb[2];
                UNROLL for (int kk = 0; kk < 2; ++kk) { sb[kk] = pk_acc2(sacc[2 * kk], sacc[2 * kk + 1]); vt[kk] = *(const bf16x8*)(VT + (16 * wave + lq) * LROW + (((4 * kk + kg) ^ (2 * wave + (lq >> 3))) << 4)); }
                UNROLL for (int t4 = 0; t4 < 4; ++t4) {
                    f32x4v x = {0.f, 0.f, 0.f, 0.f}, y = {0.f, 0.f, 0.f, 0.f};
                    UNROLL for (int kk = 0; kk < 2; ++kk) {
                        const char* pa = AT + (16 * t4 + lq) * LROW + (32 * kk + 4 * kg) * 2; const char* pr = RT + (16 * t4 + lq) * LROW + (32 * kk + 4 * kg) * 2;
                        x = MFMA16(pk_lohi(*(const u32x2*)pa, *(const u32x2*)(pa + 32)), sb[kk], x);
                        y = MFMA16(pk_lohi(*(const u32x2*)pr, *(const u32x2*)(pr + 32)), sb[kk], y);
                        if (2 * kk <= t4) {
                            x = MFMA16(*(const bf16x8*)(NAK + (16 * t4 + lq) * LROW + kk * 64 + kg * 16), vt[kk], x);
                            y = MFMA16(*(const bf16x8*)(NRK + (16 * t4 + lq) * LROW + kk * 64 + kg * 16), vt[kk], y);
                        }
                    }
                    xacc[t4] = x; yacc[t4] = y;
                }
            }
            __syncthreads();
            if (wave < 4) {
                const u32x2 z2 = {0u, 0u};
                f32x4v uacc[4];
                {
                    const u32x2 t0v = *(const u32x2*)(TJ + (0 * 16 + lq) * 32 + 4 * kg * 2);
                    uacc[0] = MFMA16(pk_lohi(t0v, z2), pk_acc1(xacc[0]), ((f32x4v){0.f, 0.f, 0.f, 0.f}));
                }
                UNROLL for (int jb = 1; jb < 4; ++jb) {
                    f32x4v z = xacc[jb];
                    const char* nr = NAB + (16 * jb + lq) * LROW + 4 * kg * 2;
                    if (jb == 1) z = MFMA16(pk_lohi(*(const u32x2*)nr, z2), pk_acc1(uacc[0]), z);
                    else {
                        z = MFMA16(pk_lohi(*(const u32x2*)nr, *(const u32x2*)(nr + 32)), pk_acc2(uacc[0], uacc[1]), z);
                        if (jb == 3) z = MFMA16(pk_lohi(*(const u32x2*)(nr + 64), z2), pk_acc1(uacc[2]), z);
                    }
                    const u32x2 tv = *(const u32x2*)(TJ + (jb * 16 + lq) * 32 + 4 * kg * 2);
                    uacc[jb] = MFMA16(pk_lohi(tv, z2), pk_acc1(z), ((f32x4v){0.f, 0.f, 0.f, 0.f}));
                }
                bf16x8 ub[2]; ub[0] = pk_acc2(uacc[0], uacc[1]); ub[1] = pk_acc2(uacc[2], uacc[3]);
                UNROLL for (int t4 = 0; t4 < 4; ++t4) {
                    f32x4v y = yacc[t4];
                    UNROLL for (int kk = 0; kk < 2; ++kk) if (2 * kk <= t4) {
                        const char* pn = NRB + (16 * t4 + lq) * LROW + (32 * kk + 4 * kg) * 2;
                        y = MFMA16(pk_lohi(*(const u32x2*)pn, *(const u32x2*)(pn + 32)), ub[kk], y);
                    }
                    UNROLL for (int i = 0; i < 4; ++i) YO[(16 * t4 + 4 * kg + i) * 68 + 16 * wave + lq] = y[i];
                }
                UNROLL for (int kt = 0; kt < 4; ++kt) {
                    f32x4v sv = sacc[kt];
                    UNROLL for (int i = 0; i < 4; ++i) sv[i] *= PCv[16 * kt + 4 * kg + i];
                    UNROLL for (int kk = 0; kk < 2; ++kk) {
                        const int xr = 2 * kt + (lq >> 3);
                        const char* pb = BH + (16 * kt + lq) * LROW + (kg & 1) * 8;
                        sv = MFMA16(pk_lohi(*(const u32x2*)(pb + (((4 * kk + (kg >> 1)) ^ xr) << 4)), *(const u32x2*)(pb + (((4 * kk + 2 + (kg >> 1)) ^ xr) << 4))), ub[kk], sv);
                        sv = MFMA16(*(const bf16x8*)(KH + (16 * kt + lq) * LROW + (((4 * kk + kg) ^ xr) << 4)), vt[kk], sv);
                    }
                    sacc[kt] = sv;
                }
            }
            __syncthreads();
            {
                const float4 ya = *(const float4*)(YO + ti * 68 + 8 * j), yb = *(const float4*)(YO + ti * 68 + 8 * j + 4);
                const float y8[8] = {ya.x, ya.y, ya.z, ya.w, yb.x, yb.y, yb.z, yb.w};
                st8(YS + ((size_t)d * NT + nb + tt) * 512 + ch, y8);
            }
            __syncthreads();
        }
    }
}

DEV void ph_rw_read(const Params& p, int L, int ntok) {
    const int lane = TID() & 63, wave = TID() >> 6;
    const bf16_t* PXR = (const bf16_t*)(p.ws + OFF_PX); const bf16_t* VF = (const bf16_t*)(p.ws + OFF_VF);
    const bf16_t* YS = (const bf16_t*)(p.ws + OFF_YS); const float* CB = (const float*)(p.ws + OFF_CB);
    bf16_t* YA = (bf16_t*)(p.ws + OFF_YA); bf16_t* SG = (bf16_t*)(p.ws + OFF_SGB);
    const float* mu = p.in[I_MU] + (size_t)L * RW_COLS;
    const float* lg = p.in[I_LNG] + (size_t)L * 512; const float* lb = p.in[I_LNB] + (size_t)L * 512;
    for (int n0 = blockIdx.x * 8; n0 < ntok; n0 += gridDim.x * 8) {
        const int n = n0 + wave, c = lane * 8, h = lane >> 3;
        float y0[8], y1[8], v8[8], o[8];
        ld8(YS + (size_t)n * 512 + c, y0); ld8(YS + ((size_t)NT + n) * 512 + c, y1); ld8(VF + (size_t)n * 512 + c, v8);
        float s = 0.f;
        UNROLL for (int i = 0; i < 8; ++i) { y0[i] += y1[i]; s += y0[i]; }
        s += __shfl_xor(s, 1); s += __shfl_xor(s, 2); s += __shfl_xor(s, 4);
        const float mean = s * (1.f / 64.f); float q = 0.f;
        UNROLL for (int i = 0; i < 8; ++i) { const float dd = y0[i] - mean; q += dd * dd; }
        q += __shfl_xor(q, 1); q += __shfl_xor(q, 2); q += __shfl_xor(q, 4);
        const float rstd = rsqrtf(q * (1.f / 64.f) + 64e-5f);
        const float bon = CB[(size_t)n * 8 + h] + CB[((size_t)NT + n) * 8 + h];
        UNROLL for (int i = 0; i < 8; ++i) o[i] = (y0[i] - mean) * rstd * lg[c + i] + lb[c + i] + bon * v8[i];
        st8(YA + (size_t)n * 512 + c, o);
        if (lane < 16) {
            int nb, tt, T; seq_of(n, nb, tt, T);
            float g8[8]; shift8(PXR, RW_COLS, nb, tt, T, 1792 + lane * 8, mu, g8);
            UNROLL for (int i = 0; i < 8; ++i) g8[i] = sigm(g8[i]);
            st8(SG + (size_t)n * 128 + lane * 8, g8);
        }
    }
}

DEV void ph_na_norm(const Params& p, int L) {
    const int lane = TID() & 63, wave = TID() >> 6;
    bf16_t* PXN = (bf16_t*)(p.ws + OFF_PX);
    const float* qg = p.in[I_QNG] + (size_t)L * 64; const float* kg = p.in[I_KNG] + (size_t)L * 64;
    for (int n0 = blockIdx.x * 8; n0 < NT; n0 += gridDim.x * 8) {
        const int n = n0 + wave, c = lane * 8;
        UNROLL for (int w = 0; w < 2; ++w) {
            bf16_t* ptr = PXN + (size_t)n * 1024 + w * 512 + c;
            float x[8]; ld8(ptr, x);
            float ss = 0.f;
            UNROLL for (int i = 0; i < 8; ++i) ss += x[i] * x[i];
            ss += __shfl_xor(ss, 1); ss += __shfl_xor(ss, 2); ss += __shfl_xor(ss, 4);
            const float r = rsqrtf(ss * (1.f / 64.f) + 1e-6f) * (w == 0 ? 0.125f : 1.f);
            const float* g = w == 0 ? qg : kg;
            UNROLL for (int i = 0; i < 8; ++i) x[i] = x[i] * r * g[(c + i) & 63];
            st8(ptr, x);
        }
    }
}

DEV void knorm8(float (&x)[8], const float* g) {
    float ss = 0.f;
    UNROLL for (int i = 0; i < 8; ++i) ss += x[i] * x[i];
    ss = sum8(ss);
    const float r = rsqrtf(ss * (1.f / 64.f) + 1e-6f);
    UNROLL for (int i = 0; i < 8; ++i) x[i] = x[i] * r * g[i];
}
DEV void ph_na_att(const Params& p, int L, char* smem) {
    const int tid0 = TID();
    const int wave = __builtin_amdgcn_readfirstlane(tid0 >> 6);
    char* KL = smem;
    char* KC = smem + 576 * LROW;
    char* VL = smem;
    char* VC = smem + 64 * 1168;
    float* OX = (float*)(smem + 119808);
    float* RP = OX + 8 * 1024;
    const bf16_t* PXN = (const bf16_t*)(p.ws + OFF_PX); bf16_t* YB = (bf16_t*)(p.ws + OFF_YB);
    const bf16_t* VT = (const bf16_t*)(p.ws + OFF_VT); const bf16_t* VTC = (const bf16_t*)(p.ws + OFF_VTC);
    const float* qgn = p.in[I_QNG] + (size_t)L * 64; const float* kgn = p.in[I_KNG] + (size_t)L * 64;
    const int nunits = 2048 + (L == 0 ? 256 : 0);
    u32x4 vraw[13], qraw[2];
#define NA_GEOM(u_) const bool cu = (u_) >= 2048; int b, h, rp = 0, rs0 = 0, g = 0; \
        if (!cu) { h = (u_) & 7; rp = ((u_) >> 3) & 15; b = (u_) >> 7; rs0 = min(max(2 * rp - 4, 0), 24); } \
        else { const int v_ = (u_) - 2048; h = v_ & 7; g = (v_ >> 3) & 1; b = v_ >> 4; } \
        const int ctx0 = NX + b * CTXL; \
        const int nb = wave & 3, ri = wave >> 2, r = 2 * rp + ri; \
        const int qtok0 = cu ? ctx0 + (g * 8 + wave) * 16 : b * SEQ + r * 64 + nb * 16;
#define NA_KQ_LOAD(u_, tid_) do { NA_GEOM(u_) \
        if (!cu) { UNROLL for (int i = 0; i < 9; ++i) { const int c = (tid_) + NTHREADS * i, kx = c >> 3, part = c & 7; \
            vraw[i] = *(const u32x4*)(PXN + (size_t)(b * SEQ + min(rs0 + (kx >> 6), 31) * 64 + (kx & 63)) * 1024 + 512 + h * 64 + part * 8); } } \
        UNROLL for (int i = 0; i < 4; ++i) { const int c = (tid_) + NTHREADS * i, kx = c >> 3, part = c & 7; \
            vraw[9 + i] = *(const u32x4*)(PXN + (size_t)(ctx0 + kx) * 1024 + 512 + h * 64 + part * 8); } \
        { const int lq_ = (tid_) & 15, kg_ = ((tid_) & 63) >> 4; \
          qraw[0] = *(const u32x4*)(PXN + (size_t)(qtok0 + lq_) * 1024 + h * 64 + kg_ * 8); qraw[1] = *(const u32x4*)(PXN + (size_t)(qtok0 + lq_) * 1024 + h * 64 + 32 + kg_ * 8); } } while (0)
    int u0 = blockIdx.x; asm volatile("" : "+s"(u0));
    if (u0 < nunits) NA_KQ_LOAD(u0, tid0);
    for (int u = u0; u < nunits; u += gridDim.x) {
        int tid = tid0; asm volatile("" : "+v"(tid));
        const int lane = tid & 63, lq = lane & 15, kg = lane >> 4;
        NA_GEOM(u)
        if (!cu) {
            UNROLL for (int i = 0; i < 9; ++i) {
                const int c = tid + NTHREADS * i, kx = c >> 3, part = c & 7;
                float kv[8]; unpack8(vraw[i], kv); knorm8(kv, kgn + part * 8);
                st8((bf16_t*)(KL + kx * LROW + part * 16), kv);
            }
            for (int i = tid; i < 15 * 31; i += NTHREADS) RP[i] = p.in[I_RPB][((size_t)L * 8 + h) * 465 + i];
        }
        UNROLL for (int i = 0; i < 4; ++i) {
            const int c = tid + NTHREADS * i, kx = c >> 3, part = c & 7;
            float kv[8]; unpack8(vraw[9 + i], kv); knorm8(kv, kgn + part * 8);
            st8((bf16_t*)(KC + kx * LROW + part * 16), kv);
        }
        const int rs = min(max(r - 4, 0), 24), roff = rs - rs0;
        const int band0 = min(max(nb * 16 - 8, 0), 32);
        bf16x8 qf[2];
        {
            float q0[8], q1[8]; unpack8(qraw[0], q0); unpack8(qraw[1], q1);
            float ss = 0.f;
            UNROLL for (int i = 0; i < 8; ++i) ss += q0[i] * q0[i] + q1[i] * q1[i];
            ss += __shfl_xor(ss, 16); ss += __shfl_xor(ss, 32);
            const float rq = rsqrtf(ss * (1.f / 64.f) + 1e-6f) * 0.125f;
            UNROLL for (int i = 0; i < 8; ++i) { q0[i] = q0[i] * rq * qgn[kg * 8 + i]; q1[i] = q1[i] * rq * qgn[32 + kg * 8 + i]; }
            u32x4 w0, w1; w0.x = pk2(q0[0], q0[1]); w0.y = pk2(q0[2], q0[3]); w0.z = pk2(q0[4], q0[5]); w0.w = pk2(q0[6], q0[7]);
            w1.x = pk2(q1[0], q1[1]); w1.y = pk2(q1[2], q1[3]); w1.z = pk2(q1[4], q1[5]); w1.w = pk2(q1[6], q1[7]);
            qf[0] = __builtin_bit_cast(bf16x8, w0); qf[1] = __builtin_bit_cast(bf16x8, w1);
        }
        __syncthreads();
        if (!cu) {
            UNROLL for (int i = 0; i < 9; ++i) {
                const int c = tid + NTHREADS * i, part = c & 7, kr = (c >> 3) % 9, d = (c >> 3) / 9;
                vraw[i] = *(const u32x4*)(VT + ((size_t)(b * 8 + h) * 64 + d) * SEQ + min(rs0 + kr, 31) * 64 + part * 8);
            }
        }
        UNROLL for (int i = 0; i < 4; ++i) {
            const int c = tid + NTHREADS * i, part = c & 31, d = c >> 5;
            vraw[9 + i] = *(const u32x4*)(VTC + ((size_t)(b * 8 + h) * 64 + d) * CTXL + part * 8);
        }
        f32x4v sacc[16];
        bf16x8 pfl[8], pfc[8];
        float ml = -3e38f, ll = 0.f, mc, lc;
        if (!cu) {
            const char* kb = KL + (roff * 64 + band0 + lq) * LROW + kg * 16;
            UNROLL for (int t = 0; t < 16; ++t) {
                f32x4v a = {0.f, 0.f, 0.f, 0.f};
                UNROLL for (int ks = 0; ks < 2; ++ks) a = __builtin_amdgcn_mfma_f32_16x16x32_bf16(*(const bf16x8*)(kb + ((t >> 1) * 64 + (t & 1) * 16) * LROW + ks * 64), qf[ks], a, 0, 0, 0);
                sacc[t] = a;
            }
            const int col = nb * 16 + lq, cs = min(max(col - 8, 0), 48);
            const int kc0 = band0 + 4 * kg;
            const float* rpp = RP + (rs - r + 7) * 31 + (kc0 - col + 15);
            UNROLL for (int t = 0; t < 16; ++t) UNROLL for (int i = 0; i < 4; ++i) {
                const int kc = kc0 + (t & 1) * 16 + i;
                const bool valid = kc >= cs && kc < cs + 16;
                sacc[t][i] = valid ? sacc[t][i] + rpp[(t >> 1) * 31 + (t & 1) * 16 + i] : -1e30f;
            }
            UNROLL for (int t = 0; t < 16; ++t) UNROLL for (int i = 0; i < 4; ++i) ml = fmaxf(ml, sacc[t][i]);
            ml = fmaxf(ml, __shfl_xor(ml, 16)); ml = fmaxf(ml, __shfl_xor(ml, 32));
            UNROLL for (int t = 0; t < 16; ++t) UNROLL for (int i = 0; i < 4; ++i) { const float e = __expf(sacc[t][i] - ml); sacc[t][i] = e; ll += e; }
            ll += __shfl_xor(ll, 16); ll += __shfl_xor(ll, 32);
            UNROLL for (int tp = 0; tp < 8; ++tp) pfl[tp] = pk_acc2(sacc[2 * tp], sacc[2 * tp + 1]);
        }
        {
            const char* kb = KC + lq * LROW + kg * 16;
            UNROLL for (int t = 0; t < 16; ++t) {
                f32x4v a = {0.f, 0.f, 0.f, 0.f};
                UNROLL for (int ks = 0; ks < 2; ++ks) a = __builtin_amdgcn_mfma_f32_16x16x32_bf16(*(const bf16x8*)(kb + t * 16 * LROW + ks * 64), qf[ks], a, 0, 0, 0);
                sacc[t] = a;
            }
            mc = -3e38f; lc = 0.f;
            UNROLL for (int t = 0; t < 16; ++t) UNROLL for (int i = 0; i < 4; ++i) mc = fmaxf(mc, sacc[t][i]);
            mc = fmaxf(mc, __shfl_xor(mc, 16)); mc = fmaxf(mc, __shfl_xor(mc, 32));
            UNROLL for (int t = 0; t < 16; ++t) UNROLL for (int i = 0; i < 4; ++i) { const float e = __expf(sacc[t][i] - mc); sacc[t][i] = e; lc += e; }
            lc += __shfl_xor(lc, 16); lc += __shfl_xor(lc, 32);
            UNROLL for (int tp = 0; tp < 8; ++tp) pfc[tp] = pk_acc2(sacc[2 * tp], sacc[2 * tp + 1]);
        }
        const float mm = fmaxf(ml, mc), el = cu ? 0.f : __expf(ml - mm), ec = __expf(mc - mm);
        const float inv = frcp(ll * el + lc * ec);
        const float fl = el * inv, fc = ec * inv;
        __syncthreads();
        if (!cu) {
            UNROLL for (int i = 0; i < 9; ++i) {
                const int c = tid + NTHREADS * i, part = c & 7, kr = (c >> 3) % 9, d = (c >> 3) / 9;
                *(u32x4*)(VL + d * 1168 + (kr * 64 + part * 8) * 2) = vraw[i];
            }
        }
        UNROLL for (int i = 0; i < 4; ++i) {
            const int c = tid + NTHREADS * i, part = c & 31, d = c >> 5;
            *(u32x4*)(VC + d * 528 + part * 16) = vraw[9 + i];
        }
        __syncthreads();
        f32x4v ol[4], oc[4];
        UNROLL for (int dt = 0; dt < 4; ++dt) { ol[dt] = (f32x4v){0.f, 0.f, 0.f, 0.f}; oc[dt] = (f32x4v){0.f, 0.f, 0.f, 0.f}; }
        if (!cu) {
            const char* vb = VL + lq * 1168 + (roff * 64 + band0 + 4 * kg) * 2;
            UNROLL for (int tp = 0; tp < 8; ++tp) UNROLL for (int dt = 0; dt < 4; ++dt)
                ol[dt] = __builtin_amdgcn_mfma_f32_16x16x32_bf16(pfl[tp], pk_lohi(*(const u32x2*)(vb + dt * 16 * 1168 + tp * 128), *(const u32x2*)(vb + dt * 16 * 1168 + tp * 128 + 32)), ol[dt], 0, 0, 0);
        }
        {
            const char* vb = VC + lq * 528 + 8 * kg;
            UNROLL for (int tp = 0; tp < 8; ++tp) UNROLL for (int dt = 0; dt < 4; ++dt)
                oc[dt] = __builtin_amdgcn_mfma_f32_16x16x32_bf16(pfc[tp], pk_lohi(*(const u32x2*)(vb + dt * 16 * 528 + tp * 64), *(const u32x2*)(vb + dt * 16 * 528 + tp * 64 + 32)), oc[dt], 0, 0, 0);
        }
        if (u + (int)gridDim.x < nunits) { const int un_ = u + (int)gridDim.x; NA_KQ_LOAD(un_, tid); }
        float* ox = OX + wave * 1024;
        UNROLL for (int i = 0; i < 4; ++i) {
            const float a = __shfl(fl, 4 * kg + i), c2 = __shfl(fc, 4 * kg + i);
            UNROLL for (int dt = 0; dt < 4; ++dt) ox[(4 * kg + i) * 64 + dt * 16 + lq] = ol[dt][i] * a + oc[dt][i] * c2;
        }
        UNROLL for (int it = 0; it < 2; ++it) {
            const int q = (lane >> 3) + 8 * it, c8 = (lane & 7) * 8;
            const float4 a = *(const float4*)(ox + q * 64 + c8), bq = *(const float4*)(ox + q * 64 + c8 + 4);
            const float v[8] = {a.x, a.y, a.z, a.w, bq.x, bq.y, bq.z, bq.w};
            st8(YB + (size_t)(qtok0 + q) * 512 + h * 64 + c8, v);
        }
        __syncthreads();
    }
#undef NA_KQ_LOAD
#undef NA_GEOM
}

DEV float sum16(float v) { v += DPP_MOV(v, 0xB1); v += DPP_MOV(v, 0x4E); v += DPP_MOV(v, 0x141); v += DPP_MOV(v, 0x140); return v; }
DEV void ph_ml_scan(const Params& p, int L, char* smem) {
    const int tid = TID(), lane = tid & 63, lq = lane & 15, kg = lane >> 4, ti = tid >> 3, j = tid & 7;
    const int wave = __builtin_amdgcn_readfirstlane(tid >> 6);
    char* QS = smem;
    char* QP = QS + 9216;
    char* KC = QP + 9216;
    char* KW = KC + 9216;
    char* PM = KW + 9216;
    char* VT = PM + 9216;
    float* BV = (float*)(VT + 128 * LROW);
    float* GI = BV + 64;
    float* DEN = GI + 64;
    float* NV = DEN + 64;
    float* RS = NV + 64;
    float* HO = RS + 256;
    const bf16_t* PXM = (const bf16_t*)(p.ws + OFF_PX); bf16_t* HS = (bf16_t*)(p.ws + OFF_HS);
    for (int u = blockIdx.x; u < 128; u += gridDim.x) {
        const int d = u & 1, h = (u >> 1) & 3, b = u >> 3;
        const float ib = p.in[I_IB][L * 8 + d * 4 + h], fb = p.in[I_FB][L * 8 + d * 4 + h];
        f32x4v cacc[4];
        UNROLL for (int i = 0; i < 4; ++i) cacc[i] = (f32x4v){0.f, 0.f, 0.f, 0.f};
        for (int i = tid; i < 64 * LROW / 4; i += NTHREADS) ((unsigned*)PM)[i] = 0u;
        if (tid < 64) NV[tid] = 0.f;
        __syncthreads();
        u32x4 pq, pk, pv0, pv1; unsigned short pig = 0, pfg = 0;
#define ML_GEOM(ci_) const bool isc = (ci_) < 4; const int T = isc ? CTXL : SEQ, cc = isc ? (ci_) : (ci_) - 4; \
            const int t0 = d == 0 ? cc * 64 : T - 64 * (cc + 1), nb = isc ? NX + b * CTXL : b * SEQ; \
            const int tt = d == 0 ? t0 + ti : t0 + 63 - ti;
#define ML_PREFETCH(ci_) do { ML_GEOM(ci_) const bf16_t* row_ = PXM + (size_t)(nb + tt) * ML_COLS; \
            pq = *(const u32x4*)(row_ + h * 64 + 8 * j); pk = *(const u32x4*)(row_ + 256 + h * 64 + 8 * j); \
            pv0 = *(const u32x4*)(row_ + 512 + h * 128 + 16 * j); pv1 = *(const u32x4*)(row_ + 512 + h * 128 + 16 * j + 8); \
            if (wave == 0) { const int tl_ = d == 0 ? t0 + lane : t0 + 63 - lane; const bf16_t* rw_ = PXM + (size_t)(nb + tl_) * ML_COLS; pig = rw_[1536 + d * 4 + h]; pfg = rw_[1544 + d * 4 + h]; } } while (0)
        ML_PREFETCH(0);
        for (int ci = 0; ci < 36; ++ci) {
            ML_GEOM(ci)
            float q8[8], k8[8];
            {
                unpack8(pq, q8); unpack8(pk, k8);
                if (!isc) {
                    const int axis = j >> 2, half = (j >> 1) & 1; const float pos = (float)(axis == 0 ? (tt >> 6) : (tt & 63));
                    UNROLL for (int i = 0; i < 8; ++i) {
                        const int f = (j & 1) * 8 + i;
                        const float inv = exp2f(-(float)f * 0.83048202372184059f);
                        const float ang = pos * inv; const float cs = __cosf(ang), sn = __sinf(ang);
                        const float qo = __shfl_xor(q8[i], 2), ko = __shfl_xor(k8[i], 2);
                        q8[i] = half == 0 ? q8[i] * cs - qo * sn : q8[i] * cs + qo * sn;
                        k8[i] = half == 0 ? k8[i] * cs - ko * sn : k8[i] * cs + ko * sn;
                    }
                }
                UNROLL for (int i = 0; i < 8; ++i) q8[i] *= 0.125f;
                st8((bf16_t*)(QS + ti * LROW) + 8 * j, q8); st8((bf16_t*)(KC + ti * LROW) + 8 * j, k8);
                float v0[8], v1[8]; unpack8(pv0, v0); unpack8(pv1, v1);
                UNROLL for (int i = 0; i < 8; ++i) { *(bf16_t*)(VT + (16 * j + i) * LROW + ti * 2) = f2bf(v0[i]); *(bf16_t*)(VT + (16 * j + 8 + i) * LROW + ti * 2) = f2bf(v1[i]); }
                if (wave == 0) {
                    const float ig = bf2f(pig) + ib, fg = bf2f(pfg) + fb;
                    const float igc = 15.f * tanhf(ig * (1.f / 15.f)), fgc = 15.f * tanhf(fg * (1.f / 15.f));
                    float lf = -(fmaxf(-fgc, 0.f) + log1pf(expf(-fabsf(fgc))));
                    UNROLL for (int o = 1; o < 64; o <<= 1) { const float up = __shfl_up(lf, o); if (lane >= o) lf += up; }
                    BV[lane] = lf; GI[lane] = igc;
                }
            }
            __syncthreads();
            if (ci + 1 < 36) ML_PREFETCH(ci + 1);
            {
                const float bt = BV[ti], bl = BV[63], gi = GI[ti];
                const float eb = __expf(bt), wk = __expf(bl - bt + gi);
                float qp[8]; float dn = 0.f;
                UNROLL for (int i = 0; i < 8; ++i) { qp[i] = q8[i] * eb; dn += q8[i] * NV[8 * j + i]; }
                st8((bf16_t*)(QP + ti * LROW) + 8 * j, qp);
                UNROLL for (int i = 0; i < 8; ++i) *(bf16_t*)(KW + (8 * j + i) * LROW + ti * 2) = f2bf(k8[i] * wk);
                dn = sum8(dn);
                if (j == 0) DEN[ti] = dn * eb;
            }
            __syncthreads();
            UNROLL for (int rep = 0; rep < 2; ++rep) {
                const int tile = wave + 8 * rep;
                if (tile < 10) {
                    const int tt4 = tile < 1 ? 0 : tile < 3 ? 1 : tile < 6 ? 2 : 3, st4 = tile - (tt4 * (tt4 + 1)) / 2;
                    f32x4v a = {0.f, 0.f, 0.f, 0.f};
                    UNROLL for (int ks = 0; ks < 2; ++ks)
                        a = __builtin_amdgcn_mfma_f32_16x16x32_bf16(*(const bf16x8*)(QS + (16 * tt4 + lq) * LROW + ks * 64 + kg * 16),
                                                                    *(const bf16x8*)(KC + (16 * st4 + lq) * LROW + ks * 64 + kg * 16), a, 0, 0, 0);
                    const int sidx = 16 * st4 + lq; const float bs = BV[sidx], gs = GI[sidx];
                    UNROLL for (int i = 0; i < 4; ++i) {
                        const int tidx = 16 * tt4 + 4 * kg + i;
                        const float val = sidx <= tidx ? a[i] * __expf(BV[tidx] - bs + gs) : 0.f;
                        *(bf16_t*)(PM + tidx * LROW + sidx * 2) = f2bf(val);
                        const float rsum = sum16(val);
                        if (lq == 0) RS[tidx * 4 + st4] = rsum;
                    }
                }
            }
            __syncthreads();
            {
                bf16x8 vf[2], cb[2];
                UNROLL for (int kk = 0; kk < 2; ++kk) vf[kk] = *(const bf16x8*)(VT + (16 * wave + lq) * LROW + kk * 64 + kg * 16);
                UNROLL for (int kk = 0; kk < 2; ++kk) {
                    u32x4 w; w.x = pk2(cacc[2 * kk][0], cacc[2 * kk][1]); w.y = pk2(cacc[2 * kk][2], cacc[2 * kk][3]);
                    w.z = pk2(cacc[2 * kk + 1][0], cacc[2 * kk + 1][1]); w.w = pk2(cacc[2 * kk + 1][2], cacc[2 * kk + 1][3]);
                    cb[kk] = __builtin_bit_cast(bf16x8, w);
                }
                UNROLL for (int tt4 = 0; tt4 < 4; ++tt4) {
                    f32x4v hacc = {0.f, 0.f, 0.f, 0.f};
                    UNROLL for (int kk = 0; kk < 2; ++kk) if (2 * kk <= tt4)
                        hacc = __builtin_amdgcn_mfma_f32_16x16x32_bf16(*(const bf16x8*)(PM + (16 * tt4 + lq) * LROW + kk * 64 + kg * 16), vf[kk], hacc, 0, 0, 0);
                    UNROLL for (int kk = 0; kk < 2; ++kk) {
                        const char* qa = QP + (16 * tt4 + lq) * LROW + (32 * kk + 4 * kg) * 2;
                        const u32x2 lo = *(const u32x2*)qa, hi = *(const u32x2*)(qa + 32);
                        u32x4 w; w.x = lo.x; w.y = lo.y; w.z = hi.x; w.w = hi.y;
                        hacc = __builtin_amdgcn_mfma_f32_16x16x32_bf16(__builtin_bit_cast(bf16x8, w), cb[kk], hacc, 0, 0, 0);
                    }
                    UNROLL for (int i = 0; i < 4; ++i) {
                        const int tidx = 16 * tt4 + 4 * kg + i;
                        float den = DEN[tidx];
                        UNROLL for (int st = 0; st <= tt4; ++st) den += RS[tidx * 4 + st];
                        HO[tidx * 132 + 16 * wave + lq] = hacc[i] * frcp(fmaxf(fabsf(den), 1.f));
                    }
                }
                const float g = __expf(BV[63]);
                UNROLL for (int dk = 0; dk < 4; ++dk) {
                    cacc[dk] = cacc[dk] * g;
                    UNROLL for (int kk = 0; kk < 2; ++kk)
                        cacc[dk] = __builtin_amdgcn_mfma_f32_16x16x32_bf16(*(const bf16x8*)(KW + (16 * dk + lq) * LROW + kk * 64 + kg * 16), vf[kk], cacc[dk], 0, 0, 0);
                }
            }
            __syncthreads();
            if (tid < 64) {
                float acc = 0.f;
                UNROLL for (int c8 = 0; c8 < 8; ++c8) { float kw[8]; ld8((const bf16_t*)(KW + tid * LROW) + 8 * c8, kw); UNROLL for (int i = 0; i < 8; ++i) acc += kw[i]; }
                NV[tid] = __expf(BV[63]) * NV[tid] + acc;
            }
            {
                const float* hr = HO + ti * 132 + 16 * j;
                float o0[8], o1[8];
                UNROLL for (int i = 0; i < 8; ++i) { o0[i] = hr[i]; o1[i] = hr[8 + i]; }
                bf16_t* dst = HS + ((size_t)d * NT + nb + tt) * 512 + h * 128 + 16 * j;
                st8(dst, o0); st8(dst + 8, o1);
            }
            __syncthreads();
        }
    }
}
DEV void ph_ml_read(const Params& p, int L, int ntok) {
    const int lane = TID() & 63, wave = TID() >> 6;
    const bf16_t* PXM = (const bf16_t*)(p.ws + OFF_PX); const bf16_t* HS = (const bf16_t*)(p.ws + OFF_HS);
    bf16_t* YC = (bf16_t*)(p.ws + OFF_YC); const float* ng = p.in[I_MNG] + (size_t)L * 512;
    for (int n0 = blockIdx.x * 8; n0 < ntok; n0 += gridDim.x * 8) {
        const int n = n0 + wave, c = lane * 8;
        float h0[8], h1[8], o8[8], out[8];
        ld8(HS + (size_t)n * 512 + c, h0); ld8(HS + ((size_t)NT + n) * 512 + c, h1); ld8(PXM + (size_t)n * ML_COLS + 1024 + c, o8);
        float ss = 0.f;
        UNROLL for (int i = 0; i < 8; ++i) { h0[i] += h1[i]; ss += h0[i] * h0[i]; }
        ss += __shfl_xor(ss, 1); ss += __shfl_xor(ss, 2); ss += __shfl_xor(ss, 4); ss += __shfl_xor(ss, 8);
        const float r = rsqrtf(ss * (1.f / 128.f) + 1e-6f);
        UNROLL for (int i = 0; i < 8; ++i) out[i] = h0[i] * r * ng[c + i] * sigm(o8[i]);
        st8(YC + (size_t)n * 512 + c, out);
    }
}

DEV void ph_route(const Params& p, int L, int ntok, char* smem) {
    const int lane = TID() & 63, wave = TID() >> 6;
    const float* LOG = (const float*)(p.ws + OFF_LOG); int* EIDX = (int*)(p.ws + OFF_EIDX); float* EW = (float*)(p.ws + OFF_EW);
    const float bias = p.in[I_MB][L * 64 + lane];
    int* MCNT = (int*)(p.ws + OFF_MCNT);
    int* hist = (int*)smem;
    if (TID() < 192) hist[TID()] = 0;
    __syncthreads();
    for (int n0 = blockIdx.x * 8; n0 < ntok; n0 += gridDim.x * 8) {
        const int n = n0 + wave, g = lane >> 3;
        const float score = sigm_acc(LOG[(size_t)n * 64 + lane]), sel = score + bias;
        float m1 = sel; m1 = fmaxf(m1, __shfl_xor(m1, 1)); m1 = fmaxf(m1, __shfl_xor(m1, 2)); m1 = fmaxf(m1, __shfl_xor(m1, 4));
        int i1 = sel == m1 ? lane : 64; i1 = min(i1, __shfl_xor(i1, 1)); i1 = min(i1, __shfl_xor(i1, 2)); i1 = min(i1, __shfl_xor(i1, 4));
        float m2 = lane == i1 ? -3e38f : sel; m2 = fmaxf(m2, __shfl_xor(m2, 1)); m2 = fmaxf(m2, __shfl_xor(m2, 2)); m2 = fmaxf(m2, __shfl_xor(m2, 4));
        const float gs = m1 + m2;
        int rank = 0;
        UNROLL for (int g2 = 0; g2 < 8; ++g2) { const float v = __shfl(gs, g2 * 8); rank += (v > gs || (v == gs && g2 < g)) ? 1 : 0; }
        const float ms = rank < 4 ? sel : -1e30f;
        int er = 0;
        for (int e2 = 0; e2 < 64; ++e2) { const float v = __shfl(ms, e2); er += (v > ms || (v == ms && e2 < lane)) ? 1 : 0; }
        const bool chosen = er < 8;
        float ws = chosen ? score : 0.f;
        UNROLL for (int o = 1; o < 64; o <<= 1) ws += __shfl_xor(ws, o);
        if (chosen) { EIDX[(size_t)n * 8 + er] = lane; EW[(size_t)n * 8 + er] = score / ws * 2.5f; atomicAdd(hist + (n / MOE_CHUNK) * 64 + lane, 1); }
    }
    __syncthreads();
    if (TID() < 192 && hist[TID()] > 0) atomicAdd(MCNT + TID(), hist[TID()]);
    __syncthreads();
}


DEV void ph_moe_scatter(const Params& p, int ntok, char* smem) {
    const int tid = TID();
    int* base = (int*)smem;
    int* lh = base + 192;
    const int* MCNT = (const int*)(p.ws + OFF_MCNT); int* CUR = (int*)(p.ws + OFF_MCNT) + 192;
    const int* EIDX = (const int*)(p.ws + OFF_EIDX); int* SORT = (int*)(p.ws + OFF_SORT);
    if (tid < 3) { int b = 0; for (int e = 0; e < 64; ++e) { base[tid * 64 + e] = b; b += (MCNT[tid * 64 + e] + 127) & ~127; } }
    if (tid < 192) lh[tid] = 0;
    __syncthreads();
    for (int i = blockIdx.x * NTHREADS + tid; i < ntok * 8; i += gridDim.x * NTHREADS) atomicAdd(lh + ((i >> 3) / MOE_CHUNK) * 64 + EIDX[i], 1);
    __syncthreads();
    if (tid < 192) { const int n = lh[tid]; if (n > 0) base[tid] += atomicAdd(CUR + tid, n); lh[tid] = 0; }
    __syncthreads();
    for (int i = blockIdx.x * NTHREADS + tid; i < ntok * 8; i += gridDim.x * NTHREADS) {
        const int ce = ((i >> 3) / MOE_CHUNK) * 64 + EIDX[i];
        SORT[(size_t)(ce >> 6) * SORT_CAP + base[ce] + atomicAdd(lh + ce, 1)] = i;
    }
    __syncthreads();
}

DEV void ph_moe_exp(const Params& p, int cb, int ce, char* smem, Topo tp) {
    typedef GC<2, 4> C;
    const int tid0 = TID();
    char* ACT = smem + 2 * C::STG;
    int* list = (int*)(smem + 3 * C::STG);
    int* cnt = list + 1024;
    const bf16_t* H2 = (const bf16_t*)(p.ws + OFF_HX); const int* EIDX = (const int*)(p.ws + OFF_EIDX); const float* EW = (const float*)(p.ws + OFF_EW);
    unsigned char* YB8 = (unsigned char*)(p.ws + OFF_YBUF); unsigned char* YSC = (unsigned char*)(p.ws + OFF_YSC);
    const int c = cb / MOE_CHUNK;
    const int* MCNT = (const int*)(p.ws + OFF_MCNT) + c * 64; const int* SORT = (const int*)(p.ws + OFF_SORT) + (size_t)c * SORT_CAP;
    int* tb = cnt + 16;
    const int xcd = tp.x, slot = tp.r, nslot = tp.n;
    __syncthreads();
    if (tid0 < 8) {
        const int tid = tid0; const int e = xcd + 8 * tid; int b = 0;
        for (int e2 = 0; e2 < e; ++e2) b += (MCNT[e2] + 127) & ~127;
        tb[16 + tid] = b; tb[32 + tid] = MCNT[e];
    }
    __syncthreads();
    if (tid0 == 0) { int t = 0; for (int k = 0; k < 8; ++k) { tb[k] = t; t += (tb[32 + k] + 127) >> 7; } tb[8] = t; }
    __syncthreads();
    const int total = tb[8];
    float* ewl = (float*)(list + 256);
    if (slot < total && tid0 < 128) {
        int k = 0;
        while (k < 7 && slot >= tb[k + 1]) ++k;
        const int j = slot - tb[k], M = min(128, tb[32 + k] - 128 * j);
        const int en = SORT[tb[16 + k] + 128 * j + min(tid0, M - 1)];
        list[tid0] = en; ewl[tid0] = EW[en];
    }
    int cur = 0;
#define GLDS4(gp, lp) __builtin_amdgcn_global_load_lds((const __attribute__((address_space(1))) void*)(gp), (__attribute__((address_space(3))) void*)(lp), 4, 0, 0)
    for (int lu = slot; lu < total; lu += nslot) {
        int tid = tid0; asm volatile("" : "+v"(tid));
        const int lane = tid & 63, wave = tid >> 6, wm = wave / 4, wn = wave % 4, fr = lane & 31, fh = lane >> 5;
        int k = 0;
        while (k < 7 && lu >= tb[k + 1]) ++k;
        const int e = xcd + 8 * k, j = lu - tb[k], M = min(128, tb[32 + k] - 128 * j);
        const int* lst = list + cur * 128; const float* ew = ewl + cur * 128;
        int* lst2 = list + (cur ^ 1) * 128; float* ew2 = ewl + (cur ^ 1) * 128;
        const bool has_next = lu + nslot < total;
        __syncthreads();
        if (has_next && tid < 128) {
            const int lu2 = lu + nslot; int k2 = 0;
            while (k2 < 7 && lu2 >= tb[k2 + 1]) ++k2;
            const int j2 = lu2 - tb[k2], M2 = min(128, tb[32 + k2] - 128 * j2);
            GLDS4(SORT + tb[16 + k2] + 128 * j2 + min(tid, M2 - 1), lst2 + tid);
        }
        const bf16_t* GU = (const bf16_t*)(p.ws + OFF_MGU) + (size_t)e * 256 * 1024;
        const bf16_t* DT = (const bf16_t*)(p.ws + OFF_MDT) + (size_t)e * 1024 * 128;
        {
            constexpr int mc = 0;
            f32x16 acc[2][2];
            {
            acc_zero(acc);
            gemm_tile<2, 4, 3, false, true>(acc, [&](int r) -> const bf16_t* { const int ix = min(mc + r, M - 1); return H2 + (size_t)(lst[ix] >> 3) * 1024; },
                                   GU, 1024, 0, 256, 1024, smem, nullptr);
            }
            const int crow = tid >> 3, cch = (tid & 7) ^ ((crow >> 1) & 7);
#define MG2_ISSUE(nt_) do { UNROLL for (int kt = 0; kt < 2; ++kt) UNROLL for (int i = 0; i < 4; ++i) \
                    GLDS16(DT + (size_t)((nt_) * 256 + ((crow + 64 * i) & ~31) + p32(crow & 31)) * 128 + kt * 64 + cch * 8, smem + kt * C::STG + C::AB + i * 8192 + tid * 16); } while (0)
            if (has_next && tid < 128) GLDS4(EW + lst2[tid], ew2 + tid);
            MG2_ISSUE(0);
            UNROLL for (int mi = 0; mi < 2; ++mi) {
                const int row = wm * 64 + mi * 32 + fr;
                const float gw = ew[row];
                float a[2][8];
                UNROLL for (int r = 0; r < 16; ++r) { const float gv = acc[mi][0][r], uv = acc[mi][1][r]; a[r >> 3][r & 7] = gv * frcp(1.f + __expf(-gv)) * uv * gw; }
                const int col0 = wn * 32 + 16 * fh, c0 = (col0 & 63) >> 3, swr = (row >> 1) & 7;
                char* arow_ = ACT + (col0 >> 6) * C::AB + row * 128;
                st8((bf16_t*)(arow_ + ((c0 ^ swr) << 4)), a[0]); st8((bf16_t*)(arow_ + (((c0 + 1) ^ swr) << 4)), a[1]);
            }
            __syncthreads();
            {
                const int sw = (fr >> 1) & 7, a_base = (wm * 64 + fr) * 128, b_base = (wn * 64 + fr) * 128;
                asm volatile("s_waitcnt vmcnt(0)" ::: "memory");
                _Pragma("unroll 1") for (int nt = 0; nt < 4; ++nt) {
                    __builtin_amdgcn_s_barrier();
                    asm volatile("" ::: "memory");
                    acc_zero(acc);
                    UNROLL for (int kt = 0; kt < 2; ++kt) {
                        const char* As_ = ACT + kt * C::AB; const char* Bs_ = smem + kt * C::STG + C::AB;
                        UNROLL for (int ks = 0; ks < 4; ++ks) {
                            const int off = ((2 * ks + fh) ^ sw) * 16;
                            bf16x8 af[2], bfv[2];
                            UNROLL for (int mi = 0; mi < 2; ++mi) af[mi] = *(const bf16x8*)(As_ + a_base + mi * 4096 + off);
                            UNROLL for (int ni = 0; ni < 2; ++ni) bfv[ni] = *(const bf16x8*)(Bs_ + b_base + ni * 4096 + off);
                            UNROLL for (int mi = 0; mi < 2; ++mi) UNROLL for (int ni = 0; ni < 2; ++ni)
                                acc[mi][ni] = __builtin_amdgcn_mfma_f32_32x32x16_bf16(bfv[ni], af[mi], acc[mi][ni], 0, 0, 0);
                        }
                    }
                    asm volatile("s_waitcnt lgkmcnt(0)" ::: "memory");
                    __builtin_amdgcn_s_barrier();
                    asm volatile("" ::: "memory");
                    if (nt < 3) MG2_ISSUE(nt + 1);
                    asm volatile("" ::: "memory");
                    UNROLL for (int mi = 0; mi < 2; ++mi) {
                        const int en = lst[wm * 64 + mi * 32 + fr] - cb * 8;
                        unsigned char* yrow = YB8 + (size_t)en * 1024 + nt * 256 + wn * 64 + 16 * fh;
                        unsigned char* srow = YSC + ((size_t)(en >> 3) * 64 + nt * 16 + wn * 4 + fh) * 8 + (en & 7);
                        UNROLL for (int ni = 0; ni < 2; ++ni) {
                            float m = 0.f;
                            UNROLL for (int i = 0; i < 16; ++i) m = fmaxf(m, fabsf(acc[mi][ni][i]));
                            const unsigned be = max(__float_as_uint(m) >> 23, 7u);
                            const float inv = __uint_as_float((261u - be) << 23);
                            u32x4 w;
                            UNROLL for (int q = 0; q < 4; ++q) {
                                int d = 0;
                                d = __builtin_amdgcn_cvt_pk_fp8_f32(acc[mi][ni][4 * q] * inv, acc[mi][ni][4 * q + 1] * inv, d, false);
                                d = __builtin_amdgcn_cvt_pk_fp8_f32(acc[mi][ni][4 * q + 2] * inv, acc[mi][ni][4 * q + 3] * inv, d, true);
                                if (q == 0) w.x = (unsigned)d; else if (q == 1) w.y = (unsigned)d; else if (q == 2) w.z = (unsigned)d; else w.w = (unsigned)d;
                            }
                            *(u32x4*)(yrow + ni * 32) = w;
                            srow[ni * 16] = (unsigned char)be;
                        }
                    }
                    asm volatile("s_waitcnt vmcnt(8)" ::: "memory");
                }
#undef MG2_ISSUE
            }
        }
        cur ^= 1;
    }
#undef GLDS4
}


#define XB_TMO      128
#define XB_XCNT(j)  (256  + 64 * (j))
#define XB_XSUB(j)  (1280 + 64 * (j))
#define XB_XGEN(j)  (2304 + 64 * (j))
#define XB_TOP      3328
#define XB_TOPGEN   3392
#define XCD_BAR_WORDS 3456
#define XB_SPIN_CAP (1u << 18)
#define LAS __attribute__((address_space(3)))

__device__ __forceinline__ unsigned xb_ld(unsigned* p)              { return __hip_atomic_load(p, __ATOMIC_RELAXED, __HIP_MEMORY_SCOPE_AGENT); }
__device__ __forceinline__ unsigned xb_add(unsigned* p, unsigned v) { return __hip_atomic_fetch_add(p, v, __ATOMIC_RELAXED, __HIP_MEMORY_SCOPE_AGENT); }
__device__ __forceinline__ unsigned xb_xcc_id() { return (unsigned)__builtin_amdgcn_s_getreg((3 << 11) | 20) & 0xFu; }
#define XB_SPIN(cond, bar) do { unsigned _sp = 0; while (cond) { __builtin_amdgcn_s_sleep(1); \
    if ((++_sp & 255u) == 0u) { if (xb_ld(&(bar)[XB_TMO])) break; if (_sp > XB_SPIN_CAP) { atomicAdd(&(bar)[XB_TMO], 1u); break; } } } } while (0)

struct XcdBarrier { unsigned* bar; unsigned x; volatile LAS unsigned* st; };

__device__ __forceinline__ XcdBarrier xcd_barrier_post(unsigned* bar, volatile LAS unsigned* st) {
    XcdBarrier b; b.bar = bar; b.x = xb_xcc_id(); b.st = st;
    if (threadIdx.x == 0) { const unsigned rank = xb_add(&bar[XB_XCNT(b.x)], 1u); st[2] = b.x; st[3] = rank; }
    return b;
}
__device__ __forceinline__ void xcd_barrier_complete(unsigned* bar, unsigned x, unsigned& nloc, unsigned& nx) {
    const unsigned G = gridDim.x * gridDim.y * gridDim.z;
    unsigned sum, cnt, mine, sp = 0u;
    for (;;) {
        sum = 0u; cnt = 0u; mine = 0u;
#pragma unroll
        for (unsigned j = 0; j < 16; ++j) { const unsigned c = xb_ld(&bar[XB_XCNT(j)]); sum += c; cnt += (c > 0u) ? 1u : 0u; mine = (j == x) ? c : mine; }
        if (sum == G) break;
        __builtin_amdgcn_s_sleep(1);
        if ((++sp & 255u) == 0u) { if (xb_ld(&bar[XB_TMO])) break; if (sp > XB_SPIN_CAP) { atomicAdd(&bar[XB_TMO], 1u); break; } }
    }
    nloc = mine > 0u ? mine : 1u; nx = cnt > 0u ? cnt : 1u;
}
__device__ __forceinline__ void xcd_barrier(const XcdBarrier& b) {
    asm volatile("s_waitcnt vmcnt(0)" ::: "memory");
    __syncthreads();
    if (threadIdx.x == 0) {
        unsigned* bar = b.bar;
        __builtin_amdgcn_s_waitcnt(0);
        unsigned nloc = b.st[0], nx = b.st[1];
        if (nloc == 0u) { xcd_barrier_complete(bar, b.x, nloc, nx); b.st[0] = nloc; b.st[1] = nx; }
        const unsigned old = xb_add(&bar[XB_XSUB(b.x)], 1u);
        const unsigned gen = old / nloc;
        if (old + 1u == (gen + 1u) * nloc) {
            __builtin_amdgcn_fence(__ATOMIC_RELEASE, "agent");
            asm volatile("s_waitcnt vmcnt(0)" ::: "memory");
            const unsigned og = xb_add(&bar[XB_TOP], 1u);
            const unsigned tg = og / nx;
            if (og + 1u == (tg + 1u) * nx) xb_add(&bar[XB_TOPGEN], 1u);
            else XB_SPIN(xb_ld(&bar[XB_TOPGEN]) == tg, bar);
            __builtin_amdgcn_fence(__ATOMIC_ACQUIRE, "agent");
            xb_add(&bar[XB_XGEN(b.x)], 1u);
            asm volatile("s_waitcnt vmcnt(0)" ::: "memory");
        } else {
            XB_SPIN(xb_ld(&bar[XB_XGEN(b.x)]) == gen, bar);
            __builtin_amdgcn_fence(__ATOMIC_ACQUIRE, "agent");
            asm volatile("s_waitcnt vmcnt(0)" ::: "memory");
        }
    }
    __syncthreads();
}

enum { PH_MODCONV = 0, PH_HX, PH_GEMM_R, PH_RW_PREP, PH_RW_SCAN, PH_RW_READ, PH_RW_G, PH_GEMM_N, PH_NA_NORM, PH_NA_ATT, PH_GEMM_M, PH_ML_SCAN, PH_ML_READ,
       PH_GEMM_G, PH_MERGE, PH_OUT, PH_NORM2, PH_ROUTER, PH_ROUTE, PH_SHARED, PH_MOE_EXP, PH_MOE_COMB, PH_COUNT };

template <int PH> DEV void run_phase(const Params& p, int L, int sub, char* smem, Topo tp) {
    const int tid = TID(), lane = tid & 63, fr = lane & 31, fh = lane >> 5;
    char* ws = p.ws;
    const int ntl = L == 0 ? NT : NX;
    const bf16_t* HX = (const bf16_t*)(ws + OFF_HX);
    const bf16_t* WINT = (const bf16_t*)(ws + OFF_WINT);
    if constexpr (PH == PH_MODCONV) { ph_mod(p, L, smem); ph_conv_mix(p, L, smem); }
    else if constexpr (PH == PH_HX) { ph_norm(p, L, 0, NT); }
    else if constexpr (PH == PH_GEMM_R || PH == PH_GEMM_M) {
        const int c0 = PH == PH_GEMM_R ? 0 : RW_COLS + NA_COLS;
        const int N = PH == PH_GEMM_R ? RW_COLS : ML_COLS;
        bf16_t* PX = (bf16_t*)(ws + OFF_PX);
        gemm256(HX, NT, WINT + (size_t)c0 * DM, N, DM, smem, tp, [&](int row, int col, const float (&v)[8]) {
            if (col < N) st8(PX + (size_t)row * N + col, v);
        });
    }
    else if constexpr (PH == PH_GEMM_N) {
        bf16_t* PX = (bf16_t*)(ws + OFF_PX); bf16_t* VT = (bf16_t*)(ws + OFF_VT); bf16_t* VTC = (bf16_t*)(ws + OFF_VTC);
        gemm256(HX, NT, WINT + (size_t)RW_COLS * DM, 1024, DM, smem, tp, [&](int row, int col, const float (&v)[8]) { st8(PX + (size_t)row * 1024 + col, v); });
        gemm_phase<4, 2>(HX, DM, NT, WINT + (size_t)(RW_COLS + 1024) * DM, DM, 512, DM, smem, tp, [&](const f32x16 (&acc)[2][2], int row0, int col0) {
            const int h = col0 >> 6;
            epi_cols(acc, smem, [&](int r8, int col, const float (&v)[8]) {
                const int n = row0 + r8;
                bf16_t* dst = n < NX ? VT + ((size_t)((n >> 11) * 8 + h) * 64 + col) * SEQ + (n & 2047)
                                     : VTC + ((size_t)(((n - NX) >> 8) * 8 + h) * 64 + col) * CTXL + ((n - NX) & 255);
                st8(dst, v);
            });
        });
    }
    else if constexpr (PH == PH_RW_PREP) { ph_rw_prep(p, L, smem); }
    else if constexpr (PH == PH_RW_SCAN) { ph_rw_scan(p, L, smem); }
    else if constexpr (PH == PH_RW_READ) { ph_rw_read(p, L, ntl); }
    else if constexpr (PH == PH_RW_G) {
        bf16_t* YA = (bf16_t*)(ws + OFF_YA);
        gemm_phase<4, 2>((const bf16_t*)(ws + OFF_SGB), 128, ntl, (const bf16_t*)(ws + OFF_G2T), 128, 512, 128, smem, tp, [&](const f32x16 (&acc)[2][2], int row0, int col0) {
            epi_rows(acc, smem, [&](int row, int c8, const float (&v)[8]) {
                bf16_t* q = YA + (size_t)(row0 + row) * 512 + col0 + c8;
                float y[8]; ld8(q, y);
                UNROLL for (int i = 0; i < 8; ++i) y[i] *= v[i];
                st8(q, y);
            });
        });
    }
    else if constexpr (PH == PH_NA_NORM) { ph_na_norm(p, L); }
    else if constexpr (PH == PH_NA_ATT) { ph_na_att(p, L, smem); }
    else if constexpr (PH == PH_ML_SCAN) {
        if (blockIdx.x < 128 || gridDim.x <= 128) ph_ml_scan(p, L, smem);
        if (gridDim.x <= 128) ph_conv_moe_gu(p, L, smem, blockIdx.x, gridDim.x);
        else if (blockIdx.x >= 128) ph_conv_moe_gu(p, L, smem, blockIdx.x - 128, gridDim.x - 128);
    }
    else if constexpr (PH == PH_ML_READ) { ph_ml_read(p, L, ntl); }
    else if constexpr (PH == PH_GEMM_G) {
        bf16_t* G = (bf16_t*)(ws + OFF_GATES);
        gemm256(HX, ntl, WINT + (size_t)(RW_COLS + NA_COLS + ML_COLS) * DM, GATE_COLS, DM, smem, tp, [&](int row, int col, const float (&v)[8]) {
            float y[8];
            UNROLL for (int i = 0; i < 8; ++i) y[i] = sigm(v[i]);
            st8(G + (size_t)row * GATE_COLS + col, y);
        });
    }
    else if constexpr (PH == PH_MERGE) {
        const bf16_t* G = (const bf16_t*)(ws + OFF_GATES); bf16_t* MG = (bf16_t*)(ws + OFF_HX);
        _Pragma("unroll 1") for (int br = 0; br < 3; ++br) {
            gemm256((const bf16_t*)(ws + OFF_YA + (size_t)br * SZ_Y1), ntl, (const bf16_t*)(ws + OFF_WBT) + (size_t)br * 1024 * 512, DM, 512, smem, tp, [&](int row, int col, const float (&v)[8]) {
                float g[8], m[8];
                ld8(G + (size_t)row * GATE_COLS + br * DM + col, g);
                bf16_t* q = MG + (size_t)row * DM + col;
                if (br == 0) { UNROLL for (int i = 0; i < 8; ++i) m[i] = g[i] * v[i]; }
                else { ld8(q, m); UNROLL for (int i = 0; i < 8; ++i) m[i] += g[i] * v[i]; }
                st8(q, m);
            });
        }
    }
    else if constexpr (PH == PH_OUT) {
        const float* MOD = (const float*)(ws + OFF_MOD);
        gemm256(HX, ntl, (const bf16_t*)(ws + OFF_WOUTT), DM, DM, smem, tp, [&](int n, int c, const float (&v)[8]) {
            const float* xp = xprev_row(p, L, n) + c; float* xo = xs_row(p, n) + c; const float* g1 = MOD + mod_row(n) * 6144 + 2 * DM + c;
            const float4 xa = *(const float4*)xp, xb = *(const float4*)(xp + 4), ga = *(const float4*)g1, gb = *(const float4*)(g1 + 4);
            float4 oa, ob;
            oa.x = xa.x + ga.x * v[0]; oa.y = xa.y + ga.y * v[1]; oa.z = xa.z + ga.z * v[2]; oa.w = xa.w + ga.w * v[3];
            ob.x = xb.x + gb.x * v[4]; ob.y = xb.y + gb.y * v[5]; ob.z = xb.z + gb.z * v[6]; ob.w = xb.w + gb.w * v[7];
            *(float4*)xo = oa; *(float4*)(xo + 4) = ob;
        });
    }
    else if constexpr (PH == PH_NORM2) {
        if (blockIdx.x == 0 && tid < 384) ((int*)(ws + OFF_MCNT))[tid] = 0;
        ph_norm(p, L, 1, ntl);
    }
    else if constexpr (PH == PH_ROUTER) {
        typedef GC<4, 2> C;
        float* LOG = (float*)(ws + OFF_LOG);
        const bf16_t* H2LO = (const bf16_t*)(ws + OFF_H2LO); const bf16_t* RH = (const bf16_t*)(ws + OFF_RTR); const bf16_t* RL = RH + 64 * 1024;
        const int wave = tid >> 6, wm = wave / 2, wn = wave % 2;
        {
            const int nrt = ntl / C::BM, G = gridDim.x;
            if (G > nrt) { if ((int)blockIdx.x >= nrt) ph_conv_moe(p, L, smem, blockIdx.x - nrt, G - nrt); }
            else ph_conv_moe(p, L, smem, blockIdx.x, G);
        }
        for (int t = blockIdx.x; t < ntl / C::BM; t += gridDim.x) {
            f32x16 acc[2][2]; acc_zero(acc);
            const bf16_t* A0 = HX + (size_t)t * C::BM * DM; const bf16_t* A1 = H2LO + (size_t)t * C::BM * DM;
            gemm_tile<4, 2, 3, false>(acc, [&](int r) { return A0 + (size_t)r * DM; }, RH, DM, 0, 64, DM, smem, nullptr);
            gemm_tile<4, 2, 3, false>(acc, [&](int r) { return A1 + (size_t)r * DM; }, RH, DM, 0, 64, DM, smem, nullptr);
            gemm_tile<4, 2, 3, false>(acc, [&](int r) { return A0 + (size_t)r * DM; }, RL, DM, 0, 64, DM, smem, nullptr);
            epi_rows(acc, smem, [&](int row, int c8, const float (&v)[8]) {
                if (wn == 0) {
                    float* q = LOG + (size_t)(t * C::BM + wm * 64 + row) * 64 + c8;
                    *(float4*)q = make_float4(v[0], v[1], v[2], v[3]); *(float4*)(q + 4) = make_float4(v[4], v[5], v[6], v[7]);
                }
            });
        }
    }
    else if constexpr (PH == PH_ROUTE) { ph_route(p, L, ntl, smem); }
    else if constexpr (PH == PH_SHARED) {
        ph_moe_scatter(p, ntl, smem);
        bf16_t* SA = (bf16_t*)(ws + OFF_SA);
        gemm256_pair(HX, ntl, (const bf16_t*)(ws + OFF_SGUT), 512, DM, smem, tp, [&](int row, int col, const float (&g)[8], const float (&u)[8]) {
            float a[8];
            UNROLL for (int i = 0; i < 8; ++i) a[i] = g[i] * frcp(1.f + __expf(-g[i])) * u[i];
            st8(SA + (size_t)row * 256 + (col >> 8) * 128 + (col & 127), a);
        });
    }
    else if constexpr (PH == PH_MOE_EXP) { const int cb = sub * MOE_CHUNK; ph_moe_exp(p, cb, min(cb + MOE_CHUNK, ntl), smem, tp); }
    else if constexpr (PH == PH_MOE_COMB) {
        const int cb = sub * MOE_CHUNK, ce = min(cb + MOE_CHUNK, ntl);
        const float* MOD = (const float*)(ws + OFF_MOD); const unsigned char* YB8 = (const unsigned char*)(ws + OFF_YBUF); const unsigned char* YSC = (const unsigned char*)(ws + OFF_YSC);
        gemm256((const bf16_t*)(ws + OFF_SA) + (size_t)cb * 256, ce - cb, (const bf16_t*)(ws + OFF_SDT), DM, 256, smem, tp, [&](int rl, int c, const float (&v)[8]) {
            const int n = cb + rl;
            float s[8];
            UNROLL for (int i = 0; i < 8; ++i) s[i] = v[i];
            const u32x2 sc = *(const u32x2*)(YSC + ((size_t)rl * 64 + (c >> 4)) * 8);
            const unsigned long long sc64 = (unsigned long long)sc.x | ((unsigned long long)sc.y << 32);
            _Pragma("unroll 2") for (int k = 0; k < 8; ++k) {
                const u32x2 d = *(const u32x2*)(YB8 + ((size_t)rl * 8 + k) * DM + c);
                const unsigned be = (unsigned)(sc64 >> (8 * k)) & 255u;
                const float scl = __uint_as_float((be - 7u) << 23);
                typedef float f2v __attribute__((ext_vector_type(2)));
                const f2v y0 = __builtin_amdgcn_cvt_pk_f32_fp8((int)d.x, false), y1 = __builtin_amdgcn_cvt_pk_f32_fp8((int)d.x, true);
                const f2v y2 = __builtin_amdgcn_cvt_pk_f32_fp8((int)d.y, false), y3 = __builtin_amdgcn_cvt_pk_f32_fp8((int)d.y, true);
                s[0] += y0.x * scl; s[1] += y0.y * scl; s[2] += y1.x * scl; s[3] += y1.y * scl;
                s[4] += y2.x * scl; s[5] += y2.y * scl; s[6] += y3.x * scl; s[7] += y3.y * scl;
            }
            float* xo = xs_row(p, n) + c; const float* g2 = MOD + mod_row(n) * 6144 + 5 * DM + c;
            float4 xa = *(const float4*)xo, xb = *(const float4*)(xo + 4); const float4 ga = *(const float4*)g2, gb = *(const float4*)(g2 + 4);
            xa.x += ga.x * s[0]; xa.y += ga.y * s[1]; xa.z += ga.z * s[2]; xa.w += ga.w * s[3];
            xb.x += gb.x * s[4]; xb.y += gb.y * s[5]; xb.z += gb.z * s[6]; xb.w += gb.w * s[7];
            *(float4*)xo = xa; *(float4*)(xo + 4) = xb;
        });
    }
}

#ifndef N_LAUNCH_MODE
#define N_LAUNCH_MODE 1
#endif
#if N_LAUNCH_MODE == 0
template <int PH> __global__ void __launch_bounds__(NTHREADS, 2) k_phase(Params p, int L, int sub) {
    extern __shared__ __attribute__((aligned(16))) char smem[];
    run_phase<PH>(p, L, sub, smem, Topo{(int)(blockIdx.x & 7), (int)(blockIdx.x >> 3), (int)((gridDim.x + 7 - (blockIdx.x & 7)) >> 3)});
}
#endif


#ifndef MEGA_SKIP
#define MEGA_SKIP 0ull
#endif
#ifndef MEGA_REPEAT
#define MEGA_REPEAT 0ull
#endif
#define BARRIER() do { XcdBarrier b2_ = bar; unsigned so_ = LDS_BYTES; asm volatile("" : "+v"(so_)); b2_.st = (volatile LAS unsigned*)(smem + so_); xcd_barrier(b2_); } while (0)
#define PHASE(PH, sub) do { if constexpr (!((MEGA_SKIP >> PH) & 1ull)) { run_phase<PH>(p, L, sub, smem, tp); BARRIER(); if constexpr ((MEGA_REPEAT >> PH) & 1ull) { run_phase<PH>(p, L, sub, smem, tp); BARRIER(); } } } while (0)
__global__ void __launch_bounds__(NTHREADS, 2) k_mega(Params p) {
    extern __shared__ __attribute__((aligned(16))) char smem[];
    volatile LAS unsigned* st = (volatile LAS unsigned*)(smem + LDS_BYTES);
    if (threadIdx.x == 0) { st[0] = 0u; st[1] = 0u; st[2] = 0u; st[3] = 0u; }
    __syncthreads();
    const XcdBarrier bar = xcd_barrier_post((unsigned*)(p.ws + OFF_BAR), st);
    Topo tp{(int)(blockIdx.x & 7), (int)(blockIdx.x >> 3), (int)((gridDim.x + 7 - (blockIdx.x & 7)) >> 3)};
    for (int L = 0; L < 2; ++L) {
        const int ntl = L == 0 ? NT : NX;
        PHASE(PH_MODCONV, 0);
        if (st[1] == 8u && st[0] != 0u) { tp.x = (int)st[2]; tp.r = (int)st[3]; tp.n = (int)st[0]; }
        PHASE(PH_HX, 0);
        PHASE(PH_GEMM_R, 0);
        PHASE(PH_RW_PREP, 0);
        PHASE(PH_RW_SCAN, 0);
        PHASE(PH_RW_READ, 0);
        PHASE(PH_RW_G, 0);
        PHASE(PH_GEMM_N, 0);
        PHASE(PH_NA_ATT, 0);
        PHASE(PH_GEMM_M, 0);
        PHASE(PH_ML_SCAN, 0);
        PHASE(PH_ML_READ, 0);
        PHASE(PH_GEMM_G, 0);
        PHASE(PH_MERGE, 0);
        PHASE(PH_OUT, 0);
        PHASE(PH_NORM2, 0);
        PHASE(PH_ROUTER, 0);
        PHASE(PH_ROUTE, 0);
        PHASE(PH_SHARED, 0);
        for (int c = 0; c * MOE_CHUNK < ntl; ++c) {
            PHASE(PH_MOE_EXP, c);
            PHASE(PH_MOE_COMB, c);
        }
    }
}

#if N_LAUNCH_MODE == 0
template <int PH> static void launch_phase(const Params& p, int L, int sub, hipStream_t stream) {
    static bool attr = false;
    if (!attr) { (void)hipFuncSetAttribute((const void*)k_phase<PH>, hipFuncAttributeMaxDynamicSharedMemorySize, LDS_BYTES); attr = true; }
    hipLaunchKernelGGL(k_phase<PH>, dim3(256), dim3(NTHREADS), LDS_BYTES, stream, p, L, sub);
}
#endif

extern "C" void kernel_launch(void* const* d_in, const int* in_sizes, int n_in, void* d_out, int out_size, void* d_ws, size_t ws_size, hipStream_t stream) {
    if (n_in != N_IN || ws_size < WS_END) { fprintf(stderr, "kernel_launch: unexpected inputs (%d) or workspace (%zu < %zu)\n", n_in, ws_size, (size_t)WS_END); return; }
    Params p{};
    for (int i = 0; i < N_IN; ++i) p.in[i] = (const float*)d_in[i];
    p.out = (float*)d_out; p.ws = (char*)d_ws;
#if N_LAUNCH_MODE == 1
    static int grid = 0;
    if (grid == 0) {
        int dev = 0, cus = 0;
        if (hipGetDevice(&dev) != hipSuccess || hipDeviceGetAttribute(&cus, hipDeviceAttributeMultiprocessorCount, dev) != hipSuccess) { grid = -1; return; }
        if (hipFuncSetAttribute((const void*)k_mega, hipFuncAttributeMaxDynamicSharedMemorySize, LDS_BYTES + 256) != hipSuccess) { grid = -1; return; }
        grid = cus;
    }
    if (grid <= 0) return;
    (void)hipMemsetAsync((char*)d_ws + OFF_BAR, 0, XCD_BAR_WORDS * sizeof(unsigned), stream);
    hipLaunchKernelGGL(k_mega, dim3(grid), dim3(NTHREADS), LDS_BYTES + 256, stream, p);
    return;
#endif
#if N_LAUNCH_MODE == 0
    for (int L = 0; L < 2; ++L) {
        const int ntl = L == 0 ? NT : NX;
        launch_phase<PH_MODCONV>(p, L, 0, stream);
        launch_phase<PH_HX>(p, L, 0, stream);
        launch_phase<PH_GEMM_R>(p, L, 0, stream);
        launch_phase<PH_RW_PREP>(p, L, 0, stream);
        launch_phase<PH_RW_SCAN>(p, L, 0, stream);
        launch_phase<PH_RW_READ>(p, L, 0, stream);
        launch_phase<PH_RW_G>(p, L, 0, stream);
        launch_phase<PH_GEMM_N>(p, L, 0, stream);
        launch_phase<PH_NA_ATT>(p, L, 0, stream);
        launch_phase<PH_GEMM_M>(p, L, 0, stream);
        launch_phase<PH_ML_SCAN>(p, L, 0, stream);
        launch_phase<PH_ML_READ>(p, L, 0, stream);
        launch_phase<PH_GEMM_G>(p, L, 0, stream);
        launch_phase<PH_MERGE>(p, L, 0, stream);
        launch_phase<PH_OUT>(p, L, 0, stream);
        launch_phase<PH_NORM2>(p, L, 0, stream);
        launch_phase<PH_ROUTER>(p, L, 0, stream);
        launch_phase<PH_ROUTE>(p, L, 0, stream);
        launch_phase<PH_SHARED>(p, L, 0, stream);
        for (int c = 0; c * MOE_CHUNK < ntl; ++c) {
            launch_phase<PH_MOE_EXP>(p, L, c, stream);
            launch_phase<PH_MOE_COMB>(p, L, c, stream);
        }
    }
#endif
}
```

```cpp
#include <hip/hip_runtime.h>
#include <stdint.h>
#include <stdio.h>

#define DEV __device__ __forceinline__
#define UNROLL _Pragma("unroll")

typedef unsigned short bf16_t;
typedef short bf16x8 __attribute__((ext_vector_type(8)));
typedef float f32x16 __attribute__((ext_vector_type(16)));
typedef float f32x4v __attribute__((ext_vector_type(4)));
typedef unsigned u32x4 __attribute__((ext_vector_type(4)));
typedef unsigned u32x2 __attribute__((ext_vector_type(2)));

constexpr int DM = 1024, NBATCH = 16, SEQ = 2048, CTXL = 256;
constexpr int NX = NBATCH * SEQ, NC = NBATCH * CTXL, NT = NX + NC;
constexpr int RW_COLS = 1920, NA_COLS = 1536, ML_COLS = 1552, GATE_COLS = 3072, IN_COLS = 8080;
constexpr int NTHREADS = 512;
constexpr int MOE_CHUNK = 16384, MOE_ST = 768;

enum { I_X = 0, I_C, I_CTX, I_CCTX, I_WADA, I_BADA, I_N1G, I_N2G, I_WIN, I_MU, I_W0, I_W2, I_A0, I_A2, I_KK, I_KA, I_RK, I_G2,
       I_LNG, I_LNB, I_V0, I_V1, I_V2, I_QNG, I_KNG, I_RPB, I_IB, I_FB, I_MNG, I_WBR, I_WOUT, I_RTR, I_MB, I_MWG, I_MWU, I_MWD,
       I_SG, I_SU, I_SD, N_IN };

constexpr size_t OFF_BAR = 0;
constexpr size_t OFF_MOD = 16384;
constexpr size_t OFF_WINT = OFF_MOD + 417792;
constexpr size_t OFF_WBT = OFF_WINT + (size_t)IN_COLS * 1024 * 2;
constexpr size_t OFF_WOUTT = OFF_WBT + (size_t)3 * 1024 * 512 * 2;
constexpr size_t OFF_SGUT = OFF_WOUTT + (size_t)1024 * 1024 * 2;
constexpr size_t OFF_SDT = OFF_SGUT + (size_t)512 * 1024 * 2;
constexpr size_t OFF_G2T = OFF_SDT + (size_t)1024 * 256 * 2;
constexpr size_t OFF_RTR = OFF_G2T + (size_t)512 * 128 * 2;
constexpr size_t OFF_CTXS = OFF_RTR + (size_t)2 * 64 * 1024 * 2;
constexpr size_t OFF_VF = OFF_CTXS + (size_t)NC * 1024 * 4;
constexpr size_t OFF_HX = OFF_VF + (size_t)NT * 512 * 2;
constexpr size_t OFF_BIG = OFF_HX + (size_t)NT * 1024 * 2;
constexpr size_t SZ_Y1 = (size_t)NT * 512 * 2;
constexpr size_t OFF_YA = OFF_BIG, OFF_YB = OFF_YA + SZ_Y1, OFF_YC = OFF_YB + SZ_Y1;
constexpr size_t OFF_PX = OFF_BIG + 3 * SZ_Y1;
constexpr size_t OFF_SCR = OFF_PX + (size_t)NT * RW_COLS * 2;
constexpr size_t SZ_SCR = (size_t)NT * 1152 * 2;
constexpr size_t OFF_MGU = OFF_SCR + SZ_SCR;
constexpr size_t WS_END = OFF_MGU + (size_t)64 * 256 * 1024 * 2;
constexpr size_t OFF_YS = OFF_YB;
constexpr size_t OFF_SGB = OFF_SCR;
constexpr size_t OFF_CB = OFF_SCR + (size_t)NT * 128 * 2;
constexpr size_t OFF_HS = OFF_SCR;
constexpr size_t OFF_VT = OFF_PX + (size_t)NT * 1024 * 2;
constexpr size_t OFF_VTC = OFF_VT + (size_t)NX * 512 * 2;
constexpr size_t OFF_GATES = OFF_PX;
constexpr size_t OFF_MDT = OFF_BIG;
constexpr size_t OFF_SA = OFF_MDT + (size_t)64 * 1024 * 128 * 2;
constexpr size_t OFF_EIDX = OFF_SA + (size_t)NT * 256 * 2;
constexpr size_t OFF_EW = OFF_EIDX + (size_t)NT * 8 * 4;
constexpr int SORT_CAP = MOE_CHUNK * 8 + 64 * 128;
constexpr size_t OFF_SORT = OFF_EW + (size_t)NT * 8 * 4;
constexpr size_t OFF_LOG = OFF_SORT + (size_t)3 * SORT_CAP * 4;
constexpr size_t OFF_H2LO = OFF_LOG + (size_t)NT * 64 * 4;
constexpr size_t OFF_YBUF = OFF_LOG;
constexpr size_t OFF_YSC = OFF_YBUF + (size_t)MOE_CHUNK * 8 * 1024;
static_assert(OFF_YSC + (size_t)MOE_CHUNK * 512 <= WS_END, "moe layout");
static_assert(OFF_GATES + (size_t)NT * 3072 * 2 <= WS_END, "gates layout");
static_assert(WS_END <= (size_t)536870912, "workspace");

constexpr size_t OFF_MCNT = OFF_BAR + 14336;
constexpr int LDS_BYTES = 155648;

struct Topo { int x, r, n; };
struct Params {
    const float* in[N_IN];
    float* out;
    char* ws;
};

DEV int TID() { int t = threadIdx.x; asm volatile("" : "+v"(t)); return t; }
DEV float bf2f(bf16_t h) { return __uint_as_float(((unsigned)h) << 16); }
typedef __bf16 bf16x2n __attribute__((ext_vector_type(2)));
typedef float f32x2n __attribute__((ext_vector_type(2)));
DEV unsigned pk2(float lo, float hi) { const f32x2n v = {lo, hi}; return __builtin_bit_cast(unsigned, __builtin_convertvector(v, bf16x2n)); }
DEV bf16_t f2bf(float f) { return (bf16_t)(pk2(f, 0.f) & 0xffffu); }
DEV void ld8(const bf16_t* p, float (&o)[8]) {
    const u32x4 v = *(const u32x4*)p;
    o[0] = __uint_as_float(v.x << 16); o[1] = __uint_as_float(v.x & 0xffff0000u);
    o[2] = __uint_as_float(v.y << 16); o[3] = __uint_as_float(v.y & 0xffff0000u);
    o[4] = __uint_as_float(v.z << 16); o[5] = __uint_as_float(v.z & 0xffff0000u);
    o[6] = __uint_as_float(v.w << 16); o[7] = __uint_as_float(v.w & 0xffff0000u);
}
DEV void st8(bf16_t* p, const float (&v)[8]) {
    u32x4 o; o.x = pk2(v[0], v[1]); o.y = pk2(v[2], v[3]); o.z = pk2(v[4], v[5]); o.w = pk2(v[6], v[7]);
    *(u32x4*)p = o;
}
#define DPP_MOV(v, ctrl) __builtin_bit_cast(float, __builtin_amdgcn_update_dpp(0, __builtin_bit_cast(int, (v)), (ctrl), 0xF, 0xF, true))
DEV float sum8(float v) { v += DPP_MOV(v, 0xB1); v += DPP_MOV(v, 0x4E); v += DPP_MOV(v, 0x141); return v; }
DEV float frcp(float x) { return __builtin_amdgcn_rcpf(x); }
DEV float sigm(float x) { return frcp(1.f + __expf(-x)); }
DEV float sigm_acc(float x) { return 1.f / (1.f + expf(-x)); }
DEV float tanh_fast(float x) { return 1.f - 2.f * frcp(1.f + __expf(2.f * x)); }
DEV float softplus_fast(float x) { return fmaxf(x, 0.f) + __logf(1.f + __expf(-fabsf(x))); }
DEV int mod_row(int n) { return n < NX ? (n >> 11) : 16; }
DEV float* xs_row(const Params& p, int n) { return n < NX ? p.out + (size_t)n * DM : (float*)(p.ws + OFF_CTXS) + (size_t)(n - NX) * DM; }
DEV const float* xprev_row(const Params& p, int L, int n) {
    if (L == 0) return n < NX ? p.in[I_X] + (size_t)n * DM : p.in[I_CTX] + (size_t)(n - NX) * DM;
    return xs_row(p, n);
}
DEV void seq_of(int n, int& nb, int& tt, int& T) {
    if (n < NX) { nb = n & ~2047; tt = n & 2047; T = SEQ; } else { const int m = n - NX; nb = NX + (m & ~255); tt = m & 255; T = CTXL; }
}
DEV void shift8(const bf16_t* z, int ld, int nb, int tt, int T, int col0, const float* mu, float (&o)[8]) {
    float c[8], l[8], r[8];
    ld8(z + (size_t)(nb + tt) * ld + col0, c);
    if (tt > 0) ld8(z + (size_t)(nb + tt - 1) * ld + col0, l); else { UNROLL for (int i = 0; i < 8; ++i) l[i] = 0.f; }
    if (tt < T - 1) ld8(z + (size_t)(nb + tt + 1) * ld + col0, r); else { UNROLL for (int i = 0; i < 8; ++i) r[i] = 0.f; }
    UNROLL for (int i = 0; i < 8; ++i) o[i] = c[i] + mu[col0 + i] * (0.5f * (l[i] + r[i]) - c[i]);
}

constexpr int LROW = 144;
template <int WM, int WN> struct GC {
    static constexpr int BM = 64 * WM, BN = 64 * WN;
    static constexpr int AB = BM * 128, BB = BN * 128, STG = AB + BB;
    static constexpr int NA = BM / 64, NBC = BN / 64;
};
DEV void acc_zero(f32x16 (&acc)[2][2]) {
    UNROLL for (int a = 0; a < 2; ++a) UNROLL for (int b = 0; b < 2; ++b) UNROLL for (int r = 0; r < 16; ++r) acc[a][b][r] = 0.f;
}
#define GLDS16(gp, lp) __builtin_amdgcn_global_load_lds((const __attribute__((address_space(1))) void*)(gp), (__attribute__((address_space(3))) void*)(lp), 16, 0, 0)
DEV int p32(int s) { return 16 * ((s >> 2) & 1) + (s & 3) + 4 * (s >> 3); }
struct KLin { DEV size_t operator()(int kt) const { return (size_t)kt * 64; } };
struct NoHook { DEV void operator()(int) const {} };
template <int WM, int WN, int NS, bool A_LDS, bool TR = false, class ARow, class KA = KLin, class KB = KLin, class Hook = NoHook>
DEV void gemm_tile(f32x16 (&acc)[2][2], ARow arow, const bf16_t* Bt, int ldb, int n0, int Nvalid, int K, char* smem, const char* alds, KA koa = KA(), KB kob = KB(), Hook hook = Hook()) {
    typedef GC<WM, WN> C;
    constexpr int LPT = (A_LDS ? 0 : C::NA) + C::NBC;
    const int tid = TID(), lane = tid & 63, wave = tid >> 6, wm = wave / WN, wn = wave % WN;
    const int fr = lane & 31, fh = lane >> 5;
    const int crow = tid >> 3, cch = (tid & 7) ^ ((crow >> 1) & 7);
    const bf16_t* pa[C::NA]; const bf16_t* pb[C::NBC];
    if (!A_LDS) { UNROLL for (int i = 0; i < C::NA; ++i) pa[i] = arow(crow + 64 * i) + cch * 8; }
    UNROLL for (int i = 0; i < C::NBC; ++i) { const int rb = crow + 64 * i, n = min(n0 + (TR ? (rb & ~31) + p32(rb & 31) : rb), Nvalid - 1); pb[i] = Bt + (size_t)n * ldb + cch * 8; }
    const int nk = K >> 6;
#define GT_ISSUE(kt, stg) do { char* sb_ = smem + (stg) * C::STG + tid * 16; \
        if (!A_LDS) { UNROLL for (int i = 0; i < C::NA; ++i) GLDS16(pa[i] + koa(kt), sb_ + i * 8192); } \
        UNROLL for (int i = 0; i < C::NBC; ++i) GLDS16(pb[i] + kob(kt), sb_ + C::AB + i * 8192); } while (0)
    const int sw = (fr >> 1) & 7;
    int offk[4];
    UNROLL for (int ks = 0; ks < 4; ++ks) offk[ks] = ((2 * ks + fh) ^ sw) * 16;
    const int a_base = (wm * 64 + fr) * 128, b_base = (wn * 64 + fr) * 128;
    UNROLL for (int s = 0; s < NS - 1; ++s) if (s < nk) GT_ISSUE(s, s);
    int stg = 0, nstg = NS - 1;
    for (int kt = 0; kt < nk; ++kt) {
        if (NS == 3 && kt + 1 < nk) asm volatile("s_waitcnt vmcnt(%0)" :: "n"(LPT) : "memory");
        else asm volatile("s_waitcnt vmcnt(0)" ::: "memory");
        __builtin_amdgcn_s_barrier();
        asm volatile("" ::: "memory");
        const bool more = kt + NS - 1 < nk;
        const char* As_ = A_LDS ? alds + kt * C::AB : smem + stg * C::STG; const char* Bs_ = smem + stg * C::STG + C::AB;
        char* db_ = smem + nstg * C::STG + tid * 16;
        bf16x8 af[2][2], bfv[2][2];
        UNROLL for (int mi = 0; mi < 2; ++mi) af[0][mi] = *(const bf16x8*)(As_ + a_base + mi * 4096 + offk[0]);
        UNROLL for (int ni = 0; ni < 2; ++ni) bfv[0][ni] = *(const bf16x8*)(Bs_ + b_base + ni * 4096 + offk[0]);
        UNROLL for (int ks = 0; ks < 4; ++ks) {
            const int cur = ks & 1, nxt = cur ^ 1;
            if (ks < 3) {
                UNROLL for (int mi = 0; mi < 2; ++mi) af[nxt][mi] = *(const bf16x8*)(As_ + a_base + mi * 4096 + offk[ks + 1]);
                UNROLL for (int ni = 0; ni < 2; ++ni) bfv[nxt][ni] = *(const bf16x8*)(Bs_ + b_base + ni * 4096 + offk[ks + 1]);
            }
            UNROLL for (int mi = 0; mi < 2; ++mi) UNROLL for (int ni = 0; ni < 2; ++ni)
                acc[mi][ni] = TR ? __builtin_amdgcn_mfma_f32_32x32x16_bf16(bfv[cur][ni], af[cur][mi], acc[mi][ni], 0, 0, 0)
                                 : __builtin_amdgcn_mfma_f32_32x32x16_bf16(af[cur][mi], bfv[cur][ni], acc[mi][ni], 0, 0, 0);
            if (more) {
                UNROLL for (int pc = 0; pc < LPT; ++pc) if (pc * 4 / LPT == ks) {
                    if (!A_LDS && pc < C::NA) GLDS16(pa[pc] + koa(kt + NS - 1), db_ + pc * 8192);
                    else { const int ib = pc - (A_LDS ? 0 : C::NA); GLDS16(pb[ib] + kob(kt + NS - 1), db_ + C::AB + ib * 8192); }
                }
            }
            __builtin_amdgcn_sched_barrier(0);
        }
        hook(kt);
        stg = stg + 1 == NS ? 0 : stg + 1; nstg = nstg + 1 == NS ? 0 : nstg + 1;
    }
    __syncthreads();
#undef GT_ISSUE
}
#define ACC_ROW(mi, r, fh) ((mi) * 32 + ((r) & 3) + 8 * ((r) >> 2) + 4 * (fh))

constexpr int EPI_SLAB = 32 * 68 * 4;
template <class F> DEV void epi_rows(const f32x16 (&acc)[2][2], char* smem, F f) {
    const int lane = TID() & 63, wave = TID() >> 6, fr = lane & 31, fh = lane >> 5;
    float* st = (float*)(smem + wave * EPI_SLAB);
    UNROLL for (int mi = 0; mi < 2; ++mi) {
        UNROLL for (int ni = 0; ni < 2; ++ni) UNROLL for (int r = 0; r < 16; ++r)
            st[((r & 3) + 8 * (r >> 2) + 4 * fh) * 68 + ni * 32 + fr] = acc[mi][ni][r];
        UNROLL for (int it = 0; it < 4; ++it) {
            const int row = it * 8 + (lane >> 3), c8 = (lane & 7) * 8;
            const float4 a = *(const float4*)(st + row * 68 + c8), b = *(const float4*)(st + row * 68 + c8 + 4);
            float v[8] = {a.x, a.y, a.z, a.w, b.x, b.y, b.z, b.w};
            f(mi * 32 + row, c8, v);
        }
    }
    __syncthreads();
}


template <class F> DEV void epi_cols(const f32x16 (&acc)[2][2], char* smem, F f) {
    const int lane = TID() & 63, wave = TID() >> 6, fr = lane & 31, fh = lane >> 5;
    float* st = (float*)(smem + wave * EPI_SLAB);
    UNROLL for (int mi = 0; mi < 2; ++mi) {
        UNROLL for (int ni = 0; ni < 2; ++ni) UNROLL for (int r = 0; r < 16; ++r)
            st[((r & 3) + 8 * (r >> 2) + 4 * fh) * 68 + ni * 32 + fr] = acc[mi][ni][r];
        UNROLL for (int it = 0; it < 4; ++it) {
            float v[8];
            UNROLL for (int i = 0; i < 8; ++i) v[i] = st[(it * 8 + i) * 68 + lane];
            f(mi * 32 + it * 8, lane, v);
        }
    }
    __syncthreads();
}

struct TileOrder {
    int x, nN, cx, total;
    DEV TileOrder(const Topo& tp, int nM, int nN_) { x = tp.x; nN = nN_; cx = nM > x ? (nM - x + 7) >> 3 : 0; total = ((cx + 3) >> 2) * 4 * nN; }
    DEV bool get(int q, int& pm, int& pn) const { const int per = 4 * nN, qi = q / per, rem = q - qi * per, i = 4 * qi + (rem & 3); pn = rem >> 2; pm = x + 8 * i; return i < cx; }
};
template <int WM, int WN, class Epi>
DEV void gemm_phase(const bf16_t* A, int lda, int M, const bf16_t* Bt, int ldb, int N, int K, char* smem, const Topo& tp, Epi epi) {
    typedef GC<WM, WN> C;
    const int nM = M / C::BM, nN = (N + C::BN - 1) / C::BN;
    const int wave = TID() >> 6, wm = wave / WN, wn = wave % WN;
    const TileOrder ord(tp, nM, nN);
    for (int q = tp.r; q < ord.total; q += tp.n) {
        int pm, pn; if (!ord.get(q, pm, pn)) continue;
        f32x16 acc[2][2]; acc_zero(acc);
        const bf16_t* Ab = A + (size_t)pm * C::BM * lda;
        gemm_tile<WM, WN, 3, false>(acc, [&](int r) { return Ab + (size_t)r * lda; }, Bt, ldb, pn * C::BN, N, K, smem, nullptr);
        epi(acc, pm * C::BM + wm * 64, pn * C::BN + wn * 64);
    }
}

namespace pg8 {
#define PG8_LAS __attribute__((address_space(3)))
typedef float f32x4 __attribute__((ext_vector_type(4)));
constexpr int BM = 256, BK = 64, HALF = 128, HTB = HALF * BK * 2  , STAGE_BYTES = 8 * HTB, NXCD = 8, WGM = 8;

__host__ __device__ __forceinline__ int lds_byte(int r, int c) { const int st = (r >> 4) * 2 + (c >> 5), rr = r & 15, cc = c & 31, ob = rr * 64 + cc * 2; return st * 1024 + (ob ^ (((ob >> 9) & 1) << 5)); }
__host__ __device__ __forceinline__ void stage_rc(int b, int& R, int& C) { const int st = b / 1024, sb = b % 1024, swz = sb ^ (((sb >> 9) & 1) << 5); R = (st >> 1) * 16 + swz / 64; C = (st & 1) * 32 + (swz % 64) / 2; }
__host__ __device__ __forceinline__ int perm32(int rho) { const int n = rho >> 4, i = rho & 15; return 8 * (i >> 2) + 4 * n + (i & 3); }

struct Unit { int pm, pn; };
struct Gemm { const bf16_t* A; const bf16_t* Bt; int M, N, K; };
template <class Epi, class Sched, bool ALIGN_EPI = false, bool SP2 = false>
__device__ __forceinline__ void gemm_phase(PG8_LAS unsigned char* lds, const Gemm g, const Sched& S, const Epi& E) {
    const int tid = TID(), wid = __builtin_amdgcn_readfirstlane(tid >> 6), lane = tid & 63, wr = wid >> 2, wc = wid & 3, fr = lane & 15, fq = lane >> 4;
    const int K = g.K, nt = K / BK;
    unsigned voffA[2], voffB[2];
#pragma unroll
    for (int i = 0; i < 2; ++i) { int R, C; stage_rc(tid * 16 + i * 8192, R, C); const int Rb = Epi::PERM ? ((R & ~31) + perm32(R & 31)) : R;
        voffA[i] = (unsigned)(R * K + C) * 2u; voffB[i] = (unsigned)(Rb * K + C) * 2u; }
    const size_t kstep = (size_t)(BK * 2);
    const size_t hstep = (size_t)HALF * K * 2;
    const size_t tstep = 2 * hstep;
    const unsigned ldsw = (unsigned)wid * 1024u;
    const int aoff = lds_byte(wr * 64 + fr, fq * 8), boff = lds_byte(wc * 32 + fr, fq * 8);
#define PG8_SA(b, h) (((b) * 2 + (h)) * HTB)
#define PG8_SB(b, h) ((4 + (b) * 2 + (h)) * HTB)
#define PG8_STAGE(bufoff, gbase, voff) do { _Pragma("unroll") for (int _i = 0; _i < 2; ++_i) \
        __builtin_amdgcn_global_load_lds((const unsigned*)((const char*)(gbase) + (voff)[_i]), (PG8_LAS unsigned*)(lds + (bufoff) + ldsw + _i * 8192), 16, 0, 0); } while (0)
#define PG8_LDA(dst, b, h) do { _Pragma("unroll") for (int m = 0; m < 4; ++m) _Pragma("unroll") for (int k = 0; k < 2; ++k) dst[m][k] = *(const PG8_LAS bf16x8*)(lds + PG8_SA(b, h) + aoff + m * 2048 + k * 1024); } while (0)
#define PG8_LDB(dst, b, h) do { _Pragma("unroll") for (int n = 0; n < 2; ++n) _Pragma("unroll") for (int k = 0; k < 2; ++k) dst[n][k] = *(const PG8_LAS bf16x8*)(lds + PG8_SB(b, h) + boff + n * 2048 + k * 1024); } while (0)
#define PG8_MMA(ai, bj, At, Bt) do { __builtin_amdgcn_s_setprio(1); _Pragma("unroll") for (int m = 0; m < 4; ++m) _Pragma("unroll") for (int n = 0; n < 2; ++n) _Pragma("unroll") for (int k = 0; k < 2; ++k) \
        acc[ai][bj][m][n] = __builtin_amdgcn_mfma_f32_16x16x32_bf16(Bt[n][k], At[m][k], acc[ai][bj][m][n], 0, 0, 0); __builtin_amdgcn_s_setprio(0); } while (0)
#define PG8_WAIT_V(n) asm volatile("s_waitcnt vmcnt(" #n ")" ::: "memory")
#define PG8_WAIT_L(n) asm volatile("s_waitcnt lgkmcnt(" #n ")" ::: "memory")
#define PG8_BAR __builtin_amdgcn_s_barrier()
#define PG8_SCHED __builtin_amdgcn_sched_barrier(0)
    Unit cur, nxt; int ui = 0;
    if (!S.next(0, cur)) return;
    f32x4 acc[2][2][4][2];
#pragma unroll
    for (int a = 0; a < 2; ++a)
#pragma unroll
        for (int b = 0; b < 2; ++b)
#pragma unroll
            for (int m = 0; m < 4; ++m)
#pragma unroll
                for (int n = 0; n < 2; ++n) acc[a][b][m][n] = (f32x4){0.f, 0.f, 0.f, 0.f};
    bf16x8 At[4][2], B0[2][2], B1[2][2];
    const char* cA = (const char*)g.A + (size_t)cur.pm * tstep; const char* cB = (const char*)g.Bt + (size_t)cur.pn * tstep;
    S.a_ready(cur);
    if constexpr (SP2) {
        PG8_STAGE(PG8_SB(0, 0), cB, voffB); PG8_STAGE(PG8_SB(0, 1), cB + hstep, voffB); PG8_STAGE(PG8_SA(0, 0), cA, voffA); PG8_STAGE(PG8_SA(0, 1), cA + hstep, voffA);
        if (wr == 1) PG8_BAR;
        PG8_WAIT_V(2); PG8_BAR;
        PG8_STAGE(PG8_SB(1, 0), cB + kstep, voffB); PG8_STAGE(PG8_SA(1, 0), cA + kstep, voffA); PG8_STAGE(PG8_SB(1, 1), cB + hstep + kstep, voffB);
        PG8_WAIT_V(6); PG8_BAR;
    } else {
        PG8_STAGE(PG8_SB(0, 0), cB, voffB); PG8_STAGE(PG8_SA(0, 0), cA, voffA); PG8_STAGE(PG8_SB(0, 1), cB + hstep, voffB); PG8_STAGE(PG8_SA(0, 1), cA + hstep, voffA);
        if (wr == 1) PG8_BAR;
        PG8_WAIT_V(4); PG8_BAR;
        PG8_STAGE(PG8_SB(1, 0), cB + kstep, voffB); PG8_STAGE(PG8_SA(1, 0), cA + kstep, voffA); PG8_STAGE(PG8_SB(1, 1), cB + hstep + kstep, voffB);
        PG8_WAIT_V(6); PG8_BAR;
    }
    for (;;) {
        const bool has_next = S.next(ui + 1, nxt);
        const char* nA = has_next ? (const char*)g.A + (size_t)nxt.pm * tstep : cA; const char* nB = has_next ? (const char*)g.Bt + (size_t)nxt.pn * tstep : cB;
        for (int t = 0; t < nt; t += 2) {
            const bool last = (t == nt - 2);
            const char* a1 = cA + (size_t)(t + 1) * kstep;
            const char* a2 = last ? nA : cA + (size_t)(t + 2) * kstep; const char* b2 = last ? nB : cB + (size_t)(t + 2) * kstep;
            const char* a3 = a2 + kstep; const char* b3 = b2 + kstep;
            if (last && has_next) S.a_ready(nxt);
            if constexpr (SP2) {
            PG8_LDB(B0, 0, 0); PG8_LDB(B1, 0, 1); PG8_SCHED; PG8_LDA(At, 0, 0); PG8_STAGE(PG8_SA(1, 1), a1 + hstep, voffA);
            PG8_WAIT_V(8); PG8_WAIT_L(0); PG8_BAR; PG8_MMA(0, 0, At, B0); PG8_MMA(0, 1, At, B1); PG8_BAR; PG8_SCHED;
            PG8_LDA(At, 0, 1); PG8_STAGE(PG8_SB(0, 0), b2, voffB); PG8_STAGE(PG8_SB(0, 1), b2 + hstep, voffB); PG8_STAGE(PG8_SA(0, 0), a2, voffA);
            PG8_WAIT_V(8); PG8_WAIT_L(0); PG8_BAR; PG8_MMA(1, 0, At, B0); PG8_MMA(1, 1, At, B1); PG8_BAR; PG8_SCHED;
            PG8_LDB(B0, 1, 0); PG8_LDB(B1, 1, 1); PG8_SCHED; PG8_LDA(At, 1, 0); PG8_STAGE(PG8_SA(0, 1), a2 + hstep, voffA);
            PG8_WAIT_V(8); PG8_WAIT_L(0); PG8_BAR; PG8_MMA(0, 0, At, B0); PG8_MMA(0, 1, At, B1); PG8_BAR; PG8_SCHED;
            PG8_LDA(At, 1, 1); PG8_STAGE(PG8_SB(1, 0), b3, voffB); PG8_STAGE(PG8_SB(1, 1), b3 + hstep, voffB); PG8_STAGE(PG8_SA(1, 0), a3, voffA);
            PG8_WAIT_V(8); PG8_WAIT_L(0); PG8_BAR; PG8_MMA(1, 0, At, B0); PG8_MMA(1, 1, At, B1); PG8_BAR; PG8_SCHED;
            } else {
            PG8_LDB(B0, 0, 0); PG8_SCHED; PG8_LDA(At, 0, 0); PG8_STAGE(PG8_SA(1, 1), a1 + hstep, voffA);
            PG8_WAIT_L(8); PG8_BAR; PG8_WAIT_L(0); PG8_MMA(0, 0, At, B0); PG8_BAR; PG8_SCHED;
            PG8_LDB(B1, 0, 1); PG8_STAGE(PG8_SB(0, 0), b2, voffB);
            PG8_BAR; PG8_WAIT_L(0); PG8_MMA(0, 1, At, B1); PG8_BAR;
            PG8_LDA(At, 0, 1); PG8_STAGE(PG8_SA(0, 0), a2, voffA);
            PG8_BAR; PG8_WAIT_L(0); PG8_MMA(1, 0, At, B0); PG8_BAR; PG8_SCHED;
            PG8_STAGE(PG8_SB(0, 1), b2 + hstep, voffB);
            PG8_WAIT_V(6); PG8_BAR; PG8_MMA(1, 1, At, B1); PG8_BAR;
            PG8_LDB(B0, 1, 0); PG8_SCHED; PG8_LDA(At, 1, 0); PG8_STAGE(PG8_SA(0, 1), a2 + hstep, voffA);
            PG8_WAIT_L(8); PG8_BAR; PG8_WAIT_L(0); PG8_MMA(0, 0, At, B0); PG8_BAR; PG8_SCHED;
            PG8_LDB(B1, 1, 1); PG8_STAGE(PG8_SB(1, 0), b3, voffB);
            PG8_BAR; PG8_WAIT_L(0); PG8_MMA(0, 1, At, B1); PG8_BAR;
            PG8_LDA(At, 1, 1); PG8_STAGE(PG8_SA(1, 0), a3, voffA);
            PG8_BAR; PG8_WAIT_L(0); PG8_MMA(1, 0, At, B0); PG8_BAR; PG8_SCHED;
            PG8_STAGE(PG8_SB(1, 1), b3 + hstep, voffB);
            PG8_WAIT_V(6); PG8_BAR; PG8_MMA(1, 1, At, B1); PG8_BAR;
            }
        }
        if constexpr (ALIGN_EPI) { if (wr == 0) PG8_BAR; }
        if constexpr (!Epi::AFTER_DRAIN) { E(acc, cur, wr, wc, fr, fq); S.done(cur); }
        if (!has_next) break;
#pragma unroll
        for (int a = 0; a < 2; ++a)
#pragma unroll
            for (int b = 0; b < 2; ++b)
#pragma unroll
                for (int m = 0; m < 4; ++m)
#pragma unroll
                    for (int n = 0; n < 2; ++n) acc[a][b][m][n] = (f32x4){0.f, 0.f, 0.f, 0.f};
        cur = nxt; cA = nA; cB = nB; ++ui;
        if constexpr (ALIGN_EPI) { if (wr == 1) PG8_BAR; }
    }
    PG8_WAIT_V(0);
    if constexpr (!ALIGN_EPI) { if (wr == 0) PG8_BAR; }
    PG8_BAR;
    if constexpr (Epi::AFTER_DRAIN) { E.fused(acc, cur, wr, wc, fr, fq, lds, wid, lane); S.done(cur); }
#undef PG8_SA
#undef PG8_SB
#undef PG8_STAGE
#undef PG8_LDA
#undef PG8_LDB
#undef PG8_MMA
#undef PG8_WAIT_V
#undef PG8_WAIT_L
#undef PG8_BAR
#undef PG8_SCHED
}
}
template <class F> struct EpiF {
    static constexpr bool PERM = true, AFTER_DRAIN = false; F f;
    DEV void operator()(const pg8::f32x4 (&acc)[2][2][4][2], const pg8::Unit& u, int wr, int wc, int fr, int fq) const {
        UNROLL for (int ai = 0; ai < 2; ++ai) UNROLL for (int m = 0; m < 4; ++m) {
            const int row = u.pm * 256 + ai * 128 + wr * 64 + m * 16 + fr;
            UNROLL for (int bj = 0; bj < 2; ++bj) {
                const int col = u.pn * 256 + bj * 128 + wc * 32 + 8 * fq;
                const float v[8] = {acc[ai][bj][m][0][0], acc[ai][bj][m][0][1], acc[ai][bj][m][0][2], acc[ai][bj][m][0][3],
                                    acc[ai][bj][m][1][0], acc[ai][bj][m][1][1], acc[ai][bj][m][1][2], acc[ai][bj][m][1][3]};
                f(row, col, v);
            }
        }
    }
};
template <class F> struct EpiF2 {
    static constexpr bool PERM = true, AFTER_DRAIN = false; F f;
    DEV void operator()(const pg8::f32x4 (&acc)[2][2][4][2], const pg8::Unit& u, int wr, int wc, int fr, int fq) const {
        UNROLL for (int ai = 0; ai < 2; ++ai) UNROLL for (int m = 0; m < 4; ++m) {
            const int row = u.pm * 256 + ai * 128 + wr * 64 + m * 16 + fr, col = u.pn * 256 + wc * 32 + 8 * fq;
            const float v0[8] = {acc[ai][0][m][0][0], acc[ai][0][m][0][1], acc[ai][0][m][0][2], acc[ai][0][m][0][3], acc[ai][0][m][1][0], acc[ai][0][m][1][1], acc[ai][0][m][1][2], acc[ai][0][m][1][3]};
            const float v1[8] = {acc[ai][1][m][0][0], acc[ai][1][m][0][1], acc[ai][1][m][0][2], acc[ai][1][m][0][3], acc[ai][1][m][1][0], acc[ai][1][m][1][1], acc[ai][1][m][1][2], acc[ai][1][m][1][3]};
            f(row, col, v0, v1);
        }
    }
};
struct XOrder {
    int x, r, n, nN, cx, fullq, total;
    DEV XOrder(const Topo& tp, int nM, int nN_) { x = tp.x; r = tp.r; n = tp.n; nN = nN_; cx = nM > x ? (nM - x + 7) >> 3 : 0; fullq = cx >> 2; total = cx * nN; }
    DEV bool next(int i, pg8::Unit& u) const {
        const int q = r + i * n; if (q >= total) return false;
        const int per = 4 * nN;
        if (q < fullq * per) { const int qi = q / per, rem = q - qi * per; u.pn = rem >> 2; u.pm = x + 8 * (4 * qi + (rem & 3)); }
        else { const int rem = q - fullq * per, cq = cx - 4 * fullq; u.pn = rem / cq; u.pm = x + 8 * (4 * fullq + rem % cq); }
        return true;
    }
    DEV void a_ready(const pg8::Unit&) const {}
    DEV void done(const pg8::Unit&) const {}
};
template <class F> DEV void gemm256_pair(const bf16_t* A, int M, const bf16_t* Bt, int N, int K, char* smem, const Topo& tp, F f) {
    const pg8::Gemm g{A, Bt, M, N, K};
    const XOrder S(tp, M / 256, (N + 255) / 256);
    const EpiF2<F> E{f};
    pg8::gemm_phase<EpiF2<F>, XOrder, true, true>((PG8_LAS unsigned char*)smem, g, S, E);
}
template <class F> DEV void gemm256(const bf16_t* A, int M, const bf16_t* Bt, int N, int K, char* smem, const Topo& tp, F f) {
    const pg8::Gemm g{A, Bt, M, N, K};
    const XOrder S(tp, M / 256, (N + 255) / 256);
    const EpiF<F> E{f};
    pg8::gemm_phase<EpiF<F>, XOrder, true, true>((PG8_LAS unsigned char*)smem, g, S, E);
}

DEV void ph_mod(const Params& p, int L, char* smem) {
    const int tid = TID();
    float* sc = (float*)smem;
    float* red = sc + 17 * 1024;
    const float* c = p.in[I_C]; const float* cc = p.in[I_CCTX];
    for (int i = tid; i < 17 * 1024; i += NTHREADS) { const float v = i < 16 * 1024 ? c[i] : cc[i - 16 * 1024]; sc[i] = v / (1.f + expf(-v)); }
    __syncthreads();
    const float* W = p.in[I_WADA] + (size_t)L * 1024 * 6144; const float* bA = p.in[I_BADA] + (size_t)L * 6144;
    float* MOD = (float*)(p.ws + OFF_MOD);
    for (int u = blockIdx.x; u < 192; u += gridDim.x) {
        const int ci = tid & 31, ks = tid >> 5, j = u * 32 + ci;
        float acc[17];
        UNROLL for (int r = 0; r < 17; ++r) acc[r] = 0.f;
        for (int k = ks * 64; k < ks * 64 + 64; ++k) {
            const float w = W[(size_t)k * 6144 + j];
            UNROLL for (int r = 0; r < 17; ++r) acc[r] += sc[r * 1024 + k] * w;
        }
        UNROLL for (int r = 0; r < 17; ++r) red[(ks * 17 + r) * 32 + ci] = acc[r];
        __syncthreads();
        for (int i = tid; i < 17 * 32; i += NTHREADS) {
            const int r = i >> 5, c2 = i & 31; float s = bA[u * 32 + c2];
            for (int k2 = 0; k2 < 16; ++k2) s += red[(k2 * 17 + r) * 32 + c2];
            MOD[r * 6144 + u * 32 + c2] = s;
        }
        __syncthreads();
    }
}
DEV void conv_job(const float* s0, const float* s1, bf16_t* d, int K, int N, int mode, int nmat, size_t sstride, size_t dstride, char* smem, int bid = -1, int nb = 0) {
    if (bid < 0) { bid = blockIdx.x; nb = gridDim.x; }
    float* tile = (float*)smem;
    const int tid = TID();
    const int tK = K / 64, tN = (mode == 1 || mode == 3) ? (2 * N) / 64 : (N + 63) / 64, per = tK * tN, total = per * nmat;
    for (int t0 = bid * 4; t0 < total; t0 += nb * 4) {
        float4 v[4][2];
        UNROLL for (int q = 0; q < 4; ++q) {
            const int t = min(t0 + q, total - 1), mat = t / per, r = t - mat * per, tk = r / tN, tn = r - tk * tN;
            const float* a0 = s0 + (size_t)mat * sstride; const float* a1 = s1 ? s1 + (size_t)mat * sstride : nullptr;
            const int c4 = (tid & 15) * 4;
            const float* src; int col;
            if (mode == 1) { src = (c4 >> 5) ? a1 : a0; col = tn * 32 + (c4 & 31); }
            else if (mode == 3) { src = ((tn >> 1) & 1) ? a1 : a0; col = (tn >> 2) * 128 + (tn & 1) * 64 + c4; }
            else { src = a0; col = tn * 64 + c4; }
            const bool ok = col < N;
            UNROLL for (int i = 0; i < 2; ++i) {
                const int k = (tid >> 4) + 32 * i;
                v[q][i] = ok ? *(const float4*)(src + (size_t)(tk * 64 + k) * N + col) : make_float4(0.f, 0.f, 0.f, 0.f);
            }
        }
        UNROLL for (int q = 0; q < 4; ++q) UNROLL for (int i = 0; i < 2; ++i) {
            float* w = tile + q * 4160 + ((tid >> 4) + 32 * i) * 65 + (tid & 15) * 4;
            w[0] = v[q][i].x; w[1] = v[q][i].y; w[2] = v[q][i].z; w[3] = v[q][i].w;
        }
        __syncthreads();
        UNROLL for (int q = 0; q < 4; ++q) if (t0 + q < total) {
            const int t = t0 + q, mat = t / per, r = t - mat * per, tk = r / tN, tn = r - tk * tN;
            bf16_t* dd = d + (size_t)mat * dstride;
            const int cc = tid >> 3, k8 = (tid & 7) * 8, row = tn * 64 + cc;
            float x[8];
            UNROLL for (int i = 0; i < 8; ++i) x[i] = tile[q * 4160 + (k8 + i) * 65 + cc];
            if (mode == 1 || mode == 3 || row < N) {
                st8(dd + (size_t)row * K + tk * 64 + k8, x);
                if (mode == 2) { float lo[8]; UNROLL for (int i = 0; i < 8; ++i) lo[i] = x[i] - bf2f(f2bf(x[i])); st8(dd + (size_t)N * K + (size_t)row * K + tk * 64 + k8, lo); }
            }
        }
        __syncthreads();
    }
}
DEV void ph_conv_mix(const Params& p, int L, char* smem) {
    char* ws = p.ws;
    conv_job(p.in[I_WIN] + (size_t)L * 1024 * IN_COLS, nullptr, (bf16_t*)(ws + OFF_WINT), 1024, IN_COLS, 0, 1, 0, 0, smem);
    conv_job(p.in[I_WBR] + (size_t)L * 3 * 512 * 1024, nullptr, (bf16_t*)(ws + OFF_WBT), 512, 1024, 0, 3, (size_t)512 * 1024, (size_t)512 * 1024, smem);
    conv_job(p.in[I_WOUT] + (size_t)L * 1024 * 1024, nullptr, (bf16_t*)(ws + OFF_WOUTT), 1024, 1024, 0, 1, 0, 0, smem);
    conv_job(p.in[I_SG] + (size_t)L * 1024 * 256, p.in[I_SU] + (size_t)L * 1024 * 256, (bf16_t*)(ws + OFF_SGUT), 1024, 256, 3, 1, 0, 0, smem);
    conv_job(p.in[I_SD] + (size_t)L * 256 * 1024, nullptr, (bf16_t*)(ws + OFF_SDT), 256, 1024, 0, 1, 0, 0, smem);
    conv_job(p.in[I_G2] + (size_t)L * 128 * 512, nullptr, (bf16_t*)(ws + OFF_G2T), 128, 512, 0, 1, 0, 0, smem);
    conv_job(p.in[I_RTR] + (size_t)L * 1024 * 64, nullptr, (bf16_t*)(ws + OFF_RTR), 1024, 64, 2, 1, 0, 0, smem);
}
DEV void ph_conv_moe_gu(const Params& p, int L, char* smem, int bid, int nb) {
    const size_t eo = (size_t)L * 64 * 1024 * 128;
    conv_job(p.in[I_MWG] + eo, p.in[I_MWU] + eo, (bf16_t*)(p.ws + OFF_MGU), 1024, 128, 1, 64, (size_t)1024 * 128, (size_t)256 * 1024, smem, bid, nb);
}
DEV void ph_conv_moe(const Params& p, int L, char* smem, int bid, int nb) {
    const size_t eo = (size_t)L * 64 * 1024 * 128;
    conv_job(p.in[I_MWD] + eo, nullptr, (bf16_t*)(p.ws + OFF_MDT), 128, 1024, 0, 64, (size_t)128 * 1024, (size_t)1024 * 128, smem, bid, nb);
}

DEV void ph_norm(const Params& p, int L, int which, int ntok) {
    const int lane = TID() & 63, wave = TID() >> 6;
    const float* MOD = (const float*)(p.ws + OFF_MOD);
    const float* g = p.in[which ? I_N2G : I_N1G] + (size_t)L * DM;
    bf16_t* H = (bf16_t*)(p.ws + OFF_HX); bf16_t* HLO = (bf16_t*)(p.ws + OFF_H2LO);
    for (int n0 = blockIdx.x * 8; n0 < ntok; n0 += gridDim.x * 8) {
        const int n = n0 + wave;
        const float* xr = which ? xs_row(p, n) : xprev_row(p, L, n);
        float4 v[4]; float ss = 0.f;
        UNROLL for (int i = 0; i < 4; ++i) { v[i] = *(const float4*)(xr + i * 256 + lane * 4); ss += v[i].x * v[i].x + v[i].y * v[i].y + v[i].z * v[i].z + v[i].w * v[i].w; }
        UNROLL for (int o = 1; o < 64; o <<= 1) ss += __shfl_xor(ss, o);
        const float rstd = rsqrtf(ss * (1.f / DM) + 1e-6f);
        const float* sh = MOD + mod_row(n) * 6144 + (which ? 3 : 0) * DM; const float* sc = sh + DM;
        UNROLL for (int i = 0; i < 4; ++i) {
            const int c = i * 256 + lane * 4;
            const float4 gg = *(const float4*)(g + c), s1 = *(const float4*)(sc + c), s0 = *(const float4*)(sh + c);
            const float h0 = v[i].x * rstd * gg.x * (1.f + s1.x) + s0.x, h1 = v[i].y * rstd * gg.y * (1.f + s1.y) + s0.y;
            const float h2 = v[i].z * rstd * gg.z * (1.f + s1.z) + s0.z, h3 = v[i].w * rstd * gg.w * (1.f + s1.w) + s0.w;
            u32x2 o; o.x = pk2(h0, h1); o.y = pk2(h2, h3);
            *(u32x2*)(H + (size_t)n * DM + c) = o;
            if (which) {
                u32x2 o2;
                o2.x = pk2(h0 - bf2f((bf16_t)(o.x & 0xffff)), h1 - bf2f((bf16_t)(o.x >> 16)));
                o2.y = pk2(h2 - bf2f((bf16_t)(o.y & 0xffff)), h3 - bf2f((bf16_t)(o.y >> 16)));
                *(u32x2*)(HLO + (size_t)n * DM + c) = o2;
            }
        }
    }
}

DEV void ph_rw_prep(const Params& p, int L, char* smem) {
    const int lane = TID() & 63, wave = TID() >> 6;
    float* vsh = (float*)smem + wave * 512;
    const bf16_t* PXR = (const bf16_t*)(p.ws + OFF_PX); bf16_t* VF = (bf16_t*)(p.ws + OFF_VF);
    const float* mu = p.in[I_MU] + (size_t)L * RW_COLS;
    const float* v0 = p.in[I_V0]; const float* v1 = p.in[I_V1]; const float* v2 = p.in[I_V2];
    for (int n0 = blockIdx.x * 8; n0 < NT; n0 += gridDim.x * 8) {
        const int n = n0 + wave; int nb, tt, T; seq_of(n, nb, tt, T);
        float vs[8]; shift8(PXR, RW_COLS, nb, tt, T, 1024 + lane * 8, mu, vs);
        if (L == 0) { st8(VF + (size_t)n * 512 + lane * 8, vs); }
        else {
            UNROLL for (int i = 0; i < 8; ++i) vsh[lane * 8 + i] = vs[i];
            __syncthreads();
            const int q = lane & 31, hf = lane >> 5; float t1 = 0.f;
            for (int jj = 0; jj < 256; ++jj) t1 += vsh[hf * 256 + jj] * v1[(hf * 256 + jj) * 32 + q];
            t1 += __shfl_xor(t1, 32);
            float u[8];
            UNROLL for (int i = 0; i < 8; ++i) u[i] = v0[lane * 8 + i];
            for (int q2 = 0; q2 < 32; ++q2) { const float tq = __shfl(t1, q2); UNROLL for (int i = 0; i < 8; ++i) u[i] += tq * v2[q2 * 512 + lane * 8 + i]; }
            float vf[8], o[8]; ld8(VF + (size_t)n * 512 + lane * 8, vf);
            UNROLL for (int i = 0; i < 8; ++i) o[i] = vs[i] + (vf[i] - vs[i]) * sigm(u[i]);
            st8(VF + (size_t)n * 512 + lane * 8, o);
            __syncthreads();
        }
    }
}

DEV bf16x8 pk_lohi(u32x2 lo, u32x2 hi) { u32x4 w; w.x = lo.x; w.y = lo.y; w.z = hi.x; w.w = hi.y; return __builtin_bit_cast(bf16x8, w); }
DEV bf16x8 pk_acc2(const f32x4v& a, const f32x4v& b) { u32x4 w; w.x = pk2(a[0], a[1]); w.y = pk2(a[2], a[3]); w.z = pk2(b[0], b[1]); w.w = pk2(b[2], b[3]); return __builtin_bit_cast(bf16x8, w); }
DEV bf16x8 pk_acc1(const f32x4v& a) { u32x4 w; w.x = pk2(a[0], a[1]); w.y = pk2(a[2], a[3]); w.z = 0u; w.w = 0u; return __builtin_bit_cast(bf16x8, w); }
#define MFMA16(a, b, c) __builtin_amdgcn_mfma_f32_16x16x32_bf16((a), (b), (c), 0, 0, 0)
struct Raw3 { u32x4 l, c, r; };
DEV Raw3 rw_raw(const bf16_t* z, int ld, int nb, int tt, int T, int col0) {
    Raw3 o;
    o.c = *(const u32x4*)(z + (size_t)(nb + tt) * ld + col0);
    o.l = *(const u32x4*)(z + (size_t)(nb + max(tt - 1, 0)) * ld + col0);
    o.r = *(const u32x4*)(z + (size_t)(nb + min(tt + 1, T - 1)) * ld + col0);
    return o;
}
DEV void unpack8(u32x4 v, float (&o)[8]) {
    o[0] = __uint_as_float(v.x << 16); o[1] = __uint_as_float(v.x & 0xffff0000u); o[2] = __uint_as_float(v.y << 16); o[3] = __uint_as_float(v.y & 0xffff0000u);
    o[4] = __uint_as_float(v.z << 16); o[5] = __uint_as_float(v.z & 0xffff0000u); o[6] = __uint_as_float(v.w << 16); o[7] = __uint_as_float(v.w & 0xffff0000u);
}
DEV void shift_from_raw(const Raw3& w, int tt, int T, const float* mu8, float (&o)[8]) {
    float c[8], l[8], r[8]; unpack8(w.c, c); unpack8(w.l, l); unpack8(w.r, r);
    const float ml = tt > 0 ? 0.5f : 0.f, mr = tt < T - 1 ? 0.5f : 0.f;
    UNROLL for (int i = 0; i < 8; ++i) o[i] = c[i] + mu8[i] * (ml * l[i] + mr * r[i] - c[i]);
}
DEV void ph_rw_scan(const Params& p, int L, char* smem) {
    const int tid = TID();
    const int wave = __builtin_amdgcn_readfirstlane(tid >> 6);
    char* AT = smem; char* BT = smem + 9216; char* KT = smem + 18432; char* RT = smem + 27648;
    char* BH = smem + 36864; char* KH = smem + 46080; char* VT = smem + 55296;
    char* W2T = smem + 64512; char* A2T = smem + 73728;
    float* PCv = (float*)(smem + 82944); float* SEGT = PCv + 64;
    char* XY = smem + 85248;
    char* T1 = XY; char* T2 = XY + 9216; float* WLf = (float*)(XY + 18432); float* ALf = (float*)(XY + 35840); float* LW = (float*)XY;
    float* TOT = (float*)(XY + 62720);
    float* PAR = (float*)(XY + 60416);
    char* NAB = XY; char* NAK = XY + 9216; char* NRB = XY + 18432; char* NRK = XY + 27648; char* TJ = XY + 36864; float* NDF = (float*)(XY + 38912); float* YO = (float*)(XY + 43008);
    const bf16_t* PXR = (const bf16_t*)(p.ws + OFF_PX); const bf16_t* VF = (const bf16_t*)(p.ws + OFF_VF);
    bf16_t* YS = (bf16_t*)(p.ws + OFF_YS); float* CB = (float*)(p.ws + OFF_CB);
    const float* mu = p.in[I_MU] + (size_t)L * RW_COLS;
    const float* w0 = p.in[I_W0] + (size_t)L * 1024; const float* w2 = p.in[I_W2] + (size_t)L * 65536;
    const float* a0 = p.in[I_A0] + (size_t)L * 1024; const float* a2 = p.in[I_A2] + (size_t)L * 65536;
    const float* kkw = p.in[I_KK] + (size_t)L * 512; const float* kaw = p.in[I_KA] + (size_t)L * 512; const float* rkw = p.in[I_RK] + (size_t)L * 512;
    for (int u = blockIdx.x; u < 256; u += gridDim.x) {
        const int b = u >> 4, h = (u >> 1) & 7, d = u & 1;
        for (int i = tid; i < 4096; i += NTHREADS) {
            const int l = i >> 6, n = i & 63;
            *(bf16_t*)(W2T + n * LROW + l * 2) = f2bf(w2[(size_t)(d * 64 + l) * 512 + h * 64 + n]);
            *(bf16_t*)(A2T + n * LROW + l * 2) = f2bf(a2[(size_t)(d * 64 + l) * 512 + h * 64 + n]);
        }
        if (tid < 64) {
            const int n = tid;
            PAR[n] = w0[d * 512 + h * 64 + n]; PAR[64 + n] = a0[d * 512 + h * 64 + n];
            PAR[128 + n] = kkw[h * 64 + n]; PAR[192 + n] = kaw[h * 64 + n]; PAR[256 + n] = rkw[h * 64 + n];
            PAR[320 + n] = mu[1536 + d * 64 + n]; PAR[384 + n] = mu[1664 + d * 64 + n]; PAR[448 + n] = mu[h * 64 + n]; PAR[512 + n] = mu[512 + h * 64 + n];
        }
        f32x4v sacc[4];
        UNROLL for (int i = 0; i < 4; ++i) sacc[i] = (f32x4v){0.f, 0.f, 0.f, 0.f};
        __syncthreads();
        Raw3 pw1, pw2, pr, pk; u32x4 pv;
#define RW_GEOM(ci_, tido_) const bool isc = (ci_) < 4; const int T = isc ? CTXL : SEQ, cc = isc ? (ci_) : (ci_) - 4; \
            const int t0 = d == 0 ? cc * 64 : T - 64 * (cc + 1), nb = isc ? NX + b * CTXL : b * SEQ; \
            const int tt = d == 0 ? t0 + ((tido_) >> 3) : t0 + 63 - ((tido_) >> 3);
#define RW_PREFETCH(ci_, tido_) do { RW_GEOM(ci_, tido_) const int j_ = (tido_) & 7; \
            pw1 = rw_raw(PXR, RW_COLS, nb, tt, T, 1536 + d * 64 + 8 * j_); pw2 = rw_raw(PXR, RW_COLS, nb, tt, T, 1664 + d * 64 + 8 * j_); \
            pr = rw_raw(PXR, RW_COLS, nb, tt, T, h * 64 + 8 * j_); pk = rw_raw(PXR, RW_COLS, nb, tt, T, 512 + h * 64 + 8 * j_); \
            pv = *(const u32x4*)(VF + (size_t)(nb + tt) * 512 + h * 64 + 8 * j_); } while (0)
        RW_PREFETCH(0, tid);
        for (int ci = 0; ci < 36; ++ci) {
            int tido = tid; asm volatile("" : "+v"(tido));
            const int lane = tido & 63, lq = lane & 15, kg = lane >> 4, ti = tido >> 3, j = tido & 7;
            const int ch = h * 64 + 8 * j;
            RW_GEOM(ci, tido)
            float r8[8], k8[8], v8[8];
            {
                float x1[8], x2[8];
                shift_from_raw(pw1, tt, T, PAR + 320 + 8 * j, x1);
                shift_from_raw(pw2, tt, T, PAR + 384 + 8 * j, x2);
                UNROLL for (int i = 0; i < 8; ++i) x1[i] = tanh_fast(x1[i]);
                st8((bf16_t*)(T1 + ti * LROW) + 8 * j, x1); st8((bf16_t*)(T2 + ti * LROW) + 8 * j, x2);
                shift_from_raw(pr, tt, T, PAR + 448 + 8 * j, r8);
                shift_from_raw(pk, tt, T, PAR + 512 + 8 * j, k8);
                unpack8(pv, v8);
            }
            __syncthreads();
            _Pragma("unroll 1") for (int rep = 0; rep < 4; ++rep) {
                const int q = wave + 8 * rep, m = q >> 4, tl = q & 15, tt4 = tl >> 2, nt4 = tl & 3;
                const char* Ab = (m ? T2 : T1) + (16 * tt4 + lq) * LROW + kg * 16; const char* Bb = (m ? A2T : W2T) + (16 * nt4 + lq) * LROW + kg * 16;
                f32x4v a = {0.f, 0.f, 0.f, 0.f};
                UNROLL for (int ks = 0; ks < 2; ++ks) a = MFMA16(*(const bf16x8*)(Ab + ks * 64), *(const bf16x8*)(Bb + ks * 64), a);
                float* dst = (m ? ALf : WLf) + (16 * tt4 + 4 * kg) * 68 + 16 * nt4 + lq;
                UNROLL for (int i = 0; i < 4; ++i) dst[i * 68] = a[i];
            }
            __syncthreads();
            float av[8], bv[8], kd8[8];
            {
                const float4 wa = *(const float4*)(WLf + ti * 68 + 8 * j), wb = *(const float4*)(WLf + ti * 68 + 8 * j + 4);
                const float4 aa = *(const float4*)(ALf + ti * 68 + 8 * j), ab = *(const float4*)(ALf + ti * 68 + 8 * j + 4);
                const float wl[8] = {wa.x, wa.y, wa.z, wa.w, wb.x, wb.y, wb.z, wb.w}, al[8] = {aa.x, aa.y, aa.z, aa.w, ab.x, ab.y, ab.z, ab.w};
                float ss = 0.f, cbp = 0.f, alpha[8], kkr[8], lw[8];
                UNROLL for (int i = 0; i < 8; ++i) {
                    const float xw = -(PAR[8 * j + i] + wl[i]);
                    const float sp = softplus_fast(xw);
                    lw[i] = -__expf(-sp - 0.5f);
                    alpha[i] = sigm(PAR[64 + 8 * j + i] + al[i]);
                    kkr[i] = k8[i] * PAR[128 + 8 * j + i]; ss += kkr[i] * kkr[i];
                    kd8[i] = k8[i] * (1.f + (alpha[i] - 1.f) * PAR[192 + 8 * j + i]);
                    cbp += r8[i] * kd8[i] * PAR[256 + 8 * j + i];
                }
                ss = sum8(ss); cbp = sum8(cbp);
                const float inv = frcp(fmaxf(__builtin_amdgcn_sqrtf(ss), 1e-12f));
                UNROLL for (int i = 0; i < 8; ++i) { const float kk = kkr[i] * inv; av[i] = -kk; bv[i] = kk * alpha[i]; }
                *(float4*)(LW + ti * 64 + 8 * j) = make_float4(lw[0], lw[1], lw[2], lw[3]); *(float4*)(LW + ti * 64 + 8 * j + 4) = make_float4(lw[4], lw[5], lw[6], lw[7]);
                if (j == 0) CB[((size_t)d * NT + nb + tt) * 8 + h] = cbp;
            }
            __syncthreads();
            {
                const int n = tid & 63, seg = wave; float run[8], acc = 0.f;
                UNROLL for (int r = 0; r < 8; ++r) { acc += LW[(seg * 8 + r) * 64 + n]; run[r] = acc; }
                SEGT[seg * 64 + n] = acc;
                __syncthreads();
                float off = 0.f, tot = 0.f;
                UNROLL for (int s2 = 0; s2 < 8; ++s2) { const float sv = SEGT[s2 * 64 + n]; tot += sv; off += s2 < seg ? sv : 0.f; }
                UNROLL for (int r = 0; r < 8; ++r) LW[(seg * 8 + r) * 64 + n] = run[r] + off;
                if (seg == 0) { TOT[n] = tot; PCv[n] = __expf(tot); }
            }
            __syncthreads();
            {
                const float4 ta = *(const float4*)(TOT + 8 * j), tb = *(const float4*)(TOT + 8 * j + 4);
                const float tot[8] = {ta.x, ta.y, ta.z, ta.w, tb.x, tb.y, tb.z, tb.w};
                const float4 la = *(const float4*)(LW + ti * 64 + 8 * j), lb = *(const float4*)(LW + ti * 64 + 8 * j + 4);
                const float lpl[8] = {la.x, la.y, la.z, la.w, lb.x, lb.y, lb.z, lb.w};
                float lpm[8];
                if (ti != 0) {
                    const float4 ma = *(const float4*)(LW + (ti - 1) * 64 + 8 * j), mb = *(const float4*)(LW + (ti - 1) * 64 + 8 * j + 4);
                    lpm[0] = ma.x; lpm[1] = ma.y; lpm[2] = ma.z; lpm[3] = ma.w; lpm[4] = mb.x; lpm[5] = mb.y; lpm[6] = mb.z; lpm[7] = mb.w;
                } else { UNROLL for (int i = 0; i < 8; ++i) lpm[i] = 0.f; }
                float oa[8], ob[8], ok[8], orr[8];
                const int wofs = (((ti >> 3) ^ j) << 4) + (ti & 7) * 2;
                UNROLL for (int i = 0; i < 8; ++i) {
                    const float lp = lpl[i], lm = lpm[i];
                    const float eP = __expf(lp), eM = __expf(-lp), ePm = __expf(lm), eE = __expf(tot[i] - lp);
                    oa[i] = av[i] * ePm; ob[i] = bv[i] * eM; ok[i] = kd8[i] * eM; orr[i] = r8[i] * eP;
                    *(bf16_t*)(BH + (8 * j + i) * LROW + wofs) = f2bf(bv[i] * eE);
                    *(bf16_t*)(KH + (8 * j + i) * LROW + wofs) = f2bf(kd8[i] * eE);
                    *(bf16_t*)(VT + (8 * j + i) * LROW + wofs) = f2bf(v8[i]);
                }
                st8((bf16_t*)(AT + ti * LROW) + 8 * j, oa); st8((bf16_t*)(BT + ti * LROW) + 8 * j, ob);
                st8((bf16_t*)(KT + ti * LROW) + 8 * j, ok); st8((bf16_t*)(RT + ti * LROW) + 8 * j, orr);
            }
            __syncthreads();
            if (ci + 1 < 36) RW_PREFETCH(ci + 1, tido);
            _Pragma("unroll 1") for (int rep = 0; rep < 6; ++rep) {
                const int q = wave + 8 * rep, m = q / 12, tl = q - 12 * m;
                const int tt4 = tl >= 10 ? 2 * (tl - 10) : tl < 1 ? 0 : tl < 3 ? 1 : tl < 6 ? 2 : 3, st4 = tl >= 10 ? tt4 + 1 : tl - (tt4 * (tt4 + 1)) / 2;
                char* dstm = m == 0 ? NAB : m == 1 ? NAK : m == 2 ? NRB : NRK;
                f32x4v a = {0.f, 0.f, 0.f, 0.f};
                if (st4 <= tt4) {
                    const char* Ab = (m < 2 ? AT : RT) + (16 * tt4 + lq) * LROW + kg * 16; const char* Bb = ((m & 1) ? KT : BT) + (16 * st4 + lq) * LROW + kg * 16;
                    UNROLL for (int ks = 0; ks < 2; ++ks) a = MFMA16(*(const bf16x8*)(Ab + ks * 64), *(const bf16x8*)(Bb + ks * 64), a);
                }
                const int sidx = 16 * st4 + lq;
                UNROLL for (int i = 0; i < 4; ++i) {
                    const int tidx = 16 * tt4 + 4 * kg + i;
                    const bool keep = m < 2 ? sidx < tidx : sidx <= tidx;
                    const float val = keep ? a[i] : 0.f;
                    *(bf16_t*)(dstm + tidx * LROW + sidx * 2) = f2bf(val);
                    if (m == 0 && st4 == tt4) NDF[(tt4 * 16 + 4 * kg + i) * 16 + lq] = val;
                }
            }
            __syncthreads();
            f32x4v xacc[4], yacc[4];
            bf16x8 vt[2];
            if (wave == 7) {
                const int blk = lane >> 4, c = lane & 15;
                float Tc[16];
                UNROLL for (int t = 0; t < 16; ++t) {
                    float a = t == c ? 1.f : 0.f;
                    UNROLL for (int s2 = 0; s2 < t; ++s2) a += NDF[(blk * 16 + t) * 16 + s2] * Tc[s2];
                    Tc[t] = a;
                }
                UNROLL for (int t = 0; t < 16; ++t) *(bf16_t*)(TJ + (blk * 16 + t) * 32 + c * 2) = f2bf(Tc[t]);
            } else if (wave < 4) {
                bf16x8 sb[2];
                UNROLL for (int kk = 0; kk < 2; ++kk) { sb[kk] = pk_acc2(sacc[2 * kk], sacc[2 * kk + 1]); vt[kk] = *(const bf16x8*)(VT + (16 * wave + lq) * LROW + (((4 * kk + kg) ^ (2 * wave + (lq >> 3))) << 4)); }
                UNROLL for (int t4 = 0; t4 < 4; ++t4) {
                    f32x4v x = {0.f, 0.f, 0.f, 0.f}, y = {0.f, 0.f, 0.f, 0.f};
                    UNROLL for (int kk = 0; kk < 2; ++kk) {
                        const char* pa = AT + (16 * t4 + lq) * LROW + (32 * kk + 4 * kg) * 2; const char* pr = RT + (16 * t4 + lq) * LROW + (32 * kk + 4 * kg) * 2;
                        x = MFMA16(pk_lohi(*(const u32x2*)pa, *(const u32x2*)(pa + 32)), sb[kk], x);
                        y = MFMA16(pk_lohi(*(const u32x2*)pr, *(const u32x2*)(pr + 32)), sb[kk], y);
                        if (2 * kk <= t4) {
                            x = MFMA16(*(const bf16x8*)(NAK + (16 * t4 + lq) * LROW + kk * 64 + kg * 16), vt[kk], x);
                            y = MFMA16(*(const bf16x8*)(NRK + (16 * t4 + lq) * LROW + kk * 64 + kg * 16), vt[kk], y);
                        }
                    }
                    xacc[t4] = x; yacc[t4] = y;
                }
            }
            __syncthreads();
            if (wave < 4) {
                const u32x2 z2 = {0u, 0u};
                f32x4v uacc[4];
                {
                    const u32x2 t0v = *(const u32x2*)(TJ + (0 * 16 + lq) * 32 + 4 * kg * 2);
                    uacc[0] = MFMA16(pk_lohi(t0v, z2), pk_acc1(xacc[0]), ((f32x4v){0.f, 0.f, 0.f, 0.f}));
                }
                UNROLL for (int jb = 1; jb < 4; ++jb) {
                    f32x4v z = xacc[jb];
                    const char* nr = NAB + (16 * jb + lq) * LROW + 4 * kg * 2;
                    if (jb == 1) z = MFMA16(pk_lohi(*(const u32x2*)nr, z2), pk_acc1(uacc[0]), z);
                    else {
                        z = MFMA16(pk_lohi(*(const u32x2*)nr, *(const u32x2*)(nr + 32)), pk_acc2(uacc[0], uacc[1]), z);
                        if (jb == 3) z = MFMA16(pk_lohi(*(const u32x2*)(nr + 64), z2), pk_acc1(uacc[2]), z);
                    }
                    const u32x2 tv = *(const u32x2*)(TJ + (jb * 16 + lq) * 32 + 4 * kg * 2);
                    uacc[jb] = MFMA16(pk_lohi(tv, z2), pk_acc1(z), ((f32x4v){0.f, 0.f, 0.f, 0.f}));
                }
                bf16x8 ub[2]; ub[0] = pk_acc2(uacc[0], uacc[1]); ub[1] = pk_acc2(uacc[2], uacc[3]);
                UNROLL for (int t4 = 0; t4 < 4; ++t4) {
                    f32x4v y = yacc[t4];
                    UNROLL for (int kk = 0; kk < 2; ++kk) if (2 * kk <= t4) {
                        const char* pn = NRB + (16 * t4 + lq) * LROW + (32 * kk + 4 * kg) * 2;
                        y = MFMA16(pk_lohi(*(const u32x2*)pn, *(const u32x2*)(pn + 32)), ub[kk], y);
                    }
                    UNROLL for (int i = 0; i < 4; ++i) YO[(16 * t4 + 4 * kg + i) * 68 + 16 * wave + lq] = y[i];
                }
                UNROLL for (int kt = 0; kt < 4; ++kt) {
                    f32x4v sv = sacc[kt];
                    UNROLL for (int i = 0; i < 4; ++i) sv[i] *= PCv[16 * kt + 4 * kg + i];
                    UNROLL for (int kk = 0; kk < 2; ++kk) {
                        const int xr = 2 * kt + (lq >> 3);
                        const char* pb = BH + (16 * kt + lq) * LROW + (kg & 1) * 8;
                        sv = MFMA16(pk_lohi(*(const u32x2*)(pb + (((4 * kk + (kg >> 1)) ^ xr) << 4)), *(const u32x2*)(pb + (((4 * kk + 2 + (kg >> 1)) ^ xr) << 4))), ub[kk], sv);
                        sv = MFMA16(*(const bf16x8*)(KH + (16 * kt + lq) * LROW + (((4 * kk + kg) ^ xr) << 4)), vt[kk], sv);
                    }
                    sacc[kt] = sv;
                }
            }
            __syncthreads();
            {
                const float4 ya = *(const float4*)(YO + ti * 68 + 8 * j), yb = *(const float4*)(YO + ti * 68 + 8 * j + 4);
                const float y8[8] = {ya.x, ya.y, ya.z, ya.w, yb.x, yb.y, yb.z, yb.w};
                st8(YS + ((size_t)d * NT + nb + tt) * 512 + ch, y8);
            }
            __syncthreads();
        }
    }
}

DEV void ph_rw_read(const Params& p, int L, int ntok) {
    const int lane = TID() & 63, wave = TID() >> 6;
    const bf16_t* PXR = (const bf16_t*)(p.ws + OFF_PX); const bf16_t* VF = (const bf16_t*)(p.ws + OFF_VF);
    const bf16_t* YS = (const bf16_t*)(p.ws + OFF_YS); const float* CB = (const float*)(p.ws + OFF_CB);
    bf16_t* YA = (bf16_t*)(p.ws + OFF_YA); bf16_t* SG = (bf16_t*)(p.ws + OFF_SGB);
    const float* mu = p.in[I_MU] + (size_t)L * RW_COLS;
    const float* lg = p.in[I_LNG] + (size_t)L * 512; const float* lb = p.in[I_LNB] + (size_t)L * 512;
    for (int n0 = blockIdx.x * 8; n0 < ntok; n0 += gridDim.x * 8) {
        const int n = n0 + wave, c = lane * 8, h = lane >> 3;
        float y0[8], y1[8], v8[8], o[8];
        ld8(YS + (size_t)n * 512 + c, y0); ld8(YS + ((size_t)NT + n) * 512 + c, y1); ld8(VF + (size_t)n * 512 + c, v8);
        float s = 0.f;
        UNROLL for (int i = 0; i < 8; ++i) { y0[i] += y1[i]; s += y0[i]; }
        s += __shfl_xor(s, 1); s += __shfl_xor(s, 2); s += __shfl_xor(s, 4);
        const float mean = s * (1.f / 64.f); float q = 0.f;
        UNROLL for (int i = 0; i < 8; ++i) { const float dd = y0[i] - mean; q += dd * dd; }
        q += __shfl_xor(q, 1); q += __shfl_xor(q, 2); q += __shfl_xor(q, 4);
        const float rstd = rsqrtf(q * (1.f / 64.f) + 64e-5f);
        const float bon = CB[(size_t)n * 8 + h] + CB[((size_t)NT + n) * 8 + h];
        UNROLL for (int i = 0; i < 8; ++i) o[i] = (y0[i] - mean) * rstd * lg[c + i] + lb[c + i] + bon * v8[i];
        st8(YA + (size_t)n * 512 + c, o);
        if (lane < 16) {
            int nb, tt, T; seq_of(n, nb, tt, T);
            float g8[8]; shift8(PXR, RW_COLS, nb, tt, T, 1792 + lane * 8, mu, g8);
            UNROLL for (int i = 0; i < 8; ++i) g8[i] = sigm(g8[i]);
            st8(SG + (size_t)n * 128 + lane * 8, g8);
        }
    }
}

DEV void ph_na_norm(const Params& p, int L) {
    const int lane = TID() & 63, wave = TID() >> 6;
    bf16_t* PXN = (bf16_t*)(p.ws + OFF_PX);
    const float* qg = p.in[I_QNG] + (size_t)L * 64; const float* kg = p.in[I_KNG] + (size_t)L * 64;
    for (int n0 = blockIdx.x * 8; n0 < NT; n0 += gridDim.x * 8) {
        const int n = n0 + wave, c = lane * 8;
        UNROLL for (int w = 0; w < 2; ++w) {
            bf16_t* ptr = PXN + (size_t)n * 1024 + w * 512 + c;
            float x[8]; ld8(ptr, x);
            float ss = 0.f;
            UNROLL for (int i = 0; i < 8; ++i) ss += x[i] * x[i];
            ss += __shfl_xor(ss, 1); ss += __shfl_xor(ss, 2); ss += __shfl_xor(ss, 4);
            const float r = rsqrtf(ss * (1.f / 64.f) + 1e-6f) * (w == 0 ? 0.125f : 1.f);
            const float* g = w == 0 ? qg : kg;
            UNROLL for (int i = 0; i < 8; ++i) x[i] = x[i] * r * g[(c + i) & 63];
            st8(ptr, x);
        }
    }
}

DEV void knorm8(float (&x)[8], const float* g) {
    float ss = 0.f;
    UNROLL for (int i = 0; i < 8; ++i) ss += x[i] * x[i];
    ss = sum8(ss);
    const float r = rsqrtf(ss * (1.f / 64.f) + 1e-6f);
    UNROLL for (int i = 0; i < 8; ++i) x[i] = x[i] * r * g[i];
}
DEV void ph_na_att(const Params& p, int L, char* smem) {
    const int tid0 = TID();
    const int wave = __builtin_amdgcn_readfirstlane(tid0 >> 6);
    char* KL = smem;
    char* KC = smem + 576 * LROW;
    char* VL = smem;
    char* VC = smem + 64 * 1168;
    float* OX = (float*)(smem + 119808);
    float* RP = OX + 8 * 1024;
    const bf16_t* PXN = (const bf16_t*)(p.ws + OFF_PX); bf16_t* YB = (bf16_t*)(p.ws + OFF_YB);
    const bf16_t* VT = (const bf16_t*)(p.ws + OFF_VT); const bf16_t* VTC = (const bf16_t*)(p.ws + OFF_VTC);
    const float* qgn = p.in[I_QNG] + (size_t)L * 64; const float* kgn = p.in[I_KNG] + (size_t)L * 64;
    const int nunits = 2048 + (L == 0 ? 256 : 0);
    u32x4 vraw[13], qraw[2];
#define NA_GEOM(u_) const bool cu = (u_) >= 2048; int b, h, rp = 0, rs0 = 0, g = 0; \
        if (!cu) { h = (u_) & 7; rp = ((u_) >> 3) & 15; b = (u_) >> 7; rs0 = min(max(2 * rp - 4, 0), 24); } \
        else { const int v_ = (u_) - 2048; h = v_ & 7; g = (v_ >> 3) & 1; b = v_ >> 4; } \
        const int ctx0 = NX + b * CTXL; \
        const int nb = wave & 3, ri = wave >> 2, r = 2 * rp + ri; \
        const int qtok0 = cu ? ctx0 + (g * 8 + wave) * 16 : b * SEQ + r * 64 + nb * 16;
#define NA_KQ_LOAD(u_, tid_) do { NA_GEOM(u_) \
        if (!cu) { UNROLL for (int i = 0; i < 9; ++i) { const int c = (tid_) + NTHREADS * i, kx = c >> 3, part = c & 7; \
            vraw[i] = *(const u32x4*)(PXN + (size_t)(b * SEQ + min(rs0 + (kx >> 6), 31) * 64 + (kx & 63)) * 1024 + 512 + h * 64 + part * 8); } } \
        UNROLL for (int i = 0; i < 4; ++i) { const int c = (tid_) + NTHREADS * i, kx = c >> 3, part = c & 7; \
            vraw[9 + i] = *(const u32x4*)(PXN + (size_t)(ctx0 + kx) * 1024 + 512 + h * 64 + part * 8); } \
        { const int lq_ = (tid_) & 15, kg_ = ((tid_) & 63) >> 4; \
          qraw[0] = *(const u32x4*)(PXN + (size_t)(qtok0 + lq_) * 1024 + h * 64 + kg_ * 8); qraw[1] = *(const u32x4*)(PXN + (size_t)(qtok0 + lq_) * 1024 + h * 64 + 32 + kg_ * 8); } } while (0)
    int u0 = blockIdx.x; asm volatile("" : "+s"(u0));
    if (u0 < nunits) NA_KQ_LOAD(u0, tid0);
    for (int u = u0; u < nunits; u += gridDim.x) {
        int tid = tid0; asm volatile("" : "+v"(tid));
        const int lane = tid & 63, lq = lane & 15, kg = lane >> 4;
        NA_GEOM(u)
        if (!cu) {
            UNROLL for (int i = 0; i < 9; ++i) {
                const int c = tid + NTHREADS * i, kx = c >> 3, part = c & 7;
                float kv[8]; unpack8(vraw[i], kv); knorm8(kv, kgn + part * 8);
                st8((bf16_t*)(KL + kx * LROW + part * 16), kv);
            }
            for (int i = tid; i < 15 * 31; i += NTHREADS) RP[i] = p.in[I_RPB][((size_t)L * 8 + h) * 465 + i];
        }
        UNROLL for (int i = 0; i < 4; ++i) {
            const int c = tid + NTHREADS * i, kx = c >> 3, part = c & 7;
            float kv[8]; unpack8(vraw[9 + i], kv); knorm8(kv, kgn + part * 8);
            st8((bf16_t*)(KC + kx * LROW + part * 16), kv);
        }
        const int rs = min(max(r - 4, 0), 24), roff = rs - rs0;
        const int band0 = min(max(nb * 16 - 8, 0), 32);
        bf16x8 qf[2];
        {
            float q0[8], q1[8]; unpack8(qraw[0], q0); unpack8(qraw[1], q1);
            float ss = 0.f;
            UNROLL for (int i = 0; i < 8; ++i) ss += q0[i] * q0[i] + q1[i] * q1[i];
            ss += __shfl_xor(ss, 16); ss += __shfl_xor(ss, 32);
            const float rq = rsqrtf(ss * (1.f / 64.f) + 1e-6f) * 0.125f;
            UNROLL for (int i = 0; i < 8; ++i) { q0[i] = q0[i] * rq * qgn[kg * 8 + i]; q1[i] = q1[i] * rq * qgn[32 + kg * 8 + i]; }
            u32x4 w0, w1; w0.x = pk2(q0[0], q0[1]); w0.y = pk2(q0[2], q0[3]); w0.z = pk2(q0[4], q0[5]); w0.w = pk2(q0[6], q0[7]);
            w1.x = pk2(q1[0], q1[1]); w1.y = pk2(q1[2], q1[3]); w1.z = pk2(q1[4], q1[5]); w1.w = pk2(q1[6], q1[7]);
            qf[0] = __builtin_bit_cast(bf16x8, w0); qf[1] = __builtin_bit_cast(bf16x8, w1);
        }
        __syncthreads();
        if (!cu) {
            UNROLL for (int i = 0; i < 9; ++i) {
                const int c = tid + NTHREADS * i, part = c & 7, kr = (c >> 3) % 9, d = (c >> 3) / 9;
                vraw[i] = *(const u32x4*)(VT + ((size_t)(b * 8 + h) * 64 + d) * SEQ + min(rs0 + kr, 31) * 64 + part * 8);
            }
        }
        UNROLL for (int i = 0; i < 4; ++i) {
            const int c = tid + NTHREADS * i, part = c & 31, d = c >> 5;
            vraw[9 + i] = *(const u32x4*)(VTC + ((size_t)(b * 8 + h) * 64 + d) * CTXL + part * 8);
        }
        f32x4v sacc[16];
        bf16x8 pfl[8], pfc[8];
        float ml = -3e38f, ll = 0.f, mc, lc;
        if (!cu) {
            const char* kb = KL + (roff * 64 + band0 + lq) * LROW + kg * 16;
            UNROLL for (int t = 0; t < 16; ++t) {
                f32x4v a = {0.f, 0.f, 0.f, 0.f};
                UNROLL for (int ks = 0; ks < 2; ++ks) a = __builtin_amdgcn_mfma_f32_16x16x32_bf16(*(const bf16x8*)(kb + ((t >> 1) * 64 + (t & 1) * 16) * LROW + ks * 64), qf[ks], a, 0, 0, 0);
                sacc[t] = a;
            }
            const int col = nb * 16 + lq, cs = min(max(col - 8, 0), 48);
            const int kc0 = band0 + 4 * kg;
            const float* rpp = RP + (rs - r + 7) * 31 + (kc0 - col + 15);
            UNROLL for (int t = 0; t < 16; ++t) UNROLL for (int i = 0; i < 4; ++i) {
                const int kc = kc0 + (t & 1) * 16 + i;
                const bool valid = kc >= cs && kc < cs + 16;
                sacc[t][i] = valid ? sacc[t][i] + rpp[(t >> 1) * 31 + (t & 1) * 16 + i] : -1e30f;
            }
            UNROLL for (int t = 0; t < 16; ++t) UNROLL for (int i = 0; i < 4; ++i) ml = fmaxf(ml, sacc[t][i]);
            ml = fmaxf(ml, __shfl_xor(ml, 16)); ml = fmaxf(ml, __shfl_xor(ml, 32));
            UNROLL for (int t = 0; t < 16; ++t) UNROLL for (int i = 0; i < 4; ++i) { const float e = __expf(sacc[t][i] - ml); sacc[t][i] = e; ll += e; }
            ll += __shfl_xor(ll, 16); ll += __shfl_xor(ll, 32);
            UNROLL for (int tp = 0; tp < 8; ++tp) pfl[tp] = pk_acc2(sacc[2 * tp], sacc[2 * tp + 1]);
        }
        {
            const char* kb = KC + lq * LROW + kg * 16;
            UNROLL for (int t = 0; t < 16; ++t) {
                f32x4v a = {0.f, 0.f, 0.f, 0.f};
                UNROLL for (int ks = 0; ks < 2; ++ks) a = __builtin_amdgcn_mfma_f32_16x16x32_bf16(*(const bf16x8*)(kb + t * 16 * LROW + ks * 64), qf[ks], a, 0, 0, 0);
                sacc[t] = a;
            }
            mc = -3e38f; lc = 0.f;
            UNROLL for (int t = 0; t < 16; ++t) UNROLL for (int i = 0; i < 4; ++i) mc = fmaxf(mc, sacc[t][i]);
            mc = fmaxf(mc, __shfl_xor(mc, 16)); mc = fmaxf(mc, __shfl_xor(mc, 32));
            UNROLL for (int t = 0; t < 16; ++t) UNROLL for (int i = 0; i < 4; ++i) { const float e = __expf(sacc[t][i] - mc); sacc[t][i] = e; lc += e; }
            lc += __shfl_xor(lc, 16); lc += __shfl_xor(lc, 32);
            UNROLL for (int tp = 0; tp < 8; ++tp) pfc[tp] = pk_acc2(sacc[2 * tp], sacc[2 * tp + 1]);
        }
        const float mm = fmaxf(ml, mc), el = cu ? 0.f : __expf(ml - mm), ec = __expf(mc - mm);
        const float inv = frcp(ll * el + lc * ec);
        const float fl = el * inv, fc = ec * inv;
        __syncthreads();
        if (!cu) {
            UNROLL for (int i = 0; i < 9; ++i) {
                const int c = tid + NTHREADS * i, part = c & 7, kr = (c >> 3) % 9, d = (c >> 3) / 9;
                *(u32x4*)(VL + d * 1168 + (kr * 64 + part * 8) * 2) = vraw[i];
            }
        }
        UNROLL for (int i = 0; i < 4; ++i) {
            const int c = tid + NTHREADS * i, part = c & 31, d = c >> 5;
            *(u32x4*)(VC + d * 528 + part * 16) = vraw[9 + i];
        }
        __syncthreads();
        f32x4v ol[4], oc[4];
        UNROLL for (int dt = 0; dt < 4; ++dt) { ol[dt] = (f32x4v){0.f, 0.f, 0.f, 0.f}; oc[dt] = (f32x4v){0.f, 0.f, 0.f, 0.f}; }
        if (!cu) {
            const char* vb = VL + lq * 1168 + (roff * 64 + band0 + 4 * kg) * 2;
            UNROLL for (int tp = 0; tp < 8; ++tp) UNROLL for (int dt = 0; dt < 4; ++dt)
                ol[dt] = __builtin_amdgcn_mfma_f32_16x16x32_bf16(pfl[tp], pk_lohi(*(const u32x2*)(vb + dt * 16 * 1168 + tp * 128), *(const u32x2*)(vb + dt * 16 * 1168 + tp * 128 + 32)), ol[dt], 0, 0, 0);
        }
        {
            const char* vb = VC + lq * 528 + 8 * kg;
            UNROLL for (int tp = 0; tp < 8; ++tp) UNROLL for (int dt = 0; dt < 4; ++dt)
                oc[dt] = __builtin_amdgcn_mfma_f32_16x16x32_bf16(pfc[tp], pk_lohi(*(const u32x2*)(vb + dt * 16 * 528 + tp * 64), *(const u32x2*)(vb + dt * 16 * 528 + tp * 64 + 32)), oc[dt], 0, 0, 0);
        }
        if (u + (int)gridDim.x < nunits) { const int un_ = u + (int)gridDim.x; NA_KQ_LOAD(un_, tid); }
        float* ox = OX + wave * 1024;
        UNROLL for (int i = 0; i < 4; ++i) {
            const float a = __shfl(fl, 4 * kg + i), c2 = __shfl(fc, 4 * kg + i);
            UNROLL for (int dt = 0; dt < 4; ++dt) ox[(4 * kg + i) * 64 + dt * 16 + lq] = ol[dt][i] * a + oc[dt][i] * c2;
        }
        UNROLL for (int it = 0; it < 2; ++it) {
            const int q = (lane >> 3) + 8 * it, c8 = (lane & 7) * 8;
            const float4 a = *(const float4*)(ox + q * 64 + c8), bq = *(const float4*)(ox + q * 64 + c8 + 4);
            const float v[8] = {a.x, a.y, a.z, a.w, bq.x, bq.y, bq.z, bq.w};
            st8(YB + (size_t)(qtok0 + q) * 512 + h * 64 + c8, v);
        }
        __syncthreads();
    }
#undef NA_KQ_LOAD
#undef NA_GEOM
}

DEV float sum16(float v) { v += DPP_MOV(v, 0xB1); v += DPP_MOV(v, 0x4E); v += DPP_MOV(v, 0x141); v += DPP_MOV(v, 0x140); return v; }
DEV void ph_ml_scan(const Params& p, int L, char* smem) {
    const int tid = TID(), lane = tid & 63, lq = lane & 15, kg = lane >> 4, ti = tid >> 3, j = tid & 7;
    const int wave = __builtin_amdgcn_readfirstlane(tid >> 6);
    char* QS = smem;
    char* QP = QS + 9216;
    char* KC = QP + 9216;
    char* KW = KC + 9216;
    char* PM = KW + 9216;
    char* VT = PM + 9216;
    float* BV = (float*)(VT + 128 * LROW);
    float* GI = BV + 64;
    float* DEN = GI + 64;
    float* NV = DEN + 64;
    float* RS = NV + 64;
    float* HO = RS + 256;
    const bf16_t* PXM = (const bf16_t*)(p.ws + OFF_PX); bf16_t* HS = (bf16_t*)(p.ws + OFF_HS);
    for (int u = blockIdx.x; u < 128; u += gridDim.x) {
        const int d = u & 1, h = (u >> 1) & 3, b = u >> 3;
        const float ib = p.in[I_IB][L * 8 + d * 4 + h], fb = p.in[I_FB][L * 8 + d * 4 + h];
        f32x4v cacc[4];
        UNROLL for (int i = 0; i < 4; ++i) cacc[i] = (f32x4v){0.f, 0.f, 0.f, 0.f};
        for (int i = tid; i < 64 * LROW / 4; i += NTHREADS) ((unsigned*)PM)[i] = 0u;
        if (tid < 64) NV[tid] = 0.f;
        __syncthreads();
        u32x4 pq, pk, pv0, pv1; unsigned short pig = 0, pfg = 0;
#define ML_GEOM(ci_) const bool isc = (ci_) < 4; const int T = isc ? CTXL : SEQ, cc = isc ? (ci_) : (ci_) - 4; \
            const int t0 = d == 0 ? cc * 64 : T - 64 * (cc + 1), nb = isc ? NX + b * CTXL : b * SEQ; \
            const int tt = d == 0 ? t0 + ti : t0 + 63 - ti;
#define ML_PREFETCH(ci_) do { ML_GEOM(ci_) const bf16_t* row_ = PXM + (size_t)(nb + tt) * ML_COLS; \
            pq = *(const u32x4*)(row_ + h * 64 + 8 * j); pk = *(const u32x4*)(row_ + 256 + h * 64 + 8 * j); \
            pv0 = *(const u32x4*)(row_ + 512 + h * 128 + 16 * j); pv1 = *(const u32x4*)(row_ + 512 + h * 128 + 16 * j + 8); \
            if (wave == 0) { const int tl_ = d == 0 ? t0 + lane : t0 + 63 - lane; const bf16_t* rw_ = PXM + (size_t)(nb + tl_) * ML_COLS; pig = rw_[1536 + d * 4 + h]; pfg = rw_[1544 + d * 4 + h]; } } while (0)
        ML_PREFETCH(0);
        for (int ci = 0; ci < 36; ++ci) {
            ML_GEOM(ci)
            float q8[8], k8[8];
            {
                unpack8(pq, q8); unpack8(pk, k8);
                if (!isc) {
                    const int axis = j >> 2, half = (j >> 1) & 1; const float pos = (float)(axis == 0 ? (tt >> 6) : (tt & 63));
                    UNROLL for (int i = 0; i < 8; ++i) {
                        const int f = (j & 1) * 8 + i;
                        const float inv = exp2f(-(float)f * 0.83048202372184059f);
                        const float ang = pos * inv; const float cs = __cosf(ang), sn = __sinf(ang);
                        const float qo = __shfl_xor(q8[i], 2), ko = __shfl_xor(k8[i], 2);
                        q8[i] = half == 0 ? q8[i] * cs - qo * sn : q8[i] * cs + qo * sn;
                        k8[i] = half == 0 ? k8[i] * cs - ko * sn : k8[i] * cs + ko * sn;
                    }
                }
                UNROLL for (int i = 0; i < 8; ++i) q8[i] *= 0.125f;
                st8((bf16_t*)(QS + ti * LROW) + 8 * j, q8); st8((bf16_t*)(KC + ti * LROW) + 8 * j, k8);
                float v0[8], v1[8]; unpack8(pv0, v0); unpack8(pv1, v1);
                UNROLL for (int i = 0; i < 8; ++i) { *(bf16_t*)(VT + (16 * j + i) * LROW + ti * 2) = f2bf(v0[i]); *(bf16_t*)(VT + (16 * j + 8 + i) * LROW + ti * 2) = f2bf(v1[i]); }
                if (wave == 0) {
                    const float ig = bf2f(pig) + ib, fg = bf2f(pfg) + fb;
                    const float igc = 15.f * tanhf(ig * (1.f / 15.f)), fgc = 15.f * tanhf(fg * (1.f / 15.f));
                    float lf = -(fmaxf(-fgc, 0.f) + log1pf(expf(-fabsf(fgc))));
                    UNROLL for (int o = 1; o < 64; o <<= 1) { const float up = __shfl_up(lf, o); if (lane >= o) lf += up; }
                    BV[lane] = lf; GI[lane] = igc;
                }
            }
            __syncthreads();
            if (ci + 1 < 36) ML_PREFETCH(ci + 1);
            {
                const float bt = BV[ti], bl = BV[63], gi = GI[ti];
                const float eb = __expf(bt), wk = __expf(bl - bt + gi);
                float qp[8]; float dn = 0.f;
                UNROLL for (int i = 0; i < 8; ++i) { qp[i] = q8[i] * eb; dn += q8[i] * NV[8 * j + i]; }
                st8((bf16_t*)(QP + ti * LROW) + 8 * j, qp);
                UNROLL for (int i = 0; i < 8; ++i) *(bf16_t*)(KW + (8 * j + i) * LROW + ti * 2) = f2bf(k8[i] * wk);
                dn = sum8(dn);
                if (j == 0) DEN[ti] = dn * eb;
            }
            __syncthreads();
            UNROLL for (int rep = 0; rep < 2; ++rep) {
                const int tile = wave + 8 * rep;
                if (tile < 10) {
                    const int tt4 = tile < 1 ? 0 : tile < 3 ? 1 : tile < 6 ? 2 : 3, st4 = tile - (tt4 * (tt4 + 1)) / 2;
                    f32x4v a = {0.f, 0.f, 0.f, 0.f};
                    UNROLL for (int ks = 0; ks < 2; ++ks)
                        a = __builtin_amdgcn_mfma_f32_16x16x32_bf16(*(const bf16x8*)(QS + (16 * tt4 + lq) * LROW + ks * 64 + kg * 16),
                                                                    *(const bf16x8*)(KC + (16 * st4 + lq) * LROW + ks * 64 + kg * 16), a, 0, 0, 0);
                    const int sidx = 16 * st4 + lq; const float bs = BV[sidx], gs = GI[sidx];
                    UNROLL for (int i = 0; i < 4; ++i) {
                        const int tidx = 16 * tt4 + 4 * kg + i;
                        const float val = sidx <= tidx ? a[i] * __expf(BV[tidx] - bs + gs) : 0.f;
                        *(bf16_t*)(PM + tidx * LROW + sidx * 2) = f2bf(val);
                        const float rsum = sum16(val);
                        if (lq == 0) RS[tidx * 4 + st4] = rsum;
                    }
                }
            }
            __syncthreads();
            {
                bf16x8 vf[2], cb[2];
                UNROLL for (int kk = 0; kk < 2; ++kk) vf[kk] = *(const bf16x8*)(VT + (16 * wave + lq) * LROW + kk * 64 + kg * 16);
                UNROLL for (int kk = 0; kk < 2; ++kk) {
                    u32x4 w; w.x = pk2(cacc[2 * kk][0], cacc[2 * kk][1]); w.y = pk2(cacc[2 * kk][2], cacc[2 * kk][3]);
                    w.z = pk2(cacc[2 * kk + 1][0], cacc[2 * kk + 1][1]); w.w = pk2(cacc[2 * kk + 1][2], cacc[2 * kk + 1][3]);
                    cb[kk] = __builtin_bit_cast(bf16x8, w);
                }
                UNROLL for (int tt4 = 0; tt4 < 4; ++tt4) {
                    f32x4v hacc = {0.f, 0.f, 0.f, 0.f};
                    UNROLL for (int kk = 0; kk < 2; ++kk) if (2 * kk <= tt4)
                        hacc = __builtin_amdgcn_mfma_f32_16x16x32_bf16(*(const bf16x8*)(PM + (16 * tt4 + lq) * LROW + kk * 64 + kg * 16), vf[kk], hacc, 0, 0, 0);
                    UNROLL for (int kk = 0; kk < 2; ++kk) {
                        const char* qa = QP + (16 * tt4 + lq) * LROW + (32 * kk + 4 * kg) * 2;
                        const u32x2 lo = *(const u32x2*)qa, hi = *(const u32x2*)(qa + 32);
                        u32x4 w; w.x = lo.x; w.y = lo.y; w.z = hi.x; w.w = hi.y;
                        hacc = __builtin_amdgcn_mfma_f32_16x16x32_bf16(__builtin_bit_cast(bf16x8, w), cb[kk], hacc, 0, 0, 0);
                    }
                    UNROLL for (int i = 0; i < 4; ++i) {
                        const int tidx = 16 * tt4 + 4 * kg + i;
                        float den = DEN[tidx];
                        UNROLL for (int st = 0; st <= tt4; ++st) den += RS[tidx * 4 + st];
                        HO[tidx * 132 + 16 * wave + lq] = hacc[i] * frcp(fmaxf(fabsf(den), 1.f));
                    }
                }
                const float g = __expf(BV[63]);
                UNROLL for (int dk = 0; dk < 4; ++dk) {
                    cacc[dk] = cacc[dk] * g;
                    UNROLL for (int kk = 0; kk < 2; ++kk)
                        cacc[dk] = __builtin_amdgcn_mfma_f32_16x16x32_bf16(*(const bf16x8*)(KW + (16 * dk + lq) * LROW + kk * 64 + kg * 16), vf[kk], cacc[dk], 0, 0, 0);
                }
            }
            __syncthreads();
            if (tid < 64) {
                float acc = 0.f;
                UNROLL for (int c8 = 0; c8 < 8; ++c8) { float kw[8]; ld8((const bf16_t*)(KW + tid * LROW) + 8 * c8, kw); UNROLL for (int i = 0; i < 8; ++i) acc += kw[i]; }
                NV[tid] = __expf(BV[63]) * NV[tid] + acc;
            }
            {
                const float* hr = HO + ti * 132 + 16 * j;
                float o0[8], o1[8];
                UNROLL for (int i = 0; i < 8; ++i) { o0[i] = hr[i]; o1[i] = hr[8 + i]; }
                bf16_t* dst = HS + ((size_t)d * NT + nb + tt) * 512 + h * 128 + 16 * j;
                st8(dst, o0); st8(dst + 8, o1);
            }
            __syncthreads();
        }
    }
}
DEV void ph_ml_read(const Params& p, int L, int ntok) {
    const int lane = TID() & 63, wave = TID() >> 6;
    const bf16_t* PXM = (const bf16_t*)(p.ws + OFF_PX); const bf16_t* HS = (const bf16_t*)(p.ws + OFF_HS);
    bf16_t* YC = (bf16_t*)(p.ws + OFF_YC); const float* ng = p.in[I_MNG] + (size_t)L * 512;
    for (int n0 = blockIdx.x * 8; n0 < ntok; n0 += gridDim.x * 8) {
        const int n = n0 + wave, c = lane * 8;
        float h0[8], h1[8], o8[8], out[8];
        ld8(HS + (size_t)n * 512 + c, h0); ld8(HS + ((size_t)NT + n) * 512 + c, h1); ld8(PXM + (size_t)n * ML_COLS + 1024 + c, o8);
        float ss = 0.f;
        UNROLL for (int i = 0; i < 8; ++i) { h0[i] += h1[i]; ss += h0[i] * h0[i]; }
        ss += __shfl_xor(ss, 1); ss += __shfl_xor(ss, 2); ss += __shfl_xor(ss, 4); ss += __shfl_xor(ss, 8);
        const float r = rsqrtf(ss * (1.f / 128.f) + 1e-6f);
        UNROLL for (int i = 0; i < 8; ++i) out[i] = h0[i] * r * ng[c + i] * sigm(o8[i]);
        st8(YC + (size_t)n * 512 + c, out);
    }
}

DEV void ph_route(const Params& p, int L, int ntok, char* smem) {
    const int lane = TID() & 63, wave = TID() >> 6;
    const float* LOG = (const float*)(p.ws + OFF_LOG); int* EIDX = (int*)(p.ws + OFF_EIDX); float* EW = (float*)(p.ws + OFF_EW);
    const float bias = p.in[I_MB][L * 64 + lane];
    int* MCNT = (int*)(p.ws + OFF_MCNT);
    int* hist = (int*)smem;
    if (TID() < 192) hist[TID()] = 0;
    __syncthreads();
    for (int n0 = blockIdx.x * 8; n0 < ntok; n0 += gridDim.x * 8) {
        const int n = n0 + wave, g = lane >> 3;
        const float score = sigm_acc(LOG[(size_t)n * 64 + lane]), sel = score + bias;
        float m1 = sel; m1 = fmaxf(m1, __shfl_xor(m1, 1)); m1 = fmaxf(m1, __shfl_xor(m1, 2)); m1 = fmaxf(m1, __shfl_xor(m1, 4));
        int i1 = sel == m1 ? lane : 64; i1 = min(i1, __shfl_xor(i1, 1)); i1 = min(i1, __shfl_xor(i1, 2)); i1 = min(i1, __shfl_xor(i1, 4));
        float m2 = lane == i1 ? -3e38f : sel; m2 = fmaxf(m2, __shfl_xor(m2, 1)); m2 = fmaxf(m2, __shfl_xor(m2, 2)); m2 = fmaxf(m2, __shfl_xor(m2, 4));
        const float gs = m1 + m2;
        int rank = 0;
        UNROLL for (int g2 = 0; g2 < 8; ++g2) { const float v = __shfl(gs, g2 * 8); rank += (v > gs || (v == gs && g2 < g)) ? 1 : 0; }
        const float ms = rank < 4 ? sel : -1e30f;
        int er = 0;
        for (int e2 = 0; e2 < 64; ++e2) { const float v = __shfl(ms, e2); er += (v > ms || (v == ms && e2 < lane)) ? 1 : 0; }
        const bool chosen = er < 8;
        float ws = chosen ? score : 0.f;
        UNROLL for (int o = 1; o < 64; o <<= 1) ws += __shfl_xor(ws, o);
        if (chosen) { EIDX[(size_t)n * 8 + er] = lane; EW[(size_t)n * 8 + er] = score / ws * 2.5f; atomicAdd(hist + (n / MOE_CHUNK) * 64 + lane, 1); }
    }
    __syncthreads();
    if (TID() < 192 && hist[TID()] > 0) atomicAdd(MCNT + TID(), hist[TID()]);
    __syncthreads();
}


DEV void ph_moe_scatter(const Params& p, int ntok, char* smem) {
    const int tid = TID();
    int* base = (int*)smem;
    int* lh = base + 192;
    const int* MCNT = (const int*)(p.ws + OFF_MCNT); int* CUR = (int*)(p.ws + OFF_MCNT) + 192;
    const int* EIDX = (const int*)(p.ws + OFF_EIDX); int* SORT = (int*)(p.ws + OFF_SORT);
    if (tid < 3) { int b = 0; for (int e = 0; e < 64; ++e) { base[tid * 64 + e] = b; b += (MCNT[tid * 64 + e] + 127) & ~127; } }
    if (tid < 192) lh[tid] = 0;
    __syncthreads();
    for (int i = blockIdx.x * NTHREADS + tid; i < ntok * 8; i += gridDim.x * NTHREADS) atomicAdd(lh + ((i >> 3) / MOE_CHUNK) * 64 + EIDX[i], 1);
    __syncthreads();
    if (tid < 192) { const int n = lh[tid]; if (n > 0) base[tid] += atomicAdd(CUR + tid, n); lh[tid] = 0; }
    __syncthreads();
    for (int i = blockIdx.x * NTHREADS + tid; i < ntok * 8; i += gridDim.x * NTHREADS) {
        const int ce = ((i >> 3) / MOE_CHUNK) * 64 + EIDX[i];
        SORT[(size_t)(ce >> 6) * SORT_CAP + base[ce] + atomicAdd(lh + ce, 1)] = i;
    }
    __syncthreads();
}

DEV void ph_moe_exp(const Params& p, int cb, int ce, char* smem, Topo tp) {
    typedef GC<2, 4> C;
    const int tid0 = TID();
    char* ACT = smem + 2 * C::STG;
    int* list = (int*)(smem + 3 * C::STG);
    int* cnt = list + 1024;
    const bf16_t* H2 = (const bf16_t*)(p.ws + OFF_HX); const int* EIDX = (const int*)(p.ws + OFF_EIDX); const float* EW = (const float*)(p.ws + OFF_EW);
    unsigned char* YB8 = (unsigned char*)(p.ws + OFF_YBUF); unsigned char* YSC = (unsigned char*)(p.ws + OFF_YSC);
    const int c = cb / MOE_CHUNK;
    const int* MCNT = (const int*)(p.ws + OFF_MCNT) + c * 64; const int* SORT = (const int*)(p.ws + OFF_SORT) + (size_t)c * SORT_CAP;
    int* tb = cnt + 16;
    const int xcd = tp.x, slot = tp.r, nslot = tp.n;
    __syncthreads();
    if (tid0 < 8) {
        const int tid = tid0; const int e = xcd + 8 * tid; int b = 0;
        for (int e2 = 0; e2 < e; ++e2) b += (MCNT[e2] + 127) & ~127;
        tb[16 + tid] = b; tb[32 + tid] = MCNT[e];
    }
    __syncthreads();
    if (tid0 == 0) { int t = 0; for (int k = 0; k < 8; ++k) { tb[k] = t; t += (tb[32 + k] + 127) >> 7; } tb[8] = t; }
    __syncthreads();
    const int total = tb[8];
    float* ewl = (float*)(list + 256);
    if (slot < total && tid0 < 128) {
        int k = 0;
        while (k < 7 && slot >= tb[k + 1]) ++k;
        const int j = slot - tb[k], M = min(128, tb[32 + k] - 128 * j);
        const int en = SORT[tb[16 + k] + 128 * j + min(tid0, M - 1)];
        list[tid0] = en; ewl[tid0] = EW[en];
    }
    int cur = 0;
#define GLDS4(gp, lp) __builtin_amdgcn_global_load_lds((const __attribute__((address_space(1))) void*)(gp), (__attribute__((address_space(3))) void*)(lp), 4, 0, 0)
    for (int lu = slot; lu < total; lu += nslot) {
        int tid = tid0; asm volatile("" : "+v"(tid));
        const int lane = tid & 63, wave = tid >> 6, wm = wave / 4, wn = wave % 4, fr = lane & 31, fh = lane >> 5;
        int k = 0;
        while (k < 7 && lu >= tb[k + 1]) ++k;
        const int e = xcd + 8 * k, j = lu - tb[k], M = min(128, tb[32 + k] - 128 * j);
        const int* lst = list + cur * 128; const float* ew = ewl + cur * 128;
        int* lst2 = list + (cur ^ 1) * 128; float* ew2 = ewl + (cur ^ 1) * 128;
        const bool has_next = lu + nslot < total;
        __syncthreads();
        if (has_next && tid < 128) {
            const int lu2 = lu + nslot; int k2 = 0;
            while (k2 < 7 && lu2 >= tb[k2 + 1]) ++k2;
            const int j2 = lu2 - tb[k2], M2 = min(128, tb[32 + k2] - 128 * j2);
            GLDS4(SORT + tb[16 + k2] + 128 * j2 + min(tid, M2 - 1), lst2 + tid);
        }
        const bf16_t* GU = (const bf16_t*)(p.ws + OFF_MGU) + (size_t)e * 256 * 1024;
        const bf16_t* DT = (const bf16_t*)(p.ws + OFF_MDT) + (size_t)e * 1024 * 128;
        {
            constexpr int mc = 0;
            f32x16 acc[2][2];
            {
            acc_zero(acc);
            gemm_tile<2, 4, 3, false, true>(acc, [&](int r) -> const bf16_t* { const int ix = min(mc + r, M - 1); return H2 + (size_t)(lst[ix] >> 3) * 1024; },
                                   GU, 1024, 0, 256, 1024, smem, nullptr);
            }
            const int crow = tid >> 3, cch = (tid & 7) ^ ((crow >> 1) & 7);
#define MG2_ISSUE(nt_) do { UNROLL for (int kt = 0; kt < 2; ++kt) UNROLL for (int i = 0; i < 4; ++i) \
                    GLDS16(DT + (size_t)((nt_) * 256 + ((crow + 64 * i) & ~31) + p32(crow & 31)) * 128 + kt * 64 + cch * 8, smem + kt * C::STG + C::AB + i * 8192 + tid * 16); } while (0)
            if (has_next && tid < 128) GLDS4(EW + lst2[tid], ew2 + tid);
            MG2_ISSUE(0);
            UNROLL for (int mi = 0; mi < 2; ++mi) {
                const int row = wm * 64 + mi * 32 + fr;
                const float gw = ew[row];
                float a[2][8];
                UNROLL for (int r = 0; r < 16; ++r) { const float gv = acc[mi][0][r], uv = acc[mi][1][r]; a[r >> 3][r & 7] = gv * frcp(1.f + __expf(-gv)) * uv * gw; }
                const int col0 = wn * 32 + 16 * fh, c0 = (col0 & 63) >> 3, swr = (row >> 1) & 7;
                char* arow_ = ACT + (col0 >> 6) * C::AB + row * 128;
                st8((bf16_t*)(arow_ + ((c0 ^ swr) << 4)), a[0]); st8((bf16_t*)(arow_ + (((c0 + 1) ^ swr) << 4)), a[1]);
            }
            __syncthreads();
            {
                const int sw = (fr >> 1) & 7, a_base = (wm * 64 + fr) * 128, b_base = (wn * 64 + fr) * 128;
                asm volatile("s_waitcnt vmcnt(0)" ::: "memory");
                _Pragma("unroll 1") for (int nt = 0; nt < 4; ++nt) {
                    __builtin_amdgcn_s_barrier();
                    asm volatile("" ::: "memory");
                    acc_zero(acc);
                    UNROLL for (int kt = 0; kt < 2; ++kt) {
                        const char* As_ = ACT + kt * C::AB; const char* Bs_ = smem + kt * C::STG + C::AB;
                        UNROLL for (int ks = 0; ks < 4; ++ks) {
                            const int off = ((2 * ks + fh) ^ sw) * 16;
                            bf16x8 af[2], bfv[2];
                            UNROLL for (int mi = 0; mi < 2; ++mi) af[mi] = *(const bf16x8*)(As_ + a_base + mi * 4096 + off);
                            UNROLL for (int ni = 0; ni < 2; ++ni) bfv[ni] = *(const bf16x8*)(Bs_ + b_base + ni * 4096 + off);
                            UNROLL for (int mi = 0; mi < 2; ++mi) UNROLL for (int ni = 0; ni < 2; ++ni)
                                acc[mi][ni] = __builtin_amdgcn_mfma_f32_32x32x16_bf16(bfv[ni], af[mi], acc[mi][ni], 0, 0, 0);
                        }
                    }
                    asm volatile("s_waitcnt lgkmcnt(0)" ::: "memory");
                    __builtin_amdgcn_s_barrier();
                    asm volatile("" ::: "memory");
                    if (nt < 3) MG2_ISSUE(nt + 1);
                    asm volatile("" ::: "memory");
                    UNROLL for (int mi = 0; mi < 2; ++mi) {
                        const int en = lst[wm * 64 + mi * 32 + fr] - cb * 8;
                        unsigned char* yrow = YB8 + (size_t)en * 1024 + nt * 256 + wn * 64 + 16 * fh;
                        unsigned char* srow = YSC + ((size_t)(en >> 3) * 64 + nt * 16 + wn * 4 + fh) * 8 + (en & 7);
                        UNROLL for (int ni = 0; ni < 2; ++ni) {
                            float m = 0.f;
                            UNROLL for (int i = 0; i < 16; ++i) m = fmaxf(m, fabsf(acc[mi][ni][i]));
                            const unsigned be = max(__float_as_uint(m) >> 23, 7u);
                            const float inv = __uint_as_float((261u - be) << 23);
                            u32x4 w;
                            UNROLL for (int q = 0; q < 4; ++q) {
                                int d = 0;
                                d = __builtin_amdgcn_cvt_pk_fp8_f32(acc[mi][ni][4 * q] * inv, acc[mi][ni][4 * q + 1] * inv, d, false);
                                d = __builtin_amdgcn_cvt_pk_fp8_f32(acc[mi][ni][4 * q + 2] * inv, acc[mi][ni][4 * q + 3] * inv, d, true);
                                if (q == 0) w.x = (unsigned)d; else if (q == 1) w.y = (unsigned)d; else if (q == 2) w.z = (unsigned)d; else w.w = (unsigned)d;
                            }
                            *(u32x4*)(yrow + ni * 32) = w;
                            srow[ni * 16] = (unsigned char)be;
                        }
                    }
                    asm volatile("s_waitcnt vmcnt(8)" ::: "memory");
                }
#undef MG2_ISSUE
            }
        }
        cur ^= 1;
    }
#undef GLDS4
}


#define XB_TMO      128
#define XB_XCNT(j)  (256  + 64 * (j))
#define XB_XSUB(j)  (1280 + 64 * (j))
#define XB_XGEN(j)  (2304 + 64 * (j))
#define XB_TOP      3328
#define XB_TOPGEN   3392
#define XCD_BAR_WORDS 3456
#define XB_SPIN_CAP (1u << 18)
#define LAS __attribute__((address_space(3)))

__device__ __forceinline__ unsigned xb_ld(unsigned* p)              { return __hip_atomic_load(p, __ATOMIC_RELAXED, __HIP_MEMORY_SCOPE_AGENT); }
__device__ __forceinline__ unsigned xb_add(unsigned* p, unsigned v) { return __hip_atomic_fetch_add(p, v, __ATOMIC_RELAXED, __HIP_MEMORY_SCOPE_AGENT); }
__device__ __forceinline__ unsigned xb_xcc_id() { return (unsigned)__builtin_amdgcn_s_getreg((3 << 11) | 20) & 0xFu; }
#define XB_SPIN(cond, bar) do { unsigned _sp = 0; while (cond) { __builtin_amdgcn_s_sleep(1); \
    if ((++_sp & 255u) == 0u) { if (xb_ld(&(bar)[XB_TMO])) break; if (_sp > XB_SPIN_CAP) { atomicAdd(&(bar)[XB_TMO], 1u); break; } } } } while (0)

struct XcdBarrier { unsigned* bar; unsigned x; volatile LAS unsigned* st; };

__device__ __forceinline__ XcdBarrier xcd_barrier_post(unsigned* bar, volatile LAS unsigned* st) {
    XcdBarrier b; b.bar = bar; b.x = xb_xcc_id(); b.st = st;
    if (threadIdx.x == 0) { const unsigned rank = xb_add(&bar[XB_XCNT(b.x)], 1u); st[2] = b.x; st[3] = rank; }
    return b;
}
__device__ __forceinline__ void xcd_barrier_complete(unsigned* bar, unsigned x, unsigned& nloc, unsigned& nx) {
    const unsigned G = gridDim.x * gridDim.y * gridDim.z;
    unsigned sum, cnt, mine, sp = 0u;
    for (;;) {
        sum = 0u; cnt = 0u; mine = 0u;
#pragma unroll
        for (unsigned j = 0; j < 16; ++j) { const unsigned c = xb_ld(&bar[XB_XCNT(j)]); sum += c; cnt += (c > 0u) ? 1u : 0u; mine = (j == x) ? c : mine; }
        if (sum == G) break;
        __builtin_amdgcn_s_sleep(1);
        if ((++sp & 255u) == 0u) { if (xb_ld(&bar[XB_TMO])) break; if (sp > XB_SPIN_CAP) { atomicAdd(&bar[XB_TMO], 1u); break; } }
    }
    nloc = mine > 0u ? mine : 1u; nx = cnt > 0u ? cnt : 1u;
}
__device__ __forceinline__ void xcd_barrier(const XcdBarrier& b) {
    asm volatile("s_waitcnt vmcnt(0)" ::: "memory");
    __syncthreads();
    if (threadIdx.x == 0) {
        unsigned* bar = b.bar;
        __builtin_amdgcn_s_waitcnt(0);
        unsigned nloc = b.st[0], nx = b.st[1];
        if (nloc == 0u) { xcd_barrier_complete(bar, b.x, nloc, nx); b.st[0] = nloc; b.st[1] = nx; }
        const unsigned old = xb_add(&bar[XB_XSUB(b.x)], 1u);
        const unsigned gen = old / nloc;
        if (old + 1u == (gen + 1u) * nloc) {
            __builtin_amdgcn_fence(__ATOMIC_RELEASE, "agent");
            asm volatile("s_waitcnt vmcnt(0)" ::: "memory");
            const unsigned og = xb_add(&bar[XB_TOP], 1u);
            const unsigned tg = og / nx;
            if (og + 1u == (tg + 1u) * nx) xb_add(&bar[XB_TOPGEN], 1u);
            else XB_SPIN(xb_ld(&bar[XB_TOPGEN]) == tg, bar);
            __builtin_amdgcn_fence(__ATOMIC_ACQUIRE, "agent");
            xb_add(&bar[XB_XGEN(b.x)], 1u);
            asm volatile("s_waitcnt vmcnt(0)" ::: "memory");
        } else {
            XB_SPIN(xb_ld(&bar[XB_XGEN(b.x)]) == gen, bar);
            __builtin_amdgcn_fence(__ATOMIC_ACQUIRE, "agent");
            asm volatile("s_waitcnt vmcnt(0)" ::: "memory");
        }
    }
    __syncthreads();
}

enum { PH_MODCONV = 0, PH_HX, PH_GEMM_R, PH_RW_PREP, PH_RW_SCAN, PH_RW_READ, PH_RW_G, PH_GEMM_N, PH_NA_NORM, PH_NA_ATT, PH_GEMM_M, PH_ML_SCAN, PH_ML_READ,
       PH_GEMM_G, PH_MERGE, PH_OUT, PH_NORM2, PH_ROUTER, PH_ROUTE, PH_SHARED, PH_MOE_EXP, PH_MOE_COMB, PH_COUNT };

template <int PH> DEV void run_phase(const Params& p, int L, int sub, char* smem, Topo tp) {
    const int tid = TID(), lane = tid & 63, fr = lane & 31, fh = lane >> 5;
    char* ws = p.ws;
    const int ntl = L == 0 ? NT : NX;
    const bf16_t* HX = (const bf16_t*)(ws + OFF_HX);
    const bf16_t* WINT = (const bf16_t*)(ws + OFF_WINT);
    if constexpr (PH == PH_MODCONV) { ph_mod(p, L, smem); ph_conv_mix(p, L, smem); }
    else if constexpr (PH == PH_HX) { ph_norm(p, L, 0, NT); }
    else if constexpr (PH == PH_GEMM_R || PH == PH_GEMM_M) {
        const int c0 = PH == PH_GEMM_R ? 0 : RW_COLS + NA_COLS;
        const int N = PH == PH_GEMM_R ? RW_COLS : ML_COLS;
        bf16_t* PX = (bf16_t*)(ws + OFF_PX);
        gemm256(HX, NT, WINT + (size_t)c0 * DM, N, DM, smem, tp, [&](int row, int col, const float (&v)[8]) {
            if (col < N) st8(PX + (size_t)row * N + col, v);
        });
    }
    else if constexpr (PH == PH_GEMM_N) {
        bf16_t* PX = (bf16_t*)(ws + OFF_PX); bf16_t* VT = (bf16_t*)(ws + OFF_VT); bf16_t* VTC = (bf16_t*)(ws + OFF_VTC);
        gemm256(HX, NT, WINT + (size_t)RW_COLS * DM, 1024, DM, smem, tp, [&](int row, int col, const float (&v)[8]) { st8(PX + (size_t)row * 1024 + col, v); });
        gemm_phase<4, 2>(HX, DM, NT, WINT + (size_t)(RW_COLS + 1024) * DM, DM, 512, DM, smem, tp, [&](const f32x16 (&acc)[2][2], int row0, int col0) {
            const int h = col0 >> 6;
            epi_cols(acc, smem, [&](int r8, int col, const float (&v)[8]) {
                const int n = row0 + r8;
                bf16_t* dst = n < NX ? VT + ((size_t)((n >> 11) * 8 + h) * 64 + col) * SEQ + (n & 2047)
                                     : VTC + ((size_t)(((n - NX) >> 8) * 8 + h) * 64 + col) * CTXL + ((n - NX) & 255);
                st8(dst, v);
            });
        });
    }
    else if constexpr (PH == PH_RW_PREP) { ph_rw_prep(p, L, smem); }
    else if constexpr (PH == PH_RW_SCAN) { ph_rw_scan(p, L, smem); }
    else if constexpr (PH == PH_RW_READ) { ph_rw_read(p, L, ntl); }
    else if constexpr (PH == PH_RW_G) {
        bf16_t* YA = (bf16_t*)(ws + OFF_YA);
        gemm_phase<4, 2>((const bf16_t*)(ws + OFF_SGB), 128, ntl, (const bf16_t*)(ws + OFF_G2T), 128, 512, 128, smem, tp, [&](const f32x16 (&acc)[2][2], int row0, int col0) {
            epi_rows(acc, smem, [&](int row, int c8, const float (&v)[8]) {
                bf16_t* q = YA + (size_t)(row0 + row) * 512 + col0 + c8;
                float y[8]; ld8(q, y);
                UNROLL for (int i = 0; i < 8; ++i) y[i] *= v[i];
                st8(q, y);
            });
        });
    }
    else if constexpr (PH == PH_NA_NORM) { ph_na_norm(p, L); }
    else if constexpr (PH == PH_NA_ATT) { ph_na_att(p, L, smem); }
    else if constexpr (PH == PH_ML_SCAN) {
        if (blockIdx.x < 128 || gridDim.x <= 128) ph_ml_scan(p, L, smem);
        if (gridDim.x <= 128) ph_conv_moe_gu(p, L, smem, blockIdx.x, gridDim.x);
        else if (blockIdx.x >= 128) ph_conv_moe_gu(p, L, smem, blockIdx.x - 128, gridDim.x - 128);
    }
    else if constexpr (PH == PH_ML_READ) { ph_ml_read(p, L, ntl); }
    else if constexpr (PH == PH_GEMM_G) {
        bf16_t* G = (bf16_t*)(ws + OFF_GATES);
        gemm256(HX, ntl, WINT + (size_t)(RW_COLS + NA_COLS + ML_COLS) * DM, GATE_COLS, DM, smem, tp, [&](int row, int col, const float (&v)[8]) {
            float y[8];
            UNROLL for (int i = 0; i < 8; ++i) y[i] = sigm(v[i]);
            st8(G + (size_t)row * GATE_COLS + col, y);
        });
    }
    else if constexpr (PH == PH_MERGE) {
        typedef GC<2, 4> C;
        const bf16_t* G = (const bf16_t*)(ws + OFF_GATES); bf16_t* MG = (bf16_t*)(ws + OFF_HX);
        const int wave = tid >> 6, wm = wave / 4, wn = wave % 4;
        const TileOrder ord(tp, ntl / C::BM, DM / C::BN);
        for (int q = tp.r; q < ord.total; q += tp.n) {
            int pm, pn; if (!ord.get(q, pm, pn)) continue;
            int tido = tid; asm volatile("" : "+v"(tido));
            const int fro = tido & 31, fho = (tido & 63) >> 5;
            const size_t row0 = (size_t)pm * C::BM + wm * 64 + fro; const int col0 = pn * C::BN + wn * 64 + 16 * fho;
            f32x16 tot[2][2], acc[2][2]; acc_zero(tot); acc_zero(acc);
            u32x4 graw[2][2][2];
#define MRG_GATES(br_) do { UNROLL for (int mi = 0; mi < 2; ++mi) UNROLL for (int ni = 0; ni < 2; ++ni) UNROLL for (int hh = 0; hh < 2; ++hh) \
                graw[mi][ni][hh] = *(const u32x4*)(G + (row0 + mi * 32) * GATE_COLS + (br_) * DM + col0 + ni * 32 + 8 * hh); } while (0)
            MRG_GATES(0);
            const bf16_t* Ab = (const bf16_t*)(ws + OFF_YA) + (size_t)pm * C::BM * 512;
            gemm_tile<2, 4, 3, false, true>(acc, [&](int r) { return Ab + (size_t)r * 512; }, (const bf16_t*)(ws + OFF_WBT), 512, pn * C::BN, DM, 1536, smem, nullptr,
                [](int kt) { return (size_t)(kt >> 3) * (SZ_Y1 / 2) + (size_t)(kt & 7) * 64; },
                [](int kt) { return (size_t)(kt >> 3) * ((size_t)1024 * 512) + (size_t)(kt & 7) * 64; },
                [&](int kt) {
                    if ((kt & 7) == 7) {
                        UNROLL for (int mi = 0; mi < 2; ++mi) UNROLL for (int ni = 0; ni < 2; ++ni) UNROLL for (int hh = 0; hh < 2; ++hh) {
                            float g[8]; unpack8(graw[mi][ni][hh], g);
                            UNROLL for (int i = 0; i < 8; ++i) { tot[mi][ni][8 * hh + i] += g[i] * acc[mi][ni][8 * hh + i]; acc[mi][ni][8 * hh + i] = 0.f; }
                        }
                        if (kt < 23) MRG_GATES((kt >> 3) + 1);
                    }
                });
#undef MRG_GATES
            UNROLL for (int mi = 0; mi < 2; ++mi) UNROLL for (int ni = 0; ni < 2; ++ni) UNROLL for (int hh = 0; hh < 2; ++hh) {
                float v[8]; UNROLL for (int i = 0; i < 8; ++i) v[i] = tot[mi][ni][8 * hh + i];
                st8(MG + (row0 + mi * 32) * DM + col0 + ni * 32 + 8 * hh, v);
            }
        }
    }
    else if constexpr (PH == PH_OUT) {
        const float* MOD = (const float*)(ws + OFF_MOD);
        gemm256(HX, ntl, (const bf16_t*)(ws + OFF_WOUTT), DM, DM, smem, tp, [&](int n, int c, const float (&v)[8]) {
            const float* xp = xprev_row(p, L, n) + c; float* xo = xs_row(p, n) + c; const float* g1 = MOD + mod_row(n) * 6144 + 2 * DM + c;
            const float4 xa = *(const float4*)xp, xb = *(const float4*)(xp + 4), ga = *(const float4*)g1, gb = *(const float4*)(g1 + 4);
            float4 oa, ob;
            oa.x = xa.x + ga.x * v[0]; oa.y = xa.y + ga.y * v[1]; oa.z = xa.z + ga.z * v[2]; oa.w = xa.w + ga.w * v[3];
            ob.x = xb.x + gb.x * v[4]; ob.y = xb.y + gb.y * v[5]; ob.z = xb.z + gb.z * v[6]; ob.w = xb.w + gb.w * v[7];
            *(float4*)xo = oa; *(float4*)(xo + 4) = ob;
        });
    }
    else if constexpr (PH == PH_NORM2) {
        if (blockIdx.x == 0 && tid < 384) ((int*)(ws + OFF_MCNT))[tid] = 0;
        ph_norm(p, L, 1, ntl);
    }
    else if constexpr (PH == PH_ROUTER) {
        typedef GC<4, 2> C;
        float* LOG = (float*)(ws + OFF_LOG);
        const bf16_t* H2LO = (const bf16_t*)(ws + OFF_H2LO); const bf16_t* RH = (const bf16_t*)(ws + OFF_RTR); const bf16_t* RL = RH + 64 * 1024;
        const int wave = tid >> 6, wm = wave / 2, wn = wave % 2;
        {
            const int nrt = ntl / C::BM, G = gridDim.x;
            if (G > nrt) { if ((int)blockIdx.x >= nrt) ph_conv_moe(p, L, smem, blockIdx.x - nrt, G - nrt); }
            else ph_conv_moe(p, L, smem, blockIdx.x, G);
        }
        for (int t = blockIdx.x; t < ntl / C::BM; t += gridDim.x) {
            f32x16 acc[2][2]; acc_zero(acc);
            const bf16_t* A0 = HX + (size_t)t * C::BM * DM; const bf16_t* A1 = H2LO + (size_t)t * C::BM * DM;
            gemm_tile<4, 2, 3, false>(acc, [&](int r) { return A0 + (size_t)r * DM; }, RH, DM, 0, 64, DM, smem, nullptr);
            gemm_tile<4, 2, 3, false>(acc, [&](int r) { return A1 + (size_t)r * DM; }, RH, DM, 0, 64, DM, smem, nullptr);
            gemm_tile<4, 2, 3, false>(acc, [&](int r) { return A0 + (size_t)r * DM; }, RL, DM, 0, 64, DM, smem, nullptr);
            epi_rows(acc, smem, [&](int row, int c8, const float (&v)[8]) {
                if (wn == 0) {
                    float* q = LOG + (size_t)(t * C::BM + wm * 64 + row) * 64 + c8;
                    *(float4*)q = make_float4(v[0], v[1], v[2], v[3]); *(float4*)(q + 4) = make_float4(v[4], v[5], v[6], v[7]);
                }
            });
        }
    }
    else if constexpr (PH == PH_ROUTE) { ph_route(p, L, ntl, smem); }
    else if constexpr (PH == PH_SHARED) {
        ph_moe_scatter(p, ntl, smem);
        bf16_t* SA = (bf16_t*)(ws + OFF_SA);
        gemm256_pair(HX, ntl, (const bf16_t*)(ws + OFF_SGUT), 512, DM, smem, tp, [&](int row, int col, const float (&g)[8], const float (&u)[8]) {
            float a[8];
            UNROLL for (int i = 0; i < 8; ++i) a[i] = g[i] * frcp(1.f + __expf(-g[i])) * u[i];
            st8(SA + (size_t)row * 256 + (col >> 8) * 128 + (col & 127), a);
        });
    }
    else if constexpr (PH == PH_MOE_EXP) { const int cb = sub * MOE_CHUNK; ph_moe_exp(p, cb, min(cb + MOE_CHUNK, ntl), smem, tp); }
    else if constexpr (PH == PH_MOE_COMB) {
        const int cb = sub * MOE_CHUNK, ce = min(cb + MOE_CHUNK, ntl);
        const float* MOD = (const float*)(ws + OFF_MOD); const unsigned char* YB8 = (const unsigned char*)(ws + OFF_YBUF); const unsigned char* YSC = (const unsigned char*)(ws + OFF_YSC);
        gemm256((const bf16_t*)(ws + OFF_SA) + (size_t)cb * 256, ce - cb, (const bf16_t*)(ws + OFF_SDT), DM, 256, smem, tp, [&](int rl, int c, const float (&v)[8]) {
            const int n = cb + rl;
            float s[8];
            UNROLL for (int i = 0; i < 8; ++i) s[i] = v[i];
            const u32x2 sc = *(const u32x2*)(YSC + ((size_t)rl * 64 + (c >> 4)) * 8);
            const unsigned long long sc64 = (unsigned long long)sc.x | ((unsigned long long)sc.y << 32);
            _Pragma("unroll 2") for (int k = 0; k < 8; ++k) {
                const u32x2 d = *(const u32x2*)(YB8 + ((size_t)rl * 8 + k) * DM + c);
                const unsigned be = (unsigned)(sc64 >> (8 * k)) & 255u;
                const float scl = __uint_as_float((be - 7u) << 23);
                typedef float f2v __attribute__((ext_vector_type(2)));
                const f2v y0 = __builtin_amdgcn_cvt_pk_f32_fp8((int)d.x, false), y1 = __builtin_amdgcn_cvt_pk_f32_fp8((int)d.x, true);
                const f2v y2 = __builtin_amdgcn_cvt_pk_f32_fp8((int)d.y, false), y3 = __builtin_amdgcn_cvt_pk_f32_fp8((int)d.y, true);
                s[0] += y0.x * scl; s[1] += y0.y * scl; s[2] += y1.x * scl; s[3] += y1.y * scl;
                s[4] += y2.x * scl; s[5] += y2.y * scl; s[6] += y3.x * scl; s[7] += y3.y * scl;
            }
            float* xo = xs_row(p, n) + c; const float* g2 = MOD + mod_row(n) * 6144 + 5 * DM + c;
            float4 xa = *(const float4*)xo, xb = *(const float4*)(xo + 4); const float4 ga = *(const float4*)g2, gb = *(const float4*)(g2 + 4);
            xa.x += ga.x * s[0]; xa.y += ga.y * s[1]; xa.z += ga.z * s[2]; xa.w += ga.w * s[3];
            xb.x += gb.x * s[4]; xb.y += gb.y * s[5]; xb.z += gb.z * s[6]; xb.w += gb.w * s[7];
            *(float4*)xo = xa; *(float4*)(xo + 4) = xb;
        });
    }
}

#ifndef N_LAUNCH_MODE
#define N_LAUNCH_MODE 1
#endif
#if N_LAUNCH_MODE == 0
template <int PH> __global__ void __launch_bounds__(NTHREADS, 2) k_phase(Params p, int L, int sub) {
    extern __shared__ __attribute__((aligned(16))) char smem[];
    run_phase<PH>(p, L, sub, smem, Topo{(int)(blockIdx.x & 7), (int)(blockIdx.x >> 3), (int)((gridDim.x + 7 - (blockIdx.x & 7)) >> 3)});
}
#endif


#ifndef MEGA_SKIP
#define MEGA_SKIP 0ull
#endif
#ifndef MEGA_REPEAT
#define MEGA_REPEAT 0ull
#endif
#define BARRIER() do { XcdBarrier b2_ = bar; unsigned so_ = LDS_BYTES; asm volatile("" : "+v"(so_)); b2_.st = (volatile LAS unsigned*)(smem + so_); xcd_barrier(b2_); } while (0)
#define PHASE(PH, sub) do { if constexpr (!((MEGA_SKIP >> PH) & 1ull)) { run_phase<PH>(p, L, sub, smem, tp); BARRIER(); if constexpr ((MEGA_REPEAT >> PH) & 1ull) { run_phase<PH>(p, L, sub, smem, tp); BARRIER(); } } } while (0)
__global__ void __launch_bounds__(NTHREADS, 2) k_mega(Params p) {
    extern __shared__ __attribute__((aligned(16))) char smem[];
    volatile LAS unsigned* st = (volatile LAS unsigned*)(smem + LDS_BYTES);
    if (threadIdx.x == 0) { st[0] = 0u; st[1] = 0u; st[2] = 0u; st[3] = 0u; }
    __syncthreads();
    const XcdBarrier bar = xcd_barrier_post((unsigned*)(p.ws + OFF_BAR), st);
    Topo tp{(int)(blockIdx.x & 7), (int)(blockIdx.x >> 3), (int)((gridDim.x + 7 - (blockIdx.x & 7)) >> 3)};
    for (int L = 0; L < 2; ++L) {
        const int ntl = L == 0 ? NT : NX;
        PHASE(PH_MODCONV, 0);
        if (st[1] == 8u && st[0] != 0u) { tp.x = (int)st[2]; tp.r = (int)st[3]; tp.n = (int)st[0]; }
        PHASE(PH_HX, 0);
        PHASE(PH_GEMM_R, 0);
        PHASE(PH_RW_PREP, 0);
        PHASE(PH_RW_SCAN, 0);
        PHASE(PH_RW_READ, 0);
        PHASE(PH_RW_G, 0);
        PHASE(PH_GEMM_N, 0);
        PHASE(PH_NA_ATT, 0);
        PHASE(PH_GEMM_M, 0);
        PHASE(PH_ML_SCAN, 0);
        PHASE(PH_ML_READ, 0);
        PHASE(PH_GEMM_G, 0);
        PHASE(PH_MERGE, 0);
        PHASE(PH_OUT, 0);
        PHASE(PH_NORM2, 0);
        PHASE(PH_ROUTER, 0);
        PHASE(PH_ROUTE, 0);
        PHASE(PH_SHARED, 0);
        for (int c = 0; c * MOE_CHUNK < ntl; ++c) {
            PHASE(PH_MOE_EXP, c);
            PHASE(PH_MOE_COMB, c);
        }
    }
}

#if N_LAUNCH_MODE == 0
template <int PH> static void launch_phase(const Params& p, int L, int sub, hipStream_t stream) {
    static bool attr = false;
    if (!attr) { (void)hipFuncSetAttribute((const void*)k_phase<PH>, hipFuncAttributeMaxDynamicSharedMemorySize, LDS_BYTES); attr = true; }
    hipLaunchKernelGGL(k_phase<PH>, dim3(256), dim3(NTHREADS), LDS_BYTES, stream, p, L, sub);
}
#endif

extern "C" void kernel_launch(void* const* d_in, const int* in_sizes, int n_in, void* d_out, int out_size, void* d_ws, size_t ws_size, hipStream_t stream) {
    if (n_in != N_IN || ws_size < WS_END) { fprintf(stderr, "kernel_launch: unexpected inputs (%d) or workspace (%zu < %zu)\n", n_in, ws_size, (size_t)WS_END); return; }
    Params p{};
    for (int i = 0; i < N_IN; ++i) p.in[i] = (const float*)d_in[i];
    p.out = (float*)d_out; p.ws = (char*)d_ws;
#if N_LAUNCH_MODE == 1
    static int grid = 0;
    if (grid == 0) {
        int dev = 0, cus = 0;
        if (hipGetDevice(&dev) != hipSuccess || hipDeviceGetAttribute(&cus, hipDeviceAttributeMultiprocessorCount, dev) != hipSuccess) { grid = -1; return; }
        if (hipFuncSetAttribute((const void*)k_mega, hipFuncAttributeMaxDynamicSharedMemorySize, LDS_BYTES + 256) != hipSuccess) { grid = -1; return; }
        grid = cus;
    }
    if (grid <= 0) return;
    (void)hipMemsetAsync((char*)d_ws + OFF_BAR, 0, XCD_BAR_WORDS * sizeof(unsigned), stream);
    hipLaunchKernelGGL(k_mega, dim3(grid), dim3(NTHREADS), LDS_BYTES + 256, stream, p);
    return;
#endif
#if N_LAUNCH_MODE == 0
    for (int L = 0; L < 2; ++L) {
        const int ntl = L == 0 ? NT : NX;
        launch_phase<PH_MODCONV>(p, L, 0, stream);
        launch_phase<PH_HX>(p, L, 0, stream);
        launch_phase<PH_GEMM_R>(p, L, 0, stream);
        launch_phase<PH_RW_PREP>(p, L, 0, stream);
        launch_phase<PH_RW_SCAN>(p, L, 0, stream);
        launch_phase<PH_RW_READ>(p, L, 0, stream);
        launch_phase<PH_RW_G>(p, L, 0, stream);
        launch_phase<PH_GEMM_N>(p, L, 0, stream);
        launch_phase<PH_NA_ATT>(p, L, 0, stream);
        launch_phase<PH_GEMM_M>(p, L, 0, stream);
        launch_phase<PH_ML_SCAN>(p, L, 0, stream);
        launch_phase<PH_ML_READ>(p, L, 0, stream);
        launch_phase<PH_GEMM_G>(p, L, 0, stream);
        launch_phase<PH_MERGE>(p, L, 0, stream);
        launch_phase<PH_OUT>(p, L, 0, stream);
        launch_phase<PH_NORM2>(p, L, 0, stream);
        launch_phase<PH_ROUTER>(p, L, 0, stream);
        launch_phase<PH_ROUTE>(p, L, 0, stream);
        launch_phase<PH_SHARED>(p, L, 0, stream);
        for (int c = 0; c * MOE_CHUNK < ntl; ++c) {
            launch_phase<PH_MOE_EXP>(p, L, c, stream);
            launch_phase<PH_MOE_COMB>(p, L, c, stream);
        }
    }
#endif
}
```

```cpp
#include <hip/hip_runtime.h>
#include <stdint.h>
#include <stdio.h>

#define DEV __device__ __forceinline__
#define UNROLL _Pragma("unroll")

typedef unsigned short bf16_t;
typedef short bf16x8 __attribute__((ext_vector_type(8)));
typedef float f32x16 __attribute__((ext_vector_type(16)));
typedef float f32x4v __attribute__((ext_vector_type(4)));
typedef unsigned u32x4 __attribute__((ext_vector_type(4)));
typedef unsigned u32x2 __attribute__((ext_vector_type(2)));

constexpr int DM = 1024, NBATCH = 16, SEQ = 2048, CTXL = 256;
constexpr int NX = NBATCH * SEQ, NC = NBATCH * CTXL, NT = NX + NC;
constexpr int RW_COLS = 1920, NA_COLS = 1536, ML_COLS = 1552, GATE_COLS = 3072, IN_COLS = 8080;
constexpr int NTHREADS = 512;
constexpr int MOE_CHUNK = 16384, MOE_ST = 768;

enum { I_X = 0, I_C, I_CTX, I_CCTX, I_WADA, I_BADA, I_N1G, I_N2G, I_WIN, I_MU, I_W0, I_W2, I_A0, I_A2, I_KK, I_KA, I_RK, I_G2,
       I_LNG, I_LNB, I_V0, I_V1, I_V2, I_QNG, I_KNG, I_RPB, I_IB, I_FB, I_MNG, I_WBR, I_WOUT, I_RTR, I_MB, I_MWG, I_MWU, I_MWD,
       I_SG, I_SU, I_SD, N_IN };

constexpr size_t OFF_BAR = 0;
constexpr size_t OFF_MOD = 16384;
constexpr size_t OFF_WINT = OFF_MOD + 417792;
constexpr size_t OFF_WBT = OFF_WINT + (size_t)IN_COLS * 1024 * 2;
constexpr size_t OFF_WOUTT = OFF_WBT + (size_t)3 * 1024 * 512 * 2;
constexpr size_t OFF_SGUT = OFF_WOUTT + (size_t)1024 * 1024 * 2;
constexpr size_t OFF_SDT = OFF_SGUT + (size_t)512 * 1024 * 2;
constexpr size_t OFF_G2T = OFF_SDT + (size_t)1024 * 256 * 2;
constexpr size_t OFF_RTR = OFF_G2T + (size_t)512 * 128 * 2;
constexpr size_t OFF_CTXS = OFF_RTR + (size_t)2 * 64 * 1024 * 2;
constexpr size_t OFF_VF = OFF_CTXS + (size_t)NC * 1024 * 4;
constexpr size_t OFF_HX = OFF_VF + (size_t)NT * 512 * 2;
constexpr size_t OFF_BIG = OFF_HX + (size_t)NT * 1024 * 2;
constexpr size_t SZ_Y1 = (size_t)NT * 512 * 2;
constexpr size_t OFF_YA = OFF_BIG, OFF_YB = OFF_YA + SZ_Y1, OFF_YC = OFF_YB + SZ_Y1;
constexpr size_t OFF_PX = OFF_BIG + 3 * SZ_Y1;
constexpr size_t OFF_SCR = OFF_PX + (size_t)NT * RW_COLS * 2;
constexpr size_t SZ_SCR = (size_t)NT * 1152 * 2;
constexpr size_t OFF_MGU = OFF_SCR + SZ_SCR;
constexpr size_t WS_END = OFF_MGU + (size_t)64 * 256 * 1024 * 2;
constexpr size_t OFF_YS = OFF_YB;
constexpr size_t OFF_SGB = OFF_SCR;
constexpr size_t OFF_CB = OFF_SCR + (size_t)NT * 128 * 2;
constexpr size_t OFF_HS = OFF_SCR;
constexpr size_t OFF_VT = OFF_PX + (size_t)NT * 1024 * 2;
constexpr size_t OFF_VTC = OFF_VT + (size_t)NX * 512 * 2;
constexpr size_t OFF_GATES = OFF_PX;
constexpr size_t OFF_MDT = OFF_BIG;
constexpr size_t OFF_SA = OFF_MDT + (size_t)64 * 1024 * 128 * 2;
constexpr size_t OFF_EIDX = OFF_SA + (size_t)NT * 256 * 2;
constexpr size_t OFF_EW = OFF_EIDX + (size_t)NT * 8 * 4;
constexpr int SORT_CAP = MOE_CHUNK * 8 + 64 * 128;
constexpr size_t OFF_SORT = OFF_EW + (size_t)NT * 8 * 4;
constexpr size_t OFF_LOG = OFF_SORT + (size_t)3 * SORT_CAP * 4;
constexpr size_t OFF_H2LO = OFF_LOG + (size_t)NT * 64 * 4;
constexpr size_t OFF_YBUF = OFF_LOG;
constexpr size_t OFF_YSC = OFF_YBUF + (size_t)MOE_CHUNK * 8 * 1024;
static_assert(OFF_YSC + (size_t)MOE_CHUNK * 512 <= WS_END, "moe layout");
static_assert(OFF_GATES + (size_t)NT * 3072 * 2 <= WS_END, "gates layout");
static_assert(WS_END <= (size_t)536870912, "workspace");

constexpr size_t OFF_MCNT = OFF_BAR + 14336;
constexpr int LDS_BYTES = 155648;

struct Topo { int x, r, n; };
struct Params {
    const float* in[N_IN];
    float* out;
    char* ws;
};

DEV int TID() { int t = threadIdx.x; asm volatile("" : "+v"(t)); return t; }
DEV float bf2f(bf16_t h) { return __uint_as_float(((unsigned)h) << 16); }
typedef __bf16 bf16x2n __attribute__((ext_vector_type(2)));
typedef float f32x2n __attribute__((ext_vector_type(2)));
DEV unsigned pk2(float lo, float hi) { const f32x2n v = {lo, hi}; return __builtin_bit_cast(unsigned, __builtin_convertvector(v, bf16x2n)); }
DEV bf16_t f2bf(float f) { return (bf16_t)(pk2(f, 0.f) & 0xffffu); }
DEV void ld8(const bf16_t* p, float (&o)[8]) {
    const u32x4 v = *(const u32x4*)p;
    o[0] = __uint_as_float(v.x << 16); o[1] = __uint_as_float(v.x & 0xffff0000u);
    o[2] = __uint_as_float(v.y << 16); o[3] = __uint_as_float(v.y & 0xffff0000u);
    o[4] = __uint_as_float(v.z << 16); o[5] = __uint_as_float(v.z & 0xffff0000u);
    o[6] = __uint_as_float(v.w << 16); o[7] = __uint_as_float(v.w & 0xffff0000u);
}
DEV void st8(bf16_t* p, const float (&v)[8]) {
    u32x4 o; o.x = pk2(v[0], v[1]); o.y = pk2(v[2], v[3]); o.z = pk2(v[4], v[5]); o.w = pk2(v[6], v[7]);
    *(u32x4*)p = o;
}
#define DPP_MOV(v, ctrl) __builtin_bit_cast(float, __builtin_amdgcn_update_dpp(0, __builtin_bit_cast(int, (v)), (ctrl), 0xF, 0xF, true))
DEV float sum8(float v) { v += DPP_MOV(v, 0xB1); v += DPP_MOV(v, 0x4E); v += DPP_MOV(v, 0x141); return v; }
DEV float frcp(float x) { return __builtin_amdgcn_rcpf(x); }
DEV float sigm(float x) { return frcp(1.f + __expf(-x)); }
DEV float sigm_acc(float x) { return 1.f / (1.f + expf(-x)); }
DEV float tanh_fast(float x) { return 1.f - 2.f * frcp(1.f + __expf(2.f * x)); }
DEV float softplus_fast(float x) { return fmaxf(x, 0.f) + __logf(1.f + __expf(-fabsf(x))); }
DEV int mod_row(int n) { return n < NX ? (n >> 11) : 16; }
DEV float* xs_row(const Params& p, int n) { return n < NX ? p.out + (size_t)n * DM : (float*)(p.ws + OFF_CTXS) + (size_t)(n - NX) * DM; }
DEV const float* xprev_row(const Params& p, int L, int n) {
    if (L == 0) return n < NX ? p.in[I_X] + (size_t)n * DM : p.in[I_CTX] + (size_t)(n - NX) * DM;
    return xs_row(p, n);
}
DEV void seq_of(int n, int& nb, int& tt, int& T) {
    if (n < NX) { nb = n & ~2047; tt = n & 2047; T = SEQ; } else { const int m = n - NX; nb = NX + (m & ~255); tt = m & 255; T = CTXL; }
}
DEV void shift8(const bf16_t* z, int ld, int nb, int tt, int T, int col0, const float* mu, float (&o)[8]) {
    float c[8], l[8], r[8];
    ld8(z + (size_t)(nb + tt) * ld + col0, c);
    if (tt > 0) ld8(z + (size_t)(nb + tt - 1) * ld + col0, l); else { UNROLL for (int i = 0; i < 8; ++i) l[i] = 0.f; }
    if (tt < T - 1) ld8(z + (size_t)(nb + tt + 1) * ld + col0, r); else { UNROLL for (int i = 0; i < 8; ++i) r[i] = 0.f; }
    UNROLL for (int i = 0; i < 8; ++i) o[i] = c[i] + mu[col0 + i] * (0.5f * (l[i] + r[i]) - c[i]);
}

constexpr int LROW = 144;
template <int WM, int WN> struct GC {
    static constexpr int BM = 64 * WM, BN = 64 * WN;
    static constexpr int AB = BM * 128, BB = BN * 128, STG = AB + BB;
    static constexpr int NA = BM / 64, NBC = BN / 64;
};
DEV void acc_zero(f32x16 (&acc)[2][2]) {
    UNROLL for (int a = 0; a < 2; ++a) UNROLL for (int b = 0; b < 2; ++b) UNROLL for (int r = 0; r < 16; ++r) acc[a][b][r] = 0.f;
}
#define GLDS16(gp, lp) __builtin_amdgcn_global_load_lds((const __attribute__((address_space(1))) void*)(gp), (__attribute__((address_space(3))) void*)(lp), 16, 0, 0)
DEV int p32(int s) { return 16 * ((s >> 2) & 1) + (s & 3) + 4 * (s >> 3); }
struct KLin { DEV size_t operator()(int kt) const { return (size_t)kt * 64; } };
struct NoHook { DEV void operator()(int) const {} };
template <int WM, int WN, int NS, bool A_LDS, bool TR = false, class ARow, class KA = KLin, class KB = KLin, class Hook = NoHook>
DEV void gemm_tile(f32x16 (&acc)[2][2], ARow arow, const bf16_t* Bt, int ldb, int n0, int Nvalid, int K, char* smem, const char* alds, KA koa = KA(), KB kob = KB(), Hook hook = Hook()) {
    typedef GC<WM, WN> C;
    constexpr int LPT = (A_LDS ? 0 : C::NA) + C::NBC;
    const int tid = TID(), lane = tid & 63, wave = tid >> 6, wm = wave / WN, wn = wave % WN;
    const int fr = lane & 31, fh = lane >> 5;
    const int crow = tid >> 3, cch = (tid & 7) ^ ((crow >> 1) & 7);
    const bf16_t* pa[C::NA]; const bf16_t* pb[C::NBC];
    if (!A_LDS) { UNROLL for (int i = 0; i < C::NA; ++i) pa[i] = arow(crow + 64 * i) + cch * 8; }
    UNROLL for (int i = 0; i < C::NBC; ++i) { const int rb = crow + 64 * i, n = min(n0 + (TR ? (rb & ~31) + p32(rb & 31) : rb), Nvalid - 1); pb[i] = Bt + (size_t)n * ldb + cch * 8; }
    const int nk = K >> 6;
#define GT_ISSUE(kt, stg) do { char* sb_ = smem + (stg) * C::STG + tid * 16; \
        if (!A_LDS) { UNROLL for (int i = 0; i < C::NA; ++i) GLDS16(pa[i] + koa(kt), sb_ + i * 8192); } \
        UNROLL for (int i = 0; i < C::NBC; ++i) GLDS16(pb[i] + kob(kt), sb_ + C::AB + i * 8192); } while (0)
    const int sw = (fr >> 1) & 7;
    int offk[4];
    UNROLL for (int ks = 0; ks < 4; ++ks) offk[ks] = ((2 * ks + fh) ^ sw) * 16;
    const int a_base = (wm * 64 + fr) * 128, b_base = (wn * 64 + fr) * 128;
    UNROLL for (int s = 0; s < NS - 1; ++s) if (s < nk) GT_ISSUE(s, s);
    int stg = 0, nstg = NS - 1;
    for (int kt = 0; kt < nk; ++kt) {
        if (NS == 3 && kt + 1 < nk) asm volatile("s_waitcnt vmcnt(%0)" :: "n"(LPT) : "memory");
        else asm volatile("s_waitcnt vmcnt(0)" ::: "memory");
        __builtin_amdgcn_s_barrier();
        asm volatile("" ::: "memory");
        const bool more = kt + NS - 1 < nk;
        const char* As_ = A_LDS ? alds + kt * C::AB : smem + stg * C::STG; const char* Bs_ = smem + stg * C::STG + C::AB;
        char* db_ = smem + nstg * C::STG + tid * 16;
        bf16x8 af[2][2], bfv[2][2];
        UNROLL for (int mi = 0; mi < 2; ++mi) af[0][mi] = *(const bf16x8*)(As_ + a_base + mi * 4096 + offk[0]);
        UNROLL for (int ni = 0; ni < 2; ++ni) bfv[0][ni] = *(const bf16x8*)(Bs_ + b_base + ni * 4096 + offk[0]);
        UNROLL for (int ks = 0; ks < 4; ++ks) {
            const int cur = ks & 1, nxt = cur ^ 1;
            if (ks < 3) {
                UNROLL for (int mi = 0; mi < 2; ++mi) af[nxt][mi] = *(const bf16x8*)(As_ + a_base + mi * 4096 + offk[ks + 1]);
                UNROLL for (int ni = 0; ni < 2; ++ni) bfv[nxt][ni] = *(const bf16x8*)(Bs_ + b_base + ni * 4096 + offk[ks + 1]);
            }
            UNROLL for (int mi = 0; mi < 2; ++mi) UNROLL for (int ni = 0; ni < 2; ++ni)
                acc[mi][ni] = TR ? __builtin_amdgcn_mfma_f32_32x32x16_bf16(bfv[cur][ni], af[cur][mi], acc[mi][ni], 0, 0, 0)
                                 : __builtin_amdgcn_mfma_f32_32x32x16_bf16(af[cur][mi], bfv[cur][ni], acc[mi][ni], 0, 0, 0);
            if (more) {
                UNROLL for (int pc = 0; pc < LPT; ++pc) if (pc * 4 / LPT == ks) {
                    if (!A_LDS && pc < C::NA) GLDS16(pa[pc] + koa(kt + NS - 1), db_ + pc * 8192);
                    else { const int ib = pc - (A_LDS ? 0 : C::NA); GLDS16(pb[ib] + kob(kt + NS - 1), db_ + C::AB + ib * 8192); }
                }
            }
            __builtin_amdgcn_sched_barrier(0);
        }
        hook(kt);
        stg = stg + 1 == NS ? 0 : stg + 1; nstg = nstg + 1 == NS ? 0 : nstg + 1;
    }
    __syncthreads();
#undef GT_ISSUE
}
#define ACC_ROW(mi, r, fh) ((mi) * 32 + ((r) & 3) + 8 * ((r) >> 2) + 4 * (fh))

constexpr int EPI_SLAB = 32 * 68 * 4;
template <class F> DEV void epi_rows(const f32x16 (&acc)[2][2], char* smem, F f) {
    const int lane = TID() & 63, wave = TID() >> 6, fr = lane & 31, fh = lane >> 5;
    float* st = (float*)(smem + wave * EPI_SLAB);
    UNROLL for (int mi = 0; mi < 2; ++mi) {
        UNROLL for (int ni = 0; ni < 2; ++ni) UNROLL for (int r = 0; r < 16; ++r)
            st[((r & 3) + 8 * (r >> 2) + 4 * fh) * 68 + ni * 32 + fr] = acc[mi][ni][r];
        UNROLL for (int it = 0; it < 4; ++it) {
            const int row = it * 8 + (lane >> 3), c8 = (lane & 7) * 8;
            const float4 a = *(const float4*)(st + row * 68 + c8), b = *(const float4*)(st + row * 68 + c8 + 4);
            float v[8] = {a.x, a.y, a.z, a.w, b.x, b.y, b.z, b.w};
            f(mi * 32 + row, c8, v);
        }
    }
    __syncthreads();
}


template <class F> DEV void epi_cols(const f32x16 (&acc)[2][2], char* smem, F f) {
    const int lane = TID() & 63, wave = TID() >> 6, fr = lane & 31, fh = lane >> 5;
    float* st = (float*)(smem + wave * EPI_SLAB);
    UNROLL for (int mi = 0; mi < 2; ++mi) {
        UNROLL for (int ni = 0; ni < 2; ++ni) UNROLL for (int r = 0; r < 16; ++r)
            st[((r & 3) + 8 * (r >> 2) + 4 * fh) * 68 + ni * 32 + fr] = acc[mi][ni][r];
        UNROLL for (int it = 0; it < 4; ++it) {
            float v[8];
            UNROLL for (int i = 0; i < 8; ++i) v[i] = st[(it * 8 + i) * 68 + lane];
            f(mi * 32 + it * 8, lane, v);
        }
    }
    __syncthreads();
}

struct TileOrder {
    int x, nN, cx, total;
    DEV TileOrder(const Topo& tp, int nM, int nN_) { x = tp.x; nN = nN_; cx = nM > x ? (nM - x + 7) >> 3 : 0; total = ((cx + 3) >> 2) * 4 * nN; }
    DEV bool get(int q, int& pm, int& pn) const { const int per = 4 * nN, qi = q / per, rem = q - qi * per, i = 4 * qi + (rem & 3); pn = rem >> 2; pm = x + 8 * i; return i < cx; }
};
template <int WM, int WN, class Epi>
DEV void gemm_phase(const bf16_t* A, int lda, int M, const bf16_t* Bt, int ldb, int N, int K, char* smem, const Topo& tp, Epi epi) {
    typedef GC<WM, WN> C;
    const int nM = M / C::BM, nN = (N + C::BN - 1) / C::BN;
    const int wave = TID() >> 6, wm = wave / WN, wn = wave % WN;
    const TileOrder ord(tp, nM, nN);
    for (int q = tp.r; q < ord.total; q += tp.n) {
        int pm, pn; if (!ord.get(q, pm, pn)) continue;
        f32x16 acc[2][2]; acc_zero(acc);
        const bf16_t* Ab = A + (size_t)pm * C::BM * lda;
        gemm_tile<WM, WN, 3, false>(acc, [&](int r) { return Ab + (size_t)r * lda; }, Bt, ldb, pn * C::BN, N, K, smem, nullptr);
        epi(acc, pm * C::BM + wm * 64, pn * C::BN + wn * 64);
    }
}

namespace pg8 {
#define PG8_LAS __attribute__((address_space(3)))
typedef float f32x4 __attribute__((ext_vector_type(4)));
constexpr int BM = 256, BK = 64, HALF = 128, HTB = HALF * BK * 2  , STAGE_BYTES = 8 * HTB, NXCD = 8, WGM = 8;

__host__ __device__ __forceinline__ int lds_byte(int r, int c) { const int st = (r >> 4) * 2 + (c >> 5), rr = r & 15, cc = c & 31, ob = rr * 64 + cc * 2; return st * 1024 + (ob ^ (((ob >> 9) & 1) << 5)); }
__host__ __device__ __forceinline__ void stage_rc(int b, int& R, int& C) { const int st = b / 1024, sb = b % 1024, swz = sb ^ (((sb >> 9) & 1) << 5); R = (st >> 1) * 16 + swz / 64; C = (st & 1) * 32 + (swz % 64) / 2; }
__host__ __device__ __forceinline__ int perm32(int rho) { const int n = rho >> 4, i = rho & 15; return 8 * (i >> 2) + 4 * n + (i & 3); }

struct Unit { int pm, pn; };
struct Gemm { const bf16_t* A; const bf16_t* Bt; int M, N, K; };
template <class Epi, class Sched, bool ALIGN_EPI = false, bool SP2 = false>
__device__ __forceinline__ void gemm_phase(PG8_LAS unsigned char* lds, const Gemm g, const Sched& S, const Epi& E) {
    const int tid = TID(), wid = __builtin_amdgcn_readfirstlane(tid >> 6), lane = tid & 63, wr = wid >> 2, wc = wid & 3, fr = lane & 15, fq = lane >> 4;
    const int K = g.K, nt = K / BK;
    unsigned voffA[2], voffB[2];
#pragma unroll
    for (int i = 0; i < 2; ++i) { int R, C; stage_rc(tid * 16 + i * 8192, R, C); const int Rb = Epi::PERM ? ((R & ~31) + perm32(R & 31)) : R;
        voffA[i] = (unsigned)(R * K + C) * 2u; voffB[i] = (unsigned)(Rb * K + C) * 2u; }
    const size_t kstep = (size_t)(BK * 2);
    const size_t hstep = (size_t)HALF * K * 2;
    const size_t tstep = 2 * hstep;
    const unsigned ldsw = (unsigned)wid * 1024u;
    const int aoff = lds_byte(wr * 64 + fr, fq * 8), boff = lds_byte(wc * 32 + fr, fq * 8);
#define PG8_SA(b, h) (((b) * 2 + (h)) * HTB)
#define PG8_SB(b, h) ((4 + (b) * 2 + (h)) * HTB)
#define PG8_STAGE(bufoff, gbase, voff) do { _Pragma("unroll") for (int _i = 0; _i < 2; ++_i) \
        __builtin_amdgcn_global_load_lds((const unsigned*)((const char*)(gbase) + (voff)[_i]), (PG8_LAS unsigned*)(lds + (bufoff) + ldsw + _i * 8192), 16, 0, 0); } while (0)
#define PG8_LDA(dst, b, h) do { _Pragma("unroll") for (int m = 0; m < 4; ++m) _Pragma("unroll") for (int k = 0; k < 2; ++k) dst[m][k] = *(const PG8_LAS bf16x8*)(lds + PG8_SA(b, h) + aoff + m * 2048 + k * 1024); } while (0)
#define PG8_LDB(dst, b, h) do { _Pragma("unroll") for (int n = 0; n < 2; ++n) _Pragma("unroll") for (int k = 0; k < 2; ++k) dst[n][k] = *(const PG8_LAS bf16x8*)(lds + PG8_SB(b, h) + boff + n * 2048 + k * 1024); } while (0)
#define PG8_MMA(ai, bj, At, Bt) do { __builtin_amdgcn_s_setprio(1); _Pragma("unroll") for (int m = 0; m < 4; ++m) _Pragma("unroll") for (int n = 0; n < 2; ++n) _Pragma("unroll") for (int k = 0; k < 2; ++k) \
        acc[ai][bj][m][n] = __builtin_amdgcn_mfma_f32_16x16x32_bf16(Bt[n][k], At[m][k], acc[ai][bj][m][n], 0, 0, 0); __builtin_amdgcn_s_setprio(0); } while (0)
#define PG8_WAIT_V(n) asm volatile("s_waitcnt vmcnt(" #n ")" ::: "memory")
#define PG8_WAIT_L(n) asm volatile("s_waitcnt lgkmcnt(" #n ")" ::: "memory")
#define PG8_BAR __builtin_amdgcn_s_barrier()
#define PG8_SCHED __builtin_amdgcn_sched_barrier(0)
    Unit cur, nxt; int ui = 0;
    if (!S.next(0, cur)) return;
    f32x4 acc[2][2][4][2];
#pragma unroll
    for (int a = 0; a < 2; ++a)
#pragma unroll
        for (int b = 0; b < 2; ++b)
#pragma unroll
            for (int m = 0; m < 4; ++m)
#pragma unroll
                for (int n = 0; n < 2; ++n) acc[a][b][m][n] = (f32x4){0.f, 0.f, 0.f, 0.f};
    bf16x8 At[4][2], B0[2][2], B1[2][2];
    const char* cA = (const char*)g.A + (size_t)cur.pm * tstep; const char* cB = (const char*)g.Bt + (size_t)cur.pn * tstep;
    S.a_ready(cur);
    if constexpr (SP2) {
        PG8_STAGE(PG8_SB(0, 0), cB, voffB); PG8_STAGE(PG8_SB(0, 1), cB + hstep, voffB); PG8_STAGE(PG8_SA(0, 0), cA, voffA); PG8_STAGE(PG8_SA(0, 1), cA + hstep, voffA);
        if (wr == 1) PG8_BAR;
        PG8_WAIT_V(2); PG8_BAR;
        PG8_STAGE(PG8_SB(1, 0), cB + kstep, voffB); PG8_STAGE(PG8_SA(1, 0), cA + kstep, voffA); PG8_STAGE(PG8_SB(1, 1), cB + hstep + kstep, voffB);
        PG8_WAIT_V(6); PG8_BAR;
    } else {
        PG8_STAGE(PG8_SB(0, 0), cB, voffB); PG8_STAGE(PG8_SA(0, 0), cA, voffA); PG8_STAGE(PG8_SB(0, 1), cB + hstep, voffB); PG8_STAGE(PG8_SA(0, 1), cA + hstep, voffA);
        if (wr == 1) PG8_BAR;
        PG8_WAIT_V(4); PG8_BAR;
        PG8_STAGE(PG8_SB(1, 0), cB + kstep, voffB); PG8_STAGE(PG8_SA(1, 0), cA + kstep, voffA); PG8_STAGE(PG8_SB(1, 1), cB + hstep + kstep, voffB);
        PG8_WAIT_V(6); PG8_BAR;
    }
    for (;;) {
        const bool has_next = S.next(ui + 1, nxt);
        const char* nA = has_next ? (const char*)g.A + (size_t)nxt.pm * tstep : cA; const char* nB = has_next ? (const char*)g.Bt + (size_t)nxt.pn * tstep : cB;
        for (int t = 0; t < nt; t += 2) {
            const bool last = (t == nt - 2);
            const char* a1 = cA + (size_t)(t + 1) * kstep;
            const char* a2 = last ? nA : cA + (size_t)(t + 2) * kstep; const char* b2 = last ? nB : cB + (size_t)(t + 2) * kstep;
            const char* a3 = a2 + kstep; const char* b3 = b2 + kstep;
            if (last && has_next) S.a_ready(nxt);
            if constexpr (SP2) {
            PG8_LDB(B0, 0, 0); PG8_LDB(B1, 0, 1); PG8_SCHED; PG8_LDA(At, 0, 0); PG8_STAGE(PG8_SA(1, 1), a1 + hstep, voffA);
            PG8_WAIT_V(8); PG8_WAIT_L(0); PG8_BAR; PG8_MMA(0, 0, At, B0); PG8_MMA(0, 1, At, B1); PG8_BAR; PG8_SCHED;
            PG8_LDA(At, 0, 1); PG8_STAGE(PG8_SB(0, 0), b2, voffB); PG8_STAGE(PG8_SB(0, 1), b2 + hstep, voffB); PG8_STAGE(PG8_SA(0, 0), a2, voffA);
            PG8_WAIT_V(8); PG8_WAIT_L(0); PG8_BAR; PG8_MMA(1, 0, At, B0); PG8_MMA(1, 1, At, B1); PG8_BAR; PG8_SCHED;
            PG8_LDB(B0, 1, 0); PG8_LDB(B1, 1, 1); PG8_SCHED; PG8_LDA(At, 1, 0); PG8_STAGE(PG8_SA(0, 1), a2 + hstep, voffA);
            PG8_WAIT_V(8); PG8_WAIT_L(0); PG8_BAR; PG8_MMA(0, 0, At, B0); PG8_MMA(0, 1, At, B1); PG8_BAR; PG8_SCHED;
            PG8_LDA(At, 1, 1); PG8_STAGE(PG8_SB(1, 0), b3, voffB); PG8_STAGE(PG8_SB(1, 1), b3 + hstep, voffB); PG8_STAGE(PG8_SA(1, 0), a3, voffA);
            PG8_WAIT_V(8); PG8_WAIT_L(0); PG8_BAR; PG8_MMA(1, 0, At, B0); PG8_MMA(1, 1, At, B1); PG8_BAR; PG8_SCHED;
            } else {
            PG8_LDB(B0, 0, 0); PG8_SCHED; PG8_LDA(At, 0, 0); PG8_STAGE(PG8_SA(1, 1), a1 + hstep, voffA);
            PG8_WAIT_L(8); PG8_BAR; PG8_WAIT_L(0); PG8_MMA(0, 0, At, B0); PG8_BAR; PG8_SCHED;
            PG8_LDB(B1, 0, 1); PG8_STAGE(PG8_SB(0, 0), b2, voffB);
            PG8_BAR; PG8_WAIT_L(0); PG8_MMA(0, 1, At, B1); PG8_BAR;
            PG8_LDA(At, 0, 1); PG8_STAGE(PG8_SA(0, 0), a2, voffA);
            PG8_BAR; PG8_WAIT_L(0); PG8_MMA(1, 0, At, B0); PG8_BAR; PG8_SCHED;
            PG8_STAGE(PG8_SB(0, 1), b2 + hstep, voffB);
            PG8_WAIT_V(6); PG8_BAR; PG8_MMA(1, 1, At, B1); PG8_BAR;
            PG8_LDB(B0, 1, 0); PG8_SCHED; PG8_LDA(At, 1, 0); PG8_STAGE(PG8_SA(0, 1), a2 + hstep, voffA);
            PG8_WAIT_L(8); PG8_BAR; PG8_WAIT_L(0); PG8_MMA(0, 0, At, B0); PG8_BAR; PG8_SCHED;
            PG8_LDB(B1, 1, 1); PG8_STAGE(PG8_SB(1, 0), b3, voffB);
            PG8_BAR; PG8_WAIT_L(0); PG8_MMA(0, 1, At, B1); PG8_BAR;
            PG8_LDA(At, 1, 1); PG8_STAGE(PG8_SA(1, 0), a3, voffA);
            PG8_BAR; PG8_WAIT_L(0); PG8_MMA(1, 0, At, B0); PG8_BAR; PG8_SCHED;
            PG8_STAGE(PG8_SB(1, 1), b3 + hstep, voffB);
            PG8_WAIT_V(6); PG8_BAR; PG8_MMA(1, 1, At, B1); PG8_BAR;
            }
        }
        if constexpr (ALIGN_EPI) { if (wr == 0) PG8_BAR; }
        if constexpr (!Epi::AFTER_DRAIN) { E(acc, cur, wr, wc, fr, fq); S.done(cur); }
        if (!has_next) break;
#pragma unroll
        for (int a = 0; a < 2; ++a)
#pragma unroll
            for (int b = 0; b < 2; ++b)
#pragma unroll
                for (int m = 0; m < 4; ++m)
#pragma unroll
                    for (int n = 0; n < 2; ++n) acc[a][b][m][n] = (f32x4){0.f, 0.f, 0.f, 0.f};
        cur = nxt; cA = nA; cB = nB; ++ui;
        if constexpr (ALIGN_EPI) { if (wr == 1) PG8_BAR; }
    }
    PG8_WAIT_V(0);
    if constexpr (!ALIGN_EPI) { if (wr == 0) PG8_BAR; }
    PG8_BAR;
    if constexpr (Epi::AFTER_DRAIN) { E.fused(acc, cur, wr, wc, fr, fq, lds, wid, lane); S.done(cur); }
#undef PG8_SA
#undef PG8_SB
#undef PG8_STAGE
#undef PG8_LDA
#undef PG8_LDB
#undef PG8_MMA
#undef PG8_WAIT_V
#undef PG8_WAIT_L
#undef PG8_BAR
#undef PG8_SCHED
}
}
template <class F> struct EpiF {
    static constexpr bool PERM = true, AFTER_DRAIN = false; F f;
    DEV void operator()(const pg8::f32x4 (&acc)[2][2][4][2], const pg8::Unit& u, int wr, int wc, int fr, int fq) const {
        UNROLL for (int ai = 0; ai < 2; ++ai) UNROLL for (int m = 0; m < 4; ++m) {
            const int row = u.pm * 256 + ai * 128 + wr * 64 + m * 16 + fr;
            UNROLL for (int bj = 0; bj < 2; ++bj) {
                const int col = u.pn * 256 + bj * 128 + wc * 32 + 8 * fq;
                const float v[8] = {acc[ai][bj][m][0][0], acc[ai][bj][m][0][1], acc[ai][bj][m][0][2], acc[ai][bj][m][0][3],
                                    acc[ai][bj][m][1][0], acc[ai][bj][m][1][1], acc[ai][bj][m][1][2], acc[ai][bj][m][1][3]};
                f(row, col, v);
            }
        }
    }
};
template <class F> struct EpiF2 {
    static constexpr bool PERM = true, AFTER_DRAIN = false; F f;
    DEV void operator()(const pg8::f32x4 (&acc)[2][2][4][2], const pg8::Unit& u, int wr, int wc, int fr, int fq) const {
        UNROLL for (int ai = 0; ai < 2; ++ai) UNROLL for (int m = 0; m < 4; ++m) {
            const int row = u.pm * 256 + ai * 128 + wr * 64 + m * 16 + fr, col = u.pn * 256 + wc * 32 + 8 * fq;
            const float v0[8] = {acc[ai][0][m][0][0], acc[ai][0][m][0][1], acc[ai][0][m][0][2], acc[ai][0][m][0][3], acc[ai][0][m][1][0], acc[ai][0][m][1][1], acc[ai][0][m][1][2], acc[ai][0][m][1][3]};
            const float v1[8] = {acc[ai][1][m][0][0], acc[ai][1][m][0][1], acc[ai][1][m][0][2], acc[ai][1][m][0][3], acc[ai][1][m][1][0], acc[ai][1][m][1][1], acc[ai][1][m][1][2], acc[ai][1][m][1][3]};
            f(row, col, v0, v1);
        }
    }
};
struct XOrder {
    int x, r, n, nN, cx, fullq, total;
    DEV XOrder(const Topo& tp, int nM, int nN_) { x = tp.x; r = tp.r; n = tp.n; nN = nN_; cx = nM > x ? (nM - x + 7) >> 3 : 0; fullq = cx >> 2; total = cx * nN; }
    DEV bool next(int i, pg8::Unit& u) const {
        const int q = r + i * n; if (q >= total) return false;
        const int per = 4 * nN;
        if (q < fullq * per) { const int qi = q / per, rem = q - qi * per; u.pn = rem >> 2; u.pm = x + 8 * (4 * qi + (rem & 3)); }
        else { const int rem = q - fullq * per, cq = cx - 4 * fullq; u.pn = rem / cq; u.pm = x + 8 * (4 * fullq + rem % cq); }
        return true;
    }
    DEV void a_ready(const pg8::Unit&) const {}
    DEV void done(const pg8::Unit&) const {}
};
template <class F> DEV void gemm256_pair(const bf16_t* A, int M, const bf16_t* Bt, int N, int K, char* smem, const Topo& tp, F f) {
    const pg8::Gemm g{A, Bt, M, N, K};
    const XOrder S(tp, M / 256, (N + 255) / 256);
    const EpiF2<F> E{f};
    pg8::gemm_phase<EpiF2<F>, XOrder, true, true>((PG8_LAS unsigned char*)smem, g, S, E);
}
template <class F> DEV void gemm256(const bf16_t* A, int M, const bf16_t* Bt, int N, int K, char* smem, const Topo& tp, F f) {
    const pg8::Gemm g{A, Bt, M, N, K};
    const XOrder S(tp, M / 256, (N + 255) / 256);
    const EpiF<F> E{f};
    pg8::gemm_phase<EpiF<F>, XOrder, true, true>((PG8_LAS unsigned char*)smem, g, S, E);
}

DEV void ph_mod(const Params& p, int L, char* smem) {
    const int tid = TID();
    float* sc = (float*)smem;
    float* red = sc + 17 * 1024;
    const float* c = p.in[I_C]; const float* cc = p.in[I_CCTX];
    for (int i = tid; i < 17 * 1024; i += NTHREADS) { const float v = i < 16 * 1024 ? c[i] : cc[i - 16 * 1024]; sc[i] = v / (1.f + expf(-v)); }
    __syncthreads();
    const float* W = p.in[I_WADA] + (size_t)L * 1024 * 6144; const float* bA = p.in[I_BADA] + (size_t)L * 6144;
    float* MOD = (float*)(p.ws + OFF_MOD);
    for (int u = blockIdx.x; u < 192; u += gridDim.x) {
        const int ci = tid & 31, ks = tid >> 5, j = u * 32 + ci;
        float acc[17];
        UNROLL for (int r = 0; r < 17; ++r) acc[r] = 0.f;
        for (int k = ks * 64; k < ks * 64 + 64; ++k) {
            const float w = W[(size_t)k * 6144 + j];
            UNROLL for (int r = 0; r < 17; ++r) acc[r] += sc[r * 1024 + k] * w;
        }
        UNROLL for (int r = 0; r < 17; ++r) red[(ks * 17 + r) * 32 + ci] = acc[r];
        __syncthreads();
        for (int i = tid; i < 17 * 32; i += NTHREADS) {
            const int r = i >> 5, c2 = i & 31; float s = bA[u * 32 + c2];
            for (int k2 = 0; k2 < 16; ++k2) s += red[(k2 * 17 + r) * 32 + c2];
            MOD[r * 6144 + u * 32 + c2] = s;
        }
        __syncthreads();
    }
}
DEV void conv_job(const float* s0, const float* s1, bf16_t* d, int K, int N, int mode, int nmat, size_t sstride, size_t dstride, char* smem, int bid = -1, int nb = 0) {
    if (bid < 0) { bid = blockIdx.x; nb = gridDim.x; }
    float* tile = (float*)smem;
    const int tid = TID();
    const int tK = K / 64, tN = (mode == 1 || mode == 3) ? (2 * N) / 64 : (N + 63) / 64, per = tK * tN, total = per * nmat;
    for (int t0 = bid * 4; t0 < total; t0 += nb * 4) {
        float4 v[4][2];
        UNROLL for (int q = 0; q < 4; ++q) {
            const int t = min(t0 + q, total - 1), mat = t / per, r = t - mat * per, tk = r / tN, tn = r - tk * tN;
            const float* a0 = s0 + (size_t)mat * sstride; const float* a1 = s1 ? s1 + (size_t)mat * sstride : nullptr;
            const int c4 = (tid & 15) * 4;
            const float* src; int col;
            if (mode == 1) { src = (c4 >> 5) ? a1 : a0; col = tn * 32 + (c4 & 31); }
            else if (mode == 3) { src = ((tn >> 1) & 1) ? a1 : a0; col = (tn >> 2) * 128 + (tn & 1) * 64 + c4; }
            else { src = a0; col = tn * 64 + c4; }
            const bool ok = col < N;
            UNROLL for (int i = 0; i < 2; ++i) {
                const int k = (tid >> 4) + 32 * i;
                v[q][i] = ok ? *(const float4*)(src + (size_t)(tk * 64 + k) * N + col) : make_float4(0.f, 0.f, 0.f, 0.f);
            }
        }
        UNROLL for (int q = 0; q < 4; ++q) UNROLL for (int i = 0; i < 2; ++i) {
            float* w = tile + q * 4160 + ((tid >> 4) + 32 * i) * 65 + (tid & 15) * 4;
            w[0] = v[q][i].x; w[1] = v[q][i].y; w[2] = v[q][i].z; w[3] = v[q][i].w;
        }
        __syncthreads();
        UNROLL for (int q = 0; q < 4; ++q) if (t0 + q < total) {
            const int t = t0 + q, mat = t / per, r = t - mat * per, tk = r / tN, tn = r - tk * tN;
            bf16_t* dd = d + (size_t)mat * dstride;
            const int cc = tid >> 3, k8 = (tid & 7) * 8, row = tn * 64 + cc;
            float x[8];
            UNROLL for (int i = 0; i < 8; ++i) x[i] = tile[q * 4160 + (k8 + i) * 65 + cc];
            if (mode == 1 || mode == 3 || row < N) {
                st8(dd + (size_t)row * K + tk * 64 + k8, x);
                if (mode == 2) { float lo[8]; UNROLL for (int i = 0; i < 8; ++i) lo[i] = x[i] - bf2f(f2bf(x[i])); st8(dd + (size_t)N * K + (size_t)row * K + tk * 64 + k8, lo); }
            }
        }
        __syncthreads();
    }
}
DEV void ph_conv_mix(const Params& p, int L, char* smem) {
    char* ws = p.ws;
    conv_job(p.in[I_WIN] + (size_t)L * 1024 * IN_COLS, nullptr, (bf16_t*)(ws + OFF_WINT), 1024, IN_COLS, 0, 1, 0, 0, smem);
    conv_job(p.in[I_WBR] + (size_t)L * 3 * 512 * 1024, nullptr, (bf16_t*)(ws + OFF_WBT), 512, 1024, 0, 3, (size_t)512 * 1024, (size_t)512 * 1024, smem);
    conv_job(p.in[I_WOUT] + (size_t)L * 1024 * 1024, nullptr, (bf16_t*)(ws + OFF_WOUTT), 1024, 1024, 0, 1, 0, 0, smem);
    conv_job(p.in[I_SG] + (size_t)L * 1024 * 256, p.in[I_SU] + (size_t)L * 1024 * 256, (bf16_t*)(ws + OFF_SGUT), 1024, 256, 3, 1, 0, 0, smem);
    conv_job(p.in[I_SD] + (size_t)L * 256 * 1024, nullptr, (bf16_t*)(ws + OFF_SDT), 256, 1024, 0, 1, 0, 0, smem);
    conv_job(p.in[I_G2] + (size_t)L * 128 * 512, nullptr, (bf16_t*)(ws + OFF_G2T), 128, 512, 0, 1, 0, 0, smem);
    conv_job(p.in[I_RTR] + (size_t)L * 1024 * 64, nullptr, (bf16_t*)(ws + OFF_RTR), 1024, 64, 2, 1, 0, 0, smem);
}
DEV void ph_conv_moe_gu(const Params& p, int L, char* smem, int bid, int nb) {
    const size_t eo = (size_t)L * 64 * 1024 * 128;
    conv_job(p.in[I_MWG] + eo, p.in[I_MWU] + eo, (bf16_t*)(p.ws + OFF_MGU), 1024, 128, 1, 64, (size_t)1024 * 128, (size_t)256 * 1024, smem, bid, nb);
}
DEV void ph_conv_moe(const Params& p, int L, char* smem, int bid, int nb) {
    const size_t eo = (size_t)L * 64 * 1024 * 128;
    conv_job(p.in[I_MWD] + eo, nullptr, (bf16_t*)(p.ws + OFF_MDT), 128, 1024, 0, 64, (size_t)128 * 1024, (size_t)1024 * 128, smem, bid, nb);
}

DEV void ph_norm(const Params& p, int L, int which, int ntok) {
    const int lane = TID() & 63, wave = TID() >> 6;
    const float* MOD = (const float*)(p.ws + OFF_MOD);
    const float* g = p.in[which ? I_N2G : I_N1G] + (size_t)L * DM;
    bf16_t* H = (bf16_t*)(p.ws + OFF_HX); bf16_t* HLO = (bf16_t*)(p.ws + OFF_H2LO);
    for (int n0 = blockIdx.x * 8; n0 < ntok; n0 += gridDim.x * 8) {
        const int n = n0 + wave;
        const float* xr = which ? xs_row(p, n) : xprev_row(p, L, n);
        float4 v[4]; float ss = 0.f;
        UNROLL for (int i = 0; i < 4; ++i) { v[i] = *(const float4*)(xr + i * 256 + lane * 4); ss += v[i].x * v[i].x + v[i].y * v[i].y + v[i].z * v[i].z + v[i].w * v[i].w; }
        UNROLL for (int o = 1; o < 64; o <<= 1) ss += __shfl_xor(ss, o);
        const float rstd = rsqrtf(ss * (1.f / DM) + 1e-6f);
        const float* sh = MOD + mod_row(n) * 6144 + (which ? 3 : 0) * DM; const float* sc = sh + DM;
        UNROLL for (int i = 0; i < 4; ++i) {
            const int c = i * 256 + lane * 4;
            const float4 gg = *(const float4*)(g + c), s1 = *(const float4*)(sc + c), s0 = *(const float4*)(sh + c);
            const float h0 = v[i].x * rstd * gg.x * (1.f + s1.x) + s0.x, h1 = v[i].y * rstd * gg.y * (1.f + s1.y) + s0.y;
            const float h2 = v[i].z * rstd * gg.z * (1.f + s1.z) + s0.z, h3 = v[i].w * rstd * gg.w * (1.f + s1.w) + s0.w;
            u32x2 o; o.x = pk2(h0, h1); o.y = pk2(h2, h3);
            *(u32x2*)(H + (size_t)n * DM + c) = o;
            if (which) {
                u32x2 o2;
                o2.x = pk2(h0 - bf2f((bf16_t)(o.x & 0xffff)), h1 - bf2f((bf16_t)(o.x >> 16)));
                o2.y = pk2(h2 - bf2f((bf16_t)(o.y & 0xffff)), h3 - bf2f((bf16_t)(o.y >> 16)));
                *(u32x2*)(HLO + (size_t)n * DM + c) = o2;
            }
        }
    }
}

DEV void ph_rw_prep(const Params& p, int L, char* smem) {
    const int lane = TID() & 63, wave = TID() >> 6;
    float* vsh = (float*)smem + wave * 512;
    const bf16_t* PXR = (const bf16_t*)(p.ws + OFF_PX); bf16_t* VF = (bf16_t*)(p.ws + OFF_VF);
    const float* mu = p.in[I_MU] + (size_t)L * RW_COLS;
    const float* v0 = p.in[I_V0]; const float* v1 = p.in[I_V1]; const float* v2 = p.in[I_V2];
    for (int n0 = blockIdx.x * 8; n0 < NT; n0 += gridDim.x * 8) {
        const int n = n0 + wave; int nb, tt, T; seq_of(n, nb, tt, T);
        float vs[8]; shift8(PXR, RW_COLS, nb, tt, T, 1024 + lane * 8, mu, vs);
        if (L == 0) { st8(VF + (size_t)n * 512 + lane * 8, vs); }
        else {
            UNROLL for (int i = 0; i < 8; ++i) vsh[lane * 8 + i] = vs[i];
            __syncthreads();
            const int q = lane & 31, hf = lane >> 5; float t1 = 0.f;
            for (int jj = 0; jj < 256; ++jj) t1 += vsh[hf * 256 + jj] * v1[(hf * 256 + jj) * 32 + q];
            t1 += __shfl_xor(t1, 32);
            float u[8];
            UNROLL for (int i = 0; i < 8; ++i) u[i] = v0[lane * 8 + i];
            for (int q2 = 0; q2 < 32; ++q2) { const float tq = __shfl(t1, q2); UNROLL for (int i = 0; i < 8; ++i) u[i] += tq * v2[q2 * 512 + lane * 8 + i]; }
            float vf[8], o[8]; ld8(VF + (size_t)n * 512 + lane * 8, vf);
            UNROLL for (int i = 0; i < 8; ++i) o[i] = vs[i] + (vf[i] - vs[i]) * sigm(u[i]);
            st8(VF + (size_t)n * 512 + lane * 8, o);
            __syncthreads();
        }
    }
}

DEV bf16x8 pk_lohi(u32x2 lo, u32x2 hi) { u32x4 w; w.x = lo.x; w.y = lo.y; w.z = hi.x; w.w = hi.y; return __builtin_bit_cast(bf16x8, w); }
DEV bf16x8 pk_acc2(const f32x4v& a, const f32x4v& b) { u32x4 w; w.x = pk2(a[0], a[1]); w.y = pk2(a[2], a[3]); w.z = pk2(b[0], b[1]); w.w = pk2(b[2], b[3]); return __builtin_bit_cast(bf16x8, w); }
DEV bf16x8 pk_acc1(const f32x4v& a) { u32x4 w; w.x = pk2(a[0], a[1]); w.y = pk2(a[2], a[3]); w.z = 0u; w.w = 0u; return __builtin_bit_cast(bf16x8, w); }
#define MFMA16(a, b, c) __builtin_amdgcn_mfma_f32_16x16x32_bf16((a), (b), (c), 0, 0, 0)
struct Raw3 { u32x4 l, c, r; };
DEV Raw3 rw_raw(const bf16_t* z, int ld, int nb, int tt, int T, int col0) {
    Raw3 o;
    o.c = *(const u32x4*)(z + (size_t)(nb + tt) * ld + col0);
    o.l = *(const u32x4*)(z + (size_t)(nb + max(tt - 1, 0)) * ld + col0);
    o.r = *(const u32x4*)(z + (size_t)(nb + min(tt + 1, T - 1)) * ld + col0);
    return o;
}
DEV void unpack8(u32x4 v, float (&o)[8]) {
    o[0] = __uint_as_float(v.x << 16); o[1] = __uint_as_float(v.x & 0xffff0000u); o[2] = __uint_as_float(v.y << 16); o[3] = __uint_as_float(v.y & 0xffff0000u);
    o[4] = __uint_as_float(v.z << 16); o[5] = __uint_as_float(v.z & 0xffff0000u); o[6] = __uint_as_float(v.w << 16); o[7] = __uint_as_float(v.w & 0xffff0000u);
}
DEV void shift_from_raw(const Raw3& w, int tt, int T, const float* mu8, float (&o)[8]) {
    float c[8], l[8], r[8]; unpack8(w.c, c); unpack8(w.l, l); unpack8(w.r, r);
    const float ml = tt > 0 ? 0.5f : 0.f, mr = tt < T - 1 ? 0.5f : 0.f;
    UNROLL for (int i = 0; i < 8; ++i) o[i] = c[i] + mu8[i] * (ml * l[i] + mr * r[i] - c[i]);
}
DEV void ph_rw_scan(const Params& p, int L, char* smem) {
    const int tid = TID();
    const int wave = __builtin_amdgcn_readfirstlane(tid >> 6);
    char* AT = smem; char* BT = smem + 9216; char* KT = smem + 18432; char* RT = smem + 27648;
    char* BH = smem + 36864; char* KH = smem + 46080; char* VT = smem + 55296;
    char* W2T = smem + 64512; char* A2T = smem + 73728;
    float* PCv = (float*)(smem + 82944); float* SEGT = PCv + 64;
    char* XY = smem + 85248;
    char* T1 = XY; char* T2 = XY + 9216; float* WLf = (float*)(XY + 18432); float* ALf = (float*)(XY + 35840); float* LW = (float*)XY;
    float* TOT = (float*)(XY + 62720);
    float* PAR = (float*)(XY + 60416);
    char* NAB = XY; char* NAK = XY + 9216; char* NRB = XY + 18432; char* NRK = XY + 27648; char* TJ = XY + 36864; float* NDF = (float*)(XY + 38912); float* YO = (float*)(XY + 43008);
    const bf16_t* PXR = (const bf16_t*)(p.ws + OFF_PX); const bf16_t* VF = (const bf16_t*)(p.ws + OFF_VF);
    bf16_t* YS = (bf16_t*)(p.ws + OFF_YS); float* CB = (float*)(p.ws + OFF_CB);
    const float* mu = p.in[I_MU] + (size_t)L * RW_COLS;
    const float* w0 = p.in[I_W0] + (size_t)L * 1024; const float* w2 = p.in[I_W2] + (size_t)L * 65536;
    const float* a0 = p.in[I_A0] + (size_t)L * 1024; const float* a2 = p.in[I_A2] + (size_t)L * 65536;
    const float* kkw = p.in[I_KK] + (size_t)L * 512; const float* kaw = p.in[I_KA] + (size_t)L * 512; const float* rkw = p.in[I_RK] + (size_t)L * 512;
    for (int u = blockIdx.x; u < 256; u += gridDim.x) {
        const int b = u >> 4, h = (u >> 1) & 7, d = u & 1;
        for (int i = tid; i < 4096; i += NTHREADS) {
            const int l = i >> 6, n = i & 63;
            *(bf16_t*)(W2T + n * LROW + l * 2) = f2bf(w2[(size_t)(d * 64 + l) * 512 + h * 64 + n]);
            *(bf16_t*)(A2T + n * LROW + l * 2) = f2bf(a2[(size_t)(d * 64 + l) * 512 + h * 64 + n]);
        }
        if (tid < 64) {
            const int n = tid;
            PAR[n] = w0[d * 512 + h * 64 + n]; PAR[64 + n] = a0[d * 512 + h * 64 + n];
            PAR[128 + n] = kkw[h * 64 + n]; PAR[192 + n] = kaw[h * 64 + n]; PAR[256 + n] = rkw[h * 64 + n];
            PAR[320 + n] = mu[1536 + d * 64 + n]; PAR[384 + n] = mu[1664 + d * 64 + n]; PAR[448 + n] = mu[h * 64 + n]; PAR[512 + n] = mu[512 + h * 64 + n];
        }
        f32x4v sacc[4];
        UNROLL for (int i = 0; i < 4; ++i) sacc[i] = (f32x4v){0.f, 0.f, 0.f, 0.f};
        __syncthreads();
        Raw3 pw1, pw2, pr, pk; u32x4 pv;
#define RW_GEOM(ci_, tido_) const bool isc = (ci_) < 4; const int T = isc ? CTXL : SEQ, cc = isc ? (ci_) : (ci_) - 4; \
            const int t0 = d == 0 ? cc * 64 : T - 64 * (cc + 1), nb = isc ? NX + b * CTXL : b * SEQ; \
            const int tt = d == 0 ? t0 + ((tido_) >> 3) : t0 + 63 - ((tido_) >> 3);
#define RW_PREFETCH(ci_, tido_) do { RW_GEOM(ci_, tido_) const int j_ = (tido_) & 7; \
            pw1 = rw_raw(PXR, RW_COLS, nb, tt, T, 1536 + d * 64 + 8 * j_); pw2 = rw_raw(PXR, RW_COLS, nb, tt, T, 1664 + d * 64 + 8 * j_); \
            pr = rw_raw(PXR, RW_COLS, nb, tt, T, h * 64 + 8 * j_); pk = rw_raw(PXR, RW_COLS, nb, tt, T, 512 + h * 64 + 8 * j_); \
            pv = *(const u32x4*)(VF + (size_t)(nb + tt) * 512 + h * 64 + 8 * j_); } while (0)
        RW_PREFETCH(0, tid);
#define RW_STORE_Y(ci_, tido_) do { RW_GEOM(ci_, tido_) const int ti_ = (tido_) >> 3, j_ = (tido_) & 7; \
            const float4 ya = *(const float4*)(YO + ti_ * 68 + 8 * j_), yb = *(const float4*)(YO + ti_ * 68 + 8 * j_ + 4); \
            const float y8[8] = {ya.x, ya.y, ya.z, ya.w, yb.x, yb.y, yb.z, yb.w}; \
            st8(YS + ((size_t)d * NT + nb + tt) * 512 + h * 64 + 8 * j_, y8); } while (0)
        for (int ci = 0; ci < 36; ++ci) {
            int tido = tid; asm volatile("" : "+v"(tido));
            const int lane = tido & 63, lq = lane & 15, kg = lane >> 4, ti = tido >> 3, j = tido & 7;
            const int ch = h * 64 + 8 * j;
            if (ci > 0) RW_STORE_Y(ci - 1, tido);
            RW_GEOM(ci, tido)
            float r8[8], k8[8], v8[8];
            {
                float x1[8], x2[8];
                shift_from_raw(pw1, tt, T, PAR + 320 + 8 * j, x1);
                shift_from_raw(pw2, tt, T, PAR + 384 + 8 * j, x2);
                UNROLL for (int i = 0; i < 8; ++i) x1[i] = tanh_fast(x1[i]);
                st8((bf16_t*)(T1 + ti * LROW) + 8 * j, x1); st8((bf16_t*)(T2 + ti * LROW) + 8 * j, x2);
                shift_from_raw(pr, tt, T, PAR + 448 + 8 * j, r8);
                shift_from_raw(pk, tt, T, PAR + 512 + 8 * j, k8);
                unpack8(pv, v8);
            }
            __syncthreads();
            _Pragma("unroll 1") for (int rep = 0; rep < 4; ++rep) {
                const int q = wave + 8 * rep, m = q >> 4, tl = q & 15, tt4 = tl >> 2, nt4 = tl & 3;
                const char* Ab = (m ? T2 : T1) + (16 * tt4 + lq) * LROW + kg * 16; const char* Bb = (m ? A2T : W2T) + (16 * nt4 + lq) * LROW + kg * 16;
                f32x4v a = {0.f, 0.f, 0.f, 0.f};
                UNROLL for (int ks = 0; ks < 2; ++ks) a = MFMA16(*(const bf16x8*)(Ab + ks * 64), *(const bf16x8*)(Bb + ks * 64), a);
                float* dst = (m ? ALf : WLf) + (16 * tt4 + 4 * kg) * 68 + 16 * nt4 + lq;
                UNROLL for (int i = 0; i < 4; ++i) dst[i * 68] = a[i];
            }
            __syncthreads();
            float av[8], bv[8], kd8[8];
            {
                const float4 wa = *(const float4*)(WLf + ti * 68 + 8 * j), wb = *(const float4*)(WLf + ti * 68 + 8 * j + 4);
                const float4 aa = *(const float4*)(ALf + ti * 68 + 8 * j), ab = *(const float4*)(ALf + ti * 68 + 8 * j + 4);
                const float wl[8] = {wa.x, wa.y, wa.z, wa.w, wb.x, wb.y, wb.z, wb.w}, al[8] = {aa.x, aa.y, aa.z, aa.w, ab.x, ab.y, ab.z, ab.w};
                float ss = 0.f, cbp = 0.f, alpha[8], kkr[8], lw[8];
                UNROLL for (int i = 0; i < 8; ++i) {
                    const float xw = -(PAR[8 * j + i] + wl[i]);
                    const float sp = softplus_fast(xw);
                    lw[i] = -__expf(-sp - 0.5f);
                    alpha[i] = sigm(PAR[64 + 8 * j + i] + al[i]);
                    kkr[i] = k8[i] * PAR[128 + 8 * j + i]; ss += kkr[i] * kkr[i];
                    kd8[i] = k8[i] * (1.f + (alpha[i] - 1.f) * PAR[192 + 8 * j + i]);
                    cbp += r8[i] * kd8[i] * PAR[256 + 8 * j + i];
                }
                ss = sum8(ss); cbp = sum8(cbp);
                const float inv = frcp(fmaxf(__builtin_amdgcn_sqrtf(ss), 1e-12f));
                UNROLL for (int i = 0; i < 8; ++i) { const float kk = kkr[i] * inv; av[i] = -kk; bv[i] = kk * alpha[i]; }
                *(float4*)(LW + ti * 64 + 8 * j) = make_float4(lw[0], lw[1], lw[2], lw[3]); *(float4*)(LW + ti * 64 + 8 * j + 4) = make_float4(lw[4], lw[5], lw[6], lw[7]);
                if (j == 0) CB[((size_t)d * NT + nb + tt) * 8 + h] = cbp;
            }
            __syncthreads();
            {
                const int n = tid & 63, seg = wave; float run[8], acc = 0.f;
                UNROLL for (int r = 0; r < 8; ++r) { acc += LW[(seg * 8 + r) * 64 + n]; run[r] = acc; }
                SEGT[seg * 64 + n] = acc;
                __syncthreads();
                float off = 0.f, tot = 0.f;
                UNROLL for (int s2 = 0; s2 < 8; ++s2) { const float sv = SEGT[s2 * 64 + n]; tot += sv; off += s2 < seg ? sv : 0.f; }
                UNROLL for (int r = 0; r < 8; ++r) LW[(seg * 8 + r) * 64 + n] = run[r] + off;
                if (seg == 0) { TOT[n] = tot; PCv[n] = __expf(tot); }
            }
            __syncthreads();
            {
                const float4 ta = *(const float4*)(TOT + 8 * j), tb = *(const float4*)(TOT + 8 * j + 4);
                const float tot[8] = {ta.x, ta.y, ta.z, ta.w, tb.x, tb.y, tb.z, tb.w};
                const float4 la = *(const float4*)(LW + ti * 64 + 8 * j), lb = *(const float4*)(LW + ti * 64 + 8 * j + 4);
                const float lpl[8] = {la.x, la.y, la.z, la.w, lb.x, lb.y, lb.z, lb.w};
                float lpm[8];
                if (ti != 0) {
                    const float4 ma = *(const float4*)(LW + (ti - 1) * 64 + 8 * j), mb = *(const float4*)(LW + (ti - 1) * 64 + 8 * j + 4);
                    lpm[0] = ma.x; lpm[1] = ma.y; lpm[2] = ma.z; lpm[3] = ma.w; lpm[4] = mb.x; lpm[5] = mb.y; lpm[6] = mb.z; lpm[7] = mb.w;
                } else { UNROLL for (int i = 0; i < 8; ++i) lpm[i] = 0.f; }
                float oa[8], ob[8], ok[8], orr[8];
                const int wofs = (((ti >> 3) ^ j) << 4) + (ti & 7) * 2;
                UNROLL for (int i = 0; i < 8; ++i) {
                    const float lp = lpl[i], lm = lpm[i];
                    const float eP = __expf(lp), eM = __expf(-lp), ePm = __expf(lm), eE = __expf(tot[i] - lp);
                    oa[i] = av[i] * ePm; ob[i] = bv[i] * eM; ok[i] = kd8[i] * eM; orr[i] = r8[i] * eP;
                    *(bf16_t*)(BH + (8 * j + i) * LROW + wofs) = f2bf(bv[i] * eE);
                    *(bf16_t*)(KH + (8 * j + i) * LROW + wofs) = f2bf(kd8[i] * eE);
                    *(bf16_t*)(VT + (8 * j + i) * LROW + wofs) = f2bf(v8[i]);
                }
                st8((bf16_t*)(AT + ti * LROW) + 8 * j, oa); st8((bf16_t*)(BT + ti * LROW) + 8 * j, ob);
                st8((bf16_t*)(KT + ti * LROW) + 8 * j, ok); st8((bf16_t*)(RT + ti * LROW) + 8 * j, orr);
            }
            __syncthreads();
            if (ci + 1 < 36) RW_PREFETCH(ci + 1, tido);
            _Pragma("unroll 1") for (int rep = 0; rep < 6; ++rep) {
                const int q = wave + 8 * rep, m = q / 12, tl = q - 12 * m;
                const int tt4 = tl >= 10 ? 2 * (tl - 10) : tl < 1 ? 0 : tl < 3 ? 1 : tl < 6 ? 2 : 3, st4 = tl >= 10 ? tt4 + 1 : tl - (tt4 * (tt4 + 1)) / 2;
                char* dstm = m == 0 ? NAB : m == 1 ? NAK : m == 2 ? NRB : NRK;
                f32x4v a = {0.f, 0.f, 0.f, 0.f};
                if (st4 <= tt4) {
                    const char* Ab = (m < 2 ? AT : RT) + (16 * tt4 + lq) * LROW + kg * 16; const char* Bb = ((m & 1) ? KT : BT) + (16 * st4 + lq) * LROW + kg * 16;
                    UNROLL for (int ks = 0; ks < 2; ++ks) a = MFMA16(*(const bf16x8*)(Ab + ks * 64), *(const bf16x8*)(Bb + ks * 64), a);
                }
                const int sidx = 16 * st4 + lq;
                UNROLL for (int i = 0; i < 4; ++i) {
                    const int tidx = 16 * tt4 + 4 * kg + i;
                    const bool keep = m < 2 ? sidx < tidx : sidx <= tidx;
                    const float val = keep ? a[i] : 0.f;
                    *(bf16_t*)(dstm + tidx * LROW + sidx * 2) = f2bf(val);
                    if (m == 0 && st4 == tt4) NDF[(tt4 * 16 + 4 * kg + i) * 16 + lq] = val;
                }
            }
            __syncthreads();
            f32x4v xacc[4], yacc[4];
            bf16x8 vt[2];
            if (wave == 7) {
                const int blk = lane >> 4, c = lane & 15;
                float Tc[16];
                UNROLL for (int t = 0; t < 16; ++t) {
                    float a = t == c ? 1.f : 0.f;
                    UNROLL for (int s2 = 0; s2 < t; ++s2) a += NDF[(blk * 16 + t) * 16 + s2] * Tc[s2];
                    Tc[t] = a;
                }
                UNROLL for (int t = 0; t < 16; ++t) *(bf16_t*)(TJ + (blk * 16 + t) * 32 + c * 2) = f2bf(Tc[t]);
            } else if (wave < 4) {
                bf16x8 sb[2];
                UNROLL for (int kk = 0; kk < 2; ++kk) { sb[kk] = pk_acc2(sacc[2 * kk], sacc[2 * kk + 1]); vt[kk] = *(const bf16x8*)(VT + (16 * wave + lq) * LROW + (((4 * kk + kg) ^ (2 * wave + (lq >> 3))) << 4)); }
                UNROLL for (int t4 = 0; t4 < 4; ++t4) {
                    f32x4v x = {0.f, 0.f, 0.f, 0.f}, y = {0.f, 0.f, 0.f, 0.f};
                    UNROLL for (int kk = 0; kk < 2; ++kk) {
                        const char* pa = AT + (16 * t4 + lq) * LROW + (32 * kk + 4 * kg) * 2; const char* pr = RT + (16 * t4 + lq) * LROW + (32 * kk + 4 * kg) * 2;
                        x = MFMA16(pk_lohi(*(const u32x2*)pa, *(const u32x2*)(pa + 32)), sb[kk], x);
                        y = MFMA16(pk_lohi(*(const u32x2*)pr, *(const u32x2*)(pr + 32)), sb[kk], y);
                        if (2 * kk <= t4) {
                            x = MFMA16(*(const bf16x8*)(NAK + (16 * t4 + lq) * LROW + kk * 64 + kg * 16), vt[kk], x);
                            y = MFMA16(*(const bf16x8*)(NRK + (16 * t4 + lq) * LROW + kk * 64 + kg * 16), vt[kk], y);
                        }
                    }
                    xacc[t4] = x; yacc[t4] = y;
                }
            }
            __syncthreads();
            if (wave < 4) {
                const u32x2 z2 = {0u, 0u};
                f32x4v uacc[4];
                {
                    const u32x2 t0v = *(const u32x2*)(TJ + (0 * 16 + lq) * 32 + 4 * kg * 2);
                    uacc[0] = MFMA16(pk_lohi(t0v, z2), pk_acc1(xacc[0]), ((f32x4v){0.f, 0.f, 0.f, 0.f}));
                }
                UNROLL for (int jb = 1; jb < 4; ++jb) {
                    f32x4v z = xacc[jb];
                    const char* nr = NAB + (16 * jb + lq) * LROW + 4 * kg * 2;
                    if (jb == 1) z = MFMA16(pk_lohi(*(const u32x2*)nr, z2), pk_acc1(uacc[0]), z);
                    else {
                        z = MFMA16(pk_lohi(*(const u32x2*)nr, *(const u32x2*)(nr + 32)), pk_acc2(uacc[0], uacc[1]), z);
                        if (jb == 3) z = MFMA16(pk_lohi(*(const u32x2*)(nr + 64), z2), pk_acc1(uacc[2]), z);
                    }
                    const u32x2 tv = *(const u32x2*)(TJ + (jb * 16 + lq) * 32 + 4 * kg * 2);
                    uacc[jb] = MFMA16(pk_lohi(tv, z2), pk_acc1(z), ((f32x4v){0.f, 0.f, 0.f, 0.f}));
                }
                bf16x8 ub[2]; ub[0] = pk_acc2(uacc[0], uacc[1]); ub[1] = pk_acc2(uacc[2], uacc[3]);
                UNROLL for (int t4 = 0; t4 < 4; ++t4) {
                    f32x4v y = yacc[t4];
                    UNROLL for (int kk = 0; kk < 2; ++kk) if (2 * kk <= t4) {
                        const char* pn = NRB + (16 * t4 + lq) * LROW + (32 * kk + 4 * kg) * 2;
                        y = MFMA16(pk_lohi(*(const u32x2*)pn, *(const u32x2*)(pn + 32)), ub[kk], y);
                    }
                    UNROLL for (int i = 0; i < 4; ++i) YO[(16 * t4 + 4 * kg + i) * 68 + 16 * wave + lq] = y[i];
                }
                UNROLL for (int kt = 0; kt < 4; ++kt) {
                    f32x4v sv = sacc[kt];
                    UNROLL for (int i = 0; i < 4; ++i) sv[i] *= PCv[16 * kt + 4 * kg + i];
                    UNROLL for (int kk = 0; kk < 2; ++kk) {
                        const int xr = 2 * kt + (lq >> 3);
                        const char* pb = BH + (16 * kt + lq) * LROW + (kg & 1) * 8;
                        sv = MFMA16(pk_lohi(*(const u32x2*)(pb + (((4 * kk + (kg >> 1)) ^ xr) << 4)), *(const u32x2*)(pb + (((4 * kk + 2 + (kg >> 1)) ^ xr) << 4))), ub[kk], sv);
                        sv = MFMA16(*(const bf16x8*)(KH + (16 * kt + lq) * LROW + (((4 * kk + kg) ^ xr) << 4)), vt[kk], sv);
                    }
                    sacc[kt] = sv;
                }
            }
            __syncthreads();
        }
        RW_STORE_Y(35, tid);
        __syncthreads();
    }
#undef RW_STORE_Y
}

DEV void ph_rw_read(const Params& p, int L, int ntok) {
    const int lane = TID() & 63, wave = TID() >> 6;
    const bf16_t* PXR = (const bf16_t*)(p.ws + OFF_PX); const bf16_t* VF = (const bf16_t*)(p.ws + OFF_VF);
    const bf16_t* YS = (const bf16_t*)(p.ws + OFF_YS); const float* CB = (const float*)(p.ws + OFF_CB);
    bf16_t* YA = (bf16_t*)(p.ws + OFF_YA); bf16_t* SG = (bf16_t*)(p.ws + OFF_SGB);
    const float* mu = p.in[I_MU] + (size_t)L * RW_COLS;
    const float* lg = p.in[I_LNG] + (size_t)L * 512; const float* lb = p.in[I_LNB] + (size_t)L * 512;
    for (int n0 = blockIdx.x * 8; n0 < ntok; n0 += gridDim.x * 8) {
        const int n = n0 + wave, c = lane * 8, h = lane >> 3;
        float y0[8], y1[8], v8[8], o[8];
        ld8(YS + (size_t)n * 512 + c, y0); ld8(YS + ((size_t)NT + n) * 512 + c, y1); ld8(VF + (size_t)n * 512 + c, v8);
        float s = 0.f;
        UNROLL for (int i = 0; i < 8; ++i) { y0[i] += y1[i]; s += y0[i]; }
        s += __shfl_xor(s, 1); s += __shfl_xor(s, 2); s += __shfl_xor(s, 4);
        const float mean = s * (1.f / 64.f); float q = 0.f;
        UNROLL for (int i = 0; i < 8; ++i) { const float dd = y0[i] - mean; q += dd * dd; }
        q += __shfl_xor(q, 1); q += __shfl_xor(q, 2); q += __shfl_xor(q, 4);
        const float rstd = rsqrtf(q * (1.f / 64.f) + 64e-5f);
        const float bon = CB[(size_t)n * 8 + h] + CB[((size_t)NT + n) * 8 + h];
        UNROLL for (int i = 0; i < 8; ++i) o[i] = (y0[i] - mean) * rstd * lg[c + i] + lb[c + i] + bon * v8[i];
        st8(YA + (size_t)n * 512 + c, o);
        if (lane < 16) {
            int nb, tt, T; seq_of(n, nb, tt, T);
            float g8[8]; shift8(PXR, RW_COLS, nb, tt, T, 1792 + lane * 8, mu, g8);
            UNROLL for (int i = 0; i < 8; ++i) g8[i] = sigm(g8[i]);
            st8(SG + (size_t)n * 128 + lane * 8, g8);
        }
    }
}

DEV void ph_na_norm(const Params& p, int L) {
    const int lane = TID() & 63, wave = TID() >> 6;
    bf16_t* PXN = (bf16_t*)(p.ws + OFF_PX);
    const float* qg = p.in[I_QNG] + (size_t)L * 64; const float* kg = p.in[I_KNG] + (size_t)L * 64;
    for (int n0 = blockIdx.x * 8; n0 < NT; n0 += gridDim.x * 8) {
        const int n = n0 + wave, c = lane * 8;
        UNROLL for (int w = 0; w < 2; ++w) {
            bf16_t* ptr = PXN + (size_t)n * 1024 + w * 512 + c;
            float x[8]; ld8(ptr, x);
            float ss = 0.f;
            UNROLL for (int i = 0; i < 8; ++i) ss += x[i] * x[i];
            ss += __shfl_xor(ss, 1); ss += __shfl_xor(ss, 2); ss += __shfl_xor(ss, 4);
            const float r = rsqrtf(ss * (1.f / 64.f) + 1e-6f) * (w == 0 ? 0.125f : 1.f);
            const float* g = w == 0 ? qg : kg;
            UNROLL for (int i = 0; i < 8; ++i) x[i] = x[i] * r * g[(c + i) & 63];
            st8(ptr, x);
        }
    }
}

DEV void knorm8(float (&x)[8], const float* g) {
    float ss = 0.f;
    UNROLL for (int i = 0; i < 8; ++i) ss += x[i] * x[i];
    ss = sum8(ss);
    const float r = rsqrtf(ss * (1.f / 64.f) + 1e-6f);
    UNROLL for (int i = 0; i < 8; ++i) x[i] = x[i] * r * g[i];
}
DEV void ph_na_att(const Params& p, int L, char* smem) {
    const int tid0 = TID();
    const int wave = __builtin_amdgcn_readfirstlane(tid0 >> 6);
    char* KL = smem;
    char* KC = smem + 576 * LROW;
    char* VL = smem;
    char* VC = smem + 64 * 1168;
    float* OX = (float*)(smem + 119808);
    float* RP = OX + 8 * 1024;
    const bf16_t* PXN = (const bf16_t*)(p.ws + OFF_PX); bf16_t* YB = (bf16_t*)(p.ws + OFF_YB);
    const bf16_t* VT = (const bf16_t*)(p.ws + OFF_VT); const bf16_t* VTC = (const bf16_t*)(p.ws + OFF_VTC);
    float* qgn = RP + 480; float* kgn = qgn + 64;
    const bool rp_once = (gridDim.x & 7) == 0;
    if (tid0 < 64) { qgn[tid0] = p.in[I_QNG][(size_t)L * 64 + tid0]; kgn[tid0] = p.in[I_KNG][(size_t)L * 64 + tid0]; }
    if (rp_once) for (int i = tid0; i < 15 * 31; i += NTHREADS) RP[i] = p.in[I_RPB][((size_t)L * 8 + (blockIdx.x & 7)) * 465 + i];
    __syncthreads();
    const int nunits = 2048 + (L == 0 ? 256 : 0);
    u32x4 vraw[13], qraw[2];
#define NA_GEOM(u_) const bool cu = (u_) >= 2048; int b, h, rp = 0, rs0 = 0, g = 0; \
        if (!cu) { h = (u_) & 7; rp = ((u_) >> 3) & 15; b = (u_) >> 7; rs0 = min(max(2 * rp - 4, 0), 24); } \
        else { const int v_ = (u_) - 2048; h = v_ & 7; g = (v_ >> 3) & 1; b = v_ >> 4; } \
        const int ctx0 = NX + b * CTXL; \
        const int nb = wave & 3, ri = wave >> 2, r = 2 * rp + ri; \
        const int qtok0 = cu ? ctx0 + (g * 8 + wave) * 16 : b * SEQ + r * 64 + nb * 16;
#define NA_KQ_LOAD(u_, tid_) do { NA_GEOM(u_) \
        if (!cu) { UNROLL for (int i = 0; i < 9; ++i) { const int c = (tid_) + NTHREADS * i, kx = c >> 3, part = c & 7; \
            vraw[i] = *(const u32x4*)(PXN + (size_t)(b * SEQ + min(rs0 + (kx >> 6), 31) * 64 + (kx & 63)) * 1024 + 512 + h * 64 + part * 8); } } \
        UNROLL for (int i = 0; i < 4; ++i) { const int c = (tid_) + NTHREADS * i, kx = c >> 3, part = c & 7; \
            vraw[9 + i] = *(const u32x4*)(PXN + (size_t)(ctx0 + kx) * 1024 + 512 + h * 64 + part * 8); } \
        { const int lq_ = (tid_) & 15, kg_ = ((tid_) & 63) >> 4; \
          qraw[0] = *(const u32x4*)(PXN + (size_t)(qtok0 + lq_) * 1024 + h * 64 + kg_ * 8); qraw[1] = *(const u32x4*)(PXN + (size_t)(qtok0 + lq_) * 1024 + h * 64 + 32 + kg_ * 8); } } while (0)
    int u0 = blockIdx.x; asm volatile("" : "+s"(u0));
    if (u0 < nunits) NA_KQ_LOAD(u0, tid0);
    for (int u = u0; u < nunits; u += gridDim.x) {
        int tid = tid0; asm volatile("" : "+v"(tid));
        const int lane = tid & 63, lq = lane & 15, kg = lane >> 4;
        NA_GEOM(u)
        if (!cu) {
            UNROLL for (int i = 0; i < 9; ++i) {
                const int c = tid + NTHREADS * i, kx = c >> 3, part = c & 7;
                float kv[8]; unpack8(vraw[i], kv); knorm8(kv, kgn + part * 8);
                st8((bf16_t*)(KL + kx * LROW + part * 16), kv);
            }
            if (!rp_once) for (int i = tid; i < 15 * 31; i += NTHREADS) RP[i] = p.in[I_RPB][((size_t)L * 8 + h) * 465 + i];
        }
        UNROLL for (int i = 0; i < 4; ++i) {
            const int c = tid + NTHREADS * i, kx = c >> 3, part = c & 7;
            float kv[8]; unpack8(vraw[9 + i], kv); knorm8(kv, kgn + part * 8);
            st8((bf16_t*)(KC + kx * LROW + part * 16), kv);
        }
        const int rs = min(max(r - 4, 0), 24), roff = rs - rs0;
        const int band0 = min(max(nb * 16 - 8, 0), 32);
        bf16x8 qf[2];
        {
            float q0[8], q1[8]; unpack8(qraw[0], q0); unpack8(qraw[1], q1);
            float ss = 0.f;
            UNROLL for (int i = 0; i < 8; ++i) ss += q0[i] * q0[i] + q1[i] * q1[i];
            ss += __shfl_xor(ss, 16); ss += __shfl_xor(ss, 32);
            const float rq = rsqrtf(ss * (1.f / 64.f) + 1e-6f) * 0.125f;
            UNROLL for (int i = 0; i < 8; ++i) { q0[i] = q0[i] * rq * qgn[kg * 8 + i]; q1[i] = q1[i] * rq * qgn[32 + kg * 8 + i]; }
            u32x4 w0, w1; w0.x = pk2(q0[0], q0[1]); w0.y = pk2(q0[2], q0[3]); w0.z = pk2(q0[4], q0[5]); w0.w = pk2(q0[6], q0[7]);
            w1.x = pk2(q1[0], q1[1]); w1.y = pk2(q1[2], q1[3]); w1.z = pk2(q1[4], q1[5]); w1.w = pk2(q1[6], q1[7]);
            qf[0] = __builtin_bit_cast(bf16x8, w0); qf[1] = __builtin_bit_cast(bf16x8, w1);
        }
        __syncthreads();
        if (!cu) {
            UNROLL for (int i = 0; i < 9; ++i) {
                const int c = tid + NTHREADS * i, part = c & 7, kr = (c >> 3) % 9, d = (c >> 3) / 9;
                vraw[i] = *(const u32x4*)(VT + ((size_t)(b * 8 + h) * 64 + d) * SEQ + min(rs0 + kr, 31) * 64 + part * 8);
            }
        }
        UNROLL for (int i = 0; i < 4; ++i) {
            const int c = tid + NTHREADS * i, part = c & 31, d = c >> 5;
            vraw[9 + i] = *(const u32x4*)(VTC + ((size_t)(b * 8 + h) * 64 + d) * CTXL + part * 8);
        }
        f32x4v sacc[16];
        bf16x8 pfl[8], pfc[8];
        float ml = -3e38f, ll = 0.f, mc, lc;
        if (!cu) {
            const char* kb = KL + (roff * 64 + band0 + lq) * LROW + kg * 16;
            UNROLL for (int t = 0; t < 16; ++t) {
                f32x4v a = {0.f, 0.f, 0.f, 0.f};
                UNROLL for (int ks = 0; ks < 2; ++ks) a = __builtin_amdgcn_mfma_f32_16x16x32_bf16(*(const bf16x8*)(kb + ((t >> 1) * 64 + (t & 1) * 16) * LROW + ks * 64), qf[ks], a, 0, 0, 0);
                sacc[t] = a;
            }
            const int col = nb * 16 + lq, cs = min(max(col - 8, 0), 48);
            const int kc0 = band0 + 4 * kg;
            const float* rpp = RP + (rs - r + 7) * 31 + (kc0 - col + 15);
            UNROLL for (int t = 0; t < 16; ++t) UNROLL for (int i = 0; i < 4; ++i) {
                const int kc = kc0 + (t & 1) * 16 + i;
                const bool valid = kc >= cs && kc < cs + 16;
                sacc[t][i] = valid ? sacc[t][i] + rpp[(t >> 1) * 31 + (t & 1) * 16 + i] : -1e30f;
            }
            UNROLL for (int t = 0; t < 16; ++t) UNROLL for (int i = 0; i < 4; ++i) ml = fmaxf(ml, sacc[t][i]);
            ml = fmaxf(ml, __shfl_xor(ml, 16)); ml = fmaxf(ml, __shfl_xor(ml, 32));
            UNROLL for (int t = 0; t < 16; ++t) UNROLL for (int i = 0; i < 4; ++i) { const float e = __expf(sacc[t][i] - ml); sacc[t][i] = e; ll += e; }
            ll += __shfl_xor(ll, 16); ll += __shfl_xor(ll, 32);
            UNROLL for (int tp = 0; tp < 8; ++tp) pfl[tp] = pk_acc2(sacc[2 * tp], sacc[2 * tp + 1]);
        }
        {
            const char* kb = KC + lq * LROW + kg * 16;
            UNROLL for (int t = 0; t < 16; ++t) {
                f32x4v a = {0.f, 0.f, 0.f, 0.f};
                UNROLL for (int ks = 0; ks < 2; ++ks) a = __builtin_amdgcn_mfma_f32_16x16x32_bf16(*(const bf16x8*)(kb + t * 16 * LROW + ks * 64), qf[ks], a, 0, 0, 0);
                sacc[t] = a;
            }
            mc = -3e38f; lc = 0.f;
            UNROLL for (int t = 0; t < 16; ++t) UNROLL for (int i = 0; i < 4; ++i) mc = fmaxf(mc, sacc[t][i]);
            mc = fmaxf(mc, __shfl_xor(mc, 16)); mc = fmaxf(mc, __shfl_xor(mc, 32));
            UNROLL for (int t = 0; t < 16; ++t) UNROLL for (int i = 0; i < 4; ++i) { const float e = __expf(sacc[t][i] - mc); sacc[t][i] = e; lc += e; }
            lc += __shfl_xor(lc, 16); lc += __shfl_xor(lc, 32);
            UNROLL for (int tp = 0; tp < 8; ++tp) pfc[tp] = pk_acc2(sacc[2 * tp], sacc[2 * tp + 1]);
        }
        const float mm = fmaxf(ml, mc), el = cu ? 0.f : __expf(ml - mm), ec = __expf(mc - mm);
        const float inv = frcp(ll * el + lc * ec);
        const float fl = el * inv, fc = ec * inv;
        __syncthreads();
        if (!cu) {
            UNROLL for (int i = 0; i < 9; ++i) {
                const int c = tid + NTHREADS * i, part = c & 7, kr = (c >> 3) % 9, d = (c >> 3) / 9;
                *(u32x4*)(VL + d * 1168 + (kr * 64 + part * 8) * 2) = vraw[i];
            }
        }
        UNROLL for (int i = 0; i < 4; ++i) {
            const int c = tid + NTHREADS * i, part = c & 31, d = c >> 5;
            *(u32x4*)(VC + d * 528 + part * 16) = vraw[9 + i];
        }
        __syncthreads();
        f32x4v ol[4], oc[4];
        UNROLL for (int dt = 0; dt < 4; ++dt) { ol[dt] = (f32x4v){0.f, 0.f, 0.f, 0.f}; oc[dt] = (f32x4v){0.f, 0.f, 0.f, 0.f}; }
        if (!cu) {
            const char* vb = VL + lq * 1168 + (roff * 64 + band0 + 4 * kg) * 2;
            UNROLL for (int tp = 0; tp < 8; ++tp) UNROLL for (int dt = 0; dt < 4; ++dt)
                ol[dt] = __builtin_amdgcn_mfma_f32_16x16x32_bf16(pfl[tp], pk_lohi(*(const u32x2*)(vb + dt * 16 * 1168 + tp * 128), *(const u32x2*)(vb + dt * 16 * 1168 + tp * 128 + 32)), ol[dt], 0, 0, 0);
        }
        {
            const char* vb = VC + lq * 528 + 8 * kg;
            UNROLL for (int tp = 0; tp < 8; ++tp) UNROLL for (int dt = 0; dt < 4; ++dt)
                oc[dt] = __builtin_amdgcn_mfma_f32_16x16x32_bf16(pfc[tp], pk_lohi(*(const u32x2*)(vb + dt * 16 * 528 + tp * 64), *(const u32x2*)(vb + dt * 16 * 528 + tp * 64 + 32)), oc[dt], 0, 0, 0);
        }
        if (u + (int)gridDim.x < nunits) { const int un_ = u + (int)gridDim.x; NA_KQ_LOAD(un_, tid); }
        float* ox = OX + wave * 1024;
        UNROLL for (int i = 0; i < 4; ++i) {
            const float a = __shfl(fl, 4 * kg + i), c2 = __shfl(fc, 4 * kg + i);
            UNROLL for (int dt = 0; dt < 4; ++dt) ox[(4 * kg + i) * 64 + dt * 16 + lq] = ol[dt][i] * a + oc[dt][i] * c2;
        }
        UNROLL for (int it = 0; it < 2; ++it) {
            const int q = (lane >> 3) + 8 * it, c8 = (lane & 7) * 8;
            const float4 a = *(const float4*)(ox + q * 64 + c8), bq = *(const float4*)(ox + q * 64 + c8 + 4);
            const float v[8] = {a.x, a.y, a.z, a.w, bq.x, bq.y, bq.z, bq.w};
            st8(YB + (size_t)(qtok0 + q) * 512 + h * 64 + c8, v);
        }
        __syncthreads();
    }
#undef NA_KQ_LOAD
#undef NA_GEOM
}

DEV float sum16(float v) { v += DPP_MOV(v, 0xB1); v += DPP_MOV(v, 0x4E); v += DPP_MOV(v, 0x141); v += DPP_MOV(v, 0x140); return v; }
DEV void ph_ml_scan(const Params& p, int L, char* smem) {
    const int tid = TID(), lane = tid & 63, lq = lane & 15, kg = lane >> 4, ti = tid >> 3, j = tid & 7;
    const int wave = __builtin_amdgcn_readfirstlane(tid >> 6);
    char* QS = smem;
    char* QP = QS + 9216;
    char* KC = QP + 9216;
    char* KW = KC + 9216;
    char* PM = KW + 9216;
    char* VT = PM + 9216;
    float* BV0 = (float*)(VT + 128 * LROW);
    float* GI0 = BV0 + 128;
    float* DEN = GI0 + 128;
    float* NV = DEN + 64;
    float* RS = NV + 64;
    float* HO = RS + 256;
    const bf16_t* PXM = (const bf16_t*)(p.ws + OFF_PX); bf16_t* HS = (bf16_t*)(p.ws + OFF_HS);
    for (int u = blockIdx.x; u < 128; u += gridDim.x) {
        const int d = u & 1, h = (u >> 1) & 3, b = u >> 3;
        const float ib = p.in[I_IB][L * 8 + d * 4 + h], fb = p.in[I_FB][L * 8 + d * 4 + h];
        f32x4v cacc[4];
        UNROLL for (int i = 0; i < 4; ++i) cacc[i] = (f32x4v){0.f, 0.f, 0.f, 0.f};
        for (int i = tid; i < 64 * LROW / 4; i += NTHREADS) ((unsigned*)PM)[i] = 0u;
        if (tid < 64) NV[tid] = 0.f;
        __syncthreads();
        u32x4 pq, pk, pv0, pv1; unsigned short pig = 0, pfg = 0;
#define ML_GEOM(ci_) const bool isc = (ci_) < 4; const int T = isc ? CTXL : SEQ, cc = isc ? (ci_) : (ci_) - 4; \
            const int t0 = d == 0 ? cc * 64 : T - 64 * (cc + 1), nb = isc ? NX + b * CTXL : b * SEQ; \
            const int tt = d == 0 ? t0 + ti : t0 + 63 - ti;
#define ML_PREFETCH(ci_) do { ML_GEOM(ci_) const bf16_t* row_ = PXM + (size_t)(nb + tt) * ML_COLS; \
            pq = *(const u32x4*)(row_ + h * 64 + 8 * j); pk = *(const u32x4*)(row_ + 256 + h * 64 + 8 * j); \
            pv0 = *(const u32x4*)(row_ + 512 + h * 128 + 16 * j); pv1 = *(const u32x4*)(row_ + 512 + h * 128 + 16 * j + 8); \
            if (wave == 7) { const int tl_ = d == 0 ? t0 + lane : t0 + 63 - lane; const bf16_t* rw_ = PXM + (size_t)(nb + tl_) * ML_COLS; pig = rw_[1536 + d * 4 + h]; pfg = rw_[1544 + d * 4 + h]; } } while (0)
        ML_PREFETCH(0);
#define ML_GATES(par_) do { const float ig = bf2f(pig) + ib, fg = bf2f(pfg) + fb; \
            const float igc = 15.f * tanh_fast(ig * (1.f / 15.f)), fgc = 15.f * tanh_fast(fg * (1.f / 15.f)); \
            float lf = -softplus_fast(-fgc);        \
            UNROLL for (int o = 1; o < 64; o <<= 1) { const float up = __shfl_up(lf, o); if (lane >= o) lf += up; } \
            BV0[(par_) * 64 + lane] = lf; GI0[(par_) * 64 + lane] = igc; } while (0)
        if (wave == 7) ML_GATES(0);
        __syncthreads();
        for (int ci = 0; ci < 36; ++ci) {
            ML_GEOM(ci)
            const float* BV = BV0 + (ci & 1) * 64; const float* GI = GI0 + (ci & 1) * 64;
            float q8[8], k8[8];
            {
                unpack8(pq, q8); unpack8(pk, k8);
                if (!isc) {
                    const int axis = j >> 2, half = (j >> 1) & 1; const float pos = (float)(axis == 0 ? (tt >> 6) : (tt & 63));
                    UNROLL for (int i = 0; i < 8; ++i) {
                        const int f = (j & 1) * 8 + i;
                        const float inv = exp2f(-(float)f * 0.83048202372184059f);
                        const float ang = pos * inv; const float cs = __cosf(ang), sn = __sinf(ang);
                        const float qo = __shfl_xor(q8[i], 2), ko = __shfl_xor(k8[i], 2);
                        q8[i] = half == 0 ? q8[i] * cs - qo * sn : q8[i] * cs + qo * sn;
                        k8[i] = half == 0 ? k8[i] * cs - ko * sn : k8[i] * cs + ko * sn;
                    }
                }
                UNROLL for (int i = 0; i < 8; ++i) q8[i] *= 0.125f;
                st8((bf16_t*)(QS + ti * LROW) + 8 * j, q8); st8((bf16_t*)(KC + ti * LROW) + 8 * j, k8);
                float v0[8], v1[8]; unpack8(pv0, v0); unpack8(pv1, v1);
                UNROLL for (int i = 0; i < 8; ++i) { *(bf16_t*)(VT + (16 * j + i) * LROW + ti * 2) = f2bf(v0[i]); *(bf16_t*)(VT + (16 * j + 8 + i) * LROW + ti * 2) = f2bf(v1[i]); }
            }
            if (ci + 1 < 36) ML_PREFETCH(ci + 1);
            {
                const float bt = BV[ti], bl = BV[63], gi = GI[ti];
                const float eb = __expf(bt), wk = __expf(bl - bt + gi);
                float qp[8]; float dn = 0.f;
                UNROLL for (int i = 0; i < 8; ++i) { qp[i] = q8[i] * eb; dn += q8[i] * NV[8 * j + i]; }
                st8((bf16_t*)(QP + ti * LROW) + 8 * j, qp);
                UNROLL for (int i = 0; i < 8; ++i) *(bf16_t*)(KW + (8 * j + i) * LROW + ti * 2) = f2bf(k8[i] * wk);
                dn = sum8(dn);
                if (j == 0) DEN[ti] = dn * eb;
            }
            __syncthreads();
            UNROLL for (int rep = 0; rep < 2; ++rep) {
                const int tile = wave + 8 * rep;
                if (tile < 10) {
                    const int tt4 = tile < 1 ? 0 : tile < 3 ? 1 : tile < 6 ? 2 : 3, st4 = tile - (tt4 * (tt4 + 1)) / 2;
                    f32x4v a = {0.f, 0.f, 0.f, 0.f};
                    UNROLL for (int ks = 0; ks < 2; ++ks)
                        a = __builtin_amdgcn_mfma_f32_16x16x32_bf16(*(const bf16x8*)(QS + (16 * tt4 + lq) * LROW + ks * 64 + kg * 16),
                                                                    *(const bf16x8*)(KC + (16 * st4 + lq) * LROW + ks * 64 + kg * 16), a, 0, 0, 0);
                    const int sidx = 16 * st4 + lq; const float bs = BV[sidx], gs = GI[sidx];
                    UNROLL for (int i = 0; i < 4; ++i) {
                        const int tidx = 16 * tt4 + 4 * kg + i;
                        const float val = sidx <= tidx ? a[i] * __expf(BV[tidx] - bs + gs) : 0.f;
                        *(bf16_t*)(PM + tidx * LROW + sidx * 2) = f2bf(val);
                        const float rsum = sum16(val);
                        if (lq == 0) RS[tidx * 4 + st4] = rsum;
                    }
                }
            }
            if (wave == 7 && ci + 1 < 36) ML_GATES((ci + 1) & 1);
            if (wave == 6) {
                float acc = 0.f;
                UNROLL for (int c8 = 0; c8 < 8; ++c8) { float kw[8]; ld8((const bf16_t*)(KW + lane * LROW) + 8 * c8, kw); UNROLL for (int i = 0; i < 8; ++i) acc += kw[i]; }
                NV[lane] = __expf(BV[63]) * NV[lane] + acc;
            }
            __syncthreads();
            {
                bf16x8 vf[2], cb[2];
                UNROLL for (int kk = 0; kk < 2; ++kk) vf[kk] = *(const bf16x8*)(VT + (16 * wave + lq) * LROW + kk * 64 + kg * 16);
                UNROLL for (int kk = 0; kk < 2; ++kk) {
                    u32x4 w; w.x = pk2(cacc[2 * kk][0], cacc[2 * kk][1]); w.y = pk2(cacc[2 * kk][2], cacc[2 * kk][3]);
                    w.z = pk2(cacc[2 * kk + 1][0], cacc[2 * kk + 1][1]); w.w = pk2(cacc[2 * kk + 1][2], cacc[2 * kk + 1][3]);
                    cb[kk] = __builtin_bit_cast(bf16x8, w);
                }
                UNROLL for (int tt4 = 0; tt4 < 4; ++tt4) {
                    f32x4v hacc = {0.f, 0.f, 0.f, 0.f};
                    UNROLL for (int kk = 0; kk < 2; ++kk) if (2 * kk <= tt4)
                        hacc = __builtin_amdgcn_mfma_f32_16x16x32_bf16(*(const bf16x8*)(PM + (16 * tt4 + lq) * LROW + kk * 64 + kg * 16), vf[kk], hacc, 0, 0, 0);
                    UNROLL for (int kk = 0; kk < 2; ++kk) {
                        const char* qa = QP + (16 * tt4 + lq) * LROW + (32 * kk + 4 * kg) * 2;
                        const u32x2 lo = *(const u32x2*)qa, hi = *(const u32x2*)(qa + 32);
                        u32x4 w; w.x = lo.x; w.y = lo.y; w.z = hi.x; w.w = hi.y;
                        hacc = __builtin_amdgcn_mfma_f32_16x16x32_bf16(__builtin_bit_cast(bf16x8, w), cb[kk], hacc, 0, 0, 0);
                    }
                    UNROLL for (int i = 0; i < 4; ++i) {
                        const int tidx = 16 * tt4 + 4 * kg + i;
                        float den = DEN[tidx];
                        UNROLL for (int st = 0; st <= tt4; ++st) den += RS[tidx * 4 + st];
                        HO[tidx * 132 + 16 * wave + lq] = hacc[i] * frcp(fmaxf(fabsf(den), 1.f));
                    }
                }
                const float g = __expf(BV[63]);
                UNROLL for (int dk = 0; dk < 4; ++dk) {
                    cacc[dk] = cacc[dk] * g;
                    UNROLL for (int kk = 0; kk < 2; ++kk)
                        cacc[dk] = __builtin_amdgcn_mfma_f32_16x16x32_bf16(*(const bf16x8*)(KW + (16 * dk + lq) * LROW + kk * 64 + kg * 16), vf[kk], cacc[dk], 0, 0, 0);
                }
            }
            __syncthreads();
            {
                const float* hr = HO + ti * 132 + 16 * j;
                float o0[8], o1[8];
                UNROLL for (int i = 0; i < 8; ++i) { o0[i] = hr[i]; o1[i] = hr[8 + i]; }
                bf16_t* dst = HS + ((size_t)d * NT + nb + tt) * 512 + h * 128 + 16 * j;
                st8(dst, o0); st8(dst + 8, o1);
            }
        }
        __syncthreads();
    }
#undef ML_GATES
}
DEV void ph_ml_read(const Params& p, int L, int ntok) {
    const int lane = TID() & 63, wave = TID() >> 6;
    const bf16_t* PXM = (const bf16_t*)(p.ws + OFF_PX); const bf16_t* HS = (const bf16_t*)(p.ws + OFF_HS);
    bf16_t* YC = (bf16_t*)(p.ws + OFF_YC); const float* ng = p.in[I_MNG] + (size_t)L * 512;
    for (int n0 = blockIdx.x * 8; n0 < ntok; n0 += gridDim.x * 8) {
        const int n = n0 + wave, c = lane * 8;
        float h0[8], h1[8], o8[8], out[8];
        ld8(HS + (size_t)n * 512 + c, h0); ld8(HS + ((size_t)NT + n) * 512 + c, h1); ld8(PXM + (size_t)n * ML_COLS + 1024 + c, o8);
        float ss = 0.f;
        UNROLL for (int i = 0; i < 8; ++i) { h0[i] += h1[i]; ss += h0[i] * h0[i]; }
        ss += __shfl_xor(ss, 1); ss += __shfl_xor(ss, 2); ss += __shfl_xor(ss, 4); ss += __shfl_xor(ss, 8);
        const float r = rsqrtf(ss * (1.f / 128.f) + 1e-6f);
        UNROLL for (int i = 0; i < 8; ++i) out[i] = h0[i] * r * ng[c + i] * sigm(o8[i]);
        st8(YC + (size_t)n * 512 + c, out);
    }
}

DEV void ph_route(const Params& p, int L, int ntok, char* smem) {
    const int lane = TID() & 63, wave = TID() >> 6;
    const float* LOG = (const float*)(p.ws + OFF_LOG); int* EIDX = (int*)(p.ws + OFF_EIDX); float* EW = (float*)(p.ws + OFF_EW);
    const float bias = p.in[I_MB][L * 64 + lane];
    int* MCNT = (int*)(p.ws + OFF_MCNT);
    int* hist = (int*)smem;
    if (TID() < 192) hist[TID()] = 0;
    __syncthreads();
    for (int n0 = blockIdx.x * 8; n0 < ntok; n0 += gridDim.x * 8) {
        const int n = n0 + wave, g = lane >> 3;
        const float score = sigm_acc(LOG[(size_t)n * 64 + lane]), sel = score + bias;
        float m1 = sel; m1 = fmaxf(m1, __shfl_xor(m1, 1)); m1 = fmaxf(m1, __shfl_xor(m1, 2)); m1 = fmaxf(m1, __shfl_xor(m1, 4));
        int i1 = sel == m1 ? lane : 64; i1 = min(i1, __shfl_xor(i1, 1)); i1 = min(i1, __shfl_xor(i1, 2)); i1 = min(i1, __shfl_xor(i1, 4));
        float m2 = lane == i1 ? -3e38f : sel; m2 = fmaxf(m2, __shfl_xor(m2, 1)); m2 = fmaxf(m2, __shfl_xor(m2, 2)); m2 = fmaxf(m2, __shfl_xor(m2, 4));
        const float gs = m1 + m2;
        int rank = 0;
        UNROLL for (int g2 = 0; g2 < 8; ++g2) { const float v = __shfl(gs, g2 * 8); rank += (v > gs || (v == gs && g2 < g)) ? 1 : 0; }
        const float ms = rank < 4 ? sel : -1e30f;
        int er = 0;
        for (int e2 = 0; e2 < 64; ++e2) { const float v = __shfl(ms, e2); er += (v > ms || (v == ms && e2 < lane)) ? 1 : 0; }
        const bool chosen = er < 8;
        float ws = chosen ? score : 0.f;
        UNROLL for (int o = 1; o < 64; o <<= 1) ws += __shfl_xor(ws, o);
        if (chosen) { EIDX[(size_t)n * 8 + er] = lane; EW[(size_t)n * 8 + er] = score / ws * 2.5f; atomicAdd(hist + (n / MOE_CHUNK) * 64 + lane, 1); }
    }
    __syncthreads();
    if (TID() < 192 && hist[TID()] > 0) atomicAdd(MCNT + TID(), hist[TID()]);
    __syncthreads();
}


DEV void ph_moe_scatter(const Params& p, int ntok, char* smem) {
    const int tid = TID();
    int* base = (int*)smem;
    int* lh = base + 192;
    const int* MCNT = (const int*)(p.ws + OFF_MCNT); int* CUR = (int*)(p.ws + OFF_MCNT) + 192;
    const int* EIDX = (const int*)(p.ws + OFF_EIDX); int* SORT = (int*)(p.ws + OFF_SORT);
    if (tid < 3) { int b = 0; for (int e = 0; e < 64; ++e) { base[tid * 64 + e] = b; b += (MCNT[tid * 64 + e] + 127) & ~127; } }
    if (tid < 192) lh[tid] = 0;
    __syncthreads();
    for (int i = blockIdx.x * NTHREADS + tid; i < ntok * 8; i += gridDim.x * NTHREADS) atomicAdd(lh + ((i >> 3) / MOE_CHUNK) * 64 + EIDX[i], 1);
    __syncthreads();
    if (tid < 192) { const int n = lh[tid]; if (n > 0) base[tid] += atomicAdd(CUR + tid, n); lh[tid] = 0; }
    __syncthreads();
    for (int i = blockIdx.x * NTHREADS + tid; i < ntok * 8; i += gridDim.x * NTHREADS) {
        const int ce = ((i >> 3) / MOE_CHUNK) * 64 + EIDX[i];
        SORT[(size_t)(ce >> 6) * SORT_CAP + base[ce] + atomicAdd(lh + ce, 1)] = i;
    }
    __syncthreads();
}

DEV void ph_moe_exp(const Params& p, int cb, int ce, char* smem, Topo tp) {
    typedef GC<2, 4> C;
    const int tid0 = TID();
    char* ACT = smem + 2 * C::STG;
    int* list = (int*)(smem + 3 * C::STG);
    int* cnt = list + 1024;
    const bf16_t* H2 = (const bf16_t*)(p.ws + OFF_HX); const int* EIDX = (const int*)(p.ws + OFF_EIDX); const float* EW = (const float*)(p.ws + OFF_EW);
    unsigned char* YB8 = (unsigned char*)(p.ws + OFF_YBUF); unsigned char* YSC = (unsigned char*)(p.ws + OFF_YSC);
    const int c = cb / MOE_CHUNK;
    const int* MCNT = (const int*)(p.ws + OFF_MCNT) + c * 64; const int* SORT = (const int*)(p.ws + OFF_SORT) + (size_t)c * SORT_CAP;
    int* tb = cnt + 16;
    const int xcd = tp.x, slot = tp.r, nslot = tp.n;
    __syncthreads();
    if (tid0 < 8) {
        const int tid = tid0; const int e = xcd + 8 * tid; int b = 0;
        for (int e2 = 0; e2 < e; ++e2) b += (MCNT[e2] + 127) & ~127;
        tb[16 + tid] = b; tb[32 + tid] = MCNT[e];
    }
    __syncthreads();
    if (tid0 == 0) { int t = 0; for (int k = 0; k < 8; ++k) { tb[k] = t; t += (tb[32 + k] + 127) >> 7; } tb[8] = t; }
    __syncthreads();
    const int total = tb[8];
    float* ewl = (float*)(list + 256);
    if (slot < total && tid0 < 128) {
        int k = 0;
        while (k < 7 && slot >= tb[k + 1]) ++k;
        const int j = slot - tb[k], M = min(128, tb[32 + k] - 128 * j);
        const int en = SORT[tb[16 + k] + 128 * j + min(tid0, M - 1)];
        list[tid0] = en; ewl[tid0] = EW[en];
    }
    int cur = 0;
#define GLDS4(gp, lp) __builtin_amdgcn_global_load_lds((const __attribute__((address_space(1))) void*)(gp), (__attribute__((address_space(3))) void*)(lp), 4, 0, 0)
    for (int lu = slot; lu < total; lu += nslot) {
        int tid = tid0; asm volatile("" : "+v"(tid));
        const int lane = tid & 63, wave = tid >> 6, wm = wave / 4, wn = wave % 4, fr = lane & 31, fh = lane >> 5;
        int k = 0;
        while (k < 7 && lu >= tb[k + 1]) ++k;
        const int e = xcd + 8 * k, j = lu - tb[k], M = min(128, tb[32 + k] - 128 * j);
        const int* lst = list + cur * 128; const float* ew = ewl + cur * 128;
        int* lst2 = list + (cur ^ 1) * 128; float* ew2 = ewl + (cur ^ 1) * 128;
        const bool has_next = lu + nslot < total;
        __syncthreads();
        if (has_next && tid < 128) {
            const int lu2 = lu + nslot; int k2 = 0;
            while (k2 < 7 && lu2 >= tb[k2 + 1]) ++k2;
            const int j2 = lu2 - tb[k2], M2 = min(128, tb[32 + k2] - 128 * j2);
            GLDS4(SORT + tb[16 + k2] + 128 * j2 + min(tid, M2 - 1), lst2 + tid);
        }
        const bf16_t* GU = (const bf16_t*)(p.ws + OFF_MGU) + (size_t)e * 256 * 1024;
        const bf16_t* DT = (const bf16_t*)(p.ws + OFF_MDT) + (size_t)e * 1024 * 128;
        {
            constexpr int mc = 0;
            f32x16 acc[2][2];
            {
            acc_zero(acc);
            gemm_tile<2, 4, 3, false, true>(acc, [&](int r) -> const bf16_t* { const int ix = min(mc + r, M - 1); return H2 + (size_t)(lst[ix] >> 3) * 1024; },
                                   GU, 1024, 0, 256, 1024, smem, nullptr);
            }
            const int crow = tid >> 3, cch = (tid & 7) ^ ((crow >> 1) & 7);
#define MG2_ISSUE(nt_) do { UNROLL for (int kt = 0; kt < 2; ++kt) UNROLL for (int i = 0; i < 4; ++i) \
                    GLDS16(DT + (size_t)((nt_) * 256 + ((crow + 64 * i) & ~31) + p32(crow & 31)) * 128 + kt * 64 + cch * 8, smem + kt * C::STG + C::AB + i * 8192 + tid * 16); } while (0)
            if (has_next && tid < 128) GLDS4(EW + lst2[tid], ew2 + tid);
            MG2_ISSUE(0);
            UNROLL for (int mi = 0; mi < 2; ++mi) {
                const int row = wm * 64 + mi * 32 + fr;
                const float gw = ew[row];
                float a[2][8];
                UNROLL for (int r = 0; r < 16; ++r) { const float gv = acc[mi][0][r], uv = acc[mi][1][r]; a[r >> 3][r & 7] = gv * frcp(1.f + __expf(-gv)) * uv * gw; }
                const int col0 = wn * 32 + 16 * fh, c0 = (col0 & 63) >> 3, swr = (row >> 1) & 7;
                char* arow_ = ACT + (col0 >> 6) * C::AB + row * 128;
                st8((bf16_t*)(arow_ + ((c0 ^ swr) << 4)), a[0]); st8((bf16_t*)(arow_ + (((c0 + 1) ^ swr) << 4)), a[1]);
            }
            __syncthreads();
            {
                const int sw = (fr >> 1) & 7, a_base = (wm * 64 + fr) * 128, b_base = (wn * 64 + fr) * 128;
                asm volatile("s_waitcnt vmcnt(0)" ::: "memory");
                _Pragma("unroll 1") for (int nt = 0; nt < 4; ++nt) {
                    __builtin_amdgcn_s_barrier();
                    asm volatile("" ::: "memory");
                    acc_zero(acc);
                    UNROLL for (int kt = 0; kt < 2; ++kt) {
                        const char* As_ = ACT + kt * C::AB; const char* Bs_ = smem + kt * C::STG + C::AB;
                        UNROLL for (int ks = 0; ks < 4; ++ks) {
                            const int off = ((2 * ks + fh) ^ sw) * 16;
                            bf16x8 af[2], bfv[2];
                            UNROLL for (int mi = 0; mi < 2; ++mi) af[mi] = *(const bf16x8*)(As_ + a_base + mi * 4096 + off);
                            UNROLL for (int ni = 0; ni < 2; ++ni) bfv[ni] = *(const bf16x8*)(Bs_ + b_base + ni * 4096 + off);
                            UNROLL for (int mi = 0; mi < 2; ++mi) UNROLL for (int ni = 0; ni < 2; ++ni)
                                acc[mi][ni] = __builtin_amdgcn_mfma_f32_32x32x16_bf16(bfv[ni], af[mi], acc[mi][ni], 0, 0, 0);
                        }
                    }
                    asm volatile("s_waitcnt lgkmcnt(0)" ::: "memory");
                    __builtin_amdgcn_s_barrier();
                    asm volatile("" ::: "memory");
                    if (nt < 3) MG2_ISSUE(nt + 1);
                    asm volatile("" ::: "memory");
                    UNROLL for (int mi = 0; mi < 2; ++mi) {
                        const int en = lst[wm * 64 + mi * 32 + fr] - cb * 8;
                        unsigned char* yrow = YB8 + (size_t)en * 1024 + nt * 256 + wn * 64 + 16 * fh;
                        unsigned char* srow = YSC + ((size_t)(en >> 3) * 64 + nt * 16 + wn * 4 + fh) * 8 + (en & 7);
                        UNROLL for (int ni = 0; ni < 2; ++ni) {
                            float m = 0.f;
                            UNROLL for (int i = 0; i < 16; ++i) m = fmaxf(m, fabsf(acc[mi][ni][i]));
                            const unsigned be = max(__float_as_uint(m) >> 23, 7u);
                            const float inv = __uint_as_float((261u - be) << 23);
                            u32x4 w;
                            UNROLL for (int q = 0; q < 4; ++q) {
                                int d = 0;
                                d = __builtin_amdgcn_cvt_pk_fp8_f32(acc[mi][ni][4 * q] * inv, acc[mi][ni][4 * q + 1] * inv, d, false);
                                d = __builtin_amdgcn_cvt_pk_fp8_f32(acc[mi][ni][4 * q + 2] * inv, acc[mi][ni][4 * q + 3] * inv, d, true);
                                if (q == 0) w.x = (unsigned)d; else if (q == 1) w.y = (unsigned)d; else if (q == 2) w.z = (unsigned)d; else w.w = (unsigned)d;
                            }
                            *(u32x4*)(yrow + ni * 32) = w;
                            srow[ni * 16] = (unsigned char)be;
                        }
                    }
                    asm volatile("s_waitcnt vmcnt(8)" ::: "memory");
                }
#undef MG2_ISSUE
            }
        }
        cur ^= 1;
    }
#undef GLDS4
}


#define XB_TMO      128
#define XB_XCNT(j)  (256  + 64 * (j))
#define XB_XSUB(j)  (1280 + 64 * (j))
#define XB_XGEN(j)  (2304 + 64 * (j))
#define XB_TOP      3328
#define XB_TOPGEN   3392
#define XCD_BAR_WORDS 3456
#define XB_SPIN_CAP (1u << 18)
#define LAS __attribute__((address_space(3)))

__device__ __forceinline__ unsigned xb_ld(unsigned* p)              { return __hip_atomic_load(p, __ATOMIC_RELAXED, __HIP_MEMORY_SCOPE_AGENT); }
__device__ __forceinline__ unsigned xb_add(unsigned* p, unsigned v) { return __hip_atomic_fetch_add(p, v, __ATOMIC_RELAXED, __HIP_MEMORY_SCOPE_AGENT); }
__device__ __forceinline__ unsigned xb_xcc_id() { return (unsigned)__builtin_amdgcn_s_getreg((3 << 11) | 20) & 0xFu; }
#define XB_SPIN(cond, bar) do { unsigned _sp = 0; while (cond) { __builtin_amdgcn_s_sleep(1); \
    if ((++_sp & 255u) == 0u) { if (xb_ld(&(bar)[XB_TMO])) break; if (_sp > XB_SPIN_CAP) { atomicAdd(&(bar)[XB_TMO], 1u); break; } } } } while (0)

struct XcdBarrier { unsigned* bar; unsigned x; volatile LAS unsigned* st; };

__device__ __forceinline__ XcdBarrier xcd_barrier_post(unsigned* bar, volatile LAS unsigned* st) {
    XcdBarrier b; b.bar = bar; b.x = xb_xcc_id(); b.st = st;
    if (threadIdx.x == 0) { const unsigned rank = xb_add(&bar[XB_XCNT(b.x)], 1u); st[2] = b.x; st[3] = rank; }
    return b;
}
__device__ __forceinline__ void xcd_barrier_complete(unsigned* bar, unsigned x, unsigned& nloc, unsigned& nx) {
    const unsigned G = gridDim.x * gridDim.y * gridDim.z;
    unsigned sum, cnt, mine, sp = 0u;
    for (;;) {
        sum = 0u; cnt = 0u; mine = 0u;
#pragma unroll
        for (unsigned j = 0; j < 16; ++j) { const unsigned c = xb_ld(&bar[XB_XCNT(j)]); sum += c; cnt += (c > 0u) ? 1u : 0u; mine = (j == x) ? c : mine; }
        if (sum == G) break;
        __builtin_amdgcn_s_sleep(1);
        if ((++sp & 255u) == 0u) { if (xb_ld(&bar[XB_TMO])) break; if (sp > XB_SPIN_CAP) { atomicAdd(&bar[XB_TMO], 1u); break; } }
    }
    nloc = mine > 0u ? mine : 1u; nx = cnt > 0u ? cnt : 1u;
}
__device__ __forceinline__ void xcd_barrier(const XcdBarrier& b) {
    asm volatile("s_waitcnt vmcnt(0)" ::: "memory");
    __syncthreads();
    if (threadIdx.x == 0) {
        unsigned* bar = b.bar;
        __builtin_amdgcn_s_waitcnt(0);
        unsigned nloc = b.st[0], nx = b.st[1];
        if (nloc == 0u) { xcd_barrier_complete(bar, b.x, nloc, nx); b.st[0] = nloc; b.st[1] = nx; }
        const unsigned old = xb_add(&bar[XB_XSUB(b.x)], 1u);
        const unsigned gen = old / nloc;
        if (old + 1u == (gen + 1u) * nloc) {
            __builtin_amdgcn_fence(__ATOMIC_RELEASE, "agent");
            asm volatile("s_waitcnt vmcnt(0)" ::: "memory");
            const unsigned og = xb_add(&bar[XB_TOP], 1u);
            const unsigned tg = og / nx;
            if (og + 1u == (tg + 1u) * nx) xb_add(&bar[XB_TOPGEN], 1u);
            else XB_SPIN(xb_ld(&bar[XB_TOPGEN]) == tg, bar);
            __builtin_amdgcn_fence(__ATOMIC_ACQUIRE, "agent");
            xb_add(&bar[XB_XGEN(b.x)], 1u);
            asm volatile("s_waitcnt vmcnt(0)" ::: "memory");
        } else {
            XB_SPIN(xb_ld(&bar[XB_XGEN(b.x)]) == gen, bar);
            __builtin_amdgcn_fence(__ATOMIC_ACQUIRE, "agent");
            asm volatile("s_waitcnt vmcnt(0)" ::: "memory");
        }
    }
    __syncthreads();
}

enum { PH_MODCONV = 0, PH_HX, PH_GEMM_R, PH_RW_PREP, PH_RW_SCAN, PH_RW_READ, PH_RW_G, PH_GEMM_N, PH_NA_NORM, PH_NA_ATT, PH_GEMM_M, PH_ML_SCAN, PH_ML_READ,
       PH_GEMM_G, PH_MERGE, PH_OUT, PH_NORM2, PH_ROUTER, PH_ROUTE, PH_SHARED, PH_MOE_EXP, PH_MOE_COMB, PH_COUNT };

template <int PH> DEV void run_phase(const Params& p, int L, int sub, char* smem, Topo tp) {
    const int tid = TID(), lane = tid & 63, fr = lane & 31, fh = lane >> 5;
    char* ws = p.ws;
    const int ntl = L == 0 ? NT : NX;
    const bf16_t* HX = (const bf16_t*)(ws + OFF_HX);
    const bf16_t* WINT = (const bf16_t*)(ws + OFF_WINT);
    if constexpr (PH == PH_MODCONV) { ph_mod(p, L, smem); ph_conv_mix(p, L, smem); }
    else if constexpr (PH == PH_HX) { ph_norm(p, L, 0, NT); }
    else if constexpr (PH == PH_GEMM_R || PH == PH_GEMM_M) {
        const int c0 = PH == PH_GEMM_R ? 0 : RW_COLS + NA_COLS;
        const int N = PH == PH_GEMM_R ? RW_COLS : ML_COLS;
        bf16_t* PX = (bf16_t*)(ws + OFF_PX);
        gemm256(HX, NT, WINT + (size_t)c0 * DM, N, DM, smem, tp, [&](int row, int col, const float (&v)[8]) {
            if (col < N) st8(PX + (size_t)row * N + col, v);
        });
    }
    else if constexpr (PH == PH_GEMM_N) {
        bf16_t* PX = (bf16_t*)(ws + OFF_PX); bf16_t* VT = (bf16_t*)(ws + OFF_VT); bf16_t* VTC = (bf16_t*)(ws + OFF_VTC);
        gemm256(HX, NT, WINT + (size_t)RW_COLS * DM, 1024, DM, smem, tp, [&](int row, int col, const float (&v)[8]) { st8(PX + (size_t)row * 1024 + col, v); });
        gemm_phase<4, 2>(HX, DM, NT, WINT + (size_t)(RW_COLS + 1024) * DM, DM, 512, DM, smem, tp, [&](const f32x16 (&acc)[2][2], int row0, int col0) {
            const int h = col0 >> 6;
            epi_cols(acc, smem, [&](int r8, int col, const float (&v)[8]) {
                const int n = row0 + r8;
                bf16_t* dst = n < NX ? VT + ((size_t)((n >> 11) * 8 + h) * 64 + col) * SEQ + (n & 2047)
                                     : VTC + ((size_t)(((n - NX) >> 8) * 8 + h) * 64 + col) * CTXL + ((n - NX) & 255);
                st8(dst, v);
            });
        });
    }
    else if constexpr (PH == PH_RW_PREP) { ph_rw_prep(p, L, smem); }
    else if constexpr (PH == PH_RW_SCAN) { ph_rw_scan(p, L, smem); }
    else if constexpr (PH == PH_RW_READ) { ph_rw_read(p, L, ntl); }
    else if constexpr (PH == PH_RW_G) {
        bf16_t* YA = (bf16_t*)(ws + OFF_YA);
        gemm_phase<4, 2>((const bf16_t*)(ws + OFF_SGB), 128, ntl, (const bf16_t*)(ws + OFF_G2T), 128, 512, 128, smem, tp, [&](const f32x16 (&acc)[2][2], int row0, int col0) {
            epi_rows(acc, smem, [&](int row, int c8, const float (&v)[8]) {
                bf16_t* q = YA + (size_t)(row0 + row) * 512 + col0 + c8;
                float y[8]; ld8(q, y);
                UNROLL for (int i = 0; i < 8; ++i) y[i] *= v[i];
                st8(q, y);
            });
        });
    }
    else if constexpr (PH == PH_NA_NORM) { ph_na_norm(p, L); }
    else if constexpr (PH == PH_NA_ATT) { ph_na_att(p, L, smem); }
    else if constexpr (PH == PH_ML_SCAN) {
        if (blockIdx.x < 128 || gridDim.x <= 128) ph_ml_scan(p, L, smem);
        if (gridDim.x <= 128) ph_conv_moe_gu(p, L, smem, blockIdx.x, gridDim.x);
        else if (blockIdx.x >= 128) ph_conv_moe_gu(p, L, smem, blockIdx.x - 128, gridDim.x - 128);
    }
    else if constexpr (PH == PH_ML_READ) { ph_ml_read(p, L, ntl); }
    else if constexpr (PH == PH_GEMM_G) {
        bf16_t* G = (bf16_t*)(ws + OFF_GATES);
        gemm256(HX, ntl, WINT + (size_t)(RW_COLS + NA_COLS + ML_COLS) * DM, GATE_COLS, DM, smem, tp, [&](int row, int col, const float (&v)[8]) {
            float y[8];
            UNROLL for (int i = 0; i < 8; ++i) y[i] = sigm(v[i]);
            st8(G + (size_t)row * GATE_COLS + col, y);
        });
    }
    else if constexpr (PH == PH_MERGE) {
        typedef GC<2, 4> C;
        const bf16_t* G = (const bf16_t*)(ws + OFF_GATES); bf16_t* MG = (bf16_t*)(ws + OFF_HX);
        const int wave = tid >> 6, wm = wave / 4, wn = wave % 4;
        const TileOrder ord(tp, ntl / C::BM, DM / C::BN);
        for (int q = tp.r; q < ord.total; q += tp.n) {
            int pm, pn; if (!ord.get(q, pm, pn)) continue;
            int tido = tid; asm volatile("" : "+v"(tido));
            const int fro = tido & 31, fho = (tido & 63) >> 5;
            const size_t row0 = (size_t)pm * C::BM + wm * 64 + fro; const int col0 = pn * C::BN + wn * 64 + 16 * fho;
            f32x16 tot[2][2], acc[2][2]; acc_zero(tot); acc_zero(acc);
            u32x4 graw[2][2][2];
#define MRG_GATES(br_) do { UNROLL for (int mi = 0; mi < 2; ++mi) UNROLL for (int ni = 0; ni < 2; ++ni) UNROLL for (int hh = 0; hh < 2; ++hh) \
                graw[mi][ni][hh] = *(const u32x4*)(G + (row0 + mi * 32) * GATE_COLS + (br_) * DM + col0 + ni * 32 + 8 * hh); } while (0)
            MRG_GATES(0);
            const bf16_t* Ab = (const bf16_t*)(ws + OFF_YA) + (size_t)pm * C::BM * 512;
            gemm_tile<2, 4, 3, false, true>(acc, [&](int r) { return Ab + (size_t)r * 512; }, (const bf16_t*)(ws + OFF_WBT), 512, pn * C::BN, DM, 1536, smem, nullptr,
                [](int kt) { return (size_t)(kt >> 3) * (SZ_Y1 / 2) + (size_t)(kt & 7) * 64; },
                [](int kt) { return (size_t)(kt >> 3) * ((size_t)1024 * 512) + (size_t)(kt & 7) * 64; },
                [&](int kt) {
                    if ((kt & 7) == 7) {
                        UNROLL for (int mi = 0; mi < 2; ++mi) UNROLL for (int ni = 0; ni < 2; ++ni) UNROLL for (int hh = 0; hh < 2; ++hh) {
                            float g[8]; unpack8(graw[mi][ni][hh], g);
                            UNROLL for (int i = 0; i < 8; ++i) { tot[mi][ni][8 * hh + i] += g[i] * acc[mi][ni][8 * hh + i]; acc[mi][ni][8 * hh + i] = 0.f; }
                        }
                        if (kt < 23) MRG_GATES((kt >> 3) + 1);
                    }
                });
#undef MRG_GATES
            UNROLL for (int mi = 0; mi < 2; ++mi) UNROLL for (int ni = 0; ni < 2; ++ni) UNROLL for (int hh = 0; hh < 2; ++hh) {
                float v[8]; UNROLL for (int i = 0; i < 8; ++i) v[i] = tot[mi][ni][8 * hh + i];
                st8(MG + (row0 + mi * 32) * DM + col0 + ni * 32 + 8 * hh, v);
            }
        }
    }
    else if constexpr (PH == PH_OUT) {
        const float* MOD = (const float*)(ws + OFF_MOD);
        gemm256(HX, ntl, (const bf16_t*)(ws + OFF_WOUTT), DM, DM, smem, tp, [&](int n, int c, const float (&v)[8]) {
            const float* xp = xprev_row(p, L, n) + c; float* xo = xs_row(p, n) + c; const float* g1 = MOD + mod_row(n) * 6144 + 2 * DM + c;
            const float4 xa = *(const float4*)xp, xb = *(const float4*)(xp + 4), ga = *(const float4*)g1, gb = *(const float4*)(g1 + 4);
            float4 oa, ob;
            oa.x = xa.x + ga.x * v[0]; oa.y = xa.y + ga.y * v[1]; oa.z = xa.z + ga.z * v[2]; oa.w = xa.w + ga.w * v[3];
            ob.x = xb.x + gb.x * v[4]; ob.y = xb.y + gb.y * v[5]; ob.z = xb.z + gb.z * v[6]; ob.w = xb.w + gb.w * v[7];
            *(float4*)xo = oa; *(float4*)(xo + 4) = ob;
        });
    }
    else if constexpr (PH == PH_NORM2) {
        if (blockIdx.x == 0 && tid < 384) ((int*)(ws + OFF_MCNT))[tid] = 0;
        ph_norm(p, L, 1, ntl);
    }
    else if constexpr (PH == PH_ROUTER) {
        typedef GC<4, 2> C;
        float* LOG = (float*)(ws + OFF_LOG);
        const bf16_t* H2LO = (const bf16_t*)(ws + OFF_H2LO); const bf16_t* RH = (const bf16_t*)(ws + OFF_RTR); const bf16_t* RL = RH + 64 * 1024;
        const int wave = tid >> 6, wm = wave / 2, wn = wave % 2;
        {
            const int nrt = ntl / C::BM, G = gridDim.x;
            if (G > nrt) { if ((int)blockIdx.x >= nrt) ph_conv_moe(p, L, smem, blockIdx.x - nrt, G - nrt); }
            else ph_conv_moe(p, L, smem, blockIdx.x, G);
        }
        const size_t lo_off = (size_t)((const bf16_t*)(ws + OFF_H2LO) - HX);
        for (int t = blockIdx.x; t < ntl / C::BM; t += gridDim.x) {
            f32x16 acc[2][2]; acc_zero(acc);
            const bf16_t* A0 = HX + (size_t)t * C::BM * DM;
            gemm_tile<4, 2, 3, false>(acc, [&](int r) { return A0 + (size_t)r * DM; }, RH, DM, 0, 128, 2048, smem, nullptr,
                [&](int kt) { return (size_t)(kt >> 4) * lo_off + (size_t)(kt & 15) * 64; }, [](int kt) { return (size_t)(kt & 15) * 64; });
            const int lane = tid & 63, fr2 = lane & 31, fh2 = lane >> 5;
            float* st = (float*)(smem + wave * EPI_SLAB);
            UNROLL for (int mi = 0; mi < 2; ++mi) {
                UNROLL for (int ni = 0; ni < 2; ++ni) UNROLL for (int r = 0; r < 16; ++r)
                    st[((r & 3) + 8 * (r >> 2) + 4 * fh2) * 68 + ni * 32 + fr2] = acc[mi][ni][r];
                __syncthreads();
                if (wn == 0) {
                    const float* st1 = (const float*)(smem + (wave + 1) * EPI_SLAB);
                    UNROLL for (int it = 0; it < 4; ++it) {
                        const int row = it * 8 + (lane >> 3), c8 = (lane & 7) * 8;
                        const float4 a0 = *(const float4*)(st + row * 68 + c8), a1 = *(const float4*)(st + row * 68 + c8 + 4);
                        const float4 b0 = *(const float4*)(st1 + row * 68 + c8), b1 = *(const float4*)(st1 + row * 68 + c8 + 4);
                        float* q = LOG + (size_t)(t * C::BM + wm * 64 + mi * 32 + row) * 64 + c8;
                        *(float4*)q = make_float4(a0.x + b0.x, a0.y + b0.y, a0.z + b0.z, a0.w + b0.w); *(float4*)(q + 4) = make_float4(a1.x + b1.x, a1.y + b1.y, a1.z + b1.z, a1.w + b1.w);
                    }
                }
                __syncthreads();
            }
        }
    }
    else if constexpr (PH == PH_ROUTE) { ph_route(p, L, ntl, smem); }
    else if constexpr (PH == PH_SHARED) {
        ph_moe_scatter(p, ntl, smem);
        bf16_t* SA = (bf16_t*)(ws + OFF_SA);
        gemm256_pair(HX, ntl, (const bf16_t*)(ws + OFF_SGUT), 512, DM, smem, tp, [&](int row, int col, const float (&g)[8], const float (&u)[8]) {
            float a[8];
            UNROLL for (int i = 0; i < 8; ++i) a[i] = g[i] * frcp(1.f + __expf(-g[i])) * u[i];
            st8(SA + (size_t)row * 256 + (col >> 8) * 128 + (col & 127), a);
        });
    }
    else if constexpr (PH == PH_MOE_EXP) { const int cb = sub * MOE_CHUNK; ph_moe_exp(p, cb, min(cb + MOE_CHUNK, ntl), smem, tp); }
    else if constexpr (PH == PH_MOE_COMB) {
        const int cb = sub * MOE_CHUNK, ce = min(cb + MOE_CHUNK, ntl);
        const float* MOD = (const float*)(ws + OFF_MOD); const unsigned char* YB8 = (const unsigned char*)(ws + OFF_YBUF); const unsigned char* YSC = (const unsigned char*)(ws + OFF_YSC);
        gemm256((const bf16_t*)(ws + OFF_SA) + (size_t)cb * 256, ce - cb, (const bf16_t*)(ws + OFF_SDT), DM, 256, smem, tp, [&](int rl, int c, const float (&v)[8]) {
            const int n = cb + rl;
            float s[8];
            UNROLL for (int i = 0; i < 8; ++i) s[i] = v[i];
            const u32x2 sc = *(const u32x2*)(YSC + ((size_t)rl * 64 + (c >> 4)) * 8);
            const unsigned long long sc64 = (unsigned long long)sc.x | ((unsigned long long)sc.y << 32);
            _Pragma("unroll 2") for (int k = 0; k < 8; ++k) {
                const u32x2 d = *(const u32x2*)(YB8 + ((size_t)rl * 8 + k) * DM + c);
                const unsigned be = (unsigned)(sc64 >> (8 * k)) & 255u;
                const float scl = __uint_as_float((be - 7u) << 23);
                typedef float f2v __attribute__((ext_vector_type(2)));
                const f2v y0 = __builtin_amdgcn_cvt_pk_f32_fp8((int)d.x, false), y1 = __builtin_amdgcn_cvt_pk_f32_fp8((int)d.x, true);
                const f2v y2 = __builtin_amdgcn_cvt_pk_f32_fp8((int)d.y, false), y3 = __builtin_amdgcn_cvt_pk_f32_fp8((int)d.y, true);
                s[0] += y0.x * scl; s[1] += y0.y * scl; s[2] += y1.x * scl; s[3] += y1.y * scl;
                s[4] += y2.x * scl; s[5] += y2.y * scl; s[6] += y3.x * scl; s[7] += y3.y * scl;
            }
            float* xo = xs_row(p, n) + c; const float* g2 = MOD + mod_row(n) * 6144 + 5 * DM + c;
            float4 xa = *(const float4*)xo, xb = *(const float4*)(xo + 4); const float4 ga = *(const float4*)g2, gb = *(const float4*)(g2 + 4);
            xa.x += ga.x * s[0]; xa.y += ga.y * s[1]; xa.z += ga.z * s[2]; xa.w += ga.w * s[3];
            xb.x += gb.x * s[4]; xb.y += gb.y * s[5]; xb.z += gb.z * s[6]; xb.w += gb.w * s[7];
            *(float4*)xo = xa; *(float4*)(xo + 4) = xb;
        });
    }
}

#ifndef N_LAUNCH_MODE
#define N_LAUNCH_MODE 1
#endif
#if N_LAUNCH_MODE == 0
template <int PH> __global__ void __launch_bounds__(NTHREADS, 2) k_phase(Params p, int L, int sub) {
    extern __shared__ __attribute__((aligned(16))) char smem[];
    run_phase<PH>(p, L, sub, smem, Topo{(int)(blockIdx.x & 7), (int)(blockIdx.x >> 3), (int)((gridDim.x + 7 - (blockIdx.x & 7)) >> 3)});
}
#endif


#ifndef MEGA_SKIP
#define MEGA_SKIP 0ull
#endif
#ifndef MEGA_REPEAT
#define MEGA_REPEAT 0ull
#endif
#define BARRIER() do { XcdBarrier b2_ = bar; unsigned so_ = LDS_BYTES; asm volatile("" : "+v"(so_)); b2_.st = (volatile LAS unsigned*)(smem + so_); xcd_barrier(b2_); } while (0)
#define PHASE(PH, sub) do { if constexpr (!((MEGA_SKIP >> PH) & 1ull)) { run_phase<PH>(p, L, sub, smem, tp); BARRIER(); if constexpr ((MEGA_REPEAT >> PH) & 1ull) { run_phase<PH>(p, L, sub, smem, tp); BARRIER(); } } } while (0)
__global__ void __launch_bounds__(NTHREADS, 2) k_mega(Params p) {
    extern __shared__ __attribute__((aligned(16))) char smem[];
    volatile LAS unsigned* st = (volatile LAS unsigned*)(smem + LDS_BYTES);
    if (threadIdx.x == 0) { st[0] = 0u; st[1] = 0u; st[2] = 0u; st[3] = 0u; }
    __syncthreads();
    const XcdBarrier bar = xcd_barrier_post((unsigned*)(p.ws + OFF_BAR), st);
    Topo tp{(int)(blockIdx.x & 7), (int)(blockIdx.x >> 3), (int)((gridDim.x + 7 - (blockIdx.x & 7)) >> 3)};
    for (int L = 0; L < 2; ++L) {
        const int ntl = L == 0 ? NT : NX;
        PHASE(PH_MODCONV, 0);
        if (st[1] == 8u && st[0] != 0u) { tp.x = (int)st[2]; tp.r = (int)st[3]; tp.n = (int)st[0]; }
        PHASE(PH_HX, 0);
        PHASE(PH_GEMM_R, 0);
        PHASE(PH_RW_PREP, 0);
        PHASE(PH_RW_SCAN, 0);
        PHASE(PH_RW_READ, 0);
        PHASE(PH_RW_G, 0);
        PHASE(PH_GEMM_N, 0);
        PHASE(PH_NA_ATT, 0);
        PHASE(PH_GEMM_M, 0);
        PHASE(PH_ML_SCAN, 0);
        PHASE(PH_ML_READ, 0);
        PHASE(PH_GEMM_G, 0);
        PHASE(PH_MERGE, 0);
        PHASE(PH_OUT, 0);
        PHASE(PH_NORM2, 0);
        PHASE(PH_ROUTER, 0);
        PHASE(PH_ROUTE, 0);
        PHASE(PH_SHARED, 0);
        for (int c = 0; c * MOE_CHUNK < ntl; ++c) {
            PHASE(PH_MOE_EXP, c);
            PHASE(PH_MOE_COMB, c);
        }
    }
}

#if N_LAUNCH_MODE == 0
template <int PH> static void launch_phase(const Params& p, int L, int sub, hipStream_t stream) {
    static bool attr = false;
    if (!attr) { (void)hipFuncSetAttribute((const void*)k_phase<PH>, hipFuncAttributeMaxDynamicSharedMemorySize, LDS_BYTES); attr = true; }
    hipLaunchKernelGGL(k_phase<PH>, dim3(256), dim3(NTHREADS), LDS_BYTES, stream, p, L, sub);
}
#endif

extern "C" void kernel_launch(void* const* d_in, const int* in_sizes, int n_in, void* d_out, int out_size, void* d_ws, size_t ws_size, hipStream_t stream) {
    if (n_in != N_IN || ws_size < WS_END) { fprintf(stderr, "kernel_launch: unexpected inputs (%d) or workspace (%zu < %zu)\n", n_in, ws_size, (size_t)WS_END); return; }
    Params p{};
    for (int i = 0; i < N_IN; ++i) p.in[i] = (const float*)d_in[i];
    p.out = (float*)d_out; p.ws = (char*)d_ws;
#if N_LAUNCH_MODE == 1
    static int grid = 0;
    if (grid == 0) {
        int dev = 0, cus = 0;
        if (hipGetDevice(&dev) != hipSuccess || hipDeviceGetAttribute(&cus, hipDeviceAttributeMultiprocessorCount, dev) != hipSuccess) { grid = -1; return; }
        if (hipFuncSetAttribute((const void*)k_mega, hipFuncAttributeMaxDynamicSharedMemorySize, LDS_BYTES + 256) != hipSuccess) { grid = -1; return; }
        grid = cus;
    }
    if (grid <= 0) return;
    (void)hipMemsetAsync((char*)d_ws + OFF_BAR, 0, XCD_BAR_WORDS * sizeof(unsigned), stream);
    hipLaunchKernelGGL(k_mega, dim3(grid), dim3(NTHREADS), LDS_BYTES + 256, stream, p);
    return;
#endif
#if N_LAUNCH_MODE == 0
    for (int L = 0; L < 2; ++L) {
        const int ntl = L == 0 ? NT : NX;
        launch_phase<PH_MODCONV>(p, L, 0, stream);
        launch_phase<PH_HX>(p, L, 0, stream);
        launch_phase<PH_GEMM_R>(p, L, 0, stream);
        launch_phase<PH_RW_PREP>(p, L, 0, stream);
        launch_phase<PH_RW_SCAN>(p, L, 0, stream);
        launch_phase<PH_RW_READ>(p, L, 0, stream);
        launch_phase<PH_RW_G>(p, L, 0, stream);
        launch_phase<PH_GEMM_N>(p, L, 0, stream);
        launch_phase<PH_NA_ATT>(p, L, 0, stream);
        launch_phase<PH_GEMM_M>(p, L, 0, stream);
        launch_phase<PH_ML_SCAN>(p, L, 0, stream);
        launch_phase<PH_ML_READ>(p, L, 0, stream);
        launch_phase<PH_GEMM_G>(p, L, 0, stream);
        launch_phase<PH_MERGE>(p, L, 0, stream);
        launch_phase<PH_OUT>(p, L, 0, stream);
        launch_phase<PH_NORM2>(p, L, 0, stream);
        launch_phase<PH_ROUTER>(p, L, 0, stream);
        launch_phase<PH_ROUTE>(p, L, 0, stream);
        launch_phase<PH_SHARED>(p, L, 0, stream);
        for (int c = 0; c * MOE_CHUNK < ntl; ++c) {
            launch_phase<PH_MOE_EXP>(p, L, c, stream);
            launch_phase<PH_MOE_COMB>(p, L, c, stream);
        }
    }
#endif
}
```

```cpp
#include <hip/hip_runtime.h>
#include <stdint.h>
#include <stdio.h>

#define DEV __device__ __forceinline__
#define UNROLL _Pragma("unroll")

typedef unsigned short bf16_t;
typedef short bf16x8 __attribute__((ext_vector_type(8)));
typedef float f32x16 __attribute__((ext_vector_type(16)));
typedef float f32x4v __attribute__((ext_vector_type(4)));
typedef unsigned u32x4 __attribute__((ext_vector_type(4)));
typedef unsigned u32x2 __attribute__((ext_vector_type(2)));

constexpr int DM = 1024, NBATCH = 16, SEQ = 2048, CTXL = 256;
constexpr int NX = NBATCH * SEQ, NC = NBATCH * CTXL, NT = NX + NC;
constexpr int RW_COLS = 1920, NA_COLS = 1536, ML_COLS = 1552, GATE_COLS = 3072, IN_COLS = 8080;
constexpr int NTHREADS = 512;
constexpr int MOE_CHUNK = 18432, MOE_ST = 768;
__host__ __device__ constexpr int moe_chunk(int L) { return L == 0 ? 18432 : 16384; }

enum { I_X = 0, I_C, I_CTX, I_CCTX, I_WADA, I_BADA, I_N1G, I_N2G, I_WIN, I_MU, I_W0, I_W2, I_A0, I_A2, I_KK, I_KA, I_RK, I_G2,
       I_LNG, I_LNB, I_V0, I_V1, I_V2, I_QNG, I_KNG, I_RPB, I_IB, I_FB, I_MNG, I_WBR, I_WOUT, I_RTR, I_MB, I_MWG, I_MWU, I_MWD,
       I_SG, I_SU, I_SD, N_IN };

constexpr size_t OFF_BAR = 0;
constexpr size_t OFF_MOD = 16384;
constexpr size_t MOD_SZ = 417792;
constexpr size_t OFF_WINT = OFF_MOD + 2 * MOD_SZ;
constexpr size_t OFF_WBT = OFF_WINT + (size_t)IN_COLS * 1024 * 2;
constexpr size_t OFF_WOUTT = OFF_WBT + (size_t)3 * 1024 * 512 * 2;
constexpr size_t OFF_SGUT = OFF_WOUTT + (size_t)1024 * 1024 * 2;
constexpr size_t OFF_SDT = OFF_SGUT + (size_t)512 * 1024 * 2;
constexpr size_t OFF_G2T = OFF_SDT + (size_t)1024 * 256 * 2;
constexpr size_t OFF_RTR = OFF_G2T + (size_t)512 * 128 * 2;
constexpr size_t OFF_CTXS = OFF_RTR + (size_t)2 * 64 * 1024 * 2;
constexpr size_t OFF_VF = OFF_CTXS + (size_t)NC * 1024 * 4;
constexpr size_t OFF_HX = OFF_VF + (size_t)NT * 512 * 2;
constexpr size_t OFF_BIG = OFF_HX + (size_t)NT * 1024 * 2;
constexpr size_t SZ_Y1 = (size_t)NT * 512 * 2;
constexpr size_t OFF_YA = OFF_BIG, OFF_YB = OFF_YA + SZ_Y1, OFF_YC = OFF_YB + SZ_Y1;
constexpr size_t OFF_PX = OFF_BIG + 3 * SZ_Y1;
constexpr size_t OFF_SCR = OFF_PX + (size_t)NT * RW_COLS * 2;
constexpr size_t SZ_SCR = (size_t)NT * 1152 * 2;
constexpr size_t OFF_MGU = OFF_SCR + SZ_SCR;
constexpr size_t WS_END = OFF_MGU + (size_t)64 * 256 * 1024 * 2;
constexpr size_t OFF_YS = OFF_YB;
constexpr size_t OFF_SGB = OFF_SCR;
constexpr size_t OFF_CB = OFF_SCR + (size_t)NT * 128 * 2;
constexpr size_t OFF_HS = OFF_SCR;
constexpr size_t OFF_VT = OFF_PX + (size_t)NT * 1024 * 2;
constexpr size_t OFF_VTC = OFF_VT + (size_t)NX * 512 * 2;
constexpr size_t OFF_GATES = OFF_PX;
constexpr size_t OFF_MDT = OFF_BIG;
constexpr size_t OFF_SA = OFF_MDT + (size_t)64 * 1024 * 128 * 2;
constexpr size_t OFF_EIDX = OFF_SA + (size_t)NT * 256 * 2;
constexpr size_t OFF_EW = OFF_EIDX + (size_t)NT * 8 * 4;
constexpr int SORT_CAP = MOE_CHUNK * 8 + 64 * 128;
constexpr size_t OFF_SORT = OFF_EW + (size_t)NT * 8 * 4;
constexpr size_t OFF_LOG = OFF_SORT + (size_t)3 * SORT_CAP * 4;
constexpr size_t OFF_H2LO = OFF_LOG + (size_t)NT * 64 * 4;
constexpr size_t OFF_YBUF = OFF_LOG;
constexpr size_t OFF_YSC = OFF_YBUF + (size_t)MOE_CHUNK * 8 * 1024;
constexpr size_t OFF_AO = OFF_YSC + (size_t)MOE_CHUNK * 512;
constexpr size_t OFF_SHX = OFF_YSC + (size_t)MOE_CHUNK * 512;
static_assert(OFF_SHX + (size_t)NT * 1024 * 2 <= OFF_MGU, "moe layout");
static_assert(OFF_GATES + (size_t)NT * 3072 * 2 <= WS_END, "gates layout");
static_assert(WS_END <= (size_t)536870912, "workspace");

constexpr size_t OFF_MCNT = OFF_BAR + 14336;
constexpr int LDS_BYTES = 155648;

struct Topo { int x, r, n; };
struct Params {
    const float* in[N_IN];
    float* out;
    char* ws;
};

DEV int TID() { int t = threadIdx.x; asm volatile("" : "+v"(t)); return t; }
DEV float bf2f(bf16_t h) { return __uint_as_float(((unsigned)h) << 16); }
typedef __bf16 bf16x2n __attribute__((ext_vector_type(2)));
typedef float f32x2n __attribute__((ext_vector_type(2)));
DEV unsigned pk2(float lo, float hi) { const f32x2n v = {lo, hi}; return __builtin_bit_cast(unsigned, __builtin_convertvector(v, bf16x2n)); }
DEV bf16_t f2bf(float f) { return (bf16_t)(pk2(f, 0.f) & 0xffffu); }
DEV void ld8(const bf16_t* p, float (&o)[8]) {
    const u32x4 v = *(const u32x4*)p;
    o[0] = __uint_as_float(v.x << 16); o[1] = __uint_as_float(v.x & 0xffff0000u);
    o[2] = __uint_as_float(v.y << 16); o[3] = __uint_as_float(v.y & 0xffff0000u);
    o[4] = __uint_as_float(v.z << 16); o[5] = __uint_as_float(v.z & 0xffff0000u);
    o[6] = __uint_as_float(v.w << 16); o[7] = __uint_as_float(v.w & 0xffff0000u);
}
DEV void st8(bf16_t* p, const float (&v)[8]) {
    u32x4 o; o.x = pk2(v[0], v[1]); o.y = pk2(v[2], v[3]); o.z = pk2(v[4], v[5]); o.w = pk2(v[6], v[7]);
    *(u32x4*)p = o;
}
#define DPP_MOV(v, ctrl) __builtin_bit_cast(float, __builtin_amdgcn_update_dpp(0, __builtin_bit_cast(int, (v)), (ctrl), 0xF, 0xF, true))
DEV float sum8(float v) { v += DPP_MOV(v, 0xB1); v += DPP_MOV(v, 0x4E); v += DPP_MOV(v, 0x141); return v; }
#define DPP_MOVI(v, ctrl) __builtin_amdgcn_update_dpp(0, (v), (ctrl), 0xF, 0xF, true)
DEV float max8(float v) { v = fmaxf(v, DPP_MOV(v, 0xB1)); v = fmaxf(v, DPP_MOV(v, 0x4E)); v = fmaxf(v, DPP_MOV(v, 0x141)); return v; }
DEV int min8i(int v) { v = min(v, DPP_MOVI(v, 0xB1)); v = min(v, DPP_MOVI(v, 0x4E)); v = min(v, DPP_MOVI(v, 0x141)); return v; }
DEV float frcp(float x) { return __builtin_amdgcn_rcpf(x); }
DEV float sigm(float x) { return frcp(1.f + __expf(-x)); }
DEV float sigm_acc(float x) { return 1.f / (1.f + expf(-x)); }
DEV float tanh_fast(float x) { return 1.f - 2.f * frcp(1.f + __expf(2.f * x)); }
DEV float softplus_fast(float x) { return fmaxf(x, 0.f) + __logf(1.f + __expf(-fabsf(x))); }
DEV int mod_row(int n) { return n < NX ? (n >> 11) : 16; }
DEV float* xs_row(const Params& p, int n) { return n < NX ? p.out + (size_t)n * DM : (float*)(p.ws + OFF_CTXS) + (size_t)(n - NX) * DM; }
DEV const float* xprev_row(const Params& p, int L, int n) {
    if (L == 0) return n < NX ? p.in[I_X] + (size_t)n * DM : p.in[I_CTX] + (size_t)(n - NX) * DM;
    return xs_row(p, n);
}
DEV void seq_of(int n, int& nb, int& tt, int& T) {
    if (n < NX) { nb = n & ~2047; tt = n & 2047; T = SEQ; } else { const int m = n - NX; nb = NX + (m & ~255); tt = m & 255; T = CTXL; }
}
DEV void shift8(const bf16_t* z, int ld, int nb, int tt, int T, int col0, const float* mu, float (&o)[8]) {
    float c[8], l[8], r[8];
    ld8(z + (size_t)(nb + tt) * ld + col0, c);
    if (tt > 0) ld8(z + (size_t)(nb + tt - 1) * ld + col0, l); else { UNROLL for (int i = 0; i < 8; ++i) l[i] = 0.f; }
    if (tt < T - 1) ld8(z + (size_t)(nb + tt + 1) * ld + col0, r); else { UNROLL for (int i = 0; i < 8; ++i) r[i] = 0.f; }
    UNROLL for (int i = 0; i < 8; ++i) o[i] = c[i] + mu[col0 + i] * (0.5f * (l[i] + r[i]) - c[i]);
}

constexpr int LROW = 144;
template <int WM, int WN> struct GC {
    static constexpr int BM = 64 * WM, BN = 64 * WN;
    static constexpr int AB = BM * 128, BB = BN * 128, STG = AB + BB;
    static constexpr int NA = BM / 64, NBC = BN / 64;
};
DEV void acc_zero(f32x16 (&acc)[2][2]) {
    UNROLL for (int a = 0; a < 2; ++a) UNROLL for (int b = 0; b < 2; ++b) UNROLL for (int r = 0; r < 16; ++r) acc[a][b][r] = 0.f;
}
#define GLDS16(gp, lp) __builtin_amdgcn_global_load_lds((const __attribute__((address_space(1))) void*)(gp), (__attribute__((address_space(3))) void*)(lp), 16, 0, 0)
DEV int p32(int s) { return 16 * ((s >> 2) & 1) + (s & 3) + 4 * (s >> 3); }
struct KLin { DEV size_t operator()(int kt) const { return (size_t)kt * 64; } };
struct NoHook { DEV void operator()(int) const {} };
template <int WM, int WN, int NS, bool A_LDS, bool TR = false, class ARow, class KA = KLin, class KB = KLin, class Hook = NoHook>
DEV void gemm_tile(f32x16 (&acc)[2][2], ARow arow, const bf16_t* Bt, int ldb, int n0, int Nvalid, int K, char* smem, const char* alds, KA koa = KA(), KB kob = KB(), Hook hook = Hook()) {
    typedef GC<WM, WN> C;
    constexpr int LPT = (A_LDS ? 0 : C::NA) + C::NBC;
    const int tid = TID(), lane = tid & 63, wave = tid >> 6, wm = wave / WN, wn = wave % WN;
    const int fr = lane & 31, fh = lane >> 5;
    const int crow = tid >> 3, cch = (tid & 7) ^ ((crow >> 1) & 7);
    const bf16_t* pa[C::NA]; const bf16_t* pb[C::NBC];
    if (!A_LDS) { UNROLL for (int i = 0; i < C::NA; ++i) pa[i] = arow(crow + 64 * i) + cch * 8; }
    UNROLL for (int i = 0; i < C::NBC; ++i) { const int rb = crow + 64 * i, n = min(n0 + (TR ? (rb & ~31) + p32(rb & 31) : rb), Nvalid - 1); pb[i] = Bt + (size_t)n * ldb + cch * 8; }
    const int nk = K >> 6;
#define GT_ISSUE(kt, stg) do { char* sb_ = smem + (stg) * C::STG + tid * 16; \
        if (!A_LDS) { UNROLL for (int i = 0; i < C::NA; ++i) GLDS16(pa[i] + koa(kt), sb_ + i * 8192); } \
        UNROLL for (int i = 0; i < C::NBC; ++i) GLDS16(pb[i] + kob(kt), sb_ + C::AB + i * 8192); } while (0)
    const int sw = (fr >> 1) & 7;
    int offk[4];
    UNROLL for (int ks = 0; ks < 4; ++ks) offk[ks] = ((2 * ks + fh) ^ sw) * 16;
    const int a_base = (wm * 64 + fr) * 128, b_base = (wn * 64 + fr) * 128;
    UNROLL for (int s = 0; s < NS - 1; ++s) if (s < nk) GT_ISSUE(s, s);
    int stg = 0, nstg = NS - 1;
    for (int kt = 0; kt < nk; ++kt) {
        if (NS == 3 && kt + 1 < nk) asm volatile("s_waitcnt vmcnt(%0)" :: "n"(LPT) : "memory");
        else asm volatile("s_waitcnt vmcnt(0)" ::: "memory");
        __builtin_amdgcn_s_barrier();
        asm volatile("" ::: "memory");
        const bool more = kt + NS - 1 < nk;
        const char* As_ = A_LDS ? alds + kt * C::AB : smem + stg * C::STG; const char* Bs_ = smem + stg * C::STG + C::AB;
        char* db_ = smem + nstg * C::STG + tid * 16;
        bf16x8 af[2][2], bfv[2][2];
        UNROLL for (int mi = 0; mi < 2; ++mi) af[0][mi] = *(const bf16x8*)(As_ + a_base + mi * 4096 + offk[0]);
        UNROLL for (int ni = 0; ni < 2; ++ni) bfv[0][ni] = *(const bf16x8*)(Bs_ + b_base + ni * 4096 + offk[0]);
        UNROLL for (int ks = 0; ks < 4; ++ks) {
            const int cur = ks & 1, nxt = cur ^ 1;
            if (ks < 3) {
                UNROLL for (int mi = 0; mi < 2; ++mi) af[nxt][mi] = *(const bf16x8*)(As_ + a_base + mi * 4096 + offk[ks + 1]);
                UNROLL for (int ni = 0; ni < 2; ++ni) bfv[nxt][ni] = *(const bf16x8*)(Bs_ + b_base + ni * 4096 + offk[ks + 1]);
            }
            UNROLL for (int mi = 0; mi < 2; ++mi) UNROLL for (int ni = 0; ni < 2; ++ni)
                acc[mi][ni] = TR ? __builtin_amdgcn_mfma_f32_32x32x16_bf16(bfv[cur][ni], af[cur][mi], acc[mi][ni], 0, 0, 0)
                                 : __builtin_amdgcn_mfma_f32_32x32x16_bf16(af[cur][mi], bfv[cur][ni], acc[mi][ni], 0, 0, 0);
            if (more) {
                UNROLL for (int pc = 0; pc < LPT; ++pc) if (pc * 4 / LPT == ks) {
                    if (!A_LDS && pc < C::NA) GLDS16(pa[pc] + koa(kt + NS - 1), db_ + pc * 8192);
                    else { const int ib = pc - (A_LDS ? 0 : C::NA); GLDS16(pb[ib] + kob(kt + NS - 1), db_ + C::AB + ib * 8192); }
                }
            }
            __builtin_amdgcn_sched_barrier(0);
        }
        hook(kt);
        stg = stg + 1 == NS ? 0 : stg + 1; nstg = nstg + 1 == NS ? 0 : nstg + 1;
    }
    __syncthreads();
#undef GT_ISSUE
}
#define ACC_ROW(mi, r, fh) ((mi) * 32 + ((r) & 3) + 8 * ((r) >> 2) + 4 * (fh))

constexpr int EPI_SLAB = 32 * 68 * 4;
template <class F> DEV void epi_rows(const f32x16 (&acc)[2][2], char* smem, F f) {
    const int lane = TID() & 63, wave = TID() >> 6, fr = lane & 31, fh = lane >> 5;
    float* st = (float*)(smem + wave * EPI_SLAB);
    UNROLL for (int mi = 0; mi < 2; ++mi) {
        UNROLL for (int ni = 0; ni < 2; ++ni) UNROLL for (int r = 0; r < 16; ++r)
            st[((r & 3) + 8 * (r >> 2) + 4 * fh) * 68 + ni * 32 + fr] = acc[mi][ni][r];
        UNROLL for (int it = 0; it < 4; ++it) {
            const int row = it * 8 + (lane >> 3), c8 = (lane & 7) * 8;
            const float4 a = *(const float4*)(st + row * 68 + c8), b = *(const float4*)(st + row * 68 + c8 + 4);
            float v[8] = {a.x, a.y, a.z, a.w, b.x, b.y, b.z, b.w};
            f(mi * 32 + row, c8, v);
        }
    }
    __syncthreads();
}


template <class F> DEV void epi_cols(const f32x16 (&acc)[2][2], char* smem, F f) {
    const int lane = TID() & 63, wave = TID() >> 6, fr = lane & 31, fh = lane >> 5;
    float* st = (float*)(smem + wave * EPI_SLAB);
    UNROLL for (int mi = 0; mi < 2; ++mi) {
        UNROLL for (int ni = 0; ni < 2; ++ni) UNROLL for (int r = 0; r < 16; ++r)
            st[((r & 3) + 8 * (r >> 2) + 4 * fh) * 68 + ni * 32 + fr] = acc[mi][ni][r];
        UNROLL for (int it = 0; it < 4; ++it) {
            float v[8];
            UNROLL for (int i = 0; i < 8; ++i) v[i] = st[(it * 8 + i) * 68 + lane];
            f(mi * 32 + it * 8, lane, v);
        }
    }
    __syncthreads();
}

struct TileOrder {
    int x, nN, cx, total;
    DEV TileOrder(const Topo& tp, int nM, int nN_) { x = tp.x; nN = nN_; cx = nM > x ? (nM - x + 7) >> 3 : 0; total = ((cx + 3) >> 2) * 4 * nN; }
    DEV bool get(int q, int& pm, int& pn) const { const int per = 4 * nN, qi = q / per, rem = q - qi * per, i = 4 * qi + (rem & 3); pn = rem >> 2; pm = x + 8 * i; return i < cx; }
};
template <int WM, int WN, class Epi>
DEV void gemm_phase(const bf16_t* A, int lda, int M, const bf16_t* Bt, int ldb, int N, int K, char* smem, const Topo& tp, Epi epi) {
    typedef GC<WM, WN> C;
    const int nM = M / C::BM, nN = (N + C::BN - 1) / C::BN;
    const int wave = TID() >> 6, wm = wave / WN, wn = wave % WN;
    const TileOrder ord(tp, nM, nN);
    for (int q = tp.r; q < ord.total; q += tp.n) {
        int pm, pn; if (!ord.get(q, pm, pn)) continue;
        f32x16 acc[2][2]; acc_zero(acc);
        const bf16_t* Ab = A + (size_t)pm * C::BM * lda;
        gemm_tile<WM, WN, 3, false>(acc, [&](int r) { return Ab + (size_t)r * lda; }, Bt, ldb, pn * C::BN, N, K, smem, nullptr);
        epi(acc, pm * C::BM + wm * 64, pn * C::BN + wn * 64);
    }
}

namespace pg8 {
#define PG8_LAS __attribute__((address_space(3)))
typedef float f32x4 __attribute__((ext_vector_type(4)));
constexpr int BM = 256, BK = 64, HALF = 128, HTB = HALF * BK * 2  , STAGE_BYTES = 8 * HTB, NXCD = 8, WGM = 8;

__host__ __device__ __forceinline__ int lds_byte(int r, int c) { const int st = (r >> 4) * 2 + (c >> 5), rr = r & 15, cc = c & 31, ob = rr * 64 + cc * 2; return st * 1024 + (ob ^ (((ob >> 9) & 1) << 5)); }
__host__ __device__ __forceinline__ void stage_rc(int b, int& R, int& C) { const int st = b / 1024, sb = b % 1024, swz = sb ^ (((sb >> 9) & 1) << 5); R = (st >> 1) * 16 + swz / 64; C = (st & 1) * 32 + (swz % 64) / 2; }
__host__ __device__ __forceinline__ int perm32(int rho) { const int n = rho >> 4, i = rho & 15; return 8 * (i >> 2) + 4 * n + (i & 3); }

struct Unit { int pm, pn; };
struct Gemm { const bf16_t* A; const bf16_t* Bt; int M, N, K; };
template <class Epi, class Sched, bool ALIGN_EPI = false, bool SP2 = false>
__device__ __forceinline__ void gemm_phase(PG8_LAS unsigned char* lds, const Gemm g, const Sched& S, const Epi& E) {
    const int tid = TID(), wid = __builtin_amdgcn_readfirstlane(tid >> 6), lane = tid & 63, wr = wid >> 2, wc = wid & 3, fr = lane & 15, fq = lane >> 4;
    const int K = g.K, nt = K / BK;
    unsigned voffA[2], voffB[2];
#pragma unroll
    for (int i = 0; i < 2; ++i) { int R, C; stage_rc(tid * 16 + i * 8192, R, C); const int Rb = Epi::PERM ? ((R & ~31) + perm32(R & 31)) : R;
        voffA[i] = (unsigned)(R * K + C) * 2u; voffB[i] = (unsigned)(Rb * K + C) * 2u; }
    const size_t kstep = (size_t)(BK * 2);
    const size_t hstep = (size_t)HALF * K * 2;
    const size_t tstep = 2 * hstep;
    const unsigned ldsw = (unsigned)wid * 1024u;
    const int aoff = lds_byte(wr * 64 + fr, fq * 8), boff = lds_byte(wc * 32 + fr, fq * 8);
#define PG8_SA(b, h) (((b) * 2 + (h)) * HTB)
#define PG8_SB(b, h) ((4 + (b) * 2 + (h)) * HTB)
#define PG8_STAGE(bufoff, gbase, voff) do { _Pragma("unroll") for (int _i = 0; _i < 2; ++_i) \
        __builtin_amdgcn_global_load_lds((const unsigned*)((const char*)(gbase) + (voff)[_i]), (PG8_LAS unsigned*)(lds + (bufoff) + ldsw + _i * 8192), 16, 0, 0); } while (0)
#define PG8_LDA(dst, b, h) do { _Pragma("unroll") for (int m = 0; m < 4; ++m) _Pragma("unroll") for (int k = 0; k < 2; ++k) dst[m][k] = *(const PG8_LAS bf16x8*)(lds + PG8_SA(b, h) + aoff + m * 2048 + k * 1024); } while (0)
#define PG8_LDB(dst, b, h) do { _Pragma("unroll") for (int n = 0; n < 2; ++n) _Pragma("unroll") for (int k = 0; k < 2; ++k) dst[n][k] = *(const PG8_LAS bf16x8*)(lds + PG8_SB(b, h) + boff + n * 2048 + k * 1024); } while (0)
#define PG8_MMA(ai, bj, At, Bt) do { __builtin_amdgcn_s_setprio(1); _Pragma("unroll") for (int m = 0; m < 4; ++m) _Pragma("unroll") for (int n = 0; n < 2; ++n) _Pragma("unroll") for (int k = 0; k < 2; ++k) \
        acc[ai][bj][m][n] = __builtin_amdgcn_mfma_f32_16x16x32_bf16(Bt[n][k], At[m][k], acc[ai][bj][m][n], 0, 0, 0); __builtin_amdgcn_s_setprio(0); } while (0)
#define PG8_WAIT_V(n) asm volatile("s_waitcnt vmcnt(" #n ")" ::: "memory")
#define PG8_WAIT_L(n) asm volatile("s_waitcnt lgkmcnt(" #n ")" ::: "memory")
#define PG8_BAR __builtin_amdgcn_s_barrier()
#define PG8_SCHED __builtin_amdgcn_sched_barrier(0)
    Unit cur, nxt; int ui = 0;
    if (!S.next(0, cur)) return;
    f32x4 acc[2][2][4][2];
#pragma unroll
    for (int a = 0; a < 2; ++a)
#pragma unroll
        for (int b = 0; b < 2; ++b)
#pragma unroll
            for (int m = 0; m < 4; ++m)
#pragma unroll
                for (int n = 0; n < 2; ++n) acc[a][b][m][n] = (f32x4){0.f, 0.f, 0.f, 0.f};
    bf16x8 At[4][2], B0[2][2], B1[2][2];
    const char* cA = (const char*)g.A + (size_t)cur.pm * tstep; const char* cB = (const char*)g.Bt + (size_t)cur.pn * tstep;
    S.a_ready(cur);
    if constexpr (SP2) {
        PG8_STAGE(PG8_SB(0, 0), cB, voffB); PG8_STAGE(PG8_SB(0, 1), cB + hstep, voffB); PG8_STAGE(PG8_SA(0, 0), cA, voffA); PG8_STAGE(PG8_SA(0, 1), cA + hstep, voffA);
        if (wr == 1) PG8_BAR;
        PG8_WAIT_V(2); PG8_BAR;
        PG8_STAGE(PG8_SB(1, 0), cB + kstep, voffB); PG8_STAGE(PG8_SA(1, 0), cA + kstep, voffA); PG8_STAGE(PG8_SB(1, 1), cB + hstep + kstep, voffB);
        PG8_WAIT_V(6); PG8_BAR;
    } else {
        PG8_STAGE(PG8_SB(0, 0), cB, voffB); PG8_STAGE(PG8_SA(0, 0), cA, voffA); PG8_STAGE(PG8_SB(0, 1), cB + hstep, voffB); PG8_STAGE(PG8_SA(0, 1), cA + hstep, voffA);
        if (wr == 1) PG8_BAR;
        PG8_WAIT_V(4); PG8_BAR;
        PG8_STAGE(PG8_SB(1, 0), cB + kstep, voffB); PG8_STAGE(PG8_SA(1, 0), cA + kstep, voffA); PG8_STAGE(PG8_SB(1, 1), cB + hstep + kstep, voffB);
        PG8_WAIT_V(6); PG8_BAR;
    }
    for (;;) {
        const bool has_next = S.next(ui + 1, nxt);
        const char* nA = has_next ? (const char*)g.A + (size_t)nxt.pm * tstep : cA; const char* nB = has_next ? (const char*)g.Bt + (size_t)nxt.pn * tstep : cB;
        for (int t = 0; t < nt; t += 2) {
            const bool last = (t == nt - 2);
            const char* a1 = cA + (size_t)(t + 1) * kstep;
            const char* a2 = last ? nA : cA + (size_t)(t + 2) * kstep; const char* b2 = last ? nB : cB + (size_t)(t + 2) * kstep;
            const char* a3 = a2 + kstep; const char* b3 = b2 + kstep;
            if (last && has_next) S.a_ready(nxt);
            if constexpr (SP2) {
            PG8_LDB(B0, 0, 0); PG8_LDB(B1, 0, 1); PG8_SCHED; PG8_LDA(At, 0, 0); PG8_STAGE(PG8_SA(1, 1), a1 + hstep, voffA);
            PG8_WAIT_V(8); PG8_WAIT_L(0); PG8_BAR; PG8_MMA(0, 0, At, B0); PG8_MMA(0, 1, At, B1); PG8_BAR; PG8_SCHED;
            PG8_LDA(At, 0, 1); PG8_STAGE(PG8_SB(0, 0), b2, voffB); PG8_STAGE(PG8_SB(0, 1), b2 + hstep, voffB); PG8_STAGE(PG8_SA(0, 0), a2, voffA);
            PG8_WAIT_V(8); PG8_WAIT_L(0); PG8_BAR; PG8_MMA(1, 0, At, B0); PG8_MMA(1, 1, At, B1); PG8_BAR; PG8_SCHED;
            PG8_LDB(B0, 1, 0); PG8_LDB(B1, 1, 1); PG8_SCHED; PG8_LDA(At, 1, 0); PG8_STAGE(PG8_SA(0, 1), a2 + hstep, voffA);
            PG8_WAIT_V(8); PG8_WAIT_L(0); PG8_BAR; PG8_MMA(0, 0, At, B0); PG8_MMA(0, 1, At, B1); PG8_BAR; PG8_SCHED;
            PG8_LDA(At, 1, 1); PG8_STAGE(PG8_SB(1, 0), b3, voffB); PG8_STAGE(PG8_SB(1, 1), b3 + hstep, voffB); PG8_STAGE(PG8_SA(1, 0), a3, voffA);
            PG8_WAIT_V(8); PG8_WAIT_L(0); PG8_BAR; PG8_MMA(1, 0, At, B0); PG8_MMA(1, 1, At, B1); PG8_BAR; PG8_SCHED;
            } else {
            PG8_LDB(B0, 0, 0); PG8_SCHED; PG8_LDA(At, 0, 0); PG8_STAGE(PG8_SA(1, 1), a1 + hstep, voffA);
            PG8_WAIT_L(8); PG8_BAR; PG8_WAIT_L(0); PG8_MMA(0, 0, At, B0); PG8_BAR; PG8_SCHED;
            PG8_LDB(B1, 0, 1); PG8_STAGE(PG8_SB(0, 0), b2, voffB);
            PG8_BAR; PG8_WAIT_L(0); PG8_MMA(0, 1, At, B1); PG8_BAR;
            PG8_LDA(At, 0, 1); PG8_STAGE(PG8_SA(0, 0), a2, voffA);
            PG8_BAR; PG8_WAIT_L(0); PG8_MMA(1, 0, At, B0); PG8_BAR; PG8_SCHED;
            PG8_STAGE(PG8_SB(0, 1), b2 + hstep, voffB);
            PG8_WAIT_V(6); PG8_BAR; PG8_MMA(1, 1, At, B1); PG8_BAR;
            PG8_LDB(B0, 1, 0); PG8_SCHED; PG8_LDA(At, 1, 0); PG8_STAGE(PG8_SA(0, 1), a2 + hstep, voffA);
            PG8_WAIT_L(8); PG8_BAR; PG8_WAIT_L(0); PG8_MMA(0, 0, At, B0); PG8_BAR; PG8_SCHED;
            PG8_LDB(B1, 1, 1); PG8_STAGE(PG8_SB(1, 0), b3, voffB);
            PG8_BAR; PG8_WAIT_L(0); PG8_MMA(0, 1, At, B1); PG8_BAR;
            PG8_LDA(At, 1, 1); PG8_STAGE(PG8_SA(1, 0), a3, voffA);
            PG8_BAR; PG8_WAIT_L(0); PG8_MMA(1, 0, At, B0); PG8_BAR; PG8_SCHED;
            PG8_STAGE(PG8_SB(1, 1), b3 + hstep, voffB);
            PG8_WAIT_V(6); PG8_BAR; PG8_MMA(1, 1, At, B1); PG8_BAR;
            }
        }
        if constexpr (ALIGN_EPI) { if (wr == 0) PG8_BAR; }
        if constexpr (!Epi::AFTER_DRAIN) { E(acc, cur, wr, wc, fr, fq); S.done(cur); }
        if (!has_next) break;
#pragma unroll
        for (int a = 0; a < 2; ++a)
#pragma unroll
            for (int b = 0; b < 2; ++b)
#pragma unroll
                for (int m = 0; m < 4; ++m)
#pragma unroll
                    for (int n = 0; n < 2; ++n) acc[a][b][m][n] = (f32x4){0.f, 0.f, 0.f, 0.f};
        cur = nxt; cA = nA; cB = nB; ++ui;
        if constexpr (ALIGN_EPI) { if (wr == 1) PG8_BAR; }
    }
    PG8_WAIT_V(0);
    if constexpr (!ALIGN_EPI) { if (wr == 0) PG8_BAR; }
    PG8_BAR;
    if constexpr (Epi::AFTER_DRAIN) { E.fused(acc, cur, wr, wc, fr, fq, lds, wid, lane); S.done(cur); }
#undef PG8_SA
#undef PG8_SB
#undef PG8_STAGE
#undef PG8_LDA
#undef PG8_LDB
#undef PG8_MMA
#undef PG8_WAIT_V
#undef PG8_WAIT_L
#undef PG8_BAR
#undef PG8_SCHED
}
}
template <class F> struct EpiF {
    static constexpr bool PERM = true, AFTER_DRAIN = false; F f;
    DEV void operator()(const pg8::f32x4 (&acc)[2][2][4][2], const pg8::Unit& u, int wr, int wc, int fr, int fq) const {
        UNROLL for (int ai = 0; ai < 2; ++ai) UNROLL for (int m = 0; m < 4; ++m) {
            const int row = u.pm * 256 + ai * 128 + wr * 64 + m * 16 + fr;
            UNROLL for (int bj = 0; bj < 2; ++bj) {
                const int col = u.pn * 256 + bj * 128 + wc * 32 + 8 * fq;
                const float v[8] = {acc[ai][bj][m][0][0], acc[ai][bj][m][0][1], acc[ai][bj][m][0][2], acc[ai][bj][m][0][3],
                                    acc[ai][bj][m][1][0], acc[ai][bj][m][1][1], acc[ai][bj][m][1][2], acc[ai][bj][m][1][3]};
                f(row, col, v);
            }
        }
    }
};
template <class F> struct EpiF2 {
    static constexpr bool PERM = true, AFTER_DRAIN = false; F f;
    DEV void operator()(const pg8::f32x4 (&acc)[2][2][4][2], const pg8::Unit& u, int wr, int wc, int fr, int fq) const {
        UNROLL for (int ai = 0; ai < 2; ++ai) UNROLL for (int m = 0; m < 4; ++m) {
            const int row = u.pm * 256 + ai * 128 + wr * 64 + m * 16 + fr, col = u.pn * 256 + wc * 32 + 8 * fq;
            const float v0[8] = {acc[ai][0][m][0][0], acc[ai][0][m][0][1], acc[ai][0][m][0][2], acc[ai][0][m][0][3], acc[ai][0][m][1][0], acc[ai][0][m][1][1], acc[ai][0][m][1][2], acc[ai][0][m][1][3]};
            const float v1[8] = {acc[ai][1][m][0][0], acc[ai][1][m][0][1], acc[ai][1][m][0][2], acc[ai][1][m][0][3], acc[ai][1][m][1][0], acc[ai][1][m][1][1], acc[ai][1][m][1][2], acc[ai][1][m][1][3]};
            f(row, col, v0, v1);
        }
    }
};
struct XOrder {
    int x, r, n, nN, cx, fullq, total;
    DEV XOrder(const Topo& tp, int nM, int nN_) { x = tp.x; r = tp.r; n = tp.n; nN = nN_; cx = nM > x ? (nM - x + 7) >> 3 : 0; fullq = cx >> 2; total = cx * nN; }
    DEV bool next(int i, pg8::Unit& u) const {
        const int q = r + i * n; if (q >= total) return false;
        const int per = 4 * nN;
        if (q < fullq * per) { const int qi = q / per, rem = q - qi * per; u.pn = rem >> 2; u.pm = x + 8 * (4 * qi + (rem & 3)); }
        else { const int rem = q - fullq * per, cq = cx - 4 * fullq; u.pn = rem / cq; u.pm = x + 8 * (4 * fullq + rem % cq); }
        return true;
    }
    DEV void a_ready(const pg8::Unit&) const {}
    DEV void done(const pg8::Unit&) const {}
};
template <class F> DEV void gemm256_pair(const bf16_t* A, int M, const bf16_t* Bt, int N, int K, char* smem, const Topo& tp, F f) {
    const pg8::Gemm g{A, Bt, M, N, K};
    const XOrder S(tp, M / 256, (N + 255) / 256);
    const EpiF2<F> E{f};
    pg8::gemm_phase<EpiF2<F>, XOrder, true, true>((PG8_LAS unsigned char*)smem, g, S, E);
}
template <class F> DEV void gemm256(const bf16_t* A, int M, const bf16_t* Bt, int N, int K, char* smem, const Topo& tp, F f) {
    const pg8::Gemm g{A, Bt, M, N, K};
    const XOrder S(tp, M / 256, (N + 255) / 256);
    const EpiF<F> E{f};
    pg8::gemm_phase<EpiF<F>, XOrder, true, true>((PG8_LAS unsigned char*)smem, g, S, E);
}

DEV void ph_mod(const Params& p, int L, char* smem) {
    const int tid = TID();
    float* sc = (float*)smem;
    float* red = sc + 17 * 1024;
    const float* c = p.in[I_C]; const float* cc = p.in[I_CCTX];
    for (int i = tid; i < 17 * 1024; i += NTHREADS) { const float v = i < 16 * 1024 ? c[i] : cc[i - 16 * 1024]; sc[i] = v / (1.f + expf(-v)); }
    __syncthreads();
    const float* W = p.in[I_WADA] + (size_t)L * 1024 * 6144; const float* bA = p.in[I_BADA] + (size_t)L * 6144;
    float* MOD = (float*)(p.ws + OFF_MOD + L * MOD_SZ);
    for (int u = blockIdx.x; u < 192; u += gridDim.x) {
        const int ci = tid & 31, ks = tid >> 5, j = u * 32 + ci;
        float acc[17];
        UNROLL for (int r = 0; r < 17; ++r) acc[r] = 0.f;
        _Pragma("unroll 1") for (int k0 = ks * 64; k0 < ks * 64 + 64; k0 += 16) {
            float w[16];
            UNROLL for (int i = 0; i < 16; ++i) w[i] = W[(size_t)(k0 + i) * 6144 + j];
            UNROLL for (int i = 0; i < 16; ++i) UNROLL for (int r = 0; r < 17; ++r) acc[r] += sc[r * 1024 + k0 + i] * w[i];
        }
        UNROLL for (int r = 0; r < 17; ++r) red[(ks * 17 + r) * 32 + ci] = acc[r];
        __syncthreads();
        for (int i = tid; i < 17 * 32; i += NTHREADS) {
            const int r = i >> 5, c2 = i & 31; float s = bA[u * 32 + c2];
            for (int k2 = 0; k2 < 16; ++k2) s += red[(k2 * 17 + r) * 32 + c2];
            MOD[r * 6144 + u * 32 + c2] = s;
        }
        __syncthreads();
    }
}
DEV void conv_job(const float* s0, const float* s1, bf16_t* d, int K, int N, int mode, int nmat, size_t sstride, size_t dstride, char* smem, int bid = -1, int nb = 0) {
    if (bid < 0) { bid = blockIdx.x; nb = gridDim.x; }
    float* tile = (float*)smem;
    const int tid = TID();
    const int tK = K / 64, tN = (mode == 1 || mode == 3) ? (2 * N) / 64 : (N + 63) / 64, per = tK * tN, total = per * nmat;
    for (int t0 = bid * 4; t0 < total; t0 += nb * 4) {
        float4 v[4][2];
        UNROLL for (int q = 0; q < 4; ++q) {
            const int t = min(t0 + q, total - 1), mat = t / per, r = t - mat * per, tk = r / tN, tn = r - tk * tN;
            const float* a0 = s0 + (size_t)mat * sstride; const float* a1 = s1 ? s1 + (size_t)mat * sstride : nullptr;
            const int c4 = (tid & 15) * 4;
            const float* src; int col;
            if (mode == 1) { src = (c4 >> 5) ? a1 : a0; col = tn * 32 + (c4 & 31); }
            else if (mode == 3) { src = ((tn >> 1) & 1) ? a1 : a0; col = (tn >> 2) * 128 + (tn & 1) * 64 + c4; }
            else { src = a0; col = tn * 64 + c4; }
            const bool ok = col < N;
            UNROLL for (int i = 0; i < 2; ++i) {
                const int k = (tid >> 4) + 32 * i;
                v[q][i] = ok ? *(const float4*)(src + (size_t)(tk * 64 + k) * N + col) : make_float4(0.f, 0.f, 0.f, 0.f);
            }
        }
        UNROLL for (int q = 0; q < 4; ++q) UNROLL for (int i = 0; i < 2; ++i) {
            float* w = tile + q * 4160 + ((tid >> 4) + 32 * i) * 65 + (tid & 15) * 4;
            w[0] = v[q][i].x; w[1] = v[q][i].y; w[2] = v[q][i].z; w[3] = v[q][i].w;
        }
        __syncthreads();
        UNROLL for (int q = 0; q < 4; ++q) if (t0 + q < total) {
            const int t = t0 + q, mat = t / per, r = t - mat * per, tk = r / tN, tn = r - tk * tN;
            bf16_t* dd = d + (size_t)mat * dstride;
            const int cc = tid >> 3, k8 = (tid & 7) * 8, row = tn * 64 + cc;
            float x[8];
            UNROLL for (int i = 0; i < 8; ++i) x[i] = tile[q * 4160 + (k8 + i) * 65 + cc];
            if (mode == 1 || mode == 3 || row < N) {
                st8(dd + (size_t)row * K + tk * 64 + k8, x);
                if (mode == 2) { float lo[8]; UNROLL for (int i = 0; i < 8; ++i) lo[i] = x[i] - bf2f(f2bf(x[i])); st8(dd + (size_t)N * K + (size_t)row * K + tk * 64 + k8, lo); }
            }
        }
        __syncthreads();
    }
}
DEV void ph_conv_mix(const Params& p, int L, char* smem) {
    char* ws = p.ws;
    conv_job(p.in[I_WIN] + (size_t)L * 1024 * IN_COLS, nullptr, (bf16_t*)(ws + OFF_WINT), 1024, IN_COLS, 0, 1, 0, 0, smem);
    conv_job(p.in[I_WBR] + (size_t)L * 3 * 512 * 1024, nullptr, (bf16_t*)(ws + OFF_WBT), 512, 1024, 0, 3, (size_t)512 * 1024, (size_t)512 * 1024, smem);
    conv_job(p.in[I_WOUT] + (size_t)L * 1024 * 1024, nullptr, (bf16_t*)(ws + OFF_WOUTT), 1024, 1024, 0, 1, 0, 0, smem);
    conv_job(p.in[I_SG] + (size_t)L * 1024 * 256, p.in[I_SU] + (size_t)L * 1024 * 256, (bf16_t*)(ws + OFF_SGUT), 1024, 256, 3, 1, 0, 0, smem);
    conv_job(p.in[I_SD] + (size_t)L * 256 * 1024, nullptr, (bf16_t*)(ws + OFF_SDT), 256, 1024, 0, 1, 0, 0, smem);
    conv_job(p.in[I_G2] + (size_t)L * 128 * 512, nullptr, (bf16_t*)(ws + OFF_G2T), 128, 512, 0, 1, 0, 0, smem);
    conv_job(p.in[I_RTR] + (size_t)L * 1024 * 64, nullptr, (bf16_t*)(ws + OFF_RTR), 1024, 64, 2, 1, 0, 0, smem);
}
DEV void ph_conv_moe_gu(const Params& p, int L, char* smem, int bid, int nb) {
    const size_t eo = (size_t)L * 64 * 1024 * 128;
    conv_job(p.in[I_MWG] + eo, p.in[I_MWU] + eo, (bf16_t*)(p.ws + OFF_MGU), 1024, 128, 1, 64, (size_t)1024 * 128, (size_t)256 * 1024, smem, bid, nb);
}
DEV void ph_conv_moe(const Params& p, int L, char* smem, int bid, int nb) {
    const size_t eo = (size_t)L * 64 * 1024 * 128;
    conv_job(p.in[I_MWD] + eo, nullptr, (bf16_t*)(p.ws + OFF_MDT), 128, 1024, 0, 64, (size_t)128 * 1024, (size_t)1024 * 128, smem, bid, nb);
}

DEV void ph_norm(const Params& p, int L, int which, int ntok) {
    const int lane = TID() & 63, wave = TID() >> 6;
    const float* MOD = (const float*)(p.ws + OFF_MOD + L * MOD_SZ);
    const float* g = p.in[which ? I_N2G : I_N1G] + (size_t)L * DM;
    bf16_t* H = (bf16_t*)(p.ws + OFF_HX); bf16_t* HLO = (bf16_t*)(p.ws + OFF_H2LO);
    for (int n0 = blockIdx.x * 8; n0 < ntok; n0 += gridDim.x * 8) {
        const int n = n0 + wave;
        const float* xr = xprev_row(p, L, n);
        float4 v[4]; float ss = 0.f;
        if (which) {
            const bf16_t* ao = (const bf16_t*)(p.ws + OFF_AO) + (size_t)n * DM; const float* g1 = MOD + mod_row(n) * 6144 + 2 * DM; float* xw = xs_row(p, n);
            u32x2 a[4]; float4 gg[4];
            UNROLL for (int i = 0; i < 4; ++i) { v[i] = *(const float4*)(xr + i * 256 + lane * 4); a[i] = *(const u32x2*)(ao + i * 256 + lane * 4); gg[i] = *(const float4*)(g1 + i * 256 + lane * 4); }
            UNROLL for (int i = 0; i < 4; ++i) {
                v[i].x += gg[i].x * __uint_as_float(a[i].x << 16); v[i].y += gg[i].y * __uint_as_float(a[i].x & 0xffff0000u);
                v[i].z += gg[i].z * __uint_as_float(a[i].y << 16); v[i].w += gg[i].w * __uint_as_float(a[i].y & 0xffff0000u);
                *(float4*)(xw + i * 256 + lane * 4) = v[i];
                ss += v[i].x * v[i].x + v[i].y * v[i].y + v[i].z * v[i].z + v[i].w * v[i].w;
            }
        } else {
            UNROLL for (int i = 0; i < 4; ++i) { v[i] = *(const float4*)(xr + i * 256 + lane * 4); ss += v[i].x * v[i].x + v[i].y * v[i].y + v[i].z * v[i].z + v[i].w * v[i].w; }
        }
        const float* sh = MOD + mod_row(n) * 6144 + (which ? 3 : 0) * DM; const float* sc = sh + DM;
        float4 ggv[4], s1v[4], s0v[4];
        UNROLL for (int i = 0; i < 4; ++i) { const int c = i * 256 + lane * 4; ggv[i] = *(const float4*)(g + c); s1v[i] = *(const float4*)(sc + c); s0v[i] = *(const float4*)(sh + c); }
        UNROLL for (int o = 1; o < 64; o <<= 1) ss += __shfl_xor(ss, o);
        const float rstd = rsqrtf(ss * (1.f / DM) + 1e-6f);
        UNROLL for (int i = 0; i < 4; ++i) {
            const int c = i * 256 + lane * 4;
            const float4 gg = ggv[i], s1 = s1v[i], s0 = s0v[i];
            const float h0 = v[i].x * rstd * gg.x * (1.f + s1.x) + s0.x, h1 = v[i].y * rstd * gg.y * (1.f + s1.y) + s0.y;
            const float h2 = v[i].z * rstd * gg.z * (1.f + s1.z) + s0.z, h3 = v[i].w * rstd * gg.w * (1.f + s1.w) + s0.w;
            u32x2 o; o.x = pk2(h0, h1); o.y = pk2(h2, h3);
            *(u32x2*)(H + (size_t)n * DM + c) = o;
            if (which) {
                u32x2 o2;
                o2.x = pk2(h0 - bf2f((bf16_t)(o.x & 0xffff)), h1 - bf2f((bf16_t)(o.x >> 16)));
                o2.y = pk2(h2 - bf2f((bf16_t)(o.y & 0xffff)), h3 - bf2f((bf16_t)(o.y >> 16)));
                *(u32x2*)(HLO + (size_t)n * DM + c) = o2;
            }
        }
    }
}

#define MFMA16(a, b, c) __builtin_amdgcn_mfma_f32_16x16x32_bf16((a), (b), (c), 0, 0, 0)
DEV void ph_rw_prep(const Params& p, int L, char* smem) {
    const int tid = TID(), lane = tid & 63, wave = tid >> 6;
    const bf16_t* PXR = (const bf16_t*)(p.ws + OFF_PX); bf16_t* VF = (bf16_t*)(p.ws + OFF_VF);
    const float* mu = p.in[I_MU] + (size_t)L * RW_COLS;
    if (L == 0) {
        for (int n0 = blockIdx.x * 8; n0 < NT; n0 += gridDim.x * 8) {
            const int n = n0 + wave; int nb, tt, T; seq_of(n, nb, tt, T);
            float vs[8]; shift8(PXR, RW_COLS, nb, tt, T, 1024 + lane * 8, mu, vs);
            st8(VF + (size_t)n * 512 + lane * 8, vs);
        }
        return;
    }
    constexpr int S1 = 1040, S2 = 80;
    char* V1T = smem;
    char* V2T = smem + 32 * S1;
    float* V0 = (float*)(V2T + 512 * S2);
    char* VS = (char*)(V0 + 512);
    char* T1 = VS + 64 * S1;
    const float* v0 = p.in[I_V0]; const float* v1 = p.in[I_V1]; const float* v2 = p.in[I_V2];
    for (int i = tid; i < 512 * 32; i += NTHREADS) {
        { const int k = i >> 5, q = i & 31; *(bf16_t*)(V1T + q * S1 + k * 2) = f2bf(v1[i]); }
        { const int q = i >> 9, c = i & 511; *(bf16_t*)(V2T + c * S2 + q * 2) = f2bf(v2[i]); }
    }
    if (tid < 512) V0[tid] = v0[tid];
    __syncthreads();
    const int lq = lane & 15, kg = lane >> 4;
    for (int tile = blockIdx.x; tile < NT / 64; tile += gridDim.x) {
        const int n0 = tile * 64;
        UNROLL for (int tl = 0; tl < 8; ++tl) {
            const int t = 8 * wave + tl; int nb, tt, T; seq_of(n0 + t, nb, tt, T);
            float vs[8]; shift8(PXR, RW_COLS, nb, tt, T, 1024 + lane * 8, mu, vs);
            st8((bf16_t*)(VS + t * S1) + lane * 8, vs);
        }
        __syncthreads();
        {
            const int rt = wave >> 1, ct = wave & 1;
            f32x4v acc = {0.f, 0.f, 0.f, 0.f};
            UNROLL for (int ks = 0; ks < 16; ++ks)
                acc = MFMA16(*(const bf16x8*)(VS + (16 * rt + lq) * S1 + ks * 64 + kg * 16), *(const bf16x8*)(V1T + (16 * ct + lq) * S1 + ks * 64 + kg * 16), acc);
            UNROLL for (int r = 0; r < 4; ++r) *(bf16_t*)(T1 + (16 * rt + 4 * kg + r) * S2 + (16 * ct + lq) * 2) = f2bf(acc[r]);
        }
        __syncthreads();
        {
            bf16x8 tf[4];
            UNROLL for (int rt = 0; rt < 4; ++rt) tf[rt] = *(const bf16x8*)(T1 + (16 * rt + lq) * S2 + kg * 16);
            UNROLL for (int cq = 0; cq < 4; ++cq) {
                const int ct = 4 * wave + cq, c0 = 16 * ct + 4 * kg;
                const bf16x8 wf = *(const bf16x8*)(V2T + (16 * ct + lq) * S2 + kg * 16);
                const float4 b0 = *(const float4*)(V0 + c0);
                u32x2 vfr[4];
                UNROLL for (int rt = 0; rt < 4; ++rt) vfr[rt] = *(const u32x2*)(VF + (size_t)(n0 + 16 * rt + lq) * 512 + c0);
                UNROLL for (int rt = 0; rt < 4; ++rt) {
                    f32x4v u = MFMA16(wf, tf[rt], ((f32x4v){0.f, 0.f, 0.f, 0.f}));
                    const u32x2 vsr = *(const u32x2*)(VS + (16 * rt + lq) * S1 + c0 * 2);
                    const float vs4[4] = {__uint_as_float(vsr.x << 16), __uint_as_float(vsr.x & 0xffff0000u), __uint_as_float(vsr.y << 16), __uint_as_float(vsr.y & 0xffff0000u)};
                    const float vf4[4] = {__uint_as_float(vfr[rt].x << 16), __uint_as_float(vfr[rt].x & 0xffff0000u), __uint_as_float(vfr[rt].y << 16), __uint_as_float(vfr[rt].y & 0xffff0000u)};
                    const float bb[4] = {b0.x, b0.y, b0.z, b0.w};
                    float o[4];
                    UNROLL for (int r = 0; r < 4; ++r) o[r] = vs4[r] + (vf4[r] - vs4[r]) * sigm(u[r] + bb[r]);
                    u32x2 w; w.x = pk2(o[0], o[1]); w.y = pk2(o[2], o[3]);
                    *(u32x2*)(VF + (size_t)(n0 + 16 * rt + lq) * 512 + c0) = w;
                }
            }
        }
        __syncthreads();
    }
}

DEV bf16x8 pk_lohi(u32x2 lo, u32x2 hi) { u32x4 w; w.x = lo.x; w.y = lo.y; w.z = hi.x; w.w = hi.y; return __builtin_bit_cast(bf16x8, w); }
DEV bf16x8 pk_acc2(const f32x4v& a, const f32x4v& b) { u32x4 w; w.x = pk2(a[0], a[1]); w.y = pk2(a[2], a[3]); w.z = pk2(b[0], b[1]); w.w = pk2(b[2], b[3]); return __builtin_bit_cast(bf16x8, w); }
DEV bf16x8 pk_acc1(const f32x4v& a) { u32x4 w; w.x = pk2(a[0], a[1]); w.y = pk2(a[2], a[3]); w.z = 0u; w.w = 0u; return __builtin_bit_cast(bf16x8, w); }
struct Raw3 { u32x4 l, c, r; };
DEV Raw3 rw_raw(const bf16_t* z, int ld, int nb, int tt, int T, int col0) {
    Raw3 o;
    o.c = *(const u32x4*)(z + (size_t)(nb + tt) * ld + col0);
    o.l = *(const u32x4*)(z + (size_t)(nb + max(tt - 1, 0)) * ld + col0);
    o.r = *(const u32x4*)(z + (size_t)(nb + min(tt + 1, T - 1)) * ld + col0);
    return o;
}
DEV void unpack8(u32x4 v, float (&o)[8]) {
    o[0] = __uint_as_float(v.x << 16); o[1] = __uint_as_float(v.x & 0xffff0000u); o[2] = __uint_as_float(v.y << 16); o[3] = __uint_as_float(v.y & 0xffff0000u);
    o[4] = __uint_as_float(v.z << 16); o[5] = __uint_as_float(v.z & 0xffff0000u); o[6] = __uint_as_float(v.w << 16); o[7] = __uint_as_float(v.w & 0xffff0000u);
}
DEV void shift_from_raw(const Raw3& w, int tt, int T, const float* mu8, float (&o)[8]) {
    float c[8], l[8], r[8]; unpack8(w.c, c); unpack8(w.l, l); unpack8(w.r, r);
    const float ml = tt > 0 ? 0.5f : 0.f, mr = tt < T - 1 ? 0.5f : 0.f;
    UNROLL for (int i = 0; i < 8; ++i) o[i] = c[i] + mu8[i] * (ml * l[i] + mr * r[i] - c[i]);
}
DEV void ph_rw_scan(const Params& p, int L, char* smem) {
    const int tid = TID();
    const int wave = __builtin_amdgcn_readfirstlane(tid >> 6);
    char* AT = smem; char* BT = smem + 9216; char* KT = smem + 18432; char* RT = smem + 27648;
    char* BH = smem + 36864; char* KH = smem + 46080; char* VT = smem + 55296;
    char* W2T = smem + 64512; char* A2T = smem + 73728;
    float* PCv = (float*)(smem + 82944); float* SEGT = PCv + 64;
    char* XY = smem + 85248;
    char* T1 = XY; char* T2 = XY + 9216; float* WLf = (float*)(XY + 18432); float* ALf = (float*)(XY + 35840); float* LW = (float*)XY;
    float* TOT = (float*)(XY + 62720);
    float* PAR = (float*)(XY + 60416);
    char* NAB = XY; char* NAK = XY + 9216; char* NRB = XY + 18432; char* NRK = XY + 27648; char* TJ = XY + 36864; float* NDF = (float*)(XY + 38912); float* YO = (float*)(XY + 43008);
    const bf16_t* PXR = (const bf16_t*)(p.ws + OFF_PX); const bf16_t* VF = (const bf16_t*)(p.ws + OFF_VF);
    bf16_t* YS = (bf16_t*)(p.ws + OFF_YS); float* CB = (float*)(p.ws + OFF_CB);
    const float* mu = p.in[I_MU] + (size_t)L * RW_COLS;
    const float* w0 = p.in[I_W0] + (size_t)L * 1024; const float* w2 = p.in[I_W2] + (size_t)L * 65536;
    const float* a0 = p.in[I_A0] + (size_t)L * 1024; const float* a2 = p.in[I_A2] + (size_t)L * 65536;
    const float* kkw = p.in[I_KK] + (size_t)L * 512; const float* kaw = p.in[I_KA] + (size_t)L * 512; const float* rkw = p.in[I_RK] + (size_t)L * 512;
    for (int u = blockIdx.x; u < 256; u += gridDim.x) {
        const int b = u >> 4, h = (u >> 1) & 7, d = u & 1;
        for (int i = tid; i < 4096; i += NTHREADS) {
            const int l = i >> 6, n = i & 63;
            *(bf16_t*)(W2T + n * LROW + l * 2) = f2bf(w2[(size_t)(d * 64 + l) * 512 + h * 64 + n]);
            *(bf16_t*)(A2T + n * LROW + l * 2) = f2bf(a2[(size_t)(d * 64 + l) * 512 + h * 64 + n]);
        }
        if (tid < 64) {
            const int n = tid;
            PAR[n] = w0[d * 512 + h * 64 + n]; PAR[64 + n] = a0[d * 512 + h * 64 + n];
            PAR[128 + n] = kkw[h * 64 + n]; PAR[192 + n] = kaw[h * 64 + n]; PAR[256 + n] = rkw[h * 64 + n];
            PAR[320 + n] = mu[1536 + d * 64 + n]; PAR[384 + n] = mu[1664 + d * 64 + n]; PAR[448 + n] = mu[h * 64 + n]; PAR[512 + n] = mu[512 + h * 64 + n];
        }
        f32x4v sacc[4];
        UNROLL for (int i = 0; i < 4; ++i) sacc[i] = (f32x4v){0.f, 0.f, 0.f, 0.f};
        __syncthreads();
        Raw3 pw1, pw2, pr, pk; u32x4 pv;
#define RW_GEOM(ci_, tido_) const bool isc = (ci_) < 4; const int T = isc ? CTXL : SEQ, cc = isc ? (ci_) : (ci_) - 4; \
            const int t0 = d == 0 ? cc * 64 : T - 64 * (cc + 1), nb = isc ? NX + b * CTXL : b * SEQ; \
            const int tt = d == 0 ? t0 + ((tido_) >> 3) : t0 + 63 - ((tido_) >> 3);
#define RW_PREFETCH(ci_, tido_) do { RW_GEOM(ci_, tido_) const int j_ = (tido_) & 7; \
            pw1 = rw_raw(PXR, RW_COLS, nb, tt, T, 1536 + d * 64 + 8 * j_); pw2 = rw_raw(PXR, RW_COLS, nb, tt, T, 1664 + d * 64 + 8 * j_); \
            pr = rw_raw(PXR, RW_COLS, nb, tt, T, h * 64 + 8 * j_); pk = rw_raw(PXR, RW_COLS, nb, tt, T, 512 + h * 64 + 8 * j_); \
            pv = *(const u32x4*)(VF + (size_t)(nb + tt) * 512 + h * 64 + 8 * j_); } while (0)
        RW_PREFETCH(0, tid);
#define RW_STORE_Y(ci_, tido_) do { RW_GEOM(ci_, tido_) const int ti_ = (tido_) >> 3, j_ = (tido_) & 7; \
            const float4 ya = *(const float4*)(YO + ti_ * 68 + 8 * j_), yb = *(const float4*)(YO + ti_ * 68 + 8 * j_ + 4); \
            const float y8[8] = {ya.x, ya.y, ya.z, ya.w, yb.x, yb.y, yb.z, yb.w}; \
            st8(YS + ((size_t)d * NT + nb + tt) * 512 + h * 64 + 8 * j_, y8); } while (0)
        for (int ci = 0; ci < 36; ++ci) {
            int tido = tid; asm volatile("" : "+v"(tido));
            const int lane = tido & 63, lq = lane & 15, kg = lane >> 4, ti = tido >> 3, j = tido & 7;
            const int ch = h * 64 + 8 * j;
            if (ci > 0) RW_STORE_Y(ci - 1, tido);
            RW_GEOM(ci, tido)
            float r8[8], k8[8], v8[8];
            {
                float x1[8], x2[8];
                shift_from_raw(pw1, tt, T, PAR + 320 + 8 * j, x1);
                shift_from_raw(pw2, tt, T, PAR + 384 + 8 * j, x2);
                UNROLL for (int i = 0; i < 8; ++i) x1[i] = tanh_fast(x1[i]);
                st8((bf16_t*)(T1 + ti * LROW) + 8 * j, x1); st8((bf16_t*)(T2 + ti * LROW) + 8 * j, x2);
                shift_from_raw(pr, tt, T, PAR + 448 + 8 * j, r8);
                shift_from_raw(pk, tt, T, PAR + 512 + 8 * j, k8);
                unpack8(pv, v8);
            }
            __syncthreads();
            _Pragma("unroll 1") for (int rep = 0; rep < 4; ++rep) {
                const int q = wave + 8 * rep, m = q >> 4, tl = q & 15, tt4 = tl >> 2, nt4 = tl & 3;
                const char* Ab = (m ? T2 : T1) + (16 * tt4 + lq) * LROW + kg * 16; const char* Bb = (m ? A2T : W2T) + (16 * nt4 + lq) * LROW + kg * 16;
                f32x4v a = {0.f, 0.f, 0.f, 0.f};
                UNROLL for (int ks = 0; ks < 2; ++ks) a = MFMA16(*(const bf16x8*)(Ab + ks * 64), *(const bf16x8*)(Bb + ks * 64), a);
                float* dst = (m ? ALf : WLf) + (16 * tt4 + 4 * kg) * 68 + 16 * nt4 + lq;
                UNROLL for (int i = 0; i < 4; ++i) dst[i * 68] = a[i];
            }
            __syncthreads();
            float av[8], bv[8], kd8[8];
            {
                const float4 wa = *(const float4*)(WLf + ti * 68 + 8 * j), wb = *(const float4*)(WLf + ti * 68 + 8 * j + 4);
                const float4 aa = *(const float4*)(ALf + ti * 68 + 8 * j), ab = *(const float4*)(ALf + ti * 68 + 8 * j + 4);
                const float wl[8] = {wa.x, wa.y, wa.z, wa.w, wb.x, wb.y, wb.z, wb.w}, al[8] = {aa.x, aa.y, aa.z, aa.w, ab.x, ab.y, ab.z, ab.w};
                float ss = 0.f, cbp = 0.f, alpha[8], kkr[8], lw[8];
                UNROLL for (int i = 0; i < 8; ++i) {
                    const float xw = -(PAR[8 * j + i] + wl[i]);
                    const float sp = softplus_fast(xw);
                    lw[i] = -__expf(-sp - 0.5f);
                    alpha[i] = sigm(PAR[64 + 8 * j + i] + al[i]);
                    kkr[i] = k8[i] * PAR[128 + 8 * j + i]; ss += kkr[i] * kkr[i];
                    kd8[i] = k8[i] * (1.f + (alpha[i] - 1.f) * PAR[192 + 8 * j + i]);
                    cbp += r8[i] * kd8[i] * PAR[256 + 8 * j + i];
                }
                ss = sum8(ss); cbp = sum8(cbp);
                const float inv = frcp(fmaxf(__builtin_amdgcn_sqrtf(ss), 1e-12f));
                UNROLL for (int i = 0; i < 8; ++i) { const float kk = kkr[i] * inv; av[i] = -kk; bv[i] = kk * alpha[i]; }
                *(float4*)(LW + ti * 64 + 8 * j) = make_float4(lw[0], lw[1], lw[2], lw[3]); *(float4*)(LW + ti * 64 + 8 * j + 4) = make_float4(lw[4], lw[5], lw[6], lw[7]);
                if (j == 0) CB[((size_t)d * NT + nb + tt) * 8 + h] = cbp;
            }
            __syncthreads();
            {
                const int n = tid & 63, seg = wave; float run[8], acc = 0.f;
                UNROLL for (int r = 0; r < 8; ++r) { acc += LW[(seg * 8 + r) * 64 + n]; run[r] = acc; }
                SEGT[seg * 64 + n] = acc;
                __syncthreads();
                float off = 0.f, tot = 0.f;
                UNROLL for (int s2 = 0; s2 < 8; ++s2) { const float sv = SEGT[s2 * 64 + n]; tot += sv; off += s2 < seg ? sv : 0.f; }
                UNROLL for (int r = 0; r < 8; ++r) LW[(seg * 8 + r) * 64 + n] = run[r] + off;
                if (seg == 0) { TOT[n] = tot; PCv[n] = __expf(tot); }
            }
            __syncthreads();
            {
                const float4 ta = *(const float4*)(TOT + 8 * j), tb = *(const float4*)(TOT + 8 * j + 4);
                const float tot[8] = {ta.x, ta.y, ta.z, ta.w, tb.x, tb.y, tb.z, tb.w};
                const float4 la = *(const float4*)(LW + ti * 64 + 8 * j), lb = *(const float4*)(LW + ti * 64 + 8 * j + 4);
                const float lpl[8] = {la.x, la.y, la.z, la.w, lb.x, lb.y, lb.z, lb.w};
                float lpm[8];
                if (ti != 0) {
                    const float4 ma = *(const float4*)(LW + (ti - 1) * 64 + 8 * j), mb = *(const float4*)(LW + (ti - 1) * 64 + 8 * j + 4);
                    lpm[0] = ma.x; lpm[1] = ma.y; lpm[2] = ma.z; lpm[3] = ma.w; lpm[4] = mb.x; lpm[5] = mb.y; lpm[6] = mb.z; lpm[7] = mb.w;
                } else { UNROLL for (int i = 0; i < 8; ++i) lpm[i] = 0.f; }
                float oa[8], ob[8], ok[8], orr[8];
                const int wofs = (((ti >> 3) ^ j) << 4) + (ti & 7) * 2;
                UNROLL for (int i = 0; i < 8; ++i) {
                    const float lp = lpl[i], lm = lpm[i];
                    const float eP = __expf(lp), eM = __expf(-lp), ePm = __expf(lm), eE = __expf(tot[i] - lp);
                    oa[i] = av[i] * ePm; ob[i] = bv[i] * eM; ok[i] = kd8[i] * eM; orr[i] = r8[i] * eP;
                    *(bf16_t*)(BH + (8 * j + i) * LROW + wofs) = f2bf(bv[i] * eE);
                    *(bf16_t*)(KH + (8 * j + i) * LROW + wofs) = f2bf(kd8[i] * eE);
                    *(bf16_t*)(VT + (8 * j + i) * LROW + wofs) = f2bf(v8[i]);
                }
                st8((bf16_t*)(AT + ti * LROW) + 8 * j, oa); st8((bf16_t*)(BT + ti * LROW) + 8 * j, ob);
                st8((bf16_t*)(KT + ti * LROW) + 8 * j, ok); st8((bf16_t*)(RT + ti * LROW) + 8 * j, orr);
            }
            __syncthreads();
            if (ci + 1 < 36) RW_PREFETCH(ci + 1, tido);
            _Pragma("unroll 1") for (int rep = 0; rep < 6; ++rep) {
                const int q = wave + 8 * rep, m = q / 12, tl = q - 12 * m;
                const int tt4 = tl >= 10 ? 2 * (tl - 10) : tl < 1 ? 0 : tl < 3 ? 1 : tl < 6 ? 2 : 3, st4 = tl >= 10 ? tt4 + 1 : tl - (tt4 * (tt4 + 1)) / 2;
                char* dstm = m == 0 ? NAB : m == 1 ? NAK : m == 2 ? NRB : NRK;
                f32x4v a = {0.f, 0.f, 0.f, 0.f};
                if (st4 <= tt4) {
                    const char* Ab = (m < 2 ? AT : RT) + (16 * tt4 + lq) * LROW + kg * 16; const char* Bb = ((m & 1) ? KT : BT) + (16 * st4 + lq) * LROW + kg * 16;
                    UNROLL for (int ks = 0; ks < 2; ++ks) a = MFMA16(*(const bf16x8*)(Ab + ks * 64), *(const bf16x8*)(Bb + ks * 64), a);
                }
                const int sidx = 16 * st4 + lq;
                UNROLL for (int i = 0; i < 4; ++i) {
                    const int tidx = 16 * tt4 + 4 * kg + i;
                    const bool keep = m < 2 ? sidx < tidx : sidx <= tidx;
                    const float val = keep ? a[i] : 0.f;
                    *(bf16_t*)(dstm + tidx * LROW + sidx * 2) = f2bf(val);
                    if (m == 0 && st4 == tt4) NDF[(tt4 * 16 + 4 * kg + i) * 16 + lq] = val;
                }
            }
            __syncthreads();
            f32x4v xacc[4], yacc[4];
            bf16x8 vt[2];
            if (wave == 7) {
                const int blk = lane >> 4, c = lane & 15;
                float Tc[16];
                UNROLL for (int t = 0; t < 16; ++t) {
                    float a = t == c ? 1.f : 0.f;
                    UNROLL for (int s2 = 0; s2 < t; ++s2) a += NDF[(blk * 16 + t) * 16 + s2] * Tc[s2];
                    Tc[t] = a;
                }
                UNROLL for (int t = 0; t < 16; ++t) *(bf16_t*)(TJ + (blk * 16 + t) * 32 + c * 2) = f2bf(Tc[t]);
            } else if (wave < 4) {
                bf16x8 sb[2];
                UNROLL for (int kk = 0; kk < 2; ++kk) { sb[kk] = pk_acc2(sacc[2 * kk], sacc[2 * kk + 1]); vt[kk] = *(const bf16x8*)(VT + (16 * wave + lq) * LROW + (((4 * kk + kg) ^ (2 * wave + (lq >> 3))) << 4)); }
                UNROLL for (int t4 = 0; t4 < 4; ++t4) {
                    f32x4v x = {0.f, 0.f, 0.f, 0.f}, y = {0.f, 0.f, 0.f, 0.f};
                    UNROLL for (int kk = 0; kk < 2; ++kk) {
                        const char* pa = AT + (16 * t4 + lq) * LROW + (32 * kk + 4 * kg) * 2; const char* pr = RT + (16 * t4 + lq) * LROW + (32 * kk + 4 * kg) * 2;
                        x = MFMA16(pk_lohi(*(const u32x2*)pa, *(const u32x2*)(pa + 32)), sb[kk], x);
                        y = MFMA16(pk_lohi(*(const u32x2*)pr, *(const u32x2*)(pr + 32)), sb[kk], y);
                        if (2 * kk <= t4) {
                            x = MFMA16(*(const bf16x8*)(NAK + (16 * t4 + lq) * LROW + kk * 64 + kg * 16), vt[kk], x);
                            y = MFMA16(*(const bf16x8*)(NRK + (16 * t4 + lq) * LROW + kk * 64 + kg * 16), vt[kk], y);
                        }
                    }
                    xacc[t4] = x; yacc[t4] = y;
                }
            }
            __syncthreads();
            if (wave < 4) {
                const u32x2 z2 = {0u, 0u};
                f32x4v uacc[4];
                {
                    const u32x2 t0v = *(const u32x2*)(TJ + (0 * 16 + lq) * 32 + 4 * kg * 2);
                    uacc[0] = MFMA16(pk_lohi(t0v, z2), pk_acc1(xacc[0]), ((f32x4v){0.f, 0.f, 0.f, 0.f}));
                }
                UNROLL for (int jb = 1; jb < 4; ++jb) {
                    f32x4v z = xacc[jb];
                    const char* nr = NAB + (16 * jb + lq) * LROW + 4 * kg * 2;
                    if (jb == 1) z = MFMA16(pk_lohi(*(const u32x2*)nr, z2), pk_acc1(uacc[0]), z);
                    else {
                        z = MFMA16(pk_lohi(*(const u32x2*)nr, *(const u32x2*)(nr + 32)), pk_acc2(uacc[0], uacc[1]), z);
                        if (jb == 3) z = MFMA16(pk_lohi(*(const u32x2*)(nr + 64), z2), pk_acc1(uacc[2]), z);
                    }
                    const u32x2 tv = *(const u32x2*)(TJ + (jb * 16 + lq) * 32 + 4 * kg * 2);
                    uacc[jb] = MFMA16(pk_lohi(tv, z2), pk_acc1(z), ((f32x4v){0.f, 0.f, 0.f, 0.f}));
                }
                bf16x8 ub[2]; ub[0] = pk_acc2(uacc[0], uacc[1]); ub[1] = pk_acc2(uacc[2], uacc[3]);
                UNROLL for (int t4 = 0; t4 < 4; ++t4) {
                    f32x4v y = yacc[t4];
                    UNROLL for (int kk = 0; kk < 2; ++kk) if (2 * kk <= t4) {
                        const char* pn = NRB + (16 * t4 + lq) * LROW + (32 * kk + 4 * kg) * 2;
                        y = MFMA16(pk_lohi(*(const u32x2*)pn, *(const u32x2*)(pn + 32)), ub[kk], y);
                    }
                    UNROLL for (int i = 0; i < 4; ++i) YO[(16 * t4 + 4 * kg + i) * 68 + 16 * wave + lq] = y[i];
                }
                UNROLL for (int kt = 0; kt < 4; ++kt) {
                    f32x4v sv = sacc[kt];
                    UNROLL for (int i = 0; i < 4; ++i) sv[i] *= PCv[16 * kt + 4 * kg + i];
                    UNROLL for (int kk = 0; kk < 2; ++kk) {
                        const int xr = 2 * kt + (lq >> 3);
                        const char* pb = BH + (16 * kt + lq) * LROW + (kg & 1) * 8;
                        sv = MFMA16(pk_lohi(*(const u32x2*)(pb + (((4 * kk + (kg >> 1)) ^ xr) << 4)), *(const u32x2*)(pb + (((4 * kk + 2 + (kg >> 1)) ^ xr) << 4))), ub[kk], sv);
                        sv = MFMA16(*(const bf16x8*)(KH + (16 * kt + lq) * LROW + (((4 * kk + kg) ^ xr) << 4)), vt[kk], sv);
                    }
                    sacc[kt] = sv;
                }
            }
            __syncthreads();
        }
        RW_STORE_Y(35, tid);
        __syncthreads();
    }
#undef RW_STORE_Y
}

DEV void ph_rw_read(const Params& p, int L, int ntok) {
    const int lane = TID() & 63, wave = TID() >> 6;
    const bf16_t* PXR = (const bf16_t*)(p.ws + OFF_PX); const bf16_t* VF = (const bf16_t*)(p.ws + OFF_VF);
    const bf16_t* YS = (const bf16_t*)(p.ws + OFF_YS); const float* CB = (const float*)(p.ws + OFF_CB);
    bf16_t* YA = (bf16_t*)(p.ws + OFF_YA); bf16_t* SG = (bf16_t*)(p.ws + OFF_SGB);
    const float* mu = p.in[I_MU] + (size_t)L * RW_COLS;
    const float* lg = p.in[I_LNG] + (size_t)L * 512; const float* lb = p.in[I_LNB] + (size_t)L * 512;
    for (int n0 = blockIdx.x * 8; n0 < ntok; n0 += gridDim.x * 8) {
        const int n = n0 + wave, c = lane * 8, h = lane >> 3;
        float y0[8], y1[8], v8[8], o[8];
        ld8(YS + (size_t)n * 512 + c, y0); ld8(YS + ((size_t)NT + n) * 512 + c, y1); ld8(VF + (size_t)n * 512 + c, v8);
        float s = 0.f;
        UNROLL for (int i = 0; i < 8; ++i) { y0[i] += y1[i]; s += y0[i]; }
        s += __shfl_xor(s, 1); s += __shfl_xor(s, 2); s += __shfl_xor(s, 4);
        const float mean = s * (1.f / 64.f); float q = 0.f;
        UNROLL for (int i = 0; i < 8; ++i) { const float dd = y0[i] - mean; q += dd * dd; }
        q += __shfl_xor(q, 1); q += __shfl_xor(q, 2); q += __shfl_xor(q, 4);
        const float rstd = rsqrtf(q * (1.f / 64.f) + 64e-5f);
        const float bon = CB[(size_t)n * 8 + h] + CB[((size_t)NT + n) * 8 + h];
        UNROLL for (int i = 0; i < 8; ++i) o[i] = (y0[i] - mean) * rstd * lg[c + i] + lb[c + i] + bon * v8[i];
        st8(YA + (size_t)n * 512 + c, o);
        if (lane < 16) {
            int nb, tt, T; seq_of(n, nb, tt, T);
            float g8[8]; shift8(PXR, RW_COLS, nb, tt, T, 1792 + lane * 8, mu, g8);
            UNROLL for (int i = 0; i < 8; ++i) g8[i] = sigm(g8[i]);
            st8(SG + (size_t)n * 128 + lane * 8, g8);
        }
    }
}

DEV void ph_na_norm(const Params& p, int L) {
    const int lane = TID() & 63, wave = TID() >> 6;
    bf16_t* PXN = (bf16_t*)(p.ws + OFF_PX);
    const float* qg = p.in[I_QNG] + (size_t)L * 64; const float* kg = p.in[I_KNG] + (size_t)L * 64;
    for (int n0 = blockIdx.x * 8; n0 < NT; n0 += gridDim.x * 8) {
        const int n = n0 + wave, c = lane * 8;
        UNROLL for (int w = 0; w < 2; ++w) {
            bf16_t* ptr = PXN + (size_t)n * 1024 + w * 512 + c;
            float x[8]; ld8(ptr, x);
            float ss = 0.f;
            UNROLL for (int i = 0; i < 8; ++i) ss += x[i] * x[i];
            ss += __shfl_xor(ss, 1); ss += __shfl_xor(ss, 2); ss += __shfl_xor(ss, 4);
            const float r = rsqrtf(ss * (1.f / 64.f) + 1e-6f) * (w == 0 ? 0.125f : 1.f);
            const float* g = w == 0 ? qg : kg;
            UNROLL for (int i = 0; i < 8; ++i) x[i] = x[i] * r * g[(c + i) & 63];
            st8(ptr, x);
        }
    }
}

DEV void knorm8u(float (&x)[8]) {
    float ss = 0.f;
    UNROLL for (int i = 0; i < 8; ++i) ss += x[i] * x[i];
    ss = sum8(ss);
    const float r = rsqrtf(ss * (1.f / 64.f) + 1e-6f);
    UNROLL for (int i = 0; i < 8; ++i) x[i] *= r;
}
DEV void knorm8(float (&x)[8], const float* g) {
    float ss = 0.f;
    UNROLL for (int i = 0; i < 8; ++i) ss += x[i] * x[i];
    ss = sum8(ss);
    const float r = rsqrtf(ss * (1.f / 64.f) + 1e-6f);
    UNROLL for (int i = 0; i < 8; ++i) x[i] = x[i] * r * g[i];
}
DEV void ph_na_att(const Params& p, int L, char* smem) {
    const int tid0 = TID();
    const int wave = __builtin_amdgcn_readfirstlane(tid0 >> 6);
    char* KL = smem;
    char* KC = smem + 576 * LROW;
    char* VL = smem;
    char* VC = smem + 64 * 1168;
    float* OX = (float*)(smem + 119808);
    float* RP = OX + 8 * 1024;
    const bf16_t* PXN = (const bf16_t*)(p.ws + OFF_PX); bf16_t* YB = (bf16_t*)(p.ws + OFF_YB);
    const bf16_t* VT = (const bf16_t*)(p.ws + OFF_VT); const bf16_t* VTC = (const bf16_t*)(p.ws + OFF_VTC);
    float* qgn = RP + 480; float* kgn = qgn + 64;
    const bool rp_once = (gridDim.x & 7) == 0;
    if (tid0 < 64) { qgn[tid0] = p.in[I_QNG][(size_t)L * 64 + tid0] * p.in[I_KNG][(size_t)L * 64 + tid0] * 1.4426950408889634f; kgn[tid0] = 1.f; }
    if (rp_once) for (int i = tid0; i < 15 * 31; i += NTHREADS) RP[i] = p.in[I_RPB][((size_t)L * 8 + (blockIdx.x & 7)) * 465 + i] * 1.4426950408889634f;
    __syncthreads();
    const int nunits = 2048 + (L == 0 ? 256 : 0);
    u32x4 vraw[13], qraw[2];
#define NA_GEOM(u_) const bool cu = (u_) >= 2048; int b, h, rp = 0, rs0 = 0, g = 0; \
        if (!cu) { h = (u_) & 7; rp = ((u_) >> 3) & 15; b = (u_) >> 7; rs0 = min(max(2 * rp - 4, 0), 24); } \
        else { const int v_ = (u_) - 2048; h = v_ & 7; g = (v_ >> 3) & 1; b = v_ >> 4; } \
        const int ctx0 = NX + b * CTXL; \
        const int nb = wave & 3, ri = wave >> 2, r = 2 * rp + ri; \
        const int qtok0 = cu ? ctx0 + (g * 8 + wave) * 16 : b * SEQ + r * 64 + nb * 16;
#define NA_KQ_LOAD(u_, tid_) do { NA_GEOM(u_) \
        if (!cu) { UNROLL for (int i = 0; i < 9; ++i) { const int c = (tid_) + NTHREADS * i, kx = c >> 3, part = c & 7; \
            vraw[i] = *(const u32x4*)(PXN + (size_t)(b * SEQ + min(rs0 + (kx >> 6), 31) * 64 + (kx & 63)) * 1024 + 512 + h * 64 + part * 8); } } \
        UNROLL for (int i = 0; i < 4; ++i) { const int c = (tid_) + NTHREADS * i, kx = c >> 3, part = c & 7; \
            vraw[9 + i] = *(const u32x4*)(PXN + (size_t)(ctx0 + kx) * 1024 + 512 + h * 64 + part * 8); } \
        { const int lq_ = (tid_) & 15, kg_ = ((tid_) & 63) >> 4; \
          qraw[0] = *(const u32x4*)(PXN + (size_t)(qtok0 + lq_) * 1024 + h * 64 + kg_ * 8); qraw[1] = *(const u32x4*)(PXN + (size_t)(qtok0 + lq_) * 1024 + h * 64 + 32 + kg_ * 8); } } while (0)
    int u0 = blockIdx.x; asm volatile("" : "+s"(u0));
    if (u0 < nunits) NA_KQ_LOAD(u0, tid0);
    for (int u = u0; u < nunits; u += gridDim.x) {
        int tid = tid0; asm volatile("" : "+v"(tid));
        const int lane = tid & 63, lq = lane & 15, kg = lane >> 4;
        NA_GEOM(u)
        if (!cu) {
            UNROLL for (int i = 0; i < 9; ++i) {
                const int c = tid + NTHREADS * i, kx = c >> 3, part = c & 7;
                float kv[8]; unpack8(vraw[i], kv); knorm8u(kv);
                st8((bf16_t*)(KL + kx * LROW + part * 16), kv);
            }
            if (!rp_once) for (int i = tid; i < 15 * 31; i += NTHREADS) RP[i] = p.in[I_RPB][((size_t)L * 8 + h) * 465 + i] * 1.4426950408889634f;
        }
        UNROLL for (int i = 0; i < 4; ++i) {
            const int c = tid + NTHREADS * i, kx = c >> 3, part = c & 7;
            float kv[8]; unpack8(vraw[9 + i], kv); knorm8u(kv);
            st8((bf16_t*)(KC + kx * LROW + part * 16), kv);
        }
        const int rs = min(max(r - 4, 0), 24), roff = rs - rs0;
        const int band0 = min(max(nb * 16 - 8, 0), 32);
        bf16x8 qf[2];
        {
            float q0[8], q1[8]; unpack8(qraw[0], q0); unpack8(qraw[1], q1);
            float ss = 0.f;
            UNROLL for (int i = 0; i < 8; ++i) ss += q0[i] * q0[i] + q1[i] * q1[i];
            ss += __shfl_xor(ss, 16); ss += __shfl_xor(ss, 32);
            const float rq = rsqrtf(ss * (1.f / 64.f) + 1e-6f) * 0.125f;
            UNROLL for (int i = 0; i < 8; ++i) { q0[i] = q0[i] * rq * qgn[kg * 8 + i]; q1[i] = q1[i] * rq * qgn[32 + kg * 8 + i]; }
            u32x4 w0, w1; w0.x = pk2(q0[0], q0[1]); w0.y = pk2(q0[2], q0[3]); w0.z = pk2(q0[4], q0[5]); w0.w = pk2(q0[6], q0[7]);
            w1.x = pk2(q1[0], q1[1]); w1.y = pk2(q1[2], q1[3]); w1.z = pk2(q1[4], q1[5]); w1.w = pk2(q1[6], q1[7]);
            qf[0] = __builtin_bit_cast(bf16x8, w0); qf[1] = __builtin_bit_cast(bf16x8, w1);
        }
        __syncthreads();
        if (!cu) {
            UNROLL for (int i = 0; i < 9; ++i) {
                const int c = tid + NTHREADS * i, part = c & 7, kr = (c >> 3) % 9, d = (c >> 3) / 9;
                vraw[i] = *(const u32x4*)(VT + ((size_t)(b * 8 + h) * 64 + d) * SEQ + min(rs0 + kr, 31) * 64 + part * 8);
            }
        }
        UNROLL for (int i = 0; i < 4; ++i) {
            const int c = tid + NTHREADS * i, part = c & 31, d = c >> 5;
            vraw[9 + i] = *(const u32x4*)(VTC + ((size_t)(b * 8 + h) * 64 + d) * CTXL + part * 8);
        }
        f32x4v sacc[16];
        bf16x8 pfl[8], pfc[8];
        float ml = -3e38f, ll = 0.f, mc, lc;
        if (!cu) {
            const char* kb = KL + (roff * 64 + band0 + lq) * LROW + kg * 16;
            UNROLL for (int t = 0; t < 16; ++t) {
                f32x4v a = {0.f, 0.f, 0.f, 0.f};
                UNROLL for (int ks = 0; ks < 2; ++ks) a = __builtin_amdgcn_mfma_f32_16x16x32_bf16(*(const bf16x8*)(kb + ((t >> 1) * 64 + (t & 1) * 16) * LROW + ks * 64), qf[ks], a, 0, 0, 0);
                sacc[t] = a;
            }
            const int col = nb * 16 + lq, cs = min(max(col - 8, 0), 48);
            const int kc0 = band0 + 4 * kg;
            const float* rpp = RP + (rs - r + 7) * 31 + (kc0 - col + 15);
            UNROLL for (int t = 0; t < 16; ++t) UNROLL for (int i = 0; i < 4; ++i) {
                const int kc = kc0 + (t & 1) * 16 + i;
                const bool valid = kc >= cs && kc < cs + 16;
                sacc[t][i] = valid ? sacc[t][i] + rpp[(t >> 1) * 31 + (t & 1) * 16 + i] : -1e30f;
            }
            UNROLL for (int t = 0; t < 16; ++t) UNROLL for (int i = 0; i < 4; ++i) ml = fmaxf(ml, sacc[t][i]);
            ml = fmaxf(ml, __shfl_xor(ml, 16)); ml = fmaxf(ml, __shfl_xor(ml, 32));
            UNROLL for (int t = 0; t < 16; ++t) UNROLL for (int i = 0; i < 4; ++i) { const float e = __builtin_amdgcn_exp2f(sacc[t][i] - ml); sacc[t][i] = e; ll += e; }
            ll += __shfl_xor(ll, 16); ll += __shfl_xor(ll, 32);
            UNROLL for (int tp = 0; tp < 8; ++tp) pfl[tp] = pk_acc2(sacc[2 * tp], sacc[2 * tp + 1]);
        }
        {
            const char* kb = KC + lq * LROW + kg * 16;
            UNROLL for (int t = 0; t < 16; ++t) {
                f32x4v a = {0.f, 0.f, 0.f, 0.f};
                UNROLL for (int ks = 0; ks < 2; ++ks) a = __builtin_amdgcn_mfma_f32_16x16x32_bf16(*(const bf16x8*)(kb + t * 16 * LROW + ks * 64), qf[ks], a, 0, 0, 0);
                sacc[t] = a;
            }
            mc = -3e38f; lc = 0.f;
            UNROLL for (int t = 0; t < 16; ++t) UNROLL for (int i = 0; i < 4; ++i) mc = fmaxf(mc, sacc[t][i]);
            mc = fmaxf(mc, __shfl_xor(mc, 16)); mc = fmaxf(mc, __shfl_xor(mc, 32));
            UNROLL for (int t = 0; t < 16; ++t) UNROLL for (int i = 0; i < 4; ++i) { const float e = __builtin_amdgcn_exp2f(sacc[t][i] - mc); sacc[t][i] = e; lc += e; }
            lc += __shfl_xor(lc, 16); lc += __shfl_xor(lc, 32);
            UNROLL for (int tp = 0; tp < 8; ++tp) pfc[tp] = pk_acc2(sacc[2 * tp], sacc[2 * tp + 1]);
        }
        const float mm = fmaxf(ml, mc), el = cu ? 0.f : __builtin_amdgcn_exp2f(ml - mm), ec = __builtin_amdgcn_exp2f(mc - mm);
        const float inv = frcp(ll * el + lc * ec);
        const float fl = el * inv, fc = ec * inv;
        __syncthreads();
        if (!cu) {
            UNROLL for (int i = 0; i < 9; ++i) {
                const int c = tid + NTHREADS * i, part = c & 7, kr = (c >> 3) % 9, d = (c >> 3) / 9;
                *(u32x4*)(VL + d * 1168 + (kr * 64 + part * 8) * 2) = vraw[i];
            }
        }
        UNROLL for (int i = 0; i < 4; ++i) {
            const int c = tid + NTHREADS * i, part = c & 31, d = c >> 5;
            *(u32x4*)(VC + d * 528 + part * 16) = vraw[9 + i];
        }
        __syncthreads();
        f32x4v ol[4], oc[4];
        UNROLL for (int dt = 0; dt < 4; ++dt) { ol[dt] = (f32x4v){0.f, 0.f, 0.f, 0.f}; oc[dt] = (f32x4v){0.f, 0.f, 0.f, 0.f}; }
        if (!cu) {
            const char* vb = VL + lq * 1168 + (roff * 64 + band0 + 4 * kg) * 2;
            UNROLL for (int tp = 0; tp < 8; ++tp) UNROLL for (int dt = 0; dt < 4; ++dt)
                ol[dt] = __builtin_amdgcn_mfma_f32_16x16x32_bf16(pfl[tp], pk_lohi(*(const u32x2*)(vb + dt * 16 * 1168 + tp * 128), *(const u32x2*)(vb + dt * 16 * 1168 + tp * 128 + 32)), ol[dt], 0, 0, 0);
        }
        {
            const char* vb = VC + lq * 528 + 8 * kg;
            UNROLL for (int tp = 0; tp < 8; ++tp) UNROLL for (int dt = 0; dt < 4; ++dt)
                oc[dt] = __builtin_amdgcn_mfma_f32_16x16x32_bf16(pfc[tp], pk_lohi(*(const u32x2*)(vb + dt * 16 * 528 + tp * 64), *(const u32x2*)(vb + dt * 16 * 528 + tp * 64 + 32)), oc[dt], 0, 0, 0);
        }
        if (u + (int)gridDim.x < nunits) { const int un_ = u + (int)gridDim.x; NA_KQ_LOAD(un_, tid); }
        float* ox = OX + wave * 1024;
        UNROLL for (int i = 0; i < 4; ++i) {
            const float a = __shfl(fl, 4 * kg + i), c2 = __shfl(fc, 4 * kg + i);
            UNROLL for (int dt = 0; dt < 4; ++dt) ox[(4 * kg + i) * 64 + dt * 16 + lq] = ol[dt][i] * a + oc[dt][i] * c2;
        }
        UNROLL for (int it = 0; it < 2; ++it) {
            const int q = (lane >> 3) + 8 * it, c8 = (lane & 7) * 8;
            const float4 a = *(const float4*)(ox + q * 64 + c8), bq = *(const float4*)(ox + q * 64 + c8 + 4);
            const float v[8] = {a.x, a.y, a.z, a.w, bq.x, bq.y, bq.z, bq.w};
            st8(YB + (size_t)(qtok0 + q) * 512 + h * 64 + c8, v);
        }
        __syncthreads();
    }
#undef NA_KQ_LOAD
#undef NA_GEOM
}

DEV float sum16(float v) { v += DPP_MOV(v, 0xB1); v += DPP_MOV(v, 0x4E); v += DPP_MOV(v, 0x141); v += DPP_MOV(v, 0x140); return v; }
DEV void ph_ml_scan(const Params& p, int L, char* smem) {
    const int tid = TID(), lane = tid & 63, lq = lane & 15, kg = lane >> 4, ti = tid >> 3, j = tid & 7;
    const int wave = __builtin_amdgcn_readfirstlane(tid >> 6);
    char* QS = smem;
    char* QP = QS + 9216;
    char* KC = QP + 9216;
    char* KW = KC + 9216;
    char* PM = KW + 9216;
    char* VT = PM + 9216;
    float* BV0 = (float*)(VT + 128 * LROW);
    float* GI0 = BV0 + 128;
    float* DEN = GI0 + 128;
    float* NV = DEN + 64;
    float* RS = NV + 64;
    float* HO = RS + 256;
    const bf16_t* PXM = (const bf16_t*)(p.ws + OFF_PX); bf16_t* HS = (bf16_t*)(p.ws + OFF_HS);
    for (int u = blockIdx.x; u < 128; u += gridDim.x) {
        const int d = u & 1, h = (u >> 1) & 3, b = u >> 3;
        const float ib = p.in[I_IB][L * 8 + d * 4 + h], fb = p.in[I_FB][L * 8 + d * 4 + h];
        f32x4v cacc[4];
        UNROLL for (int i = 0; i < 4; ++i) cacc[i] = (f32x4v){0.f, 0.f, 0.f, 0.f};
        for (int i = tid; i < 64 * LROW / 4; i += NTHREADS) ((unsigned*)PM)[i] = 0u;
        if (tid < 64) NV[tid] = 0.f;
        __syncthreads();
        u32x4 pq, pk, pv0, pv1; unsigned short pig = 0, pfg = 0;
#define ML_GEOM(ci_) const bool isc = (ci_) < 4; const int T = isc ? CTXL : SEQ, cc = isc ? (ci_) : (ci_) - 4; \
            const int t0 = d == 0 ? cc * 64 : T - 64 * (cc + 1), nb = isc ? NX + b * CTXL : b * SEQ; \
            const int tt = d == 0 ? t0 + ti : t0 + 63 - ti;
#define ML_PREFETCH(ci_) do { ML_GEOM(ci_) const bf16_t* row_ = PXM + (size_t)(nb + tt) * ML_COLS; \
            pq = *(const u32x4*)(row_ + h * 64 + 8 * j); pk = *(const u32x4*)(row_ + 256 + h * 64 + 8 * j); \
            pv0 = *(const u32x4*)(row_ + 512 + h * 128 + 16 * j); pv1 = *(const u32x4*)(row_ + 512 + h * 128 + 16 * j + 8); \
            if (wave == 7) { const int tl_ = d == 0 ? t0 + lane : t0 + 63 - lane; const bf16_t* rw_ = PXM + (size_t)(nb + tl_) * ML_COLS; pig = rw_[1536 + d * 4 + h]; pfg = rw_[1544 + d * 4 + h]; } } while (0)
        ML_PREFETCH(0);
#define ML_GATES(par_) do { const float ig = bf2f(pig) + ib, fg = bf2f(pfg) + fb; \
            const float igc = 15.f * tanh_fast(ig * (1.f / 15.f)), fgc = 15.f * tanh_fast(fg * (1.f / 15.f)); \
            float lf = -softplus_fast(-fgc);        \
            UNROLL for (int o = 1; o < 64; o <<= 1) { const float up = __shfl_up(lf, o); if (lane >= o) lf += up; } \
            BV0[(par_) * 64 + lane] = lf; GI0[(par_) * 64 + lane] = igc; } while (0)
        if (wave == 7) ML_GATES(0);
        __syncthreads();
        for (int ci = 0; ci < 36; ++ci) {
            ML_GEOM(ci)
            const float* BV = BV0 + (ci & 1) * 64; const float* GI = GI0 + (ci & 1) * 64;
            float q8[8], k8[8];
            {
                unpack8(pq, q8); unpack8(pk, k8);
                if (!isc) {
                    const int axis = j >> 2, half = (j >> 1) & 1; const float pos = (float)(axis == 0 ? (tt >> 6) : (tt & 63));
                    UNROLL for (int i = 0; i < 8; ++i) {
                        const int f = (j & 1) * 8 + i;
                        const float inv = exp2f(-(float)f * 0.83048202372184059f);
                        const float ang = pos * inv; const float cs = __cosf(ang), sn = __sinf(ang);
                        const float qo = __shfl_xor(q8[i], 2), ko = __shfl_xor(k8[i], 2);
                        q8[i] = half == 0 ? q8[i] * cs - qo * sn : q8[i] * cs + qo * sn;
                        k8[i] = half == 0 ? k8[i] * cs - ko * sn : k8[i] * cs + ko * sn;
                    }
                }
                UNROLL for (int i = 0; i < 8; ++i) q8[i] *= 0.125f;
                st8((bf16_t*)(QS + ti * LROW) + 8 * j, q8); st8((bf16_t*)(KC + ti * LROW) + 8 * j, k8);
                float v0[8], v1[8]; unpack8(pv0, v0); unpack8(pv1, v1);
                UNROLL for (int i = 0; i < 8; ++i) { *(bf16_t*)(VT + (16 * j + i) * LROW + ti * 2) = f2bf(v0[i]); *(bf16_t*)(VT + (16 * j + 8 + i) * LROW + ti * 2) = f2bf(v1[i]); }
            }
            if (ci + 1 < 36) ML_PREFETCH(ci + 1);
            {
                const float bt = BV[ti], bl = BV[63], gi = GI[ti];
                const float eb = __expf(bt), wk = __expf(bl - bt + gi);
                float qp[8]; float dn = 0.f;
                UNROLL for (int i = 0; i < 8; ++i) { qp[i] = q8[i] * eb; dn += q8[i] * NV[8 * j + i]; }
                st8((bf16_t*)(QP + ti * LROW) + 8 * j, qp);
                UNROLL for (int i = 0; i < 8; ++i) *(bf16_t*)(KW + (8 * j + i) * LROW + ti * 2) = f2bf(k8[i] * wk);
                dn = sum8(dn);
                if (j == 0) DEN[ti] = dn * eb;
            }
            __syncthreads();
            UNROLL for (int rep = 0; rep < 2; ++rep) {
                const int tile = wave + 8 * rep;
                if (tile < 10) {
                    const int tt4 = tile < 1 ? 0 : tile < 3 ? 1 : tile < 6 ? 2 : 3, st4 = tile - (tt4 * (tt4 + 1)) / 2;
                    f32x4v a = {0.f, 0.f, 0.f, 0.f};
                    UNROLL for (int ks = 0; ks < 2; ++ks)
                        a = __builtin_amdgcn_mfma_f32_16x16x32_bf16(*(const bf16x8*)(QS + (16 * tt4 + lq) * LROW + ks * 64 + kg * 16),
                                                                    *(const bf16x8*)(KC + (16 * st4 + lq) * LROW + ks * 64 + kg * 16), a, 0, 0, 0);
                    const int sidx = 16 * st4 + lq; const float bs = BV[sidx], gs = GI[sidx];
                    UNROLL for (int i = 0; i < 4; ++i) {
                        const int tidx = 16 * tt4 + 4 * kg + i;
                        const float val = sidx <= tidx ? a[i] * __expf(BV[tidx] - bs + gs) : 0.f;
                        *(bf16_t*)(PM + tidx * LROW + sidx * 2) = f2bf(val);
                        const float rsum = sum16(val);
                        if (lq == 0) RS[tidx * 4 + st4] = rsum;
                    }
                }
            }
            if (wave == 7 && ci + 1 < 36) ML_GATES((ci + 1) & 1);
            if (wave == 6) {
                float acc = 0.f;
                UNROLL for (int c8 = 0; c8 < 8; ++c8) { float kw[8]; ld8((const bf16_t*)(KW + lane * LROW) + 8 * c8, kw); UNROLL for (int i = 0; i < 8; ++i) acc += kw[i]; }
                NV[lane] = __expf(BV[63]) * NV[lane] + acc;
            }
            __syncthreads();
            {
                bf16x8 vf[2], cb[2];
                UNROLL for (int kk = 0; kk < 2; ++kk) vf[kk] = *(const bf16x8*)(VT + (16 * wave + lq) * LROW + kk * 64 + kg * 16);
                UNROLL for (int kk = 0; kk < 2; ++kk) {
                    u32x4 w; w.x = pk2(cacc[2 * kk][0], cacc[2 * kk][1]); w.y = pk2(cacc[2 * kk][2], cacc[2 * kk][3]);
                    w.z = pk2(cacc[2 * kk + 1][0], cacc[2 * kk + 1][1]); w.w = pk2(cacc[2 * kk + 1][2], cacc[2 * kk + 1][3]);
                    cb[kk] = __builtin_bit_cast(bf16x8, w);
                }
                UNROLL for (int tt4 = 0; tt4 < 4; ++tt4) {
                    f32x4v hacc = {0.f, 0.f, 0.f, 0.f};
                    UNROLL for (int kk = 0; kk < 2; ++kk) if (2 * kk <= tt4)
                        hacc = __builtin_amdgcn_mfma_f32_16x16x32_bf16(*(const bf16x8*)(PM + (16 * tt4 + lq) * LROW + kk * 64 + kg * 16), vf[kk], hacc, 0, 0, 0);
                    UNROLL for (int kk = 0; kk < 2; ++kk) {
                        const char* qa = QP + (16 * tt4 + lq) * LROW + (32 * kk + 4 * kg) * 2;
                        const u32x2 lo = *(const u32x2*)qa, hi = *(const u32x2*)(qa + 32);
                        u32x4 w; w.x = lo.x; w.y = lo.y; w.z = hi.x; w.w = hi.y;
                        hacc = __builtin_amdgcn_mfma_f32_16x16x32_bf16(__builtin_bit_cast(bf16x8, w), cb[kk], hacc, 0, 0, 0);
                    }
                    UNROLL for (int i = 0; i < 4; ++i) {
                        const int tidx = 16 * tt4 + 4 * kg + i;
                        float den = DEN[tidx];
                        UNROLL for (int st = 0; st <= tt4; ++st) den += RS[tidx * 4 + st];
                        HO[tidx * 132 + 16 * wave + lq] = hacc[i] * frcp(fmaxf(fabsf(den), 1.f));
                    }
                }
                const float g = __expf(BV[63]);
                UNROLL for (int dk = 0; dk < 4; ++dk) {
                    cacc[dk] = cacc[dk] * g;
                    UNROLL for (int kk = 0; kk < 2; ++kk)
                        cacc[dk] = __builtin_amdgcn_mfma_f32_16x16x32_bf16(*(const bf16x8*)(KW + (16 * dk + lq) * LROW + kk * 64 + kg * 16), vf[kk], cacc[dk], 0, 0, 0);
                }
            }
            __syncthreads();
            {
                const float* hr = HO + ti * 132 + 16 * j;
                float o0[8], o1[8];
                UNROLL for (int i = 0; i < 8; ++i) { o0[i] = hr[i]; o1[i] = hr[8 + i]; }
                bf16_t* dst = HS + ((size_t)d * NT + nb + tt) * 512 + h * 128 + 16 * j;
                st8(dst, o0); st8(dst + 8, o1);
            }
        }
        __syncthreads();
    }
#undef ML_GATES
}
DEV void ph_ml_read(const Params& p, int L, int ntok) {
    const int lane = TID() & 63, wave = TID() >> 6;
    const bf16_t* PXM = (const bf16_t*)(p.ws + OFF_PX); const bf16_t* HS = (const bf16_t*)(p.ws + OFF_HS);
    bf16_t* YC = (bf16_t*)(p.ws + OFF_YC); const float* ng = p.in[I_MNG] + (size_t)L * 512;
    for (int n0 = blockIdx.x * 8; n0 < ntok; n0 += gridDim.x * 8) {
        const int n = n0 + wave, c = lane * 8;
        float h0[8], h1[8], o8[8], out[8];
        ld8(HS + (size_t)n * 512 + c, h0); ld8(HS + ((size_t)NT + n) * 512 + c, h1); ld8(PXM + (size_t)n * ML_COLS + 1024 + c, o8);
        float ss = 0.f;
        UNROLL for (int i = 0; i < 8; ++i) { h0[i] += h1[i]; ss += h0[i] * h0[i]; }
        ss += __shfl_xor(ss, 1); ss += __shfl_xor(ss, 2); ss += __shfl_xor(ss, 4); ss += __shfl_xor(ss, 8);
        const float r = rsqrtf(ss * (1.f / 128.f) + 1e-6f);
        UNROLL for (int i = 0; i < 8; ++i) out[i] = h0[i] * r * ng[c + i] * sigm(o8[i]);
        st8(YC + (size_t)n * 512 + c, out);
    }
}

DEV void ph_route(const Params& p, int L, int ntok, char* smem) {
    const int lane = TID() & 63, wave = TID() >> 6;
    const float* LOG = (const float*)(p.ws + OFF_LOG); int* EIDX = (int*)(p.ws + OFF_EIDX); float* EW = (float*)(p.ws + OFF_EW);
    const float bias = p.in[I_MB][L * 64 + lane];
    int* MCNT = (int*)(p.ws + OFF_MCNT);
    int* hist = (int*)smem;
    if (TID() < 192) hist[TID()] = 0;
    __syncthreads();
    constexpr int TW = 2;
    float lg[TW];
    UNROLL for (int t = 0; t < TW; ++t) lg[t] = (int)(blockIdx.x * 8 * TW) < ntok ? LOG[(size_t)(blockIdx.x * 8 * TW + t * 8 + wave) * 64 + lane] : 0.f;
    for (int n0 = blockIdx.x * 8 * TW; n0 < ntok; n0 += gridDim.x * 8 * TW) {
        const int g = lane >> 3;
        float score[TW], sel[TW], gs[TW], ms[TW]; unsigned cur[TW]; int er[TW];
        UNROLL for (int t = 0; t < TW; ++t) score[t] = sigm_acc(lg[t]);
        { const int nn = n0 + gridDim.x * 8 * TW; if (nn < ntok) { UNROLL for (int t = 0; t < TW; ++t) lg[t] = LOG[(size_t)(nn + t * 8 + wave) * 64 + lane]; } }
        UNROLL for (int t = 0; t < TW; ++t) {
            sel[t] = score[t] + bias;
            const float m1 = max8(sel[t]);
            const int i1 = min8i(sel[t] == m1 ? lane : 64);
            const float m2 = max8(lane == i1 ? -3e38f : sel[t]);
            gs[t] = m1 + m2;
        }
        UNROLL for (int t = 0; t < TW; ++t) {
            int rank = 0;
            UNROLL for (int g2 = 0; g2 < 8; ++g2) { const float v = __int_as_float(__builtin_amdgcn_readlane(__float_as_int(gs[t]), g2 * 8)); rank += (v > gs[t] || (v == gs[t] && g2 < g)) ? 1 : 0; }
            ms[t] = rank < 4 ? sel[t] : -1e30f; er[t] = 64;
            const unsigned fb = __float_as_uint(ms[t]); cur[t] = fb ^ ((int)fb < 0 ? 0xFFFFFFFFu : 0x80000000u);
        }
        UNROLL for (int k = 0; k < 8; ++k) UNROLL for (int t = 0; t < TW; ++t) {
            unsigned r = cur[t];
            r = max(r, (unsigned)DPP_MOVI((int)r, 0xB1)); r = max(r, (unsigned)DPP_MOVI((int)r, 0x4E)); r = max(r, (unsigned)DPP_MOVI((int)r, 0x141)); r = max(r, (unsigned)DPP_MOVI((int)r, 0x140));
            const unsigned r0 = (unsigned)__builtin_amdgcn_readlane((int)r, 0), r1 = (unsigned)__builtin_amdgcn_readlane((int)r, 16);
            const unsigned r2 = (unsigned)__builtin_amdgcn_readlane((int)r, 32), r3 = (unsigned)__builtin_amdgcn_readlane((int)r, 48);
            const unsigned m = max(max(r0, r1), max(r2, r3));
            const unsigned long long bal = __ballot(cur[t] == m);
            const int first = __builtin_ctzll(bal);
            if (lane == first) { er[t] = k; cur[t] = 0u; }
        }
        UNROLL for (int t = 0; t < TW; ++t) {
            const int n = n0 + t * 8 + wave;
            const bool chosen = er[t] < 8;
            const float w16 = sum16(chosen ? score[t] : 0.f);
            const float ws = (__int_as_float(__builtin_amdgcn_readlane(__float_as_int(w16), 0)) + __int_as_float(__builtin_amdgcn_readlane(__float_as_int(w16), 16)))
                           + (__int_as_float(__builtin_amdgcn_readlane(__float_as_int(w16), 32)) + __int_as_float(__builtin_amdgcn_readlane(__float_as_int(w16), 48)));
            if (chosen) { EIDX[(size_t)n * 8 + er[t]] = lane; EW[(size_t)n * 8 + er[t]] = score[t] / ws * 2.5f; atomicAdd(hist + (n / moe_chunk(L)) * 64 + lane, 1); }
        }
    }
    __syncthreads();
    if (TID() < 192 && hist[TID()] > 0) atomicAdd(MCNT + TID(), hist[TID()]);
    __syncthreads();
}


DEV void ph_moe_scatter(const Params& p, int ntok, int mch, char* smem) {
    const int tid = TID();
    int* base = (int*)smem;
    int* lh = base + 192;
    const int* MCNT = (const int*)(p.ws + OFF_MCNT); int* CUR = (int*)(p.ws + OFF_MCNT) + 192;
    const int* EIDX = (const int*)(p.ws + OFF_EIDX); int* SORT = (int*)(p.ws + OFF_SORT);
    if (tid < 192) lh[tid] = MCNT[tid];
    __syncthreads();
    if (tid < 3) { int b = 0; for (int e = 0; e < 64; ++e) { base[tid * 64 + e] = b; b += (lh[tid * 64 + e] + 127) & ~127; } }
    __syncthreads();
    if (tid < 192) lh[tid] = 0;
    __syncthreads();
    for (int i = blockIdx.x * NTHREADS + tid; i < ntok * 8; i += gridDim.x * NTHREADS) atomicAdd(lh + ((i >> 3) / mch) * 64 + EIDX[i], 1);
    __syncthreads();
    if (tid < 192) { const int n = lh[tid]; if (n > 0) base[tid] += atomicAdd(CUR + tid, n); lh[tid] = 0; }
    __syncthreads();
    for (int i = blockIdx.x * NTHREADS + tid; i < ntok * 8; i += gridDim.x * NTHREADS) {
        const int ce = ((i >> 3) / mch) * 64 + EIDX[i];
        SORT[(size_t)(ce >> 6) * SORT_CAP + base[ce] + atomicAdd(lh + ce, 1)] = i;
    }
    __syncthreads();
}

DEV void ph_moe_exp(const Params& p, int cidx, int cb, int ce, char* smem, Topo tp) {
    typedef GC<2, 4> C;
    const int tid0 = TID();
    char* ACT = smem + 2 * C::STG;
    int* list = (int*)(smem + 3 * C::STG);
    int* cnt = list + 1024;
    const bf16_t* H2 = (const bf16_t*)(p.ws + OFF_HX); const int* EIDX = (const int*)(p.ws + OFF_EIDX); const float* EW = (const float*)(p.ws + OFF_EW);
    unsigned char* YB8 = (unsigned char*)(p.ws + OFF_YBUF); unsigned char* YSC = (unsigned char*)(p.ws + OFF_YSC);
    const int c = cidx;
    const int* MCNT = (const int*)(p.ws + OFF_MCNT) + c * 64; const int* SORT = (const int*)(p.ws + OFF_SORT) + (size_t)c * SORT_CAP;
    int* tb = cnt + 16;
    const int xcd = tp.x, slot = tp.r, nslot = tp.n;
    __syncthreads();
    int* rc = cnt + 128;
    if (tid0 < 64) rc[tid0] = MCNT[tid0];
    __syncthreads();
    if (tid0 < 8) {
        const int tid = tid0; const int e = xcd + 8 * tid; int b = 0;
        for (int e2 = 0; e2 < e; ++e2) b += (rc[e2] + 127) & ~127;
        tb[16 + tid] = b; tb[32 + tid] = rc[e];
    }
    __syncthreads();
    if (tid0 == 0) { int t = 0; for (int k = 0; k < 8; ++k) { tb[k] = t; t += (tb[32 + k] + 127) >> 7; } tb[8] = t; }
    __syncthreads();
    const int total = tb[8];
    float* ewl = (float*)(list + 256);
    if (slot < total && tid0 < 128) {
        int k = 0;
        while (k < 7 && slot >= tb[k + 1]) ++k;
        const int j = slot - tb[k], M = min(128, tb[32 + k] - 128 * j);
        const int en = SORT[tb[16 + k] + 128 * j + min(tid0, M - 1)];
        list[tid0] = en; ewl[tid0] = EW[en];
    }
    int cur = 0;
#define GLDS4(gp, lp) __builtin_amdgcn_global_load_lds((const __attribute__((address_space(1))) void*)(gp), (__attribute__((address_space(3))) void*)(lp), 4, 0, 0)
    for (int lu = slot; lu < total; lu += nslot) {
        int tid = tid0; asm volatile("" : "+v"(tid));
        const int lane = tid & 63, wave = tid >> 6, wm = wave / 4, wn = wave % 4, fr = lane & 31, fh = lane >> 5;
        int k = 0;
        while (k < 7 && lu >= tb[k + 1]) ++k;
        const int e = xcd + 8 * k, j = lu - tb[k], M = min(128, tb[32 + k] - 128 * j);
        const int* lst = list + cur * 128; const float* ew = ewl + cur * 128;
        int* lst2 = list + (cur ^ 1) * 128; float* ew2 = ewl + (cur ^ 1) * 128;
        const bool has_next = lu + nslot < total;
        __syncthreads();
        if (has_next && tid < 128) {
            const int lu2 = lu + nslot; int k2 = 0;
            while (k2 < 7 && lu2 >= tb[k2 + 1]) ++k2;
            const int j2 = lu2 - tb[k2], M2 = min(128, tb[32 + k2] - 128 * j2);
            GLDS4(SORT + tb[16 + k2] + 128 * j2 + min(tid, M2 - 1), lst2 + tid);
        }
        const bf16_t* GU = (const bf16_t*)(p.ws + OFF_MGU) + (size_t)e * 256 * 1024;
        const bf16_t* DT = (const bf16_t*)(p.ws + OFF_MDT) + (size_t)e * 1024 * 128;
        {
            constexpr int mc = 0;
            f32x16 acc[2][2];
            {
            acc_zero(acc);
            gemm_tile<2, 4, 3, false, true>(acc, [&](int r) -> const bf16_t* { const int ix = min(mc + r, M - 1); return H2 + (size_t)(lst[ix] >> 3) * 1024; },
                                   GU, 1024, 0, 256, 1024, smem, nullptr);
            }
            const int crow = tid >> 3, cch = (tid & 7) ^ ((crow >> 1) & 7);
#define MG2_BUF(s_, kt) (((s_) & 3) == 0 ? smem + C::AB + (kt) * 16384 : ((s_) & 3) == 1 ? smem + C::STG + C::AB + (kt) * 16384 : ((s_) & 3) == 2 ? smem + 2 * C::STG + (kt) * 16384 : smem + (kt) * C::STG)
#define MG2_ISSUE(s_) do { UNROLL for (int kt = 0; kt < 2; ++kt) UNROLL for (int i = 0; i < 2; ++i) \
                    GLDS16(DT + (size_t)((s_) * 128 + ((crow + 64 * i) & ~31) + p32(crow & 31)) * 128 + kt * 64 + cch * 8, MG2_BUF(s_, kt) + i * 8192 + tid * 16); } while (0)
            if (has_next && tid < 128) GLDS4(EW + lst2[tid], ew2 + tid);
            MG2_ISSUE(0); MG2_ISSUE(1); MG2_ISSUE(3);
            UNROLL for (int mi = 0; mi < 2; ++mi) {
                const int row = wm * 64 + mi * 32 + fr;
                const float gw = ew[row];
                float a[2][8];
                UNROLL for (int r = 0; r < 16; ++r) { const float gv = acc[mi][0][r], uv = acc[mi][1][r]; a[r >> 3][r & 7] = gv * frcp(1.f + __expf(-gv)) * uv * gw; }
                const int col0 = wn * 32 + 16 * fh, c0 = (col0 & 63) >> 3, swr = (row >> 1) & 7;
                char* arow_ = ACT + (col0 >> 6) * C::AB + row * 128;
                st8((bf16_t*)(arow_ + ((c0 ^ swr) << 4)), a[0]); st8((bf16_t*)(arow_ + (((c0 + 1) ^ swr) << 4)), a[1]);
            }
            __syncthreads();
            {
                const int sw = (fr >> 1) & 7, a_base = (wm * 64 + fr) * 128, b_base = (wn * 32 + fr) * 128;
                bf16x8 afr[2][4][2];
                UNROLL for (int kt = 0; kt < 2; ++kt) UNROLL for (int ks = 0; ks < 4; ++ks) UNROLL for (int mi = 0; mi < 2; ++mi)
                    afr[kt][ks][mi] = *(const bf16x8*)(ACT + kt * C::AB + a_base + mi * 4096 + ((2 * ks + fh) ^ sw) * 16);
#define MG2_MMA(sl_, A_) do { UNROLL for (int mi = 0; mi < 2; ++mi) UNROLL for (int r = 0; r < 16; ++r) A_[mi][r] = 0.f; \
                    UNROLL for (int kt = 0; kt < 2; ++kt) { const char* Bs_ = MG2_BUF(sl_, kt); \
                        UNROLL for (int ks = 0; ks < 4; ++ks) { const bf16x8 bfv = *(const bf16x8*)(Bs_ + b_base + ((2 * ks + fh) ^ sw) * 16); \
                            UNROLL for (int mi = 0; mi < 2; ++mi) A_[mi] = __builtin_amdgcn_mfma_f32_32x32x16_bf16(bfv, afr[kt][ks][mi], A_[mi], 0, 0, 0); } } } while (0)
#define MG2_EPI(sl_, A_) do { UNROLL for (int mi = 0; mi < 2; ++mi) { \
                        unsigned char* yrow = YB8 + (size_t)en2[mi] * 1024 + (sl_) * 128 + wn * 32 + 16 * fh; \
                        unsigned char* srow = YSC + ((size_t)(en2[mi] >> 3) * 64 + (sl_) * 8 + wn * 2 + fh) * 8 + (en2[mi] & 7); \
                        float m = 0.f; \
                        UNROLL for (int i = 0; i < 16; ++i) m = fmaxf(m, fabsf(A_[mi][i])); \
                        const unsigned be = max(__float_as_uint(m) >> 23, 7u); \
                        const float inv = __uint_as_float((261u - be) << 23); \
                        u32x4 w; \
                        UNROLL for (int q = 0; q < 4; ++q) { int d = 0; \
                            d = __builtin_amdgcn_cvt_pk_fp8_f32(A_[mi][4 * q] * inv, A_[mi][4 * q + 1] * inv, d, false); \
                            d = __builtin_amdgcn_cvt_pk_fp8_f32(A_[mi][4 * q + 2] * inv, A_[mi][4 * q + 3] * inv, d, true); \
                            if (q == 0) w.x = (unsigned)d; else if (q == 1) w.y = (unsigned)d; else if (q == 2) w.z = (unsigned)d; else w.w = (unsigned)d; } \
                        *(u32x4*)yrow = w; *srow = (unsigned char)be; } } while (0)
#define MG2_TOP(sl_, cnt_) do { asm volatile("s_waitcnt vmcnt(" #cnt_ ")" ::: "memory"); __builtin_amdgcn_s_barrier(); asm volatile("" ::: "memory"); \
                    if ((sl_) >= 1 && (sl_) < 7) MG2_ISSUE((sl_) + 1); asm volatile("" ::: "memory"); } while (0)
                int en2[2];
                UNROLL for (int mi = 0; mi < 2; ++mi) en2[mi] = lst[wm * 64 + mi * 32 + fr] - cb * 8;
                f32x16 aA[2], aB[2], aC[2];
                asm volatile("s_waitcnt vmcnt(4) lgkmcnt(0)" ::: "memory");
                __builtin_amdgcn_s_barrier(); asm volatile("" ::: "memory");
                MG2_ISSUE(2);
                asm volatile("" ::: "memory");
                MG2_MMA(0, aA); MG2_MMA(1, aB);
                asm volatile("s_waitcnt vmcnt(0)" ::: "memory");
                __builtin_amdgcn_s_barrier(); asm volatile("" ::: "memory");
                MG2_ISSUE(4); MG2_ISSUE(5);
                asm volatile("" ::: "memory");
                MG2_MMA(2, aC); MG2_EPI(0, aA); MG2_MMA(3, aA); MG2_EPI(1, aB);
                asm volatile("s_waitcnt vmcnt(8)" ::: "memory");
                __builtin_amdgcn_s_barrier(); asm volatile("" ::: "memory");
                MG2_ISSUE(6); MG2_ISSUE(7);
                asm volatile("" ::: "memory");
                MG2_MMA(4, aB); MG2_EPI(2, aC); MG2_MMA(5, aC); MG2_EPI(3, aA);
                asm volatile("s_waitcnt vmcnt(8)" ::: "memory");
                __builtin_amdgcn_s_barrier(); asm volatile("" ::: "memory");
                MG2_MMA(6, aA); MG2_EPI(4, aB); MG2_MMA(7, aB); MG2_EPI(5, aC);
                MG2_EPI(6, aA); MG2_EPI(7, aB);
#undef MG2_MMA
#undef MG2_EPI
#undef MG2_TOP
#undef MG2_BUF
#undef MG2_ISSUE
            }
        }
        cur ^= 1;
    }
#undef GLDS4
}


#define XB_TMO      128
#define XB_XCNT(j)  (256  + 64 * (j))
#define XB_XSUB(j)  (1280 + 64 * (j))
#define XB_XGEN(j)  (2304 + 64 * (j))
#define XB_TOP      3328
#define XB_TOPGEN   3392
#define XCD_BAR_WORDS 3456
#define XB_SPIN_CAP (1u << 18)
#define LAS __attribute__((address_space(3)))

__device__ __forceinline__ unsigned xb_ld(unsigned* p)              { return __hip_atomic_load(p, __ATOMIC_RELAXED, __HIP_MEMORY_SCOPE_AGENT); }
__device__ __forceinline__ unsigned xb_add(unsigned* p, unsigned v) { return __hip_atomic_fetch_add(p, v, __ATOMIC_RELAXED, __HIP_MEMORY_SCOPE_AGENT); }
__device__ __forceinline__ unsigned xb_xcc_id() { return (unsigned)__builtin_amdgcn_s_getreg((3 << 11) | 20) & 0xFu; }
#define XB_SPIN(cond, bar) do { unsigned _sp = 0; while (cond) { __builtin_amdgcn_s_sleep(1); \
    if ((++_sp & 255u) == 0u) { if (xb_ld(&(bar)[XB_TMO])) break; if (_sp > XB_SPIN_CAP) { atomicAdd(&(bar)[XB_TMO], 1u); break; } } } } while (0)

struct XcdBarrier { unsigned* bar; unsigned x; volatile LAS unsigned* st; };

__device__ __forceinline__ XcdBarrier xcd_barrier_post(unsigned* bar, volatile LAS unsigned* st) {
    XcdBarrier b; b.bar = bar; b.x = xb_xcc_id(); b.st = st;
    if (threadIdx.x == 0) { const unsigned rank = xb_add(&bar[XB_XCNT(b.x)], 1u); st[2] = b.x; st[3] = rank; }
    return b;
}
__device__ __forceinline__ void xcd_barrier_complete(unsigned* bar, unsigned x, unsigned& nloc, unsigned& nx) {
    const unsigned G = gridDim.x * gridDim.y * gridDim.z;
    unsigned sum, cnt, mine, sp = 0u;
    for (;;) {
        sum = 0u; cnt = 0u; mine = 0u;
#pragma unroll
        for (unsigned j = 0; j < 16; ++j) { const unsigned c = xb_ld(&bar[XB_XCNT(j)]); sum += c; cnt += (c > 0u) ? 1u : 0u; mine = (j == x) ? c : mine; }
        if (sum == G) break;
        __builtin_amdgcn_s_sleep(1);
        if ((++sp & 255u) == 0u) { if (xb_ld(&bar[XB_TMO])) break; if (sp > XB_SPIN_CAP) { atomicAdd(&bar[XB_TMO], 1u); break; } }
    }
    nloc = mine > 0u ? mine : 1u; nx = cnt > 0u ? cnt : 1u;
}
__device__ __forceinline__ void xcd_barrier(const XcdBarrier& b) {
    asm volatile("s_waitcnt vmcnt(0)" ::: "memory");
    __syncthreads();
    if (threadIdx.x == 0) {
        unsigned* bar = b.bar;
        __builtin_amdgcn_s_waitcnt(0);
        unsigned nloc = b.st[0], nx = b.st[1];
        if (nloc == 0u) { xcd_barrier_complete(bar, b.x, nloc, nx); b.st[0] = nloc; b.st[1] = nx; }
        const unsigned old = xb_add(&bar[XB_XSUB(b.x)], 1u);
        const unsigned gen = old / nloc;
        if (old + 1u == (gen + 1u) * nloc) {
            __builtin_amdgcn_fence(__ATOMIC_RELEASE, "agent");
            asm volatile("s_waitcnt vmcnt(0)" ::: "memory");
            const unsigned og = xb_add(&bar[XB_TOP], 1u);
            const unsigned tg = og / nx;
            if (og + 1u == (tg + 1u) * nx) xb_add(&bar[XB_TOPGEN], 1u);
            else XB_SPIN(xb_ld(&bar[XB_TOPGEN]) == tg, bar);
            __builtin_amdgcn_fence(__ATOMIC_ACQUIRE, "agent");
            xb_add(&bar[XB_XGEN(b.x)], 1u);
            asm volatile("s_waitcnt vmcnt(0)" ::: "memory");
        } else {
            XB_SPIN(xb_ld(&bar[XB_XGEN(b.x)]) == gen, bar);
            __builtin_amdgcn_fence(__ATOMIC_ACQUIRE, "agent");
            asm volatile("s_waitcnt vmcnt(0)" ::: "memory");
        }
    }
    __syncthreads();
}

enum { PH_MODCONV = 0, PH_HX, PH_GEMM_R, PH_RW_PREP, PH_RW_SCAN, PH_RW_READ, PH_RW_G, PH_GEMM_N, PH_NA_NORM, PH_NA_ATT, PH_GEMM_M, PH_ML_SCAN, PH_ML_READ,
       PH_GEMM_G, PH_MERGE, PH_OUT, PH_NORM2, PH_ROUTER, PH_ROUTE, PH_SHARED, PH_MOE_EXP, PH_MOE_COMB, PH_SHDOWN, PH_COUNT };

template <int PH> DEV void run_phase(const Params& p, int L, int sub, char* smem, Topo tp) {
    const int tid = TID(), lane = tid & 63, fr = lane & 31, fh = lane >> 5;
    char* ws = p.ws;
    const int ntl = L == 0 ? NT : NX;
    const bf16_t* HX = (const bf16_t*)(ws + OFF_HX);
    const bf16_t* WINT = (const bf16_t*)(ws + OFF_WINT);
    if constexpr (PH == PH_MODCONV) { if (L == 0) { ph_mod(p, 0, smem); ph_mod(p, 1, smem); } ph_conv_mix(p, L, smem); }
    else if constexpr (PH == PH_HX) { ph_norm(p, L, 0, NT); }
    else if constexpr (PH == PH_GEMM_R || PH == PH_GEMM_M) {
        const int c0 = PH == PH_GEMM_R ? 0 : RW_COLS + NA_COLS;
        const int N = PH == PH_GEMM_R ? RW_COLS : ML_COLS;
        bf16_t* PX = (bf16_t*)(ws + OFF_PX);
        if constexpr (PH == PH_GEMM_R) {
            gemm256(HX, NT, WINT, 1792, DM, smem, tp, [&](int row, int col, const float (&v)[8]) { st8(PX + (size_t)row * RW_COLS + col, v); });
            gemm_phase<4, 2>(HX, DM, NT, WINT + (size_t)1792 * DM, DM, 128, DM, smem, tp, [&](const f32x16 (&acc)[2][2], int row0, int col0) {
                epi_rows(acc, smem, [&](int row, int c8, const float (&v)[8]) { st8(PX + (size_t)(row0 + row) * RW_COLS + 1792 + col0 + c8, v); });
            });
        } else {
            gemm256(HX, NT, WINT + (size_t)c0 * DM, N, DM, smem, tp, [&](int row, int col, const float (&v)[8]) {
                if (col < N) st8(PX + (size_t)row * N + col, v);
            });
        }
    }
    else if constexpr (PH == PH_GEMM_N) {
        {

        bf16_t* YA = (bf16_t*)(ws + OFF_YA);
        gemm_phase<4, 2>((const bf16_t*)(ws + OFF_SGB), 128, ntl, (const bf16_t*)(ws + OFF_G2T), 128, 512, 128, smem, tp, [&](const f32x16 (&acc)[2][2], int row0, int col0) {
            epi_rows(acc, smem, [&](int row, int c8, const float (&v)[8]) {
                bf16_t* q = YA + (size_t)(row0 + row) * 512 + col0 + c8;
                float y[8]; ld8(q, y);
                UNROLL for (int i = 0; i < 8; ++i) y[i] *= v[i];
                st8(q, y);
            });
        });
                __syncthreads();
        }
        bf16_t* PX = (bf16_t*)(ws + OFF_PX); bf16_t* VT = (bf16_t*)(ws + OFF_VT); bf16_t* VTC = (bf16_t*)(ws + OFF_VTC);
        gemm256(HX, NT, WINT + (size_t)RW_COLS * DM, 1024, DM, smem, tp, [&](int row, int col, const float (&v)[8]) { st8(PX + (size_t)row * 1024 + col, v); });
        const Topo tv{tp.x, (tp.r + (tp.n >> 1)) % tp.n, tp.n};
        gemm_phase<4, 2>(HX, DM, NT, WINT + (size_t)(RW_COLS + 1024) * DM, DM, 512, DM, smem, tv, [&](const f32x16 (&acc)[2][2], int row0, int col0) {
            const int h = col0 >> 6;
            epi_cols(acc, smem, [&](int r8, int col, const float (&v)[8]) {
                const int n = row0 + r8;
                bf16_t* dst = n < NX ? VT + ((size_t)((n >> 11) * 8 + h) * 64 + col) * SEQ + (n & 2047)
                                     : VTC + ((size_t)(((n - NX) >> 8) * 8 + h) * 64 + col) * CTXL + ((n - NX) & 255);
                st8(dst, v);
            });
        });
    }
    else if constexpr (PH == PH_RW_PREP) { ph_rw_prep(p, L, smem); }
    else if constexpr (PH == PH_RW_SCAN) { ph_rw_scan(p, L, smem); }
    else if constexpr (PH == PH_RW_READ) { ph_rw_read(p, L, ntl); }
    else if constexpr (PH == PH_NA_NORM) { ph_na_norm(p, L); }
    else if constexpr (PH == PH_NA_ATT) { ph_na_att(p, L, smem); }
    else if constexpr (PH == PH_ML_SCAN) {
        if (blockIdx.x < 128 || gridDim.x <= 128) ph_ml_scan(p, L, smem);
        if (gridDim.x <= 128) ph_conv_moe_gu(p, L, smem, blockIdx.x, gridDim.x);
        else if (blockIdx.x >= 128) ph_conv_moe_gu(p, L, smem, blockIdx.x - 128, gridDim.x - 128);
    }
    else if constexpr (PH == PH_ML_READ) { ph_ml_read(p, L, ntl); }
    else if constexpr (PH == PH_GEMM_G) {
        bf16_t* G = (bf16_t*)(ws + OFF_GATES);
        gemm256(HX, ntl, WINT + (size_t)(RW_COLS + NA_COLS + ML_COLS) * DM, GATE_COLS, DM, smem, tp, [&](int row, int col, const float (&v)[8]) {
            float y[8];
            UNROLL for (int i = 0; i < 8; ++i) y[i] = sigm(v[i]);
            const int pm = row >> 7, r = row & 127, br = col >> 10, c = col & 1023, pn = c >> 8, cc = c & 255;
            const int wv = (r >> 6) * 4 + (cc >> 6), pc = ((r >> 5) & 1) * 4 + ((cc >> 5) & 1) * 2 + ((cc >> 3) & 1), ln = ((cc >> 4) & 1) * 32 + (r & 31);
            st8(G + ((((size_t)(pm * 4 + pn) * 3 + br) * 8 + wv) * 8 + pc) * 512 + ln * 8, y);
        });
    }
    else if constexpr (PH == PH_MERGE) {
        typedef GC<2, 4> C;
        const bf16_t* G = (const bf16_t*)(ws + OFF_GATES); bf16_t* MG = (bf16_t*)(ws + OFF_HX);
        const int wave = tid >> 6, wm = wave / 4, wn = wave % 4;
        const TileOrder ord(tp, ntl / C::BM, DM / C::BN);
        for (int q = tp.r; q < ord.total; q += tp.n) {
            int pm, pn; if (!ord.get(q, pm, pn)) continue;
            int tido = tid; asm volatile("" : "+v"(tido));
            const int fro = tido & 31, fho = (tido & 63) >> 5;
            const size_t row0 = (size_t)pm * C::BM + wm * 64 + fro; const int col0 = pn * C::BN + wn * 64 + 16 * fho;
            f32x16 tot[2][2], acc[2][2]; acc_zero(tot); acc_zero(acc);
            u32x4 graw[2][2][2];
#define MRG_GATES(br_) do { const bf16_t* gb_ = G + ((((size_t)(pm * 4 + pn) * 3 + (br_)) * 8 + wave) * 8) * 512 + (tido & 63) * 8; \
                UNROLL for (int mi = 0; mi < 2; ++mi) UNROLL for (int ni = 0; ni < 2; ++ni) UNROLL for (int hh = 0; hh < 2; ++hh) \
                    graw[mi][ni][hh] = *(const u32x4*)(gb_ + (mi * 4 + ni * 2 + hh) * 512); } while (0)
            MRG_GATES(0);
            const bf16_t* Ab = (const bf16_t*)(ws + OFF_YA) + (size_t)pm * C::BM * 512;
            gemm_tile<2, 4, 3, false, true>(acc, [&](int r) { return Ab + (size_t)r * 512; }, (const bf16_t*)(ws + OFF_WBT), 512, pn * C::BN, DM, 1536, smem, nullptr,
                [](int kt) { return (size_t)(kt >> 3) * (SZ_Y1 / 2) + (size_t)(kt & 7) * 64; },
                [](int kt) { return (size_t)(kt >> 3) * ((size_t)1024 * 512) + (size_t)(kt & 7) * 64; },
                [&](int kt) {
                    if ((kt & 7) == 7) {
                        UNROLL for (int mi = 0; mi < 2; ++mi) UNROLL for (int ni = 0; ni < 2; ++ni) UNROLL for (int hh = 0; hh < 2; ++hh) {
                            float g[8]; unpack8(graw[mi][ni][hh], g);
                            UNROLL for (int i = 0; i < 8; ++i) { tot[mi][ni][8 * hh + i] += g[i] * acc[mi][ni][8 * hh + i]; acc[mi][ni][8 * hh + i] = 0.f; }
                        }
                        if (kt < 23) MRG_GATES((kt >> 3) + 1);
                    }
                });
#undef MRG_GATES
            UNROLL for (int mi = 0; mi < 2; ++mi) UNROLL for (int ni = 0; ni < 2; ++ni) UNROLL for (int hh = 0; hh < 2; ++hh) {
                float v[8]; UNROLL for (int i = 0; i < 8; ++i) v[i] = tot[mi][ni][8 * hh + i];
                st8(MG + (row0 + mi * 32) * DM + col0 + ni * 32 + 8 * hh, v);
            }
        }
    }
    else if constexpr (PH == PH_OUT) {
        bf16_t* AO = (bf16_t*)(ws + OFF_AO);
        gemm256(HX, ntl, (const bf16_t*)(ws + OFF_WOUTT), DM, DM, smem, tp, [&](int n, int c, const float (&v)[8]) { st8(AO + (size_t)n * DM + c, v); });
    }
    else if constexpr (PH == PH_NORM2) {
        if (blockIdx.x == 0 && tid < 384) ((int*)(ws + OFF_MCNT))[tid] = 0;
        ph_norm(p, L, 1, ntl);
    }
    else if constexpr (PH == PH_ROUTER) {
        typedef GC<4, 2> C;
        float* LOG = (float*)(ws + OFF_LOG);
        const bf16_t* H2LO = (const bf16_t*)(ws + OFF_H2LO); const bf16_t* RH = (const bf16_t*)(ws + OFF_RTR); const bf16_t* RL = RH + 64 * 1024;
        const int wave = tid >> 6, wm = wave / 2, wn = wave % 2;
        {
            const int nrt = ntl / C::BM, G = gridDim.x;
            if (G > nrt) { if ((int)blockIdx.x >= nrt) ph_conv_moe(p, L, smem, blockIdx.x - nrt, G - nrt); }
            else ph_conv_moe(p, L, smem, blockIdx.x, G);
            if (L == 0 && G >= nrt + 16 && (int)blockIdx.x >= nrt) {
                __syncthreads();
                int id = blockIdx.x - nrt; asm volatile("" : "+s"(id));
                const int ns = (G - nrt) >> 3;
                if (id < ns * 8) {
                    bf16_t* SA = (bf16_t*)(ws + OFF_SA) + (size_t)NX * 256;
                    gemm256_pair(HX + (size_t)NX * DM, NC, (const bf16_t*)(ws + OFF_SGUT), 512, DM, smem, Topo{id & 7, id >> 3, ns}, [&](int row, int col, const float (&g)[8], const float (&u)[8]) {
                        float a[8];
                        UNROLL for (int i = 0; i < 8; ++i) a[i] = g[i] * frcp(1.f + __expf(-g[i])) * u[i];
                        st8(SA + (size_t)row * 256 + (col >> 8) * 128 + (col & 127), a);
                    });
                }
                __syncthreads();
            }
        }
        const size_t lo_off = (size_t)((const bf16_t*)(ws + OFF_H2LO) - HX);
        for (int t = blockIdx.x; t < ntl / C::BM; t += gridDim.x) {
            f32x16 acc[2][2]; acc_zero(acc);
            const bf16_t* A0 = HX + (size_t)t * C::BM * DM;
            gemm_tile<4, 2, 3, false>(acc, [&](int r) { return A0 + (size_t)r * DM; }, RH, DM, 0, 128, 2048, smem, nullptr,
                [&](int kt) { return (size_t)(kt >> 4) * lo_off + (size_t)(kt & 15) * 64; }, [](int kt) { return (size_t)(kt & 15) * 64; });
            const int lane = tid & 63, fr2 = lane & 31, fh2 = lane >> 5;
            float* st = (float*)(smem + wave * EPI_SLAB);
            UNROLL for (int mi = 0; mi < 2; ++mi) {
                UNROLL for (int ni = 0; ni < 2; ++ni) UNROLL for (int r = 0; r < 16; ++r)
                    st[((r & 3) + 8 * (r >> 2) + 4 * fh2) * 68 + ni * 32 + fr2] = acc[mi][ni][r];
                __syncthreads();
                if (wn == 0) {
                    const float* st1 = (const float*)(smem + (wave + 1) * EPI_SLAB);
                    UNROLL for (int it = 0; it < 4; ++it) {
                        const int row = it * 8 + (lane >> 3), c8 = (lane & 7) * 8;
                        const float4 a0 = *(const float4*)(st + row * 68 + c8), a1 = *(const float4*)(st + row * 68 + c8 + 4);
                        const float4 b0 = *(const float4*)(st1 + row * 68 + c8), b1 = *(const float4*)(st1 + row * 68 + c8 + 4);
                        float* q = LOG + (size_t)(t * C::BM + wm * 64 + mi * 32 + row) * 64 + c8;
                        *(float4*)q = make_float4(a0.x + b0.x, a0.y + b0.y, a0.z + b0.z, a0.w + b0.w); *(float4*)(q + 4) = make_float4(a1.x + b1.x, a1.y + b1.y, a1.z + b1.z, a1.w + b1.w);
                    }
                }
                __syncthreads();
            }
        }
    }
    else if constexpr (PH == PH_ROUTE) {
        ph_route(p, L, ntl, smem);
        __syncthreads();
        bf16_t* SA = (bf16_t*)(ws + OFF_SA);
        const int msh = (L == 0 && (int)gridDim.x >= NT / 256 + 16) ? NX : ntl;
        gemm256_pair(HX, msh, (const bf16_t*)(ws + OFF_SGUT), 512, DM, smem, tp, [&](int row, int col, const float (&g)[8], const float (&u)[8]) {
            float a[8];
            UNROLL for (int i = 0; i < 8; ++i) a[i] = g[i] * frcp(1.f + __expf(-g[i])) * u[i];
            st8(SA + (size_t)row * 256 + (col >> 8) * 128 + (col & 127), a);
        });
    }
    else if constexpr (PH == PH_SHARED) {
        ph_moe_scatter(p, ntl, moe_chunk(L), smem);
        __syncthreads();
        bf16_t* SHX = (bf16_t*)(ws + OFF_SHX);
        int k256 = 256; asm volatile("" : "+s"(k256));
        gemm256((const bf16_t*)(ws + OFF_SA), ntl, (const bf16_t*)(ws + OFF_SDT), DM, k256, smem, tp, [&](int row, int col, const float (&v)[8]) { st8(SHX + (size_t)row * DM + col, v); });
    }
    else if constexpr (PH == PH_MOE_EXP) {
        const int cb = sub * moe_chunk(L); ph_moe_exp(p, sub, cb, min(cb + moe_chunk(L), ntl), smem, tp);
    }
    else if constexpr (PH == PH_MOE_COMB) {
        const int cb = sub * moe_chunk(L), ce = min(cb + moe_chunk(L), ntl), wave = tid >> 6, c0 = lane * 16;
        const float* MOD = (const float*)(ws + OFF_MOD + L * MOD_SZ); const unsigned char* YB8 = (const unsigned char*)(ws + OFF_YBUF); const unsigned char* YSC = (const unsigned char*)(ws + OFF_YSC);
        const bf16_t* SHX = (const bf16_t*)(ws + OFF_SHX);
        for (int n0 = cb + blockIdx.x * 8; n0 < ce; n0 += gridDim.x * 8) {
            const int n = n0 + wave, rl = n - cb;
            float* xo = xs_row(p, n) + c0; const float* g2 = MOD + mod_row(n) * 6144 + 5 * DM + c0;
            u32x4 d[8];
            UNROLL for (int k = 0; k < 8; ++k) d[k] = *(const u32x4*)(YB8 + ((size_t)rl * 8 + k) * DM + c0);
            const u32x2 sc = *(const u32x2*)(YSC + ((size_t)rl * 64 + lane) * 8);
            float sa[8], sb[8], s[16];
            ld8(SHX + (size_t)n * DM + c0, sa); ld8(SHX + (size_t)n * DM + c0 + 8, sb);
            UNROLL for (int i = 0; i < 8; ++i) { s[i] = sa[i]; s[8 + i] = sb[i]; }
            float4 xv[4], gv[4], ng[4], n1[4], n0v[4];
            UNROLL for (int q = 0; q < 4; ++q) { xv[q] = *(const float4*)(xo + 4 * q); gv[q] = *(const float4*)(g2 + 4 * q); }
            if (L == 0) {
                const float* g = p.in[I_N1G] + DM + c0; const float* sh = (const float*)(ws + OFF_MOD + MOD_SZ) + mod_row(n) * 6144 + c0;
                UNROLL for (int q = 0; q < 4; ++q) { ng[q] = *(const float4*)(g + 4 * q); n0v[q] = *(const float4*)(sh + 4 * q); n1[q] = *(const float4*)(sh + DM + 4 * q); }
            }
            UNROLL for (int k = 0; k < 8; ++k) {
                const unsigned be = ((k < 4 ? sc.x : sc.y) >> (8 * (k & 3))) & 255u;
                const float scl = __uint_as_float((be - 7u) << 23);
                typedef float f2v __attribute__((ext_vector_type(2)));
                const unsigned w4[4] = {d[k].x, d[k].y, d[k].z, d[k].w};
                UNROLL for (int q = 0; q < 4; ++q) {
                    const f2v y0 = __builtin_amdgcn_cvt_pk_f32_fp8((int)w4[q], false), y1 = __builtin_amdgcn_cvt_pk_f32_fp8((int)w4[q], true);
                    s[4 * q] += y0.x * scl; s[4 * q + 1] += y0.y * scl; s[4 * q + 2] += y1.x * scl; s[4 * q + 3] += y1.y * scl;
                }
            }
            float xn[16];
            UNROLL for (int q = 0; q < 4; ++q) {
                float4 o; o.x = xv[q].x + gv[q].x * s[4 * q]; o.y = xv[q].y + gv[q].y * s[4 * q + 1]; o.z = xv[q].z + gv[q].z * s[4 * q + 2]; o.w = xv[q].w + gv[q].w * s[4 * q + 3];
                *(float4*)(xo + 4 * q) = o;
                xn[4 * q] = o.x; xn[4 * q + 1] = o.y; xn[4 * q + 2] = o.z; xn[4 * q + 3] = o.w;
            }
            if (L == 0) {
                float ss = 0.f;
                UNROLL for (int i = 0; i < 16; ++i) ss += xn[i] * xn[i];
                UNROLL for (int o = 1; o < 64; o <<= 1) ss += __shfl_xor(ss, o);
                const float rstd = rsqrtf(ss * (1.f / DM) + 1e-6f);
                float h[16];
                UNROLL for (int q = 0; q < 4; ++q) {
                    const float4 gg = ng[q], s1 = n1[q], s0 = n0v[q];
                    h[4 * q] = xn[4 * q] * rstd * gg.x * (1.f + s1.x) + s0.x; h[4 * q + 1] = xn[4 * q + 1] * rstd * gg.y * (1.f + s1.y) + s0.y;
                    h[4 * q + 2] = xn[4 * q + 2] * rstd * gg.z * (1.f + s1.z) + s0.z; h[4 * q + 3] = xn[4 * q + 3] * rstd * gg.w * (1.f + s1.w) + s0.w;
                }
                bf16_t* hx = (bf16_t*)(ws + OFF_HX) + (size_t)n * DM + c0;
                float h0[8], h1[8];
                UNROLL for (int i = 0; i < 8; ++i) { h0[i] = h[i]; h1[i] = h[8 + i]; }
                st8(hx, h0); st8(hx + 8, h1);
            }
        }
    }
}

#ifndef N_LAUNCH_MODE
#define N_LAUNCH_MODE 1
#endif
#if N_LAUNCH_MODE == 0
template <int PH> __global__ void __launch_bounds__(NTHREADS, 2) k_phase(Params p, int L, int sub) {
    extern __shared__ __attribute__((aligned(16))) char smem[];
    run_phase<PH>(p, L, sub, smem, Topo{(int)(blockIdx.x & 7), (int)(blockIdx.x >> 3), (int)((gridDim.x + 7 - (blockIdx.x & 7)) >> 3)});
}
#endif


#ifndef MEGA_SKIP
#define MEGA_SKIP 0ull
#endif
#ifndef MEGA_REPEAT
#define MEGA_REPEAT 0ull
#endif
#define BARRIER() do { XcdBarrier b2_ = bar; unsigned so_ = LDS_BYTES; asm volatile("" : "+v"(so_)); b2_.st = (volatile LAS unsigned*)(smem + so_); xcd_barrier(b2_); } while (0)
#define PHASE(PH, sub) do { if constexpr (!((MEGA_SKIP >> PH) & 1ull)) { run_phase<PH>(p, L, sub, smem, tp); BARRIER(); if constexpr ((MEGA_REPEAT >> PH) & 1ull) { run_phase<PH>(p, L, sub, smem, tp); BARRIER(); } } } while (0)
__global__ void __launch_bounds__(NTHREADS, 2) k_mega(Params p) {
    extern __shared__ __attribute__((aligned(16))) char smem[];
    volatile LAS unsigned* st = (volatile LAS unsigned*)(smem + LDS_BYTES);
    if (threadIdx.x == 0) { st[0] = 0u; st[1] = 0u; st[2] = 0u; st[3] = 0u; }
    __syncthreads();
    const XcdBarrier bar = xcd_barrier_post((unsigned*)(p.ws + OFF_BAR), st);
    Topo tp{(int)(blockIdx.x & 7), (int)(blockIdx.x >> 3), (int)((gridDim.x + 7 - (blockIdx.x & 7)) >> 3)};
    for (int L = 0; L < 2; ++L) {
        const int ntl = L == 0 ? NT : NX;
        PHASE(PH_MODCONV, 0);
        if (st[1] == 8u && st[0] != 0u) { tp.x = (int)st[2]; tp.r = (int)st[3]; tp.n = (int)st[0]; }
        if (L == 0) { PHASE(PH_HX, 0); }
        PHASE(PH_GEMM_R, 0);
        PHASE(PH_RW_PREP, 0);
        PHASE(PH_RW_SCAN, 0);
        PHASE(PH_RW_READ, 0);
        PHASE(PH_GEMM_N, 0);
        PHASE(PH_NA_ATT, 0);
        PHASE(PH_GEMM_M, 0);
        PHASE(PH_ML_SCAN, 0);
        PHASE(PH_ML_READ, 0);
        PHASE(PH_GEMM_G, 0);
        PHASE(PH_MERGE, 0);
        PHASE(PH_OUT, 0);
        PHASE(PH_NORM2, 0);
        PHASE(PH_ROUTER, 0);
        PHASE(PH_ROUTE, 0);
        PHASE(PH_SHARED, 0);
        for (int c = 0; c * moe_chunk(L) < ntl; ++c) {
            PHASE(PH_MOE_EXP, c);
            PHASE(PH_MOE_COMB, c);
        }
    }
}

#if N_LAUNCH_MODE == 0
template <int PH> static void launch_phase(const Params& p, int L, int sub, hipStream_t stream) {
    static bool attr = false;
    if (!attr) { (void)hipFuncSetAttribute((const void*)k_phase<PH>, hipFuncAttributeMaxDynamicSharedMemorySize, LDS_BYTES); attr = true; }
    hipLaunchKernelGGL(k_phase<PH>, dim3(256), dim3(NTHREADS), LDS_BYTES, stream, p, L, sub);
}
#endif

extern "C" void kernel_launch(void* const* d_in, const int* in_sizes, int n_in, void* d_out, int out_size, void* d_ws, size_t ws_size, hipStream_t stream) {
    if (n_in != N_IN || ws_size < WS_END) { fprintf(stderr, "kernel_launch: unexpected inputs (%d) or workspace (%zu < %zu)\n", n_in, ws_size, (size_t)WS_END); return; }
    Params p{};
    for (int i = 0; i < N_IN; ++i) p.in[i] = (const float*)d_in[i];
    p.out = (float*)d_out; p.ws = (char*)d_ws;
#if N_LAUNCH_MODE == 1
    static int grid = 0;
    if (grid == 0) {
        int dev = 0, cus = 0;
        if (hipGetDevice(&dev) != hipSuccess || hipDeviceGetAttribute(&cus, hipDeviceAttributeMultiprocessorCount, dev) != hipSuccess) { grid = -1; return; }
        if (hipFuncSetAttribute((const void*)k_mega, hipFuncAttributeMaxDynamicSharedMemorySize, LDS_BYTES + 256) != hipSuccess) { grid = -1; return; }
        grid = cus;
    }
    if (grid <= 0) return;
    (void)hipMemsetAsync((char*)d_ws + OFF_BAR, 0, XCD_BAR_WORDS * sizeof(unsigned), stream);
    hipLaunchKernelGGL(k_mega, dim3(grid), dim3(NTHREADS), LDS_BYTES + 256, stream, p);
    return;
#endif
#if N_LAUNCH_MODE == 0
    for (int L = 0; L < 2; ++L) {
        const int ntl = L == 0 ? NT : NX;
        launch_phase<PH_MODCONV>(p, L, 0, stream);
        launch_phase<PH_HX>(p, L, 0, stream);
        launch_phase<PH_GEMM_R>(p, L, 0, stream);
        launch_phase<PH_RW_PREP>(p, L, 0, stream);
        launch_phase<PH_RW_SCAN>(p, L, 0, stream);
        launch_phase<PH_RW_READ>(p, L, 0, stream);
        launch_phase<PH_GEMM_N>(p, L, 0, stream);
        launch_phase<PH_NA_ATT>(p, L, 0, stream);
        launch_phase<PH_GEMM_M>(p, L, 0, stream);
        launch_phase<PH_ML_SCAN>(p, L, 0, stream);
        launch_phase<PH_ML_READ>(p, L, 0, stream);
        launch_phase<PH_GEMM_G>(p, L, 0, stream);
        launch_phase<PH_MERGE>(p, L, 0, stream);
        launch_phase<PH_OUT>(p, L, 0, stream);
        launch_phase<PH_NORM2>(p, L, 0, stream);
        launch_phase<PH_ROUTER>(p, L, 0, stream);
        launch_phase<PH_ROUTE>(p, L, 0, stream);
        launch_phase<PH_SHARED>(p, L, 0, stream);
        for (int c = 0; c * moe_chunk(L) < ntl; ++c) {
            launch_phase<PH_MOE_EXP>(p, L, c, stream);
            launch_phase<PH_MOE_COMB>(p, L, c, stream);
        }
    }
#endif
}
```
